# Optimizing an MI355X kernel written in HIP

```python
import jax, jax.numpy as jnp
from jax import lax
import numpy as np

D_MODEL = 1024
BATCH = 8
SEQ = 8192
DEPTH = 1

NSA_HEADS = 8
NSA_KV_GROUPS = 2
NSA_REP = NSA_HEADS // NSA_KV_GROUPS
HEAD_DIM = 64
NSA_WIDTH = NSA_HEADS * HEAD_DIM
KV_WIDTH = NSA_KV_GROUPS * HEAD_DIM
CMP_BLOCK = 32
CMP_STRIDE = 16
CMP_HIDDEN = 2 * HEAD_DIM
SEL_BLOCK = 64
SEL_TOPK = 16
WINDOW = 512
Q_BLOCK = 64
ROPE_THETA = 10000.0
SGU_GROUPS = 8
SGU_WIDTH = D_MODEL // 2
SGU_GROUP_DIM = SGU_WIDTH // SGU_GROUPS
SGU_CHUNK = 128
IN_COLS = NSA_WIDTH + 6 * KV_WIDTH + 3 * NSA_HEADS + 2 * SGU_WIDTH
PEER_HEADS = 8
PEER_NKEYS = 128
PEER_EXPERTS = PEER_NKEYS * PEER_NKEYS
PEER_QDIM = 256
PEER_HALF = PEER_QDIM // 2
PEER_TOPK = 16
PEER_TOK_BLOCK = 128
DN_ALPHA = (2.0 * DEPTH) ** 0.25
DN_BETA = (8.0 * DEPTH) ** -0.25
LN_EPS = 1e-5
NEG_INF = -1e30
FORCE_SCORE = 1e9

kernel_name = 'hybrid_nsa_sgu_peer_block'


def _layernorm(x, g=None, b=None):
    xf = x.astype(jnp.float32)
    mu = jnp.mean(xf, axis=-1, keepdims=True)
    var = jnp.mean(jnp.square(xf - mu), axis=-1, keepdims=True)
    y = (xf - mu) * lax.rsqrt(var + LN_EPS)
    if g is not None:
        y = y * g.astype(jnp.float32) + b.astype(jnp.float32)
    return y.astype(x.dtype)


def _rope(t):
    half = HEAD_DIM // 2
    pos = jnp.arange(t.shape[1], dtype=jnp.float32)
    inv_freq = ROPE_THETA ** (-jnp.arange(half, dtype=jnp.float32) / half)
    ang = pos[:, None] * inv_freq[None, :]
    cos = jnp.cos(ang)[:, None, :]
    sin = jnp.sin(ang)[:, None, :]
    tf = t.astype(jnp.float32)
    t1, t2 = tf[..., :half], tf[..., half:]
    return jnp.concatenate([t1 * cos - t2 * sin, t1 * sin + t2 * cos], axis=-1).astype(t.dtype)


def _masked_softmax(s, mask):
    p = jax.nn.softmax(jnp.where(mask, s, NEG_INF), axis=-1)
    return p * mask


def _compress(t, pos_emb, w1, b1, w2, b2):
    B, S, G, _ = t.shape
    n_cmp = (S - CMP_BLOCK) // CMP_STRIDE + 1
    idx = np.arange(n_cmp)[:, None] * CMP_STRIDE + np.arange(CMP_BLOCK)[None, :]
    blk = t[:, idx] + pos_emb[:, None, :]
    blk = jnp.moveaxis(blk, 3, 2).reshape(B, n_cmp, G, CMP_BLOCK * HEAD_DIM)
    hid = jax.nn.gelu(blk @ w1 + b1, approximate=False)
    return hid @ w2 + b2


def _sel_aggregation(n_cmp, n_sel):
    c0 = np.arange(n_cmp)[:, None] * CMP_STRIDE
    s0 = np.arange(n_sel)[None, :] * SEL_BLOCK
    ov = np.clip(np.minimum(c0 + CMP_BLOCK, s0 + SEL_BLOCK) - np.maximum(c0, s0), 0, None)
    return (ov / CMP_BLOCK).astype(np.float32)


def _nsa(q, kc, vc, ks, vs, kw, vw, gate_logits):
    B, S = q.shape[0], q.shape[1]
    G, R, HD = NSA_KV_GROUPS, NSA_REP, HEAD_DIM
    n_cmp = kc.shape[1]
    n_sel = S // SEL_BLOCK
    k_top = min(SEL_TOPK, n_sel)
    n_qb = S // Q_BLOCK
    scale = HD ** -0.5
    cmp_end = jnp.arange(n_cmp) * CMP_STRIDE + CMP_BLOCK - 1
    agg = jnp.asarray(_sel_aggregation(n_cmp, n_sel))
    blk_id = jnp.arange(n_sel)
    ks_b = ks.reshape(B, n_sel, SEL_BLOCK, G, HD).transpose(0, 3, 1, 2, 4)
    vs_b = vs.reshape(B, n_sel, SEL_BLOCK, G, HD).transpose(0, 3, 1, 2, 4)
    pad = ((0, 0), (WINDOW, 0), (0, 0), (0, 0))
    kw_p = jnp.pad(kw, pad)
    vw_p = jnp.pad(vw, pad)
    span = Q_BLOCK + WINDOW
    gather = jax.vmap(jax.vmap(lambda tab, idx: tab[idx]))

    def block(args):
        qb, q_blk, g_blk = args
        t = qb * Q_BLOCK + jnp.arange(Q_BLOCK)
        qg = q_blk.reshape(B, Q_BLOCK, G, R, HD)
        s_c = jnp.einsum('bqgrd,bngd->bgrqn', qg, kc).astype(jnp.float32) * scale
        p_c = _masked_softmax(s_c, cmp_end[None, :] <= t[:, None])
        o_c = jnp.einsum('bgrqn,bngd->bqgrd', p_c.astype(vc.dtype), vc)
        imp = jnp.einsum('bgrqn,nj->bgqj', p_c, agg)
        cur = (t // SEL_BLOCK)[:, None]
        forced = (blk_id == 0) | (blk_id == cur) | (blk_id == cur - 1)
        imp = jnp.where(forced, FORCE_SCORE, jnp.where(blk_id <= cur, imp, NEG_INF))
        _, sel = lax.top_k(imp, k_top)
        k_g = gather(ks_b, sel)
        v_g = gather(vs_b, sel)
        kpos = sel[..., None] * SEL_BLOCK + jnp.arange(SEL_BLOCK)
        valid_s = (kpos <= t[:, None, None]).reshape(B, G, 1, Q_BLOCK, k_top * SEL_BLOCK)
        s_s = jnp.einsum('bqgrd,bgqnkd->bgrqnk', qg, k_g).astype(jnp.float32) * scale
        p_s = _masked_softmax(s_s.reshape(B, G, R, Q_BLOCK, k_top * SEL_BLOCK), valid_s)
        o_s = jnp.einsum('bgrqm,bgqmd->bqgrd', p_s.astype(vs.dtype),
                         v_g.reshape(B, G, Q_BLOCK, k_top * SEL_BLOCK, HD))
        start = qb * Q_BLOCK
        k_w = lax.dynamic_slice_in_dim(kw_p, start, span, axis=1)
        v_w = lax.dynamic_slice_in_dim(vw_p, start, span, axis=1)
        kpos_w = start - WINDOW + jnp.arange(span)
        dlt = t[:, None] - kpos_w[None, :]
        valid_w = (dlt >= 0) & (dlt < WINDOW) & (kpos_w[None, :] >= 0)
        s_w = jnp.einsum('bqgrd,bkgd->bgrqk', qg, k_w).astype(jnp.float32) * scale
        p_w = _masked_softmax(s_w, valid_w)
        o_w = jnp.einsum('bgrqk,bkgd->bqgrd', p_w.astype(vw.dtype), v_w)
        g = jax.nn.sigmoid(g_blk.astype(jnp.float32)).reshape(B, Q_BLOCK, G, R, 3).astype(q.dtype)
        o = g[..., 0:1] * o_c + g[..., 1:2] * o_s + g[..., 2:3] * o_w
        return o.reshape(B, Q_BLOCK, NSA_WIDTH)

    qs = q.reshape(B, n_qb, Q_BLOCK, NSA_HEADS, HD).swapaxes(0, 1)
    gs = gate_logits.reshape(B, n_qb, Q_BLOCK, NSA_HEADS, 3).swapaxes(0, 1)
    out = lax.map(block, (jnp.arange(n_qb), qs, gs))
    return out.swapaxes(0, 1).reshape(B, S, NSA_WIDTH)


def _sgu(z, ln_g, ln_b, w_s, b_s):
    B, S, _ = z.shape
    z = jax.nn.gelu(z, approximate=False)
    u, v = z[..., :SGU_WIDTH], z[..., SGU_WIDTH:]
    v = _layernorm(v, ln_g, ln_b)
    v = v.reshape(B, S // SGU_CHUNK, SGU_CHUNK, SGU_GROUPS, SGU_GROUP_DIM)
    mixed = jnp.einsum('gij,bcjgd->bcigd', jnp.tril(w_s), v) + b_s.T[None, None, :, :, None]
    return u * mixed.reshape(B, S, SGU_WIDTH)


def _peer(h, w_q, sub_keys, expert_u, expert_v):
    B, S, D = h.shape
    tokens = h.reshape((B * S) // PEER_TOK_BLOCK, PEER_TOK_BLOCK, D)

    def step(xt):
        qh = (xt @ w_q).reshape(PEER_TOK_BLOCK, PEER_HEADS, 2, PEER_HALF)
        s = jnp.einsum('thcd,hcnd->thcn', qh, sub_keys).astype(jnp.float32)
        s1, i1 = lax.top_k(s[:, :, 0], PEER_TOPK)
        s2, i2 = lax.top_k(s[:, :, 1], PEER_TOPK)
        cand = (s1[..., :, None] + s2[..., None, :]).reshape(PEER_TOK_BLOCK, PEER_HEADS, PEER_TOPK * PEER_TOPK)
        cidx = (i1[..., :, None] * PEER_NKEYS + i2[..., None, :]).reshape(PEER_TOK_BLOCK, PEER_HEADS, PEER_TOPK * PEER_TOPK)
        top_s, pos = lax.top_k(cand, PEER_TOPK)
        eidx = jnp.take_along_axis(cidx, pos, axis=-1)
        gate = jax.nn.softmax(top_s, axis=-1)
        u = expert_u[eidx]
        act = jax.nn.gelu(jnp.einsum('thkd,td->thk', u, xt).astype(jnp.float32), approximate=False)
        w = (gate * act).astype(xt.dtype)
        return jnp.einsum('thk,thkd->td', w, expert_v[eidx])

    return lax.map(step, tokens).reshape(B, S, D)


def _token_mixers(h, w_in, cmp_pos, cmp_w1, cmp_b1, cmp_w2, cmp_b2, sgu_ln_g, sgu_ln_b,
                  sgu_w, sgu_b, w_branch, w_merge, b_merge, w_out):
    B, S, _ = h.shape
    G = NSA_KV_GROUPS
    proj = h @ w_in
    splits = np.cumsum([NSA_WIDTH] + [KV_WIDTH] * 6 + [3 * NSA_HEADS]).tolist()
    q, kc, vc, ks, vs, kw, vw, g_nsa, z = jnp.split(proj, splits, axis=-1)
    q = _rope(q.reshape(B, S, NSA_HEADS, HEAD_DIM))
    kc = _compress(_rope(kc.reshape(B, S, G, HEAD_DIM)), cmp_pos[0], cmp_w1[0], cmp_b1[0], cmp_w2[0], cmp_b2[0])
    vc = _compress(vc.reshape(B, S, G, HEAD_DIM), cmp_pos[1], cmp_w1[1], cmp_b1[1], cmp_w2[1], cmp_b2[1])
    ks = _rope(ks.reshape(B, S, G, HEAD_DIM))
    vs = vs.reshape(B, S, G, HEAD_DIM)
    kw = _rope(kw.reshape(B, S, G, HEAD_DIM))
    vw = vw.reshape(B, S, G, HEAD_DIM)
    o_nsa = _nsa(q, kc, vc, ks, vs, kw, vw, g_nsa.reshape(B, S, NSA_HEADS, 3))
    o_sgu = _sgu(z, sgu_ln_g, sgu_ln_b, sgu_w, sgu_b)
    gate_a, gate_b = jnp.split(jax.nn.sigmoid(h @ w_merge + b_merge), 2, axis=-1)
    merged = gate_a * (o_nsa @ w_branch[0]) + gate_b * (o_sgu @ w_branch[1])
    return merged @ w_out


def setup_inputs(seed: int = 0) -> dict:
    key = jax.random.key(seed)
    ks = jax.random.split(key, 26)
    L, D = DEPTH, D_MODEL
    f32 = jnp.float32

    def nrm(k, shape, scale):
        return scale * jax.random.normal(k, shape, f32)

    return {
        'x': nrm(ks[0], (BATCH, SEQ, D), 1.0),
        'c': nrm(ks[1], (BATCH, D), 1.0),
        'w_ada': nrm(ks[2], (L, D, 6 * D), 0.5 * D ** -0.5),
        'b_ada': nrm(ks[3], (L, 6 * D), 0.02),
        'w_in': nrm(ks[4], (L, D, IN_COLS), D ** -0.5),
        'cmp_pos': nrm(ks[5], (L, 2, CMP_BLOCK, HEAD_DIM), 0.1),
        'cmp_w1': nrm(ks[6], (L, 2, CMP_BLOCK * HEAD_DIM, CMP_HIDDEN), (CMP_BLOCK * HEAD_DIM) ** -0.5),
        'cmp_b1': nrm(ks[7], (L, 2, CMP_HIDDEN), 0.02),
        'cmp_w2': nrm(ks[8], (L, 2, CMP_HIDDEN, HEAD_DIM), CMP_HIDDEN ** -0.5),
        'cmp_b2': nrm(ks[9], (L, 2, HEAD_DIM), 0.02),
        'sgu_ln_g': 1.0 + nrm(ks[10], (L, SGU_WIDTH), 0.02),
        'sgu_ln_b': nrm(ks[11], (L, SGU_WIDTH), 0.02),
        'sgu_w': nrm(ks[12], (L, SGU_GROUPS, SGU_CHUNK, SGU_CHUNK), SGU_CHUNK ** -0.5),
        'sgu_b': 1.0 + nrm(ks[13], (L, SGU_GROUPS, SGU_CHUNK), 0.1),
        'w_branch': nrm(ks[14], (L, 2, NSA_WIDTH, D), NSA_WIDTH ** -0.5),
        'w_merge': nrm(ks[15], (L, D, 2 * D), D ** -0.5),
        'b_merge': nrm(ks[16], (L, 2 * D), 0.02),
        'w_out': nrm(ks[17], (L, D, D), DN_BETA * D ** -0.5),
        'ln1_g': 1.0 + nrm(ks[18], (L, D), 0.02),
        'ln1_b': nrm(ks[19], (L, D), 0.02),
        'peer_wq': nrm(ks[20], (L, D, PEER_HEADS * PEER_QDIM), D ** -0.5),
        'peer_keys': nrm(ks[21], (L, PEER_HEADS, 2, PEER_NKEYS, PEER_HALF), PEER_HALF ** -0.5),
        'peer_u': nrm(ks[22], (L, PEER_EXPERTS, D), D ** -0.5),
        'peer_v': nrm(ks[23], (L, PEER_EXPERTS, D), DN_BETA),
        'ln2_g': 1.0 + nrm(ks[24], (L, D), 0.02),
        'ln2_b': nrm(ks[25], (L, D), 0.02),
    }


def reference(x, c, w_ada, b_ada, w_in, cmp_pos, cmp_w1, cmp_b1, cmp_w2, cmp_b2,
              sgu_ln_g, sgu_ln_b, sgu_w, sgu_b, w_branch, w_merge, b_merge, w_out,
              ln1_g, ln1_b, peer_wq, peer_keys, peer_u, peer_v, ln2_g, ln2_b):
    for l in range(DEPTH):
        mod = jax.nn.silu(c) @ w_ada[l] + b_ada[l]
        sh1, sc1, gt1, sh2, sc2, gt2 = [m[:, None, :] for m in jnp.split(mod, 6, axis=-1)]
        h = _layernorm(x) * (1.0 + sc1) + sh1
        mix = _token_mixers(h, w_in[l], cmp_pos[l], cmp_w1[l], cmp_b1[l], cmp_w2[l], cmp_b2[l],
                            sgu_ln_g[l], sgu_ln_b[l], sgu_w[l], sgu_b[l], w_branch[l],
                            w_merge[l], b_merge[l], w_out[l])
        x = _layernorm(DN_ALPHA * x + gt1 * mix, ln1_g[l], ln1_b[l])
        h = _layernorm(x) * (1.0 + sc2) + sh2
        ffn = _peer(h, peer_wq[l], peer_keys[l], peer_u[l], peer_v[l])
        x = _layernorm(DN_ALPHA * x + gt2 * ffn, ln2_g[l], ln2_b[l])
    return x
```

```cpp
#include <hip/hip_runtime.h>
#include <hip/hip_cooperative_groups.h>
#include <stdint.h>
#include <stdio.h>
#include <math.h>
namespace cg = cooperative_groups;

#ifndef STAGE
#define STAGE 4
#endif

#ifndef NSA_MASK
#define NSA_MASK 7
#endif
typedef unsigned short bf16_t;
typedef short bf16x8 __attribute__((ext_vector_type(8)));
typedef short s16x4 __attribute__((ext_vector_type(4)));
typedef float f32x16 __attribute__((ext_vector_type(16)));
typedef float f32x4 __attribute__((ext_vector_type(4)));
typedef float f32x2 __attribute__((ext_vector_type(2)));
typedef __bf16 bf16v2 __attribute__((ext_vector_type(2)));
typedef unsigned u32x4 __attribute__((ext_vector_type(4)));
typedef unsigned u32x2 __attribute__((ext_vector_type(2)));
#define DI __device__ __forceinline__
#define MFMA32(a, b, c) __builtin_amdgcn_mfma_f32_32x32x16_bf16((a), (b), (c), 0, 0, 0)

constexpr int NT = 256;
constexpr int NB = 8, SEQ = 8192, DM = 1024, NTOK = NB * SEQ;
constexpr int N1 = 4480;
constexpr float DN_ALPHA = 1.189207115002721f;
constexpr float LN_EPS = 1e-5f;

constexpr size_t MB = 1024 * 1024;
constexpr size_t OFF_MOD = 0;
constexpr size_t OFF_ROPE = OFF_MOD + 256 * 1024;
constexpr size_t OFF_POSB = OFF_ROPE + 2 * MB;
constexpr size_t OFF_WT1 = OFF_POSB + 4096;
constexpr size_t OFF_WB = OFF_WT1 + (size_t)N1 * 1024 * 2;
constexpr size_t OFF_WOUT = OFF_WB + 2 * MB;
constexpr size_t OFF_WQ = OFF_WOUT + 2 * MB;
constexpr size_t OFF_PKEYS = OFF_WQ + 4 * MB;
constexpr size_t OFF_CW1 = OFF_PKEYS + MB / 2;
constexpr size_t OFF_CW2 = OFF_CW1 + MB;
constexpr size_t OFF_SGUW = OFF_CW2 + 32 * 1024;
constexpr size_t OFF_PU = OFF_SGUW + 256 * 1024;
constexpr size_t OFF_PV = OFF_PU + 32 * MB;
constexpr size_t OFF_ACT = ((OFF_PV + 32 * MB + 4095) / 4096) * 4096;
constexpr size_t OFF_H = OFF_ACT;
constexpr size_t OFF_Q = OFF_H + 128 * MB;
constexpr size_t OFF_KC = OFF_Q + 64 * MB;
constexpr size_t OFF_VC = OFF_KC + 16 * MB;
constexpr size_t OFF_KS = OFF_VC + 16 * MB;
constexpr size_t OFF_VST = OFF_KS + 16 * MB;
constexpr size_t OFF_KW = OFF_VST + 16 * MB;
constexpr size_t OFF_VWT = OFF_KW + 16 * MB;
constexpr size_t OFF_U = OFF_VWT + 16 * MB;
constexpr size_t OFF_V = OFF_U + 64 * MB;
constexpr size_t OFF_GATE = OFF_V + 64 * MB;
constexpr size_t OFF_GSIG = OFF_GATE + 256 * MB;
constexpr size_t OFF_KCMP = OFF_GSIG + 8 * MB;
constexpr size_t OFF_VCMPT = OFF_KCMP + MB;
constexpr size_t OFF_ONSA = OFF_VCMPT + MB;
constexpr size_t OFF_END = OFF_ONSA + 64 * MB;
constexpr size_t OFF_X1 = OFF_Q;
constexpr size_t OFF_Y = OFF_GATE;
constexpr size_t OFF_PQ = OFF_GATE;
constexpr size_t OFF_EIDX = OFF_ONSA;
constexpr size_t OFF_PGATE = OFF_ONSA + 32 * MB;

struct Params {
  const float *x, *c, *w_ada, *b_ada, *w_in, *cmp_pos, *cmp_w1, *cmp_b1, *cmp_w2, *cmp_b2, *sgu_ln_g, *sgu_ln_b, *sgu_w, *sgu_b,
      *w_branch, *w_merge, *b_merge, *w_out, *ln1_g, *ln1_b, *peer_wq, *peer_keys, *peer_u, *peer_v, *ln2_g, *ln2_b;
  float* out;
  char* ws;
  float inv_freq[32];
};

DI unsigned pack2(float lo, float hi) { f32x2 v = {lo, hi}; bf16v2 r = __builtin_convertvector(v, bf16v2); return __builtin_bit_cast(unsigned, r); }
DI bf16_t f2bf(float f) { __bf16 r = (__bf16)f; return __builtin_bit_cast(unsigned short, r); }
DI float bf2f(bf16_t h) { return __uint_as_float(((unsigned)h) << 16); }
DI float bflo(unsigned u) { return __uint_as_float(u << 16); }
DI float bfhi(unsigned u) { return __uint_as_float(u & 0xffff0000u); }
DI float gelu_f(float v) { return 0.5f * v * (1.0f + erff(v * 0.70710678118654752f)); }
DI float sigmoid_f(float v) { return 1.0f / (1.0f + __expf(-v)); }
DI float wave_sum(float v) {
#pragma unroll
  for (int o = 32; o > 0; o >>= 1) v += __shfl_xor(v, o);
  return v;
}

template <class F>
DI void tconv_tile(float* tile, int k0, int n0, bf16_t* dst, int ldd, F f) {
  const int tid = threadIdx.x;
  __syncthreads();
#pragma unroll 4
  for (int i = 0; i < 16; ++i) { const int kl = i * 4 + (tid >> 6), nl = tid & 63; tile[nl * 65 + kl] = f(k0 + kl, n0 + nl); }
  __syncthreads();
#pragma unroll
  for (int i = 0; i < 2; ++i) {
    const int idx = tid + i * 256, nl = idx >> 3, kc = idx & 7;
    const float* t = tile + nl * 65 + kc * 8;
    u32x4 w; w.x = pack2(t[0], t[1]); w.y = pack2(t[2], t[3]); w.z = pack2(t[4], t[5]); w.w = pack2(t[6], t[7]);
    *(u32x4*)(dst + (size_t)(n0 + nl) * ldd + k0 + kc * 8) = w;
  }
}

DI void conv_chunk(const float* src, bf16_t* dst, size_t base) {
  const size_t i = base + (size_t)threadIdx.x * 8;
  const f32x4 a = *(const f32x4*)(src + i), b = *(const f32x4*)(src + i + 4);
  u32x4 w; w.x = pack2(a.x, a.y); w.y = pack2(a.z, a.w); w.z = pack2(b.x, b.y); w.w = pack2(b.z, b.w);
  *(u32x4*)(dst + i) = w;
}

DI void sincos_d(double x, double& s, double& c) {
  const double y = x * 0.25, y2 = y * y;
  double sn = y * (1.0 + y2 * (-1.0 / 6 + y2 * (1.0 / 120 + y2 * (-1.0 / 5040 + y2 * (1.0 / 362880 + y2 * (-1.0 / 39916800 + y2 * (1.0 / 6227020800.0)))))));
  double cs = 1.0 + y2 * (-0.5 + y2 * (1.0 / 24 + y2 * (-1.0 / 720 + y2 * (1.0 / 40320 + y2 * (-1.0 / 3628800 + y2 * (1.0 / 479001600.0 + y2 * (-1.0 / 87178291200.0)))))));
#pragma unroll
  for (int i = 0; i < 2; ++i) { const double s2 = 2.0 * sn * cs, c2 = cs * cs - sn * sn; sn = s2; cs = c2; }
  s = sn; c = cs;
}

__device__ void phase_prep(const Params& p, char* smem) {
  const int tid = threadIdx.x;
  float* fs = (float*)smem;
  char* ws = p.ws;
  constexpr int nA = 192, nB = 16 * 70, nC = 2 * 8 * 16, nD = 256, nE = 16 * 32, nF = 2 * 32 * 2, nG = 4, nH = 8, nI = 1024, nJ = 128, nK = 64, nL = 8192, nM = 8192;
  constexpr int total = nA + nB + nC + nD + nE + nF + nG + nH + nI + nJ + nK + nL + nM;
  for (int item = blockIdx.x; item < total; item += gridDim.x) {
    int it = item;
    if (it < nA) {
      float* sc = fs;
      float* red = fs + 8192;
      __syncthreads();
      for (int i = tid; i < 8192; i += NT) { const float v = p.c[i]; sc[i] = v / (1.0f + __expf(-v)); }
      __syncthreads();
      const int ks = tid >> 5, cj = tid & 31, col = it * 32 + cj;
      float acc[8];
#pragma unroll
      for (int b = 0; b < 8; ++b) acc[b] = 0.f;
#pragma unroll 4
      for (int k = ks * 128; k < ks * 128 + 128; ++k) {
        const float w = p.w_ada[(size_t)k * 6144 + col];
#pragma unroll
        for (int b = 0; b < 8; ++b) acc[b] += sc[b * 1024 + k] * w;
      }
#pragma unroll
      for (int b = 0; b < 8; ++b) red[(ks * 8 + b) * 32 + cj] = acc[b];
      __syncthreads();
      {
        const int b = tid >> 5;
        float s = p.b_ada[col];
#pragma unroll
        for (int k2 = 0; k2 < 8; ++k2) s += red[(k2 * 8 + b) * 32 + cj];
        ((float*)(ws + OFF_MOD))[b * 6144 + col] = s;
      }
      continue;
    }
    it -= nA;
    if (it < nB) {
      const int kt = it / 70, ntile = it % 70;
      const float* w_in = p.w_in; const float* w_merge = p.w_merge;
      tconv_tile(fs, kt * 64, ntile * 64, (bf16_t*)(ws + OFF_WT1), 1024, [=](int k, int n) -> float {
        if (n < 1280) return w_in[(size_t)k * 2328 + n];
        if (n < 2304) return w_in[(size_t)k * 2328 + n + 24];
        if (n < 4352) return w_merge[(size_t)k * 2048 + (n - 2304)];
        if (n < 4376) return w_in[(size_t)k * 2328 + 1280 + (n - 4352)];
        return 0.f; });
      continue;
    }
    it -= nB;
    if (it < nC) {
      const int br = it >> 7, r = it & 127, kt = r >> 4, ntile = r & 15;
      const float* src = p.w_branch + (size_t)br * 512 * 1024;
      tconv_tile(fs, kt * 64, ntile * 64, (bf16_t*)(ws + OFF_WB) + (size_t)br * 1024 * 512, 512, [=](int k, int n) -> float { return src[(size_t)k * 1024 + n]; });
      continue;
    }
    it -= nC;
    if (it < nD) {
      const int kt = it >> 4, ntile = it & 15;
      const float* src = p.w_out;
      tconv_tile(fs, kt * 64, ntile * 64, (bf16_t*)(ws + OFF_WOUT), 1024, [=](int k, int n) -> float { return src[(size_t)k * 1024 + n]; });
      continue;
    }
    it -= nD;
    if (it < nE) {
      const int kt = it >> 5, ntile = it & 31;
      const float* src = p.peer_wq;
      tconv_tile(fs, kt * 64, ntile * 64, (bf16_t*)(ws + OFF_WQ), 1024, [=](int k, int n) -> float { return src[(size_t)k * 2048 + n]; });
      continue;
    }
    it -= nE;
    if (it < nF) {
      const int w = it >> 6, r = it & 63, kt = r >> 1, ntile = r & 1;
      const float* src = p.cmp_w1 + (size_t)w * 2048 * 128;
      tconv_tile(fs, kt * 64, ntile * 64, (bf16_t*)(ws + OFF_CW1) + (size_t)w * 128 * 2048, 2048, [=](int k, int n) -> float { return src[(size_t)k * 128 + n]; });
      continue;
    }
    it -= nF;
    if (it < nG) {
      const int w = it >> 1, kt = it & 1;
      const float* src = p.cmp_w2 + (size_t)w * 128 * 64;
      tconv_tile(fs, kt * 64, 0, (bf16_t*)(ws + OFF_CW2) + (size_t)w * 64 * 128, 128, [=](int k, int n) -> float { return src[(size_t)k * 64 + n]; });
      continue;
    }
    it -= nG;
    if (it < nH) {
      const int w = it >> 2, jc = it & 3, ks = tid >> 5, cj = tid & 31, j = jc * 32 + cj;
      float* red = fs;
      const float* pos = p.cmp_pos + w * 2048; const float* w1 = p.cmp_w1 + (size_t)w * 2048 * 128;
      float acc = 0.f;
#pragma unroll 4
      for (int k = ks * 256; k < ks * 256 + 256; ++k) acc += pos[k] * w1[(size_t)k * 128 + j];
      __syncthreads();
      red[ks * 32 + cj] = acc;
      __syncthreads();
      if (tid < 32) { float s = p.cmp_b1[w * 128 + j]; for (int k2 = 0; k2 < 8; ++k2) s += red[k2 * 32 + tid]; ((float*)(ws + OFF_POSB))[w * 128 + j] = s; }
      continue;
    }
    it -= nH;
    if (it < nI) {
      const int e = it * 256 + tid, pos = e >> 5, i = e & 31;
      const float ang = (float)pos * p.inv_freq[i];
      const double a = (double)ang;
      const double kk = rint(a * 0.15915494309189535);
      const double r = a - kk * 6.283185307179586476925;
      double s, c; sincos_d(r, s, c);
      ((float*)(ws + OFF_ROPE))[e] = (float)c;
      ((float*)(ws + OFF_ROPE))[262144 + e] = (float)s;
      continue;
    }
    it -= nI;
    if (it < nJ) { conv_chunk(p.peer_keys, (bf16_t*)(ws + OFF_PKEYS), (size_t)it * 2048); continue; }
    it -= nJ;
    if (it < nK) {
      const size_t i0 = (size_t)it * 2048 + (size_t)tid * 8;
      const int rowi = (int)((i0 >> 7) & 127), j0 = (int)(i0 & 127);
      float v[8];
#pragma unroll
      for (int j = 0; j < 8; ++j) v[j] = (j0 + j <= rowi) ? p.sgu_w[i0 + j] : 0.f;
      u32x4 w; w.x = pack2(v[0], v[1]); w.y = pack2(v[2], v[3]); w.z = pack2(v[4], v[5]); w.w = pack2(v[6], v[7]);
      *(u32x4*)((bf16_t*)(ws + OFF_SGUW) + i0) = w;
      continue;
    }
    it -= nK;
    if (it < nL) { conv_chunk(p.peer_u, (bf16_t*)(ws + OFF_PU), (size_t)it * 2048); continue; }
    it -= nL;
    conv_chunk(p.peer_v, (bf16_t*)(ws + OFF_PV), (size_t)it * 2048);
  }
}

DI void row_stats(const float (&v)[16], float& mean, float& rstd) {
  float s = 0.f;
#pragma unroll
  for (int i = 0; i < 16; ++i) s += v[i];
  mean = wave_sum(s) * (1.0f / 1024.0f);
  float q = 0.f;
#pragma unroll
  for (int i = 0; i < 16; ++i) { const float d = v[i] - mean; q += d * d; }
  rstd = rsqrtf(wave_sum(q) * (1.0f / 1024.0f) + LN_EPS);
}

__device__ void phase_ln_in(const Params& p) {
  const int lane = threadIdx.x & 63, wave = threadIdx.x >> 6;
  const float* mod = (const float*)(p.ws + OFF_MOD);
  bf16_t* h = (bf16_t*)(p.ws + OFF_H);
  for (int grp = blockIdx.x; grp < NTOK / 4; grp += gridDim.x) {
    const int row = grp * 4 + wave, b = row >> 13;
    const float* xr = p.x + (size_t)row * DM;
    float v[16];
#pragma unroll
    for (int i = 0; i < 4; ++i) { const f32x4 t = *(const f32x4*)(xr + i * 256 + lane * 4); v[4 * i] = t.x; v[4 * i + 1] = t.y; v[4 * i + 2] = t.z; v[4 * i + 3] = t.w; }
    float mean, rstd; row_stats(v, mean, rstd);
#pragma unroll
    for (int i = 0; i < 4; ++i) {
      const int col = i * 256 + lane * 4;
      const f32x4 sh = *(const f32x4*)(mod + b * 6144 + col), sc = *(const f32x4*)(mod + b * 6144 + 1024 + col);
      const float o0 = (v[4 * i] - mean) * rstd * (1.f + sc.x) + sh.x, o1 = (v[4 * i + 1] - mean) * rstd * (1.f + sc.y) + sh.y;
      const float o2 = (v[4 * i + 2] - mean) * rstd * (1.f + sc.z) + sh.z, o3 = (v[4 * i + 3] - mean) * rstd * (1.f + sc.w) + sh.w;
      u32x2 w; w.x = pack2(o0, o1); w.y = pack2(o2, o3);
      *(u32x2*)(h + (size_t)row * DM + col) = w;
    }
  }
}

__device__ void phase_ln_mid(const Params& p, bool y_is_x) {
  const int lane = threadIdx.x & 63, wave = threadIdx.x >> 6;
  const float* mod = (const float*)(p.ws + OFF_MOD);
  const float* y = (const float*)(p.ws + OFF_Y);
  float* x1 = (float*)(p.ws + OFF_X1);
  bf16_t* h2 = (bf16_t*)(p.ws + OFF_H);
  for (int grp = blockIdx.x; grp < NTOK / 4; grp += gridDim.x) {
    const int row = grp * 4 + wave, b = row >> 13;
    const float* yr = (y_is_x ? p.x : y) + (size_t)row * DM;
    float v[16];
#pragma unroll
    for (int i = 0; i < 4; ++i) { const f32x4 t = *(const f32x4*)(yr + i * 256 + lane * 4); v[4 * i] = t.x; v[4 * i + 1] = t.y; v[4 * i + 2] = t.z; v[4 * i + 3] = t.w; }
    if (y_is_x) {
#pragma unroll
      for (int i = 0; i < 16; ++i) v[i] *= DN_ALPHA;
    }
    float mean, rstd; row_stats(v, mean, rstd);
#pragma unroll
    for (int i = 0; i < 4; ++i) {
      const int col = i * 256 + lane * 4;
      const f32x4 g = *(const f32x4*)(p.ln1_g + col), bb = *(const f32x4*)(p.ln1_b + col);
      f32x4 o;
      o.x = (v[4 * i] - mean) * rstd * g.x + bb.x; o.y = (v[4 * i + 1] - mean) * rstd * g.y + bb.y;
      o.z = (v[4 * i + 2] - mean) * rstd * g.z + bb.z; o.w = (v[4 * i + 3] - mean) * rstd * g.w + bb.w;
      *(f32x4*)(x1 + (size_t)row * DM + col) = o;
      v[4 * i] = o.x; v[4 * i + 1] = o.y; v[4 * i + 2] = o.z; v[4 * i + 3] = o.w;
    }
    row_stats(v, mean, rstd);
#pragma unroll
    for (int i = 0; i < 4; ++i) {
      const int col = i * 256 + lane * 4;
      const f32x4 sh = *(const f32x4*)(mod + b * 6144 + 3072 + col), sc = *(const f32x4*)(mod + b * 6144 + 4096 + col);
      const float o0 = (v[4 * i] - mean) * rstd * (1.f + sc.x) + sh.x, o1 = (v[4 * i + 1] - mean) * rstd * (1.f + sc.y) + sh.y;
      const float o2 = (v[4 * i + 2] - mean) * rstd * (1.f + sc.z) + sh.z, o3 = (v[4 * i + 3] - mean) * rstd * (1.f + sc.w) + sh.w;
      u32x2 w; w.x = pack2(o0, o1); w.y = pack2(o2, o3);
      *(u32x2*)(h2 + (size_t)row * DM + col) = w;
    }
  }
}

__device__ void phase_final_noffn(const Params& p) {
  const int lane = threadIdx.x & 63, wave = threadIdx.x >> 6;
  const float* x1 = (const float*)(p.ws + OFF_X1);
  for (int grp = blockIdx.x; grp < NTOK / 4; grp += gridDim.x) {
    const int row = grp * 4 + wave;
    const float* xr = x1 + (size_t)row * DM;
    float v[16];
#pragma unroll
    for (int i = 0; i < 4; ++i) { const f32x4 t = *(const f32x4*)(xr + i * 256 + lane * 4); v[4 * i] = t.x * DN_ALPHA; v[4 * i + 1] = t.y * DN_ALPHA; v[4 * i + 2] = t.z * DN_ALPHA; v[4 * i + 3] = t.w * DN_ALPHA; }
    float mean, rstd; row_stats(v, mean, rstd);
#pragma unroll
    for (int i = 0; i < 4; ++i) {
      const int col = i * 256 + lane * 4;
      const f32x4 g = *(const f32x4*)(p.ln2_g + col), bb = *(const f32x4*)(p.ln2_b + col);
      f32x4 o;
      o.x = (v[4 * i] - mean) * rstd * g.x + bb.x; o.y = (v[4 * i + 1] - mean) * rstd * g.y + bb.y;
      o.z = (v[4 * i + 2] - mean) * rstd * g.z + bb.z; o.w = (v[4 * i + 3] - mean) * rstd * g.w + bb.w;
      *(f32x4*)(p.out + (size_t)row * DM + col) = o;
    }
  }
}

constexpr int LDT = 72;
constexpr int GEMM_SMEM = 2 * 2 * 128 * LDT * 2;

DI void zero_acc(f32x16 (&acc)[2][2]) {
#pragma unroll
  for (int i = 0; i < 2; ++i)
#pragma unroll
    for (int j = 0; j < 2; ++j)
#pragma unroll
      for (int r = 0; r < 16; ++r) acc[i][j][r] = 0.f;
}

DI void gemm_mainloop(f32x16 (&acc)[2][2], const bf16_t* __restrict__ A, int lda, const bf16_t* __restrict__ Bt, int ldb, int K, int row0, int col0, char* smem) {
  bf16_t* As = (bf16_t*)smem;
  bf16_t* Bs = As + 2 * 128 * LDT;
  const int tid = threadIdx.x, lane = tid & 63, wave = tid >> 6, wr = wave >> 1, wc = wave & 1;
  const int lr = tid >> 3, lc = (tid & 7) * 8;
  const bf16_t* ga = A + (size_t)(row0 + lr) * lda + lc;
  const bf16_t* gb = Bt + (size_t)(col0 + lr) * ldb + lc;
  const int lofs = lr * LDT + lc;
  u32x4 ra[4], rb[4];
#pragma unroll
  for (int i = 0; i < 4; ++i) { ra[i] = *(const u32x4*)(ga + (size_t)i * 32 * lda); rb[i] = *(const u32x4*)(gb + (size_t)i * 32 * ldb); }
  __syncthreads();
#pragma unroll
  for (int i = 0; i < 4; ++i) { *(u32x4*)(As + lofs + i * 32 * LDT) = ra[i]; *(u32x4*)(Bs + lofs + i * 32 * LDT) = rb[i]; }
  __syncthreads();
  const int nk = K >> 6;
  const int fa = (wr * 64 + (lane & 31)) * LDT + (lane >> 5) * 8;
  const int fb = (wc * 64 + (lane & 31)) * LDT + (lane >> 5) * 8;
  for (int kt = 0; kt < nk; ++kt) {
    const int cur = kt & 1;
    if (kt + 1 < nk) {
#pragma unroll
      for (int i = 0; i < 4; ++i) { ra[i] = *(const u32x4*)(ga + (size_t)i * 32 * lda + (kt + 1) * 64); rb[i] = *(const u32x4*)(gb + (size_t)i * 32 * ldb + (kt + 1) * 64); }
    }
    const bf16_t* as = As + cur * 128 * LDT + fa;
    const bf16_t* bs = Bs + cur * 128 * LDT + fb;
#pragma unroll
    for (int ks = 0; ks < 4; ++ks) {
      const bf16x8 a0 = *(const bf16x8*)(as + ks * 16), a1 = *(const bf16x8*)(as + 32 * LDT + ks * 16);
      const bf16x8 b0 = *(const bf16x8*)(bs + ks * 16), b1 = *(const bf16x8*)(bs + 32 * LDT + ks * 16);
      acc[0][0] = MFMA32(a0, b0, acc[0][0]); acc[0][1] = MFMA32(a0, b1, acc[0][1]);
      acc[1][0] = MFMA32(a1, b0, acc[1][0]); acc[1][1] = MFMA32(a1, b1, acc[1][1]);
    }
    if (kt + 1 < nk) {
      bf16_t* ad = As + (cur ^ 1) * 128 * LDT + lofs; bf16_t* bd = Bs + (cur ^ 1) * 128 * LDT + lofs;
#pragma unroll
      for (int i = 0; i < 4; ++i) { *(u32x4*)(ad + i * 32 * LDT) = ra[i]; *(u32x4*)(bd + i * 32 * LDT) = rb[i]; }
    }
    __syncthreads();
  }
}

DI void store_rope(bf16_t* dst, int ld, int cofs, const f32x16 (&acc)[2][2], int rb, int lane, const float* rope, float scale) {
  const int d = lane & 31, hh = lane >> 5;
#pragma unroll
  for (int mi = 0; mi < 2; ++mi)
#pragma unroll
    for (int r = 0; r < 16; ++r) {
      const int row = rb + mi * 32 + (r & 3) + 8 * (r >> 2) + 4 * hh, pos = row & (SEQ - 1);
      const float c = rope[pos * 32 + d], s = rope[262144 + pos * 32 + d];
      const float t1 = acc[mi][0][r], t2 = acc[mi][1][r];
      dst[(size_t)row * ld + cofs + d] = f2bf((t1 * c - t2 * s) * scale);
      dst[(size_t)row * ld + cofs + 32 + d] = f2bf((t1 * s + t2 * c) * scale);
    }
}
template <int ACT>
DI void store_plain(bf16_t* dst, int ld, int cofs, const f32x16 (&acc)[2][2], int rb, int lane) {
  const int d = lane & 31, hh = lane >> 5;
#pragma unroll
  for (int mi = 0; mi < 2; ++mi)
#pragma unroll
    for (int ni = 0; ni < 2; ++ni)
#pragma unroll
      for (int r = 0; r < 16; ++r) {
        const int row = rb + mi * 32 + (r & 3) + 8 * (r >> 2) + 4 * hh;
        float v = acc[mi][ni][r];
        if (ACT == 1) v = gelu_f(v);
        dst[(size_t)row * ld + cofs + ni * 32 + d] = f2bf(v);
      }
}
DI void store_vT(bf16_t* dst, int g, const f32x16 (&acc)[2][2], int rb, int lane) {
  const int d = lane & 31, hh = lane >> 5, b = rb >> 13;
#pragma unroll
  for (int mi = 0; mi < 2; ++mi)
#pragma unroll
    for (int ni = 0; ni < 2; ++ni)
#pragma unroll
      for (int q = 0; q < 4; ++q) {
        const int pos = (rb & (SEQ - 1)) + mi * 32 + 8 * q + 4 * hh;
        u32x2 w; w.x = pack2(acc[mi][ni][4 * q], acc[mi][ni][4 * q + 1]); w.y = pack2(acc[mi][ni][4 * q + 2], acc[mi][ni][4 * q + 3]);
        *(u32x2*)(dst + ((size_t)((b * 2 + g) * 64 + ni * 32 + d)) * SEQ + pos) = w;
      }
}

__device__ void phase_gemm1(const Params& p, char* smem) {
  char* ws = p.ws;
  const bf16_t* A = (const bf16_t*)(ws + OFF_H);
  const bf16_t* Bt = (const bf16_t*)(ws + OFF_WT1);
  const float* rope = (const float*)(ws + OFF_ROPE);
  const int lane = threadIdx.x & 63, wave = threadIdx.x >> 6;
  constexpr int NCT = N1 / 128, NRT = NTOK / 128;
  for (int tile = blockIdx.x; tile < NCT * NRT; tile += gridDim.x) {
    const int rt = tile / NCT, ct = tile % NCT;
    f32x16 acc[2][2]; zero_acc(acc);
    gemm_mainloop(acc, A, 1024, Bt, 1024, 1024, rt * 128, ct * 128, smem);
    const int rb = rt * 128 + (wave >> 1) * 64, cb = ct * 128 + (wave & 1) * 64;
    if (cb < 512) store_rope((bf16_t*)(ws + OFF_Q), 512, cb, acc, rb, lane, rope, 0.125f);
    else if (cb < 640) store_rope((bf16_t*)(ws + OFF_KC), 128, cb - 512, acc, rb, lane, rope, 1.0f);
    else if (cb < 768) store_plain<0>((bf16_t*)(ws + OFF_VC), 128, cb - 640, acc, rb, lane);
    else if (cb < 896) store_rope((bf16_t*)(ws + OFF_KS), 128, cb - 768, acc, rb, lane, rope, 1.0f);
    else if (cb < 1024) store_vT((bf16_t*)(ws + OFF_VST), (cb - 896) >> 6, acc, rb, lane);
    else if (cb < 1152) store_rope((bf16_t*)(ws + OFF_KW), 128, cb - 1024, acc, rb, lane, rope, 1.0f);
    else if (cb < 1280) store_vT((bf16_t*)(ws + OFF_VWT), (cb - 1152) >> 6, acc, rb, lane);
    else if (cb < 1792) store_plain<1>((bf16_t*)(ws + OFF_U), 512, cb - 1280, acc, rb, lane);
    else if (cb < 2304) store_plain<1>((bf16_t*)(ws + OFF_V), 512, cb - 1792, acc, rb, lane);
    else if (cb < 4352) {
      bf16_t* gate = (bf16_t*)(ws + OFF_GATE);
      const int d = lane & 31, hh = lane >> 5, c0 = cb - 2304;
#pragma unroll
      for (int ni = 0; ni < 2; ++ni) {
        const float bias = p.b_merge[c0 + ni * 32 + d];
#pragma unroll
        for (int mi = 0; mi < 2; ++mi)
#pragma unroll
          for (int r = 0; r < 16; ++r) {
            const int row = rb + mi * 32 + (r & 3) + 8 * (r >> 2) + 4 * hh;
            gate[(size_t)row * 2048 + c0 + ni * 32 + d] = f2bf(sigmoid_f(acc[mi][ni][r] + bias));
          }
      }
    } else if (cb < 4416) {
      float* gs = (float*)(ws + OFF_GSIG);
      const int d = lane & 31, hh = lane >> 5;
      if (d < 24) {
#pragma unroll
        for (int mi = 0; mi < 2; ++mi)
#pragma unroll
          for (int r = 0; r < 16; ++r) {
            const int row = rb + mi * 32 + (r & 3) + 8 * (r >> 2) + 4 * hh;
            gs[(size_t)row * 32 + d] = sigmoid_f(acc[mi][0][r]);
          }
      }
    }
  }
}

__device__ void phase_sgu(const Params& p, char* smem) {
  char* ws = p.ws;
  const int tid = threadIdx.x, lane = tid & 63, wave = tid >> 6;
  bf16_t* u = (bf16_t*)(ws + OFF_U);
  const bf16_t* v = (const bf16_t*)(ws + OFF_V);
  const bf16_t* W = (const bf16_t*)(ws + OFF_SGUW);
  float* st = (float*)smem;
  bf16_t* vt = (bf16_t*)(smem + 1024);
  constexpr int LV = 136;
  for (int item = blockIdx.x; item < NTOK / 128; item += gridDim.x) {
    const int t0 = item * 128;
    __syncthreads();
    for (int i = 0; i < 32; ++i) {
      const int t = wave * 32 + i;
      const u32x4 raw = *(const u32x4*)(v + (size_t)(t0 + t) * 512 + lane * 8);
      float f[8] = {bflo(raw.x), bfhi(raw.x), bflo(raw.y), bfhi(raw.y), bflo(raw.z), bfhi(raw.z), bflo(raw.w), bfhi(raw.w)};
      float s = 0.f;
#pragma unroll
      for (int j = 0; j < 8; ++j) s += f[j];
      const float mean = wave_sum(s) * (1.f / 512.f);
      float q = 0.f;
#pragma unroll
      for (int j = 0; j < 8; ++j) { const float d = f[j] - mean; q += d * d; }
      const float rstd = rsqrtf(wave_sum(q) * (1.f / 512.f) + LN_EPS);
      if (lane == 0) { st[t * 2] = mean; st[t * 2 + 1] = rstd; }
    }
    for (int g = 0; g < 8; ++g) {
      __syncthreads();
      for (int i = 0; i < 4; ++i) {
        const int idx = tid + i * 256, j = idx >> 3, dc = (idx & 7) * 8;
        const u32x4 raw = *(const u32x4*)(v + (size_t)(t0 + j) * 512 + g * 64 + dc);
        const float mean = st[j * 2], rstd = st[j * 2 + 1];
        const float f[8] = {bflo(raw.x), bfhi(raw.x), bflo(raw.y), bfhi(raw.y), bflo(raw.z), bfhi(raw.z), bflo(raw.w), bfhi(raw.w)};
#pragma unroll
        for (int k = 0; k < 8; ++k) {
          const int col = g * 64 + dc + k;
          vt[(dc + k) * LV + j] = f2bf((f[k] - mean) * rstd * p.sgu_ln_g[col] + p.sgu_ln_b[col]);
        }
      }
      __syncthreads();
      f32x16 acc[2];
#pragma unroll
      for (int r = 0; r < 16; ++r) { acc[0][r] = 0.f; acc[1][r] = 0.f; }
      const bf16_t* wrow = W + ((size_t)g * 128 + wave * 32 + (lane & 31)) * 128 + (lane >> 5) * 8;
#pragma unroll
      for (int ks = 0; ks < 8; ++ks) {
        const bf16x8 a = *(const bf16x8*)(wrow + ks * 16);
        const bf16x8 b0 = *(const bf16x8*)(vt + (lane & 31) * LV + ks * 16 + (lane >> 5) * 8);
        const bf16x8 b1 = *(const bf16x8*)(vt + (32 + (lane & 31)) * LV + ks * 16 + (lane >> 5) * 8);
        acc[0] = MFMA32(a, b0, acc[0]); acc[1] = MFMA32(a, b1, acc[1]);
      }
      const int d = lane & 31, hh = lane >> 5;
#pragma unroll
      for (int ni = 0; ni < 2; ++ni)
#pragma unroll
        for (int r = 0; r < 16; ++r) {
          const int i = wave * 32 + (r & 3) + 8 * (r >> 2) + 4 * hh;
          const float m = acc[ni][r] + p.sgu_b[g * 128 + i];
          bf16_t* up = u + (size_t)(t0 + i) * 512 + g * 64 + ni * 32 + d;
          *up = f2bf(bf2f(*up) * m);
        }
    }
  }
}

__device__ void phase_merge(const Params& p, char* smem, bool use_nsa) {
  char* ws = p.ws;
  const bf16_t* onsa = (const bf16_t*)(ws + OFF_ONSA);
  const bf16_t* osgu = (const bf16_t*)(ws + OFF_U);
  const bf16_t* Wb = (const bf16_t*)(ws + OFF_WB);
  const bf16_t* gate = (const bf16_t*)(ws + OFF_GATE);
  bf16_t* merged = (bf16_t*)(ws + OFF_H);
  const int lane = threadIdx.x & 63, wave = threadIdx.x >> 6;
  for (int tile = blockIdx.x; tile < 8 * (NTOK / 128); tile += gridDim.x) {
    const int rt = tile >> 3, ct = tile & 7;
    f32x16 aa[2][2], ab[2][2]; zero_acc(aa); zero_acc(ab);
    if (use_nsa) gemm_mainloop(aa, onsa, 512, Wb, 512, 512, rt * 128, ct * 128, smem);
    gemm_mainloop(ab, osgu, 512, Wb + (size_t)1024 * 512, 512, 512, rt * 128, ct * 128, smem);
    const int rb = rt * 128 + (wave >> 1) * 64, cb = ct * 128 + (wave & 1) * 64, d = lane & 31, hh = lane >> 5;
#pragma unroll
    for (int mi = 0; mi < 2; ++mi)
#pragma unroll
      for (int ni = 0; ni < 2; ++ni)
#pragma unroll
        for (int r = 0; r < 16; ++r) {
          const int row = rb + mi * 32 + (r & 3) + 8 * (r >> 2) + 4 * hh, col = cb + ni * 32 + d;
          const float ga = bf2f(gate[(size_t)row * 2048 + col]), gb = bf2f(gate[(size_t)row * 2048 + 1024 + col]);
          merged[(size_t)row * 1024 + col] = f2bf(ga * aa[mi][ni][r] + gb * ab[mi][ni][r]);
        }
  }
}

__device__ void phase_outproj(const Params& p, char* smem) {
  char* ws = p.ws;
  const bf16_t* merged = (const bf16_t*)(ws + OFF_H);
  const bf16_t* Wo = (const bf16_t*)(ws + OFF_WOUT);
  const float* mod = (const float*)(ws + OFF_MOD);
  float* y = (float*)(ws + OFF_Y);
  const int lane = threadIdx.x & 63, wave = threadIdx.x >> 6;
  for (int tile = blockIdx.x; tile < 8 * (NTOK / 128); tile += gridDim.x) {
    const int rt = tile >> 3, ct = tile & 7;
    f32x16 acc[2][2]; zero_acc(acc);
    gemm_mainloop(acc, merged, 1024, Wo, 1024, 1024, rt * 128, ct * 128, smem);
    const int rb = rt * 128 + (wave >> 1) * 64, cb = ct * 128 + (wave & 1) * 64, d = lane & 31, hh = lane >> 5, b = rb >> 13;
#pragma unroll
    for (int ni = 0; ni < 2; ++ni) {
      const int col = cb + ni * 32 + d;
      const float gt = mod[b * 6144 + 2048 + col];
#pragma unroll
      for (int mi = 0; mi < 2; ++mi)
#pragma unroll
        for (int r = 0; r < 16; ++r) {
          const int row = rb + mi * 32 + (r & 3) + 8 * (r >> 2) + 4 * hh;
          y[(size_t)row * 1024 + col] = DN_ALPHA * p.x[(size_t)row * 1024 + col] + gt * acc[mi][ni][r];
        }
    }
  }
}

__device__ void phase_compress(const Params& p, char* smem) {
  char* ws = p.ws;
  const int tid = threadIdx.x, lane = tid & 63, wave = tid >> 6, l31 = lane & 31, hh = lane >> 5;
  bf16_t* hid = (bf16_t*)smem;
  constexpr int LH = 136;
  for (int item = blockIdx.x; item < 256; item += gridDim.x) {
    const int w = item >> 7, R0 = (item & 127) * 64;
    const bf16_t* src = (const bf16_t*)(ws + (w == 0 ? OFF_KC : OFF_VC));
    const bf16_t* W1 = (const bf16_t*)(ws + OFF_CW1) + (size_t)w * 128 * 2048;
    const bf16_t* W2 = (const bf16_t*)(ws + OFF_CW2) + (size_t)w * 64 * 128;
    const float* posb = (const float*)(ws + OFF_POSB) + w * 128;
    const bf16_t* abase[2];
#pragma unroll
    for (int mi = 0; mi < 2; ++mi) {
      const int R = R0 + mi * 32 + l31, bg = R >> 9, n = R & 511, nn = n < 510 ? n : 510;
      abase[mi] = src + ((size_t)((bg >> 1) * SEQ + 16 * nn)) * 128 + (bg & 1) * 64 + hh * 8;
    }
    const bf16_t* bbase = W1 + (size_t)(wave * 32 + l31) * 2048 + hh * 8;
    f32x16 acc[2];
#pragma unroll
    for (int r = 0; r < 16; ++r) { acc[0][r] = 0.f; acc[1][r] = 0.f; }
#pragma unroll 8
    for (int ks = 0; ks < 128; ++ks) {
      const int aofs = (ks >> 2) * 128 + (ks & 3) * 16;
      const bf16x8 a0 = *(const bf16x8*)(abase[0] + aofs), a1 = *(const bf16x8*)(abase[1] + aofs);
      const bf16x8 bb = *(const bf16x8*)(bbase + ks * 16);
      acc[0] = MFMA32(a0, bb, acc[0]); acc[1] = MFMA32(a1, bb, acc[1]);
    }
    __syncthreads();
    {
      const float pb = posb[wave * 32 + l31];
#pragma unroll
      for (int mi = 0; mi < 2; ++mi)
#pragma unroll
        for (int r = 0; r < 16; ++r) {
          const int row = mi * 32 + (r & 3) + 8 * (r >> 2) + 4 * hh;
          hid[row * LH + wave * 32 + l31] = f2bf(gelu_f(acc[mi][r] + pb));
        }
    }
    __syncthreads();
    const int mi = wave >> 1, ni = wave & 1;
    f32x16 o;
#pragma unroll
    for (int r = 0; r < 16; ++r) o[r] = 0.f;
#pragma unroll
    for (int ks = 0; ks < 8; ++ks) {
      const bf16x8 a = *(const bf16x8*)(hid + (mi * 32 + l31) * LH + ks * 16 + hh * 8);
      const bf16x8 bb = *(const bf16x8*)(W2 + (size_t)(ni * 32 + l31) * 128 + ks * 16 + hh * 8);
      o = MFMA32(a, bb, o);
    }
    const int d = ni * 32 + l31;
    const float b2 = p.cmp_b2[w * 64 + d];
    const int bg = R0 >> 9;
    if (w == 0) {
      bf16_t* kc = (bf16_t*)(ws + OFF_KCMP);
#pragma unroll
      for (int r = 0; r < 16; ++r) {
        const int n = (R0 & 511) + mi * 32 + (r & 3) + 8 * (r >> 2) + 4 * hh;
        kc[((size_t)bg * 512 + n) * 64 + d] = f2bf(n < 511 ? o[r] + b2 : 0.f);
      }
    } else {
      bf16_t* vc = (bf16_t*)(ws + OFF_VCMPT);
#pragma unroll
      for (int q = 0; q < 4; ++q) {
        const int n = (R0 & 511) + mi * 32 + 8 * q + 4 * hh;
        float v0 = o[4 * q] + b2, v1 = o[4 * q + 1] + b2, v2 = o[4 * q + 2] + b2, v3 = o[4 * q + 3] + b2;
        if (n + 3 >= 511) v3 = 0.f;
        u32x2 wv; wv.x = pack2(v0, v1); wv.y = pack2(v2, v3);
        *(u32x2*)(vc + ((size_t)bg * 64 + d) * 512 + n) = wv;
      }
    }
  }
}

constexpr int LK = 72;
constexpr int LVT = 68;
constexpr int NSA_KS = 0, NSA_VS = 9216, NSA_AIMP = 17920, NSA_CIMP = NSA_AIMP + 16384, NSA_SELM = NSA_CIMP + 16384;
struct TileRegs { u32x4 k[2]; u32x4 v[2]; };

DI void nsa_load_tile(TileRegs& t, const bf16_t* kbase, size_t kstride, const bf16_t* vtbase, size_t vstride) {
  const int tid = threadIdx.x;
#pragma unroll
  for (int i = 0; i < 2; ++i) {
    const int idx = tid + i * 256, r = idx >> 3, ch = idx & 7;
    t.k[i] = *(const u32x4*)(kbase + (size_t)r * kstride + ch * 8);
    t.v[i] = *(const u32x4*)(vtbase + (size_t)r * vstride + ch * 8);
  }
}
DI void nsa_store_tile(const TileRegs& t, char* smem) {
  const int tid = threadIdx.x;
  bf16_t* Ks = (bf16_t*)(smem + NSA_KS); bf16_t* Vs = (bf16_t*)(smem + NSA_VS);
#pragma unroll
  for (int i = 0; i < 2; ++i) {
    const int idx = tid + i * 256, r = idx >> 3, ch = idx & 7;
    *(u32x4*)(Ks + r * LK + ch * 8) = t.k[i];
    u32x2 lo, hi; lo.x = t.v[i].x; lo.y = t.v[i].y; hi.x = t.v[i].z; hi.y = t.v[i].w;
    *(u32x2*)(Vs + r * LVT + ch * 8) = lo; *(u32x2*)(Vs + r * LVT + ch * 8 + 4) = hi;
  }
}
DI void nsa_scores(f32x16 (&st)[2], const char* smem, const bf16x8 (&qf)[4], int lane) {
  const bf16_t* Ks = (const bf16_t*)(smem + NSA_KS);
#pragma unroll
  for (int kt = 0; kt < 2; ++kt) {
#pragma unroll
    for (int r = 0; r < 16; ++r) st[kt][r] = 0.f;
#pragma unroll
    for (int ks = 0; ks < 4; ++ks) {
      const bf16x8 a = *(const bf16x8*)(Ks + (kt * 32 + (lane & 31)) * LK + ks * 16 + (lane >> 5) * 8);
      st[kt] = MFMA32(a, qf[ks], st[kt]);
    }
  }
}
DI void nsa_pv(f32x16 (&o)[2], const f32x16 (&pt)[2], const char* smem, int lane) {
  const bf16_t* Vs = (const bf16_t*)(smem + NSA_VS);
#pragma unroll
  for (int kt = 0; kt < 2; ++kt)
#pragma unroll
    for (int s = 0; s < 2; ++s) {
      u32x4 pk; pk.x = pack2(pt[kt][8 * s], pt[kt][8 * s + 1]); pk.y = pack2(pt[kt][8 * s + 2], pt[kt][8 * s + 3]);
      pk.z = pack2(pt[kt][8 * s + 4], pt[kt][8 * s + 5]); pk.w = pack2(pt[kt][8 * s + 6], pt[kt][8 * s + 7]);
      const bf16x8 pb = __builtin_bit_cast(bf16x8, pk);
#pragma unroll
      for (int dt = 0; dt < 2; ++dt) {
        const bf16_t* vp = Vs + (dt * 32 + (lane & 31)) * LVT + kt * 32 + 16 * s + 4 * (lane >> 5);
        const s16x4 lo = *(const s16x4*)vp, hi = *(const s16x4*)(vp + 8);
        const bf16x8 a = __builtin_shufflevector(lo, hi, 0, 1, 2, 3, 4, 5, 6, 7);
        o[dt] = MFMA32(a, pb, o[dt]);
      }
    }
}

struct NsaLane {
  bf16x8 qf[4];
  int t;
  int hh;
  unsigned selw[4];
};

DI void nsa_online(f32x16 (&st)[2], unsigned vm0, unsigned vm1, float& m, float& l, f32x16 (&o)[2], const char* smem, int lane) {
  float mx = -1e30f;
#pragma unroll
  for (int r = 0; r < 16; ++r) { if ((vm0 >> r) & 1u) mx = fmaxf(mx, st[0][r]); if ((vm1 >> r) & 1u) mx = fmaxf(mx, st[1][r]); }
  mx = fmaxf(mx, __shfl_xor(mx, 32));
  const float mn = fmaxf(m, mx);
  const float alpha = __expf(m - mn);
  m = mn;
  float sum = 0.f;
#pragma unroll
  for (int r = 0; r < 16; ++r) {
    const float p0 = ((vm0 >> r) & 1u) ? __expf(st[0][r] - mn) : 0.f;
    const float p1 = ((vm1 >> r) & 1u) ? __expf(st[1][r] - mn) : 0.f;
    st[0][r] = p0; st[1][r] = p1; sum += p0 + p1;
  }
  l = l * alpha + sum;
#pragma unroll
  for (int r = 0; r < 16; ++r) { o[0][r] *= alpha; o[1][r] *= alpha; }
  nsa_pv(o, st, smem, lane);
}

__device__ void phase_nsa(const Params& p, char* smem, int branch_mask) {
  char* ws = p.ws;
  const int tid = threadIdx.x, lane = tid & 63, wave = tid >> 6, hh = lane >> 5, c = lane & 31, qi = c >> 2, r4 = c & 3;
  const bf16_t* Q = (const bf16_t*)(ws + OFF_Q);
  const bf16_t* KS = (const bf16_t*)(ws + OFF_KS); const bf16_t* VST = (const bf16_t*)(ws + OFF_VST);
  const bf16_t* KW = (const bf16_t*)(ws + OFF_KW); const bf16_t* VWT = (const bf16_t*)(ws + OFF_VWT);
  const bf16_t* KCMP = (const bf16_t*)(ws + OFF_KCMP); const bf16_t* VCMPT = (const bf16_t*)(ws + OFF_VCMPT);
  const float* gsig = (const float*)(ws + OFF_GSIG);
  bf16_t* ONSA = (bf16_t*)(ws + OFF_ONSA);
  float* Aimp = (float*)(smem + NSA_AIMP) + wave * 1024;
  float* Cimp = (float*)(smem + NSA_CIMP) + wave * 1024;
  unsigned short* selm16 = (unsigned short*)(smem + NSA_SELM) + wave * 64;
  const unsigned* selm32 = (const unsigned*)(smem + NSA_SELM) + wave * 32;

  for (int item = blockIdx.x; item < 4096; item += gridDim.x) {
    const int qb = 127 - (item >> 5), rest = item & 31, b = rest >> 2, g = (rest >> 1) & 1, half = rest & 1;
    const int bg = b * 2 + g;
    const int t = qb * 64 + half * 32 + wave * 8 + qi;
    const int tmax = qb * 64 + half * 32 + 31;
    const size_t tokrow = (size_t)b * SEQ + t;
    bf16x8 qf[4];
#pragma unroll
    for (int ks = 0; ks < 4; ++ks) qf[ks] = *(const bf16x8*)(Q + tokrow * 512 + (g * 4 + r4) * 64 + ks * 16 + hh * 8);
    const float g_c = gsig[tokrow * 32 + (g * 4 + r4) * 3 + 0], g_s = gsig[tokrow * 32 + (g * 4 + r4) * 3 + 1], g_w = gsig[tokrow * 32 + (g * 4 + r4) * 3 + 2];
    f32x16 otot[2];
#pragma unroll
    for (int r = 0; r < 16; ++r) { otot[0][r] = 0.f; otot[1][r] = 0.f; }
    unsigned selw0 = 0, selw1 = 0, selw2 = 0, selw3 = 0;
    TileRegs tr;

    {
      const int nmax = (tmax - 31) >> 4;
      const int ntile = (tmax >= 31) ? (nmax >> 6) + 1 : 0;
      const bf16_t* kb = KCMP + (size_t)bg * 512 * 64;
      const bf16_t* vb = VCMPT + (size_t)bg * 64 * 512;
      float m = -1e30f, l = 0.f;
      __syncthreads();
      for (int i = lane; i < 1024; i += 64) { Aimp[i] = 0.f; Cimp[i] = 0.f; }
      if (ntile > 0) nsa_load_tile(tr, kb, 64, vb, 512);
      for (int j = 0; j < ntile; ++j) {
        __syncthreads();
        nsa_store_tile(tr, smem);
        __syncthreads();
        if (j + 1 < ntile) nsa_load_tile(tr, kb + (size_t)(j + 1) * 64 * 64, 64, vb + (j + 1) * 64, 512);
        f32x16 st[2];
        nsa_scores(st, smem, qf, lane);
        float mx = -1e30f;
#pragma unroll
        for (int kt = 0; kt < 2; ++kt)
#pragma unroll
          for (int r = 0; r < 16; ++r) {
            const int n = j * 64 + kt * 32 + (r & 3) + 8 * (r >> 2) + 4 * hh;
            if (16 * n + 31 <= t) mx = fmaxf(mx, st[kt][r]);
          }
        mx = fmaxf(mx, __shfl_xor(mx, 32));
        const float mn = fmaxf(m, mx);
        float sum = 0.f;
#pragma unroll
        for (int kt = 0; kt < 2; ++kt)
#pragma unroll
          for (int r = 0; r < 16; ++r) {
            const int n = j * 64 + kt * 32 + (r & 3) + 8 * (r >> 2) + 4 * hh;
            if (16 * n + 31 <= t) sum += __expf(st[kt][r] - mn);
          }
        l = l * __expf(m - mn) + sum;
        m = mn;
      }
      l += __shfl_xor(l, 32);
      const float inv_l = l > 0.f ? 1.0f / l : 0.f;
      f32x16 o[2];
#pragma unroll
      for (int r = 0; r < 16; ++r) { o[0][r] = 0.f; o[1][r] = 0.f; }
      if (ntile > 0) nsa_load_tile(tr, kb, 64, vb, 512);
      for (int j = 0; j < ntile; ++j) {
        __syncthreads();
        nsa_store_tile(tr, smem);
        __syncthreads();
        if (j + 1 < ntile) nsa_load_tile(tr, kb + (size_t)(j + 1) * 64 * 64, 64, vb + (j + 1) * 64, 512);
        f32x16 st[2];
        nsa_scores(st, smem, qf, lane);
#pragma unroll
        for (int kt = 0; kt < 2; ++kt)
#pragma unroll
          for (int r = 0; r < 16; ++r) {
            const int n = j * 64 + kt * 32 + (r & 3) + 8 * (r >> 2) + 4 * hh;
            st[kt][r] = (16 * n + 31 <= t) ? __expf(st[kt][r] - m) * inv_l : 0.f;
          }
#pragma unroll
        for (int kt = 0; kt < 2; ++kt)
#pragma unroll
          for (int c4 = 0; c4 < 4; ++c4) {
            float carry = 0.5f * st[kt][4 * c4 + 3];
            float full = st[kt][4 * c4] + st[kt][4 * c4 + 1] + st[kt][4 * c4 + 2] + carry;
            full += __shfl_xor(full, 1); full += __shfl_xor(full, 2);
            carry += __shfl_xor(carry, 1); carry += __shfl_xor(carry, 2);
            const int jb = j * 16 + kt * 8 + 2 * c4 + hh;
            if (r4 == 0) { Aimp[qi * 128 + jb] = full; Cimp[qi * 128 + jb] = carry; }
          }
        if (branch_mask & 1) nsa_pv(o, st, smem, lane);
      }
      if (branch_mask & 1) {
#pragma unroll
        for (int r = 0; r < 16; ++r) { otot[0][r] += g_c * o[0][r]; otot[1][r] += g_c * o[1][r]; }
      }
      __syncthreads();
      const int cur = qb;
      if (cur <= 15) {
        if (lane < 8) { selm16[lane * 8 + 0] = (unsigned short)((2u << cur) - 1u);
#pragma unroll
          for (int k = 1; k < 8; ++k) selm16[lane * 8 + k] = 0; }
      } else {
        const int qs = lane >> 3, sub = lane & 7;
        float v[16];
#pragma unroll
        for (int i = 0; i < 16; ++i) {
          const int jj = sub * 16 + i;
          const bool ok = (jj >= 1) && (jj <= cur - 2);
          const int jm = jj >= 1 ? jj - 1 : 0;
          v[i] = ok ? (Aimp[qs * 128 + jj] + Cimp[qs * 128 + jm]) : -3e38f;
        }
        unsigned bits = 0;
        for (int it = 0; it < 13; ++it) {
          float bv = v[0]; int bi = 0;
#pragma unroll
          for (int i = 1; i < 16; ++i) if (v[i] > bv) { bv = v[i]; bi = i; }
          int bj = sub * 16 + bi;
#pragma unroll
          for (int o2 = 1; o2 < 8; o2 <<= 1) {
            const float ov = __shfl_xor(bv, o2); const int oj = __shfl_xor(bj, o2);
            if (ov > bv || (ov == bv && oj < bj)) { bv = ov; bj = oj; }
          }
          if ((bj >> 4) == sub) {
            const int i2 = bj & 15;
#pragma unroll
            for (int i = 0; i < 16; ++i) if (i == i2) v[i] = -3e38f;
            bits |= 1u << i2;
          }
        }
        if (sub == 0) bits |= 1u;
        if ((cur >> 4) == sub) bits |= 1u << (cur & 15);
        if (((cur - 1) >> 4) == sub) bits |= 1u << ((cur - 1) & 15);
        selm16[qs * 8 + sub] = (unsigned short)bits;
      }
      __syncthreads();
      selw0 = selm32[qi * 4 + 0]; selw1 = selm32[qi * 4 + 1]; selw2 = selm32[qi * 4 + 2]; selw3 = selm32[qi * 4 + 3];
    }

    if (branch_mask & 2) {
      const bf16_t* kb = KS + (size_t)b * SEQ * 128 + g * 64;
      const bf16_t* vb = VST + (size_t)bg * 64 * SEQ;
      float m = -1e30f, l = 0.f;
      f32x16 o[2];
#pragma unroll
      for (int r = 0; r < 16; ++r) { o[0][r] = 0.f; o[1][r] = 0.f; }
      nsa_load_tile(tr, kb, 128, vb, SEQ);
      for (int j = 0; j <= qb; ++j) {
        __syncthreads();
        nsa_store_tile(tr, smem);
        __syncthreads();
        if (j + 1 <= qb) nsa_load_tile(tr, kb + (size_t)(j + 1) * 64 * 128, 128, vb + (j + 1) * 64, SEQ);
        const unsigned w = j < 32 ? selw0 : (j < 64 ? selw1 : (j < 96 ? selw2 : selw3));
        const bool sel = (w >> (j & 31)) & 1u;
        if (__any(sel)) {
          f32x16 st[2];
          nsa_scores(st, smem, qf, lane);
          unsigned vm0 = 0, vm1 = 0;
#pragma unroll
          for (int r = 0; r < 16; ++r) {
            const int k0 = j * 64 + (r & 3) + 8 * (r >> 2) + 4 * hh;
            if (sel && k0 <= t) vm0 |= 1u << r;
            if (sel && k0 + 32 <= t) vm1 |= 1u << r;
          }
          nsa_online(st, vm0, vm1, m, l, o, smem, lane);
        }
      }
      l += __shfl_xor(l, 32);
      const float sc = l > 0.f ? g_s / l : 0.f;
#pragma unroll
      for (int r = 0; r < 16; ++r) { otot[0][r] += sc * o[0][r]; otot[1][r] += sc * o[1][r]; }
    }

    if (branch_mask & 4) {
      const bf16_t* kb = KW + (size_t)b * SEQ * 128 + g * 64;
      const bf16_t* vb = VWT + (size_t)bg * 64 * SEQ;
      float m = -1e30f, l = 0.f;
      f32x16 o[2];
#pragma unroll
      for (int r = 0; r < 16; ++r) { o[0][r] = 0.f; o[1][r] = 0.f; }
      const int j0 = qb >= 8 ? qb - 8 : 0;
      nsa_load_tile(tr, kb + (size_t)j0 * 64 * 128, 128, vb + j0 * 64, SEQ);
      for (int j = j0; j <= qb; ++j) {
        __syncthreads();
        nsa_store_tile(tr, smem);
        __syncthreads();
        if (j + 1 <= qb) nsa_load_tile(tr, kb + (size_t)(j + 1) * 64 * 128, 128, vb + (j + 1) * 64, SEQ);
        f32x16 st[2];
        nsa_scores(st, smem, qf, lane);
        unsigned vm0 = 0, vm1 = 0;
#pragma unroll
        for (int r = 0; r < 16; ++r) {
          const int k0 = j * 64 + (r & 3) + 8 * (r >> 2) + 4 * hh;
          if (k0 <= t && t - k0 < 512) vm0 |= 1u << r;
          if (k0 + 32 <= t && t - (k0 + 32) < 512) vm1 |= 1u << r;
        }
        nsa_online(st, vm0, vm1, m, l, o, smem, lane);
      }
      l += __shfl_xor(l, 32);
      const float sc = l > 0.f ? g_w / l : 0.f;
#pragma unroll
      for (int r = 0; r < 16; ++r) { otot[0][r] += sc * o[0][r]; otot[1][r] += sc * o[1][r]; }
    }

#pragma unroll
    for (int dt = 0; dt < 2; ++dt)
#pragma unroll
      for (int q4 = 0; q4 < 4; ++q4) {
        u32x2 wv; wv.x = pack2(otot[dt][4 * q4], otot[dt][4 * q4 + 1]); wv.y = pack2(otot[dt][4 * q4 + 2], otot[dt][4 * q4 + 3]);
        *(u32x2*)(ONSA + tokrow * 512 + (g * 4 + r4) * 64 + dt * 32 + 8 * q4 + 4 * hh) = wv;
      }
  }
}

__device__ void phase_peerq(const Params& p, char* smem) {
  char* ws = p.ws;
  const bf16_t* h2 = (const bf16_t*)(ws + OFF_H);
  const bf16_t* Wq = (const bf16_t*)(ws + OFF_WQ);
  bf16_t* pq = (bf16_t*)(ws + OFF_PQ);
  const int lane = threadIdx.x & 63, wave = threadIdx.x >> 6;
  for (int tile = blockIdx.x; tile < 16 * (NTOK / 128); tile += gridDim.x) {
    const int rt = tile >> 4, ct = tile & 15;
    f32x16 acc[2][2]; zero_acc(acc);
    gemm_mainloop(acc, h2, 1024, Wq, 1024, 1024, rt * 128, ct * 128, smem);
    store_plain<0>(pq, 2048, ct * 128 + (wave & 1) * 64, acc, rt * 128 + (wave >> 1) * 64, lane);
  }
}

DI void argmax16(float& bv, int& bk) {
#pragma unroll
  for (int o = 1; o < 16; o <<= 1) {
    const float ov = __shfl_xor(bv, o); const int ok = __shfl_xor(bk, o);
    if (ov > bv || (ov == bv && ok < bk)) { bv = ov; bk = ok; }
  }
}
__device__ void phase_route(const Params& p, char* smem) {
  char* ws = p.ws;
  const int tid = threadIdx.x, lane = tid & 63, wave = tid >> 6, l31 = lane & 31, hh = lane >> 5;
  const bf16_t* pq = (const bf16_t*)(ws + OFF_PQ);
  const bf16_t* pk = (const bf16_t*)(ws + OFF_PKEYS);
  int* eidx = (int*)(ws + OFF_EIDX);
  float* pgate = (float*)(ws + OFF_PGATE);
  float* S = (float*)smem;
  constexpr int LS = 132;
  for (int item = blockIdx.x; item < (NTOK / 32) * 8; item += gridDim.x) {
    const int h = item & 7, t0 = (item >> 3) * 32;
    __syncthreads();
#pragma unroll
    for (int c = 0; c < 2; ++c) {
      f32x16 acc;
#pragma unroll
      for (int r = 0; r < 16; ++r) acc[r] = 0.f;
      const bf16_t* ap = pq + (size_t)(t0 + l31) * 2048 + h * 256 + c * 128 + hh * 8;
      const bf16_t* bp = pk + ((size_t)(h * 2 + c) * 128 + wave * 32 + l31) * 128 + hh * 8;
#pragma unroll
      for (int ks = 0; ks < 8; ++ks) {
        const bf16x8 a = *(const bf16x8*)(ap + ks * 16), bb = *(const bf16x8*)(bp + ks * 16);
        acc = MFMA32(a, bb, acc);
      }
#pragma unroll
      for (int r = 0; r < 16; ++r) S[(c * 32 + (r & 3) + 8 * (r >> 2) + 4 * hh) * LS + wave * 32 + l31] = acc[r];
    }
    __syncthreads();
    const int gid = tid >> 4, li = tid & 15;
#pragma unroll 1
    for (int rd = 0; rd < 2; ++rd) {
      const int tok = rd * 16 + gid;
      float sv[2]; int si[2];
#pragma unroll
      for (int c = 0; c < 2; ++c) {
        float v[8];
#pragma unroll
        for (int i = 0; i < 8; ++i) v[i] = S[(c * 32 + tok) * LS + li + 16 * i];
        float rs = 0.f; int rn = 0;
        for (int it = 0; it < 16; ++it) {
          float bv = v[0]; int bi = 0;
#pragma unroll
          for (int i = 1; i < 8; ++i) if (v[i] > bv) { bv = v[i]; bi = i; }
          int bn = li + 16 * bi;
          argmax16(bv, bn);
          if ((bn & 15) == li) {
            const int i2 = bn >> 4;
#pragma unroll
            for (int i = 0; i < 8; ++i) if (i == i2) v[i] = -3e38f;
          }
          if (li == it) { rs = bv; rn = bn; }
        }
        sv[c] = rs; si[c] = rn;
      }
      int pp = 0; float ts = 0.f; int tf = 0;
      for (int it = 0; it < 16; ++it) {
        const float s2p = __shfl(sv[1], pp & 15, 16);
        float bv = (pp < 16) ? sv[0] + s2p : -3e38f;
        int bf = li * 16 + pp;
        argmax16(bv, bf);
        if ((bf >> 4) == li) ++pp;
        if (li == it) { ts = bv; tf = bf; }
      }
      const int e1 = __shfl(si[0], tf >> 4, 16), e2 = __shfl(si[1], tf & 15, 16);
      const float mx = __shfl(ts, 0, 16);
      const float ex = __expf(ts - mx);
      float sum = ex;
#pragma unroll
      for (int o = 1; o < 16; o <<= 1) sum += __shfl_xor(sum, o);
      const size_t oidx = ((size_t)(t0 + tok) * 8 + h) * 16 + li;
      eidx[oidx] = e1 * 128 + e2;
      pgate[oidx] = ex / sum;
    }
  }
}

__device__ void phase_ffn(const Params& p) {
  char* ws = p.ws;
  const int lane = threadIdx.x & 63, wave = threadIdx.x >> 6;
  const bf16_t* h2 = (const bf16_t*)(ws + OFF_H);
  const bf16_t* PU = (const bf16_t*)(ws + OFF_PU);
  const bf16_t* PV = (const bf16_t*)(ws + OFF_PV);
  const int* eidx = (const int*)(ws + OFF_EIDX);
  const float* pgate = (const float*)(ws + OFF_PGATE);
  const float* x1 = (const float*)(ws + OFF_X1);
  const float* mod = (const float*)(ws + OFF_MOD);
  for (int grp = blockIdx.x; grp < NTOK / 4; grp += gridDim.x) {
    const int row = grp * 4 + wave, b = row >> 13;
    float hx[16];
    {
      const u32x4 a = *(const u32x4*)(h2 + (size_t)row * DM + lane * 8), c = *(const u32x4*)(h2 + (size_t)row * DM + 512 + lane * 8);
      hx[0] = bflo(a.x); hx[1] = bfhi(a.x); hx[2] = bflo(a.y); hx[3] = bfhi(a.y); hx[4] = bflo(a.z); hx[5] = bfhi(a.z); hx[6] = bflo(a.w); hx[7] = bfhi(a.w);
      hx[8] = bflo(c.x); hx[9] = bfhi(c.x); hx[10] = bflo(c.y); hx[11] = bfhi(c.y); hx[12] = bflo(c.z); hx[13] = bfhi(c.z); hx[14] = bflo(c.w); hx[15] = bfhi(c.w);
    }
    const int ev0 = eidx[(size_t)row * 128 + lane], ev1 = eidx[(size_t)row * 128 + 64 + lane];
    const float gv0 = pgate[(size_t)row * 128 + lane], gv1 = pgate[(size_t)row * 128 + 64 + lane];
    float acc[16];
#pragma unroll
    for (int i = 0; i < 16; ++i) acc[i] = 0.f;
#pragma unroll 4
    for (int j = 0; j < 128; ++j) {
      const int e = __builtin_amdgcn_readlane(j < 64 ? ev0 : ev1, j & 63);
      const float gt = __int_as_float(__builtin_amdgcn_readlane(__float_as_int(j < 64 ? gv0 : gv1), j & 63));
      const bf16_t* up = PU + (size_t)e * DM + lane * 8;
      const bf16_t* vp = PV + (size_t)e * DM + lane * 8;
      const u32x4 ua = *(const u32x4*)up, ub = *(const u32x4*)(up + 512);
      const u32x4 va = *(const u32x4*)vp, vb = *(const u32x4*)(vp + 512);
      float d = hx[0] * bflo(ua.x) + hx[1] * bfhi(ua.x) + hx[2] * bflo(ua.y) + hx[3] * bfhi(ua.y) + hx[4] * bflo(ua.z) + hx[5] * bfhi(ua.z) + hx[6] * bflo(ua.w) + hx[7] * bfhi(ua.w);
      d += hx[8] * bflo(ub.x) + hx[9] * bfhi(ub.x) + hx[10] * bflo(ub.y) + hx[11] * bfhi(ub.y) + hx[12] * bflo(ub.z) + hx[13] * bfhi(ub.z) + hx[14] * bflo(ub.w) + hx[15] * bfhi(ub.w);
      const float act = wave_sum(d);
      const float w = gt * gelu_f(act);
      acc[0] += w * bflo(va.x); acc[1] += w * bfhi(va.x); acc[2] += w * bflo(va.y); acc[3] += w * bfhi(va.y);
      acc[4] += w * bflo(va.z); acc[5] += w * bfhi(va.z); acc[6] += w * bflo(va.w); acc[7] += w * bfhi(va.w);
      acc[8] += w * bflo(vb.x); acc[9] += w * bfhi(vb.x); acc[10] += w * bflo(vb.y); acc[11] += w * bfhi(vb.y);
      acc[12] += w * bflo(vb.z); acc[13] += w * bfhi(vb.z); acc[14] += w * bflo(vb.w); acc[15] += w * bfhi(vb.w);
    }
    float v[16];
#pragma unroll
    for (int hf = 0; hf < 2; ++hf)
#pragma unroll
      for (int q = 0; q < 2; ++q) {
        const int col = hf * 512 + lane * 8 + q * 4;
        const f32x4 xv = *(const f32x4*)(x1 + (size_t)row * DM + col), gt2 = *(const f32x4*)(mod + b * 6144 + 5120 + col);
        v[hf * 8 + q * 4 + 0] = DN_ALPHA * xv.x + gt2.x * acc[hf * 8 + q * 4 + 0];
        v[hf * 8 + q * 4 + 1] = DN_ALPHA * xv.y + gt2.y * acc[hf * 8 + q * 4 + 1];
        v[hf * 8 + q * 4 + 2] = DN_ALPHA * xv.z + gt2.z * acc[hf * 8 + q * 4 + 2];
        v[hf * 8 + q * 4 + 3] = DN_ALPHA * xv.w + gt2.w * acc[hf * 8 + q * 4 + 3];
      }
    float mean, rstd; row_stats(v, mean, rstd);
#pragma unroll
    for (int hf = 0; hf < 2; ++hf)
#pragma unroll
      for (int q = 0; q < 2; ++q) {
        const int col = hf * 512 + lane * 8 + q * 4;
        const f32x4 g = *(const f32x4*)(p.ln2_g + col), bb = *(const f32x4*)(p.ln2_b + col);
        f32x4 o;
        o.x = (v[hf * 8 + q * 4 + 0] - mean) * rstd * g.x + bb.x; o.y = (v[hf * 8 + q * 4 + 1] - mean) * rstd * g.y + bb.y;
        o.z = (v[hf * 8 + q * 4 + 2] - mean) * rstd * g.z + bb.z; o.w = (v[hf * 8 + q * 4 + 3] - mean) * rstd * g.w + bb.w;
        *(f32x4*)(p.out + (size_t)row * DM + col) = o;
      }
  }
}

constexpr int SMEM_BYTES = 73728;

template <int PH>
__global__ void __launch_bounds__(NT) k_phase(Params p) {
  __shared__ __attribute__((aligned(16))) char smem[SMEM_BYTES];
  if (PH == 0) phase_prep(p, smem);
  if (PH == 1) phase_ln_in(p);
  if (PH == 2) phase_gemm1(p, smem);
  if (PH == 3) { phase_compress(p, smem); phase_sgu(p, smem); }
  if (PH == 4) phase_nsa(p, smem, NSA_MASK);
  if (PH == 5) phase_merge(p, smem, STAGE >= 3);
  if (PH == 6) phase_outproj(p, smem);
  if (PH == 7) phase_ln_mid(p, STAGE == 1);
  if (PH == 8) phase_peerq(p, smem);
  if (PH == 9) phase_route(p, smem);
  if (PH == 10) phase_ffn(p);
  if (PH == 11) phase_final_noffn(p);
}

extern "C" void kernel_launch(void* const* d_in, const int* in_sizes, int n_in, void* d_out, int out_size, void* d_ws, size_t ws_size, hipStream_t stream) {
  if (ws_size < OFF_END) { fprintf(stderr, "workspace too small: %zu < %zu\n", ws_size, (size_t)OFF_END); return; }
  Params p{};
  const float** fp = (const float**)&p;
  for (int i = 0; i < 26; ++i) fp[i] = (const float*)d_in[i];
  p.out = (float*)d_out;
  p.ws = (char*)d_ws;
  for (int i = 0; i < 32; ++i) p.inv_freq[i] = (float)pow(10000.0, -(double)i / 32.0);
  const int grid = 1024;
  k_phase<0><<<grid, NT, 0, stream>>>(p);
  k_phase<1><<<grid, NT, 0, stream>>>(p);
#if STAGE >= 2
  k_phase<2><<<grid, NT, 0, stream>>>(p);
  k_phase<3><<<grid, NT, 0, stream>>>(p);
#if STAGE >= 3
  k_phase<4><<<grid, NT, 0, stream>>>(p);
#endif
  k_phase<5><<<grid, NT, 0, stream>>>(p);
  k_phase<6><<<grid, NT, 0, stream>>>(p);
#endif
  k_phase<7><<<grid, NT, 0, stream>>>(p);
#if STAGE >= 4
  k_phase<8><<<grid, NT, 0, stream>>>(p);
  k_phase<9><<<grid, NT, 0, stream>>>(p);
  k_phase<10><<<grid, NT, 0, stream>>>(p);
#else
  k_phase<11><<<grid, NT, 0, stream>>>(p);
#endif
}
```

```cpp
#include <hip/hip_runtime.h>
#include <hip/hip_cooperative_groups.h>
#include <stdint.h>
#include <stdio.h>
#include <math.h>
namespace cg = cooperative_groups;

#ifndef STAGE
#define STAGE 4
#endif

#ifndef NSA_MASK
#define NSA_MASK 7
#endif
typedef unsigned short bf16_t;
typedef short bf16x8 __attribute__((ext_vector_type(8)));
typedef short s16x4 __attribute__((ext_vector_type(4)));
typedef float f32x16 __attribute__((ext_vector_type(16)));
typedef float f32x4 __attribute__((ext_vector_type(4)));
typedef float f32x2 __attribute__((ext_vector_type(2)));
typedef __bf16 bf16v2 __attribute__((ext_vector_type(2)));
typedef unsigned u32x4 __attribute__((ext_vector_type(4)));
typedef unsigned u32x2 __attribute__((ext_vector_type(2)));
#define DI __device__ __forceinline__
#define MFMA32(a, b, c) __builtin_amdgcn_mfma_f32_32x32x16_bf16((a), (b), (c), 0, 0, 0)

constexpr int NT = 256;
constexpr int NB = 8, SEQ = 8192, DM = 1024, NTOK = NB * SEQ;
constexpr int N1 = 4480;
constexpr float DN_ALPHA = 1.189207115002721f;
constexpr float LN_EPS = 1e-5f;

constexpr size_t MB = 1024 * 1024;
constexpr size_t OFF_MOD = 0;
constexpr size_t OFF_ROPE = OFF_MOD + 256 * 1024;
constexpr size_t OFF_POSB = OFF_ROPE + 2 * MB;
constexpr size_t OFF_WT1 = OFF_POSB + 4096;
constexpr size_t OFF_WB = OFF_WT1 + (size_t)N1 * 1024 * 2;
constexpr size_t OFF_WOUT = OFF_WB + 2 * MB;
constexpr size_t OFF_WQ = OFF_WOUT + 2 * MB;
constexpr size_t OFF_PKEYS = OFF_WQ + 4 * MB;
constexpr size_t OFF_CW1 = OFF_PKEYS + MB / 2;
constexpr size_t OFF_CW2 = OFF_CW1 + MB;
constexpr size_t OFF_SGUW = OFF_CW2 + 32 * 1024;
constexpr size_t OFF_PU = OFF_SGUW + 256 * 1024;
constexpr size_t OFF_PV = OFF_PU + 32 * MB;
constexpr size_t OFF_ACT = ((OFF_PV + 32 * MB + 4095) / 4096) * 4096;
constexpr size_t OFF_H = OFF_ACT;
constexpr size_t OFF_Q = OFF_H + 128 * MB;
constexpr size_t OFF_KC = OFF_Q + 64 * MB;
constexpr size_t OFF_VC = OFF_KC + 16 * MB;
constexpr size_t OFF_KS = OFF_VC + 16 * MB;
constexpr size_t OFF_VST = OFF_KS + 16 * MB;
constexpr size_t OFF_KW = OFF_VST + 16 * MB;
constexpr size_t OFF_VWT = OFF_KW + 16 * MB;
constexpr size_t OFF_U = OFF_VWT + 16 * MB;
constexpr size_t OFF_V = OFF_U + 64 * MB;
constexpr size_t OFF_GATE = OFF_V + 64 * MB;
constexpr size_t OFF_GSIG = OFF_GATE + 256 * MB;
constexpr size_t OFF_KCMP = OFF_GSIG + 8 * MB;
constexpr size_t OFF_VCMPT = OFF_KCMP + MB;
constexpr size_t OFF_ONSA = OFF_VCMPT + MB;
constexpr size_t OFF_SELG = OFF_ONSA + 64 * MB;
constexpr size_t OFF_END = OFF_SELG + 2 * MB;
constexpr size_t OFF_X1 = OFF_Q;
constexpr size_t OFF_Y = OFF_GATE;
constexpr size_t OFF_PQ = OFF_GATE;
constexpr size_t OFF_EIDX = OFF_ONSA;
constexpr size_t OFF_PGATE = OFF_ONSA + 32 * MB;

struct Params {
  const float *x, *c, *w_ada, *b_ada, *w_in, *cmp_pos, *cmp_w1, *cmp_b1, *cmp_w2, *cmp_b2, *sgu_ln_g, *sgu_ln_b, *sgu_w, *sgu_b,
      *w_branch, *w_merge, *b_merge, *w_out, *ln1_g, *ln1_b, *peer_wq, *peer_keys, *peer_u, *peer_v, *ln2_g, *ln2_b;
  float* out;
  char* ws;
  float inv_freq[32];
};

DI unsigned pack2(float lo, float hi) { f32x2 v = {lo, hi}; bf16v2 r = __builtin_convertvector(v, bf16v2); return __builtin_bit_cast(unsigned, r); }
DI bf16_t f2bf(float f) { __bf16 r = (__bf16)f; return __builtin_bit_cast(unsigned short, r); }
DI float bf2f(bf16_t h) { return __uint_as_float(((unsigned)h) << 16); }
DI float bflo(unsigned u) { return __uint_as_float(u << 16); }
DI float bfhi(unsigned u) { return __uint_as_float(u & 0xffff0000u); }
DI float gelu_f(float v) { return 0.5f * v * (1.0f + erff(v * 0.70710678118654752f)); }
DI float sigmoid_f(float v) { return 1.0f / (1.0f + __expf(-v)); }
DI float wave_sum(float v) {
#pragma unroll
  for (int o = 32; o > 0; o >>= 1) v += __shfl_xor(v, o);
  return v;
}

template <class F>
DI void tconv_tile(float* tile, int k0, int n0, bf16_t* dst, int ldd, F f) {
  const int tid = threadIdx.x;
  __syncthreads();
#pragma unroll 4
  for (int i = 0; i < 16; ++i) { const int kl = i * 4 + (tid >> 6), nl = tid & 63; tile[nl * 65 + kl] = f(k0 + kl, n0 + nl); }
  __syncthreads();
#pragma unroll
  for (int i = 0; i < 2; ++i) {
    const int idx = tid + i * 256, nl = idx >> 3, kc = idx & 7;
    const float* t = tile + nl * 65 + kc * 8;
    u32x4 w; w.x = pack2(t[0], t[1]); w.y = pack2(t[2], t[3]); w.z = pack2(t[4], t[5]); w.w = pack2(t[6], t[7]);
    *(u32x4*)(dst + (size_t)(n0 + nl) * ldd + k0 + kc * 8) = w;
  }
}

DI void conv_chunk(const float* src, bf16_t* dst, size_t base) {
  const size_t i = base + (size_t)threadIdx.x * 8;
  const f32x4 a = *(const f32x4*)(src + i), b = *(const f32x4*)(src + i + 4);
  u32x4 w; w.x = pack2(a.x, a.y); w.y = pack2(a.z, a.w); w.z = pack2(b.x, b.y); w.w = pack2(b.z, b.w);
  *(u32x4*)(dst + i) = w;
}

DI void sincos_d(double x, double& s, double& c) {
  const double y = x * 0.25, y2 = y * y;
  double sn = y * (1.0 + y2 * (-1.0 / 6 + y2 * (1.0 / 120 + y2 * (-1.0 / 5040 + y2 * (1.0 / 362880 + y2 * (-1.0 / 39916800 + y2 * (1.0 / 6227020800.0)))))));
  double cs = 1.0 + y2 * (-0.5 + y2 * (1.0 / 24 + y2 * (-1.0 / 720 + y2 * (1.0 / 40320 + y2 * (-1.0 / 3628800 + y2 * (1.0 / 479001600.0 + y2 * (-1.0 / 87178291200.0)))))));
#pragma unroll
  for (int i = 0; i < 2; ++i) { const double s2 = 2.0 * sn * cs, c2 = cs * cs - sn * sn; sn = s2; cs = c2; }
  s = sn; c = cs;
}

__device__ void phase_prep(const Params& p, char* smem) {
  const int tid = threadIdx.x;
  float* fs = (float*)smem;
  char* ws = p.ws;
  constexpr int nA = 192, nB = 16 * 70, nC = 2 * 8 * 16, nD = 256, nE = 16 * 32, nF = 2 * 32 * 2, nG = 4, nH = 8, nI = 1024, nJ = 128, nK = 64, nL = 8192, nM = 8192;
  constexpr int total = nA + nB + nC + nD + nE + nF + nG + nH + nI + nJ + nK + nL + nM;
  for (int item = blockIdx.x; item < total; item += gridDim.x) {
    int it = item;
    if (it < nA) {
      float* sc = fs;
      float* red = fs + 8192;
      __syncthreads();
      for (int i = tid; i < 8192; i += NT) { const float v = p.c[i]; sc[i] = v / (1.0f + __expf(-v)); }
      __syncthreads();
      const int ks = tid >> 5, cj = tid & 31, col = it * 32 + cj;
      float acc[8];
#pragma unroll
      for (int b = 0; b < 8; ++b) acc[b] = 0.f;
#pragma unroll 4
      for (int k = ks * 128; k < ks * 128 + 128; ++k) {
        const float w = p.w_ada[(size_t)k * 6144 + col];
#pragma unroll
        for (int b = 0; b < 8; ++b) acc[b] += sc[b * 1024 + k] * w;
      }
#pragma unroll
      for (int b = 0; b < 8; ++b) red[(ks * 8 + b) * 32 + cj] = acc[b];
      __syncthreads();
      {
        const int b = tid >> 5;
        float s = p.b_ada[col];
#pragma unroll
        for (int k2 = 0; k2 < 8; ++k2) s += red[(k2 * 8 + b) * 32 + cj];
        ((float*)(ws + OFF_MOD))[b * 6144 + col] = s;
      }
      continue;
    }
    it -= nA;
    if (it < nB) {
      const int kt = it / 70, ntile = it % 70;
      const float* w_in = p.w_in; const float* w_merge = p.w_merge;
      tconv_tile(fs, kt * 64, ntile * 64, (bf16_t*)(ws + OFF_WT1), 1024, [=](int k, int n) -> float {
        if (n < 1280) return w_in[(size_t)k * 2328 + n];
        if (n < 2304) return w_in[(size_t)k * 2328 + n + 24];
        if (n < 4352) return w_merge[(size_t)k * 2048 + (n - 2304)];
        if (n < 4376) return w_in[(size_t)k * 2328 + 1280 + (n - 4352)];
        return 0.f; });
      continue;
    }
    it -= nB;
    if (it < nC) {
      const int br = it >> 7, r = it & 127, kt = r >> 4, ntile = r & 15;
      const float* src = p.w_branch + (size_t)br * 512 * 1024;
      tconv_tile(fs, kt * 64, ntile * 64, (bf16_t*)(ws + OFF_WB) + (size_t)br * 1024 * 512, 512, [=](int k, int n) -> float { return src[(size_t)k * 1024 + n]; });
      continue;
    }
    it -= nC;
    if (it < nD) {
      const int kt = it >> 4, ntile = it & 15;
      const float* src = p.w_out;
      tconv_tile(fs, kt * 64, ntile * 64, (bf16_t*)(ws + OFF_WOUT), 1024, [=](int k, int n) -> float { return src[(size_t)k * 1024 + n]; });
      continue;
    }
    it -= nD;
    if (it < nE) {
      const int kt = it >> 5, ntile = it & 31;
      const float* src = p.peer_wq;
      tconv_tile(fs, kt * 64, ntile * 64, (bf16_t*)(ws + OFF_WQ), 1024, [=](int k, int n) -> float { return src[(size_t)k * 2048 + n]; });
      continue;
    }
    it -= nE;
    if (it < nF) {
      const int w = it >> 6, r = it & 63, kt = r >> 1, ntile = r & 1;
      const float* src = p.cmp_w1 + (size_t)w * 2048 * 128;
      tconv_tile(fs, kt * 64, ntile * 64, (bf16_t*)(ws + OFF_CW1) + (size_t)w * 128 * 2048, 2048, [=](int k, int n) -> float { return src[(size_t)k * 128 + n]; });
      continue;
    }
    it -= nF;
    if (it < nG) {
      const int w = it >> 1, kt = it & 1;
      const float* src = p.cmp_w2 + (size_t)w * 128 * 64;
      tconv_tile(fs, kt * 64, 0, (bf16_t*)(ws + OFF_CW2) + (size_t)w * 64 * 128, 128, [=](int k, int n) -> float { return src[(size_t)k * 64 + n]; });
      continue;
    }
    it -= nG;
    if (it < nH) {
      const int w = it >> 2, jc = it & 3, ks = tid >> 5, cj = tid & 31, j = jc * 32 + cj;
      float* red = fs;
      const float* pos = p.cmp_pos + w * 2048; const float* w1 = p.cmp_w1 + (size_t)w * 2048 * 128;
      float acc = 0.f;
#pragma unroll 4
      for (int k = ks * 256; k < ks * 256 + 256; ++k) acc += pos[k] * w1[(size_t)k * 128 + j];
      __syncthreads();
      red[ks * 32 + cj] = acc;
      __syncthreads();
      if (tid < 32) { float s = p.cmp_b1[w * 128 + j]; for (int k2 = 0; k2 < 8; ++k2) s += red[k2 * 32 + tid]; ((float*)(ws + OFF_POSB))[w * 128 + j] = s; }
      continue;
    }
    it -= nH;
    if (it < nI) {
      const int e = it * 256 + tid, pos = e >> 5, i = e & 31;
      const float ang = (float)pos * p.inv_freq[i];
      const double a = (double)ang;
      const double kk = rint(a * 0.15915494309189535);
      const double r = a - kk * 6.283185307179586476925;
      double s, c; sincos_d(r, s, c);
      ((float*)(ws + OFF_ROPE))[e] = (float)c;
      ((float*)(ws + OFF_ROPE))[262144 + e] = (float)s;
      continue;
    }
    it -= nI;
    if (it < nJ) { conv_chunk(p.peer_keys, (bf16_t*)(ws + OFF_PKEYS), (size_t)it * 2048); continue; }
    it -= nJ;
    if (it < nK) {
      const size_t i0 = (size_t)it * 2048 + (size_t)tid * 8;
      const int rowi = (int)((i0 >> 7) & 127), j0 = (int)(i0 & 127);
      float v[8];
#pragma unroll
      for (int j = 0; j < 8; ++j) v[j] = (j0 + j <= rowi) ? p.sgu_w[i0 + j] : 0.f;
      u32x4 w; w.x = pack2(v[0], v[1]); w.y = pack2(v[2], v[3]); w.z = pack2(v[4], v[5]); w.w = pack2(v[6], v[7]);
      *(u32x4*)((bf16_t*)(ws + OFF_SGUW) + i0) = w;
      continue;
    }
    it -= nK;
    if (it < nL) { conv_chunk(p.peer_u, (bf16_t*)(ws + OFF_PU), (size_t)it * 2048); continue; }
    it -= nL;
    conv_chunk(p.peer_v, (bf16_t*)(ws + OFF_PV), (size_t)it * 2048);
  }
}

DI void row_stats(const float (&v)[16], float& mean, float& rstd) {
  float s = 0.f;
#pragma unroll
  for (int i = 0; i < 16; ++i) s += v[i];
  mean = wave_sum(s) * (1.0f / 1024.0f);
  float q = 0.f;
#pragma unroll
  for (int i = 0; i < 16; ++i) { const float d = v[i] - mean; q += d * d; }
  rstd = rsqrtf(wave_sum(q) * (1.0f / 1024.0f) + LN_EPS);
}

__device__ void phase_ln_in(const Params& p) {
  const int lane = threadIdx.x & 63, wave = threadIdx.x >> 6;
  const float* mod = (const float*)(p.ws + OFF_MOD);
  bf16_t* h = (bf16_t*)(p.ws + OFF_H);
  for (int grp = blockIdx.x; grp < NTOK / 4; grp += gridDim.x) {
    const int row = grp * 4 + wave, b = row >> 13;
    const float* xr = p.x + (size_t)row * DM;
    float v[16];
#pragma unroll
    for (int i = 0; i < 4; ++i) { const f32x4 t = *(const f32x4*)(xr + i * 256 + lane * 4); v[4 * i] = t.x; v[4 * i + 1] = t.y; v[4 * i + 2] = t.z; v[4 * i + 3] = t.w; }
    float mean, rstd; row_stats(v, mean, rstd);
#pragma unroll
    for (int i = 0; i < 4; ++i) {
      const int col = i * 256 + lane * 4;
      const f32x4 sh = *(const f32x4*)(mod + b * 6144 + col), sc = *(const f32x4*)(mod + b * 6144 + 1024 + col);
      const float o0 = (v[4 * i] - mean) * rstd * (1.f + sc.x) + sh.x, o1 = (v[4 * i + 1] - mean) * rstd * (1.f + sc.y) + sh.y;
      const float o2 = (v[4 * i + 2] - mean) * rstd * (1.f + sc.z) + sh.z, o3 = (v[4 * i + 3] - mean) * rstd * (1.f + sc.w) + sh.w;
      u32x2 w; w.x = pack2(o0, o1); w.y = pack2(o2, o3);
      *(u32x2*)(h + (size_t)row * DM + col) = w;
    }
  }
}

__device__ void phase_ln_mid(const Params& p, bool y_is_x) {
  const int lane = threadIdx.x & 63, wave = threadIdx.x >> 6;
  const float* mod = (const float*)(p.ws + OFF_MOD);
  const float* y = (const float*)(p.ws + OFF_Y);
  float* x1 = (float*)(p.ws + OFF_X1);
  bf16_t* h2 = (bf16_t*)(p.ws + OFF_H);
  for (int grp = blockIdx.x; grp < NTOK / 4; grp += gridDim.x) {
    const int row = grp * 4 + wave, b = row >> 13;
    const float* yr = (y_is_x ? p.x : y) + (size_t)row * DM;
    float v[16];
#pragma unroll
    for (int i = 0; i < 4; ++i) { const f32x4 t = *(const f32x4*)(yr + i * 256 + lane * 4); v[4 * i] = t.x; v[4 * i + 1] = t.y; v[4 * i + 2] = t.z; v[4 * i + 3] = t.w; }
    if (y_is_x) {
#pragma unroll
      for (int i = 0; i < 16; ++i) v[i] *= DN_ALPHA;
    }
    float mean, rstd; row_stats(v, mean, rstd);
#pragma unroll
    for (int i = 0; i < 4; ++i) {
      const int col = i * 256 + lane * 4;
      const f32x4 g = *(const f32x4*)(p.ln1_g + col), bb = *(const f32x4*)(p.ln1_b + col);
      f32x4 o;
      o.x = (v[4 * i] - mean) * rstd * g.x + bb.x; o.y = (v[4 * i + 1] - mean) * rstd * g.y + bb.y;
      o.z = (v[4 * i + 2] - mean) * rstd * g.z + bb.z; o.w = (v[4 * i + 3] - mean) * rstd * g.w + bb.w;
      *(f32x4*)(x1 + (size_t)row * DM + col) = o;
      v[4 * i] = o.x; v[4 * i + 1] = o.y; v[4 * i + 2] = o.z; v[4 * i + 3] = o.w;
    }
    row_stats(v, mean, rstd);
#pragma unroll
    for (int i = 0; i < 4; ++i) {
      const int col = i * 256 + lane * 4;
      const f32x4 sh = *(const f32x4*)(mod + b * 6144 + 3072 + col), sc = *(const f32x4*)(mod + b * 6144 + 4096 + col);
      const float o0 = (v[4 * i] - mean) * rstd * (1.f + sc.x) + sh.x, o1 = (v[4 * i + 1] - mean) * rstd * (1.f + sc.y) + sh.y;
      const float o2 = (v[4 * i + 2] - mean) * rstd * (1.f + sc.z) + sh.z, o3 = (v[4 * i + 3] - mean) * rstd * (1.f + sc.w) + sh.w;
      u32x2 w; w.x = pack2(o0, o1); w.y = pack2(o2, o3);
      *(u32x2*)(h2 + (size_t)row * DM + col) = w;
    }
  }
}

__device__ void phase_final_noffn(const Params& p) {
  const int lane = threadIdx.x & 63, wave = threadIdx.x >> 6;
  const float* x1 = (const float*)(p.ws + OFF_X1);
  for (int grp = blockIdx.x; grp < NTOK / 4; grp += gridDim.x) {
    const int row = grp * 4 + wave;
    const float* xr = x1 + (size_t)row * DM;
    float v[16];
#pragma unroll
    for (int i = 0; i < 4; ++i) { const f32x4 t = *(const f32x4*)(xr + i * 256 + lane * 4); v[4 * i] = t.x * DN_ALPHA; v[4 * i + 1] = t.y * DN_ALPHA; v[4 * i + 2] = t.z * DN_ALPHA; v[4 * i + 3] = t.w * DN_ALPHA; }
    float mean, rstd; row_stats(v, mean, rstd);
#pragma unroll
    for (int i = 0; i < 4; ++i) {
      const int col = i * 256 + lane * 4;
      const f32x4 g = *(const f32x4*)(p.ln2_g + col), bb = *(const f32x4*)(p.ln2_b + col);
      f32x4 o;
      o.x = (v[4 * i] - mean) * rstd * g.x + bb.x; o.y = (v[4 * i + 1] - mean) * rstd * g.y + bb.y;
      o.z = (v[4 * i + 2] - mean) * rstd * g.z + bb.z; o.w = (v[4 * i + 3] - mean) * rstd * g.w + bb.w;
      *(f32x4*)(p.out + (size_t)row * DM + col) = o;
    }
  }
}

constexpr int LDT = 72;
constexpr int GEMM_SMEM = 2 * 2 * 128 * LDT * 2;

DI void zero_acc(f32x16 (&acc)[2][2]) {
#pragma unroll
  for (int i = 0; i < 2; ++i)
#pragma unroll
    for (int j = 0; j < 2; ++j)
#pragma unroll
      for (int r = 0; r < 16; ++r) acc[i][j][r] = 0.f;
}

DI void gemm_mainloop(f32x16 (&acc)[2][2], const bf16_t* __restrict__ A, int lda, const bf16_t* __restrict__ Bt, int ldb, int K, int row0, int col0, char* smem) {
  bf16_t* As = (bf16_t*)smem;
  bf16_t* Bs = As + 2 * 128 * LDT;
  const int tid = threadIdx.x, lane = tid & 63, wave = tid >> 6, wr = wave >> 1, wc = wave & 1;
  const int lr = tid >> 3, lc = (tid & 7) * 8;
  const bf16_t* ga = A + (size_t)(row0 + lr) * lda + lc;
  const bf16_t* gb = Bt + (size_t)(col0 + lr) * ldb + lc;
  const int lofs = lr * LDT + lc;
  u32x4 ra[4], rb[4];
#pragma unroll
  for (int i = 0; i < 4; ++i) { ra[i] = *(const u32x4*)(ga + (size_t)i * 32 * lda); rb[i] = *(const u32x4*)(gb + (size_t)i * 32 * ldb); }
  __syncthreads();
#pragma unroll
  for (int i = 0; i < 4; ++i) { *(u32x4*)(As + lofs + i * 32 * LDT) = ra[i]; *(u32x4*)(Bs + lofs + i * 32 * LDT) = rb[i]; }
  __syncthreads();
  const int nk = K >> 6;
  const int fa = (wr * 64 + (lane & 31)) * LDT + (lane >> 5) * 8;
  const int fb = (wc * 64 + (lane & 31)) * LDT + (lane >> 5) * 8;
#pragma unroll 1
  for (int kt = 0; kt < nk; ++kt) {
    const int cur = kt & 1;
    if (kt + 1 < nk) {
#pragma unroll
      for (int i = 0; i < 4; ++i) { ra[i] = *(const u32x4*)(ga + (size_t)i * 32 * lda + (kt + 1) * 64); rb[i] = *(const u32x4*)(gb + (size_t)i * 32 * ldb + (kt + 1) * 64); }
    }
    const bf16_t* as = As + cur * 128 * LDT + fa;
    const bf16_t* bs = Bs + cur * 128 * LDT + fb;
#pragma unroll
    for (int ks = 0; ks < 4; ++ks) {
      const bf16x8 a0 = *(const bf16x8*)(as + ks * 16), a1 = *(const bf16x8*)(as + 32 * LDT + ks * 16);
      const bf16x8 b0 = *(const bf16x8*)(bs + ks * 16), b1 = *(const bf16x8*)(bs + 32 * LDT + ks * 16);
      acc[0][0] = MFMA32(a0, b0, acc[0][0]); acc[0][1] = MFMA32(a0, b1, acc[0][1]);
      acc[1][0] = MFMA32(a1, b0, acc[1][0]); acc[1][1] = MFMA32(a1, b1, acc[1][1]);
    }
    if (kt + 1 < nk) {
      bf16_t* ad = As + (cur ^ 1) * 128 * LDT + lofs; bf16_t* bd = Bs + (cur ^ 1) * 128 * LDT + lofs;
#pragma unroll
      for (int i = 0; i < 4; ++i) { *(u32x4*)(ad + i * 32 * LDT) = ra[i]; *(u32x4*)(bd + i * 32 * LDT) = rb[i]; }
    }
    __syncthreads();
  }
}

constexpr int LDE = 68;
DI float* epi_stage(const f32x16 (&acc)[2][2], char* smem, int wave, int lane) {
  float* e = (float*)smem + wave * 64 * LDE;
  const int l31 = lane & 31, hh = lane >> 5;
#pragma unroll
  for (int mi = 0; mi < 2; ++mi)
#pragma unroll
    for (int ni = 0; ni < 2; ++ni)
#pragma unroll
      for (int r = 0; r < 16; ++r) e[(mi * 32 + (r & 3) + 8 * (r >> 2) + 4 * hh) * LDE + ni * 32 + l31] = acc[mi][ni][r];
  return e;
}
DI void ld8(const float* pz, float (&v)[8]) { const f32x4 a = *(const f32x4*)pz, b = *(const f32x4*)(pz + 4); v[0] = a.x; v[1] = a.y; v[2] = a.z; v[3] = a.w; v[4] = b.x; v[5] = b.y; v[6] = b.z; v[7] = b.w; }
DI u32x4 pack8(const float (&v)[8]) { u32x4 w; w.x = pack2(v[0], v[1]); w.y = pack2(v[2], v[3]); w.z = pack2(v[4], v[5]); w.w = pack2(v[6], v[7]); return w; }
DI void unpack8(const u32x4 w, float (&v)[8]) { v[0] = bflo(w.x); v[1] = bfhi(w.x); v[2] = bflo(w.y); v[3] = bfhi(w.y); v[4] = bflo(w.z); v[5] = bfhi(w.z); v[6] = bflo(w.w); v[7] = bfhi(w.w); }

template <int ACT>
DI void epi_plain(const float* e, bf16_t* dst, unsigned ld, unsigned cofs, int rb, int lane, const float* bias) {
  const int c8 = (lane & 7) * 8;
  float bv[8];
  if (ACT == 2) ld8(bias + c8, bv);
#pragma unroll
  for (int ps = 0; ps < 8; ++ps) {
    const int row = ps * 8 + (lane >> 3);
    float v[8]; ld8(e + row * LDE + c8, v);
#pragma unroll
    for (int j = 0; j < 8; ++j) { if (ACT == 1) v[j] = gelu_f(v[j]); if (ACT == 2) v[j] = sigmoid_f(v[j] + bv[j]); }
    *(u32x4*)(dst + (unsigned)(rb + row) * ld + cofs + c8) = pack8(v);
  }
}
DI void epi_rope(const float* e, bf16_t* dst, unsigned ld, unsigned cofs, int rb, int lane, const float* rope, float scale) {
  const int c8 = (lane & 3) * 8;
#pragma unroll
  for (int ps = 0; ps < 4; ++ps) {
    const int row = ps * 16 + (lane >> 2), pos = (rb + row) & (SEQ - 1);
    float t1[8], t2[8], cs[8], sn[8], o1[8], o2[8];
    ld8(e + row * LDE + c8, t1); ld8(e + row * LDE + 32 + c8, t2);
    ld8(rope + pos * 32 + c8, cs); ld8(rope + 262144 + pos * 32 + c8, sn);
#pragma unroll
    for (int j = 0; j < 8; ++j) { o1[j] = (t1[j] * cs[j] - t2[j] * sn[j]) * scale; o2[j] = (t1[j] * sn[j] + t2[j] * cs[j]) * scale; }
    *(u32x4*)(dst + (unsigned)(rb + row) * ld + cofs + c8) = pack8(o1);
    *(u32x4*)(dst + (unsigned)(rb + row) * ld + cofs + 32 + c8) = pack8(o2);
  }
}
DI void epi_vT(const float* e, bf16_t* dst, int g, int rb, int lane) {
  const int b = rb >> 13, pos0 = rb & (SEQ - 1);
  bf16_t* drow = dst + ((size_t)((b * 2 + g) * 64 + lane)) * SEQ + pos0;
#pragma unroll
  for (int ch = 0; ch < 8; ++ch) {
    float v[8];
#pragma unroll
    for (int j = 0; j < 8; ++j) v[j] = e[(ch * 8 + j) * LDE + lane];
    *(u32x4*)(drow + ch * 8) = pack8(v);
  }
}

__device__ void phase_gemm1(const Params& p, char* smem) {
  char* ws = p.ws;
  const bf16_t* A = (const bf16_t*)(ws + OFF_H);
  const bf16_t* Bt = (const bf16_t*)(ws + OFF_WT1);
  const float* rope = (const float*)(ws + OFF_ROPE);
  const int lane = threadIdx.x & 63, wave = threadIdx.x >> 6;
  constexpr int NCT = N1 / 128, NRT = NTOK / 128;
  for (int tile = blockIdx.x; tile < NCT * NRT; tile += gridDim.x) {
    const int rt = tile / NCT, ct = tile % NCT;
    f32x16 acc[2][2]; zero_acc(acc);
    gemm_mainloop(acc, A, 1024, Bt, 1024, 1024, rt * 128, ct * 128, smem);
    const int rb = rt * 128 + (wave >> 1) * 64, cb = ct * 128 + (wave & 1) * 64;
    const float* e = epi_stage(acc, smem, wave, lane);
    if (cb < 512) epi_rope(e, (bf16_t*)(ws + OFF_Q), 512, cb, rb, lane, rope, 0.125f);
    else if (cb < 640) epi_rope(e, (bf16_t*)(ws + OFF_KC), 128, cb - 512, rb, lane, rope, 1.0f);
    else if (cb < 768) epi_plain<0>(e, (bf16_t*)(ws + OFF_VC), 128, cb - 640, rb, lane, nullptr);
    else if (cb < 896) epi_rope(e, (bf16_t*)(ws + OFF_KS), 128, cb - 768, rb, lane, rope, 1.0f);
    else if (cb < 1024) epi_vT(e, (bf16_t*)(ws + OFF_VST), (cb - 896) >> 6, rb, lane);
    else if (cb < 1152) epi_rope(e, (bf16_t*)(ws + OFF_KW), 128, cb - 1024, rb, lane, rope, 1.0f);
    else if (cb < 1280) epi_vT(e, (bf16_t*)(ws + OFF_VWT), (cb - 1152) >> 6, rb, lane);
    else if (cb < 1792) epi_plain<1>(e, (bf16_t*)(ws + OFF_U), 512, cb - 1280, rb, lane, nullptr);
    else if (cb < 2304) epi_plain<1>(e, (bf16_t*)(ws + OFF_V), 512, cb - 1792, rb, lane, nullptr);
    else if (cb < 4352) epi_plain<2>(e, (bf16_t*)(ws + OFF_GATE), 2048, cb - 2304, rb, lane, p.b_merge + (cb - 2304));
    else if (cb < 4416) {
      float* gs = (float*)(ws + OFF_GSIG);
      const int c8 = (lane & 7) * 8;
      if (c8 < 24) {
#pragma unroll
        for (int ps = 0; ps < 8; ++ps) {
          const int row = ps * 8 + (lane >> 3);
          float v[8]; ld8(e + row * LDE + c8, v);
          f32x4 o0, o1; o0.x = sigmoid_f(v[0]); o0.y = sigmoid_f(v[1]); o0.z = sigmoid_f(v[2]); o0.w = sigmoid_f(v[3]);
          o1.x = sigmoid_f(v[4]); o1.y = sigmoid_f(v[5]); o1.z = sigmoid_f(v[6]); o1.w = sigmoid_f(v[7]);
          *(f32x4*)(gs + (unsigned)(rb + row) * 32 + c8) = o0; *(f32x4*)(gs + (unsigned)(rb + row) * 32 + c8 + 4) = o1;
        }
      }
    }
  }
}

__device__ void phase_sgu(const Params& p, char* smem) {
  char* ws = p.ws;
  const int tid = threadIdx.x, lane = tid & 63, wave = tid >> 6;
  bf16_t* u = (bf16_t*)(ws + OFF_U);
  const bf16_t* v = (const bf16_t*)(ws + OFF_V);
  const bf16_t* W = (const bf16_t*)(ws + OFF_SGUW);
  float* st = (float*)smem;
  bf16_t* vt = (bf16_t*)(smem + 1024);
  constexpr int LV = 136;
  for (int item = blockIdx.x; item < NTOK / 128; item += gridDim.x) {
    const int t0 = item * 128;
    __syncthreads();
    for (int i = 0; i < 32; ++i) {
      const int t = wave * 32 + i;
      const u32x4 raw = *(const u32x4*)(v + (size_t)(t0 + t) * 512 + lane * 8);
      float f[8] = {bflo(raw.x), bfhi(raw.x), bflo(raw.y), bfhi(raw.y), bflo(raw.z), bfhi(raw.z), bflo(raw.w), bfhi(raw.w)};
      float s = 0.f;
#pragma unroll
      for (int j = 0; j < 8; ++j) s += f[j];
      const float mean = wave_sum(s) * (1.f / 512.f);
      float q = 0.f;
#pragma unroll
      for (int j = 0; j < 8; ++j) { const float d = f[j] - mean; q += d * d; }
      const float rstd = rsqrtf(wave_sum(q) * (1.f / 512.f) + LN_EPS);
      if (lane == 0) { st[t * 2] = mean; st[t * 2 + 1] = rstd; }
    }
    for (int g = 0; g < 8; ++g) {
      __syncthreads();
      for (int i = 0; i < 4; ++i) {
        const int idx = tid + i * 256, j = idx >> 3, dc = (idx & 7) * 8;
        const u32x4 raw = *(const u32x4*)(v + (size_t)(t0 + j) * 512 + g * 64 + dc);
        const float mean = st[j * 2], rstd = st[j * 2 + 1];
        const float f[8] = {bflo(raw.x), bfhi(raw.x), bflo(raw.y), bfhi(raw.y), bflo(raw.z), bfhi(raw.z), bflo(raw.w), bfhi(raw.w)};
#pragma unroll
        for (int k = 0; k < 8; ++k) {
          const int col = g * 64 + dc + k;
          vt[(dc + k) * LV + j] = f2bf((f[k] - mean) * rstd * p.sgu_ln_g[col] + p.sgu_ln_b[col]);
        }
      }
      __syncthreads();
      f32x16 acc[2];
#pragma unroll
      for (int r = 0; r < 16; ++r) { acc[0][r] = 0.f; acc[1][r] = 0.f; }
      const bf16_t* wrow = W + ((size_t)g * 128 + wave * 32 + (lane & 31)) * 128 + (lane >> 5) * 8;
#pragma unroll
      for (int ks = 0; ks < 8; ++ks) {
        const bf16x8 a = *(const bf16x8*)(wrow + ks * 16);
        const bf16x8 b0 = *(const bf16x8*)(vt + (lane & 31) * LV + ks * 16 + (lane >> 5) * 8);
        const bf16x8 b1 = *(const bf16x8*)(vt + (32 + (lane & 31)) * LV + ks * 16 + (lane >> 5) * 8);
        acc[0] = MFMA32(a, b0, acc[0]); acc[1] = MFMA32(a, b1, acc[1]);
      }
      const int d = lane & 31, hh = lane >> 5;
#pragma unroll
      for (int ni = 0; ni < 2; ++ni)
#pragma unroll
        for (int r = 0; r < 16; ++r) {
          const int i = wave * 32 + (r & 3) + 8 * (r >> 2) + 4 * hh;
          const float m = acc[ni][r] + p.sgu_b[g * 128 + i];
          bf16_t* up = u + (size_t)(t0 + i) * 512 + g * 64 + ni * 32 + d;
          *up = f2bf(bf2f(*up) * m);
        }
    }
  }
}

__device__ void phase_merge(const Params& p, char* smem, bool use_nsa) {
  char* ws = p.ws;
  const bf16_t* onsa = (const bf16_t*)(ws + OFF_ONSA);
  const bf16_t* osgu = (const bf16_t*)(ws + OFF_U);
  const bf16_t* Wb = (const bf16_t*)(ws + OFF_WB);
  const bf16_t* gate = (const bf16_t*)(ws + OFF_GATE);
  bf16_t* merged = (bf16_t*)(ws + OFF_H);
  const int lane = threadIdx.x & 63, wave = threadIdx.x >> 6;
  for (int tile = blockIdx.x; tile < 8 * (NTOK / 128); tile += gridDim.x) {
    const int rt = tile >> 3, ct = tile & 7;
    const int rb = rt * 128 + (wave >> 1) * 64, cb = ct * 128 + (wave & 1) * 64, c8 = (lane & 7) * 8;
#pragma unroll 1
    for (int br = 0; br < 2; ++br) {
      f32x16 acc[2][2]; zero_acc(acc);
      if (br == 1 || use_nsa) gemm_mainloop(acc, br == 0 ? onsa : osgu, 512, Wb + (size_t)br * 1024 * 512, 512, 512, rt * 128, ct * 128, smem);
      const float* e = epi_stage(acc, smem, wave, lane);
#pragma unroll
      for (int ps = 0; ps < 8; ++ps) {
        const int row = ps * 8 + (lane >> 3);
        float v[8], gg[8]; ld8(e + row * LDE + c8, v);
        unpack8(*(const u32x4*)(gate + (unsigned)(rb + row) * 2048u + (unsigned)(br * 1024 + cb + c8)), gg);
        bf16_t* mp = merged + (unsigned)(rb + row) * 1024u + (unsigned)(cb + c8);
#pragma unroll
        for (int j = 0; j < 8; ++j) v[j] *= gg[j];
        if (br == 1) {
          float old[8]; unpack8(*(const u32x4*)mp, old);
#pragma unroll
          for (int j = 0; j < 8; ++j) v[j] += old[j];
        }
        *(u32x4*)mp = pack8(v);
      }
    }
  }
}

__device__ void phase_outproj(const Params& p, char* smem) {
  char* ws = p.ws;
  const bf16_t* merged = (const bf16_t*)(ws + OFF_H);
  const bf16_t* Wo = (const bf16_t*)(ws + OFF_WOUT);
  const float* mod = (const float*)(ws + OFF_MOD);
  float* y = (float*)(ws + OFF_Y);
  const int lane = threadIdx.x & 63, wave = threadIdx.x >> 6;
  for (int tile = blockIdx.x; tile < 8 * (NTOK / 128); tile += gridDim.x) {
    const int rt = tile >> 3, ct = tile & 7;
    f32x16 acc[2][2]; zero_acc(acc);
    gemm_mainloop(acc, merged, 1024, Wo, 1024, 1024, rt * 128, ct * 128, smem);
    const int rb = rt * 128 + (wave >> 1) * 64, cb = ct * 128 + (wave & 1) * 64, b = rb >> 13, c8 = (lane & 7) * 8;
    const float* e = epi_stage(acc, smem, wave, lane);
    float gt[8]; ld8(mod + b * 6144 + 2048 + cb + c8, gt);
#pragma unroll
    for (int ps = 0; ps < 8; ++ps) {
      const int row = ps * 8 + (lane >> 3);
      float v[8], xv[8]; ld8(e + row * LDE + c8, v);
      const unsigned o = (unsigned)(rb + row) * 1024u + (unsigned)(cb + c8);
      ld8(p.x + o, xv);
      f32x4 o0, o1;
      o0.x = DN_ALPHA * xv[0] + gt[0] * v[0]; o0.y = DN_ALPHA * xv[1] + gt[1] * v[1]; o0.z = DN_ALPHA * xv[2] + gt[2] * v[2]; o0.w = DN_ALPHA * xv[3] + gt[3] * v[3];
      o1.x = DN_ALPHA * xv[4] + gt[4] * v[4]; o1.y = DN_ALPHA * xv[5] + gt[5] * v[5]; o1.z = DN_ALPHA * xv[6] + gt[6] * v[6]; o1.w = DN_ALPHA * xv[7] + gt[7] * v[7];
      *(f32x4*)(y + o) = o0; *(f32x4*)(y + o + 4) = o1;
    }
  }
}

__device__ void phase_compress(const Params& p, char* smem) {
  char* ws = p.ws;
  const int tid = threadIdx.x, lane = tid & 63, wave = tid >> 6, l31 = lane & 31, hh = lane >> 5;
  bf16_t* hid = (bf16_t*)smem;
  constexpr int LH = 136;
  for (int item = blockIdx.x; item < 256; item += gridDim.x) {
    const int w = item >> 7, R0 = (item & 127) * 64;
    const bf16_t* src = (const bf16_t*)(ws + (w == 0 ? OFF_KC : OFF_VC));
    const bf16_t* W1 = (const bf16_t*)(ws + OFF_CW1) + (size_t)w * 128 * 2048;
    const bf16_t* W2 = (const bf16_t*)(ws + OFF_CW2) + (size_t)w * 64 * 128;
    const float* posb = (const float*)(ws + OFF_POSB) + w * 128;
    const bf16_t* abase[2];
#pragma unroll
    for (int mi = 0; mi < 2; ++mi) {
      const int R = R0 + mi * 32 + l31, bg = R >> 9, n = R & 511, nn = n < 510 ? n : 510;
      abase[mi] = src + ((size_t)((bg >> 1) * SEQ + 16 * nn)) * 128 + (bg & 1) * 64 + hh * 8;
    }
    const bf16_t* bbase = W1 + (size_t)(wave * 32 + l31) * 2048 + hh * 8;
    f32x16 acc[2];
#pragma unroll
    for (int r = 0; r < 16; ++r) { acc[0][r] = 0.f; acc[1][r] = 0.f; }
#pragma unroll 8
    for (int ks = 0; ks < 128; ++ks) {
      const int aofs = (ks >> 2) * 128 + (ks & 3) * 16;
      const bf16x8 a0 = *(const bf16x8*)(abase[0] + aofs), a1 = *(const bf16x8*)(abase[1] + aofs);
      const bf16x8 bb = *(const bf16x8*)(bbase + ks * 16);
      acc[0] = MFMA32(a0, bb, acc[0]); acc[1] = MFMA32(a1, bb, acc[1]);
    }
    __syncthreads();
    {
      const float pb = posb[wave * 32 + l31];
#pragma unroll
      for (int mi = 0; mi < 2; ++mi)
#pragma unroll
        for (int r = 0; r < 16; ++r) {
          const int row = mi * 32 + (r & 3) + 8 * (r >> 2) + 4 * hh;
          hid[row * LH + wave * 32 + l31] = f2bf(gelu_f(acc[mi][r] + pb));
        }
    }
    __syncthreads();
    const int mi = wave >> 1, ni = wave & 1;
    f32x16 o;
#pragma unroll
    for (int r = 0; r < 16; ++r) o[r] = 0.f;
#pragma unroll
    for (int ks = 0; ks < 8; ++ks) {
      const bf16x8 a = *(const bf16x8*)(hid + (mi * 32 + l31) * LH + ks * 16 + hh * 8);
      const bf16x8 bb = *(const bf16x8*)(W2 + (size_t)(ni * 32 + l31) * 128 + ks * 16 + hh * 8);
      o = MFMA32(a, bb, o);
    }
    const int d = ni * 32 + l31;
    const float b2 = p.cmp_b2[w * 64 + d];
    const int bg = R0 >> 9;
    if (w == 0) {
      bf16_t* kc = (bf16_t*)(ws + OFF_KCMP);
#pragma unroll
      for (int r = 0; r < 16; ++r) {
        const int n = (R0 & 511) + mi * 32 + (r & 3) + 8 * (r >> 2) + 4 * hh;
        kc[((size_t)bg * 512 + n) * 64 + d] = f2bf(n < 511 ? o[r] + b2 : 0.f);
      }
    } else {
      bf16_t* vc = (bf16_t*)(ws + OFF_VCMPT);
#pragma unroll
      for (int q = 0; q < 4; ++q) {
        const int n = (R0 & 511) + mi * 32 + 8 * q + 4 * hh;
        float v0 = o[4 * q] + b2, v1 = o[4 * q + 1] + b2, v2 = o[4 * q + 2] + b2, v3 = o[4 * q + 3] + b2;
        if (n + 3 >= 511) v3 = 0.f;
        u32x2 wv; wv.x = pack2(v0, v1); wv.y = pack2(v2, v3);
        *(u32x2*)(vc + ((size_t)bg * 64 + d) * 512 + n) = wv;
      }
    }
  }
}

constexpr int LK = 72;
constexpr int LVT = 68;
constexpr int NSA_KS = 0, NSA_VS = 9216, NSA_AIMP = 17920, NSA_CIMP = NSA_AIMP + 16384, NSA_SELM = NSA_CIMP + 16384;
struct TileRegs { u32x4 k[2]; u32x4 v[2]; };

DI void nsa_load_tile(TileRegs& t, const bf16_t* kbase, size_t kstride, const bf16_t* vtbase, size_t vstride) {
  const int tid = threadIdx.x;
#pragma unroll
  for (int i = 0; i < 2; ++i) {
    const int idx = tid + i * 256, r = idx >> 3, ch = idx & 7;
    t.k[i] = *(const u32x4*)(kbase + (size_t)r * kstride + ch * 8);
    t.v[i] = *(const u32x4*)(vtbase + (size_t)r * vstride + ch * 8);
  }
}
DI void nsa_store_tile(const TileRegs& t, char* smem) {
  const int tid = threadIdx.x;
  bf16_t* Ks = (bf16_t*)(smem + NSA_KS); bf16_t* Vs = (bf16_t*)(smem + NSA_VS);
#pragma unroll
  for (int i = 0; i < 2; ++i) {
    const int idx = tid + i * 256, r = idx >> 3, ch = idx & 7;
    *(u32x4*)(Ks + r * LK + ch * 8) = t.k[i];
    u32x2 lo, hi; lo.x = t.v[i].x; lo.y = t.v[i].y; hi.x = t.v[i].z; hi.y = t.v[i].w;
    *(u32x2*)(Vs + r * LVT + ch * 8) = lo; *(u32x2*)(Vs + r * LVT + ch * 8 + 4) = hi;
  }
}
DI void nsa_scores(f32x16 (&st)[2], const char* smem, const bf16x8 (&qf)[4], int lane) {
  const bf16_t* Ks = (const bf16_t*)(smem + NSA_KS);
#pragma unroll
  for (int kt = 0; kt < 2; ++kt) {
#pragma unroll
    for (int r = 0; r < 16; ++r) st[kt][r] = 0.f;
#pragma unroll
    for (int ks = 0; ks < 4; ++ks) {
      const bf16x8 a = *(const bf16x8*)(Ks + (kt * 32 + (lane & 31)) * LK + ks * 16 + (lane >> 5) * 8);
      st[kt] = MFMA32(a, qf[ks], st[kt]);
    }
  }
}
DI void nsa_pv(f32x16 (&o)[2], const f32x16 (&pt)[2], const char* smem, int lane) {
  const bf16_t* Vs = (const bf16_t*)(smem + NSA_VS);
#pragma unroll
  for (int kt = 0; kt < 2; ++kt)
#pragma unroll
    for (int s = 0; s < 2; ++s) {
      u32x4 pk; pk.x = pack2(pt[kt][8 * s], pt[kt][8 * s + 1]); pk.y = pack2(pt[kt][8 * s + 2], pt[kt][8 * s + 3]);
      pk.z = pack2(pt[kt][8 * s + 4], pt[kt][8 * s + 5]); pk.w = pack2(pt[kt][8 * s + 6], pt[kt][8 * s + 7]);
      const bf16x8 pb = __builtin_bit_cast(bf16x8, pk);
#pragma unroll
      for (int dt = 0; dt < 2; ++dt) {
        const bf16_t* vp = Vs + (dt * 32 + (lane & 31)) * LVT + kt * 32 + 16 * s + 4 * (lane >> 5);
        const s16x4 lo = *(const s16x4*)vp, hi = *(const s16x4*)(vp + 8);
        const bf16x8 a = __builtin_shufflevector(lo, hi, 0, 1, 2, 3, 4, 5, 6, 7);
        o[dt] = MFMA32(a, pb, o[dt]);
      }
    }
}

struct NsaLane {
  bf16x8 qf[4];
  int t;
  int hh;
  unsigned selw[4];
};

DI void nsa_online(f32x16 (&st)[2], unsigned vm0, unsigned vm1, float& m, float& l, f32x16 (&o)[2], const char* smem, int lane) {
  float mx = -1e30f;
#pragma unroll
  for (int r = 0; r < 16; ++r) { if ((vm0 >> r) & 1u) mx = fmaxf(mx, st[0][r]); if ((vm1 >> r) & 1u) mx = fmaxf(mx, st[1][r]); }
  mx = fmaxf(mx, __shfl_xor(mx, 32));
  const float mn = fmaxf(m, mx);
  const float alpha = __expf(m - mn);
  m = mn;
  float sum = 0.f;
#pragma unroll
  for (int r = 0; r < 16; ++r) {
    const float p0 = ((vm0 >> r) & 1u) ? __expf(st[0][r] - mn) : 0.f;
    const float p1 = ((vm1 >> r) & 1u) ? __expf(st[1][r] - mn) : 0.f;
    st[0][r] = p0; st[1][r] = p1; sum += p0 + p1;
  }
  l = l * alpha + sum;
#pragma unroll
  for (int r = 0; r < 16; ++r) { o[0][r] *= alpha; o[1][r] *= alpha; }
  nsa_pv(o, st, smem, lane);
}

struct NsaItem { int qb, b, g, bg, t; size_t tokrow; };
DI NsaItem nsa_item(int item, int wave, int qi) {
  NsaItem it; it.qb = 127 - (item >> 5); const int rest = item & 31; it.b = rest >> 2; it.g = (rest >> 1) & 1; const int half = rest & 1;
  it.bg = it.b * 2 + it.g; it.t = it.qb * 64 + half * 32 + wave * 8 + qi; it.tokrow = (size_t)it.b * SEQ + it.t; return it;
}
DI void nsa_accum_store(bf16_t* dst, const f32x16 (&o)[2], float sc, bool first, int hh) {
#pragma unroll
  for (int dt = 0; dt < 2; ++dt)
#pragma unroll
    for (int q4 = 0; q4 < 4; ++q4) {
      u32x2* pp = (u32x2*)(dst + dt * 32 + 8 * q4 + 4 * hh);
      float a0 = sc * o[dt][4 * q4], a1 = sc * o[dt][4 * q4 + 1], a2 = sc * o[dt][4 * q4 + 2], a3 = sc * o[dt][4 * q4 + 3];
      if (!first) { const u32x2 old = *pp; a0 += bflo(old.x); a1 += bfhi(old.x); a2 += bflo(old.y); a3 += bfhi(old.y); }
      u32x2 wv; wv.x = pack2(a0, a1); wv.y = pack2(a2, a3);
      *pp = wv;
    }
}

__device__ void phase_nsa(const Params& p, char* smem, int branch_mask) {
  char* ws = p.ws;
  const int tid = threadIdx.x, lane = tid & 63, wave = tid >> 6, hh = lane >> 5, c = lane & 31, qi = c >> 2, r4 = c & 3;
  const bf16_t* Q = (const bf16_t*)(ws + OFF_Q);
  const float* gsig = (const float*)(ws + OFF_GSIG);
  bf16_t* ONSA = (bf16_t*)(ws + OFF_ONSA);
  u32x4* SELG = (u32x4*)(ws + OFF_SELG);

  {
    const bf16_t* KCMP = (const bf16_t*)(ws + OFF_KCMP); const bf16_t* VCMPT = (const bf16_t*)(ws + OFF_VCMPT);
    float* Aimp = (float*)(smem + NSA_AIMP) + wave * 1024;
    float* Cimp = (float*)(smem + NSA_CIMP) + wave * 1024;
    unsigned short* selm16 = (unsigned short*)(smem + NSA_SELM) + wave * 64;
    const u32x4* selm128 = (const u32x4*)(smem + NSA_SELM) + wave * 8;
    for (int item = blockIdx.x; item < 4096; item += gridDim.x) {
      const NsaItem it = nsa_item(item, wave, qi);
      const int t = it.t;
      const int tmaxb = it.qb * 64 + ((item & 1) * 32) + 31;
      bf16x8 qf[4];
#pragma unroll
      for (int ks = 0; ks < 4; ++ks) qf[ks] = *(const bf16x8*)(Q + it.tokrow * 512 + (it.g * 4 + r4) * 64 + ks * 16 + hh * 8);
      const float g_c = gsig[it.tokrow * 32 + (it.g * 4 + r4) * 3 + 0];
      TileRegs tr;
      const int nmax = (tmaxb - 31) >> 4;
      const int ntile = (tmaxb >= 31) ? (nmax >> 6) + 1 : 0;
      const bf16_t* kb = KCMP + (size_t)it.bg * 512 * 64;
      const bf16_t* vb = VCMPT + (size_t)it.bg * 64 * 512;
      float m = -1e30f, l = 0.f;
      __syncthreads();
      for (int i = lane; i < 1024; i += 64) { Aimp[i] = 0.f; Cimp[i] = 0.f; }
      if (ntile > 0) nsa_load_tile(tr, kb, 64, vb, 512);
      for (int j = 0; j < ntile; ++j) {
        __syncthreads();
        nsa_store_tile(tr, smem);
        __syncthreads();
        if (j + 1 < ntile) nsa_load_tile(tr, kb + (size_t)(j + 1) * 64 * 64, 64, vb + (j + 1) * 64, 512);
        f32x16 st[2];
        nsa_scores(st, smem, qf, lane);
        float mx = -1e30f;
#pragma unroll
        for (int kt = 0; kt < 2; ++kt)
#pragma unroll
          for (int r = 0; r < 16; ++r) {
            const int n = j * 64 + kt * 32 + (r & 3) + 8 * (r >> 2) + 4 * hh;
            if (16 * n + 31 <= t) mx = fmaxf(mx, st[kt][r]);
          }
        mx = fmaxf(mx, __shfl_xor(mx, 32));
        const float mn = fmaxf(m, mx);
        float sum = 0.f;
#pragma unroll
        for (int kt = 0; kt < 2; ++kt)
#pragma unroll
          for (int r = 0; r < 16; ++r) {
            const int n = j * 64 + kt * 32 + (r & 3) + 8 * (r >> 2) + 4 * hh;
            if (16 * n + 31 <= t) sum += __expf(st[kt][r] - mn);
          }
        l = l * __expf(m - mn) + sum;
        m = mn;
      }
      l += __shfl_xor(l, 32);
      const float inv_l = l > 0.f ? 1.0f / l : 0.f;
      f32x16 o[2];
#pragma unroll
      for (int r = 0; r < 16; ++r) { o[0][r] = 0.f; o[1][r] = 0.f; }
      if (ntile > 0) nsa_load_tile(tr, kb, 64, vb, 512);
      for (int j = 0; j < ntile; ++j) {
        __syncthreads();
        nsa_store_tile(tr, smem);
        __syncthreads();
        if (j + 1 < ntile) nsa_load_tile(tr, kb + (size_t)(j + 1) * 64 * 64, 64, vb + (j + 1) * 64, 512);
        f32x16 st[2];
        nsa_scores(st, smem, qf, lane);
#pragma unroll
        for (int kt = 0; kt < 2; ++kt)
#pragma unroll
          for (int r = 0; r < 16; ++r) {
            const int n = j * 64 + kt * 32 + (r & 3) + 8 * (r >> 2) + 4 * hh;
            st[kt][r] = (16 * n + 31 <= t) ? __expf(st[kt][r] - m) * inv_l : 0.f;
          }
#pragma unroll
        for (int kt = 0; kt < 2; ++kt)
#pragma unroll
          for (int c4 = 0; c4 < 4; ++c4) {
            float carry = 0.5f * st[kt][4 * c4 + 3];
            float full = st[kt][4 * c4] + st[kt][4 * c4 + 1] + st[kt][4 * c4 + 2] + carry;
            full += __shfl_xor(full, 1); full += __shfl_xor(full, 2);
            carry += __shfl_xor(carry, 1); carry += __shfl_xor(carry, 2);
            const int jb = j * 16 + kt * 8 + 2 * c4 + hh;
            if (r4 == 0) { Aimp[qi * 128 + jb] = full; Cimp[qi * 128 + jb] = carry; }
          }
        if (branch_mask & 1) nsa_pv(o, st, smem, lane);
      }
      nsa_accum_store(ONSA + it.tokrow * 512 + (it.g * 4 + r4) * 64, o, (branch_mask & 1) ? g_c : 0.f, true, hh);
      __syncthreads();
      const int cur = it.qb;
      if (cur <= 15) {
        if (lane < 8) { selm16[lane * 8 + 0] = (unsigned short)((2u << cur) - 1u);
#pragma unroll
          for (int k = 1; k < 8; ++k) selm16[lane * 8 + k] = 0; }
      } else {
        const int qs = lane >> 3, sub = lane & 7;
        float v[16];
#pragma unroll
        for (int i = 0; i < 16; ++i) {
          const int jj = sub * 16 + i;
          const bool ok = (jj >= 1) && (jj <= cur - 2);
          const int jm = jj >= 1 ? jj - 1 : 0;
          v[i] = ok ? (Aimp[qs * 128 + jj] + Cimp[qs * 128 + jm]) : -3e38f;
        }
        unsigned bits = 0;
        for (int itn = 0; itn < 13; ++itn) {
          float bv = v[0]; int bi = 0;
#pragma unroll
          for (int i = 1; i < 16; ++i) if (v[i] > bv) { bv = v[i]; bi = i; }
          int bj = sub * 16 + bi;
#pragma unroll
          for (int o2 = 1; o2 < 8; o2 <<= 1) {
            const float ov = __shfl_xor(bv, o2); const int oj = __shfl_xor(bj, o2);
            if (ov > bv || (ov == bv && oj < bj)) { bv = ov; bj = oj; }
          }
          if ((bj >> 4) == sub) {
            const int i2 = bj & 15;
#pragma unroll
            for (int i = 0; i < 16; ++i) if (i == i2) v[i] = -3e38f;
            bits |= 1u << i2;
          }
        }
        if (sub == 0) bits |= 1u;
        if ((cur >> 4) == sub) bits |= 1u << (cur & 15);
        if (((cur - 1) >> 4) == sub) bits |= 1u << ((cur - 1) & 15);
        selm16[qs * 8 + sub] = (unsigned short)bits;
      }
      __syncthreads();
      if (r4 == 0 && hh == 0) SELG[(size_t)it.bg * SEQ + t] = selm128[qi];
    }
  }
  __threadfence_block();
  __syncthreads();

  if (branch_mask & 2) {
    const bf16_t* KS = (const bf16_t*)(ws + OFF_KS); const bf16_t* VST = (const bf16_t*)(ws + OFF_VST);
    for (int item = blockIdx.x; item < 4096; item += gridDim.x) {
      const NsaItem it = nsa_item(item, wave, qi);
      const int t = it.t, qb = it.qb;
      bf16x8 qf[4];
#pragma unroll
      for (int ks = 0; ks < 4; ++ks) qf[ks] = *(const bf16x8*)(Q + it.tokrow * 512 + (it.g * 4 + r4) * 64 + ks * 16 + hh * 8);
      const float g_s = gsig[it.tokrow * 32 + (it.g * 4 + r4) * 3 + 1];
      const u32x4 selw = SELG[(size_t)it.bg * SEQ + t];
      TileRegs tr;
      const bf16_t* kb = KS + (size_t)it.b * SEQ * 128 + it.g * 64;
      const bf16_t* vb = VST + (size_t)it.bg * 64 * SEQ;
      float m = -1e30f, l = 0.f;
      f32x16 o[2];
#pragma unroll
      for (int r = 0; r < 16; ++r) { o[0][r] = 0.f; o[1][r] = 0.f; }
      nsa_load_tile(tr, kb, 128, vb, SEQ);
      for (int j = 0; j <= qb; ++j) {
        __syncthreads();
        nsa_store_tile(tr, smem);
        __syncthreads();
        if (j + 1 <= qb) nsa_load_tile(tr, kb + (size_t)(j + 1) * 64 * 128, 128, vb + (j + 1) * 64, SEQ);
        const unsigned w = j < 32 ? selw.x : (j < 64 ? selw.y : (j < 96 ? selw.z : selw.w));
        const bool sel = (w >> (j & 31)) & 1u;
        if (__any(sel)) {
          f32x16 st[2];
          nsa_scores(st, smem, qf, lane);
          unsigned vm0 = 0, vm1 = 0;
#pragma unroll
          for (int r = 0; r < 16; ++r) {
            const int k0 = j * 64 + (r & 3) + 8 * (r >> 2) + 4 * hh;
            if (sel && k0 <= t) vm0 |= 1u << r;
            if (sel && k0 + 32 <= t) vm1 |= 1u << r;
          }
          nsa_online(st, vm0, vm1, m, l, o, smem, lane);
        }
      }
      l += __shfl_xor(l, 32);
      nsa_accum_store(ONSA + it.tokrow * 512 + (it.g * 4 + r4) * 64, o, l > 0.f ? g_s / l : 0.f, false, hh);
    }
  }

  if (branch_mask & 4) {
    const bf16_t* KW = (const bf16_t*)(ws + OFF_KW); const bf16_t* VWT = (const bf16_t*)(ws + OFF_VWT);
    for (int item = blockIdx.x; item < 4096; item += gridDim.x) {
      const NsaItem it = nsa_item(item, wave, qi);
      const int t = it.t, qb = it.qb;
      bf16x8 qf[4];
#pragma unroll
      for (int ks = 0; ks < 4; ++ks) qf[ks] = *(const bf16x8*)(Q + it.tokrow * 512 + (it.g * 4 + r4) * 64 + ks * 16 + hh * 8);
      const float g_w = gsig[it.tokrow * 32 + (it.g * 4 + r4) * 3 + 2];
      TileRegs tr;
      const bf16_t* kb = KW + (size_t)it.b * SEQ * 128 + it.g * 64;
      const bf16_t* vb = VWT + (size_t)it.bg * 64 * SEQ;
      float m = -1e30f, l = 0.f;
      f32x16 o[2];
#pragma unroll
      for (int r = 0; r < 16; ++r) { o[0][r] = 0.f; o[1][r] = 0.f; }
      const int j0 = qb >= 8 ? qb - 8 : 0;
      nsa_load_tile(tr, kb + (size_t)j0 * 64 * 128, 128, vb + j0 * 64, SEQ);
      for (int j = j0; j <= qb; ++j) {
        __syncthreads();
        nsa_store_tile(tr, smem);
        __syncthreads();
        if (j + 1 <= qb) nsa_load_tile(tr, kb + (size_t)(j + 1) * 64 * 128, 128, vb + (j + 1) * 64, SEQ);
        f32x16 st[2];
        nsa_scores(st, smem, qf, lane);
        unsigned vm0 = 0, vm1 = 0;
#pragma unroll
        for (int r = 0; r < 16; ++r) {
          const int k0 = j * 64 + (r & 3) + 8 * (r >> 2) + 4 * hh;
          if (k0 <= t && t - k0 < 512) vm0 |= 1u << r;
          if (k0 + 32 <= t && t - (k0 + 32) < 512) vm1 |= 1u << r;
        }
        nsa_online(st, vm0, vm1, m, l, o, smem, lane);
      }
      l += __shfl_xor(l, 32);
      nsa_accum_store(ONSA + it.tokrow * 512 + (it.g * 4 + r4) * 64, o, l > 0.f ? g_w / l : 0.f, false, hh);
    }
  }
}

__device__ void phase_peerq(const Params& p, char* smem) {
  char* ws = p.ws;
  const bf16_t* h2 = (const bf16_t*)(ws + OFF_H);
  const bf16_t* Wq = (const bf16_t*)(ws + OFF_WQ);
  bf16_t* pq = (bf16_t*)(ws + OFF_PQ);
  const int lane = threadIdx.x & 63, wave = threadIdx.x >> 6;
  for (int tile = blockIdx.x; tile < 16 * (NTOK / 128); tile += gridDim.x) {
    const int rt = tile >> 4, ct = tile & 15;
    f32x16 acc[2][2]; zero_acc(acc);
    gemm_mainloop(acc, h2, 1024, Wq, 1024, 1024, rt * 128, ct * 128, smem);
    const float* e = epi_stage(acc, smem, wave, lane);
    epi_plain<0>(e, pq, 2048, ct * 128 + (wave & 1) * 64, rt * 128 + (wave >> 1) * 64, lane, nullptr);
  }
}

DI void argmax16(float& bv, int& bk) {
#pragma unroll
  for (int o = 1; o < 16; o <<= 1) {
    const float ov = __shfl_xor(bv, o); const int ok = __shfl_xor(bk, o);
    if (ov > bv || (ov == bv && ok < bk)) { bv = ov; bk = ok; }
  }
}
__device__ void phase_route(const Params& p, char* smem) {
  char* ws = p.ws;
  const int tid = threadIdx.x, lane = tid & 63, wave = tid >> 6, l31 = lane & 31, hh = lane >> 5;
  const bf16_t* pq = (const bf16_t*)(ws + OFF_PQ);
  const bf16_t* pk = (const bf16_t*)(ws + OFF_PKEYS);
  int* eidx = (int*)(ws + OFF_EIDX);
  float* pgate = (float*)(ws + OFF_PGATE);
  float* S = (float*)smem;
  constexpr int LS = 132;
  for (int item = blockIdx.x; item < (NTOK / 32) * 8; item += gridDim.x) {
    const int h = item & 7, t0 = (item >> 3) * 32;
    __syncthreads();
#pragma unroll
    for (int c = 0; c < 2; ++c) {
      f32x16 acc;
#pragma unroll
      for (int r = 0; r < 16; ++r) acc[r] = 0.f;
      const bf16_t* ap = pq + (size_t)(t0 + l31) * 2048 + h * 256 + c * 128 + hh * 8;
      const bf16_t* bp = pk + ((size_t)(h * 2 + c) * 128 + wave * 32 + l31) * 128 + hh * 8;
#pragma unroll
      for (int ks = 0; ks < 8; ++ks) {
        const bf16x8 a = *(const bf16x8*)(ap + ks * 16), bb = *(const bf16x8*)(bp + ks * 16);
        acc = MFMA32(a, bb, acc);
      }
#pragma unroll
      for (int r = 0; r < 16; ++r) S[(c * 32 + (r & 3) + 8 * (r >> 2) + 4 * hh) * LS + wave * 32 + l31] = acc[r];
    }
    __syncthreads();
    const int gid = tid >> 4, li = tid & 15;
#pragma unroll 1
    for (int rd = 0; rd < 2; ++rd) {
      const int tok = rd * 16 + gid;
      float sv[2]; int si[2];
#pragma unroll
      for (int c = 0; c < 2; ++c) {
        float v[8];
#pragma unroll
        for (int i = 0; i < 8; ++i) v[i] = S[(c * 32 + tok) * LS + li + 16 * i];
        float rs = 0.f; int rn = 0;
        for (int it = 0; it < 16; ++it) {
          float bv = v[0]; int bi = 0;
#pragma unroll
          for (int i = 1; i < 8; ++i) if (v[i] > bv) { bv = v[i]; bi = i; }
          int bn = li + 16 * bi;
          argmax16(bv, bn);
          if ((bn & 15) == li) {
            const int i2 = bn >> 4;
#pragma unroll
            for (int i = 0; i < 8; ++i) if (i == i2) v[i] = -3e38f;
          }
          if (li == it) { rs = bv; rn = bn; }
        }
        sv[c] = rs; si[c] = rn;
      }
      int pp = 0; float ts = 0.f; int tf = 0;
      for (int it = 0; it < 16; ++it) {
        const float s2p = __shfl(sv[1], pp & 15, 16);
        float bv = (pp < 16) ? sv[0] + s2p : -3e38f;
        int bf = li * 16 + pp;
        argmax16(bv, bf);
        if ((bf >> 4) == li) ++pp;
        if (li == it) { ts = bv; tf = bf; }
      }
      const int e1 = __shfl(si[0], tf >> 4, 16), e2 = __shfl(si[1], tf & 15, 16);
      const float mx = __shfl(ts, 0, 16);
      const float ex = __expf(ts - mx);
      float sum = ex;
#pragma unroll
      for (int o = 1; o < 16; o <<= 1) sum += __shfl_xor(sum, o);
      const size_t oidx = ((size_t)(t0 + tok) * 8 + h) * 16 + li;
      eidx[oidx] = e1 * 128 + e2;
      pgate[oidx] = ex / sum;
    }
  }
}

__device__ void phase_ffn(const Params& p) {
  char* ws = p.ws;
  const int lane = threadIdx.x & 63, wave = threadIdx.x >> 6;
  const bf16_t* h2 = (const bf16_t*)(ws + OFF_H);
  const bf16_t* PU = (const bf16_t*)(ws + OFF_PU);
  const bf16_t* PV = (const bf16_t*)(ws + OFF_PV);
  const int* eidx = (const int*)(ws + OFF_EIDX);
  const float* pgate = (const float*)(ws + OFF_PGATE);
  const float* x1 = (const float*)(ws + OFF_X1);
  const float* mod = (const float*)(ws + OFF_MOD);
  for (int grp = blockIdx.x; grp < NTOK / 4; grp += gridDim.x) {
    const int row = grp * 4 + wave, b = row >> 13;
    float hx[16];
    {
      const u32x4 a = *(const u32x4*)(h2 + (size_t)row * DM + lane * 8), c = *(const u32x4*)(h2 + (size_t)row * DM + 512 + lane * 8);
      hx[0] = bflo(a.x); hx[1] = bfhi(a.x); hx[2] = bflo(a.y); hx[3] = bfhi(a.y); hx[4] = bflo(a.z); hx[5] = bfhi(a.z); hx[6] = bflo(a.w); hx[7] = bfhi(a.w);
      hx[8] = bflo(c.x); hx[9] = bfhi(c.x); hx[10] = bflo(c.y); hx[11] = bfhi(c.y); hx[12] = bflo(c.z); hx[13] = bfhi(c.z); hx[14] = bflo(c.w); hx[15] = bfhi(c.w);
    }
    const int ev0 = eidx[(size_t)row * 128 + lane], ev1 = eidx[(size_t)row * 128 + 64 + lane];
    const float gv0 = pgate[(size_t)row * 128 + lane], gv1 = pgate[(size_t)row * 128 + 64 + lane];
    float acc[16];
#pragma unroll
    for (int i = 0; i < 16; ++i) acc[i] = 0.f;
#pragma unroll 4
    for (int j = 0; j < 128; ++j) {
      const int e = __builtin_amdgcn_readlane(j < 64 ? ev0 : ev1, j & 63);
      const float gt = __int_as_float(__builtin_amdgcn_readlane(__float_as_int(j < 64 ? gv0 : gv1), j & 63));
      const bf16_t* up = PU + (size_t)e * DM + lane * 8;
      const bf16_t* vp = PV + (size_t)e * DM + lane * 8;
      const u32x4 ua = *(const u32x4*)up, ub = *(const u32x4*)(up + 512);
      const u32x4 va = *(const u32x4*)vp, vb = *(const u32x4*)(vp + 512);
      float d = hx[0] * bflo(ua.x) + hx[1] * bfhi(ua.x) + hx[2] * bflo(ua.y) + hx[3] * bfhi(ua.y) + hx[4] * bflo(ua.z) + hx[5] * bfhi(ua.z) + hx[6] * bflo(ua.w) + hx[7] * bfhi(ua.w);
      d += hx[8] * bflo(ub.x) + hx[9] * bfhi(ub.x) + hx[10] * bflo(ub.y) + hx[11] * bfhi(ub.y) + hx[12] * bflo(ub.z) + hx[13] * bfhi(ub.z) + hx[14] * bflo(ub.w) + hx[15] * bfhi(ub.w);
      const float act = wave_sum(d);
      const float w = gt * gelu_f(act);
      acc[0] += w * bflo(va.x); acc[1] += w * bfhi(va.x); acc[2] += w * bflo(va.y); acc[3] += w * bfhi(va.y);
      acc[4] += w * bflo(va.z); acc[5] += w * bfhi(va.z); acc[6] += w * bflo(va.w); acc[7] += w * bfhi(va.w);
      acc[8] += w * bflo(vb.x); acc[9] += w * bfhi(vb.x); acc[10] += w * bflo(vb.y); acc[11] += w * bfhi(vb.y);
      acc[12] += w * bflo(vb.z); acc[13] += w * bfhi(vb.z); acc[14] += w * bflo(vb.w); acc[15] += w * bfhi(vb.w);
    }
    float v[16];
#pragma unroll
    for (int hf = 0; hf < 2; ++hf)
#pragma unroll
      for (int q = 0; q < 2; ++q) {
        const int col = hf * 512 + lane * 8 + q * 4;
        const f32x4 xv = *(const f32x4*)(x1 + (size_t)row * DM + col), gt2 = *(const f32x4*)(mod + b * 6144 + 5120 + col);
        v[hf * 8 + q * 4 + 0] = DN_ALPHA * xv.x + gt2.x * acc[hf * 8 + q * 4 + 0];
        v[hf * 8 + q * 4 + 1] = DN_ALPHA * xv.y + gt2.y * acc[hf * 8 + q * 4 + 1];
        v[hf * 8 + q * 4 + 2] = DN_ALPHA * xv.z + gt2.z * acc[hf * 8 + q * 4 + 2];
        v[hf * 8 + q * 4 + 3] = DN_ALPHA * xv.w + gt2.w * acc[hf * 8 + q * 4 + 3];
      }
    float mean, rstd; row_stats(v, mean, rstd);
#pragma unroll
    for (int hf = 0; hf < 2; ++hf)
#pragma unroll
      for (int q = 0; q < 2; ++q) {
        const int col = hf * 512 + lane * 8 + q * 4;
        const f32x4 g = *(const f32x4*)(p.ln2_g + col), bb = *(const f32x4*)(p.ln2_b + col);
        f32x4 o;
        o.x = (v[hf * 8 + q * 4 + 0] - mean) * rstd * g.x + bb.x; o.y = (v[hf * 8 + q * 4 + 1] - mean) * rstd * g.y + bb.y;
        o.z = (v[hf * 8 + q * 4 + 2] - mean) * rstd * g.z + bb.z; o.w = (v[hf * 8 + q * 4 + 3] - mean) * rstd * g.w + bb.w;
        *(f32x4*)(p.out + (size_t)row * DM + col) = o;
      }
  }
}

constexpr int SMEM_BYTES = 73728;

__global__ void __launch_bounds__(NT, 2) k_mega(Params p) {
  __shared__ __attribute__((aligned(16))) char smem[SMEM_BYTES];
  cg::grid_group grid = cg::this_grid();
  phase_prep(p, smem);
  grid.sync();
  phase_ln_in(p);
  grid.sync();
  phase_gemm1(p, smem);
  grid.sync();
  phase_compress(p, smem);
  phase_sgu(p, smem);
  grid.sync();
  phase_nsa(p, smem, NSA_MASK);
  grid.sync();
  phase_merge(p, smem, true);
  grid.sync();
  phase_outproj(p, smem);
  grid.sync();
  phase_ln_mid(p, false);
  grid.sync();
  phase_peerq(p, smem);
  grid.sync();
  phase_route(p, smem);
  grid.sync();
  phase_ffn(p);
}

extern "C" void kernel_launch(void* const* d_in, const int* in_sizes, int n_in, void* d_out, int out_size, void* d_ws, size_t ws_size, hipStream_t stream) {
  if (ws_size < OFF_END) { fprintf(stderr, "workspace too small: %zu < %zu\n", ws_size, (size_t)OFF_END); return; }
  static int grid_blocks = 0;
  if (!grid_blocks) {
    int dev = 0, cus = 0, per_cu = 0;
    hipGetDevice(&dev);
    hipDeviceGetAttribute(&cus, hipDeviceAttributeMultiprocessorCount, dev);
    hipOccupancyMaxActiveBlocksPerMultiprocessor(&per_cu, k_mega, NT, 0);
    if (per_cu > 2) per_cu = 2;
    if (per_cu < 1) per_cu = 1;
    grid_blocks = cus * per_cu;
  }
  Params p{};
  const float** fp = (const float**)&p;
  for (int i = 0; i < 26; ++i) fp[i] = (const float*)d_in[i];
  p.out = (float*)d_out;
  p.ws = (char*)d_ws;
  for (int i = 0; i < 32; ++i) p.inv_freq[i] = (float)pow(10000.0, -(double)i / 32.0);
  void* args[] = {&p};
  hipError_t e = hipLaunchCooperativeKernel((void*)k_mega, dim3(grid_blocks), dim3(NT), args, 0, stream);
  if (e != hipSuccess) fprintf(stderr, "cooperative launch failed: %s (grid %d)\n", hipGetErrorString(e), grid_blocks);
}
```

```cpp
#include <hip/hip_runtime.h>
#include <hip/hip_cooperative_groups.h>
#include <stdint.h>
#include <stdio.h>
#include <math.h>
namespace cg = cooperative_groups;

#ifndef STAGE
#define STAGE 4
#endif

#ifndef PROBE_DUP
#define PROBE_DUP 0
#endif
#ifndef NSA_MASK
#define NSA_MASK 7
#endif
typedef unsigned short bf16_t;
typedef short bf16x8 __attribute__((ext_vector_type(8)));
typedef short s16x4 __attribute__((ext_vector_type(4)));
typedef float f32x16 __attribute__((ext_vector_type(16)));
typedef float f32x4 __attribute__((ext_vector_type(4)));
typedef float f32x2 __attribute__((ext_vector_type(2)));
typedef __bf16 bf16v2 __attribute__((ext_vector_type(2)));
typedef unsigned u32x4 __attribute__((ext_vector_type(4)));
typedef unsigned u32x2 __attribute__((ext_vector_type(2)));
#define DI __device__ __forceinline__
#define MFMA32(a, b, c) __builtin_amdgcn_mfma_f32_32x32x16_bf16((a), (b), (c), 0, 0, 0)

constexpr int NT = 256;
constexpr int NB = 8, SEQ = 8192, DM = 1024, NTOK = NB * SEQ;
constexpr int N1 = 4480;
constexpr float DN_ALPHA = 1.189207115002721f;
constexpr float LN_EPS = 1e-5f;

constexpr size_t MB = 1024 * 1024;
constexpr size_t OFF_MOD = 0;
constexpr size_t OFF_ROPE = OFF_MOD + 256 * 1024;
constexpr size_t OFF_POSB = OFF_ROPE + 2 * MB;
constexpr size_t OFF_WT1 = OFF_POSB + 4096;
constexpr size_t OFF_WB = OFF_WT1 + (size_t)N1 * 1024 * 2;
constexpr size_t OFF_WOUT = OFF_WB + 2 * MB;
constexpr size_t OFF_WQ = OFF_WOUT + 2 * MB;
constexpr size_t OFF_PKEYS = OFF_WQ + 4 * MB;
constexpr size_t OFF_CW1 = OFF_PKEYS + MB / 2;
constexpr size_t OFF_CW2 = OFF_CW1 + MB;
constexpr size_t OFF_SGUW = OFF_CW2 + 32 * 1024;
constexpr size_t OFF_SCU = OFF_SGUW + 256 * 1024;
constexpr size_t OFF_SCV = OFF_SCU + 64 * 1024;
constexpr size_t OFF_PU = OFF_SCV + 64 * 1024;
constexpr size_t OFF_PV = OFF_PU + 32 * MB;
constexpr size_t OFF_ACT = ((OFF_PV + 32 * MB + 4095) / 4096) * 4096;
constexpr size_t OFF_H = OFF_ACT;
constexpr size_t OFF_Q = OFF_H + 128 * MB;
constexpr size_t OFF_KC = OFF_Q + 64 * MB;
constexpr size_t OFF_VC = OFF_KC + 16 * MB;
constexpr size_t OFF_KS = OFF_VC + 16 * MB;
constexpr size_t OFF_VST = OFF_KS + 16 * MB;
constexpr size_t OFF_KW = OFF_VST + 16 * MB;
constexpr size_t OFF_VWT = OFF_KW + 16 * MB;
constexpr size_t OFF_U = OFF_VWT + 16 * MB;
constexpr size_t OFF_V = OFF_U + 64 * MB;
constexpr size_t OFF_GATE = OFF_V + 64 * MB;
constexpr size_t OFF_GSIG = OFF_GATE + 256 * MB;
constexpr size_t OFF_KCMP = OFF_GSIG + 8 * MB;
constexpr size_t OFF_VCMPT = OFF_KCMP + MB;
constexpr size_t OFF_ONSA = OFF_VCMPT + MB;
constexpr size_t OFF_SELG = OFF_ONSA + 64 * MB;
constexpr size_t OFF_END = OFF_SELG + 2 * MB;
constexpr size_t OFF_X1 = OFF_Q;
constexpr size_t OFF_Y = OFF_GATE;
constexpr size_t OFF_PQ = OFF_GATE;
constexpr size_t OFF_EIDX = OFF_ONSA;
constexpr size_t OFF_PGATE = OFF_ONSA + 32 * MB;
constexpr size_t OFF_PU8 = OFF_PU;
constexpr size_t OFF_PV8 = OFF_PU + 16 * MB;
constexpr size_t OFF_WBUF = OFF_PU + 32 * MB;
constexpr size_t OFF_FFNB = OFF_GATE;

struct Params {
  const float *x, *c, *w_ada, *b_ada, *w_in, *cmp_pos, *cmp_w1, *cmp_b1, *cmp_w2, *cmp_b2, *sgu_ln_g, *sgu_ln_b, *sgu_w, *sgu_b,
      *w_branch, *w_merge, *b_merge, *w_out, *ln1_g, *ln1_b, *peer_wq, *peer_keys, *peer_u, *peer_v, *ln2_g, *ln2_b;
  float* out;
  char* ws;
  float inv_freq[32];
};

DI unsigned pack2(float lo, float hi) { f32x2 v = {lo, hi}; bf16v2 r = __builtin_convertvector(v, bf16v2); return __builtin_bit_cast(unsigned, r); }
DI bf16_t f2bf(float f) { __bf16 r = (__bf16)f; return __builtin_bit_cast(unsigned short, r); }
DI float bf2f(bf16_t h) { return __uint_as_float(((unsigned)h) << 16); }
DI float bflo(unsigned u) { return __uint_as_float(u << 16); }
DI float bfhi(unsigned u) { return __uint_as_float(u & 0xffff0000u); }
DI float gelu_f(float v) { return 0.5f * v * (1.0f + erff(v * 0.70710678118654752f)); }
DI float sigmoid_f(float v) { return 1.0f / (1.0f + __expf(-v)); }
DI float wave_sum(float v) {
#pragma unroll
  for (int o = 32; o > 0; o >>= 1) v += __shfl_xor(v, o);
  return v;
}

template <class F>
DI void tconv_tile(float* tile, int k0, int n0, bf16_t* dst, int ldd, F f) {
  const int tid = threadIdx.x;
  __syncthreads();
#pragma unroll 4
  for (int i = 0; i < 16; ++i) { const int kl = i * 4 + (tid >> 6), nl = tid & 63; tile[nl * 65 + kl] = f(k0 + kl, n0 + nl); }
  __syncthreads();
#pragma unroll
  for (int i = 0; i < 2; ++i) {
    const int idx = tid + i * 256, nl = idx >> 3, kc = idx & 7;
    const float* t = tile + nl * 65 + kc * 8;
    u32x4 w; w.x = pack2(t[0], t[1]); w.y = pack2(t[2], t[3]); w.z = pack2(t[4], t[5]); w.w = pack2(t[6], t[7]);
    *(u32x4*)(dst + (size_t)(n0 + nl) * ldd + k0 + kc * 8) = w;
  }
}

DI void conv_chunk(const float* src, bf16_t* dst, size_t base) {
  const size_t i = base + (size_t)threadIdx.x * 8;
  const f32x4 a = *(const f32x4*)(src + i), b = *(const f32x4*)(src + i + 4);
  u32x4 w; w.x = pack2(a.x, a.y); w.y = pack2(a.z, a.w); w.z = pack2(b.x, b.y); w.w = pack2(b.z, b.w);
  *(u32x4*)(dst + i) = w;
}

DI void sincos_d(double x, double& s, double& c) {
  const double y = x * 0.25, y2 = y * y;
  double sn = y * (1.0 + y2 * (-1.0 / 6 + y2 * (1.0 / 120 + y2 * (-1.0 / 5040 + y2 * (1.0 / 362880 + y2 * (-1.0 / 39916800 + y2 * (1.0 / 6227020800.0)))))));
  double cs = 1.0 + y2 * (-0.5 + y2 * (1.0 / 24 + y2 * (-1.0 / 720 + y2 * (1.0 / 40320 + y2 * (-1.0 / 3628800 + y2 * (1.0 / 479001600.0 + y2 * (-1.0 / 87178291200.0)))))));
#pragma unroll
  for (int i = 0; i < 2; ++i) { const double s2 = 2.0 * sn * cs, c2 = cs * cs - sn * sn; sn = s2; cs = c2; }
  s = sn; c = cs;
}

DI void phase_prep(const Params& p, char* smem) {
  const int tid = threadIdx.x;
  float* fs = (float*)smem;
  char* ws = p.ws;
  constexpr int nA = 192, nB = 16 * 70, nC = 2 * 8 * 16, nD = 256, nE = 16 * 32, nF = 2 * 32 * 2, nG = 4, nH = 8, nI = 1024, nJ = 128, nK = 64, nL = 4096, nM = 4096;
  constexpr int total = nA + nB + nC + nD + nE + nF + nG + nH + nI + nJ + nK + nL + nM;
  for (int item = blockIdx.x; item < total; item += gridDim.x) {
    int it = item;
    if (it < nA) {
      float* sc = fs;
      float* red = fs + 8192;
      __syncthreads();
      for (int i = tid; i < 8192; i += NT) { const float v = p.c[i]; sc[i] = v / (1.0f + __expf(-v)); }
      __syncthreads();
      const int ks = tid >> 5, cj = tid & 31, col = it * 32 + cj;
      float acc[8];
#pragma unroll
      for (int b = 0; b < 8; ++b) acc[b] = 0.f;
#pragma unroll 4
      for (int k = ks * 128; k < ks * 128 + 128; ++k) {
        const float w = p.w_ada[(size_t)k * 6144 + col];
#pragma unroll
        for (int b = 0; b < 8; ++b) acc[b] += sc[b * 1024 + k] * w;
      }
#pragma unroll
      for (int b = 0; b < 8; ++b) red[(ks * 8 + b) * 32 + cj] = acc[b];
      __syncthreads();
      {
        const int b = tid >> 5;
        float s = p.b_ada[col];
#pragma unroll
        for (int k2 = 0; k2 < 8; ++k2) s += red[(k2 * 8 + b) * 32 + cj];
        ((float*)(ws + OFF_MOD))[b * 6144 + col] = s;
      }
      continue;
    }
    it -= nA;
    if (it < nB) {
      const int kt = it / 70, ntile = it % 70;
      const float* w_in = p.w_in; const float* w_merge = p.w_merge;
      tconv_tile(fs, kt * 64, ntile * 64, (bf16_t*)(ws + OFF_WT1), 1024, [=](int k, int n) -> float {
        if (n < 1280) return w_in[(size_t)k * 2328 + n];
        if (n < 2304) return w_in[(size_t)k * 2328 + n + 24];
        if (n < 4352) return w_merge[(size_t)k * 2048 + (n - 2304)];
        if (n < 4376) return w_in[(size_t)k * 2328 + 1280 + (n - 4352)];
        return 0.f; });
      continue;
    }
    it -= nB;
    if (it < nC) {
      const int br = it >> 7, r = it & 127, kt = r >> 4, ntile = r & 15;
      const float* src = p.w_branch + (size_t)br * 512 * 1024;
      tconv_tile(fs, kt * 64, ntile * 64, (bf16_t*)(ws + OFF_WB) + (size_t)br * 1024 * 512, 512, [=](int k, int n) -> float { return src[(size_t)k * 1024 + n]; });
      continue;
    }
    it -= nC;
    if (it < nD) {
      const int kt = it >> 4, ntile = it & 15;
      const float* src = p.w_out;
      tconv_tile(fs, kt * 64, ntile * 64, (bf16_t*)(ws + OFF_WOUT), 1024, [=](int k, int n) -> float { return src[(size_t)k * 1024 + n]; });
      continue;
    }
    it -= nD;
    if (it < nE) {
      const int kt = it >> 5, ntile = it & 31;
      const float* src = p.peer_wq;
      tconv_tile(fs, kt * 64, ntile * 64, (bf16_t*)(ws + OFF_WQ), 1024, [=](int k, int n) -> float { return src[(size_t)k * 2048 + n]; });
      continue;
    }
    it -= nE;
    if (it < nF) {
      const int w = it >> 6, r = it & 63, kt = r >> 1, ntile = r & 1;
      const float* src = p.cmp_w1 + (size_t)w * 2048 * 128;
      tconv_tile(fs, kt * 64, ntile * 64, (bf16_t*)(ws + OFF_CW1) + (size_t)w * 128 * 2048, 2048, [=](int k, int n) -> float { return src[(size_t)k * 128 + n]; });
      continue;
    }
    it -= nF;
    if (it < nG) {
      const int w = it >> 1, kt = it & 1;
      const float* src = p.cmp_w2 + (size_t)w * 128 * 64;
      tconv_tile(fs, kt * 64, 0, (bf16_t*)(ws + OFF_CW2) + (size_t)w * 64 * 128, 128, [=](int k, int n) -> float { return src[(size_t)k * 64 + n]; });
      continue;
    }
    it -= nG;
    if (it < nH) {
      const int w = it >> 2, jc = it & 3, ks = tid >> 5, cj = tid & 31, j = jc * 32 + cj;
      float* red = fs;
      const float* pos = p.cmp_pos + w * 2048; const float* w1 = p.cmp_w1 + (size_t)w * 2048 * 128;
      float acc = 0.f;
#pragma unroll 4
      for (int k = ks * 256; k < ks * 256 + 256; ++k) acc += pos[k] * w1[(size_t)k * 128 + j];
      __syncthreads();
      red[ks * 32 + cj] = acc;
      __syncthreads();
      if (tid < 32) { float s = p.cmp_b1[w * 128 + j]; for (int k2 = 0; k2 < 8; ++k2) s += red[k2 * 32 + tid]; ((float*)(ws + OFF_POSB))[w * 128 + j] = s; }
      continue;
    }
    it -= nH;
    if (it < nI) {
      const int e = it * 256 + tid, pos = e >> 5, i = e & 31;
      const float ang = (float)pos * p.inv_freq[i];
      const double a = (double)ang;
      const double kk = rint(a * 0.15915494309189535);
      const double r = a - kk * 6.283185307179586476925;
      double s, c; sincos_d(r, s, c);
      ((float*)(ws + OFF_ROPE))[e] = (float)c;
      ((float*)(ws + OFF_ROPE))[262144 + e] = (float)s;
      continue;
    }
    it -= nI;
    if (it < nJ) { conv_chunk(p.peer_keys, (bf16_t*)(ws + OFF_PKEYS), (size_t)it * 2048); continue; }
    it -= nJ;
    if (it < nK) {
      const size_t i0 = (size_t)it * 2048 + (size_t)tid * 8;
      const int rowi = (int)((i0 >> 7) & 127), j0 = (int)(i0 & 127);
      float v[8];
#pragma unroll
      for (int j = 0; j < 8; ++j) v[j] = (j0 + j <= rowi) ? p.sgu_w[i0 + j] : 0.f;
      u32x4 w; w.x = pack2(v[0], v[1]); w.y = pack2(v[2], v[3]); w.z = pack2(v[4], v[5]); w.w = pack2(v[6], v[7]);
      *(u32x4*)((bf16_t*)(ws + OFF_SGUW) + i0) = w;
      continue;
    }
    it -= nK;
    {
      const bool isv = it >= nL;
      if (isv) it -= nL;
      const int lane = tid & 63, e = it * 4 + (tid >> 6);
      const float* src = (isv ? p.peer_v : p.peer_u) + (size_t)e * 1024 + lane * 16;
      float v[16];
#pragma unroll
      for (int i = 0; i < 4; ++i) { const f32x4 t4 = *(const f32x4*)(src + i * 4); v[4 * i] = t4.x; v[4 * i + 1] = t4.y; v[4 * i + 2] = t4.z; v[4 * i + 3] = t4.w; }
      float amax = 0.f;
#pragma unroll
      for (int i = 0; i < 16; ++i) amax = fmaxf(amax, fabsf(v[i]));
#pragma unroll
      for (int o = 32; o > 0; o >>= 1) amax = fmaxf(amax, __shfl_xor(amax, o));
      const unsigned be = (__float_as_uint(amax) >> 23) & 0xffu;
      const bool okr = be >= 16u && be <= 240u;
      const float scale = okr ? __uint_as_float((261u - be) << 23) : 1.0f;
      const float inv = okr ? __uint_as_float((be - 7u) << 23) : 1.0f;
      u32x4 w;
      int t0 = 0, t1 = 0, t2 = 0, t3 = 0;
      t0 = __builtin_amdgcn_cvt_pk_fp8_f32(v[0] * scale, v[1] * scale, t0, false); t0 = __builtin_amdgcn_cvt_pk_fp8_f32(v[2] * scale, v[3] * scale, t0, true);
      t1 = __builtin_amdgcn_cvt_pk_fp8_f32(v[4] * scale, v[5] * scale, t1, false); t1 = __builtin_amdgcn_cvt_pk_fp8_f32(v[6] * scale, v[7] * scale, t1, true);
      t2 = __builtin_amdgcn_cvt_pk_fp8_f32(v[8] * scale, v[9] * scale, t2, false); t2 = __builtin_amdgcn_cvt_pk_fp8_f32(v[10] * scale, v[11] * scale, t2, true);
      t3 = __builtin_amdgcn_cvt_pk_fp8_f32(v[12] * scale, v[13] * scale, t3, false); t3 = __builtin_amdgcn_cvt_pk_fp8_f32(v[14] * scale, v[15] * scale, t3, true);
      w.x = (unsigned)t0; w.y = (unsigned)t1; w.z = (unsigned)t2; w.w = (unsigned)t3;
      if (!isv) {
        *(u32x4*)(ws + OFF_PU8 + (size_t)e * 1024 + lane * 16) = w;
        if (lane == 0) ((float*)(ws + OFF_SCU))[e] = inv;
      } else {
        *(u32x4*)(ws + OFF_PV8 + ((size_t)(lane >> 3) * 16384 + e) * 128 + (lane & 7) * 16) = w;
        if (lane == 0) ((float*)(ws + OFF_SCV))[e] = inv;
      }
    }
  }
}

DI void row_stats(const float (&v)[16], float& mean, float& rstd) {
  float s = 0.f;
#pragma unroll
  for (int i = 0; i < 16; ++i) s += v[i];
  mean = wave_sum(s) * (1.0f / 1024.0f);
  float q = 0.f;
#pragma unroll
  for (int i = 0; i < 16; ++i) { const float d = v[i] - mean; q += d * d; }
  rstd = rsqrtf(wave_sum(q) * (1.0f / 1024.0f) + LN_EPS);
}

DI void phase_ln_in(const Params& p) {
  const int lane = threadIdx.x & 63, wave = threadIdx.x >> 6;
  const float* mod = (const float*)(p.ws + OFF_MOD);
  bf16_t* h = (bf16_t*)(p.ws + OFF_H);
  for (int grp = blockIdx.x; grp < NTOK / 4; grp += gridDim.x) {
    const int row = grp * 4 + wave, b = row >> 13;
    const float* xr = p.x + (size_t)row * DM;
    float v[16];
#pragma unroll
    for (int i = 0; i < 4; ++i) { const f32x4 t = *(const f32x4*)(xr + i * 256 + lane * 4); v[4 * i] = t.x; v[4 * i + 1] = t.y; v[4 * i + 2] = t.z; v[4 * i + 3] = t.w; }
    float mean, rstd; row_stats(v, mean, rstd);
#pragma unroll
    for (int i = 0; i < 4; ++i) {
      const int col = i * 256 + lane * 4;
      const f32x4 sh = *(const f32x4*)(mod + b * 6144 + col), sc = *(const f32x4*)(mod + b * 6144 + 1024 + col);
      const float o0 = (v[4 * i] - mean) * rstd * (1.f + sc.x) + sh.x, o1 = (v[4 * i + 1] - mean) * rstd * (1.f + sc.y) + sh.y;
      const float o2 = (v[4 * i + 2] - mean) * rstd * (1.f + sc.z) + sh.z, o3 = (v[4 * i + 3] - mean) * rstd * (1.f + sc.w) + sh.w;
      u32x2 w; w.x = pack2(o0, o1); w.y = pack2(o2, o3);
      *(u32x2*)(h + (size_t)row * DM + col) = w;
    }
  }
}

DI void phase_ln_mid(const Params& p, bool y_is_x) {
  const int lane = threadIdx.x & 63, wave = threadIdx.x >> 6;
  const float* mod = (const float*)(p.ws + OFF_MOD);
  const float* y = (const float*)(p.ws + OFF_Y);
  float* x1 = (float*)(p.ws + OFF_X1);
  bf16_t* h2 = (bf16_t*)(p.ws + OFF_H);
  for (int grp = blockIdx.x; grp < NTOK / 4; grp += gridDim.x) {
    const int row = grp * 4 + wave, b = row >> 13;
    const float* yr = (y_is_x ? p.x : y) + (size_t)row * DM;
    float v[16];
#pragma unroll
    for (int i = 0; i < 4; ++i) { const f32x4 t = *(const f32x4*)(yr + i * 256 + lane * 4); v[4 * i] = t.x; v[4 * i + 1] = t.y; v[4 * i + 2] = t.z; v[4 * i + 3] = t.w; }
    if (y_is_x) {
#pragma unroll
      for (int i = 0; i < 16; ++i) v[i] *= DN_ALPHA;
    }
    float mean, rstd; row_stats(v, mean, rstd);
#pragma unroll
    for (int i = 0; i < 4; ++i) {
      const int col = i * 256 + lane * 4;
      const f32x4 g = *(const f32x4*)(p.ln1_g + col), bb = *(const f32x4*)(p.ln1_b + col);
      f32x4 o;
      o.x = (v[4 * i] - mean) * rstd * g.x + bb.x; o.y = (v[4 * i + 1] - mean) * rstd * g.y + bb.y;
      o.z = (v[4 * i + 2] - mean) * rstd * g.z + bb.z; o.w = (v[4 * i + 3] - mean) * rstd * g.w + bb.w;
      *(f32x4*)(x1 + (size_t)row * DM + col) = o;
      v[4 * i] = o.x; v[4 * i + 1] = o.y; v[4 * i + 2] = o.z; v[4 * i + 3] = o.w;
    }
    row_stats(v, mean, rstd);
#pragma unroll
    for (int i = 0; i < 4; ++i) {
      const int col = i * 256 + lane * 4;
      const f32x4 sh = *(const f32x4*)(mod + b * 6144 + 3072 + col), sc = *(const f32x4*)(mod + b * 6144 + 4096 + col);
      const float o0 = (v[4 * i] - mean) * rstd * (1.f + sc.x) + sh.x, o1 = (v[4 * i + 1] - mean) * rstd * (1.f + sc.y) + sh.y;
      const float o2 = (v[4 * i + 2] - mean) * rstd * (1.f + sc.z) + sh.z, o3 = (v[4 * i + 3] - mean) * rstd * (1.f + sc.w) + sh.w;
      u32x2 w; w.x = pack2(o0, o1); w.y = pack2(o2, o3);
      *(u32x2*)(h2 + (size_t)row * DM + col) = w;
    }
  }
}

DI void phase_final_noffn(const Params& p) {
  const int lane = threadIdx.x & 63, wave = threadIdx.x >> 6;
  const float* x1 = (const float*)(p.ws + OFF_X1);
  for (int grp = blockIdx.x; grp < NTOK / 4; grp += gridDim.x) {
    const int row = grp * 4 + wave;
    const float* xr = x1 + (size_t)row * DM;
    float v[16];
#pragma unroll
    for (int i = 0; i < 4; ++i) { const f32x4 t = *(const f32x4*)(xr + i * 256 + lane * 4); v[4 * i] = t.x * DN_ALPHA; v[4 * i + 1] = t.y * DN_ALPHA; v[4 * i + 2] = t.z * DN_ALPHA; v[4 * i + 3] = t.w * DN_ALPHA; }
    float mean, rstd; row_stats(v, mean, rstd);
#pragma unroll
    for (int i = 0; i < 4; ++i) {
      const int col = i * 256 + lane * 4;
      const f32x4 g = *(const f32x4*)(p.ln2_g + col), bb = *(const f32x4*)(p.ln2_b + col);
      f32x4 o;
      o.x = (v[4 * i] - mean) * rstd * g.x + bb.x; o.y = (v[4 * i + 1] - mean) * rstd * g.y + bb.y;
      o.z = (v[4 * i + 2] - mean) * rstd * g.z + bb.z; o.w = (v[4 * i + 3] - mean) * rstd * g.w + bb.w;
      *(f32x4*)(p.out + (size_t)row * DM + col) = o;
    }
  }
}

constexpr int LDT = 72;
constexpr int GEMM_SMEM = 2 * 2 * 128 * LDT * 2;

DI void zero_acc(f32x16 (&acc)[2][2]) {
#pragma unroll
  for (int i = 0; i < 2; ++i)
#pragma unroll
    for (int j = 0; j < 2; ++j)
#pragma unroll
      for (int r = 0; r < 16; ++r) acc[i][j][r] = 0.f;
}

DI void gemm_mainloop(f32x16 (&acc)[2][2], const bf16_t* __restrict__ A, int lda, const bf16_t* __restrict__ Bt, int ldb, int K, int row0, int col0, char* smem) {
  bf16_t* As = (bf16_t*)smem;
  bf16_t* Bs = As + 2 * 128 * LDT;
  const int tid = threadIdx.x, lane = tid & 63, wave = tid >> 6, wr = wave >> 1, wc = wave & 1;
  const int lr = tid >> 3, lc = (tid & 7) * 8;
  const bf16_t* ga = A + (size_t)(row0 + lr) * lda + lc;
  const bf16_t* gb = Bt + (size_t)(col0 + lr) * ldb + lc;
  const int lofs = lr * LDT + lc;
  u32x4 ra[4], rb[4];
#pragma unroll
  for (int i = 0; i < 4; ++i) { ra[i] = *(const u32x4*)(ga + (size_t)i * 32 * lda); rb[i] = *(const u32x4*)(gb + (size_t)i * 32 * ldb); }
  __syncthreads();
#pragma unroll
  for (int i = 0; i < 4; ++i) { *(u32x4*)(As + lofs + i * 32 * LDT) = ra[i]; *(u32x4*)(Bs + lofs + i * 32 * LDT) = rb[i]; }
  __syncthreads();
  const int nk = K >> 6;
  const int fa = (wr * 64 + (lane & 31)) * LDT + (lane >> 5) * 8;
  const int fb = (wc * 64 + (lane & 31)) * LDT + (lane >> 5) * 8;
#pragma unroll 1
  for (int kt = 0; kt < nk; ++kt) {
    const int cur = kt & 1;
    if (kt + 1 < nk) {
#pragma unroll
      for (int i = 0; i < 4; ++i) { ra[i] = *(const u32x4*)(ga + (size_t)i * 32 * lda + (kt + 1) * 64); rb[i] = *(const u32x4*)(gb + (size_t)i * 32 * ldb + (kt + 1) * 64); }
    }
    const bf16_t* as = As + cur * 128 * LDT + fa;
    const bf16_t* bs = Bs + cur * 128 * LDT + fb;
#pragma unroll
    for (int ks = 0; ks < 4; ++ks) {
      const bf16x8 a0 = *(const bf16x8*)(as + ks * 16), a1 = *(const bf16x8*)(as + 32 * LDT + ks * 16);
      const bf16x8 b0 = *(const bf16x8*)(bs + ks * 16), b1 = *(const bf16x8*)(bs + 32 * LDT + ks * 16);
      acc[0][0] = MFMA32(a0, b0, acc[0][0]); acc[0][1] = MFMA32(a0, b1, acc[0][1]);
      acc[1][0] = MFMA32(a1, b0, acc[1][0]); acc[1][1] = MFMA32(a1, b1, acc[1][1]);
    }
    if (kt + 1 < nk) {
      bf16_t* ad = As + (cur ^ 1) * 128 * LDT + lofs; bf16_t* bd = Bs + (cur ^ 1) * 128 * LDT + lofs;
#pragma unroll
      for (int i = 0; i < 4; ++i) { *(u32x4*)(ad + i * 32 * LDT) = ra[i]; *(u32x4*)(bd + i * 32 * LDT) = rb[i]; }
    }
    __syncthreads();
  }
}

constexpr int LDE = 68;
DI float* epi_stage(const f32x16 (&acc)[2][2], char* smem, int wave, int lane) {
  float* e = (float*)smem + wave * 64 * LDE;
  const int l31 = lane & 31, hh = lane >> 5;
#pragma unroll
  for (int mi = 0; mi < 2; ++mi)
#pragma unroll
    for (int ni = 0; ni < 2; ++ni)
#pragma unroll
      for (int r = 0; r < 16; ++r) e[(mi * 32 + (r & 3) + 8 * (r >> 2) + 4 * hh) * LDE + ni * 32 + l31] = acc[mi][ni][r];
  return e;
}
DI void ld8(const float* pz, float (&v)[8]) { const f32x4 a = *(const f32x4*)pz, b = *(const f32x4*)(pz + 4); v[0] = a.x; v[1] = a.y; v[2] = a.z; v[3] = a.w; v[4] = b.x; v[5] = b.y; v[6] = b.z; v[7] = b.w; }
DI u32x4 pack8(const float (&v)[8]) { u32x4 w; w.x = pack2(v[0], v[1]); w.y = pack2(v[2], v[3]); w.z = pack2(v[4], v[5]); w.w = pack2(v[6], v[7]); return w; }
DI void unpack8(const u32x4 w, float (&v)[8]) { v[0] = bflo(w.x); v[1] = bfhi(w.x); v[2] = bflo(w.y); v[3] = bfhi(w.y); v[4] = bflo(w.z); v[5] = bfhi(w.z); v[6] = bflo(w.w); v[7] = bfhi(w.w); }

template <int ACT>
DI void epi_plain(const float* e, bf16_t* dst, unsigned ld, unsigned cofs, int rb, int lane, const float* bias) {
  const int c8 = (lane & 7) * 8;
  float bv[8];
  if (ACT == 2) ld8(bias + c8, bv);
#pragma unroll
  for (int ps = 0; ps < 8; ++ps) {
    const int row = ps * 8 + (lane >> 3);
    float v[8]; ld8(e + row * LDE + c8, v);
#pragma unroll
    for (int j = 0; j < 8; ++j) { if (ACT == 1) v[j] = gelu_f(v[j]); if (ACT == 2) v[j] = sigmoid_f(v[j] + bv[j]); }
    *(u32x4*)(dst + (unsigned)(rb + row) * ld + cofs + c8) = pack8(v);
  }
}
DI void epi_rope(const float* e, bf16_t* dst, unsigned ld, unsigned cofs, int rb, int lane, const float* rope, float scale) {
  const int c8 = (lane & 3) * 8;
#pragma unroll
  for (int ps = 0; ps < 4; ++ps) {
    const int row = ps * 16 + (lane >> 2), pos = (rb + row) & (SEQ - 1);
    float t1[8], t2[8], cs[8], sn[8], o1[8], o2[8];
    ld8(e + row * LDE + c8, t1); ld8(e + row * LDE + 32 + c8, t2);
    ld8(rope + pos * 32 + c8, cs); ld8(rope + 262144 + pos * 32 + c8, sn);
#pragma unroll
    for (int j = 0; j < 8; ++j) { o1[j] = (t1[j] * cs[j] - t2[j] * sn[j]) * scale; o2[j] = (t1[j] * sn[j] + t2[j] * cs[j]) * scale; }
    *(u32x4*)(dst + (unsigned)(rb + row) * ld + cofs + c8) = pack8(o1);
    *(u32x4*)(dst + (unsigned)(rb + row) * ld + cofs + 32 + c8) = pack8(o2);
  }
}
DI void epi_vT(const float* e, bf16_t* dst, int g, int rb, int lane) {
  const int b = rb >> 13, pos0 = rb & (SEQ - 1);
  bf16_t* drow = dst + ((size_t)((b * 2 + g) * 64 + lane)) * SEQ + pos0;
#pragma unroll
  for (int ch = 0; ch < 8; ++ch) {
    float v[8];
#pragma unroll
    for (int j = 0; j < 8; ++j) v[j] = e[(ch * 8 + j) * LDE + lane];
    *(u32x4*)(drow + ch * 8) = pack8(v);
  }
}

DI void phase_gemm1(const Params& p, char* smem) {
  char* ws = p.ws;
  const bf16_t* A = (const bf16_t*)(ws + OFF_H);
  const bf16_t* Bt = (const bf16_t*)(ws + OFF_WT1);
  const float* rope = (const float*)(ws + OFF_ROPE);
  const int lane = threadIdx.x & 63, wave = threadIdx.x >> 6;
  constexpr int NCT = N1 / 128, NRT = NTOK / 128;
  for (int tile = blockIdx.x; tile < NCT * NRT; tile += gridDim.x) {
    const int rt = tile / NCT, ct = tile % NCT;
    f32x16 acc[2][2]; zero_acc(acc);
    gemm_mainloop(acc, A, 1024, Bt, 1024, 1024, rt * 128, ct * 128, smem);
    const int rb = rt * 128 + (wave >> 1) * 64, cb = ct * 128 + (wave & 1) * 64;
    const float* e = epi_stage(acc, smem, wave, lane);
    if (cb < 512) epi_rope(e, (bf16_t*)(ws + OFF_Q), 512, cb, rb, lane, rope, 0.125f);
    else if (cb < 640) epi_rope(e, (bf16_t*)(ws + OFF_KC), 128, cb - 512, rb, lane, rope, 1.0f);
    else if (cb < 768) epi_plain<0>(e, (bf16_t*)(ws + OFF_VC), 128, cb - 640, rb, lane, nullptr);
    else if (cb < 896) epi_rope(e, (bf16_t*)(ws + OFF_KS), 128, cb - 768, rb, lane, rope, 1.0f);
    else if (cb < 1024) epi_vT(e, (bf16_t*)(ws + OFF_VST), (cb - 896) >> 6, rb, lane);
    else if (cb < 1152) epi_rope(e, (bf16_t*)(ws + OFF_KW), 128, cb - 1024, rb, lane, rope, 1.0f);
    else if (cb < 1280) epi_vT(e, (bf16_t*)(ws + OFF_VWT), (cb - 1152) >> 6, rb, lane);
    else if (cb < 1792) epi_plain<1>(e, (bf16_t*)(ws + OFF_U), 512, cb - 1280, rb, lane, nullptr);
    else if (cb < 2304) epi_plain<1>(e, (bf16_t*)(ws + OFF_V), 512, cb - 1792, rb, lane, nullptr);
    else if (cb < 4352) epi_plain<2>(e, (bf16_t*)(ws + OFF_GATE), 2048, cb - 2304, rb, lane, p.b_merge + (cb - 2304));
    else if (cb < 4416) {
      float* gs = (float*)(ws + OFF_GSIG);
      const int c8 = (lane & 7) * 8;
      if (c8 < 24) {
#pragma unroll
        for (int ps = 0; ps < 8; ++ps) {
          const int row = ps * 8 + (lane >> 3);
          float v[8]; ld8(e + row * LDE + c8, v);
          f32x4 o0, o1; o0.x = sigmoid_f(v[0]); o0.y = sigmoid_f(v[1]); o0.z = sigmoid_f(v[2]); o0.w = sigmoid_f(v[3]);
          o1.x = sigmoid_f(v[4]); o1.y = sigmoid_f(v[5]); o1.z = sigmoid_f(v[6]); o1.w = sigmoid_f(v[7]);
          *(f32x4*)(gs + (unsigned)(rb + row) * 32 + c8) = o0; *(f32x4*)(gs + (unsigned)(rb + row) * 32 + c8 + 4) = o1;
        }
      }
    }
  }
}

DI void phase_sgu(const Params& p, char* smem) {
  char* ws = p.ws;
  const int tid = threadIdx.x, lane = tid & 63, wave = tid >> 6;
  bf16_t* u = (bf16_t*)(ws + OFF_U);
  const bf16_t* v = (const bf16_t*)(ws + OFF_V);
  const bf16_t* W = (const bf16_t*)(ws + OFF_SGUW);
  float* st = (float*)smem;
  bf16_t* vt = (bf16_t*)(smem + 1024);
  constexpr int LV = 136;
  for (int item = blockIdx.x; item < NTOK / 128; item += gridDim.x) {
    const int t0 = item * 128;
    __syncthreads();
    for (int i = 0; i < 32; ++i) {
      const int t = wave * 32 + i;
      const u32x4 raw = *(const u32x4*)(v + (size_t)(t0 + t) * 512 + lane * 8);
      float f[8] = {bflo(raw.x), bfhi(raw.x), bflo(raw.y), bfhi(raw.y), bflo(raw.z), bfhi(raw.z), bflo(raw.w), bfhi(raw.w)};
      float s = 0.f;
#pragma unroll
      for (int j = 0; j < 8; ++j) s += f[j];
      const float mean = wave_sum(s) * (1.f / 512.f);
      float q = 0.f;
#pragma unroll
      for (int j = 0; j < 8; ++j) { const float d = f[j] - mean; q += d * d; }
      const float rstd = rsqrtf(wave_sum(q) * (1.f / 512.f) + LN_EPS);
      if (lane == 0) { st[t * 2] = mean; st[t * 2 + 1] = rstd; }
    }
    for (int g = 0; g < 8; ++g) {
      __syncthreads();
      for (int i = 0; i < 4; ++i) {
        const int idx = tid + i * 256, j = idx >> 3, dc = (idx & 7) * 8;
        const u32x4 raw = *(const u32x4*)(v + (size_t)(t0 + j) * 512 + g * 64 + dc);
        const float mean = st[j * 2], rstd = st[j * 2 + 1];
        const float f[8] = {bflo(raw.x), bfhi(raw.x), bflo(raw.y), bfhi(raw.y), bflo(raw.z), bfhi(raw.z), bflo(raw.w), bfhi(raw.w)};
#pragma unroll
        for (int k = 0; k < 8; ++k) {
          const int col = g * 64 + dc + k;
          vt[(dc + k) * LV + j] = f2bf((f[k] - mean) * rstd * p.sgu_ln_g[col] + p.sgu_ln_b[col]);
        }
      }
      __syncthreads();
      f32x16 acc[2];
#pragma unroll
      for (int r = 0; r < 16; ++r) { acc[0][r] = 0.f; acc[1][r] = 0.f; }
      const bf16_t* wrow = W + ((size_t)g * 128 + wave * 32 + (lane & 31)) * 128 + (lane >> 5) * 8;
#pragma unroll
      for (int ks = 0; ks < 8; ++ks) {
        const bf16x8 a = *(const bf16x8*)(wrow + ks * 16);
        const bf16x8 b0 = *(const bf16x8*)(vt + (lane & 31) * LV + ks * 16 + (lane >> 5) * 8);
        const bf16x8 b1 = *(const bf16x8*)(vt + (32 + (lane & 31)) * LV + ks * 16 + (lane >> 5) * 8);
        acc[0] = MFMA32(a, b0, acc[0]); acc[1] = MFMA32(a, b1, acc[1]);
      }
      const int d = lane & 31, hh = lane >> 5;
#pragma unroll
      for (int ni = 0; ni < 2; ++ni)
#pragma unroll
        for (int r = 0; r < 16; ++r) {
          const int i = wave * 32 + (r & 3) + 8 * (r >> 2) + 4 * hh;
          const float m = acc[ni][r] + p.sgu_b[g * 128 + i];
          bf16_t* up = u + (size_t)(t0 + i) * 512 + g * 64 + ni * 32 + d;
          *up = f2bf(bf2f(*up) * m);
        }
    }
  }
}

DI void phase_merge(const Params& p, char* smem, bool use_nsa) {
  char* ws = p.ws;
  const bf16_t* onsa = (const bf16_t*)(ws + OFF_ONSA);
  const bf16_t* osgu = (const bf16_t*)(ws + OFF_U);
  const bf16_t* Wb = (const bf16_t*)(ws + OFF_WB);
  const bf16_t* gate = (const bf16_t*)(ws + OFF_GATE);
  bf16_t* merged = (bf16_t*)(ws + OFF_H);
  const int lane = threadIdx.x & 63, wave = threadIdx.x >> 6;
  for (int tile = blockIdx.x; tile < 8 * (NTOK / 128); tile += gridDim.x) {
    const int rt = tile >> 3, ct = tile & 7;
    const int rb = rt * 128 + (wave >> 1) * 64, cb = ct * 128 + (wave & 1) * 64, c8 = (lane & 7) * 8;
#pragma unroll 1
    for (int br = 0; br < 2; ++br) {
      f32x16 acc[2][2]; zero_acc(acc);
      if (br == 1 || use_nsa) gemm_mainloop(acc, br == 0 ? onsa : osgu, 512, Wb + (size_t)br * 1024 * 512, 512, 512, rt * 128, ct * 128, smem);
      const float* e = epi_stage(acc, smem, wave, lane);
#pragma unroll
      for (int ps = 0; ps < 8; ++ps) {
        const int row = ps * 8 + (lane >> 3);
        float v[8], gg[8]; ld8(e + row * LDE + c8, v);
        unpack8(*(const u32x4*)(gate + (unsigned)(rb + row) * 2048u + (unsigned)(br * 1024 + cb + c8)), gg);
        bf16_t* mp = merged + (unsigned)(rb + row) * 1024u + (unsigned)(cb + c8);
#pragma unroll
        for (int j = 0; j < 8; ++j) v[j] *= gg[j];
        if (br == 1) {
          float old[8]; unpack8(*(const u32x4*)mp, old);
#pragma unroll
          for (int j = 0; j < 8; ++j) v[j] += old[j];
        }
        *(u32x4*)mp = pack8(v);
      }
    }
  }
}

DI void phase_outproj(const Params& p, char* smem) {
  char* ws = p.ws;
  const bf16_t* merged = (const bf16_t*)(ws + OFF_H);
  const bf16_t* Wo = (const bf16_t*)(ws + OFF_WOUT);
  const float* mod = (const float*)(ws + OFF_MOD);
  float* y = (float*)(ws + OFF_Y);
  const int lane = threadIdx.x & 63, wave = threadIdx.x >> 6;
  for (int tile = blockIdx.x; tile < 8 * (NTOK / 128); tile += gridDim.x) {
    const int rt = tile >> 3, ct = tile & 7;
    f32x16 acc[2][2]; zero_acc(acc);
    gemm_mainloop(acc, merged, 1024, Wo, 1024, 1024, rt * 128, ct * 128, smem);
    const int rb = rt * 128 + (wave >> 1) * 64, cb = ct * 128 + (wave & 1) * 64, b = rb >> 13, c8 = (lane & 7) * 8;
    const float* e = epi_stage(acc, smem, wave, lane);
    float gt[8]; ld8(mod + b * 6144 + 2048 + cb + c8, gt);
#pragma unroll
    for (int ps = 0; ps < 8; ++ps) {
      const int row = ps * 8 + (lane >> 3);
      float v[8], xv[8]; ld8(e + row * LDE + c8, v);
      const unsigned o = (unsigned)(rb + row) * 1024u + (unsigned)(cb + c8);
      ld8(p.x + o, xv);
      f32x4 o0, o1;
      o0.x = DN_ALPHA * xv[0] + gt[0] * v[0]; o0.y = DN_ALPHA * xv[1] + gt[1] * v[1]; o0.z = DN_ALPHA * xv[2] + gt[2] * v[2]; o0.w = DN_ALPHA * xv[3] + gt[3] * v[3];
      o1.x = DN_ALPHA * xv[4] + gt[4] * v[4]; o1.y = DN_ALPHA * xv[5] + gt[5] * v[5]; o1.z = DN_ALPHA * xv[6] + gt[6] * v[6]; o1.w = DN_ALPHA * xv[7] + gt[7] * v[7];
      *(f32x4*)(y + o) = o0; *(f32x4*)(y + o + 4) = o1;
    }
  }
}

DI void phase_compress(const Params& p, char* smem) {
  char* ws = p.ws;
  const int tid = threadIdx.x, lane = tid & 63, wave = tid >> 6, l31 = lane & 31, hh = lane >> 5;
  bf16_t* hid = (bf16_t*)smem;
  constexpr int LH = 136;
  for (int item = blockIdx.x; item < 256; item += gridDim.x) {
    const int w = item >> 7, R0 = (item & 127) * 64;
    const bf16_t* src = (const bf16_t*)(ws + (w == 0 ? OFF_KC : OFF_VC));
    const bf16_t* W1 = (const bf16_t*)(ws + OFF_CW1) + (size_t)w * 128 * 2048;
    const bf16_t* W2 = (const bf16_t*)(ws + OFF_CW2) + (size_t)w * 64 * 128;
    const float* posb = (const float*)(ws + OFF_POSB) + w * 128;
    const bf16_t* abase[2];
#pragma unroll
    for (int mi = 0; mi < 2; ++mi) {
      const int R = R0 + mi * 32 + l31, bg = R >> 9, n = R & 511, nn = n < 510 ? n : 510;
      abase[mi] = src + ((size_t)((bg >> 1) * SEQ + 16 * nn)) * 128 + (bg & 1) * 64 + hh * 8;
    }
    const bf16_t* bbase = W1 + (size_t)(wave * 32 + l31) * 2048 + hh * 8;
    f32x16 acc[2];
#pragma unroll
    for (int r = 0; r < 16; ++r) { acc[0][r] = 0.f; acc[1][r] = 0.f; }
#pragma unroll 8
    for (int ks = 0; ks < 128; ++ks) {
      const int aofs = (ks >> 2) * 128 + (ks & 3) * 16;
      const bf16x8 a0 = *(const bf16x8*)(abase[0] + aofs), a1 = *(const bf16x8*)(abase[1] + aofs);
      const bf16x8 bb = *(const bf16x8*)(bbase + ks * 16);
      acc[0] = MFMA32(a0, bb, acc[0]); acc[1] = MFMA32(a1, bb, acc[1]);
    }
    __syncthreads();
    {
      const float pb = posb[wave * 32 + l31];
#pragma unroll
      for (int mi = 0; mi < 2; ++mi)
#pragma unroll
        for (int r = 0; r < 16; ++r) {
          const int row = mi * 32 + (r & 3) + 8 * (r >> 2) + 4 * hh;
          hid[row * LH + wave * 32 + l31] = f2bf(gelu_f(acc[mi][r] + pb));
        }
    }
    __syncthreads();
    const int mi = wave >> 1, ni = wave & 1;
    f32x16 o;
#pragma unroll
    for (int r = 0; r < 16; ++r) o[r] = 0.f;
#pragma unroll
    for (int ks = 0; ks < 8; ++ks) {
      const bf16x8 a = *(const bf16x8*)(hid + (mi * 32 + l31) * LH + ks * 16 + hh * 8);
      const bf16x8 bb = *(const bf16x8*)(W2 + (size_t)(ni * 32 + l31) * 128 + ks * 16 + hh * 8);
      o = MFMA32(a, bb, o);
    }
    const int d = ni * 32 + l31;
    const float b2 = p.cmp_b2[w * 64 + d];
    const int bg = R0 >> 9;
    if (w == 0) {
      bf16_t* kc = (bf16_t*)(ws + OFF_KCMP);
#pragma unroll
      for (int r = 0; r < 16; ++r) {
        const int n = (R0 & 511) + mi * 32 + (r & 3) + 8 * (r >> 2) + 4 * hh;
        kc[((size_t)bg * 512 + n) * 64 + d] = f2bf(n < 511 ? o[r] + b2 : 0.f);
      }
    } else {
      bf16_t* vc = (bf16_t*)(ws + OFF_VCMPT);
#pragma unroll
      for (int q = 0; q < 4; ++q) {
        const int n = (R0 & 511) + mi * 32 + 8 * q + 4 * hh;
        float v0 = o[4 * q] + b2, v1 = o[4 * q + 1] + b2, v2 = o[4 * q + 2] + b2, v3 = o[4 * q + 3] + b2;
        if (n + 3 >= 511) v3 = 0.f;
        u32x2 wv; wv.x = pack2(v0, v1); wv.y = pack2(v2, v3);
        *(u32x2*)(vc + ((size_t)bg * 64 + d) * 512 + n) = wv;
      }
    }
  }
}

constexpr int LK = 72;
constexpr int LVT = 68;
constexpr int NSA_KS = 0, NSA_VS = 9216, NSA_AIMP = 17920, NSA_CIMP = NSA_AIMP + 16384, NSA_SELM = NSA_CIMP + 16384;
struct TileRegs { u32x4 k[2]; u32x4 v[2]; };

DI void nsa_load_tile(TileRegs& t, const bf16_t* kbase, size_t kstride, const bf16_t* vtbase, size_t vstride) {
  const int tid = threadIdx.x;
#pragma unroll
  for (int i = 0; i < 2; ++i) {
    const int idx = tid + i * 256, r = idx >> 3, ch = idx & 7;
    t.k[i] = *(const u32x4*)(kbase + (size_t)r * kstride + ch * 8);
    t.v[i] = *(const u32x4*)(vtbase + (size_t)r * vstride + ch * 8);
  }
}
DI void nsa_store_tile(const TileRegs& t, char* smem) {
  const int tid = threadIdx.x;
  bf16_t* Ks = (bf16_t*)(smem + NSA_KS); bf16_t* Vs = (bf16_t*)(smem + NSA_VS);
#pragma unroll
  for (int i = 0; i < 2; ++i) {
    const int idx = tid + i * 256, r = idx >> 3, ch = idx & 7;
    *(u32x4*)(Ks + r * LK + ch * 8) = t.k[i];
    u32x2 lo, hi; lo.x = t.v[i].x; lo.y = t.v[i].y; hi.x = t.v[i].z; hi.y = t.v[i].w;
    *(u32x2*)(Vs + r * LVT + ch * 8) = lo; *(u32x2*)(Vs + r * LVT + ch * 8 + 4) = hi;
  }
}
DI void nsa_scores(f32x16 (&st)[2], const char* smem, const bf16x8 (&qf)[4], int lane) {
  const bf16_t* Ks = (const bf16_t*)(smem + NSA_KS);
#pragma unroll
  for (int kt = 0; kt < 2; ++kt) {
#pragma unroll
    for (int r = 0; r < 16; ++r) st[kt][r] = 0.f;
#pragma unroll
    for (int ks = 0; ks < 4; ++ks) {
      const bf16x8 a = *(const bf16x8*)(Ks + (kt * 32 + (lane & 31)) * LK + ks * 16 + (lane >> 5) * 8);
      st[kt] = MFMA32(a, qf[ks], st[kt]);
    }
  }
}
DI void nsa_pv(f32x16 (&o)[2], const f32x16 (&pt)[2], const char* smem, int lane) {
  const bf16_t* Vs = (const bf16_t*)(smem + NSA_VS);
#pragma unroll
  for (int kt = 0; kt < 2; ++kt)
#pragma unroll
    for (int s = 0; s < 2; ++s) {
      u32x4 pk; pk.x = pack2(pt[kt][8 * s], pt[kt][8 * s + 1]); pk.y = pack2(pt[kt][8 * s + 2], pt[kt][8 * s + 3]);
      pk.z = pack2(pt[kt][8 * s + 4], pt[kt][8 * s + 5]); pk.w = pack2(pt[kt][8 * s + 6], pt[kt][8 * s + 7]);
      const bf16x8 pb = __builtin_bit_cast(bf16x8, pk);
#pragma unroll
      for (int dt = 0; dt < 2; ++dt) {
        const bf16_t* vp = Vs + (dt * 32 + (lane & 31)) * LVT + kt * 32 + 16 * s + 4 * (lane >> 5);
        const s16x4 lo = *(const s16x4*)vp, hi = *(const s16x4*)(vp + 8);
        const bf16x8 a = __builtin_shufflevector(lo, hi, 0, 1, 2, 3, 4, 5, 6, 7);
        o[dt] = MFMA32(a, pb, o[dt]);
      }
    }
}

struct NsaLane {
  bf16x8 qf[4];
  int t;
  int hh;
  unsigned selw[4];
};

DI void nsa_online(f32x16 (&st)[2], unsigned vm0, unsigned vm1, float& m, float& l, f32x16 (&o)[2], const char* smem, int lane) {
  float mx = -1e30f;
#pragma unroll
  for (int r = 0; r < 16; ++r) { if ((vm0 >> r) & 1u) mx = fmaxf(mx, st[0][r]); if ((vm1 >> r) & 1u) mx = fmaxf(mx, st[1][r]); }
  mx = fmaxf(mx, __shfl_xor(mx, 32));
  const float mn = fmaxf(m, mx);
  const float alpha = __expf(m - mn);
  m = mn;
  float sum = 0.f;
#pragma unroll
  for (int r = 0; r < 16; ++r) {
    const float p0 = ((vm0 >> r) & 1u) ? __expf(st[0][r] - mn) : 0.f;
    const float p1 = ((vm1 >> r) & 1u) ? __expf(st[1][r] - mn) : 0.f;
    st[0][r] = p0; st[1][r] = p1; sum += p0 + p1;
  }
  l = l * alpha + sum;
#pragma unroll
  for (int r = 0; r < 16; ++r) { o[0][r] *= alpha; o[1][r] *= alpha; }
  nsa_pv(o, st, smem, lane);
}

struct NsaItem { int qb, b, g, bg, t; size_t tokrow; };
DI NsaItem nsa_item(int item, int wave, int qi) {
  NsaItem it; it.qb = 127 - (item >> 5); const int rest = item & 31; it.b = rest >> 2; it.g = (rest >> 1) & 1; const int half = rest & 1;
  it.bg = it.b * 2 + it.g; it.t = it.qb * 64 + half * 32 + wave * 8 + qi; it.tokrow = (size_t)it.b * SEQ + it.t; return it;
}
DI void nsa_accum_store(bf16_t* dst, const f32x16 (&o)[2], float sc, bool first, int hh) {
#pragma unroll
  for (int dt = 0; dt < 2; ++dt)
#pragma unroll
    for (int q4 = 0; q4 < 4; ++q4) {
      u32x2* pp = (u32x2*)(dst + dt * 32 + 8 * q4 + 4 * hh);
      float a0 = sc * o[dt][4 * q4], a1 = sc * o[dt][4 * q4 + 1], a2 = sc * o[dt][4 * q4 + 2], a3 = sc * o[dt][4 * q4 + 3];
      if (!first) { const u32x2 old = *pp; a0 += bflo(old.x); a1 += bfhi(old.x); a2 += bflo(old.y); a3 += bfhi(old.y); }
      u32x2 wv; wv.x = pack2(a0, a1); wv.y = pack2(a2, a3);
      *pp = wv;
    }
}

DI void phase_nsa(const Params& p, char* smem, int branch_mask) {
  char* ws = p.ws;
  const int tid = threadIdx.x, lane = tid & 63, wave = tid >> 6, hh = lane >> 5, c = lane & 31, qi = c >> 2, r4 = c & 3;
  const bf16_t* Q = (const bf16_t*)(ws + OFF_Q);
  const float* gsig = (const float*)(ws + OFF_GSIG);
  bf16_t* ONSA = (bf16_t*)(ws + OFF_ONSA);
  u32x4* SELG = (u32x4*)(ws + OFF_SELG);

  {
    const bf16_t* KCMP = (const bf16_t*)(ws + OFF_KCMP); const bf16_t* VCMPT = (const bf16_t*)(ws + OFF_VCMPT);
    float* Aimp = (float*)(smem + NSA_AIMP) + wave * 1024;
    float* Cimp = (float*)(smem + NSA_CIMP) + wave * 1024;
    unsigned short* selm16 = (unsigned short*)(smem + NSA_SELM) + wave * 64;
    const u32x4* selm128 = (const u32x4*)(smem + NSA_SELM) + wave * 8;
    for (int item = blockIdx.x; item < 4096; item += gridDim.x) {
      const NsaItem it = nsa_item(item, wave, qi);
      const int t = it.t;
      const int tmaxb = it.qb * 64 + ((item & 1) * 32) + 31;
      bf16x8 qf[4];
#pragma unroll
      for (int ks = 0; ks < 4; ++ks) qf[ks] = *(const bf16x8*)(Q + it.tokrow * 512 + (it.g * 4 + r4) * 64 + ks * 16 + hh * 8);
      const float g_c = gsig[it.tokrow * 32 + (it.g * 4 + r4) * 3 + 0];
      TileRegs tr;
      const int nmax = (tmaxb - 31) >> 4;
      const int ntile = (tmaxb >= 31) ? (nmax >> 6) + 1 : 0;
      const bf16_t* kb = KCMP + (size_t)it.bg * 512 * 64;
      const bf16_t* vb = VCMPT + (size_t)it.bg * 64 * 512;
      float m = -1e30f, l = 0.f;
      __syncthreads();
      for (int i = lane; i < 1024; i += 64) { Aimp[i] = 0.f; Cimp[i] = 0.f; }
      if (ntile > 0) nsa_load_tile(tr, kb, 64, vb, 512);
      for (int j = 0; j < ntile; ++j) {
        __syncthreads();
        nsa_store_tile(tr, smem);
        __syncthreads();
        if (j + 1 < ntile) nsa_load_tile(tr, kb + (size_t)(j + 1) * 64 * 64, 64, vb + (j + 1) * 64, 512);
        f32x16 st[2];
        nsa_scores(st, smem, qf, lane);
        float mx = -1e30f;
#pragma unroll
        for (int kt = 0; kt < 2; ++kt)
#pragma unroll
          for (int r = 0; r < 16; ++r) {
            const int n = j * 64 + kt * 32 + (r & 3) + 8 * (r >> 2) + 4 * hh;
            if (16 * n + 31 <= t) mx = fmaxf(mx, st[kt][r]);
          }
        mx = fmaxf(mx, __shfl_xor(mx, 32));
        const float mn = fmaxf(m, mx);
        float sum = 0.f;
#pragma unroll
        for (int kt = 0; kt < 2; ++kt)
#pragma unroll
          for (int r = 0; r < 16; ++r) {
            const int n = j * 64 + kt * 32 + (r & 3) + 8 * (r >> 2) + 4 * hh;
            if (16 * n + 31 <= t) sum += __expf(st[kt][r] - mn);
          }
        l = l * __expf(m - mn) + sum;
        m = mn;
      }
      l += __shfl_xor(l, 32);
      const float inv_l = l > 0.f ? 1.0f / l : 0.f;
      f32x16 o[2];
#pragma unroll
      for (int r = 0; r < 16; ++r) { o[0][r] = 0.f; o[1][r] = 0.f; }
      if (ntile > 0) nsa_load_tile(tr, kb, 64, vb, 512);
      for (int j = 0; j < ntile; ++j) {
        __syncthreads();
        nsa_store_tile(tr, smem);
        __syncthreads();
        if (j + 1 < ntile) nsa_load_tile(tr, kb + (size_t)(j + 1) * 64 * 64, 64, vb + (j + 1) * 64, 512);
        f32x16 st[2];
        nsa_scores(st, smem, qf, lane);
#pragma unroll
        for (int kt = 0; kt < 2; ++kt)
#pragma unroll
          for (int r = 0; r < 16; ++r) {
            const int n = j * 64 + kt * 32 + (r & 3) + 8 * (r >> 2) + 4 * hh;
            st[kt][r] = (16 * n + 31 <= t) ? __expf(st[kt][r] - m) * inv_l : 0.f;
          }
#pragma unroll
        for (int kt = 0; kt < 2; ++kt)
#pragma unroll
          for (int c4 = 0; c4 < 4; ++c4) {
            float carry = 0.5f * st[kt][4 * c4 + 3];
            float full = st[kt][4 * c4] + st[kt][4 * c4 + 1] + st[kt][4 * c4 + 2] + carry;
            full += __shfl_xor(full, 1); full += __shfl_xor(full, 2);
            carry += __shfl_xor(carry, 1); carry += __shfl_xor(carry, 2);
            const int jb = j * 16 + kt * 8 + 2 * c4 + hh;
            if (r4 == 0) { Aimp[qi * 128 + jb] = full; Cimp[qi * 128 + jb] = carry; }
          }
        if (branch_mask & 1) nsa_pv(o, st, smem, lane);
      }
      nsa_accum_store(ONSA + it.tokrow * 512 + (it.g * 4 + r4) * 64, o, (branch_mask & 1) ? g_c : 0.f, true, hh);
      __syncthreads();
      const int cur = it.qb;
      if (cur <= 15) {
        if (lane < 8) { selm16[lane * 8 + 0] = (unsigned short)((2u << cur) - 1u);
#pragma unroll
          for (int k = 1; k < 8; ++k) selm16[lane * 8 + k] = 0; }
      } else {
        const int qs = lane >> 3, sub = lane & 7;
        float v[16];
#pragma unroll
        for (int i = 0; i < 16; ++i) {
          const int jj = sub * 16 + i;
          const bool ok = (jj >= 1) && (jj <= cur - 2);
          const int jm = jj >= 1 ? jj - 1 : 0;
          v[i] = ok ? (Aimp[qs * 128 + jj] + Cimp[qs * 128 + jm]) : -3e38f;
        }
        unsigned bits = 0;
        for (int itn = 0; itn < 13; ++itn) {
          float bv = v[0]; int bi = 0;
#pragma unroll
          for (int i = 1; i < 16; ++i) if (v[i] > bv) { bv = v[i]; bi = i; }
          int bj = sub * 16 + bi;
#pragma unroll
          for (int o2 = 1; o2 < 8; o2 <<= 1) {
            const float ov = __shfl_xor(bv, o2); const int oj = __shfl_xor(bj, o2);
            if (ov > bv || (ov == bv && oj < bj)) { bv = ov; bj = oj; }
          }
          if ((bj >> 4) == sub) {
            const int i2 = bj & 15;
#pragma unroll
            for (int i = 0; i < 16; ++i) if (i == i2) v[i] = -3e38f;
            bits |= 1u << i2;
          }
        }
        if (sub == 0) bits |= 1u;
        if ((cur >> 4) == sub) bits |= 1u << (cur & 15);
        if (((cur - 1) >> 4) == sub) bits |= 1u << ((cur - 1) & 15);
        selm16[qs * 8 + sub] = (unsigned short)bits;
      }
      __syncthreads();
      if (r4 == 0 && hh == 0) SELG[(size_t)it.bg * SEQ + t] = selm128[qi];
    }
  }
  __threadfence_block();
  __syncthreads();

  if (branch_mask & 2) {
    const bf16_t* KS = (const bf16_t*)(ws + OFF_KS); const bf16_t* VST = (const bf16_t*)(ws + OFF_VST);
    for (int item = blockIdx.x; item < 4096; item += gridDim.x) {
      const NsaItem it = nsa_item(item, wave, qi);
      const int t = it.t, qb = it.qb;
      bf16x8 qf[4];
#pragma unroll
      for (int ks = 0; ks < 4; ++ks) qf[ks] = *(const bf16x8*)(Q + it.tokrow * 512 + (it.g * 4 + r4) * 64 + ks * 16 + hh * 8);
      const float g_s = gsig[it.tokrow * 32 + (it.g * 4 + r4) * 3 + 1];
      const u32x4 selw = SELG[(size_t)it.bg * SEQ + t];
      TileRegs tr;
      const bf16_t* kb = KS + (size_t)it.b * SEQ * 128 + it.g * 64;
      const bf16_t* vb = VST + (size_t)it.bg * 64 * SEQ;
      float m = -1e30f, l = 0.f;
      f32x16 o[2];
#pragma unroll
      for (int r = 0; r < 16; ++r) { o[0][r] = 0.f; o[1][r] = 0.f; }
      nsa_load_tile(tr, kb, 128, vb, SEQ);
      for (int j = 0; j <= qb; ++j) {
        __syncthreads();
        nsa_store_tile(tr, smem);
        __syncthreads();
        if (j + 1 <= qb) nsa_load_tile(tr, kb + (size_t)(j + 1) * 64 * 128, 128, vb + (j + 1) * 64, SEQ);
        const unsigned w = j < 32 ? selw.x : (j < 64 ? selw.y : (j < 96 ? selw.z : selw.w));
        const bool sel = (w >> (j & 31)) & 1u;
        if (__any(sel)) {
          f32x16 st[2];
          nsa_scores(st, smem, qf, lane);
          unsigned vm0 = 0, vm1 = 0;
#pragma unroll
          for (int r = 0; r < 16; ++r) {
            const int k0 = j * 64 + (r & 3) + 8 * (r >> 2) + 4 * hh;
            if (sel && k0 <= t) vm0 |= 1u << r;
            if (sel && k0 + 32 <= t) vm1 |= 1u << r;
          }
          nsa_online(st, vm0, vm1, m, l, o, smem, lane);
        }
      }
      l += __shfl_xor(l, 32);
      nsa_accum_store(ONSA + it.tokrow * 512 + (it.g * 4 + r4) * 64, o, l > 0.f ? g_s / l : 0.f, false, hh);
    }
  }

  if (branch_mask & 4) {
    const bf16_t* KW = (const bf16_t*)(ws + OFF_KW); const bf16_t* VWT = (const bf16_t*)(ws + OFF_VWT);
    for (int item = blockIdx.x; item < 4096; item += gridDim.x) {
      const NsaItem it = nsa_item(item, wave, qi);
      const int t = it.t, qb = it.qb;
      bf16x8 qf[4];
#pragma unroll
      for (int ks = 0; ks < 4; ++ks) qf[ks] = *(const bf16x8*)(Q + it.tokrow * 512 + (it.g * 4 + r4) * 64 + ks * 16 + hh * 8);
      const float g_w = gsig[it.tokrow * 32 + (it.g * 4 + r4) * 3 + 2];
      TileRegs tr;
      const bf16_t* kb = KW + (size_t)it.b * SEQ * 128 + it.g * 64;
      const bf16_t* vb = VWT + (size_t)it.bg * 64 * SEQ;
      float m = -1e30f, l = 0.f;
      f32x16 o[2];
#pragma unroll
      for (int r = 0; r < 16; ++r) { o[0][r] = 0.f; o[1][r] = 0.f; }
      const int j0 = qb >= 8 ? qb - 8 : 0;
      nsa_load_tile(tr, kb + (size_t)j0 * 64 * 128, 128, vb + j0 * 64, SEQ);
      for (int j = j0; j <= qb; ++j) {
        __syncthreads();
        nsa_store_tile(tr, smem);
        __syncthreads();
        if (j + 1 <= qb) nsa_load_tile(tr, kb + (size_t)(j + 1) * 64 * 128, 128, vb + (j + 1) * 64, SEQ);
        f32x16 st[2];
        nsa_scores(st, smem, qf, lane);
        unsigned vm0 = 0, vm1 = 0;
#pragma unroll
        for (int r = 0; r < 16; ++r) {
          const int k0 = j * 64 + (r & 3) + 8 * (r >> 2) + 4 * hh;
          if (k0 <= t && t - k0 < 512) vm0 |= 1u << r;
          if (k0 + 32 <= t && t - (k0 + 32) < 512) vm1 |= 1u << r;
        }
        nsa_online(st, vm0, vm1, m, l, o, smem, lane);
      }
      l += __shfl_xor(l, 32);
      nsa_accum_store(ONSA + it.tokrow * 512 + (it.g * 4 + r4) * 64, o, l > 0.f ? g_w / l : 0.f, false, hh);
    }
  }
}

DI void phase_peerq(const Params& p, char* smem) {
  char* ws = p.ws;
  const bf16_t* h2 = (const bf16_t*)(ws + OFF_H);
  const bf16_t* Wq = (const bf16_t*)(ws + OFF_WQ);
  bf16_t* pq = (bf16_t*)(ws + OFF_PQ);
  const int lane = threadIdx.x & 63, wave = threadIdx.x >> 6;
  for (int tile = blockIdx.x; tile < 16 * (NTOK / 128); tile += gridDim.x) {
    const int rt = tile >> 4, ct = tile & 15;
    f32x16 acc[2][2]; zero_acc(acc);
    gemm_mainloop(acc, h2, 1024, Wq, 1024, 1024, rt * 128, ct * 128, smem);
    const float* e = epi_stage(acc, smem, wave, lane);
    epi_plain<0>(e, pq, 2048, ct * 128 + (wave & 1) * 64, rt * 128 + (wave >> 1) * 64, lane, nullptr);
  }
}

DI void argmax16(float& bv, int& bk) {
#pragma unroll
  for (int o = 1; o < 16; o <<= 1) {
    const float ov = __shfl_xor(bv, o); const int ok = __shfl_xor(bk, o);
    if (ov > bv || (ov == bv && ok < bk)) { bv = ov; bk = ok; }
  }
}
DI void phase_route(const Params& p, char* smem) {
  char* ws = p.ws;
  const int tid = threadIdx.x, lane = tid & 63, wave = tid >> 6, l31 = lane & 31, hh = lane >> 5;
  const bf16_t* pq = (const bf16_t*)(ws + OFF_PQ);
  const bf16_t* pk = (const bf16_t*)(ws + OFF_PKEYS);
  int* eidx = (int*)(ws + OFF_EIDX);
  float* pgate = (float*)(ws + OFF_PGATE);
  float* S = (float*)smem;
  constexpr int LS = 132;
  for (int item = blockIdx.x; item < (NTOK / 32) * 8; item += gridDim.x) {
    const int h = item & 7, t0 = (item >> 3) * 32;
    __syncthreads();
#pragma unroll
    for (int c = 0; c < 2; ++c) {
      f32x16 acc;
#pragma unroll
      for (int r = 0; r < 16; ++r) acc[r] = 0.f;
      const bf16_t* ap = pq + (size_t)(t0 + l31) * 2048 + h * 256 + c * 128 + hh * 8;
      const bf16_t* bp = pk + ((size_t)(h * 2 + c) * 128 + wave * 32 + l31) * 128 + hh * 8;
#pragma unroll
      for (int ks = 0; ks < 8; ++ks) {
        const bf16x8 a = *(const bf16x8*)(ap + ks * 16), bb = *(const bf16x8*)(bp + ks * 16);
        acc = MFMA32(a, bb, acc);
      }
#pragma unroll
      for (int r = 0; r < 16; ++r) S[(c * 32 + (r & 3) + 8 * (r >> 2) + 4 * hh) * LS + wave * 32 + l31] = acc[r];
    }
    __syncthreads();
    const int gid = tid >> 4, li = tid & 15;
#pragma unroll 1
    for (int rd = 0; rd < 2; ++rd) {
      const int tok = rd * 16 + gid;
      float sv[2]; int si[2];
#pragma unroll
      for (int c = 0; c < 2; ++c) {
        float v[8];
#pragma unroll
        for (int i = 0; i < 8; ++i) v[i] = S[(c * 32 + tok) * LS + li + 16 * i];
        float rs = 0.f; int rn = 0;
        for (int it = 0; it < 16; ++it) {
          float bv = v[0]; int bi = 0;
#pragma unroll
          for (int i = 1; i < 8; ++i) if (v[i] > bv) { bv = v[i]; bi = i; }
          int bn = li + 16 * bi;
          argmax16(bv, bn);
          if ((bn & 15) == li) {
            const int i2 = bn >> 4;
#pragma unroll
            for (int i = 0; i < 8; ++i) if (i == i2) v[i] = -3e38f;
          }
          if (li == it) { rs = bv; rn = bn; }
        }
        sv[c] = rs; si[c] = rn;
      }
      int pp = 0; float ts = 0.f; int tf = 0;
      for (int it = 0; it < 16; ++it) {
        const float s2p = __shfl(sv[1], pp & 15, 16);
        float bv = (pp < 16) ? sv[0] + s2p : -3e38f;
        int bf = li * 16 + pp;
        argmax16(bv, bf);
        if ((bf >> 4) == li) ++pp;
        if (li == it) { ts = bv; tf = bf; }
      }
      const int e1 = __shfl(si[0], tf >> 4, 16), e2 = __shfl(si[1], tf & 15, 16);
      const float mx = __shfl(ts, 0, 16);
      const float ex = __expf(ts - mx);
      float sum = ex;
#pragma unroll
      for (int o = 1; o < 16; o <<= 1) sum += __shfl_xor(sum, o);
      const size_t oidx = ((size_t)(t0 + tok) * 8 + h) * 16 + li;
      eidx[oidx] = e1 * 128 + e2;
      pgate[oidx] = ex / sum;
    }
  }
}

DI float dot16_fp8(const u32x4 raw, const float (&hx)[16]) {
  const f32x2 a0 = __builtin_amdgcn_cvt_pk_f32_fp8((int)raw.x, false), a1 = __builtin_amdgcn_cvt_pk_f32_fp8((int)raw.x, true);
  const f32x2 b0 = __builtin_amdgcn_cvt_pk_f32_fp8((int)raw.y, false), b1 = __builtin_amdgcn_cvt_pk_f32_fp8((int)raw.y, true);
  const f32x2 c0 = __builtin_amdgcn_cvt_pk_f32_fp8((int)raw.z, false), c1 = __builtin_amdgcn_cvt_pk_f32_fp8((int)raw.z, true);
  const f32x2 d0 = __builtin_amdgcn_cvt_pk_f32_fp8((int)raw.w, false), d1 = __builtin_amdgcn_cvt_pk_f32_fp8((int)raw.w, true);
  float d = hx[0] * a0.x + hx[1] * a0.y + hx[2] * a1.x + hx[3] * a1.y;
  d += hx[4] * b0.x + hx[5] * b0.y + hx[6] * b1.x + hx[7] * b1.y;
  d += hx[8] * c0.x + hx[9] * c0.y + hx[10] * c1.x + hx[11] * c1.y;
  d += hx[12] * d0.x + hx[13] * d0.y + hx[14] * d1.x + hx[15] * d1.y;
  return d;
}
struct FfnMeta { int ev0, ev1; float gv0, gv1; u32x4 ha, hc; };
DI void ffn_u_meta(FfnMeta& m, const int* eidx, const float* pgate, const bf16_t* h2, int t, int lane) {
  m.ev0 = eidx[(size_t)t * 128 + lane]; m.ev1 = eidx[(size_t)t * 128 + 64 + lane];
  m.gv0 = pgate[(size_t)t * 128 + lane]; m.gv1 = pgate[(size_t)t * 128 + 64 + lane];
  m.ha = *(const u32x4*)(h2 + (size_t)t * DM + lane * 16); m.hc = *(const u32x4*)(h2 + (size_t)t * DM + lane * 16 + 8);
}
DI void phase_ffn_u(const Params& p) {
  char* ws = p.ws;
  const int lane = threadIdx.x & 63, wave = threadIdx.x >> 6;
  const int sl = blockIdx.x & 7, wslot = (blockIdx.x >> 3) * 4 + wave, nw = (gridDim.x >> 3) * 4;
  const bf16_t* h2 = (const bf16_t*)(ws + OFF_H);
  const unsigned char* PU8 = (const unsigned char*)(ws + OFF_PU8) + lane * 16;
  const float* scu = (const float*)(ws + OFF_SCU);
  const int* eidx = (const int*)(ws + OFF_EIDX);
  const float* pgate = (const float*)(ws + OFF_PGATE);
  float* wbuf = (float*)(ws + OFF_WBUF);
  const int myslot = lane >> 1;
  FfnMeta cur, nxt;
  if (wslot < NTOK) ffn_u_meta(cur, eidx, pgate, h2, wslot, lane);
  for (int t = wslot; t < NTOK; t += nw) {
    if (t + nw < NTOK) ffn_u_meta(nxt, eidx, pgate, h2, t + nw, lane);
    const bool in0 = (cur.ev0 >> 11) == sl, in1 = (cur.ev1 >> 11) == sl;
    unsigned long long ma = __ballot(in0), mb = __ballot(in1);
    const int cnt = __builtin_popcountll(ma) + __builtin_popcountll(mb);
    float hx[16];
    hx[0] = bflo(cur.ha.x); hx[1] = bfhi(cur.ha.x); hx[2] = bflo(cur.ha.y); hx[3] = bfhi(cur.ha.y); hx[4] = bflo(cur.ha.z); hx[5] = bfhi(cur.ha.z); hx[6] = bflo(cur.ha.w); hx[7] = bfhi(cur.ha.w);
    hx[8] = bflo(cur.hc.x); hx[9] = bfhi(cur.hc.x); hx[10] = bflo(cur.hc.y); hx[11] = bfhi(cur.hc.y); hx[12] = bflo(cur.hc.z); hx[13] = bfhi(cur.hc.z); hx[14] = bflo(cur.hc.w); hx[15] = bfhi(cur.hc.w);
    int my_e = 0, my_j = 0;
#define FFN_LD(k) u32x4 raw##k = {0u, 0u, 0u, 0u}; if (k < cnt) { int jpos; \
      if (ma) { jpos = (int)__builtin_ctzll(ma); ma &= ma - 1; } else { jpos = 64 + (int)__builtin_ctzll(mb); mb &= mb - 1; } \
      const int e = __builtin_amdgcn_readlane(jpos < 64 ? cur.ev0 : cur.ev1, jpos & 63); \
      raw##k = *(const u32x4*)(PU8 + (size_t)e * 1024); \
      if (myslot == k) { my_e = e; my_j = jpos; } }
#define FOR8(M, o) M(o) M(o + 1) M(o + 2) M(o + 3) M(o + 4) M(o + 5) M(o + 6) M(o + 7)
#define FFN_LD0(i) FFN_LD(i)
    FFN_LD(0) FFN_LD(1) FFN_LD(2) FFN_LD(3) FFN_LD(4) FFN_LD(5) FFN_LD(6) FFN_LD(7)
    FFN_LD(8) FFN_LD(9) FFN_LD(10) FFN_LD(11) FFN_LD(12) FFN_LD(13) FFN_LD(14) FFN_LD(15)
    FFN_LD(16) FFN_LD(17) FFN_LD(18) FFN_LD(19) FFN_LD(20) FFN_LD(21) FFN_LD(22) FFN_LD(23)
    FFN_LD(24) FFN_LD(25) FFN_LD(26) FFN_LD(27) FFN_LD(28) FFN_LD(29) FFN_LD(30) FFN_LD(31)
    float d[32];
#define FFN_DOT(k) d[k] = dot16_fp8(raw##k, hx);
#define FFN_Z(k) d[k] = 0.f;
    FFN_DOT(0) FFN_DOT(1) FFN_DOT(2) FFN_DOT(3) FFN_DOT(4) FFN_DOT(5) FFN_DOT(6) FFN_DOT(7)
    if (cnt > 8) { FFN_DOT(8) FFN_DOT(9) FFN_DOT(10) FFN_DOT(11) FFN_DOT(12) FFN_DOT(13) FFN_DOT(14) FFN_DOT(15) }
    else { FFN_Z(8) FFN_Z(9) FFN_Z(10) FFN_Z(11) FFN_Z(12) FFN_Z(13) FFN_Z(14) FFN_Z(15) }
    if (cnt > 16) { FFN_DOT(16) FFN_DOT(17) FFN_DOT(18) FFN_DOT(19) FFN_DOT(20) FFN_DOT(21) FFN_DOT(22) FFN_DOT(23) }
    else { FFN_Z(16) FFN_Z(17) FFN_Z(18) FFN_Z(19) FFN_Z(20) FFN_Z(21) FFN_Z(22) FFN_Z(23) }
    if (cnt > 24) { FFN_DOT(24) FFN_DOT(25) FFN_DOT(26) FFN_DOT(27) FFN_DOT(28) FFN_DOT(29) FFN_DOT(30) FFN_DOT(31) }
    else { FFN_Z(24) FFN_Z(25) FFN_Z(26) FFN_Z(27) FFN_Z(28) FFN_Z(29) FFN_Z(30) FFN_Z(31) }
    float r16[16], r8[8], r4[4], r2[2];
    {
      const bool hi = lane & 32;
#pragma unroll
      for (int i = 0; i < 16; ++i) { const float keep = hi ? d[16 + i] : d[i], send = hi ? d[i] : d[16 + i]; r16[i] = keep + __shfl_xor(send, 32); }
    }
    {
      const bool hi = lane & 16;
#pragma unroll
      for (int i = 0; i < 8; ++i) { const float keep = hi ? r16[8 + i] : r16[i], send = hi ? r16[i] : r16[8 + i]; r8[i] = keep + __shfl_xor(send, 16); }
    }
    {
      const bool hi = lane & 8;
#pragma unroll
      for (int i = 0; i < 4; ++i) { const float keep = hi ? r8[4 + i] : r8[i], send = hi ? r8[i] : r8[4 + i]; r4[i] = keep + __shfl_xor(send, 8); }
    }
    {
      const bool hi = lane & 4;
#pragma unroll
      for (int i = 0; i < 2; ++i) { const float keep = hi ? r4[2 + i] : r4[i], send = hi ? r4[i] : r4[2 + i]; r2[i] = keep + __shfl_xor(send, 4); }
    }
    float tot;
    {
      const bool hi = lane & 2;
      const float keep = hi ? r2[1] : r2[0], send = hi ? r2[0] : r2[1];
      tot = keep + __shfl_xor(send, 2);
    }
    tot += __shfl_xor(tot, 1);
    if (myslot < cnt && !(lane & 1)) {
      const float act = tot * scu[my_e];
      const float gt = pgate[(size_t)t * 128 + my_j];
      wbuf[(size_t)t * 128 + my_j] = gt * gelu_f(act);
    }
    while (ma | mb) {
      int jpos;
      if (ma) { jpos = (int)__builtin_ctzll(ma); ma &= ma - 1; } else { jpos = 64 + (int)__builtin_ctzll(mb); mb &= mb - 1; }
      const int e = __builtin_amdgcn_readlane(jpos < 64 ? cur.ev0 : cur.ev1, jpos & 63);
      const u32x4 r1 = *(const u32x4*)(PU8 + (size_t)e * 1024);
      const float act = wave_sum(dot16_fp8(r1, hx)) * scu[e];
      const float gt = __int_as_float(__builtin_amdgcn_readlane(__float_as_int(jpos < 64 ? cur.gv0 : cur.gv1), jpos & 63));
      if (lane == 0) wbuf[(size_t)t * 128 + jpos] = gt * gelu_f(act);
    }
    cur = nxt;
  }
}
DI void phase_ffn_v(const Params& p) {
  char* ws = p.ws;
  const int lane = threadIdx.x & 63, wave = threadIdx.x >> 6, ps = lane >> 4, dc = lane & 15;
  const int sl = blockIdx.x & 7, wslot = (blockIdx.x >> 3) * 4 + wave, nw = (gridDim.x >> 3) * 4;
  const unsigned char* PV8 = (const unsigned char*)(ws + OFF_PV8) + (size_t)sl * 16384 * 128 + dc * 8;
  const float* scv = (const float*)(ws + OFF_SCV);
  const int* eidx = (const int*)(ws + OFF_EIDX);
  const float* wbuf = (const float*)(ws + OFF_WBUF);
  bf16_t* ffnb = (bf16_t*)(ws + OFF_FFNB);
  int ev0 = 0, ev1 = 0, nev0 = 0, nev1 = 0; float wr0 = 0.f, wr1 = 0.f, nwr0 = 0.f, nwr1 = 0.f;
  if (wslot < NTOK) { ev0 = eidx[(size_t)wslot * 128 + lane]; ev1 = eidx[(size_t)wslot * 128 + 64 + lane]; wr0 = wbuf[(size_t)wslot * 128 + lane]; wr1 = wbuf[(size_t)wslot * 128 + 64 + lane]; }
  for (int t = wslot; t < NTOK; t += nw) {
    if (t + nw < NTOK) { const size_t o = (size_t)(t + nw) * 128; nev0 = eidx[o + lane]; nev1 = eidx[o + 64 + lane]; nwr0 = wbuf[o + lane]; nwr1 = wbuf[o + 64 + lane]; }
    const float w0 = wr0 * scv[ev0], w1 = wr1 * scv[ev1];
#define FFV_LD(it) const u32x2 rv##it = *(const u32x2*)(PV8 + (size_t)__shfl((it) < 16 ? ev0 : ev1, ((it) & 15) * 4 + ps) * 128);
#define FFV_CP(it) { const float wj = __shfl((it) < 16 ? w0 : w1, ((it) & 15) * 4 + ps); \
      const f32x2 a0 = __builtin_amdgcn_cvt_pk_f32_fp8((int)rv##it.x, false), a1 = __builtin_amdgcn_cvt_pk_f32_fp8((int)rv##it.x, true); \
      const f32x2 b0 = __builtin_amdgcn_cvt_pk_f32_fp8((int)rv##it.y, false), b1 = __builtin_amdgcn_cvt_pk_f32_fp8((int)rv##it.y, true); \
      acc[0] += wj * a0.x; acc[1] += wj * a0.y; acc[2] += wj * a1.x; acc[3] += wj * a1.y; \
      acc[4] += wj * b0.x; acc[5] += wj * b0.y; acc[6] += wj * b1.x; acc[7] += wj * b1.y; }
#define FOR32(M) M(0) M(1) M(2) M(3) M(4) M(5) M(6) M(7) M(8) M(9) M(10) M(11) M(12) M(13) M(14) M(15) M(16) M(17) M(18) M(19) M(20) M(21) M(22) M(23) M(24) M(25) M(26) M(27) M(28) M(29) M(30) M(31)
    FOR32(FFV_LD)
    float acc[8];
#pragma unroll
    for (int i = 0; i < 8; ++i) acc[i] = 0.f;
    FOR32(FFV_CP)
#pragma unroll
    for (int i = 0; i < 8; ++i) { acc[i] += __shfl_xor(acc[i], 16); acc[i] += __shfl_xor(acc[i], 32); }
    if (ps == 0) *(u32x4*)(ffnb + (size_t)t * DM + sl * 128 + dc * 8) = pack8(acc);
    ev0 = nev0; ev1 = nev1; wr0 = nwr0; wr1 = nwr1;
  }
}
DI void phase_final(const Params& p) {
  char* ws = p.ws;
  const int lane = threadIdx.x & 63, wave = threadIdx.x >> 6;
  const float* x1 = (const float*)(ws + OFF_X1);
  const bf16_t* ffnb = (const bf16_t*)(ws + OFF_FFNB);
  const float* mod = (const float*)(ws + OFF_MOD);
  for (int grp = blockIdx.x; grp < NTOK / 4; grp += gridDim.x) {
    const int row = grp * 4 + wave, b = row >> 13;
    float v[16];
#pragma unroll
    for (int i = 0; i < 4; ++i) {
      const int col = i * 256 + lane * 4;
      const f32x4 xv = *(const f32x4*)(x1 + (size_t)row * DM + col), gt2 = *(const f32x4*)(mod + b * 6144 + 5120 + col);
      const u32x2 fr = *(const u32x2*)(ffnb + (size_t)row * DM + col);
      v[4 * i] = DN_ALPHA * xv.x + gt2.x * bflo(fr.x); v[4 * i + 1] = DN_ALPHA * xv.y + gt2.y * bfhi(fr.x);
      v[4 * i + 2] = DN_ALPHA * xv.z + gt2.z * bflo(fr.y); v[4 * i + 3] = DN_ALPHA * xv.w + gt2.w * bfhi(fr.y);
    }
    float mean, rstd; row_stats(v, mean, rstd);
#pragma unroll
    for (int i = 0; i < 4; ++i) {
      const int col = i * 256 + lane * 4;
      const f32x4 g = *(const f32x4*)(p.ln2_g + col), bb = *(const f32x4*)(p.ln2_b + col);
      f32x4 o;
      o.x = (v[4 * i] - mean) * rstd * g.x + bb.x; o.y = (v[4 * i + 1] - mean) * rstd * g.y + bb.y;
      o.z = (v[4 * i + 2] - mean) * rstd * g.z + bb.z; o.w = (v[4 * i + 3] - mean) * rstd * g.w + bb.w;
      *(f32x4*)(p.out + (size_t)row * DM + col) = o;
    }
  }
}

constexpr int SMEM_BYTES = 73728;

__global__ void __launch_bounds__(NT, 2) k_mega(Params p) {
  __shared__ __attribute__((aligned(16))) char smem[SMEM_BYTES];
  cg::grid_group grid = cg::this_grid();
#define REP(mask) _Pragma("unroll 1") for (int rep_ = 0; rep_ < ((PROBE_DUP & (mask)) ? 2 : 1); ++rep_)
  REP(1) phase_prep(p, smem);
  grid.sync();
  REP(1) phase_ln_in(p);
  grid.sync();
  REP(2) phase_gemm1(p, smem);
  grid.sync();
  REP(4) phase_compress(p, smem);
  phase_sgu(p, smem);
  grid.sync();
  REP(8) phase_nsa(p, smem, NSA_MASK);
  grid.sync();
  REP(16) phase_merge(p, smem, true);
  grid.sync();
  REP(16) phase_outproj(p, smem);
  grid.sync();
  REP(1) phase_ln_mid(p, false);
  grid.sync();
  REP(32) phase_peerq(p, smem);
  grid.sync();
  REP(64) phase_route(p, smem);
  grid.sync();
  REP(128) phase_ffn_u(p);
  grid.sync();
  REP(256) phase_ffn_v(p);
  grid.sync();
  REP(512) phase_final(p);
}

extern "C" void kernel_launch(void* const* d_in, const int* in_sizes, int n_in, void* d_out, int out_size, void* d_ws, size_t ws_size, hipStream_t stream) {
  if (ws_size < OFF_END) { fprintf(stderr, "workspace too small: %zu < %zu\n", ws_size, (size_t)OFF_END); return; }
  static int grid_blocks = 0;
  if (!grid_blocks) {
    int dev = 0, cus = 0, per_cu = 0;
    hipGetDevice(&dev);
    hipDeviceGetAttribute(&cus, hipDeviceAttributeMultiprocessorCount, dev);
    hipOccupancyMaxActiveBlocksPerMultiprocessor(&per_cu, k_mega, NT, 0);
    if (per_cu > 2) per_cu = 2;
    if (per_cu < 1) per_cu = 1;
    grid_blocks = cus * per_cu;
  }
  Params p{};
  const float** fp = (const float**)&p;
  for (int i = 0; i < 26; ++i) fp[i] = (const float*)d_in[i];
  p.out = (float*)d_out;
  p.ws = (char*)d_ws;
  for (int i = 0; i < 32; ++i) p.inv_freq[i] = (float)pow(10000.0, -(double)i / 32.0);
  void* args[] = {&p};
  hipError_t e = hipLaunchCooperativeKernel((void*)k_mega, dim3(grid_blocks), dim3(NT), args, 0, stream);
  if (e != hipSuccess) fprintf(stderr, "cooperative launch failed: %s (grid %d)\n", hipGetErrorString(e), grid_blocks);
}
```

```cpp
#include <hip/hip_runtime.h>
#include <hip/hip_cooperative_groups.h>
#include <stdint.h>
#include <stdio.h>
#include <math.h>
namespace cg = cooperative_groups;

#ifndef PROBE_DUP
#define PROBE_DUP 0
#endif
#ifndef NSA_MASK
#define NSA_MASK 7
#endif
typedef unsigned short bf16_t;
typedef short bf16x8 __attribute__((ext_vector_type(8)));
typedef short s16x4 __attribute__((ext_vector_type(4)));
typedef float f32x16 __attribute__((ext_vector_type(16)));
typedef float f32x4 __attribute__((ext_vector_type(4)));
typedef float f32x2 __attribute__((ext_vector_type(2)));
typedef __bf16 bf16v2 __attribute__((ext_vector_type(2)));
typedef unsigned u32x4 __attribute__((ext_vector_type(4)));
typedef unsigned u32x2 __attribute__((ext_vector_type(2)));
#define DI __device__ __forceinline__
#define LAS __attribute__((address_space(3)))
#define MFMA32(a, b, c) __builtin_amdgcn_mfma_f32_32x32x16_bf16((a), (b), (c), 0, 0, 0)

constexpr int NT = 512, NW = 8;
constexpr int NB = 8, SEQ = 8192, DM = 1024, NTOK = NB * SEQ;
constexpr int N1 = 4608;
constexpr float DN_ALPHA = 1.189207115002721f;
constexpr float LN_EPS = 1e-5f;

constexpr size_t MB = 1024 * 1024;
constexpr size_t OFF_MOD = 0;
constexpr size_t OFF_ROPE = OFF_MOD + 256 * 1024;
constexpr size_t OFF_POSB = OFF_ROPE + 2 * MB;
constexpr size_t OFF_WT1 = OFF_POSB + 4096;
constexpr size_t OFF_WB = OFF_WT1 + (size_t)N1 * 1024 * 2;
constexpr size_t OFF_WOUT = OFF_WB + 2 * MB;
constexpr size_t OFF_WQ = OFF_WOUT + 2 * MB;
constexpr size_t OFF_PKEYS = OFF_WQ + 4 * MB;
constexpr size_t OFF_CW1 = OFF_PKEYS + MB / 2;
constexpr size_t OFF_CW2 = OFF_CW1 + MB;
constexpr size_t OFF_SGUW = OFF_CW2 + 32 * 1024;
constexpr size_t OFF_SCU = OFF_SGUW + 256 * 1024;
constexpr size_t OFF_SCV = OFF_SCU + 64 * 1024;
constexpr size_t OFF_PU = OFF_SCV + 64 * 1024;
constexpr size_t OFF_PV = OFF_PU + 32 * MB;
constexpr size_t OFF_ACT = ((OFF_PV + 32 * MB + 4095) / 4096) * 4096;
constexpr size_t OFF_H = OFF_ACT;
constexpr size_t OFF_Q = OFF_H + 128 * MB;
constexpr size_t OFF_KC = OFF_Q + 64 * MB;
constexpr size_t OFF_VC = OFF_KC + 16 * MB;
constexpr size_t OFF_KS = OFF_VC + 16 * MB;
constexpr size_t OFF_VS = OFF_KS + 16 * MB;
constexpr size_t OFF_KW = OFF_VS + 16 * MB;
constexpr size_t OFF_VW = OFF_KW + 16 * MB;
constexpr size_t OFF_U = OFF_VW + 16 * MB;
constexpr size_t OFF_V = OFF_U + 64 * MB;
constexpr size_t OFF_GATE = OFF_V + 64 * MB;
constexpr size_t OFF_GSIG = OFF_GATE + 256 * MB;
constexpr size_t OFF_KCMP = OFF_GSIG + 8 * MB;
constexpr size_t OFF_VCMP = OFF_KCMP + MB;
constexpr size_t OFF_ONSA = OFF_VCMP + MB;
constexpr size_t OFF_SELG = OFF_ONSA + 64 * MB;
constexpr size_t OFF_BAR = OFF_SELG + 2 * MB;
constexpr size_t OFF_END = OFF_BAR + 64 * 1024;
constexpr size_t OFF_X1 = OFF_Q;
constexpr size_t OFF_Y = OFF_GATE;
constexpr size_t OFF_PQ = OFF_GATE;
constexpr size_t OFF_EIDX = OFF_ONSA;
constexpr size_t OFF_PGATE = OFF_ONSA + 32 * MB;
constexpr size_t OFF_PU8 = OFF_PU;
constexpr size_t OFF_PART = OFF_GATE;
constexpr size_t OFF_PV8 = OFF_PU + 16 * MB;
constexpr size_t OFF_WBUF = OFF_PU + 32 * MB;
constexpr size_t OFF_FFNB = OFF_GATE;

struct Params {
  const float *x, *c, *w_ada, *b_ada, *w_in, *cmp_pos, *cmp_w1, *cmp_b1, *cmp_w2, *cmp_b2, *sgu_ln_g, *sgu_ln_b, *sgu_w, *sgu_b,
      *w_branch, *w_merge, *b_merge, *w_out, *ln1_g, *ln1_b, *peer_wq, *peer_keys, *peer_u, *peer_v, *ln2_g, *ln2_b;
  float* out;
  char* ws;
  float inv_freq[32];
};

DI unsigned pack2(float lo, float hi) { f32x2 v = {lo, hi}; bf16v2 r = __builtin_convertvector(v, bf16v2); return __builtin_bit_cast(unsigned, r); }
DI bf16_t f2bf(float f) { __bf16 r = (__bf16)f; return __builtin_bit_cast(unsigned short, r); }
DI float bf2f(bf16_t h) { return __uint_as_float(((unsigned)h) << 16); }
DI float bflo(unsigned u) { return __uint_as_float(u << 16); }
DI float bfhi(unsigned u) { return __uint_as_float(u & 0xffff0000u); }
DI float gelu_f(float v) { return 0.5f * v * (1.0f + erff(v * 0.70710678118654752f)); }
DI float sigmoid_f(float v) { return 1.0f / (1.0f + __expf(-v)); }
DI int otid() { int t = __builtin_amdgcn_workitem_id_x(); asm volatile("" : "+v"(t)); return t; }
DI float wave_sum(float v) {
#pragma unroll
  for (int o = 32; o > 0; o >>= 1) v += __shfl_xor(v, o);
  return v;
}
DI void ld8(const float* pz, float (&v)[8]) { const f32x4 a = *(const f32x4*)pz, b = *(const f32x4*)(pz + 4); v[0] = a.x; v[1] = a.y; v[2] = a.z; v[3] = a.w; v[4] = b.x; v[5] = b.y; v[6] = b.z; v[7] = b.w; }
DI u32x4 pack8(const float (&v)[8]) { u32x4 w; w.x = pack2(v[0], v[1]); w.y = pack2(v[2], v[3]); w.z = pack2(v[4], v[5]); w.w = pack2(v[6], v[7]); return w; }
DI void unpack8(const u32x4 w, float (&v)[8]) { v[0] = bflo(w.x); v[1] = bfhi(w.x); v[2] = bflo(w.y); v[3] = bfhi(w.y); v[4] = bflo(w.z); v[5] = bfhi(w.z); v[6] = bflo(w.w); v[7] = bfhi(w.w); }
DI f32x2 gelu_pk(f32x2 v) {
  const f32x2 av = __builtin_elementwise_abs(v), d = av * 0.2316418882f + 1.0f;
  f32x2 t; t.x = __builtin_amdgcn_rcpf(d.x); t.y = __builtin_amdgcn_rcpf(d.y);
  f32x2 q = t * 0.5307027145f + (-0.7265760135f); q = q * t + 0.7107068705f; q = q * t + (-0.142248368f); q = q * t + 0.127414796f; q = q * t;
  const f32x2 s = (v * v) * (-0.72134752044f);
  f32x2 e; e.x = __builtin_amdgcn_exp2f(s.x); e.y = __builtin_amdgcn_exp2f(s.y);
  const f32x2 m = v * (q * e), r = v - m;
  f32x2 o; o.x = v.x < 0.f ? m.x : r.x; o.y = v.y < 0.f ? m.y : r.y; return o;
}
__host__ __device__ __forceinline__ int dperm(int q) { const int grp = q >> 5, fq = (q >> 3) & 3, j = q & 7; return (j < 4) ? (16 * grp + 4 * fq + j) : (32 + 16 * grp + 4 * fq + (j - 4)); }

template <class F>
DI void tconv_tile(float* tile, int k0, int n0, bf16_t* dst, int ldd, F f) {
  const int tid = otid();
  __syncthreads();
#pragma unroll 4
  for (int i = 0; i < 8; ++i) { const int kl = i * 8 + (tid >> 6), nl = tid & 63; tile[nl * 65 + kl] = f(k0 + kl, n0 + nl); }
  __syncthreads();
  {
    const int nl = tid >> 3, kc = tid & 7;
    const float* t = tile + nl * 65 + kc * 8;
    u32x4 w; w.x = pack2(t[0], t[1]); w.y = pack2(t[2], t[3]); w.z = pack2(t[4], t[5]); w.w = pack2(t[6], t[7]);
    *(u32x4*)(dst + (size_t)(n0 + nl) * ldd + k0 + kc * 8) = w;
  }
}

DI void conv_chunk(const float* src, bf16_t* dst, size_t base) {
  const size_t i = base + (size_t)otid() * 8;
  const f32x4 a = *(const f32x4*)(src + i), b = *(const f32x4*)(src + i + 4);
  u32x4 w; w.x = pack2(a.x, a.y); w.y = pack2(a.z, a.w); w.z = pack2(b.x, b.y); w.w = pack2(b.z, b.w);
  *(u32x4*)(dst + i) = w;
}

DI void sincos_d(double x, double& s, double& c) {
  const double y = x * 0.25, y2 = y * y;
  double sn = y * (1.0 + y2 * (-1.0 / 6 + y2 * (1.0 / 120 + y2 * (-1.0 / 5040 + y2 * (1.0 / 362880 + y2 * (-1.0 / 39916800 + y2 * (1.0 / 6227020800.0)))))));
  double cs = 1.0 + y2 * (-0.5 + y2 * (1.0 / 24 + y2 * (-1.0 / 720 + y2 * (1.0 / 40320 + y2 * (-1.0 / 3628800 + y2 * (1.0 / 479001600.0 + y2 * (-1.0 / 87178291200.0)))))));
#pragma unroll
  for (int i = 0; i < 2; ++i) { const double s2 = 2.0 * sn * cs, c2 = cs * cs - sn * sn; sn = s2; cs = c2; }
  s = sn; c = cs;
}

DI void phase_prep(const Params& p, char* smem) {
  const int tid = otid();
  float* fs = (float*)smem;
  char* ws = p.ws;
  constexpr int nA = 192, nB = 16 * 72, nC = 2 * 8 * 16, nD = 256, nE = 16 * 32, nF = 2 * 32 * 2, nG = 4, nH = 8, nI = 512, nJ = 64, nK = 32, nL = 2048, nM = 2048;
  constexpr int total = nA + nB + nC + nD + nE + nF + nG + nH + nI + nJ + nK + nL + nM;
  for (int item = blockIdx.x; item < total; item += gridDim.x) {
    int it = item;
    if (it < nA) {
      float* sc = fs;
      float* red = fs + 8192;
      __syncthreads();
      for (int i = tid; i < 8192; i += NT) { const float v = p.c[i]; sc[i] = v / (1.0f + __expf(-v)); }
      __syncthreads();
      const int ks = tid >> 5, cj = tid & 31, col = it * 32 + cj;
      float acc[8];
#pragma unroll
      for (int b = 0; b < 8; ++b) acc[b] = 0.f;
#pragma unroll 4
      for (int k = ks * 64; k < ks * 64 + 64; ++k) {
        const float w = p.w_ada[(size_t)k * 6144 + col];
#pragma unroll
        for (int b = 0; b < 8; ++b) acc[b] += sc[b * 1024 + k] * w;
      }
#pragma unroll
      for (int b = 0; b < 8; ++b) red[(ks * 8 + b) * 32 + cj] = acc[b];
      __syncthreads();
      if (tid < 256) {
        const int b = tid >> 5;
        float s = p.b_ada[col];
#pragma unroll
        for (int k2 = 0; k2 < 16; ++k2) s += red[(k2 * 8 + b) * 32 + cj];
        ((float*)(ws + OFF_MOD))[b * 6144 + col] = s;
      }
      continue;
    }
    it -= nA;
    if (it < nB) {
      const int kt = it / 72, ntile = it % 72;
      const float* w_in = p.w_in; const float* w_merge = p.w_merge;
      tconv_tile(fs, kt * 64, ntile * 64, (bf16_t*)(ws + OFF_WT1), 1024, [=](int k, int n) -> float {
        if (n < 1280) {
          const bool roped = (n < 640) || (n >= 768 && n < 896) || (n >= 1024 && n < 1152);
          const int col = roped ? ((n & ~63) + dperm(n & 63)) : n;
          return w_in[(size_t)k * 2328 + col];
        }
        if (n < 2304) return w_in[(size_t)k * 2328 + n + 24];
        if (n < 4352) return w_merge[(size_t)k * 2048 + (n - 2304)];
        if (n < 4376) return w_in[(size_t)k * 2328 + 1280 + (n - 4352)];
        return 0.f; });
      continue;
    }
    it -= nB;
    if (it < nC) {
      const int br = it >> 7, r = it & 127, kt = r >> 4, ntile = r & 15;
      const float* src = p.w_branch + (size_t)br * 512 * 1024;
      tconv_tile(fs, kt * 64, ntile * 64, (bf16_t*)(ws + OFF_WB) + (size_t)br * 1024 * 512, 512, [=](int k, int n) -> float { return src[(size_t)k * 1024 + n]; });
      continue;
    }
    it -= nC;
    if (it < nD) {
      const int kt = it >> 4, ntile = it & 15;
      const float* src = p.w_out;
      tconv_tile(fs, kt * 64, ntile * 64, (bf16_t*)(ws + OFF_WOUT), 1024, [=](int k, int n) -> float { return src[(size_t)k * 1024 + n]; });
      continue;
    }
    it -= nD;
    if (it < nE) {
      const int kt = it >> 5, ntile = it & 31;
      const float* src = p.peer_wq;
      tconv_tile(fs, kt * 64, ntile * 64, (bf16_t*)(ws + OFF_WQ), 1024, [=](int k, int n) -> float { return src[(size_t)k * 2048 + n]; });
      continue;
    }
    it -= nE;
    if (it < nF) {
      const int w = it >> 6, r = it & 63, kt = r >> 1, ntile = r & 1;
      const float* src = p.cmp_w1 + (size_t)w * 2048 * 128;
      tconv_tile(fs, kt * 64, ntile * 64, (bf16_t*)(ws + OFF_CW1) + (size_t)w * 128 * 2048, 2048, [=](int k, int n) -> float {
        const int ksrc = (w == 0) ? ((k & ~63) + dperm(k & 63)) : k;
        return src[(size_t)ksrc * 128 + n]; });
      continue;
    }
    it -= nF;
    if (it < nG) {
      const int w = it >> 1, kt = it & 1;
      const float* src = p.cmp_w2 + (size_t)w * 128 * 64;
      tconv_tile(fs, kt * 64, 0, (bf16_t*)(ws + OFF_CW2) + (size_t)w * 64 * 128, 128, [=](int k, int n) -> float { return src[(size_t)k * 64 + ((w == 0) ? dperm(n) : n)]; });
      continue;
    }
    it -= nG;
    if (it < nH) {
      const int w = it >> 2, jc = it & 3, ks = tid >> 5, cj = tid & 31, j = jc * 32 + cj;
      float* red = fs;
      const float* pos = p.cmp_pos + w * 2048; const float* w1 = p.cmp_w1 + (size_t)w * 2048 * 128;
      float acc = 0.f;
#pragma unroll 4
      for (int k = ks * 128; k < ks * 128 + 128; ++k) acc += pos[k] * w1[(size_t)k * 128 + j];
      __syncthreads();
      red[ks * 32 + cj] = acc;
      __syncthreads();
      if (tid < 32) { float s = p.cmp_b1[w * 128 + j]; for (int k2 = 0; k2 < 16; ++k2) s += red[k2 * 32 + tid]; ((float*)(ws + OFF_POSB))[w * 128 + j] = s; }
      continue;
    }
    it -= nH;
    if (it < nI) {
      const int e = it * 512 + tid, pos = e >> 5, i = e & 31;
      const float ang = (float)pos * p.inv_freq[i];
      const double a = (double)ang;
      const double kk = rint(a * 0.15915494309189535);
      const double r = a - kk * 6.283185307179586476925;
      double s, c; sincos_d(r, s, c);
      ((float*)(ws + OFF_ROPE))[e] = (float)c;
      ((float*)(ws + OFF_ROPE))[262144 + e] = (float)s;
      continue;
    }
    it -= nI;
    if (it < nJ) { conv_chunk(p.peer_keys, (bf16_t*)(ws + OFF_PKEYS), (size_t)it * 4096); continue; }
    it -= nJ;
    if (it < nK) {
      const size_t i0 = (size_t)it * 4096 + (size_t)tid * 8;
      const int rowi = (int)((i0 >> 7) & 127), j0 = (int)(i0 & 127);
      float v[8];
#pragma unroll
      for (int j = 0; j < 8; ++j) v[j] = (j0 + j <= rowi) ? p.sgu_w[i0 + j] : 0.f;
      u32x4 w; w.x = pack2(v[0], v[1]); w.y = pack2(v[2], v[3]); w.z = pack2(v[4], v[5]); w.w = pack2(v[6], v[7]);
      *(u32x4*)((bf16_t*)(ws + OFF_SGUW) + i0) = w;
      continue;
    }
    it -= nK;
    {
      const bool isv = it >= nL;
      if (isv) it -= nL;
      const int lane = tid & 63, e = it * 8 + (tid >> 6);
      const float* src = (isv ? p.peer_v : p.peer_u) + (size_t)e * 1024 + lane * 16;
      float v[16];
#pragma unroll
      for (int i = 0; i < 4; ++i) { const f32x4 t4 = *(const f32x4*)(src + i * 4); v[4 * i] = t4.x; v[4 * i + 1] = t4.y; v[4 * i + 2] = t4.z; v[4 * i + 3] = t4.w; }
      float amax = 0.f;
#pragma unroll
      for (int i = 0; i < 16; ++i) amax = fmaxf(amax, fabsf(v[i]));
#pragma unroll
      for (int o = 32; o > 0; o >>= 1) amax = fmaxf(amax, __shfl_xor(amax, o));
      const unsigned be = (__float_as_uint(amax) >> 23) & 0xffu;
      const bool okr = be >= 16u && be <= 240u;
      const float scale = okr ? __uint_as_float((261u - be) << 23) : 1.0f;
      const float inv = okr ? __uint_as_float((be - 7u) << 23) : 1.0f;
      u32x4 w;
      int t0 = 0, t1 = 0, t2 = 0, t3 = 0;
      t0 = __builtin_amdgcn_cvt_pk_fp8_f32(v[0] * scale, v[1] * scale, t0, false); t0 = __builtin_amdgcn_cvt_pk_fp8_f32(v[2] * scale, v[3] * scale, t0, true);
      t1 = __builtin_amdgcn_cvt_pk_fp8_f32(v[4] * scale, v[5] * scale, t1, false); t1 = __builtin_amdgcn_cvt_pk_fp8_f32(v[6] * scale, v[7] * scale, t1, true);
      t2 = __builtin_amdgcn_cvt_pk_fp8_f32(v[8] * scale, v[9] * scale, t2, false); t2 = __builtin_amdgcn_cvt_pk_fp8_f32(v[10] * scale, v[11] * scale, t2, true);
      t3 = __builtin_amdgcn_cvt_pk_fp8_f32(v[12] * scale, v[13] * scale, t3, false); t3 = __builtin_amdgcn_cvt_pk_fp8_f32(v[14] * scale, v[15] * scale, t3, true);
      w.x = (unsigned)t0; w.y = (unsigned)t1; w.z = (unsigned)t2; w.w = (unsigned)t3;
      if (!isv) {
        *(u32x4*)(ws + OFF_PU8 + ((size_t)(lane >> 3) * 16384 + e) * 128 + (lane & 7) * 16) = w;
        if (lane == 0) ((float*)(ws + OFF_SCU))[e] = inv;
      } else {
        *(u32x4*)(ws + OFF_PV8 + ((size_t)(lane >> 3) * 16384 + e) * 128 + (lane & 7) * 16) = w;
        if (lane == 0) ((float*)(ws + OFF_SCV))[e] = inv;
      }
    }
  }
}

DI void row_stats(const float (&v)[16], float& mean, float& rstd) {
  float s = 0.f;
#pragma unroll
  for (int i = 0; i < 16; ++i) s += v[i];
  mean = wave_sum(s) * (1.0f / 1024.0f);
  float q = 0.f;
#pragma unroll
  for (int i = 0; i < 16; ++i) { const float d = v[i] - mean; q += d * d; }
  rstd = rsqrtf(wave_sum(q) * (1.0f / 1024.0f) + LN_EPS);
}

DI void phase_ln_in(const Params& p) {
  const int lane = otid() & 63, wave = otid() >> 6;
  const float* mod = (const float*)(p.ws + OFF_MOD);
  bf16_t* h = (bf16_t*)(p.ws + OFF_H);
  for (int grp = blockIdx.x; grp < NTOK / NW; grp += gridDim.x) {
    const int row = grp * NW + wave, b = row >> 13;
    const float* xr = p.x + (size_t)row * DM;
    float v[16];
#pragma unroll
    for (int i = 0; i < 4; ++i) { const f32x4 t = *(const f32x4*)(xr + i * 256 + lane * 4); v[4 * i] = t.x; v[4 * i + 1] = t.y; v[4 * i + 2] = t.z; v[4 * i + 3] = t.w; }
    float mean, rstd; row_stats(v, mean, rstd);
#pragma unroll
    for (int i = 0; i < 4; ++i) {
      const int col = i * 256 + lane * 4;
      const f32x4 sh = *(const f32x4*)(mod + b * 6144 + col), sc = *(const f32x4*)(mod + b * 6144 + 1024 + col);
      const float o0 = (v[4 * i] - mean) * rstd * (1.f + sc.x) + sh.x, o1 = (v[4 * i + 1] - mean) * rstd * (1.f + sc.y) + sh.y;
      const float o2 = (v[4 * i + 2] - mean) * rstd * (1.f + sc.z) + sh.z, o3 = (v[4 * i + 3] - mean) * rstd * (1.f + sc.w) + sh.w;
      u32x2 w; w.x = pack2(o0, o1); w.y = pack2(o2, o3);
      *(u32x2*)(h + (size_t)row * DM + col) = w;
    }
  }
}

DI void phase_ln_mid(const Params& p) {
  const int lane = otid() & 63, wave = otid() >> 6;
  const float* mod = (const float*)(p.ws + OFF_MOD);
  const float* y = (const float*)(p.ws + OFF_Y);
  float* x1 = (float*)(p.ws + OFF_X1);
  bf16_t* h2 = (bf16_t*)(p.ws + OFF_H);
  for (int grp = blockIdx.x; grp < NTOK / NW; grp += gridDim.x) {
    const int row = grp * NW + wave, b = row >> 13;
    const float* yr = y + (size_t)row * DM;
    float v[16];
#pragma unroll
    for (int i = 0; i < 4; ++i) { const f32x4 t = *(const f32x4*)(yr + i * 256 + lane * 4); v[4 * i] = t.x; v[4 * i + 1] = t.y; v[4 * i + 2] = t.z; v[4 * i + 3] = t.w; }
    float mean, rstd; row_stats(v, mean, rstd);
#pragma unroll
    for (int i = 0; i < 4; ++i) {
      const int col = i * 256 + lane * 4;
      const f32x4 g = *(const f32x4*)(p.ln1_g + col), bb = *(const f32x4*)(p.ln1_b + col);
      f32x4 o;
      o.x = (v[4 * i] - mean) * rstd * g.x + bb.x; o.y = (v[4 * i + 1] - mean) * rstd * g.y + bb.y;
      o.z = (v[4 * i + 2] - mean) * rstd * g.z + bb.z; o.w = (v[4 * i + 3] - mean) * rstd * g.w + bb.w;
      *(f32x4*)(x1 + (size_t)row * DM + col) = o;
      v[4 * i] = o.x; v[4 * i + 1] = o.y; v[4 * i + 2] = o.z; v[4 * i + 3] = o.w;
    }
    row_stats(v, mean, rstd);
#pragma unroll
    for (int i = 0; i < 4; ++i) {
      const int col = i * 256 + lane * 4;
      const f32x4 sh = *(const f32x4*)(mod + b * 6144 + 3072 + col), sc = *(const f32x4*)(mod + b * 6144 + 4096 + col);
      const float o0 = (v[4 * i] - mean) * rstd * (1.f + sc.x) + sh.x, o1 = (v[4 * i + 1] - mean) * rstd * (1.f + sc.y) + sh.y;
      const float o2 = (v[4 * i + 2] - mean) * rstd * (1.f + sc.z) + sh.z, o3 = (v[4 * i + 3] - mean) * rstd * (1.f + sc.w) + sh.w;
      u32x2 w; w.x = pack2(o0, o1); w.y = pack2(o2, o3);
      *(u32x2*)(h2 + (size_t)row * DM + col) = w;
    }
  }
}

namespace pg8 {
constexpr int BM = 256, BK = 64, HALF = 128, HTB = HALF * BK * 2, STAGE_BYTES = 8 * HTB, NXCD = 8, WGM = 8;
DI int lds_byte(int r, int c) { const int st = (r >> 4) * 2 + (c >> 5), rr = r & 15, cc = c & 31, ob = rr * 64 + cc * 2; return st * 1024 + (ob ^ (((ob >> 9) & 1) << 5)); }
DI void stage_rc(int b, int& R, int& C) { const int st = b / 1024, sb = b % 1024, swz = sb ^ (((sb >> 9) & 1) << 5); R = (st >> 1) * 16 + swz / 64; C = (st & 1) * 32 + (swz % 64) / 2; }
DI int perm32(int rho) { const int n = rho >> 4, i = rho & 15; return 8 * (i >> 2) + 4 * n + (i & 3); }
struct Unit { int pm, pn; };
struct Gemm { const bf16_t* A; const bf16_t* Bt; int M, N, K; };
struct StaticOrder {
  int nM, nN, nwg, G, c;
  DI void init(int M, int N, int G_, int c_) { nM = M / BM; nN = N / BM; nwg = nM * nN; G = G_; c = c_; }
  DI bool next(int i, Unit& u) const {
    const long L = (long)i * G + c; if (L >= nwg) return false;
    int wgid = (int)L; { const int q = nwg / NXCD, r = nwg % NXCD, xcd = wgid % NXCD, off = wgid / NXCD; wgid = (xcd < r ? xcd * (q + 1) : r * (q + 1) + (xcd - r) * q) + off; }
    const int nig = WGM * nN, gid = wgid / nig, fm = gid * WGM, gsz = (nM - fm) < WGM ? (nM - fm) : WGM;
    u.pm = fm + ((wgid % nig) % gsz); u.pn = (wgid % nig) / gsz; return true;
  }
};

template <class Epi>
DI void gemm_phase(LAS unsigned char* lds, const Gemm g, const StaticOrder& S, const Epi& E) {
  const int tid = otid(), wid = __builtin_amdgcn_readfirstlane(tid >> 6), lane = tid & 63, wr = wid >> 2, wc = wid & 3, fr = lane & 15, fq = lane >> 4;
  const int K = g.K, nt = K / BK;
  unsigned voffA[2], voffB[2];
#pragma unroll
  for (int i = 0; i < 2; ++i) { int R, C; stage_rc(tid * 16 + i * 8192, R, C); const int Rb = Epi::PERM ? ((R & ~31) + perm32(R & 31)) : R;
    voffA[i] = (unsigned)(R * K + C) * 2u; voffB[i] = (unsigned)(Rb * K + C) * 2u; }
  const size_t kstep = (size_t)(BK * 2);
  const size_t hstep = (size_t)HALF * K * 2;
  const size_t tstep = 2 * hstep;
  const unsigned ldsw = (unsigned)wid * 1024u;
  const int aoff = lds_byte(wr * 64 + fr, fq * 8), boff = lds_byte(wc * 32 + fr, fq * 8);
#define PG8_SA(b, h) (((b) * 2 + (h)) * HTB)
#define PG8_SB(b, h) ((4 + (b) * 2 + (h)) * HTB)
#define PG8_STAGE(bufoff, gbase, voff) do { _Pragma("unroll") for (int _i = 0; _i < 2; ++_i) \
    __builtin_amdgcn_global_load_lds((const unsigned*)((const char*)(gbase) + (voff)[_i]), (LAS unsigned*)(lds + (bufoff) + ldsw + _i * 8192), 16, 0, 0); } while (0)
#define PG8_LDA(dst, b, h) do { _Pragma("unroll") for (int m = 0; m < 4; ++m) _Pragma("unroll") for (int k = 0; k < 2; ++k) dst[m][k] = *(const LAS bf16x8*)(lds + PG8_SA(b, h) + aoff + m * 2048 + k * 1024); } while (0)
#define PG8_LDB(dst, b, h) do { _Pragma("unroll") for (int n = 0; n < 2; ++n) _Pragma("unroll") for (int k = 0; k < 2; ++k) dst[n][k] = *(const LAS bf16x8*)(lds + PG8_SB(b, h) + boff + n * 2048 + k * 1024); } while (0)
#define PG8_MMA(ai, bj, At, Bt) do { __builtin_amdgcn_s_setprio(1); _Pragma("unroll") for (int m = 0; m < 4; ++m) _Pragma("unroll") for (int n = 0; n < 2; ++n) _Pragma("unroll") for (int k = 0; k < 2; ++k) \
    acc[ai][bj][m][n] = __builtin_amdgcn_mfma_f32_16x16x32_bf16(Bt[n][k], At[m][k], acc[ai][bj][m][n], 0, 0, 0); __builtin_amdgcn_s_setprio(0); } while (0)
#define PG8_WAIT_V(n) asm volatile("s_waitcnt vmcnt(" #n ")" ::: "memory")
#define PG8_WAIT_L(n) asm volatile("s_waitcnt lgkmcnt(" #n ")" ::: "memory")
#define PG8_BAR __builtin_amdgcn_s_barrier()
#define PG8_SCHED __builtin_amdgcn_sched_barrier(0)
  Unit cur, nxt; int ui = 0;
  if (!S.next(0, cur)) return;
  f32x4 acc[2][2][4][2];
#pragma unroll
  for (int a = 0; a < 2; ++a)
#pragma unroll
    for (int b = 0; b < 2; ++b)
#pragma unroll
      for (int m = 0; m < 4; ++m)
#pragma unroll
        for (int n = 0; n < 2; ++n) acc[a][b][m][n] = (f32x4){0.f, 0.f, 0.f, 0.f};
  bf16x8 At[4][2], B0[2][2], B1[2][2];
  const char* cA = (const char*)g.A + (size_t)cur.pm * tstep; const char* cB = (const char*)g.Bt + (size_t)cur.pn * tstep;
  PG8_STAGE(PG8_SB(0, 0), cB, voffB); PG8_STAGE(PG8_SA(0, 0), cA, voffA); PG8_STAGE(PG8_SB(0, 1), cB + hstep, voffB); PG8_STAGE(PG8_SA(0, 1), cA + hstep, voffA);
  if (wr == 1) PG8_BAR;
  PG8_WAIT_V(4); PG8_BAR;
  PG8_STAGE(PG8_SB(1, 0), cB + kstep, voffB); PG8_STAGE(PG8_SA(1, 0), cA + kstep, voffA); PG8_STAGE(PG8_SB(1, 1), cB + hstep + kstep, voffB);
  PG8_WAIT_V(6); PG8_BAR;
  for (;;) {
    const bool has_next = S.next(ui + 1, nxt);
    const char* nA = has_next ? (const char*)g.A + (size_t)nxt.pm * tstep : cA; const char* nB = has_next ? (const char*)g.Bt + (size_t)nxt.pn * tstep : cB;
    for (int t = 0; t < nt; t += 2) {
      const bool last = (t == nt - 2);
      const char* a1 = cA + (size_t)(t + 1) * kstep;
      const char* a2 = last ? nA : cA + (size_t)(t + 2) * kstep; const char* b2 = last ? nB : cB + (size_t)(t + 2) * kstep;
      const char* a3 = a2 + kstep; const char* b3 = b2 + kstep;
      PG8_LDB(B0, 0, 0); PG8_SCHED; PG8_LDA(At, 0, 0); PG8_STAGE(PG8_SA(1, 1), a1 + hstep, voffA);
      PG8_WAIT_L(8); PG8_BAR; PG8_WAIT_L(0); PG8_MMA(0, 0, At, B0); PG8_BAR; PG8_SCHED;
      PG8_LDB(B1, 0, 1); PG8_STAGE(PG8_SB(0, 0), b2, voffB);
      PG8_BAR; PG8_WAIT_L(0); PG8_MMA(0, 1, At, B1); PG8_BAR;
      PG8_LDA(At, 0, 1); PG8_STAGE(PG8_SA(0, 0), a2, voffA);
      PG8_BAR; PG8_WAIT_L(0); PG8_MMA(1, 0, At, B0); PG8_BAR; PG8_SCHED;
      PG8_STAGE(PG8_SB(0, 1), b2 + hstep, voffB);
      PG8_WAIT_V(6); PG8_BAR; PG8_MMA(1, 1, At, B1); PG8_BAR;
      PG8_LDB(B0, 1, 0); PG8_SCHED; PG8_LDA(At, 1, 0); PG8_STAGE(PG8_SA(0, 1), a2 + hstep, voffA);
      PG8_WAIT_L(8); PG8_BAR; PG8_WAIT_L(0); PG8_MMA(0, 0, At, B0); PG8_BAR; PG8_SCHED;
      PG8_LDB(B1, 1, 1); PG8_STAGE(PG8_SB(1, 0), b3, voffB);
      PG8_BAR; PG8_WAIT_L(0); PG8_MMA(0, 1, At, B1); PG8_BAR;
      PG8_LDA(At, 1, 1); PG8_STAGE(PG8_SA(1, 0), a3, voffA);
      PG8_BAR; PG8_WAIT_L(0); PG8_MMA(1, 0, At, B0); PG8_BAR; PG8_SCHED;
      PG8_STAGE(PG8_SB(1, 1), b3 + hstep, voffB);
      PG8_WAIT_V(6); PG8_BAR; PG8_MMA(1, 1, At, B1); PG8_BAR;
    }
    E(acc, cur, wr, wc, fr, fq);
    if (!has_next) break;
#pragma unroll
    for (int a = 0; a < 2; ++a)
#pragma unroll
      for (int b = 0; b < 2; ++b)
#pragma unroll
        for (int m = 0; m < 4; ++m)
#pragma unroll
          for (int n = 0; n < 2; ++n) acc[a][b][m][n] = (f32x4){0.f, 0.f, 0.f, 0.f};
    cur = nxt; cA = nA; cB = nB; ++ui;
  }
  PG8_WAIT_V(0);
  if (wr == 0) PG8_BAR;
  PG8_BAR;
#undef PG8_SA
#undef PG8_SB
#undef PG8_STAGE
#undef PG8_LDA
#undef PG8_LDB
#undef PG8_MMA
#undef PG8_WAIT_V
#undef PG8_WAIT_L
#undef PG8_BAR
#undef PG8_SCHED
}
}

struct EpiProj {
  static constexpr bool PERM = true;
  char* ws; const float* b_merge;
  DI void operator()(const f32x4 (&acc)[2][2][4][2], const pg8::Unit& u, int wr, int wc, int fr, int fq) const {
    const float* rope = (const float*)(ws + OFF_ROPE);
    const int row0 = u.pm * 256 + wr * 64 + fr;
#pragma unroll
    for (int bj = 0; bj < 2; ++bj) {
      const int cg = u.pn * 256 + bj * 128 + wc * 32;
      const int c0 = cg + 8 * fq;
      if (cg >= 4384) continue;
      if (cg < 1280 && (cg < 640 || (cg >= 768 && cg < 896) || (cg >= 1024 && cg < 1152))) {
        bf16_t* dst; unsigned ld, cofs; float scale = 1.0f;
        if (cg < 512) { dst = (bf16_t*)(ws + OFF_Q); ld = 512; cofs = c0; scale = 0.125f; }
        else if (cg < 640) { dst = (bf16_t*)(ws + OFF_KC); ld = 128; cofs = c0 - 512; }
        else if (cg < 896) { dst = (bf16_t*)(ws + OFF_KS); ld = 128; cofs = c0 - 768; }
        else { dst = (bf16_t*)(ws + OFF_KW); ld = 128; cofs = c0 - 1024; }
        const int d0 = 16 * ((cg >> 5) & 1) + 4 * fq;
#pragma unroll
        for (int ai = 0; ai < 2; ++ai)
#pragma unroll
          for (int m = 0; m < 4; ++m) {
            const int row = row0 + ai * 128 + m * 16, pos = row & (SEQ - 1);
            const f32x4 cs = *(const f32x4*)(rope + pos * 32 + d0), sn = *(const f32x4*)(rope + 262144 + pos * 32 + d0);
            const f32x4 t1 = acc[ai][bj][m][0], t2 = acc[ai][bj][m][1];
            const f32x4 o1 = (t1 * cs - t2 * sn) * scale, o2 = (t1 * sn + t2 * cs) * scale;
            u32x4 w; w.x = pack2(o1.x, o1.y); w.y = pack2(o1.z, o1.w); w.z = pack2(o2.x, o2.y); w.w = pack2(o2.z, o2.w);
            *(u32x4*)(dst + (unsigned)row * ld + cofs) = w;
          }
      } else if (cg < 1280) {
        bf16_t* dst; unsigned cofs;
        if (cg < 768) { dst = (bf16_t*)(ws + OFF_VC); cofs = c0 - 640; }
        else if (cg < 1024) { dst = (bf16_t*)(ws + OFF_VS); cofs = c0 - 896; }
        else { dst = (bf16_t*)(ws + OFF_VW); cofs = c0 - 1152; }
#pragma unroll
        for (int ai = 0; ai < 2; ++ai)
#pragma unroll
          for (int m = 0; m < 4; ++m) {
            const int row = row0 + ai * 128 + m * 16;
            const f32x4 a = acc[ai][bj][m][0], b = acc[ai][bj][m][1];
            u32x4 w; w.x = pack2(a.x, a.y); w.y = pack2(a.z, a.w); w.z = pack2(b.x, b.y); w.w = pack2(b.z, b.w);
            *(u32x4*)(dst + (unsigned)row * 128u + cofs) = w;
          }
      } else if (cg < 2304) {
        bf16_t* dst = (bf16_t*)(ws + (cg < 1792 ? OFF_U : OFF_V));
        const unsigned cofs = c0 - (cg < 1792 ? 1280 : 1792);
#pragma unroll
        for (int ai = 0; ai < 2; ++ai)
#pragma unroll
          for (int m = 0; m < 4; ++m) {
            const int row = row0 + ai * 128 + m * 16;
            const f32x4 a = acc[ai][bj][m][0], b = acc[ai][bj][m][1];
            const f32x2 g0 = gelu_pk((f32x2){a.x, a.y}), g1 = gelu_pk((f32x2){a.z, a.w}), g2 = gelu_pk((f32x2){b.x, b.y}), g3 = gelu_pk((f32x2){b.z, b.w});
            u32x4 w; w.x = pack2(g0.x, g0.y); w.y = pack2(g1.x, g1.y); w.z = pack2(g2.x, g2.y); w.w = pack2(g3.x, g3.y);
            *(u32x4*)(dst + (unsigned)row * 512u + cofs) = w;
          }
      } else if (cg < 4352) {
        bf16_t* dst = (bf16_t*)(ws + OFF_GATE);
        const unsigned cofs = c0 - 2304;
        const f32x4 b0 = *(const f32x4*)(b_merge + cofs), b1 = *(const f32x4*)(b_merge + cofs + 4);
#pragma unroll
        for (int ai = 0; ai < 2; ++ai)
#pragma unroll
          for (int m = 0; m < 4; ++m) {
            const int row = row0 + ai * 128 + m * 16;
            const f32x4 a = acc[ai][bj][m][0] + b0, b = acc[ai][bj][m][1] + b1;
            u32x4 w; w.x = pack2(sigmoid_f(a.x), sigmoid_f(a.y)); w.y = pack2(sigmoid_f(a.z), sigmoid_f(a.w));
            w.z = pack2(sigmoid_f(b.x), sigmoid_f(b.y)); w.w = pack2(sigmoid_f(b.z), sigmoid_f(b.w));
            *(u32x4*)(dst + (unsigned)row * 2048u + cofs) = w;
          }
      } else {
        float* gs = (float*)(ws + OFF_GSIG);
        if (fq < 3) {
#pragma unroll
          for (int ai = 0; ai < 2; ++ai)
#pragma unroll
            for (int m = 0; m < 4; ++m) {
              const int row = row0 + ai * 128 + m * 16;
              const f32x4 a = acc[ai][bj][m][0], b = acc[ai][bj][m][1];
              f32x4 o0, o1; o0.x = sigmoid_f(a.x); o0.y = sigmoid_f(a.y); o0.z = sigmoid_f(a.z); o0.w = sigmoid_f(a.w);
              o1.x = sigmoid_f(b.x); o1.y = sigmoid_f(b.y); o1.z = sigmoid_f(b.z); o1.w = sigmoid_f(b.w);
              *(f32x4*)(gs + (unsigned)row * 32u + 8 * fq) = o0; *(f32x4*)(gs + (unsigned)row * 32u + 8 * fq + 4) = o1;
            }
        }
      }
    }
  }
};
DI void phase_gemm1(const Params& p, char* smem) {
  pg8::Gemm g{(const bf16_t*)(p.ws + OFF_H), (const bf16_t*)(p.ws + OFF_WT1), NTOK, N1, 1024};
  pg8::StaticOrder S; S.init(NTOK, N1, gridDim.x, blockIdx.x);
  EpiProj E{p.ws, p.b_merge};
  pg8::gemm_phase((LAS unsigned char*)smem, g, S, E);
}

template <int BR> struct EpiMerge {
  static constexpr bool PERM = true;
  char* ws;
  DI void operator()(const f32x4 (&acc)[2][2][4][2], const pg8::Unit& u, int wr, int wc, int fr, int fq) const {
    const bf16_t* gate = (const bf16_t*)(ws + OFF_GATE);
    bf16_t* merged = (bf16_t*)(ws + OFF_H);
    const int row0 = u.pm * 256 + wr * 64 + fr;
#pragma unroll
    for (int bj = 0; bj < 2; ++bj) {
      const unsigned c0 = u.pn * 256 + bj * 128 + wc * 32 + 8 * fq;
#pragma unroll
      for (int ai = 0; ai < 2; ++ai)
#pragma unroll
        for (int m = 0; m < 4; ++m) {
          const unsigned row = row0 + ai * 128 + m * 16;
          float gg[8]; unpack8(*(const u32x4*)(gate + row * 2048u + BR * 1024 + c0), gg);
          const f32x4 a = acc[ai][bj][m][0], b = acc[ai][bj][m][1];
          float v[8] = {a.x * gg[0], a.y * gg[1], a.z * gg[2], a.w * gg[3], b.x * gg[4], b.y * gg[5], b.z * gg[6], b.w * gg[7]};
          bf16_t* mp = merged + row * 1024u + c0;
          if (BR == 1) {
            float old[8]; unpack8(*(const u32x4*)mp, old);
#pragma unroll
            for (int j = 0; j < 8; ++j) v[j] += old[j];
          }
          *(u32x4*)mp = pack8(v);
        }
    }
  }
};
DI void phase_merge(const Params& p, char* smem) {
  pg8::StaticOrder S; S.init(NTOK, 1024, gridDim.x, blockIdx.x);
  {
    pg8::Gemm g{(const bf16_t*)(p.ws + OFF_ONSA), (const bf16_t*)(p.ws + OFF_WB), NTOK, 1024, 512};
    EpiMerge<0> E{p.ws};
    pg8::gemm_phase((LAS unsigned char*)smem, g, S, E);
  }
  {
    pg8::Gemm g{(const bf16_t*)(p.ws + OFF_U), (const bf16_t*)(p.ws + OFF_WB) + (size_t)1024 * 512, NTOK, 1024, 512};
    EpiMerge<1> E{p.ws};
    pg8::gemm_phase((LAS unsigned char*)smem, g, S, E);
  }
}

struct EpiOut {
  static constexpr bool PERM = false;
  char* ws; const float* x;
  DI void operator()(const f32x4 (&acc)[2][2][4][2], const pg8::Unit& u, int wr, int wc, int fr, int fq) const {
    const float* mod = (const float*)(ws + OFF_MOD);
    float* y = (float*)(ws + OFF_Y);
    const int row0 = u.pm * 256 + wr * 64 + fr, b = (u.pm * 256) >> 13;
#pragma unroll
    for (int bj = 0; bj < 2; ++bj)
#pragma unroll
      for (int n = 0; n < 2; ++n) {
        const unsigned c = u.pn * 256 + bj * 128 + wc * 32 + n * 16 + 4 * fq;
        const f32x4 gt = *(const f32x4*)(mod + b * 6144 + 2048 + c);
#pragma unroll
        for (int ai = 0; ai < 2; ++ai)
#pragma unroll
          for (int m = 0; m < 4; ++m) {
            const unsigned o = (unsigned)(row0 + ai * 128 + m * 16) * 1024u + c;
            const f32x4 xv = *(const f32x4*)(x + o);
            *(f32x4*)(y + o) = xv * DN_ALPHA + gt * acc[ai][bj][m][n];
          }
      }
  }
};
DI void phase_outproj(const Params& p, char* smem) {
  pg8::Gemm g{(const bf16_t*)(p.ws + OFF_H), (const bf16_t*)(p.ws + OFF_WOUT), NTOK, 1024, 1024};
  pg8::StaticOrder S; S.init(NTOK, 1024, gridDim.x, blockIdx.x);
  EpiOut E{p.ws, p.x};
  pg8::gemm_phase((LAS unsigned char*)smem, g, S, E);
}

struct EpiPq {
  static constexpr bool PERM = true;
  char* ws;
  DI void operator()(const f32x4 (&acc)[2][2][4][2], const pg8::Unit& u, int wr, int wc, int fr, int fq) const {
    bf16_t* pq = (bf16_t*)(ws + OFF_PQ);
    const int row0 = u.pm * 256 + wr * 64 + fr;
#pragma unroll
    for (int bj = 0; bj < 2; ++bj) {
      const unsigned c0 = u.pn * 256 + bj * 128 + wc * 32 + 8 * fq;
#pragma unroll
      for (int ai = 0; ai < 2; ++ai)
#pragma unroll
        for (int m = 0; m < 4; ++m) {
          const f32x4 a = acc[ai][bj][m][0], b = acc[ai][bj][m][1];
          u32x4 w; w.x = pack2(a.x, a.y); w.y = pack2(a.z, a.w); w.z = pack2(b.x, b.y); w.w = pack2(b.z, b.w);
          *(u32x4*)(pq + (unsigned)(row0 + ai * 128 + m * 16) * 2048u + c0) = w;
        }
    }
  }
};
DI void phase_peerq(const Params& p, char* smem) {
  pg8::Gemm g{(const bf16_t*)(p.ws + OFF_H), (const bf16_t*)(p.ws + OFF_WQ), NTOK, 2048, 1024};
  pg8::StaticOrder S; S.init(NTOK, 2048, gridDim.x, blockIdx.x);
  EpiPq E{p.ws};
  pg8::gemm_phase((LAS unsigned char*)smem, g, S, E);
}

DI void phase_sgu(const Params& p, char* smem) {
  char* ws = p.ws;
  const int tid = otid(), lane = tid & 63, wave = tid >> 6;
  bf16_t* u = (bf16_t*)(ws + OFF_U);
  const bf16_t* v = (const bf16_t*)(ws + OFF_V);
  const bf16_t* W = (const bf16_t*)(ws + OFF_SGUW);
  float* st = (float*)smem;
  bf16_t* vt = (bf16_t*)(smem + 1024);
  constexpr int LV = 136;
  for (int item = blockIdx.x; item < NTOK / 128; item += gridDim.x) {
    const int t0 = item * 128;
    __syncthreads();
    for (int i = 0; i < 16; ++i) {
      const int t = wave * 16 + i;
      const u32x4 raw = *(const u32x4*)(v + (size_t)(t0 + t) * 512 + lane * 8);
      float f[8]; unpack8(raw, f);
      float s = 0.f;
#pragma unroll
      for (int j = 0; j < 8; ++j) s += f[j];
      const float mean = wave_sum(s) * (1.f / 512.f);
      float q = 0.f;
#pragma unroll
      for (int j = 0; j < 8; ++j) { const float d = f[j] - mean; q += d * d; }
      const float rstd = rsqrtf(wave_sum(q) * (1.f / 512.f) + LN_EPS);
      if (lane == 0) { st[t * 2] = mean; st[t * 2 + 1] = rstd; }
    }
    for (int g = 0; g < 8; ++g) {
      __syncthreads();
      for (int i = 0; i < 2; ++i) {
        const int idx = tid + i * NT, j = idx >> 3, dc = (idx & 7) * 8;
        const u32x4 raw = *(const u32x4*)(v + (size_t)(t0 + j) * 512 + g * 64 + dc);
        const float mean = st[j * 2], rstd = st[j * 2 + 1];
        float f[8]; unpack8(raw, f);
#pragma unroll
        for (int k = 0; k < 8; ++k) {
          const int col = g * 64 + dc + k;
          vt[(dc + k) * LV + j] = f2bf((f[k] - mean) * rstd * p.sgu_ln_g[col] + p.sgu_ln_b[col]);
        }
      }
      __syncthreads();
      const int rt = wave >> 1, ni = wave & 1;
      f32x16 acc;
#pragma unroll
      for (int r = 0; r < 16; ++r) acc[r] = 0.f;
      const bf16_t* wrow = W + ((size_t)g * 128 + rt * 32 + (lane & 31)) * 128 + (lane >> 5) * 8;
#pragma unroll
      for (int ks = 0; ks < 8; ++ks) {
        const bf16x8 a = *(const bf16x8*)(wrow + ks * 16);
        const bf16x8 b0 = *(const bf16x8*)(vt + (ni * 32 + (lane & 31)) * LV + ks * 16 + (lane >> 5) * 8);
        acc = MFMA32(a, b0, acc);
      }
      const int d = lane & 31, hh = lane >> 5;
#pragma unroll
      for (int r = 0; r < 16; ++r) {
        const int i = rt * 32 + (r & 3) + 8 * (r >> 2) + 4 * hh;
        const float m = acc[r] + p.sgu_b[g * 128 + i];
        bf16_t* up = u + (size_t)(t0 + i) * 512 + g * 64 + ni * 32 + d;
        *up = f2bf(bf2f(*up) * m);
      }
    }
  }
}

DI void phase_compress(const Params& p, char* smem) {
  char* ws = p.ws;
  const int tid = otid(), lane = tid & 63, wave = tid >> 6, l31 = lane & 31, hh = lane >> 5;
  bf16_t* hid = (bf16_t*)smem;
  constexpr int LH = 136;
  for (int item = blockIdx.x; item < 128; item += gridDim.x) {
    const int w = item >> 6, R0 = (item & 63) * 128;
    const bf16_t* src = (const bf16_t*)(ws + (w == 0 ? OFF_KC : OFF_VC));
    const bf16_t* W1 = (const bf16_t*)(ws + OFF_CW1) + (size_t)w * 128 * 2048;
    const bf16_t* W2 = (const bf16_t*)(ws + OFF_CW2) + (size_t)w * 64 * 128;
    const float* posb = (const float*)(ws + OFF_POSB) + w * 128;
    const int rg = wave >> 2, cgp = wave & 3;
    const bf16_t* abase[2];
#pragma unroll
    for (int mi = 0; mi < 2; ++mi) {
      const int R = R0 + rg * 64 + mi * 32 + l31, bg = R >> 9, n = R & 511, nn = n < 510 ? n : 510;
      abase[mi] = src + ((size_t)((bg >> 1) * SEQ + 16 * nn)) * 128 + (bg & 1) * 64 + hh * 8;
    }
    const bf16_t* bbase = W1 + (size_t)(cgp * 32 + l31) * 2048 + hh * 8;
    f32x16 acc[2];
#pragma unroll
    for (int r = 0; r < 16; ++r) { acc[0][r] = 0.f; acc[1][r] = 0.f; }
#pragma unroll 8
    for (int ks = 0; ks < 128; ++ks) {
      const int aofs = (ks >> 2) * 128 + (ks & 3) * 16;
      const bf16x8 a0 = *(const bf16x8*)(abase[0] + aofs), a1 = *(const bf16x8*)(abase[1] + aofs);
      const bf16x8 bb = *(const bf16x8*)(bbase + ks * 16);
      acc[0] = MFMA32(a0, bb, acc[0]); acc[1] = MFMA32(a1, bb, acc[1]);
    }
    __syncthreads();
    {
      const float pb = posb[cgp * 32 + l31];
#pragma unroll
      for (int mi = 0; mi < 2; ++mi)
#pragma unroll
        for (int r = 0; r < 16; ++r) {
          const int row = rg * 64 + mi * 32 + (r & 3) + 8 * (r >> 2) + 4 * hh;
          hid[row * LH + cgp * 32 + l31] = f2bf(gelu_f(acc[mi][r] + pb));
        }
    }
    __syncthreads();
    const int mi2 = wave >> 1, ni = wave & 1;
    f32x16 o;
#pragma unroll
    for (int r = 0; r < 16; ++r) o[r] = 0.f;
#pragma unroll
    for (int ks = 0; ks < 8; ++ks) {
      const bf16x8 a = *(const bf16x8*)(hid + (mi2 * 32 + l31) * LH + ks * 16 + hh * 8);
      const bf16x8 bb = *(const bf16x8*)(W2 + (size_t)(ni * 32 + l31) * 128 + ks * 16 + hh * 8);
      o = MFMA32(a, bb, o);
    }
    const int d = ni * 32 + l31;
    const float b2 = p.cmp_b2[w * 64 + (w == 0 ? dperm(d) : d)];
    const int bg = R0 >> 9;
    bf16_t* dst = (bf16_t*)(ws + (w == 0 ? OFF_KCMP : OFF_VCMP));
#pragma unroll
    for (int r = 0; r < 16; ++r) {
      const int n = (R0 & 511) + mi2 * 32 + (r & 3) + 8 * (r >> 2) + 4 * hh;
      dst[((size_t)bg * 512 + n) * 64 + d] = f2bf(n < 511 ? o[r] + b2 : 0.f);
    }
  }
}

constexpr int LK = 72;
constexpr int NSA_KS = 0, NSA_VS = 9216, NSA_AIMP = 18432, NSA_CIMP = NSA_AIMP + 32768, NSA_SELM = NSA_CIMP + 32768;
struct TileRegs { u32x4 k; u32x4 v; };

DI void nsa_load_tile(TileRegs& t, const bf16_t* kbase, size_t kstride, const bf16_t* vbase, size_t vstride) {
  const int tid = otid(), r = tid >> 3, ch = tid & 7;
  t.k = *(const u32x4*)(kbase + (size_t)r * kstride + ch * 8);
  t.v = *(const u32x4*)(vbase + (size_t)r * vstride + ch * 8);
}
DI void nsa_store_tile(const TileRegs& t, char* smem) {
  const int tid = otid(), r = tid >> 3, ch = tid & 7;
  *(u32x4*)((bf16_t*)(smem + NSA_KS) + r * LK + ch * 8) = t.k;
  *(u32x4*)((bf16_t*)(smem + NSA_VS) + r * LK + ch * 8) = t.v;
}
DI void nsa_scores(f32x16 (&st)[2], const char* smem, const bf16x8 (&qf)[4], int lane) {
  const bf16_t* Ks = (const bf16_t*)(smem + NSA_KS);
#pragma unroll
  for (int kt = 0; kt < 2; ++kt) {
#pragma unroll
    for (int r = 0; r < 16; ++r) st[kt][r] = 0.f;
#pragma unroll
    for (int ks = 0; ks < 4; ++ks) {
      const bf16x8 a = *(const bf16x8*)(Ks + (kt * 32 + (lane & 31)) * LK + ks * 16 + (lane >> 5) * 8);
      st[kt] = MFMA32(a, qf[ks], st[kt]);
    }
  }
}
DI void nsa_pv(f32x16 (&o)[2], const f32x16 (&pt)[2], const char* smem, int lane) {
  const int gi = lane >> 4, i16 = lane & 15, q = i16 >> 2, pp = i16 & 3;
  const LAS bf16_t* Vs = (const LAS bf16_t*)(smem + NSA_VS) + (4 * (gi >> 1) + q) * LK + 16 * (gi & 1) + 4 * pp;
#pragma unroll
  for (int kt = 0; kt < 2; ++kt)
#pragma unroll
    for (int s = 0; s < 2; ++s) {
      u32x4 pk; pk.x = pack2(pt[kt][8 * s], pt[kt][8 * s + 1]); pk.y = pack2(pt[kt][8 * s + 2], pt[kt][8 * s + 3]);
      pk.z = pack2(pt[kt][8 * s + 4], pt[kt][8 * s + 5]); pk.w = pack2(pt[kt][8 * s + 6], pt[kt][8 * s + 7]);
      const bf16x8 pb = __builtin_bit_cast(bf16x8, pk);
#pragma unroll
      for (int dt = 0; dt < 2; ++dt) {
        const LAS bf16_t* vp = Vs + (kt * 32 + 16 * s) * LK + dt * 32;
        const s16x4 lo = __builtin_amdgcn_ds_read_tr16_b64_v4i16((LAS s16x4*)vp);
        const s16x4 hi = __builtin_amdgcn_ds_read_tr16_b64_v4i16((LAS s16x4*)(vp + 8 * LK));
        const bf16x8 a = __builtin_shufflevector(lo, hi, 0, 1, 2, 3, 4, 5, 6, 7);
        o[dt] = MFMA32(a, pb, o[dt]);
      }
    }
}

DI void nsa_online(f32x16 (&st)[2], unsigned vm0, unsigned vm1, float& m, float& l, f32x16 (&o)[2], const char* smem, int lane) {
  float mx = -1e30f;
#pragma unroll
  for (int r = 0; r < 16; ++r) { if ((vm0 >> r) & 1u) mx = fmaxf(mx, st[0][r]); if ((vm1 >> r) & 1u) mx = fmaxf(mx, st[1][r]); }
  mx = fmaxf(mx, __shfl_xor(mx, 32));
  const float mn = fmaxf(m, mx);
  const float alpha = __expf(m - mn);
  m = mn;
  float sum = 0.f;
#pragma unroll
  for (int r = 0; r < 16; ++r) {
    const float p0 = ((vm0 >> r) & 1u) ? __expf(st[0][r] - mn) : 0.f;
    const float p1 = ((vm1 >> r) & 1u) ? __expf(st[1][r] - mn) : 0.f;
    st[0][r] = p0; st[1][r] = p1; sum += p0 + p1;
  }
  l = l * alpha + sum;
#pragma unroll
  for (int r = 0; r < 16; ++r) { o[0][r] *= alpha; o[1][r] *= alpha; }
  nsa_pv(o, st, smem, lane);
}

struct NsaItem { int qb, b, g, bg, t; size_t tokrow; };
DI NsaItem nsa_item(int item, int wave, int qi) {
  NsaItem it; it.qb = 127 - (item >> 4); const int rest = item & 15; it.b = rest >> 1; it.g = rest & 1;
  it.bg = it.b * 2 + it.g; it.t = it.qb * 64 + wave * 8 + qi; it.tokrow = (size_t)it.b * SEQ + it.t; return it;
}
DI void nsa_accum_store(bf16_t* dst, const f32x16 (&o)[2], float sc, bool first, int hh) {
#pragma unroll
  for (int dt = 0; dt < 2; ++dt)
#pragma unroll
    for (int q4 = 0; q4 < 4; ++q4) {
      u32x2* pp = (u32x2*)(dst + dt * 32 + 8 * q4 + 4 * hh);
      float a0 = sc * o[dt][4 * q4], a1 = sc * o[dt][4 * q4 + 1], a2 = sc * o[dt][4 * q4 + 2], a3 = sc * o[dt][4 * q4 + 3];
      if (!first) { const u32x2 old = *pp; a0 += bflo(old.x); a1 += bfhi(old.x); a2 += bflo(old.y); a3 += bfhi(old.y); }
      u32x2 wv; wv.x = pack2(a0, a1); wv.y = pack2(a2, a3);
      *pp = wv;
    }
}

DI void phase_nsa(const Params& p, char* smem, int branch_mask) {
  char* ws = p.ws;
  const int tid = otid(), lane = tid & 63, wave = tid >> 6, hh = lane >> 5, c = lane & 31, qi = c >> 2, r4 = c & 3;
  const bf16_t* Q = (const bf16_t*)(ws + OFF_Q);
  const float* gsig = (const float*)(ws + OFF_GSIG);
  bf16_t* ONSA = (bf16_t*)(ws + OFF_ONSA);
  u32x4* SELG = (u32x4*)(ws + OFF_SELG);
  constexpr int NITEM = NB * 2 * 128;

  {
    const bf16_t* KCMP = (const bf16_t*)(ws + OFF_KCMP); const bf16_t* VCMP = (const bf16_t*)(ws + OFF_VCMP);
    float* Aimp = (float*)(smem + NSA_AIMP) + wave * 1024;
    float* Cimp = (float*)(smem + NSA_CIMP) + wave * 1024;
    unsigned short* selm16 = (unsigned short*)(smem + NSA_SELM) + wave * 64;
    const u32x4* selm128 = (const u32x4*)(smem + NSA_SELM) + wave * 8;
    for (int item = blockIdx.x; item < NITEM; item += gridDim.x) {
      const NsaItem it = nsa_item(item, wave, qi);
      const int t = it.t;
      const int tmaxb = it.qb * 64 + 63;
      bf16x8 qf[4];
#pragma unroll
      for (int ks = 0; ks < 4; ++ks) qf[ks] = *(const bf16x8*)(Q + it.tokrow * 512 + (it.g * 4 + r4) * 64 + ks * 16 + hh * 8);
      const float g_c = gsig[it.tokrow * 32 + (it.g * 4 + r4) * 3 + 0];
      TileRegs tr;
      const int nmax = (tmaxb - 31) >> 4;
      const int ntile = (nmax >> 6) + 1;
      const bf16_t* kb = KCMP + (size_t)it.bg * 512 * 64;
      const bf16_t* vb = VCMP + (size_t)it.bg * 512 * 64;
      float m = -1e30f, l = 0.f;
      __syncthreads();
      for (int i = lane; i < 1024; i += 64) { Aimp[i] = 0.f; Cimp[i] = 0.f; }
      nsa_load_tile(tr, kb, 64, vb, 64);
      for (int j = 0; j < ntile; ++j) {
        __syncthreads();
        nsa_store_tile(tr, smem);
        __syncthreads();
        if (j + 1 < ntile) nsa_load_tile(tr, kb + (size_t)(j + 1) * 64 * 64, 64, vb + (size_t)(j + 1) * 64 * 64, 64);
        f32x16 st[2];
        nsa_scores(st, smem, qf, lane);
        float mx = -1e30f;
#pragma unroll
        for (int kt = 0; kt < 2; ++kt)
#pragma unroll
          for (int r = 0; r < 16; ++r) {
            const int n = j * 64 + kt * 32 + (r & 3) + 8 * (r >> 2) + 4 * hh;
            if (16 * n + 31 <= t) mx = fmaxf(mx, st[kt][r]);
          }
        mx = fmaxf(mx, __shfl_xor(mx, 32));
        const float mn = fmaxf(m, mx);
        float sum = 0.f;
#pragma unroll
        for (int kt = 0; kt < 2; ++kt)
#pragma unroll
          for (int r = 0; r < 16; ++r) {
            const int n = j * 64 + kt * 32 + (r & 3) + 8 * (r >> 2) + 4 * hh;
            if (16 * n + 31 <= t) sum += __expf(st[kt][r] - mn);
          }
        l = l * __expf(m - mn) + sum;
        m = mn;
      }
      l += __shfl_xor(l, 32);
      const float inv_l = l > 0.f ? 1.0f / l : 0.f;
      f32x16 o[2];
#pragma unroll
      for (int r = 0; r < 16; ++r) { o[0][r] = 0.f; o[1][r] = 0.f; }
      nsa_load_tile(tr, kb, 64, vb, 64);
      for (int j = 0; j < ntile; ++j) {
        __syncthreads();
        nsa_store_tile(tr, smem);
        __syncthreads();
        if (j + 1 < ntile) nsa_load_tile(tr, kb + (size_t)(j + 1) * 64 * 64, 64, vb + (size_t)(j + 1) * 64 * 64, 64);
        f32x16 st[2];
        nsa_scores(st, smem, qf, lane);
#pragma unroll
        for (int kt = 0; kt < 2; ++kt)
#pragma unroll
          for (int r = 0; r < 16; ++r) {
            const int n = j * 64 + kt * 32 + (r & 3) + 8 * (r >> 2) + 4 * hh;
            st[kt][r] = (16 * n + 31 <= t) ? __expf(st[kt][r] - m) * inv_l : 0.f;
          }
#pragma unroll
        for (int kt = 0; kt < 2; ++kt)
#pragma unroll
          for (int c4 = 0; c4 < 4; ++c4) {
            float carry = 0.5f * st[kt][4 * c4 + 3];
            float full = st[kt][4 * c4] + st[kt][4 * c4 + 1] + st[kt][4 * c4 + 2] + carry;
            full += __shfl_xor(full, 1); full += __shfl_xor(full, 2);
            carry += __shfl_xor(carry, 1); carry += __shfl_xor(carry, 2);
            const int jb = j * 16 + kt * 8 + 2 * c4 + hh;
            if (r4 == 0) { Aimp[qi * 128 + jb] = full; Cimp[qi * 128 + jb] = carry; }
          }
        if (branch_mask & 1) nsa_pv(o, st, smem, lane);
      }
      nsa_accum_store(ONSA + it.tokrow * 512 + (it.g * 4 + r4) * 64, o, (branch_mask & 1) ? g_c : 0.f, true, hh);
      __syncthreads();
      const int cur = it.qb;
      if (cur <= 15) {
        if (lane < 8) { selm16[lane * 8 + 0] = (unsigned short)((2u << cur) - 1u);
#pragma unroll
          for (int k = 1; k < 8; ++k) selm16[lane * 8 + k] = 0; }
      } else {
        const int qs = lane >> 3, sub = lane & 7;
        float v[16];
#pragma unroll
        for (int i = 0; i < 16; ++i) {
          const int jj = sub * 16 + i;
          const bool ok = (jj >= 1) && (jj <= cur - 2);
          const int jm = jj >= 1 ? jj - 1 : 0;
          v[i] = ok ? (Aimp[qs * 128 + jj] + Cimp[qs * 128 + jm]) : -3e38f;
        }
        unsigned bits = 0;
        for (int itn = 0; itn < 13; ++itn) {
          float bv = v[0]; int bi = 0;
#pragma unroll
          for (int i = 1; i < 16; ++i) if (v[i] > bv) { bv = v[i]; bi = i; }
          int bj = sub * 16 + bi;
#pragma unroll
          for (int o2 = 1; o2 < 8; o2 <<= 1) {
            const float ov = __shfl_xor(bv, o2); const int oj = __shfl_xor(bj, o2);
            if (ov > bv || (ov == bv && oj < bj)) { bv = ov; bj = oj; }
          }
          if ((bj >> 4) == sub) {
            const int i2 = bj & 15;
#pragma unroll
            for (int i = 0; i < 16; ++i) if (i == i2) v[i] = -3e38f;
            bits |= 1u << i2;
          }
        }
        if (sub == 0) bits |= 1u;
        if ((cur >> 4) == sub) bits |= 1u << (cur & 15);
        if (((cur - 1) >> 4) == sub) bits |= 1u << ((cur - 1) & 15);
        selm16[qs * 8 + sub] = (unsigned short)bits;
      }
      __syncthreads();
      if (r4 == 0 && hh == 0) SELG[(size_t)it.bg * SEQ + t] = selm128[qi];
    }
  }
  __threadfence_block();
  __syncthreads();

  if (branch_mask & 2) {
    const bf16_t* KS = (const bf16_t*)(ws + OFF_KS); const bf16_t* VS = (const bf16_t*)(ws + OFF_VS);
    for (int item = blockIdx.x; item < NITEM; item += gridDim.x) {
      const NsaItem it = nsa_item(item, wave, qi);
      const int t = it.t, qb = it.qb;
      bf16x8 qf[4];
#pragma unroll
      for (int ks = 0; ks < 4; ++ks) qf[ks] = *(const bf16x8*)(Q + it.tokrow * 512 + (it.g * 4 + r4) * 64 + ks * 16 + hh * 8);
      const float g_s = gsig[it.tokrow * 32 + (it.g * 4 + r4) * 3 + 1];
      const u32x4 selw = SELG[(size_t)it.bg * SEQ + t];
      TileRegs tr;
      const bf16_t* kb = KS + (size_t)it.b * SEQ * 128 + it.g * 64;
      const bf16_t* vb = VS + (size_t)it.b * SEQ * 128 + it.g * 64;
      float m = -1e30f, l = 0.f;
      f32x16 o[2];
#pragma unroll
      for (int r = 0; r < 16; ++r) { o[0][r] = 0.f; o[1][r] = 0.f; }
      nsa_load_tile(tr, kb, 128, vb, 128);
      for (int j = 0; j <= qb; ++j) {
        __syncthreads();
        nsa_store_tile(tr, smem);
        __syncthreads();
        if (j + 1 <= qb) nsa_load_tile(tr, kb + (size_t)(j + 1) * 64 * 128, 128, vb + (size_t)(j + 1) * 64 * 128, 128);
        const unsigned w = j < 32 ? selw.x : (j < 64 ? selw.y : (j < 96 ? selw.z : selw.w));
        const bool sel = (w >> (j & 31)) & 1u;
        if (__any(sel)) {
          f32x16 st[2];
          nsa_scores(st, smem, qf, lane);
          unsigned vm0 = 0, vm1 = 0;
#pragma unroll
          for (int r = 0; r < 16; ++r) {
            const int k0 = j * 64 + (r & 3) + 8 * (r >> 2) + 4 * hh;
            if (sel && k0 <= t) vm0 |= 1u << r;
            if (sel && k0 + 32 <= t) vm1 |= 1u << r;
          }
          nsa_online(st, vm0, vm1, m, l, o, smem, lane);
        }
      }
      l += __shfl_xor(l, 32);
      nsa_accum_store(ONSA + it.tokrow * 512 + (it.g * 4 + r4) * 64, o, l > 0.f ? g_s / l : 0.f, false, hh);
    }
  }

  if (branch_mask & 4) {
    const bf16_t* KW = (const bf16_t*)(ws + OFF_KW); const bf16_t* VW = (const bf16_t*)(ws + OFF_VW);
    for (int item = blockIdx.x; item < NITEM; item += gridDim.x) {
      const NsaItem it = nsa_item(item, wave, qi);
      const int t = it.t, qb = it.qb;
      bf16x8 qf[4];
#pragma unroll
      for (int ks = 0; ks < 4; ++ks) qf[ks] = *(const bf16x8*)(Q + it.tokrow * 512 + (it.g * 4 + r4) * 64 + ks * 16 + hh * 8);
      const float g_w = gsig[it.tokrow * 32 + (it.g * 4 + r4) * 3 + 2];
      TileRegs tr;
      const bf16_t* kb = KW + (size_t)it.b * SEQ * 128 + it.g * 64;
      const bf16_t* vb = VW + (size_t)it.b * SEQ * 128 + it.g * 64;
      float m = -1e30f, l = 0.f;
      f32x16 o[2];
#pragma unroll
      for (int r = 0; r < 16; ++r) { o[0][r] = 0.f; o[1][r] = 0.f; }
      const int j0 = qb >= 8 ? qb - 8 : 0;
      nsa_load_tile(tr, kb + (size_t)j0 * 64 * 128, 128, vb + (size_t)j0 * 64 * 128, 128);
      for (int j = j0; j <= qb; ++j) {
        __syncthreads();
        nsa_store_tile(tr, smem);
        __syncthreads();
        if (j + 1 <= qb) nsa_load_tile(tr, kb + (size_t)(j + 1) * 64 * 128, 128, vb + (size_t)(j + 1) * 64 * 128, 128);
        f32x16 st[2];
        nsa_scores(st, smem, qf, lane);
        unsigned vm0 = 0, vm1 = 0;
#pragma unroll
        for (int r = 0; r < 16; ++r) {
          const int k0 = j * 64 + (r & 3) + 8 * (r >> 2) + 4 * hh;
          if (k0 <= t && t - k0 < 512) vm0 |= 1u << r;
          if (k0 + 32 <= t && t - (k0 + 32) < 512) vm1 |= 1u << r;
        }
        nsa_online(st, vm0, vm1, m, l, o, smem, lane);
      }
      l += __shfl_xor(l, 32);
      nsa_accum_store(ONSA + it.tokrow * 512 + (it.g * 4 + r4) * 64, o, l > 0.f ? g_w / l : 0.f, false, hh);
    }
  }
}

DI unsigned ord_key(float f) { const unsigned u = __float_as_uint(f); return (u & 0x80000000u) ? ~u : (u | 0x80000000u); }
DI float ord_val(unsigned k) { return __uint_as_float((k & 0x80000000u) ? (k & 0x7fffffffu) : ~k); }
DI void cex(unsigned& hi, unsigned& lo) { const unsigned x = hi, y = lo; hi = x > y ? x : y; lo = x > y ? y : x; }
DI void sort16_desc(unsigned (&a)[16]) {
#pragma unroll
  for (int k = 2; k <= 16; k <<= 1)
#pragma unroll
    for (int j = k >> 1; j > 0; j >>= 1)
#pragma unroll
      for (int i = 0; i < 16; ++i) {
        const int l = i ^ j;
        if (l > i) { if ((i & k) == 0) cex(a[i], a[l]); else cex(a[l], a[i]); }
      }
}
DI void bitonic_finish16(unsigned (&a)[16]) {
#pragma unroll
  for (int j = 8; j > 0; j >>= 1)
#pragma unroll
    for (int i = 0; i < 16; ++i) { const int l = i ^ j; if (l > i) cex(a[i], a[l]); }
}
DI void merge_top16(unsigned (&a)[16], const unsigned (&b)[16]) {
#pragma unroll
  for (int i = 0; i < 16; ++i) a[i] = a[i] > b[15 - i] ? a[i] : b[15 - i];
  bitonic_finish16(a);
}
DI void merge_partner16(unsigned (&a)[16]) {
  unsigned b[16];
#pragma unroll
  for (int i = 0; i < 16; ++i) b[i] = (unsigned)__shfl_xor((int)a[i], 32);
  merge_top16(a, b);
}


DI void peer_top16(unsigned (&top)[16], const bf16_t* pqrow, const bf16_t* keys, int lane) {
  const int l31 = lane & 31, hh = lane >> 5;
  bf16x8 bq[8];
#pragma unroll
  for (int ks = 0; ks < 8; ++ks) bq[ks] = *(const bf16x8*)(pqrow + ks * 16 + hh * 8);
  unsigned grp[16];
#pragma unroll
  for (int nt = 0; nt < 4; ++nt) {
    f32x16 sa;
#pragma unroll
    for (int r = 0; r < 16; ++r) sa[r] = 0.f;
    const bf16_t* kp = keys + (size_t)(nt * 32 + l31) * 128 + hh * 8;
#pragma unroll
    for (int ks = 0; ks < 8; ++ks) { const bf16x8 a = *(const bf16x8*)(kp + ks * 16); sa = MFMA32(a, bq[ks], sa); }
#pragma unroll
    for (int r = 0; r < 16; ++r) {
      const int n = nt * 32 + (r & 3) + 8 * (r >> 2) + 4 * hh;
      grp[r] = (ord_key(sa[r]) & ~0x7Fu) | (unsigned)(127 - n);
    }
    sort16_desc(grp);
    if (nt == 0) {
#pragma unroll
      for (int i = 0; i < 16; ++i) top[i] = grp[i];
    } else merge_top16(top, grp);
  }
  merge_partner16(top);
}

DI void phase_route(const Params& p, char* smem) {
  char* ws = p.ws;
  const int tid = otid(), lane = tid & 63, wave = tid >> 6, l31 = lane & 31, hh = lane >> 5;
  const bf16_t* pq = (const bf16_t*)(ws + OFF_PQ);
  const bf16_t* pk = (const bf16_t*)(ws + OFF_PKEYS);
  int* eidx = (int*)(ws + OFF_EIDX);
  float* pgate = (float*)(ws + OFF_PGATE);
  unsigned* LS = (unsigned*)smem + wave * 1024;
  constexpr int CA[64] = {0,0,0,0,0,0,0,0,0,0,0,0,0,0,0,0, 1,1,1,1,1,1,1,1, 2,2,2,2,2, 3,3,3,3, 4,4,4, 5,5, 6,6, 7,7, 8,9,10,11,12,13,14,15, 0,0,0,0,0,0,0,0,0,0,0,0,0,0};
  constexpr int CB[64] = {0,1,2,3,4,5,6,7,8,9,10,11,12,13,14,15, 0,1,2,3,4,5,6,7, 0,1,2,3,4, 0,1,2,3, 0,1,2, 0,1, 0,1, 0,1, 0,0,0,0,0,0,0,0, 0,0,0,0,0,0,0,0,0,0,0,0,0,0};
  for (int item = blockIdx.x; item < (NTOK / 256) * 8; item += gridDim.x) {
    const int h = item & 7, t0 = (item >> 3) * 256 + wave * 32;
    unsigned s1[16], s2[16];
    const bf16_t* pqrow = pq + (size_t)(t0 + l31) * 2048 + h * 256;
    peer_top16(s1, pqrow, pk + (size_t)(h * 2) * 128 * 128, lane);
    peer_top16(s2, pqrow + 128, pk + (size_t)(h * 2 + 1) * 128 * 128, lane);
    float f1[16], f2[16];
#pragma unroll
    for (int i = 0; i < 16; ++i) { f1[i] = ord_val(s1[i]); f2[i] = ord_val(s2[i]); }
    unsigned ca[16], cb2[16];
#pragma unroll
    for (int i = 0; i < 32; ++i) {
      const int i0 = i, i1 = 25 + i;
      unsigned k0 = 0u, k1 = 0u;
      if (i0 < 25) k0 = (ord_key(f1[CA[i0]] + f2[CB[i0]]) & ~0xFFu) | (unsigned)(255 - (CA[i0] * 16 + CB[i0]));
      if (i1 < 50) k1 = (ord_key(f1[CA[i1]] + f2[CB[i1]]) & ~0xFFu) | (unsigned)(255 - (CA[i1] * 16 + CB[i1]));
      const unsigned kk = hh ? k1 : k0;
      if (i < 16) ca[i] = kk; else cb2[i - 16] = kk;
    }
    sort16_desc(ca); sort16_desc(cb2);
    merge_top16(ca, cb2);
    merge_partner16(ca);
    if (hh == 0) {
#pragma unroll
      for (int i = 0; i < 16; ++i) { LS[l31 * 32 + i] = s1[i]; LS[l31 * 32 + 16 + i] = s2[i]; }
    }
    const float mx = ord_val(ca[0]);
    float ex[16], sum = 0.f;
#pragma unroll
    for (int i = 0; i < 16; ++i) { ex[i] = __expf(ord_val(ca[i]) - mx); sum += ex[i]; }
    const float inv = 1.0f / sum;
    int eo[16]; float go[16];
#pragma unroll
    for (int i = 0; i < 16; ++i) {
      const int flat = 255 - (int)(ca[i] & 0xFFu);
      const unsigned k1 = LS[l31 * 32 + (flat >> 4)], k2 = LS[l31 * 32 + 16 + (flat & 15)];
      eo[i] = (127 - (int)(k1 & 0x7Fu)) * 128 + (127 - (int)(k2 & 0x7Fu));
      go[i] = ex[i] * inv;
    }
    const size_t ob = ((size_t)(t0 + l31) * 8 + h) * 16;
    if (hh == 0) {
      *(u32x4*)(eidx + ob) = (u32x4){(unsigned)eo[0], (unsigned)eo[1], (unsigned)eo[2], (unsigned)eo[3]};
      *(u32x4*)(eidx + ob + 4) = (u32x4){(unsigned)eo[4], (unsigned)eo[5], (unsigned)eo[6], (unsigned)eo[7]};
      *(f32x4*)(pgate + ob) = (f32x4){go[0], go[1], go[2], go[3]};
      *(f32x4*)(pgate + ob + 4) = (f32x4){go[4], go[5], go[6], go[7]};
    } else {
      *(u32x4*)(eidx + ob + 8) = (u32x4){(unsigned)eo[8], (unsigned)eo[9], (unsigned)eo[10], (unsigned)eo[11]};
      *(u32x4*)(eidx + ob + 12) = (u32x4){(unsigned)eo[12], (unsigned)eo[13], (unsigned)eo[14], (unsigned)eo[15]};
      *(f32x4*)(pgate + ob + 8) = (f32x4){go[8], go[9], go[10], go[11]};
      *(f32x4*)(pgate + ob + 12) = (f32x4){go[12], go[13], go[14], go[15]};
    }
  }
}

#define FOR32(M) M(0) M(1) M(2) M(3) M(4) M(5) M(6) M(7) M(8) M(9) M(10) M(11) M(12) M(13) M(14) M(15) M(16) M(17) M(18) M(19) M(20) M(21) M(22) M(23) M(24) M(25) M(26) M(27) M(28) M(29) M(30) M(31)
DI void phase_ffn_u(const Params& p) {
  char* ws = p.ws;
  const int lane = otid() & 63, wave = otid() >> 6, ps = lane >> 4, dc = lane & 15;
  const int sl = blockIdx.x & 7, wslot = (blockIdx.x >> 3) * NW + wave, nw = (gridDim.x >> 3) * NW;
  const unsigned char* PU8 = (const unsigned char*)(ws + OFF_PU8) + (size_t)sl * 16384 * 128 + dc * 8;
  const bf16_t* h2 = (const bf16_t*)(ws + OFF_H) + sl * 128 + dc * 8;
  const int* eidx = (const int*)(ws + OFF_EIDX);
  float* part = (float*)(ws + OFF_PART) + (size_t)sl * NTOK * 128;
  int ev0 = 0, ev1 = 0, nev0 = 0, nev1 = 0; u32x4 hr = {0u, 0u, 0u, 0u}, nhr = {0u, 0u, 0u, 0u};
  if (wslot < NTOK) { ev0 = eidx[(size_t)wslot * 128 + lane]; ev1 = eidx[(size_t)wslot * 128 + 64 + lane]; hr = *(const u32x4*)(h2 + (size_t)wslot * DM); }
  for (int t = wslot; t < NTOK; t += nw) {
    if (t + nw < NTOK) { const size_t o = (size_t)(t + nw) * 128; nev0 = eidx[o + lane]; nev1 = eidx[o + 64 + lane]; nhr = *(const u32x4*)(h2 + (size_t)(t + nw) * DM); }
    float hx[8]; unpack8(hr, hx);
#define FFU_LD(it) const u32x2 ru##it = *(const u32x2*)(PU8 + (size_t)__shfl((it) < 16 ? ev0 : ev1, ((it) & 15) * 4 + ps) * 128);
    FOR32(FFU_LD)
    float d[32];
#define FFU_CP(it) { const f32x2 a0 = __builtin_amdgcn_cvt_pk_f32_fp8((int)ru##it.x, false), a1 = __builtin_amdgcn_cvt_pk_f32_fp8((int)ru##it.x, true); \
      const f32x2 b0 = __builtin_amdgcn_cvt_pk_f32_fp8((int)ru##it.y, false), b1 = __builtin_amdgcn_cvt_pk_f32_fp8((int)ru##it.y, true); \
      d[it] = (hx[0] * a0.x + hx[1] * a0.y) + (hx[2] * a1.x + hx[3] * a1.y) + (hx[4] * b0.x + hx[5] * b0.y) + (hx[6] * b1.x + hx[7] * b1.y); }
    FOR32(FFU_CP)
    float r16[16], r8[8], r4[4], r2[2];
    { const bool hi = dc & 8;
#pragma unroll
      for (int i = 0; i < 16; ++i) { const float keep = hi ? d[16 + i] : d[i], send = hi ? d[i] : d[16 + i]; r16[i] = keep + __shfl_xor(send, 8); } }
    { const bool hi = dc & 4;
#pragma unroll
      for (int i = 0; i < 8; ++i) { const float keep = hi ? r16[8 + i] : r16[i], send = hi ? r16[i] : r16[8 + i]; r8[i] = keep + __shfl_xor(send, 4); } }
    { const bool hi = dc & 2;
#pragma unroll
      for (int i = 0; i < 4; ++i) { const float keep = hi ? r8[4 + i] : r8[i], send = hi ? r8[i] : r8[4 + i]; r4[i] = keep + __shfl_xor(send, 2); } }
    { const bool hi = dc & 1;
#pragma unroll
      for (int i = 0; i < 2; ++i) { const float keep = hi ? r4[2 + i] : r4[i], send = hi ? r4[i] : r4[2 + i]; r2[i] = keep + __shfl_xor(send, 1); } }
    const int j0 = (dc >> 3) * 64 + ((2 * dc) & 15) * 4 + ps;
    part[(size_t)t * 128 + j0] = r2[0];
    part[(size_t)t * 128 + j0 + 4] = r2[1];
    ev0 = nev0; ev1 = nev1; hr = nhr;
  }
}
DI void phase_ffn_w(const Params& p) {
  char* ws = p.ws;
  const int lane = otid() & 63, wave = otid() >> 6;
  const float* part = (const float*)(ws + OFF_PART);
  const float* scu = (const float*)(ws + OFF_SCU); const float* scv = (const float*)(ws + OFF_SCV);
  const int* eidx = (const int*)(ws + OFF_EIDX);
  const float* pgate = (const float*)(ws + OFF_PGATE);
  float* wbuf = (float*)(ws + OFF_WBUF);
  for (int grp = blockIdx.x; grp < NTOK / NW; grp += gridDim.x) {
    const size_t o = (size_t)(grp * NW + wave) * 128 + lane;
    float a0 = 0.f, a1 = 0.f;
#pragma unroll
    for (int s8 = 0; s8 < 8; ++s8) { a0 += part[(size_t)s8 * NTOK * 128 + o]; a1 += part[(size_t)s8 * NTOK * 128 + o + 64]; }
    const int e0 = eidx[o], e1 = eidx[o + 64];
    wbuf[o] = pgate[o] * gelu_f(a0 * scu[e0]) * scv[e0];
    wbuf[o + 64] = pgate[o + 64] * gelu_f(a1 * scu[e1]) * scv[e1];
  }
}
DI void phase_ffn_v(const Params& p) {
  char* ws = p.ws;
  const int lane = otid() & 63, wave = otid() >> 6, ps = lane >> 4, dc = lane & 15;
  const int sl = blockIdx.x & 7, wslot = (blockIdx.x >> 3) * NW + wave, nw = (gridDim.x >> 3) * NW;
  const unsigned char* PV8 = (const unsigned char*)(ws + OFF_PV8) + (size_t)sl * 16384 * 128 + dc * 8;
  const int* eidx = (const int*)(ws + OFF_EIDX);
  const float* wbuf = (const float*)(ws + OFF_WBUF);
  bf16_t* ffnb = (bf16_t*)(ws + OFF_FFNB);
  int ev0 = 0, ev1 = 0, nev0 = 0, nev1 = 0; float w0 = 0.f, w1 = 0.f, nw0 = 0.f, nw1 = 0.f;
  if (wslot < NTOK) { ev0 = eidx[(size_t)wslot * 128 + lane]; ev1 = eidx[(size_t)wslot * 128 + 64 + lane]; w0 = wbuf[(size_t)wslot * 128 + lane]; w1 = wbuf[(size_t)wslot * 128 + 64 + lane]; }
  for (int t = wslot; t < NTOK; t += nw) {
    if (t + nw < NTOK) { const size_t o = (size_t)(t + nw) * 128; nev0 = eidx[o + lane]; nev1 = eidx[o + 64 + lane]; nw0 = wbuf[o + lane]; nw1 = wbuf[o + 64 + lane]; }
#define FFV_LD(it) const u32x2 rv##it = *(const u32x2*)(PV8 + (size_t)__shfl((it) < 16 ? ev0 : ev1, ((it) & 15) * 4 + ps) * 128);
#define FFV_CP(it) { const float wj = __shfl((it) < 16 ? w0 : w1, ((it) & 15) * 4 + ps); \
      const f32x2 a0 = __builtin_amdgcn_cvt_pk_f32_fp8((int)rv##it.x, false), a1 = __builtin_amdgcn_cvt_pk_f32_fp8((int)rv##it.x, true); \
      const f32x2 b0 = __builtin_amdgcn_cvt_pk_f32_fp8((int)rv##it.y, false), b1 = __builtin_amdgcn_cvt_pk_f32_fp8((int)rv##it.y, true); \
      acc[0] += wj * a0.x; acc[1] += wj * a0.y; acc[2] += wj * a1.x; acc[3] += wj * a1.y; \
      acc[4] += wj * b0.x; acc[5] += wj * b0.y; acc[6] += wj * b1.x; acc[7] += wj * b1.y; }
    FOR32(FFV_LD)
    float acc[8];
#pragma unroll
    for (int i = 0; i < 8; ++i) acc[i] = 0.f;
    FOR32(FFV_CP)
#pragma unroll
    for (int i = 0; i < 8; ++i) { acc[i] += __shfl_xor(acc[i], 16); acc[i] += __shfl_xor(acc[i], 32); }
    if (ps == 0) *(u32x4*)(ffnb + (size_t)t * DM + sl * 128 + dc * 8) = pack8(acc);
    ev0 = nev0; ev1 = nev1; w0 = nw0; w1 = nw1;
  }
}
DI void phase_final(const Params& p) {
  char* ws = p.ws;
  const int lane = otid() & 63, wave = otid() >> 6;
  const float* x1 = (const float*)(ws + OFF_X1);
  const bf16_t* ffnb = (const bf16_t*)(ws + OFF_FFNB);
  const float* mod = (const float*)(ws + OFF_MOD);
  for (int grp = blockIdx.x; grp < NTOK / NW; grp += gridDim.x) {
    const int row = grp * NW + wave, b = row >> 13;
    float v[16];
#pragma unroll
    for (int i = 0; i < 4; ++i) {
      const int col = i * 256 + lane * 4;
      const f32x4 xv = *(const f32x4*)(x1 + (size_t)row * DM + col), gt2 = *(const f32x4*)(mod + b * 6144 + 5120 + col);
      const u32x2 fr = *(const u32x2*)(ffnb + (size_t)row * DM + col);
      v[4 * i] = DN_ALPHA * xv.x + gt2.x * bflo(fr.x); v[4 * i + 1] = DN_ALPHA * xv.y + gt2.y * bfhi(fr.x);
      v[4 * i + 2] = DN_ALPHA * xv.z + gt2.z * bflo(fr.y); v[4 * i + 3] = DN_ALPHA * xv.w + gt2.w * bfhi(fr.y);
    }
    float mean, rstd; row_stats(v, mean, rstd);
#pragma unroll
    for (int i = 0; i < 4; ++i) {
      const int col = i * 256 + lane * 4;
      const f32x4 g = *(const f32x4*)(p.ln2_g + col), bb = *(const f32x4*)(p.ln2_b + col);
      f32x4 o;
      o.x = (v[4 * i] - mean) * rstd * g.x + bb.x; o.y = (v[4 * i + 1] - mean) * rstd * g.y + bb.y;
      o.z = (v[4 * i + 2] - mean) * rstd * g.z + bb.z; o.w = (v[4 * i + 3] - mean) * rstd * g.w + bb.w;
      *(f32x4*)(p.out + (size_t)row * DM + col) = o;
    }
  }
}

#define XB_TMO      128
#define XB_XCNT(j)  (256  + 64 * (j))
#define XB_XSUB(j)  (1280 + 64 * (j))
#define XB_XGEN(j)  (2304 + 64 * (j))
#define XB_TOP      3328
#define XB_TOPGEN   3392
#define XCD_BAR_WORDS 3456
#define XB_SPIN_CAP (1u << 22)
DI unsigned xb_ld(unsigned* p) { return __hip_atomic_load(p, __ATOMIC_RELAXED, __HIP_MEMORY_SCOPE_AGENT); }
DI unsigned xb_add(unsigned* p, unsigned v) { return __hip_atomic_fetch_add(p, v, __ATOMIC_RELAXED, __HIP_MEMORY_SCOPE_AGENT); }
DI unsigned xb_xcc_id() { return (unsigned)__builtin_amdgcn_s_getreg((3 << 11) | 20) & 0xFu; }
#define XB_SPIN(cond, bar) do { unsigned _sp = 0; while (cond) { __builtin_amdgcn_s_sleep(1); \
    if ((++_sp & 255u) == 0u) { if (xb_ld(&(bar)[XB_TMO])) break; if (_sp > XB_SPIN_CAP) { atomicAdd(&(bar)[XB_TMO], 1u); break; } } } } while (0)
struct XcdBarrier { unsigned* bar; unsigned x; volatile LAS unsigned* st; };
DI XcdBarrier xcd_barrier_post(unsigned* bar, volatile LAS unsigned* st) {
  XcdBarrier b; b.bar = bar; b.x = xb_xcc_id(); b.st = st;
  if (threadIdx.x == 0) (void)xb_add(&bar[XB_XCNT(b.x)], 1u);
  return b;
}
DI void xcd_barrier_complete(unsigned* bar, unsigned x, unsigned& nloc, unsigned& nx) {
  const unsigned G = gridDim.x * gridDim.y * gridDim.z;
  unsigned sum, cnt, mine, sp = 0u;
  for (;;) {
    sum = 0u; cnt = 0u; mine = 0u;
#pragma unroll
    for (unsigned j = 0; j < 16; ++j) { const unsigned c = xb_ld(&bar[XB_XCNT(j)]); sum += c; cnt += (c > 0u) ? 1u : 0u; mine = (j == x) ? c : mine; }
    if (sum == G) break;
    __builtin_amdgcn_s_sleep(1);
    if ((++sp & 255u) == 0u) { if (xb_ld(&bar[XB_TMO])) break; if (sp > XB_SPIN_CAP) { atomicAdd(&bar[XB_TMO], 1u); break; } }
  }
  nloc = mine > 0u ? mine : 1u; nx = cnt > 0u ? cnt : 1u;
}
DI void xcd_barrier(const XcdBarrier& b) {
  asm volatile("s_waitcnt vmcnt(0)" ::: "memory");
  __syncthreads();
  if (threadIdx.x == 0) {
    unsigned* bar = b.bar;
    __builtin_amdgcn_s_waitcnt(0);
    unsigned nloc = b.st[0], nx = b.st[1];
    if (nloc == 0u) { xcd_barrier_complete(bar, b.x, nloc, nx); b.st[0] = nloc; b.st[1] = nx; }
    const unsigned old = xb_add(&bar[XB_XSUB(b.x)], 1u);
    const unsigned gen = old / nloc;
    if (old + 1u == (gen + 1u) * nloc) {
      __builtin_amdgcn_fence(__ATOMIC_RELEASE, "agent");
      asm volatile("s_waitcnt vmcnt(0)" ::: "memory");
      const unsigned og = xb_add(&bar[XB_TOP], 1u);
      const unsigned tg = og / nx;
      if (og + 1u == (tg + 1u) * nx) xb_add(&bar[XB_TOPGEN], 1u);
      else XB_SPIN(xb_ld(&bar[XB_TOPGEN]) == tg, bar);
      __builtin_amdgcn_fence(__ATOMIC_ACQUIRE, "agent");
      xb_add(&bar[XB_XGEN(b.x)], 1u);
      asm volatile("s_waitcnt vmcnt(0)" ::: "memory");
    } else {
      XB_SPIN(xb_ld(&bar[XB_XGEN(b.x)]) == gen, bar);
      __builtin_amdgcn_fence(__ATOMIC_ACQUIRE, "agent");
      asm volatile("s_waitcnt vmcnt(0)" ::: "memory");
    }
  }
  __syncthreads();
}

constexpr int SMEM_BYTES = 131072 + 256;

__global__ void __launch_bounds__(NT, 2) k_mega(Params p) {
  __shared__ __attribute__((aligned(16))) char smem[SMEM_BYTES];
  cg::grid_group grid = cg::this_grid();
  if (threadIdx.x == 0) *(u32x4*)(smem + 131072) = (u32x4){0u, 0u, 0u, 0u};
  __syncthreads();
  const XcdBarrier xb = xcd_barrier_post((unsigned*)(p.ws + OFF_BAR), (volatile LAS unsigned*)(smem + 131072));
#define REP(mask) _Pragma("unroll 1") for (int rep_ = 0; rep_ < ((PROBE_DUP & (mask)) ? 2 : 1); ++rep_)
  REP(1) phase_prep(p, smem);
  grid.sync();
  REP(1) phase_ln_in(p);
  xcd_barrier(xb);
  REP(2) phase_gemm1(p, smem);
  xcd_barrier(xb);
  REP(4) phase_compress(p, smem);
  phase_sgu(p, smem);
  xcd_barrier(xb);
  REP(8) phase_nsa(p, smem, NSA_MASK);
  xcd_barrier(xb);
  REP(16) phase_merge(p, smem);
  xcd_barrier(xb);
  REP(16) phase_outproj(p, smem);
  xcd_barrier(xb);
  REP(1) phase_ln_mid(p);
  xcd_barrier(xb);
  REP(32) phase_peerq(p, smem);
  xcd_barrier(xb);
  REP(64) phase_route(p, smem);
  xcd_barrier(xb);
  REP(128) phase_ffn_u(p);
  xcd_barrier(xb);
  REP(128) phase_ffn_w(p);
  xcd_barrier(xb);
  REP(256) phase_ffn_v(p);
  xcd_barrier(xb);
  REP(512) phase_final(p);
}

extern "C" void kernel_launch(void* const* d_in, const int* in_sizes, int n_in, void* d_out, int out_size, void* d_ws, size_t ws_size, hipStream_t stream) {
  if (ws_size < OFF_END) { fprintf(stderr, "workspace too small: %zu < %zu\n", ws_size, (size_t)OFF_END); return; }
  static int grid_blocks = 0;
  if (!grid_blocks) {
    int dev = 0, cus = 0, per_cu = 0;
    (void)hipGetDevice(&dev);
    (void)hipDeviceGetAttribute(&cus, hipDeviceAttributeMultiprocessorCount, dev);
    (void)hipOccupancyMaxActiveBlocksPerMultiprocessor(&per_cu, k_mega, NT, 0);
    if (per_cu < 1) fprintf(stderr, "occupancy query returned %d\n", per_cu);
    grid_blocks = (cus / 8) * 8;
  }
  Params p{};
  const float** fp = (const float**)&p;
  for (int i = 0; i < 26; ++i) fp[i] = (const float*)d_in[i];
  p.out = (float*)d_out;
  p.ws = (char*)d_ws;
  for (int i = 0; i < 32; ++i) p.inv_freq[i] = (float)pow(10000.0, -(double)i / 32.0);
  (void)hipMemsetAsync((char*)d_ws + OFF_BAR, 0, XCD_BAR_WORDS * 4, stream);
  void* args[] = {&p};
  hipError_t e = hipLaunchCooperativeKernel((void*)k_mega, dim3(grid_blocks), dim3(NT), args, 0, stream);
  if (e != hipSuccess) fprintf(stderr, "cooperative launch failed: %s (grid %d)\n", hipGetErrorString(e), grid_blocks);
}
```

```cpp
#include <hip/hip_runtime.h>
#include <hip/hip_cooperative_groups.h>
#include <stdint.h>
#include <stdio.h>
#include <math.h>
namespace cg = cooperative_groups;

#ifndef PROBE_DUP
#define PROBE_DUP 0
#endif
#ifndef NSA_MASK
#define NSA_MASK 7
#endif
typedef unsigned short bf16_t;
typedef short bf16x8 __attribute__((ext_vector_type(8)));
typedef short s16x4 __attribute__((ext_vector_type(4)));
typedef float f32x16 __attribute__((ext_vector_type(16)));
typedef float f32x4 __attribute__((ext_vector_type(4)));
typedef float f32x2 __attribute__((ext_vector_type(2)));
typedef __bf16 bf16v2 __attribute__((ext_vector_type(2)));
typedef unsigned u32x4 __attribute__((ext_vector_type(4)));
typedef unsigned u32x2 __attribute__((ext_vector_type(2)));
#define DI __device__ __forceinline__
#define LAS __attribute__((address_space(3)))
#define MFMA32(a, b, c) __builtin_amdgcn_mfma_f32_32x32x16_bf16((a), (b), (c), 0, 0, 0)

constexpr int NT = 512, NW = 8;
constexpr int NB = 8, SEQ = 8192, DM = 1024, NTOK = NB * SEQ;
constexpr int N1 = 4608;
constexpr float DN_ALPHA = 1.189207115002721f;
constexpr float LN_EPS = 1e-5f;

constexpr size_t MB = 1024 * 1024;
constexpr size_t OFF_MOD = 0;
constexpr size_t OFF_ROPE = OFF_MOD + 256 * 1024;
constexpr size_t OFF_POSB = OFF_ROPE + 2 * MB;
constexpr size_t OFF_WT1 = OFF_POSB + 4096;
constexpr size_t OFF_WB = OFF_WT1 + (size_t)N1 * 1024 * 2;
constexpr size_t OFF_WOUT = OFF_WB + 2 * MB;
constexpr size_t OFF_WQ = OFF_WOUT + 2 * MB;
constexpr size_t OFF_PKEYS = OFF_WQ + 4 * MB;
constexpr size_t OFF_CW1 = OFF_PKEYS + MB / 2;
constexpr size_t OFF_CW2 = OFF_CW1 + MB;
constexpr size_t OFF_SGUW = OFF_CW2 + 32 * 1024;
constexpr size_t OFF_SCU = OFF_SGUW + 256 * 1024;
constexpr size_t OFF_SCV = OFF_SCU + 64 * 1024;
constexpr size_t OFF_PU = OFF_SCV + 64 * 1024;
constexpr size_t OFF_PV = OFF_PU + 32 * MB;
constexpr size_t OFF_ACT = ((OFF_PV + 32 * MB + 4095) / 4096) * 4096;
constexpr size_t OFF_H = OFF_ACT;
constexpr size_t OFF_Q = OFF_H + 128 * MB;
constexpr size_t OFF_KC = OFF_Q + 64 * MB;
constexpr size_t OFF_VC = OFF_KC + 16 * MB;
constexpr size_t OFF_KS = OFF_VC + 16 * MB;
constexpr size_t OFF_VS = OFF_KS + 16 * MB;
constexpr size_t OFF_KW = OFF_VS + 16 * MB;
constexpr size_t OFF_VW = OFF_KW + 16 * MB;
constexpr size_t OFF_U = OFF_VW + 16 * MB;
constexpr size_t OFF_V = OFF_U + 64 * MB;
constexpr size_t OFF_GATE = OFF_V + 64 * MB;
constexpr size_t OFF_GSIG = OFF_GATE + 256 * MB;
constexpr size_t OFF_KCMP = OFF_GSIG + 8 * MB;
constexpr size_t OFF_VCMP = OFF_KCMP + MB;
constexpr size_t OFF_ONSA = OFF_VCMP + MB;
constexpr size_t OFF_SELG = OFF_ONSA + 64 * MB;
constexpr size_t OFF_BAR = OFF_SELG + 2 * MB;
constexpr size_t OFF_END = OFF_BAR + 64 * 1024;
constexpr size_t OFF_X1 = OFF_Q;
constexpr size_t OFF_Y = OFF_GATE;
constexpr size_t OFF_PQ = OFF_GATE;
constexpr size_t OFF_EIDX = OFF_ONSA;
constexpr size_t OFF_PGATE = OFF_ONSA + 32 * MB;
constexpr size_t OFF_PU8 = OFF_PU;
constexpr size_t OFF_PART = OFF_GATE;
constexpr size_t OFF_PV8 = OFF_PU + 16 * MB;
constexpr size_t OFF_WBUF = OFF_PU + 32 * MB;
constexpr size_t OFF_FFNB = OFF_GATE;

struct Params {
  const float *x, *c, *w_ada, *b_ada, *w_in, *cmp_pos, *cmp_w1, *cmp_b1, *cmp_w2, *cmp_b2, *sgu_ln_g, *sgu_ln_b, *sgu_w, *sgu_b,
      *w_branch, *w_merge, *b_merge, *w_out, *ln1_g, *ln1_b, *peer_wq, *peer_keys, *peer_u, *peer_v, *ln2_g, *ln2_b;
  float* out;
  char* ws;
  float inv_freq[32];
};

DI unsigned pack2(float lo, float hi) { f32x2 v = {lo, hi}; bf16v2 r = __builtin_convertvector(v, bf16v2); return __builtin_bit_cast(unsigned, r); }
DI bf16_t f2bf(float f) { __bf16 r = (__bf16)f; return __builtin_bit_cast(unsigned short, r); }
DI float bf2f(bf16_t h) { return __uint_as_float(((unsigned)h) << 16); }
DI float bflo(unsigned u) { return __uint_as_float(u << 16); }
DI float bfhi(unsigned u) { return __uint_as_float(u & 0xffff0000u); }
DI float gelu_f(float v) { return 0.5f * v * (1.0f + erff(v * 0.70710678118654752f)); }
DI float sigmoid_f(float v) { return 1.0f / (1.0f + __expf(-v)); }
DI int otid() { int t = __builtin_amdgcn_workitem_id_x(); asm volatile("" : "+v"(t)); return t; }
DI float wave_sum(float v) {
#pragma unroll
  for (int o = 32; o > 0; o >>= 1) v += __shfl_xor(v, o);
  return v;
}
DI void ld8(const float* pz, float (&v)[8]) { const f32x4 a = *(const f32x4*)pz, b = *(const f32x4*)(pz + 4); v[0] = a.x; v[1] = a.y; v[2] = a.z; v[3] = a.w; v[4] = b.x; v[5] = b.y; v[6] = b.z; v[7] = b.w; }
DI u32x4 pack8(const float (&v)[8]) { u32x4 w; w.x = pack2(v[0], v[1]); w.y = pack2(v[2], v[3]); w.z = pack2(v[4], v[5]); w.w = pack2(v[6], v[7]); return w; }
DI void unpack8(const u32x4 w, float (&v)[8]) { v[0] = bflo(w.x); v[1] = bfhi(w.x); v[2] = bflo(w.y); v[3] = bfhi(w.y); v[4] = bflo(w.z); v[5] = bfhi(w.z); v[6] = bflo(w.w); v[7] = bfhi(w.w); }
DI f32x2 gelu_pk(f32x2 v) {
  const f32x2 av = __builtin_elementwise_abs(v), d = av * 0.2316418882f + 1.0f;
  f32x2 t; t.x = __builtin_amdgcn_rcpf(d.x); t.y = __builtin_amdgcn_rcpf(d.y);
  f32x2 q = t * 0.5307027145f + (-0.7265760135f); q = q * t + 0.7107068705f; q = q * t + (-0.142248368f); q = q * t + 0.127414796f; q = q * t;
  const f32x2 s = (v * v) * (-0.72134752044f);
  f32x2 e; e.x = __builtin_amdgcn_exp2f(s.x); e.y = __builtin_amdgcn_exp2f(s.y);
  const f32x2 m = v * (q * e), r = v - m;
  f32x2 o; o.x = v.x < 0.f ? m.x : r.x; o.y = v.y < 0.f ? m.y : r.y; return o;
}
__host__ __device__ __forceinline__ int dperm(int q) { const int grp = q >> 5, fq = (q >> 3) & 3, j = q & 7; return (j < 4) ? (16 * grp + 4 * fq + j) : (32 + 16 * grp + 4 * fq + (j - 4)); }

template <class F>
DI void tconv_tile(float* tile, int k0, int n0, bf16_t* dst, int ldd, F f) {
  const int tid = otid();
  __syncthreads();
#pragma unroll 4
  for (int i = 0; i < 8; ++i) { const int kl = i * 8 + (tid >> 6), nl = tid & 63; tile[nl * 65 + kl] = f(k0 + kl, n0 + nl); }
  __syncthreads();
  {
    const int nl = tid >> 3, kc = tid & 7;
    const float* t = tile + nl * 65 + kc * 8;
    u32x4 w; w.x = pack2(t[0], t[1]); w.y = pack2(t[2], t[3]); w.z = pack2(t[4], t[5]); w.w = pack2(t[6], t[7]);
    *(u32x4*)(dst + (size_t)(n0 + nl) * ldd + k0 + kc * 8) = w;
  }
}

DI void conv_chunk(const float* src, bf16_t* dst, size_t base) {
  const size_t i = base + (size_t)otid() * 8;
  const f32x4 a = *(const f32x4*)(src + i), b = *(const f32x4*)(src + i + 4);
  u32x4 w; w.x = pack2(a.x, a.y); w.y = pack2(a.z, a.w); w.z = pack2(b.x, b.y); w.w = pack2(b.z, b.w);
  *(u32x4*)(dst + i) = w;
}

DI void sincos_d(double x, double& s, double& c) {
  const double y = x * 0.25, y2 = y * y;
  double sn = y * (1.0 + y2 * (-1.0 / 6 + y2 * (1.0 / 120 + y2 * (-1.0 / 5040 + y2 * (1.0 / 362880 + y2 * (-1.0 / 39916800 + y2 * (1.0 / 6227020800.0)))))));
  double cs = 1.0 + y2 * (-0.5 + y2 * (1.0 / 24 + y2 * (-1.0 / 720 + y2 * (1.0 / 40320 + y2 * (-1.0 / 3628800 + y2 * (1.0 / 479001600.0 + y2 * (-1.0 / 87178291200.0)))))));
#pragma unroll
  for (int i = 0; i < 2; ++i) { const double s2 = 2.0 * sn * cs, c2 = cs * cs - sn * sn; sn = s2; cs = c2; }
  s = sn; c = cs;
}

DI void phase_prep(const Params& p, char* smem) {
  const int tid = otid();
  float* fs = (float*)smem;
  char* ws = p.ws;
  constexpr int nA = 192, nB = 16 * 72, nC = 2 * 8 * 16, nD = 256, nE = 16 * 32, nF = 2 * 32 * 2, nG = 4, nH = 8, nI = 512, nJ = 64, nK = 32, nL = 2048, nM = 2048;
  constexpr int total = nA + nB + nC + nD + nE + nF + nG + nH + nI + nJ + nK + nL + nM;
  for (int item = blockIdx.x; item < total; item += gridDim.x) {
    int it = item;
    if (it < nA) {
      float* sc = fs;
      float* red = fs + 8192;
      __syncthreads();
      for (int i = tid; i < 8192; i += NT) { const float v = p.c[i]; sc[i] = v / (1.0f + __expf(-v)); }
      __syncthreads();
      const int ks = tid >> 5, cj = tid & 31, col = it * 32 + cj;
      float acc[8];
#pragma unroll
      for (int b = 0; b < 8; ++b) acc[b] = 0.f;
#pragma unroll 4
      for (int k = ks * 64; k < ks * 64 + 64; ++k) {
        const float w = p.w_ada[(size_t)k * 6144 + col];
#pragma unroll
        for (int b = 0; b < 8; ++b) acc[b] += sc[b * 1024 + k] * w;
      }
#pragma unroll
      for (int b = 0; b < 8; ++b) red[(ks * 8 + b) * 32 + cj] = acc[b];
      __syncthreads();
      if (tid < 256) {
        const int b = tid >> 5;
        float s = p.b_ada[col];
#pragma unroll
        for (int k2 = 0; k2 < 16; ++k2) s += red[(k2 * 8 + b) * 32 + cj];
        ((float*)(ws + OFF_MOD))[b * 6144 + col] = s;
      }
      continue;
    }
    it -= nA;
    if (it < nB) {
      const int kt = it / 72, ntile = it % 72;
      const float* w_in = p.w_in; const float* w_merge = p.w_merge;
      tconv_tile(fs, kt * 64, ntile * 64, (bf16_t*)(ws + OFF_WT1), 1024, [=](int k, int n) -> float {
        if (n < 1280) {
          const bool roped = (n < 640) || (n >= 768 && n < 896) || (n >= 1024 && n < 1152);
          const int col = roped ? ((n & ~63) + dperm(n & 63)) : n;
          return w_in[(size_t)k * 2328 + col];
        }
        if (n < 2304) return w_in[(size_t)k * 2328 + n + 24];
        if (n < 4352) return w_merge[(size_t)k * 2048 + (n - 2304)];
        if (n < 4376) return w_in[(size_t)k * 2328 + 1280 + (n - 4352)];
        return 0.f; });
      continue;
    }
    it -= nB;
    if (it < nC) {
      const int br = it >> 7, r = it & 127, kt = r >> 4, ntile = r & 15;
      const float* src = p.w_branch + (size_t)br * 512 * 1024;
      tconv_tile(fs, kt * 64, ntile * 64, (bf16_t*)(ws + OFF_WB) + (size_t)br * 1024 * 512, 512, [=](int k, int n) -> float { return src[(size_t)k * 1024 + n]; });
      continue;
    }
    it -= nC;
    if (it < nD) {
      const int kt = it >> 4, ntile = it & 15;
      const float* src = p.w_out;
      tconv_tile(fs, kt * 64, ntile * 64, (bf16_t*)(ws + OFF_WOUT), 1024, [=](int k, int n) -> float { return src[(size_t)k * 1024 + n]; });
      continue;
    }
    it -= nD;
    if (it < nE) {
      const int kt = it >> 5, ntile = it & 31;
      const float* src = p.peer_wq;
      tconv_tile(fs, kt * 64, ntile * 64, (bf16_t*)(ws + OFF_WQ), 1024, [=](int k, int n) -> float { return src[(size_t)k * 2048 + n]; });
      continue;
    }
    it -= nE;
    if (it < nF) {
      const int w = it >> 6, r = it & 63, kt = r >> 1, ntile = r & 1;
      const float* src = p.cmp_w1 + (size_t)w * 2048 * 128;
      tconv_tile(fs, kt * 64, ntile * 64, (bf16_t*)(ws + OFF_CW1) + (size_t)w * 128 * 2048, 2048, [=](int k, int n) -> float {
        const int ksrc = (w == 0) ? ((k & ~63) + dperm(k & 63)) : k;
        return src[(size_t)ksrc * 128 + n]; });
      continue;
    }
    it -= nF;
    if (it < nG) {
      const int w = it >> 1, kt = it & 1;
      const float* src = p.cmp_w2 + (size_t)w * 128 * 64;
      tconv_tile(fs, kt * 64, 0, (bf16_t*)(ws + OFF_CW2) + (size_t)w * 64 * 128, 128, [=](int k, int n) -> float { return src[(size_t)k * 64 + ((w == 0) ? dperm(n) : n)]; });
      continue;
    }
    it -= nG;
    if (it < nH) {
      const int w = it >> 2, jc = it & 3, ks = tid >> 5, cj = tid & 31, j = jc * 32 + cj;
      float* red = fs;
      const float* pos = p.cmp_pos + w * 2048; const float* w1 = p.cmp_w1 + (size_t)w * 2048 * 128;
      float acc = 0.f;
#pragma unroll 4
      for (int k = ks * 128; k < ks * 128 + 128; ++k) acc += pos[k] * w1[(size_t)k * 128 + j];
      __syncthreads();
      red[ks * 32 + cj] = acc;
      __syncthreads();
      if (tid < 32) { float s = p.cmp_b1[w * 128 + j]; for (int k2 = 0; k2 < 16; ++k2) s += red[k2 * 32 + tid]; ((float*)(ws + OFF_POSB))[w * 128 + j] = s; }
      continue;
    }
    it -= nH;
    if (it < nI) {
      const int e = it * 512 + tid, pos = e >> 5, i = e & 31;
      const float ang = (float)pos * p.inv_freq[i];
      const double a = (double)ang;
      const double kk = rint(a * 0.15915494309189535);
      const double r = a - kk * 6.283185307179586476925;
      double s, c; sincos_d(r, s, c);
      ((float*)(ws + OFF_ROPE))[e] = (float)c;
      ((float*)(ws + OFF_ROPE))[262144 + e] = (float)s;
      continue;
    }
    it -= nI;
    if (it < nJ) { conv_chunk(p.peer_keys, (bf16_t*)(ws + OFF_PKEYS), (size_t)it * 4096); continue; }
    it -= nJ;
    if (it < nK) {
      const size_t i0 = (size_t)it * 4096 + (size_t)tid * 8;
      const int rowi = (int)((i0 >> 7) & 127), j0 = (int)(i0 & 127);
      float v[8];
#pragma unroll
      for (int j = 0; j < 8; ++j) v[j] = (j0 + j <= rowi) ? p.sgu_w[i0 + j] : 0.f;
      u32x4 w; w.x = pack2(v[0], v[1]); w.y = pack2(v[2], v[3]); w.z = pack2(v[4], v[5]); w.w = pack2(v[6], v[7]);
      *(u32x4*)((bf16_t*)(ws + OFF_SGUW) + i0) = w;
      continue;
    }
    it -= nK;
    {
      const bool isv = it >= nL;
      if (isv) it -= nL;
      const int lane = tid & 63, e = it * 8 + (tid >> 6);
      const float* src = (isv ? p.peer_v : p.peer_u) + (size_t)e * 1024 + lane * 16;
      float v[16];
#pragma unroll
      for (int i = 0; i < 4; ++i) { const f32x4 t4 = *(const f32x4*)(src + i * 4); v[4 * i] = t4.x; v[4 * i + 1] = t4.y; v[4 * i + 2] = t4.z; v[4 * i + 3] = t4.w; }
      float amax = 0.f;
#pragma unroll
      for (int i = 0; i < 16; ++i) amax = fmaxf(amax, fabsf(v[i]));
#pragma unroll
      for (int o = 32; o > 0; o >>= 1) amax = fmaxf(amax, __shfl_xor(amax, o));
      const unsigned be = (__float_as_uint(amax) >> 23) & 0xffu;
      const bool okr = be >= 16u && be <= 240u;
      const float scale = okr ? __uint_as_float((261u - be) << 23) : 1.0f;
      const float inv = okr ? __uint_as_float((be - 7u) << 23) : 1.0f;
      u32x4 w;
      int t0 = 0, t1 = 0, t2 = 0, t3 = 0;
      t0 = __builtin_amdgcn_cvt_pk_fp8_f32(v[0] * scale, v[1] * scale, t0, false); t0 = __builtin_amdgcn_cvt_pk_fp8_f32(v[2] * scale, v[3] * scale, t0, true);
      t1 = __builtin_amdgcn_cvt_pk_fp8_f32(v[4] * scale, v[5] * scale, t1, false); t1 = __builtin_amdgcn_cvt_pk_fp8_f32(v[6] * scale, v[7] * scale, t1, true);
      t2 = __builtin_amdgcn_cvt_pk_fp8_f32(v[8] * scale, v[9] * scale, t2, false); t2 = __builtin_amdgcn_cvt_pk_fp8_f32(v[10] * scale, v[11] * scale, t2, true);
      t3 = __builtin_amdgcn_cvt_pk_fp8_f32(v[12] * scale, v[13] * scale, t3, false); t3 = __builtin_amdgcn_cvt_pk_fp8_f32(v[14] * scale, v[15] * scale, t3, true);
      w.x = (unsigned)t0; w.y = (unsigned)t1; w.z = (unsigned)t2; w.w = (unsigned)t3;
      if (!isv) {
        *(u32x4*)(ws + OFF_PU8 + ((size_t)(lane >> 3) * 16384 + e) * 128 + (lane & 7) * 16) = w;
        if (lane == 0) ((float*)(ws + OFF_SCU))[e] = inv;
      } else {
        *(u32x4*)(ws + OFF_PV8 + ((size_t)(lane >> 3) * 16384 + e) * 128 + (lane & 7) * 16) = w;
        if (lane == 0) ((float*)(ws + OFF_SCV))[e] = inv;
      }
    }
  }
}

DI void row_stats(const float (&v)[16], float& mean, float& rstd) {
  float s = 0.f;
#pragma unroll
  for (int i = 0; i < 16; ++i) s += v[i];
  mean = wave_sum(s) * (1.0f / 1024.0f);
  float q = 0.f;
#pragma unroll
  for (int i = 0; i < 16; ++i) { const float d = v[i] - mean; q += d * d; }
  rstd = rsqrtf(wave_sum(q) * (1.0f / 1024.0f) + LN_EPS);
}

DI void phase_ln_in(const Params& p) {
  const int lane = otid() & 63, wave = otid() >> 6;
  const float* mod = (const float*)(p.ws + OFF_MOD);
  bf16_t* h = (bf16_t*)(p.ws + OFF_H);
  for (int grp = blockIdx.x; grp < NTOK / NW; grp += gridDim.x) {
    const int row = grp * NW + wave, b = row >> 13;
    const float* xr = p.x + (size_t)row * DM;
    float v[16];
#pragma unroll
    for (int i = 0; i < 4; ++i) { const f32x4 t = *(const f32x4*)(xr + i * 256 + lane * 4); v[4 * i] = t.x; v[4 * i + 1] = t.y; v[4 * i + 2] = t.z; v[4 * i + 3] = t.w; }
    float mean, rstd; row_stats(v, mean, rstd);
#pragma unroll
    for (int i = 0; i < 4; ++i) {
      const int col = i * 256 + lane * 4;
      const f32x4 sh = *(const f32x4*)(mod + b * 6144 + col), sc = *(const f32x4*)(mod + b * 6144 + 1024 + col);
      const float o0 = (v[4 * i] - mean) * rstd * (1.f + sc.x) + sh.x, o1 = (v[4 * i + 1] - mean) * rstd * (1.f + sc.y) + sh.y;
      const float o2 = (v[4 * i + 2] - mean) * rstd * (1.f + sc.z) + sh.z, o3 = (v[4 * i + 3] - mean) * rstd * (1.f + sc.w) + sh.w;
      u32x2 w; w.x = pack2(o0, o1); w.y = pack2(o2, o3);
      *(u32x2*)(h + (size_t)row * DM + col) = w;
    }
  }
}

DI void phase_ln_mid(const Params& p) {
  const int lane = otid() & 63, wave = otid() >> 6;
  const float* mod = (const float*)(p.ws + OFF_MOD);
  const bf16_t* y = (const bf16_t*)(p.ws + OFF_Y);
  bf16_t* x1 = (bf16_t*)(p.ws + OFF_X1);
  bf16_t* h2 = (bf16_t*)(p.ws + OFF_H);
  for (int grp = blockIdx.x; grp < NTOK / NW; grp += gridDim.x) {
    const int row = grp * NW + wave, b = row >> 13;
    const bf16_t* yr = y + (size_t)row * DM;
    float v[16];
#pragma unroll
    for (int i = 0; i < 4; ++i) { const u32x2 t = *(const u32x2*)(yr + i * 256 + lane * 4); v[4 * i] = bflo(t.x); v[4 * i + 1] = bfhi(t.x); v[4 * i + 2] = bflo(t.y); v[4 * i + 3] = bfhi(t.y); }
    float mean, rstd; row_stats(v, mean, rstd);
#pragma unroll
    for (int i = 0; i < 4; ++i) {
      const int col = i * 256 + lane * 4;
      const f32x4 g = *(const f32x4*)(p.ln1_g + col), bb = *(const f32x4*)(p.ln1_b + col);
      f32x4 o;
      o.x = (v[4 * i] - mean) * rstd * g.x + bb.x; o.y = (v[4 * i + 1] - mean) * rstd * g.y + bb.y;
      o.z = (v[4 * i + 2] - mean) * rstd * g.z + bb.z; o.w = (v[4 * i + 3] - mean) * rstd * g.w + bb.w;
      { u32x2 w; w.x = pack2(o.x, o.y); w.y = pack2(o.z, o.w); *(u32x2*)(x1 + (size_t)row * DM + col) = w; }
      v[4 * i] = o.x; v[4 * i + 1] = o.y; v[4 * i + 2] = o.z; v[4 * i + 3] = o.w;
    }
    row_stats(v, mean, rstd);
#pragma unroll
    for (int i = 0; i < 4; ++i) {
      const int col = i * 256 + lane * 4;
      const f32x4 sh = *(const f32x4*)(mod + b * 6144 + 3072 + col), sc = *(const f32x4*)(mod + b * 6144 + 4096 + col);
      const float o0 = (v[4 * i] - mean) * rstd * (1.f + sc.x) + sh.x, o1 = (v[4 * i + 1] - mean) * rstd * (1.f + sc.y) + sh.y;
      const float o2 = (v[4 * i + 2] - mean) * rstd * (1.f + sc.z) + sh.z, o3 = (v[4 * i + 3] - mean) * rstd * (1.f + sc.w) + sh.w;
      u32x2 w; w.x = pack2(o0, o1); w.y = pack2(o2, o3);
      *(u32x2*)(h2 + (size_t)row * DM + col) = w;
    }
  }
}

namespace pg8 {
constexpr int BM = 256, BK = 64, HALF = 128, HTB = HALF * BK * 2, STAGE_BYTES = 8 * HTB, NXCD = 8, WGM = 8;
DI int lds_byte(int r, int c) { const int st = (r >> 4) * 2 + (c >> 5), rr = r & 15, cc = c & 31, ob = rr * 64 + cc * 2; return st * 1024 + (ob ^ (((ob >> 9) & 1) << 5)); }
DI void stage_rc(int b, int& R, int& C) { const int st = b / 1024, sb = b % 1024, swz = sb ^ (((sb >> 9) & 1) << 5); R = (st >> 1) * 16 + swz / 64; C = (st & 1) * 32 + (swz % 64) / 2; }
DI int perm32(int rho) { const int n = rho >> 4, i = rho & 15; return 8 * (i >> 2) + 4 * n + (i & 3); }
struct Unit { int pm, pn; };
struct Gemm { const bf16_t* A; const bf16_t* Bt; int M, N, K; };
struct StaticOrder {
  int nM, nN, nwg, G, c;
  DI void init(int M, int N, int G_, int c_) { nM = M / BM; nN = N / BM; nwg = nM * nN; G = G_; c = c_; }
  DI bool next(int i, Unit& u) const {
    const long L = (long)i * G + c; if (L >= nwg) return false;
    int wgid = (int)L; { const int q = nwg / NXCD, r = nwg % NXCD, xcd = wgid % NXCD, off = wgid / NXCD; wgid = (xcd < r ? xcd * (q + 1) : r * (q + 1) + (xcd - r) * q) + off; }
    const int nig = WGM * nN, gid = wgid / nig, fm = gid * WGM, gsz = (nM - fm) < WGM ? (nM - fm) : WGM;
    u.pm = fm + ((wgid % nig) % gsz); u.pn = (wgid % nig) / gsz; return true;
  }
};

template <class Epi>
DI void gemm_phase(LAS unsigned char* lds, const Gemm g, const StaticOrder& S, const Epi& E) {
  const int tid = otid(), wid = __builtin_amdgcn_readfirstlane(tid >> 6), lane = tid & 63, wr = wid >> 2, wc = wid & 3, fr = lane & 15, fq = lane >> 4;
  const int K = g.K, nt = K / BK;
  unsigned voffA[2], voffB[2];
#pragma unroll
  for (int i = 0; i < 2; ++i) { int R, C; stage_rc(tid * 16 + i * 8192, R, C); const int Rb = Epi::PERM ? ((R & ~31) + perm32(R & 31)) : R;
    voffA[i] = (unsigned)(R * K + C) * 2u; voffB[i] = (unsigned)(Rb * K + C) * 2u; }
  const size_t kstep = (size_t)(BK * 2);
  const size_t hstep = (size_t)HALF * K * 2;
  const size_t tstep = 2 * hstep;
  const unsigned ldsw = (unsigned)wid * 1024u;
  const int aoff = lds_byte(wr * 64 + fr, fq * 8), boff = lds_byte(wc * 32 + fr, fq * 8);
#define PG8_SA(b, h) (((b) * 2 + (h)) * HTB)
#define PG8_SB(b, h) ((4 + (b) * 2 + (h)) * HTB)
#define PG8_STAGE(bufoff, gbase, voff) do { _Pragma("unroll") for (int _i = 0; _i < 2; ++_i) \
    __builtin_amdgcn_global_load_lds((const unsigned*)((const char*)(gbase) + (voff)[_i]), (LAS unsigned*)(lds + (bufoff) + ldsw + _i * 8192), 16, 0, 0); } while (0)
#define PG8_LDA(dst, b, h) do { _Pragma("unroll") for (int m = 0; m < 4; ++m) _Pragma("unroll") for (int k = 0; k < 2; ++k) dst[m][k] = *(const LAS bf16x8*)(lds + PG8_SA(b, h) + aoff + m * 2048 + k * 1024); } while (0)
#define PG8_LDB(dst, b, h) do { _Pragma("unroll") for (int n = 0; n < 2; ++n) _Pragma("unroll") for (int k = 0; k < 2; ++k) dst[n][k] = *(const LAS bf16x8*)(lds + PG8_SB(b, h) + boff + n * 2048 + k * 1024); } while (0)
#define PG8_MMA(ai, bj, At, Bt) do { __builtin_amdgcn_s_setprio(1); _Pragma("unroll") for (int m = 0; m < 4; ++m) _Pragma("unroll") for (int n = 0; n < 2; ++n) _Pragma("unroll") for (int k = 0; k < 2; ++k) \
    acc[ai][bj][m][n] = __builtin_amdgcn_mfma_f32_16x16x32_bf16(Bt[n][k], At[m][k], acc[ai][bj][m][n], 0, 0, 0); __builtin_amdgcn_s_setprio(0); } while (0)
#define PG8_WAIT_V(n) asm volatile("s_waitcnt vmcnt(" #n ")" ::: "memory")
#define PG8_WAIT_L(n) asm volatile("s_waitcnt lgkmcnt(" #n ")" ::: "memory")
#define PG8_BAR __builtin_amdgcn_s_barrier()
#define PG8_SCHED __builtin_amdgcn_sched_barrier(0)
  Unit cur, nxt; int ui = 0;
  if (!S.next(0, cur)) return;
  f32x4 acc[2][2][4][2];
#pragma unroll
  for (int a = 0; a < 2; ++a)
#pragma unroll
    for (int b = 0; b < 2; ++b)
#pragma unroll
      for (int m = 0; m < 4; ++m)
#pragma unroll
        for (int n = 0; n < 2; ++n) acc[a][b][m][n] = (f32x4){0.f, 0.f, 0.f, 0.f};
  bf16x8 At[4][2], B0[2][2], B1[2][2];
  const char* cA = (const char*)g.A + (size_t)cur.pm * tstep; const char* cB = (const char*)g.Bt + (size_t)cur.pn * tstep;
  PG8_STAGE(PG8_SB(0, 0), cB, voffB); PG8_STAGE(PG8_SA(0, 0), cA, voffA); PG8_STAGE(PG8_SB(0, 1), cB + hstep, voffB); PG8_STAGE(PG8_SA(0, 1), cA + hstep, voffA);
  if (wr == 1) PG8_BAR;
  PG8_WAIT_V(4); PG8_BAR;
  PG8_STAGE(PG8_SB(1, 0), cB + kstep, voffB); PG8_STAGE(PG8_SA(1, 0), cA + kstep, voffA); PG8_STAGE(PG8_SB(1, 1), cB + hstep + kstep, voffB);
  PG8_WAIT_V(6); PG8_BAR;
  for (;;) {
    const bool has_next = S.next(ui + 1, nxt);
    const char* nA = has_next ? (const char*)g.A + (size_t)nxt.pm * tstep : cA; const char* nB = has_next ? (const char*)g.Bt + (size_t)nxt.pn * tstep : cB;
    for (int t = 0; t < nt; t += 2) {
      const bool last = (t == nt - 2);
      const char* a1 = cA + (size_t)(t + 1) * kstep;
      const char* a2 = last ? nA : cA + (size_t)(t + 2) * kstep; const char* b2 = last ? nB : cB + (size_t)(t + 2) * kstep;
      const char* a3 = a2 + kstep; const char* b3 = b2 + kstep;
      PG8_LDB(B0, 0, 0); PG8_SCHED; PG8_LDA(At, 0, 0); PG8_STAGE(PG8_SA(1, 1), a1 + hstep, voffA);
      PG8_WAIT_L(8); PG8_BAR; PG8_WAIT_L(0); PG8_MMA(0, 0, At, B0); PG8_BAR; PG8_SCHED;
      PG8_LDB(B1, 0, 1); PG8_STAGE(PG8_SB(0, 0), b2, voffB);
      PG8_BAR; PG8_WAIT_L(0); PG8_MMA(0, 1, At, B1); PG8_BAR;
      PG8_LDA(At, 0, 1); PG8_STAGE(PG8_SA(0, 0), a2, voffA);
      PG8_BAR; PG8_WAIT_L(0); PG8_MMA(1, 0, At, B0); PG8_BAR; PG8_SCHED;
      PG8_STAGE(PG8_SB(0, 1), b2 + hstep, voffB);
      PG8_WAIT_V(6); PG8_BAR; PG8_MMA(1, 1, At, B1); PG8_BAR;
      PG8_LDB(B0, 1, 0); PG8_SCHED; PG8_LDA(At, 1, 0); PG8_STAGE(PG8_SA(0, 1), a2 + hstep, voffA);
      PG8_WAIT_L(8); PG8_BAR; PG8_WAIT_L(0); PG8_MMA(0, 0, At, B0); PG8_BAR; PG8_SCHED;
      PG8_LDB(B1, 1, 1); PG8_STAGE(PG8_SB(1, 0), b3, voffB);
      PG8_BAR; PG8_WAIT_L(0); PG8_MMA(0, 1, At, B1); PG8_BAR;
      PG8_LDA(At, 1, 1); PG8_STAGE(PG8_SA(1, 0), a3, voffA);
      PG8_BAR; PG8_WAIT_L(0); PG8_MMA(1, 0, At, B0); PG8_BAR; PG8_SCHED;
      PG8_STAGE(PG8_SB(1, 1), b3 + hstep, voffB);
      PG8_WAIT_V(6); PG8_BAR; PG8_MMA(1, 1, At, B1); PG8_BAR;
    }
    E(acc, cur, wr, wc, fr, fq);
    if (!has_next) break;
#pragma unroll
    for (int a = 0; a < 2; ++a)
#pragma unroll
      for (int b = 0; b < 2; ++b)
#pragma unroll
        for (int m = 0; m < 4; ++m)
#pragma unroll
          for (int n = 0; n < 2; ++n) acc[a][b][m][n] = (f32x4){0.f, 0.f, 0.f, 0.f};
    cur = nxt; cA = nA; cB = nB; ++ui;
  }
  PG8_WAIT_V(0);
  if (wr == 0) PG8_BAR;
  PG8_BAR;
#undef PG8_SA
#undef PG8_SB
#undef PG8_STAGE
#undef PG8_LDA
#undef PG8_LDB
#undef PG8_MMA
#undef PG8_WAIT_V
#undef PG8_WAIT_L
#undef PG8_BAR
#undef PG8_SCHED
}
}

struct EpiProj {
  static constexpr bool PERM = true;
  char* ws; const float* b_merge;
  DI void operator()(const f32x4 (&acc)[2][2][4][2], const pg8::Unit& u, int wr, int wc, int fr, int fq) const {
    const float* rope = (const float*)(ws + OFF_ROPE);
    const int row0 = u.pm * 256 + wr * 64 + fr;
#pragma unroll
    for (int bj = 0; bj < 2; ++bj) {
      const int cg = u.pn * 256 + bj * 128 + wc * 32;
      const int c0 = cg + 8 * fq;
      if (cg >= 4384) continue;
      if (cg < 1280 && (cg < 640 || (cg >= 768 && cg < 896) || (cg >= 1024 && cg < 1152))) {
        bf16_t* dst; unsigned ld, cofs; float scale = 1.0f;
        if (cg < 512) { dst = (bf16_t*)(ws + OFF_Q); ld = 512; cofs = c0; scale = 0.18033688011112042f; }
        else if (cg < 640) { dst = (bf16_t*)(ws + OFF_KC); ld = 128; cofs = c0 - 512; }
        else if (cg < 896) { dst = (bf16_t*)(ws + OFF_KS); ld = 128; cofs = c0 - 768; }
        else { dst = (bf16_t*)(ws + OFF_KW); ld = 128; cofs = c0 - 1024; }
        const int d0 = 16 * ((cg >> 5) & 1) + 4 * fq;
#pragma unroll
        for (int ai = 0; ai < 2; ++ai)
#pragma unroll
          for (int m = 0; m < 4; ++m) {
            const int row = row0 + ai * 128 + m * 16, pos = row & (SEQ - 1);
            const f32x4 cs = *(const f32x4*)(rope + pos * 32 + d0), sn = *(const f32x4*)(rope + 262144 + pos * 32 + d0);
            const f32x4 t1 = acc[ai][bj][m][0], t2 = acc[ai][bj][m][1];
            const f32x4 o1 = (t1 * cs - t2 * sn) * scale, o2 = (t1 * sn + t2 * cs) * scale;
            u32x4 w; w.x = pack2(o1.x, o1.y); w.y = pack2(o1.z, o1.w); w.z = pack2(o2.x, o2.y); w.w = pack2(o2.z, o2.w);
            *(u32x4*)(dst + (unsigned)row * ld + cofs) = w;
          }
      } else if (cg < 1280) {
        bf16_t* dst; unsigned cofs;
        if (cg < 768) { dst = (bf16_t*)(ws + OFF_VC); cofs = c0 - 640; }
        else if (cg < 1024) { dst = (bf16_t*)(ws + OFF_VS); cofs = c0 - 896; }
        else { dst = (bf16_t*)(ws + OFF_VW); cofs = c0 - 1152; }
#pragma unroll
        for (int ai = 0; ai < 2; ++ai)
#pragma unroll
          for (int m = 0; m < 4; ++m) {
            const int row = row0 + ai * 128 + m * 16;
            const f32x4 a = acc[ai][bj][m][0], b = acc[ai][bj][m][1];
            u32x4 w; w.x = pack2(a.x, a.y); w.y = pack2(a.z, a.w); w.z = pack2(b.x, b.y); w.w = pack2(b.z, b.w);
            *(u32x4*)(dst + (unsigned)row * 128u + cofs) = w;
          }
      } else if (cg < 2304) {
        bf16_t* dst = (bf16_t*)(ws + (cg < 1792 ? OFF_U : OFF_V));
        const unsigned cofs = c0 - (cg < 1792 ? 1280 : 1792);
#pragma unroll
        for (int ai = 0; ai < 2; ++ai)
#pragma unroll
          for (int m = 0; m < 4; ++m) {
            const int row = row0 + ai * 128 + m * 16;
            const f32x4 a = acc[ai][bj][m][0], b = acc[ai][bj][m][1];
            const f32x2 g0 = gelu_pk((f32x2){a.x, a.y}), g1 = gelu_pk((f32x2){a.z, a.w}), g2 = gelu_pk((f32x2){b.x, b.y}), g3 = gelu_pk((f32x2){b.z, b.w});
            u32x4 w; w.x = pack2(g0.x, g0.y); w.y = pack2(g1.x, g1.y); w.z = pack2(g2.x, g2.y); w.w = pack2(g3.x, g3.y);
            *(u32x4*)(dst + (unsigned)row * 512u + cofs) = w;
          }
      } else if (cg < 4352) {
        bf16_t* dst = (bf16_t*)(ws + OFF_GATE);
        const unsigned cofs = c0 - 2304;
        const f32x4 b0 = *(const f32x4*)(b_merge + cofs), b1 = *(const f32x4*)(b_merge + cofs + 4);
#pragma unroll
        for (int ai = 0; ai < 2; ++ai)
#pragma unroll
          for (int m = 0; m < 4; ++m) {
            const int row = row0 + ai * 128 + m * 16;
            const f32x4 a = acc[ai][bj][m][0] + b0, b = acc[ai][bj][m][1] + b1;
            u32x4 w; w.x = pack2(sigmoid_f(a.x), sigmoid_f(a.y)); w.y = pack2(sigmoid_f(a.z), sigmoid_f(a.w));
            w.z = pack2(sigmoid_f(b.x), sigmoid_f(b.y)); w.w = pack2(sigmoid_f(b.z), sigmoid_f(b.w));
            *(u32x4*)(dst + (unsigned)row * 2048u + cofs) = w;
          }
      } else {
        float* gs = (float*)(ws + OFF_GSIG);
        if (fq < 3) {
#pragma unroll
          for (int ai = 0; ai < 2; ++ai)
#pragma unroll
            for (int m = 0; m < 4; ++m) {
              const int row = row0 + ai * 128 + m * 16;
              const f32x4 a = acc[ai][bj][m][0], b = acc[ai][bj][m][1];
              f32x4 o0, o1; o0.x = sigmoid_f(a.x); o0.y = sigmoid_f(a.y); o0.z = sigmoid_f(a.z); o0.w = sigmoid_f(a.w);
              o1.x = sigmoid_f(b.x); o1.y = sigmoid_f(b.y); o1.z = sigmoid_f(b.z); o1.w = sigmoid_f(b.w);
              *(f32x4*)(gs + (unsigned)row * 32u + 8 * fq) = o0; *(f32x4*)(gs + (unsigned)row * 32u + 8 * fq + 4) = o1;
            }
        }
      }
    }
  }
};
DI void phase_gemm1(const Params& p, char* smem) {
  pg8::Gemm g{(const bf16_t*)(p.ws + OFF_H), (const bf16_t*)(p.ws + OFF_WT1), NTOK, N1, 1024};
  pg8::StaticOrder S; S.init(NTOK, N1, gridDim.x, blockIdx.x);
  EpiProj E{p.ws, p.b_merge};
  pg8::gemm_phase((LAS unsigned char*)smem, g, S, E);
}

template <int BR> struct EpiMerge {
  static constexpr bool PERM = true;
  char* ws;
  DI void operator()(const f32x4 (&acc)[2][2][4][2], const pg8::Unit& u, int wr, int wc, int fr, int fq) const {
    const bf16_t* gate = (const bf16_t*)(ws + OFF_GATE);
    bf16_t* merged = (bf16_t*)(ws + OFF_H);
    const int row0 = u.pm * 256 + wr * 64 + fr;
#pragma unroll
    for (int bj = 0; bj < 2; ++bj) {
      const unsigned c0 = u.pn * 256 + bj * 128 + wc * 32 + 8 * fq;
#pragma unroll
      for (int ai = 0; ai < 2; ++ai)
#pragma unroll
        for (int m = 0; m < 4; ++m) {
          const unsigned row = row0 + ai * 128 + m * 16;
          float gg[8]; unpack8(*(const u32x4*)(gate + row * 2048u + BR * 1024 + c0), gg);
          const f32x4 a = acc[ai][bj][m][0], b = acc[ai][bj][m][1];
          float v[8] = {a.x * gg[0], a.y * gg[1], a.z * gg[2], a.w * gg[3], b.x * gg[4], b.y * gg[5], b.z * gg[6], b.w * gg[7]};
          bf16_t* mp = merged + row * 1024u + c0;
          if (BR == 1) {
            float old[8]; unpack8(*(const u32x4*)mp, old);
#pragma unroll
            for (int j = 0; j < 8; ++j) v[j] += old[j];
          }
          *(u32x4*)mp = pack8(v);
        }
    }
  }
};
DI void phase_merge(const Params& p, char* smem) {
  pg8::StaticOrder S; S.init(NTOK, 1024, gridDim.x, blockIdx.x);
  {
    pg8::Gemm g{(const bf16_t*)(p.ws + OFF_ONSA), (const bf16_t*)(p.ws + OFF_WB), NTOK, 1024, 512};
    EpiMerge<0> E{p.ws};
    pg8::gemm_phase((LAS unsigned char*)smem, g, S, E);
  }
  {
    pg8::Gemm g{(const bf16_t*)(p.ws + OFF_U), (const bf16_t*)(p.ws + OFF_WB) + (size_t)1024 * 512, NTOK, 1024, 512};
    EpiMerge<1> E{p.ws};
    pg8::gemm_phase((LAS unsigned char*)smem, g, S, E);
  }
}

struct EpiOut {
  static constexpr bool PERM = true;
  char* ws; const float* x;
  DI void operator()(const f32x4 (&acc)[2][2][4][2], const pg8::Unit& u, int wr, int wc, int fr, int fq) const {
    const float* mod = (const float*)(ws + OFF_MOD);
    bf16_t* y = (bf16_t*)(ws + OFF_Y);
    const int row0 = u.pm * 256 + wr * 64 + fr, b = (u.pm * 256) >> 13;
#pragma unroll
    for (int bj = 0; bj < 2; ++bj) {
      const unsigned c0 = u.pn * 256 + bj * 128 + wc * 32 + 8 * fq;
      const f32x4 g0 = *(const f32x4*)(mod + b * 6144 + 2048 + c0), g1 = *(const f32x4*)(mod + b * 6144 + 2048 + c0 + 4);
#pragma unroll
      for (int ai = 0; ai < 2; ++ai)
#pragma unroll
        for (int m = 0; m < 4; ++m) {
          const unsigned o = (unsigned)(row0 + ai * 128 + m * 16) * 1024u + c0;
          const f32x4 x0 = *(const f32x4*)(x + o), x1v = *(const f32x4*)(x + o + 4);
          const f32x4 v0 = x0 * DN_ALPHA + g0 * acc[ai][bj][m][0], v1 = x1v * DN_ALPHA + g1 * acc[ai][bj][m][1];
          u32x4 w; w.x = pack2(v0.x, v0.y); w.y = pack2(v0.z, v0.w); w.z = pack2(v1.x, v1.y); w.w = pack2(v1.z, v1.w);
          *(u32x4*)(y + o) = w;
        }
    }
  }
};
DI void phase_outproj(const Params& p, char* smem) {
  pg8::Gemm g{(const bf16_t*)(p.ws + OFF_H), (const bf16_t*)(p.ws + OFF_WOUT), NTOK, 1024, 1024};
  pg8::StaticOrder S; S.init(NTOK, 1024, gridDim.x, blockIdx.x);
  EpiOut E{p.ws, p.x};
  pg8::gemm_phase((LAS unsigned char*)smem, g, S, E);
}

struct EpiPq {
  static constexpr bool PERM = true;
  char* ws;
  DI void operator()(const f32x4 (&acc)[2][2][4][2], const pg8::Unit& u, int wr, int wc, int fr, int fq) const {
    bf16_t* pq = (bf16_t*)(ws + OFF_PQ);
    const int row0 = u.pm * 256 + wr * 64 + fr;
#pragma unroll
    for (int bj = 0; bj < 2; ++bj) {
      const unsigned c0 = u.pn * 256 + bj * 128 + wc * 32 + 8 * fq;
#pragma unroll
      for (int ai = 0; ai < 2; ++ai)
#pragma unroll
        for (int m = 0; m < 4; ++m) {
          const f32x4 a = acc[ai][bj][m][0], b = acc[ai][bj][m][1];
          u32x4 w; w.x = pack2(a.x, a.y); w.y = pack2(a.z, a.w); w.z = pack2(b.x, b.y); w.w = pack2(b.z, b.w);
          *(u32x4*)(pq + (unsigned)(row0 + ai * 128 + m * 16) * 2048u + c0) = w;
        }
    }
  }
};
DI void phase_peerq(const Params& p, char* smem) {
  pg8::Gemm g{(const bf16_t*)(p.ws + OFF_H), (const bf16_t*)(p.ws + OFF_WQ), NTOK, 2048, 1024};
  pg8::StaticOrder S; S.init(NTOK, 2048, gridDim.x, blockIdx.x);
  EpiPq E{p.ws};
  pg8::gemm_phase((LAS unsigned char*)smem, g, S, E);
}

DI void phase_sgu(const Params& p, char* smem) {
  char* ws = p.ws;
  const int tid = otid(), lane = tid & 63, wave = tid >> 6;
  bf16_t* u = (bf16_t*)(ws + OFF_U);
  const bf16_t* v = (const bf16_t*)(ws + OFF_V);
  const bf16_t* W = (const bf16_t*)(ws + OFF_SGUW);
  float* st = (float*)smem;
  bf16_t* vt = (bf16_t*)(smem + 1024);
  constexpr int LV = 136;
  for (int item = blockIdx.x; item < NTOK / 128; item += gridDim.x) {
    const int t0 = item * 128;
    __syncthreads();
    for (int i = 0; i < 16; ++i) {
      const int t = wave * 16 + i;
      const u32x4 raw = *(const u32x4*)(v + (size_t)(t0 + t) * 512 + lane * 8);
      float f[8]; unpack8(raw, f);
      float s = 0.f;
#pragma unroll
      for (int j = 0; j < 8; ++j) s += f[j];
      const float mean = wave_sum(s) * (1.f / 512.f);
      float q = 0.f;
#pragma unroll
      for (int j = 0; j < 8; ++j) { const float d = f[j] - mean; q += d * d; }
      const float rstd = rsqrtf(wave_sum(q) * (1.f / 512.f) + LN_EPS);
      if (lane == 0) { st[t * 2] = mean; st[t * 2 + 1] = rstd; }
    }
    for (int g = 0; g < 8; ++g) {
      __syncthreads();
      for (int i = 0; i < 2; ++i) {
        const int idx = tid + i * NT, j = idx >> 3, dc = (idx & 7) * 8;
        const u32x4 raw = *(const u32x4*)(v + (size_t)(t0 + j) * 512 + g * 64 + dc);
        const float mean = st[j * 2], rstd = st[j * 2 + 1];
        float f[8]; unpack8(raw, f);
#pragma unroll
        for (int k = 0; k < 8; ++k) {
          const int col = g * 64 + dc + k;
          vt[(dc + k) * LV + j] = f2bf((f[k] - mean) * rstd * p.sgu_ln_g[col] + p.sgu_ln_b[col]);
        }
      }
      __syncthreads();
      const int rt = wave >> 1, ni = wave & 1;
      f32x16 acc;
#pragma unroll
      for (int r = 0; r < 16; ++r) acc[r] = 0.f;
      const bf16_t* wrow = W + ((size_t)g * 128 + rt * 32 + (lane & 31)) * 128 + (lane >> 5) * 8;
#pragma unroll
      for (int ks = 0; ks < 8; ++ks) {
        const bf16x8 a = *(const bf16x8*)(wrow + ks * 16);
        const bf16x8 b0 = *(const bf16x8*)(vt + (ni * 32 + (lane & 31)) * LV + ks * 16 + (lane >> 5) * 8);
        acc = MFMA32(a, b0, acc);
      }
      const int d = lane & 31, hh = lane >> 5;
#pragma unroll
      for (int r = 0; r < 16; ++r) {
        const int i = rt * 32 + (r & 3) + 8 * (r >> 2) + 4 * hh;
        const float m = acc[r] + p.sgu_b[g * 128 + i];
        bf16_t* up = u + (size_t)(t0 + i) * 512 + g * 64 + ni * 32 + d;
        *up = f2bf(bf2f(*up) * m);
      }
    }
  }
}

DI void phase_compress(const Params& p, char* smem) {
  char* ws = p.ws;
  const int tid = otid(), lane = tid & 63, wave = tid >> 6, l31 = lane & 31, hh = lane >> 5;
  bf16_t* hid = (bf16_t*)smem;
  constexpr int LH = 136;
  for (int item = blockIdx.x; item < 128; item += gridDim.x) {
    const int w = item >> 6, R0 = (item & 63) * 128;
    const bf16_t* src = (const bf16_t*)(ws + (w == 0 ? OFF_KC : OFF_VC));
    const bf16_t* W1 = (const bf16_t*)(ws + OFF_CW1) + (size_t)w * 128 * 2048;
    const bf16_t* W2 = (const bf16_t*)(ws + OFF_CW2) + (size_t)w * 64 * 128;
    const float* posb = (const float*)(ws + OFF_POSB) + w * 128;
    const int rg = wave >> 2, cgp = wave & 3;
    const bf16_t* abase[2];
#pragma unroll
    for (int mi = 0; mi < 2; ++mi) {
      const int R = R0 + rg * 64 + mi * 32 + l31, bg = R >> 9, n = R & 511, nn = n < 510 ? n : 510;
      abase[mi] = src + ((size_t)((bg >> 1) * SEQ + 16 * nn)) * 128 + (bg & 1) * 64 + hh * 8;
    }
    const bf16_t* bbase = W1 + (size_t)(cgp * 32 + l31) * 2048 + hh * 8;
    f32x16 acc[2];
#pragma unroll
    for (int r = 0; r < 16; ++r) { acc[0][r] = 0.f; acc[1][r] = 0.f; }
#pragma unroll 8
    for (int ks = 0; ks < 128; ++ks) {
      const int aofs = (ks >> 2) * 128 + (ks & 3) * 16;
      const bf16x8 a0 = *(const bf16x8*)(abase[0] + aofs), a1 = *(const bf16x8*)(abase[1] + aofs);
      const bf16x8 bb = *(const bf16x8*)(bbase + ks * 16);
      acc[0] = MFMA32(a0, bb, acc[0]); acc[1] = MFMA32(a1, bb, acc[1]);
    }
    __syncthreads();
    {
      const float pb = posb[cgp * 32 + l31];
#pragma unroll
      for (int mi = 0; mi < 2; ++mi)
#pragma unroll
        for (int r = 0; r < 16; ++r) {
          const int row = rg * 64 + mi * 32 + (r & 3) + 8 * (r >> 2) + 4 * hh;
          hid[row * LH + cgp * 32 + l31] = f2bf(gelu_f(acc[mi][r] + pb));
        }
    }
    __syncthreads();
    const int mi2 = wave >> 1, ni = wave & 1;
    f32x16 o;
#pragma unroll
    for (int r = 0; r < 16; ++r) o[r] = 0.f;
#pragma unroll
    for (int ks = 0; ks < 8; ++ks) {
      const bf16x8 a = *(const bf16x8*)(hid + (mi2 * 32 + l31) * LH + ks * 16 + hh * 8);
      const bf16x8 bb = *(const bf16x8*)(W2 + (size_t)(ni * 32 + l31) * 128 + ks * 16 + hh * 8);
      o = MFMA32(a, bb, o);
    }
    const int d = ni * 32 + l31;
    const float b2 = p.cmp_b2[w * 64 + (w == 0 ? dperm(d) : d)];
    const int bg = R0 >> 9;
    bf16_t* dst = (bf16_t*)(ws + (w == 0 ? OFF_KCMP : OFF_VCMP));
#pragma unroll
    for (int r = 0; r < 16; ++r) {
      const int n = (R0 & 511) + mi2 * 32 + (r & 3) + 8 * (r >> 2) + 4 * hh;
      dst[((size_t)bg * 512 + n) * 64 + d] = f2bf(n < 511 ? o[r] + b2 : 0.f);
    }
  }
}

constexpr int LK = 72;
constexpr int NSA_TILE = 18432;
constexpr int NSA_AIMP = 3 * NSA_TILE, NSA_CIMP = NSA_AIMP + 32768, NSA_SELM = NSA_CIMP + 32768;
constexpr float NSA_THR = 6.0f;
struct TileRegs { u32x4 k; u32x4 v; };

DI void nsa_load_tile(TileRegs& t, const bf16_t* kbase, size_t kstride, const bf16_t* vbase, size_t vstride) {
  const int tid = otid(), r = tid >> 3, ch = tid & 7;
  t.k = *(const u32x4*)(kbase + (size_t)r * kstride + ch * 8);
  t.v = *(const u32x4*)(vbase + (size_t)r * vstride + ch * 8);
}
DI void nsa_store_tile(const TileRegs& t, char* tile) {
  const int tid = otid(), r = tid >> 3, ch = tid & 7;
  *(u32x4*)((bf16_t*)tile + r * LK + ch * 8) = t.k;
  *(u32x4*)((bf16_t*)(tile + 9216) + r * LK + ch * 8) = t.v;
}
DI void nsa_scores(f32x16 (&st)[2], const char* tile, const bf16x8 (&qf)[4], int lane) {
  const bf16_t* Ks = (const bf16_t*)tile;
#pragma unroll
  for (int kt = 0; kt < 2; ++kt)
#pragma unroll
    for (int r = 0; r < 16; ++r) st[kt][r] = 0.f;
  __builtin_amdgcn_s_setprio(1);
#pragma unroll
  for (int ks = 0; ks < 4; ++ks)
#pragma unroll
    for (int kt = 0; kt < 2; ++kt) {
      const bf16x8 a = *(const bf16x8*)(Ks + (kt * 32 + (lane & 31)) * LK + ks * 16 + (lane >> 5) * 8);
      st[kt] = MFMA32(a, qf[ks], st[kt]);
    }
  __builtin_amdgcn_s_setprio(0);
}
DI void nsa_pv(f32x16 (&o)[2], const f32x16 (&pt)[2], const char* tile, int lane) {
  const int gi = lane >> 4, i16 = lane & 15, q = i16 >> 2, pp = i16 & 3;
  const LAS bf16_t* Vs = (const LAS bf16_t*)(tile + 9216) + (4 * (gi >> 1) + q) * LK + 16 * (gi & 1) + 4 * pp;
#pragma unroll
  for (int kt = 0; kt < 2; ++kt)
#pragma unroll
    for (int s = 0; s < 2; ++s) {
      u32x4 pk; pk.x = pack2(pt[kt][8 * s], pt[kt][8 * s + 1]); pk.y = pack2(pt[kt][8 * s + 2], pt[kt][8 * s + 3]);
      pk.z = pack2(pt[kt][8 * s + 4], pt[kt][8 * s + 5]); pk.w = pack2(pt[kt][8 * s + 6], pt[kt][8 * s + 7]);
      const bf16x8 pb = __builtin_bit_cast(bf16x8, pk);
      bf16x8 a[2];
#pragma unroll
      for (int dt = 0; dt < 2; ++dt) {
        const LAS bf16_t* vp = Vs + (kt * 32 + 16 * s) * LK + dt * 32;
        const s16x4 lo = __builtin_amdgcn_ds_read_tr16_b64_v4i16((LAS s16x4*)vp);
        const s16x4 hi = __builtin_amdgcn_ds_read_tr16_b64_v4i16((LAS s16x4*)(vp + 8 * LK));
        a[dt] = __builtin_shufflevector(lo, hi, 0, 1, 2, 3, 4, 5, 6, 7);
      }
      __builtin_amdgcn_s_setprio(1);
      o[0] = MFMA32(a[0], pb, o[0]); o[1] = MFMA32(a[1], pb, o[1]);
      __builtin_amdgcn_s_setprio(0);
    }
}

constexpr float NSA_NEG = -3.0e38f;
DI void nsa_online(f32x16 (&st)[2], bool sel, float& m, float& l, f32x16 (&o)[2], const char* tile, int lane) {
  float mx = NSA_NEG;
#pragma unroll
  for (int r = 0; r < 16; ++r) mx = fmaxf(mx, fmaxf(st[0][r], st[1][r]));
  mx = fmaxf(mx, __shfl_xor(mx, 32));
  mx = sel ? mx : NSA_NEG;
  if (__any(mx > m + NSA_THR)) {
    const float mn = fmaxf(m, mx);
    const float alpha = __builtin_amdgcn_exp2f(m - mn);
    m = mn; l *= alpha;
#pragma unroll
    for (int r = 0; r < 16; ++r) { o[0][r] *= alpha; o[1][r] *= alpha; }
  }
  const float ms = sel ? m : 1e30f;
  float sum = 0.f;
#pragma unroll
  for (int r = 0; r < 16; ++r) {
    const float p0 = __builtin_amdgcn_exp2f(st[0][r] - ms), p1 = __builtin_amdgcn_exp2f(st[1][r] - ms);
    st[0][r] = p0; st[1][r] = p1; sum += p0 + p1;
  }
  l += sum;
  nsa_pv(o, st, tile, lane);
}

struct NsaItem { int qb, b, g, bg, t; size_t tokrow; };
DI NsaItem nsa_item(int item0, int wave, int qi) {
  const int G = gridDim.x, k = item0 / G, bb = item0 - k * G;
  const int item = (k & 1) ? (k * G + (G - 1 - bb)) : item0;
  NsaItem it; it.qb = 127 - (item >> 4); const int rest = item & 15; it.b = rest >> 1; it.g = rest & 1;
  it.bg = it.b * 2 + it.g; it.t = it.qb * 64 + wave * 8 + qi; it.tokrow = (size_t)it.b * SEQ + it.t; return it;
}
DI void nsa_accum_store(bf16_t* dst, const f32x16 (&o)[2], float sc, bool first, int hh) {
#pragma unroll
  for (int dt = 0; dt < 2; ++dt)
#pragma unroll
    for (int q4 = 0; q4 < 4; ++q4) {
      u32x2* pp = (u32x2*)(dst + dt * 32 + 8 * q4 + 4 * hh);
      float a0 = sc * o[dt][4 * q4], a1 = sc * o[dt][4 * q4 + 1], a2 = sc * o[dt][4 * q4 + 2], a3 = sc * o[dt][4 * q4 + 3];
      if (!first) { const u32x2 old = *pp; a0 += bflo(old.x); a1 += bfhi(old.x); a2 += bflo(old.y); a3 += bfhi(old.y); }
      u32x2 wv; wv.x = pack2(a0, a1); wv.y = pack2(a2, a3);
      *pp = wv;
    }
}

DI void phase_nsa(const Params& p, char* smem, int branch_mask) {
  char* ws = p.ws;
  const int tid = otid(), lane = tid & 63, wave = tid >> 6, hh = lane >> 5, c = lane & 31, qi = c >> 2, r4 = c & 3;
  const bf16_t* Q = (const bf16_t*)(ws + OFF_Q);
  const float* gsig = (const float*)(ws + OFF_GSIG);
  bf16_t* ONSA = (bf16_t*)(ws + OFF_ONSA);
  u32x4* SELG = (u32x4*)(ws + OFF_SELG);
  constexpr int NITEM = NB * 2 * 128;

#pragma unroll 1
  for (int rep1 = 0; rep1 < ((PROBE_DUP & 4096) ? 2 : 1); ++rep1) {
    const bf16_t* KCMP = (const bf16_t*)(ws + OFF_KCMP); const bf16_t* VCMP = (const bf16_t*)(ws + OFF_VCMP);
    float* Aimp = (float*)(smem + NSA_AIMP) + wave * 1024;
    float* Cimp = (float*)(smem + NSA_CIMP) + wave * 1024;
    unsigned short* selm16 = (unsigned short*)(smem + NSA_SELM) + wave * 64;
    const u32x4* selm128 = (const u32x4*)(smem + NSA_SELM) + wave * 8;
    for (int item = blockIdx.x; item < NITEM; item += gridDim.x) {
      const NsaItem it = nsa_item(item, wave, qi);
      const int t = it.t;
      bf16x8 qf[4];
#pragma unroll
      for (int ks = 0; ks < 4; ++ks) qf[ks] = *(const bf16x8*)(Q + it.tokrow * 512 + (it.g * 4 + r4) * 64 + ks * 16 + hh * 8);
      const float g_c = gsig[it.tokrow * 32 + (it.g * 4 + r4) * 3 + 0];
      TileRegs tr;
      const int nmax = (it.qb * 64 + 63 - 31) >> 4, ntile = (nmax >> 6) + 1;
      const int nfull = (it.qb * 64 - 31) >> 4;
      const bf16_t* kb = KCMP + (size_t)it.bg * 512 * 64;
      const bf16_t* vb = VCMP + (size_t)it.bg * 512 * 64;
      float m = -1e30f, l = 0.f;
      __syncthreads();
      for (int i = lane; i < 1024; i += 64) { Aimp[i] = 0.f; Cimp[i] = 0.f; }
      nsa_load_tile(tr, kb, 64, vb, 64);
      nsa_store_tile(tr, smem);
      __syncthreads();
      for (int j = 0; j < ntile; ++j) {
        const char* tile = smem + (j & 1) * NSA_TILE;
        if (j + 1 < ntile) nsa_load_tile(tr, kb + (size_t)(j + 1) * 64 * 64, 64, vb + (size_t)(j + 1) * 64 * 64, 64);
        f32x16 st[2];
        nsa_scores(st, tile, qf, lane);
        const bool full = (j * 64 + 63 <= nfull);
        const int nlim = full ? 100000 : ((t - 31) >> 4) - j * 64 - 4 * hh;
        float mx = NSA_NEG;
#pragma unroll
        for (int kt = 0; kt < 2; ++kt)
#pragma unroll
          for (int r = 0; r < 16; ++r) {
            st[kt][r] = (kt * 32 + (r & 3) + 8 * (r >> 2) <= nlim) ? st[kt][r] : NSA_NEG;
            mx = fmaxf(mx, st[kt][r]);
          }
        mx = fmaxf(mx, __shfl_xor(mx, 32));
        const float mn = fmaxf(m, mx);
        float sum = 0.f;
#pragma unroll
        for (int kt = 0; kt < 2; ++kt)
#pragma unroll
          for (int r = 0; r < 16; ++r) sum += __builtin_amdgcn_exp2f(st[kt][r] - mn);
        l = l * __builtin_amdgcn_exp2f(m - mn) + sum;
        m = mn;
        if (j + 1 < ntile) nsa_store_tile(tr, smem + ((j + 1) & 1) * NSA_TILE);
        __syncthreads();
      }
      l += __shfl_xor(l, 32);
      const float inv_l = l > 0.f ? 1.0f / l : 0.f;
      f32x16 o[2];
#pragma unroll
      for (int r = 0; r < 16; ++r) { o[0][r] = 0.f; o[1][r] = 0.f; }
      nsa_load_tile(tr, kb, 64, vb, 64);
      nsa_store_tile(tr, smem);
      __syncthreads();
      for (int j = 0; j < ntile; ++j) {
        const char* tile = smem + (j & 1) * NSA_TILE;
        if (j + 1 < ntile) nsa_load_tile(tr, kb + (size_t)(j + 1) * 64 * 64, 64, vb + (size_t)(j + 1) * 64 * 64, 64);
        f32x16 st[2];
        nsa_scores(st, tile, qf, lane);
        const bool full = (j * 64 + 63 <= nfull);
        const int nlim = full ? 100000 : ((t - 31) >> 4) - j * 64 - 4 * hh;
#pragma unroll
        for (int kt = 0; kt < 2; ++kt)
#pragma unroll
          for (int r = 0; r < 16; ++r) {
            const float arg = (kt * 32 + (r & 3) + 8 * (r >> 2) <= nlim) ? st[kt][r] - m : NSA_NEG;
            st[kt][r] = __builtin_amdgcn_exp2f(arg) * inv_l;
          }
#pragma unroll
        for (int kt = 0; kt < 2; ++kt)
#pragma unroll
          for (int c4 = 0; c4 < 4; ++c4) {
            float carry = 0.5f * st[kt][4 * c4 + 3];
            float fullv = st[kt][4 * c4] + st[kt][4 * c4 + 1] + st[kt][4 * c4 + 2] + carry;
            fullv += __shfl_xor(fullv, 1); fullv += __shfl_xor(fullv, 2);
            carry += __shfl_xor(carry, 1); carry += __shfl_xor(carry, 2);
            const int jb = j * 16 + kt * 8 + 2 * c4 + hh;
            if (r4 == 0) { Aimp[qi * 128 + jb] = fullv; Cimp[qi * 128 + jb] = carry; }
          }
        if (branch_mask & 1) nsa_pv(o, st, tile, lane);
        if (j + 1 < ntile) nsa_store_tile(tr, smem + ((j + 1) & 1) * NSA_TILE);
        __syncthreads();
      }
      nsa_accum_store(ONSA + it.tokrow * 512 + (it.g * 4 + r4) * 64, o, (branch_mask & 1) ? g_c : 0.f, true, hh);
      const int cur = it.qb;
      if (cur <= 15) {
        if (lane < 8) { selm16[lane * 8 + 0] = (unsigned short)((2u << cur) - 1u);
#pragma unroll
          for (int k = 1; k < 8; ++k) selm16[lane * 8 + k] = 0; }
      } else {
        const int qs = lane >> 3, sub = lane & 7;
        float v[16];
#pragma unroll
        for (int i = 0; i < 16; ++i) {
          const int jj = sub * 16 + i;
          const bool ok = (jj >= 1) && (jj <= cur - 2);
          const int jm = jj >= 1 ? jj - 1 : 0;
          v[i] = ok ? (Aimp[qs * 128 + jj] + Cimp[qs * 128 + jm]) : -3e38f;
        }
        unsigned bits = 0;
        for (int itn = 0; itn < 13; ++itn) {
          float bv = v[0]; int bi = 0;
#pragma unroll
          for (int i = 1; i < 16; ++i) if (v[i] > bv) { bv = v[i]; bi = i; }
          int bj = sub * 16 + bi;
#pragma unroll
          for (int o2 = 1; o2 < 8; o2 <<= 1) {
            const float ov = __shfl_xor(bv, o2); const int oj = __shfl_xor(bj, o2);
            if (ov > bv || (ov == bv && oj < bj)) { bv = ov; bj = oj; }
          }
          if ((bj >> 4) == sub) {
            const int i2 = bj & 15;
#pragma unroll
            for (int i = 0; i < 16; ++i) if (i == i2) v[i] = -3e38f;
            bits |= 1u << i2;
          }
        }
        if (sub == 0) bits |= 1u;
        if ((cur >> 4) == sub) bits |= 1u << (cur & 15);
        if (((cur - 1) >> 4) == sub) bits |= 1u << ((cur - 1) & 15);
        selm16[qs * 8 + sub] = (unsigned short)bits;
      }
      __syncthreads();
      if (r4 == 0 && hh == 0) SELG[(size_t)it.bg * SEQ + t] = selm128[qi];
    }
  }
  __threadfence_block();
  __syncthreads();

#pragma unroll 1
  for (int sweep_i = 0; sweep_i < 2 + ((PROBE_DUP & 1024) ? 1 : 0) + ((PROBE_DUP & 2048) ? 1 : 0); ++sweep_i) {
    const int sweep = (sweep_i < 2) ? sweep_i : (((PROBE_DUP & 1024) && sweep_i == 2) ? 0 : 1);
    const bool dry = sweep_i >= 2;
    if (!(branch_mask & (sweep == 0 ? 2 : 4))) continue;
    const bf16_t* KB = (const bf16_t*)(ws + (sweep == 0 ? OFF_KS : OFF_KW)); const bf16_t* VB = (const bf16_t*)(ws + (sweep == 0 ? OFF_VS : OFF_VW));
    for (int item = blockIdx.x; item < NITEM; item += gridDim.x) {
      const NsaItem it = nsa_item(item, wave, qi);
      const int t = it.t, qb = it.qb;
      bf16x8 qf[4];
#pragma unroll
      for (int ks = 0; ks < 4; ++ks) qf[ks] = *(const bf16x8*)(Q + it.tokrow * 512 + (it.g * 4 + r4) * 64 + ks * 16 + hh * 8);
      const float g_b = gsig[it.tokrow * 32 + (it.g * 4 + r4) * 3 + 1 + sweep];
      u32x4 selw = {0xffffffffu, 0xffffffffu, 0xffffffffu, 0xffffffffu};
      if (sweep == 0) selw = SELG[(size_t)it.bg * SEQ + t];
      TileRegs tr;
      const bf16_t* kb = KB + (size_t)it.b * SEQ * 128 + it.g * 64;
      const bf16_t* vb = VB + (size_t)it.b * SEQ * 128 + it.g * 64;
      float m = -1e30f, l = 0.f;
      f32x16 o[2];
#pragma unroll
      for (int r = 0; r < 16; ++r) { o[0][r] = 0.f; o[1][r] = 0.f; }
      const int j0 = (sweep == 1 && qb >= 8) ? qb - 8 : 0;
      __syncthreads();
      nsa_load_tile(tr, kb + (size_t)j0 * 64 * 128, 128, vb + (size_t)j0 * 64 * 128, 128);
      nsa_store_tile(tr, smem);
      if (j0 + 1 <= qb) { nsa_load_tile(tr, kb + (size_t)(j0 + 1) * 64 * 128, 128, vb + (size_t)(j0 + 1) * 64 * 128, 128); nsa_store_tile(tr, smem + NSA_TILE); }
      if (j0 + 2 <= qb) nsa_load_tile(tr, kb + (size_t)(j0 + 2) * 64 * 128, 128, vb + (size_t)(j0 + 2) * 64 * 128, 128);
      __syncthreads();
      const bool late = wave >= 4;
      bool has = false;
      m = 0.f;
      f32x16 st[2];
      {
        const unsigned w0 = j0 < 32 ? selw.x : (j0 < 64 ? selw.y : (j0 < 96 ? selw.z : selw.w));
        const float ini = ((w0 >> (j0 & 31)) & 1u) ? 0.f : -1e30f;
#pragma unroll
        for (int r = 0; r < 16; ++r) { st[0][r] = ini; st[1][r] = ini; }
        const bf16_t* Kc = (const bf16_t*)smem;
#pragma unroll
        for (int ks = 0; ks < 4; ++ks)
#pragma unroll
          for (int kt = 0; kt < 2; ++kt) st[kt] = MFMA32(*(const bf16x8*)(Kc + (kt * 32 + (lane & 31)) * LK + ks * 16 + (lane >> 5) * 8), qf[ks], st[kt]);
      }
      int bi = 0;
      for (int j = j0; j <= qb; ++j) {
        const char* tile = smem + bi * NSA_TILE;
        const int bn = bi == 2 ? 0 : bi + 1, bnn = bn == 2 ? 0 : bn + 1;
        const int jn = j + 1;
        const unsigned wn = jn < 32 ? selw.x : (jn < 64 ? selw.y : (jn < 96 ? selw.z : selw.w));
        const bool seln = (wn >> (jn & 31)) & 1u;
        const bf16_t* Kn = (const bf16_t*)(smem + bn * NSA_TILE) + (lane & 31) * LK + (lane >> 5) * 8;
        f32x16 sn[2];
        if (!late) {
          const float ini = seln ? -m : -1e30f;
#pragma unroll
          for (int r = 0; r < 16; ++r) { sn[0][r] = ini; sn[1][r] = ini; }
#pragma unroll
          for (int ks = 0; ks < 4; ++ks)
#pragma unroll
            for (int kt = 0; kt < 2; ++kt) sn[kt] = MFMA32(*(const bf16x8*)(Kn + kt * 32 * LK + ks * 16), qf[ks], sn[kt]);
        }
        if (j == qb || (sweep == 1 && j == qb - 8)) {
          const int khi = t - j * 64 - 4 * hh, klo = (sweep == 1) ? khi - 511 : -100000;
#pragma unroll
          for (int r = 0; r < 16; ++r) {
            const int o0 = (r & 3) + 8 * (r >> 2);
            st[0][r] = (o0 <= khi && o0 >= klo) ? st[0][r] : NSA_NEG;
            st[1][r] = (o0 + 32 <= khi && o0 + 32 >= klo) ? st[1][r] : NSA_NEG;
          }
        }
        float mx;
        {
          float a0, a1, a2, a3;
          asm("v_max3_f32 %0, %1, %2, %3" : "=v"(a0) : "v"(st[0][0]), "v"(st[0][1]), "v"(st[0][2]));
          asm("v_max3_f32 %0, %1, %2, %3" : "=v"(a1) : "v"(st[0][3]), "v"(st[0][4]), "v"(st[0][5]));
          asm("v_max3_f32 %0, %1, %2, %3" : "=v"(a2) : "v"(st[0][6]), "v"(st[0][7]), "v"(st[0][8]));
          asm("v_max3_f32 %0, %1, %2, %3" : "=v"(a3) : "v"(st[0][9]), "v"(st[0][10]), "v"(st[0][11]));
          asm("v_max3_f32 %0, %1, %2, %3" : "=v"(a0) : "v"(a0), "v"(st[0][12]), "v"(st[0][13]));
          asm("v_max3_f32 %0, %1, %2, %3" : "=v"(a1) : "v"(a1), "v"(st[0][14]), "v"(st[0][15]));
          asm("v_max3_f32 %0, %1, %2, %3" : "=v"(a2) : "v"(a2), "v"(st[1][0]), "v"(st[1][1]));
          asm("v_max3_f32 %0, %1, %2, %3" : "=v"(a3) : "v"(a3), "v"(st[1][2]), "v"(st[1][3]));
          asm("v_max3_f32 %0, %1, %2, %3" : "=v"(a0) : "v"(a0), "v"(st[1][4]), "v"(st[1][5]));
          asm("v_max3_f32 %0, %1, %2, %3" : "=v"(a1) : "v"(a1), "v"(st[1][6]), "v"(st[1][7]));
          asm("v_max3_f32 %0, %1, %2, %3" : "=v"(a2) : "v"(a2), "v"(st[1][8]), "v"(st[1][9]));
          asm("v_max3_f32 %0, %1, %2, %3" : "=v"(a3) : "v"(a3), "v"(st[1][10]), "v"(st[1][11]));
          asm("v_max3_f32 %0, %1, %2, %3" : "=v"(a0) : "v"(a0), "v"(st[1][12]), "v"(st[1][13]));
          asm("v_max3_f32 %0, %1, %2, %3" : "=v"(a1) : "v"(a1), "v"(st[1][14]), "v"(st[1][15]));
          asm("v_max3_f32 %0, %1, %2, %3" : "=v"(a0) : "v"(a0), "v"(a1), "v"(a2));
          const float other = a3;
          asm("v_max_f32 %0, %1, %2" : "=v"(mx) : "v"(a0), "v"(other));
          const float px = __shfl_xor(mx, 32);
          asm("v_max_f32 %0, %1, %2" : "=v"(mx) : "v"(mx), "v"(px));
        }
        const bool real = mx > -1e29f;
        const bool fresh = !has && real, up = has && (mx > NSA_THR);
        if (__any(fresh || up)) {
          const float delta = (fresh || up) ? mx : 0.f;
          const float alpha = up ? __builtin_amdgcn_exp2f(-delta) : 1.0f;
          m += delta; l *= alpha;
#pragma unroll
          for (int r = 0; r < 16; ++r) { o[0][r] *= alpha; o[1][r] *= alpha; st[0][r] -= delta; st[1][r] -= delta; }
          if (!late) {
            const float dn = seln ? delta : 0.f;
#pragma unroll
            for (int r = 0; r < 16; ++r) { sn[0][r] -= dn; sn[1][r] -= dn; }
          }
        }
        has = has || real;
        f32x2 s2 = {0.f, 0.f};
#pragma unroll
        for (int r = 0; r < 16; ++r) {
          const float p0 = __builtin_amdgcn_exp2f(st[0][r]), p1 = __builtin_amdgcn_exp2f(st[1][r]);
          st[0][r] = p0; st[1][r] = p1; s2 += (f32x2){p0, p1};
        }
        l += s2.x + s2.y;
        nsa_pv(o, st, tile, lane);
        if (late) {
          const float ini = seln ? -m : -1e30f;
#pragma unroll
          for (int r = 0; r < 16; ++r) { sn[0][r] = ini; sn[1][r] = ini; }
#pragma unroll
          for (int ks = 0; ks < 4; ++ks)
#pragma unroll
            for (int kt = 0; kt < 2; ++kt) sn[kt] = MFMA32(*(const bf16x8*)(Kn + kt * 32 * LK + ks * 16), qf[ks], sn[kt]);
        }
        if (j + 2 <= qb) nsa_store_tile(tr, smem + bnn * NSA_TILE);
        if (j + 3 <= qb) nsa_load_tile(tr, kb + (size_t)(j + 3) * 64 * 128, 128, vb + (size_t)(j + 3) * 64 * 128, 128);
#pragma unroll
        for (int r = 0; r < 16; ++r) { st[0][r] = sn[0][r]; st[1][r] = sn[1][r]; }
        bi = bn;
        __syncthreads();
      }
      l += __shfl_xor(l, 32);
      if (!dry) nsa_accum_store(ONSA + it.tokrow * 512 + (it.g * 4 + r4) * 64, o, l > 0.f ? g_b / l : 0.f, false, hh);
      else asm volatile("" :: "v"(o[0]), "v"(o[1]), "v"(l));
    }
  }
}

DI unsigned ord_key(float f) { const unsigned u = __float_as_uint(f); return (u & 0x80000000u) ? ~u : (u | 0x80000000u); }
DI float ord_val(unsigned k) { return __uint_as_float((k & 0x80000000u) ? (k & 0x7fffffffu) : ~k); }
DI void cex(unsigned& hi, unsigned& lo) { const unsigned x = hi, y = lo; hi = x > y ? x : y; lo = x > y ? y : x; }
DI void sort16_desc(unsigned (&a)[16]) {
#pragma unroll
  for (int k = 2; k <= 16; k <<= 1)
#pragma unroll
    for (int j = k >> 1; j > 0; j >>= 1)
#pragma unroll
      for (int i = 0; i < 16; ++i) {
        const int l = i ^ j;
        if (l > i) { if ((i & k) == 0) cex(a[i], a[l]); else cex(a[l], a[i]); }
      }
}
DI void bitonic_finish16(unsigned (&a)[16]) {
#pragma unroll
  for (int j = 8; j > 0; j >>= 1)
#pragma unroll
    for (int i = 0; i < 16; ++i) { const int l = i ^ j; if (l > i) cex(a[i], a[l]); }
}
DI void merge_top16(unsigned (&a)[16], const unsigned (&b)[16]) {
#pragma unroll
  for (int i = 0; i < 16; ++i) a[i] = a[i] > b[15 - i] ? a[i] : b[15 - i];
  bitonic_finish16(a);
}
DI void merge_partner16(unsigned (&a)[16]) {
  unsigned b[16];
#pragma unroll
  for (int i = 0; i < 16; ++i) b[i] = (unsigned)__shfl_xor((int)a[i], 32);
  merge_top16(a, b);
}


DI void peer_top16(unsigned (&top)[16], const bf16_t* pqrow, const bf16_t* keys, int lane) {
  const int l31 = lane & 31, hh = lane >> 5;
  bf16x8 bq[8];
#pragma unroll
  for (int ks = 0; ks < 8; ++ks) bq[ks] = *(const bf16x8*)(pqrow + ks * 16 + hh * 8);
  unsigned grp[16];
#pragma unroll
  for (int nt = 0; nt < 4; ++nt) {
    f32x16 sa;
#pragma unroll
    for (int r = 0; r < 16; ++r) sa[r] = 0.f;
    const bf16_t* kp = keys + (size_t)(nt * 32 + l31) * 128 + hh * 8;
#pragma unroll
    for (int ks = 0; ks < 8; ++ks) { const bf16x8 a = *(const bf16x8*)(kp + ks * 16); sa = MFMA32(a, bq[ks], sa); }
#pragma unroll
    for (int r = 0; r < 16; ++r) {
      const int n = nt * 32 + (r & 3) + 8 * (r >> 2) + 4 * hh;
      grp[r] = (ord_key(sa[r]) & ~0x7Fu) | (unsigned)(127 - n);
    }
    sort16_desc(grp);
    if (nt == 0) {
#pragma unroll
      for (int i = 0; i < 16; ++i) top[i] = grp[i];
    } else merge_top16(top, grp);
  }
  merge_partner16(top);
}

DI void phase_route(const Params& p, char* smem) {
  char* ws = p.ws;
  const int tid = otid(), lane = tid & 63, wave = tid >> 6, l31 = lane & 31, hh = lane >> 5;
  const bf16_t* pq = (const bf16_t*)(ws + OFF_PQ);
  const bf16_t* pk = (const bf16_t*)(ws + OFF_PKEYS);
  int* eidx = (int*)(ws + OFF_EIDX);
  float* pgate = (float*)(ws + OFF_PGATE);
  unsigned* LS = (unsigned*)smem + wave * 1024;
  constexpr int CA[64] = {0,0,0,0,0,0,0,0,0,0,0,0,0,0,0,0, 1,1,1,1,1,1,1,1, 2,2,2,2,2, 3,3,3,3, 4,4,4, 5,5, 6,6, 7,7, 8,9,10,11,12,13,14,15, 0,0,0,0,0,0,0,0,0,0,0,0,0,0};
  constexpr int CB[64] = {0,1,2,3,4,5,6,7,8,9,10,11,12,13,14,15, 0,1,2,3,4,5,6,7, 0,1,2,3,4, 0,1,2,3, 0,1,2, 0,1, 0,1, 0,1, 0,0,0,0,0,0,0,0, 0,0,0,0,0,0,0,0,0,0,0,0,0,0};
  for (int item = blockIdx.x; item < (NTOK / 256) * 8; item += gridDim.x) {
    const int h = item & 7, t0 = (item >> 3) * 256 + wave * 32;
    unsigned s1[16], s2[16];
    const bf16_t* pqrow = pq + (size_t)(t0 + l31) * 2048 + h * 256;
    peer_top16(s1, pqrow, pk + (size_t)(h * 2) * 128 * 128, lane);
    peer_top16(s2, pqrow + 128, pk + (size_t)(h * 2 + 1) * 128 * 128, lane);
    float f1[16], f2[16];
#pragma unroll
    for (int i = 0; i < 16; ++i) { f1[i] = ord_val(s1[i]); f2[i] = ord_val(s2[i]); }
    unsigned ca[16], cb2[16];
#pragma unroll
    for (int i = 0; i < 32; ++i) {
      const int i0 = i, i1 = 25 + i;
      unsigned k0 = 0u, k1 = 0u;
      if (i0 < 25) k0 = (ord_key(f1[CA[i0]] + f2[CB[i0]]) & ~0xFFu) | (unsigned)(255 - (CA[i0] * 16 + CB[i0]));
      if (i1 < 50) k1 = (ord_key(f1[CA[i1]] + f2[CB[i1]]) & ~0xFFu) | (unsigned)(255 - (CA[i1] * 16 + CB[i1]));
      const unsigned kk = hh ? k1 : k0;
      if (i < 16) ca[i] = kk; else cb2[i - 16] = kk;
    }
    sort16_desc(ca); sort16_desc(cb2);
    merge_top16(ca, cb2);
    merge_partner16(ca);
    if (hh == 0) {
#pragma unroll
      for (int i = 0; i < 16; ++i) { LS[l31 * 32 + i] = s1[i]; LS[l31 * 32 + 16 + i] = s2[i]; }
    }
    const float mx = ord_val(ca[0]);
    float ex[16], sum = 0.f;
#pragma unroll
    for (int i = 0; i < 16; ++i) { ex[i] = __expf(ord_val(ca[i]) - mx); sum += ex[i]; }
    const float inv = 1.0f / sum;
    int eo[16]; float go[16];
#pragma unroll
    for (int i = 0; i < 16; ++i) {
      const int flat = 255 - (int)(ca[i] & 0xFFu);
      const unsigned k1 = LS[l31 * 32 + (flat >> 4)], k2 = LS[l31 * 32 + 16 + (flat & 15)];
      eo[i] = (127 - (int)(k1 & 0x7Fu)) * 128 + (127 - (int)(k2 & 0x7Fu));
      go[i] = ex[i] * inv;
    }
    const size_t ob = ((size_t)(t0 + l31) * 8 + h) * 16;
    if (hh == 0) {
      *(u32x4*)(eidx + ob) = (u32x4){(unsigned)eo[0], (unsigned)eo[1], (unsigned)eo[2], (unsigned)eo[3]};
      *(u32x4*)(eidx + ob + 4) = (u32x4){(unsigned)eo[4], (unsigned)eo[5], (unsigned)eo[6], (unsigned)eo[7]};
      *(f32x4*)(pgate + ob) = (f32x4){go[0], go[1], go[2], go[3]};
      *(f32x4*)(pgate + ob + 4) = (f32x4){go[4], go[5], go[6], go[7]};
    } else {
      *(u32x4*)(eidx + ob + 8) = (u32x4){(unsigned)eo[8], (unsigned)eo[9], (unsigned)eo[10], (unsigned)eo[11]};
      *(u32x4*)(eidx + ob + 12) = (u32x4){(unsigned)eo[12], (unsigned)eo[13], (unsigned)eo[14], (unsigned)eo[15]};
      *(f32x4*)(pgate + ob + 8) = (f32x4){go[8], go[9], go[10], go[11]};
      *(f32x4*)(pgate + ob + 12) = (f32x4){go[12], go[13], go[14], go[15]};
    }
  }
}

#define FOR32(M) M(0) M(1) M(2) M(3) M(4) M(5) M(6) M(7) M(8) M(9) M(10) M(11) M(12) M(13) M(14) M(15) M(16) M(17) M(18) M(19) M(20) M(21) M(22) M(23) M(24) M(25) M(26) M(27) M(28) M(29) M(30) M(31)
DI float dot16_fp8(const u32x4 raw, const float (&hx)[16]) {
  const f32x2 a0 = __builtin_amdgcn_cvt_pk_f32_fp8((int)raw.x, false), a1 = __builtin_amdgcn_cvt_pk_f32_fp8((int)raw.x, true);
  const f32x2 b0 = __builtin_amdgcn_cvt_pk_f32_fp8((int)raw.y, false), b1 = __builtin_amdgcn_cvt_pk_f32_fp8((int)raw.y, true);
  const f32x2 c0 = __builtin_amdgcn_cvt_pk_f32_fp8((int)raw.z, false), c1 = __builtin_amdgcn_cvt_pk_f32_fp8((int)raw.z, true);
  const f32x2 d0 = __builtin_amdgcn_cvt_pk_f32_fp8((int)raw.w, false), d1 = __builtin_amdgcn_cvt_pk_f32_fp8((int)raw.w, true);
  float d = (hx[0] * a0.x + hx[1] * a0.y) + (hx[2] * a1.x + hx[3] * a1.y);
  d += (hx[4] * b0.x + hx[5] * b0.y) + (hx[6] * b1.x + hx[7] * b1.y);
  d += (hx[8] * c0.x + hx[9] * c0.y) + (hx[10] * c1.x + hx[11] * c1.y);
  d += (hx[12] * d0.x + hx[13] * d0.y) + (hx[14] * d1.x + hx[15] * d1.y);
  return d;
}
#define FOR16(M) M(0) M(1) M(2) M(3) M(4) M(5) M(6) M(7) M(8) M(9) M(10) M(11) M(12) M(13) M(14) M(15)
DI void phase_ffn_u(const Params& p) {
  char* ws = p.ws;
  const int lane = otid() & 63, wave = otid() >> 6, pg = lane >> 3, dc = lane & 7;
  const int sl = blockIdx.x & 7, wslot = (blockIdx.x >> 3) * NW + wave, nw = (gridDim.x >> 3) * NW;
  const unsigned char* PU8 = (const unsigned char*)(ws + OFF_PU8) + (size_t)sl * 16384 * 128 + dc * 16;
  const bf16_t* h2 = (const bf16_t*)(ws + OFF_H) + sl * 128 + dc * 16;
  const int* eidx = (const int*)(ws + OFF_EIDX);
  float* part = (float*)(ws + OFF_PART) + (size_t)sl * NTOK * 128;
  const int j0 = (dc >> 2) * 64 + ((2 * dc) & 7) * 8 + pg;
  int ev0 = 0, ev1 = 0, nev0 = 0, nev1 = 0; u32x4 ha = {0u, 0u, 0u, 0u}, hb = ha, nha = ha, nhb = ha;
  if (wslot < NTOK) { ev0 = eidx[(size_t)wslot * 128 + lane]; ev1 = eidx[(size_t)wslot * 128 + 64 + lane]; ha = *(const u32x4*)(h2 + (size_t)wslot * DM); hb = *(const u32x4*)(h2 + (size_t)wslot * DM + 8); }
  for (int t = wslot; t < NTOK; t += nw) {
    if (t + nw < NTOK) { const size_t o = (size_t)(t + nw) * 128; nev0 = eidx[o + lane]; nev1 = eidx[o + 64 + lane]; nha = *(const u32x4*)(h2 + (size_t)(t + nw) * DM); nhb = *(const u32x4*)(h2 + (size_t)(t + nw) * DM + 8); }
    float hx[16];
    { float t8[8]; unpack8(ha, t8);
#pragma unroll
      for (int i = 0; i < 8; ++i) hx[i] = t8[i];
      unpack8(hb, t8);
#pragma unroll
      for (int i = 0; i < 8; ++i) hx[8 + i] = t8[i]; }
#define FFU_LD(it) const u32x4 ru##it = *(const u32x4*)(PU8 + (size_t)__shfl((it) < 8 ? ev0 : ev1, ((it) & 7) * 8 + pg) * 128);
    FOR16(FFU_LD)
    float d[16];
#define FFU_CP(it) d[it] = dot16_fp8(ru##it, hx);
    FOR16(FFU_CP)
    float r8[8], r4[4], r2[2];
    { const bool hi = dc & 4;
#pragma unroll
      for (int i = 0; i < 8; ++i) { const float keep = hi ? d[8 + i] : d[i], send = hi ? d[i] : d[8 + i]; r8[i] = keep + __shfl_xor(send, 4); } }
    { const bool hi = dc & 2;
#pragma unroll
      for (int i = 0; i < 4; ++i) { const float keep = hi ? r8[4 + i] : r8[i], send = hi ? r8[i] : r8[4 + i]; r4[i] = keep + __shfl_xor(send, 2); } }
    { const bool hi = dc & 1;
#pragma unroll
      for (int i = 0; i < 2; ++i) { const float keep = hi ? r4[2 + i] : r4[i], send = hi ? r4[i] : r4[2 + i]; r2[i] = keep + __shfl_xor(send, 1); } }
    part[(size_t)t * 128 + j0] = r2[0];
    part[(size_t)t * 128 + j0 + 8] = r2[1];
    ev0 = nev0; ev1 = nev1; ha = nha; hb = nhb;
  }
}
DI void phase_ffn_w(const Params& p) {
  char* ws = p.ws;
  const int lane = otid() & 63, wave = otid() >> 6;
  const float* part = (const float*)(ws + OFF_PART);
  const float* scu = (const float*)(ws + OFF_SCU); const float* scv = (const float*)(ws + OFF_SCV);
  const int* eidx = (const int*)(ws + OFF_EIDX);
  const float* pgate = (const float*)(ws + OFF_PGATE);
  float* wbuf = (float*)(ws + OFF_WBUF);
  for (int grp = blockIdx.x; grp < NTOK / NW; grp += gridDim.x) {
    const size_t o = (size_t)(grp * NW + wave) * 128 + lane;
    float a0 = 0.f, a1 = 0.f;
#pragma unroll
    for (int s8 = 0; s8 < 8; ++s8) { a0 += part[(size_t)s8 * NTOK * 128 + o]; a1 += part[(size_t)s8 * NTOK * 128 + o + 64]; }
    const int e0 = eidx[o], e1 = eidx[o + 64];
    wbuf[o] = pgate[o] * gelu_f(a0 * scu[e0]) * scv[e0];
    wbuf[o + 64] = pgate[o + 64] * gelu_f(a1 * scu[e1]) * scv[e1];
  }
}
DI void phase_ffn_v(const Params& p) {
  char* ws = p.ws;
  const int lane = otid() & 63, wave = otid() >> 6, pg = lane >> 3, dc = lane & 7;
  const int sl = blockIdx.x & 7, wslot = (blockIdx.x >> 3) * NW + wave, nw = (gridDim.x >> 3) * NW;
  const unsigned char* PV8 = (const unsigned char*)(ws + OFF_PV8) + (size_t)sl * 16384 * 128 + dc * 16;
  const int* eidx = (const int*)(ws + OFF_EIDX);
  const float* wbuf = (const float*)(ws + OFF_WBUF);
  bf16_t* ffnb = (bf16_t*)(ws + OFF_FFNB);
  int ev0 = 0, ev1 = 0, nev0 = 0, nev1 = 0; float w0 = 0.f, w1 = 0.f, nw0 = 0.f, nw1 = 0.f;
  if (wslot < NTOK) { ev0 = eidx[(size_t)wslot * 128 + lane]; ev1 = eidx[(size_t)wslot * 128 + 64 + lane]; w0 = wbuf[(size_t)wslot * 128 + lane]; w1 = wbuf[(size_t)wslot * 128 + 64 + lane]; }
  for (int t = wslot; t < NTOK; t += nw) {
    if (t + nw < NTOK) { const size_t o = (size_t)(t + nw) * 128; nev0 = eidx[o + lane]; nev1 = eidx[o + 64 + lane]; nw0 = wbuf[o + lane]; nw1 = wbuf[o + 64 + lane]; }
#define FFV_LD(it) const u32x4 rv##it = *(const u32x4*)(PV8 + (size_t)__shfl((it) < 8 ? ev0 : ev1, ((it) & 7) * 8 + pg) * 128);
#define FFV_CP(it) { const float wj = __shfl((it) < 8 ? w0 : w1, ((it) & 7) * 8 + pg); \
      const f32x2 a0 = __builtin_amdgcn_cvt_pk_f32_fp8((int)rv##it.x, false), a1 = __builtin_amdgcn_cvt_pk_f32_fp8((int)rv##it.x, true); \
      const f32x2 b0 = __builtin_amdgcn_cvt_pk_f32_fp8((int)rv##it.y, false), b1 = __builtin_amdgcn_cvt_pk_f32_fp8((int)rv##it.y, true); \
      const f32x2 c0 = __builtin_amdgcn_cvt_pk_f32_fp8((int)rv##it.z, false), c1 = __builtin_amdgcn_cvt_pk_f32_fp8((int)rv##it.z, true); \
      const f32x2 d0 = __builtin_amdgcn_cvt_pk_f32_fp8((int)rv##it.w, false), d1 = __builtin_amdgcn_cvt_pk_f32_fp8((int)rv##it.w, true); \
      acc[0] += wj * a0.x; acc[1] += wj * a0.y; acc[2] += wj * a1.x; acc[3] += wj * a1.y; acc[4] += wj * b0.x; acc[5] += wj * b0.y; acc[6] += wj * b1.x; acc[7] += wj * b1.y; \
      acc[8] += wj * c0.x; acc[9] += wj * c0.y; acc[10] += wj * c1.x; acc[11] += wj * c1.y; acc[12] += wj * d0.x; acc[13] += wj * d0.y; acc[14] += wj * d1.x; acc[15] += wj * d1.y; }
    FOR16(FFV_LD)
    float acc[16];
#pragma unroll
    for (int i = 0; i < 16; ++i) acc[i] = 0.f;
    FOR16(FFV_CP)
    float r8[8], r4[4], r2[2];
    { const bool hi = lane & 32;
#pragma unroll
      for (int i = 0; i < 8; ++i) { const float keep = hi ? acc[8 + i] : acc[i], send = hi ? acc[i] : acc[8 + i]; r8[i] = keep + __shfl_xor(send, 32); } }
    { const bool hi = lane & 16;
#pragma unroll
      for (int i = 0; i < 4; ++i) { const float keep = hi ? r8[4 + i] : r8[i], send = hi ? r8[i] : r8[4 + i]; r4[i] = keep + __shfl_xor(send, 16); } }
    { const bool hi = lane & 8;
#pragma unroll
      for (int i = 0; i < 2; ++i) { const float keep = hi ? r4[2 + i] : r4[i], send = hi ? r4[i] : r4[2 + i]; r2[i] = keep + __shfl_xor(send, 8); } }
    *(unsigned*)(ffnb + (size_t)t * DM + sl * 128 + dc * 16 + 2 * pg) = pack2(r2[0], r2[1]);
    ev0 = nev0; ev1 = nev1; w0 = nw0; w1 = nw1;
  }
}
DI void phase_final(const Params& p) {
  char* ws = p.ws;
  const int lane = otid() & 63, wave = otid() >> 6;
  const bf16_t* x1 = (const bf16_t*)(ws + OFF_X1);
  const bf16_t* ffnb = (const bf16_t*)(ws + OFF_FFNB);
  const float* mod = (const float*)(ws + OFF_MOD);
  for (int grp = blockIdx.x; grp < NTOK / NW; grp += gridDim.x) {
    const int row = grp * NW + wave, b = row >> 13;
    float v[16];
#pragma unroll
    for (int i = 0; i < 4; ++i) {
      const int col = i * 256 + lane * 4;
      const f32x4 gt2 = *(const f32x4*)(mod + b * 6144 + 5120 + col);
      const u32x2 xr = *(const u32x2*)(x1 + (size_t)row * DM + col), fr = *(const u32x2*)(ffnb + (size_t)row * DM + col);
      v[4 * i] = DN_ALPHA * bflo(xr.x) + gt2.x * bflo(fr.x); v[4 * i + 1] = DN_ALPHA * bfhi(xr.x) + gt2.y * bfhi(fr.x);
      v[4 * i + 2] = DN_ALPHA * bflo(xr.y) + gt2.z * bflo(fr.y); v[4 * i + 3] = DN_ALPHA * bfhi(xr.y) + gt2.w * bfhi(fr.y);
    }
    float mean, rstd; row_stats(v, mean, rstd);
#pragma unroll
    for (int i = 0; i < 4; ++i) {
      const int col = i * 256 + lane * 4;
      const f32x4 g = *(const f32x4*)(p.ln2_g + col), bb = *(const f32x4*)(p.ln2_b + col);
      f32x4 o;
      o.x = (v[4 * i] - mean) * rstd * g.x + bb.x; o.y = (v[4 * i + 1] - mean) * rstd * g.y + bb.y;
      o.z = (v[4 * i + 2] - mean) * rstd * g.z + bb.z; o.w = (v[4 * i + 3] - mean) * rstd * g.w + bb.w;
      *(f32x4*)(p.out + (size_t)row * DM + col) = o;
    }
  }
}

#define XB_TMO      128
#define XB_XCNT(j)  (256  + 64 * (j))
#define XB_XSUB(j)  (1280 + 64 * (j))
#define XB_XGEN(j)  (2304 + 64 * (j))
#define XB_TOP      3328
#define XB_TOPGEN   3392
#define XCD_BAR_WORDS 3456
#define XB_SPIN_CAP (1u << 22)
DI unsigned xb_ld(unsigned* p) { return __hip_atomic_load(p, __ATOMIC_RELAXED, __HIP_MEMORY_SCOPE_AGENT); }
DI unsigned xb_add(unsigned* p, unsigned v) { return __hip_atomic_fetch_add(p, v, __ATOMIC_RELAXED, __HIP_MEMORY_SCOPE_AGENT); }
DI unsigned xb_xcc_id() { return (unsigned)__builtin_amdgcn_s_getreg((3 << 11) | 20) & 0xFu; }
#define XB_SPIN(cond, bar) do { unsigned _sp = 0; while (cond) { __builtin_amdgcn_s_sleep(1); \
    if ((++_sp & 255u) == 0u) { if (xb_ld(&(bar)[XB_TMO])) break; if (_sp > XB_SPIN_CAP) { atomicAdd(&(bar)[XB_TMO], 1u); break; } } } } while (0)
struct XcdBarrier { unsigned* bar; unsigned x; volatile LAS unsigned* st; };
DI XcdBarrier xcd_barrier_post(unsigned* bar, volatile LAS unsigned* st) {
  XcdBarrier b; b.bar = bar; b.x = xb_xcc_id(); b.st = st;
  if (threadIdx.x == 0) (void)xb_add(&bar[XB_XCNT(b.x)], 1u);
  return b;
}
DI void xcd_barrier_complete(unsigned* bar, unsigned x, unsigned& nloc, unsigned& nx) {
  const unsigned G = gridDim.x * gridDim.y * gridDim.z;
  unsigned sum, cnt, mine, sp = 0u;
  for (;;) {
    sum = 0u; cnt = 0u; mine = 0u;
#pragma unroll
    for (unsigned j = 0; j < 16; ++j) { const unsigned c = xb_ld(&bar[XB_XCNT(j)]); sum += c; cnt += (c > 0u) ? 1u : 0u; mine = (j == x) ? c : mine; }
    if (sum == G) break;
    __builtin_amdgcn_s_sleep(1);
    if ((++sp & 255u) == 0u) { if (xb_ld(&bar[XB_TMO])) break; if (sp > XB_SPIN_CAP) { atomicAdd(&bar[XB_TMO], 1u); break; } }
  }
  nloc = mine > 0u ? mine : 1u; nx = cnt > 0u ? cnt : 1u;
}
DI void xcd_barrier(const XcdBarrier& b) {
  asm volatile("s_waitcnt vmcnt(0)" ::: "memory");
  __syncthreads();
  if (threadIdx.x == 0) {
    unsigned* bar = b.bar;
    __builtin_amdgcn_s_waitcnt(0);
    unsigned nloc = b.st[0], nx = b.st[1];
    if (nloc == 0u) { xcd_barrier_complete(bar, b.x, nloc, nx); b.st[0] = nloc; b.st[1] = nx; }
    const unsigned old = xb_add(&bar[XB_XSUB(b.x)], 1u);
    const unsigned gen = old / nloc;
    if (old + 1u == (gen + 1u) * nloc) {
      __builtin_amdgcn_fence(__ATOMIC_RELEASE, "agent");
      asm volatile("s_waitcnt vmcnt(0)" ::: "memory");
      const unsigned og = xb_add(&bar[XB_TOP], 1u);
      const unsigned tg = og / nx;
      if (og + 1u == (tg + 1u) * nx) xb_add(&bar[XB_TOPGEN], 1u);
      else XB_SPIN(xb_ld(&bar[XB_TOPGEN]) == tg, bar);
      __builtin_amdgcn_fence(__ATOMIC_ACQUIRE, "agent");
      xb_add(&bar[XB_XGEN(b.x)], 1u);
      asm volatile("s_waitcnt vmcnt(0)" ::: "memory");
    } else {
      XB_SPIN(xb_ld(&bar[XB_XGEN(b.x)]) == gen, bar);
      __builtin_amdgcn_fence(__ATOMIC_ACQUIRE, "agent");
      asm volatile("s_waitcnt vmcnt(0)" ::: "memory");
    }
  }
  __syncthreads();
}

constexpr int SMEM_BYTES = 131072 + 256;

__global__ void __launch_bounds__(NT, 2) k_mega(Params p) {
  __shared__ __attribute__((aligned(16))) char smem[SMEM_BYTES];
  cg::grid_group grid = cg::this_grid();
  if (threadIdx.x == 0) *(u32x4*)(smem + 131072) = (u32x4){0u, 0u, 0u, 0u};
  __syncthreads();
  const XcdBarrier xb = xcd_barrier_post((unsigned*)(p.ws + OFF_BAR), (volatile LAS unsigned*)(smem + 131072));
#define REP(mask) _Pragma("unroll 1") for (int rep_ = 0; rep_ < ((PROBE_DUP & (mask)) ? 2 : 1); ++rep_)
  REP(1) phase_prep(p, smem);
  grid.sync();
  REP(1) phase_ln_in(p);
  xcd_barrier(xb);
  REP(2) phase_gemm1(p, smem);
  xcd_barrier(xb);
  REP(4) phase_compress(p, smem);
  phase_sgu(p, smem);
  xcd_barrier(xb);
  REP(8) phase_nsa(p, smem, NSA_MASK);
  xcd_barrier(xb);
  REP(16) phase_merge(p, smem);
  xcd_barrier(xb);
  REP(16) phase_outproj(p, smem);
  xcd_barrier(xb);
  REP(1) phase_ln_mid(p);
  xcd_barrier(xb);
  REP(32) phase_peerq(p, smem);
  xcd_barrier(xb);
  REP(64) phase_route(p, smem);
  xcd_barrier(xb);
  REP(128) phase_ffn_u(p);
  xcd_barrier(xb);
  REP(128) phase_ffn_w(p);
  xcd_barrier(xb);
  REP(256) phase_ffn_v(p);
  xcd_barrier(xb);
  REP(512) phase_final(p);
}

extern "C" void kernel_launch(void* const* d_in, const int* in_sizes, int n_in, void* d_out, int out_size, void* d_ws, size_t ws_size, hipStream_t stream) {
  if (ws_size < OFF_END) { fprintf(stderr, "workspace too small: %zu < %zu\n", ws_size, (size_t)OFF_END); return; }
  static int grid_blocks = 0;
  if (!grid_blocks) {
    int dev = 0, cus = 0, per_cu = 0;
    (void)hipGetDevice(&dev);
    (void)hipDeviceGetAttribute(&cus, hipDeviceAttributeMultiprocessorCount, dev);
    (void)hipOccupancyMaxActiveBlocksPerMultiprocessor(&per_cu, k_mega, NT, 0);
    if (per_cu < 1) fprintf(stderr, "occupancy query returned %d\n", per_cu);
    grid_blocks = (cus / 8) * 8;
  }
  Params p{};
  const float** fp = (const float**)&p;
  for (int i = 0; i < 26; ++i) fp[i] = (const float*)d_in[i];
  p.out = (float*)d_out;
  p.ws = (char*)d_ws;
  for (int i = 0; i < 32; ++i) p.inv_freq[i] = (float)pow(10000.0, -(double)i / 32.0);
  (void)hipMemsetAsync((char*)d_ws + OFF_BAR, 0, XCD_BAR_WORDS * 4, stream);
  void* args[] = {&p};
  hipError_t e = hipLaunchCooperativeKernel((void*)k_mega, dim3(grid_blocks), dim3(NT), args, 0, stream);
  if (e != hipSuccess) fprintf(stderr, "cooperative launch failed: %s (grid %d)\n", hipGetErrorString(e), grid_blocks);
}
```

```cpp
#include <hip/hip_runtime.h>
#include <hip/hip_cooperative_groups.h>
#include <stdint.h>
#include <stdio.h>
#include <math.h>
namespace cg = cooperative_groups;

#ifndef PROBE_DUP
#define PROBE_DUP 0
#endif
#ifndef NSA_MASK
#define NSA_MASK 7
#endif
typedef unsigned short bf16_t;
typedef short bf16x8 __attribute__((ext_vector_type(8)));
typedef short s16x4 __attribute__((ext_vector_type(4)));
typedef float f32x16 __attribute__((ext_vector_type(16)));
typedef float f32x4 __attribute__((ext_vector_type(4)));
typedef float f32x2 __attribute__((ext_vector_type(2)));
typedef __bf16 bf16v2 __attribute__((ext_vector_type(2)));
typedef unsigned u32x4 __attribute__((ext_vector_type(4)));
typedef unsigned u32x2 __attribute__((ext_vector_type(2)));
#define DI __device__ __forceinline__
#define LAS __attribute__((address_space(3)))
#define MFMA32(a, b, c) __builtin_amdgcn_mfma_f32_32x32x16_bf16((a), (b), (c), 0, 0, 0)

constexpr int NT = 512, NW = 8;
constexpr int NB = 8, SEQ = 8192, DM = 1024, NTOK = NB * SEQ;
constexpr int N1 = 4608;
constexpr float DN_ALPHA = 1.189207115002721f;
constexpr float LN_EPS = 1e-5f;

constexpr size_t MB = 1024 * 1024;
constexpr size_t OFF_MOD = 0;
constexpr size_t OFF_ROPE = OFF_MOD + 256 * 1024;
constexpr size_t OFF_POSB = OFF_ROPE + 2 * MB;
constexpr size_t OFF_WT1 = OFF_POSB + 4096;
constexpr size_t OFF_WB = OFF_WT1 + (size_t)N1 * 1024 * 2;
constexpr size_t OFF_WOUT = OFF_WB + 2 * MB;
constexpr size_t OFF_WQ = OFF_WOUT + 2 * MB;
constexpr size_t OFF_PKEYS = OFF_WQ + 4 * MB;
constexpr size_t OFF_CW1 = OFF_PKEYS + MB / 2;
constexpr size_t OFF_CW2 = OFF_CW1 + MB;
constexpr size_t OFF_SGUW = OFF_CW2 + 32 * 1024;
constexpr size_t OFF_SCU = OFF_SGUW + 256 * 1024;
constexpr size_t OFF_SCV = OFF_SCU + 64 * 1024;
constexpr size_t OFF_PU = OFF_SCV + 64 * 1024;
constexpr size_t OFF_PV = OFF_PU + 32 * MB;
constexpr size_t OFF_ACT = ((OFF_PV + 32 * MB + 4095) / 4096) * 4096;
constexpr size_t OFF_H = OFF_ACT;
constexpr size_t OFF_Q = OFF_H + 128 * MB;
constexpr size_t OFF_KC = OFF_Q + 64 * MB;
constexpr size_t OFF_VC = OFF_KC + 16 * MB;
constexpr size_t OFF_KS = OFF_VC + 16 * MB;
constexpr size_t OFF_VS = OFF_KS + 16 * MB;
constexpr size_t OFF_KW = OFF_VS + 16 * MB;
constexpr size_t OFF_VW = OFF_KW + 16 * MB;
constexpr size_t OFF_U = OFF_VW + 16 * MB;
constexpr size_t OFF_V = OFF_U + 64 * MB;
constexpr size_t OFF_GATE = OFF_V + 64 * MB;
constexpr size_t OFF_GSIG = OFF_GATE + 256 * MB;
constexpr size_t OFF_KCMP = OFF_GSIG + 8 * MB;
constexpr size_t OFF_VCMP = OFF_KCMP + MB;
constexpr size_t OFF_ONSA = OFF_VCMP + MB;
constexpr size_t OFF_SELG = OFF_ONSA + 64 * MB;
constexpr size_t OFF_BAR = OFF_SELG + 2 * MB;
constexpr size_t OFF_END = OFF_BAR + 64 * 1024;
constexpr size_t OFF_X1 = OFF_Q;
constexpr size_t OFF_Y = OFF_GATE;
constexpr size_t OFF_PQ = OFF_GATE;
constexpr size_t OFF_EIDX = OFF_ONSA;
constexpr size_t OFF_PGATE = OFF_ONSA + 32 * MB;
constexpr size_t OFF_PU8 = OFF_PU;
constexpr size_t OFF_PART = OFF_GATE;
constexpr size_t OFF_PV8 = OFF_PU + 16 * MB;
constexpr size_t OFF_WBUF = OFF_PU + 32 * MB;
constexpr size_t OFF_FFNB = OFF_GATE;

struct Params {
  const float *x, *c, *w_ada, *b_ada, *w_in, *cmp_pos, *cmp_w1, *cmp_b1, *cmp_w2, *cmp_b2, *sgu_ln_g, *sgu_ln_b, *sgu_w, *sgu_b,
      *w_branch, *w_merge, *b_merge, *w_out, *ln1_g, *ln1_b, *peer_wq, *peer_keys, *peer_u, *peer_v, *ln2_g, *ln2_b;
  float* out;
  char* ws;
  float inv_freq[32];
};

DI unsigned pack2(float lo, float hi) { f32x2 v = {lo, hi}; bf16v2 r = __builtin_convertvector(v, bf16v2); return __builtin_bit_cast(unsigned, r); }
DI bf16_t f2bf(float f) { __bf16 r = (__bf16)f; return __builtin_bit_cast(unsigned short, r); }
DI float bf2f(bf16_t h) { return __uint_as_float(((unsigned)h) << 16); }
DI float bflo(unsigned u) { return __uint_as_float(u << 16); }
DI float bfhi(unsigned u) { return __uint_as_float(u & 0xffff0000u); }
DI float gelu_f(float v) { return 0.5f * v * (1.0f + erff(v * 0.70710678118654752f)); }
DI float sigmoid_f(float v) { return 1.0f / (1.0f + __expf(-v)); }
DI int otid() { int t = __builtin_amdgcn_workitem_id_x(); asm volatile("" : "+v"(t)); return t; }
DI float wave_sum(float v) {
#pragma unroll
  for (int o = 32; o > 0; o >>= 1) v += __shfl_xor(v, o);
  return v;
}
DI void ld8(const float* pz, float (&v)[8]) { const f32x4 a = *(const f32x4*)pz, b = *(const f32x4*)(pz + 4); v[0] = a.x; v[1] = a.y; v[2] = a.z; v[3] = a.w; v[4] = b.x; v[5] = b.y; v[6] = b.z; v[7] = b.w; }
DI u32x4 pack8(const float (&v)[8]) { u32x4 w; w.x = pack2(v[0], v[1]); w.y = pack2(v[2], v[3]); w.z = pack2(v[4], v[5]); w.w = pack2(v[6], v[7]); return w; }
DI void unpack8(const u32x4 w, float (&v)[8]) { v[0] = bflo(w.x); v[1] = bfhi(w.x); v[2] = bflo(w.y); v[3] = bfhi(w.y); v[4] = bflo(w.z); v[5] = bfhi(w.z); v[6] = bflo(w.w); v[7] = bfhi(w.w); }
DI f32x2 gelu_pk(f32x2 v) {
  const f32x2 av = __builtin_elementwise_abs(v), d = av * 0.2316418882f + 1.0f;
  f32x2 t; t.x = __builtin_amdgcn_rcpf(d.x); t.y = __builtin_amdgcn_rcpf(d.y);
  f32x2 q = t * 0.5307027145f + (-0.7265760135f); q = q * t + 0.7107068705f; q = q * t + (-0.142248368f); q = q * t + 0.127414796f; q = q * t;
  const f32x2 s = (v * v) * (-0.72134752044f);
  f32x2 e; e.x = __builtin_amdgcn_exp2f(s.x); e.y = __builtin_amdgcn_exp2f(s.y);
  const f32x2 m = v * (q * e), r = v - m;
  f32x2 o; o.x = v.x < 0.f ? m.x : r.x; o.y = v.y < 0.f ? m.y : r.y; return o;
}
__host__ __device__ __forceinline__ int dperm(int q) { const int grp = q >> 5, fq = (q >> 3) & 3, j = q & 7; return (j < 4) ? (16 * grp + 4 * fq + j) : (32 + 16 * grp + 4 * fq + (j - 4)); }

template <class F>
DI void tconv_tile(float* tile, int k0, int n0, bf16_t* dst, int ldd, F f) {
  const int tid = otid();
  __syncthreads();
#pragma unroll 4
  for (int i = 0; i < 8; ++i) { const int kl = i * 8 + (tid >> 6), nl = tid & 63; tile[nl * 65 + kl] = f(k0 + kl, n0 + nl); }
  __syncthreads();
  {
    const int nl = tid >> 3, kc = tid & 7;
    const float* t = tile + nl * 65 + kc * 8;
    u32x4 w; w.x = pack2(t[0], t[1]); w.y = pack2(t[2], t[3]); w.z = pack2(t[4], t[5]); w.w = pack2(t[6], t[7]);
    *(u32x4*)(dst + (size_t)(n0 + nl) * ldd + k0 + kc * 8) = w;
  }
}

DI void conv_chunk(const float* src, bf16_t* dst, size_t base) {
  const size_t i = base + (size_t)otid() * 8;
  const f32x4 a = *(const f32x4*)(src + i), b = *(const f32x4*)(src + i + 4);
  u32x4 w; w.x = pack2(a.x, a.y); w.y = pack2(a.z, a.w); w.z = pack2(b.x, b.y); w.w = pack2(b.z, b.w);
  *(u32x4*)(dst + i) = w;
}

DI void sincos_d(double x, double& s, double& c) {
  const double y = x * 0.25, y2 = y * y;
  double sn = y * (1.0 + y2 * (-1.0 / 6 + y2 * (1.0 / 120 + y2 * (-1.0 / 5040 + y2 * (1.0 / 362880 + y2 * (-1.0 / 39916800 + y2 * (1.0 / 6227020800.0)))))));
  double cs = 1.0 + y2 * (-0.5 + y2 * (1.0 / 24 + y2 * (-1.0 / 720 + y2 * (1.0 / 40320 + y2 * (-1.0 / 3628800 + y2 * (1.0 / 479001600.0 + y2 * (-1.0 / 87178291200.0)))))));
#pragma unroll
  for (int i = 0; i < 2; ++i) { const double s2 = 2.0 * sn * cs, c2 = cs * cs - sn * sn; sn = s2; cs = c2; }
  s = sn; c = cs;
}

DI void phase_prep(const Params& p, char* smem) {
  const int tid = otid();
  float* fs = (float*)smem;
  char* ws = p.ws;
  constexpr int nA = 192, nB = 16 * 72, nC = 2 * 8 * 16, nD = 256, nE = 16 * 32, nF = 2 * 32 * 2, nG = 4, nH = 8, nI = 512, nJ = 64, nK = 32, nL = 2048, nM = 2048;
  constexpr int total = nA + nB + nC + nD + nE + nF + nG + nH + nI + nJ + nK + nL + nM;
  for (int item = blockIdx.x; item < total; item += gridDim.x) {
    int it = item;
    if (it < nA) {
      float* sc = fs;
      float* red = fs + 8192;
      __syncthreads();
      for (int i = tid; i < 8192; i += NT) { const float v = p.c[i]; sc[i] = v / (1.0f + __expf(-v)); }
      __syncthreads();
      const int ks = tid >> 5, cj = tid & 31, col = it * 32 + cj;
      float acc[8];
#pragma unroll
      for (int b = 0; b < 8; ++b) acc[b] = 0.f;
#pragma unroll 4
      for (int k = ks * 64; k < ks * 64 + 64; ++k) {
        const float w = p.w_ada[(size_t)k * 6144 + col];
#pragma unroll
        for (int b = 0; b < 8; ++b) acc[b] += sc[b * 1024 + k] * w;
      }
#pragma unroll
      for (int b = 0; b < 8; ++b) red[(ks * 8 + b) * 32 + cj] = acc[b];
      __syncthreads();
      if (tid < 256) {
        const int b = tid >> 5;
        float s = p.b_ada[col];
#pragma unroll
        for (int k2 = 0; k2 < 16; ++k2) s += red[(k2 * 8 + b) * 32 + cj];
        ((float*)(ws + OFF_MOD))[b * 6144 + col] = s;
      }
      continue;
    }
    it -= nA;
    if (it < nB) {
      const int kt = it / 72, ntile = it % 72;
      const float* w_in = p.w_in; const float* w_merge = p.w_merge;
      tconv_tile(fs, kt * 64, ntile * 64, (bf16_t*)(ws + OFF_WT1), 1024, [=](int k, int n) -> float {
        if (n < 1280) {
          const bool roped = (n < 640) || (n >= 768 && n < 896) || (n >= 1024 && n < 1152);
          const int col = roped ? ((n & ~63) + dperm(n & 63)) : n;
          return w_in[(size_t)k * 2328 + col];
        }
        if (n < 2304) return w_in[(size_t)k * 2328 + n + 24];
        if (n < 4352) return w_merge[(size_t)k * 2048 + (n - 2304)];
        if (n < 4376) return w_in[(size_t)k * 2328 + 1280 + (n - 4352)];
        return 0.f; });
      continue;
    }
    it -= nB;
    if (it < nC) {
      const int br = it >> 7, r = it & 127, kt = r >> 4, ntile = r & 15;
      const float* src = p.w_branch + (size_t)br * 512 * 1024;
      tconv_tile(fs, kt * 64, ntile * 64, (bf16_t*)(ws + OFF_WB) + (size_t)br * 1024 * 512, 512, [=](int k, int n) -> float { return src[(size_t)k * 1024 + n]; });
      continue;
    }
    it -= nC;
    if (it < nD) {
      const int kt = it >> 4, ntile = it & 15;
      const float* src = p.w_out;
      tconv_tile(fs, kt * 64, ntile * 64, (bf16_t*)(ws + OFF_WOUT), 1024, [=](int k, int n) -> float { return src[(size_t)k * 1024 + n]; });
      continue;
    }
    it -= nD;
    if (it < nE) {
      const int kt = it >> 5, ntile = it & 31;
      const float* src = p.peer_wq;
      tconv_tile(fs, kt * 64, ntile * 64, (bf16_t*)(ws + OFF_WQ), 1024, [=](int k, int n) -> float { return src[(size_t)k * 2048 + n]; });
      continue;
    }
    it -= nE;
    if (it < nF) {
      const int w = it >> 6, r = it & 63, kt = r >> 1, ntile = r & 1;
      const float* src = p.cmp_w1 + (size_t)w * 2048 * 128;
      tconv_tile(fs, kt * 64, ntile * 64, (bf16_t*)(ws + OFF_CW1) + (size_t)w * 128 * 2048, 2048, [=](int k, int n) -> float {
        const int ksrc = (w == 0) ? ((k & ~63) + dperm(k & 63)) : k;
        return src[(size_t)ksrc * 128 + n]; });
      continue;
    }
    it -= nF;
    if (it < nG) {
      const int w = it >> 1, kt = it & 1;
      const float* src = p.cmp_w2 + (size_t)w * 128 * 64;
      tconv_tile(fs, kt * 64, 0, (bf16_t*)(ws + OFF_CW2) + (size_t)w * 64 * 128, 128, [=](int k, int n) -> float { return src[(size_t)k * 64 + ((w == 0) ? dperm(n) : n)]; });
      continue;
    }
    it -= nG;
    if (it < nH) {
      const int w = it >> 2, jc = it & 3, ks = tid >> 5, cj = tid & 31, j = jc * 32 + cj;
      float* red = fs;
      const float* pos = p.cmp_pos + w * 2048; const float* w1 = p.cmp_w1 + (size_t)w * 2048 * 128;
      float acc = 0.f;
#pragma unroll 4
      for (int k = ks * 128; k < ks * 128 + 128; ++k) acc += pos[k] * w1[(size_t)k * 128 + j];
      __syncthreads();
      red[ks * 32 + cj] = acc;
      __syncthreads();
      if (tid < 32) { float s = p.cmp_b1[w * 128 + j]; for (int k2 = 0; k2 < 16; ++k2) s += red[k2 * 32 + tid]; ((float*)(ws + OFF_POSB))[w * 128 + j] = s; }
      continue;
    }
    it -= nH;
    if (it < nI) {
      const int e = it * 512 + tid, pos = e >> 5, i = e & 31;
      const float ang = (float)pos * p.inv_freq[i];
      const double a = (double)ang;
      const double kk = rint(a * 0.15915494309189535);
      const double r = a - kk * 6.283185307179586476925;
      double s, c; sincos_d(r, s, c);
      ((float*)(ws + OFF_ROPE))[e] = (float)c;
      ((float*)(ws + OFF_ROPE))[262144 + e] = (float)s;
      continue;
    }
    it -= nI;
    if (it < nJ) { conv_chunk(p.peer_keys, (bf16_t*)(ws + OFF_PKEYS), (size_t)it * 4096); continue; }
    it -= nJ;
    if (it < nK) {
      const size_t i0 = (size_t)it * 4096 + (size_t)tid * 8;
      const int rowi = (int)((i0 >> 7) & 127), j0 = (int)(i0 & 127);
      float v[8];
#pragma unroll
      for (int j = 0; j < 8; ++j) v[j] = (j0 + j <= rowi) ? p.sgu_w[i0 + j] : 0.f;
      u32x4 w; w.x = pack2(v[0], v[1]); w.y = pack2(v[2], v[3]); w.z = pack2(v[4], v[5]); w.w = pack2(v[6], v[7]);
      *(u32x4*)((bf16_t*)(ws + OFF_SGUW) + i0) = w;
      continue;
    }
    it -= nK;
    {
      const bool isv = it >= nL;
      if (isv) it -= nL;
      const int lane = tid & 63, e = it * 8 + (tid >> 6);
      const float* src = (isv ? p.peer_v : p.peer_u) + (size_t)e * 1024 + lane * 16;
      float v[16];
#pragma unroll
      for (int i = 0; i < 4; ++i) { const f32x4 t4 = *(const f32x4*)(src + i * 4); v[4 * i] = t4.x; v[4 * i + 1] = t4.y; v[4 * i + 2] = t4.z; v[4 * i + 3] = t4.w; }
      float amax = 0.f;
#pragma unroll
      for (int i = 0; i < 16; ++i) amax = fmaxf(amax, fabsf(v[i]));
#pragma unroll
      for (int o = 32; o > 0; o >>= 1) amax = fmaxf(amax, __shfl_xor(amax, o));
      const unsigned be = (__float_as_uint(amax) >> 23) & 0xffu;
      const bool okr = be >= 16u && be <= 240u;
      const float scale = okr ? __uint_as_float((261u - be) << 23) : 1.0f;
      const float inv = okr ? __uint_as_float((be - 7u) << 23) : 1.0f;
      u32x4 w;
      int t0 = 0, t1 = 0, t2 = 0, t3 = 0;
      t0 = __builtin_amdgcn_cvt_pk_fp8_f32(v[0] * scale, v[1] * scale, t0, false); t0 = __builtin_amdgcn_cvt_pk_fp8_f32(v[2] * scale, v[3] * scale, t0, true);
      t1 = __builtin_amdgcn_cvt_pk_fp8_f32(v[4] * scale, v[5] * scale, t1, false); t1 = __builtin_amdgcn_cvt_pk_fp8_f32(v[6] * scale, v[7] * scale, t1, true);
      t2 = __builtin_amdgcn_cvt_pk_fp8_f32(v[8] * scale, v[9] * scale, t2, false); t2 = __builtin_amdgcn_cvt_pk_fp8_f32(v[10] * scale, v[11] * scale, t2, true);
      t3 = __builtin_amdgcn_cvt_pk_fp8_f32(v[12] * scale, v[13] * scale, t3, false); t3 = __builtin_amdgcn_cvt_pk_fp8_f32(v[14] * scale, v[15] * scale, t3, true);
      w.x = (unsigned)t0; w.y = (unsigned)t1; w.z = (unsigned)t2; w.w = (unsigned)t3;
      if (!isv) {
        *(u32x4*)(ws + OFF_PU8 + ((size_t)(lane >> 3) * 16384 + e) * 128 + (lane & 7) * 16) = w;
        if (lane == 0) ((float*)(ws + OFF_SCU))[e] = inv;
      } else {
        *(u32x4*)(ws + OFF_PV8 + ((size_t)(lane >> 3) * 16384 + e) * 128 + (lane & 7) * 16) = w;
        if (lane == 0) ((float*)(ws + OFF_SCV))[e] = inv;
      }
    }
  }
}

DI void row_stats(const float (&v)[16], float& mean, float& rstd) {
  float s = 0.f;
#pragma unroll
  for (int i = 0; i < 16; ++i) s += v[i];
  mean = wave_sum(s) * (1.0f / 1024.0f);
  float q = 0.f;
#pragma unroll
  for (int i = 0; i < 16; ++i) { const float d = v[i] - mean; q += d * d; }
  rstd = rsqrtf(wave_sum(q) * (1.0f / 1024.0f) + LN_EPS);
}

DI void phase_ln_in(const Params& p) {
  const int lane = otid() & 63, wave = otid() >> 6;
  const float* mod = (const float*)(p.ws + OFF_MOD);
  bf16_t* h = (bf16_t*)(p.ws + OFF_H);
  for (int grp = blockIdx.x; grp < NTOK / NW; grp += gridDim.x) {
    const int row = grp * NW + wave, b = row >> 13;
    const float* xr = p.x + (size_t)row * DM;
    float v[16];
#pragma unroll
    for (int i = 0; i < 4; ++i) { const f32x4 t = *(const f32x4*)(xr + i * 256 + lane * 4); v[4 * i] = t.x; v[4 * i + 1] = t.y; v[4 * i + 2] = t.z; v[4 * i + 3] = t.w; }
    float mean, rstd; row_stats(v, mean, rstd);
#pragma unroll
    for (int i = 0; i < 4; ++i) {
      const int col = i * 256 + lane * 4;
      const f32x4 sh = *(const f32x4*)(mod + b * 6144 + col), sc = *(const f32x4*)(mod + b * 6144 + 1024 + col);
      const float o0 = (v[4 * i] - mean) * rstd * (1.f + sc.x) + sh.x, o1 = (v[4 * i + 1] - mean) * rstd * (1.f + sc.y) + sh.y;
      const float o2 = (v[4 * i + 2] - mean) * rstd * (1.f + sc.z) + sh.z, o3 = (v[4 * i + 3] - mean) * rstd * (1.f + sc.w) + sh.w;
      u32x2 w; w.x = pack2(o0, o1); w.y = pack2(o2, o3);
      *(u32x2*)(h + (size_t)row * DM + col) = w;
    }
  }
}

DI void phase_ln_mid(const Params& p) {
  const int lane = otid() & 63, wave = otid() >> 6;
  const float* mod = (const float*)(p.ws + OFF_MOD);
  const bf16_t* y = (const bf16_t*)(p.ws + OFF_Y);
  bf16_t* x1 = (bf16_t*)(p.ws + OFF_X1);
  bf16_t* h2 = (bf16_t*)(p.ws + OFF_H);
  for (int grp = blockIdx.x; grp < NTOK / NW; grp += gridDim.x) {
    const int row = grp * NW + wave, b = row >> 13;
    const bf16_t* yr = y + (size_t)row * DM;
    float v[16];
#pragma unroll
    for (int i = 0; i < 4; ++i) { const u32x2 t = *(const u32x2*)(yr + i * 256 + lane * 4); v[4 * i] = bflo(t.x); v[4 * i + 1] = bfhi(t.x); v[4 * i + 2] = bflo(t.y); v[4 * i + 3] = bfhi(t.y); }
    float mean, rstd; row_stats(v, mean, rstd);
#pragma unroll
    for (int i = 0; i < 4; ++i) {
      const int col = i * 256 + lane * 4;
      const f32x4 g = *(const f32x4*)(p.ln1_g + col), bb = *(const f32x4*)(p.ln1_b + col);
      f32x4 o;
      o.x = (v[4 * i] - mean) * rstd * g.x + bb.x; o.y = (v[4 * i + 1] - mean) * rstd * g.y + bb.y;
      o.z = (v[4 * i + 2] - mean) * rstd * g.z + bb.z; o.w = (v[4 * i + 3] - mean) * rstd * g.w + bb.w;
      { u32x2 w; w.x = pack2(o.x, o.y); w.y = pack2(o.z, o.w); *(u32x2*)(x1 + (size_t)row * DM + col) = w; }
      v[4 * i] = o.x; v[4 * i + 1] = o.y; v[4 * i + 2] = o.z; v[4 * i + 3] = o.w;
    }
    row_stats(v, mean, rstd);
#pragma unroll
    for (int i = 0; i < 4; ++i) {
      const int col = i * 256 + lane * 4;
      const f32x4 sh = *(const f32x4*)(mod + b * 6144 + 3072 + col), sc = *(const f32x4*)(mod + b * 6144 + 4096 + col);
      const float o0 = (v[4 * i] - mean) * rstd * (1.f + sc.x) + sh.x, o1 = (v[4 * i + 1] - mean) * rstd * (1.f + sc.y) + sh.y;
      const float o2 = (v[4 * i + 2] - mean) * rstd * (1.f + sc.z) + sh.z, o3 = (v[4 * i + 3] - mean) * rstd * (1.f + sc.w) + sh.w;
      u32x2 w; w.x = pack2(o0, o1); w.y = pack2(o2, o3);
      *(u32x2*)(h2 + (size_t)row * DM + col) = w;
    }
  }
}

namespace pg8 {
constexpr int BM = 256, BK = 64, HALF = 128, HTB = HALF * BK * 2, STAGE_BYTES = 8 * HTB, NXCD = 8, WGM = 8;
DI int lds_byte(int r, int c) { const int st = (r >> 4) * 2 + (c >> 5), rr = r & 15, cc = c & 31, ob = rr * 64 + cc * 2; return st * 1024 + (ob ^ (((ob >> 9) & 1) << 5)); }
DI void stage_rc(int b, int& R, int& C) { const int st = b / 1024, sb = b % 1024, swz = sb ^ (((sb >> 9) & 1) << 5); R = (st >> 1) * 16 + swz / 64; C = (st & 1) * 32 + (swz % 64) / 2; }
DI int perm32(int rho) { const int n = rho >> 4, i = rho & 15; return 8 * (i >> 2) + 4 * n + (i & 3); }
struct Unit { int pm, pn; };
struct Gemm { const bf16_t* A; const bf16_t* Bt; int M, N, K; };
struct StaticOrder {
  int nM, nN, nwg, G, c;
  DI void init(int M, int N, int G_, int c_) { nM = M / BM; nN = N / BM; nwg = nM * nN; G = G_; c = c_; }
  DI bool next(int i, Unit& u) const {
    const long L = (long)i * G + c; if (L >= nwg) return false;
    int wgid = (int)L; { const int q = nwg / NXCD, r = nwg % NXCD, xcd = wgid % NXCD, off = wgid / NXCD; wgid = (xcd < r ? xcd * (q + 1) : r * (q + 1) + (xcd - r) * q) + off; }
    const int nig = WGM * nN, gid = wgid / nig, fm = gid * WGM, gsz = (nM - fm) < WGM ? (nM - fm) : WGM;
    u.pm = fm + ((wgid % nig) % gsz); u.pn = (wgid % nig) / gsz; return true;
  }
};

template <class Epi>
DI void gemm_phase(LAS unsigned char* lds, const Gemm g, const StaticOrder& S, const Epi& E) {
  const int tid = otid(), wid = __builtin_amdgcn_readfirstlane(tid >> 6), lane = tid & 63, wr = wid >> 2, wc = wid & 3, fr = lane & 15, fq = lane >> 4;
  const int K = g.K, nt = K / BK;
  unsigned voffA[2], voffB[2];
#pragma unroll
  for (int i = 0; i < 2; ++i) { int R, C; stage_rc(tid * 16 + i * 8192, R, C); const int Rb = Epi::PERM ? ((R & ~31) + perm32(R & 31)) : R;
    voffA[i] = (unsigned)(R * K + C) * 2u; voffB[i] = (unsigned)(Rb * K + C) * 2u; }
  const size_t kstep = (size_t)(BK * 2);
  const size_t hstep = (size_t)HALF * K * 2;
  const size_t tstep = 2 * hstep;
  const unsigned ldsw = (unsigned)wid * 1024u;
  const int aoff = lds_byte(wr * 64 + fr, fq * 8), boff = lds_byte(wc * 32 + fr, fq * 8);
#define PG8_SA(b, h) (((b) * 2 + (h)) * HTB)
#define PG8_SB(b, h) ((4 + (b) * 2 + (h)) * HTB)
#define PG8_STAGE(bufoff, gbase, voff) do { _Pragma("unroll") for (int _i = 0; _i < 2; ++_i) \
    __builtin_amdgcn_global_load_lds((const unsigned*)((const char*)(gbase) + (voff)[_i]), (LAS unsigned*)(lds + (bufoff) + ldsw + _i * 8192), 16, 0, 0); } while (0)
#define PG8_LDA(dst, b, h) do { _Pragma("unroll") for (int m = 0; m < 4; ++m) _Pragma("unroll") for (int k = 0; k < 2; ++k) dst[m][k] = *(const LAS bf16x8*)(lds + PG8_SA(b, h) + aoff + m * 2048 + k * 1024); } while (0)
#define PG8_LDB(dst, b, h) do { _Pragma("unroll") for (int n = 0; n < 2; ++n) _Pragma("unroll") for (int k = 0; k < 2; ++k) dst[n][k] = *(const LAS bf16x8*)(lds + PG8_SB(b, h) + boff + n * 2048 + k * 1024); } while (0)
#define PG8_MMA(ai, bj, At, Bt) do { __builtin_amdgcn_s_setprio(1); _Pragma("unroll") for (int m = 0; m < 4; ++m) _Pragma("unroll") for (int n = 0; n < 2; ++n) _Pragma("unroll") for (int k = 0; k < 2; ++k) \
    acc[ai][bj][m][n] = __builtin_amdgcn_mfma_f32_16x16x32_bf16(Bt[n][k], At[m][k], acc[ai][bj][m][n], 0, 0, 0); __builtin_amdgcn_s_setprio(0); } while (0)
#define PG8_WAIT_V(n) asm volatile("s_waitcnt vmcnt(" #n ")" ::: "memory")
#define PG8_WAIT_L(n) asm volatile("s_waitcnt lgkmcnt(" #n ")" ::: "memory")
#define PG8_BAR __builtin_amdgcn_s_barrier()
#define PG8_SCHED __builtin_amdgcn_sched_barrier(0)
  Unit cur, nxt; int ui = 0;
  if (!S.next(0, cur)) return;
  f32x4 acc[2][2][4][2];
#pragma unroll
  for (int a = 0; a < 2; ++a)
#pragma unroll
    for (int b = 0; b < 2; ++b)
#pragma unroll
      for (int m = 0; m < 4; ++m)
#pragma unroll
        for (int n = 0; n < 2; ++n) acc[a][b][m][n] = (f32x4){0.f, 0.f, 0.f, 0.f};
  bf16x8 At[4][2], B0[2][2], B1[2][2];
  const char* cA = (const char*)g.A + (size_t)cur.pm * tstep; const char* cB = (const char*)g.Bt + (size_t)cur.pn * tstep;
  PG8_STAGE(PG8_SB(0, 0), cB, voffB); PG8_STAGE(PG8_SA(0, 0), cA, voffA); PG8_STAGE(PG8_SB(0, 1), cB + hstep, voffB); PG8_STAGE(PG8_SA(0, 1), cA + hstep, voffA);
  if (wr == 1) PG8_BAR;
  PG8_WAIT_V(4); PG8_BAR;
  PG8_STAGE(PG8_SB(1, 0), cB + kstep, voffB); PG8_STAGE(PG8_SA(1, 0), cA + kstep, voffA); PG8_STAGE(PG8_SB(1, 1), cB + hstep + kstep, voffB);
  PG8_WAIT_V(6); PG8_BAR;
  for (;;) {
    const bool has_next = S.next(ui + 1, nxt);
    const char* nA = has_next ? (const char*)g.A + (size_t)nxt.pm * tstep : cA; const char* nB = has_next ? (const char*)g.Bt + (size_t)nxt.pn * tstep : cB;
    for (int t = 0; t < nt; t += 2) {
      const bool last = (t == nt - 2);
      const char* a1 = cA + (size_t)(t + 1) * kstep;
      const char* a2 = last ? nA : cA + (size_t)(t + 2) * kstep; const char* b2 = last ? nB : cB + (size_t)(t + 2) * kstep;
      const char* a3 = a2 + kstep; const char* b3 = b2 + kstep;
      PG8_LDB(B0, 0, 0); PG8_SCHED; PG8_LDA(At, 0, 0); PG8_STAGE(PG8_SA(1, 1), a1 + hstep, voffA);
      PG8_WAIT_L(8); PG8_BAR; PG8_WAIT_L(0); PG8_MMA(0, 0, At, B0); PG8_BAR; PG8_SCHED;
      PG8_LDB(B1, 0, 1); PG8_STAGE(PG8_SB(0, 0), b2, voffB);
      PG8_BAR; PG8_WAIT_L(0); PG8_MMA(0, 1, At, B1); PG8_BAR;
      PG8_LDA(At, 0, 1); PG8_STAGE(PG8_SA(0, 0), a2, voffA);
      PG8_BAR; PG8_WAIT_L(0); PG8_MMA(1, 0, At, B0); PG8_BAR; PG8_SCHED;
      PG8_STAGE(PG8_SB(0, 1), b2 + hstep, voffB);
      PG8_WAIT_V(6); PG8_BAR; PG8_MMA(1, 1, At, B1); PG8_BAR;
      PG8_LDB(B0, 1, 0); PG8_SCHED; PG8_LDA(At, 1, 0); PG8_STAGE(PG8_SA(0, 1), a2 + hstep, voffA);
      PG8_WAIT_L(8); PG8_BAR; PG8_WAIT_L(0); PG8_MMA(0, 0, At, B0); PG8_BAR; PG8_SCHED;
      PG8_LDB(B1, 1, 1); PG8_STAGE(PG8_SB(1, 0), b3, voffB);
      PG8_BAR; PG8_WAIT_L(0); PG8_MMA(0, 1, At, B1); PG8_BAR;
      PG8_LDA(At, 1, 1); PG8_STAGE(PG8_SA(1, 0), a3, voffA);
      PG8_BAR; PG8_WAIT_L(0); PG8_MMA(1, 0, At, B0); PG8_BAR; PG8_SCHED;
      PG8_STAGE(PG8_SB(1, 1), b3 + hstep, voffB);
      PG8_WAIT_V(6); PG8_BAR; PG8_MMA(1, 1, At, B1); PG8_BAR;
    }
    E(acc, cur, wr, wc, fr, fq);
    if (!has_next) break;
#pragma unroll
    for (int a = 0; a < 2; ++a)
#pragma unroll
      for (int b = 0; b < 2; ++b)
#pragma unroll
        for (int m = 0; m < 4; ++m)
#pragma unroll
          for (int n = 0; n < 2; ++n) acc[a][b][m][n] = (f32x4){0.f, 0.f, 0.f, 0.f};
    cur = nxt; cA = nA; cB = nB; ++ui;
  }
  PG8_WAIT_V(0);
  if (wr == 0) PG8_BAR;
  PG8_BAR;
#undef PG8_SA
#undef PG8_SB
#undef PG8_STAGE
#undef PG8_LDA
#undef PG8_LDB
#undef PG8_MMA
#undef PG8_WAIT_V
#undef PG8_WAIT_L
#undef PG8_BAR
#undef PG8_SCHED
}
}

struct EpiProj {
  static constexpr bool PERM = true;
  char* ws; const float* b_merge;
  DI void operator()(const f32x4 (&acc)[2][2][4][2], const pg8::Unit& u, int wr, int wc, int fr, int fq) const {
    const float* rope = (const float*)(ws + OFF_ROPE);
    const int row0 = u.pm * 256 + wr * 64 + fr;
#pragma unroll
    for (int bj = 0; bj < 2; ++bj) {
      const int cg = u.pn * 256 + bj * 128 + wc * 32;
      const int c0 = cg + 8 * fq;
      if (cg >= 4384) continue;
      if (cg < 1280 && (cg < 640 || (cg >= 768 && cg < 896) || (cg >= 1024 && cg < 1152))) {
        bf16_t* dst; unsigned ld, cofs; float scale = 1.0f;
        if (cg < 512) { dst = (bf16_t*)(ws + OFF_Q); ld = 512; cofs = c0; scale = 0.18033688011112042f; }
        else if (cg < 640) { dst = (bf16_t*)(ws + OFF_KC); ld = 128; cofs = c0 - 512; }
        else if (cg < 896) { dst = (bf16_t*)(ws + OFF_KS); ld = 128; cofs = c0 - 768; }
        else { dst = (bf16_t*)(ws + OFF_KW); ld = 128; cofs = c0 - 1024; }
        const int d0 = 16 * ((cg >> 5) & 1) + 4 * fq;
#pragma unroll
        for (int ai = 0; ai < 2; ++ai)
#pragma unroll
          for (int m = 0; m < 4; ++m) {
            const int row = row0 + ai * 128 + m * 16, pos = row & (SEQ - 1);
            const f32x4 cs = *(const f32x4*)(rope + pos * 32 + d0), sn = *(const f32x4*)(rope + 262144 + pos * 32 + d0);
            const f32x4 t1 = acc[ai][bj][m][0], t2 = acc[ai][bj][m][1];
            const f32x4 o1 = (t1 * cs - t2 * sn) * scale, o2 = (t1 * sn + t2 * cs) * scale;
            u32x4 w; w.x = pack2(o1.x, o1.y); w.y = pack2(o1.z, o1.w); w.z = pack2(o2.x, o2.y); w.w = pack2(o2.z, o2.w);
            *(u32x4*)(dst + (unsigned)row * ld + cofs) = w;
          }
      } else if (cg < 1280) {
        bf16_t* dst; unsigned cofs;
        if (cg < 768) { dst = (bf16_t*)(ws + OFF_VC); cofs = c0 - 640; }
        else if (cg < 1024) { dst = (bf16_t*)(ws + OFF_VS); cofs = c0 - 896; }
        else { dst = (bf16_t*)(ws + OFF_VW); cofs = c0 - 1152; }
#pragma unroll
        for (int ai = 0; ai < 2; ++ai)
#pragma unroll
          for (int m = 0; m < 4; ++m) {
            const int row = row0 + ai * 128 + m * 16;
            const f32x4 a = acc[ai][bj][m][0], b = acc[ai][bj][m][1];
            u32x4 w; w.x = pack2(a.x, a.y); w.y = pack2(a.z, a.w); w.z = pack2(b.x, b.y); w.w = pack2(b.z, b.w);
            *(u32x4*)(dst + (unsigned)row * 128u + cofs) = w;
          }
      } else if (cg < 2304) {
        bf16_t* dst = (bf16_t*)(ws + (cg < 1792 ? OFF_U : OFF_V));
        const unsigned cofs = c0 - (cg < 1792 ? 1280 : 1792);
#pragma unroll
        for (int ai = 0; ai < 2; ++ai)
#pragma unroll
          for (int m = 0; m < 4; ++m) {
            const int row = row0 + ai * 128 + m * 16;
            const f32x4 a = acc[ai][bj][m][0], b = acc[ai][bj][m][1];
            const f32x2 g0 = gelu_pk((f32x2){a.x, a.y}), g1 = gelu_pk((f32x2){a.z, a.w}), g2 = gelu_pk((f32x2){b.x, b.y}), g3 = gelu_pk((f32x2){b.z, b.w});
            u32x4 w; w.x = pack2(g0.x, g0.y); w.y = pack2(g1.x, g1.y); w.z = pack2(g2.x, g2.y); w.w = pack2(g3.x, g3.y);
            *(u32x4*)(dst + (unsigned)row * 512u + cofs) = w;
          }
      } else if (cg < 4352) {
        bf16_t* dst = (bf16_t*)(ws + OFF_GATE);
        const unsigned cofs = c0 - 2304;
        const f32x4 b0 = *(const f32x4*)(b_merge + cofs), b1 = *(const f32x4*)(b_merge + cofs + 4);
#pragma unroll
        for (int ai = 0; ai < 2; ++ai)
#pragma unroll
          for (int m = 0; m < 4; ++m) {
            const int row = row0 + ai * 128 + m * 16;
            const f32x4 a = acc[ai][bj][m][0] + b0, b = acc[ai][bj][m][1] + b1;
            u32x4 w; w.x = pack2(sigmoid_f(a.x), sigmoid_f(a.y)); w.y = pack2(sigmoid_f(a.z), sigmoid_f(a.w));
            w.z = pack2(sigmoid_f(b.x), sigmoid_f(b.y)); w.w = pack2(sigmoid_f(b.z), sigmoid_f(b.w));
            *(u32x4*)(dst + (unsigned)row * 2048u + cofs) = w;
          }
      } else {
        float* gs = (float*)(ws + OFF_GSIG);
        if (fq < 3) {
#pragma unroll
          for (int ai = 0; ai < 2; ++ai)
#pragma unroll
            for (int m = 0; m < 4; ++m) {
              const int row = row0 + ai * 128 + m * 16;
              const f32x4 a = acc[ai][bj][m][0], b = acc[ai][bj][m][1];
              f32x4 o0, o1; o0.x = sigmoid_f(a.x); o0.y = sigmoid_f(a.y); o0.z = sigmoid_f(a.z); o0.w = sigmoid_f(a.w);
              o1.x = sigmoid_f(b.x); o1.y = sigmoid_f(b.y); o1.z = sigmoid_f(b.z); o1.w = sigmoid_f(b.w);
              *(f32x4*)(gs + (unsigned)row * 32u + 8 * fq) = o0; *(f32x4*)(gs + (unsigned)row * 32u + 8 * fq + 4) = o1;
            }
        }
      }
    }
  }
};
DI void phase_gemm1(const Params& p, char* smem) {
  pg8::Gemm g{(const bf16_t*)(p.ws + OFF_H), (const bf16_t*)(p.ws + OFF_WT1), NTOK, N1, 1024};
  pg8::StaticOrder S; S.init(NTOK, N1, gridDim.x, blockIdx.x);
  EpiProj E{p.ws, p.b_merge};
  pg8::gemm_phase((LAS unsigned char*)smem, g, S, E);
}

template <int BR> struct EpiMerge {
  static constexpr bool PERM = true;
  char* ws;
  DI void operator()(const f32x4 (&acc)[2][2][4][2], const pg8::Unit& u, int wr, int wc, int fr, int fq) const {
    const bf16_t* gate = (const bf16_t*)(ws + OFF_GATE);
    bf16_t* merged = (bf16_t*)(ws + OFF_H);
    const int row0 = u.pm * 256 + wr * 64 + fr;
#pragma unroll
    for (int bj = 0; bj < 2; ++bj) {
      const unsigned c0 = u.pn * 256 + bj * 128 + wc * 32 + 8 * fq;
#pragma unroll
      for (int ai = 0; ai < 2; ++ai)
#pragma unroll
        for (int m = 0; m < 4; ++m) {
          const unsigned row = row0 + ai * 128 + m * 16;
          float gg[8]; unpack8(*(const u32x4*)(gate + row * 2048u + BR * 1024 + c0), gg);
          const f32x4 a = acc[ai][bj][m][0], b = acc[ai][bj][m][1];
          float v[8] = {a.x * gg[0], a.y * gg[1], a.z * gg[2], a.w * gg[3], b.x * gg[4], b.y * gg[5], b.z * gg[6], b.w * gg[7]};
          bf16_t* mp = merged + row * 1024u + c0;
          if (BR == 1) {
            float old[8]; unpack8(*(const u32x4*)mp, old);
#pragma unroll
            for (int j = 0; j < 8; ++j) v[j] += old[j];
          }
          *(u32x4*)mp = pack8(v);
        }
    }
  }
};
DI void phase_merge(const Params& p, char* smem) {
  pg8::StaticOrder S; S.init(NTOK, 1024, gridDim.x, blockIdx.x);
  {
    pg8::Gemm g{(const bf16_t*)(p.ws + OFF_ONSA), (const bf16_t*)(p.ws + OFF_WB), NTOK, 1024, 512};
    EpiMerge<0> E{p.ws};
    pg8::gemm_phase((LAS unsigned char*)smem, g, S, E);
  }
  {
    pg8::Gemm g{(const bf16_t*)(p.ws + OFF_U), (const bf16_t*)(p.ws + OFF_WB) + (size_t)1024 * 512, NTOK, 1024, 512};
    EpiMerge<1> E{p.ws};
    pg8::gemm_phase((LAS unsigned char*)smem, g, S, E);
  }
}

struct EpiOut {
  static constexpr bool PERM = true;
  char* ws; const float* x;
  DI void operator()(const f32x4 (&acc)[2][2][4][2], const pg8::Unit& u, int wr, int wc, int fr, int fq) const {
    const float* mod = (const float*)(ws + OFF_MOD);
    bf16_t* y = (bf16_t*)(ws + OFF_Y);
    const int row0 = u.pm * 256 + wr * 64 + fr, b = (u.pm * 256) >> 13;
#pragma unroll
    for (int bj = 0; bj < 2; ++bj) {
      const unsigned c0 = u.pn * 256 + bj * 128 + wc * 32 + 8 * fq;
      const f32x4 g0 = *(const f32x4*)(mod + b * 6144 + 2048 + c0), g1 = *(const f32x4*)(mod + b * 6144 + 2048 + c0 + 4);
#pragma unroll
      for (int ai = 0; ai < 2; ++ai)
#pragma unroll
        for (int m = 0; m < 4; ++m) {
          const unsigned o = (unsigned)(row0 + ai * 128 + m * 16) * 1024u + c0;
          const f32x4 x0 = *(const f32x4*)(x + o), x1v = *(const f32x4*)(x + o + 4);
          const f32x4 v0 = x0 * DN_ALPHA + g0 * acc[ai][bj][m][0], v1 = x1v * DN_ALPHA + g1 * acc[ai][bj][m][1];
          u32x4 w; w.x = pack2(v0.x, v0.y); w.y = pack2(v0.z, v0.w); w.z = pack2(v1.x, v1.y); w.w = pack2(v1.z, v1.w);
          *(u32x4*)(y + o) = w;
        }
    }
  }
};
DI void phase_outproj(const Params& p, char* smem) {
  pg8::Gemm g{(const bf16_t*)(p.ws + OFF_H), (const bf16_t*)(p.ws + OFF_WOUT), NTOK, 1024, 1024};
  pg8::StaticOrder S; S.init(NTOK, 1024, gridDim.x, blockIdx.x);
  EpiOut E{p.ws, p.x};
  pg8::gemm_phase((LAS unsigned char*)smem, g, S, E);
}

struct EpiPq {
  static constexpr bool PERM = true;
  char* ws;
  DI void operator()(const f32x4 (&acc)[2][2][4][2], const pg8::Unit& u, int wr, int wc, int fr, int fq) const {
    bf16_t* pq = (bf16_t*)(ws + OFF_PQ);
    const int row0 = u.pm * 256 + wr * 64 + fr;
#pragma unroll
    for (int bj = 0; bj < 2; ++bj) {
      const unsigned c0 = u.pn * 256 + bj * 128 + wc * 32 + 8 * fq;
#pragma unroll
      for (int ai = 0; ai < 2; ++ai)
#pragma unroll
        for (int m = 0; m < 4; ++m) {
          const f32x4 a = acc[ai][bj][m][0], b = acc[ai][bj][m][1];
          u32x4 w; w.x = pack2(a.x, a.y); w.y = pack2(a.z, a.w); w.z = pack2(b.x, b.y); w.w = pack2(b.z, b.w);
          *(u32x4*)(pq + (unsigned)(row0 + ai * 128 + m * 16) * 2048u + c0) = w;
        }
    }
  }
};
DI void phase_peerq(const Params& p, char* smem) {
  pg8::Gemm g{(const bf16_t*)(p.ws + OFF_H), (const bf16_t*)(p.ws + OFF_WQ), NTOK, 2048, 1024};
  pg8::StaticOrder S; S.init(NTOK, 2048, gridDim.x, blockIdx.x);
  EpiPq E{p.ws};
  pg8::gemm_phase((LAS unsigned char*)smem, g, S, E);
}

DI void phase_sgu(const Params& p, char* smem) {
  char* ws = p.ws;
  const int tid = otid(), lane = tid & 63, wave = tid >> 6;
  bf16_t* u = (bf16_t*)(ws + OFF_U);
  const bf16_t* v = (const bf16_t*)(ws + OFF_V);
  const bf16_t* W = (const bf16_t*)(ws + OFF_SGUW);
  float* st = (float*)smem;
  bf16_t* vt = (bf16_t*)(smem + 1024);
  constexpr int LV = 136;
  for (int item = blockIdx.x; item < NTOK / 128; item += gridDim.x) {
    const int t0 = item * 128;
    __syncthreads();
    for (int i = 0; i < 16; ++i) {
      const int t = wave * 16 + i;
      const u32x4 raw = *(const u32x4*)(v + (size_t)(t0 + t) * 512 + lane * 8);
      float f[8]; unpack8(raw, f);
      float s = 0.f;
#pragma unroll
      for (int j = 0; j < 8; ++j) s += f[j];
      const float mean = wave_sum(s) * (1.f / 512.f);
      float q = 0.f;
#pragma unroll
      for (int j = 0; j < 8; ++j) { const float d = f[j] - mean; q += d * d; }
      const float rstd = rsqrtf(wave_sum(q) * (1.f / 512.f) + LN_EPS);
      if (lane == 0) { st[t * 2] = mean; st[t * 2 + 1] = rstd; }
    }
    for (int g = 0; g < 8; ++g) {
      __syncthreads();
      for (int i = 0; i < 2; ++i) {
        const int idx = tid + i * NT, j = idx >> 3, dc = (idx & 7) * 8;
        const u32x4 raw = *(const u32x4*)(v + (size_t)(t0 + j) * 512 + g * 64 + dc);
        const float mean = st[j * 2], rstd = st[j * 2 + 1];
        float f[8]; unpack8(raw, f);
#pragma unroll
        for (int k = 0; k < 8; ++k) {
          const int col = g * 64 + dc + k;
          vt[(dc + k) * LV + j] = f2bf((f[k] - mean) * rstd * p.sgu_ln_g[col] + p.sgu_ln_b[col]);
        }
      }
      __syncthreads();
      const int rt = wave >> 1, ni = wave & 1;
      f32x16 acc;
#pragma unroll
      for (int r = 0; r < 16; ++r) acc[r] = 0.f;
      const bf16_t* wrow = W + ((size_t)g * 128 + rt * 32 + (lane & 31)) * 128 + (lane >> 5) * 8;
#pragma unroll
      for (int ks = 0; ks < 8; ++ks) {
        const bf16x8 a = *(const bf16x8*)(wrow + ks * 16);
        const bf16x8 b0 = *(const bf16x8*)(vt + (ni * 32 + (lane & 31)) * LV + ks * 16 + (lane >> 5) * 8);
        acc = MFMA32(a, b0, acc);
      }
      const int d = lane & 31, hh = lane >> 5;
#pragma unroll
      for (int r = 0; r < 16; ++r) {
        const int i = rt * 32 + (r & 3) + 8 * (r >> 2) + 4 * hh;
        const float m = acc[r] + p.sgu_b[g * 128 + i];
        bf16_t* up = u + (size_t)(t0 + i) * 512 + g * 64 + ni * 32 + d;
        *up = f2bf(bf2f(*up) * m);
      }
    }
  }
}

DI void phase_compress(const Params& p, char* smem) {
  char* ws = p.ws;
  const int tid = otid(), lane = tid & 63, wave = tid >> 6, l31 = lane & 31, hh = lane >> 5;
  bf16_t* hid = (bf16_t*)smem;
  constexpr int LH = 136;
  for (int item = blockIdx.x; item < 128; item += gridDim.x) {
    const int w = item >> 6, R0 = (item & 63) * 128;
    const bf16_t* src = (const bf16_t*)(ws + (w == 0 ? OFF_KC : OFF_VC));
    const bf16_t* W1 = (const bf16_t*)(ws + OFF_CW1) + (size_t)w * 128 * 2048;
    const bf16_t* W2 = (const bf16_t*)(ws + OFF_CW2) + (size_t)w * 64 * 128;
    const float* posb = (const float*)(ws + OFF_POSB) + w * 128;
    const int rg = wave >> 2, cgp = wave & 3;
    const bf16_t* abase[2];
#pragma unroll
    for (int mi = 0; mi < 2; ++mi) {
      const int R = R0 + rg * 64 + mi * 32 + l31, bg = R >> 9, n = R & 511, nn = n < 510 ? n : 510;
      abase[mi] = src + ((size_t)((bg >> 1) * SEQ + 16 * nn)) * 128 + (bg & 1) * 64 + hh * 8;
    }
    const bf16_t* bbase = W1 + (size_t)(cgp * 32 + l31) * 2048 + hh * 8;
    f32x16 acc[2];
#pragma unroll
    for (int r = 0; r < 16; ++r) { acc[0][r] = 0.f; acc[1][r] = 0.f; }
#pragma unroll 8
    for (int ks = 0; ks < 128; ++ks) {
      const int aofs = (ks >> 2) * 128 + (ks & 3) * 16;
      const bf16x8 a0 = *(const bf16x8*)(abase[0] + aofs), a1 = *(const bf16x8*)(abase[1] + aofs);
      const bf16x8 bb = *(const bf16x8*)(bbase + ks * 16);
      acc[0] = MFMA32(a0, bb, acc[0]); acc[1] = MFMA32(a1, bb, acc[1]);
    }
    __syncthreads();
    {
      const float pb = posb[cgp * 32 + l31];
#pragma unroll
      for (int mi = 0; mi < 2; ++mi)
#pragma unroll
        for (int r = 0; r < 16; ++r) {
          const int row = rg * 64 + mi * 32 + (r & 3) + 8 * (r >> 2) + 4 * hh;
          hid[row * LH + cgp * 32 + l31] = f2bf(gelu_f(acc[mi][r] + pb));
        }
    }
    __syncthreads();
    const int mi2 = wave >> 1, ni = wave & 1;
    f32x16 o;
#pragma unroll
    for (int r = 0; r < 16; ++r) o[r] = 0.f;
#pragma unroll
    for (int ks = 0; ks < 8; ++ks) {
      const bf16x8 a = *(const bf16x8*)(hid + (mi2 * 32 + l31) * LH + ks * 16 + hh * 8);
      const bf16x8 bb = *(const bf16x8*)(W2 + (size_t)(ni * 32 + l31) * 128 + ks * 16 + hh * 8);
      o = MFMA32(a, bb, o);
    }
    const int d = ni * 32 + l31;
    const float b2 = p.cmp_b2[w * 64 + (w == 0 ? dperm(d) : d)];
    const int bg = R0 >> 9;
    bf16_t* dst = (bf16_t*)(ws + (w == 0 ? OFF_KCMP : OFF_VCMP));
#pragma unroll
    for (int r = 0; r < 16; ++r) {
      const int n = (R0 & 511) + mi2 * 32 + (r & 3) + 8 * (r >> 2) + 4 * hh;
      dst[((size_t)bg * 512 + n) * 64 + d] = f2bf(n < 511 ? o[r] + b2 : 0.f);
    }
  }
}

constexpr int LK = 72;
constexpr int NSA_TILE = 18432;
constexpr int NSA_AIMP = 3 * NSA_TILE, NSA_CIMP = NSA_AIMP + 32768, NSA_SELM = NSA_CIMP + 32768;
constexpr float NSA_THR = 6.0f;
struct TileRegs { u32x4 k; u32x4 v; };

DI void nsa_load_tile(TileRegs& t, const bf16_t* kbase, size_t kstride, const bf16_t* vbase, size_t vstride) {
  const int tid = otid(), r = tid >> 3, ch = tid & 7;
  t.k = *(const u32x4*)(kbase + (size_t)r * kstride + ch * 8);
  t.v = *(const u32x4*)(vbase + (size_t)r * vstride + ch * 8);
}
DI void nsa_store_tile(const TileRegs& t, char* tile) {
  const int tid = otid(), r = tid >> 3, ch = tid & 7;
  *(u32x4*)((bf16_t*)tile + r * LK + ch * 8) = t.k;
  *(u32x4*)((bf16_t*)(tile + 9216) + r * LK + ch * 8) = t.v;
}
DI void nsa_scores(f32x16 (&st)[2], const char* tile, const bf16x8 (&qf)[4], int lane) {
  const bf16_t* Ks = (const bf16_t*)tile;
#pragma unroll
  for (int kt = 0; kt < 2; ++kt)
#pragma unroll
    for (int r = 0; r < 16; ++r) st[kt][r] = 0.f;
  __builtin_amdgcn_s_setprio(1);
#pragma unroll
  for (int ks = 0; ks < 4; ++ks)
#pragma unroll
    for (int kt = 0; kt < 2; ++kt) {
      const bf16x8 a = *(const bf16x8*)(Ks + (kt * 32 + (lane & 31)) * LK + ks * 16 + (lane >> 5) * 8);
      st[kt] = MFMA32(a, qf[ks], st[kt]);
    }
  __builtin_amdgcn_s_setprio(0);
}
DI void nsa_pv(f32x16 (&o)[2], const f32x16 (&pt)[2], const char* tile, int lane) {
  const int gi = lane >> 4, i16 = lane & 15, q = i16 >> 2, pp = i16 & 3;
  const LAS bf16_t* Vs = (const LAS bf16_t*)(tile + 9216) + (4 * (gi >> 1) + q) * LK + 16 * (gi & 1) + 4 * pp;
#pragma unroll
  for (int kt = 0; kt < 2; ++kt)
#pragma unroll
    for (int s = 0; s < 2; ++s) {
      u32x4 pk; pk.x = pack2(pt[kt][8 * s], pt[kt][8 * s + 1]); pk.y = pack2(pt[kt][8 * s + 2], pt[kt][8 * s + 3]);
      pk.z = pack2(pt[kt][8 * s + 4], pt[kt][8 * s + 5]); pk.w = pack2(pt[kt][8 * s + 6], pt[kt][8 * s + 7]);
      const bf16x8 pb = __builtin_bit_cast(bf16x8, pk);
      bf16x8 a[2];
#pragma unroll
      for (int dt = 0; dt < 2; ++dt) {
        const LAS bf16_t* vp = Vs + (kt * 32 + 16 * s) * LK + dt * 32;
        const s16x4 lo = __builtin_amdgcn_ds_read_tr16_b64_v4i16((LAS s16x4*)vp);
        const s16x4 hi = __builtin_amdgcn_ds_read_tr16_b64_v4i16((LAS s16x4*)(vp + 8 * LK));
        a[dt] = __builtin_shufflevector(lo, hi, 0, 1, 2, 3, 4, 5, 6, 7);
      }
      o[0] = MFMA32(a[0], pb, o[0]); o[1] = MFMA32(a[1], pb, o[1]);
    }
}

constexpr float NSA_NEG = -3.0e38f;
DI void nsa_online(f32x16 (&st)[2], bool sel, float& m, float& l, f32x16 (&o)[2], const char* tile, int lane) {
  float mx = NSA_NEG;
#pragma unroll
  for (int r = 0; r < 16; ++r) mx = fmaxf(mx, fmaxf(st[0][r], st[1][r]));
  mx = fmaxf(mx, __shfl_xor(mx, 32));
  mx = sel ? mx : NSA_NEG;
  if (__any(mx > m + NSA_THR)) {
    const float mn = fmaxf(m, mx);
    const float alpha = __builtin_amdgcn_exp2f(m - mn);
    m = mn; l *= alpha;
#pragma unroll
    for (int r = 0; r < 16; ++r) { o[0][r] *= alpha; o[1][r] *= alpha; }
  }
  const float ms = sel ? m : 1e30f;
  float sum = 0.f;
#pragma unroll
  for (int r = 0; r < 16; ++r) {
    const float p0 = __builtin_amdgcn_exp2f(st[0][r] - ms), p1 = __builtin_amdgcn_exp2f(st[1][r] - ms);
    st[0][r] = p0; st[1][r] = p1; sum += p0 + p1;
  }
  l += sum;
  nsa_pv(o, st, tile, lane);
}

struct NsaItem { int qb, b, g, bg, t; size_t tokrow; };
DI NsaItem nsa_item(int item0, int wave, int qi) {
  const int G = gridDim.x, k = item0 / G, bb = item0 - k * G;
  const int item = (k & 1) ? (k * G + (G - 1 - bb)) : item0;
  NsaItem it; it.qb = 127 - (item >> 4); const int rest = item & 15; it.b = rest >> 1; it.g = rest & 1;
  it.bg = it.b * 2 + it.g; it.t = it.qb * 64 + wave * 8 + qi; it.tokrow = (size_t)it.b * SEQ + it.t; return it;
}
DI void nsa_accum_store(bf16_t* dst, const f32x16 (&o)[2], float sc, bool first, int hh) {
#pragma unroll
  for (int dt = 0; dt < 2; ++dt)
#pragma unroll
    for (int q4 = 0; q4 < 4; ++q4) {
      u32x2* pp = (u32x2*)(dst + dt * 32 + 8 * q4 + 4 * hh);
      float a0 = sc * o[dt][4 * q4], a1 = sc * o[dt][4 * q4 + 1], a2 = sc * o[dt][4 * q4 + 2], a3 = sc * o[dt][4 * q4 + 3];
      if (!first) { const u32x2 old = *pp; a0 += bflo(old.x); a1 += bfhi(old.x); a2 += bflo(old.y); a3 += bfhi(old.y); }
      u32x2 wv; wv.x = pack2(a0, a1); wv.y = pack2(a2, a3);
      *pp = wv;
    }
}

DI void phase_nsa(const Params& p, char* smem, int branch_mask) {
  char* ws = p.ws;
  const int tid = otid(), lane = tid & 63, wave = tid >> 6, hh = lane >> 5, c = lane & 31, qi = c >> 2, r4 = c & 3;
  const bf16_t* Q = (const bf16_t*)(ws + OFF_Q);
  const float* gsig = (const float*)(ws + OFF_GSIG);
  bf16_t* ONSA = (bf16_t*)(ws + OFF_ONSA);
  u32x4* SELG = (u32x4*)(ws + OFF_SELG);
  constexpr int NITEM = NB * 2 * 128;

#pragma unroll 1
  for (int rep1 = 0; rep1 < ((PROBE_DUP & 4096) ? 2 : 1); ++rep1) {
    const bf16_t* KCMP = (const bf16_t*)(ws + OFF_KCMP); const bf16_t* VCMP = (const bf16_t*)(ws + OFF_VCMP);
    float* Aimp = (float*)(smem + NSA_AIMP) + wave * 1024;
    float* Cimp = (float*)(smem + NSA_CIMP) + wave * 1024;
    unsigned short* selm16 = (unsigned short*)(smem + NSA_SELM) + wave * 64;
    const u32x4* selm128 = (const u32x4*)(smem + NSA_SELM) + wave * 8;
    for (int item = blockIdx.x; item < NITEM; item += gridDim.x) {
      const NsaItem it = nsa_item(item, wave, qi);
      const int t = it.t;
      bf16x8 qf[4];
#pragma unroll
      for (int ks = 0; ks < 4; ++ks) qf[ks] = *(const bf16x8*)(Q + it.tokrow * 512 + (it.g * 4 + r4) * 64 + ks * 16 + hh * 8);
      const float g_c = gsig[it.tokrow * 32 + (it.g * 4 + r4) * 3 + 0];
      TileRegs tr;
      const int nmax = (it.qb * 64 + 63 - 31) >> 4, ntile = (nmax >> 6) + 1;
      const int nfull = (it.qb * 64 - 31) >> 4;
      const bf16_t* kb = KCMP + (size_t)it.bg * 512 * 64;
      const bf16_t* vb = VCMP + (size_t)it.bg * 512 * 64;
      float m = -1e30f, l = 0.f;
      __syncthreads();
      for (int i = lane; i < 1024; i += 64) { Aimp[i] = 0.f; Cimp[i] = 0.f; }
      nsa_load_tile(tr, kb, 64, vb, 64);
      nsa_store_tile(tr, smem);
      __syncthreads();
      for (int j = 0; j < ntile; ++j) {
        const char* tile = smem + (j & 1) * NSA_TILE;
        if (j + 1 < ntile) nsa_load_tile(tr, kb + (size_t)(j + 1) * 64 * 64, 64, vb + (size_t)(j + 1) * 64 * 64, 64);
        f32x16 st[2];
        nsa_scores(st, tile, qf, lane);
        const bool full = (j * 64 + 63 <= nfull);
        const int nlim = full ? 100000 : ((t - 31) >> 4) - j * 64 - 4 * hh;
        float mx = NSA_NEG;
#pragma unroll
        for (int kt = 0; kt < 2; ++kt)
#pragma unroll
          for (int r = 0; r < 16; ++r) {
            st[kt][r] = (kt * 32 + (r & 3) + 8 * (r >> 2) <= nlim) ? st[kt][r] : NSA_NEG;
            mx = fmaxf(mx, st[kt][r]);
          }
        mx = fmaxf(mx, __shfl_xor(mx, 32));
        const float mn = fmaxf(m, mx);
        float sum = 0.f;
#pragma unroll
        for (int kt = 0; kt < 2; ++kt)
#pragma unroll
          for (int r = 0; r < 16; ++r) sum += __builtin_amdgcn_exp2f(st[kt][r] - mn);
        l = l * __builtin_amdgcn_exp2f(m - mn) + sum;
        m = mn;
        if (j + 1 < ntile) nsa_store_tile(tr, smem + ((j + 1) & 1) * NSA_TILE);
        __syncthreads();
      }
      l += __shfl_xor(l, 32);
      const float inv_l = l > 0.f ? 1.0f / l : 0.f;
      f32x16 o[2];
#pragma unroll
      for (int r = 0; r < 16; ++r) { o[0][r] = 0.f; o[1][r] = 0.f; }
      nsa_load_tile(tr, kb, 64, vb, 64);
      nsa_store_tile(tr, smem);
      __syncthreads();
      for (int j = 0; j < ntile; ++j) {
        const char* tile = smem + (j & 1) * NSA_TILE;
        if (j + 1 < ntile) nsa_load_tile(tr, kb + (size_t)(j + 1) * 64 * 64, 64, vb + (size_t)(j + 1) * 64 * 64, 64);
        f32x16 st[2];
        nsa_scores(st, tile, qf, lane);
        const bool full = (j * 64 + 63 <= nfull);
        const int nlim = full ? 100000 : ((t - 31) >> 4) - j * 64 - 4 * hh;
#pragma unroll
        for (int kt = 0; kt < 2; ++kt)
#pragma unroll
          for (int r = 0; r < 16; ++r) {
            const float arg = (kt * 32 + (r & 3) + 8 * (r >> 2) <= nlim) ? st[kt][r] - m : NSA_NEG;
            st[kt][r] = __builtin_amdgcn_exp2f(arg) * inv_l;
          }
#pragma unroll
        for (int kt = 0; kt < 2; ++kt)
#pragma unroll
          for (int c4 = 0; c4 < 4; ++c4) {
            float carry = 0.5f * st[kt][4 * c4 + 3];
            float fullv = st[kt][4 * c4] + st[kt][4 * c4 + 1] + st[kt][4 * c4 + 2] + carry;
            fullv += __shfl_xor(fullv, 1); fullv += __shfl_xor(fullv, 2);
            carry += __shfl_xor(carry, 1); carry += __shfl_xor(carry, 2);
            const int jb = j * 16 + kt * 8 + 2 * c4 + hh;
            if (r4 == 0) { Aimp[qi * 128 + jb] = fullv; Cimp[qi * 128 + jb] = carry; }
          }
        if (branch_mask & 1) nsa_pv(o, st, tile, lane);
        if (j + 1 < ntile) nsa_store_tile(tr, smem + ((j + 1) & 1) * NSA_TILE);
        __syncthreads();
      }
      nsa_accum_store(ONSA + it.tokrow * 512 + (it.g * 4 + r4) * 64, o, (branch_mask & 1) ? g_c : 0.f, true, hh);
      const int cur = it.qb;
      if (cur <= 15) {
        if (lane < 8) { selm16[lane * 8 + 0] = (unsigned short)((2u << cur) - 1u);
#pragma unroll
          for (int k = 1; k < 8; ++k) selm16[lane * 8 + k] = 0; }
      } else {
        const int qs = lane >> 3, sub = lane & 7;
        float v[16];
#pragma unroll
        for (int i = 0; i < 16; ++i) {
          const int jj = sub * 16 + i;
          const bool ok = (jj >= 1) && (jj <= cur - 2);
          const int jm = jj >= 1 ? jj - 1 : 0;
          v[i] = ok ? (Aimp[qs * 128 + jj] + Cimp[qs * 128 + jm]) : -3e38f;
        }
        unsigned bits = 0;
        for (int itn = 0; itn < 13; ++itn) {
          float bv = v[0]; int bi = 0;
#pragma unroll
          for (int i = 1; i < 16; ++i) if (v[i] > bv) { bv = v[i]; bi = i; }
          int bj = sub * 16 + bi;
#pragma unroll
          for (int o2 = 1; o2 < 8; o2 <<= 1) {
            const float ov = __shfl_xor(bv, o2); const int oj = __shfl_xor(bj, o2);
            if (ov > bv || (ov == bv && oj < bj)) { bv = ov; bj = oj; }
          }
          if ((bj >> 4) == sub) {
            const int i2 = bj & 15;
#pragma unroll
            for (int i = 0; i < 16; ++i) if (i == i2) v[i] = -3e38f;
            bits |= 1u << i2;
          }
        }
        if (sub == 0) bits |= 1u;
        if ((cur >> 4) == sub) bits |= 1u << (cur & 15);
        if (((cur - 1) >> 4) == sub) bits |= 1u << ((cur - 1) & 15);
        selm16[qs * 8 + sub] = (unsigned short)bits;
      }
      __syncthreads();
      if (r4 == 0 && hh == 0) SELG[(size_t)it.bg * SEQ + t] = selm128[qi];
    }
  }
  __threadfence_block();
  __syncthreads();

#pragma unroll 1
  for (int sweep_i = 0; sweep_i < 2 + ((PROBE_DUP & 1024) ? 1 : 0) + ((PROBE_DUP & 2048) ? 1 : 0); ++sweep_i) {
    const int sweep = (sweep_i < 2) ? sweep_i : (((PROBE_DUP & 1024) && sweep_i == 2) ? 0 : 1);
    const bool dry = sweep_i >= 2;
    if (!(branch_mask & (sweep == 0 ? 2 : 4))) continue;
    const bf16_t* KB = (const bf16_t*)(ws + (sweep == 0 ? OFF_KS : OFF_KW)); const bf16_t* VB = (const bf16_t*)(ws + (sweep == 0 ? OFF_VS : OFF_VW));
    for (int item = blockIdx.x; item < NITEM; item += gridDim.x) {
      const NsaItem it = nsa_item(item, wave, qi);
      const int t = it.t, qb = it.qb;
      bf16x8 qf[4];
#pragma unroll
      for (int ks = 0; ks < 4; ++ks) qf[ks] = *(const bf16x8*)(Q + it.tokrow * 512 + (it.g * 4 + r4) * 64 + ks * 16 + hh * 8);
      const float g_b = gsig[it.tokrow * 32 + (it.g * 4 + r4) * 3 + 1 + sweep];
      u32x4 selw = {0xffffffffu, 0xffffffffu, 0xffffffffu, 0xffffffffu};
      if (sweep == 0) selw = SELG[(size_t)it.bg * SEQ + t];
      TileRegs tr;
      const bf16_t* kb = KB + (size_t)it.b * SEQ * 128 + it.g * 64;
      const bf16_t* vb = VB + (size_t)it.b * SEQ * 128 + it.g * 64;
      float m = -1e30f, l = 0.f;
      f32x16 o[2];
#pragma unroll
      for (int r = 0; r < 16; ++r) { o[0][r] = 0.f; o[1][r] = 0.f; }
      const int j0 = (sweep == 1 && qb >= 8) ? qb - 8 : 0;
      __syncthreads();
      nsa_load_tile(tr, kb + (size_t)j0 * 64 * 128, 128, vb + (size_t)j0 * 64 * 128, 128);
      nsa_store_tile(tr, smem);
      if (j0 + 1 <= qb) { nsa_load_tile(tr, kb + (size_t)(j0 + 1) * 64 * 128, 128, vb + (size_t)(j0 + 1) * 64 * 128, 128); nsa_store_tile(tr, smem + NSA_TILE); }
      if (j0 + 2 <= qb) nsa_load_tile(tr, kb + (size_t)(j0 + 2) * 64 * 128, 128, vb + (size_t)(j0 + 2) * 64 * 128, 128);
      __syncthreads();
      const bool late = wave >= 4;
      if (__builtin_amdgcn_readfirstlane(wave) >= 4) __builtin_amdgcn_s_setprio(1);
      bool has = false;
      m = 0.f;
      f32x16 st[2];
      {
        const unsigned w0 = j0 < 32 ? selw.x : (j0 < 64 ? selw.y : (j0 < 96 ? selw.z : selw.w));
        const float ini = ((w0 >> (j0 & 31)) & 1u) ? 0.f : -1e30f;
#pragma unroll
        for (int r = 0; r < 16; ++r) { st[0][r] = ini; st[1][r] = ini; }
        const bf16_t* Kc = (const bf16_t*)smem;
#pragma unroll
        for (int ks = 0; ks < 4; ++ks)
#pragma unroll
          for (int kt = 0; kt < 2; ++kt) st[kt] = MFMA32(*(const bf16x8*)(Kc + (kt * 32 + (lane & 31)) * LK + ks * 16 + (lane >> 5) * 8), qf[ks], st[kt]);
      }
      int bi = 0;
      for (int j = j0; j <= qb; ++j) {
        const char* tile = smem + bi * NSA_TILE;
        const int bn = bi == 2 ? 0 : bi + 1, bnn = bn == 2 ? 0 : bn + 1;
        const int jn = j + 1;
        const unsigned wn = jn < 32 ? selw.x : (jn < 64 ? selw.y : (jn < 96 ? selw.z : selw.w));
        const bool seln = (wn >> (jn & 31)) & 1u;
        const bf16_t* Kn = (const bf16_t*)(smem + bn * NSA_TILE) + (lane & 31) * LK + (lane >> 5) * 8;
        f32x16 sn[2];
        if (!late) {
          const float ini = seln ? -m : -1e30f;
#pragma unroll
          for (int r = 0; r < 16; ++r) { sn[0][r] = ini; sn[1][r] = ini; }
#pragma unroll
          for (int ks = 0; ks < 4; ++ks)
#pragma unroll
            for (int kt = 0; kt < 2; ++kt) sn[kt] = MFMA32(*(const bf16x8*)(Kn + kt * 32 * LK + ks * 16), qf[ks], sn[kt]);
        }
        if (j == qb || (sweep == 1 && j == qb - 8)) {
          const int khi = t - j * 64 - 4 * hh, klo = (sweep == 1) ? khi - 511 : -100000;
#pragma unroll
          for (int r = 0; r < 16; ++r) {
            const int o0 = (r & 3) + 8 * (r >> 2);
            st[0][r] = (o0 <= khi && o0 >= klo) ? st[0][r] : NSA_NEG;
            st[1][r] = (o0 + 32 <= khi && o0 + 32 >= klo) ? st[1][r] : NSA_NEG;
          }
        }
        float mx;
        {
          float a0, a1, a2, a3;
          asm("v_max3_f32 %0, %1, %2, %3" : "=v"(a0) : "v"(st[0][0]), "v"(st[0][1]), "v"(st[0][2]));
          asm("v_max3_f32 %0, %1, %2, %3" : "=v"(a1) : "v"(st[0][3]), "v"(st[0][4]), "v"(st[0][5]));
          asm("v_max3_f32 %0, %1, %2, %3" : "=v"(a2) : "v"(st[0][6]), "v"(st[0][7]), "v"(st[0][8]));
          asm("v_max3_f32 %0, %1, %2, %3" : "=v"(a3) : "v"(st[0][9]), "v"(st[0][10]), "v"(st[0][11]));
          asm("v_max3_f32 %0, %1, %2, %3" : "=v"(a0) : "v"(a0), "v"(st[0][12]), "v"(st[0][13]));
          asm("v_max3_f32 %0, %1, %2, %3" : "=v"(a1) : "v"(a1), "v"(st[0][14]), "v"(st[0][15]));
          asm("v_max3_f32 %0, %1, %2, %3" : "=v"(a2) : "v"(a2), "v"(st[1][0]), "v"(st[1][1]));
          asm("v_max3_f32 %0, %1, %2, %3" : "=v"(a3) : "v"(a3), "v"(st[1][2]), "v"(st[1][3]));
          asm("v_max3_f32 %0, %1, %2, %3" : "=v"(a0) : "v"(a0), "v"(st[1][4]), "v"(st[1][5]));
          asm("v_max3_f32 %0, %1, %2, %3" : "=v"(a1) : "v"(a1), "v"(st[1][6]), "v"(st[1][7]));
          asm("v_max3_f32 %0, %1, %2, %3" : "=v"(a2) : "v"(a2), "v"(st[1][8]), "v"(st[1][9]));
          asm("v_max3_f32 %0, %1, %2, %3" : "=v"(a3) : "v"(a3), "v"(st[1][10]), "v"(st[1][11]));
          asm("v_max3_f32 %0, %1, %2, %3" : "=v"(a0) : "v"(a0), "v"(st[1][12]), "v"(st[1][13]));
          asm("v_max3_f32 %0, %1, %2, %3" : "=v"(a1) : "v"(a1), "v"(st[1][14]), "v"(st[1][15]));
          asm("v_max3_f32 %0, %1, %2, %3" : "=v"(a0) : "v"(a0), "v"(a1), "v"(a2));
          const float other = a3;
          asm("v_max_f32 %0, %1, %2" : "=v"(mx) : "v"(a0), "v"(other));
          const float px = __shfl_xor(mx, 32);
          asm("v_max_f32 %0, %1, %2" : "=v"(mx) : "v"(mx), "v"(px));
        }
        const bool real = mx > -1e29f;
        const bool fresh = !has && real, up = has && (mx > NSA_THR);
        if (__any(fresh || up)) {
          const float delta = (fresh || up) ? mx : 0.f;
          const float alpha = up ? __builtin_amdgcn_exp2f(-delta) : 1.0f;
          m += delta; l *= alpha;
#pragma unroll
          for (int r = 0; r < 16; ++r) { o[0][r] *= alpha; o[1][r] *= alpha; st[0][r] -= delta; st[1][r] -= delta; }
          if (!late) {
            const float dn = seln ? delta : 0.f;
#pragma unroll
            for (int r = 0; r < 16; ++r) { sn[0][r] -= dn; sn[1][r] -= dn; }
          }
        }
        has = has || real;
        f32x2 s2 = {0.f, 0.f};
#pragma unroll
        for (int r = 0; r < 16; ++r) {
          const float p0 = __builtin_amdgcn_exp2f(st[0][r]), p1 = __builtin_amdgcn_exp2f(st[1][r]);
          st[0][r] = p0; st[1][r] = p1; s2 += (f32x2){p0, p1};
        }
        l += s2.x + s2.y;
        nsa_pv(o, st, tile, lane);
        if (late) {
          const float ini = seln ? -m : -1e30f;
#pragma unroll
          for (int r = 0; r < 16; ++r) { sn[0][r] = ini; sn[1][r] = ini; }
#pragma unroll
          for (int ks = 0; ks < 4; ++ks)
#pragma unroll
            for (int kt = 0; kt < 2; ++kt) sn[kt] = MFMA32(*(const bf16x8*)(Kn + kt * 32 * LK + ks * 16), qf[ks], sn[kt]);
        }
        if (j + 2 <= qb) nsa_store_tile(tr, smem + bnn * NSA_TILE);
        if (j + 3 <= qb) nsa_load_tile(tr, kb + (size_t)(j + 3) * 64 * 128, 128, vb + (size_t)(j + 3) * 64 * 128, 128);
#pragma unroll
        for (int r = 0; r < 16; ++r) { st[0][r] = sn[0][r]; st[1][r] = sn[1][r]; }
        bi = bn;
        __syncthreads();
      }
      __builtin_amdgcn_s_setprio(0);
      l += __shfl_xor(l, 32);
      if (!dry) nsa_accum_store(ONSA + it.tokrow * 512 + (it.g * 4 + r4) * 64, o, l > 0.f ? g_b / l : 0.f, false, hh);
      else asm volatile("" :: "v"(o[0]), "v"(o[1]), "v"(l));
    }
  }
}

DI unsigned ord_key(float f) { const unsigned u = __float_as_uint(f); return (u & 0x80000000u) ? ~u : (u | 0x80000000u); }
DI float ord_val(unsigned k) { return __uint_as_float((k & 0x80000000u) ? (k & 0x7fffffffu) : ~k); }
DI void cex(unsigned& hi, unsigned& lo) { const unsigned x = hi, y = lo; hi = x > y ? x : y; lo = x > y ? y : x; }
DI void sort16_desc(unsigned (&a)[16]) {
#pragma unroll
  for (int k = 2; k <= 16; k <<= 1)
#pragma unroll
    for (int j = k >> 1; j > 0; j >>= 1)
#pragma unroll
      for (int i = 0; i < 16; ++i) {
        const int l = i ^ j;
        if (l > i) { if ((i & k) == 0) cex(a[i], a[l]); else cex(a[l], a[i]); }
      }
}
DI void bitonic_finish16(unsigned (&a)[16]) {
#pragma unroll
  for (int j = 8; j > 0; j >>= 1)
#pragma unroll
    for (int i = 0; i < 16; ++i) { const int l = i ^ j; if (l > i) cex(a[i], a[l]); }
}
DI void merge_top16(unsigned (&a)[16], const unsigned (&b)[16]) {
#pragma unroll
  for (int i = 0; i < 16; ++i) a[i] = a[i] > b[15 - i] ? a[i] : b[15 - i];
  bitonic_finish16(a);
}
DI void merge_partner16(unsigned (&a)[16]) {
  unsigned b[16];
#pragma unroll
  for (int i = 0; i < 16; ++i) b[i] = (unsigned)__shfl_xor((int)a[i], 32);
  merge_top16(a, b);
}


DI void peer_top16(unsigned (&top)[16], const bf16_t* pqrow, const bf16_t* keys, int lane) {
  const int l31 = lane & 31, hh = lane >> 5;
  bf16x8 bq[8];
#pragma unroll
  for (int ks = 0; ks < 8; ++ks) bq[ks] = *(const bf16x8*)(pqrow + ks * 16 + hh * 8);
  unsigned grp[16];
#pragma unroll
  for (int nt = 0; nt < 4; ++nt) {
    f32x16 sa;
#pragma unroll
    for (int r = 0; r < 16; ++r) sa[r] = 0.f;
    const bf16_t* kp = keys + (size_t)(nt * 32 + l31) * 128 + hh * 8;
#pragma unroll
    for (int ks = 0; ks < 8; ++ks) { const bf16x8 a = *(const bf16x8*)(kp + ks * 16); sa = MFMA32(a, bq[ks], sa); }
#pragma unroll
    for (int r = 0; r < 16; ++r) {
      const int n = nt * 32 + (r & 3) + 8 * (r >> 2) + 4 * hh;
      grp[r] = (ord_key(sa[r]) & ~0x7Fu) | (unsigned)(127 - n);
    }
    sort16_desc(grp);
    if (nt == 0) {
#pragma unroll
      for (int i = 0; i < 16; ++i) top[i] = grp[i];
    } else merge_top16(top, grp);
  }
  merge_partner16(top);
}

DI void phase_route(const Params& p, char* smem) {
  char* ws = p.ws;
  const int tid = otid(), lane = tid & 63, wave = tid >> 6, l31 = lane & 31, hh = lane >> 5;
  const bf16_t* pq = (const bf16_t*)(ws + OFF_PQ);
  const bf16_t* pk = (const bf16_t*)(ws + OFF_PKEYS);
  int* eidx = (int*)(ws + OFF_EIDX);
  float* pgate = (float*)(ws + OFF_PGATE);
  unsigned* LS = (unsigned*)smem + wave * 1024;
  constexpr int CA[64] = {0,0,0,0,0,0,0,0,0,0,0,0,0,0,0,0, 1,1,1,1,1,1,1,1, 2,2,2,2,2, 3,3,3,3, 4,4,4, 5,5, 6,6, 7,7, 8,9,10,11,12,13,14,15, 0,0,0,0,0,0,0,0,0,0,0,0,0,0};
  constexpr int CB[64] = {0,1,2,3,4,5,6,7,8,9,10,11,12,13,14,15, 0,1,2,3,4,5,6,7, 0,1,2,3,4, 0,1,2,3, 0,1,2, 0,1, 0,1, 0,1, 0,0,0,0,0,0,0,0, 0,0,0,0,0,0,0,0,0,0,0,0,0,0};
  for (int item = blockIdx.x; item < (NTOK / 256) * 8; item += gridDim.x) {
    const int h = item & 7, t0 = (item >> 3) * 256 + wave * 32;
    unsigned s1[16], s2[16];
    const bf16_t* pqrow = pq + (size_t)(t0 + l31) * 2048 + h * 256;
    peer_top16(s1, pqrow, pk + (size_t)(h * 2) * 128 * 128, lane);
    peer_top16(s2, pqrow + 128, pk + (size_t)(h * 2 + 1) * 128 * 128, lane);
    float f1[16], f2[16];
#pragma unroll
    for (int i = 0; i < 16; ++i) { f1[i] = ord_val(s1[i]); f2[i] = ord_val(s2[i]); }
    unsigned ca[16], cb2[16];
#pragma unroll
    for (int i = 0; i < 32; ++i) {
      const int i0 = i, i1 = 25 + i;
      unsigned k0 = 0u, k1 = 0u;
      if (i0 < 25) k0 = (ord_key(f1[CA[i0]] + f2[CB[i0]]) & ~0xFFu) | (unsigned)(255 - (CA[i0] * 16 + CB[i0]));
      if (i1 < 50) k1 = (ord_key(f1[CA[i1]] + f2[CB[i1]]) & ~0xFFu) | (unsigned)(255 - (CA[i1] * 16 + CB[i1]));
      const unsigned kk = hh ? k1 : k0;
      if (i < 16) ca[i] = kk; else cb2[i - 16] = kk;
    }
    sort16_desc(ca); sort16_desc(cb2);
    merge_top16(ca, cb2);
    merge_partner16(ca);
    if (hh == 0) {
#pragma unroll
      for (int i = 0; i < 16; ++i) { LS[l31 * 32 + i] = s1[i]; LS[l31 * 32 + 16 + i] = s2[i]; }
    }
    const float mx = ord_val(ca[0]);
    float ex[16], sum = 0.f;
#pragma unroll
    for (int i = 0; i < 16; ++i) { ex[i] = __expf(ord_val(ca[i]) - mx); sum += ex[i]; }
    const float inv = 1.0f / sum;
    int eo[16]; float go[16];
#pragma unroll
    for (int i = 0; i < 16; ++i) {
      const int flat = 255 - (int)(ca[i] & 0xFFu);
      const unsigned k1 = LS[l31 * 32 + (flat >> 4)], k2 = LS[l31 * 32 + 16 + (flat & 15)];
      eo[i] = (127 - (int)(k1 & 0x7Fu)) * 128 + (127 - (int)(k2 & 0x7Fu));
      go[i] = ex[i] * inv;
    }
    const size_t ob = ((size_t)(t0 + l31) * 8 + h) * 16;
    if (hh == 0) {
      *(u32x4*)(eidx + ob) = (u32x4){(unsigned)eo[0], (unsigned)eo[1], (unsigned)eo[2], (unsigned)eo[3]};
      *(u32x4*)(eidx + ob + 4) = (u32x4){(unsigned)eo[4], (unsigned)eo[5], (unsigned)eo[6], (unsigned)eo[7]};
      *(f32x4*)(pgate + ob) = (f32x4){go[0], go[1], go[2], go[3]};
      *(f32x4*)(pgate + ob + 4) = (f32x4){go[4], go[5], go[6], go[7]};
    } else {
      *(u32x4*)(eidx + ob + 8) = (u32x4){(unsigned)eo[8], (unsigned)eo[9], (unsigned)eo[10], (unsigned)eo[11]};
      *(u32x4*)(eidx + ob + 12) = (u32x4){(unsigned)eo[12], (unsigned)eo[13], (unsigned)eo[14], (unsigned)eo[15]};
      *(f32x4*)(pgate + ob + 8) = (f32x4){go[8], go[9], go[10], go[11]};
      *(f32x4*)(pgate + ob + 12) = (f32x4){go[12], go[13], go[14], go[15]};
    }
  }
}

#define FOR32(M) M(0) M(1) M(2) M(3) M(4) M(5) M(6) M(7) M(8) M(9) M(10) M(11) M(12) M(13) M(14) M(15) M(16) M(17) M(18) M(19) M(20) M(21) M(22) M(23) M(24) M(25) M(26) M(27) M(28) M(29) M(30) M(31)
DI float dot16_fp8(const u32x4 raw, const float (&hx)[16]) {
  const f32x2 a0 = __builtin_amdgcn_cvt_pk_f32_fp8((int)raw.x, false), a1 = __builtin_amdgcn_cvt_pk_f32_fp8((int)raw.x, true);
  const f32x2 b0 = __builtin_amdgcn_cvt_pk_f32_fp8((int)raw.y, false), b1 = __builtin_amdgcn_cvt_pk_f32_fp8((int)raw.y, true);
  const f32x2 c0 = __builtin_amdgcn_cvt_pk_f32_fp8((int)raw.z, false), c1 = __builtin_amdgcn_cvt_pk_f32_fp8((int)raw.z, true);
  const f32x2 d0 = __builtin_amdgcn_cvt_pk_f32_fp8((int)raw.w, false), d1 = __builtin_amdgcn_cvt_pk_f32_fp8((int)raw.w, true);
  float d = (hx[0] * a0.x + hx[1] * a0.y) + (hx[2] * a1.x + hx[3] * a1.y);
  d += (hx[4] * b0.x + hx[5] * b0.y) + (hx[6] * b1.x + hx[7] * b1.y);
  d += (hx[8] * c0.x + hx[9] * c0.y) + (hx[10] * c1.x + hx[11] * c1.y);
  d += (hx[12] * d0.x + hx[13] * d0.y) + (hx[14] * d1.x + hx[15] * d1.y);
  return d;
}
#define FOR16(M) M(0) M(1) M(2) M(3) M(4) M(5) M(6) M(7) M(8) M(9) M(10) M(11) M(12) M(13) M(14) M(15)
DI void phase_ffn_u(const Params& p) {
  char* ws = p.ws;
  const int lane = otid() & 63, wave = otid() >> 6, pg = lane >> 3, dc = lane & 7;
  const int sl = blockIdx.x & 7, wslot = (blockIdx.x >> 3) * NW + wave, nw = (gridDim.x >> 3) * NW;
  const unsigned char* PU8 = (const unsigned char*)(ws + OFF_PU8) + (size_t)sl * 16384 * 128 + dc * 16;
  const bf16_t* h2 = (const bf16_t*)(ws + OFF_H) + sl * 128 + dc * 16;
  const int* eidx = (const int*)(ws + OFF_EIDX);
  float* part = (float*)(ws + OFF_PART) + (size_t)sl * NTOK * 128;
  const int j0 = (dc >> 2) * 64 + ((2 * dc) & 7) * 8 + pg;
  int ev0 = 0, ev1 = 0, nev0 = 0, nev1 = 0; u32x4 ha = {0u, 0u, 0u, 0u}, hb = ha, nha = ha, nhb = ha;
  if (wslot < NTOK) { ev0 = eidx[(size_t)wslot * 128 + lane]; ev1 = eidx[(size_t)wslot * 128 + 64 + lane]; ha = *(const u32x4*)(h2 + (size_t)wslot * DM); hb = *(const u32x4*)(h2 + (size_t)wslot * DM + 8); }
  for (int t = wslot; t < NTOK; t += nw) {
    if (t + nw < NTOK) { const size_t o = (size_t)(t + nw) * 128; nev0 = eidx[o + lane]; nev1 = eidx[o + 64 + lane]; nha = *(const u32x4*)(h2 + (size_t)(t + nw) * DM); nhb = *(const u32x4*)(h2 + (size_t)(t + nw) * DM + 8); }
    float hx[16];
    { float t8[8]; unpack8(ha, t8);
#pragma unroll
      for (int i = 0; i < 8; ++i) hx[i] = t8[i];
      unpack8(hb, t8);
#pragma unroll
      for (int i = 0; i < 8; ++i) hx[8 + i] = t8[i]; }
#define FFU_LD(it) const u32x4 ru##it = *(const u32x4*)(PU8 + (size_t)__shfl((it) < 8 ? ev0 : ev1, ((it) & 7) * 8 + pg) * 128);
    FOR16(FFU_LD)
    float d[16];
#define FFU_CP(it) d[it] = dot16_fp8(ru##it, hx);
    FOR16(FFU_CP)
    float r8[8], r4[4], r2[2];
    { const bool hi = dc & 4;
#pragma unroll
      for (int i = 0; i < 8; ++i) { const float keep = hi ? d[8 + i] : d[i], send = hi ? d[i] : d[8 + i]; r8[i] = keep + __shfl_xor(send, 4); } }
    { const bool hi = dc & 2;
#pragma unroll
      for (int i = 0; i < 4; ++i) { const float keep = hi ? r8[4 + i] : r8[i], send = hi ? r8[i] : r8[4 + i]; r4[i] = keep + __shfl_xor(send, 2); } }
    { const bool hi = dc & 1;
#pragma unroll
      for (int i = 0; i < 2; ++i) { const float keep = hi ? r4[2 + i] : r4[i], send = hi ? r4[i] : r4[2 + i]; r2[i] = keep + __shfl_xor(send, 1); } }
    part[(size_t)t * 128 + j0] = r2[0];
    part[(size_t)t * 128 + j0 + 8] = r2[1];
    ev0 = nev0; ev1 = nev1; ha = nha; hb = nhb;
  }
}
DI void phase_ffn_w(const Params& p) {
  char* ws = p.ws;
  const int lane = otid() & 63, wave = otid() >> 6;
  const float* part = (const float*)(ws + OFF_PART);
  const float* scu = (const float*)(ws + OFF_SCU); const float* scv = (const float*)(ws + OFF_SCV);
  const int* eidx = (const int*)(ws + OFF_EIDX);
  const float* pgate = (const float*)(ws + OFF_PGATE);
  float* wbuf = (float*)(ws + OFF_WBUF);
  for (int grp = blockIdx.x; grp < NTOK / NW; grp += gridDim.x) {
    const size_t o = (size_t)(grp * NW + wave) * 128 + lane;
    float a0 = 0.f, a1 = 0.f;
#pragma unroll
    for (int s8 = 0; s8 < 8; ++s8) { a0 += part[(size_t)s8 * NTOK * 128 + o]; a1 += part[(size_t)s8 * NTOK * 128 + o + 64]; }
    const int e0 = eidx[o], e1 = eidx[o + 64];
    wbuf[o] = pgate[o] * gelu_f(a0 * scu[e0]) * scv[e0];
    wbuf[o + 64] = pgate[o + 64] * gelu_f(a1 * scu[e1]) * scv[e1];
  }
}
DI void phase_ffn_v(const Params& p) {
  char* ws = p.ws;
  const int lane = otid() & 63, wave = otid() >> 6, pg = lane >> 3, dc = lane & 7;
  const int sl = blockIdx.x & 7, wslot = (blockIdx.x >> 3) * NW + wave, nw = (gridDim.x >> 3) * NW;
  const unsigned char* PV8 = (const unsigned char*)(ws + OFF_PV8) + (size_t)sl * 16384 * 128 + dc * 16;
  const int* eidx = (const int*)(ws + OFF_EIDX);
  const float* wbuf = (const float*)(ws + OFF_WBUF);
  bf16_t* ffnb = (bf16_t*)(ws + OFF_FFNB);
  int ev0 = 0, ev1 = 0, nev0 = 0, nev1 = 0; float w0 = 0.f, w1 = 0.f, nw0 = 0.f, nw1 = 0.f;
  if (wslot < NTOK) { ev0 = eidx[(size_t)wslot * 128 + lane]; ev1 = eidx[(size_t)wslot * 128 + 64 + lane]; w0 = wbuf[(size_t)wslot * 128 + lane]; w1 = wbuf[(size_t)wslot * 128 + 64 + lane]; }
  for (int t = wslot; t < NTOK; t += nw) {
    if (t + nw < NTOK) { const size_t o = (size_t)(t + nw) * 128; nev0 = eidx[o + lane]; nev1 = eidx[o + 64 + lane]; nw0 = wbuf[o + lane]; nw1 = wbuf[o + 64 + lane]; }
#define FFV_LD(it) const u32x4 rv##it = *(const u32x4*)(PV8 + (size_t)__shfl((it) < 8 ? ev0 : ev1, ((it) & 7) * 8 + pg) * 128);
#define FFV_CP(it) { const float wj = __shfl((it) < 8 ? w0 : w1, ((it) & 7) * 8 + pg); \
      const f32x2 a0 = __builtin_amdgcn_cvt_pk_f32_fp8((int)rv##it.x, false), a1 = __builtin_amdgcn_cvt_pk_f32_fp8((int)rv##it.x, true); \
      const f32x2 b0 = __builtin_amdgcn_cvt_pk_f32_fp8((int)rv##it.y, false), b1 = __builtin_amdgcn_cvt_pk_f32_fp8((int)rv##it.y, true); \
      const f32x2 c0 = __builtin_amdgcn_cvt_pk_f32_fp8((int)rv##it.z, false), c1 = __builtin_amdgcn_cvt_pk_f32_fp8((int)rv##it.z, true); \
      const f32x2 d0 = __builtin_amdgcn_cvt_pk_f32_fp8((int)rv##it.w, false), d1 = __builtin_amdgcn_cvt_pk_f32_fp8((int)rv##it.w, true); \
      acc[0] += wj * a0.x; acc[1] += wj * a0.y; acc[2] += wj * a1.x; acc[3] += wj * a1.y; acc[4] += wj * b0.x; acc[5] += wj * b0.y; acc[6] += wj * b1.x; acc[7] += wj * b1.y; \
      acc[8] += wj * c0.x; acc[9] += wj * c0.y; acc[10] += wj * c1.x; acc[11] += wj * c1.y; acc[12] += wj * d0.x; acc[13] += wj * d0.y; acc[14] += wj * d1.x; acc[15] += wj * d1.y; }
    FOR16(FFV_LD)
    float acc[16];
#pragma unroll
    for (int i = 0; i < 16; ++i) acc[i] = 0.f;
    FOR16(FFV_CP)
    float r8[8], r4[4], r2[2];
    { const bool hi = lane & 32;
#pragma unroll
      for (int i = 0; i < 8; ++i) { const float keep = hi ? acc[8 + i] : acc[i], send = hi ? acc[i] : acc[8 + i]; r8[i] = keep + __shfl_xor(send, 32); } }
    { const bool hi = lane & 16;
#pragma unroll
      for (int i = 0; i < 4; ++i) { const float keep = hi ? r8[4 + i] : r8[i], send = hi ? r8[i] : r8[4 + i]; r4[i] = keep + __shfl_xor(send, 16); } }
    { const bool hi = lane & 8;
#pragma unroll
      for (int i = 0; i < 2; ++i) { const float keep = hi ? r4[2 + i] : r4[i], send = hi ? r4[i] : r4[2 + i]; r2[i] = keep + __shfl_xor(send, 8); } }
    *(unsigned*)(ffnb + (size_t)t * DM + sl * 128 + dc * 16 + 2 * pg) = pack2(r2[0], r2[1]);
    ev0 = nev0; ev1 = nev1; w0 = nw0; w1 = nw1;
  }
}
DI void phase_final(const Params& p) {
  char* ws = p.ws;
  const int lane = otid() & 63, wave = otid() >> 6;
  const bf16_t* x1 = (const bf16_t*)(ws + OFF_X1);
  const bf16_t* ffnb = (const bf16_t*)(ws + OFF_FFNB);
  const float* mod = (const float*)(ws + OFF_MOD);
  for (int grp = blockIdx.x; grp < NTOK / NW; grp += gridDim.x) {
    const int row = grp * NW + wave, b = row >> 13;
    float v[16];
#pragma unroll
    for (int i = 0; i < 4; ++i) {
      const int col = i * 256 + lane * 4;
      const f32x4 gt2 = *(const f32x4*)(mod + b * 6144 + 5120 + col);
      const u32x2 xr = *(const u32x2*)(x1 + (size_t)row * DM + col), fr = *(const u32x2*)(ffnb + (size_t)row * DM + col);
      v[4 * i] = DN_ALPHA * bflo(xr.x) + gt2.x * bflo(fr.x); v[4 * i + 1] = DN_ALPHA * bfhi(xr.x) + gt2.y * bfhi(fr.x);
      v[4 * i + 2] = DN_ALPHA * bflo(xr.y) + gt2.z * bflo(fr.y); v[4 * i + 3] = DN_ALPHA * bfhi(xr.y) + gt2.w * bfhi(fr.y);
    }
    float mean, rstd; row_stats(v, mean, rstd);
#pragma unroll
    for (int i = 0; i < 4; ++i) {
      const int col = i * 256 + lane * 4;
      const f32x4 g = *(const f32x4*)(p.ln2_g + col), bb = *(const f32x4*)(p.ln2_b + col);
      f32x4 o;
      o.x = (v[4 * i] - mean) * rstd * g.x + bb.x; o.y = (v[4 * i + 1] - mean) * rstd * g.y + bb.y;
      o.z = (v[4 * i + 2] - mean) * rstd * g.z + bb.z; o.w = (v[4 * i + 3] - mean) * rstd * g.w + bb.w;
      *(f32x4*)(p.out + (size_t)row * DM + col) = o;
    }
  }
}

#define XB_TMO      128
#define XB_XCNT(j)  (256  + 64 * (j))
#define XB_XSUB(j)  (1280 + 64 * (j))
#define XB_XGEN(j)  (2304 + 64 * (j))
#define XB_TOP      3328
#define XB_TOPGEN   3392
#define XCD_BAR_WORDS 3456
#define XB_SPIN_CAP (1u << 22)
DI unsigned xb_ld(unsigned* p) { return __hip_atomic_load(p, __ATOMIC_RELAXED, __HIP_MEMORY_SCOPE_AGENT); }
DI unsigned xb_add(unsigned* p, unsigned v) { return __hip_atomic_fetch_add(p, v, __ATOMIC_RELAXED, __HIP_MEMORY_SCOPE_AGENT); }
DI unsigned xb_xcc_id() { return (unsigned)__builtin_amdgcn_s_getreg((3 << 11) | 20) & 0xFu; }
#define XB_SPIN(cond, bar) do { unsigned _sp = 0; while (cond) { __builtin_amdgcn_s_sleep(1); \
    if ((++_sp & 255u) == 0u) { if (xb_ld(&(bar)[XB_TMO])) break; if (_sp > XB_SPIN_CAP) { atomicAdd(&(bar)[XB_TMO], 1u); break; } } } } while (0)
struct XcdBarrier { unsigned* bar; unsigned x; volatile LAS unsigned* st; };
DI XcdBarrier xcd_barrier_post(unsigned* bar, volatile LAS unsigned* st) {
  XcdBarrier b; b.bar = bar; b.x = xb_xcc_id(); b.st = st;
  if (threadIdx.x == 0) (void)xb_add(&bar[XB_XCNT(b.x)], 1u);
  return b;
}
DI void xcd_barrier_complete(unsigned* bar, unsigned x, unsigned& nloc, unsigned& nx) {
  const unsigned G = gridDim.x * gridDim.y * gridDim.z;
  unsigned sum, cnt, mine, sp = 0u;
  for (;;) {
    sum = 0u; cnt = 0u; mine = 0u;
#pragma unroll
    for (unsigned j = 0; j < 16; ++j) { const unsigned c = xb_ld(&bar[XB_XCNT(j)]); sum += c; cnt += (c > 0u) ? 1u : 0u; mine = (j == x) ? c : mine; }
    if (sum == G) break;
    __builtin_amdgcn_s_sleep(1);
    if ((++sp & 255u) == 0u) { if (xb_ld(&bar[XB_TMO])) break; if (sp > XB_SPIN_CAP) { atomicAdd(&bar[XB_TMO], 1u); break; } }
  }
  nloc = mine > 0u ? mine : 1u; nx = cnt > 0u ? cnt : 1u;
}
DI void xcd_barrier(const XcdBarrier& b) {
  asm volatile("s_waitcnt vmcnt(0)" ::: "memory");
  __syncthreads();
  if (threadIdx.x == 0) {
    unsigned* bar = b.bar;
    __builtin_amdgcn_s_waitcnt(0);
    unsigned nloc = b.st[0], nx = b.st[1];
    if (nloc == 0u) { xcd_barrier_complete(bar, b.x, nloc, nx); b.st[0] = nloc; b.st[1] = nx; }
    const unsigned old = xb_add(&bar[XB_XSUB(b.x)], 1u);
    const unsigned gen = old / nloc;
    if (old + 1u == (gen + 1u) * nloc) {
      __builtin_amdgcn_fence(__ATOMIC_RELEASE, "agent");
      asm volatile("s_waitcnt vmcnt(0)" ::: "memory");
      const unsigned og = xb_add(&bar[XB_TOP], 1u);
      const unsigned tg = og / nx;
      if (og + 1u == (tg + 1u) * nx) xb_add(&bar[XB_TOPGEN], 1u);
      else XB_SPIN(xb_ld(&bar[XB_TOPGEN]) == tg, bar);
      __builtin_amdgcn_fence(__ATOMIC_ACQUIRE, "agent");
      xb_add(&bar[XB_XGEN(b.x)], 1u);
      asm volatile("s_waitcnt vmcnt(0)" ::: "memory");
    } else {
      XB_SPIN(xb_ld(&bar[XB_XGEN(b.x)]) == gen, bar);
      __builtin_amdgcn_fence(__ATOMIC_ACQUIRE, "agent");
      asm volatile("s_waitcnt vmcnt(0)" ::: "memory");
    }
  }
  __syncthreads();
}

constexpr int SMEM_BYTES = 131072 + 256;

__global__ void __launch_bounds__(NT, 2) k_mega(Params p) {
  __shared__ __attribute__((aligned(16))) char smem[SMEM_BYTES];
  cg::grid_group grid = cg::this_grid();
  if (threadIdx.x == 0) *(u32x4*)(smem + 131072) = (u32x4){0u, 0u, 0u, 0u};
  __syncthreads();
  const XcdBarrier xb = xcd_barrier_post((unsigned*)(p.ws + OFF_BAR), (volatile LAS unsigned*)(smem + 131072));
#define REP(mask) _Pragma("unroll 1") for (int rep_ = 0; rep_ < ((PROBE_DUP & (mask)) ? 2 : 1); ++rep_)
  REP(1) phase_prep(p, smem);
  grid.sync();
  REP(1) phase_ln_in(p);
  xcd_barrier(xb);
  REP(2) phase_gemm1(p, smem);
  xcd_barrier(xb);
  REP(4) phase_compress(p, smem);
  phase_sgu(p, smem);
  xcd_barrier(xb);
  REP(8) phase_nsa(p, smem, NSA_MASK);
  xcd_barrier(xb);
  REP(16) phase_merge(p, smem);
  xcd_barrier(xb);
  REP(16) phase_outproj(p, smem);
  xcd_barrier(xb);
  REP(1) phase_ln_mid(p);
  xcd_barrier(xb);
  REP(32) phase_peerq(p, smem);
  xcd_barrier(xb);
  REP(64) phase_route(p, smem);
  xcd_barrier(xb);
  REP(128) phase_ffn_u(p);
  xcd_barrier(xb);
  REP(128) phase_ffn_w(p);
  xcd_barrier(xb);
  REP(256) phase_ffn_v(p);
  xcd_barrier(xb);
  REP(512) phase_final(p);
}

extern "C" void kernel_launch(void* const* d_in, const int* in_sizes, int n_in, void* d_out, int out_size, void* d_ws, size_t ws_size, hipStream_t stream) {
  if (ws_size < OFF_END) { fprintf(stderr, "workspace too small: %zu < %zu\n", ws_size, (size_t)OFF_END); return; }
  static int grid_blocks = 0;
  if (!grid_blocks) {
    int dev = 0, cus = 0, per_cu = 0;
    (void)hipGetDevice(&dev);
    (void)hipDeviceGetAttribute(&cus, hipDeviceAttributeMultiprocessorCount, dev);
    (void)hipOccupancyMaxActiveBlocksPerMultiprocessor(&per_cu, k_mega, NT, 0);
    if (per_cu < 1) fprintf(stderr, "occupancy query returned %d\n", per_cu);
    grid_blocks = (cus / 8) * 8;
  }
  Params p{};
  const float** fp = (const float**)&p;
  for (int i = 0; i < 26; ++i) fp[i] = (const float*)d_in[i];
  p.out = (float*)d_out;
  p.ws = (char*)d_ws;
  for (int i = 0; i < 32; ++i) p.inv_freq[i] = (float)pow(10000.0, -(double)i / 32.0);
  (void)hipMemsetAsync((char*)d_ws + OFF_BAR, 0, XCD_BAR_WORDS * 4, stream);
  void* args[] = {&p};
  hipError_t e = hipLaunchCooperativeKernel((void*)k_mega, dim3(grid_blocks), dim3(NT), args, 0, stream);
  if (e != hipSuccess) fprintf(stderr, "cooperative launch failed: %s (grid %d)\n", hipGetErrorString(e), grid_blocks);
}
```

```cpp
#include <hip/hip_runtime.h>
#include <hip/hip_cooperative_groups.h>
#include <stdint.h>
#include <stdio.h>
#include <math.h>
namespace cg = cooperative_groups;

#ifndef PROBE_DUP
#define PROBE_DUP 0
#endif
#ifndef NSA_MASK
#define NSA_MASK 7
#endif
typedef unsigned short bf16_t;
typedef short bf16x8 __attribute__((ext_vector_type(8)));
typedef short s16x4 __attribute__((ext_vector_type(4)));
typedef float f32x16 __attribute__((ext_vector_type(16)));
typedef float f32x4 __attribute__((ext_vector_type(4)));
typedef float f32x2 __attribute__((ext_vector_type(2)));
typedef __bf16 bf16v2 __attribute__((ext_vector_type(2)));
typedef unsigned u32x4 __attribute__((ext_vector_type(4)));
typedef unsigned u32x2 __attribute__((ext_vector_type(2)));
#define DI __device__ __forceinline__
#define LAS __attribute__((address_space(3)))
#define MFMA32(a, b, c) __builtin_amdgcn_mfma_f32_32x32x16_bf16((a), (b), (c), 0, 0, 0)

constexpr int NT = 512, NW = 8;
constexpr int NB = 8, SEQ = 8192, DM = 1024, NTOK = NB * SEQ;
constexpr int N1 = 4608;
constexpr float DN_ALPHA = 1.189207115002721f;
constexpr float LN_EPS = 1e-5f;

constexpr size_t MB = 1024 * 1024;
constexpr size_t OFF_MOD = 0;
constexpr size_t OFF_ROPE = OFF_MOD + 256 * 1024;
constexpr size_t OFF_POSB = OFF_ROPE + 2 * MB;
constexpr size_t OFF_WT1 = OFF_POSB + 4096;
constexpr size_t OFF_WB = OFF_WT1 + (size_t)N1 * 1024 * 2;
constexpr size_t OFF_WOUT = OFF_WB + 2 * MB;
constexpr size_t OFF_WQ = OFF_WOUT + 2 * MB;
constexpr size_t OFF_PKEYS = OFF_WQ + 4 * MB;
constexpr size_t OFF_CW1 = OFF_PKEYS + MB / 2;
constexpr size_t OFF_CW2 = OFF_CW1 + MB;
constexpr size_t OFF_SGUW = OFF_CW2 + 32 * 1024;
constexpr size_t OFF_SCU = OFF_SGUW + 256 * 1024;
constexpr size_t OFF_SCV = OFF_SCU + 64 * 1024;
constexpr size_t OFF_PU = OFF_SCV + 64 * 1024;
constexpr size_t OFF_PV = OFF_PU + 32 * MB;
constexpr size_t OFF_ACT = ((OFF_PV + 32 * MB + 4095) / 4096) * 4096;
constexpr size_t OFF_H = OFF_ACT;
constexpr size_t OFF_Q = OFF_H + 128 * MB;
constexpr size_t OFF_KC = OFF_Q + 64 * MB;
constexpr size_t OFF_VC = OFF_KC + 16 * MB;
constexpr size_t OFF_KS = OFF_VC + 16 * MB;
constexpr size_t OFF_VS = OFF_KS + 16 * MB;
constexpr size_t OFF_KW = OFF_VS + 16 * MB;
constexpr size_t OFF_VW = OFF_KW + 16 * MB;
constexpr size_t OFF_U = OFF_VW + 16 * MB;
constexpr size_t OFF_V = OFF_U + 64 * MB;
constexpr size_t OFF_GATE = OFF_V + 64 * MB;
constexpr size_t OFF_GSIG = OFF_GATE + 256 * MB;
constexpr size_t OFF_KCMP = OFF_GSIG + 8 * MB;
constexpr size_t OFF_VCMP = OFF_KCMP + MB;
constexpr size_t OFF_ONSA = OFF_VCMP + MB;
constexpr size_t OFF_SELG = OFF_ONSA + 64 * MB;
constexpr size_t OFF_BAR = OFF_SELG + 2 * MB;
constexpr size_t OFF_END = OFF_BAR + 64 * 1024;
constexpr size_t OFF_X1 = OFF_Q;
constexpr size_t OFF_Y = OFF_GATE;
constexpr size_t OFF_PQ = OFF_GATE;
constexpr size_t OFF_EIDX = OFF_ONSA;
constexpr size_t OFF_PGATE = OFF_ONSA + 32 * MB;
constexpr size_t OFF_PU8 = OFF_PU;
constexpr size_t OFF_PART = OFF_GATE;
constexpr size_t OFF_PV8 = OFF_PU + 16 * MB;
constexpr size_t OFF_WBUF = OFF_PU + 32 * MB;
constexpr size_t OFF_FFNB = OFF_GATE;

struct Params {
  const float *x, *c, *w_ada, *b_ada, *w_in, *cmp_pos, *cmp_w1, *cmp_b1, *cmp_w2, *cmp_b2, *sgu_ln_g, *sgu_ln_b, *sgu_w, *sgu_b,
      *w_branch, *w_merge, *b_merge, *w_out, *ln1_g, *ln1_b, *peer_wq, *peer_keys, *peer_u, *peer_v, *ln2_g, *ln2_b;
  float* out;
  char* ws;
  float inv_freq[32];
};

DI unsigned pack2(float lo, float hi) { f32x2 v = {lo, hi}; bf16v2 r = __builtin_convertvector(v, bf16v2); return __builtin_bit_cast(unsigned, r); }
DI bf16_t f2bf(float f) { __bf16 r = (__bf16)f; return __builtin_bit_cast(unsigned short, r); }
DI float bf2f(bf16_t h) { return __uint_as_float(((unsigned)h) << 16); }
DI float bflo(unsigned u) { return __uint_as_float(u << 16); }
DI float bfhi(unsigned u) { return __uint_as_float(u & 0xffff0000u); }
DI float gelu_f(float v) { return 0.5f * v * (1.0f + erff(v * 0.70710678118654752f)); }
DI float sigmoid_f(float v) { return 1.0f / (1.0f + __expf(-v)); }
DI int otid() { int t = __builtin_amdgcn_workitem_id_x(); asm volatile("" : "+v"(t)); return t; }
DI void lds_barrier() { asm volatile("s_waitcnt lgkmcnt(0)" ::: "memory"); __builtin_amdgcn_s_barrier(); asm volatile("" ::: "memory"); }
DI float wave_sum(float v) {
#pragma unroll
  for (int o = 32; o > 0; o >>= 1) v += __shfl_xor(v, o);
  return v;
}
DI void ld8(const float* pz, float (&v)[8]) { const f32x4 a = *(const f32x4*)pz, b = *(const f32x4*)(pz + 4); v[0] = a.x; v[1] = a.y; v[2] = a.z; v[3] = a.w; v[4] = b.x; v[5] = b.y; v[6] = b.z; v[7] = b.w; }
DI u32x4 pack8(const float (&v)[8]) { u32x4 w; w.x = pack2(v[0], v[1]); w.y = pack2(v[2], v[3]); w.z = pack2(v[4], v[5]); w.w = pack2(v[6], v[7]); return w; }
DI void unpack8(const u32x4 w, float (&v)[8]) { v[0] = bflo(w.x); v[1] = bfhi(w.x); v[2] = bflo(w.y); v[3] = bfhi(w.y); v[4] = bflo(w.z); v[5] = bfhi(w.z); v[6] = bflo(w.w); v[7] = bfhi(w.w); }
DI f32x2 gelu_pk(f32x2 v) {
  const f32x2 av = __builtin_elementwise_abs(v), d = av * 0.2316418882f + 1.0f;
  f32x2 t; t.x = __builtin_amdgcn_rcpf(d.x); t.y = __builtin_amdgcn_rcpf(d.y);
  f32x2 q = t * 0.5307027145f + (-0.7265760135f); q = q * t + 0.7107068705f; q = q * t + (-0.142248368f); q = q * t + 0.127414796f; q = q * t;
  const f32x2 s = (v * v) * (-0.72134752044f);
  f32x2 e; e.x = __builtin_amdgcn_exp2f(s.x); e.y = __builtin_amdgcn_exp2f(s.y);
  const f32x2 m = v * (q * e), r = v - m;
  f32x2 o; o.x = v.x < 0.f ? m.x : r.x; o.y = v.y < 0.f ? m.y : r.y; return o;
}
__host__ __device__ __forceinline__ int dperm(int q) { const int grp = q >> 5, fq = (q >> 3) & 3, j = q & 7; return (j < 4) ? (16 * grp + 4 * fq + j) : (32 + 16 * grp + 4 * fq + (j - 4)); }

template <class F>
DI void tconv_tile(float* tile, int k0, int n0, bf16_t* dst, int ldd, F f) {
  const int tid = otid();
  __syncthreads();
#pragma unroll 4
  for (int i = 0; i < 8; ++i) { const int kl = i * 8 + (tid >> 6), nl = tid & 63; tile[nl * 65 + kl] = f(k0 + kl, n0 + nl); }
  __syncthreads();
  {
    const int nl = tid >> 3, kc = tid & 7;
    const float* t = tile + nl * 65 + kc * 8;
    u32x4 w; w.x = pack2(t[0], t[1]); w.y = pack2(t[2], t[3]); w.z = pack2(t[4], t[5]); w.w = pack2(t[6], t[7]);
    *(u32x4*)(dst + (size_t)(n0 + nl) * ldd + k0 + kc * 8) = w;
  }
}

DI void conv_chunk(const float* src, bf16_t* dst, size_t base) {
  const size_t i = base + (size_t)otid() * 8;
  const f32x4 a = *(const f32x4*)(src + i), b = *(const f32x4*)(src + i + 4);
  u32x4 w; w.x = pack2(a.x, a.y); w.y = pack2(a.z, a.w); w.z = pack2(b.x, b.y); w.w = pack2(b.z, b.w);
  *(u32x4*)(dst + i) = w;
}

DI void sincos_d(double x, double& s, double& c) {
  const double y = x * 0.25, y2 = y * y;
  double sn = y * (1.0 + y2 * (-1.0 / 6 + y2 * (1.0 / 120 + y2 * (-1.0 / 5040 + y2 * (1.0 / 362880 + y2 * (-1.0 / 39916800 + y2 * (1.0 / 6227020800.0)))))));
  double cs = 1.0 + y2 * (-0.5 + y2 * (1.0 / 24 + y2 * (-1.0 / 720 + y2 * (1.0 / 40320 + y2 * (-1.0 / 3628800 + y2 * (1.0 / 479001600.0 + y2 * (-1.0 / 87178291200.0)))))));
#pragma unroll
  for (int i = 0; i < 2; ++i) { const double s2 = 2.0 * sn * cs, c2 = cs * cs - sn * sn; sn = s2; cs = c2; }
  s = sn; c = cs;
}

DI void phase_prep(const Params& p, char* smem) {
  const int tid = otid();
  float* fs = (float*)smem;
  char* ws = p.ws;
  constexpr int nA = 192, nB = 16 * 72, nC = 2 * 8 * 16, nD = 256, nE = 16 * 32, nF = 2 * 32 * 2, nG = 4, nH = 8, nI = 512, nJ = 64, nK = 32, nL = 2048, nM = 2048;
  constexpr int total = nA + nB + nC + nD + nE + nF + nG + nH + nI + nJ + nK + nL + nM;
  for (int item = blockIdx.x; item < total; item += gridDim.x) {
    int it = item;
    if (it < nA) {
      float* sc = fs;
      float* red = fs + 8192;
      __syncthreads();
      for (int i = tid; i < 8192; i += NT) { const float v = p.c[i]; sc[i] = v / (1.0f + __expf(-v)); }
      __syncthreads();
      const int ks = tid >> 5, cj = tid & 31, col = it * 32 + cj;
      float acc[8];
#pragma unroll
      for (int b = 0; b < 8; ++b) acc[b] = 0.f;
#pragma unroll 4
      for (int k = ks * 64; k < ks * 64 + 64; ++k) {
        const float w = p.w_ada[(size_t)k * 6144 + col];
#pragma unroll
        for (int b = 0; b < 8; ++b) acc[b] += sc[b * 1024 + k] * w;
      }
#pragma unroll
      for (int b = 0; b < 8; ++b) red[(ks * 8 + b) * 32 + cj] = acc[b];
      __syncthreads();
      if (tid < 256) {
        const int b = tid >> 5;
        float s = p.b_ada[col];
#pragma unroll
        for (int k2 = 0; k2 < 16; ++k2) s += red[(k2 * 8 + b) * 32 + cj];
        ((float*)(ws + OFF_MOD))[b * 6144 + col] = s;
      }
      continue;
    }
    it -= nA;
    if (it < nB) {
      const int kt = it / 72, ntile = it % 72;
      const float* w_in = p.w_in; const float* w_merge = p.w_merge;
      tconv_tile(fs, kt * 64, ntile * 64, (bf16_t*)(ws + OFF_WT1), 1024, [=](int k, int n) -> float {
        if (n < 1280) {
          const bool roped = (n < 640) || (n >= 768 && n < 896) || (n >= 1024 && n < 1152);
          const int col = roped ? ((n & ~63) + dperm(n & 63)) : n;
          return w_in[(size_t)k * 2328 + col];
        }
        if (n < 2304) return w_in[(size_t)k * 2328 + n + 24];
        if (n < 4352) return w_merge[(size_t)k * 2048 + (n - 2304)];
        if (n < 4376) return w_in[(size_t)k * 2328 + 1280 + (n - 4352)];
        return 0.f; });
      continue;
    }
    it -= nB;
    if (it < nC) {
      const int br = it >> 7, r = it & 127, kt = r >> 4, ntile = r & 15;
      const float* src = p.w_branch + (size_t)br * 512 * 1024;
      tconv_tile(fs, kt * 64, ntile * 64, (bf16_t*)(ws + OFF_WB) + (size_t)br * 1024 * 512, 512, [=](int k, int n) -> float { return src[(size_t)k * 1024 + n]; });
      continue;
    }
    it -= nC;
    if (it < nD) {
      const int kt = it >> 4, ntile = it & 15;
      const float* src = p.w_out;
      tconv_tile(fs, kt * 64, ntile * 64, (bf16_t*)(ws + OFF_WOUT), 1024, [=](int k, int n) -> float { return src[(size_t)k * 1024 + n]; });
      continue;
    }
    it -= nD;
    if (it < nE) {
      const int kt = it >> 5, ntile = it & 31;
      const float* src = p.peer_wq;
      tconv_tile(fs, kt * 64, ntile * 64, (bf16_t*)(ws + OFF_WQ), 1024, [=](int k, int n) -> float { return src[(size_t)k * 2048 + n]; });
      continue;
    }
    it -= nE;
    if (it < nF) {
      const int w = it >> 6, r = it & 63, kt = r >> 1, ntile = r & 1;
      const float* src = p.cmp_w1 + (size_t)w * 2048 * 128;
      tconv_tile(fs, kt * 64, ntile * 64, (bf16_t*)(ws + OFF_CW1) + (size_t)w * 128 * 2048, 2048, [=](int k, int n) -> float {
        const int ksrc = (w == 0) ? ((k & ~63) + dperm(k & 63)) : k;
        return src[(size_t)ksrc * 128 + n]; });
      continue;
    }
    it -= nF;
    if (it < nG) {
      const int w = it >> 1, kt = it & 1;
      const float* src = p.cmp_w2 + (size_t)w * 128 * 64;
      tconv_tile(fs, kt * 64, 0, (bf16_t*)(ws + OFF_CW2) + (size_t)w * 64 * 128, 128, [=](int k, int n) -> float { return src[(size_t)k * 64 + ((w == 0) ? dperm(n) : n)]; });
      continue;
    }
    it -= nG;
    if (it < nH) {
      const int w = it >> 2, jc = it & 3, ks = tid >> 5, cj = tid & 31, j = jc * 32 + cj;
      float* red = fs;
      const float* pos = p.cmp_pos + w * 2048; const float* w1 = p.cmp_w1 + (size_t)w * 2048 * 128;
      float acc = 0.f;
#pragma unroll 4
      for (int k = ks * 128; k < ks * 128 + 128; ++k) acc += pos[k] * w1[(size_t)k * 128 + j];
      __syncthreads();
      red[ks * 32 + cj] = acc;
      __syncthreads();
      if (tid < 32) { float s = p.cmp_b1[w * 128 + j]; for (int k2 = 0; k2 < 16; ++k2) s += red[k2 * 32 + tid]; ((float*)(ws + OFF_POSB))[w * 128 + j] = s; }
      continue;
    }
    it -= nH;
    if (it < nI) {
      const int e = it * 512 + tid, pos = e >> 5, i = e & 31;
      const float ang = (float)pos * p.inv_freq[i];
      const double a = (double)ang;
      const double kk = rint(a * 0.15915494309189535);
      const double r = a - kk * 6.283185307179586476925;
      double s, c; sincos_d(r, s, c);
      ((float*)(ws + OFF_ROPE))[e] = (float)c;
      ((float*)(ws + OFF_ROPE))[262144 + e] = (float)s;
      continue;
    }
    it -= nI;
    if (it < nJ) { conv_chunk(p.peer_keys, (bf16_t*)(ws + OFF_PKEYS), (size_t)it * 4096); continue; }
    it -= nJ;
    if (it < nK) {
      const size_t i0 = (size_t)it * 4096 + (size_t)tid * 8;
      const int rowi = (int)((i0 >> 7) & 127), j0 = (int)(i0 & 127);
      float v[8];
#pragma unroll
      for (int j = 0; j < 8; ++j) v[j] = (j0 + j <= rowi) ? p.sgu_w[i0 + j] : 0.f;
      u32x4 w; w.x = pack2(v[0], v[1]); w.y = pack2(v[2], v[3]); w.z = pack2(v[4], v[5]); w.w = pack2(v[6], v[7]);
      *(u32x4*)((bf16_t*)(ws + OFF_SGUW) + i0) = w;
      continue;
    }
    it -= nK;
    {
      const bool isv = it >= nL;
      if (isv) it -= nL;
      const int lane = tid & 63, e = it * 8 + (tid >> 6);
      const float* src = (isv ? p.peer_v : p.peer_u) + (size_t)e * 1024 + lane * 16;
      float v[16];
#pragma unroll
      for (int i = 0; i < 4; ++i) { const f32x4 t4 = *(const f32x4*)(src + i * 4); v[4 * i] = t4.x; v[4 * i + 1] = t4.y; v[4 * i + 2] = t4.z; v[4 * i + 3] = t4.w; }
      float amax = 0.f;
#pragma unroll
      for (int i = 0; i < 16; ++i) amax = fmaxf(amax, fabsf(v[i]));
#pragma unroll
      for (int o = 32; o > 0; o >>= 1) amax = fmaxf(amax, __shfl_xor(amax, o));
      const unsigned be = (__float_as_uint(amax) >> 23) & 0xffu;
      const bool okr = be >= 16u && be <= 240u;
      const float scale = okr ? __uint_as_float((261u - be) << 23) : 1.0f;
      const float inv = okr ? __uint_as_float((be - 7u) << 23) : 1.0f;
      u32x4 w;
      int t0 = 0, t1 = 0, t2 = 0, t3 = 0;
      t0 = __builtin_amdgcn_cvt_pk_fp8_f32(v[0] * scale, v[1] * scale, t0, false); t0 = __builtin_amdgcn_cvt_pk_fp8_f32(v[2] * scale, v[3] * scale, t0, true);
      t1 = __builtin_amdgcn_cvt_pk_fp8_f32(v[4] * scale, v[5] * scale, t1, false); t1 = __builtin_amdgcn_cvt_pk_fp8_f32(v[6] * scale, v[7] * scale, t1, true);
      t2 = __builtin_amdgcn_cvt_pk_fp8_f32(v[8] * scale, v[9] * scale, t2, false); t2 = __builtin_amdgcn_cvt_pk_fp8_f32(v[10] * scale, v[11] * scale, t2, true);
      t3 = __builtin_amdgcn_cvt_pk_fp8_f32(v[12] * scale, v[13] * scale, t3, false); t3 = __builtin_amdgcn_cvt_pk_fp8_f32(v[14] * scale, v[15] * scale, t3, true);
      w.x = (unsigned)t0; w.y = (unsigned)t1; w.z = (unsigned)t2; w.w = (unsigned)t3;
      if (!isv) {
        *(u32x4*)(ws + OFF_PU8 + ((size_t)(lane >> 3) * 16384 + e) * 128 + (lane & 7) * 16) = w;
        if (lane == 0) ((float*)(ws + OFF_SCU))[e] = inv;
      } else {
        *(u32x4*)(ws + OFF_PV8 + ((size_t)(lane >> 3) * 16384 + e) * 128 + (lane & 7) * 16) = w;
        if (lane == 0) ((float*)(ws + OFF_SCV))[e] = inv;
      }
    }
  }
}

DI void row_stats(const float (&v)[16], float& mean, float& rstd) {
  float s = 0.f;
#pragma unroll
  for (int i = 0; i < 16; ++i) s += v[i];
  mean = wave_sum(s) * (1.0f / 1024.0f);
  float q = 0.f;
#pragma unroll
  for (int i = 0; i < 16; ++i) { const float d = v[i] - mean; q += d * d; }
  rstd = rsqrtf(wave_sum(q) * (1.0f / 1024.0f) + LN_EPS);
}

DI void phase_ln_in(const Params& p) {
  const int lane = otid() & 63, wave = otid() >> 6;
  const float* mod = (const float*)(p.ws + OFF_MOD);
  bf16_t* h = (bf16_t*)(p.ws + OFF_H);
  for (int grp = blockIdx.x; grp < NTOK / NW; grp += gridDim.x) {
    const int row = grp * NW + wave, b = row >> 13;
    const float* xr = p.x + (size_t)row * DM;
    float v[16];
#pragma unroll
    for (int i = 0; i < 4; ++i) { const f32x4 t = *(const f32x4*)(xr + i * 256 + lane * 4); v[4 * i] = t.x; v[4 * i + 1] = t.y; v[4 * i + 2] = t.z; v[4 * i + 3] = t.w; }
    float mean, rstd; row_stats(v, mean, rstd);
#pragma unroll
    for (int i = 0; i < 4; ++i) {
      const int col = i * 256 + lane * 4;
      const f32x4 sh = *(const f32x4*)(mod + b * 6144 + col), sc = *(const f32x4*)(mod + b * 6144 + 1024 + col);
      const float o0 = (v[4 * i] - mean) * rstd * (1.f + sc.x) + sh.x, o1 = (v[4 * i + 1] - mean) * rstd * (1.f + sc.y) + sh.y;
      const float o2 = (v[4 * i + 2] - mean) * rstd * (1.f + sc.z) + sh.z, o3 = (v[4 * i + 3] - mean) * rstd * (1.f + sc.w) + sh.w;
      u32x2 w; w.x = pack2(o0, o1); w.y = pack2(o2, o3);
      *(u32x2*)(h + (size_t)row * DM + col) = w;
    }
  }
}

DI void phase_ln_mid(const Params& p) {
  const int lane = otid() & 63, wave = otid() >> 6;
  const float* mod = (const float*)(p.ws + OFF_MOD);
  const bf16_t* y = (const bf16_t*)(p.ws + OFF_Y);
  bf16_t* x1 = (bf16_t*)(p.ws + OFF_X1);
  bf16_t* h2 = (bf16_t*)(p.ws + OFF_H);
  for (int grp = blockIdx.x; grp < NTOK / NW; grp += gridDim.x) {
    const int row = grp * NW + wave, b = row >> 13;
    const bf16_t* yr = y + (size_t)row * DM;
    float v[16];
#pragma unroll
    for (int i = 0; i < 4; ++i) { const u32x2 t = *(const u32x2*)(yr + i * 256 + lane * 4); v[4 * i] = bflo(t.x); v[4 * i + 1] = bfhi(t.x); v[4 * i + 2] = bflo(t.y); v[4 * i + 3] = bfhi(t.y); }
    float mean, rstd; row_stats(v, mean, rstd);
#pragma unroll
    for (int i = 0; i < 4; ++i) {
      const int col = i * 256 + lane * 4;
      const f32x4 g = *(const f32x4*)(p.ln1_g + col), bb = *(const f32x4*)(p.ln1_b + col);
      f32x4 o;
      o.x = (v[4 * i] - mean) * rstd * g.x + bb.x; o.y = (v[4 * i + 1] - mean) * rstd * g.y + bb.y;
      o.z = (v[4 * i + 2] - mean) * rstd * g.z + bb.z; o.w = (v[4 * i + 3] - mean) * rstd * g.w + bb.w;
      { u32x2 w; w.x = pack2(o.x, o.y); w.y = pack2(o.z, o.w); *(u32x2*)(x1 + (size_t)row * DM + col) = w; }
      v[4 * i] = o.x; v[4 * i + 1] = o.y; v[4 * i + 2] = o.z; v[4 * i + 3] = o.w;
    }
    row_stats(v, mean, rstd);
#pragma unroll
    for (int i = 0; i < 4; ++i) {
      const int col = i * 256 + lane * 4;
      const f32x4 sh = *(const f32x4*)(mod + b * 6144 + 3072 + col), sc = *(const f32x4*)(mod + b * 6144 + 4096 + col);
      const float o0 = (v[4 * i] - mean) * rstd * (1.f + sc.x) + sh.x, o1 = (v[4 * i + 1] - mean) * rstd * (1.f + sc.y) + sh.y;
      const float o2 = (v[4 * i + 2] - mean) * rstd * (1.f + sc.z) + sh.z, o3 = (v[4 * i + 3] - mean) * rstd * (1.f + sc.w) + sh.w;
      u32x2 w; w.x = pack2(o0, o1); w.y = pack2(o2, o3);
      *(u32x2*)(h2 + (size_t)row * DM + col) = w;
    }
  }
}

namespace pg8 {
constexpr int BM = 256, BK = 64, HALF = 128, HTB = HALF * BK * 2, STAGE_BYTES = 8 * HTB, NXCD = 8, WGM = 8;
DI int lds_byte(int r, int c) { const int st = (r >> 4) * 2 + (c >> 5), rr = r & 15, cc = c & 31, ob = rr * 64 + cc * 2; return st * 1024 + (ob ^ (((ob >> 9) & 1) << 5)); }
DI void stage_rc(int b, int& R, int& C) { const int st = b / 1024, sb = b % 1024, swz = sb ^ (((sb >> 9) & 1) << 5); R = (st >> 1) * 16 + swz / 64; C = (st & 1) * 32 + (swz % 64) / 2; }
DI int perm32(int rho) { const int n = rho >> 4, i = rho & 15; return 8 * (i >> 2) + 4 * n + (i & 3); }
struct Unit { int pm, pn; };
struct Gemm { const bf16_t* A; const bf16_t* Bt; int M, N, K; };
struct StaticOrder {
  int nM, nN, nwg, G, c;
  DI void init(int M, int N, int G_, int c_) { nM = M / BM; nN = N / BM; nwg = nM * nN; G = G_; c = c_; }
  DI bool next(int i, Unit& u) const {
    const long L = (long)i * G + c; if (L >= nwg) return false;
    int wgid = (int)L; { const int q = nwg / NXCD, r = nwg % NXCD, xcd = wgid % NXCD, off = wgid / NXCD; wgid = (xcd < r ? xcd * (q + 1) : r * (q + 1) + (xcd - r) * q) + off; }
    const int nig = WGM * nN, gid = wgid / nig, fm = gid * WGM, gsz = (nM - fm) < WGM ? (nM - fm) : WGM;
    u.pm = fm + ((wgid % nig) % gsz); u.pn = (wgid % nig) / gsz; return true;
  }
};

template <class Epi>
DI void gemm_phase(LAS unsigned char* lds, const Gemm g, const StaticOrder& S, const Epi& E) {
  const int tid = otid(), wid = __builtin_amdgcn_readfirstlane(tid >> 6), lane = tid & 63, wr = wid >> 2, wc = wid & 3, fr = lane & 15, fq = lane >> 4;
  const int K = g.K, nt = K / BK;
  unsigned voffA[2], voffB[2];
#pragma unroll
  for (int i = 0; i < 2; ++i) { int R, C; stage_rc(tid * 16 + i * 8192, R, C); const int Rb = Epi::PERM ? ((R & ~31) + perm32(R & 31)) : R;
    voffA[i] = (unsigned)(R * K + C) * 2u; voffB[i] = (unsigned)(Rb * K + C) * 2u; }
  const size_t kstep = (size_t)(BK * 2);
  const size_t hstep = (size_t)HALF * K * 2;
  const size_t tstep = 2 * hstep;
  const unsigned ldsw = (unsigned)wid * 1024u;
  const int aoff = lds_byte(wr * 64 + fr, fq * 8), boff = lds_byte(wc * 32 + fr, fq * 8);
#define PG8_SA(b, h) (((b) * 2 + (h)) * HTB)
#define PG8_SB(b, h) ((4 + (b) * 2 + (h)) * HTB)
#define PG8_STAGE(bufoff, gbase, voff) do { _Pragma("unroll") for (int _i = 0; _i < 2; ++_i) \
    __builtin_amdgcn_global_load_lds((const unsigned*)((const char*)(gbase) + (voff)[_i]), (LAS unsigned*)(lds + (bufoff) + ldsw + _i * 8192), 16, 0, 0); } while (0)
#define PG8_LDA(dst, b, h) do { _Pragma("unroll") for (int m = 0; m < 4; ++m) _Pragma("unroll") for (int k = 0; k < 2; ++k) dst[m][k] = *(const LAS bf16x8*)(lds + PG8_SA(b, h) + aoff + m * 2048 + k * 1024); } while (0)
#define PG8_LDB(dst, b, h) do { _Pragma("unroll") for (int n = 0; n < 2; ++n) _Pragma("unroll") for (int k = 0; k < 2; ++k) dst[n][k] = *(const LAS bf16x8*)(lds + PG8_SB(b, h) + boff + n * 2048 + k * 1024); } while (0)
#define PG8_MMA(ai, bj, At, Bt) do { __builtin_amdgcn_s_setprio(1); _Pragma("unroll") for (int m = 0; m < 4; ++m) _Pragma("unroll") for (int n = 0; n < 2; ++n) _Pragma("unroll") for (int k = 0; k < 2; ++k) \
    acc[ai][bj][m][n] = __builtin_amdgcn_mfma_f32_16x16x32_bf16(Bt[n][k], At[m][k], acc[ai][bj][m][n], 0, 0, 0); __builtin_amdgcn_s_setprio(0); } while (0)
#define PG8_WAIT_V(n) asm volatile("s_waitcnt vmcnt(" #n ")" ::: "memory")
#define PG8_WAIT_L(n) asm volatile("s_waitcnt lgkmcnt(" #n ")" ::: "memory")
#define PG8_BAR __builtin_amdgcn_s_barrier()
#define PG8_SCHED __builtin_amdgcn_sched_barrier(0)
  Unit cur, nxt; int ui = 0;
  if (!S.next(0, cur)) return;
  f32x4 acc[2][2][4][2];
#pragma unroll
  for (int a = 0; a < 2; ++a)
#pragma unroll
    for (int b = 0; b < 2; ++b)
#pragma unroll
      for (int m = 0; m < 4; ++m)
#pragma unroll
        for (int n = 0; n < 2; ++n) acc[a][b][m][n] = (f32x4){0.f, 0.f, 0.f, 0.f};
  bf16x8 At[4][2], B0[2][2], B1[2][2];
  const char* cA = (const char*)g.A + (size_t)cur.pm * tstep; const char* cB = (const char*)g.Bt + (size_t)cur.pn * tstep;
  PG8_STAGE(PG8_SB(0, 0), cB, voffB); PG8_STAGE(PG8_SA(0, 0), cA, voffA); PG8_STAGE(PG8_SB(0, 1), cB + hstep, voffB); PG8_STAGE(PG8_SA(0, 1), cA + hstep, voffA);
  if (wr == 1) PG8_BAR;
  PG8_WAIT_V(4); PG8_BAR;
  PG8_STAGE(PG8_SB(1, 0), cB + kstep, voffB); PG8_STAGE(PG8_SA(1, 0), cA + kstep, voffA); PG8_STAGE(PG8_SB(1, 1), cB + hstep + kstep, voffB);
  PG8_WAIT_V(6); PG8_BAR;
  for (;;) {
    const bool has_next = S.next(ui + 1, nxt);
    const char* nA = has_next ? (const char*)g.A + (size_t)nxt.pm * tstep : cA; const char* nB = has_next ? (const char*)g.Bt + (size_t)nxt.pn * tstep : cB;
    for (int t = 0; t < nt; t += 2) {
      const bool last = (t == nt - 2);
      const char* a1 = cA + (size_t)(t + 1) * kstep;
      const char* a2 = last ? nA : cA + (size_t)(t + 2) * kstep; const char* b2 = last ? nB : cB + (size_t)(t + 2) * kstep;
      const char* a3 = a2 + kstep; const char* b3 = b2 + kstep;
      PG8_LDB(B0, 0, 0); PG8_SCHED; PG8_LDA(At, 0, 0); PG8_STAGE(PG8_SA(1, 1), a1 + hstep, voffA);
      PG8_WAIT_L(8); PG8_BAR; PG8_WAIT_L(0); PG8_MMA(0, 0, At, B0); PG8_BAR; PG8_SCHED;
      PG8_LDB(B1, 0, 1); PG8_STAGE(PG8_SB(0, 0), b2, voffB);
      PG8_BAR; PG8_WAIT_L(0); PG8_MMA(0, 1, At, B1); PG8_BAR;
      PG8_LDA(At, 0, 1); PG8_STAGE(PG8_SA(0, 0), a2, voffA);
      PG8_BAR; PG8_WAIT_L(0); PG8_MMA(1, 0, At, B0); PG8_BAR; PG8_SCHED;
      PG8_STAGE(PG8_SB(0, 1), b2 + hstep, voffB);
      PG8_WAIT_V(6); PG8_BAR; PG8_MMA(1, 1, At, B1); PG8_BAR;
      PG8_LDB(B0, 1, 0); PG8_SCHED; PG8_LDA(At, 1, 0); PG8_STAGE(PG8_SA(0, 1), a2 + hstep, voffA);
      PG8_WAIT_L(8); PG8_BAR; PG8_WAIT_L(0); PG8_MMA(0, 0, At, B0); PG8_BAR; PG8_SCHED;
      PG8_LDB(B1, 1, 1); PG8_STAGE(PG8_SB(1, 0), b3, voffB);
      PG8_BAR; PG8_WAIT_L(0); PG8_MMA(0, 1, At, B1); PG8_BAR;
      PG8_LDA(At, 1, 1); PG8_STAGE(PG8_SA(1, 0), a3, voffA);
      PG8_BAR; PG8_WAIT_L(0); PG8_MMA(1, 0, At, B0); PG8_BAR; PG8_SCHED;
      PG8_STAGE(PG8_SB(1, 1), b3 + hstep, voffB);
      PG8_WAIT_V(6); PG8_BAR; PG8_MMA(1, 1, At, B1); PG8_BAR;
    }
    E(acc, cur, wr, wc, fr, fq);
    if (!has_next) break;
#pragma unroll
    for (int a = 0; a < 2; ++a)
#pragma unroll
      for (int b = 0; b < 2; ++b)
#pragma unroll
        for (int m = 0; m < 4; ++m)
#pragma unroll
          for (int n = 0; n < 2; ++n) acc[a][b][m][n] = (f32x4){0.f, 0.f, 0.f, 0.f};
    cur = nxt; cA = nA; cB = nB; ++ui;
  }
  PG8_WAIT_V(0);
  if (wr == 0) PG8_BAR;
  PG8_BAR;
#undef PG8_SA
#undef PG8_SB
#undef PG8_STAGE
#undef PG8_LDA
#undef PG8_LDB
#undef PG8_MMA
#undef PG8_WAIT_V
#undef PG8_WAIT_L
#undef PG8_BAR
#undef PG8_SCHED
}
}

struct EpiProj {
  static constexpr bool PERM = true;
  char* ws; const float* b_merge;
  DI void operator()(const f32x4 (&acc)[2][2][4][2], const pg8::Unit& u, int wr, int wc, int fr, int fq) const {
    const float* rope = (const float*)(ws + OFF_ROPE);
    const int row0 = u.pm * 256 + wr * 64 + fr;
#pragma unroll
    for (int bj = 0; bj < 2; ++bj) {
      const int cg = u.pn * 256 + bj * 128 + wc * 32;
      const int c0 = cg + 8 * fq;
      if (cg >= 4384) continue;
      if (cg < 1280 && (cg < 640 || (cg >= 768 && cg < 896) || (cg >= 1024 && cg < 1152))) {
        bf16_t* dst; unsigned ld, cofs; float scale = 1.0f;
        if (cg < 512) { dst = (bf16_t*)(ws + OFF_Q); ld = 512; cofs = c0; scale = 0.18033688011112042f; }
        else if (cg < 640) { dst = (bf16_t*)(ws + OFF_KC); ld = 128; cofs = c0 - 512; }
        else if (cg < 896) { dst = (bf16_t*)(ws + OFF_KS); ld = 128; cofs = c0 - 768; }
        else { dst = (bf16_t*)(ws + OFF_KW); ld = 128; cofs = c0 - 1024; }
        const int d0 = 16 * ((cg >> 5) & 1) + 4 * fq;
#pragma unroll
        for (int ai = 0; ai < 2; ++ai)
#pragma unroll
          for (int m = 0; m < 4; ++m) {
            const int row = row0 + ai * 128 + m * 16, pos = row & (SEQ - 1);
            const f32x4 cs = *(const f32x4*)(rope + pos * 32 + d0), sn = *(const f32x4*)(rope + 262144 + pos * 32 + d0);
            const f32x4 t1 = acc[ai][bj][m][0], t2 = acc[ai][bj][m][1];
            const f32x4 o1 = (t1 * cs - t2 * sn) * scale, o2 = (t1 * sn + t2 * cs) * scale;
            u32x4 w; w.x = pack2(o1.x, o1.y); w.y = pack2(o1.z, o1.w); w.z = pack2(o2.x, o2.y); w.w = pack2(o2.z, o2.w);
            *(u32x4*)(dst + (unsigned)row * ld + cofs) = w;
          }
      } else if (cg < 1280) {
        bf16_t* dst; unsigned cofs;
        if (cg < 768) { dst = (bf16_t*)(ws + OFF_VC); cofs = c0 - 640; }
        else if (cg < 1024) { dst = (bf16_t*)(ws + OFF_VS); cofs = c0 - 896; }
        else { dst = (bf16_t*)(ws + OFF_VW); cofs = c0 - 1152; }
#pragma unroll
        for (int ai = 0; ai < 2; ++ai)
#pragma unroll
          for (int m = 0; m < 4; ++m) {
            const int row = row0 + ai * 128 + m * 16;
            const f32x4 a = acc[ai][bj][m][0], b = acc[ai][bj][m][1];
            u32x4 w; w.x = pack2(a.x, a.y); w.y = pack2(a.z, a.w); w.z = pack2(b.x, b.y); w.w = pack2(b.z, b.w);
            *(u32x4*)(dst + (unsigned)row * 128u + cofs) = w;
          }
      } else if (cg < 2304) {
        bf16_t* dst = (bf16_t*)(ws + (cg < 1792 ? OFF_U : OFF_V));
        const unsigned cofs = c0 - (cg < 1792 ? 1280 : 1792);
#pragma unroll
        for (int ai = 0; ai < 2; ++ai)
#pragma unroll
          for (int m = 0; m < 4; ++m) {
            const int row = row0 + ai * 128 + m * 16;
            const f32x4 a = acc[ai][bj][m][0], b = acc[ai][bj][m][1];
            const f32x2 g0 = gelu_pk((f32x2){a.x, a.y}), g1 = gelu_pk((f32x2){a.z, a.w}), g2 = gelu_pk((f32x2){b.x, b.y}), g3 = gelu_pk((f32x2){b.z, b.w});
            u32x4 w; w.x = pack2(g0.x, g0.y); w.y = pack2(g1.x, g1.y); w.z = pack2(g2.x, g2.y); w.w = pack2(g3.x, g3.y);
            *(u32x4*)(dst + (unsigned)row * 512u + cofs) = w;
          }
      } else if (cg < 4352) {
        bf16_t* dst = (bf16_t*)(ws + OFF_GATE);
        const unsigned cofs = c0 - 2304;
        const f32x4 b0 = *(const f32x4*)(b_merge + cofs), b1 = *(const f32x4*)(b_merge + cofs + 4);
#pragma unroll
        for (int ai = 0; ai < 2; ++ai)
#pragma unroll
          for (int m = 0; m < 4; ++m) {
            const int row = row0 + ai * 128 + m * 16;
            const f32x4 a = acc[ai][bj][m][0] + b0, b = acc[ai][bj][m][1] + b1;
            u32x4 w; w.x = pack2(sigmoid_f(a.x), sigmoid_f(a.y)); w.y = pack2(sigmoid_f(a.z), sigmoid_f(a.w));
            w.z = pack2(sigmoid_f(b.x), sigmoid_f(b.y)); w.w = pack2(sigmoid_f(b.z), sigmoid_f(b.w));
            *(u32x4*)(dst + (unsigned)row * 2048u + cofs) = w;
          }
      } else {
        float* gs = (float*)(ws + OFF_GSIG);
        if (fq < 3) {
#pragma unroll
          for (int ai = 0; ai < 2; ++ai)
#pragma unroll
            for (int m = 0; m < 4; ++m) {
              const int row = row0 + ai * 128 + m * 16;
              const f32x4 a = acc[ai][bj][m][0], b = acc[ai][bj][m][1];
              f32x4 o0, o1; o0.x = sigmoid_f(a.x); o0.y = sigmoid_f(a.y); o0.z = sigmoid_f(a.z); o0.w = sigmoid_f(a.w);
              o1.x = sigmoid_f(b.x); o1.y = sigmoid_f(b.y); o1.z = sigmoid_f(b.z); o1.w = sigmoid_f(b.w);
              *(f32x4*)(gs + (unsigned)row * 32u + 8 * fq) = o0; *(f32x4*)(gs + (unsigned)row * 32u + 8 * fq + 4) = o1;
            }
        }
      }
    }
  }
};
DI void phase_gemm1(const Params& p, char* smem) {
  pg8::Gemm g{(const bf16_t*)(p.ws + OFF_H), (const bf16_t*)(p.ws + OFF_WT1), NTOK, N1, 1024};
  pg8::StaticOrder S; S.init(NTOK, N1, gridDim.x, blockIdx.x);
  EpiProj E{p.ws, p.b_merge};
  pg8::gemm_phase((LAS unsigned char*)smem, g, S, E);
}

template <int BR> struct EpiMerge {
  static constexpr bool PERM = true;
  char* ws;
  DI void operator()(const f32x4 (&acc)[2][2][4][2], const pg8::Unit& u, int wr, int wc, int fr, int fq) const {
    const bf16_t* gate = (const bf16_t*)(ws + OFF_GATE);
    bf16_t* merged = (bf16_t*)(ws + OFF_H);
    const int row0 = u.pm * 256 + wr * 64 + fr;
#pragma unroll
    for (int bj = 0; bj < 2; ++bj) {
      const unsigned c0 = u.pn * 256 + bj * 128 + wc * 32 + 8 * fq;
#pragma unroll
      for (int ai = 0; ai < 2; ++ai)
#pragma unroll
        for (int m = 0; m < 4; ++m) {
          const unsigned row = row0 + ai * 128 + m * 16;
          float gg[8]; unpack8(*(const u32x4*)(gate + row * 2048u + BR * 1024 + c0), gg);
          const f32x4 a = acc[ai][bj][m][0], b = acc[ai][bj][m][1];
          float v[8] = {a.x * gg[0], a.y * gg[1], a.z * gg[2], a.w * gg[3], b.x * gg[4], b.y * gg[5], b.z * gg[6], b.w * gg[7]};
          bf16_t* mp = merged + row * 1024u + c0;
          if (BR == 1) {
            float old[8]; unpack8(*(const u32x4*)mp, old);
#pragma unroll
            for (int j = 0; j < 8; ++j) v[j] += old[j];
          }
          *(u32x4*)mp = pack8(v);
        }
    }
  }
};
DI void phase_merge(const Params& p, char* smem) {
  pg8::StaticOrder S; S.init(NTOK, 1024, gridDim.x, blockIdx.x);
  {
    pg8::Gemm g{(const bf16_t*)(p.ws + OFF_ONSA), (const bf16_t*)(p.ws + OFF_WB), NTOK, 1024, 512};
    EpiMerge<0> E{p.ws};
    pg8::gemm_phase((LAS unsigned char*)smem, g, S, E);
  }
  {
    pg8::Gemm g{(const bf16_t*)(p.ws + OFF_U), (const bf16_t*)(p.ws + OFF_WB) + (size_t)1024 * 512, NTOK, 1024, 512};
    EpiMerge<1> E{p.ws};
    pg8::gemm_phase((LAS unsigned char*)smem, g, S, E);
  }
}

struct EpiOut {
  static constexpr bool PERM = true;
  char* ws; const float* x;
  DI void operator()(const f32x4 (&acc)[2][2][4][2], const pg8::Unit& u, int wr, int wc, int fr, int fq) const {
    const float* mod = (const float*)(ws + OFF_MOD);
    bf16_t* y = (bf16_t*)(ws + OFF_Y);
    const int row0 = u.pm * 256 + wr * 64 + fr, b = (u.pm * 256) >> 13;
#pragma unroll
    for (int bj = 0; bj < 2; ++bj) {
      const unsigned c0 = u.pn * 256 + bj * 128 + wc * 32 + 8 * fq;
      const f32x4 g0 = *(const f32x4*)(mod + b * 6144 + 2048 + c0), g1 = *(const f32x4*)(mod + b * 6144 + 2048 + c0 + 4);
#pragma unroll
      for (int ai = 0; ai < 2; ++ai)
#pragma unroll
        for (int m = 0; m < 4; ++m) {
          const unsigned o = (unsigned)(row0 + ai * 128 + m * 16) * 1024u + c0;
          const f32x4 x0 = *(const f32x4*)(x + o), x1v = *(const f32x4*)(x + o + 4);
          const f32x4 v0 = x0 * DN_ALPHA + g0 * acc[ai][bj][m][0], v1 = x1v * DN_ALPHA + g1 * acc[ai][bj][m][1];
          u32x4 w; w.x = pack2(v0.x, v0.y); w.y = pack2(v0.z, v0.w); w.z = pack2(v1.x, v1.y); w.w = pack2(v1.z, v1.w);
          *(u32x4*)(y + o) = w;
        }
    }
  }
};
DI void phase_outproj(const Params& p, char* smem) {
  pg8::Gemm g{(const bf16_t*)(p.ws + OFF_H), (const bf16_t*)(p.ws + OFF_WOUT), NTOK, 1024, 1024};
  pg8::StaticOrder S; S.init(NTOK, 1024, gridDim.x, blockIdx.x);
  EpiOut E{p.ws, p.x};
  pg8::gemm_phase((LAS unsigned char*)smem, g, S, E);
}

struct EpiPq {
  static constexpr bool PERM = true;
  char* ws;
  DI void operator()(const f32x4 (&acc)[2][2][4][2], const pg8::Unit& u, int wr, int wc, int fr, int fq) const {
    bf16_t* pq = (bf16_t*)(ws + OFF_PQ);
    const int row0 = u.pm * 256 + wr * 64 + fr;
#pragma unroll
    for (int bj = 0; bj < 2; ++bj) {
      const unsigned c0 = u.pn * 256 + bj * 128 + wc * 32 + 8 * fq;
#pragma unroll
      for (int ai = 0; ai < 2; ++ai)
#pragma unroll
        for (int m = 0; m < 4; ++m) {
          const f32x4 a = acc[ai][bj][m][0], b = acc[ai][bj][m][1];
          u32x4 w; w.x = pack2(a.x, a.y); w.y = pack2(a.z, a.w); w.z = pack2(b.x, b.y); w.w = pack2(b.z, b.w);
          *(u32x4*)(pq + (unsigned)(row0 + ai * 128 + m * 16) * 2048u + c0) = w;
        }
    }
  }
};
DI void phase_peerq(const Params& p, char* smem) {
  pg8::Gemm g{(const bf16_t*)(p.ws + OFF_H), (const bf16_t*)(p.ws + OFF_WQ), NTOK, 2048, 1024};
  pg8::StaticOrder S; S.init(NTOK, 2048, gridDim.x, blockIdx.x);
  EpiPq E{p.ws};
  pg8::gemm_phase((LAS unsigned char*)smem, g, S, E);
}

DI void phase_sgu(const Params& p, char* smem) {
  char* ws = p.ws;
  const int tid = otid(), lane = tid & 63, wave = tid >> 6;
  bf16_t* u = (bf16_t*)(ws + OFF_U);
  const bf16_t* v = (const bf16_t*)(ws + OFF_V);
  const bf16_t* W = (const bf16_t*)(ws + OFF_SGUW);
  float* st = (float*)smem;
  bf16_t* vt = (bf16_t*)(smem + 1024);
  constexpr int LV = 136;
  for (int item = blockIdx.x; item < NTOK / 128; item += gridDim.x) {
    const int t0 = item * 128;
    __syncthreads();
    for (int i = 0; i < 16; ++i) {
      const int t = wave * 16 + i;
      const u32x4 raw = *(const u32x4*)(v + (size_t)(t0 + t) * 512 + lane * 8);
      float f[8]; unpack8(raw, f);
      float s = 0.f;
#pragma unroll
      for (int j = 0; j < 8; ++j) s += f[j];
      const float mean = wave_sum(s) * (1.f / 512.f);
      float q = 0.f;
#pragma unroll
      for (int j = 0; j < 8; ++j) { const float d = f[j] - mean; q += d * d; }
      const float rstd = rsqrtf(wave_sum(q) * (1.f / 512.f) + LN_EPS);
      if (lane == 0) { st[t * 2] = mean; st[t * 2 + 1] = rstd; }
    }
    for (int g = 0; g < 8; ++g) {
      __syncthreads();
      for (int i = 0; i < 2; ++i) {
        const int idx = tid + i * NT, j = idx >> 3, dc = (idx & 7) * 8;
        const u32x4 raw = *(const u32x4*)(v + (size_t)(t0 + j) * 512 + g * 64 + dc);
        const float mean = st[j * 2], rstd = st[j * 2 + 1];
        float f[8]; unpack8(raw, f);
#pragma unroll
        for (int k = 0; k < 8; ++k) {
          const int col = g * 64 + dc + k;
          vt[(dc + k) * LV + j] = f2bf((f[k] - mean) * rstd * p.sgu_ln_g[col] + p.sgu_ln_b[col]);
        }
      }
      __syncthreads();
      const int rt = wave >> 1, ni = wave & 1;
      f32x16 acc;
#pragma unroll
      for (int r = 0; r < 16; ++r) acc[r] = 0.f;
      const bf16_t* wrow = W + ((size_t)g * 128 + rt * 32 + (lane & 31)) * 128 + (lane >> 5) * 8;
#pragma unroll
      for (int ks = 0; ks < 8; ++ks) {
        const bf16x8 a = *(const bf16x8*)(wrow + ks * 16);
        const bf16x8 b0 = *(const bf16x8*)(vt + (ni * 32 + (lane & 31)) * LV + ks * 16 + (lane >> 5) * 8);
        acc = MFMA32(a, b0, acc);
      }
      const int d = lane & 31, hh = lane >> 5;
#pragma unroll
      for (int r = 0; r < 16; ++r) {
        const int i = rt * 32 + (r & 3) + 8 * (r >> 2) + 4 * hh;
        const float m = acc[r] + p.sgu_b[g * 128 + i];
        bf16_t* up = u + (size_t)(t0 + i) * 512 + g * 64 + ni * 32 + d;
        *up = f2bf(bf2f(*up) * m);
      }
    }
  }
}

DI void phase_compress(const Params& p, char* smem) {
  char* ws = p.ws;
  const int tid = otid(), lane = tid & 63, wave = tid >> 6, l31 = lane & 31, hh = lane >> 5;
  bf16_t* hid = (bf16_t*)smem;
  constexpr int LH = 136;
  for (int item = blockIdx.x; item < 128; item += gridDim.x) {
    const int w = item >> 6, R0 = (item & 63) * 128;
    const bf16_t* src = (const bf16_t*)(ws + (w == 0 ? OFF_KC : OFF_VC));
    const bf16_t* W1 = (const bf16_t*)(ws + OFF_CW1) + (size_t)w * 128 * 2048;
    const bf16_t* W2 = (const bf16_t*)(ws + OFF_CW2) + (size_t)w * 64 * 128;
    const float* posb = (const float*)(ws + OFF_POSB) + w * 128;
    const int rg = wave >> 2, cgp = wave & 3;
    const bf16_t* abase[2];
#pragma unroll
    for (int mi = 0; mi < 2; ++mi) {
      const int R = R0 + rg * 64 + mi * 32 + l31, bg = R >> 9, n = R & 511, nn = n < 510 ? n : 510;
      abase[mi] = src + ((size_t)((bg >> 1) * SEQ + 16 * nn)) * 128 + (bg & 1) * 64 + hh * 8;
    }
    const bf16_t* bbase = W1 + (size_t)(cgp * 32 + l31) * 2048 + hh * 8;
    f32x16 acc[2];
#pragma unroll
    for (int r = 0; r < 16; ++r) { acc[0][r] = 0.f; acc[1][r] = 0.f; }
#pragma unroll 8
    for (int ks = 0; ks < 128; ++ks) {
      const int aofs = (ks >> 2) * 128 + (ks & 3) * 16;
      const bf16x8 a0 = *(const bf16x8*)(abase[0] + aofs), a1 = *(const bf16x8*)(abase[1] + aofs);
      const bf16x8 bb = *(const bf16x8*)(bbase + ks * 16);
      acc[0] = MFMA32(a0, bb, acc[0]); acc[1] = MFMA32(a1, bb, acc[1]);
    }
    __syncthreads();
    {
      const float pb = posb[cgp * 32 + l31];
#pragma unroll
      for (int mi = 0; mi < 2; ++mi)
#pragma unroll
        for (int r = 0; r < 16; ++r) {
          const int row = rg * 64 + mi * 32 + (r & 3) + 8 * (r >> 2) + 4 * hh;
          hid[row * LH + cgp * 32 + l31] = f2bf(gelu_f(acc[mi][r] + pb));
        }
    }
    __syncthreads();
    const int mi2 = wave >> 1, ni = wave & 1;
    f32x16 o;
#pragma unroll
    for (int r = 0; r < 16; ++r) o[r] = 0.f;
#pragma unroll
    for (int ks = 0; ks < 8; ++ks) {
      const bf16x8 a = *(const bf16x8*)(hid + (mi2 * 32 + l31) * LH + ks * 16 + hh * 8);
      const bf16x8 bb = *(const bf16x8*)(W2 + (size_t)(ni * 32 + l31) * 128 + ks * 16 + hh * 8);
      o = MFMA32(a, bb, o);
    }
    const int d = ni * 32 + l31;
    const float b2 = p.cmp_b2[w * 64 + (w == 0 ? dperm(d) : d)];
    const int bg = R0 >> 9;
    bf16_t* dst = (bf16_t*)(ws + (w == 0 ? OFF_KCMP : OFF_VCMP));
#pragma unroll
    for (int r = 0; r < 16; ++r) {
      const int n = (R0 & 511) + mi2 * 32 + (r & 3) + 8 * (r >> 2) + 4 * hh;
      dst[((size_t)bg * 512 + n) * 64 + d] = f2bf(n < 511 ? o[r] + b2 : 0.f);
    }
  }
}

constexpr int LK = 72;
constexpr int NSA_TILE = 18432;
constexpr int NSA_AIMP = 3 * NSA_TILE, NSA_CIMP = NSA_AIMP + 32768, NSA_SELM = NSA_CIMP + 32768;
constexpr float NSA_THR = 6.0f;
struct TileRegs { u32x4 k; u32x4 v; };

DI void nsa_load_tile(TileRegs& t, const bf16_t* kbase, size_t kstride, const bf16_t* vbase, size_t vstride) {
  const int tid = otid(), r = tid >> 3, ch = tid & 7;
  t.k = *(const u32x4*)(kbase + (size_t)r * kstride + ch * 8);
  t.v = *(const u32x4*)(vbase + (size_t)r * vstride + ch * 8);
}
DI void nsa_store_tile(const TileRegs& t, char* tile) {
  const int tid = otid(), r = tid >> 3, ch = tid & 7;
  *(u32x4*)((bf16_t*)tile + r * LK + ch * 8) = t.k;
  *(u32x4*)((bf16_t*)(tile + 9216) + r * LK + ch * 8) = t.v;
}
DI void nsa_scores(f32x16 (&st)[2], const char* tile, const bf16x8 (&qf)[4], int lane) {
  const bf16_t* Ks = (const bf16_t*)tile;
#pragma unroll
  for (int kt = 0; kt < 2; ++kt)
#pragma unroll
    for (int r = 0; r < 16; ++r) st[kt][r] = 0.f;
  __builtin_amdgcn_s_setprio(1);
#pragma unroll
  for (int ks = 0; ks < 4; ++ks)
#pragma unroll
    for (int kt = 0; kt < 2; ++kt) {
      const bf16x8 a = *(const bf16x8*)(Ks + (kt * 32 + (lane & 31)) * LK + ks * 16 + (lane >> 5) * 8);
      st[kt] = MFMA32(a, qf[ks], st[kt]);
    }
  __builtin_amdgcn_s_setprio(0);
}
DI void nsa_pv(f32x16 (&o)[2], const f32x16 (&pt)[2], const char* tile, int lane) {
  const int gi = lane >> 4, i16 = lane & 15, q = i16 >> 2, pp = i16 & 3;
  const LAS bf16_t* Vs = (const LAS bf16_t*)(tile + 9216) + (4 * (gi >> 1) + q) * LK + 16 * (gi & 1) + 4 * pp;
#pragma unroll
  for (int kt = 0; kt < 2; ++kt)
#pragma unroll
    for (int s = 0; s < 2; ++s) {
      u32x4 pk; pk.x = pack2(pt[kt][8 * s], pt[kt][8 * s + 1]); pk.y = pack2(pt[kt][8 * s + 2], pt[kt][8 * s + 3]);
      pk.z = pack2(pt[kt][8 * s + 4], pt[kt][8 * s + 5]); pk.w = pack2(pt[kt][8 * s + 6], pt[kt][8 * s + 7]);
      const bf16x8 pb = __builtin_bit_cast(bf16x8, pk);
      bf16x8 a[2];
#pragma unroll
      for (int dt = 0; dt < 2; ++dt) {
        const LAS bf16_t* vp = Vs + (kt * 32 + 16 * s) * LK + dt * 32;
        const s16x4 lo = __builtin_amdgcn_ds_read_tr16_b64_v4i16((LAS s16x4*)vp);
        const s16x4 hi = __builtin_amdgcn_ds_read_tr16_b64_v4i16((LAS s16x4*)(vp + 8 * LK));
        a[dt] = __builtin_shufflevector(lo, hi, 0, 1, 2, 3, 4, 5, 6, 7);
      }
      o[0] = MFMA32(a[0], pb, o[0]); o[1] = MFMA32(a[1], pb, o[1]);
    }
}

constexpr float NSA_NEG = -3.0e38f;
DI void nsa_online(f32x16 (&st)[2], bool sel, float& m, float& l, f32x16 (&o)[2], const char* tile, int lane) {
  float mx = NSA_NEG;
#pragma unroll
  for (int r = 0; r < 16; ++r) mx = fmaxf(mx, fmaxf(st[0][r], st[1][r]));
  mx = fmaxf(mx, __shfl_xor(mx, 32));
  mx = sel ? mx : NSA_NEG;
  if (__any(mx > m + NSA_THR)) {
    const float mn = fmaxf(m, mx);
    const float alpha = __builtin_amdgcn_exp2f(m - mn);
    m = mn; l *= alpha;
#pragma unroll
    for (int r = 0; r < 16; ++r) { o[0][r] *= alpha; o[1][r] *= alpha; }
  }
  const float ms = sel ? m : 1e30f;
  float sum = 0.f;
#pragma unroll
  for (int r = 0; r < 16; ++r) {
    const float p0 = __builtin_amdgcn_exp2f(st[0][r] - ms), p1 = __builtin_amdgcn_exp2f(st[1][r] - ms);
    st[0][r] = p0; st[1][r] = p1; sum += p0 + p1;
  }
  l += sum;
  nsa_pv(o, st, tile, lane);
}

struct NsaItem { int qb, b, g, bg, t; size_t tokrow; };
DI NsaItem nsa_item(int item0, int wave, int qi) {
  const int G = gridDim.x, k = item0 / G, bb = item0 - k * G;
  const int item = (k & 1) ? (k * G + (G - 1 - bb)) : item0;
  NsaItem it; it.qb = 127 - (item >> 4); const int rest = item & 15; it.b = rest >> 1; it.g = rest & 1;
  it.bg = it.b * 2 + it.g; it.t = it.qb * 64 + wave * 8 + qi; it.tokrow = (size_t)it.b * SEQ + it.t; return it;
}
DI void nsa_accum_store(bf16_t* dst, const f32x16 (&o)[2], float sc, bool first, int hh) {
#pragma unroll
  for (int dt = 0; dt < 2; ++dt)
#pragma unroll
    for (int q4 = 0; q4 < 4; ++q4) {
      u32x2* pp = (u32x2*)(dst + dt * 32 + 8 * q4 + 4 * hh);
      float a0 = sc * o[dt][4 * q4], a1 = sc * o[dt][4 * q4 + 1], a2 = sc * o[dt][4 * q4 + 2], a3 = sc * o[dt][4 * q4 + 3];
      if (!first) { const u32x2 old = *pp; a0 += bflo(old.x); a1 += bfhi(old.x); a2 += bflo(old.y); a3 += bfhi(old.y); }
      u32x2 wv; wv.x = pack2(a0, a1); wv.y = pack2(a2, a3);
      *pp = wv;
    }
}

constexpr int NSA_STAGE = 4 * 18432;
typedef float f32x4v __attribute__((ext_vector_type(4)));
#define MFMA16(a, b, c) __builtin_amdgcn_mfma_f32_16x16x32_bf16((a), (b), (c), 0, 0, 0)
struct StageRegs { u32x4 r[8]; };
DI void nsa_load_stage(StageRegs& sr, const bf16_t* kb, const bf16_t* vb, int j0s, int qb) {
  const int tid = otid(), r = tid >> 3, ch = tid & 7;
#pragma unroll
  for (int tt = 0; tt < 4; ++tt) {
    const int j = (j0s + tt <= qb) ? j0s + tt : qb;
    sr.r[2 * tt] = *(const u32x4*)(kb + ((size_t)j * 64 + r) * 128 + ch * 8);
    sr.r[2 * tt + 1] = *(const u32x4*)(vb + ((size_t)j * 64 + r) * 128 + ch * 8);
  }
}
DI void nsa_store_stage(const StageRegs& sr, char* stage) {
  const int tid = otid(), r = tid >> 3, ch = tid & 7;
#pragma unroll
  for (int tt = 0; tt < 4; ++tt) {
    *(u32x4*)((bf16_t*)(stage + tt * 18432) + r * LK + ch * 8) = sr.r[2 * tt];
    *(u32x4*)((bf16_t*)(stage + tt * 18432 + 9216) + r * LK + ch * 8) = sr.r[2 * tt + 1];
  }
}
struct Sel16 { float m, l; bool has; f32x4v o[4]; };
DI void nsa_unit16(Sel16& g, const char* tile, const bf16x8 (&qf)[2], bool sel, int klim  , int lane) {
  const int c16 = lane & 15, kg = lane >> 4, tq = c16 >> 2, tp = c16 & 3;
  const bf16_t* Ks = (const bf16_t*)tile + c16 * LK + kg * 8;
  f32x4v st[4];
  const float ini = sel ? -g.m : -1e30f;
#pragma unroll
  for (int kt = 0; kt < 4; ++kt) {
    st[kt] = (f32x4v){ini, ini, ini, ini};
#pragma unroll
    for (int ks = 0; ks < 2; ++ks) st[kt] = MFMA16(*(const bf16x8*)(Ks + kt * 16 * LK + ks * 32), qf[ks], st[kt]);
  }
  if (klim < 64) {
#pragma unroll
    for (int kt = 0; kt < 4; ++kt)
#pragma unroll
      for (int r = 0; r < 4; ++r) st[kt][r] = (kt * 16 + 4 * kg + r <= klim) ? st[kt][r] : NSA_NEG;
  }
  float mx = fmaxf(fmaxf(fmaxf(st[0][0], st[0][1]), fmaxf(st[0][2], st[0][3])), fmaxf(fmaxf(st[1][0], st[1][1]), fmaxf(st[1][2], st[1][3])));
  mx = fmaxf(mx, fmaxf(fmaxf(fmaxf(st[2][0], st[2][1]), fmaxf(st[2][2], st[2][3])), fmaxf(fmaxf(st[3][0], st[3][1]), fmaxf(st[3][2], st[3][3]))));
  mx = fmaxf(mx, __shfl_xor(mx, 16));
  mx = fmaxf(mx, __shfl_xor(mx, 32));
  const bool real = mx > -1e29f;
  const bool fresh = !g.has && real, up = g.has && (mx > NSA_THR);
  if (__any(fresh || up)) {
    const float delta = (fresh || up) ? mx : 0.f;
    const float alpha = up ? __builtin_amdgcn_exp2f(-delta) : 1.0f;
    g.m += delta; g.l *= alpha;
#pragma unroll
    for (int dt = 0; dt < 4; ++dt) g.o[dt] *= alpha;
#pragma unroll
    for (int kt = 0; kt < 4; ++kt) st[kt] -= delta;
  }
  g.has = g.has || real;
  float sum = 0.f;
#pragma unroll
  for (int kt = 0; kt < 4; ++kt)
#pragma unroll
    for (int r = 0; r < 4; ++r) { const float pv = __builtin_amdgcn_exp2f(st[kt][r]); st[kt][r] = pv; sum += pv; }
  g.l += sum;
  const LAS bf16_t* Vs = (const LAS bf16_t*)(tile + 9216) + (4 * kg + tq) * LK + 4 * tp;
#pragma unroll
  for (int kp = 0; kp < 2; ++kp) {
    u32x4 pk; pk.x = pack2(st[2 * kp][0], st[2 * kp][1]); pk.y = pack2(st[2 * kp][2], st[2 * kp][3]);
    pk.z = pack2(st[2 * kp + 1][0], st[2 * kp + 1][1]); pk.w = pack2(st[2 * kp + 1][2], st[2 * kp + 1][3]);
    const bf16x8 pb = __builtin_bit_cast(bf16x8, pk);
#pragma unroll
    for (int dt = 0; dt < 4; ++dt) {
      const LAS bf16_t* vp = Vs + (2 * kp) * 16 * LK + dt * 16;
      const s16x4 lo = __builtin_amdgcn_ds_read_tr16_b64_v4i16((LAS s16x4*)vp);
      const s16x4 hi = __builtin_amdgcn_ds_read_tr16_b64_v4i16((LAS s16x4*)(vp + 16 * LK));
      g.o[dt] = MFMA16(__builtin_shufflevector(lo, hi, 0, 1, 2, 3, 4, 5, 6, 7), pb, g.o[dt]);
    }
  }
}
DI void nsa_sel16(const Params& p, char* smem, bool dry) {
  char* ws = p.ws;
  const int tid = otid(), lane = tid & 63, wave = tid >> 6, c16 = lane & 15, kg = lane >> 4, qi4 = c16 >> 2, r4 = c16 & 3;
  const bf16_t* Q = (const bf16_t*)(ws + OFF_Q);
  const float* gsig = (const float*)(ws + OFF_GSIG);
  bf16_t* ONSA = (bf16_t*)(ws + OFF_ONSA);
  const u32x4* SELG = (const u32x4*)(ws + OFF_SELG);
  const bf16_t* KS = (const bf16_t*)(ws + OFF_KS); const bf16_t* VS = (const bf16_t*)(ws + OFF_VS);
  constexpr int NITEM = NB * 2 * 128;
  for (int item = blockIdx.x; item < NITEM; item += gridDim.x) {
    const NsaItem it = nsa_item(item, wave, 0);
    const int qb = it.qb;
    bf16x8 qf[2][2]; u32x4 selw[2]; float g_s[2]; int tg[2]; Sel16 G[2];
#pragma unroll
    for (int gq = 0; gq < 2; ++gq) {
      tg[gq] = it.t + 4 * gq + qi4;
      const size_t tokrow = (size_t)it.b * SEQ + tg[gq];
#pragma unroll
      for (int ks = 0; ks < 2; ++ks) qf[gq][ks] = *(const bf16x8*)(Q + tokrow * 512 + (it.g * 4 + r4) * 64 + ks * 32 + kg * 8);
      selw[gq] = SELG[(size_t)it.bg * SEQ + tg[gq]];
      g_s[gq] = gsig[tokrow * 32 + (it.g * 4 + r4) * 3 + 1];
      G[gq].m = 0.f; G[gq].l = 0.f; G[gq].has = false;
#pragma unroll
      for (int dt = 0; dt < 4; ++dt) G[gq].o[dt] = (f32x4v){0.f, 0.f, 0.f, 0.f};
    }
    const bf16_t* kb = KS + (size_t)it.b * SEQ * 128 + it.g * 64;
    const bf16_t* vb = VS + (size_t)it.b * SEQ * 128 + it.g * 64;
    const int nst = (qb >> 2) + 1;
    StageRegs sr;
    lds_barrier();
    nsa_load_stage(sr, kb, vb, 0, qb);
    nsa_store_stage(sr, smem);
    lds_barrier();
    for (int sidx = 0; sidx < nst; ++sidx) {
      const char* stage = smem + (sidx & 1) * NSA_STAGE;
      if (sidx + 1 < nst) nsa_load_stage(sr, kb, vb, 4 * (sidx + 1), qb);
#pragma unroll 1
      for (int tt = 0; tt < 4; ++tt) {
        const int j = 4 * sidx + tt;
        if (j > qb) break;
#pragma unroll
        for (int gq = 0; gq < 2; ++gq) {
          const unsigned w = j < 32 ? selw[gq].x : (j < 64 ? selw[gq].y : (j < 96 ? selw[gq].z : selw[gq].w));
          const bool sel = (w >> (j & 31)) & 1u;
          if (__any(sel)) nsa_unit16(G[gq], stage + tt * 18432, qf[gq], sel, (j == qb) ? (tg[gq] - j * 64) : 1000, lane);
        }
      }
      if (sidx + 1 < nst) nsa_store_stage(sr, smem + ((sidx + 1) & 1) * NSA_STAGE);
      lds_barrier();
    }
#pragma unroll
    for (int gq = 0; gq < 2; ++gq) {
      float l = G[gq].l;
      l += __shfl_xor(l, 16); l += __shfl_xor(l, 32);
      const float sc = l > 0.f ? g_s[gq] / l : 0.f;
      bf16_t* dst = ONSA + ((size_t)it.b * SEQ + tg[gq]) * 512 + (it.g * 4 + r4) * 64 + 4 * kg;
      if (!dry) {
#pragma unroll
        for (int dt = 0; dt < 4; ++dt) {
          u32x2* pp = (u32x2*)(dst + dt * 16);
          const u32x2 old = *pp;
          u32x2 wv; wv.x = pack2(bflo(old.x) + sc * G[gq].o[dt][0], bfhi(old.x) + sc * G[gq].o[dt][1]);
          wv.y = pack2(bflo(old.y) + sc * G[gq].o[dt][2], bfhi(old.y) + sc * G[gq].o[dt][3]);
          *pp = wv;
        }
      } else asm volatile("" :: "v"(G[gq].o[0]), "v"(G[gq].o[1]), "v"(G[gq].o[2]), "v"(G[gq].o[3]), "v"(l));
    }
  }
}

DI void phase_nsa(const Params& p, char* smem, int branch_mask) {
  char* ws = p.ws;
  const int tid = otid(), lane = tid & 63, wave = tid >> 6, hh = lane >> 5, c = lane & 31, qi = c >> 2, r4 = c & 3;
  const bf16_t* Q = (const bf16_t*)(ws + OFF_Q);
  const float* gsig = (const float*)(ws + OFF_GSIG);
  bf16_t* ONSA = (bf16_t*)(ws + OFF_ONSA);
  u32x4* SELG = (u32x4*)(ws + OFF_SELG);
  constexpr int NITEM = NB * 2 * 128;

#pragma unroll 1
  for (int rep1 = 0; rep1 < ((PROBE_DUP & 4096) ? 2 : 1); ++rep1) {
    const bf16_t* KCMP = (const bf16_t*)(ws + OFF_KCMP); const bf16_t* VCMP = (const bf16_t*)(ws + OFF_VCMP);
    float* Aimp = (float*)(smem + NSA_AIMP) + wave * 1024;
    float* Cimp = (float*)(smem + NSA_CIMP) + wave * 1024;
    unsigned short* selm16 = (unsigned short*)(smem + NSA_SELM) + wave * 64;
    const u32x4* selm128 = (const u32x4*)(smem + NSA_SELM) + wave * 8;
    for (int item = blockIdx.x; item < NITEM; item += gridDim.x) {
      const NsaItem it = nsa_item(item, wave, qi);
      const int t = it.t;
      bf16x8 qf[4];
#pragma unroll
      for (int ks = 0; ks < 4; ++ks) qf[ks] = *(const bf16x8*)(Q + it.tokrow * 512 + (it.g * 4 + r4) * 64 + ks * 16 + hh * 8);
      const float g_c = gsig[it.tokrow * 32 + (it.g * 4 + r4) * 3 + 0];
      TileRegs tr;
      const int nmax = (it.qb * 64 + 63 - 31) >> 4, ntile = (nmax >> 6) + 1;
      const int nfull = (it.qb * 64 - 31) >> 4;
      const bf16_t* kb = KCMP + (size_t)it.bg * 512 * 64;
      const bf16_t* vb = VCMP + (size_t)it.bg * 512 * 64;
      float m = -1e30f, l = 0.f;
      __syncthreads();
      for (int i = lane; i < 1024; i += 64) { Aimp[i] = 0.f; Cimp[i] = 0.f; }
      nsa_load_tile(tr, kb, 64, vb, 64);
      nsa_store_tile(tr, smem);
      __syncthreads();
      for (int j = 0; j < ntile; ++j) {
        const char* tile = smem + (j & 1) * NSA_TILE;
        if (j + 1 < ntile) nsa_load_tile(tr, kb + (size_t)(j + 1) * 64 * 64, 64, vb + (size_t)(j + 1) * 64 * 64, 64);
        f32x16 st[2];
        nsa_scores(st, tile, qf, lane);
        const bool full = (j * 64 + 63 <= nfull);
        const int nlim = full ? 100000 : ((t - 31) >> 4) - j * 64 - 4 * hh;
        float mx = NSA_NEG;
#pragma unroll
        for (int kt = 0; kt < 2; ++kt)
#pragma unroll
          for (int r = 0; r < 16; ++r) {
            st[kt][r] = (kt * 32 + (r & 3) + 8 * (r >> 2) <= nlim) ? st[kt][r] : NSA_NEG;
            mx = fmaxf(mx, st[kt][r]);
          }
        mx = fmaxf(mx, __shfl_xor(mx, 32));
        const float mn = fmaxf(m, mx);
        float sum = 0.f;
#pragma unroll
        for (int kt = 0; kt < 2; ++kt)
#pragma unroll
          for (int r = 0; r < 16; ++r) sum += __builtin_amdgcn_exp2f(st[kt][r] - mn);
        l = l * __builtin_amdgcn_exp2f(m - mn) + sum;
        m = mn;
        if (j + 1 < ntile) nsa_store_tile(tr, smem + ((j + 1) & 1) * NSA_TILE);
        __syncthreads();
      }
      l += __shfl_xor(l, 32);
      const float inv_l = l > 0.f ? 1.0f / l : 0.f;
      f32x16 o[2];
#pragma unroll
      for (int r = 0; r < 16; ++r) { o[0][r] = 0.f; o[1][r] = 0.f; }
      nsa_load_tile(tr, kb, 64, vb, 64);
      nsa_store_tile(tr, smem);
      __syncthreads();
      for (int j = 0; j < ntile; ++j) {
        const char* tile = smem + (j & 1) * NSA_TILE;
        if (j + 1 < ntile) nsa_load_tile(tr, kb + (size_t)(j + 1) * 64 * 64, 64, vb + (size_t)(j + 1) * 64 * 64, 64);
        f32x16 st[2];
        nsa_scores(st, tile, qf, lane);
        const bool full = (j * 64 + 63 <= nfull);
        const int nlim = full ? 100000 : ((t - 31) >> 4) - j * 64 - 4 * hh;
#pragma unroll
        for (int kt = 0; kt < 2; ++kt)
#pragma unroll
          for (int r = 0; r < 16; ++r) {
            const float arg = (kt * 32 + (r & 3) + 8 * (r >> 2) <= nlim) ? st[kt][r] - m : NSA_NEG;
            st[kt][r] = __builtin_amdgcn_exp2f(arg) * inv_l;
          }
#pragma unroll
        for (int kt = 0; kt < 2; ++kt)
#pragma unroll
          for (int c4 = 0; c4 < 4; ++c4) {
            float carry = 0.5f * st[kt][4 * c4 + 3];
            float fullv = st[kt][4 * c4] + st[kt][4 * c4 + 1] + st[kt][4 * c4 + 2] + carry;
            fullv += __shfl_xor(fullv, 1); fullv += __shfl_xor(fullv, 2);
            carry += __shfl_xor(carry, 1); carry += __shfl_xor(carry, 2);
            const int jb = j * 16 + kt * 8 + 2 * c4 + hh;
            if (r4 == 0) { Aimp[qi * 128 + jb] = fullv; Cimp[qi * 128 + jb] = carry; }
          }
        if (branch_mask & 1) nsa_pv(o, st, tile, lane);
        if (j + 1 < ntile) nsa_store_tile(tr, smem + ((j + 1) & 1) * NSA_TILE);
        __syncthreads();
      }
      nsa_accum_store(ONSA + it.tokrow * 512 + (it.g * 4 + r4) * 64, o, (branch_mask & 1) ? g_c : 0.f, true, hh);
      const int cur = it.qb;
      if (cur <= 15) {
        if (lane < 8) { selm16[lane * 8 + 0] = (unsigned short)((2u << cur) - 1u);
#pragma unroll
          for (int k = 1; k < 8; ++k) selm16[lane * 8 + k] = 0; }
      } else {
        const int qs = lane >> 3, sub = lane & 7;
        float v[16];
#pragma unroll
        for (int i = 0; i < 16; ++i) {
          const int jj = sub * 16 + i;
          const bool ok = (jj >= 1) && (jj <= cur - 2);
          const int jm = jj >= 1 ? jj - 1 : 0;
          v[i] = ok ? (Aimp[qs * 128 + jj] + Cimp[qs * 128 + jm]) : -3e38f;
        }
        unsigned bits = 0;
        for (int itn = 0; itn < 13; ++itn) {
          float bv = v[0]; int bi = 0;
#pragma unroll
          for (int i = 1; i < 16; ++i) if (v[i] > bv) { bv = v[i]; bi = i; }
          int bj = sub * 16 + bi;
#pragma unroll
          for (int o2 = 1; o2 < 8; o2 <<= 1) {
            const float ov = __shfl_xor(bv, o2); const int oj = __shfl_xor(bj, o2);
            if (ov > bv || (ov == bv && oj < bj)) { bv = ov; bj = oj; }
          }
          if ((bj >> 4) == sub) {
            const int i2 = bj & 15;
#pragma unroll
            for (int i = 0; i < 16; ++i) if (i == i2) v[i] = -3e38f;
            bits |= 1u << i2;
          }
        }
        if (sub == 0) bits |= 1u;
        if ((cur >> 4) == sub) bits |= 1u << (cur & 15);
        if (((cur - 1) >> 4) == sub) bits |= 1u << ((cur - 1) & 15);
        selm16[qs * 8 + sub] = (unsigned short)bits;
      }
      __syncthreads();
      if (r4 == 0 && hh == 0) SELG[(size_t)it.bg * SEQ + t] = selm128[qi];
    }
  }
  __threadfence_block();
  __syncthreads();

#pragma unroll 1
  for (int sweep_i = 0; sweep_i < 2 + ((PROBE_DUP & 1024) ? 1 : 0) + ((PROBE_DUP & 2048) ? 1 : 0); ++sweep_i) {
    const int sweep = (sweep_i < 2) ? sweep_i : (((PROBE_DUP & 1024) && sweep_i == 2) ? 0 : 1);
    const bool dry = sweep_i >= 2;
    if (!(branch_mask & (sweep == 0 ? 2 : 4))) continue;
    if (sweep == 0) { nsa_sel16(p, smem, dry); continue; }
    const bf16_t* KB = (const bf16_t*)(ws + (sweep == 0 ? OFF_KS : OFF_KW)); const bf16_t* VB = (const bf16_t*)(ws + (sweep == 0 ? OFF_VS : OFF_VW));
    for (int item = blockIdx.x; item < NITEM; item += gridDim.x) {
      const NsaItem it = nsa_item(item, wave, qi);
      const int t = it.t, qb = it.qb;
      bf16x8 qf[4];
#pragma unroll
      for (int ks = 0; ks < 4; ++ks) qf[ks] = *(const bf16x8*)(Q + it.tokrow * 512 + (it.g * 4 + r4) * 64 + ks * 16 + hh * 8);
      const float g_b = gsig[it.tokrow * 32 + (it.g * 4 + r4) * 3 + 1 + sweep];
      u32x4 selw = {0xffffffffu, 0xffffffffu, 0xffffffffu, 0xffffffffu};
      if (sweep == 0) selw = SELG[(size_t)it.bg * SEQ + t];
      TileRegs tr;
      const bf16_t* kb = KB + (size_t)it.b * SEQ * 128 + it.g * 64;
      const bf16_t* vb = VB + (size_t)it.b * SEQ * 128 + it.g * 64;
      float m = -1e30f, l = 0.f;
      f32x16 o[2];
#pragma unroll
      for (int r = 0; r < 16; ++r) { o[0][r] = 0.f; o[1][r] = 0.f; }
      const int j0 = (sweep == 1 && qb >= 8) ? qb - 8 : 0;
      __syncthreads();
      nsa_load_tile(tr, kb + (size_t)j0 * 64 * 128, 128, vb + (size_t)j0 * 64 * 128, 128);
      nsa_store_tile(tr, smem);
      if (j0 + 1 <= qb) { nsa_load_tile(tr, kb + (size_t)(j0 + 1) * 64 * 128, 128, vb + (size_t)(j0 + 1) * 64 * 128, 128); nsa_store_tile(tr, smem + NSA_TILE); }
      if (j0 + 2 <= qb) nsa_load_tile(tr, kb + (size_t)(j0 + 2) * 64 * 128, 128, vb + (size_t)(j0 + 2) * 64 * 128, 128);
      __syncthreads();
      const bool late = wave >= 4;
      if (__builtin_amdgcn_readfirstlane(wave) >= 4) __builtin_amdgcn_s_setprio(1);
      bool has = false;
      m = 0.f;
      f32x16 st[2];
      {
        const unsigned w0 = j0 < 32 ? selw.x : (j0 < 64 ? selw.y : (j0 < 96 ? selw.z : selw.w));
        const float ini = ((w0 >> (j0 & 31)) & 1u) ? 0.f : -1e30f;
#pragma unroll
        for (int r = 0; r < 16; ++r) { st[0][r] = ini; st[1][r] = ini; }
        const bf16_t* Kc = (const bf16_t*)smem;
#pragma unroll
        for (int ks = 0; ks < 4; ++ks)
#pragma unroll
          for (int kt = 0; kt < 2; ++kt) st[kt] = MFMA32(*(const bf16x8*)(Kc + (kt * 32 + (lane & 31)) * LK + ks * 16 + (lane >> 5) * 8), qf[ks], st[kt]);
      }
      int bi = 0;
      for (int j = j0; j <= qb; ++j) {
        const char* tile = smem + bi * NSA_TILE;
        const int bn = bi == 2 ? 0 : bi + 1, bnn = bn == 2 ? 0 : bn + 1;
        const int jn = j + 1;
        const unsigned wn = jn < 32 ? selw.x : (jn < 64 ? selw.y : (jn < 96 ? selw.z : selw.w));
        const bool seln = (wn >> (jn & 31)) & 1u;
        const bf16_t* Kn = (const bf16_t*)(smem + bn * NSA_TILE) + (lane & 31) * LK + (lane >> 5) * 8;
        f32x16 sn[2];
        if (!late) {
          const float ini = seln ? -m : -1e30f;
#pragma unroll
          for (int r = 0; r < 16; ++r) { sn[0][r] = ini; sn[1][r] = ini; }
#pragma unroll
          for (int ks = 0; ks < 4; ++ks)
#pragma unroll
            for (int kt = 0; kt < 2; ++kt) sn[kt] = MFMA32(*(const bf16x8*)(Kn + kt * 32 * LK + ks * 16), qf[ks], sn[kt]);
        }
        if (j == qb || (sweep == 1 && j == qb - 8)) {
          const int khi = t - j * 64 - 4 * hh, klo = (sweep == 1) ? khi - 511 : -100000;
#pragma unroll
          for (int r = 0; r < 16; ++r) {
            const int o0 = (r & 3) + 8 * (r >> 2);
            st[0][r] = (o0 <= khi && o0 >= klo) ? st[0][r] : NSA_NEG;
            st[1][r] = (o0 + 32 <= khi && o0 + 32 >= klo) ? st[1][r] : NSA_NEG;
          }
        }
        float mx;
        {
          float a0, a1, a2, a3;
          asm("v_max3_f32 %0, %1, %2, %3" : "=v"(a0) : "v"(st[0][0]), "v"(st[0][1]), "v"(st[0][2]));
          asm("v_max3_f32 %0, %1, %2, %3" : "=v"(a1) : "v"(st[0][3]), "v"(st[0][4]), "v"(st[0][5]));
          asm("v_max3_f32 %0, %1, %2, %3" : "=v"(a2) : "v"(st[0][6]), "v"(st[0][7]), "v"(st[0][8]));
          asm("v_max3_f32 %0, %1, %2, %3" : "=v"(a3) : "v"(st[0][9]), "v"(st[0][10]), "v"(st[0][11]));
          asm("v_max3_f32 %0, %1, %2, %3" : "=v"(a0) : "v"(a0), "v"(st[0][12]), "v"(st[0][13]));
          asm("v_max3_f32 %0, %1, %2, %3" : "=v"(a1) : "v"(a1), "v"(st[0][14]), "v"(st[0][15]));
          asm("v_max3_f32 %0, %1, %2, %3" : "=v"(a2) : "v"(a2), "v"(st[1][0]), "v"(st[1][1]));
          asm("v_max3_f32 %0, %1, %2, %3" : "=v"(a3) : "v"(a3), "v"(st[1][2]), "v"(st[1][3]));
          asm("v_max3_f32 %0, %1, %2, %3" : "=v"(a0) : "v"(a0), "v"(st[1][4]), "v"(st[1][5]));
          asm("v_max3_f32 %0, %1, %2, %3" : "=v"(a1) : "v"(a1), "v"(st[1][6]), "v"(st[1][7]));
          asm("v_max3_f32 %0, %1, %2, %3" : "=v"(a2) : "v"(a2), "v"(st[1][8]), "v"(st[1][9]));
          asm("v_max3_f32 %0, %1, %2, %3" : "=v"(a3) : "v"(a3), "v"(st[1][10]), "v"(st[1][11]));
          asm("v_max3_f32 %0, %1, %2, %3" : "=v"(a0) : "v"(a0), "v"(st[1][12]), "v"(st[1][13]));
          asm("v_max3_f32 %0, %1, %2, %3" : "=v"(a1) : "v"(a1), "v"(st[1][14]), "v"(st[1][15]));
          asm("v_max3_f32 %0, %1, %2, %3" : "=v"(a0) : "v"(a0), "v"(a1), "v"(a2));
          const float other = a3;
          asm("v_max_f32 %0, %1, %2" : "=v"(mx) : "v"(a0), "v"(other));
          const float px = __shfl_xor(mx, 32);
          asm("v_max_f32 %0, %1, %2" : "=v"(mx) : "v"(mx), "v"(px));
        }
        const bool real = mx > -1e29f;
        const bool fresh = !has && real, up = has && (mx > NSA_THR);
        if (__any(fresh || up)) {
          const float delta = (fresh || up) ? mx : 0.f;
          const float alpha = up ? __builtin_amdgcn_exp2f(-delta) : 1.0f;
          m += delta; l *= alpha;
#pragma unroll
          for (int r = 0; r < 16; ++r) { o[0][r] *= alpha; o[1][r] *= alpha; st[0][r] -= delta; st[1][r] -= delta; }
          if (!late) {
            const float dn = seln ? delta : 0.f;
#pragma unroll
            for (int r = 0; r < 16; ++r) { sn[0][r] -= dn; sn[1][r] -= dn; }
          }
        }
        has = has || real;
        f32x2 s2 = {0.f, 0.f};
#pragma unroll
        for (int r = 0; r < 16; ++r) {
          const float p0 = __builtin_amdgcn_exp2f(st[0][r]), p1 = __builtin_amdgcn_exp2f(st[1][r]);
          st[0][r] = p0; st[1][r] = p1; s2 += (f32x2){p0, p1};
        }
        l += s2.x + s2.y;
        nsa_pv(o, st, tile, lane);
        if (late) {
          const float ini = seln ? -m : -1e30f;
#pragma unroll
          for (int r = 0; r < 16; ++r) { sn[0][r] = ini; sn[1][r] = ini; }
#pragma unroll
          for (int ks = 0; ks < 4; ++ks)
#pragma unroll
            for (int kt = 0; kt < 2; ++kt) sn[kt] = MFMA32(*(const bf16x8*)(Kn + kt * 32 * LK + ks * 16), qf[ks], sn[kt]);
        }
        if (j + 2 <= qb) nsa_store_tile(tr, smem + bnn * NSA_TILE);
        if (j + 3 <= qb) nsa_load_tile(tr, kb + (size_t)(j + 3) * 64 * 128, 128, vb + (size_t)(j + 3) * 64 * 128, 128);
#pragma unroll
        for (int r = 0; r < 16; ++r) { st[0][r] = sn[0][r]; st[1][r] = sn[1][r]; }
        bi = bn;
        __syncthreads();
      }
      __builtin_amdgcn_s_setprio(0);
      l += __shfl_xor(l, 32);
      if (!dry) nsa_accum_store(ONSA + it.tokrow * 512 + (it.g * 4 + r4) * 64, o, l > 0.f ? g_b / l : 0.f, false, hh);
      else asm volatile("" :: "v"(o[0]), "v"(o[1]), "v"(l));
    }
  }
}

DI unsigned ord_key(float f) { const unsigned u = __float_as_uint(f); return (u & 0x80000000u) ? ~u : (u | 0x80000000u); }
DI float ord_val(unsigned k) { return __uint_as_float((k & 0x80000000u) ? (k & 0x7fffffffu) : ~k); }
DI void cex(unsigned& hi, unsigned& lo) { const unsigned x = hi, y = lo; hi = x > y ? x : y; lo = x > y ? y : x; }
DI void sort16_desc(unsigned (&a)[16]) {
#pragma unroll
  for (int k = 2; k <= 16; k <<= 1)
#pragma unroll
    for (int j = k >> 1; j > 0; j >>= 1)
#pragma unroll
      for (int i = 0; i < 16; ++i) {
        const int l = i ^ j;
        if (l > i) { if ((i & k) == 0) cex(a[i], a[l]); else cex(a[l], a[i]); }
      }
}
DI void bitonic_finish16(unsigned (&a)[16]) {
#pragma unroll
  for (int j = 8; j > 0; j >>= 1)
#pragma unroll
    for (int i = 0; i < 16; ++i) { const int l = i ^ j; if (l > i) cex(a[i], a[l]); }
}
DI void merge_top16(unsigned (&a)[16], const unsigned (&b)[16]) {
#pragma unroll
  for (int i = 0; i < 16; ++i) a[i] = a[i] > b[15 - i] ? a[i] : b[15 - i];
  bitonic_finish16(a);
}
DI void merge_partner16(unsigned (&a)[16]) {
  unsigned b[16];
#pragma unroll
  for (int i = 0; i < 16; ++i) b[i] = (unsigned)__shfl_xor((int)a[i], 32);
  merge_top16(a, b);
}


DI void peer_top16(unsigned (&top)[16], const bf16_t* pqrow, const bf16_t* keys, int lane) {
  const int l31 = lane & 31, hh = lane >> 5;
  bf16x8 bq[8];
#pragma unroll
  for (int ks = 0; ks < 8; ++ks) bq[ks] = *(const bf16x8*)(pqrow + ks * 16 + hh * 8);
  unsigned grp[16];
#pragma unroll
  for (int nt = 0; nt < 4; ++nt) {
    f32x16 sa;
#pragma unroll
    for (int r = 0; r < 16; ++r) sa[r] = 0.f;
    const bf16_t* kp = keys + (size_t)(nt * 32 + l31) * 128 + hh * 8;
#pragma unroll
    for (int ks = 0; ks < 8; ++ks) { const bf16x8 a = *(const bf16x8*)(kp + ks * 16); sa = MFMA32(a, bq[ks], sa); }
#pragma unroll
    for (int r = 0; r < 16; ++r) {
      const int n = nt * 32 + (r & 3) + 8 * (r >> 2) + 4 * hh;
      grp[r] = (ord_key(sa[r]) & ~0x7Fu) | (unsigned)(127 - n);
    }
    sort16_desc(grp);
    if (nt == 0) {
#pragma unroll
      for (int i = 0; i < 16; ++i) top[i] = grp[i];
    } else merge_top16(top, grp);
  }
  merge_partner16(top);
}

DI void phase_route(const Params& p, char* smem) {
  char* ws = p.ws;
  const int tid = otid(), lane = tid & 63, wave = tid >> 6, l31 = lane & 31, hh = lane >> 5;
  const bf16_t* pq = (const bf16_t*)(ws + OFF_PQ);
  const bf16_t* pk = (const bf16_t*)(ws + OFF_PKEYS);
  int* eidx = (int*)(ws + OFF_EIDX);
  float* pgate = (float*)(ws + OFF_PGATE);
  unsigned* LS = (unsigned*)smem + wave * 1024;
  constexpr int CA[64] = {0,0,0,0,0,0,0,0,0,0,0,0,0,0,0,0, 1,1,1,1,1,1,1,1, 2,2,2,2,2, 3,3,3,3, 4,4,4, 5,5, 6,6, 7,7, 8,9,10,11,12,13,14,15, 0,0,0,0,0,0,0,0,0,0,0,0,0,0};
  constexpr int CB[64] = {0,1,2,3,4,5,6,7,8,9,10,11,12,13,14,15, 0,1,2,3,4,5,6,7, 0,1,2,3,4, 0,1,2,3, 0,1,2, 0,1, 0,1, 0,1, 0,0,0,0,0,0,0,0, 0,0,0,0,0,0,0,0,0,0,0,0,0,0};
  for (int item = blockIdx.x; item < (NTOK / 256) * 8; item += gridDim.x) {
    const int h = item & 7, t0 = (item >> 3) * 256 + wave * 32;
    unsigned s1[16], s2[16];
    const bf16_t* pqrow = pq + (size_t)(t0 + l31) * 2048 + h * 256;
    peer_top16(s1, pqrow, pk + (size_t)(h * 2) * 128 * 128, lane);
    peer_top16(s2, pqrow + 128, pk + (size_t)(h * 2 + 1) * 128 * 128, lane);
    float f1[16], f2[16];
#pragma unroll
    for (int i = 0; i < 16; ++i) { f1[i] = ord_val(s1[i]); f2[i] = ord_val(s2[i]); }
    unsigned ca[16], cb2[16];
#pragma unroll
    for (int i = 0; i < 32; ++i) {
      const int i0 = i, i1 = 25 + i;
      unsigned k0 = 0u, k1 = 0u;
      if (i0 < 25) k0 = (ord_key(f1[CA[i0]] + f2[CB[i0]]) & ~0xFFu) | (unsigned)(255 - (CA[i0] * 16 + CB[i0]));
      if (i1 < 50) k1 = (ord_key(f1[CA[i1]] + f2[CB[i1]]) & ~0xFFu) | (unsigned)(255 - (CA[i1] * 16 + CB[i1]));
      const unsigned kk = hh ? k1 : k0;
      if (i < 16) ca[i] = kk; else cb2[i - 16] = kk;
    }
    sort16_desc(ca); sort16_desc(cb2);
    merge_top16(ca, cb2);
    merge_partner16(ca);
    if (hh == 0) {
#pragma unroll
      for (int i = 0; i < 16; ++i) { LS[l31 * 32 + i] = s1[i]; LS[l31 * 32 + 16 + i] = s2[i]; }
    }
    const float mx = ord_val(ca[0]);
    float ex[16], sum = 0.f;
#pragma unroll
    for (int i = 0; i < 16; ++i) { ex[i] = __expf(ord_val(ca[i]) - mx); sum += ex[i]; }
    const float inv = 1.0f / sum;
    int eo[16]; float go[16];
#pragma unroll
    for (int i = 0; i < 16; ++i) {
      const int flat = 255 - (int)(ca[i] & 0xFFu);
      const unsigned k1 = LS[l31 * 32 + (flat >> 4)], k2 = LS[l31 * 32 + 16 + (flat & 15)];
      eo[i] = (127 - (int)(k1 & 0x7Fu)) * 128 + (127 - (int)(k2 & 0x7Fu));
      go[i] = ex[i] * inv;
    }
    const size_t ob = ((size_t)(t0 + l31) * 8 + h) * 16;
    if (hh == 0) {
      *(u32x4*)(eidx + ob) = (u32x4){(unsigned)eo[0], (unsigned)eo[1], (unsigned)eo[2], (unsigned)eo[3]};
      *(u32x4*)(eidx + ob + 4) = (u32x4){(unsigned)eo[4], (unsigned)eo[5], (unsigned)eo[6], (unsigned)eo[7]};
      *(f32x4*)(pgate + ob) = (f32x4){go[0], go[1], go[2], go[3]};
      *(f32x4*)(pgate + ob + 4) = (f32x4){go[4], go[5], go[6], go[7]};
    } else {
      *(u32x4*)(eidx + ob + 8) = (u32x4){(unsigned)eo[8], (unsigned)eo[9], (unsigned)eo[10], (unsigned)eo[11]};
      *(u32x4*)(eidx + ob + 12) = (u32x4){(unsigned)eo[12], (unsigned)eo[13], (unsigned)eo[14], (unsigned)eo[15]};
      *(f32x4*)(pgate + ob + 8) = (f32x4){go[8], go[9], go[10], go[11]};
      *(f32x4*)(pgate + ob + 12) = (f32x4){go[12], go[13], go[14], go[15]};
    }
  }
}

#define FOR32(M) M(0) M(1) M(2) M(3) M(4) M(5) M(6) M(7) M(8) M(9) M(10) M(11) M(12) M(13) M(14) M(15) M(16) M(17) M(18) M(19) M(20) M(21) M(22) M(23) M(24) M(25) M(26) M(27) M(28) M(29) M(30) M(31)
DI float dot16_fp8(const u32x4 raw, const float (&hx)[16]) {
  const f32x2 a0 = __builtin_amdgcn_cvt_pk_f32_fp8((int)raw.x, false), a1 = __builtin_amdgcn_cvt_pk_f32_fp8((int)raw.x, true);
  const f32x2 b0 = __builtin_amdgcn_cvt_pk_f32_fp8((int)raw.y, false), b1 = __builtin_amdgcn_cvt_pk_f32_fp8((int)raw.y, true);
  const f32x2 c0 = __builtin_amdgcn_cvt_pk_f32_fp8((int)raw.z, false), c1 = __builtin_amdgcn_cvt_pk_f32_fp8((int)raw.z, true);
  const f32x2 d0 = __builtin_amdgcn_cvt_pk_f32_fp8((int)raw.w, false), d1 = __builtin_amdgcn_cvt_pk_f32_fp8((int)raw.w, true);
  float d = (hx[0] * a0.x + hx[1] * a0.y) + (hx[2] * a1.x + hx[3] * a1.y);
  d += (hx[4] * b0.x + hx[5] * b0.y) + (hx[6] * b1.x + hx[7] * b1.y);
  d += (hx[8] * c0.x + hx[9] * c0.y) + (hx[10] * c1.x + hx[11] * c1.y);
  d += (hx[12] * d0.x + hx[13] * d0.y) + (hx[14] * d1.x + hx[15] * d1.y);
  return d;
}
#define FOR16(M) M(0) M(1) M(2) M(3) M(4) M(5) M(6) M(7) M(8) M(9) M(10) M(11) M(12) M(13) M(14) M(15)
DI void phase_ffn_u(const Params& p) {
  char* ws = p.ws;
  const int lane = otid() & 63, wave = otid() >> 6, pg = lane >> 3, dc = lane & 7;
  const int sl = blockIdx.x & 7, wslot = (blockIdx.x >> 3) * NW + wave, nw = (gridDim.x >> 3) * NW;
  const unsigned char* PU8 = (const unsigned char*)(ws + OFF_PU8) + (size_t)sl * 16384 * 128 + dc * 16;
  const bf16_t* h2 = (const bf16_t*)(ws + OFF_H) + sl * 128 + dc * 16;
  const int* eidx = (const int*)(ws + OFF_EIDX);
  float* part = (float*)(ws + OFF_PART) + (size_t)sl * NTOK * 128;
  const int j0 = (dc >> 2) * 64 + ((2 * dc) & 7) * 8 + pg;
  int ev0 = 0, ev1 = 0, nev0 = 0, nev1 = 0; u32x4 ha = {0u, 0u, 0u, 0u}, hb = ha, nha = ha, nhb = ha;
  if (wslot < NTOK) { ev0 = eidx[(size_t)wslot * 128 + lane]; ev1 = eidx[(size_t)wslot * 128 + 64 + lane]; ha = *(const u32x4*)(h2 + (size_t)wslot * DM); hb = *(const u32x4*)(h2 + (size_t)wslot * DM + 8); }
  for (int t = wslot; t < NTOK; t += nw) {
    if (t + nw < NTOK) { const size_t o = (size_t)(t + nw) * 128; nev0 = eidx[o + lane]; nev1 = eidx[o + 64 + lane]; nha = *(const u32x4*)(h2 + (size_t)(t + nw) * DM); nhb = *(const u32x4*)(h2 + (size_t)(t + nw) * DM + 8); }
    float hx[16];
    { float t8[8]; unpack8(ha, t8);
#pragma unroll
      for (int i = 0; i < 8; ++i) hx[i] = t8[i];
      unpack8(hb, t8);
#pragma unroll
      for (int i = 0; i < 8; ++i) hx[8 + i] = t8[i]; }
#define FFU_LD(it) const u32x4 ru##it = *(const u32x4*)(PU8 + (size_t)__shfl((it) < 8 ? ev0 : ev1, ((it) & 7) * 8 + pg) * 128);
    FOR16(FFU_LD)
    float d[16];
#define FFU_CP(it) d[it] = dot16_fp8(ru##it, hx);
    FOR16(FFU_CP)
    float r8[8], r4[4], r2[2];
    { const bool hi = dc & 4;
#pragma unroll
      for (int i = 0; i < 8; ++i) { const float keep = hi ? d[8 + i] : d[i], send = hi ? d[i] : d[8 + i]; r8[i] = keep + __shfl_xor(send, 4); } }
    { const bool hi = dc & 2;
#pragma unroll
      for (int i = 0; i < 4; ++i) { const float keep = hi ? r8[4 + i] : r8[i], send = hi ? r8[i] : r8[4 + i]; r4[i] = keep + __shfl_xor(send, 2); } }
    { const bool hi = dc & 1;
#pragma unroll
      for (int i = 0; i < 2; ++i) { const float keep = hi ? r4[2 + i] : r4[i], send = hi ? r4[i] : r4[2 + i]; r2[i] = keep + __shfl_xor(send, 1); } }
    part[(size_t)t * 128 + j0] = r2[0];
    part[(size_t)t * 128 + j0 + 8] = r2[1];
    ev0 = nev0; ev1 = nev1; ha = nha; hb = nhb;
  }
}
DI void phase_ffn_w(const Params& p) {
  char* ws = p.ws;
  const int lane = otid() & 63, wave = otid() >> 6;
  const float* part = (const float*)(ws + OFF_PART);
  const float* scu = (const float*)(ws + OFF_SCU); const float* scv = (const float*)(ws + OFF_SCV);
  const int* eidx = (const int*)(ws + OFF_EIDX);
  const float* pgate = (const float*)(ws + OFF_PGATE);
  float* wbuf = (float*)(ws + OFF_WBUF);
  for (int grp = blockIdx.x; grp < NTOK / NW; grp += gridDim.x) {
    const size_t o = (size_t)(grp * NW + wave) * 128 + lane;
    float a0 = 0.f, a1 = 0.f;
#pragma unroll
    for (int s8 = 0; s8 < 8; ++s8) { a0 += part[(size_t)s8 * NTOK * 128 + o]; a1 += part[(size_t)s8 * NTOK * 128 + o + 64]; }
    const int e0 = eidx[o], e1 = eidx[o + 64];
    wbuf[o] = pgate[o] * gelu_f(a0 * scu[e0]) * scv[e0];
    wbuf[o + 64] = pgate[o + 64] * gelu_f(a1 * scu[e1]) * scv[e1];
  }
}
DI void phase_ffn_v(const Params& p) {
  char* ws = p.ws;
  const int lane = otid() & 63, wave = otid() >> 6, pg = lane >> 3, dc = lane & 7;
  const int sl = blockIdx.x & 7, wslot = (blockIdx.x >> 3) * NW + wave, nw = (gridDim.x >> 3) * NW;
  const unsigned char* PV8 = (const unsigned char*)(ws + OFF_PV8) + (size_t)sl * 16384 * 128 + dc * 16;
  const int* eidx = (const int*)(ws + OFF_EIDX);
  const float* wbuf = (const float*)(ws + OFF_WBUF);
  bf16_t* ffnb = (bf16_t*)(ws + OFF_FFNB);
  int ev0 = 0, ev1 = 0, nev0 = 0, nev1 = 0; float w0 = 0.f, w1 = 0.f, nw0 = 0.f, nw1 = 0.f;
  if (wslot < NTOK) { ev0 = eidx[(size_t)wslot * 128 + lane]; ev1 = eidx[(size_t)wslot * 128 + 64 + lane]; w0 = wbuf[(size_t)wslot * 128 + lane]; w1 = wbuf[(size_t)wslot * 128 + 64 + lane]; }
  for (int t = wslot; t < NTOK; t += nw) {
    if (t + nw < NTOK) { const size_t o = (size_t)(t + nw) * 128; nev0 = eidx[o + lane]; nev1 = eidx[o + 64 + lane]; nw0 = wbuf[o + lane]; nw1 = wbuf[o + 64 + lane]; }
#define FFV_LD(it) const u32x4 rv##it = *(const u32x4*)(PV8 + (size_t)__shfl((it) < 8 ? ev0 : ev1, ((it) & 7) * 8 + pg) * 128);
#define FFV_CP(it) { const float wj = __shfl((it) < 8 ? w0 : w1, ((it) & 7) * 8 + pg); \
      const f32x2 a0 = __builtin_amdgcn_cvt_pk_f32_fp8((int)rv##it.x, false), a1 = __builtin_amdgcn_cvt_pk_f32_fp8((int)rv##it.x, true); \
      const f32x2 b0 = __builtin_amdgcn_cvt_pk_f32_fp8((int)rv##it.y, false), b1 = __builtin_amdgcn_cvt_pk_f32_fp8((int)rv##it.y, true); \
      const f32x2 c0 = __builtin_amdgcn_cvt_pk_f32_fp8((int)rv##it.z, false), c1 = __builtin_amdgcn_cvt_pk_f32_fp8((int)rv##it.z, true); \
      const f32x2 d0 = __builtin_amdgcn_cvt_pk_f32_fp8((int)rv##it.w, false), d1 = __builtin_amdgcn_cvt_pk_f32_fp8((int)rv##it.w, true); \
      acc[0] += wj * a0.x; acc[1] += wj * a0.y; acc[2] += wj * a1.x; acc[3] += wj * a1.y; acc[4] += wj * b0.x; acc[5] += wj * b0.y; acc[6] += wj * b1.x; acc[7] += wj * b1.y; \
      acc[8] += wj * c0.x; acc[9] += wj * c0.y; acc[10] += wj * c1.x; acc[11] += wj * c1.y; acc[12] += wj * d0.x; acc[13] += wj * d0.y; acc[14] += wj * d1.x; acc[15] += wj * d1.y; }
    FOR16(FFV_LD)
    float acc[16];
#pragma unroll
    for (int i = 0; i < 16; ++i) acc[i] = 0.f;
    FOR16(FFV_CP)
    float r8[8], r4[4], r2[2];
    { const bool hi = lane & 32;
#pragma unroll
      for (int i = 0; i < 8; ++i) { const float keep = hi ? acc[8 + i] : acc[i], send = hi ? acc[i] : acc[8 + i]; r8[i] = keep + __shfl_xor(send, 32); } }
    { const bool hi = lane & 16;
#pragma unroll
      for (int i = 0; i < 4; ++i) { const float keep = hi ? r8[4 + i] : r8[i], send = hi ? r8[i] : r8[4 + i]; r4[i] = keep + __shfl_xor(send, 16); } }
    { const bool hi = lane & 8;
#pragma unroll
      for (int i = 0; i < 2; ++i) { const float keep = hi ? r4[2 + i] : r4[i], send = hi ? r4[i] : r4[2 + i]; r2[i] = keep + __shfl_xor(send, 8); } }
    *(unsigned*)(ffnb + (size_t)t * DM + sl * 128 + dc * 16 + 2 * pg) = pack2(r2[0], r2[1]);
    ev0 = nev0; ev1 = nev1; w0 = nw0; w1 = nw1;
  }
}
DI void phase_final(const Params& p) {
  char* ws = p.ws;
  const int lane = otid() & 63, wave = otid() >> 6;
  const bf16_t* x1 = (const bf16_t*)(ws + OFF_X1);
  const bf16_t* ffnb = (const bf16_t*)(ws + OFF_FFNB);
  const float* mod = (const float*)(ws + OFF_MOD);
  for (int grp = blockIdx.x; grp < NTOK / NW; grp += gridDim.x) {
    const int row = grp * NW + wave, b = row >> 13;
    float v[16];
#pragma unroll
    for (int i = 0; i < 4; ++i) {
      const int col = i * 256 + lane * 4;
      const f32x4 gt2 = *(const f32x4*)(mod + b * 6144 + 5120 + col);
      const u32x2 xr = *(const u32x2*)(x1 + (size_t)row * DM + col), fr = *(const u32x2*)(ffnb + (size_t)row * DM + col);
      v[4 * i] = DN_ALPHA * bflo(xr.x) + gt2.x * bflo(fr.x); v[4 * i + 1] = DN_ALPHA * bfhi(xr.x) + gt2.y * bfhi(fr.x);
      v[4 * i + 2] = DN_ALPHA * bflo(xr.y) + gt2.z * bflo(fr.y); v[4 * i + 3] = DN_ALPHA * bfhi(xr.y) + gt2.w * bfhi(fr.y);
    }
    float mean, rstd; row_stats(v, mean, rstd);
#pragma unroll
    for (int i = 0; i < 4; ++i) {
      const int col = i * 256 + lane * 4;
      const f32x4 g = *(const f32x4*)(p.ln2_g + col), bb = *(const f32x4*)(p.ln2_b + col);
      f32x4 o;
      o.x = (v[4 * i] - mean) * rstd * g.x + bb.x; o.y = (v[4 * i + 1] - mean) * rstd * g.y + bb.y;
      o.z = (v[4 * i + 2] - mean) * rstd * g.z + bb.z; o.w = (v[4 * i + 3] - mean) * rstd * g.w + bb.w;
      *(f32x4*)(p.out + (size_t)row * DM + col) = o;
    }
  }
}

#define XB_TMO      128
#define XB_XCNT(j)  (256  + 64 * (j))
#define XB_XSUB(j)  (1280 + 64 * (j))
#define XB_XGEN(j)  (2304 + 64 * (j))
#define XB_TOP      3328
#define XB_TOPGEN   3392
#define XCD_BAR_WORDS 3456
#define XB_SPIN_CAP (1u << 22)
DI unsigned xb_ld(unsigned* p) { return __hip_atomic_load(p, __ATOMIC_RELAXED, __HIP_MEMORY_SCOPE_AGENT); }
DI unsigned xb_add(unsigned* p, unsigned v) { return __hip_atomic_fetch_add(p, v, __ATOMIC_RELAXED, __HIP_MEMORY_SCOPE_AGENT); }
DI unsigned xb_xcc_id() { return (unsigned)__builtin_amdgcn_s_getreg((3 << 11) | 20) & 0xFu; }
#define XB_SPIN(cond, bar) do { unsigned _sp = 0; while (cond) { __builtin_amdgcn_s_sleep(1); \
    if ((++_sp & 255u) == 0u) { if (xb_ld(&(bar)[XB_TMO])) break; if (_sp > XB_SPIN_CAP) { atomicAdd(&(bar)[XB_TMO], 1u); break; } } } } while (0)
struct XcdBarrier { unsigned* bar; unsigned x; volatile LAS unsigned* st; };
DI XcdBarrier xcd_barrier_post(unsigned* bar, volatile LAS unsigned* st) {
  XcdBarrier b; b.bar = bar; b.x = xb_xcc_id(); b.st = st;
  if (threadIdx.x == 0) (void)xb_add(&bar[XB_XCNT(b.x)], 1u);
  return b;
}
DI void xcd_barrier_complete(unsigned* bar, unsigned x, unsigned& nloc, unsigned& nx) {
  const unsigned G = gridDim.x * gridDim.y * gridDim.z;
  unsigned sum, cnt, mine, sp = 0u;
  for (;;) {
    sum = 0u; cnt = 0u; mine = 0u;
#pragma unroll
    for (unsigned j = 0; j < 16; ++j) { const unsigned c = xb_ld(&bar[XB_XCNT(j)]); sum += c; cnt += (c > 0u) ? 1u : 0u; mine = (j == x) ? c : mine; }
    if (sum == G) break;
    __builtin_amdgcn_s_sleep(1);
    if ((++sp & 255u) == 0u) { if (xb_ld(&bar[XB_TMO])) break; if (sp > XB_SPIN_CAP) { atomicAdd(&bar[XB_TMO], 1u); break; } }
  }
  nloc = mine > 0u ? mine : 1u; nx = cnt > 0u ? cnt : 1u;
}
DI void xcd_barrier(const XcdBarrier& b) {
  asm volatile("s_waitcnt vmcnt(0)" ::: "memory");
  __syncthreads();
  if (threadIdx.x == 0) {
    unsigned* bar = b.bar;
    __builtin_amdgcn_s_waitcnt(0);
    unsigned nloc = b.st[0], nx = b.st[1];
    if (nloc == 0u) { xcd_barrier_complete(bar, b.x, nloc, nx); b.st[0] = nloc; b.st[1] = nx; }
    const unsigned old = xb_add(&bar[XB_XSUB(b.x)], 1u);
    const unsigned gen = old / nloc;
    if (old + 1u == (gen + 1u) * nloc) {
      __builtin_amdgcn_fence(__ATOMIC_RELEASE, "agent");
      asm volatile("s_waitcnt vmcnt(0)" ::: "memory");
      const unsigned og = xb_add(&bar[XB_TOP], 1u);
      const unsigned tg = og / nx;
      if (og + 1u == (tg + 1u) * nx) xb_add(&bar[XB_TOPGEN], 1u);
      else XB_SPIN(xb_ld(&bar[XB_TOPGEN]) == tg, bar);
      __builtin_amdgcn_fence(__ATOMIC_ACQUIRE, "agent");
      xb_add(&bar[XB_XGEN(b.x)], 1u);
      asm volatile("s_waitcnt vmcnt(0)" ::: "memory");
    } else {
      XB_SPIN(xb_ld(&bar[XB_XGEN(b.x)]) == gen, bar);
      __builtin_amdgcn_fence(__ATOMIC_ACQUIRE, "agent");
      asm volatile("s_waitcnt vmcnt(0)" ::: "memory");
    }
  }
  __syncthreads();
}

constexpr int SMEM_BYTES = 147456 + 256;

__global__ void __launch_bounds__(NT, 2) k_mega(Params p) {
  __shared__ __attribute__((aligned(16))) char smem[SMEM_BYTES];
  cg::grid_group grid = cg::this_grid();
  if (threadIdx.x == 0) *(u32x4*)(smem + 147456) = (u32x4){0u, 0u, 0u, 0u};
  __syncthreads();
  const XcdBarrier xb = xcd_barrier_post((unsigned*)(p.ws + OFF_BAR), (volatile LAS unsigned*)(smem + 147456));
#define REP(mask) _Pragma("unroll 1") for (int rep_ = 0; rep_ < ((PROBE_DUP & (mask)) ? 2 : 1); ++rep_)
  REP(1) phase_prep(p, smem);
  grid.sync();
  REP(1) phase_ln_in(p);
  xcd_barrier(xb);
  REP(2) phase_gemm1(p, smem);
  xcd_barrier(xb);
  REP(4) phase_compress(p, smem);
  phase_sgu(p, smem);
  xcd_barrier(xb);
  REP(8) phase_nsa(p, smem, NSA_MASK);
  xcd_barrier(xb);
  REP(16) phase_merge(p, smem);
  xcd_barrier(xb);
  REP(16) phase_outproj(p, smem);
  xcd_barrier(xb);
  REP(1) phase_ln_mid(p);
  xcd_barrier(xb);
  REP(32) phase_peerq(p, smem);
  xcd_barrier(xb);
  REP(64) phase_route(p, smem);
  xcd_barrier(xb);
  REP(128) phase_ffn_u(p);
  xcd_barrier(xb);
  REP(128) phase_ffn_w(p);
  xcd_barrier(xb);
  REP(256) phase_ffn_v(p);
  xcd_barrier(xb);
  REP(512) phase_final(p);
}

extern "C" void kernel_launch(void* const* d_in, const int* in_sizes, int n_in, void* d_out, int out_size, void* d_ws, size_t ws_size, hipStream_t stream) {
  if (ws_size < OFF_END) { fprintf(stderr, "workspace too small: %zu < %zu\n", ws_size, (size_t)OFF_END); return; }
  static int grid_blocks = 0;
  if (!grid_blocks) {
    int dev = 0, cus = 0, per_cu = 0;
    (void)hipGetDevice(&dev);
    (void)hipDeviceGetAttribute(&cus, hipDeviceAttributeMultiprocessorCount, dev);
    (void)hipOccupancyMaxActiveBlocksPerMultiprocessor(&per_cu, k_mega, NT, 0);
    if (per_cu < 1) fprintf(stderr, "occupancy query returned %d\n", per_cu);
    grid_blocks = (cus / 8) * 8;
  }
  Params p{};
  const float** fp = (const float**)&p;
  for (int i = 0; i < 26; ++i) fp[i] = (const float*)d_in[i];
  p.out = (float*)d_out;
  p.ws = (char*)d_ws;
  for (int i = 0; i < 32; ++i) p.inv_freq[i] = (float)pow(10000.0, -(double)i / 32.0);
  (void)hipMemsetAsync((char*)d_ws + OFF_BAR, 0, XCD_BAR_WORDS * 4, stream);
  void* args[] = {&p};
  hipError_t e = hipLaunchCooperativeKernel((void*)k_mega, dim3(grid_blocks), dim3(NT), args, 0, stream);
  if (e != hipSuccess) fprintf(stderr, "cooperative launch failed: %s (grid %d)\n", hipGetErrorString(e), grid_blocks);
}
```

```cpp
#include <hip/hip_runtime.h>
#include <hip/hip_cooperative_groups.h>
#include <stdint.h>
#include <stdio.h>
#include <math.h>
namespace cg = cooperative_groups;

#ifndef PROBE_DUP
#define PROBE_DUP 0
#endif
#ifndef NSA_MASK
#define NSA_MASK 7
#endif
typedef unsigned short bf16_t;
typedef short bf16x8 __attribute__((ext_vector_type(8)));
typedef short s16x4 __attribute__((ext_vector_type(4)));
typedef float f32x16 __attribute__((ext_vector_type(16)));
typedef float f32x4 __attribute__((ext_vector_type(4)));
typedef float f32x2 __attribute__((ext_vector_type(2)));
typedef __bf16 bf16v2 __attribute__((ext_vector_type(2)));
typedef unsigned u32x4 __attribute__((ext_vector_type(4)));
typedef unsigned u32x2 __attribute__((ext_vector_type(2)));
#define DI __device__ __forceinline__
#define LAS __attribute__((address_space(3)))
#define MFMA32(a, b, c) __builtin_amdgcn_mfma_f32_32x32x16_bf16((a), (b), (c), 0, 0, 0)

constexpr int NT = 512, NW = 8;
constexpr int NB = 8, SEQ = 8192, DM = 1024, NTOK = NB * SEQ;
constexpr int N1 = 4608;
constexpr float DN_ALPHA = 1.189207115002721f;
constexpr float LN_EPS = 1e-5f;

constexpr size_t MB = 1024 * 1024;
constexpr size_t OFF_MOD = 0;
constexpr size_t OFF_ROPE = OFF_MOD + 256 * 1024;
constexpr size_t OFF_POSB = OFF_ROPE + 2 * MB;
constexpr size_t OFF_WT1 = OFF_POSB + 4096;
constexpr size_t OFF_WB = OFF_WT1 + (size_t)N1 * 1024 * 2;
constexpr size_t OFF_WOUT = OFF_WB + 2 * MB;
constexpr size_t OFF_WQ = OFF_WOUT + 2 * MB;
constexpr size_t OFF_PKEYS = OFF_WQ + 4 * MB;
constexpr size_t OFF_CW1 = OFF_PKEYS + MB / 2;
constexpr size_t OFF_CW2 = OFF_CW1 + MB;
constexpr size_t OFF_SGUW = OFF_CW2 + 32 * 1024;
constexpr size_t OFF_SCU = OFF_SGUW + 256 * 1024;
constexpr size_t OFF_SCV = OFF_SCU + 64 * 1024;
constexpr size_t OFF_PU = OFF_SCV + 64 * 1024;
constexpr size_t OFF_PV = OFF_PU + 32 * MB;
constexpr size_t OFF_ACT = ((OFF_PV + 32 * MB + 4095) / 4096) * 4096;
constexpr size_t OFF_H = OFF_ACT;
constexpr size_t OFF_Q = OFF_H + 128 * MB;
constexpr size_t OFF_KC = OFF_Q + 64 * MB;
constexpr size_t OFF_VC = OFF_KC + 16 * MB;
constexpr size_t OFF_KS = OFF_VC + 16 * MB;
constexpr size_t OFF_VS = OFF_KS + 16 * MB;
constexpr size_t OFF_KW = OFF_VS + 16 * MB;
constexpr size_t OFF_VW = OFF_KW + 16 * MB;
constexpr size_t OFF_U = OFF_VW + 16 * MB;
constexpr size_t OFF_V = OFF_U + 64 * MB;
constexpr size_t OFF_GATE = OFF_V + 64 * MB;
constexpr size_t OFF_GSIG = OFF_GATE + 256 * MB;
constexpr size_t OFF_KCMP = OFF_GSIG + 8 * MB;
constexpr size_t OFF_VCMP = OFF_KCMP + MB;
constexpr size_t OFF_ONSA = OFF_VCMP + MB;
constexpr size_t OFF_SELG = OFF_ONSA + 64 * MB;
constexpr size_t OFF_BAR = OFF_SELG + 2 * MB;
constexpr size_t OFF_END = OFF_BAR + 64 * 1024;
constexpr size_t OFF_X1 = OFF_Q;
constexpr size_t OFF_Y = OFF_GATE;
constexpr size_t OFF_PQ = OFF_GATE;
constexpr size_t OFF_EIDX = OFF_ONSA;
constexpr size_t OFF_PGATE = OFF_ONSA + 32 * MB;
constexpr size_t OFF_PU8 = OFF_PU;
constexpr size_t OFF_PART = OFF_GATE;
constexpr size_t OFF_PV8 = OFF_PU + 16 * MB;
constexpr size_t OFF_WBUF = OFF_PU + 32 * MB;
constexpr size_t OFF_FFNB = OFF_GATE;

struct Params {
  const float *x, *c, *w_ada, *b_ada, *w_in, *cmp_pos, *cmp_w1, *cmp_b1, *cmp_w2, *cmp_b2, *sgu_ln_g, *sgu_ln_b, *sgu_w, *sgu_b,
      *w_branch, *w_merge, *b_merge, *w_out, *ln1_g, *ln1_b, *peer_wq, *peer_keys, *peer_u, *peer_v, *ln2_g, *ln2_b;
  float* out;
  char* ws;
  float inv_freq[32];
};

DI unsigned pack2(float lo, float hi) { f32x2 v = {lo, hi}; bf16v2 r = __builtin_convertvector(v, bf16v2); return __builtin_bit_cast(unsigned, r); }
DI bf16_t f2bf(float f) { __bf16 r = (__bf16)f; return __builtin_bit_cast(unsigned short, r); }
DI float bf2f(bf16_t h) { return __uint_as_float(((unsigned)h) << 16); }
DI float bflo(unsigned u) { return __uint_as_float(u << 16); }
DI float bfhi(unsigned u) { return __uint_as_float(u & 0xffff0000u); }
DI float gelu_f(float v) { return 0.5f * v * (1.0f + erff(v * 0.70710678118654752f)); }
DI float sigmoid_f(float v) { return 1.0f / (1.0f + __expf(-v)); }
DI int otid() { int t = __builtin_amdgcn_workitem_id_x(); asm volatile("" : "+v"(t)); return t; }
DI void lds_barrier() { asm volatile("s_waitcnt lgkmcnt(0)" ::: "memory"); __builtin_amdgcn_s_barrier(); asm volatile("" ::: "memory"); }
DI float wave_sum(float v) {
#pragma unroll
  for (int o = 32; o > 0; o >>= 1) v += __shfl_xor(v, o);
  return v;
}
DI void ld8(const float* pz, float (&v)[8]) { const f32x4 a = *(const f32x4*)pz, b = *(const f32x4*)(pz + 4); v[0] = a.x; v[1] = a.y; v[2] = a.z; v[3] = a.w; v[4] = b.x; v[5] = b.y; v[6] = b.z; v[7] = b.w; }
DI u32x4 pack8(const float (&v)[8]) { u32x4 w; w.x = pack2(v[0], v[1]); w.y = pack2(v[2], v[3]); w.z = pack2(v[4], v[5]); w.w = pack2(v[6], v[7]); return w; }
DI void unpack8(const u32x4 w, float (&v)[8]) { v[0] = bflo(w.x); v[1] = bfhi(w.x); v[2] = bflo(w.y); v[3] = bfhi(w.y); v[4] = bflo(w.z); v[5] = bfhi(w.z); v[6] = bflo(w.w); v[7] = bfhi(w.w); }
DI f32x2 gelu_pk(f32x2 v) {
  const f32x2 av = __builtin_elementwise_abs(v), d = av * 0.2316418882f + 1.0f;
  f32x2 t; t.x = __builtin_amdgcn_rcpf(d.x); t.y = __builtin_amdgcn_rcpf(d.y);
  f32x2 q = t * 0.5307027145f + (-0.7265760135f); q = q * t + 0.7107068705f; q = q * t + (-0.142248368f); q = q * t + 0.127414796f; q = q * t;
  const f32x2 s = (v * v) * (-0.72134752044f);
  f32x2 e; e.x = __builtin_amdgcn_exp2f(s.x); e.y = __builtin_amdgcn_exp2f(s.y);
  const f32x2 m = v * (q * e), r = v - m;
  f32x2 o; o.x = v.x < 0.f ? m.x : r.x; o.y = v.y < 0.f ? m.y : r.y; return o;
}
__host__ __device__ __forceinline__ int dperm(int q) { const int grp = q >> 5, fq = (q >> 3) & 3, j = q & 7; return (j < 4) ? (16 * grp + 4 * fq + j) : (32 + 16 * grp + 4 * fq + (j - 4)); }

template <class F>
DI void tconv_tile(float* tile, int k0, int n0, bf16_t* dst, int ldd, F f) {
  const int tid = otid();
  __syncthreads();
#pragma unroll 4
  for (int i = 0; i < 8; ++i) { const int kl = i * 8 + (tid >> 6), nl = tid & 63; tile[nl * 65 + kl] = f(k0 + kl, n0 + nl); }
  __syncthreads();
  {
    const int nl = tid >> 3, kc = tid & 7;
    const float* t = tile + nl * 65 + kc * 8;
    u32x4 w; w.x = pack2(t[0], t[1]); w.y = pack2(t[2], t[3]); w.z = pack2(t[4], t[5]); w.w = pack2(t[6], t[7]);
    *(u32x4*)(dst + (size_t)(n0 + nl) * ldd + k0 + kc * 8) = w;
  }
}

DI void conv_chunk(const float* src, bf16_t* dst, size_t base) {
  const size_t i = base + (size_t)otid() * 8;
  const f32x4 a = *(const f32x4*)(src + i), b = *(const f32x4*)(src + i + 4);
  u32x4 w; w.x = pack2(a.x, a.y); w.y = pack2(a.z, a.w); w.z = pack2(b.x, b.y); w.w = pack2(b.z, b.w);
  *(u32x4*)(dst + i) = w;
}

DI void sincos_d(double x, double& s, double& c) {
  const double y = x * 0.25, y2 = y * y;
  double sn = y * (1.0 + y2 * (-1.0 / 6 + y2 * (1.0 / 120 + y2 * (-1.0 / 5040 + y2 * (1.0 / 362880 + y2 * (-1.0 / 39916800 + y2 * (1.0 / 6227020800.0)))))));
  double cs = 1.0 + y2 * (-0.5 + y2 * (1.0 / 24 + y2 * (-1.0 / 720 + y2 * (1.0 / 40320 + y2 * (-1.0 / 3628800 + y2 * (1.0 / 479001600.0 + y2 * (-1.0 / 87178291200.0)))))));
#pragma unroll
  for (int i = 0; i < 2; ++i) { const double s2 = 2.0 * sn * cs, c2 = cs * cs - sn * sn; sn = s2; cs = c2; }
  s = sn; c = cs;
}

DI void phase_prep(const Params& p, char* smem) {
  const int tid = otid();
  float* fs = (float*)smem;
  char* ws = p.ws;
  constexpr int nA = 192, nB = 16 * 72, nC = 2 * 8 * 16, nD = 256, nE = 16 * 32, nF = 2 * 32 * 2, nG = 4, nH = 8, nI = 512, nJ = 64, nK = 32, nL = 2048, nM = 2048;
  constexpr int total = nA + nB + nC + nD + nE + nF + nG + nH + nI + nJ + nK + nL + nM;
  for (int item = blockIdx.x; item < total; item += gridDim.x) {
    int it = item;
    if (it < nA) {
      float* sc = fs;
      float* red = fs + 8192;
      __syncthreads();
      for (int i = tid; i < 8192; i += NT) { const float v = p.c[i]; sc[i] = v / (1.0f + __expf(-v)); }
      __syncthreads();
      const int ks = tid >> 5, cj = tid & 31, col = it * 32 + cj;
      float acc[8];
#pragma unroll
      for (int b = 0; b < 8; ++b) acc[b] = 0.f;
#pragma unroll 4
      for (int k = ks * 64; k < ks * 64 + 64; ++k) {
        const float w = p.w_ada[(size_t)k * 6144 + col];
#pragma unroll
        for (int b = 0; b < 8; ++b) acc[b] += sc[b * 1024 + k] * w;
      }
#pragma unroll
      for (int b = 0; b < 8; ++b) red[(ks * 8 + b) * 32 + cj] = acc[b];
      __syncthreads();
      if (tid < 256) {
        const int b = tid >> 5;
        float s = p.b_ada[col];
#pragma unroll
        for (int k2 = 0; k2 < 16; ++k2) s += red[(k2 * 8 + b) * 32 + cj];
        ((float*)(ws + OFF_MOD))[b * 6144 + col] = s;
      }
      continue;
    }
    it -= nA;
    if (it < nB) {
      const int kt = it / 72, ntile = it % 72;
      const float* w_in = p.w_in; const float* w_merge = p.w_merge;
      tconv_tile(fs, kt * 64, ntile * 64, (bf16_t*)(ws + OFF_WT1), 1024, [=](int k, int n) -> float {
        if (n < 1280) {
          const bool roped = (n < 640) || (n >= 768 && n < 896) || (n >= 1024 && n < 1152);
          const int col = roped ? ((n & ~63) + dperm(n & 63)) : n;
          return w_in[(size_t)k * 2328 + col];
        }
        if (n < 2304) return w_in[(size_t)k * 2328 + n + 24];
        if (n < 4352) return w_merge[(size_t)k * 2048 + (n - 2304)];
        if (n < 4376) return w_in[(size_t)k * 2328 + 1280 + (n - 4352)];
        return 0.f; });
      continue;
    }
    it -= nB;
    if (it < nC) {
      const int br = it >> 7, r = it & 127, kt = r >> 4, ntile = r & 15;
      const float* src = p.w_branch + (size_t)br * 512 * 1024;
      tconv_tile(fs, kt * 64, ntile * 64, (bf16_t*)(ws + OFF_WB) + (size_t)br * 1024 * 512, 512, [=](int k, int n) -> float { return src[(size_t)k * 1024 + n]; });
      continue;
    }
    it -= nC;
    if (it < nD) {
      const int kt = it >> 4, ntile = it & 15;
      const float* src = p.w_out;
      tconv_tile(fs, kt * 64, ntile * 64, (bf16_t*)(ws + OFF_WOUT), 1024, [=](int k, int n) -> float { return src[(size_t)k * 1024 + n]; });
      continue;
    }
    it -= nD;
    if (it < nE) {
      const int kt = it >> 5, ntile = it & 31;
      const float* src = p.peer_wq;
      tconv_tile(fs, kt * 64, ntile * 64, (bf16_t*)(ws + OFF_WQ), 1024, [=](int k, int n) -> float { return src[(size_t)k * 2048 + n]; });
      continue;
    }
    it -= nE;
    if (it < nF) {
      const int w = it >> 6, r = it & 63, kt = r >> 1, ntile = r & 1;
      const float* src = p.cmp_w1 + (size_t)w * 2048 * 128;
      tconv_tile(fs, kt * 64, ntile * 64, (bf16_t*)(ws + OFF_CW1) + (size_t)w * 128 * 2048, 2048, [=](int k, int n) -> float {
        const int ksrc = (w == 0) ? ((k & ~63) + dperm(k & 63)) : k;
        return src[(size_t)ksrc * 128 + n]; });
      continue;
    }
    it -= nF;
    if (it < nG) {
      const int w = it >> 1, kt = it & 1;
      const float* src = p.cmp_w2 + (size_t)w * 128 * 64;
      tconv_tile(fs, kt * 64, 0, (bf16_t*)(ws + OFF_CW2) + (size_t)w * 64 * 128, 128, [=](int k, int n) -> float { return src[(size_t)k * 64 + ((w == 0) ? dperm(n) : n)]; });
      continue;
    }
    it -= nG;
    if (it < nH) {
      const int w = it >> 2, jc = it & 3, ks = tid >> 5, cj = tid & 31, j = jc * 32 + cj;
      float* red = fs;
      const float* pos = p.cmp_pos + w * 2048; const float* w1 = p.cmp_w1 + (size_t)w * 2048 * 128;
      float acc = 0.f;
#pragma unroll 4
      for (int k = ks * 128; k < ks * 128 + 128; ++k) acc += pos[k] * w1[(size_t)k * 128 + j];
      __syncthreads();
      red[ks * 32 + cj] = acc;
      __syncthreads();
      if (tid < 32) { float s = p.cmp_b1[w * 128 + j]; for (int k2 = 0; k2 < 16; ++k2) s += red[k2 * 32 + tid]; ((float*)(ws + OFF_POSB))[w * 128 + j] = s; }
      continue;
    }
    it -= nH;
    if (it < nI) {
      const int e = it * 512 + tid, pos = e >> 5, i = e & 31;
      const float ang = (float)pos * p.inv_freq[i];
      const double a = (double)ang;
      const double kk = rint(a * 0.15915494309189535);
      const double r = a - kk * 6.283185307179586476925;
      double s, c; sincos_d(r, s, c);
      ((float*)(ws + OFF_ROPE))[e] = (float)c;
      ((float*)(ws + OFF_ROPE))[262144 + e] = (float)s;
      continue;
    }
    it -= nI;
    if (it < nJ) { conv_chunk(p.peer_keys, (bf16_t*)(ws + OFF_PKEYS), (size_t)it * 4096); continue; }
    it -= nJ;
    if (it < nK) {
      const size_t i0 = (size_t)it * 4096 + (size_t)tid * 8;
      const int rowi = (int)((i0 >> 7) & 127), j0 = (int)(i0 & 127);
      float v[8];
#pragma unroll
      for (int j = 0; j < 8; ++j) v[j] = (j0 + j <= rowi) ? p.sgu_w[i0 + j] : 0.f;
      u32x4 w; w.x = pack2(v[0], v[1]); w.y = pack2(v[2], v[3]); w.z = pack2(v[4], v[5]); w.w = pack2(v[6], v[7]);
      *(u32x4*)((bf16_t*)(ws + OFF_SGUW) + i0) = w;
      continue;
    }
    it -= nK;
    {
      const bool isv = it >= nL;
      if (isv) it -= nL;
      const int lane = tid & 63, e = it * 8 + (tid >> 6);
      const float* src = (isv ? p.peer_v : p.peer_u) + (size_t)e * 1024 + lane * 16;
      float v[16];
#pragma unroll
      for (int i = 0; i < 4; ++i) { const f32x4 t4 = *(const f32x4*)(src + i * 4); v[4 * i] = t4.x; v[4 * i + 1] = t4.y; v[4 * i + 2] = t4.z; v[4 * i + 3] = t4.w; }
      float amax = 0.f;
#pragma unroll
      for (int i = 0; i < 16; ++i) amax = fmaxf(amax, fabsf(v[i]));
#pragma unroll
      for (int o = 32; o > 0; o >>= 1) amax = fmaxf(amax, __shfl_xor(amax, o));
      const unsigned be = (__float_as_uint(amax) >> 23) & 0xffu;
      const bool okr = be >= 16u && be <= 240u;
      const float scale = okr ? __uint_as_float((261u - be) << 23) : 1.0f;
      const float inv = okr ? __uint_as_float((be - 7u) << 23) : 1.0f;
      u32x4 w;
      int t0 = 0, t1 = 0, t2 = 0, t3 = 0;
      t0 = __builtin_amdgcn_cvt_pk_fp8_f32(v[0] * scale, v[1] * scale, t0, false); t0 = __builtin_amdgcn_cvt_pk_fp8_f32(v[2] * scale, v[3] * scale, t0, true);
      t1 = __builtin_amdgcn_cvt_pk_fp8_f32(v[4] * scale, v[5] * scale, t1, false); t1 = __builtin_amdgcn_cvt_pk_fp8_f32(v[6] * scale, v[7] * scale, t1, true);
      t2 = __builtin_amdgcn_cvt_pk_fp8_f32(v[8] * scale, v[9] * scale, t2, false); t2 = __builtin_amdgcn_cvt_pk_fp8_f32(v[10] * scale, v[11] * scale, t2, true);
      t3 = __builtin_amdgcn_cvt_pk_fp8_f32(v[12] * scale, v[13] * scale, t3, false); t3 = __builtin_amdgcn_cvt_pk_fp8_f32(v[14] * scale, v[15] * scale, t3, true);
      w.x = (unsigned)t0; w.y = (unsigned)t1; w.z = (unsigned)t2; w.w = (unsigned)t3;
      if (!isv) {
        *(u32x4*)(ws + OFF_PU8 + ((size_t)(lane >> 3) * 16384 + e) * 128 + (lane & 7) * 16) = w;
        if (lane == 0) ((float*)(ws + OFF_SCU))[e] = inv;
      } else {
        *(u32x4*)(ws + OFF_PV8 + ((size_t)(lane >> 3) * 16384 + e) * 128 + (lane & 7) * 16) = w;
        if (lane == 0) ((float*)(ws + OFF_SCV))[e] = inv;
      }
    }
  }
}

DI void row_stats(const float (&v)[16], float& mean, float& rstd) {
  float s = 0.f;
#pragma unroll
  for (int i = 0; i < 16; ++i) s += v[i];
  mean = wave_sum(s) * (1.0f / 1024.0f);
  float q = 0.f;
#pragma unroll
  for (int i = 0; i < 16; ++i) { const float d = v[i] - mean; q += d * d; }
  rstd = rsqrtf(wave_sum(q) * (1.0f / 1024.0f) + LN_EPS);
}

DI void phase_ln_in(const Params& p) {
  const int lane = otid() & 63, wave = otid() >> 6;
  const float* mod = (const float*)(p.ws + OFF_MOD);
  bf16_t* h = (bf16_t*)(p.ws + OFF_H);
  for (int grp = blockIdx.x; grp < NTOK / NW; grp += gridDim.x) {
    const int row = grp * NW + wave, b = row >> 13;
    const float* xr = p.x + (size_t)row * DM;
    float v[16];
#pragma unroll
    for (int i = 0; i < 4; ++i) { const f32x4 t = *(const f32x4*)(xr + i * 256 + lane * 4); v[4 * i] = t.x; v[4 * i + 1] = t.y; v[4 * i + 2] = t.z; v[4 * i + 3] = t.w; }
    float mean, rstd; row_stats(v, mean, rstd);
#pragma unroll
    for (int i = 0; i < 4; ++i) {
      const int col = i * 256 + lane * 4;
      const f32x4 sh = *(const f32x4*)(mod + b * 6144 + col), sc = *(const f32x4*)(mod + b * 6144 + 1024 + col);
      const float o0 = (v[4 * i] - mean) * rstd * (1.f + sc.x) + sh.x, o1 = (v[4 * i + 1] - mean) * rstd * (1.f + sc.y) + sh.y;
      const float o2 = (v[4 * i + 2] - mean) * rstd * (1.f + sc.z) + sh.z, o3 = (v[4 * i + 3] - mean) * rstd * (1.f + sc.w) + sh.w;
      u32x2 w; w.x = pack2(o0, o1); w.y = pack2(o2, o3);
      *(u32x2*)(h + (size_t)row * DM + col) = w;
    }
  }
}

DI void phase_ln_mid(const Params& p) {
  const int lane = otid() & 63, wave = otid() >> 6;
  const float* mod = (const float*)(p.ws + OFF_MOD);
  const bf16_t* y = (const bf16_t*)(p.ws + OFF_Y);
  bf16_t* x1 = (bf16_t*)(p.ws + OFF_X1);
  bf16_t* h2 = (bf16_t*)(p.ws + OFF_H);
  for (int grp = blockIdx.x; grp < NTOK / NW; grp += gridDim.x) {
    const int row = grp * NW + wave, b = row >> 13;
    const bf16_t* yr = y + (size_t)row * DM;
    float v[16];
#pragma unroll
    for (int i = 0; i < 4; ++i) { const u32x2 t = *(const u32x2*)(yr + i * 256 + lane * 4); v[4 * i] = bflo(t.x); v[4 * i + 1] = bfhi(t.x); v[4 * i + 2] = bflo(t.y); v[4 * i + 3] = bfhi(t.y); }
    float mean, rstd; row_stats(v, mean, rstd);
#pragma unroll
    for (int i = 0; i < 4; ++i) {
      const int col = i * 256 + lane * 4;
      const f32x4 g = *(const f32x4*)(p.ln1_g + col), bb = *(const f32x4*)(p.ln1_b + col);
      f32x4 o;
      o.x = (v[4 * i] - mean) * rstd * g.x + bb.x; o.y = (v[4 * i + 1] - mean) * rstd * g.y + bb.y;
      o.z = (v[4 * i + 2] - mean) * rstd * g.z + bb.z; o.w = (v[4 * i + 3] - mean) * rstd * g.w + bb.w;
      { u32x2 w; w.x = pack2(o.x, o.y); w.y = pack2(o.z, o.w); *(u32x2*)(x1 + (size_t)row * DM + col) = w; }
      v[4 * i] = o.x; v[4 * i + 1] = o.y; v[4 * i + 2] = o.z; v[4 * i + 3] = o.w;
    }
    row_stats(v, mean, rstd);
#pragma unroll
    for (int i = 0; i < 4; ++i) {
      const int col = i * 256 + lane * 4;
      const f32x4 sh = *(const f32x4*)(mod + b * 6144 + 3072 + col), sc = *(const f32x4*)(mod + b * 6144 + 4096 + col);
      const float o0 = (v[4 * i] - mean) * rstd * (1.f + sc.x) + sh.x, o1 = (v[4 * i + 1] - mean) * rstd * (1.f + sc.y) + sh.y;
      const float o2 = (v[4 * i + 2] - mean) * rstd * (1.f + sc.z) + sh.z, o3 = (v[4 * i + 3] - mean) * rstd * (1.f + sc.w) + sh.w;
      u32x2 w; w.x = pack2(o0, o1); w.y = pack2(o2, o3);
      *(u32x2*)(h2 + (size_t)row * DM + col) = w;
    }
  }
}

namespace pg8 {
constexpr int BM = 256, BK = 64, HALF = 128, HTB = HALF * BK * 2, STAGE_BYTES = 8 * HTB, NXCD = 8, WGM = 8;
DI int lds_byte(int r, int c) { const int st = (r >> 4) * 2 + (c >> 5), rr = r & 15, cc = c & 31, ob = rr * 64 + cc * 2; return st * 1024 + (ob ^ (((ob >> 9) & 1) << 5)); }
DI void stage_rc(int b, int& R, int& C) { const int st = b / 1024, sb = b % 1024, swz = sb ^ (((sb >> 9) & 1) << 5); R = (st >> 1) * 16 + swz / 64; C = (st & 1) * 32 + (swz % 64) / 2; }
DI int perm32(int rho) { const int n = rho >> 4, i = rho & 15; return 8 * (i >> 2) + 4 * n + (i & 3); }
struct Unit { int pm, pn; };
struct Gemm { const bf16_t* A; const bf16_t* Bt; int M, N, K; };
struct StaticOrder {
  int nM, nN, nwg, G, c;
  DI void init(int M, int N, int G_, int c_) { nM = M / BM; nN = N / BM; nwg = nM * nN; G = G_; c = c_; }
  DI bool next(int i, Unit& u) const {
    const long L = (long)i * G + c; if (L >= nwg) return false;
    int wgid = (int)L; { const int q = nwg / NXCD, r = nwg % NXCD, xcd = wgid % NXCD, off = wgid / NXCD; wgid = (xcd < r ? xcd * (q + 1) : r * (q + 1) + (xcd - r) * q) + off; }
    const int nig = WGM * nN, gid = wgid / nig, fm = gid * WGM, gsz = (nM - fm) < WGM ? (nM - fm) : WGM;
    u.pm = fm + ((wgid % nig) % gsz); u.pn = (wgid % nig) / gsz; return true;
  }
};

template <class Epi>
DI void gemm_phase(LAS unsigned char* lds, const Gemm g, const StaticOrder& S, const Epi& E) {
  const int tid = otid(), wid = __builtin_amdgcn_readfirstlane(tid >> 6), lane = tid & 63, wr = wid >> 2, wc = wid & 3, fr = lane & 15, fq = lane >> 4;
  const int K = g.K, nt = K / BK;
  unsigned voffA[2], voffB[2];
#pragma unroll
  for (int i = 0; i < 2; ++i) { int R, C; stage_rc(tid * 16 + i * 8192, R, C); const int Rb = Epi::PERM ? ((R & ~31) + perm32(R & 31)) : R;
    voffA[i] = (unsigned)(R * K + C) * 2u; voffB[i] = (unsigned)(Rb * K + C) * 2u; }
  const size_t kstep = (size_t)(BK * 2);
  const size_t hstep = (size_t)HALF * K * 2;
  const size_t tstep = 2 * hstep;
  const unsigned ldsw = (unsigned)wid * 1024u;
  const int aoff = lds_byte(wr * 64 + fr, fq * 8), boff = lds_byte(wc * 32 + fr, fq * 8);
#define PG8_SA(b, h) (((b) * 2 + (h)) * HTB)
#define PG8_SB(b, h) ((4 + (b) * 2 + (h)) * HTB)
#define PG8_STAGE(bufoff, gbase, voff) do { _Pragma("unroll") for (int _i = 0; _i < 2; ++_i) \
    __builtin_amdgcn_global_load_lds((const unsigned*)((const char*)(gbase) + (voff)[_i]), (LAS unsigned*)(lds + (bufoff) + ldsw + _i * 8192), 16, 0, 0); } while (0)
#define PG8_LDA(dst, b, h) do { _Pragma("unroll") for (int m = 0; m < 4; ++m) _Pragma("unroll") for (int k = 0; k < 2; ++k) dst[m][k] = *(const LAS bf16x8*)(lds + PG8_SA(b, h) + aoff + m * 2048 + k * 1024); } while (0)
#define PG8_LDB(dst, b, h) do { _Pragma("unroll") for (int n = 0; n < 2; ++n) _Pragma("unroll") for (int k = 0; k < 2; ++k) dst[n][k] = *(const LAS bf16x8*)(lds + PG8_SB(b, h) + boff + n * 2048 + k * 1024); } while (0)
#define PG8_MMA(ai, bj, At, Bt) do { __builtin_amdgcn_s_setprio(1); _Pragma("unroll") for (int m = 0; m < 4; ++m) _Pragma("unroll") for (int n = 0; n < 2; ++n) _Pragma("unroll") for (int k = 0; k < 2; ++k) \
    acc[ai][bj][m][n] = __builtin_amdgcn_mfma_f32_16x16x32_bf16(Bt[n][k], At[m][k], acc[ai][bj][m][n], 0, 0, 0); __builtin_amdgcn_s_setprio(0); } while (0)
#define PG8_WAIT_V(n) asm volatile("s_waitcnt vmcnt(" #n ")" ::: "memory")
#define PG8_WAIT_L(n) asm volatile("s_waitcnt lgkmcnt(" #n ")" ::: "memory")
#define PG8_BAR __builtin_amdgcn_s_barrier()
#define PG8_SCHED __builtin_amdgcn_sched_barrier(0)
  Unit cur, nxt; int ui = 0;
  if (!S.next(0, cur)) return;
  f32x4 acc[2][2][4][2];
#pragma unroll
  for (int a = 0; a < 2; ++a)
#pragma unroll
    for (int b = 0; b < 2; ++b)
#pragma unroll
      for (int m = 0; m < 4; ++m)
#pragma unroll
        for (int n = 0; n < 2; ++n) acc[a][b][m][n] = (f32x4){0.f, 0.f, 0.f, 0.f};
  bf16x8 At[4][2], B0[2][2], B1[2][2];
  const char* cA = (const char*)g.A + (size_t)cur.pm * tstep; const char* cB = (const char*)g.Bt + (size_t)cur.pn * tstep;
  PG8_STAGE(PG8_SB(0, 0), cB, voffB); PG8_STAGE(PG8_SA(0, 0), cA, voffA); PG8_STAGE(PG8_SB(0, 1), cB + hstep, voffB); PG8_STAGE(PG8_SA(0, 1), cA + hstep, voffA);
  if (wr == 1) PG8_BAR;
  PG8_WAIT_V(4); PG8_BAR;
  PG8_STAGE(PG8_SB(1, 0), cB + kstep, voffB); PG8_STAGE(PG8_SA(1, 0), cA + kstep, voffA); PG8_STAGE(PG8_SB(1, 1), cB + hstep + kstep, voffB);
  PG8_WAIT_V(6); PG8_BAR;
  for (;;) {
    const bool has_next = S.next(ui + 1, nxt);
    const char* nA = has_next ? (const char*)g.A + (size_t)nxt.pm * tstep : cA; const char* nB = has_next ? (const char*)g.Bt + (size_t)nxt.pn * tstep : cB;
    for (int t = 0; t < nt; t += 2) {
      const bool last = (t == nt - 2);
      const char* a1 = cA + (size_t)(t + 1) * kstep;
      const char* a2 = last ? nA : cA + (size_t)(t + 2) * kstep; const char* b2 = last ? nB : cB + (size_t)(t + 2) * kstep;
      const char* a3 = a2 + kstep; const char* b3 = b2 + kstep;
      PG8_LDB(B0, 0, 0); PG8_SCHED; PG8_LDA(At, 0, 0); PG8_STAGE(PG8_SA(1, 1), a1 + hstep, voffA);
      PG8_WAIT_L(8); PG8_BAR; PG8_WAIT_L(0); PG8_MMA(0, 0, At, B0); PG8_BAR; PG8_SCHED;
      PG8_LDB(B1, 0, 1); PG8_STAGE(PG8_SB(0, 0), b2, voffB);
      PG8_BAR; PG8_WAIT_L(0); PG8_MMA(0, 1, At, B1); PG8_BAR;
      PG8_LDA(At, 0, 1); PG8_STAGE(PG8_SA(0, 0), a2, voffA);
      PG8_BAR; PG8_WAIT_L(0); PG8_MMA(1, 0, At, B0); PG8_BAR; PG8_SCHED;
      PG8_STAGE(PG8_SB(0, 1), b2 + hstep, voffB);
      PG8_WAIT_V(6); PG8_BAR; PG8_MMA(1, 1, At, B1); PG8_BAR;
      PG8_LDB(B0, 1, 0); PG8_SCHED; PG8_LDA(At, 1, 0); PG8_STAGE(PG8_SA(0, 1), a2 + hstep, voffA);
      PG8_WAIT_L(8); PG8_BAR; PG8_WAIT_L(0); PG8_MMA(0, 0, At, B0); PG8_BAR; PG8_SCHED;
      PG8_LDB(B1, 1, 1); PG8_STAGE(PG8_SB(1, 0), b3, voffB);
      PG8_BAR; PG8_WAIT_L(0); PG8_MMA(0, 1, At, B1); PG8_BAR;
      PG8_LDA(At, 1, 1); PG8_STAGE(PG8_SA(1, 0), a3, voffA);
      PG8_BAR; PG8_WAIT_L(0); PG8_MMA(1, 0, At, B0); PG8_BAR; PG8_SCHED;
      PG8_STAGE(PG8_SB(1, 1), b3 + hstep, voffB);
      PG8_WAIT_V(6); PG8_BAR; PG8_MMA(1, 1, At, B1); PG8_BAR;
    }
    E(acc, cur, wr, wc, fr, fq);
    if (!has_next) break;
#pragma unroll
    for (int a = 0; a < 2; ++a)
#pragma unroll
      for (int b = 0; b < 2; ++b)
#pragma unroll
        for (int m = 0; m < 4; ++m)
#pragma unroll
          for (int n = 0; n < 2; ++n) acc[a][b][m][n] = (f32x4){0.f, 0.f, 0.f, 0.f};
    cur = nxt; cA = nA; cB = nB; ++ui;
  }
  PG8_WAIT_V(0);
  if (wr == 0) PG8_BAR;
  PG8_BAR;
#undef PG8_SA
#undef PG8_SB
#undef PG8_STAGE
#undef PG8_LDA
#undef PG8_LDB
#undef PG8_MMA
#undef PG8_WAIT_V
#undef PG8_WAIT_L
#undef PG8_BAR
#undef PG8_SCHED
}
}

struct EpiProj {
  static constexpr bool PERM = true;
  char* ws; const float* b_merge;
  DI void operator()(const f32x4 (&acc)[2][2][4][2], const pg8::Unit& u, int wr, int wc, int fr, int fq) const {
    const float* rope = (const float*)(ws + OFF_ROPE);
    const int row0 = u.pm * 256 + wr * 64 + fr;
#pragma unroll
    for (int bj = 0; bj < 2; ++bj) {
      const int cg = u.pn * 256 + bj * 128 + wc * 32;
      const int c0 = cg + 8 * fq;
      if (cg >= 4384) continue;
      if (cg < 1280 && (cg < 640 || (cg >= 768 && cg < 896) || (cg >= 1024 && cg < 1152))) {
        bf16_t* dst; unsigned ld, cofs; float scale = 1.0f;
        if (cg < 512) { dst = (bf16_t*)(ws + OFF_Q); ld = 512; cofs = c0; scale = 0.18033688011112042f; }
        else if (cg < 640) { dst = (bf16_t*)(ws + OFF_KC); ld = 128; cofs = c0 - 512; }
        else if (cg < 896) { dst = (bf16_t*)(ws + OFF_KS); ld = 128; cofs = c0 - 768; }
        else { dst = (bf16_t*)(ws + OFF_KW); ld = 128; cofs = c0 - 1024; }
        const int d0 = 16 * ((cg >> 5) & 1) + 4 * fq;
#pragma unroll
        for (int ai = 0; ai < 2; ++ai)
#pragma unroll
          for (int m = 0; m < 4; ++m) {
            const int row = row0 + ai * 128 + m * 16, pos = row & (SEQ - 1);
            const f32x4 cs = *(const f32x4*)(rope + pos * 32 + d0), sn = *(const f32x4*)(rope + 262144 + pos * 32 + d0);
            const f32x4 t1 = acc[ai][bj][m][0], t2 = acc[ai][bj][m][1];
            const f32x4 o1 = (t1 * cs - t2 * sn) * scale, o2 = (t1 * sn + t2 * cs) * scale;
            u32x4 w; w.x = pack2(o1.x, o1.y); w.y = pack2(o1.z, o1.w); w.z = pack2(o2.x, o2.y); w.w = pack2(o2.z, o2.w);
            *(u32x4*)(dst + (unsigned)row * ld + cofs) = w;
          }
      } else if (cg < 1280) {
        bf16_t* dst; unsigned cofs;
        if (cg < 768) { dst = (bf16_t*)(ws + OFF_VC); cofs = c0 - 640; }
        else if (cg < 1024) { dst = (bf16_t*)(ws + OFF_VS); cofs = c0 - 896; }
        else { dst = (bf16_t*)(ws + OFF_VW); cofs = c0 - 1152; }
#pragma unroll
        for (int ai = 0; ai < 2; ++ai)
#pragma unroll
          for (int m = 0; m < 4; ++m) {
            const int row = row0 + ai * 128 + m * 16;
            const f32x4 a = acc[ai][bj][m][0], b = acc[ai][bj][m][1];
            u32x4 w; w.x = pack2(a.x, a.y); w.y = pack2(a.z, a.w); w.z = pack2(b.x, b.y); w.w = pack2(b.z, b.w);
            *(u32x4*)(dst + (unsigned)row * 128u + cofs) = w;
          }
      } else if (cg < 2304) {
        bf16_t* dst = (bf16_t*)(ws + (cg < 1792 ? OFF_U : OFF_V));
        const unsigned cofs = c0 - (cg < 1792 ? 1280 : 1792);
#pragma unroll
        for (int ai = 0; ai < 2; ++ai)
#pragma unroll
          for (int m = 0; m < 4; ++m) {
            const int row = row0 + ai * 128 + m * 16;
            const f32x4 a = acc[ai][bj][m][0], b = acc[ai][bj][m][1];
            const f32x2 g0 = gelu_pk((f32x2){a.x, a.y}), g1 = gelu_pk((f32x2){a.z, a.w}), g2 = gelu_pk((f32x2){b.x, b.y}), g3 = gelu_pk((f32x2){b.z, b.w});
            u32x4 w; w.x = pack2(g0.x, g0.y); w.y = pack2(g1.x, g1.y); w.z = pack2(g2.x, g2.y); w.w = pack2(g3.x, g3.y);
            *(u32x4*)(dst + (unsigned)row * 512u + cofs) = w;
          }
      } else if (cg < 4352) {
        bf16_t* dst = (bf16_t*)(ws + OFF_GATE);
        const unsigned cofs = c0 - 2304;
        const f32x4 b0 = *(const f32x4*)(b_merge + cofs), b1 = *(const f32x4*)(b_merge + cofs + 4);
#pragma unroll
        for (int ai = 0; ai < 2; ++ai)
#pragma unroll
          for (int m = 0; m < 4; ++m) {
            const int row = row0 + ai * 128 + m * 16;
            const f32x4 a = acc[ai][bj][m][0] + b0, b = acc[ai][bj][m][1] + b1;
            u32x4 w; w.x = pack2(sigmoid_f(a.x), sigmoid_f(a.y)); w.y = pack2(sigmoid_f(a.z), sigmoid_f(a.w));
            w.z = pack2(sigmoid_f(b.x), sigmoid_f(b.y)); w.w = pack2(sigmoid_f(b.z), sigmoid_f(b.w));
            *(u32x4*)(dst + (unsigned)row * 2048u + cofs) = w;
          }
      } else {
        float* gs = (float*)(ws + OFF_GSIG);
        if (fq < 3) {
#pragma unroll
          for (int ai = 0; ai < 2; ++ai)
#pragma unroll
            for (int m = 0; m < 4; ++m) {
              const int row = row0 + ai * 128 + m * 16;
              const f32x4 a = acc[ai][bj][m][0], b = acc[ai][bj][m][1];
              f32x4 o0, o1; o0.x = sigmoid_f(a.x); o0.y = sigmoid_f(a.y); o0.z = sigmoid_f(a.z); o0.w = sigmoid_f(a.w);
              o1.x = sigmoid_f(b.x); o1.y = sigmoid_f(b.y); o1.z = sigmoid_f(b.z); o1.w = sigmoid_f(b.w);
              *(f32x4*)(gs + (unsigned)row * 32u + 8 * fq) = o0; *(f32x4*)(gs + (unsigned)row * 32u + 8 * fq + 4) = o1;
            }
        }
      }
    }
  }
};
DI void phase_gemm1(const Params& p, char* smem) {
  pg8::Gemm g{(const bf16_t*)(p.ws + OFF_H), (const bf16_t*)(p.ws + OFF_WT1), NTOK, N1, 1024};
  pg8::StaticOrder S; S.init(NTOK, N1, gridDim.x, blockIdx.x);
  EpiProj E{p.ws, p.b_merge};
  pg8::gemm_phase((LAS unsigned char*)smem, g, S, E);
}

template <int BR> struct EpiMerge {
  static constexpr bool PERM = true;
  char* ws;
  DI void operator()(const f32x4 (&acc)[2][2][4][2], const pg8::Unit& u, int wr, int wc, int fr, int fq) const {
    const bf16_t* gate = (const bf16_t*)(ws + OFF_GATE);
    bf16_t* merged = (bf16_t*)(ws + OFF_H);
    const int row0 = u.pm * 256 + wr * 64 + fr;
#pragma unroll
    for (int bj = 0; bj < 2; ++bj) {
      const unsigned c0 = u.pn * 256 + bj * 128 + wc * 32 + 8 * fq;
#pragma unroll
      for (int ai = 0; ai < 2; ++ai)
#pragma unroll
        for (int m = 0; m < 4; ++m) {
          const unsigned row = row0 + ai * 128 + m * 16;
          float gg[8]; unpack8(*(const u32x4*)(gate + row * 2048u + BR * 1024 + c0), gg);
          const f32x4 a = acc[ai][bj][m][0], b = acc[ai][bj][m][1];
          float v[8] = {a.x * gg[0], a.y * gg[1], a.z * gg[2], a.w * gg[3], b.x * gg[4], b.y * gg[5], b.z * gg[6], b.w * gg[7]};
          bf16_t* mp = merged + row * 1024u + c0;
          if (BR == 1) {
            float old[8]; unpack8(*(const u32x4*)mp, old);
#pragma unroll
            for (int j = 0; j < 8; ++j) v[j] += old[j];
          }
          *(u32x4*)mp = pack8(v);
        }
    }
  }
};
DI void phase_merge(const Params& p, char* smem) {
  pg8::StaticOrder S; S.init(NTOK, 1024, gridDim.x, blockIdx.x);
  {
    pg8::Gemm g{(const bf16_t*)(p.ws + OFF_ONSA), (const bf16_t*)(p.ws + OFF_WB), NTOK, 1024, 512};
    EpiMerge<0> E{p.ws};
    pg8::gemm_phase((LAS unsigned char*)smem, g, S, E);
  }
  {
    pg8::Gemm g{(const bf16_t*)(p.ws + OFF_U), (const bf16_t*)(p.ws + OFF_WB) + (size_t)1024 * 512, NTOK, 1024, 512};
    EpiMerge<1> E{p.ws};
    pg8::gemm_phase((LAS unsigned char*)smem, g, S, E);
  }
}

struct EpiOut {
  static constexpr bool PERM = true;
  char* ws; const float* x;
  DI void operator()(const f32x4 (&acc)[2][2][4][2], const pg8::Unit& u, int wr, int wc, int fr, int fq) const {
    const float* mod = (const float*)(ws + OFF_MOD);
    bf16_t* y = (bf16_t*)(ws + OFF_Y);
    const int row0 = u.pm * 256 + wr * 64 + fr, b = (u.pm * 256) >> 13;
#pragma unroll
    for (int bj = 0; bj < 2; ++bj) {
      const unsigned c0 = u.pn * 256 + bj * 128 + wc * 32 + 8 * fq;
      const f32x4 g0 = *(const f32x4*)(mod + b * 6144 + 2048 + c0), g1 = *(const f32x4*)(mod + b * 6144 + 2048 + c0 + 4);
#pragma unroll
      for (int ai = 0; ai < 2; ++ai)
#pragma unroll
        for (int m = 0; m < 4; ++m) {
          const unsigned o = (unsigned)(row0 + ai * 128 + m * 16) * 1024u + c0;
          const f32x4 x0 = *(const f32x4*)(x + o), x1v = *(const f32x4*)(x + o + 4);
          const f32x4 v0 = x0 * DN_ALPHA + g0 * acc[ai][bj][m][0], v1 = x1v * DN_ALPHA + g1 * acc[ai][bj][m][1];
          u32x4 w; w.x = pack2(v0.x, v0.y); w.y = pack2(v0.z, v0.w); w.z = pack2(v1.x, v1.y); w.w = pack2(v1.z, v1.w);
          *(u32x4*)(y + o) = w;
        }
    }
  }
};
DI void phase_outproj(const Params& p, char* smem) {
  pg8::Gemm g{(const bf16_t*)(p.ws + OFF_H), (const bf16_t*)(p.ws + OFF_WOUT), NTOK, 1024, 1024};
  pg8::StaticOrder S; S.init(NTOK, 1024, gridDim.x, blockIdx.x);
  EpiOut E{p.ws, p.x};
  pg8::gemm_phase((LAS unsigned char*)smem, g, S, E);
}

struct EpiPq {
  static constexpr bool PERM = true;
  char* ws;
  DI void operator()(const f32x4 (&acc)[2][2][4][2], const pg8::Unit& u, int wr, int wc, int fr, int fq) const {
    bf16_t* pq = (bf16_t*)(ws + OFF_PQ);
    const int row0 = u.pm * 256 + wr * 64 + fr;
#pragma unroll
    for (int bj = 0; bj < 2; ++bj) {
      const unsigned c0 = u.pn * 256 + bj * 128 + wc * 32 + 8 * fq;
#pragma unroll
      for (int ai = 0; ai < 2; ++ai)
#pragma unroll
        for (int m = 0; m < 4; ++m) {
          const f32x4 a = acc[ai][bj][m][0], b = acc[ai][bj][m][1];
          u32x4 w; w.x = pack2(a.x, a.y); w.y = pack2(a.z, a.w); w.z = pack2(b.x, b.y); w.w = pack2(b.z, b.w);
          *(u32x4*)(pq + (unsigned)(row0 + ai * 128 + m * 16) * 2048u + c0) = w;
        }
    }
  }
};
DI void phase_peerq(const Params& p, char* smem) {
  pg8::Gemm g{(const bf16_t*)(p.ws + OFF_H), (const bf16_t*)(p.ws + OFF_WQ), NTOK, 2048, 1024};
  pg8::StaticOrder S; S.init(NTOK, 2048, gridDim.x, blockIdx.x);
  EpiPq E{p.ws};
  pg8::gemm_phase((LAS unsigned char*)smem, g, S, E);
}

DI void phase_sgu(const Params& p, char* smem) {
  char* ws = p.ws;
  const int tid = otid(), lane = tid & 63, wave = tid >> 6, l31 = lane & 31, hh = lane >> 5;
  bf16_t* u = (bf16_t*)(ws + OFF_U);
  const bf16_t* v = (const bf16_t*)(ws + OFF_V);
  const bf16_t* W = (const bf16_t*)(ws + OFF_SGUW);
  float* st = (float*)smem;
  bf16_t* vn = (bf16_t*)(smem + 1024);
  constexpr int LN_ = 72;
  const int dt = wave & 1, it = wave >> 1;
  const int gi = lane >> 4, i16 = lane & 15, tq = i16 >> 2, tp = i16 & 3;
  for (int item = blockIdx.x; item < NTOK / 128; item += gridDim.x) {
    const int t0 = item * 128;
    __syncthreads();
    for (int i = 0; i < 16; ++i) {
      const int t = wave * 16 + i;
      const u32x4 raw = *(const u32x4*)(v + (size_t)(t0 + t) * 512 + lane * 8);
      float f[8]; unpack8(raw, f);
      float s = 0.f;
#pragma unroll
      for (int j = 0; j < 8; ++j) s += f[j];
      const float mean = wave_sum(s) * (1.f / 512.f);
      float q = 0.f;
#pragma unroll
      for (int j = 0; j < 8; ++j) { const float d = f[j] - mean; q += d * d; }
      const float rstd = rsqrtf(wave_sum(q) * (1.f / 512.f) + LN_EPS);
      if (lane == 0) { st[t * 2] = mean; st[t * 2 + 1] = rstd; }
    }
    u32x4 vnext[2];
#pragma unroll
    for (int i = 0; i < 2; ++i) { const int idx = tid + i * NT; vnext[i] = *(const u32x4*)(v + (size_t)(t0 + (idx >> 3)) * 512 + (idx & 7) * 8); }
    for (int g = 0; g < 8; ++g) {
      u32x4 vcur[2] = {vnext[0], vnext[1]};
      if (g + 1 < 8) {
#pragma unroll
        for (int i = 0; i < 2; ++i) { const int idx = tid + i * NT; vnext[i] = *(const u32x4*)(v + (size_t)(t0 + (idx >> 3)) * 512 + (g + 1) * 64 + (idx & 7) * 8); }
      }
      u32x2 uold[4];
      {
        const bf16_t* urow0 = u + (size_t)(t0 + it * 32 + l31) * 512 + g * 64 + dt * 32 + 4 * hh;
#pragma unroll
        for (int q4 = 0; q4 < 4; ++q4) uold[q4] = *(const u32x2*)(urow0 + 8 * q4);
      }
      lds_barrier();
#pragma unroll
      for (int i = 0; i < 2; ++i) {
        const int idx = tid + i * NT, j = idx >> 3, dc = (idx & 7) * 8;
        const u32x4 raw = vcur[i];
        const float mean = st[j * 2], rstd = st[j * 2 + 1];
        float f[8], gg[8], bb[8]; unpack8(raw, f); ld8(p.sgu_ln_g + g * 64 + dc, gg); ld8(p.sgu_ln_b + g * 64 + dc, bb);
#pragma unroll
        for (int k = 0; k < 8; ++k) f[k] = (f[k] - mean) * rstd * gg[k] + bb[k];
        *(u32x4*)(vn + j * LN_ + dc) = pack8(f);
      }
      lds_barrier();
      f32x16 acc;
#pragma unroll
      for (int r = 0; r < 16; ++r) acc[r] = 0.f;
      const bf16_t* wrow = W + ((size_t)g * 128 + it * 32 + l31) * 128 + hh * 8;
      const LAS bf16_t* vbase = (const LAS bf16_t*)vn + (8 * (gi >> 1) + tq) * LN_ + dt * 32 + 16 * (gi & 1) + 4 * tp;
#pragma unroll
      for (int ks = 0; ks < 8; ++ks) {
        if (ks <= 2 * it + 1) {
          const LAS bf16_t* vp = vbase + (ks * 16) * LN_;
          const s16x4 lo = __builtin_amdgcn_ds_read_tr16_b64_v4i16((LAS s16x4*)vp);
          const s16x4 hi = __builtin_amdgcn_ds_read_tr16_b64_v4i16((LAS s16x4*)(vp + 4 * LN_));
          const bf16x8 bw = *(const bf16x8*)(wrow + ks * 16);
          acc = MFMA32(__builtin_shufflevector(lo, hi, 0, 1, 2, 3, 4, 5, 6, 7), bw, acc);
        }
      }
      const int i = it * 32 + l31;
      const float bsv = p.sgu_b[g * 128 + i];
      bf16_t* urow = u + (size_t)(t0 + i) * 512 + g * 64 + dt * 32 + 4 * hh;
#pragma unroll
      for (int q4 = 0; q4 < 4; ++q4) {
        u32x2* up = (u32x2*)(urow + 8 * q4);
        const u32x2 old = uold[q4];
        u32x2 wv; wv.x = pack2(bflo(old.x) * (acc[4 * q4] + bsv), bfhi(old.x) * (acc[4 * q4 + 1] + bsv));
        wv.y = pack2(bflo(old.y) * (acc[4 * q4 + 2] + bsv), bfhi(old.y) * (acc[4 * q4 + 3] + bsv));
        *up = wv;
      }
    }
  }
}

DI void phase_compress(const Params& p, char* smem) {
  char* ws = p.ws;
  const int tid = otid(), lane = tid & 63, wave = tid >> 6, l31 = lane & 31, hh = lane >> 5;
  bf16_t* hid = (bf16_t*)smem;
  constexpr int LH = 136;
  for (int item = blockIdx.x; item < 128; item += gridDim.x) {
    const int w = item >> 6, R0 = (item & 63) * 128;
    const bf16_t* src = (const bf16_t*)(ws + (w == 0 ? OFF_KC : OFF_VC));
    const bf16_t* W1 = (const bf16_t*)(ws + OFF_CW1) + (size_t)w * 128 * 2048;
    const bf16_t* W2 = (const bf16_t*)(ws + OFF_CW2) + (size_t)w * 64 * 128;
    const float* posb = (const float*)(ws + OFF_POSB) + w * 128;
    const int rg = wave >> 2, cgp = wave & 3;
    const bf16_t* abase[2];
#pragma unroll
    for (int mi = 0; mi < 2; ++mi) {
      const int R = R0 + rg * 64 + mi * 32 + l31, bg = R >> 9, n = R & 511, nn = n < 510 ? n : 510;
      abase[mi] = src + ((size_t)((bg >> 1) * SEQ + 16 * nn)) * 128 + (bg & 1) * 64 + hh * 8;
    }
    const bf16_t* bbase = W1 + (size_t)(cgp * 32 + l31) * 2048 + hh * 8;
    f32x16 acc[2];
#pragma unroll
    for (int r = 0; r < 16; ++r) { acc[0][r] = 0.f; acc[1][r] = 0.f; }
#pragma unroll 8
    for (int ks = 0; ks < 128; ++ks) {
      const int aofs = (ks >> 2) * 128 + (ks & 3) * 16;
      const bf16x8 a0 = *(const bf16x8*)(abase[0] + aofs), a1 = *(const bf16x8*)(abase[1] + aofs);
      const bf16x8 bb = *(const bf16x8*)(bbase + ks * 16);
      acc[0] = MFMA32(a0, bb, acc[0]); acc[1] = MFMA32(a1, bb, acc[1]);
    }
    __syncthreads();
    {
      const float pb = posb[cgp * 32 + l31];
#pragma unroll
      for (int mi = 0; mi < 2; ++mi)
#pragma unroll
        for (int r = 0; r < 16; ++r) {
          const int row = rg * 64 + mi * 32 + (r & 3) + 8 * (r >> 2) + 4 * hh;
          hid[row * LH + cgp * 32 + l31] = f2bf(gelu_f(acc[mi][r] + pb));
        }
    }
    __syncthreads();
    const int mi2 = wave >> 1, ni = wave & 1;
    f32x16 o;
#pragma unroll
    for (int r = 0; r < 16; ++r) o[r] = 0.f;
#pragma unroll
    for (int ks = 0; ks < 8; ++ks) {
      const bf16x8 a = *(const bf16x8*)(hid + (mi2 * 32 + l31) * LH + ks * 16 + hh * 8);
      const bf16x8 bb = *(const bf16x8*)(W2 + (size_t)(ni * 32 + l31) * 128 + ks * 16 + hh * 8);
      o = MFMA32(a, bb, o);
    }
    const int d = ni * 32 + l31;
    const float b2 = p.cmp_b2[w * 64 + (w == 0 ? dperm(d) : d)];
    const int bg = R0 >> 9;
    bf16_t* dst = (bf16_t*)(ws + (w == 0 ? OFF_KCMP : OFF_VCMP));
#pragma unroll
    for (int r = 0; r < 16; ++r) {
      const int n = (R0 & 511) + mi2 * 32 + (r & 3) + 8 * (r >> 2) + 4 * hh;
      dst[((size_t)bg * 512 + n) * 64 + d] = f2bf(n < 511 ? o[r] + b2 : 0.f);
    }
  }
}

constexpr int LK = 72;
constexpr int NSA_TILE = 18432;
constexpr int NSA_AIMP = 3 * NSA_TILE, NSA_CIMP = NSA_AIMP + 32768, NSA_SELM = NSA_CIMP + 32768;
constexpr float NSA_THR = 6.0f;
struct TileRegs { u32x4 k; u32x4 v; };

DI void nsa_load_tile(TileRegs& t, const bf16_t* kbase, size_t kstride, const bf16_t* vbase, size_t vstride) {
  const int tid = otid(), r = tid >> 3, ch = tid & 7;
  t.k = *(const u32x4*)(kbase + (size_t)r * kstride + ch * 8);
  t.v = *(const u32x4*)(vbase + (size_t)r * vstride + ch * 8);
}
DI void nsa_store_tile(const TileRegs& t, char* tile) {
  const int tid = otid(), r = tid >> 3, ch = tid & 7;
  *(u32x4*)((bf16_t*)tile + r * LK + ch * 8) = t.k;
  *(u32x4*)((bf16_t*)(tile + 9216) + r * LK + ch * 8) = t.v;
}
DI void nsa_scores(f32x16 (&st)[2], const char* tile, const bf16x8 (&qf)[4], int lane) {
  const bf16_t* Ks = (const bf16_t*)tile;
#pragma unroll
  for (int kt = 0; kt < 2; ++kt)
#pragma unroll
    for (int r = 0; r < 16; ++r) st[kt][r] = 0.f;
  __builtin_amdgcn_s_setprio(1);
#pragma unroll
  for (int ks = 0; ks < 4; ++ks)
#pragma unroll
    for (int kt = 0; kt < 2; ++kt) {
      const bf16x8 a = *(const bf16x8*)(Ks + (kt * 32 + (lane & 31)) * LK + ks * 16 + (lane >> 5) * 8);
      st[kt] = MFMA32(a, qf[ks], st[kt]);
    }
  __builtin_amdgcn_s_setprio(0);
}
DI void nsa_pv(f32x16 (&o)[2], const f32x16 (&pt)[2], const char* tile, int lane) {
  const int gi = lane >> 4, i16 = lane & 15, q = i16 >> 2, pp = i16 & 3;
  const LAS bf16_t* Vs = (const LAS bf16_t*)(tile + 9216) + (4 * (gi >> 1) + q) * LK + 16 * (gi & 1) + 4 * pp;
#pragma unroll
  for (int kt = 0; kt < 2; ++kt)
#pragma unroll
    for (int s = 0; s < 2; ++s) {
      u32x4 pk; pk.x = pack2(pt[kt][8 * s], pt[kt][8 * s + 1]); pk.y = pack2(pt[kt][8 * s + 2], pt[kt][8 * s + 3]);
      pk.z = pack2(pt[kt][8 * s + 4], pt[kt][8 * s + 5]); pk.w = pack2(pt[kt][8 * s + 6], pt[kt][8 * s + 7]);
      const bf16x8 pb = __builtin_bit_cast(bf16x8, pk);
      bf16x8 a[2];
#pragma unroll
      for (int dt = 0; dt < 2; ++dt) {
        const LAS bf16_t* vp = Vs + (kt * 32 + 16 * s) * LK + dt * 32;
        const s16x4 lo = __builtin_amdgcn_ds_read_tr16_b64_v4i16((LAS s16x4*)vp);
        const s16x4 hi = __builtin_amdgcn_ds_read_tr16_b64_v4i16((LAS s16x4*)(vp + 8 * LK));
        a[dt] = __builtin_shufflevector(lo, hi, 0, 1, 2, 3, 4, 5, 6, 7);
      }
      o[0] = MFMA32(a[0], pb, o[0]); o[1] = MFMA32(a[1], pb, o[1]);
    }
}

constexpr float NSA_NEG = -3.0e38f;
DI void nsa_online(f32x16 (&st)[2], bool sel, float& m, float& l, f32x16 (&o)[2], const char* tile, int lane) {
  float mx = NSA_NEG;
#pragma unroll
  for (int r = 0; r < 16; ++r) mx = fmaxf(mx, fmaxf(st[0][r], st[1][r]));
  mx = fmaxf(mx, __shfl_xor(mx, 32));
  mx = sel ? mx : NSA_NEG;
  if (__any(mx > m + NSA_THR)) {
    const float mn = fmaxf(m, mx);
    const float alpha = __builtin_amdgcn_exp2f(m - mn);
    m = mn; l *= alpha;
#pragma unroll
    for (int r = 0; r < 16; ++r) { o[0][r] *= alpha; o[1][r] *= alpha; }
  }
  const float ms = sel ? m : 1e30f;
  float sum = 0.f;
#pragma unroll
  for (int r = 0; r < 16; ++r) {
    const float p0 = __builtin_amdgcn_exp2f(st[0][r] - ms), p1 = __builtin_amdgcn_exp2f(st[1][r] - ms);
    st[0][r] = p0; st[1][r] = p1; sum += p0 + p1;
  }
  l += sum;
  nsa_pv(o, st, tile, lane);
}

struct NsaItem { int qb, b, g, bg, t; size_t tokrow; };
DI NsaItem nsa_item(int item0, int wave, int qi) {
  const int G = gridDim.x, k = item0 / G, bb = item0 - k * G;
  const int item = (k & 1) ? (k * G + (G - 1 - bb)) : item0;
  NsaItem it; it.qb = 127 - (item >> 4); const int rest = item & 15; it.b = rest >> 1; it.g = rest & 1;
  it.bg = it.b * 2 + it.g; it.t = it.qb * 64 + wave * 8 + qi; it.tokrow = (size_t)it.b * SEQ + it.t; return it;
}
DI void nsa_accum_store(bf16_t* dst, const f32x16 (&o)[2], float sc, bool first, int hh) {
#pragma unroll
  for (int dt = 0; dt < 2; ++dt)
#pragma unroll
    for (int q4 = 0; q4 < 4; ++q4) {
      u32x2* pp = (u32x2*)(dst + dt * 32 + 8 * q4 + 4 * hh);
      float a0 = sc * o[dt][4 * q4], a1 = sc * o[dt][4 * q4 + 1], a2 = sc * o[dt][4 * q4 + 2], a3 = sc * o[dt][4 * q4 + 3];
      if (!first) { const u32x2 old = *pp; a0 += bflo(old.x); a1 += bfhi(old.x); a2 += bflo(old.y); a3 += bfhi(old.y); }
      u32x2 wv; wv.x = pack2(a0, a1); wv.y = pack2(a2, a3);
      *pp = wv;
    }
}

constexpr int NSA_STAGE = 4 * 18432;
typedef float f32x4v __attribute__((ext_vector_type(4)));
#define MFMA16(a, b, c) __builtin_amdgcn_mfma_f32_16x16x32_bf16((a), (b), (c), 0, 0, 0)
struct StageRegs { u32x4 r[8]; };
DI void nsa_load_stage(StageRegs& sr, const bf16_t* kb, const bf16_t* vb, int j0s, int qb) {
  const int tid = otid(), r = tid >> 3, ch = tid & 7;
#pragma unroll
  for (int tt = 0; tt < 4; ++tt) {
    const int j = (j0s + tt <= qb) ? j0s + tt : qb;
    sr.r[2 * tt] = *(const u32x4*)(kb + ((size_t)j * 64 + r) * 128 + ch * 8);
    sr.r[2 * tt + 1] = *(const u32x4*)(vb + ((size_t)j * 64 + r) * 128 + ch * 8);
  }
}
DI void nsa_store_stage(const StageRegs& sr, char* stage) {
  const int tid = otid(), r = tid >> 3, ch = tid & 7;
#pragma unroll
  for (int tt = 0; tt < 4; ++tt) {
    *(u32x4*)((bf16_t*)(stage + tt * 18432) + r * LK + ch * 8) = sr.r[2 * tt];
    *(u32x4*)((bf16_t*)(stage + tt * 18432 + 9216) + r * LK + ch * 8) = sr.r[2 * tt + 1];
  }
}
struct Sel16 { float m, l; bool has; f32x4v o[4]; };
DI void nsa_unit16(Sel16& g, const char* tile, const bf16x8 (&qf)[2], bool sel, int klim  , int lane) {
  const int c16 = lane & 15, kg = lane >> 4, tq = c16 >> 2, tp = c16 & 3;
  const bf16_t* Ks = (const bf16_t*)tile + c16 * LK + kg * 8;
  f32x4v st[4];
  const float ini = sel ? -g.m : -1e30f;
#pragma unroll
  for (int kt = 0; kt < 4; ++kt) {
    st[kt] = (f32x4v){ini, ini, ini, ini};
#pragma unroll
    for (int ks = 0; ks < 2; ++ks) st[kt] = MFMA16(*(const bf16x8*)(Ks + kt * 16 * LK + ks * 32), qf[ks], st[kt]);
  }
  if (klim < 64) {
#pragma unroll
    for (int kt = 0; kt < 4; ++kt)
#pragma unroll
      for (int r = 0; r < 4; ++r) st[kt][r] = (kt * 16 + 4 * kg + r <= klim) ? st[kt][r] : NSA_NEG;
  }
  float mx = fmaxf(fmaxf(fmaxf(st[0][0], st[0][1]), fmaxf(st[0][2], st[0][3])), fmaxf(fmaxf(st[1][0], st[1][1]), fmaxf(st[1][2], st[1][3])));
  mx = fmaxf(mx, fmaxf(fmaxf(fmaxf(st[2][0], st[2][1]), fmaxf(st[2][2], st[2][3])), fmaxf(fmaxf(st[3][0], st[3][1]), fmaxf(st[3][2], st[3][3]))));
  mx = fmaxf(mx, __shfl_xor(mx, 16));
  mx = fmaxf(mx, __shfl_xor(mx, 32));
  const bool real = mx > -1e29f;
  const bool fresh = !g.has && real, up = g.has && (mx > NSA_THR);
  if (__any(fresh || up)) {
    const float delta = (fresh || up) ? mx : 0.f;
    const float alpha = up ? __builtin_amdgcn_exp2f(-delta) : 1.0f;
    g.m += delta; g.l *= alpha;
#pragma unroll
    for (int dt = 0; dt < 4; ++dt) g.o[dt] *= alpha;
#pragma unroll
    for (int kt = 0; kt < 4; ++kt) st[kt] -= delta;
  }
  g.has = g.has || real;
  float sum = 0.f;
#pragma unroll
  for (int kt = 0; kt < 4; ++kt)
#pragma unroll
    for (int r = 0; r < 4; ++r) { const float pv = __builtin_amdgcn_exp2f(st[kt][r]); st[kt][r] = pv; sum += pv; }
  g.l += sum;
  const LAS bf16_t* Vs = (const LAS bf16_t*)(tile + 9216) + (4 * kg + tq) * LK + 4 * tp;
#pragma unroll
  for (int kp = 0; kp < 2; ++kp) {
    u32x4 pk; pk.x = pack2(st[2 * kp][0], st[2 * kp][1]); pk.y = pack2(st[2 * kp][2], st[2 * kp][3]);
    pk.z = pack2(st[2 * kp + 1][0], st[2 * kp + 1][1]); pk.w = pack2(st[2 * kp + 1][2], st[2 * kp + 1][3]);
    const bf16x8 pb = __builtin_bit_cast(bf16x8, pk);
#pragma unroll
    for (int dt = 0; dt < 4; ++dt) {
      const LAS bf16_t* vp = Vs + (2 * kp) * 16 * LK + dt * 16;
      const s16x4 lo = __builtin_amdgcn_ds_read_tr16_b64_v4i16((LAS s16x4*)vp);
      const s16x4 hi = __builtin_amdgcn_ds_read_tr16_b64_v4i16((LAS s16x4*)(vp + 16 * LK));
      g.o[dt] = MFMA16(__builtin_shufflevector(lo, hi, 0, 1, 2, 3, 4, 5, 6, 7), pb, g.o[dt]);
    }
  }
}
DI void nsa_sel16(const Params& p, char* smem, bool dry) {
  char* ws = p.ws;
  const int tid = otid(), lane = tid & 63, wave = tid >> 6, c16 = lane & 15, kg = lane >> 4, qi4 = c16 >> 2, r4 = c16 & 3;
  const bf16_t* Q = (const bf16_t*)(ws + OFF_Q);
  const float* gsig = (const float*)(ws + OFF_GSIG);
  bf16_t* ONSA = (bf16_t*)(ws + OFF_ONSA);
  const u32x4* SELG = (const u32x4*)(ws + OFF_SELG);
  const bf16_t* KS = (const bf16_t*)(ws + OFF_KS); const bf16_t* VS = (const bf16_t*)(ws + OFF_VS);
  constexpr int NITEM = NB * 2 * 128;
  for (int item = blockIdx.x; item < NITEM; item += gridDim.x) {
    const NsaItem it = nsa_item(item, wave, 0);
    const int qb = it.qb;
    bf16x8 qf[2][2]; u32x4 selw[2]; float g_s[2]; int tg[2]; Sel16 G[2];
#pragma unroll
    for (int gq = 0; gq < 2; ++gq) {
      tg[gq] = it.t + 4 * gq + qi4;
      const size_t tokrow = (size_t)it.b * SEQ + tg[gq];
#pragma unroll
      for (int ks = 0; ks < 2; ++ks) qf[gq][ks] = *(const bf16x8*)(Q + tokrow * 512 + (it.g * 4 + r4) * 64 + ks * 32 + kg * 8);
      selw[gq] = SELG[(size_t)it.bg * SEQ + tg[gq]];
      g_s[gq] = gsig[tokrow * 32 + (it.g * 4 + r4) * 3 + 1];
      G[gq].m = 0.f; G[gq].l = 0.f; G[gq].has = false;
#pragma unroll
      for (int dt = 0; dt < 4; ++dt) G[gq].o[dt] = (f32x4v){0.f, 0.f, 0.f, 0.f};
    }
    const bf16_t* kb = KS + (size_t)it.b * SEQ * 128 + it.g * 64;
    const bf16_t* vb = VS + (size_t)it.b * SEQ * 128 + it.g * 64;
    const int nst = (qb >> 2) + 1;
    StageRegs sr;
    lds_barrier();
    nsa_load_stage(sr, kb, vb, 0, qb);
    nsa_store_stage(sr, smem);
    lds_barrier();
    for (int sidx = 0; sidx < nst; ++sidx) {
      const char* stage = smem + (sidx & 1) * NSA_STAGE;
      if (sidx + 1 < nst) nsa_load_stage(sr, kb, vb, 4 * (sidx + 1), qb);
#pragma unroll 1
      for (int tt = 0; tt < 4; ++tt) {
        const int j = 4 * sidx + tt;
        if (j > qb) break;
#pragma unroll
        for (int gq = 0; gq < 2; ++gq) {
          const unsigned w = j < 32 ? selw[gq].x : (j < 64 ? selw[gq].y : (j < 96 ? selw[gq].z : selw[gq].w));
          const bool sel = (w >> (j & 31)) & 1u;
          if (__any(sel)) nsa_unit16(G[gq], stage + tt * 18432, qf[gq], sel, (j == qb) ? (tg[gq] - j * 64) : 1000, lane);
        }
      }
      if (sidx + 1 < nst) nsa_store_stage(sr, smem + ((sidx + 1) & 1) * NSA_STAGE);
      lds_barrier();
    }
#pragma unroll
    for (int gq = 0; gq < 2; ++gq) {
      float l = G[gq].l;
      l += __shfl_xor(l, 16); l += __shfl_xor(l, 32);
      const float sc = l > 0.f ? g_s[gq] / l : 0.f;
      bf16_t* dst = ONSA + ((size_t)it.b * SEQ + tg[gq]) * 512 + (it.g * 4 + r4) * 64 + 4 * kg;
      if (!dry) {
#pragma unroll
        for (int dt = 0; dt < 4; ++dt) {
          u32x2* pp = (u32x2*)(dst + dt * 16);
          const u32x2 old = *pp;
          u32x2 wv; wv.x = pack2(bflo(old.x) + sc * G[gq].o[dt][0], bfhi(old.x) + sc * G[gq].o[dt][1]);
          wv.y = pack2(bflo(old.y) + sc * G[gq].o[dt][2], bfhi(old.y) + sc * G[gq].o[dt][3]);
          *pp = wv;
        }
      } else asm volatile("" :: "v"(G[gq].o[0]), "v"(G[gq].o[1]), "v"(G[gq].o[2]), "v"(G[gq].o[3]), "v"(l));
    }
  }
}

DI void phase_nsa(const Params& p, char* smem, int branch_mask) {
  char* ws = p.ws;
  const int tid = otid(), lane = tid & 63, wave = tid >> 6, hh = lane >> 5, c = lane & 31, qi = c >> 2, r4 = c & 3;
  const bf16_t* Q = (const bf16_t*)(ws + OFF_Q);
  const float* gsig = (const float*)(ws + OFF_GSIG);
  bf16_t* ONSA = (bf16_t*)(ws + OFF_ONSA);
  u32x4* SELG = (u32x4*)(ws + OFF_SELG);
  constexpr int NITEM = NB * 2 * 128;

#pragma unroll 1
  for (int rep1 = 0; rep1 < ((PROBE_DUP & 4096) ? 2 : 1); ++rep1) {
    const bf16_t* KCMP = (const bf16_t*)(ws + OFF_KCMP); const bf16_t* VCMP = (const bf16_t*)(ws + OFF_VCMP);
    float* Aimp = (float*)(smem + NSA_AIMP) + wave * 1024;
    float* Cimp = (float*)(smem + NSA_CIMP) + wave * 1024;
    unsigned short* selm16 = (unsigned short*)(smem + NSA_SELM) + wave * 64;
    const u32x4* selm128 = (const u32x4*)(smem + NSA_SELM) + wave * 8;
    for (int item = blockIdx.x; item < NITEM; item += gridDim.x) {
      const NsaItem it = nsa_item(item, wave, qi);
      const int t = it.t;
      bf16x8 qf[4];
#pragma unroll
      for (int ks = 0; ks < 4; ++ks) qf[ks] = *(const bf16x8*)(Q + it.tokrow * 512 + (it.g * 4 + r4) * 64 + ks * 16 + hh * 8);
      const float g_c = gsig[it.tokrow * 32 + (it.g * 4 + r4) * 3 + 0];
      TileRegs tr;
      const int nmax = (it.qb * 64 + 63 - 31) >> 4, ntile = (nmax >> 6) + 1;
      const int nfull = (it.qb * 64 - 31) >> 4;
      const bf16_t* kb = KCMP + (size_t)it.bg * 512 * 64;
      const bf16_t* vb = VCMP + (size_t)it.bg * 512 * 64;
      float m = -1e30f, l = 0.f;
      __syncthreads();
      for (int i = lane; i < 1024; i += 64) { Aimp[i] = 0.f; Cimp[i] = 0.f; }
      nsa_load_tile(tr, kb, 64, vb, 64);
      nsa_store_tile(tr, smem);
      __syncthreads();
      for (int j = 0; j < ntile; ++j) {
        const char* tile = smem + (j & 1) * NSA_TILE;
        if (j + 1 < ntile) nsa_load_tile(tr, kb + (size_t)(j + 1) * 64 * 64, 64, vb + (size_t)(j + 1) * 64 * 64, 64);
        f32x16 st[2];
        nsa_scores(st, tile, qf, lane);
        const bool full = (j * 64 + 63 <= nfull);
        const int nlim = full ? 100000 : ((t - 31) >> 4) - j * 64 - 4 * hh;
        float mx = NSA_NEG;
#pragma unroll
        for (int kt = 0; kt < 2; ++kt)
#pragma unroll
          for (int r = 0; r < 16; ++r) {
            st[kt][r] = (kt * 32 + (r & 3) + 8 * (r >> 2) <= nlim) ? st[kt][r] : NSA_NEG;
            mx = fmaxf(mx, st[kt][r]);
          }
        mx = fmaxf(mx, __shfl_xor(mx, 32));
        const float mn = fmaxf(m, mx);
        float sum = 0.f;
#pragma unroll
        for (int kt = 0; kt < 2; ++kt)
#pragma unroll
          for (int r = 0; r < 16; ++r) sum += __builtin_amdgcn_exp2f(st[kt][r] - mn);
        l = l * __builtin_amdgcn_exp2f(m - mn) + sum;
        m = mn;
        if (j + 1 < ntile) nsa_store_tile(tr, smem + ((j + 1) & 1) * NSA_TILE);
        __syncthreads();
      }
      l += __shfl_xor(l, 32);
      const float inv_l = l > 0.f ? 1.0f / l : 0.f;
      f32x16 o[2];
#pragma unroll
      for (int r = 0; r < 16; ++r) { o[0][r] = 0.f; o[1][r] = 0.f; }
      nsa_load_tile(tr, kb, 64, vb, 64);
      nsa_store_tile(tr, smem);
      __syncthreads();
      for (int j = 0; j < ntile; ++j) {
        const char* tile = smem + (j & 1) * NSA_TILE;
        if (j + 1 < ntile) nsa_load_tile(tr, kb + (size_t)(j + 1) * 64 * 64, 64, vb + (size_t)(j + 1) * 64 * 64, 64);
        f32x16 st[2];
        nsa_scores(st, tile, qf, lane);
        const bool full = (j * 64 + 63 <= nfull);
        const int nlim = full ? 100000 : ((t - 31) >> 4) - j * 64 - 4 * hh;
#pragma unroll
        for (int kt = 0; kt < 2; ++kt)
#pragma unroll
          for (int r = 0; r < 16; ++r) {
            const float arg = (kt * 32 + (r & 3) + 8 * (r >> 2) <= nlim) ? st[kt][r] - m : NSA_NEG;
            st[kt][r] = __builtin_amdgcn_exp2f(arg) * inv_l;
          }
#pragma unroll
        for (int kt = 0; kt < 2; ++kt)
#pragma unroll
          for (int c4 = 0; c4 < 4; ++c4) {
            float carry = 0.5f * st[kt][4 * c4 + 3];
            float fullv = st[kt][4 * c4] + st[kt][4 * c4 + 1] + st[kt][4 * c4 + 2] + carry;
            fullv += __shfl_xor(fullv, 1); fullv += __shfl_xor(fullv, 2);
            carry += __shfl_xor(carry, 1); carry += __shfl_xor(carry, 2);
            const int jb = j * 16 + kt * 8 + 2 * c4 + hh;
            if (r4 == 0) { Aimp[qi * 128 + jb] = fullv; Cimp[qi * 128 + jb] = carry; }
          }
        if (branch_mask & 1) nsa_pv(o, st, tile, lane);
        if (j + 1 < ntile) nsa_store_tile(tr, smem + ((j + 1) & 1) * NSA_TILE);
        __syncthreads();
      }
      nsa_accum_store(ONSA + it.tokrow * 512 + (it.g * 4 + r4) * 64, o, (branch_mask & 1) ? g_c : 0.f, true, hh);
      const int cur = it.qb;
      if (cur <= 15) {
        if (lane < 8) { selm16[lane * 8 + 0] = (unsigned short)((2u << cur) - 1u);
#pragma unroll
          for (int k = 1; k < 8; ++k) selm16[lane * 8 + k] = 0; }
      } else {
        const int qs = lane >> 3, sub = lane & 7;
        float v[16];
#pragma unroll
        for (int i = 0; i < 16; ++i) {
          const int jj = sub * 16 + i;
          const bool ok = (jj >= 1) && (jj <= cur - 2);
          const int jm = jj >= 1 ? jj - 1 : 0;
          v[i] = ok ? (Aimp[qs * 128 + jj] + Cimp[qs * 128 + jm]) : -3e38f;
        }
        unsigned bits = 0;
        for (int itn = 0; itn < 13; ++itn) {
          float bv = v[0]; int bi = 0;
#pragma unroll
          for (int i = 1; i < 16; ++i) if (v[i] > bv) { bv = v[i]; bi = i; }
          int bj = sub * 16 + bi;
#pragma unroll
          for (int o2 = 1; o2 < 8; o2 <<= 1) {
            const float ov = __shfl_xor(bv, o2); const int oj = __shfl_xor(bj, o2);
            if (ov > bv || (ov == bv && oj < bj)) { bv = ov; bj = oj; }
          }
          if ((bj >> 4) == sub) {
            const int i2 = bj & 15;
#pragma unroll
            for (int i = 0; i < 16; ++i) if (i == i2) v[i] = -3e38f;
            bits |= 1u << i2;
          }
        }
        if (sub == 0) bits |= 1u;
        if ((cur >> 4) == sub) bits |= 1u << (cur & 15);
        if (((cur - 1) >> 4) == sub) bits |= 1u << ((cur - 1) & 15);
        selm16[qs * 8 + sub] = (unsigned short)bits;
      }
      __syncthreads();
      if (r4 == 0 && hh == 0) SELG[(size_t)it.bg * SEQ + t] = selm128[qi];
    }
  }
  __threadfence_block();
  __syncthreads();

#pragma unroll 1
  for (int sweep_i = 0; sweep_i < 2 + ((PROBE_DUP & 1024) ? 1 : 0) + ((PROBE_DUP & 2048) ? 1 : 0); ++sweep_i) {
    const int sweep = (sweep_i < 2) ? sweep_i : (((PROBE_DUP & 1024) && sweep_i == 2) ? 0 : 1);
    const bool dry = sweep_i >= 2;
    if (!(branch_mask & (sweep == 0 ? 2 : 4))) continue;
    if (sweep == 0) { nsa_sel16(p, smem, dry); continue; }
    const bf16_t* KB = (const bf16_t*)(ws + (sweep == 0 ? OFF_KS : OFF_KW)); const bf16_t* VB = (const bf16_t*)(ws + (sweep == 0 ? OFF_VS : OFF_VW));
    for (int item = blockIdx.x; item < NITEM; item += gridDim.x) {
      const NsaItem it = nsa_item(item, wave, qi);
      const int t = it.t, qb = it.qb;
      bf16x8 qf[4];
#pragma unroll
      for (int ks = 0; ks < 4; ++ks) qf[ks] = *(const bf16x8*)(Q + it.tokrow * 512 + (it.g * 4 + r4) * 64 + ks * 16 + hh * 8);
      const float g_b = gsig[it.tokrow * 32 + (it.g * 4 + r4) * 3 + 1 + sweep];
      u32x4 selw = {0xffffffffu, 0xffffffffu, 0xffffffffu, 0xffffffffu};
      if (sweep == 0) selw = SELG[(size_t)it.bg * SEQ + t];
      TileRegs tr;
      const bf16_t* kb = KB + (size_t)it.b * SEQ * 128 + it.g * 64;
      const bf16_t* vb = VB + (size_t)it.b * SEQ * 128 + it.g * 64;
      float m = -1e30f, l = 0.f;
      f32x16 o[2];
#pragma unroll
      for (int r = 0; r < 16; ++r) { o[0][r] = 0.f; o[1][r] = 0.f; }
      const int j0 = (sweep == 1 && qb >= 8) ? qb - 8 : 0;
      __syncthreads();
      nsa_load_tile(tr, kb + (size_t)j0 * 64 * 128, 128, vb + (size_t)j0 * 64 * 128, 128);
      nsa_store_tile(tr, smem);
      if (j0 + 1 <= qb) { nsa_load_tile(tr, kb + (size_t)(j0 + 1) * 64 * 128, 128, vb + (size_t)(j0 + 1) * 64 * 128, 128); nsa_store_tile(tr, smem + NSA_TILE); }
      if (j0 + 2 <= qb) nsa_load_tile(tr, kb + (size_t)(j0 + 2) * 64 * 128, 128, vb + (size_t)(j0 + 2) * 64 * 128, 128);
      __syncthreads();
      const bool late = wave >= 4;
      if (__builtin_amdgcn_readfirstlane(wave) >= 4) __builtin_amdgcn_s_setprio(1);
      bool has = false;
      m = 0.f;
      f32x16 st[2];
      {
        const unsigned w0 = j0 < 32 ? selw.x : (j0 < 64 ? selw.y : (j0 < 96 ? selw.z : selw.w));
        const float ini = ((w0 >> (j0 & 31)) & 1u) ? 0.f : -1e30f;
#pragma unroll
        for (int r = 0; r < 16; ++r) { st[0][r] = ini; st[1][r] = ini; }
        const bf16_t* Kc = (const bf16_t*)smem;
#pragma unroll
        for (int ks = 0; ks < 4; ++ks)
#pragma unroll
          for (int kt = 0; kt < 2; ++kt) st[kt] = MFMA32(*(const bf16x8*)(Kc + (kt * 32 + (lane & 31)) * LK + ks * 16 + (lane >> 5) * 8), qf[ks], st[kt]);
      }
      int bi = 0;
      for (int j = j0; j <= qb; ++j) {
        const char* tile = smem + bi * NSA_TILE;
        const int bn = bi == 2 ? 0 : bi + 1, bnn = bn == 2 ? 0 : bn + 1;
        const int jn = j + 1;
        const unsigned wn = jn < 32 ? selw.x : (jn < 64 ? selw.y : (jn < 96 ? selw.z : selw.w));
        const bool seln = (wn >> (jn & 31)) & 1u;
        const bf16_t* Kn = (const bf16_t*)(smem + bn * NSA_TILE) + (lane & 31) * LK + (lane >> 5) * 8;
        f32x16 sn[2];
        if (!late) {
          const float ini = seln ? -m : -1e30f;
#pragma unroll
          for (int r = 0; r < 16; ++r) { sn[0][r] = ini; sn[1][r] = ini; }
#pragma unroll
          for (int ks = 0; ks < 4; ++ks)
#pragma unroll
            for (int kt = 0; kt < 2; ++kt) sn[kt] = MFMA32(*(const bf16x8*)(Kn + kt * 32 * LK + ks * 16), qf[ks], sn[kt]);
        }
        if (j == qb || (sweep == 1 && j == qb - 8)) {
          const int khi = t - j * 64 - 4 * hh, klo = (sweep == 1) ? khi - 511 : -100000;
#pragma unroll
          for (int r = 0; r < 16; ++r) {
            const int o0 = (r & 3) + 8 * (r >> 2);
            st[0][r] = (o0 <= khi && o0 >= klo) ? st[0][r] : NSA_NEG;
            st[1][r] = (o0 + 32 <= khi && o0 + 32 >= klo) ? st[1][r] : NSA_NEG;
          }
        }
        float mx;
        {
          float a0, a1, a2, a3;
          asm("v_max3_f32 %0, %1, %2, %3" : "=v"(a0) : "v"(st[0][0]), "v"(st[0][1]), "v"(st[0][2]));
          asm("v_max3_f32 %0, %1, %2, %3" : "=v"(a1) : "v"(st[0][3]), "v"(st[0][4]), "v"(st[0][5]));
          asm("v_max3_f32 %0, %1, %2, %3" : "=v"(a2) : "v"(st[0][6]), "v"(st[0][7]), "v"(st[0][8]));
          asm("v_max3_f32 %0, %1, %2, %3" : "=v"(a3) : "v"(st[0][9]), "v"(st[0][10]), "v"(st[0][11]));
          asm("v_max3_f32 %0, %1, %2, %3" : "=v"(a0) : "v"(a0), "v"(st[0][12]), "v"(st[0][13]));
          asm("v_max3_f32 %0, %1, %2, %3" : "=v"(a1) : "v"(a1), "v"(st[0][14]), "v"(st[0][15]));
          asm("v_max3_f32 %0, %1, %2, %3" : "=v"(a2) : "v"(a2), "v"(st[1][0]), "v"(st[1][1]));
          asm("v_max3_f32 %0, %1, %2, %3" : "=v"(a3) : "v"(a3), "v"(st[1][2]), "v"(st[1][3]));
          asm("v_max3_f32 %0, %1, %2, %3" : "=v"(a0) : "v"(a0), "v"(st[1][4]), "v"(st[1][5]));
          asm("v_max3_f32 %0, %1, %2, %3" : "=v"(a1) : "v"(a1), "v"(st[1][6]), "v"(st[1][7]));
          asm("v_max3_f32 %0, %1, %2, %3" : "=v"(a2) : "v"(a2), "v"(st[1][8]), "v"(st[1][9]));
          asm("v_max3_f32 %0, %1, %2, %3" : "=v"(a3) : "v"(a3), "v"(st[1][10]), "v"(st[1][11]));
          asm("v_max3_f32 %0, %1, %2, %3" : "=v"(a0) : "v"(a0), "v"(st[1][12]), "v"(st[1][13]));
          asm("v_max3_f32 %0, %1, %2, %3" : "=v"(a1) : "v"(a1), "v"(st[1][14]), "v"(st[1][15]));
          asm("v_max3_f32 %0, %1, %2, %3" : "=v"(a0) : "v"(a0), "v"(a1), "v"(a2));
          const float other = a3;
          asm("v_max_f32 %0, %1, %2" : "=v"(mx) : "v"(a0), "v"(other));
          const float px = __shfl_xor(mx, 32);
          asm("v_max_f32 %0, %1, %2" : "=v"(mx) : "v"(mx), "v"(px));
        }
        const bool real = mx > -1e29f;
        const bool fresh = !has && real, up = has && (mx > NSA_THR);
        if (__any(fresh || up)) {
          const float delta = (fresh || up) ? mx : 0.f;
          const float alpha = up ? __builtin_amdgcn_exp2f(-delta) : 1.0f;
          m += delta; l *= alpha;
#pragma unroll
          for (int r = 0; r < 16; ++r) { o[0][r] *= alpha; o[1][r] *= alpha; st[0][r] -= delta; st[1][r] -= delta; }
          if (!late) {
            const float dn = seln ? delta : 0.f;
#pragma unroll
            for (int r = 0; r < 16; ++r) { sn[0][r] -= dn; sn[1][r] -= dn; }
          }
        }
        has = has || real;
        f32x2 s2 = {0.f, 0.f};
#pragma unroll
        for (int r = 0; r < 16; ++r) {
          const float p0 = __builtin_amdgcn_exp2f(st[0][r]), p1 = __builtin_amdgcn_exp2f(st[1][r]);
          st[0][r] = p0; st[1][r] = p1; s2 += (f32x2){p0, p1};
        }
        l += s2.x + s2.y;
        nsa_pv(o, st, tile, lane);
        if (late) {
          const float ini = seln ? -m : -1e30f;
#pragma unroll
          for (int r = 0; r < 16; ++r) { sn[0][r] = ini; sn[1][r] = ini; }
#pragma unroll
          for (int ks = 0; ks < 4; ++ks)
#pragma unroll
            for (int kt = 0; kt < 2; ++kt) sn[kt] = MFMA32(*(const bf16x8*)(Kn + kt * 32 * LK + ks * 16), qf[ks], sn[kt]);
        }
        if (j + 2 <= qb) nsa_store_tile(tr, smem + bnn * NSA_TILE);
        if (j + 3 <= qb) nsa_load_tile(tr, kb + (size_t)(j + 3) * 64 * 128, 128, vb + (size_t)(j + 3) * 64 * 128, 128);
#pragma unroll
        for (int r = 0; r < 16; ++r) { st[0][r] = sn[0][r]; st[1][r] = sn[1][r]; }
        bi = bn;
        __syncthreads();
      }
      __builtin_amdgcn_s_setprio(0);
      l += __shfl_xor(l, 32);
      if (!dry) nsa_accum_store(ONSA + it.tokrow * 512 + (it.g * 4 + r4) * 64, o, l > 0.f ? g_b / l : 0.f, false, hh);
      else asm volatile("" :: "v"(o[0]), "v"(o[1]), "v"(l));
    }
  }
}

DI unsigned ord_key(float f) { const unsigned u = __float_as_uint(f); return (u & 0x80000000u) ? ~u : (u | 0x80000000u); }
DI float ord_val(unsigned k) { return __uint_as_float((k & 0x80000000u) ? (k & 0x7fffffffu) : ~k); }
DI void cex(unsigned& hi, unsigned& lo) { const unsigned x = hi, y = lo; hi = x > y ? x : y; lo = x > y ? y : x; }
DI void sort16_desc(unsigned (&a)[16]) {
#pragma unroll
  for (int k = 2; k <= 16; k <<= 1)
#pragma unroll
    for (int j = k >> 1; j > 0; j >>= 1)
#pragma unroll
      for (int i = 0; i < 16; ++i) {
        const int l = i ^ j;
        if (l > i) { if ((i & k) == 0) cex(a[i], a[l]); else cex(a[l], a[i]); }
      }
}
DI void bitonic_finish16(unsigned (&a)[16]) {
#pragma unroll
  for (int j = 8; j > 0; j >>= 1)
#pragma unroll
    for (int i = 0; i < 16; ++i) { const int l = i ^ j; if (l > i) cex(a[i], a[l]); }
}
DI void merge_top16(unsigned (&a)[16], const unsigned (&b)[16]) {
#pragma unroll
  for (int i = 0; i < 16; ++i) a[i] = a[i] > b[15 - i] ? a[i] : b[15 - i];
  bitonic_finish16(a);
}
DI void merge_partner16(unsigned (&a)[16]) {
  unsigned b[16];
#pragma unroll
  for (int i = 0; i < 16; ++i) b[i] = (unsigned)__shfl_xor((int)a[i], 32);
  merge_top16(a, b);
}


DI void peer_top16(unsigned (&top)[16], const bf16_t* pqrow, const bf16_t* keys, int lane) {
  const int l31 = lane & 31, hh = lane >> 5;
  bf16x8 bq[8];
#pragma unroll
  for (int ks = 0; ks < 8; ++ks) bq[ks] = *(const bf16x8*)(pqrow + ks * 16 + hh * 8);
  unsigned grp[16];
#pragma unroll
  for (int nt = 0; nt < 4; ++nt) {
    f32x16 sa;
#pragma unroll
    for (int r = 0; r < 16; ++r) sa[r] = 0.f;
    const bf16_t* kp = keys + (size_t)(nt * 32 + l31) * 128 + hh * 8;
#pragma unroll
    for (int ks = 0; ks < 8; ++ks) { const bf16x8 a = *(const bf16x8*)(kp + ks * 16); sa = MFMA32(a, bq[ks], sa); }
#pragma unroll
    for (int r = 0; r < 16; ++r) {
      const int n = nt * 32 + (r & 3) + 8 * (r >> 2) + 4 * hh;
      grp[r] = (ord_key(sa[r]) & ~0x7Fu) | (unsigned)(127 - n);
    }
    sort16_desc(grp);
    if (nt == 0) {
#pragma unroll
      for (int i = 0; i < 16; ++i) top[i] = grp[i];
    } else merge_top16(top, grp);
  }
  merge_partner16(top);
}

DI void phase_route(const Params& p, char* smem) {
  char* ws = p.ws;
  const int tid = otid(), lane = tid & 63, wave = tid >> 6, l31 = lane & 31, hh = lane >> 5;
  const bf16_t* pq = (const bf16_t*)(ws + OFF_PQ);
  const bf16_t* pk = (const bf16_t*)(ws + OFF_PKEYS);
  int* eidx = (int*)(ws + OFF_EIDX);
  float* pgate = (float*)(ws + OFF_PGATE);
  unsigned* LS = (unsigned*)smem + wave * 1024;
  constexpr int CA[64] = {0,0,0,0,0,0,0,0,0,0,0,0,0,0,0,0, 1,1,1,1,1,1,1,1, 2,2,2,2,2, 3,3,3,3, 4,4,4, 5,5, 6,6, 7,7, 8,9,10,11,12,13,14,15, 0,0,0,0,0,0,0,0,0,0,0,0,0,0};
  constexpr int CB[64] = {0,1,2,3,4,5,6,7,8,9,10,11,12,13,14,15, 0,1,2,3,4,5,6,7, 0,1,2,3,4, 0,1,2,3, 0,1,2, 0,1, 0,1, 0,1, 0,0,0,0,0,0,0,0, 0,0,0,0,0,0,0,0,0,0,0,0,0,0};
  for (int item = blockIdx.x; item < (NTOK / 256) * 8; item += gridDim.x) {
    const int h = item & 7, t0 = (item >> 3) * 256 + wave * 32;
    unsigned s1[16], s2[16];
    const bf16_t* pqrow = pq + (size_t)(t0 + l31) * 2048 + h * 256;
    peer_top16(s1, pqrow, pk + (size_t)(h * 2) * 128 * 128, lane);
    peer_top16(s2, pqrow + 128, pk + (size_t)(h * 2 + 1) * 128 * 128, lane);
    float f1[16], f2[16];
#pragma unroll
    for (int i = 0; i < 16; ++i) { f1[i] = ord_val(s1[i]); f2[i] = ord_val(s2[i]); }
    unsigned ca[16], cb2[16];
#pragma unroll
    for (int i = 0; i < 32; ++i) {
      const int i0 = i, i1 = 25 + i;
      unsigned k0 = 0u, k1 = 0u;
      if (i0 < 25) k0 = (ord_key(f1[CA[i0]] + f2[CB[i0]]) & ~0xFFu) | (unsigned)(255 - (CA[i0] * 16 + CB[i0]));
      if (i1 < 50) k1 = (ord_key(f1[CA[i1]] + f2[CB[i1]]) & ~0xFFu) | (unsigned)(255 - (CA[i1] * 16 + CB[i1]));
      const unsigned kk = hh ? k1 : k0;
      if (i < 16) ca[i] = kk; else cb2[i - 16] = kk;
    }
    sort16_desc(ca); sort16_desc(cb2);
    merge_top16(ca, cb2);
    merge_partner16(ca);
    if (hh == 0) {
#pragma unroll
      for (int i = 0; i < 16; ++i) { LS[l31 * 32 + i] = s1[i]; LS[l31 * 32 + 16 + i] = s2[i]; }
    }
    const float mx = ord_val(ca[0]);
    float ex[16], sum = 0.f;
#pragma unroll
    for (int i = 0; i < 16; ++i) { ex[i] = __expf(ord_val(ca[i]) - mx); sum += ex[i]; }
    const float inv = 1.0f / sum;
    int eo[16]; float go[16];
#pragma unroll
    for (int i = 0; i < 16; ++i) {
      const int flat = 255 - (int)(ca[i] & 0xFFu);
      const unsigned k1 = LS[l31 * 32 + (flat >> 4)], k2 = LS[l31 * 32 + 16 + (flat & 15)];
      eo[i] = (127 - (int)(k1 & 0x7Fu)) * 128 + (127 - (int)(k2 & 0x7Fu));
      go[i] = ex[i] * inv;
    }
    const size_t ob = ((size_t)(t0 + l31) * 8 + h) * 16;
    if (hh == 0) {
      *(u32x4*)(eidx + ob) = (u32x4){(unsigned)eo[0], (unsigned)eo[1], (unsigned)eo[2], (unsigned)eo[3]};
      *(u32x4*)(eidx + ob + 4) = (u32x4){(unsigned)eo[4], (unsigned)eo[5], (unsigned)eo[6], (unsigned)eo[7]};
      *(f32x4*)(pgate + ob) = (f32x4){go[0], go[1], go[2], go[3]};
      *(f32x4*)(pgate + ob + 4) = (f32x4){go[4], go[5], go[6], go[7]};
    } else {
      *(u32x4*)(eidx + ob + 8) = (u32x4){(unsigned)eo[8], (unsigned)eo[9], (unsigned)eo[10], (unsigned)eo[11]};
      *(u32x4*)(eidx + ob + 12) = (u32x4){(unsigned)eo[12], (unsigned)eo[13], (unsigned)eo[14], (unsigned)eo[15]};
      *(f32x4*)(pgate + ob + 8) = (f32x4){go[8], go[9], go[10], go[11]};
      *(f32x4*)(pgate + ob + 12) = (f32x4){go[12], go[13], go[14], go[15]};
    }
  }
}

#define FOR32(M) M(0) M(1) M(2) M(3) M(4) M(5) M(6) M(7) M(8) M(9) M(10) M(11) M(12) M(13) M(14) M(15) M(16) M(17) M(18) M(19) M(20) M(21) M(22) M(23) M(24) M(25) M(26) M(27) M(28) M(29) M(30) M(31)
DI float dot16_fp8(const u32x4 raw, const float (&hx)[16]) {
  const f32x2 a0 = __builtin_amdgcn_cvt_pk_f32_fp8((int)raw.x, false), a1 = __builtin_amdgcn_cvt_pk_f32_fp8((int)raw.x, true);
  const f32x2 b0 = __builtin_amdgcn_cvt_pk_f32_fp8((int)raw.y, false), b1 = __builtin_amdgcn_cvt_pk_f32_fp8((int)raw.y, true);
  const f32x2 c0 = __builtin_amdgcn_cvt_pk_f32_fp8((int)raw.z, false), c1 = __builtin_amdgcn_cvt_pk_f32_fp8((int)raw.z, true);
  const f32x2 d0 = __builtin_amdgcn_cvt_pk_f32_fp8((int)raw.w, false), d1 = __builtin_amdgcn_cvt_pk_f32_fp8((int)raw.w, true);
  float d = (hx[0] * a0.x + hx[1] * a0.y) + (hx[2] * a1.x + hx[3] * a1.y);
  d += (hx[4] * b0.x + hx[5] * b0.y) + (hx[6] * b1.x + hx[7] * b1.y);
  d += (hx[8] * c0.x + hx[9] * c0.y) + (hx[10] * c1.x + hx[11] * c1.y);
  d += (hx[12] * d0.x + hx[13] * d0.y) + (hx[14] * d1.x + hx[15] * d1.y);
  return d;
}
#define FOR16(M) M(0) M(1) M(2) M(3) M(4) M(5) M(6) M(7) M(8) M(9) M(10) M(11) M(12) M(13) M(14) M(15)
DI void phase_ffn_u(const Params& p) {
  char* ws = p.ws;
  const int lane = otid() & 63, wave = otid() >> 6, pg = lane >> 3, dc = lane & 7;
  const int sl = blockIdx.x & 7, wslot = (blockIdx.x >> 3) * NW + wave, nw = (gridDim.x >> 3) * NW;
  const unsigned char* PU8 = (const unsigned char*)(ws + OFF_PU8) + (size_t)sl * 16384 * 128 + dc * 16;
  const bf16_t* h2 = (const bf16_t*)(ws + OFF_H) + sl * 128 + dc * 16;
  const int* eidx = (const int*)(ws + OFF_EIDX);
  float* part = (float*)(ws + OFF_PART) + (size_t)sl * NTOK * 128;
  const int j0 = (dc >> 2) * 64 + ((2 * dc) & 7) * 8 + pg;
  int ev0 = 0, ev1 = 0, nev0 = 0, nev1 = 0; u32x4 ha = {0u, 0u, 0u, 0u}, hb = ha, nha = ha, nhb = ha;
  if (wslot < NTOK) { ev0 = eidx[(size_t)wslot * 128 + lane]; ev1 = eidx[(size_t)wslot * 128 + 64 + lane]; ha = *(const u32x4*)(h2 + (size_t)wslot * DM); hb = *(const u32x4*)(h2 + (size_t)wslot * DM + 8); }
  for (int t = wslot; t < NTOK; t += nw) {
    if (t + nw < NTOK) { const size_t o = (size_t)(t + nw) * 128; nev0 = eidx[o + lane]; nev1 = eidx[o + 64 + lane]; nha = *(const u32x4*)(h2 + (size_t)(t + nw) * DM); nhb = *(const u32x4*)(h2 + (size_t)(t + nw) * DM + 8); }
    float hx[16];
    { float t8[8]; unpack8(ha, t8);
#pragma unroll
      for (int i = 0; i < 8; ++i) hx[i] = t8[i];
      unpack8(hb, t8);
#pragma unroll
      for (int i = 0; i < 8; ++i) hx[8 + i] = t8[i]; }
#define FFU_LD(it) const u32x4 ru##it = *(const u32x4*)(PU8 + (size_t)__shfl((it) < 8 ? ev0 : ev1, ((it) & 7) * 8 + pg) * 128);
    FOR16(FFU_LD)
    float d[16];
#define FFU_CP(it) d[it] = dot16_fp8(ru##it, hx);
    FOR16(FFU_CP)
    float r8[8], r4[4], r2[2];
    { const bool hi = dc & 4;
#pragma unroll
      for (int i = 0; i < 8; ++i) { const float keep = hi ? d[8 + i] : d[i], send = hi ? d[i] : d[8 + i]; r8[i] = keep + __shfl_xor(send, 4); } }
    { const bool hi = dc & 2;
#pragma unroll
      for (int i = 0; i < 4; ++i) { const float keep = hi ? r8[4 + i] : r8[i], send = hi ? r8[i] : r8[4 + i]; r4[i] = keep + __shfl_xor(send, 2); } }
    { const bool hi = dc & 1;
#pragma unroll
      for (int i = 0; i < 2; ++i) { const float keep = hi ? r4[2 + i] : r4[i], send = hi ? r4[i] : r4[2 + i]; r2[i] = keep + __shfl_xor(send, 1); } }
    part[(size_t)t * 128 + j0] = r2[0];
    part[(size_t)t * 128 + j0 + 8] = r2[1];
    ev0 = nev0; ev1 = nev1; ha = nha; hb = nhb;
  }
}
DI void phase_ffn_w(const Params& p) {
  char* ws = p.ws;
  const int lane = otid() & 63, wave = otid() >> 6;
  const float* part = (const float*)(ws + OFF_PART);
  const float* scu = (const float*)(ws + OFF_SCU); const float* scv = (const float*)(ws + OFF_SCV);
  const int* eidx = (const int*)(ws + OFF_EIDX);
  const float* pgate = (const float*)(ws + OFF_PGATE);
  float* wbuf = (float*)(ws + OFF_WBUF);
  for (int grp = blockIdx.x; grp < NTOK / NW; grp += gridDim.x) {
    const size_t o = (size_t)(grp * NW + wave) * 128 + lane;
    float a0 = 0.f, a1 = 0.f;
#pragma unroll
    for (int s8 = 0; s8 < 8; ++s8) { a0 += part[(size_t)s8 * NTOK * 128 + o]; a1 += part[(size_t)s8 * NTOK * 128 + o + 64]; }
    const int e0 = eidx[o], e1 = eidx[o + 64];
    wbuf[o] = pgate[o] * gelu_f(a0 * scu[e0]) * scv[e0];
    wbuf[o + 64] = pgate[o + 64] * gelu_f(a1 * scu[e1]) * scv[e1];
  }
}
DI void phase_ffn_v(const Params& p) {
  char* ws = p.ws;
  const int lane = otid() & 63, wave = otid() >> 6, pg = lane >> 3, dc = lane & 7;
  const int sl = blockIdx.x & 7, wslot = (blockIdx.x >> 3) * NW + wave, nw = (gridDim.x >> 3) * NW;
  const unsigned char* PV8 = (const unsigned char*)(ws + OFF_PV8) + (size_t)sl * 16384 * 128 + dc * 16;
  const int* eidx = (const int*)(ws + OFF_EIDX);
  const float* wbuf = (const float*)(ws + OFF_WBUF);
  bf16_t* ffnb = (bf16_t*)(ws + OFF_FFNB);
  int ev0 = 0, ev1 = 0, nev0 = 0, nev1 = 0; float w0 = 0.f, w1 = 0.f, nw0 = 0.f, nw1 = 0.f;
  if (wslot < NTOK) { ev0 = eidx[(size_t)wslot * 128 + lane]; ev1 = eidx[(size_t)wslot * 128 + 64 + lane]; w0 = wbuf[(size_t)wslot * 128 + lane]; w1 = wbuf[(size_t)wslot * 128 + 64 + lane]; }
  for (int t = wslot; t < NTOK; t += nw) {
    if (t + nw < NTOK) { const size_t o = (size_t)(t + nw) * 128; nev0 = eidx[o + lane]; nev1 = eidx[o + 64 + lane]; nw0 = wbuf[o + lane]; nw1 = wbuf[o + 64 + lane]; }
#define FFV_LD(it) const u32x4 rv##it = *(const u32x4*)(PV8 + (size_t)__shfl((it) < 8 ? ev0 : ev1, ((it) & 7) * 8 + pg) * 128);
#define FFV_CP(it) { const float wj = __shfl((it) < 8 ? w0 : w1, ((it) & 7) * 8 + pg); \
      const f32x2 a0 = __builtin_amdgcn_cvt_pk_f32_fp8((int)rv##it.x, false), a1 = __builtin_amdgcn_cvt_pk_f32_fp8((int)rv##it.x, true); \
      const f32x2 b0 = __builtin_amdgcn_cvt_pk_f32_fp8((int)rv##it.y, false), b1 = __builtin_amdgcn_cvt_pk_f32_fp8((int)rv##it.y, true); \
      const f32x2 c0 = __builtin_amdgcn_cvt_pk_f32_fp8((int)rv##it.z, false), c1 = __builtin_amdgcn_cvt_pk_f32_fp8((int)rv##it.z, true); \
      const f32x2 d0 = __builtin_amdgcn_cvt_pk_f32_fp8((int)rv##it.w, false), d1 = __builtin_amdgcn_cvt_pk_f32_fp8((int)rv##it.w, true); \
      acc[0] += wj * a0.x; acc[1] += wj * a0.y; acc[2] += wj * a1.x; acc[3] += wj * a1.y; acc[4] += wj * b0.x; acc[5] += wj * b0.y; acc[6] += wj * b1.x; acc[7] += wj * b1.y; \
      acc[8] += wj * c0.x; acc[9] += wj * c0.y; acc[10] += wj * c1.x; acc[11] += wj * c1.y; acc[12] += wj * d0.x; acc[13] += wj * d0.y; acc[14] += wj * d1.x; acc[15] += wj * d1.y; }
    FOR16(FFV_LD)
    float acc[16];
#pragma unroll
    for (int i = 0; i < 16; ++i) acc[i] = 0.f;
    FOR16(FFV_CP)
    float r8[8], r4[4], r2[2];
    { const bool hi = lane & 32;
#pragma unroll
      for (int i = 0; i < 8; ++i) { const float keep = hi ? acc[8 + i] : acc[i], send = hi ? acc[i] : acc[8 + i]; r8[i] = keep + __shfl_xor(send, 32); } }
    { const bool hi = lane & 16;
#pragma unroll
      for (int i = 0; i < 4; ++i) { const float keep = hi ? r8[4 + i] : r8[i], send = hi ? r8[i] : r8[4 + i]; r4[i] = keep + __shfl_xor(send, 16); } }
    { const bool hi = lane & 8;
#pragma unroll
      for (int i = 0; i < 2; ++i) { const float keep = hi ? r4[2 + i] : r4[i], send = hi ? r4[i] : r4[2 + i]; r2[i] = keep + __shfl_xor(send, 8); } }
    *(unsigned*)(ffnb + (size_t)t * DM + sl * 128 + dc * 16 + 2 * pg) = pack2(r2[0], r2[1]);
    ev0 = nev0; ev1 = nev1; w0 = nw0; w1 = nw1;
  }
}
DI void phase_final(const Params& p) {
  char* ws = p.ws;
  const int lane = otid() & 63, wave = otid() >> 6;
  const bf16_t* x1 = (const bf16_t*)(ws + OFF_X1);
  const bf16_t* ffnb = (const bf16_t*)(ws + OFF_FFNB);
  const float* mod = (const float*)(ws + OFF_MOD);
  for (int grp = blockIdx.x; grp < NTOK / NW; grp += gridDim.x) {
    const int row = grp * NW + wave, b = row >> 13;
    float v[16];
#pragma unroll
    for (int i = 0; i < 4; ++i) {
      const int col = i * 256 + lane * 4;
      const f32x4 gt2 = *(const f32x4*)(mod + b * 6144 + 5120 + col);
      const u32x2 xr = *(const u32x2*)(x1 + (size_t)row * DM + col), fr = *(const u32x2*)(ffnb + (size_t)row * DM + col);
      v[4 * i] = DN_ALPHA * bflo(xr.x) + gt2.x * bflo(fr.x); v[4 * i + 1] = DN_ALPHA * bfhi(xr.x) + gt2.y * bfhi(fr.x);
      v[4 * i + 2] = DN_ALPHA * bflo(xr.y) + gt2.z * bflo(fr.y); v[4 * i + 3] = DN_ALPHA * bfhi(xr.y) + gt2.w * bfhi(fr.y);
    }
    float mean, rstd; row_stats(v, mean, rstd);
#pragma unroll
    for (int i = 0; i < 4; ++i) {
      const int col = i * 256 + lane * 4;
      const f32x4 g = *(const f32x4*)(p.ln2_g + col), bb = *(const f32x4*)(p.ln2_b + col);
      f32x4 o;
      o.x = (v[4 * i] - mean) * rstd * g.x + bb.x; o.y = (v[4 * i + 1] - mean) * rstd * g.y + bb.y;
      o.z = (v[4 * i + 2] - mean) * rstd * g.z + bb.z; o.w = (v[4 * i + 3] - mean) * rstd * g.w + bb.w;
      *(f32x4*)(p.out + (size_t)row * DM + col) = o;
    }
  }
}

#define XB_TMO      128
#define XB_XCNT(j)  (256  + 64 * (j))
#define XB_XSUB(j)  (1280 + 64 * (j))
#define XB_XGEN(j)  (2304 + 64 * (j))
#define XB_TOP      3328
#define XB_TOPGEN   3392
#define XCD_BAR_WORDS 3456
#define XB_SPIN_CAP (1u << 22)
DI unsigned xb_ld(unsigned* p) { return __hip_atomic_load(p, __ATOMIC_RELAXED, __HIP_MEMORY_SCOPE_AGENT); }
DI unsigned xb_add(unsigned* p, unsigned v) { return __hip_atomic_fetch_add(p, v, __ATOMIC_RELAXED, __HIP_MEMORY_SCOPE_AGENT); }
DI unsigned xb_xcc_id() { return (unsigned)__builtin_amdgcn_s_getreg((3 << 11) | 20) & 0xFu; }
#define XB_SPIN(cond, bar) do { unsigned _sp = 0; while (cond) { __builtin_amdgcn_s_sleep(1); \
    if ((++_sp & 255u) == 0u) { if (xb_ld(&(bar)[XB_TMO])) break; if (_sp > XB_SPIN_CAP) { atomicAdd(&(bar)[XB_TMO], 1u); break; } } } } while (0)
struct XcdBarrier { unsigned* bar; unsigned x; volatile LAS unsigned* st; };
DI XcdBarrier xcd_barrier_post(unsigned* bar, volatile LAS unsigned* st) {
  XcdBarrier b; b.bar = bar; b.x = xb_xcc_id(); b.st = st;
  if (threadIdx.x == 0) (void)xb_add(&bar[XB_XCNT(b.x)], 1u);
  return b;
}
DI void xcd_barrier_complete(unsigned* bar, unsigned x, unsigned& nloc, unsigned& nx) {
  const unsigned G = gridDim.x * gridDim.y * gridDim.z;
  unsigned sum, cnt, mine, sp = 0u;
  for (;;) {
    sum = 0u; cnt = 0u; mine = 0u;
#pragma unroll
    for (unsigned j = 0; j < 16; ++j) { const unsigned c = xb_ld(&bar[XB_XCNT(j)]); sum += c; cnt += (c > 0u) ? 1u : 0u; mine = (j == x) ? c : mine; }
    if (sum == G) break;
    __builtin_amdgcn_s_sleep(1);
    if ((++sp & 255u) == 0u) { if (xb_ld(&bar[XB_TMO])) break; if (sp > XB_SPIN_CAP) { atomicAdd(&bar[XB_TMO], 1u); break; } }
  }
  nloc = mine > 0u ? mine : 1u; nx = cnt > 0u ? cnt : 1u;
}
DI void xcd_barrier(const XcdBarrier& b) {
  asm volatile("s_waitcnt vmcnt(0)" ::: "memory");
  __syncthreads();
  if (threadIdx.x == 0) {
    unsigned* bar = b.bar;
    __builtin_amdgcn_s_waitcnt(0);
    unsigned nloc = b.st[0], nx = b.st[1];
    if (nloc == 0u) { xcd_barrier_complete(bar, b.x, nloc, nx); b.st[0] = nloc; b.st[1] = nx; }
    const unsigned old = xb_add(&bar[XB_XSUB(b.x)], 1u);
    const unsigned gen = old / nloc;
    if (old + 1u == (gen + 1u) * nloc) {
      __builtin_amdgcn_fence(__ATOMIC_RELEASE, "agent");
      asm volatile("s_waitcnt vmcnt(0)" ::: "memory");
      const unsigned og = xb_add(&bar[XB_TOP], 1u);
      const unsigned tg = og / nx;
      if (og + 1u == (tg + 1u) * nx) xb_add(&bar[XB_TOPGEN], 1u);
      else XB_SPIN(xb_ld(&bar[XB_TOPGEN]) == tg, bar);
      __builtin_amdgcn_fence(__ATOMIC_ACQUIRE, "agent");
      xb_add(&bar[XB_XGEN(b.x)], 1u);
      asm volatile("s_waitcnt vmcnt(0)" ::: "memory");
    } else {
      XB_SPIN(xb_ld(&bar[XB_XGEN(b.x)]) == gen, bar);
      __builtin_amdgcn_fence(__ATOMIC_ACQUIRE, "agent");
      asm volatile("s_waitcnt vmcnt(0)" ::: "memory");
    }
  }
  __syncthreads();
}

constexpr int SMEM_BYTES = 147456 + 256;

__global__ void __launch_bounds__(NT, 2) k_mega(Params p) {
  __shared__ __attribute__((aligned(16))) char smem[SMEM_BYTES];
  cg::grid_group grid = cg::this_grid();
  if (threadIdx.x == 0) *(u32x4*)(smem + 147456) = (u32x4){0u, 0u, 0u, 0u};
  __syncthreads();
  const XcdBarrier xb = xcd_barrier_post((unsigned*)(p.ws + OFF_BAR), (volatile LAS unsigned*)(smem + 147456));
#define REP(mask) _Pragma("unroll 1") for (int rep_ = 0; rep_ < ((PROBE_DUP & (mask)) ? 2 : 1); ++rep_)
  REP(1) phase_prep(p, smem);
  grid.sync();
  REP(1) phase_ln_in(p);
  xcd_barrier(xb);
  REP(2) phase_gemm1(p, smem);
  xcd_barrier(xb);
  REP(4) phase_compress(p, smem);
  phase_sgu(p, smem);
  xcd_barrier(xb);
  REP(8) phase_nsa(p, smem, NSA_MASK);
  xcd_barrier(xb);
  REP(16) phase_merge(p, smem);
  xcd_barrier(xb);
  REP(16) phase_outproj(p, smem);
  xcd_barrier(xb);
  REP(1) phase_ln_mid(p);
  xcd_barrier(xb);
  REP(32) phase_peerq(p, smem);
  xcd_barrier(xb);
  REP(64) phase_route(p, smem);
  xcd_barrier(xb);
  REP(128) phase_ffn_u(p);
  xcd_barrier(xb);
  REP(128) phase_ffn_w(p);
  xcd_barrier(xb);
  REP(256) phase_ffn_v(p);
  xcd_barrier(xb);
  REP(512) phase_final(p);
}

extern "C" void kernel_launch(void* const* d_in, const int* in_sizes, int n_in, void* d_out, int out_size, void* d_ws, size_t ws_size, hipStream_t stream) {
  if (ws_size < OFF_END) { fprintf(stderr, "workspace too small: %zu < %zu\n", ws_size, (size_t)OFF_END); return; }
  static int grid_blocks = 0;
  if (!grid_blocks) {
    int dev = 0, cus = 0, per_cu = 0;
    (void)hipGetDevice(&dev);
    (void)hipDeviceGetAttribute(&cus, hipDeviceAttributeMultiprocessorCount, dev);
    (void)hipOccupancyMaxActiveBlocksPerMultiprocessor(&per_cu, k_mega, NT, 0);
    if (per_cu < 1) fprintf(stderr, "occupancy query returned %d\n", per_cu);
    grid_blocks = (cus / 8) * 8;
  }
  Params p{};
  const float** fp = (const float**)&p;
  for (int i = 0; i < 26; ++i) fp[i] = (const float*)d_in[i];
  p.out = (float*)d_out;
  p.ws = (char*)d_ws;
  for (int i = 0; i < 32; ++i) p.inv_freq[i] = (float)pow(10000.0, -(double)i / 32.0);
  (void)hipMemsetAsync((char*)d_ws + OFF_BAR, 0, XCD_BAR_WORDS * 4, stream);
  void* args[] = {&p};
  hipError_t e = hipLaunchCooperativeKernel((void*)k_mega, dim3(grid_blocks), dim3(NT), args, 0, stream);
  if (e != hipSuccess) fprintf(stderr, "cooperative launch failed: %s (grid %d)\n", hipGetErrorString(e), grid_blocks);
}
```

```cpp
#include <hip/hip_runtime.h>
#include <hip/hip_cooperative_groups.h>
#include <stdint.h>
#include <stdio.h>
#include <math.h>
namespace cg = cooperative_groups;

#ifndef PROBE_DUP
#define PROBE_DUP 0
#endif
#ifndef NSA_MASK
#define NSA_MASK 7
#endif
typedef unsigned short bf16_t;
typedef short bf16x8 __attribute__((ext_vector_type(8)));
typedef short s16x4 __attribute__((ext_vector_type(4)));
typedef float f32x16 __attribute__((ext_vector_type(16)));
typedef float f32x4 __attribute__((ext_vector_type(4)));
typedef float f32x2 __attribute__((ext_vector_type(2)));
typedef __bf16 bf16v2 __attribute__((ext_vector_type(2)));
typedef unsigned u32x4 __attribute__((ext_vector_type(4)));
typedef unsigned u32x2 __attribute__((ext_vector_type(2)));
#define DI __device__ __forceinline__
#define LAS __attribute__((address_space(3)))
#define MFMA32(a, b, c) __builtin_amdgcn_mfma_f32_32x32x16_bf16((a), (b), (c), 0, 0, 0)

constexpr int NT = 512, NW = 8;
constexpr int NB = 8, SEQ = 8192, DM = 1024, NTOK = NB * SEQ;
constexpr int N1 = 4608;
constexpr float DN_ALPHA = 1.189207115002721f;
constexpr float LN_EPS = 1e-5f;

constexpr size_t MB = 1024 * 1024;
constexpr size_t OFF_MOD = 0;
constexpr size_t OFF_ROPE = OFF_MOD + 256 * 1024;
constexpr size_t OFF_POSB = OFF_ROPE + 2 * MB;
constexpr size_t OFF_WT1 = OFF_POSB + 4096;
constexpr size_t OFF_WB = OFF_WT1 + (size_t)N1 * 1024 * 2;
constexpr size_t OFF_WOUT = OFF_WB + 2 * MB;
constexpr size_t OFF_WQ = OFF_WOUT + 2 * MB;
constexpr size_t OFF_PKEYS = OFF_WQ + 4 * MB;
constexpr size_t OFF_CW1 = OFF_PKEYS + MB / 2;
constexpr size_t OFF_CW2 = OFF_CW1 + MB;
constexpr size_t OFF_SGUW = OFF_CW2 + 32 * 1024;
constexpr size_t OFF_SCU = OFF_SGUW + 256 * 1024;
constexpr size_t OFF_SCV = OFF_SCU + 64 * 1024;
constexpr size_t OFF_PU = OFF_SCV + 64 * 1024;
constexpr size_t OFF_PV = OFF_PU + 32 * MB;
constexpr size_t OFF_ACT = ((OFF_PV + 32 * MB + 4095) / 4096) * 4096;
constexpr size_t OFF_H = OFF_ACT;
constexpr size_t OFF_Q = OFF_H + 128 * MB;
constexpr size_t OFF_KC = OFF_Q + 64 * MB;
constexpr size_t OFF_VC = OFF_KC + 16 * MB;
constexpr size_t OFF_KS = OFF_VC + 16 * MB;
constexpr size_t OFF_VS = OFF_KS + 16 * MB;
constexpr size_t OFF_KW = OFF_VS + 16 * MB;
constexpr size_t OFF_VW = OFF_KW + 16 * MB;
constexpr size_t OFF_U = OFF_VW + 16 * MB;
constexpr size_t OFF_V = OFF_U + 64 * MB;
constexpr size_t OFF_GATE = OFF_V + 64 * MB;
constexpr size_t OFF_GSIG = OFF_GATE + 256 * MB;
constexpr size_t OFF_KCMP = OFF_GSIG + 8 * MB;
constexpr size_t OFF_VCMP = OFF_KCMP + MB;
constexpr size_t OFF_ONSA = OFF_VCMP + MB;
constexpr size_t OFF_SELG = OFF_ONSA + 64 * MB;
constexpr size_t OFF_BAR = OFF_SELG + 2 * MB;
constexpr size_t OFF_END = OFF_BAR + 64 * 1024;
constexpr size_t OFF_X1 = OFF_Q;
constexpr size_t OFF_Y = OFF_GATE;
constexpr size_t OFF_PQ = OFF_GATE;
constexpr size_t OFF_EIDX = OFF_ONSA;
constexpr size_t OFF_PGATE = OFF_ONSA + 32 * MB;
constexpr size_t OFF_PU8 = OFF_PU;
constexpr size_t OFF_PART = OFF_GATE;
constexpr size_t OFF_PV8 = OFF_PU + 16 * MB;
constexpr size_t OFF_WBUF = OFF_PU + 32 * MB;
constexpr size_t OFF_FFNB = OFF_GATE;

struct Params {
  const float *x, *c, *w_ada, *b_ada, *w_in, *cmp_pos, *cmp_w1, *cmp_b1, *cmp_w2, *cmp_b2, *sgu_ln_g, *sgu_ln_b, *sgu_w, *sgu_b,
      *w_branch, *w_merge, *b_merge, *w_out, *ln1_g, *ln1_b, *peer_wq, *peer_keys, *peer_u, *peer_v, *ln2_g, *ln2_b;
  float* out;
  char* ws;
  float inv_freq[32];
};

DI unsigned pack2(float lo, float hi) { f32x2 v = {lo, hi}; bf16v2 r = __builtin_convertvector(v, bf16v2); return __builtin_bit_cast(unsigned, r); }
DI bf16_t f2bf(float f) { __bf16 r = (__bf16)f; return __builtin_bit_cast(unsigned short, r); }
DI float bf2f(bf16_t h) { return __uint_as_float(((unsigned)h) << 16); }
DI float bflo(unsigned u) { return __uint_as_float(u << 16); }
DI float bfhi(unsigned u) { return __uint_as_float(u & 0xffff0000u); }
DI float gelu_f(float v) { return 0.5f * v * (1.0f + erff(v * 0.70710678118654752f)); }
DI float sigmoid_f(float v) { return 1.0f / (1.0f + __expf(-v)); }
DI int otid() { int t = __builtin_amdgcn_workitem_id_x(); asm volatile("" : "+v"(t)); return t; }
DI void lds_barrier() { asm volatile("s_waitcnt lgkmcnt(0)" ::: "memory"); __builtin_amdgcn_s_barrier(); asm volatile("" ::: "memory"); }
DI float wave_sum(float v) {
#pragma unroll
  for (int o = 32; o > 0; o >>= 1) v += __shfl_xor(v, o);
  return v;
}
DI void ld8(const float* pz, float (&v)[8]) { const f32x4 a = *(const f32x4*)pz, b = *(const f32x4*)(pz + 4); v[0] = a.x; v[1] = a.y; v[2] = a.z; v[3] = a.w; v[4] = b.x; v[5] = b.y; v[6] = b.z; v[7] = b.w; }
DI u32x4 pack8(const float (&v)[8]) { u32x4 w; w.x = pack2(v[0], v[1]); w.y = pack2(v[2], v[3]); w.z = pack2(v[4], v[5]); w.w = pack2(v[6], v[7]); return w; }
DI void unpack8(const u32x4 w, float (&v)[8]) { v[0] = bflo(w.x); v[1] = bfhi(w.x); v[2] = bflo(w.y); v[3] = bfhi(w.y); v[4] = bflo(w.z); v[5] = bfhi(w.z); v[6] = bflo(w.w); v[7] = bfhi(w.w); }
DI f32x2 gelu_pk(f32x2 v) {
  const f32x2 av = __builtin_elementwise_abs(v), d = av * 0.2316418882f + 1.0f;
  f32x2 t; t.x = __builtin_amdgcn_rcpf(d.x); t.y = __builtin_amdgcn_rcpf(d.y);
  f32x2 q = t * 0.5307027145f + (-0.7265760135f); q = q * t + 0.7107068705f; q = q * t + (-0.142248368f); q = q * t + 0.127414796f; q = q * t;
  const f32x2 s = (v * v) * (-0.72134752044f);
  f32x2 e; e.x = __builtin_amdgcn_exp2f(s.x); e.y = __builtin_amdgcn_exp2f(s.y);
  const f32x2 m = v * (q * e), r = v - m;
  f32x2 o; o.x = v.x < 0.f ? m.x : r.x; o.y = v.y < 0.f ? m.y : r.y; return o;
}
__host__ __device__ __forceinline__ int dperm(int q) { const int grp = q >> 5, fq = (q >> 3) & 3, j = q & 7; return (j < 4) ? (16 * grp + 4 * fq + j) : (32 + 16 * grp + 4 * fq + (j - 4)); }

template <class F>
DI void tconv_tile(float* tile, int k0, int n0, bf16_t* dst, int ldd, F f) {
  const int tid = otid();
  __syncthreads();
#pragma unroll 4
  for (int i = 0; i < 8; ++i) { const int kl = i * 8 + (tid >> 6), nl = tid & 63; tile[nl * 65 + kl] = f(k0 + kl, n0 + nl); }
  __syncthreads();
  {
    const int nl = tid >> 3, kc = tid & 7;
    const float* t = tile + nl * 65 + kc * 8;
    u32x4 w; w.x = pack2(t[0], t[1]); w.y = pack2(t[2], t[3]); w.z = pack2(t[4], t[5]); w.w = pack2(t[6], t[7]);
    *(u32x4*)(dst + (size_t)(n0 + nl) * ldd + k0 + kc * 8) = w;
  }
}

DI void conv_chunk(const float* src, bf16_t* dst, size_t base) {
  const size_t i = base + (size_t)otid() * 8;
  const f32x4 a = *(const f32x4*)(src + i), b = *(const f32x4*)(src + i + 4);
  u32x4 w; w.x = pack2(a.x, a.y); w.y = pack2(a.z, a.w); w.z = pack2(b.x, b.y); w.w = pack2(b.z, b.w);
  *(u32x4*)(dst + i) = w;
}

DI void sincos_d(double x, double& s, double& c) {
  const double y = x * 0.25, y2 = y * y;
  double sn = y * (1.0 + y2 * (-1.0 / 6 + y2 * (1.0 / 120 + y2 * (-1.0 / 5040 + y2 * (1.0 / 362880 + y2 * (-1.0 / 39916800 + y2 * (1.0 / 6227020800.0)))))));
  double cs = 1.0 + y2 * (-0.5 + y2 * (1.0 / 24 + y2 * (-1.0 / 720 + y2 * (1.0 / 40320 + y2 * (-1.0 / 3628800 + y2 * (1.0 / 479001600.0 + y2 * (-1.0 / 87178291200.0)))))));
#pragma unroll
  for (int i = 0; i < 2; ++i) { const double s2 = 2.0 * sn * cs, c2 = cs * cs - sn * sn; sn = s2; cs = c2; }
  s = sn; c = cs;
}

DI void phase_prep(const Params& p, char* smem) {
  const int tid = otid();
  float* fs = (float*)smem;
  char* ws = p.ws;
  constexpr int nA = 192, nB = 16 * 72, nC = 2 * 8 * 16, nD = 256, nE = 16 * 32, nF = 2 * 32 * 2, nG = 4, nH = 8, nI = 512, nJ = 64, nK = 32, nL = 2048, nM = 2048;
  constexpr int total = nA + nB + nC + nD + nE + nF + nG + nH + nI + nJ + nK + nL + nM;
  for (int item = blockIdx.x; item < total; item += gridDim.x) {
    int it = item;
    if (it < nA) {
      float* sc = fs;
      float* red = fs + 8192;
      __syncthreads();
      for (int i = tid; i < 8192; i += NT) { const float v = p.c[i]; sc[i] = v / (1.0f + __expf(-v)); }
      __syncthreads();
      const int ks = tid >> 5, cj = tid & 31, col = it * 32 + cj;
      float acc[8];
#pragma unroll
      for (int b = 0; b < 8; ++b) acc[b] = 0.f;
#pragma unroll 4
      for (int k = ks * 64; k < ks * 64 + 64; ++k) {
        const float w = p.w_ada[(size_t)k * 6144 + col];
#pragma unroll
        for (int b = 0; b < 8; ++b) acc[b] += sc[b * 1024 + k] * w;
      }
#pragma unroll
      for (int b = 0; b < 8; ++b) red[(ks * 8 + b) * 32 + cj] = acc[b];
      __syncthreads();
      if (tid < 256) {
        const int b = tid >> 5;
        float s = p.b_ada[col];
#pragma unroll
        for (int k2 = 0; k2 < 16; ++k2) s += red[(k2 * 8 + b) * 32 + cj];
        ((float*)(ws + OFF_MOD))[b * 6144 + col] = s;
      }
      continue;
    }
    it -= nA;
    if (it < nB) {
      const int kt = it / 72, ntile = it % 72;
      const float* w_in = p.w_in; const float* w_merge = p.w_merge;
      tconv_tile(fs, kt * 64, ntile * 64, (bf16_t*)(ws + OFF_WT1), 1024, [=](int k, int n) -> float {
        if (n < 1280) {
          const bool roped = (n < 640) || (n >= 768 && n < 896) || (n >= 1024 && n < 1152);
          const int col = roped ? ((n & ~63) + dperm(n & 63)) : n;
          return w_in[(size_t)k * 2328 + col];
        }
        if (n < 2304) return w_in[(size_t)k * 2328 + n + 24];
        if (n < 4352) return w_merge[(size_t)k * 2048 + (n - 2304)];
        if (n < 4376) return w_in[(size_t)k * 2328 + 1280 + (n - 4352)];
        return 0.f; });
      continue;
    }
    it -= nB;
    if (it < nC) {
      const int br = it >> 7, r = it & 127, kt = r >> 4, ntile = r & 15;
      const float* src = p.w_branch + (size_t)br * 512 * 1024;
      tconv_tile(fs, kt * 64, ntile * 64, (bf16_t*)(ws + OFF_WB) + (size_t)br * 1024 * 512, 512, [=](int k, int n) -> float { return src[(size_t)k * 1024 + n]; });
      continue;
    }
    it -= nC;
    if (it < nD) {
      const int kt = it >> 4, ntile = it & 15;
      const float* src = p.w_out;
      tconv_tile(fs, kt * 64, ntile * 64, (bf16_t*)(ws + OFF_WOUT), 1024, [=](int k, int n) -> float { return src[(size_t)k * 1024 + n]; });
      continue;
    }
    it -= nD;
    if (it < nE) {
      const int kt = it >> 5, ntile = it & 31;
      const float* src = p.peer_wq;
      tconv_tile(fs, kt * 64, ntile * 64, (bf16_t*)(ws + OFF_WQ), 1024, [=](int k, int n) -> float { return src[(size_t)k * 2048 + n]; });
      continue;
    }
    it -= nE;
    if (it < nF) {
      const int w = it >> 6, r = it & 63, kt = r >> 1, ntile = r & 1;
      const float* src = p.cmp_w1 + (size_t)w * 2048 * 128;
      tconv_tile(fs, kt * 64, ntile * 64, (bf16_t*)(ws + OFF_CW1) + (size_t)w * 128 * 2048, 2048, [=](int k, int n) -> float {
        const int ksrc = (w == 0) ? ((k & ~63) + dperm(k & 63)) : k;
        return src[(size_t)ksrc * 128 + n]; });
      continue;
    }
    it -= nF;
    if (it < nG) {
      const int w = it >> 1, kt = it & 1;
      const float* src = p.cmp_w2 + (size_t)w * 128 * 64;
      tconv_tile(fs, kt * 64, 0, (bf16_t*)(ws + OFF_CW2) + (size_t)w * 64 * 128, 128, [=](int k, int n) -> float { return src[(size_t)k * 64 + ((w == 0) ? dperm(n) : n)]; });
      continue;
    }
    it -= nG;
    if (it < nH) {
      const int w = it >> 2, jc = it & 3, ks = tid >> 5, cj = tid & 31, j = jc * 32 + cj;
      float* red = fs;
      const float* pos = p.cmp_pos + w * 2048; const float* w1 = p.cmp_w1 + (size_t)w * 2048 * 128;
      float acc = 0.f;
#pragma unroll 4
      for (int k = ks * 128; k < ks * 128 + 128; ++k) acc += pos[k] * w1[(size_t)k * 128 + j];
      __syncthreads();
      red[ks * 32 + cj] = acc;
      __syncthreads();
      if (tid < 32) { float s = p.cmp_b1[w * 128 + j]; for (int k2 = 0; k2 < 16; ++k2) s += red[k2 * 32 + tid]; ((float*)(ws + OFF_POSB))[w * 128 + j] = s; }
      continue;
    }
    it -= nH;
    if (it < nI) {
      const int e = it * 512 + tid, pos = e >> 5, i = e & 31;
      const float ang = (float)pos * p.inv_freq[i];
      const double a = (double)ang;
      const double kk = rint(a * 0.15915494309189535);
      const double r = a - kk * 6.283185307179586476925;
      double s, c; sincos_d(r, s, c);
      ((float*)(ws + OFF_ROPE))[e] = (float)c;
      ((float*)(ws + OFF_ROPE))[262144 + e] = (float)s;
      continue;
    }
    it -= nI;
    if (it < nJ) { conv_chunk(p.peer_keys, (bf16_t*)(ws + OFF_PKEYS), (size_t)it * 4096); continue; }
    it -= nJ;
    if (it < nK) {
      const size_t i0 = (size_t)it * 4096 + (size_t)tid * 8;
      const int rowi = (int)((i0 >> 7) & 127), j0 = (int)(i0 & 127);
      float v[8];
#pragma unroll
      for (int j = 0; j < 8; ++j) v[j] = (j0 + j <= rowi) ? p.sgu_w[i0 + j] : 0.f;
      u32x4 w; w.x = pack2(v[0], v[1]); w.y = pack2(v[2], v[3]); w.z = pack2(v[4], v[5]); w.w = pack2(v[6], v[7]);
      *(u32x4*)((bf16_t*)(ws + OFF_SGUW) + i0) = w;
      continue;
    }
    it -= nK;
    {
      const bool isv = it >= nL;
      if (isv) it -= nL;
      const int lane = tid & 63, e = it * 8 + (tid >> 6);
      const float* src = (isv ? p.peer_v : p.peer_u) + (size_t)e * 1024 + lane * 16;
      float v[16];
#pragma unroll
      for (int i = 0; i < 4; ++i) { const f32x4 t4 = *(const f32x4*)(src + i * 4); v[4 * i] = t4.x; v[4 * i + 1] = t4.y; v[4 * i + 2] = t4.z; v[4 * i + 3] = t4.w; }
      float amax = 0.f;
#pragma unroll
      for (int i = 0; i < 16; ++i) amax = fmaxf(amax, fabsf(v[i]));
#pragma unroll
      for (int o = 32; o > 0; o >>= 1) amax = fmaxf(amax, __shfl_xor(amax, o));
      const unsigned be = (__float_as_uint(amax) >> 23) & 0xffu;
      const bool okr = be >= 16u && be <= 240u;
      const float scale = okr ? __uint_as_float((261u - be) << 23) : 1.0f;
      const float inv = okr ? __uint_as_float((be - 7u) << 23) : 1.0f;
      u32x4 w;
      int t0 = 0, t1 = 0, t2 = 0, t3 = 0;
      t0 = __builtin_amdgcn_cvt_pk_fp8_f32(v[0] * scale, v[1] * scale, t0, false); t0 = __builtin_amdgcn_cvt_pk_fp8_f32(v[2] * scale, v[3] * scale, t0, true);
      t1 = __builtin_amdgcn_cvt_pk_fp8_f32(v[4] * scale, v[5] * scale, t1, false); t1 = __builtin_amdgcn_cvt_pk_fp8_f32(v[6] * scale, v[7] * scale, t1, true);
      t2 = __builtin_amdgcn_cvt_pk_fp8_f32(v[8] * scale, v[9] * scale, t2, false); t2 = __builtin_amdgcn_cvt_pk_fp8_f32(v[10] * scale, v[11] * scale, t2, true);
      t3 = __builtin_amdgcn_cvt_pk_fp8_f32(v[12] * scale, v[13] * scale, t3, false); t3 = __builtin_amdgcn_cvt_pk_fp8_f32(v[14] * scale, v[15] * scale, t3, true);
      w.x = (unsigned)t0; w.y = (unsigned)t1; w.z = (unsigned)t2; w.w = (unsigned)t3;
      if (!isv) {
        *(u32x4*)(ws + OFF_PU8 + ((size_t)(lane >> 3) * 16384 + e) * 128 + (lane & 7) * 16) = w;
        if (lane == 0) ((float*)(ws + OFF_SCU))[e] = inv;
      } else {
        *(u32x4*)(ws + OFF_PV8 + ((size_t)(lane >> 3) * 16384 + e) * 128 + (lane & 7) * 16) = w;
        if (lane == 0) ((float*)(ws + OFF_SCV))[e] = inv;
      }
    }
  }
}

DI void row_stats(const float (&v)[16], float& mean, float& rstd) {
  float s = 0.f;
#pragma unroll
  for (int i = 0; i < 16; ++i) s += v[i];
  mean = wave_sum(s) * (1.0f / 1024.0f);
  float q = 0.f;
#pragma unroll
  for (int i = 0; i < 16; ++i) { const float d = v[i] - mean; q += d * d; }
  rstd = rsqrtf(wave_sum(q) * (1.0f / 1024.0f) + LN_EPS);
}

DI void phase_ln_in(const Params& p) {
  const int lane = otid() & 63, wave = otid() >> 6;
  const float* mod = (const float*)(p.ws + OFF_MOD);
  bf16_t* h = (bf16_t*)(p.ws + OFF_H);
  for (int grp = blockIdx.x; grp < NTOK / NW; grp += gridDim.x) {
    const int row = grp * NW + wave, b = row >> 13;
    const float* xr = p.x + (size_t)row * DM;
    float v[16];
#pragma unroll
    for (int i = 0; i < 4; ++i) { const f32x4 t = *(const f32x4*)(xr + i * 256 + lane * 4); v[4 * i] = t.x; v[4 * i + 1] = t.y; v[4 * i + 2] = t.z; v[4 * i + 3] = t.w; }
    float mean, rstd; row_stats(v, mean, rstd);
#pragma unroll
    for (int i = 0; i < 4; ++i) {
      const int col = i * 256 + lane * 4;
      const f32x4 sh = *(const f32x4*)(mod + b * 6144 + col), sc = *(const f32x4*)(mod + b * 6144 + 1024 + col);
      const float o0 = (v[4 * i] - mean) * rstd * (1.f + sc.x) + sh.x, o1 = (v[4 * i + 1] - mean) * rstd * (1.f + sc.y) + sh.y;
      const float o2 = (v[4 * i + 2] - mean) * rstd * (1.f + sc.z) + sh.z, o3 = (v[4 * i + 3] - mean) * rstd * (1.f + sc.w) + sh.w;
      u32x2 w; w.x = pack2(o0, o1); w.y = pack2(o2, o3);
      *(u32x2*)(h + (size_t)row * DM + col) = w;
    }
  }
}

DI void phase_ln_mid(const Params& p) {
  const int lane = otid() & 63, wave = otid() >> 6;
  const float* mod = (const float*)(p.ws + OFF_MOD);
  const bf16_t* y = (const bf16_t*)(p.ws + OFF_Y);
  bf16_t* x1 = (bf16_t*)(p.ws + OFF_X1);
  bf16_t* h2 = (bf16_t*)(p.ws + OFF_H);
  for (int grp = blockIdx.x; grp < NTOK / NW; grp += gridDim.x) {
    const int row = grp * NW + wave, b = row >> 13;
    const bf16_t* yr = y + (size_t)row * DM;
    float v[16];
#pragma unroll
    for (int i = 0; i < 4; ++i) { const u32x2 t = *(const u32x2*)(yr + i * 256 + lane * 4); v[4 * i] = bflo(t.x); v[4 * i + 1] = bfhi(t.x); v[4 * i + 2] = bflo(t.y); v[4 * i + 3] = bfhi(t.y); }
    float mean, rstd; row_stats(v, mean, rstd);
#pragma unroll
    for (int i = 0; i < 4; ++i) {
      const int col = i * 256 + lane * 4;
      const f32x4 g = *(const f32x4*)(p.ln1_g + col), bb = *(const f32x4*)(p.ln1_b + col);
      f32x4 o;
      o.x = (v[4 * i] - mean) * rstd * g.x + bb.x; o.y = (v[4 * i + 1] - mean) * rstd * g.y + bb.y;
      o.z = (v[4 * i + 2] - mean) * rstd * g.z + bb.z; o.w = (v[4 * i + 3] - mean) * rstd * g.w + bb.w;
      { u32x2 w; w.x = pack2(o.x, o.y); w.y = pack2(o.z, o.w); *(u32x2*)(x1 + (size_t)row * DM + col) = w; }
      v[4 * i] = o.x; v[4 * i + 1] = o.y; v[4 * i + 2] = o.z; v[4 * i + 3] = o.w;
    }
    row_stats(v, mean, rstd);
#pragma unroll
    for (int i = 0; i < 4; ++i) {
      const int col = i * 256 + lane * 4;
      const f32x4 sh = *(const f32x4*)(mod + b * 6144 + 3072 + col), sc = *(const f32x4*)(mod + b * 6144 + 4096 + col);
      const float o0 = (v[4 * i] - mean) * rstd * (1.f + sc.x) + sh.x, o1 = (v[4 * i + 1] - mean) * rstd * (1.f + sc.y) + sh.y;
      const float o2 = (v[4 * i + 2] - mean) * rstd * (1.f + sc.z) + sh.z, o3 = (v[4 * i + 3] - mean) * rstd * (1.f + sc.w) + sh.w;
      u32x2 w; w.x = pack2(o0, o1); w.y = pack2(o2, o3);
      *(u32x2*)(h2 + (size_t)row * DM + col) = w;
    }
  }
}

namespace pg8 {
constexpr int BM = 256, BK = 64, HALF = 128, HTB = HALF * BK * 2, STAGE_BYTES = 8 * HTB, NXCD = 8, WGM = 8;
DI int lds_byte(int r, int c) { const int st = (r >> 4) * 2 + (c >> 5), rr = r & 15, cc = c & 31, ob = rr * 64 + cc * 2; return st * 1024 + (ob ^ (((ob >> 9) & 1) << 5)); }
DI void stage_rc(int b, int& R, int& C) { const int st = b / 1024, sb = b % 1024, swz = sb ^ (((sb >> 9) & 1) << 5); R = (st >> 1) * 16 + swz / 64; C = (st & 1) * 32 + (swz % 64) / 2; }
DI int perm32(int rho) { const int n = rho >> 4, i = rho & 15; return 8 * (i >> 2) + 4 * n + (i & 3); }
struct Unit { int pm, pn; };
struct Gemm { const bf16_t* A; const bf16_t* Bt; int M, N, K; };
struct StaticOrder {
  int nM, nN, nwg, G, c;
  DI void init(int M, int N, int G_, int c_) { nM = M / BM; nN = N / BM; nwg = nM * nN; G = G_; c = c_; }
  DI bool next(int i, Unit& u) const {
    const long L = (long)i * G + c; if (L >= nwg) return false;
    int wgid = (int)L; { const int q = nwg / NXCD, r = nwg % NXCD, xcd = wgid % NXCD, off = wgid / NXCD; wgid = (xcd < r ? xcd * (q + 1) : r * (q + 1) + (xcd - r) * q) + off; }
    const int nig = WGM * nN, gid = wgid / nig, fm = gid * WGM, gsz = (nM - fm) < WGM ? (nM - fm) : WGM;
    u.pm = fm + ((wgid % nig) % gsz); u.pn = (wgid % nig) / gsz; return true;
  }
};

template <class Epi>
DI void gemm_phase(LAS unsigned char* lds, const Gemm g, const StaticOrder& S, const Epi& E) {
  const int tid = otid(), wid = __builtin_amdgcn_readfirstlane(tid >> 6), lane = tid & 63, wr = wid >> 2, wc = wid & 3, fr = lane & 15, fq = lane >> 4;
  const int K = g.K, nt = K / BK;
  unsigned voffA[2], voffB[2];
#pragma unroll
  for (int i = 0; i < 2; ++i) { int R, C; stage_rc(tid * 16 + i * 8192, R, C); const int Rb = Epi::PERM ? ((R & ~31) + perm32(R & 31)) : R;
    voffA[i] = (unsigned)(R * K + C) * 2u; voffB[i] = (unsigned)(Rb * K + C) * 2u; }
  const size_t kstep = (size_t)(BK * 2);
  const size_t hstep = (size_t)HALF * K * 2;
  const size_t tstep = 2 * hstep;
  const unsigned ldsw = (unsigned)wid * 1024u;
  const int aoff = lds_byte(wr * 64 + fr, fq * 8), boff = lds_byte(wc * 32 + fr, fq * 8);
#define PG8_SA(b, h) (((b) * 2 + (h)) * HTB)
#define PG8_SB(b, h) ((4 + (b) * 2 + (h)) * HTB)
#define PG8_STAGE(bufoff, gbase, voff) do { _Pragma("unroll") for (int _i = 0; _i < 2; ++_i) \
    __builtin_amdgcn_global_load_lds((const unsigned*)((const char*)(gbase) + (voff)[_i]), (LAS unsigned*)(lds + (bufoff) + ldsw + _i * 8192), 16, 0, 0); } while (0)
#define PG8_LDA(dst, b, h) do { _Pragma("unroll") for (int m = 0; m < 4; ++m) _Pragma("unroll") for (int k = 0; k < 2; ++k) dst[m][k] = *(const LAS bf16x8*)(lds + PG8_SA(b, h) + aoff + m * 2048 + k * 1024); } while (0)
#define PG8_LDB(dst, b, h) do { _Pragma("unroll") for (int n = 0; n < 2; ++n) _Pragma("unroll") for (int k = 0; k < 2; ++k) dst[n][k] = *(const LAS bf16x8*)(lds + PG8_SB(b, h) + boff + n * 2048 + k * 1024); } while (0)
#define PG8_MMA(ai, bj, At, Bt) do { __builtin_amdgcn_s_setprio(1); _Pragma("unroll") for (int m = 0; m < 4; ++m) _Pragma("unroll") for (int n = 0; n < 2; ++n) _Pragma("unroll") for (int k = 0; k < 2; ++k) \
    acc[ai][bj][m][n] = __builtin_amdgcn_mfma_f32_16x16x32_bf16(Bt[n][k], At[m][k], acc[ai][bj][m][n], 0, 0, 0); __builtin_amdgcn_s_setprio(0); } while (0)
#define PG8_WAIT_V(n) asm volatile("s_waitcnt vmcnt(" #n ")" ::: "memory")
#define PG8_WAIT_L(n) asm volatile("s_waitcnt lgkmcnt(" #n ")" ::: "memory")
#define PG8_BAR __builtin_amdgcn_s_barrier()
#define PG8_SCHED __builtin_amdgcn_sched_barrier(0)
  Unit cur, nxt; int ui = 0;
  if (!S.next(0, cur)) return;
  f32x4 acc[2][2][4][2];
#pragma unroll
  for (int a = 0; a < 2; ++a)
#pragma unroll
    for (int b = 0; b < 2; ++b)
#pragma unroll
      for (int m = 0; m < 4; ++m)
#pragma unroll
        for (int n = 0; n < 2; ++n) acc[a][b][m][n] = (f32x4){0.f, 0.f, 0.f, 0.f};
  bf16x8 At[4][2], B0[2][2], B1[2][2];
  const char* cA = (const char*)g.A + (size_t)cur.pm * tstep; const char* cB = (const char*)g.Bt + (size_t)cur.pn * tstep;
  PG8_STAGE(PG8_SB(0, 0), cB, voffB); PG8_STAGE(PG8_SA(0, 0), cA, voffA); PG8_STAGE(PG8_SB(0, 1), cB + hstep, voffB); PG8_STAGE(PG8_SA(0, 1), cA + hstep, voffA);
  if (wr == 1) PG8_BAR;
  PG8_WAIT_V(4); PG8_BAR;
  PG8_STAGE(PG8_SB(1, 0), cB + kstep, voffB); PG8_STAGE(PG8_SA(1, 0), cA + kstep, voffA); PG8_STAGE(PG8_SB(1, 1), cB + hstep + kstep, voffB);
  PG8_WAIT_V(6); PG8_BAR;
  for (;;) {
    const bool has_next = S.next(ui + 1, nxt);
    const char* nA = has_next ? (const char*)g.A + (size_t)nxt.pm * tstep : cA; const char* nB = has_next ? (const char*)g.Bt + (size_t)nxt.pn * tstep : cB;
    for (int t = 0; t < nt; t += 2) {
      const bool last = (t == nt - 2);
      const char* a1 = cA + (size_t)(t + 1) * kstep;
      const char* a2 = last ? nA : cA + (size_t)(t + 2) * kstep; const char* b2 = last ? nB : cB + (size_t)(t + 2) * kstep;
      const char* a3 = a2 + kstep; const char* b3 = b2 + kstep;
      PG8_LDB(B0, 0, 0); PG8_SCHED; PG8_LDA(At, 0, 0); PG8_STAGE(PG8_SA(1, 1), a1 + hstep, voffA);
      PG8_WAIT_L(8); PG8_BAR; PG8_WAIT_L(0); PG8_MMA(0, 0, At, B0); PG8_BAR; PG8_SCHED;
      PG8_LDB(B1, 0, 1); PG8_STAGE(PG8_SB(0, 0), b2, voffB);
      PG8_BAR; PG8_WAIT_L(0); PG8_MMA(0, 1, At, B1); PG8_BAR;
      PG8_LDA(At, 0, 1); PG8_STAGE(PG8_SA(0, 0), a2, voffA);
      PG8_BAR; PG8_WAIT_L(0); PG8_MMA(1, 0, At, B0); PG8_BAR; PG8_SCHED;
      PG8_STAGE(PG8_SB(0, 1), b2 + hstep, voffB);
      PG8_WAIT_V(6); PG8_BAR; PG8_MMA(1, 1, At, B1); PG8_BAR;
      PG8_LDB(B0, 1, 0); PG8_SCHED; PG8_LDA(At, 1, 0); PG8_STAGE(PG8_SA(0, 1), a2 + hstep, voffA);
      PG8_WAIT_L(8); PG8_BAR; PG8_WAIT_L(0); PG8_MMA(0, 0, At, B0); PG8_BAR; PG8_SCHED;
      PG8_LDB(B1, 1, 1); PG8_STAGE(PG8_SB(1, 0), b3, voffB);
      PG8_BAR; PG8_WAIT_L(0); PG8_MMA(0, 1, At, B1); PG8_BAR;
      PG8_LDA(At, 1, 1); PG8_STAGE(PG8_SA(1, 0), a3, voffA);
      PG8_BAR; PG8_WAIT_L(0); PG8_MMA(1, 0, At, B0); PG8_BAR; PG8_SCHED;
      PG8_STAGE(PG8_SB(1, 1), b3 + hstep, voffB);
      PG8_WAIT_V(6); PG8_BAR; PG8_MMA(1, 1, At, B1); PG8_BAR;
    }
    E(acc, cur, wr, wc, fr, fq);
    if (!has_next) break;
#pragma unroll
    for (int a = 0; a < 2; ++a)
#pragma unroll
      for (int b = 0; b < 2; ++b)
#pragma unroll
        for (int m = 0; m < 4; ++m)
#pragma unroll
          for (int n = 0; n < 2; ++n) acc[a][b][m][n] = (f32x4){0.f, 0.f, 0.f, 0.f};
    cur = nxt; cA = nA; cB = nB; ++ui;
  }
  PG8_WAIT_V(0);
  if (wr == 0) PG8_BAR;
  PG8_BAR;
#undef PG8_SA
#undef PG8_SB
#undef PG8_STAGE
#undef PG8_LDA
#undef PG8_LDB
#undef PG8_MMA
#undef PG8_WAIT_V
#undef PG8_WAIT_L
#undef PG8_BAR
#undef PG8_SCHED
}
}

struct EpiProj {
  static constexpr bool PERM = true;
  char* ws; const float* b_merge;
  DI void operator()(const f32x4 (&acc)[2][2][4][2], const pg8::Unit& u, int wr, int wc, int fr, int fq) const {
    const float* rope = (const float*)(ws + OFF_ROPE);
    const int row0 = u.pm * 256 + wr * 64 + fr;
#pragma unroll
    for (int bj = 0; bj < 2; ++bj) {
      const int cg = u.pn * 256 + bj * 128 + wc * 32;
      const int c0 = cg + 8 * fq;
      if (cg >= 4384) continue;
      if (cg < 1280 && (cg < 640 || (cg >= 768 && cg < 896) || (cg >= 1024 && cg < 1152))) {
        bf16_t* dst; unsigned ld, cofs; float scale = 1.0f;
        if (cg < 512) { dst = (bf16_t*)(ws + OFF_Q); ld = 512; cofs = c0; scale = 0.18033688011112042f; }
        else if (cg < 640) { dst = (bf16_t*)(ws + OFF_KC); ld = 128; cofs = c0 - 512; }
        else if (cg < 896) { dst = (bf16_t*)(ws + OFF_KS); ld = 128; cofs = c0 - 768; }
        else { dst = (bf16_t*)(ws + OFF_KW); ld = 128; cofs = c0 - 1024; }
        const int d0 = 16 * ((cg >> 5) & 1) + 4 * fq;
#pragma unroll
        for (int ai = 0; ai < 2; ++ai)
#pragma unroll
          for (int m = 0; m < 4; ++m) {
            const int row = row0 + ai * 128 + m * 16, pos = row & (SEQ - 1);
            const f32x4 cs = *(const f32x4*)(rope + pos * 32 + d0), sn = *(const f32x4*)(rope + 262144 + pos * 32 + d0);
            const f32x4 t1 = acc[ai][bj][m][0], t2 = acc[ai][bj][m][1];
            const f32x4 o1 = (t1 * cs - t2 * sn) * scale, o2 = (t1 * sn + t2 * cs) * scale;
            u32x4 w; w.x = pack2(o1.x, o1.y); w.y = pack2(o1.z, o1.w); w.z = pack2(o2.x, o2.y); w.w = pack2(o2.z, o2.w);
            *(u32x4*)(dst + (unsigned)row * ld + cofs) = w;
          }
      } else if (cg < 1280) {
        bf16_t* dst; unsigned cofs;
        if (cg < 768) { dst = (bf16_t*)(ws + OFF_VC); cofs = c0 - 640; }
        else if (cg < 1024) { dst = (bf16_t*)(ws + OFF_VS); cofs = c0 - 896; }
        else { dst = (bf16_t*)(ws + OFF_VW); cofs = c0 - 1152; }
#pragma unroll
        for (int ai = 0; ai < 2; ++ai)
#pragma unroll
          for (int m = 0; m < 4; ++m) {
            const int row = row0 + ai * 128 + m * 16;
            const f32x4 a = acc[ai][bj][m][0], b = acc[ai][bj][m][1];
            u32x4 w; w.x = pack2(a.x, a.y); w.y = pack2(a.z, a.w); w.z = pack2(b.x, b.y); w.w = pack2(b.z, b.w);
            *(u32x4*)(dst + (unsigned)row * 128u + cofs) = w;
          }
      } else if (cg < 2304) {
        bf16_t* dst = (bf16_t*)(ws + (cg < 1792 ? OFF_U : OFF_V));
        const unsigned cofs = c0 - (cg < 1792 ? 1280 : 1792);
#pragma unroll
        for (int ai = 0; ai < 2; ++ai)
#pragma unroll
          for (int m = 0; m < 4; ++m) {
            const int row = row0 + ai * 128 + m * 16;
            const f32x4 a = acc[ai][bj][m][0], b = acc[ai][bj][m][1];
            const f32x2 g0 = gelu_pk((f32x2){a.x, a.y}), g1 = gelu_pk((f32x2){a.z, a.w}), g2 = gelu_pk((f32x2){b.x, b.y}), g3 = gelu_pk((f32x2){b.z, b.w});
            u32x4 w; w.x = pack2(g0.x, g0.y); w.y = pack2(g1.x, g1.y); w.z = pack2(g2.x, g2.y); w.w = pack2(g3.x, g3.y);
            *(u32x4*)(dst + (unsigned)row * 512u + cofs) = w;
          }
      } else if (cg < 4352) {
        bf16_t* dst = (bf16_t*)(ws + OFF_GATE);
        const unsigned cofs = c0 - 2304;
        const f32x4 b0 = *(const f32x4*)(b_merge + cofs), b1 = *(const f32x4*)(b_merge + cofs + 4);
#pragma unroll
        for (int ai = 0; ai < 2; ++ai)
#pragma unroll
          for (int m = 0; m < 4; ++m) {
            const int row = row0 + ai * 128 + m * 16;
            const f32x4 a = acc[ai][bj][m][0] + b0, b = acc[ai][bj][m][1] + b1;
            u32x4 w; w.x = pack2(sigmoid_f(a.x), sigmoid_f(a.y)); w.y = pack2(sigmoid_f(a.z), sigmoid_f(a.w));
            w.z = pack2(sigmoid_f(b.x), sigmoid_f(b.y)); w.w = pack2(sigmoid_f(b.z), sigmoid_f(b.w));
            *(u32x4*)(dst + (unsigned)row * 2048u + cofs) = w;
          }
      } else {
        float* gs = (float*)(ws + OFF_GSIG);
        if (fq < 3) {
#pragma unroll
          for (int ai = 0; ai < 2; ++ai)
#pragma unroll
            for (int m = 0; m < 4; ++m) {
              const int row = row0 + ai * 128 + m * 16;
              const f32x4 a = acc[ai][bj][m][0], b = acc[ai][bj][m][1];
              f32x4 o0, o1; o0.x = sigmoid_f(a.x); o0.y = sigmoid_f(a.y); o0.z = sigmoid_f(a.z); o0.w = sigmoid_f(a.w);
              o1.x = sigmoid_f(b.x); o1.y = sigmoid_f(b.y); o1.z = sigmoid_f(b.z); o1.w = sigmoid_f(b.w);
              *(f32x4*)(gs + (unsigned)row * 32u + 8 * fq) = o0; *(f32x4*)(gs + (unsigned)row * 32u + 8 * fq + 4) = o1;
            }
        }
      }
    }
  }
};
DI void phase_gemm1(const Params& p, char* smem) {
  pg8::Gemm g{(const bf16_t*)(p.ws + OFF_H), (const bf16_t*)(p.ws + OFF_WT1), NTOK, N1, 1024};
  pg8::StaticOrder S; S.init(NTOK, N1, gridDim.x, blockIdx.x);
  EpiProj E{p.ws, p.b_merge};
  pg8::gemm_phase((LAS unsigned char*)smem, g, S, E);
}

template <int BR> struct EpiMerge {
  static constexpr bool PERM = true;
  char* ws;
  DI void operator()(const f32x4 (&acc)[2][2][4][2], const pg8::Unit& u, int wr, int wc, int fr, int fq) const {
    const bf16_t* gate = (const bf16_t*)(ws + OFF_GATE);
    bf16_t* merged = (bf16_t*)(ws + OFF_H);
    const int row0 = u.pm * 256 + wr * 64 + fr;
#pragma unroll
    for (int bj = 0; bj < 2; ++bj) {
      const unsigned c0 = u.pn * 256 + bj * 128 + wc * 32 + 8 * fq;
#pragma unroll
      for (int ai = 0; ai < 2; ++ai)
#pragma unroll
        for (int m = 0; m < 4; ++m) {
          const unsigned row = row0 + ai * 128 + m * 16;
          float gg[8]; unpack8(*(const u32x4*)(gate + row * 2048u + BR * 1024 + c0), gg);
          const f32x4 a = acc[ai][bj][m][0], b = acc[ai][bj][m][1];
          float v[8] = {a.x * gg[0], a.y * gg[1], a.z * gg[2], a.w * gg[3], b.x * gg[4], b.y * gg[5], b.z * gg[6], b.w * gg[7]};
          bf16_t* mp = merged + row * 1024u + c0;
          if (BR == 1) {
            float old[8]; unpack8(*(const u32x4*)mp, old);
#pragma unroll
            for (int j = 0; j < 8; ++j) v[j] += old[j];
          }
          *(u32x4*)mp = pack8(v);
        }
    }
  }
};
DI void phase_merge(const Params& p, char* smem) {
  pg8::StaticOrder S; S.init(NTOK, 1024, gridDim.x, blockIdx.x);
  {
    pg8::Gemm g{(const bf16_t*)(p.ws + OFF_ONSA), (const bf16_t*)(p.ws + OFF_WB), NTOK, 1024, 512};
    EpiMerge<0> E{p.ws};
    pg8::gemm_phase((LAS unsigned char*)smem, g, S, E);
  }
  {
    pg8::Gemm g{(const bf16_t*)(p.ws + OFF_U), (const bf16_t*)(p.ws + OFF_WB) + (size_t)1024 * 512, NTOK, 1024, 512};
    EpiMerge<1> E{p.ws};
    pg8::gemm_phase((LAS unsigned char*)smem, g, S, E);
  }
}

struct EpiOut {
  static constexpr bool PERM = true;
  char* ws; const float* x;
  DI void operator()(const f32x4 (&acc)[2][2][4][2], const pg8::Unit& u, int wr, int wc, int fr, int fq) const {
    const float* mod = (const float*)(ws + OFF_MOD);
    bf16_t* y = (bf16_t*)(ws + OFF_Y);
    const int row0 = u.pm * 256 + wr * 64 + fr, b = (u.pm * 256) >> 13;
#pragma unroll
    for (int bj = 0; bj < 2; ++bj) {
      const unsigned c0 = u.pn * 256 + bj * 128 + wc * 32 + 8 * fq;
      const f32x4 g0 = *(const f32x4*)(mod + b * 6144 + 2048 + c0), g1 = *(const f32x4*)(mod + b * 6144 + 2048 + c0 + 4);
#pragma unroll
      for (int ai = 0; ai < 2; ++ai)
#pragma unroll
        for (int m = 0; m < 4; ++m) {
          const unsigned o = (unsigned)(row0 + ai * 128 + m * 16) * 1024u + c0;
          const f32x4 x0 = *(const f32x4*)(x + o), x1v = *(const f32x4*)(x + o + 4);
          const f32x4 v0 = x0 * DN_ALPHA + g0 * acc[ai][bj][m][0], v1 = x1v * DN_ALPHA + g1 * acc[ai][bj][m][1];
          u32x4 w; w.x = pack2(v0.x, v0.y); w.y = pack2(v0.z, v0.w); w.z = pack2(v1.x, v1.y); w.w = pack2(v1.z, v1.w);
          *(u32x4*)(y + o) = w;
        }
    }
  }
};
DI void phase_outproj(const Params& p, char* smem) {
  pg8::Gemm g{(const bf16_t*)(p.ws + OFF_H), (const bf16_t*)(p.ws + OFF_WOUT), NTOK, 1024, 1024};
  pg8::StaticOrder S; S.init(NTOK, 1024, gridDim.x, blockIdx.x);
  EpiOut E{p.ws, p.x};
  pg8::gemm_phase((LAS unsigned char*)smem, g, S, E);
}

struct EpiPq {
  static constexpr bool PERM = true;
  char* ws;
  DI void operator()(const f32x4 (&acc)[2][2][4][2], const pg8::Unit& u, int wr, int wc, int fr, int fq) const {
    bf16_t* pq = (bf16_t*)(ws + OFF_PQ);
    const int row0 = u.pm * 256 + wr * 64 + fr;
#pragma unroll
    for (int bj = 0; bj < 2; ++bj) {
      const unsigned c0 = u.pn * 256 + bj * 128 + wc * 32 + 8 * fq;
#pragma unroll
      for (int ai = 0; ai < 2; ++ai)
#pragma unroll
        for (int m = 0; m < 4; ++m) {
          const f32x4 a = acc[ai][bj][m][0], b = acc[ai][bj][m][1];
          u32x4 w; w.x = pack2(a.x, a.y); w.y = pack2(a.z, a.w); w.z = pack2(b.x, b.y); w.w = pack2(b.z, b.w);
          *(u32x4*)(pq + (unsigned)(row0 + ai * 128 + m * 16) * 2048u + c0) = w;
        }
    }
  }
};
DI void phase_peerq(const Params& p, char* smem) {
  pg8::Gemm g{(const bf16_t*)(p.ws + OFF_H), (const bf16_t*)(p.ws + OFF_WQ), NTOK, 2048, 1024};
  pg8::StaticOrder S; S.init(NTOK, 2048, gridDim.x, blockIdx.x);
  EpiPq E{p.ws};
  pg8::gemm_phase((LAS unsigned char*)smem, g, S, E);
}

DI void phase_sgu(const Params& p, char* smem) {
  char* ws = p.ws;
  const int tid = otid(), lane = tid & 63, wave = tid >> 6, l31 = lane & 31, hh = lane >> 5;
  bf16_t* u = (bf16_t*)(ws + OFF_U);
  const bf16_t* v = (const bf16_t*)(ws + OFF_V);
  const bf16_t* W = (const bf16_t*)(ws + OFF_SGUW);
  float* st = (float*)smem;
  bf16_t* vn = (bf16_t*)(smem + 1024);
  constexpr int LN_ = 72;
  const int dt = wave & 1, it = wave >> 1;
  const int gi = lane >> 4, i16 = lane & 15, tq = i16 >> 2, tp = i16 & 3;
  for (int item = blockIdx.x; item < NTOK / 128; item += gridDim.x) {
    const int t0 = item * 128;
    __syncthreads();
    for (int i = 0; i < 16; ++i) {
      const int t = wave * 16 + i;
      const u32x4 raw = *(const u32x4*)(v + (size_t)(t0 + t) * 512 + lane * 8);
      float f[8]; unpack8(raw, f);
      float s = 0.f;
#pragma unroll
      for (int j = 0; j < 8; ++j) s += f[j];
      const float mean = wave_sum(s) * (1.f / 512.f);
      float q = 0.f;
#pragma unroll
      for (int j = 0; j < 8; ++j) { const float d = f[j] - mean; q += d * d; }
      const float rstd = rsqrtf(wave_sum(q) * (1.f / 512.f) + LN_EPS);
      if (lane == 0) { st[t * 2] = mean; st[t * 2 + 1] = rstd; }
    }
    u32x4 vnext[2];
#pragma unroll
    for (int i = 0; i < 2; ++i) { const int idx = tid + i * NT; vnext[i] = *(const u32x4*)(v + (size_t)(t0 + (idx >> 3)) * 512 + (idx & 7) * 8); }
    for (int g = 0; g < 8; ++g) {
      u32x4 vcur[2] = {vnext[0], vnext[1]};
      if (g + 1 < 8) {
#pragma unroll
        for (int i = 0; i < 2; ++i) { const int idx = tid + i * NT; vnext[i] = *(const u32x4*)(v + (size_t)(t0 + (idx >> 3)) * 512 + (g + 1) * 64 + (idx & 7) * 8); }
      }
      u32x2 uold[4];
      {
        const bf16_t* urow0 = u + (size_t)(t0 + it * 32 + l31) * 512 + g * 64 + dt * 32 + 4 * hh;
#pragma unroll
        for (int q4 = 0; q4 < 4; ++q4) uold[q4] = *(const u32x2*)(urow0 + 8 * q4);
      }
      lds_barrier();
#pragma unroll
      for (int i = 0; i < 2; ++i) {
        const int idx = tid + i * NT, j = idx >> 3, dc = (idx & 7) * 8;
        const u32x4 raw = vcur[i];
        const float mean = st[j * 2], rstd = st[j * 2 + 1];
        float f[8], gg[8], bb[8]; unpack8(raw, f); ld8(p.sgu_ln_g + g * 64 + dc, gg); ld8(p.sgu_ln_b + g * 64 + dc, bb);
#pragma unroll
        for (int k = 0; k < 8; ++k) f[k] = (f[k] - mean) * rstd * gg[k] + bb[k];
        *(u32x4*)(vn + j * LN_ + dc) = pack8(f);
      }
      lds_barrier();
      f32x16 acc;
#pragma unroll
      for (int r = 0; r < 16; ++r) acc[r] = 0.f;
      const bf16_t* wrow = W + ((size_t)g * 128 + it * 32 + l31) * 128 + hh * 8;
      const LAS bf16_t* vbase = (const LAS bf16_t*)vn + (8 * (gi >> 1) + tq) * LN_ + dt * 32 + 16 * (gi & 1) + 4 * tp;
#pragma unroll
      for (int ks = 0; ks < 8; ++ks) {
        if (ks <= 2 * it + 1) {
          const LAS bf16_t* vp = vbase + (ks * 16) * LN_;
          const s16x4 lo = __builtin_amdgcn_ds_read_tr16_b64_v4i16((LAS s16x4*)vp);
          const s16x4 hi = __builtin_amdgcn_ds_read_tr16_b64_v4i16((LAS s16x4*)(vp + 4 * LN_));
          const bf16x8 bw = *(const bf16x8*)(wrow + ks * 16);
          acc = MFMA32(__builtin_shufflevector(lo, hi, 0, 1, 2, 3, 4, 5, 6, 7), bw, acc);
        }
      }
      const int i = it * 32 + l31;
      const float bsv = p.sgu_b[g * 128 + i];
      bf16_t* urow = u + (size_t)(t0 + i) * 512 + g * 64 + dt * 32 + 4 * hh;
#pragma unroll
      for (int q4 = 0; q4 < 4; ++q4) {
        u32x2* up = (u32x2*)(urow + 8 * q4);
        const u32x2 old = uold[q4];
        u32x2 wv; wv.x = pack2(bflo(old.x) * (acc[4 * q4] + bsv), bfhi(old.x) * (acc[4 * q4 + 1] + bsv));
        wv.y = pack2(bflo(old.y) * (acc[4 * q4 + 2] + bsv), bfhi(old.y) * (acc[4 * q4 + 3] + bsv));
        *up = wv;
      }
    }
  }
}

DI void phase_compress(const Params& p, char* smem) {
  char* ws = p.ws;
  const int tid = otid(), lane = tid & 63, wave = tid >> 6, l31 = lane & 31, hh = lane >> 5;
  bf16_t* hid = (bf16_t*)smem;
  constexpr int LH = 136;
  for (int item = blockIdx.x; item < 128; item += gridDim.x) {
    const int w = item >> 6, R0 = (item & 63) * 128;
    const bf16_t* src = (const bf16_t*)(ws + (w == 0 ? OFF_KC : OFF_VC));
    const bf16_t* W1 = (const bf16_t*)(ws + OFF_CW1) + (size_t)w * 128 * 2048;
    const bf16_t* W2 = (const bf16_t*)(ws + OFF_CW2) + (size_t)w * 64 * 128;
    const float* posb = (const float*)(ws + OFF_POSB) + w * 128;
    const int rg = wave >> 2, cgp = wave & 3;
    const bf16_t* abase[2];
#pragma unroll
    for (int mi = 0; mi < 2; ++mi) {
      const int R = R0 + rg * 64 + mi * 32 + l31, bg = R >> 9, n = R & 511, nn = n < 510 ? n : 510;
      abase[mi] = src + ((size_t)((bg >> 1) * SEQ + 16 * nn)) * 128 + (bg & 1) * 64 + hh * 8;
    }
    const bf16_t* bbase = W1 + (size_t)(cgp * 32 + l31) * 2048 + hh * 8;
    f32x16 acc[2];
#pragma unroll
    for (int r = 0; r < 16; ++r) { acc[0][r] = 0.f; acc[1][r] = 0.f; }
#pragma unroll 8
    for (int ks = 0; ks < 128; ++ks) {
      const int aofs = (ks >> 2) * 128 + (ks & 3) * 16;
      const bf16x8 a0 = *(const bf16x8*)(abase[0] + aofs), a1 = *(const bf16x8*)(abase[1] + aofs);
      const bf16x8 bb = *(const bf16x8*)(bbase + ks * 16);
      acc[0] = MFMA32(a0, bb, acc[0]); acc[1] = MFMA32(a1, bb, acc[1]);
    }
    __syncthreads();
    {
      const float pb = posb[cgp * 32 + l31];
#pragma unroll
      for (int mi = 0; mi < 2; ++mi)
#pragma unroll
        for (int r = 0; r < 16; ++r) {
          const int row = rg * 64 + mi * 32 + (r & 3) + 8 * (r >> 2) + 4 * hh;
          hid[row * LH + cgp * 32 + l31] = f2bf(gelu_f(acc[mi][r] + pb));
        }
    }
    __syncthreads();
    const int mi2 = wave >> 1, ni = wave & 1;
    f32x16 o;
#pragma unroll
    for (int r = 0; r < 16; ++r) o[r] = 0.f;
#pragma unroll
    for (int ks = 0; ks < 8; ++ks) {
      const bf16x8 a = *(const bf16x8*)(hid + (mi2 * 32 + l31) * LH + ks * 16 + hh * 8);
      const bf16x8 bb = *(const bf16x8*)(W2 + (size_t)(ni * 32 + l31) * 128 + ks * 16 + hh * 8);
      o = MFMA32(a, bb, o);
    }
    const int d = ni * 32 + l31;
    const float b2 = p.cmp_b2[w * 64 + (w == 0 ? dperm(d) : d)];
    const int bg = R0 >> 9;
    bf16_t* dst = (bf16_t*)(ws + (w == 0 ? OFF_KCMP : OFF_VCMP));
#pragma unroll
    for (int r = 0; r < 16; ++r) {
      const int n = (R0 & 511) + mi2 * 32 + (r & 3) + 8 * (r >> 2) + 4 * hh;
      dst[((size_t)bg * 512 + n) * 64 + d] = f2bf(n < 511 ? o[r] + b2 : 0.f);
    }
  }
}

constexpr int LK = 72;
constexpr int NSA_TILE = 18432;
constexpr int NSA_AIMP = 3 * NSA_TILE, NSA_CIMP = NSA_AIMP + 32768, NSA_SELM = NSA_CIMP + 32768;
constexpr float NSA_THR = 6.0f;
struct TileRegs { u32x4 k; u32x4 v; };

DI void nsa_load_tile(TileRegs& t, const bf16_t* kbase, size_t kstride, const bf16_t* vbase, size_t vstride) {
  const int tid = otid(), r = tid >> 3, ch = tid & 7;
  t.k = *(const u32x4*)(kbase + (size_t)r * kstride + ch * 8);
  t.v = *(const u32x4*)(vbase + (size_t)r * vstride + ch * 8);
}
DI void nsa_store_tile(const TileRegs& t, char* tile) {
  const int tid = otid(), r = tid >> 3, ch = tid & 7;
  *(u32x4*)((bf16_t*)tile + r * LK + ch * 8) = t.k;
  *(u32x4*)((bf16_t*)(tile + 9216) + r * LK + ch * 8) = t.v;
}
DI void nsa_scores(f32x16 (&st)[2], const char* tile, const bf16x8 (&qf)[4], int lane) {
  const bf16_t* Ks = (const bf16_t*)tile;
#pragma unroll
  for (int kt = 0; kt < 2; ++kt)
#pragma unroll
    for (int r = 0; r < 16; ++r) st[kt][r] = 0.f;
  __builtin_amdgcn_s_setprio(1);
#pragma unroll
  for (int ks = 0; ks < 4; ++ks)
#pragma unroll
    for (int kt = 0; kt < 2; ++kt) {
      const bf16x8 a = *(const bf16x8*)(Ks + (kt * 32 + (lane & 31)) * LK + ks * 16 + (lane >> 5) * 8);
      st[kt] = MFMA32(a, qf[ks], st[kt]);
    }
  __builtin_amdgcn_s_setprio(0);
}
DI void nsa_pv(f32x16 (&o)[2], const f32x16 (&pt)[2], const char* tile, int lane) {
  const int gi = lane >> 4, i16 = lane & 15, q = i16 >> 2, pp = i16 & 3;
  const LAS bf16_t* Vs = (const LAS bf16_t*)(tile + 9216) + (4 * (gi >> 1) + q) * LK + 16 * (gi & 1) + 4 * pp;
#pragma unroll
  for (int kt = 0; kt < 2; ++kt)
#pragma unroll
    for (int s = 0; s < 2; ++s) {
      u32x4 pk; pk.x = pack2(pt[kt][8 * s], pt[kt][8 * s + 1]); pk.y = pack2(pt[kt][8 * s + 2], pt[kt][8 * s + 3]);
      pk.z = pack2(pt[kt][8 * s + 4], pt[kt][8 * s + 5]); pk.w = pack2(pt[kt][8 * s + 6], pt[kt][8 * s + 7]);
      const bf16x8 pb = __builtin_bit_cast(bf16x8, pk);
      bf16x8 a[2];
#pragma unroll
      for (int dt = 0; dt < 2; ++dt) {
        const LAS bf16_t* vp = Vs + (kt * 32 + 16 * s) * LK + dt * 32;
        const s16x4 lo = __builtin_amdgcn_ds_read_tr16_b64_v4i16((LAS s16x4*)vp);
        const s16x4 hi = __builtin_amdgcn_ds_read_tr16_b64_v4i16((LAS s16x4*)(vp + 8 * LK));
        a[dt] = __builtin_shufflevector(lo, hi, 0, 1, 2, 3, 4, 5, 6, 7);
      }
      o[0] = MFMA32(a[0], pb, o[0]); o[1] = MFMA32(a[1], pb, o[1]);
    }
}

constexpr float NSA_NEG = -3.0e38f;
DI void nsa_online(f32x16 (&st)[2], bool sel, float& m, float& l, f32x16 (&o)[2], const char* tile, int lane) {
  float mx = NSA_NEG;
#pragma unroll
  for (int r = 0; r < 16; ++r) mx = fmaxf(mx, fmaxf(st[0][r], st[1][r]));
  mx = fmaxf(mx, __shfl_xor(mx, 32));
  mx = sel ? mx : NSA_NEG;
  if (__any(mx > m + NSA_THR)) {
    const float mn = fmaxf(m, mx);
    const float alpha = __builtin_amdgcn_exp2f(m - mn);
    m = mn; l *= alpha;
#pragma unroll
    for (int r = 0; r < 16; ++r) { o[0][r] *= alpha; o[1][r] *= alpha; }
  }
  const float ms = sel ? m : 1e30f;
  float sum = 0.f;
#pragma unroll
  for (int r = 0; r < 16; ++r) {
    const float p0 = __builtin_amdgcn_exp2f(st[0][r] - ms), p1 = __builtin_amdgcn_exp2f(st[1][r] - ms);
    st[0][r] = p0; st[1][r] = p1; sum += p0 + p1;
  }
  l += sum;
  nsa_pv(o, st, tile, lane);
}

struct NsaItem { int qb, b, g, bg, t; size_t tokrow; };
DI NsaItem nsa_item(int item0, int wave, int qi) {
  const int G = gridDim.x, k = item0 / G, bb = item0 - k * G;
  const int item = (k & 1) ? (k * G + (G - 1 - bb)) : item0;
  NsaItem it; it.qb = 127 - (item >> 4); const int rest = item & 15; it.b = rest >> 1; it.g = rest & 1;
  it.bg = it.b * 2 + it.g; it.t = it.qb * 64 + wave * 8 + qi; it.tokrow = (size_t)it.b * SEQ + it.t; return it;
}
DI void nsa_accum_store(bf16_t* dst, const f32x16 (&o)[2], float sc, bool first, int hh) {
#pragma unroll
  for (int dt = 0; dt < 2; ++dt)
#pragma unroll
    for (int q4 = 0; q4 < 4; ++q4) {
      u32x2* pp = (u32x2*)(dst + dt * 32 + 8 * q4 + 4 * hh);
      float a0 = sc * o[dt][4 * q4], a1 = sc * o[dt][4 * q4 + 1], a2 = sc * o[dt][4 * q4 + 2], a3 = sc * o[dt][4 * q4 + 3];
      if (!first) { const u32x2 old = *pp; a0 += bflo(old.x); a1 += bfhi(old.x); a2 += bflo(old.y); a3 += bfhi(old.y); }
      u32x2 wv; wv.x = pack2(a0, a1); wv.y = pack2(a2, a3);
      *pp = wv;
    }
}

constexpr int NSA_STAGE = 4 * 18432;
typedef float f32x4v __attribute__((ext_vector_type(4)));
#define MFMA16(a, b, c) __builtin_amdgcn_mfma_f32_16x16x32_bf16((a), (b), (c), 0, 0, 0)
struct StageRegs { u32x4 r[8]; };
DI void nsa_load_stage(StageRegs& sr, const bf16_t* kb, const bf16_t* vb, int j0s, int qb) {
  const int tid = otid(), r = tid >> 3, ch = tid & 7;
#pragma unroll
  for (int tt = 0; tt < 4; ++tt) {
    const int j = (j0s + tt <= qb) ? j0s + tt : qb;
    sr.r[2 * tt] = *(const u32x4*)(kb + ((size_t)j * 64 + r) * 128 + ch * 8);
    sr.r[2 * tt + 1] = *(const u32x4*)(vb + ((size_t)j * 64 + r) * 128 + ch * 8);
  }
}
DI void nsa_store_stage(const StageRegs& sr, char* stage) {
  const int tid = otid(), r = tid >> 3, ch = tid & 7;
#pragma unroll
  for (int tt = 0; tt < 4; ++tt) {
    *(u32x4*)((bf16_t*)(stage + tt * 18432) + r * LK + ch * 8) = sr.r[2 * tt];
    *(u32x4*)((bf16_t*)(stage + tt * 18432 + 9216) + r * LK + ch * 8) = sr.r[2 * tt + 1];
  }
}
struct Sel16 { float m, l; bool has; f32x4v o[4]; };
DI void nsa_unit16(Sel16& g, const char* tile, const bf16x8 (&qf)[2], bool sel, int klim  , int lane) {
  const int c16 = lane & 15, kg = lane >> 4, tq = c16 >> 2, tp = c16 & 3;
  const bf16_t* Ks = (const bf16_t*)tile + c16 * LK + kg * 8;
  f32x4v st[4];
  const float ini = sel ? -g.m : -1e30f;
#pragma unroll
  for (int kt = 0; kt < 4; ++kt) {
    st[kt] = (f32x4v){ini, ini, ini, ini};
#pragma unroll
    for (int ks = 0; ks < 2; ++ks) st[kt] = MFMA16(*(const bf16x8*)(Ks + kt * 16 * LK + ks * 32), qf[ks], st[kt]);
  }
  if (klim < 64) {
#pragma unroll
    for (int kt = 0; kt < 4; ++kt)
#pragma unroll
      for (int r = 0; r < 4; ++r) st[kt][r] = (kt * 16 + 4 * kg + r <= klim) ? st[kt][r] : NSA_NEG;
  }
  float mx = fmaxf(fmaxf(fmaxf(st[0][0], st[0][1]), fmaxf(st[0][2], st[0][3])), fmaxf(fmaxf(st[1][0], st[1][1]), fmaxf(st[1][2], st[1][3])));
  mx = fmaxf(mx, fmaxf(fmaxf(fmaxf(st[2][0], st[2][1]), fmaxf(st[2][2], st[2][3])), fmaxf(fmaxf(st[3][0], st[3][1]), fmaxf(st[3][2], st[3][3]))));
  mx = fmaxf(mx, __shfl_xor(mx, 16));
  mx = fmaxf(mx, __shfl_xor(mx, 32));
  const bool real = mx > -1e29f;
  const bool fresh = !g.has && real, up = g.has && (mx > NSA_THR);
  if (__any(fresh || up)) {
    const float delta = (fresh || up) ? mx : 0.f;
    const float alpha = up ? __builtin_amdgcn_exp2f(-delta) : 1.0f;
    g.m += delta; g.l *= alpha;
#pragma unroll
    for (int dt = 0; dt < 4; ++dt) g.o[dt] *= alpha;
#pragma unroll
    for (int kt = 0; kt < 4; ++kt) st[kt] -= delta;
  }
  g.has = g.has || real;
  float sum = 0.f;
#pragma unroll
  for (int kt = 0; kt < 4; ++kt)
#pragma unroll
    for (int r = 0; r < 4; ++r) { const float pv = __builtin_amdgcn_exp2f(st[kt][r]); st[kt][r] = pv; sum += pv; }
  g.l += sum;
  const LAS bf16_t* Vs = (const LAS bf16_t*)(tile + 9216) + (4 * kg + tq) * LK + 4 * tp;
#pragma unroll
  for (int kp = 0; kp < 2; ++kp) {
    u32x4 pk; pk.x = pack2(st[2 * kp][0], st[2 * kp][1]); pk.y = pack2(st[2 * kp][2], st[2 * kp][3]);
    pk.z = pack2(st[2 * kp + 1][0], st[2 * kp + 1][1]); pk.w = pack2(st[2 * kp + 1][2], st[2 * kp + 1][3]);
    const bf16x8 pb = __builtin_bit_cast(bf16x8, pk);
#pragma unroll
    for (int dt = 0; dt < 4; ++dt) {
      const LAS bf16_t* vp = Vs + (2 * kp) * 16 * LK + dt * 16;
      const s16x4 lo = __builtin_amdgcn_ds_read_tr16_b64_v4i16((LAS s16x4*)vp);
      const s16x4 hi = __builtin_amdgcn_ds_read_tr16_b64_v4i16((LAS s16x4*)(vp + 16 * LK));
      g.o[dt] = MFMA16(__builtin_shufflevector(lo, hi, 0, 1, 2, 3, 4, 5, 6, 7), pb, g.o[dt]);
    }
  }
}
DI void nsa_sel16(const Params& p, char* smem, bool dry) {
  char* ws = p.ws;
  const int tid = otid(), lane = tid & 63, wave = tid >> 6, c16 = lane & 15, kg = lane >> 4, qi4 = c16 >> 2, r4 = c16 & 3;
  const bf16_t* Q = (const bf16_t*)(ws + OFF_Q);
  const float* gsig = (const float*)(ws + OFF_GSIG);
  bf16_t* ONSA = (bf16_t*)(ws + OFF_ONSA);
  const u32x4* SELG = (const u32x4*)(ws + OFF_SELG);
  const bf16_t* KS = (const bf16_t*)(ws + OFF_KS); const bf16_t* VS = (const bf16_t*)(ws + OFF_VS);
  constexpr int NITEM = NB * 2 * 128;
  for (int item = blockIdx.x; item < NITEM; item += gridDim.x) {
    const NsaItem it = nsa_item(item, wave, 0);
    const int qb = it.qb;
    bf16x8 qf[2][2]; u32x4 selw[2]; float g_s[2]; int tg[2]; Sel16 G[2];
#pragma unroll
    for (int gq = 0; gq < 2; ++gq) {
      tg[gq] = it.t + 4 * gq + qi4;
      const size_t tokrow = (size_t)it.b * SEQ + tg[gq];
#pragma unroll
      for (int ks = 0; ks < 2; ++ks) qf[gq][ks] = *(const bf16x8*)(Q + tokrow * 512 + (it.g * 4 + r4) * 64 + ks * 32 + kg * 8);
      selw[gq] = SELG[(size_t)it.bg * SEQ + tg[gq]];
      g_s[gq] = gsig[tokrow * 32 + (it.g * 4 + r4) * 3 + 1];
      G[gq].m = 0.f; G[gq].l = 0.f; G[gq].has = false;
#pragma unroll
      for (int dt = 0; dt < 4; ++dt) G[gq].o[dt] = (f32x4v){0.f, 0.f, 0.f, 0.f};
    }
    const bf16_t* kb = KS + (size_t)it.b * SEQ * 128 + it.g * 64;
    const bf16_t* vb = VS + (size_t)it.b * SEQ * 128 + it.g * 64;
    const int nst = (qb >> 2) + 1;
    StageRegs sr;
    lds_barrier();
    nsa_load_stage(sr, kb, vb, 0, qb);
    nsa_store_stage(sr, smem);
    lds_barrier();
    for (int sidx = 0; sidx < nst; ++sidx) {
      const char* stage = smem + (sidx & 1) * NSA_STAGE;
      if (sidx + 1 < nst) nsa_load_stage(sr, kb, vb, 4 * (sidx + 1), qb);
#pragma unroll 1
      for (int tt = 0; tt < 4; ++tt) {
        const int j = 4 * sidx + tt;
        if (j > qb) break;
#pragma unroll
        for (int gq = 0; gq < 2; ++gq) {
          const unsigned w = j < 32 ? selw[gq].x : (j < 64 ? selw[gq].y : (j < 96 ? selw[gq].z : selw[gq].w));
          const bool sel = (w >> (j & 31)) & 1u;
          if (__any(sel)) nsa_unit16(G[gq], stage + tt * 18432, qf[gq], sel, (j == qb) ? (tg[gq] - j * 64) : 1000, lane);
        }
      }
      if (sidx + 1 < nst) nsa_store_stage(sr, smem + ((sidx + 1) & 1) * NSA_STAGE);
      lds_barrier();
    }
#pragma unroll
    for (int gq = 0; gq < 2; ++gq) {
      float l = G[gq].l;
      l += __shfl_xor(l, 16); l += __shfl_xor(l, 32);
      const float sc = l > 0.f ? g_s[gq] / l : 0.f;
      bf16_t* dst = ONSA + ((size_t)it.b * SEQ + tg[gq]) * 512 + (it.g * 4 + r4) * 64 + 4 * kg;
      if (!dry) {
#pragma unroll
        for (int dt = 0; dt < 4; ++dt) {
          u32x2* pp = (u32x2*)(dst + dt * 16);
          const u32x2 old = *pp;
          u32x2 wv; wv.x = pack2(bflo(old.x) + sc * G[gq].o[dt][0], bfhi(old.x) + sc * G[gq].o[dt][1]);
          wv.y = pack2(bflo(old.y) + sc * G[gq].o[dt][2], bfhi(old.y) + sc * G[gq].o[dt][3]);
          *pp = wv;
        }
      } else asm volatile("" :: "v"(G[gq].o[0]), "v"(G[gq].o[1]), "v"(G[gq].o[2]), "v"(G[gq].o[3]), "v"(l));
    }
  }
}

DI void phase_nsa(const Params& p, char* smem, int branch_mask) {
  char* ws = p.ws;
  const int tid = otid(), lane = tid & 63, wave = tid >> 6, hh = lane >> 5, c = lane & 31, qi = c >> 2, r4 = c & 3;
  const bf16_t* Q = (const bf16_t*)(ws + OFF_Q);
  const float* gsig = (const float*)(ws + OFF_GSIG);
  bf16_t* ONSA = (bf16_t*)(ws + OFF_ONSA);
  u32x4* SELG = (u32x4*)(ws + OFF_SELG);
  constexpr int NITEM = NB * 2 * 128;

#pragma unroll 1
  for (int rep1 = 0; rep1 < ((PROBE_DUP & 4096) ? 2 : 1); ++rep1) {
    const bf16_t* KCMP = (const bf16_t*)(ws + OFF_KCMP); const bf16_t* VCMP = (const bf16_t*)(ws + OFF_VCMP);
    float* Aimp = (float*)(smem + NSA_AIMP) + wave * 1024;
    float* Cimp = (float*)(smem + NSA_CIMP) + wave * 1024;
    unsigned short* selm16 = (unsigned short*)(smem + NSA_SELM) + wave * 64;
    const u32x4* selm128 = (const u32x4*)(smem + NSA_SELM) + wave * 8;
    for (int item = blockIdx.x; item < NITEM; item += gridDim.x) {
      const NsaItem it = nsa_item(item, wave, qi);
      const int t = it.t;
      bf16x8 qf[4];
#pragma unroll
      for (int ks = 0; ks < 4; ++ks) qf[ks] = *(const bf16x8*)(Q + it.tokrow * 512 + (it.g * 4 + r4) * 64 + ks * 16 + hh * 8);
      const float g_c = gsig[it.tokrow * 32 + (it.g * 4 + r4) * 3 + 0];
      TileRegs tr;
      const int nmax = (it.qb * 64 + 63 - 31) >> 4, ntile = (nmax >> 6) + 1;
      const int nfull = (it.qb * 64 - 31) >> 4;
      const bf16_t* kb = KCMP + (size_t)it.bg * 512 * 64;
      const bf16_t* vb = VCMP + (size_t)it.bg * 512 * 64;
      float m = -1e30f, l = 0.f;
      __syncthreads();
      for (int i = lane; i < 1024; i += 64) { Aimp[i] = 0.f; Cimp[i] = 0.f; }
      nsa_load_tile(tr, kb, 64, vb, 64);
      nsa_store_tile(tr, smem);
      __syncthreads();
      for (int j = 0; j < ntile; ++j) {
        const char* tile = smem + (j & 1) * NSA_TILE;
        if (j + 1 < ntile) nsa_load_tile(tr, kb + (size_t)(j + 1) * 64 * 64, 64, vb + (size_t)(j + 1) * 64 * 64, 64);
        f32x16 st[2];
        nsa_scores(st, tile, qf, lane);
        const bool full = (j * 64 + 63 <= nfull);
        const int nlim = full ? 100000 : ((t - 31) >> 4) - j * 64 - 4 * hh;
        float mx = NSA_NEG;
#pragma unroll
        for (int kt = 0; kt < 2; ++kt)
#pragma unroll
          for (int r = 0; r < 16; ++r) {
            st[kt][r] = (kt * 32 + (r & 3) + 8 * (r >> 2) <= nlim) ? st[kt][r] : NSA_NEG;
            mx = fmaxf(mx, st[kt][r]);
          }
        mx = fmaxf(mx, __shfl_xor(mx, 32));
        const float mn = fmaxf(m, mx);
        float sum = 0.f;
#pragma unroll
        for (int kt = 0; kt < 2; ++kt)
#pragma unroll
          for (int r = 0; r < 16; ++r) sum += __builtin_amdgcn_exp2f(st[kt][r] - mn);
        l = l * __builtin_amdgcn_exp2f(m - mn) + sum;
        m = mn;
        if (j + 1 < ntile) nsa_store_tile(tr, smem + ((j + 1) & 1) * NSA_TILE);
        __syncthreads();
      }
      l += __shfl_xor(l, 32);
      const float inv_l = l > 0.f ? 1.0f / l : 0.f;
      f32x16 o[2];
#pragma unroll
      for (int r = 0; r < 16; ++r) { o[0][r] = 0.f; o[1][r] = 0.f; }
      nsa_load_tile(tr, kb, 64, vb, 64);
      nsa_store_tile(tr, smem);
      __syncthreads();
      for (int j = 0; j < ntile; ++j) {
        const char* tile = smem + (j & 1) * NSA_TILE;
        if (j + 1 < ntile) nsa_load_tile(tr, kb + (size_t)(j + 1) * 64 * 64, 64, vb + (size_t)(j + 1) * 64 * 64, 64);
        f32x16 st[2];
        nsa_scores(st, tile, qf, lane);
        const bool full = (j * 64 + 63 <= nfull);
        const int nlim = full ? 100000 : ((t - 31) >> 4) - j * 64 - 4 * hh;
#pragma unroll
        for (int kt = 0; kt < 2; ++kt)
#pragma unroll
          for (int r = 0; r < 16; ++r) {
            const float arg = (kt * 32 + (r & 3) + 8 * (r >> 2) <= nlim) ? st[kt][r] - m : NSA_NEG;
            st[kt][r] = __builtin_amdgcn_exp2f(arg) * inv_l;
          }
#pragma unroll
        for (int kt = 0; kt < 2; ++kt)
#pragma unroll
          for (int c4 = 0; c4 < 4; ++c4) {
            float carry = 0.5f * st[kt][4 * c4 + 3];
            float fullv = st[kt][4 * c4] + st[kt][4 * c4 + 1] + st[kt][4 * c4 + 2] + carry;
            fullv += __shfl_xor(fullv, 1); fullv += __shfl_xor(fullv, 2);
            carry += __shfl_xor(carry, 1); carry += __shfl_xor(carry, 2);
            const int jb = j * 16 + kt * 8 + 2 * c4 + hh;
            if (r4 == 0) { Aimp[qi * 128 + jb] = fullv; Cimp[qi * 128 + jb] = carry; }
          }
        if (branch_mask & 1) nsa_pv(o, st, tile, lane);
        if (j + 1 < ntile) nsa_store_tile(tr, smem + ((j + 1) & 1) * NSA_TILE);
        __syncthreads();
      }
      nsa_accum_store(ONSA + it.tokrow * 512 + (it.g * 4 + r4) * 64, o, (branch_mask & 1) ? g_c : 0.f, true, hh);
      const int cur = it.qb;
      if (cur <= 15) {
        if (lane < 8) { selm16[lane * 8 + 0] = (unsigned short)((2u << cur) - 1u);
#pragma unroll
          for (int k = 1; k < 8; ++k) selm16[lane * 8 + k] = 0; }
      } else {
        const int qs = lane >> 3, sub = lane & 7;
        float v[16];
#pragma unroll
        for (int i = 0; i < 16; ++i) {
          const int jj = sub * 16 + i;
          const bool ok = (jj >= 1) && (jj <= cur - 2);
          const int jm = jj >= 1 ? jj - 1 : 0;
          v[i] = ok ? (Aimp[qs * 128 + jj] + Cimp[qs * 128 + jm]) : -3e38f;
        }
        unsigned bits = 0;
        for (int itn = 0; itn < 13; ++itn) {
          float bv = v[0]; int bi = 0;
#pragma unroll
          for (int i = 1; i < 16; ++i) if (v[i] > bv) { bv = v[i]; bi = i; }
          int bj = sub * 16 + bi;
#pragma unroll
          for (int o2 = 1; o2 < 8; o2 <<= 1) {
            const float ov = __shfl_xor(bv, o2); const int oj = __shfl_xor(bj, o2);
            if (ov > bv || (ov == bv && oj < bj)) { bv = ov; bj = oj; }
          }
          if ((bj >> 4) == sub) {
            const int i2 = bj & 15;
#pragma unroll
            for (int i = 0; i < 16; ++i) if (i == i2) v[i] = -3e38f;
            bits |= 1u << i2;
          }
        }
        if (sub == 0) bits |= 1u;
        if ((cur >> 4) == sub) bits |= 1u << (cur & 15);
        if (((cur - 1) >> 4) == sub) bits |= 1u << ((cur - 1) & 15);
        selm16[qs * 8 + sub] = (unsigned short)bits;
      }
      __syncthreads();
      if (r4 == 0 && hh == 0) SELG[(size_t)it.bg * SEQ + t] = selm128[qi];
    }
  }
  __threadfence_block();
  __syncthreads();

#pragma unroll 1
  for (int sweep_i = 0; sweep_i < 2 + ((PROBE_DUP & 1024) ? 1 : 0) + ((PROBE_DUP & 2048) ? 1 : 0); ++sweep_i) {
    const int sweep = (sweep_i < 2) ? sweep_i : (((PROBE_DUP & 1024) && sweep_i == 2) ? 0 : 1);
    const bool dry = sweep_i >= 2;
    if (!(branch_mask & (sweep == 0 ? 2 : 4))) continue;
    if (sweep == 0) { nsa_sel16(p, smem, dry); continue; }
    const bf16_t* KB = (const bf16_t*)(ws + (sweep == 0 ? OFF_KS : OFF_KW)); const bf16_t* VB = (const bf16_t*)(ws + (sweep == 0 ? OFF_VS : OFF_VW));
    for (int item = blockIdx.x; item < NITEM; item += gridDim.x) {
      const NsaItem it = nsa_item(item, wave, qi);
      const int t = it.t, qb = it.qb;
      bf16x8 qf[4];
#pragma unroll
      for (int ks = 0; ks < 4; ++ks) qf[ks] = *(const bf16x8*)(Q + it.tokrow * 512 + (it.g * 4 + r4) * 64 + ks * 16 + hh * 8);
      const float g_b = gsig[it.tokrow * 32 + (it.g * 4 + r4) * 3 + 1 + sweep];
      u32x4 selw = {0xffffffffu, 0xffffffffu, 0xffffffffu, 0xffffffffu};
      if (sweep == 0) selw = SELG[(size_t)it.bg * SEQ + t];
      TileRegs tr;
      const bf16_t* kb = KB + (size_t)it.b * SEQ * 128 + it.g * 64;
      const bf16_t* vb = VB + (size_t)it.b * SEQ * 128 + it.g * 64;
      float m = -1e30f, l = 0.f;
      f32x16 o[2];
#pragma unroll
      for (int r = 0; r < 16; ++r) { o[0][r] = 0.f; o[1][r] = 0.f; }
      const int j0 = (sweep == 1 && qb >= 8) ? qb - 8 : 0;
      __syncthreads();
      nsa_load_tile(tr, kb + (size_t)j0 * 64 * 128, 128, vb + (size_t)j0 * 64 * 128, 128);
      nsa_store_tile(tr, smem);
      if (j0 + 1 <= qb) { nsa_load_tile(tr, kb + (size_t)(j0 + 1) * 64 * 128, 128, vb + (size_t)(j0 + 1) * 64 * 128, 128); nsa_store_tile(tr, smem + NSA_TILE); }
      if (j0 + 2 <= qb) nsa_load_tile(tr, kb + (size_t)(j0 + 2) * 64 * 128, 128, vb + (size_t)(j0 + 2) * 64 * 128, 128);
      __syncthreads();
      const bool late = wave >= 4;
      if (__builtin_amdgcn_readfirstlane(wave) >= 4) __builtin_amdgcn_s_setprio(1);
      bool has = false;
      m = 0.f;
      f32x16 st[2];
      {
        const unsigned w0 = j0 < 32 ? selw.x : (j0 < 64 ? selw.y : (j0 < 96 ? selw.z : selw.w));
        const float ini = ((w0 >> (j0 & 31)) & 1u) ? 0.f : -1e30f;
#pragma unroll
        for (int r = 0; r < 16; ++r) { st[0][r] = ini; st[1][r] = ini; }
        const bf16_t* Kc = (const bf16_t*)smem;
#pragma unroll
        for (int ks = 0; ks < 4; ++ks)
#pragma unroll
          for (int kt = 0; kt < 2; ++kt) st[kt] = MFMA32(*(const bf16x8*)(Kc + (kt * 32 + (lane & 31)) * LK + ks * 16 + (lane >> 5) * 8), qf[ks], st[kt]);
      }
      int bi = 0;
      for (int j = j0; j <= qb; ++j) {
        const char* tile = smem + bi * NSA_TILE;
        const int bn = bi == 2 ? 0 : bi + 1, bnn = bn == 2 ? 0 : bn + 1;
        const int jn = j + 1;
        const unsigned wn = jn < 32 ? selw.x : (jn < 64 ? selw.y : (jn < 96 ? selw.z : selw.w));
        const bool seln = (wn >> (jn & 31)) & 1u;
        const bf16_t* Kn = (const bf16_t*)(smem + bn * NSA_TILE) + (lane & 31) * LK + (lane >> 5) * 8;
        f32x16 sn[2];
        if (!late) {
          const float ini = seln ? -m : -1e30f;
#pragma unroll
          for (int r = 0; r < 16; ++r) { sn[0][r] = ini; sn[1][r] = ini; }
#pragma unroll
          for (int ks = 0; ks < 4; ++ks)
#pragma unroll
            for (int kt = 0; kt < 2; ++kt) sn[kt] = MFMA32(*(const bf16x8*)(Kn + kt * 32 * LK + ks * 16), qf[ks], sn[kt]);
        }
        if (j == qb || (sweep == 1 && j == qb - 8)) {
          const int khi = t - j * 64 - 4 * hh, klo = (sweep == 1) ? khi - 511 : -100000;
#pragma unroll
          for (int r = 0; r < 16; ++r) {
            const int o0 = (r & 3) + 8 * (r >> 2);
            st[0][r] = (o0 <= khi && o0 >= klo) ? st[0][r] : NSA_NEG;
            st[1][r] = (o0 + 32 <= khi && o0 + 32 >= klo) ? st[1][r] : NSA_NEG;
          }
        }
        float mx;
        {
          float a0, a1, a2, a3;
          asm("v_max3_f32 %0, %1, %2, %3" : "=v"(a0) : "v"(st[0][0]), "v"(st[0][1]), "v"(st[0][2]));
          asm("v_max3_f32 %0, %1, %2, %3" : "=v"(a1) : "v"(st[0][3]), "v"(st[0][4]), "v"(st[0][5]));
          asm("v_max3_f32 %0, %1, %2, %3" : "=v"(a2) : "v"(st[0][6]), "v"(st[0][7]), "v"(st[0][8]));
          asm("v_max3_f32 %0, %1, %2, %3" : "=v"(a3) : "v"(st[0][9]), "v"(st[0][10]), "v"(st[0][11]));
          asm("v_max3_f32 %0, %1, %2, %3" : "=v"(a0) : "v"(a0), "v"(st[0][12]), "v"(st[0][13]));
          asm("v_max3_f32 %0, %1, %2, %3" : "=v"(a1) : "v"(a1), "v"(st[0][14]), "v"(st[0][15]));
          asm("v_max3_f32 %0, %1, %2, %3" : "=v"(a2) : "v"(a2), "v"(st[1][0]), "v"(st[1][1]));
          asm("v_max3_f32 %0, %1, %2, %3" : "=v"(a3) : "v"(a3), "v"(st[1][2]), "v"(st[1][3]));
          asm("v_max3_f32 %0, %1, %2, %3" : "=v"(a0) : "v"(a0), "v"(st[1][4]), "v"(st[1][5]));
          asm("v_max3_f32 %0, %1, %2, %3" : "=v"(a1) : "v"(a1), "v"(st[1][6]), "v"(st[1][7]));
          asm("v_max3_f32 %0, %1, %2, %3" : "=v"(a2) : "v"(a2), "v"(st[1][8]), "v"(st[1][9]));
          asm("v_max3_f32 %0, %1, %2, %3" : "=v"(a3) : "v"(a3), "v"(st[1][10]), "v"(st[1][11]));
          asm("v_max3_f32 %0, %1, %2, %3" : "=v"(a0) : "v"(a0), "v"(st[1][12]), "v"(st[1][13]));
          asm("v_max3_f32 %0, %1, %2, %3" : "=v"(a1) : "v"(a1), "v"(st[1][14]), "v"(st[1][15]));
          asm("v_max3_f32 %0, %1, %2, %3" : "=v"(a0) : "v"(a0), "v"(a1), "v"(a2));
          const float other = a3;
          asm("v_max_f32 %0, %1, %2" : "=v"(mx) : "v"(a0), "v"(other));
          const float px = __shfl_xor(mx, 32);
          asm("v_max_f32 %0, %1, %2" : "=v"(mx) : "v"(mx), "v"(px));
        }
        const bool real = mx > -1e29f;
        const bool fresh = !has && real, up = has && (mx > NSA_THR);
        if (__any(fresh || up)) {
          const float delta = (fresh || up) ? mx : 0.f;
          const float alpha = up ? __builtin_amdgcn_exp2f(-delta) : 1.0f;
          m += delta; l *= alpha;
#pragma unroll
          for (int r = 0; r < 16; ++r) { o[0][r] *= alpha; o[1][r] *= alpha; st[0][r] -= delta; st[1][r] -= delta; }
          if (!late) {
            const float dn = seln ? delta : 0.f;
#pragma unroll
            for (int r = 0; r < 16; ++r) { sn[0][r] -= dn; sn[1][r] -= dn; }
          }
        }
        has = has || real;
        f32x2 s2 = {0.f, 0.f};
#pragma unroll
        for (int r = 0; r < 16; ++r) {
          const float p0 = __builtin_amdgcn_exp2f(st[0][r]), p1 = __builtin_amdgcn_exp2f(st[1][r]);
          st[0][r] = p0; st[1][r] = p1; s2 += (f32x2){p0, p1};
        }
        l += s2.x + s2.y;
        nsa_pv(o, st, tile, lane);
        if (late) {
          const float ini = seln ? -m : -1e30f;
#pragma unroll
          for (int r = 0; r < 16; ++r) { sn[0][r] = ini; sn[1][r] = ini; }
#pragma unroll
          for (int ks = 0; ks < 4; ++ks)
#pragma unroll
            for (int kt = 0; kt < 2; ++kt) sn[kt] = MFMA32(*(const bf16x8*)(Kn + kt * 32 * LK + ks * 16), qf[ks], sn[kt]);
        }
        if (j + 2 <= qb) nsa_store_tile(tr, smem + bnn * NSA_TILE);
        if (j + 3 <= qb) nsa_load_tile(tr, kb + (size_t)(j + 3) * 64 * 128, 128, vb + (size_t)(j + 3) * 64 * 128, 128);
#pragma unroll
        for (int r = 0; r < 16; ++r) { st[0][r] = sn[0][r]; st[1][r] = sn[1][r]; }
        bi = bn;
        __syncthreads();
      }
      __builtin_amdgcn_s_setprio(0);
      l += __shfl_xor(l, 32);
      if (!dry) nsa_accum_store(ONSA + it.tokrow * 512 + (it.g * 4 + r4) * 64, o, l > 0.f ? g_b / l : 0.f, false, hh);
      else asm volatile("" :: "v"(o[0]), "v"(o[1]), "v"(l));
    }
  }
}

DI unsigned ord_key(float f) { const unsigned u = __float_as_uint(f); return (u & 0x80000000u) ? ~u : (u | 0x80000000u); }
DI float ord_val(unsigned k) { return __uint_as_float((k & 0x80000000u) ? (k & 0x7fffffffu) : ~k); }
DI void cex(unsigned& hi, unsigned& lo) { const unsigned x = hi, y = lo; hi = x > y ? x : y; lo = x > y ? y : x; }
DI void sort16_desc(unsigned (&a)[16]) {
#pragma unroll
  for (int k = 2; k <= 16; k <<= 1)
#pragma unroll
    for (int j = k >> 1; j > 0; j >>= 1)
#pragma unroll
      for (int i = 0; i < 16; ++i) {
        const int l = i ^ j;
        if (l > i) { if ((i & k) == 0) cex(a[i], a[l]); else cex(a[l], a[i]); }
      }
}
DI void bitonic_finish16(unsigned (&a)[16]) {
#pragma unroll
  for (int j = 8; j > 0; j >>= 1)
#pragma unroll
    for (int i = 0; i < 16; ++i) { const int l = i ^ j; if (l > i) cex(a[i], a[l]); }
}
DI void merge_top16(unsigned (&a)[16], const unsigned (&b)[16]) {
#pragma unroll
  for (int i = 0; i < 16; ++i) a[i] = a[i] > b[15 - i] ? a[i] : b[15 - i];
  bitonic_finish16(a);
}
DI void merge_partner16(unsigned (&a)[16]) {
  unsigned b[16];
#pragma unroll
  for (int i = 0; i < 16; ++i) b[i] = (unsigned)__shfl_xor((int)a[i], 32);
  merge_top16(a, b);
}


DI void peer_top16(unsigned (&top)[16], const bf16_t* pqrow, const bf16_t* keys, int lane) {
  const int l31 = lane & 31, hh = lane >> 5;
  bf16x8 bq[8];
#pragma unroll
  for (int ks = 0; ks < 8; ++ks) bq[ks] = *(const bf16x8*)(pqrow + ks * 16 + hh * 8);
  unsigned grp[16];
#pragma unroll
  for (int nt = 0; nt < 4; ++nt) {
    f32x16 sa;
#pragma unroll
    for (int r = 0; r < 16; ++r) sa[r] = 0.f;
    const bf16_t* kp = keys + (size_t)(nt * 32 + l31) * 128 + hh * 8;
#pragma unroll
    for (int ks = 0; ks < 8; ++ks) { const bf16x8 a = *(const bf16x8*)(kp + ks * 16); sa = MFMA32(a, bq[ks], sa); }
#pragma unroll
    for (int r = 0; r < 16; ++r) {
      const int n = nt * 32 + (r & 3) + 8 * (r >> 2) + 4 * hh;
      grp[r] = (ord_key(sa[r]) & ~0x7Fu) | (unsigned)(127 - n);
    }
    sort16_desc(grp);
    if (nt == 0) {
#pragma unroll
      for (int i = 0; i < 16; ++i) top[i] = grp[i];
    } else merge_top16(top, grp);
  }
  merge_partner16(top);
}

DI void phase_route(const Params& p, char* smem) {
  char* ws = p.ws;
  const int tid = otid(), lane = tid & 63, wave = tid >> 6, l31 = lane & 31, hh = lane >> 5;
  const bf16_t* pq = (const bf16_t*)(ws + OFF_PQ);
  const bf16_t* pk = (const bf16_t*)(ws + OFF_PKEYS);
  int* eidx = (int*)(ws + OFF_EIDX);
  float* pgate = (float*)(ws + OFF_PGATE);
  unsigned* LS = (unsigned*)smem + wave * 1024;
  constexpr int CA[64] = {0,0,0,0,0,0,0,0,0,0,0,0,0,0,0,0, 1,1,1,1,1,1,1,1, 2,2,2,2,2, 3,3,3,3, 4,4,4, 5,5, 6,6, 7,7, 8,9,10,11,12,13,14,15, 0,0,0,0,0,0,0,0,0,0,0,0,0,0};
  constexpr int CB[64] = {0,1,2,3,4,5,6,7,8,9,10,11,12,13,14,15, 0,1,2,3,4,5,6,7, 0,1,2,3,4, 0,1,2,3, 0,1,2, 0,1, 0,1, 0,1, 0,0,0,0,0,0,0,0, 0,0,0,0,0,0,0,0,0,0,0,0,0,0};
  for (int item = blockIdx.x; item < (NTOK / 256) * 8; item += gridDim.x) {
    const int h = item & 7, t0 = (item >> 3) * 256 + wave * 32;
    unsigned s1[16], s2[16];
    const bf16_t* pqrow = pq + (size_t)(t0 + l31) * 2048 + h * 256;
    peer_top16(s1, pqrow, pk + (size_t)(h * 2) * 128 * 128, lane);
    peer_top16(s2, pqrow + 128, pk + (size_t)(h * 2 + 1) * 128 * 128, lane);
    float f1[16], f2[16];
#pragma unroll
    for (int i = 0; i < 16; ++i) { f1[i] = ord_val(s1[i]); f2[i] = ord_val(s2[i]); }
    unsigned ca[16], cb2[16];
#pragma unroll
    for (int i = 0; i < 32; ++i) {
      const int i0 = i, i1 = 25 + i;
      unsigned k0 = 0u, k1 = 0u;
      if (i0 < 25) k0 = (ord_key(f1[CA[i0]] + f2[CB[i0]]) & ~0xFFu) | (unsigned)(255 - (CA[i0] * 16 + CB[i0]));
      if (i1 < 50) k1 = (ord_key(f1[CA[i1]] + f2[CB[i1]]) & ~0xFFu) | (unsigned)(255 - (CA[i1] * 16 + CB[i1]));
      const unsigned kk = hh ? k1 : k0;
      if (i < 16) ca[i] = kk; else cb2[i - 16] = kk;
    }
    sort16_desc(ca); sort16_desc(cb2);
    merge_top16(ca, cb2);
    merge_partner16(ca);
    if (hh == 0) {
#pragma unroll
      for (int i = 0; i < 16; ++i) { LS[l31 * 32 + i] = s1[i]; LS[l31 * 32 + 16 + i] = s2[i]; }
    }
    const float mx = ord_val(ca[0]);
    float ex[16], sum = 0.f;
#pragma unroll
    for (int i = 0; i < 16; ++i) { ex[i] = __expf(ord_val(ca[i]) - mx); sum += ex[i]; }
    const float inv = 1.0f / sum;
    int eo[16]; float go[16];
#pragma unroll
    for (int i = 0; i < 16; ++i) {
      const int flat = 255 - (int)(ca[i] & 0xFFu);
      const unsigned k1 = LS[l31 * 32 + (flat >> 4)], k2 = LS[l31 * 32 + 16 + (flat & 15)];
      eo[i] = (127 - (int)(k1 & 0x7Fu)) * 128 + (127 - (int)(k2 & 0x7Fu));
      go[i] = ex[i] * inv;
    }
    const size_t ob = ((size_t)(t0 + l31) * 8 + h) * 16;
    if (hh == 0) {
      *(u32x4*)(eidx + ob) = (u32x4){(unsigned)eo[0], (unsigned)eo[1], (unsigned)eo[2], (unsigned)eo[3]};
      *(u32x4*)(eidx + ob + 4) = (u32x4){(unsigned)eo[4], (unsigned)eo[5], (unsigned)eo[6], (unsigned)eo[7]};
      *(f32x4*)(pgate + ob) = (f32x4){go[0], go[1], go[2], go[3]};
      *(f32x4*)(pgate + ob + 4) = (f32x4){go[4], go[5], go[6], go[7]};
    } else {
      *(u32x4*)(eidx + ob + 8) = (u32x4){(unsigned)eo[8], (unsigned)eo[9], (unsigned)eo[10], (unsigned)eo[11]};
      *(u32x4*)(eidx + ob + 12) = (u32x4){(unsigned)eo[12], (unsigned)eo[13], (unsigned)eo[14], (unsigned)eo[15]};
      *(f32x4*)(pgate + ob + 8) = (f32x4){go[8], go[9], go[10], go[11]};
      *(f32x4*)(pgate + ob + 12) = (f32x4){go[12], go[13], go[14], go[15]};
    }
  }
}

#define FOR32(M) M(0) M(1) M(2) M(3) M(4) M(5) M(6) M(7) M(8) M(9) M(10) M(11) M(12) M(13) M(14) M(15) M(16) M(17) M(18) M(19) M(20) M(21) M(22) M(23) M(24) M(25) M(26) M(27) M(28) M(29) M(30) M(31)
DI float dot16_fp8(const u32x4 raw, const float (&hx)[16]) {
  const f32x2 a0 = __builtin_amdgcn_cvt_pk_f32_fp8((int)raw.x, false), a1 = __builtin_amdgcn_cvt_pk_f32_fp8((int)raw.x, true);
  const f32x2 b0 = __builtin_amdgcn_cvt_pk_f32_fp8((int)raw.y, false), b1 = __builtin_amdgcn_cvt_pk_f32_fp8((int)raw.y, true);
  const f32x2 c0 = __builtin_amdgcn_cvt_pk_f32_fp8((int)raw.z, false), c1 = __builtin_amdgcn_cvt_pk_f32_fp8((int)raw.z, true);
  const f32x2 d0 = __builtin_amdgcn_cvt_pk_f32_fp8((int)raw.w, false), d1 = __builtin_amdgcn_cvt_pk_f32_fp8((int)raw.w, true);
  float d = (hx[0] * a0.x + hx[1] * a0.y) + (hx[2] * a1.x + hx[3] * a1.y);
  d += (hx[4] * b0.x + hx[5] * b0.y) + (hx[6] * b1.x + hx[7] * b1.y);
  d += (hx[8] * c0.x + hx[9] * c0.y) + (hx[10] * c1.x + hx[11] * c1.y);
  d += (hx[12] * d0.x + hx[13] * d0.y) + (hx[14] * d1.x + hx[15] * d1.y);
  return d;
}
#define FOR16(M) M(0) M(1) M(2) M(3) M(4) M(5) M(6) M(7) M(8) M(9) M(10) M(11) M(12) M(13) M(14) M(15)
DI void phase_ffn_u(const Params& p) {
  char* ws = p.ws;
  const int lane = otid() & 63, wave = otid() >> 6, pg = lane >> 3, dc = lane & 7;
  const int sl = blockIdx.x & 7, wslot = (blockIdx.x >> 3) * NW + wave, nw = (gridDim.x >> 3) * NW;
  const unsigned char* PU8 = (const unsigned char*)(ws + OFF_PU8) + (size_t)sl * 16384 * 128 + dc * 16;
  const bf16_t* h2 = (const bf16_t*)(ws + OFF_H) + sl * 128 + dc * 16;
  const int* eidx = (const int*)(ws + OFF_EIDX);
  float* part = (float*)(ws + OFF_PART) + (size_t)sl * NTOK * 128;
  const int j0 = (dc >> 2) * 64 + ((2 * dc) & 7) * 8 + pg;
  int ev0 = 0, ev1 = 0, nev0 = 0, nev1 = 0; u32x4 ha = {0u, 0u, 0u, 0u}, hb = ha, nha = ha, nhb = ha;
  if (wslot < NTOK) { ev0 = eidx[(size_t)wslot * 128 + lane]; ev1 = eidx[(size_t)wslot * 128 + 64 + lane]; ha = *(const u32x4*)(h2 + (size_t)wslot * DM); hb = *(const u32x4*)(h2 + (size_t)wslot * DM + 8); }
  for (int t = wslot; t < NTOK; t += nw) {
    if (t + nw < NTOK) { const size_t o = (size_t)(t + nw) * 128; nev0 = eidx[o + lane]; nev1 = eidx[o + 64 + lane]; nha = *(const u32x4*)(h2 + (size_t)(t + nw) * DM); nhb = *(const u32x4*)(h2 + (size_t)(t + nw) * DM + 8); }
    float hx[16];
    { float t8[8]; unpack8(ha, t8);
#pragma unroll
      for (int i = 0; i < 8; ++i) hx[i] = t8[i];
      unpack8(hb, t8);
#pragma unroll
      for (int i = 0; i < 8; ++i) hx[8 + i] = t8[i]; }
#define FFU_LD(it) const u32x4 ru##it = *(const u32x4*)(PU8 + (size_t)__shfl((it) < 8 ? ev0 : ev1, ((it) & 7) * 8 + pg) * 128);
    FOR16(FFU_LD)
    float d[16];
#define FFU_CP(it) d[it] = dot16_fp8(ru##it, hx);
    FOR16(FFU_CP)
    float r8[8], r4[4], r2[2];
    { const bool hi = dc & 4;
#pragma unroll
      for (int i = 0; i < 8; ++i) { const float keep = hi ? d[8 + i] : d[i], send = hi ? d[i] : d[8 + i]; r8[i] = keep + __shfl_xor(send, 4); } }
    { const bool hi = dc & 2;
#pragma unroll
      for (int i = 0; i < 4; ++i) { const float keep = hi ? r8[4 + i] : r8[i], send = hi ? r8[i] : r8[4 + i]; r4[i] = keep + __shfl_xor(send, 2); } }
    { const bool hi = dc & 1;
#pragma unroll
      for (int i = 0; i < 2; ++i) { const float keep = hi ? r4[2 + i] : r4[i], send = hi ? r4[i] : r4[2 + i]; r2[i] = keep + __shfl_xor(send, 1); } }
    part[(size_t)t * 128 + j0] = r2[0];
    part[(size_t)t * 128 + j0 + 8] = r2[1];
    ev0 = nev0; ev1 = nev1; ha = nha; hb = nhb;
  }
}
DI void phase_ffn_w(const Params& p) {
  char* ws = p.ws;
  const int lane = otid() & 63, wave = otid() >> 6;
  const float* part = (const float*)(ws + OFF_PART);
  const float* scu = (const float*)(ws + OFF_SCU); const float* scv = (const float*)(ws + OFF_SCV);
  const int* eidx = (const int*)(ws + OFF_EIDX);
  const float* pgate = (const float*)(ws + OFF_PGATE);
  float* wbuf = (float*)(ws + OFF_WBUF);
  for (int grp = blockIdx.x; grp < NTOK / NW; grp += gridDim.x) {
    const size_t o = (size_t)(grp * NW + wave) * 128 + lane;
    float a0 = 0.f, a1 = 0.f;
#pragma unroll
    for (int s8 = 0; s8 < 8; ++s8) { a0 += part[(size_t)s8 * NTOK * 128 + o]; a1 += part[(size_t)s8 * NTOK * 128 + o + 64]; }
    const int e0 = eidx[o], e1 = eidx[o + 64];
    wbuf[o] = pgate[o] * gelu_f(a0 * scu[e0]) * scv[e0];
    wbuf[o + 64] = pgate[o + 64] * gelu_f(a1 * scu[e1]) * scv[e1];
  }
}
DI void phase_ffn_v(const Params& p) {
  char* ws = p.ws;
  const int lane = otid() & 63, wave = otid() >> 6, pg = lane >> 3, dc = lane & 7;
  const int sl = blockIdx.x & 7, wslot = (blockIdx.x >> 3) * NW + wave, nw = (gridDim.x >> 3) * NW;
  const unsigned char* PV8 = (const unsigned char*)(ws + OFF_PV8) + (size_t)sl * 16384 * 128 + dc * 16;
  const int* eidx = (const int*)(ws + OFF_EIDX) + 16 * pg;
  const float* wbuf = (const float*)(ws + OFF_WBUF) + 16 * pg;
  bf16_t* ffnb = (bf16_t*)(ws + OFF_FFNB);
  u32x4 ne0 = {0u, 0u, 0u, 0u}, ne1 = ne0, ne2 = ne0, ne3 = ne0;
  if (wslot < NTOK) { const int* ep = eidx + (size_t)wslot * 128; ne0 = *(const u32x4*)ep; ne1 = *(const u32x4*)(ep + 4); ne2 = *(const u32x4*)(ep + 8); ne3 = *(const u32x4*)(ep + 12); }
#pragma unroll 1
  for (int t = wslot; t < NTOK; t += nw) {
    const u32x4 ce0 = ne0, ce1 = ne1, ce2 = ne2, ce3 = ne3;
    if (t + nw < NTOK) { const int* ep = eidx + (size_t)(t + nw) * 128; ne0 = *(const u32x4*)ep; ne1 = *(const u32x4*)(ep + 4); ne2 = *(const u32x4*)(ep + 8); ne3 = *(const u32x4*)(ep + 12); }
    const float* wp = wbuf + (size_t)t * 128;
    const f32x4 wq0 = *(const f32x4*)wp, wq1 = *(const f32x4*)(wp + 4), wq2 = *(const f32x4*)(wp + 8), wq3 = *(const f32x4*)(wp + 12);
#define FFV_E(it) ((it) < 4 ? ce0[(it) & 3] : (it) < 8 ? ce1[(it) & 3] : (it) < 12 ? ce2[(it) & 3] : ce3[(it) & 3])
#define FFV_W(it) ((it) < 4 ? wq0[(it) & 3] : (it) < 8 ? wq1[(it) & 3] : (it) < 12 ? wq2[(it) & 3] : wq3[(it) & 3])
#define FFV_LD(it) const u32x4 rv##it = *(const u32x4*)(PV8 + (size_t)FFV_E(it) * 128);
#define FFV_CP(it) { const float wj = FFV_W(it); \
      const f32x2 a0 = __builtin_amdgcn_cvt_pk_f32_fp8((int)rv##it.x, false), a1 = __builtin_amdgcn_cvt_pk_f32_fp8((int)rv##it.x, true); \
      const f32x2 b0 = __builtin_amdgcn_cvt_pk_f32_fp8((int)rv##it.y, false), b1 = __builtin_amdgcn_cvt_pk_f32_fp8((int)rv##it.y, true); \
      const f32x2 c0 = __builtin_amdgcn_cvt_pk_f32_fp8((int)rv##it.z, false), c1 = __builtin_amdgcn_cvt_pk_f32_fp8((int)rv##it.z, true); \
      const f32x2 d0 = __builtin_amdgcn_cvt_pk_f32_fp8((int)rv##it.w, false), d1 = __builtin_amdgcn_cvt_pk_f32_fp8((int)rv##it.w, true); \
      acc[0] += wj * a0.x; acc[1] += wj * a0.y; acc[2] += wj * a1.x; acc[3] += wj * a1.y; acc[4] += wj * b0.x; acc[5] += wj * b0.y; acc[6] += wj * b1.x; acc[7] += wj * b1.y; \
      acc[8] += wj * c0.x; acc[9] += wj * c0.y; acc[10] += wj * c1.x; acc[11] += wj * c1.y; acc[12] += wj * d0.x; acc[13] += wj * d0.y; acc[14] += wj * d1.x; acc[15] += wj * d1.y; }
    FOR16(FFV_LD)
    float acc[16];
#pragma unroll
    for (int i = 0; i < 16; ++i) acc[i] = 0.f;
    FOR16(FFV_CP)
    float r8[8], r4[4], r2[2];
    { const bool hi = lane & 32;
#pragma unroll
      for (int i = 0; i < 8; ++i) { const float keep = hi ? acc[8 + i] : acc[i], send = hi ? acc[i] : acc[8 + i]; r8[i] = keep + __shfl_xor(send, 32); } }
    { const bool hi = lane & 16;
#pragma unroll
      for (int i = 0; i < 4; ++i) { const float keep = hi ? r8[4 + i] : r8[i], send = hi ? r8[i] : r8[4 + i]; r4[i] = keep + __shfl_xor(send, 16); } }
    { const bool hi = lane & 8;
#pragma unroll
      for (int i = 0; i < 2; ++i) { const float keep = hi ? r4[2 + i] : r4[i], send = hi ? r4[i] : r4[2 + i]; r2[i] = keep + __shfl_xor(send, 8); } }
    *(unsigned*)(ffnb + (size_t)t * DM + sl * 128 + dc * 16 + 2 * pg) = pack2(r2[0], r2[1]);
  }
}
DI void phase_final(const Params& p) {
  char* ws = p.ws;
  const int lane = otid() & 63, wave = otid() >> 6;
  const bf16_t* x1 = (const bf16_t*)(ws + OFF_X1);
  const bf16_t* ffnb = (const bf16_t*)(ws + OFF_FFNB);
  const float* mod = (const float*)(ws + OFF_MOD);
  for (int grp = blockIdx.x; grp < NTOK / NW; grp += gridDim.x) {
    const int row = grp * NW + wave, b = row >> 13;
    float v[16];
#pragma unroll
    for (int i = 0; i < 4; ++i) {
      const int col = i * 256 + lane * 4;
      const f32x4 gt2 = *(const f32x4*)(mod + b * 6144 + 5120 + col);
      const u32x2 xr = *(const u32x2*)(x1 + (size_t)row * DM + col), fr = *(const u32x2*)(ffnb + (size_t)row * DM + col);
      v[4 * i] = DN_ALPHA * bflo(xr.x) + gt2.x * bflo(fr.x); v[4 * i + 1] = DN_ALPHA * bfhi(xr.x) + gt2.y * bfhi(fr.x);
      v[4 * i + 2] = DN_ALPHA * bflo(xr.y) + gt2.z * bflo(fr.y); v[4 * i + 3] = DN_ALPHA * bfhi(xr.y) + gt2.w * bfhi(fr.y);
    }
    float mean, rstd; row_stats(v, mean, rstd);
#pragma unroll
    for (int i = 0; i < 4; ++i) {
      const int col = i * 256 + lane * 4;
      const f32x4 g = *(const f32x4*)(p.ln2_g + col), bb = *(const f32x4*)(p.ln2_b + col);
      f32x4 o;
      o.x = (v[4 * i] - mean) * rstd * g.x + bb.x; o.y = (v[4 * i + 1] - mean) * rstd * g.y + bb.y;
      o.z = (v[4 * i + 2] - mean) * rstd * g.z + bb.z; o.w = (v[4 * i + 3] - mean) * rstd * g.w + bb.w;
      *(f32x4*)(p.out + (size_t)row * DM + col) = o;
    }
  }
}

#define XB_TMO      128
#define XB_XCNT(j)  (256  + 64 * (j))
#define XB_XSUB(j)  (1280 + 64 * (j))
#define XB_XGEN(j)  (2304 + 64 * (j))
#define XB_TOP      3328
#define XB_TOPGEN   3392
#define XCD_BAR_WORDS 3456
#define XB_SPIN_CAP (1u << 22)
DI unsigned xb_ld(unsigned* p) { return __hip_atomic_load(p, __ATOMIC_RELAXED, __HIP_MEMORY_SCOPE_AGENT); }
DI unsigned xb_add(unsigned* p, unsigned v) { return __hip_atomic_fetch_add(p, v, __ATOMIC_RELAXED, __HIP_MEMORY_SCOPE_AGENT); }
DI unsigned xb_xcc_id() { return (unsigned)__builtin_amdgcn_s_getreg((3 << 11) | 20) & 0xFu; }
#define XB_SPIN(cond, bar) do { unsigned _sp = 0; while (cond) { __builtin_amdgcn_s_sleep(1); \
    if ((++_sp & 255u) == 0u) { if (xb_ld(&(bar)[XB_TMO])) break; if (_sp > XB_SPIN_CAP) { atomicAdd(&(bar)[XB_TMO], 1u); break; } } } } while (0)
struct XcdBarrier { unsigned* bar; unsigned x; volatile LAS unsigned* st; };
DI XcdBarrier xcd_barrier_post(unsigned* bar, volatile LAS unsigned* st) {
  XcdBarrier b; b.bar = bar; b.x = xb_xcc_id(); b.st = st;
  if (threadIdx.x == 0) (void)xb_add(&bar[XB_XCNT(b.x)], 1u);
  return b;
}
DI void xcd_barrier_complete(unsigned* bar, unsigned x, unsigned& nloc, unsigned& nx) {
  const unsigned G = gridDim.x * gridDim.y * gridDim.z;
  unsigned sum, cnt, mine, sp = 0u;
  for (;;) {
    sum = 0u; cnt = 0u; mine = 0u;
#pragma unroll
    for (unsigned j = 0; j < 16; ++j) { const unsigned c = xb_ld(&bar[XB_XCNT(j)]); sum += c; cnt += (c > 0u) ? 1u : 0u; mine = (j == x) ? c : mine; }
    if (sum == G) break;
    __builtin_amdgcn_s_sleep(1);
    if ((++sp & 255u) == 0u) { if (xb_ld(&bar[XB_TMO])) break; if (sp > XB_SPIN_CAP) { atomicAdd(&bar[XB_TMO], 1u); break; } }
  }
  nloc = mine > 0u ? mine : 1u; nx = cnt > 0u ? cnt : 1u;
}
DI void xcd_barrier(const XcdBarrier& b) {
  asm volatile("s_waitcnt vmcnt(0)" ::: "memory");
  __syncthreads();
  if (threadIdx.x == 0) {
    unsigned* bar = b.bar;
    __builtin_amdgcn_s_waitcnt(0);
    unsigned nloc = b.st[0], nx = b.st[1];
    if (nloc == 0u) { xcd_barrier_complete(bar, b.x, nloc, nx); b.st[0] = nloc; b.st[1] = nx; }
    const unsigned old = xb_add(&bar[XB_XSUB(b.x)], 1u);
    const unsigned gen = old / nloc;
    if (old + 1u == (gen + 1u) * nloc) {
      __builtin_amdgcn_fence(__ATOMIC_RELEASE, "agent");
      asm volatile("s_waitcnt vmcnt(0)" ::: "memory");
      const unsigned og = xb_add(&bar[XB_TOP], 1u);
      const unsigned tg = og / nx;
      if (og + 1u == (tg + 1u) * nx) xb_add(&bar[XB_TOPGEN], 1u);
      else XB_SPIN(xb_ld(&bar[XB_TOPGEN]) == tg, bar);
      __builtin_amdgcn_fence(__ATOMIC_ACQUIRE, "agent");
      xb_add(&bar[XB_XGEN(b.x)], 1u);
      asm volatile("s_waitcnt vmcnt(0)" ::: "memory");
    } else {
      XB_SPIN(xb_ld(&bar[XB_XGEN(b.x)]) == gen, bar);
      __builtin_amdgcn_fence(__ATOMIC_ACQUIRE, "agent");
      asm volatile("s_waitcnt vmcnt(0)" ::: "memory");
    }
  }
  __syncthreads();
}

constexpr int SMEM_BYTES = 147456 + 256;

__global__ void __launch_bounds__(NT, 2) k_mega(Params p) {
  __shared__ __attribute__((aligned(16))) char smem[SMEM_BYTES];
  cg::grid_group grid = cg::this_grid();
  if (threadIdx.x == 0) *(u32x4*)(smem + 147456) = (u32x4){0u, 0u, 0u, 0u};
  __syncthreads();
  const XcdBarrier xb = xcd_barrier_post((unsigned*)(p.ws + OFF_BAR), (volatile LAS unsigned*)(smem + 147456));
#define REP(mask) _Pragma("unroll 1") for (int rep_ = 0; rep_ < ((PROBE_DUP & (mask)) ? 2 : 1); ++rep_)
  REP(1) phase_prep(p, smem);
  grid.sync();
  REP(1) phase_ln_in(p);
  xcd_barrier(xb);
  REP(2) phase_gemm1(p, smem);
  xcd_barrier(xb);
  REP(4) phase_compress(p, smem);
  phase_sgu(p, smem);
  xcd_barrier(xb);
  REP(8) phase_nsa(p, smem, NSA_MASK);
  xcd_barrier(xb);
  REP(16) phase_merge(p, smem);
  xcd_barrier(xb);
  REP(16) phase_outproj(p, smem);
  xcd_barrier(xb);
  REP(1) phase_ln_mid(p);
  xcd_barrier(xb);
  REP(32) phase_peerq(p, smem);
  xcd_barrier(xb);
  REP(64) phase_route(p, smem);
  xcd_barrier(xb);
  REP(128) phase_ffn_u(p);
  xcd_barrier(xb);
  REP(128) phase_ffn_w(p);
  xcd_barrier(xb);
  REP(256) phase_ffn_v(p);
  xcd_barrier(xb);
  REP(512) phase_final(p);
}

extern "C" void kernel_launch(void* const* d_in, const int* in_sizes, int n_in, void* d_out, int out_size, void* d_ws, size_t ws_size, hipStream_t stream) {
  if (ws_size < OFF_END) { fprintf(stderr, "workspace too small: %zu < %zu\n", ws_size, (size_t)OFF_END); return; }
  static int grid_blocks = 0;
  if (!grid_blocks) {
    int dev = 0, cus = 0, per_cu = 0;
    (void)hipGetDevice(&dev);
    (void)hipDeviceGetAttribute(&cus, hipDeviceAttributeMultiprocessorCount, dev);
    (void)hipOccupancyMaxActiveBlocksPerMultiprocessor(&per_cu, k_mega, NT, 0);
    if (per_cu < 1) fprintf(stderr, "occupancy query returned %d\n", per_cu);
    grid_blocks = (cus / 8) * 8;
  }
  Params p{};
  const float** fp = (const float**)&p;
  for (int i = 0; i < 26; ++i) fp[i] = (const float*)d_in[i];
  p.out = (float*)d_out;
  p.ws = (char*)d_ws;
  for (int i = 0; i < 32; ++i) p.inv_freq[i] = (float)pow(10000.0, -(double)i / 32.0);
  (void)hipMemsetAsync((char*)d_ws + OFF_BAR, 0, XCD_BAR_WORDS * 4, stream);
  void* args[] = {&p};
  hipError_t e = hipLaunchCooperativeKernel((void*)k_mega, dim3(grid_blocks), dim3(NT), args, 0, stream);
  if (e != hipSuccess) fprintf(stderr, "cooperative launch failed: %s (grid %d)\n", hipGetErrorString(e), grid_blocks);
}
```

```cpp
#include <hip/hip_runtime.h>
#include <hip/hip_cooperative_groups.h>
#include <stdint.h>
#include <stdio.h>
#include <math.h>
namespace cg = cooperative_groups;

#ifndef PROBE_DUP
#define PROBE_DUP 0
#endif
#ifndef NSA_MASK
#define NSA_MASK 7
#endif
typedef unsigned short bf16_t;
typedef short bf16x8 __attribute__((ext_vector_type(8)));
typedef short s16x4 __attribute__((ext_vector_type(4)));
typedef float f32x16 __attribute__((ext_vector_type(16)));
typedef float f32x4 __attribute__((ext_vector_type(4)));
typedef float f32x2 __attribute__((ext_vector_type(2)));
typedef __bf16 bf16v2 __attribute__((ext_vector_type(2)));
typedef unsigned u32x4 __attribute__((ext_vector_type(4)));
typedef unsigned u32x2 __attribute__((ext_vector_type(2)));
#define DI __device__ __forceinline__
#define LAS __attribute__((address_space(3)))
#define MFMA32(a, b, c) __builtin_amdgcn_mfma_f32_32x32x16_bf16((a), (b), (c), 0, 0, 0)

constexpr int NT = 512, NW = 8;
constexpr int NB = 8, SEQ = 8192, DM = 1024, NTOK = NB * SEQ;
constexpr int N1 = 4608;
constexpr float DN_ALPHA = 1.189207115002721f;
constexpr float LN_EPS = 1e-5f;

constexpr size_t MB = 1024 * 1024;
constexpr size_t OFF_MOD = 0;
constexpr size_t OFF_ROPE = OFF_MOD + 256 * 1024;
constexpr size_t OFF_POSB = OFF_ROPE + 2 * MB;
constexpr size_t OFF_WT1 = OFF_POSB + 4096;
constexpr size_t OFF_WB = OFF_WT1 + (size_t)N1 * 1024 * 2;
constexpr size_t OFF_WOUT = OFF_WB + 2 * MB;
constexpr size_t OFF_WQ = OFF_WOUT + 2 * MB;
constexpr size_t OFF_PKEYS = OFF_WQ + 4 * MB;
constexpr size_t OFF_CW1 = OFF_PKEYS + MB / 2;
constexpr size_t OFF_CW2 = OFF_CW1 + MB;
constexpr size_t OFF_SGUW = OFF_CW2 + 32 * 1024;
constexpr size_t OFF_SCU = OFF_SGUW + 256 * 1024;
constexpr size_t OFF_SCV = OFF_SCU + 64 * 1024;
constexpr size_t OFF_PU = OFF_SCV + 64 * 1024;
constexpr size_t OFF_PV = OFF_PU + 32 * MB;
constexpr size_t OFF_ACT = ((OFF_PV + 32 * MB + 4095) / 4096) * 4096;
constexpr size_t OFF_H = OFF_ACT;
constexpr size_t OFF_Q = OFF_H + 128 * MB;
constexpr size_t OFF_KC = OFF_Q + 64 * MB;
constexpr size_t OFF_VC = OFF_KC + 16 * MB;
constexpr size_t OFF_KS = OFF_VC + 16 * MB;
constexpr size_t OFF_VS = OFF_KS + 16 * MB;
constexpr size_t OFF_KW = OFF_VS + 16 * MB;
constexpr size_t OFF_VW = OFF_KW + 16 * MB;
constexpr size_t OFF_U = OFF_VW + 16 * MB;
constexpr size_t OFF_V = OFF_U + 64 * MB;
constexpr size_t OFF_GATE = OFF_V + 64 * MB;
constexpr size_t OFF_GSIG = OFF_GATE + 256 * MB;
constexpr size_t OFF_KCMP = OFF_GSIG + 8 * MB;
constexpr size_t OFF_VCMP = OFF_KCMP + MB;
constexpr size_t OFF_ONSA = OFF_VCMP + MB;
constexpr size_t OFF_SELG = OFF_ONSA + 64 * MB;
constexpr size_t OFF_BAR = OFF_SELG + 2 * MB;
constexpr size_t OFF_END = OFF_BAR + 64 * 1024;
constexpr size_t OFF_X1 = OFF_Q;
constexpr size_t OFF_Y = OFF_GATE;
constexpr size_t OFF_PQ = OFF_GATE;
constexpr size_t OFF_EIDX = OFF_ONSA;
constexpr size_t OFF_PGATE = OFF_ONSA + 32 * MB;
constexpr size_t OFF_PU8 = OFF_PU;
constexpr size_t OFF_PART = OFF_GATE;
constexpr size_t OFF_PV8 = OFF_PU + 16 * MB;
constexpr size_t OFF_WBUF = OFF_PU + 32 * MB;
constexpr size_t OFF_FFNB = OFF_GATE;

struct Params {
  const float *x, *c, *w_ada, *b_ada, *w_in, *cmp_pos, *cmp_w1, *cmp_b1, *cmp_w2, *cmp_b2, *sgu_ln_g, *sgu_ln_b, *sgu_w, *sgu_b,
      *w_branch, *w_merge, *b_merge, *w_out, *ln1_g, *ln1_b, *peer_wq, *peer_keys, *peer_u, *peer_v, *ln2_g, *ln2_b;
  float* out;
  char* ws;
  float inv_freq[32];
};

DI unsigned pack2(float lo, float hi) { f32x2 v = {lo, hi}; bf16v2 r = __builtin_convertvector(v, bf16v2); return __builtin_bit_cast(unsigned, r); }
DI bf16_t f2bf(float f) { __bf16 r = (__bf16)f; return __builtin_bit_cast(unsigned short, r); }
DI float bf2f(bf16_t h) { return __uint_as_float(((unsigned)h) << 16); }
DI float bflo(unsigned u) { return __uint_as_float(u << 16); }
DI float bfhi(unsigned u) { return __uint_as_float(u & 0xffff0000u); }
DI float gelu_f(float v) { return 0.5f * v * (1.0f + erff(v * 0.70710678118654752f)); }
DI float sigmoid_f(float v) { return 1.0f / (1.0f + __expf(-v)); }
DI int otid() { int t = __builtin_amdgcn_workitem_id_x(); asm volatile("" : "+v"(t)); return t; }
DI void lds_barrier() { asm volatile("s_waitcnt lgkmcnt(0)" ::: "memory"); __builtin_amdgcn_s_barrier(); asm volatile("" ::: "memory"); }
DI float wave_sum(float v) {
#pragma unroll
  for (int o = 32; o > 0; o >>= 1) v += __shfl_xor(v, o);
  return v;
}
DI void ld8(const float* pz, float (&v)[8]) { const f32x4 a = *(const f32x4*)pz, b = *(const f32x4*)(pz + 4); v[0] = a.x; v[1] = a.y; v[2] = a.z; v[3] = a.w; v[4] = b.x; v[5] = b.y; v[6] = b.z; v[7] = b.w; }
DI u32x4 pack8(const float (&v)[8]) { u32x4 w; w.x = pack2(v[0], v[1]); w.y = pack2(v[2], v[3]); w.z = pack2(v[4], v[5]); w.w = pack2(v[6], v[7]); return w; }
DI void unpack8(const u32x4 w, float (&v)[8]) { v[0] = bflo(w.x); v[1] = bfhi(w.x); v[2] = bflo(w.y); v[3] = bfhi(w.y); v[4] = bflo(w.z); v[5] = bfhi(w.z); v[6] = bflo(w.w); v[7] = bfhi(w.w); }
DI f32x2 gelu_pk(f32x2 v) {
  const f32x2 av = __builtin_elementwise_abs(v), d = av * 0.2316418882f + 1.0f;
  f32x2 t; t.x = __builtin_amdgcn_rcpf(d.x); t.y = __builtin_amdgcn_rcpf(d.y);
  f32x2 q = t * 0.5307027145f + (-0.7265760135f); q = q * t + 0.7107068705f; q = q * t + (-0.142248368f); q = q * t + 0.127414796f; q = q * t;
  const f32x2 s = (v * v) * (-0.72134752044f);
  f32x2 e; e.x = __builtin_amdgcn_exp2f(s.x); e.y = __builtin_amdgcn_exp2f(s.y);
  const f32x2 m = v * (q * e), r = v - m;
  f32x2 o; o.x = v.x < 0.f ? m.x : r.x; o.y = v.y < 0.f ? m.y : r.y; return o;
}
__host__ __device__ __forceinline__ int dperm(int q) { const int grp = q >> 5, fq = (q >> 3) & 3, j = q & 7; return (j < 4) ? (16 * grp + 4 * fq + j) : (32 + 16 * grp + 4 * fq + (j - 4)); }

template <class F>
DI void tconv_tile(float* tile, int k0, int n0, bf16_t* dst, int ldd, F f) {
  const int tid = otid();
  __syncthreads();
#pragma unroll 4
  for (int i = 0; i < 8; ++i) { const int kl = i * 8 + (tid >> 6), nl = tid & 63; tile[nl * 65 + kl] = f(k0 + kl, n0 + nl); }
  __syncthreads();
  {
    const int nl = tid >> 3, kc = tid & 7;
    const float* t = tile + nl * 65 + kc * 8;
    u32x4 w; w.x = pack2(t[0], t[1]); w.y = pack2(t[2], t[3]); w.z = pack2(t[4], t[5]); w.w = pack2(t[6], t[7]);
    *(u32x4*)(dst + (size_t)(n0 + nl) * ldd + k0 + kc * 8) = w;
  }
}

DI void conv_chunk(const float* src, bf16_t* dst, size_t base) {
  const size_t i = base + (size_t)otid() * 8;
  const f32x4 a = *(const f32x4*)(src + i), b = *(const f32x4*)(src + i + 4);
  u32x4 w; w.x = pack2(a.x, a.y); w.y = pack2(a.z, a.w); w.z = pack2(b.x, b.y); w.w = pack2(b.z, b.w);
  *(u32x4*)(dst + i) = w;
}

DI void sincos_d(double x, double& s, double& c) {
  const double y = x * 0.25, y2 = y * y;
  double sn = y * (1.0 + y2 * (-1.0 / 6 + y2 * (1.0 / 120 + y2 * (-1.0 / 5040 + y2 * (1.0 / 362880 + y2 * (-1.0 / 39916800 + y2 * (1.0 / 6227020800.0)))))));
  double cs = 1.0 + y2 * (-0.5 + y2 * (1.0 / 24 + y2 * (-1.0 / 720 + y2 * (1.0 / 40320 + y2 * (-1.0 / 3628800 + y2 * (1.0 / 479001600.0 + y2 * (-1.0 / 87178291200.0)))))));
#pragma unroll
  for (int i = 0; i < 2; ++i) { const double s2 = 2.0 * sn * cs, c2 = cs * cs - sn * sn; sn = s2; cs = c2; }
  s = sn; c = cs;
}

DI void phase_prep(const Params& p, char* smem) {
  const int tid = otid();
  float* fs = (float*)smem;
  char* ws = p.ws;
  constexpr int nA = 192, nB = 16 * 72, nC = 2 * 8 * 16, nD = 256, nE = 16 * 32, nF = 2 * 32 * 2, nG = 4, nH = 8, nI = 512, nJ = 64, nK = 32, nL = 2048, nM = 2048;
  constexpr int total = nA + nB + nC + nD + nE + nF + nG + nH + nI + nJ + nK + nL + nM;
  for (int item = blockIdx.x; item < total; item += gridDim.x) {
    int it = item;
    if (it < nA) {
      float* sc = fs;
      float* red = fs + 8192;
      __syncthreads();
      for (int i = tid; i < 8192; i += NT) { const float v = p.c[i]; sc[i] = v / (1.0f + __expf(-v)); }
      __syncthreads();
      const int ks = tid >> 5, cj = tid & 31, col = it * 32 + cj;
      float acc[8];
#pragma unroll
      for (int b = 0; b < 8; ++b) acc[b] = 0.f;
#pragma unroll 4
      for (int k = ks * 64; k < ks * 64 + 64; ++k) {
        const float w = p.w_ada[(size_t)k * 6144 + col];
#pragma unroll
        for (int b = 0; b < 8; ++b) acc[b] += sc[b * 1024 + k] * w;
      }
#pragma unroll
      for (int b = 0; b < 8; ++b) red[(ks * 8 + b) * 32 + cj] = acc[b];
      __syncthreads();
      if (tid < 256) {
        const int b = tid >> 5;
        float s = p.b_ada[col];
#pragma unroll
        for (int k2 = 0; k2 < 16; ++k2) s += red[(k2 * 8 + b) * 32 + cj];
        ((float*)(ws + OFF_MOD))[b * 6144 + col] = s;
      }
      continue;
    }
    it -= nA;
    if (it < nB) {
      const int kt = it / 72, ntile = it % 72;
      const float* w_in = p.w_in; const float* w_merge = p.w_merge;
      tconv_tile(fs, kt * 64, ntile * 64, (bf16_t*)(ws + OFF_WT1), 1024, [=](int k, int n) -> float {
        if (n < 1280) {
          const bool roped = (n < 640) || (n >= 768 && n < 896) || (n >= 1024 && n < 1152);
          const int col = roped ? ((n & ~63) + dperm(n & 63)) : n;
          return w_in[(size_t)k * 2328 + col];
        }
        if (n < 2304) return w_in[(size_t)k * 2328 + n + 24];
        if (n < 4352) return w_merge[(size_t)k * 2048 + (n - 2304)];
        if (n < 4376) return w_in[(size_t)k * 2328 + 1280 + (n - 4352)];
        return 0.f; });
      continue;
    }
    it -= nB;
    if (it < nC) {
      const int br = it >> 7, r = it & 127, kt = r >> 4, ntile = r & 15;
      const float* src = p.w_branch + (size_t)br * 512 * 1024;
      tconv_tile(fs, kt * 64, ntile * 64, (bf16_t*)(ws + OFF_WB) + (size_t)br * 1024 * 512, 512, [=](int k, int n) -> float { return src[(size_t)k * 1024 + n]; });
      continue;
    }
    it -= nC;
    if (it < nD) {
      const int kt = it >> 4, ntile = it & 15;
      const float* src = p.w_out;
      tconv_tile(fs, kt * 64, ntile * 64, (bf16_t*)(ws + OFF_WOUT), 1024, [=](int k, int n) -> float { return src[(size_t)k * 1024 + n]; });
      continue;
    }
    it -= nD;
    if (it < nE) {
      const int kt = it >> 5, ntile = it & 31;
      const float* src = p.peer_wq;
      tconv_tile(fs, kt * 64, ntile * 64, (bf16_t*)(ws + OFF_WQ), 1024, [=](int k, int n) -> float { return src[(size_t)k * 2048 + n]; });
      continue;
    }
    it -= nE;
    if (it < nF) {
      const int w = it >> 6, r = it & 63, kt = r >> 1, ntile = r & 1;
      const float* src = p.cmp_w1 + (size_t)w * 2048 * 128;
      tconv_tile(fs, kt * 64, ntile * 64, (bf16_t*)(ws + OFF_CW1) + (size_t)w * 128 * 2048, 2048, [=](int k, int n) -> float {
        const int ksrc = (w == 0) ? ((k & ~63) + dperm(k & 63)) : k;
        return src[(size_t)ksrc * 128 + n]; });
      continue;
    }
    it -= nF;
    if (it < nG) {
      const int w = it >> 1, kt = it & 1;
      const float* src = p.cmp_w2 + (size_t)w * 128 * 64;
      tconv_tile(fs, kt * 64, 0, (bf16_t*)(ws + OFF_CW2) + (size_t)w * 64 * 128, 128, [=](int k, int n) -> float { return src[(size_t)k * 64 + ((w == 0) ? dperm(n) : n)]; });
      continue;
    }
    it -= nG;
    if (it < nH) {
      const int w = it >> 2, jc = it & 3, ks = tid >> 5, cj = tid & 31, j = jc * 32 + cj;
      float* red = fs;
      const float* pos = p.cmp_pos + w * 2048; const float* w1 = p.cmp_w1 + (size_t)w * 2048 * 128;
      float acc = 0.f;
#pragma unroll 4
      for (int k = ks * 128; k < ks * 128 + 128; ++k) acc += pos[k] * w1[(size_t)k * 128 + j];
      __syncthreads();
      red[ks * 32 + cj] = acc;
      __syncthreads();
      if (tid < 32) { float s = p.cmp_b1[w * 128 + j]; for (int k2 = 0; k2 < 16; ++k2) s += red[k2 * 32 + tid]; ((float*)(ws + OFF_POSB))[w * 128 + j] = s; }
      continue;
    }
    it -= nH;
    if (it < nI) {
      const int e = it * 512 + tid, pos = e >> 5, i = e & 31;
      const float ang = (float)pos * p.inv_freq[i];
      const double a = (double)ang;
      const double kk = rint(a * 0.15915494309189535);
      const double r = a - kk * 6.283185307179586476925;
      double s, c; sincos_d(r, s, c);
      ((float*)(ws + OFF_ROPE))[e] = (float)c;
      ((float*)(ws + OFF_ROPE))[262144 + e] = (float)s;
      continue;
    }
    it -= nI;
    if (it < nJ) { conv_chunk(p.peer_keys, (bf16_t*)(ws + OFF_PKEYS), (size_t)it * 4096); continue; }
    it -= nJ;
    if (it < nK) {
      const size_t i0 = (size_t)it * 4096 + (size_t)tid * 8;
      const int rowi = (int)((i0 >> 7) & 127), j0 = (int)(i0 & 127);
      float v[8];
#pragma unroll
      for (int j = 0; j < 8; ++j) v[j] = (j0 + j <= rowi) ? p.sgu_w[i0 + j] : 0.f;
      u32x4 w; w.x = pack2(v[0], v[1]); w.y = pack2(v[2], v[3]); w.z = pack2(v[4], v[5]); w.w = pack2(v[6], v[7]);
      *(u32x4*)((bf16_t*)(ws + OFF_SGUW) + i0) = w;
      continue;
    }
    it -= nK;
    {
      const bool isv = it >= nL;
      if (isv) it -= nL;
      const int lane = tid & 63, e = it * 8 + (tid >> 6);
      const float* src = (isv ? p.peer_v : p.peer_u) + (size_t)e * 1024 + lane * 16;
      float v[16];
#pragma unroll
      for (int i = 0; i < 4; ++i) { const f32x4 t4 = *(const f32x4*)(src + i * 4); v[4 * i] = t4.x; v[4 * i + 1] = t4.y; v[4 * i + 2] = t4.z; v[4 * i + 3] = t4.w; }
      float amax = 0.f;
#pragma unroll
      for (int i = 0; i < 16; ++i) amax = fmaxf(amax, fabsf(v[i]));
#pragma unroll
      for (int o = 32; o > 0; o >>= 1) amax = fmaxf(amax, __shfl_xor(amax, o));
      const unsigned be = (__float_as_uint(amax) >> 23) & 0xffu;
      const bool okr = be >= 16u && be <= 240u;
      const float scale = okr ? __uint_as_float((261u - be) << 23) : 1.0f;
      const float inv = okr ? __uint_as_float((be - 7u) << 23) : 1.0f;
      u32x4 w;
      int t0 = 0, t1 = 0, t2 = 0, t3 = 0;
      t0 = __builtin_amdgcn_cvt_pk_fp8_f32(v[0] * scale, v[1] * scale, t0, false); t0 = __builtin_amdgcn_cvt_pk_fp8_f32(v[2] * scale, v[3] * scale, t0, true);
      t1 = __builtin_amdgcn_cvt_pk_fp8_f32(v[4] * scale, v[5] * scale, t1, false); t1 = __builtin_amdgcn_cvt_pk_fp8_f32(v[6] * scale, v[7] * scale, t1, true);
      t2 = __builtin_amdgcn_cvt_pk_fp8_f32(v[8] * scale, v[9] * scale, t2, false); t2 = __builtin_amdgcn_cvt_pk_fp8_f32(v[10] * scale, v[11] * scale, t2, true);
      t3 = __builtin_amdgcn_cvt_pk_fp8_f32(v[12] * scale, v[13] * scale, t3, false); t3 = __builtin_amdgcn_cvt_pk_fp8_f32(v[14] * scale, v[15] * scale, t3, true);
      w.x = (unsigned)t0; w.y = (unsigned)t1; w.z = (unsigned)t2; w.w = (unsigned)t3;
      if (!isv) {
        *(u32x4*)(ws + OFF_PU8 + ((size_t)(lane >> 3) * 16384 + e) * 128 + (lane & 7) * 16) = w;
        if (lane == 0) ((float*)(ws + OFF_SCU))[e] = inv;
      } else {
        *(u32x4*)(ws + OFF_PV8 + ((size_t)(lane >> 3) * 16384 + e) * 128 + (lane & 7) * 16) = w;
        if (lane == 0) ((float*)(ws + OFF_SCV))[e] = inv;
      }
    }
  }
}

DI void row_stats(const float (&v)[16], float& mean, float& rstd) {
  float s = 0.f;
#pragma unroll
  for (int i = 0; i < 16; ++i) s += v[i];
  mean = wave_sum(s) * (1.0f / 1024.0f);
  float q = 0.f;
#pragma unroll
  for (int i = 0; i < 16; ++i) { const float d = v[i] - mean; q += d * d; }
  rstd = rsqrtf(wave_sum(q) * (1.0f / 1024.0f) + LN_EPS);
}

DI void phase_ln_in(const Params& p) {
  const int lane = otid() & 63, wave = otid() >> 6;
  const float* mod = (const float*)(p.ws + OFF_MOD);
  bf16_t* h = (bf16_t*)(p.ws + OFF_H);
  for (int grp = blockIdx.x; grp < NTOK / NW; grp += gridDim.x) {
    const int row = grp * NW + wave, b = row >> 13;
    const float* xr = p.x + (size_t)row * DM;
    float v[16];
#pragma unroll
    for (int i = 0; i < 4; ++i) { const f32x4 t = *(const f32x4*)(xr + i * 256 + lane * 4); v[4 * i] = t.x; v[4 * i + 1] = t.y; v[4 * i + 2] = t.z; v[4 * i + 3] = t.w; }
    float mean, rstd; row_stats(v, mean, rstd);
#pragma unroll
    for (int i = 0; i < 4; ++i) {
      const int col = i * 256 + lane * 4;
      const f32x4 sh = *(const f32x4*)(mod + b * 6144 + col), sc = *(const f32x4*)(mod + b * 6144 + 1024 + col);
      const float o0 = (v[4 * i] - mean) * rstd * (1.f + sc.x) + sh.x, o1 = (v[4 * i + 1] - mean) * rstd * (1.f + sc.y) + sh.y;
      const float o2 = (v[4 * i + 2] - mean) * rstd * (1.f + sc.z) + sh.z, o3 = (v[4 * i + 3] - mean) * rstd * (1.f + sc.w) + sh.w;
      u32x2 w; w.x = pack2(o0, o1); w.y = pack2(o2, o3);
      *(u32x2*)(h + (size_t)row * DM + col) = w;
    }
  }
}

DI void phase_ln_mid(const Params& p) {
  const int lane = otid() & 63, wave = otid() >> 6;
  const float* mod = (const float*)(p.ws + OFF_MOD);
  const bf16_t* y = (const bf16_t*)(p.ws + OFF_Y);
  bf16_t* x1 = (bf16_t*)(p.ws + OFF_X1);
  bf16_t* h2 = (bf16_t*)(p.ws + OFF_H);
  for (int grp = blockIdx.x; grp < NTOK / NW; grp += gridDim.x) {
    const int row = grp * NW + wave, b = row >> 13;
    const bf16_t* yr = y + (size_t)row * DM;
    float v[16];
#pragma unroll
    for (int i = 0; i < 4; ++i) { const u32x2 t = *(const u32x2*)(yr + i * 256 + lane * 4); v[4 * i] = bflo(t.x); v[4 * i + 1] = bfhi(t.x); v[4 * i + 2] = bflo(t.y); v[4 * i + 3] = bfhi(t.y); }
    float mean, rstd; row_stats(v, mean, rstd);
#pragma unroll
    for (int i = 0; i < 4; ++i) {
      const int col = i * 256 + lane * 4;
      const f32x4 g = *(const f32x4*)(p.ln1_g + col), bb = *(const f32x4*)(p.ln1_b + col);
      f32x4 o;
      o.x = (v[4 * i] - mean) * rstd * g.x + bb.x; o.y = (v[4 * i + 1] - mean) * rstd * g.y + bb.y;
      o.z = (v[4 * i + 2] - mean) * rstd * g.z + bb.z; o.w = (v[4 * i + 3] - mean) * rstd * g.w + bb.w;
      { u32x2 w; w.x = pack2(o.x, o.y); w.y = pack2(o.z, o.w); *(u32x2*)(x1 + (size_t)row * DM + col) = w; }
      v[4 * i] = o.x; v[4 * i + 1] = o.y; v[4 * i + 2] = o.z; v[4 * i + 3] = o.w;
    }
    row_stats(v, mean, rstd);
#pragma unroll
    for (int i = 0; i < 4; ++i) {
      const int col = i * 256 + lane * 4;
      const f32x4 sh = *(const f32x4*)(mod + b * 6144 + 3072 + col), sc = *(const f32x4*)(mod + b * 6144 + 4096 + col);
      const float o0 = (v[4 * i] - mean) * rstd * (1.f + sc.x) + sh.x, o1 = (v[4 * i + 1] - mean) * rstd * (1.f + sc.y) + sh.y;
      const float o2 = (v[4 * i + 2] - mean) * rstd * (1.f + sc.z) + sh.z, o3 = (v[4 * i + 3] - mean) * rstd * (1.f + sc.w) + sh.w;
      u32x2 w; w.x = pack2(o0, o1); w.y = pack2(o2, o3);
      *(u32x2*)(h2 + (size_t)row * DM + col) = w;
    }
  }
}

namespace pg8 {
constexpr int BM = 256, BK = 64, HALF = 128, HTB = HALF * BK * 2, STAGE_BYTES = 8 * HTB, NXCD = 8, WGM = 8;
DI int lds_byte(int r, int c) { const int st = (r >> 4) * 2 + (c >> 5), rr = r & 15, cc = c & 31, ob = rr * 64 + cc * 2; return st * 1024 + (ob ^ (((ob >> 9) & 1) << 5)); }
DI void stage_rc(int b, int& R, int& C) { const int st = b / 1024, sb = b % 1024, swz = sb ^ (((sb >> 9) & 1) << 5); R = (st >> 1) * 16 + swz / 64; C = (st & 1) * 32 + (swz % 64) / 2; }
DI int perm32(int rho) { const int n = rho >> 4, i = rho & 15; return 8 * (i >> 2) + 4 * n + (i & 3); }
struct Unit { int pm, pn; };
struct Gemm { const bf16_t* A; const bf16_t* Bt; int M, N, K; };
struct StaticOrder {
  int nM, nN, nwg, G, c;
  DI void init(int M, int N, int G_, int c_) { nM = M / BM; nN = N / BM; nwg = nM * nN; G = G_; c = c_; }
  DI bool next(int i, Unit& u) const {
    const long L = (long)i * G + c; if (L >= nwg) return false;
    int wgid = (int)L; { const int q = nwg / NXCD, r = nwg % NXCD, xcd = wgid % NXCD, off = wgid / NXCD; wgid = (xcd < r ? xcd * (q + 1) : r * (q + 1) + (xcd - r) * q) + off; }
    const int nig = WGM * nN, gid = wgid / nig, fm = gid * WGM, gsz = (nM - fm) < WGM ? (nM - fm) : WGM;
    u.pm = fm + ((wgid % nig) % gsz); u.pn = (wgid % nig) / gsz; return true;
  }
};

template <class Epi>
DI void gemm_phase(LAS unsigned char* lds, const Gemm g, const StaticOrder& S, const Epi& E) {
  const int tid = otid(), wid = __builtin_amdgcn_readfirstlane(tid >> 6), lane = tid & 63, wr = wid >> 2, wc = wid & 3, fr = lane & 15, fq = lane >> 4;
  const int K = g.K, nt = K / BK;
  unsigned voffA[2], voffB[2];
#pragma unroll
  for (int i = 0; i < 2; ++i) { int R, C; stage_rc(tid * 16 + i * 8192, R, C); const int Rb = Epi::PERM ? ((R & ~31) + perm32(R & 31)) : R;
    voffA[i] = (unsigned)(R * K + C) * 2u; voffB[i] = (unsigned)(Rb * K + C) * 2u; }
  const size_t kstep = (size_t)(BK * 2);
  const size_t hstep = (size_t)HALF * K * 2;
  const size_t tstep = 2 * hstep;
  const unsigned ldsw = (unsigned)wid * 1024u;
  const int aoff = lds_byte(wr * 64 + fr, fq * 8), boff = lds_byte(wc * 32 + fr, fq * 8);
#define PG8_SA(b, h) (((b) * 2 + (h)) * HTB)
#define PG8_SB(b, h) ((4 + (b) * 2 + (h)) * HTB)
#define PG8_STAGE(bufoff, gbase, voff) do { _Pragma("unroll") for (int _i = 0; _i < 2; ++_i) \
    __builtin_amdgcn_global_load_lds((const unsigned*)((const char*)(gbase) + (voff)[_i]), (LAS unsigned*)(lds + (bufoff) + ldsw + _i * 8192), 16, 0, 0); } while (0)
#define PG8_LDA(dst, b, h) do { _Pragma("unroll") for (int m = 0; m < 4; ++m) _Pragma("unroll") for (int k = 0; k < 2; ++k) dst[m][k] = *(const LAS bf16x8*)(lds + PG8_SA(b, h) + aoff + m * 2048 + k * 1024); } while (0)
#define PG8_LDB(dst, b, h) do { _Pragma("unroll") for (int n = 0; n < 2; ++n) _Pragma("unroll") for (int k = 0; k < 2; ++k) dst[n][k] = *(const LAS bf16x8*)(lds + PG8_SB(b, h) + boff + n * 2048 + k * 1024); } while (0)
#define PG8_MMA(ai, bj, At, Bt) do { __builtin_amdgcn_s_setprio(1); _Pragma("unroll") for (int m = 0; m < 4; ++m) _Pragma("unroll") for (int n = 0; n < 2; ++n) _Pragma("unroll") for (int k = 0; k < 2; ++k) \
    acc[ai][bj][m][n] = __builtin_amdgcn_mfma_f32_16x16x32_bf16(Bt[n][k], At[m][k], acc[ai][bj][m][n], 0, 0, 0); __builtin_amdgcn_s_setprio(0); } while (0)
#define PG8_WAIT_V(n) asm volatile("s_waitcnt vmcnt(" #n ")" ::: "memory")
#define PG8_WAIT_L(n) asm volatile("s_waitcnt lgkmcnt(" #n ")" ::: "memory")
#define PG8_BAR __builtin_amdgcn_s_barrier()
#define PG8_SCHED __builtin_amdgcn_sched_barrier(0)
  Unit cur, nxt; int ui = 0;
  if (!S.next(0, cur)) return;
  f32x4 acc[2][2][4][2];
#pragma unroll
  for (int a = 0; a < 2; ++a)
#pragma unroll
    for (int b = 0; b < 2; ++b)
#pragma unroll
      for (int m = 0; m < 4; ++m)
#pragma unroll
        for (int n = 0; n < 2; ++n) acc[a][b][m][n] = (f32x4){0.f, 0.f, 0.f, 0.f};
  bf16x8 At[4][2], B0[2][2], B1[2][2];
  const char* cA = (const char*)g.A + (size_t)cur.pm * tstep; const char* cB = (const char*)g.Bt + (size_t)cur.pn * tstep;
  PG8_STAGE(PG8_SB(0, 0), cB, voffB); PG8_STAGE(PG8_SA(0, 0), cA, voffA); PG8_STAGE(PG8_SB(0, 1), cB + hstep, voffB); PG8_STAGE(PG8_SA(0, 1), cA + hstep, voffA);
  if (wr == 1) PG8_BAR;
  PG8_WAIT_V(4); PG8_BAR;
  PG8_STAGE(PG8_SB(1, 0), cB + kstep, voffB); PG8_STAGE(PG8_SA(1, 0), cA + kstep, voffA); PG8_STAGE(PG8_SB(1, 1), cB + hstep + kstep, voffB);
  PG8_WAIT_V(6); PG8_BAR;
  for (;;) {
    const bool has_next = S.next(ui + 1, nxt);
    const char* nA = has_next ? (const char*)g.A + (size_t)nxt.pm * tstep : cA; const char* nB = has_next ? (const char*)g.Bt + (size_t)nxt.pn * tstep : cB;
    for (int t = 0; t < nt; t += 2) {
      const bool last = (t == nt - 2);
      const char* a1 = cA + (size_t)(t + 1) * kstep;
      const char* a2 = last ? nA : cA + (size_t)(t + 2) * kstep; const char* b2 = last ? nB : cB + (size_t)(t + 2) * kstep;
      const char* a3 = a2 + kstep; const char* b3 = b2 + kstep;
      PG8_LDB(B0, 0, 0); PG8_SCHED; PG8_LDA(At, 0, 0); PG8_STAGE(PG8_SA(1, 1), a1 + hstep, voffA);
      PG8_WAIT_L(8); PG8_BAR; PG8_WAIT_L(0); PG8_MMA(0, 0, At, B0); PG8_BAR; PG8_SCHED;
      PG8_LDB(B1, 0, 1); PG8_STAGE(PG8_SB(0, 0), b2, voffB);
      PG8_BAR; PG8_WAIT_L(0); PG8_MMA(0, 1, At, B1); PG8_BAR;
      PG8_LDA(At, 0, 1); PG8_STAGE(PG8_SA(0, 0), a2, voffA);
      PG8_BAR; PG8_WAIT_L(0); PG8_MMA(1, 0, At, B0); PG8_BAR; PG8_SCHED;
      PG8_STAGE(PG8_SB(0, 1), b2 + hstep, voffB);
      PG8_WAIT_V(6); PG8_BAR; PG8_MMA(1, 1, At, B1); PG8_BAR;
      PG8_LDB(B0, 1, 0); PG8_SCHED; PG8_LDA(At, 1, 0); PG8_STAGE(PG8_SA(0, 1), a2 + hstep, voffA);
      PG8_WAIT_L(8); PG8_BAR; PG8_WAIT_L(0); PG8_MMA(0, 0, At, B0); PG8_BAR; PG8_SCHED;
      PG8_LDB(B1, 1, 1); PG8_STAGE(PG8_SB(1, 0), b3, voffB);
      PG8_BAR; PG8_WAIT_L(0); PG8_MMA(0, 1, At, B1); PG8_BAR;
      PG8_LDA(At, 1, 1); PG8_STAGE(PG8_SA(1, 0), a3, voffA);
      PG8_BAR; PG8_WAIT_L(0); PG8_MMA(1, 0, At, B0); PG8_BAR; PG8_SCHED;
      PG8_STAGE(PG8_SB(1, 1), b3 + hstep, voffB);
      PG8_WAIT_V(6); PG8_BAR; PG8_MMA(1, 1, At, B1); PG8_BAR;
    }
    E(acc, cur, wr, wc, fr, fq);
    if (!has_next) break;
#pragma unroll
    for (int a = 0; a < 2; ++a)
#pragma unroll
      for (int b = 0; b < 2; ++b)
#pragma unroll
        for (int m = 0; m < 4; ++m)
#pragma unroll
          for (int n = 0; n < 2; ++n) acc[a][b][m][n] = (f32x4){0.f, 0.f, 0.f, 0.f};
    cur = nxt; cA = nA; cB = nB; ++ui;
  }
  PG8_WAIT_V(0);
  if (wr == 0) PG8_BAR;
  PG8_BAR;
#undef PG8_SA
#undef PG8_SB
#undef PG8_STAGE
#undef PG8_LDA
#undef PG8_LDB
#undef PG8_MMA
#undef PG8_WAIT_V
#undef PG8_WAIT_L
#undef PG8_BAR
#undef PG8_SCHED
}
}

struct EpiProj {
  static constexpr bool PERM = true;
  char* ws; const float* b_merge;
  DI void operator()(const f32x4 (&acc)[2][2][4][2], const pg8::Unit& u, int wr, int wc, int fr, int fq) const {
    const float* rope = (const float*)(ws + OFF_ROPE);
    const int row0 = u.pm * 256 + wr * 64 + fr;
#pragma unroll
    for (int bj = 0; bj < 2; ++bj) {
      const int cg = u.pn * 256 + bj * 128 + wc * 32;
      const int c0 = cg + 8 * fq;
      if (cg >= 4384) continue;
      if (cg < 1280 && (cg < 640 || (cg >= 768 && cg < 896) || (cg >= 1024 && cg < 1152))) {
        bf16_t* dst; unsigned ld, cofs; float scale = 1.0f;
        if (cg < 512) { dst = (bf16_t*)(ws + OFF_Q); ld = 512; cofs = c0; scale = 0.18033688011112042f; }
        else if (cg < 640) { dst = (bf16_t*)(ws + OFF_KC); ld = 128; cofs = c0 - 512; }
        else if (cg < 896) { dst = (bf16_t*)(ws + OFF_KS); ld = 128; cofs = c0 - 768; }
        else { dst = (bf16_t*)(ws + OFF_KW); ld = 128; cofs = c0 - 1024; }
        const int d0 = 16 * ((cg >> 5) & 1) + 4 * fq;
#pragma unroll
        for (int ai = 0; ai < 2; ++ai)
#pragma unroll
          for (int m = 0; m < 4; ++m) {
            const int row = row0 + ai * 128 + m * 16, pos = row & (SEQ - 1);
            const f32x4 cs = *(const f32x4*)(rope + pos * 32 + d0), sn = *(const f32x4*)(rope + 262144 + pos * 32 + d0);
            const f32x4 t1 = acc[ai][bj][m][0], t2 = acc[ai][bj][m][1];
            const f32x4 o1 = (t1 * cs - t2 * sn) * scale, o2 = (t1 * sn + t2 * cs) * scale;
            u32x4 w; w.x = pack2(o1.x, o1.y); w.y = pack2(o1.z, o1.w); w.z = pack2(o2.x, o2.y); w.w = pack2(o2.z, o2.w);
            *(u32x4*)(dst + (unsigned)row * ld + cofs) = w;
          }
      } else if (cg < 1280) {
        bf16_t* dst; unsigned cofs;
        if (cg < 768) { dst = (bf16_t*)(ws + OFF_VC); cofs = c0 - 640; }
        else if (cg < 1024) { dst = (bf16_t*)(ws + OFF_VS); cofs = c0 - 896; }
        else { dst = (bf16_t*)(ws + OFF_VW); cofs = c0 - 1152; }
#pragma unroll
        for (int ai = 0; ai < 2; ++ai)
#pragma unroll
          for (int m = 0; m < 4; ++m) {
            const int row = row0 + ai * 128 + m * 16;
            const f32x4 a = acc[ai][bj][m][0], b = acc[ai][bj][m][1];
            u32x4 w; w.x = pack2(a.x, a.y); w.y = pack2(a.z, a.w); w.z = pack2(b.x, b.y); w.w = pack2(b.z, b.w);
            *(u32x4*)(dst + (unsigned)row * 128u + cofs) = w;
          }
      } else if (cg < 2304) {
        bf16_t* dst = (bf16_t*)(ws + (cg < 1792 ? OFF_U : OFF_V));
        const unsigned cofs = c0 - (cg < 1792 ? 1280 : 1792);
#pragma unroll
        for (int ai = 0; ai < 2; ++ai)
#pragma unroll
          for (int m = 0; m < 4; ++m) {
            const int row = row0 + ai * 128 + m * 16;
            const f32x4 a = acc[ai][bj][m][0], b = acc[ai][bj][m][1];
            const f32x2 g0 = gelu_pk((f32x2){a.x, a.y}), g1 = gelu_pk((f32x2){a.z, a.w}), g2 = gelu_pk((f32x2){b.x, b.y}), g3 = gelu_pk((f32x2){b.z, b.w});
            u32x4 w; w.x = pack2(g0.x, g0.y); w.y = pack2(g1.x, g1.y); w.z = pack2(g2.x, g2.y); w.w = pack2(g3.x, g3.y);
            *(u32x4*)(dst + (unsigned)row * 512u + cofs) = w;
          }
      } else if (cg < 4352) {
        bf16_t* dst = (bf16_t*)(ws + OFF_GATE);
        const unsigned cofs = c0 - 2304;
        const f32x4 b0 = *(const f32x4*)(b_merge + cofs), b1 = *(const f32x4*)(b_merge + cofs + 4);
#pragma unroll
        for (int ai = 0; ai < 2; ++ai)
#pragma unroll
          for (int m = 0; m < 4; ++m) {
            const int row = row0 + ai * 128 + m * 16;
            const f32x4 a = acc[ai][bj][m][0] + b0, b = acc[ai][bj][m][1] + b1;
            u32x4 w; w.x = pack2(sigmoid_f(a.x), sigmoid_f(a.y)); w.y = pack2(sigmoid_f(a.z), sigmoid_f(a.w));
            w.z = pack2(sigmoid_f(b.x), sigmoid_f(b.y)); w.w = pack2(sigmoid_f(b.z), sigmoid_f(b.w));
            *(u32x4*)(dst + (unsigned)row * 2048u + cofs) = w;
          }
      } else {
        float* gs = (float*)(ws + OFF_GSIG);
        if (fq < 3) {
#pragma unroll
          for (int ai = 0; ai < 2; ++ai)
#pragma unroll
            for (int m = 0; m < 4; ++m) {
              const int row = row0 + ai * 128 + m * 16;
              const f32x4 a = acc[ai][bj][m][0], b = acc[ai][bj][m][1];
              f32x4 o0, o1; o0.x = sigmoid_f(a.x); o0.y = sigmoid_f(a.y); o0.z = sigmoid_f(a.z); o0.w = sigmoid_f(a.w);
              o1.x = sigmoid_f(b.x); o1.y = sigmoid_f(b.y); o1.z = sigmoid_f(b.z); o1.w = sigmoid_f(b.w);
              *(f32x4*)(gs + (unsigned)row * 32u + 8 * fq) = o0; *(f32x4*)(gs + (unsigned)row * 32u + 8 * fq + 4) = o1;
            }
        }
      }
    }
  }
};
DI void phase_gemm1(const Params& p, char* smem) {
  pg8::Gemm g{(const bf16_t*)(p.ws + OFF_H), (const bf16_t*)(p.ws + OFF_WT1), NTOK, N1, 1024};
  pg8::StaticOrder S; S.init(NTOK, N1, gridDim.x, blockIdx.x);
  EpiProj E{p.ws, p.b_merge};
  pg8::gemm_phase((LAS unsigned char*)smem, g, S, E);
}

template <int BR> struct EpiMerge {
  static constexpr bool PERM = true;
  char* ws;
  DI void operator()(const f32x4 (&acc)[2][2][4][2], const pg8::Unit& u, int wr, int wc, int fr, int fq) const {
    const bf16_t* gate = (const bf16_t*)(ws + OFF_GATE);
    bf16_t* merged = (bf16_t*)(ws + OFF_H);
    const int row0 = u.pm * 256 + wr * 64 + fr;
#pragma unroll
    for (int bj = 0; bj < 2; ++bj) {
      const unsigned c0 = u.pn * 256 + bj * 128 + wc * 32 + 8 * fq;
#pragma unroll
      for (int ai = 0; ai < 2; ++ai)
#pragma unroll
        for (int m = 0; m < 4; ++m) {
          const unsigned row = row0 + ai * 128 + m * 16;
          float gg[8]; unpack8(*(const u32x4*)(gate + row * 2048u + BR * 1024 + c0), gg);
          const f32x4 a = acc[ai][bj][m][0], b = acc[ai][bj][m][1];
          float v[8] = {a.x * gg[0], a.y * gg[1], a.z * gg[2], a.w * gg[3], b.x * gg[4], b.y * gg[5], b.z * gg[6], b.w * gg[7]};
          bf16_t* mp = merged + row * 1024u + c0;
          if (BR == 1) {
            float old[8]; unpack8(*(const u32x4*)mp, old);
#pragma unroll
            for (int j = 0; j < 8; ++j) v[j] += old[j];
          }
          *(u32x4*)mp = pack8(v);
        }
    }
  }
};
DI void phase_merge(const Params& p, char* smem) {
  pg8::StaticOrder S; S.init(NTOK, 1024, gridDim.x, blockIdx.x);
  {
    pg8::Gemm g{(const bf16_t*)(p.ws + OFF_ONSA), (const bf16_t*)(p.ws + OFF_WB), NTOK, 1024, 512};
    EpiMerge<0> E{p.ws};
    pg8::gemm_phase((LAS unsigned char*)smem, g, S, E);
  }
  {
    pg8::Gemm g{(const bf16_t*)(p.ws + OFF_U), (const bf16_t*)(p.ws + OFF_WB) + (size_t)1024 * 512, NTOK, 1024, 512};
    EpiMerge<1> E{p.ws};
    pg8::gemm_phase((LAS unsigned char*)smem, g, S, E);
  }
}

struct EpiOut {
  static constexpr bool PERM = true;
  char* ws; const float* x;
  DI void operator()(const f32x4 (&acc)[2][2][4][2], const pg8::Unit& u, int wr, int wc, int fr, int fq) const {
    const float* mod = (const float*)(ws + OFF_MOD);
    bf16_t* y = (bf16_t*)(ws + OFF_Y);
    const int row0 = u.pm * 256 + wr * 64 + fr, b = (u.pm * 256) >> 13;
#pragma unroll
    for (int bj = 0; bj < 2; ++bj) {
      const unsigned c0 = u.pn * 256 + bj * 128 + wc * 32 + 8 * fq;
      const f32x4 g0 = *(const f32x4*)(mod + b * 6144 + 2048 + c0), g1 = *(const f32x4*)(mod + b * 6144 + 2048 + c0 + 4);
#pragma unroll
      for (int ai = 0; ai < 2; ++ai)
#pragma unroll
        for (int m = 0; m < 4; ++m) {
          const unsigned o = (unsigned)(row0 + ai * 128 + m * 16) * 1024u + c0;
          const f32x4 x0 = *(const f32x4*)(x + o), x1v = *(const f32x4*)(x + o + 4);
          const f32x4 v0 = x0 * DN_ALPHA + g0 * acc[ai][bj][m][0], v1 = x1v * DN_ALPHA + g1 * acc[ai][bj][m][1];
          u32x4 w; w.x = pack2(v0.x, v0.y); w.y = pack2(v0.z, v0.w); w.z = pack2(v1.x, v1.y); w.w = pack2(v1.z, v1.w);
          *(u32x4*)(y + o) = w;
        }
    }
  }
};
DI void phase_outproj(const Params& p, char* smem) {
  pg8::Gemm g{(const bf16_t*)(p.ws + OFF_H), (const bf16_t*)(p.ws + OFF_WOUT), NTOK, 1024, 1024};
  pg8::StaticOrder S; S.init(NTOK, 1024, gridDim.x, blockIdx.x);
  EpiOut E{p.ws, p.x};
  pg8::gemm_phase((LAS unsigned char*)smem, g, S, E);
}

struct EpiPq {
  static constexpr bool PERM = true;
  char* ws;
  DI void operator()(const f32x4 (&acc)[2][2][4][2], const pg8::Unit& u, int wr, int wc, int fr, int fq) const {
    bf16_t* pq = (bf16_t*)(ws + OFF_PQ);
    const int row0 = u.pm * 256 + wr * 64 + fr;
#pragma unroll
    for (int bj = 0; bj < 2; ++bj) {
      const unsigned c0 = u.pn * 256 + bj * 128 + wc * 32 + 8 * fq;
#pragma unroll
      for (int ai = 0; ai < 2; ++ai)
#pragma unroll
        for (int m = 0; m < 4; ++m) {
          const f32x4 a = acc[ai][bj][m][0], b = acc[ai][bj][m][1];
          u32x4 w; w.x = pack2(a.x, a.y); w.y = pack2(a.z, a.w); w.z = pack2(b.x, b.y); w.w = pack2(b.z, b.w);
          *(u32x4*)(pq + (unsigned)(row0 + ai * 128 + m * 16) * 2048u + c0) = w;
        }
    }
  }
};
DI void phase_peerq(const Params& p, char* smem) {
  pg8::Gemm g{(const bf16_t*)(p.ws + OFF_H), (const bf16_t*)(p.ws + OFF_WQ), NTOK, 2048, 1024};
  pg8::StaticOrder S; S.init(NTOK, 2048, gridDim.x, blockIdx.x);
  EpiPq E{p.ws};
  pg8::gemm_phase((LAS unsigned char*)smem, g, S, E);
}

DI void phase_sgu(const Params& p, char* smem) {
  char* ws = p.ws;
  const int tid = otid(), lane = tid & 63, wave = tid >> 6, l31 = lane & 31, hh = lane >> 5;
  bf16_t* u = (bf16_t*)(ws + OFF_U);
  const bf16_t* v = (const bf16_t*)(ws + OFF_V);
  const bf16_t* W = (const bf16_t*)(ws + OFF_SGUW);
  float* st = (float*)smem;
  bf16_t* vn = (bf16_t*)(smem + 1024);
  constexpr int LN_ = 72;
  const int dt = wave & 1, it = wave >> 1;
  const int gi = lane >> 4, i16 = lane & 15, tq = i16 >> 2, tp = i16 & 3;
  for (int item = blockIdx.x; item < NTOK / 128; item += gridDim.x) {
    const int t0 = item * 128;
    __syncthreads();
    for (int i = 0; i < 16; ++i) {
      const int t = wave * 16 + i;
      const u32x4 raw = *(const u32x4*)(v + (size_t)(t0 + t) * 512 + lane * 8);
      float f[8]; unpack8(raw, f);
      float s = 0.f;
#pragma unroll
      for (int j = 0; j < 8; ++j) s += f[j];
      const float mean = wave_sum(s) * (1.f / 512.f);
      float q = 0.f;
#pragma unroll
      for (int j = 0; j < 8; ++j) { const float d = f[j] - mean; q += d * d; }
      const float rstd = rsqrtf(wave_sum(q) * (1.f / 512.f) + LN_EPS);
      if (lane == 0) { st[t * 2] = mean; st[t * 2 + 1] = rstd; }
    }
    u32x4 vnext[2];
#pragma unroll
    for (int i = 0; i < 2; ++i) { const int idx = tid + i * NT; vnext[i] = *(const u32x4*)(v + (size_t)(t0 + (idx >> 3)) * 512 + (idx & 7) * 8); }
    for (int g = 0; g < 8; ++g) {
      u32x4 vcur[2] = {vnext[0], vnext[1]};
      if (g + 1 < 8) {
#pragma unroll
        for (int i = 0; i < 2; ++i) { const int idx = tid + i * NT; vnext[i] = *(const u32x4*)(v + (size_t)(t0 + (idx >> 3)) * 512 + (g + 1) * 64 + (idx & 7) * 8); }
      }
      u32x2 uold[4];
      {
        const bf16_t* urow0 = u + (size_t)(t0 + it * 32 + l31) * 512 + g * 64 + dt * 32 + 4 * hh;
#pragma unroll
        for (int q4 = 0; q4 < 4; ++q4) uold[q4] = *(const u32x2*)(urow0 + 8 * q4);
      }
      lds_barrier();
#pragma unroll
      for (int i = 0; i < 2; ++i) {
        const int idx = tid + i * NT, j = idx >> 3, dc = (idx & 7) * 8;
        const u32x4 raw = vcur[i];
        const float mean = st[j * 2], rstd = st[j * 2 + 1];
        float f[8], gg[8], bb[8]; unpack8(raw, f); ld8(p.sgu_ln_g + g * 64 + dc, gg); ld8(p.sgu_ln_b + g * 64 + dc, bb);
#pragma unroll
        for (int k = 0; k < 8; ++k) f[k] = (f[k] - mean) * rstd * gg[k] + bb[k];
        *(u32x4*)(vn + j * LN_ + dc) = pack8(f);
      }
      lds_barrier();
      f32x16 acc;
#pragma unroll
      for (int r = 0; r < 16; ++r) acc[r] = 0.f;
      const bf16_t* wrow = W + ((size_t)g * 128 + it * 32 + l31) * 128 + hh * 8;
      const LAS bf16_t* vbase = (const LAS bf16_t*)vn + (8 * (gi >> 1) + tq) * LN_ + dt * 32 + 16 * (gi & 1) + 4 * tp;
#pragma unroll
      for (int ks = 0; ks < 8; ++ks) {
        if (ks <= 2 * it + 1) {
          const LAS bf16_t* vp = vbase + (ks * 16) * LN_;
          const s16x4 lo = __builtin_amdgcn_ds_read_tr16_b64_v4i16((LAS s16x4*)vp);
          const s16x4 hi = __builtin_amdgcn_ds_read_tr16_b64_v4i16((LAS s16x4*)(vp + 4 * LN_));
          const bf16x8 bw = *(const bf16x8*)(wrow + ks * 16);
          acc = MFMA32(__builtin_shufflevector(lo, hi, 0, 1, 2, 3, 4, 5, 6, 7), bw, acc);
        }
      }
      const int i = it * 32 + l31;
      const float bsv = p.sgu_b[g * 128 + i];
      bf16_t* urow = u + (size_t)(t0 + i) * 512 + g * 64 + dt * 32 + 4 * hh;
#pragma unroll
      for (int q4 = 0; q4 < 4; ++q4) {
        u32x2* up = (u32x2*)(urow + 8 * q4);
        const u32x2 old = uold[q4];
        u32x2 wv; wv.x = pack2(bflo(old.x) * (acc[4 * q4] + bsv), bfhi(old.x) * (acc[4 * q4 + 1] + bsv));
        wv.y = pack2(bflo(old.y) * (acc[4 * q4 + 2] + bsv), bfhi(old.y) * (acc[4 * q4 + 3] + bsv));
        *up = wv;
      }
    }
  }
}

DI void phase_compress(const Params& p, char* smem) {
  char* ws = p.ws;
  const int tid = otid(), lane = tid & 63, wave = tid >> 6, l31 = lane & 31, hh = lane >> 5;
  bf16_t* hid = (bf16_t*)smem;
  constexpr int LH = 136;
  for (int item = blockIdx.x; item < 128; item += gridDim.x) {
    const int w = item >> 6, R0 = (item & 63) * 128;
    const bf16_t* src = (const bf16_t*)(ws + (w == 0 ? OFF_KC : OFF_VC));
    const bf16_t* W1 = (const bf16_t*)(ws + OFF_CW1) + (size_t)w * 128 * 2048;
    const bf16_t* W2 = (const bf16_t*)(ws + OFF_CW2) + (size_t)w * 64 * 128;
    const float* posb = (const float*)(ws + OFF_POSB) + w * 128;
    const int rg = wave >> 2, cgp = wave & 3;
    const bf16_t* abase[2];
#pragma unroll
    for (int mi = 0; mi < 2; ++mi) {
      const int R = R0 + rg * 64 + mi * 32 + l31, bg = R >> 9, n = R & 511, nn = n < 510 ? n : 510;
      abase[mi] = src + ((size_t)((bg >> 1) * SEQ + 16 * nn)) * 128 + (bg & 1) * 64 + hh * 8;
    }
    const bf16_t* bbase = W1 + (size_t)(cgp * 32 + l31) * 2048 + hh * 8;
    f32x16 acc[2];
#pragma unroll
    for (int r = 0; r < 16; ++r) { acc[0][r] = 0.f; acc[1][r] = 0.f; }
#pragma unroll 8
    for (int ks = 0; ks < 128; ++ks) {
      const int aofs = (ks >> 2) * 128 + (ks & 3) * 16;
      const bf16x8 a0 = *(const bf16x8*)(abase[0] + aofs), a1 = *(const bf16x8*)(abase[1] + aofs);
      const bf16x8 bb = *(const bf16x8*)(bbase + ks * 16);
      acc[0] = MFMA32(a0, bb, acc[0]); acc[1] = MFMA32(a1, bb, acc[1]);
    }
    __syncthreads();
    {
      const float pb = posb[cgp * 32 + l31];
#pragma unroll
      for (int mi = 0; mi < 2; ++mi)
#pragma unroll
        for (int r = 0; r < 16; ++r) {
          const int row = rg * 64 + mi * 32 + (r & 3) + 8 * (r >> 2) + 4 * hh;
          hid[row * LH + cgp * 32 + l31] = f2bf(gelu_f(acc[mi][r] + pb));
        }
    }
    __syncthreads();
    const int mi2 = wave >> 1, ni = wave & 1;
    f32x16 o;
#pragma unroll
    for (int r = 0; r < 16; ++r) o[r] = 0.f;
#pragma unroll
    for (int ks = 0; ks < 8; ++ks) {
      const bf16x8 a = *(const bf16x8*)(hid + (mi2 * 32 + l31) * LH + ks * 16 + hh * 8);
      const bf16x8 bb = *(const bf16x8*)(W2 + (size_t)(ni * 32 + l31) * 128 + ks * 16 + hh * 8);
      o = MFMA32(a, bb, o);
    }
    const int d = ni * 32 + l31;
    const float b2 = p.cmp_b2[w * 64 + (w == 0 ? dperm(d) : d)];
    const int bg = R0 >> 9;
    bf16_t* dst = (bf16_t*)(ws + (w == 0 ? OFF_KCMP : OFF_VCMP));
#pragma unroll
    for (int r = 0; r < 16; ++r) {
      const int n = (R0 & 511) + mi2 * 32 + (r & 3) + 8 * (r >> 2) + 4 * hh;
      dst[((size_t)bg * 512 + n) * 64 + d] = f2bf(n < 511 ? o[r] + b2 : 0.f);
    }
  }
}

constexpr int LK = 72;
constexpr int NSA_TILE = 18432;
constexpr int NSA_AIMP = 3 * NSA_TILE, NSA_CIMP = NSA_AIMP + 32768, NSA_SELM = NSA_CIMP + 32768;
constexpr float NSA_THR = 6.0f;
struct TileRegs { u32x4 k; u32x4 v; };

DI void nsa_load_tile(TileRegs& t, const bf16_t* kbase, size_t kstride, const bf16_t* vbase, size_t vstride) {
  const int tid = otid(), r = tid >> 3, ch = tid & 7;
  t.k = *(const u32x4*)(kbase + (size_t)r * kstride + ch * 8);
  t.v = *(const u32x4*)(vbase + (size_t)r * vstride + ch * 8);
}
DI void nsa_store_tile(const TileRegs& t, char* tile) {
  const int tid = otid(), r = tid >> 3, ch = tid & 7;
  *(u32x4*)((bf16_t*)tile + r * LK + ch * 8) = t.k;
  *(u32x4*)((bf16_t*)(tile + 9216) + r * LK + ch * 8) = t.v;
}
DI void nsa_scores(f32x16 (&st)[2], const char* tile, const bf16x8 (&qf)[4], int lane) {
  const bf16_t* Ks = (const bf16_t*)tile;
#pragma unroll
  for (int kt = 0; kt < 2; ++kt)
#pragma unroll
    for (int r = 0; r < 16; ++r) st[kt][r] = 0.f;
  __builtin_amdgcn_s_setprio(1);
#pragma unroll
  for (int ks = 0; ks < 4; ++ks)
#pragma unroll
    for (int kt = 0; kt < 2; ++kt) {
      const bf16x8 a = *(const bf16x8*)(Ks + (kt * 32 + (lane & 31)) * LK + ks * 16 + (lane >> 5) * 8);
      st[kt] = MFMA32(a, qf[ks], st[kt]);
    }
  __builtin_amdgcn_s_setprio(0);
}
DI void nsa_pv(f32x16 (&o)[2], const f32x16 (&pt)[2], const char* tile, int lane) {
  const int gi = lane >> 4, i16 = lane & 15, q = i16 >> 2, pp = i16 & 3;
  const LAS bf16_t* Vs = (const LAS bf16_t*)(tile + 9216) + (4 * (gi >> 1) + q) * LK + 16 * (gi & 1) + 4 * pp;
#pragma unroll
  for (int kt = 0; kt < 2; ++kt)
#pragma unroll
    for (int s = 0; s < 2; ++s) {
      u32x4 pk; pk.x = pack2(pt[kt][8 * s], pt[kt][8 * s + 1]); pk.y = pack2(pt[kt][8 * s + 2], pt[kt][8 * s + 3]);
      pk.z = pack2(pt[kt][8 * s + 4], pt[kt][8 * s + 5]); pk.w = pack2(pt[kt][8 * s + 6], pt[kt][8 * s + 7]);
      const bf16x8 pb = __builtin_bit_cast(bf16x8, pk);
      bf16x8 a[2];
#pragma unroll
      for (int dt = 0; dt < 2; ++dt) {
        const LAS bf16_t* vp = Vs + (kt * 32 + 16 * s) * LK + dt * 32;
        const s16x4 lo = __builtin_amdgcn_ds_read_tr16_b64_v4i16((LAS s16x4*)vp);
        const s16x4 hi = __builtin_amdgcn_ds_read_tr16_b64_v4i16((LAS s16x4*)(vp + 8 * LK));
        a[dt] = __builtin_shufflevector(lo, hi, 0, 1, 2, 3, 4, 5, 6, 7);
      }
      o[0] = MFMA32(a[0], pb, o[0]); o[1] = MFMA32(a[1], pb, o[1]);
    }
}

constexpr float NSA_NEG = -3.0e38f;
DI void nsa_online(f32x16 (&st)[2], bool sel, float& m, float& l, f32x16 (&o)[2], const char* tile, int lane) {
  float mx = NSA_NEG;
#pragma unroll
  for (int r = 0; r < 16; ++r) mx = fmaxf(mx, fmaxf(st[0][r], st[1][r]));
  mx = fmaxf(mx, __shfl_xor(mx, 32));
  mx = sel ? mx : NSA_NEG;
  if (__any(mx > m + NSA_THR)) {
    const float mn = fmaxf(m, mx);
    const float alpha = __builtin_amdgcn_exp2f(m - mn);
    m = mn; l *= alpha;
#pragma unroll
    for (int r = 0; r < 16; ++r) { o[0][r] *= alpha; o[1][r] *= alpha; }
  }
  const float ms = sel ? m : 1e30f;
  float sum = 0.f;
#pragma unroll
  for (int r = 0; r < 16; ++r) {
    const float p0 = __builtin_amdgcn_exp2f(st[0][r] - ms), p1 = __builtin_amdgcn_exp2f(st[1][r] - ms);
    st[0][r] = p0; st[1][r] = p1; sum += p0 + p1;
  }
  l += sum;
  nsa_pv(o, st, tile, lane);
}

struct NsaItem { int qb, b, g, bg, t; size_t tokrow; };
DI NsaItem nsa_item(int item0, int wave, int qi) {
  const int G = gridDim.x, k = item0 / G, bb = item0 - k * G;
  const int item = (k & 1) ? (k * G + (G - 1 - bb)) : item0;
  NsaItem it; it.qb = 127 - (item >> 4); const int rest = item & 15; it.b = rest >> 1; it.g = rest & 1;
  it.bg = it.b * 2 + it.g; it.t = it.qb * 64 + wave * 8 + qi; it.tokrow = (size_t)it.b * SEQ + it.t; return it;
}
DI void nsa_accum_store(bf16_t* dst, const f32x16 (&o)[2], float sc, bool first, int hh) {
#pragma unroll
  for (int dt = 0; dt < 2; ++dt)
#pragma unroll
    for (int q4 = 0; q4 < 4; ++q4) {
      u32x2* pp = (u32x2*)(dst + dt * 32 + 8 * q4 + 4 * hh);
      float a0 = sc * o[dt][4 * q4], a1 = sc * o[dt][4 * q4 + 1], a2 = sc * o[dt][4 * q4 + 2], a3 = sc * o[dt][4 * q4 + 3];
      if (!first) { const u32x2 old = *pp; a0 += bflo(old.x); a1 += bfhi(old.x); a2 += bflo(old.y); a3 += bfhi(old.y); }
      u32x2 wv; wv.x = pack2(a0, a1); wv.y = pack2(a2, a3);
      *pp = wv;
    }
}

constexpr int NSA_STAGE = 4 * 18432;
typedef float f32x4v __attribute__((ext_vector_type(4)));
#define MFMA16(a, b, c) __builtin_amdgcn_mfma_f32_16x16x32_bf16((a), (b), (c), 0, 0, 0)
struct StageRegs { u32x4 r[8]; };
DI void nsa_load_stage(StageRegs& sr, const bf16_t* kb, const bf16_t* vb, int j0s, int qb) {
  const int tid = otid(), r = tid >> 3, ch = tid & 7;
#pragma unroll
  for (int tt = 0; tt < 4; ++tt) {
    const int j = (j0s + tt <= qb) ? j0s + tt : qb;
    sr.r[2 * tt] = *(const u32x4*)(kb + ((size_t)j * 64 + r) * 128 + ch * 8);
    sr.r[2 * tt + 1] = *(const u32x4*)(vb + ((size_t)j * 64 + r) * 128 + ch * 8);
  }
}
DI void nsa_store_stage(const StageRegs& sr, char* stage) {
  const int tid = otid(), r = tid >> 3, ch = tid & 7;
#pragma unroll
  for (int tt = 0; tt < 4; ++tt) {
    *(u32x4*)((bf16_t*)(stage + tt * 18432) + r * LK + ch * 8) = sr.r[2 * tt];
    *(u32x4*)((bf16_t*)(stage + tt * 18432 + 9216) + r * LK + ch * 8) = sr.r[2 * tt + 1];
  }
}
struct Sel16 { float m, l; bool has; f32x4v o[4]; };
DI void nsa_unit16(Sel16& g, const char* tile, const bf16x8 (&qf)[2], bool sel, int klim  , int lane) {
  const int c16 = lane & 15, kg = lane >> 4, tq = c16 >> 2, tp = c16 & 3;
  const bf16_t* Ks = (const bf16_t*)tile + c16 * LK + kg * 8;
  f32x4v st[4];
  const float ini = sel ? -g.m : -1e30f;
#pragma unroll
  for (int kt = 0; kt < 4; ++kt) {
    st[kt] = (f32x4v){ini, ini, ini, ini};
#pragma unroll
    for (int ks = 0; ks < 2; ++ks) st[kt] = MFMA16(*(const bf16x8*)(Ks + kt * 16 * LK + ks * 32), qf[ks], st[kt]);
  }
  if (klim < 64) {
#pragma unroll
    for (int kt = 0; kt < 4; ++kt)
#pragma unroll
      for (int r = 0; r < 4; ++r) st[kt][r] = (kt * 16 + 4 * kg + r <= klim) ? st[kt][r] : NSA_NEG;
  }
  float mx = fmaxf(fmaxf(fmaxf(st[0][0], st[0][1]), fmaxf(st[0][2], st[0][3])), fmaxf(fmaxf(st[1][0], st[1][1]), fmaxf(st[1][2], st[1][3])));
  mx = fmaxf(mx, fmaxf(fmaxf(fmaxf(st[2][0], st[2][1]), fmaxf(st[2][2], st[2][3])), fmaxf(fmaxf(st[3][0], st[3][1]), fmaxf(st[3][2], st[3][3]))));
  mx = fmaxf(mx, __shfl_xor(mx, 16));
  mx = fmaxf(mx, __shfl_xor(mx, 32));
  const bool real = mx > -1e29f;
  const bool fresh = !g.has && real, up = g.has && (mx > NSA_THR);
  if (__any(fresh || up)) {
    const float delta = (fresh || up) ? mx : 0.f;
    const float alpha = up ? __builtin_amdgcn_exp2f(-delta) : 1.0f;
    g.m += delta; g.l *= alpha;
#pragma unroll
    for (int dt = 0; dt < 4; ++dt) g.o[dt] *= alpha;
#pragma unroll
    for (int kt = 0; kt < 4; ++kt) st[kt] -= delta;
  }
  g.has = g.has || real;
  float sum = 0.f;
#pragma unroll
  for (int kt = 0; kt < 4; ++kt)
#pragma unroll
    for (int r = 0; r < 4; ++r) { const float pv = __builtin_amdgcn_exp2f(st[kt][r]); st[kt][r] = pv; sum += pv; }
  g.l += sum;
  const LAS bf16_t* Vs = (const LAS bf16_t*)(tile + 9216) + (4 * kg + tq) * LK + 4 * tp;
#pragma unroll
  for (int kp = 0; kp < 2; ++kp) {
    u32x4 pk; pk.x = pack2(st[2 * kp][0], st[2 * kp][1]); pk.y = pack2(st[2 * kp][2], st[2 * kp][3]);
    pk.z = pack2(st[2 * kp + 1][0], st[2 * kp + 1][1]); pk.w = pack2(st[2 * kp + 1][2], st[2 * kp + 1][3]);
    const bf16x8 pb = __builtin_bit_cast(bf16x8, pk);
#pragma unroll
    for (int dt = 0; dt < 4; ++dt) {
      const LAS bf16_t* vp = Vs + (2 * kp) * 16 * LK + dt * 16;
      const s16x4 lo = __builtin_amdgcn_ds_read_tr16_b64_v4i16((LAS s16x4*)vp);
      const s16x4 hi = __builtin_amdgcn_ds_read_tr16_b64_v4i16((LAS s16x4*)(vp + 16 * LK));
      g.o[dt] = MFMA16(__builtin_shufflevector(lo, hi, 0, 1, 2, 3, 4, 5, 6, 7), pb, g.o[dt]);
    }
  }
}
DI void nsa_sel16(const Params& p, char* smem, bool dry) {
  char* ws = p.ws;
  const int tid = otid(), lane = tid & 63, wave = tid >> 6, c16 = lane & 15, kg = lane >> 4, qi4 = c16 >> 2, r4 = c16 & 3;
  const bf16_t* Q = (const bf16_t*)(ws + OFF_Q);
  const float* gsig = (const float*)(ws + OFF_GSIG);
  bf16_t* ONSA = (bf16_t*)(ws + OFF_ONSA);
  const u32x4* SELG = (const u32x4*)(ws + OFF_SELG);
  const bf16_t* KS = (const bf16_t*)(ws + OFF_KS); const bf16_t* VS = (const bf16_t*)(ws + OFF_VS);
  constexpr int NITEM = NB * 2 * 128;
  for (int item = blockIdx.x; item < NITEM; item += gridDim.x) {
    const NsaItem it = nsa_item(item, wave, 0);
    const int qb = it.qb;
    bf16x8 qf[2][2]; u32x4 selw[2]; float g_s[2]; int tg[2]; Sel16 G[2];
#pragma unroll
    for (int gq = 0; gq < 2; ++gq) {
      tg[gq] = it.t + 4 * gq + qi4;
      const size_t tokrow = (size_t)it.b * SEQ + tg[gq];
#pragma unroll
      for (int ks = 0; ks < 2; ++ks) qf[gq][ks] = *(const bf16x8*)(Q + tokrow * 512 + (it.g * 4 + r4) * 64 + ks * 32 + kg * 8);
      selw[gq] = SELG[(size_t)it.bg * SEQ + tg[gq]];
      g_s[gq] = gsig[tokrow * 32 + (it.g * 4 + r4) * 3 + 1];
      G[gq].m = 0.f; G[gq].l = 0.f; G[gq].has = false;
#pragma unroll
      for (int dt = 0; dt < 4; ++dt) G[gq].o[dt] = (f32x4v){0.f, 0.f, 0.f, 0.f};
    }
    const bf16_t* kb = KS + (size_t)it.b * SEQ * 128 + it.g * 64;
    const bf16_t* vb = VS + (size_t)it.b * SEQ * 128 + it.g * 64;
    const int nst = (qb >> 2) + 1;
    StageRegs sr;
    lds_barrier();
    nsa_load_stage(sr, kb, vb, 0, qb);
    nsa_store_stage(sr, smem);
    lds_barrier();
    for (int sidx = 0; sidx < nst; ++sidx) {
      const char* stage = smem + (sidx & 1) * NSA_STAGE;
      if (sidx + 1 < nst) nsa_load_stage(sr, kb, vb, 4 * (sidx + 1), qb);
#pragma unroll 1
      for (int tt = 0; tt < 4; ++tt) {
        const int j = 4 * sidx + tt;
        if (j > qb) break;
#pragma unroll
        for (int gq = 0; gq < 2; ++gq) {
          const unsigned w = j < 32 ? selw[gq].x : (j < 64 ? selw[gq].y : (j < 96 ? selw[gq].z : selw[gq].w));
          const bool sel = (w >> (j & 31)) & 1u;
          if (__any(sel)) nsa_unit16(G[gq], stage + tt * 18432, qf[gq], sel, (j == qb) ? (tg[gq] - j * 64) : 1000, lane);
        }
      }
      if (sidx + 1 < nst) nsa_store_stage(sr, smem + ((sidx + 1) & 1) * NSA_STAGE);
      lds_barrier();
    }
#pragma unroll
    for (int gq = 0; gq < 2; ++gq) {
      float l = G[gq].l;
      l += __shfl_xor(l, 16); l += __shfl_xor(l, 32);
      const float sc = l > 0.f ? g_s[gq] / l : 0.f;
      bf16_t* dst = ONSA + ((size_t)it.b * SEQ + tg[gq]) * 512 + (it.g * 4 + r4) * 64 + 4 * kg;
      if (!dry) {
#pragma unroll
        for (int dt = 0; dt < 4; ++dt) {
          u32x2* pp = (u32x2*)(dst + dt * 16);
          const u32x2 old = *pp;
          u32x2 wv; wv.x = pack2(bflo(old.x) + sc * G[gq].o[dt][0], bfhi(old.x) + sc * G[gq].o[dt][1]);
          wv.y = pack2(bflo(old.y) + sc * G[gq].o[dt][2], bfhi(old.y) + sc * G[gq].o[dt][3]);
          *pp = wv;
        }
      } else asm volatile("" :: "v"(G[gq].o[0]), "v"(G[gq].o[1]), "v"(G[gq].o[2]), "v"(G[gq].o[3]), "v"(l));
    }
  }
}

DI void phase_nsa(const Params& p, char* smem, int branch_mask) {
  char* ws = p.ws;
  const int tid = otid(), lane = tid & 63, wave = tid >> 6, hh = lane >> 5, c = lane & 31, qi = c >> 2, r4 = c & 3;
  const bf16_t* Q = (const bf16_t*)(ws + OFF_Q);
  const float* gsig = (const float*)(ws + OFF_GSIG);
  bf16_t* ONSA = (bf16_t*)(ws + OFF_ONSA);
  u32x4* SELG = (u32x4*)(ws + OFF_SELG);
  constexpr int NITEM = NB * 2 * 128;

#pragma unroll 1
  for (int rep1 = 0; rep1 < ((PROBE_DUP & 4096) ? 2 : 1); ++rep1) {
    const bf16_t* KCMP = (const bf16_t*)(ws + OFF_KCMP); const bf16_t* VCMP = (const bf16_t*)(ws + OFF_VCMP);
    float* Aimp = (float*)(smem + NSA_AIMP) + wave * 1024;
    float* Cimp = (float*)(smem + NSA_CIMP) + wave * 1024;
    unsigned short* selm16 = (unsigned short*)(smem + NSA_SELM) + wave * 64;
    const u32x4* selm128 = (const u32x4*)(smem + NSA_SELM) + wave * 8;
    for (int item = blockIdx.x; item < NITEM; item += gridDim.x) {
      const NsaItem it = nsa_item(item, wave, qi);
      const int t = it.t;
      bf16x8 qf[4];
#pragma unroll
      for (int ks = 0; ks < 4; ++ks) qf[ks] = *(const bf16x8*)(Q + it.tokrow * 512 + (it.g * 4 + r4) * 64 + ks * 16 + hh * 8);
      const float g_c = gsig[it.tokrow * 32 + (it.g * 4 + r4) * 3 + 0];
      TileRegs tr;
      const int nmax = (it.qb * 64 + 63 - 31) >> 4, ntile = (nmax >> 6) + 1;
      const int nfull = (it.qb * 64 - 31) >> 4;
      const bf16_t* kb = KCMP + (size_t)it.bg * 512 * 64;
      const bf16_t* vb = VCMP + (size_t)it.bg * 512 * 64;
      float m = -1e30f, l = 0.f;
      __syncthreads();
      for (int i = lane; i < 1024; i += 64) { Aimp[i] = 0.f; Cimp[i] = 0.f; }
      nsa_load_tile(tr, kb, 64, vb, 64);
      nsa_store_tile(tr, smem);
      __syncthreads();
      for (int j = 0; j < ntile; ++j) {
        const char* tile = smem + (j & 1) * NSA_TILE;
        if (j + 1 < ntile) nsa_load_tile(tr, kb + (size_t)(j + 1) * 64 * 64, 64, vb + (size_t)(j + 1) * 64 * 64, 64);
        f32x16 st[2];
        nsa_scores(st, tile, qf, lane);
        const bool full = (j * 64 + 63 <= nfull);
        const int nlim = full ? 100000 : ((t - 31) >> 4) - j * 64 - 4 * hh;
        float mx = NSA_NEG;
#pragma unroll
        for (int kt = 0; kt < 2; ++kt)
#pragma unroll
          for (int r = 0; r < 16; ++r) {
            st[kt][r] = (kt * 32 + (r & 3) + 8 * (r >> 2) <= nlim) ? st[kt][r] : NSA_NEG;
            mx = fmaxf(mx, st[kt][r]);
          }
        mx = fmaxf(mx, __shfl_xor(mx, 32));
        const float mn = fmaxf(m, mx);
        float sum = 0.f;
#pragma unroll
        for (int kt = 0; kt < 2; ++kt)
#pragma unroll
          for (int r = 0; r < 16; ++r) sum += __builtin_amdgcn_exp2f(st[kt][r] - mn);
        l = l * __builtin_amdgcn_exp2f(m - mn) + sum;
        m = mn;
        if (j + 1 < ntile) nsa_store_tile(tr, smem + ((j + 1) & 1) * NSA_TILE);
        __syncthreads();
      }
      l += __shfl_xor(l, 32);
      const float inv_l = l > 0.f ? 1.0f / l : 0.f;
      f32x16 o[2];
#pragma unroll
      for (int r = 0; r < 16; ++r) { o[0][r] = 0.f; o[1][r] = 0.f; }
      nsa_load_tile(tr, kb, 64, vb, 64);
      nsa_store_tile(tr, smem);
      __syncthreads();
      for (int j = 0; j < ntile; ++j) {
        const char* tile = smem + (j & 1) * NSA_TILE;
        if (j + 1 < ntile) nsa_load_tile(tr, kb + (size_t)(j + 1) * 64 * 64, 64, vb + (size_t)(j + 1) * 64 * 64, 64);
        f32x16 st[2];
        nsa_scores(st, tile, qf, lane);
        const bool full = (j * 64 + 63 <= nfull);
        const int nlim = full ? 100000 : ((t - 31) >> 4) - j * 64 - 4 * hh;
#pragma unroll
        for (int kt = 0; kt < 2; ++kt)
#pragma unroll
          for (int r = 0; r < 16; ++r) {
            const float arg = (kt * 32 + (r & 3) + 8 * (r >> 2) <= nlim) ? st[kt][r] - m : NSA_NEG;
            st[kt][r] = __builtin_amdgcn_exp2f(arg) * inv_l;
          }
#pragma unroll
        for (int kt = 0; kt < 2; ++kt)
#pragma unroll
          for (int c4 = 0; c4 < 4; ++c4) {
            float carry = 0.5f * st[kt][4 * c4 + 3];
            float fullv = st[kt][4 * c4] + st[kt][4 * c4 + 1] + st[kt][4 * c4 + 2] + carry;
            fullv += __shfl_xor(fullv, 1); fullv += __shfl_xor(fullv, 2);
            carry += __shfl_xor(carry, 1); carry += __shfl_xor(carry, 2);
            const int jb = j * 16 + kt * 8 + 2 * c4 + hh;
            if (r4 == 0) { Aimp[qi * 128 + jb] = fullv; Cimp[qi * 128 + jb] = carry; }
          }
        if (branch_mask & 1) nsa_pv(o, st, tile, lane);
        if (j + 1 < ntile) nsa_store_tile(tr, smem + ((j + 1) & 1) * NSA_TILE);
        __syncthreads();
      }
      nsa_accum_store(ONSA + it.tokrow * 512 + (it.g * 4 + r4) * 64, o, (branch_mask & 1) ? g_c : 0.f, true, hh);
      const int cur = it.qb;
      if (cur <= 15) {
        if (lane < 8) { selm16[lane * 8 + 0] = (unsigned short)((2u << cur) - 1u);
#pragma unroll
          for (int k = 1; k < 8; ++k) selm16[lane * 8 + k] = 0; }
      } else {
        const int qs = lane >> 3, sub = lane & 7;
        float v[16];
#pragma unroll
        for (int i = 0; i < 16; ++i) {
          const int jj = sub * 16 + i;
          const bool ok = (jj >= 1) && (jj <= cur - 2);
          const int jm = jj >= 1 ? jj - 1 : 0;
          v[i] = ok ? (Aimp[qs * 128 + jj] + Cimp[qs * 128 + jm]) : -3e38f;
        }
        unsigned bits = 0;
        for (int itn = 0; itn < 13; ++itn) {
          float bv = v[0]; int bi = 0;
#pragma unroll
          for (int i = 1; i < 16; ++i) if (v[i] > bv) { bv = v[i]; bi = i; }
          int bj = sub * 16 + bi;
#pragma unroll
          for (int o2 = 1; o2 < 8; o2 <<= 1) {
            const float ov = __shfl_xor(bv, o2); const int oj = __shfl_xor(bj, o2);
            if (ov > bv || (ov == bv && oj < bj)) { bv = ov; bj = oj; }
          }
          if ((bj >> 4) == sub) {
            const int i2 = bj & 15;
#pragma unroll
            for (int i = 0; i < 16; ++i) if (i == i2) v[i] = -3e38f;
            bits |= 1u << i2;
          }
        }
        if (sub == 0) bits |= 1u;
        if ((cur >> 4) == sub) bits |= 1u << (cur & 15);
        if (((cur - 1) >> 4) == sub) bits |= 1u << ((cur - 1) & 15);
        selm16[qs * 8 + sub] = (unsigned short)bits;
      }
      __syncthreads();
      if (r4 == 0 && hh == 0) SELG[(size_t)it.bg * SEQ + t] = selm128[qi];
    }
  }
  __threadfence_block();
  __syncthreads();

#pragma unroll 1
  for (int sweep_i = 0; sweep_i < 2 + ((PROBE_DUP & 1024) ? 1 : 0) + ((PROBE_DUP & 2048) ? 1 : 0); ++sweep_i) {
    const int sweep = (sweep_i < 2) ? sweep_i : (((PROBE_DUP & 1024) && sweep_i == 2) ? 0 : 1);
    const bool dry = sweep_i >= 2;
    if (!(branch_mask & (sweep == 0 ? 2 : 4))) continue;
    if (sweep == 0) { nsa_sel16(p, smem, dry); continue; }
    const bf16_t* KB = (const bf16_t*)(ws + (sweep == 0 ? OFF_KS : OFF_KW)); const bf16_t* VB = (const bf16_t*)(ws + (sweep == 0 ? OFF_VS : OFF_VW));
    for (int item = blockIdx.x; item < NITEM; item += gridDim.x) {
      const NsaItem it = nsa_item(item, wave, qi);
      const int t = it.t, qb = it.qb;
      bf16x8 qf[4];
#pragma unroll
      for (int ks = 0; ks < 4; ++ks) qf[ks] = *(const bf16x8*)(Q + it.tokrow * 512 + (it.g * 4 + r4) * 64 + ks * 16 + hh * 8);
      const float g_b = gsig[it.tokrow * 32 + (it.g * 4 + r4) * 3 + 1 + sweep];
      u32x4 selw = {0xffffffffu, 0xffffffffu, 0xffffffffu, 0xffffffffu};
      if (sweep == 0) selw = SELG[(size_t)it.bg * SEQ + t];
      TileRegs tr;
      const bf16_t* kb = KB + (size_t)it.b * SEQ * 128 + it.g * 64;
      const bf16_t* vb = VB + (size_t)it.b * SEQ * 128 + it.g * 64;
      float m = -1e30f, l = 0.f;
      f32x16 o[2];
#pragma unroll
      for (int r = 0; r < 16; ++r) { o[0][r] = 0.f; o[1][r] = 0.f; }
      const int j0 = (sweep == 1 && qb >= 8) ? qb - 8 : 0;
      __syncthreads();
      nsa_load_tile(tr, kb + (size_t)j0 * 64 * 128, 128, vb + (size_t)j0 * 64 * 128, 128);
      nsa_store_tile(tr, smem);
      if (j0 + 1 <= qb) { nsa_load_tile(tr, kb + (size_t)(j0 + 1) * 64 * 128, 128, vb + (size_t)(j0 + 1) * 64 * 128, 128); nsa_store_tile(tr, smem + NSA_TILE); }
      if (j0 + 2 <= qb) nsa_load_tile(tr, kb + (size_t)(j0 + 2) * 64 * 128, 128, vb + (size_t)(j0 + 2) * 64 * 128, 128);
      __syncthreads();
      const bool late = wave >= 4;
      if (__builtin_amdgcn_readfirstlane(wave) >= 4) __builtin_amdgcn_s_setprio(1);
      bool has = false;
      m = 0.f;
      f32x16 st[2];
      {
        const unsigned w0 = j0 < 32 ? selw.x : (j0 < 64 ? selw.y : (j0 < 96 ? selw.z : selw.w));
        const float ini = ((w0 >> (j0 & 31)) & 1u) ? 0.f : -1e30f;
#pragma unroll
        for (int r = 0; r < 16; ++r) { st[0][r] = ini; st[1][r] = ini; }
        const bf16_t* Kc = (const bf16_t*)smem;
#pragma unroll
        for (int ks = 0; ks < 4; ++ks)
#pragma unroll
          for (int kt = 0; kt < 2; ++kt) st[kt] = MFMA32(*(const bf16x8*)(Kc + (kt * 32 + (lane & 31)) * LK + ks * 16 + (lane >> 5) * 8), qf[ks], st[kt]);
      }
      int bi = 0;
      for (int j = j0; j <= qb; ++j) {
        const char* tile = smem + bi * NSA_TILE;
        const int bn = bi == 2 ? 0 : bi + 1, bnn = bn == 2 ? 0 : bn + 1;
        const int jn = j + 1;
        const unsigned wn = jn < 32 ? selw.x : (jn < 64 ? selw.y : (jn < 96 ? selw.z : selw.w));
        const bool seln = (wn >> (jn & 31)) & 1u;
        const bf16_t* Kn = (const bf16_t*)(smem + bn * NSA_TILE) + (lane & 31) * LK + (lane >> 5) * 8;
        f32x16 sn[2];
        if (!late) {
          const float ini = seln ? -m : -1e30f;
#pragma unroll
          for (int r = 0; r < 16; ++r) { sn[0][r] = ini; sn[1][r] = ini; }
#pragma unroll
          for (int ks = 0; ks < 4; ++ks)
#pragma unroll
            for (int kt = 0; kt < 2; ++kt) sn[kt] = MFMA32(*(const bf16x8*)(Kn + kt * 32 * LK + ks * 16), qf[ks], sn[kt]);
        }
        if (j == qb || (sweep == 1 && j == qb - 8)) {
          const int khi = t - j * 64 - 4 * hh, klo = (sweep == 1) ? khi - 511 : -100000;
#pragma unroll
          for (int r = 0; r < 16; ++r) {
            const int o0 = (r & 3) + 8 * (r >> 2);
            st[0][r] = (o0 <= khi && o0 >= klo) ? st[0][r] : NSA_NEG;
            st[1][r] = (o0 + 32 <= khi && o0 + 32 >= klo) ? st[1][r] : NSA_NEG;
          }
        }
        float mx;
        {
          float a0, a1, a2, a3;
          asm("v_max3_f32 %0, %1, %2, %3" : "=v"(a0) : "v"(st[0][0]), "v"(st[0][1]), "v"(st[0][2]));
          asm("v_max3_f32 %0, %1, %2, %3" : "=v"(a1) : "v"(st[0][3]), "v"(st[0][4]), "v"(st[0][5]));
          asm("v_max3_f32 %0, %1, %2, %3" : "=v"(a2) : "v"(st[0][6]), "v"(st[0][7]), "v"(st[0][8]));
          asm("v_max3_f32 %0, %1, %2, %3" : "=v"(a3) : "v"(st[0][9]), "v"(st[0][10]), "v"(st[0][11]));
          asm("v_max3_f32 %0, %1, %2, %3" : "=v"(a0) : "v"(a0), "v"(st[0][12]), "v"(st[0][13]));
          asm("v_max3_f32 %0, %1, %2, %3" : "=v"(a1) : "v"(a1), "v"(st[0][14]), "v"(st[0][15]));
          asm("v_max3_f32 %0, %1, %2, %3" : "=v"(a2) : "v"(a2), "v"(st[1][0]), "v"(st[1][1]));
          asm("v_max3_f32 %0, %1, %2, %3" : "=v"(a3) : "v"(a3), "v"(st[1][2]), "v"(st[1][3]));
          asm("v_max3_f32 %0, %1, %2, %3" : "=v"(a0) : "v"(a0), "v"(st[1][4]), "v"(st[1][5]));
          asm("v_max3_f32 %0, %1, %2, %3" : "=v"(a1) : "v"(a1), "v"(st[1][6]), "v"(st[1][7]));
          asm("v_max3_f32 %0, %1, %2, %3" : "=v"(a2) : "v"(a2), "v"(st[1][8]), "v"(st[1][9]));
          asm("v_max3_f32 %0, %1, %2, %3" : "=v"(a3) : "v"(a3), "v"(st[1][10]), "v"(st[1][11]));
          asm("v_max3_f32 %0, %1, %2, %3" : "=v"(a0) : "v"(a0), "v"(st[1][12]), "v"(st[1][13]));
          asm("v_max3_f32 %0, %1, %2, %3" : "=v"(a1) : "v"(a1), "v"(st[1][14]), "v"(st[1][15]));
          asm("v_max3_f32 %0, %1, %2, %3" : "=v"(a0) : "v"(a0), "v"(a1), "v"(a2));
          const float other = a3;
          asm("v_max_f32 %0, %1, %2" : "=v"(mx) : "v"(a0), "v"(other));
          const float px = __shfl_xor(mx, 32);
          asm("v_max_f32 %0, %1, %2" : "=v"(mx) : "v"(mx), "v"(px));
        }
        const bool real = mx > -1e29f;
        const bool fresh = !has && real, up = has && (mx > NSA_THR);
        if (__any(fresh || up)) {
          const float delta = (fresh || up) ? mx : 0.f;
          const float alpha = up ? __builtin_amdgcn_exp2f(-delta) : 1.0f;
          m += delta; l *= alpha;
#pragma unroll
          for (int r = 0; r < 16; ++r) { o[0][r] *= alpha; o[1][r] *= alpha; st[0][r] -= delta; st[1][r] -= delta; }
          if (!late) {
            const float dn = seln ? delta : 0.f;
#pragma unroll
            for (int r = 0; r < 16; ++r) { sn[0][r] -= dn; sn[1][r] -= dn; }
          }
        }
        has = has || real;
        f32x2 s2 = {0.f, 0.f};
#pragma unroll
        for (int r = 0; r < 16; ++r) {
          const float p0 = __builtin_amdgcn_exp2f(st[0][r]), p1 = __builtin_amdgcn_exp2f(st[1][r]);
          st[0][r] = p0; st[1][r] = p1; s2 += (f32x2){p0, p1};
        }
        l += s2.x + s2.y;
        nsa_pv(o, st, tile, lane);
        if (late) {
          const float ini = seln ? -m : -1e30f;
#pragma unroll
          for (int r = 0; r < 16; ++r) { sn[0][r] = ini; sn[1][r] = ini; }
#pragma unroll
          for (int ks = 0; ks < 4; ++ks)
#pragma unroll
            for (int kt = 0; kt < 2; ++kt) sn[kt] = MFMA32(*(const bf16x8*)(Kn + kt * 32 * LK + ks * 16), qf[ks], sn[kt]);
        }
        if (j + 2 <= qb) nsa_store_tile(tr, smem + bnn * NSA_TILE);
        if (j + 3 <= qb) nsa_load_tile(tr, kb + (size_t)(j + 3) * 64 * 128, 128, vb + (size_t)(j + 3) * 64 * 128, 128);
#pragma unroll
        for (int r = 0; r < 16; ++r) { st[0][r] = sn[0][r]; st[1][r] = sn[1][r]; }
        bi = bn;
        __syncthreads();
      }
      __builtin_amdgcn_s_setprio(0);
      l += __shfl_xor(l, 32);
      if (!dry) nsa_accum_store(ONSA + it.tokrow * 512 + (it.g * 4 + r4) * 64, o, l > 0.f ? g_b / l : 0.f, false, hh);
      else asm volatile("" :: "v"(o[0]), "v"(o[1]), "v"(l));
    }
  }
}

DI unsigned ord_key(float f) { const unsigned u = __float_as_uint(f); return (u & 0x80000000u) ? ~u : (u | 0x80000000u); }
DI float ord_val(unsigned k) { return __uint_as_float((k & 0x80000000u) ? (k & 0x7fffffffu) : ~k); }
DI void cex(unsigned& hi, unsigned& lo) { const unsigned x = hi, y = lo; hi = x > y ? x : y; lo = x > y ? y : x; }
DI void sort16_desc(unsigned (&a)[16]) {
#pragma unroll
  for (int k = 2; k <= 16; k <<= 1)
#pragma unroll
    for (int j = k >> 1; j > 0; j >>= 1)
#pragma unroll
      for (int i = 0; i < 16; ++i) {
        const int l = i ^ j;
        if (l > i) { if ((i & k) == 0) cex(a[i], a[l]); else cex(a[l], a[i]); }
      }
}
DI void bitonic_finish16(unsigned (&a)[16]) {
#pragma unroll
  for (int j = 8; j > 0; j >>= 1)
#pragma unroll
    for (int i = 0; i < 16; ++i) { const int l = i ^ j; if (l > i) cex(a[i], a[l]); }
}
DI void merge_top16(unsigned (&a)[16], const unsigned (&b)[16]) {
#pragma unroll
  for (int i = 0; i < 16; ++i) a[i] = a[i] > b[15 - i] ? a[i] : b[15 - i];
  bitonic_finish16(a);
}
DI void merge_partner16(unsigned (&a)[16]) {
  unsigned b[16];
#pragma unroll
  for (int i = 0; i < 16; ++i) b[i] = (unsigned)__shfl_xor((int)a[i], 32);
  merge_top16(a, b);
}


DI void peer_top16(unsigned (&top)[16], const bf16_t* pqrow, const bf16_t* keys, int lane) {
  const int l31 = lane & 31, hh = lane >> 5;
  bf16x8 bq[8];
#pragma unroll
  for (int ks = 0; ks < 8; ++ks) bq[ks] = *(const bf16x8*)(pqrow + ks * 16 + hh * 8);
  unsigned grp[16];
#pragma unroll
  for (int nt = 0; nt < 4; ++nt) {
    f32x16 sa;
#pragma unroll
    for (int r = 0; r < 16; ++r) sa[r] = 0.f;
    const bf16_t* kp = keys + (size_t)(nt * 32 + l31) * 128 + hh * 8;
#pragma unroll
    for (int ks = 0; ks < 8; ++ks) { const bf16x8 a = *(const bf16x8*)(kp + ks * 16); sa = MFMA32(a, bq[ks], sa); }
#pragma unroll
    for (int r = 0; r < 16; ++r) {
      const int n = nt * 32 + (r & 3) + 8 * (r >> 2) + 4 * hh;
      grp[r] = (ord_key(sa[r]) & ~0x7Fu) | (unsigned)(127 - n);
    }
    sort16_desc(grp);
    if (nt == 0) {
#pragma unroll
      for (int i = 0; i < 16; ++i) top[i] = grp[i];
    } else merge_top16(top, grp);
  }
  merge_partner16(top);
}

DI void phase_route(const Params& p, char* smem) {
  char* ws = p.ws;
  const int tid = otid(), lane = tid & 63, wave = tid >> 6, l31 = lane & 31, hh = lane >> 5;
  const bf16_t* pq = (const bf16_t*)(ws + OFF_PQ);
  const bf16_t* pk = (const bf16_t*)(ws + OFF_PKEYS);
  int* eidx = (int*)(ws + OFF_EIDX);
  float* pgate = (float*)(ws + OFF_PGATE);
  unsigned* LS = (unsigned*)smem + wave * 1024;
  constexpr int CA[64] = {0,0,0,0,0,0,0,0,0,0,0,0,0,0,0,0, 1,1,1,1,1,1,1,1, 2,2,2,2,2, 3,3,3,3, 4,4,4, 5,5, 6,6, 7,7, 8,9,10,11,12,13,14,15, 0,0,0,0,0,0,0,0,0,0,0,0,0,0};
  constexpr int CB[64] = {0,1,2,3,4,5,6,7,8,9,10,11,12,13,14,15, 0,1,2,3,4,5,6,7, 0,1,2,3,4, 0,1,2,3, 0,1,2, 0,1, 0,1, 0,1, 0,0,0,0,0,0,0,0, 0,0,0,0,0,0,0,0,0,0,0,0,0,0};
  for (int item = blockIdx.x; item < (NTOK / 256) * 8; item += gridDim.x) {
    const int h = item & 7, t0 = (item >> 3) * 256 + wave * 32;
    unsigned s1[16], s2[16];
    const bf16_t* pqrow = pq + (size_t)(t0 + l31) * 2048 + h * 256;
    peer_top16(s1, pqrow, pk + (size_t)(h * 2) * 128 * 128, lane);
    peer_top16(s2, pqrow + 128, pk + (size_t)(h * 2 + 1) * 128 * 128, lane);
    float f1[16], f2[16];
#pragma unroll
    for (int i = 0; i < 16; ++i) { f1[i] = ord_val(s1[i]); f2[i] = ord_val(s2[i]); }
    unsigned ca[16], cb2[16];
#pragma unroll
    for (int i = 0; i < 32; ++i) {
      const int i0 = i, i1 = 25 + i;
      unsigned k0 = 0u, k1 = 0u;
      if (i0 < 25) k0 = (ord_key(f1[CA[i0]] + f2[CB[i0]]) & ~0xFFu) | (unsigned)(255 - (CA[i0] * 16 + CB[i0]));
      if (i1 < 50) k1 = (ord_key(f1[CA[i1]] + f2[CB[i1]]) & ~0xFFu) | (unsigned)(255 - (CA[i1] * 16 + CB[i1]));
      const unsigned kk = hh ? k1 : k0;
      if (i < 16) ca[i] = kk; else cb2[i - 16] = kk;
    }
    sort16_desc(ca); sort16_desc(cb2);
    merge_top16(ca, cb2);
    merge_partner16(ca);
    if (hh == 0) {
#pragma unroll
      for (int i = 0; i < 16; ++i) { LS[l31 * 32 + i] = s1[i]; LS[l31 * 32 + 16 + i] = s2[i]; }
    }
    const float mx = ord_val(ca[0]);
    float ex[16], sum = 0.f;
#pragma unroll
    for (int i = 0; i < 16; ++i) { ex[i] = __expf(ord_val(ca[i]) - mx); sum += ex[i]; }
    const float inv = 1.0f / sum;
    int eo[16]; float go[16];
#pragma unroll
    for (int i = 0; i < 16; ++i) {
      const int flat = 255 - (int)(ca[i] & 0xFFu);
      const unsigned k1 = LS[l31 * 32 + (flat >> 4)], k2 = LS[l31 * 32 + 16 + (flat & 15)];
      eo[i] = (127 - (int)(k1 & 0x7Fu)) * 128 + (127 - (int)(k2 & 0x7Fu));
      go[i] = ex[i] * inv;
    }
    const size_t ob = ((size_t)(t0 + l31) * 8 + h) * 16;
    if (hh == 0) {
      *(u32x4*)(eidx + ob) = (u32x4){(unsigned)eo[0], (unsigned)eo[1], (unsigned)eo[2], (unsigned)eo[3]};
      *(u32x4*)(eidx + ob + 4) = (u32x4){(unsigned)eo[4], (unsigned)eo[5], (unsigned)eo[6], (unsigned)eo[7]};
      *(f32x4*)(pgate + ob) = (f32x4){go[0], go[1], go[2], go[3]};
      *(f32x4*)(pgate + ob + 4) = (f32x4){go[4], go[5], go[6], go[7]};
    } else {
      *(u32x4*)(eidx + ob + 8) = (u32x4){(unsigned)eo[8], (unsigned)eo[9], (unsigned)eo[10], (unsigned)eo[11]};
      *(u32x4*)(eidx + ob + 12) = (u32x4){(unsigned)eo[12], (unsigned)eo[13], (unsigned)eo[14], (unsigned)eo[15]};
      *(f32x4*)(pgate + ob + 8) = (f32x4){go[8], go[9], go[10], go[11]};
      *(f32x4*)(pgate + ob + 12) = (f32x4){go[12], go[13], go[14], go[15]};
    }
  }
}

#define FOR32(M) M(0) M(1) M(2) M(3) M(4) M(5) M(6) M(7) M(8) M(9) M(10) M(11) M(12) M(13) M(14) M(15) M(16) M(17) M(18) M(19) M(20) M(21) M(22) M(23) M(24) M(25) M(26) M(27) M(28) M(29) M(30) M(31)
DI float dot16_fp8(const u32x4 raw, const float (&hx)[16]) {
  const f32x2 a0 = __builtin_amdgcn_cvt_pk_f32_fp8((int)raw.x, false), a1 = __builtin_amdgcn_cvt_pk_f32_fp8((int)raw.x, true);
  const f32x2 b0 = __builtin_amdgcn_cvt_pk_f32_fp8((int)raw.y, false), b1 = __builtin_amdgcn_cvt_pk_f32_fp8((int)raw.y, true);
  const f32x2 c0 = __builtin_amdgcn_cvt_pk_f32_fp8((int)raw.z, false), c1 = __builtin_amdgcn_cvt_pk_f32_fp8((int)raw.z, true);
  const f32x2 d0 = __builtin_amdgcn_cvt_pk_f32_fp8((int)raw.w, false), d1 = __builtin_amdgcn_cvt_pk_f32_fp8((int)raw.w, true);
  f32x2 s0 = a0 * (f32x2){hx[0], hx[1]}, s1 = a1 * (f32x2){hx[2], hx[3]};
  s0 = b0 * (f32x2){hx[4], hx[5]} + s0; s1 = b1 * (f32x2){hx[6], hx[7]} + s1;
  s0 = c0 * (f32x2){hx[8], hx[9]} + s0; s1 = c1 * (f32x2){hx[10], hx[11]} + s1;
  s0 = d0 * (f32x2){hx[12], hx[13]} + s0; s1 = d1 * (f32x2){hx[14], hx[15]} + s1;
  s0 += s1;
  return s0.x + s0.y;
}
#define FOR16(M) M(0) M(1) M(2) M(3) M(4) M(5) M(6) M(7) M(8) M(9) M(10) M(11) M(12) M(13) M(14) M(15)
DI void phase_ffn_u(const Params& p) {
  char* ws = p.ws;
  const int lane = otid() & 63, wave = otid() >> 6, pg = lane >> 3, dc = lane & 7;
  const int sl = blockIdx.x & 7, wslot = (blockIdx.x >> 3) * NW + wave, nw = (gridDim.x >> 3) * NW;
  const unsigned char* PU8 = (const unsigned char*)(ws + OFF_PU8) + (size_t)sl * 16384 * 128 + dc * 16;
  const bf16_t* h2 = (const bf16_t*)(ws + OFF_H) + sl * 128 + dc * 16;
  const int* eidx = (const int*)(ws + OFF_EIDX);
  float* part = (float*)(ws + OFF_PART) + (size_t)sl * NTOK * 128;
  const int j0 = (dc >> 2) * 64 + ((2 * dc) & 7) * 8 + pg;
  int ev0 = 0, ev1 = 0, nev0 = 0, nev1 = 0; u32x4 ha = {0u, 0u, 0u, 0u}, hb = ha, nha = ha, nhb = ha;
  if (wslot < NTOK) { ev0 = eidx[(size_t)wslot * 128 + lane]; ev1 = eidx[(size_t)wslot * 128 + 64 + lane]; ha = *(const u32x4*)(h2 + (size_t)wslot * DM); hb = *(const u32x4*)(h2 + (size_t)wslot * DM + 8); }
  for (int t = wslot; t < NTOK; t += nw) {
    if (t + nw < NTOK) { const size_t o = (size_t)(t + nw) * 128; nev0 = eidx[o + lane]; nev1 = eidx[o + 64 + lane]; nha = *(const u32x4*)(h2 + (size_t)(t + nw) * DM); nhb = *(const u32x4*)(h2 + (size_t)(t + nw) * DM + 8); }
    float hx[16];
    { float t8[8]; unpack8(ha, t8);
#pragma unroll
      for (int i = 0; i < 8; ++i) hx[i] = t8[i];
      unpack8(hb, t8);
#pragma unroll
      for (int i = 0; i < 8; ++i) hx[8 + i] = t8[i]; }
#define FFU_LD(it) const u32x4 ru##it = *(const u32x4*)(PU8 + (size_t)__shfl((it) < 8 ? ev0 : ev1, ((it) & 7) * 8 + pg) * 128);
    FOR16(FFU_LD)
    float d[16];
#define FFU_CP(it) d[it] = dot16_fp8(ru##it, hx);
    FOR16(FFU_CP)
    float r8[8], r4[4], r2[2];
    { const bool hi = dc & 4;
#pragma unroll
      for (int i = 0; i < 8; ++i) { const float keep = hi ? d[8 + i] : d[i], send = hi ? d[i] : d[8 + i]; r8[i] = keep + __shfl_xor(send, 4); } }
    { const bool hi = dc & 2;
#pragma unroll
      for (int i = 0; i < 4; ++i) { const float keep = hi ? r8[4 + i] : r8[i], send = hi ? r8[i] : r8[4 + i]; r4[i] = keep + __shfl_xor(send, 2); } }
    { const bool hi = dc & 1;
#pragma unroll
      for (int i = 0; i < 2; ++i) { const float keep = hi ? r4[2 + i] : r4[i], send = hi ? r4[i] : r4[2 + i]; r2[i] = keep + __shfl_xor(send, 1); } }
    part[(size_t)t * 128 + j0] = r2[0];
    part[(size_t)t * 128 + j0 + 8] = r2[1];
    ev0 = nev0; ev1 = nev1; ha = nha; hb = nhb;
  }
}
DI void phase_ffn_w(const Params& p) {
  char* ws = p.ws;
  const int lane = otid() & 63, wave = otid() >> 6;
  const float* part = (const float*)(ws + OFF_PART);
  const float* scu = (const float*)(ws + OFF_SCU); const float* scv = (const float*)(ws + OFF_SCV);
  const int* eidx = (const int*)(ws + OFF_EIDX);
  const float* pgate = (const float*)(ws + OFF_PGATE);
  float* wbuf = (float*)(ws + OFF_WBUF);
  for (int grp = blockIdx.x; grp < NTOK / NW; grp += gridDim.x) {
    const size_t o = (size_t)(grp * NW + wave) * 128 + lane;
    float a0 = 0.f, a1 = 0.f;
#pragma unroll
    for (int s8 = 0; s8 < 8; ++s8) { a0 += part[(size_t)s8 * NTOK * 128 + o]; a1 += part[(size_t)s8 * NTOK * 128 + o + 64]; }
    const int e0 = eidx[o], e1 = eidx[o + 64];
    wbuf[o] = pgate[o] * gelu_f(a0 * scu[e0]) * scv[e0];
    wbuf[o + 64] = pgate[o + 64] * gelu_f(a1 * scu[e1]) * scv[e1];
  }
}
DI void phase_ffn_v(const Params& p) {
  char* ws = p.ws;
  const int lane = otid() & 63, wave = otid() >> 6, pg = lane >> 3, dc = lane & 7;
  const int sl = blockIdx.x & 7, wslot = (blockIdx.x >> 3) * NW + wave, nw = (gridDim.x >> 3) * NW;
  const unsigned char* PV8 = (const unsigned char*)(ws + OFF_PV8) + (size_t)sl * 16384 * 128 + dc * 16;
  const int* eidx = (const int*)(ws + OFF_EIDX) + 16 * pg;
  const float* wbuf = (const float*)(ws + OFF_WBUF) + 16 * pg;
  bf16_t* ffnb = (bf16_t*)(ws + OFF_FFNB);
  u32x4 ne0 = {0u, 0u, 0u, 0u}, ne1 = ne0, ne2 = ne0, ne3 = ne0;
  if (wslot < NTOK) { const int* ep = eidx + (size_t)wslot * 128; ne0 = *(const u32x4*)ep; ne1 = *(const u32x4*)(ep + 4); ne2 = *(const u32x4*)(ep + 8); ne3 = *(const u32x4*)(ep + 12); }
#pragma unroll 1
  for (int t = wslot; t < NTOK; t += nw) {
    const u32x4 ce0 = ne0, ce1 = ne1, ce2 = ne2, ce3 = ne3;
    if (t + nw < NTOK) { const int* ep = eidx + (size_t)(t + nw) * 128; ne0 = *(const u32x4*)ep; ne1 = *(const u32x4*)(ep + 4); ne2 = *(const u32x4*)(ep + 8); ne3 = *(const u32x4*)(ep + 12); }
    const float* wp = wbuf + (size_t)t * 128;
    const f32x4 wq0 = *(const f32x4*)wp, wq1 = *(const f32x4*)(wp + 4), wq2 = *(const f32x4*)(wp + 8), wq3 = *(const f32x4*)(wp + 12);
#define FFV_E(it) ((it) < 4 ? ce0[(it) & 3] : (it) < 8 ? ce1[(it) & 3] : (it) < 12 ? ce2[(it) & 3] : ce3[(it) & 3])
#define FFV_W(it) ((it) < 4 ? wq0[(it) & 3] : (it) < 8 ? wq1[(it) & 3] : (it) < 12 ? wq2[(it) & 3] : wq3[(it) & 3])
#define FFV_LD(it) const u32x4 rv##it = *(const u32x4*)(PV8 + (size_t)FFV_E(it) * 128);
#define FFV_CP(it) { const float wj = FFV_W(it); const f32x2 w2 = {wj, wj}; \
      acc2[0] += __builtin_amdgcn_cvt_pk_f32_fp8((int)rv##it.x, false) * w2; acc2[1] += __builtin_amdgcn_cvt_pk_f32_fp8((int)rv##it.x, true) * w2; \
      acc2[2] += __builtin_amdgcn_cvt_pk_f32_fp8((int)rv##it.y, false) * w2; acc2[3] += __builtin_amdgcn_cvt_pk_f32_fp8((int)rv##it.y, true) * w2; \
      acc2[4] += __builtin_amdgcn_cvt_pk_f32_fp8((int)rv##it.z, false) * w2; acc2[5] += __builtin_amdgcn_cvt_pk_f32_fp8((int)rv##it.z, true) * w2; \
      acc2[6] += __builtin_amdgcn_cvt_pk_f32_fp8((int)rv##it.w, false) * w2; acc2[7] += __builtin_amdgcn_cvt_pk_f32_fp8((int)rv##it.w, true) * w2; }
    FOR16(FFV_LD)
    f32x2 acc2[8];
#pragma unroll
    for (int i = 0; i < 8; ++i) acc2[i] = (f32x2){0.f, 0.f};
    FOR16(FFV_CP)
    float acc[16];
#pragma unroll
    for (int i = 0; i < 8; ++i) { acc[2 * i] = acc2[i].x; acc[2 * i + 1] = acc2[i].y; }
    float r8[8], r4[4], r2[2];
    { const bool hi = lane & 32;
#pragma unroll
      for (int i = 0; i < 8; ++i) { const float keep = hi ? acc[8 + i] : acc[i], send = hi ? acc[i] : acc[8 + i]; r8[i] = keep + __shfl_xor(send, 32); } }
    { const bool hi = lane & 16;
#pragma unroll
      for (int i = 0; i < 4; ++i) { const float keep = hi ? r8[4 + i] : r8[i], send = hi ? r8[i] : r8[4 + i]; r4[i] = keep + __shfl_xor(send, 16); } }
    { const bool hi = lane & 8;
#pragma unroll
      for (int i = 0; i < 2; ++i) { const float keep = hi ? r4[2 + i] : r4[i], send = hi ? r4[i] : r4[2 + i]; r2[i] = keep + __shfl_xor(send, 8); } }
    *(unsigned*)(ffnb + (size_t)t * DM + sl * 128 + dc * 16 + 2 * pg) = pack2(r2[0], r2[1]);
  }
}
DI void phase_final(const Params& p) {
  char* ws = p.ws;
  const int lane = otid() & 63, wave = otid() >> 6;
  const bf16_t* x1 = (const bf16_t*)(ws + OFF_X1);
  const bf16_t* ffnb = (const bf16_t*)(ws + OFF_FFNB);
  const float* mod = (const float*)(ws + OFF_MOD);
  for (int grp = blockIdx.x; grp < NTOK / NW; grp += gridDim.x) {
    const int row = grp * NW + wave, b = row >> 13;
    float v[16];
#pragma unroll
    for (int i = 0; i < 4; ++i) {
      const int col = i * 256 + lane * 4;
      const f32x4 gt2 = *(const f32x4*)(mod + b * 6144 + 5120 + col);
      const u32x2 xr = *(const u32x2*)(x1 + (size_t)row * DM + col), fr = *(const u32x2*)(ffnb + (size_t)row * DM + col);
      v[4 * i] = DN_ALPHA * bflo(xr.x) + gt2.x * bflo(fr.x); v[4 * i + 1] = DN_ALPHA * bfhi(xr.x) + gt2.y * bfhi(fr.x);
      v[4 * i + 2] = DN_ALPHA * bflo(xr.y) + gt2.z * bflo(fr.y); v[4 * i + 3] = DN_ALPHA * bfhi(xr.y) + gt2.w * bfhi(fr.y);
    }
    float mean, rstd; row_stats(v, mean, rstd);
#pragma unroll
    for (int i = 0; i < 4; ++i) {
      const int col = i * 256 + lane * 4;
      const f32x4 g = *(const f32x4*)(p.ln2_g + col), bb = *(const f32x4*)(p.ln2_b + col);
      f32x4 o;
      o.x = (v[4 * i] - mean) * rstd * g.x + bb.x; o.y = (v[4 * i + 1] - mean) * rstd * g.y + bb.y;
      o.z = (v[4 * i + 2] - mean) * rstd * g.z + bb.z; o.w = (v[4 * i + 3] - mean) * rstd * g.w + bb.w;
      *(f32x4*)(p.out + (size_t)row * DM + col) = o;
    }
  }
}

#define XB_TMO      128
#define XB_XCNT(j)  (256  + 64 * (j))
#define XB_XSUB(j)  (1280 + 64 * (j))
#define XB_XGEN(j)  (2304 + 64 * (j))
#define XB_TOP      3328
#define XB_TOPGEN   3392
#define XCD_BAR_WORDS 3456
#define XB_SPIN_CAP (1u << 22)
DI unsigned xb_ld(unsigned* p) { return __hip_atomic_load(p, __ATOMIC_RELAXED, __HIP_MEMORY_SCOPE_AGENT); }
DI unsigned xb_add(unsigned* p, unsigned v) { return __hip_atomic_fetch_add(p, v, __ATOMIC_RELAXED, __HIP_MEMORY_SCOPE_AGENT); }
DI unsigned xb_xcc_id() { return (unsigned)__builtin_amdgcn_s_getreg((3 << 11) | 20) & 0xFu; }
#define XB_SPIN(cond, bar) do { unsigned _sp = 0; while (cond) { __builtin_amdgcn_s_sleep(1); \
    if ((++_sp & 255u) == 0u) { if (xb_ld(&(bar)[XB_TMO])) break; if (_sp > XB_SPIN_CAP) { atomicAdd(&(bar)[XB_TMO], 1u); break; } } } } while (0)
struct XcdBarrier { unsigned* bar; unsigned x; volatile LAS unsigned* st; };
DI XcdBarrier xcd_barrier_post(unsigned* bar, volatile LAS unsigned* st) {
  XcdBarrier b; b.bar = bar; b.x = xb_xcc_id(); b.st = st;
  if (threadIdx.x == 0) (void)xb_add(&bar[XB_XCNT(b.x)], 1u);
  return b;
}
DI void xcd_barrier_complete(unsigned* bar, unsigned x, unsigned& nloc, unsigned& nx) {
  const unsigned G = gridDim.x * gridDim.y * gridDim.z;
  unsigned sum, cnt, mine, sp = 0u;
  for (;;) {
    sum = 0u; cnt = 0u; mine = 0u;
#pragma unroll
    for (unsigned j = 0; j < 16; ++j) { const unsigned c = xb_ld(&bar[XB_XCNT(j)]); sum += c; cnt += (c > 0u) ? 1u : 0u; mine = (j == x) ? c : mine; }
    if (sum == G) break;
    __builtin_amdgcn_s_sleep(1);
    if ((++sp & 255u) == 0u) { if (xb_ld(&bar[XB_TMO])) break; if (sp > XB_SPIN_CAP) { atomicAdd(&bar[XB_TMO], 1u); break; } }
  }
  nloc = mine > 0u ? mine : 1u; nx = cnt > 0u ? cnt : 1u;
}
DI void xcd_barrier(const XcdBarrier& b) {
  asm volatile("s_waitcnt vmcnt(0)" ::: "memory");
  __syncthreads();
  if (threadIdx.x == 0) {
    unsigned* bar = b.bar;
    __builtin_amdgcn_s_waitcnt(0);
    unsigned nloc = b.st[0], nx = b.st[1];
    if (nloc == 0u) { xcd_barrier_complete(bar, b.x, nloc, nx); b.st[0] = nloc; b.st[1] = nx; }
    const unsigned old = xb_add(&bar[XB_XSUB(b.x)], 1u);
    const unsigned gen = old / nloc;
    if (old + 1u == (gen + 1u) * nloc) {
      __builtin_amdgcn_fence(__ATOMIC_RELEASE, "agent");
      asm volatile("s_waitcnt vmcnt(0)" ::: "memory");
      const unsigned og = xb_add(&bar[XB_TOP], 1u);
      const unsigned tg = og / nx;
      if (og + 1u == (tg + 1u) * nx) xb_add(&bar[XB_TOPGEN], 1u);
      else XB_SPIN(xb_ld(&bar[XB_TOPGEN]) == tg, bar);
      __builtin_amdgcn_fence(__ATOMIC_ACQUIRE, "agent");
      xb_add(&bar[XB_XGEN(b.x)], 1u);
      asm volatile("s_waitcnt vmcnt(0)" ::: "memory");
    } else {
      XB_SPIN(xb_ld(&bar[XB_XGEN(b.x)]) == gen, bar);
      __builtin_amdgcn_fence(__ATOMIC_ACQUIRE, "agent");
      asm volatile("s_waitcnt vmcnt(0)" ::: "memory");
    }
  }
  __syncthreads();
}

constexpr int SMEM_BYTES = 147456 + 256;

__global__ void __launch_bounds__(NT, 2) k_mega(Params p) {
  __shared__ __attribute__((aligned(16))) char smem[SMEM_BYTES];
  cg::grid_group grid = cg::this_grid();
  if (threadIdx.x == 0) *(u32x4*)(smem + 147456) = (u32x4){0u, 0u, 0u, 0u};
  __syncthreads();
  const XcdBarrier xb = xcd_barrier_post((unsigned*)(p.ws + OFF_BAR), (volatile LAS unsigned*)(smem + 147456));
#define REP(mask) _Pragma("unroll 1") for (int rep_ = 0; rep_ < ((PROBE_DUP & (mask)) ? 2 : 1); ++rep_)
  REP(1) phase_prep(p, smem);
  grid.sync();
  REP(1) phase_ln_in(p);
  xcd_barrier(xb);
  REP(2) phase_gemm1(p, smem);
  xcd_barrier(xb);
  REP(4) phase_compress(p, smem);
  phase_sgu(p, smem);
  xcd_barrier(xb);
  REP(8) phase_nsa(p, smem, NSA_MASK);
  xcd_barrier(xb);
  REP(16) phase_merge(p, smem);
  xcd_barrier(xb);
  REP(16) phase_outproj(p, smem);
  xcd_barrier(xb);
  REP(1) phase_ln_mid(p);
  xcd_barrier(xb);
  REP(32) phase_peerq(p, smem);
  xcd_barrier(xb);
  REP(64) phase_route(p, smem);
  xcd_barrier(xb);
  REP(128) phase_ffn_u(p);
  xcd_barrier(xb);
  REP(128) phase_ffn_w(p);
  xcd_barrier(xb);
  REP(256) phase_ffn_v(p);
  xcd_barrier(xb);
  REP(512) phase_final(p);
}

extern "C" void kernel_launch(void* const* d_in, const int* in_sizes, int n_in, void* d_out, int out_size, void* d_ws, size_t ws_size, hipStream_t stream) {
  if (ws_size < OFF_END) { fprintf(stderr, "workspace too small: %zu < %zu\n", ws_size, (size_t)OFF_END); return; }
  static int grid_blocks = 0;
  if (!grid_blocks) {
    int dev = 0, cus = 0, per_cu = 0;
    (void)hipGetDevice(&dev);
    (void)hipDeviceGetAttribute(&cus, hipDeviceAttributeMultiprocessorCount, dev);
    (void)hipOccupancyMaxActiveBlocksPerMultiprocessor(&per_cu, k_mega, NT, 0);
    if (per_cu < 1) fprintf(stderr, "occupancy query returned %d\n", per_cu);
    grid_blocks = (cus / 8) * 8;
  }
  Params p{};
  const float** fp = (const float**)&p;
  for (int i = 0; i < 26; ++i) fp[i] = (const float*)d_in[i];
  p.out = (float*)d_out;
  p.ws = (char*)d_ws;
  for (int i = 0; i < 32; ++i) p.inv_freq[i] = (float)pow(10000.0, -(double)i / 32.0);
  (void)hipMemsetAsync((char*)d_ws + OFF_BAR, 0, XCD_BAR_WORDS * 4, stream);
  void* args[] = {&p};
  hipError_t e = hipLaunchCooperativeKernel((void*)k_mega, dim3(grid_blocks), dim3(NT), args, 0, stream);
  if (e != hipSuccess) fprintf(stderr, "cooperative launch failed: %s (grid %d)\n", hipGetErrorString(e), grid_blocks);
}
```

```cpp
#include <hip/hip_runtime.h>
#include <hip/hip_cooperative_groups.h>
#include <stdint.h>
#include <stdio.h>
#include <math.h>
namespace cg = cooperative_groups;

#ifndef PROBE_DUP
#define PROBE_DUP 0
#endif
#ifndef NSA_MASK
#define NSA_MASK 7
#endif
typedef unsigned short bf16_t;
typedef short bf16x8 __attribute__((ext_vector_type(8)));
typedef short s16x4 __attribute__((ext_vector_type(4)));
typedef float f32x16 __attribute__((ext_vector_type(16)));
typedef float f32x4 __attribute__((ext_vector_type(4)));
typedef float f32x2 __attribute__((ext_vector_type(2)));
typedef __bf16 bf16v2 __attribute__((ext_vector_type(2)));
typedef unsigned u32x4 __attribute__((ext_vector_type(4)));
typedef unsigned u32x2 __attribute__((ext_vector_type(2)));
#define DI __device__ __forceinline__
#define LAS __attribute__((address_space(3)))
#define MFMA32(a, b, c) __builtin_amdgcn_mfma_f32_32x32x16_bf16((a), (b), (c), 0, 0, 0)

constexpr int NT = 512, NW = 8;
constexpr int NB = 8, SEQ = 8192, DM = 1024, NTOK = NB * SEQ;
constexpr int N1 = 4608;
constexpr float DN_ALPHA = 1.189207115002721f;
constexpr float LN_EPS = 1e-5f;

constexpr size_t MB = 1024 * 1024;
constexpr size_t OFF_MOD = 0;
constexpr size_t OFF_ROPE = OFF_MOD + 256 * 1024;
constexpr size_t OFF_POSB = OFF_ROPE + 2 * MB;
constexpr size_t OFF_WT1 = OFF_POSB + 4096;
constexpr size_t OFF_WB = OFF_WT1 + (size_t)N1 * 1024 * 2;
constexpr size_t OFF_WOUT = OFF_WB + 2 * MB;
constexpr size_t OFF_WQ = OFF_WOUT + 2 * MB;
constexpr size_t OFF_PKEYS = OFF_WQ + 4 * MB;
constexpr size_t OFF_CW1 = OFF_PKEYS + MB / 2;
constexpr size_t OFF_CW2 = OFF_CW1 + MB;
constexpr size_t OFF_SGUW = OFF_CW2 + 32 * 1024;
constexpr size_t OFF_SCU = OFF_SGUW + 256 * 1024;
constexpr size_t OFF_SCV = OFF_SCU + 64 * 1024;
constexpr size_t OFF_PU = OFF_SCV + 64 * 1024;
constexpr size_t OFF_PV = OFF_PU + 32 * MB;
constexpr size_t OFF_ACT = ((OFF_PV + 32 * MB + 4095) / 4096) * 4096;
constexpr size_t OFF_H = OFF_ACT;
constexpr size_t OFF_Q = OFF_H + 128 * MB;
constexpr size_t OFF_KC = OFF_Q + 64 * MB;
constexpr size_t OFF_VC = OFF_KC + 16 * MB;
constexpr size_t OFF_KS = OFF_VC + 16 * MB;
constexpr size_t OFF_VS = OFF_KS + 16 * MB;
constexpr size_t OFF_KW = OFF_VS + 16 * MB;
constexpr size_t OFF_VW = OFF_KW + 16 * MB;
constexpr size_t OFF_U = OFF_VW + 16 * MB;
constexpr size_t OFF_V = OFF_U + 64 * MB;
constexpr size_t OFF_GATE = OFF_V + 64 * MB;
constexpr size_t OFF_GSIG = OFF_GATE + 256 * MB;
constexpr size_t OFF_KCMP = OFF_GSIG + 8 * MB;
constexpr size_t OFF_VCMP = OFF_KCMP + MB;
constexpr size_t OFF_ONSA = OFF_VCMP + MB;
constexpr size_t OFF_SELG = OFF_ONSA + 64 * MB;
constexpr size_t OFF_BAR = OFF_SELG + 2 * MB;
constexpr size_t OFF_END = OFF_BAR + 64 * 1024;
constexpr size_t OFF_X1 = OFF_Q;
constexpr size_t OFF_Y = OFF_GATE;
constexpr size_t OFF_PQ = OFF_GATE;
constexpr size_t OFF_EIDX = OFF_ONSA;
constexpr size_t OFF_PGATE = OFF_ONSA + 32 * MB;
constexpr size_t OFF_PU8 = OFF_PU;
constexpr size_t OFF_PART = OFF_GATE;
constexpr size_t OFF_PV8 = OFF_PU + 16 * MB;
constexpr size_t OFF_WBUF = OFF_PU + 32 * MB;
constexpr size_t OFF_FFNB = OFF_GATE;

struct Params {
  const float *x, *c, *w_ada, *b_ada, *w_in, *cmp_pos, *cmp_w1, *cmp_b1, *cmp_w2, *cmp_b2, *sgu_ln_g, *sgu_ln_b, *sgu_w, *sgu_b,
      *w_branch, *w_merge, *b_merge, *w_out, *ln1_g, *ln1_b, *peer_wq, *peer_keys, *peer_u, *peer_v, *ln2_g, *ln2_b;
  float* out;
  char* ws;
  float inv_freq[32];
};

DI unsigned pack2(float lo, float hi) { f32x2 v = {lo, hi}; bf16v2 r = __builtin_convertvector(v, bf16v2); return __builtin_bit_cast(unsigned, r); }
DI bf16_t f2bf(float f) { __bf16 r = (__bf16)f; return __builtin_bit_cast(unsigned short, r); }
DI float bf2f(bf16_t h) { return __uint_as_float(((unsigned)h) << 16); }
DI float bflo(unsigned u) { return __uint_as_float(u << 16); }
DI float bfhi(unsigned u) { return __uint_as_float(u & 0xffff0000u); }
DI float gelu_f(float v) { return 0.5f * v * (1.0f + erff(v * 0.70710678118654752f)); }
DI float sigmoid_f(float v) { return 1.0f / (1.0f + __expf(-v)); }
DI int otid() { int t = __builtin_amdgcn_workitem_id_x(); asm volatile("" : "+v"(t)); return t; }
DI void lds_barrier() { asm volatile("s_waitcnt lgkmcnt(0)" ::: "memory"); __builtin_amdgcn_s_barrier(); asm volatile("" ::: "memory"); }
DI float xor1f(float x) { const int xi = __float_as_int(x); return __int_as_float(__builtin_amdgcn_update_dpp(xi, xi, 0xB1, 0xF, 0xF, false)); }
DI float xor2f(float x) { const int xi = __float_as_int(x); return __int_as_float(__builtin_amdgcn_update_dpp(xi, xi, 0x4E, 0xF, 0xF, false)); }
DI float xor8f(float x) { const int xi = __float_as_int(x); return __int_as_float(__builtin_amdgcn_update_dpp(xi, xi, 0x128, 0xF, 0xF, false)); }
DI unsigned xor32u(unsigned x, int lane) { const u32x2 r = __builtin_amdgcn_permlane32_swap(x, x, false, false); return (lane & 32) ? r.x : r.y; }
DI unsigned xor16u(unsigned x, int lane) { const u32x2 r = __builtin_amdgcn_permlane16_swap(x, x, false, false); return (lane & 16) ? r.x : r.y; }
DI float xor32f(float x, int lane) { return __uint_as_float(xor32u(__float_as_uint(x), lane)); }
DI float xor16f(float x, int lane) { return __uint_as_float(xor16u(__float_as_uint(x), lane)); }
DI float wave_sum(float v) {
#pragma unroll
  for (int o = 32; o > 0; o >>= 1) v += __shfl_xor(v, o);
  return v;
}
DI void ld8(const float* pz, float (&v)[8]) { const f32x4 a = *(const f32x4*)pz, b = *(const f32x4*)(pz + 4); v[0] = a.x; v[1] = a.y; v[2] = a.z; v[3] = a.w; v[4] = b.x; v[5] = b.y; v[6] = b.z; v[7] = b.w; }
DI u32x4 pack8(const float (&v)[8]) { u32x4 w; w.x = pack2(v[0], v[1]); w.y = pack2(v[2], v[3]); w.z = pack2(v[4], v[5]); w.w = pack2(v[6], v[7]); return w; }
DI void unpack8(const u32x4 w, float (&v)[8]) { v[0] = bflo(w.x); v[1] = bfhi(w.x); v[2] = bflo(w.y); v[3] = bfhi(w.y); v[4] = bflo(w.z); v[5] = bfhi(w.z); v[6] = bflo(w.w); v[7] = bfhi(w.w); }
DI f32x2 gelu_pk(f32x2 v) {
  const f32x2 av = __builtin_elementwise_abs(v), d = av * 0.2316418882f + 1.0f;
  f32x2 t; t.x = __builtin_amdgcn_rcpf(d.x); t.y = __builtin_amdgcn_rcpf(d.y);
  f32x2 q = t * 0.5307027145f + (-0.7265760135f); q = q * t + 0.7107068705f; q = q * t + (-0.142248368f); q = q * t + 0.127414796f; q = q * t;
  const f32x2 s = (v * v) * (-0.72134752044f);
  f32x2 e; e.x = __builtin_amdgcn_exp2f(s.x); e.y = __builtin_amdgcn_exp2f(s.y);
  const f32x2 m = v * (q * e), r = v - m;
  f32x2 o; o.x = v.x < 0.f ? m.x : r.x; o.y = v.y < 0.f ? m.y : r.y; return o;
}
__host__ __device__ __forceinline__ int dperm(int q) { const int grp = q >> 5, fq = (q >> 3) & 3, j = q & 7; return (j < 4) ? (16 * grp + 4 * fq + j) : (32 + 16 * grp + 4 * fq + (j - 4)); }

template <class F>
DI void tconv_tile(float* tile, int k0, int n0, bf16_t* dst, int ldd, F f) {
  const int tid = otid();
  __syncthreads();
#pragma unroll 4
  for (int i = 0; i < 8; ++i) { const int kl = i * 8 + (tid >> 6), nl = tid & 63; tile[nl * 65 + kl] = f(k0 + kl, n0 + nl); }
  __syncthreads();
  {
    const int nl = tid >> 3, kc = tid & 7;
    const float* t = tile + nl * 65 + kc * 8;
    u32x4 w; w.x = pack2(t[0], t[1]); w.y = pack2(t[2], t[3]); w.z = pack2(t[4], t[5]); w.w = pack2(t[6], t[7]);
    *(u32x4*)(dst + (size_t)(n0 + nl) * ldd + k0 + kc * 8) = w;
  }
}

DI void conv_chunk(const float* src, bf16_t* dst, size_t base) {
  const size_t i = base + (size_t)otid() * 8;
  const f32x4 a = *(const f32x4*)(src + i), b = *(const f32x4*)(src + i + 4);
  u32x4 w; w.x = pack2(a.x, a.y); w.y = pack2(a.z, a.w); w.z = pack2(b.x, b.y); w.w = pack2(b.z, b.w);
  *(u32x4*)(dst + i) = w;
}

DI void sincos_d(double x, double& s, double& c) {
  const double y = x * 0.25, y2 = y * y;
  double sn = y * (1.0 + y2 * (-1.0 / 6 + y2 * (1.0 / 120 + y2 * (-1.0 / 5040 + y2 * (1.0 / 362880 + y2 * (-1.0 / 39916800 + y2 * (1.0 / 6227020800.0)))))));
  double cs = 1.0 + y2 * (-0.5 + y2 * (1.0 / 24 + y2 * (-1.0 / 720 + y2 * (1.0 / 40320 + y2 * (-1.0 / 3628800 + y2 * (1.0 / 479001600.0 + y2 * (-1.0 / 87178291200.0)))))));
#pragma unroll
  for (int i = 0; i < 2; ++i) { const double s2 = 2.0 * sn * cs, c2 = cs * cs - sn * sn; sn = s2; cs = c2; }
  s = sn; c = cs;
}

DI void phase_prep(const Params& p, char* smem) {
  const int tid = otid();
  float* fs = (float*)smem;
  char* ws = p.ws;
  constexpr int nA = 192, nB = 16 * 72, nC = 2 * 8 * 16, nD = 256, nE = 16 * 32, nF = 2 * 32 * 2, nG = 4, nH = 8, nI = 512, nJ = 64, nK = 32, nL = 2048, nM = 2048;
  constexpr int total = nA + nB + nC + nD + nE + nF + nG + nH + nI + nJ + nK + nL + nM;
  for (int item = blockIdx.x; item < total; item += gridDim.x) {
    int it = item;
    if (it < nA) {
      float* sc = fs;
      float* red = fs + 8192;
      __syncthreads();
      for (int i = tid; i < 8192; i += NT) { const float v = p.c[i]; sc[i] = v / (1.0f + __expf(-v)); }
      __syncthreads();
      const int ks = tid >> 5, cj = tid & 31, col = it * 32 + cj;
      float acc[8];
#pragma unroll
      for (int b = 0; b < 8; ++b) acc[b] = 0.f;
#pragma unroll 4
      for (int k = ks * 64; k < ks * 64 + 64; ++k) {
        const float w = p.w_ada[(size_t)k * 6144 + col];
#pragma unroll
        for (int b = 0; b < 8; ++b) acc[b] += sc[b * 1024 + k] * w;
      }
#pragma unroll
      for (int b = 0; b < 8; ++b) red[(ks * 8 + b) * 32 + cj] = acc[b];
      __syncthreads();
      if (tid < 256) {
        const int b = tid >> 5;
        float s = p.b_ada[col];
#pragma unroll
        for (int k2 = 0; k2 < 16; ++k2) s += red[(k2 * 8 + b) * 32 + cj];
        ((float*)(ws + OFF_MOD))[b * 6144 + col] = s;
      }
      continue;
    }
    it -= nA;
    if (it < nB) {
      const int kt = it / 72, ntile = it % 72;
      const float* w_in = p.w_in; const float* w_merge = p.w_merge;
      tconv_tile(fs, kt * 64, ntile * 64, (bf16_t*)(ws + OFF_WT1), 1024, [=](int k, int n) -> float {
        if (n < 1280) {
          const bool roped = (n < 640) || (n >= 768 && n < 896) || (n >= 1024 && n < 1152);
          const int col = roped ? ((n & ~63) + dperm(n & 63)) : n;
          return w_in[(size_t)k * 2328 + col];
        }
        if (n < 2304) return w_in[(size_t)k * 2328 + n + 24];
        if (n < 4352) return w_merge[(size_t)k * 2048 + (n - 2304)];
        if (n < 4376) return w_in[(size_t)k * 2328 + 1280 + (n - 4352)];
        return 0.f; });
      continue;
    }
    it -= nB;
    if (it < nC) {
      const int br = it >> 7, r = it & 127, kt = r >> 4, ntile = r & 15;
      const float* src = p.w_branch + (size_t)br * 512 * 1024;
      tconv_tile(fs, kt * 64, ntile * 64, (bf16_t*)(ws + OFF_WB) + (size_t)br * 1024 * 512, 512, [=](int k, int n) -> float { return src[(size_t)k * 1024 + n]; });
      continue;
    }
    it -= nC;
    if (it < nD) {
      const int kt = it >> 4, ntile = it & 15;
      const float* src = p.w_out;
      tconv_tile(fs, kt * 64, ntile * 64, (bf16_t*)(ws + OFF_WOUT), 1024, [=](int k, int n) -> float { return src[(size_t)k * 1024 + n]; });
      continue;
    }
    it -= nD;
    if (it < nE) {
      const int kt = it >> 5, ntile = it & 31;
      const float* src = p.peer_wq;
      tconv_tile(fs, kt * 64, ntile * 64, (bf16_t*)(ws + OFF_WQ), 1024, [=](int k, int n) -> float { return src[(size_t)k * 2048 + n]; });
      continue;
    }
    it -= nE;
    if (it < nF) {
      const int w = it >> 6, r = it & 63, kt = r >> 1, ntile = r & 1;
      const float* src = p.cmp_w1 + (size_t)w * 2048 * 128;
      tconv_tile(fs, kt * 64, ntile * 64, (bf16_t*)(ws + OFF_CW1) + (size_t)w * 128 * 2048, 2048, [=](int k, int n) -> float {
        const int ksrc = (w == 0) ? ((k & ~63) + dperm(k & 63)) : k;
        return src[(size_t)ksrc * 128 + n]; });
      continue;
    }
    it -= nF;
    if (it < nG) {
      const int w = it >> 1, kt = it & 1;
      const float* src = p.cmp_w2 + (size_t)w * 128 * 64;
      tconv_tile(fs, kt * 64, 0, (bf16_t*)(ws + OFF_CW2) + (size_t)w * 64 * 128, 128, [=](int k, int n) -> float { return src[(size_t)k * 64 + ((w == 0) ? dperm(n) : n)]; });
      continue;
    }
    it -= nG;
    if (it < nH) {
      const int w = it >> 2, jc = it & 3, ks = tid >> 5, cj = tid & 31, j = jc * 32 + cj;
      float* red = fs;
      const float* pos = p.cmp_pos + w * 2048; const float* w1 = p.cmp_w1 + (size_t)w * 2048 * 128;
      float acc = 0.f;
#pragma unroll 4
      for (int k = ks * 128; k < ks * 128 + 128; ++k) acc += pos[k] * w1[(size_t)k * 128 + j];
      __syncthreads();
      red[ks * 32 + cj] = acc;
      __syncthreads();
      if (tid < 32) { float s = p.cmp_b1[w * 128 + j]; for (int k2 = 0; k2 < 16; ++k2) s += red[k2 * 32 + tid]; ((float*)(ws + OFF_POSB))[w * 128 + j] = s; }
      continue;
    }
    it -= nH;
    if (it < nI) {
      const int e = it * 512 + tid, pos = e >> 5, i = e & 31;
      const float ang = (float)pos * p.inv_freq[i];
      const double a = (double)ang;
      const double kk = rint(a * 0.15915494309189535);
      const double r = a - kk * 6.283185307179586476925;
      double s, c; sincos_d(r, s, c);
      ((float*)(ws + OFF_ROPE))[e] = (float)c;
      ((float*)(ws + OFF_ROPE))[262144 + e] = (float)s;
      continue;
    }
    it -= nI;
    if (it < nJ) { conv_chunk(p.peer_keys, (bf16_t*)(ws + OFF_PKEYS), (size_t)it * 4096); continue; }
    it -= nJ;
    if (it < nK) {
      const size_t i0 = (size_t)it * 4096 + (size_t)tid * 8;
      const int rowi = (int)((i0 >> 7) & 127), j0 = (int)(i0 & 127);
      float v[8];
#pragma unroll
      for (int j = 0; j < 8; ++j) v[j] = (j0 + j <= rowi) ? p.sgu_w[i0 + j] : 0.f;
      u32x4 w; w.x = pack2(v[0], v[1]); w.y = pack2(v[2], v[3]); w.z = pack2(v[4], v[5]); w.w = pack2(v[6], v[7]);
      *(u32x4*)((bf16_t*)(ws + OFF_SGUW) + i0) = w;
      continue;
    }
    it -= nK;
    {
      const bool isv = it >= nL;
      if (isv) it -= nL;
      const int lane = tid & 63, e = it * 8 + (tid >> 6);
      const float* src = (isv ? p.peer_v : p.peer_u) + (size_t)e * 1024 + lane * 16;
      float v[16];
#pragma unroll
      for (int i = 0; i < 4; ++i) { const f32x4 t4 = *(const f32x4*)(src + i * 4); v[4 * i] = t4.x; v[4 * i + 1] = t4.y; v[4 * i + 2] = t4.z; v[4 * i + 3] = t4.w; }
      float amax = 0.f;
#pragma unroll
      for (int i = 0; i < 16; ++i) amax = fmaxf(amax, fabsf(v[i]));
#pragma unroll
      for (int o = 32; o > 0; o >>= 1) amax = fmaxf(amax, __shfl_xor(amax, o));
      const unsigned be = (__float_as_uint(amax) >> 23) & 0xffu;
      const bool okr = be >= 16u && be <= 240u;
      const float scale = okr ? __uint_as_float((261u - be) << 23) : 1.0f;
      const float inv = okr ? __uint_as_float((be - 7u) << 23) : 1.0f;
      u32x4 w;
      int t0 = 0, t1 = 0, t2 = 0, t3 = 0;
      t0 = __builtin_amdgcn_cvt_pk_fp8_f32(v[0] * scale, v[1] * scale, t0, false); t0 = __builtin_amdgcn_cvt_pk_fp8_f32(v[2] * scale, v[3] * scale, t0, true);
      t1 = __builtin_amdgcn_cvt_pk_fp8_f32(v[4] * scale, v[5] * scale, t1, false); t1 = __builtin_amdgcn_cvt_pk_fp8_f32(v[6] * scale, v[7] * scale, t1, true);
      t2 = __builtin_amdgcn_cvt_pk_fp8_f32(v[8] * scale, v[9] * scale, t2, false); t2 = __builtin_amdgcn_cvt_pk_fp8_f32(v[10] * scale, v[11] * scale, t2, true);
      t3 = __builtin_amdgcn_cvt_pk_fp8_f32(v[12] * scale, v[13] * scale, t3, false); t3 = __builtin_amdgcn_cvt_pk_fp8_f32(v[14] * scale, v[15] * scale, t3, true);
      w.x = (unsigned)t0; w.y = (unsigned)t1; w.z = (unsigned)t2; w.w = (unsigned)t3;
      if (!isv) {
        *(u32x4*)(ws + OFF_PU8 + ((size_t)(lane >> 3) * 16384 + e) * 128 + (lane & 7) * 16) = w;
        if (lane == 0) ((float*)(ws + OFF_SCU))[e] = inv;
      } else {
        *(u32x4*)(ws + OFF_PV8 + ((size_t)(lane >> 3) * 16384 + e) * 128 + (lane & 7) * 16) = w;
        if (lane == 0) ((float*)(ws + OFF_SCV))[e] = inv;
      }
    }
  }
}

DI void row_stats(const float (&v)[16], float& mean, float& rstd) {
  float s = 0.f;
#pragma unroll
  for (int i = 0; i < 16; ++i) s += v[i];
  mean = wave_sum(s) * (1.0f / 1024.0f);
  float q = 0.f;
#pragma unroll
  for (int i = 0; i < 16; ++i) { const float d = v[i] - mean; q += d * d; }
  rstd = rsqrtf(wave_sum(q) * (1.0f / 1024.0f) + LN_EPS);
}

DI void phase_ln_in(const Params& p) {
  const int lane = otid() & 63, wave = otid() >> 6;
  const float* mod = (const float*)(p.ws + OFF_MOD);
  bf16_t* h = (bf16_t*)(p.ws + OFF_H);
  for (int grp = blockIdx.x; grp < NTOK / NW; grp += gridDim.x) {
    const int row = grp * NW + wave, b = row >> 13;
    const float* xr = p.x + (size_t)row * DM;
    float v[16];
#pragma unroll
    for (int i = 0; i < 4; ++i) { const f32x4 t = *(const f32x4*)(xr + i * 256 + lane * 4); v[4 * i] = t.x; v[4 * i + 1] = t.y; v[4 * i + 2] = t.z; v[4 * i + 3] = t.w; }
    float mean, rstd; row_stats(v, mean, rstd);
#pragma unroll
    for (int i = 0; i < 4; ++i) {
      const int col = i * 256 + lane * 4;
      const f32x4 sh = *(const f32x4*)(mod + b * 6144 + col), sc = *(const f32x4*)(mod + b * 6144 + 1024 + col);
      const float o0 = (v[4 * i] - mean) * rstd * (1.f + sc.x) + sh.x, o1 = (v[4 * i + 1] - mean) * rstd * (1.f + sc.y) + sh.y;
      const float o2 = (v[4 * i + 2] - mean) * rstd * (1.f + sc.z) + sh.z, o3 = (v[4 * i + 3] - mean) * rstd * (1.f + sc.w) + sh.w;
      u32x2 w; w.x = pack2(o0, o1); w.y = pack2(o2, o3);
      *(u32x2*)(h + (size_t)row * DM + col) = w;
    }
  }
}

DI void phase_ln_mid(const Params& p) {
  const int lane = otid() & 63, wave = otid() >> 6;
  const float* mod = (const float*)(p.ws + OFF_MOD);
  const bf16_t* y = (const bf16_t*)(p.ws + OFF_Y);
  bf16_t* x1 = (bf16_t*)(p.ws + OFF_X1);
  bf16_t* h2 = (bf16_t*)(p.ws + OFF_H);
  for (int grp = blockIdx.x; grp < NTOK / NW; grp += gridDim.x) {
    const int row = grp * NW + wave, b = row >> 13;
    const bf16_t* yr = y + (size_t)row * DM;
    float v[16];
#pragma unroll
    for (int i = 0; i < 4; ++i) { const u32x2 t = *(const u32x2*)(yr + i * 256 + lane * 4); v[4 * i] = bflo(t.x); v[4 * i + 1] = bfhi(t.x); v[4 * i + 2] = bflo(t.y); v[4 * i + 3] = bfhi(t.y); }
    float mean, rstd; row_stats(v, mean, rstd);
#pragma unroll
    for (int i = 0; i < 4; ++i) {
      const int col = i * 256 + lane * 4;
      const f32x4 g = *(const f32x4*)(p.ln1_g + col), bb = *(const f32x4*)(p.ln1_b + col);
      f32x4 o;
      o.x = (v[4 * i] - mean) * rstd * g.x + bb.x; o.y = (v[4 * i + 1] - mean) * rstd * g.y + bb.y;
      o.z = (v[4 * i + 2] - mean) * rstd * g.z + bb.z; o.w = (v[4 * i + 3] - mean) * rstd * g.w + bb.w;
      { u32x2 w; w.x = pack2(o.x, o.y); w.y = pack2(o.z, o.w); *(u32x2*)(x1 + (size_t)row * DM + col) = w; }
      v[4 * i] = o.x; v[4 * i + 1] = o.y; v[4 * i + 2] = o.z; v[4 * i + 3] = o.w;
    }
    row_stats(v, mean, rstd);
#pragma unroll
    for (int i = 0; i < 4; ++i) {
      const int col = i * 256 + lane * 4;
      const f32x4 sh = *(const f32x4*)(mod + b * 6144 + 3072 + col), sc = *(const f32x4*)(mod + b * 6144 + 4096 + col);
      const float o0 = (v[4 * i] - mean) * rstd * (1.f + sc.x) + sh.x, o1 = (v[4 * i + 1] - mean) * rstd * (1.f + sc.y) + sh.y;
      const float o2 = (v[4 * i + 2] - mean) * rstd * (1.f + sc.z) + sh.z, o3 = (v[4 * i + 3] - mean) * rstd * (1.f + sc.w) + sh.w;
      u32x2 w; w.x = pack2(o0, o1); w.y = pack2(o2, o3);
      *(u32x2*)(h2 + (size_t)row * DM + col) = w;
    }
  }
}

namespace pg8 {
constexpr int BM = 256, BK = 64, HALF = 128, HTB = HALF * BK * 2, STAGE_BYTES = 8 * HTB, NXCD = 8, WGM = 8;
DI int lds_byte(int r, int c) { const int st = (r >> 4) * 2 + (c >> 5), rr = r & 15, cc = c & 31, ob = rr * 64 + cc * 2; return st * 1024 + (ob ^ (((ob >> 9) & 1) << 5)); }
DI void stage_rc(int b, int& R, int& C) { const int st = b / 1024, sb = b % 1024, swz = sb ^ (((sb >> 9) & 1) << 5); R = (st >> 1) * 16 + swz / 64; C = (st & 1) * 32 + (swz % 64) / 2; }
DI int perm32(int rho) { const int n = rho >> 4, i = rho & 15; return 8 * (i >> 2) + 4 * n + (i & 3); }
struct Unit { int pm, pn; };
struct Gemm { const bf16_t* A; const bf16_t* Bt; int M, N, K; };
struct StaticOrder {
  int nM, nN, nwg, G, c;
  DI void init(int M, int N, int G_, int c_) { nM = M / BM; nN = N / BM; nwg = nM * nN; G = G_; c = c_; }
  DI bool next(int i, Unit& u) const {
    const long L = (long)i * G + c; if (L >= nwg) return false;
    int wgid = (int)L; { const int q = nwg / NXCD, r = nwg % NXCD, xcd = wgid % NXCD, off = wgid / NXCD; wgid = (xcd < r ? xcd * (q + 1) : r * (q + 1) + (xcd - r) * q) + off; }
    const int nig = WGM * nN, gid = wgid / nig, fm = gid * WGM, gsz = (nM - fm) < WGM ? (nM - fm) : WGM;
    u.pm = fm + ((wgid % nig) % gsz); u.pn = (wgid % nig) / gsz; return true;
  }
};

template <class Epi>
DI void gemm_phase(LAS unsigned char* lds, const Gemm g, const StaticOrder& S, const Epi& E) {
  const int tid = otid(), wid = __builtin_amdgcn_readfirstlane(tid >> 6), lane = tid & 63, wr = wid >> 2, wc = wid & 3, fr = lane & 15, fq = lane >> 4;
  const int K = g.K, nt = K / BK;
  unsigned voffA[2], voffB[2];
#pragma unroll
  for (int i = 0; i < 2; ++i) { int R, C; stage_rc(tid * 16 + i * 8192, R, C); const int Rb = Epi::PERM ? ((R & ~31) + perm32(R & 31)) : R;
    voffA[i] = (unsigned)(R * K + C) * 2u; voffB[i] = (unsigned)(Rb * K + C) * 2u; }
  const size_t kstep = (size_t)(BK * 2);
  const size_t hstep = (size_t)HALF * K * 2;
  const size_t tstep = 2 * hstep;
  const unsigned ldsw = (unsigned)wid * 1024u;
  const int aoff = lds_byte(wr * 64 + fr, fq * 8), boff = lds_byte(wc * 32 + fr, fq * 8);
#define PG8_SA(b, h) (((b) * 2 + (h)) * HTB)
#define PG8_SB(b, h) ((4 + (b) * 2 + (h)) * HTB)
#define PG8_STAGE(bufoff, gbase, voff) do { _Pragma("unroll") for (int _i = 0; _i < 2; ++_i) \
    __builtin_amdgcn_global_load_lds((const unsigned*)((const char*)(gbase) + (voff)[_i]), (LAS unsigned*)(lds + (bufoff) + ldsw + _i * 8192), 16, 0, 0); } while (0)
#define PG8_LDA(dst, b, h) do { _Pragma("unroll") for (int m = 0; m < 4; ++m) _Pragma("unroll") for (int k = 0; k < 2; ++k) dst[m][k] = *(const LAS bf16x8*)(lds + PG8_SA(b, h) + aoff + m * 2048 + k * 1024); } while (0)
#define PG8_LDB(dst, b, h) do { _Pragma("unroll") for (int n = 0; n < 2; ++n) _Pragma("unroll") for (int k = 0; k < 2; ++k) dst[n][k] = *(const LAS bf16x8*)(lds + PG8_SB(b, h) + boff + n * 2048 + k * 1024); } while (0)
#define PG8_MMA(ai, bj, At, Bt) do { __builtin_amdgcn_s_setprio(1); _Pragma("unroll") for (int m = 0; m < 4; ++m) _Pragma("unroll") for (int n = 0; n < 2; ++n) _Pragma("unroll") for (int k = 0; k < 2; ++k) \
    acc[ai][bj][m][n] = __builtin_amdgcn_mfma_f32_16x16x32_bf16(Bt[n][k], At[m][k], acc[ai][bj][m][n], 0, 0, 0); __builtin_amdgcn_s_setprio(0); } while (0)
#define PG8_WAIT_V(n) asm volatile("s_waitcnt vmcnt(" #n ")" ::: "memory")
#define PG8_WAIT_L(n) asm volatile("s_waitcnt lgkmcnt(" #n ")" ::: "memory")
#define PG8_BAR __builtin_amdgcn_s_barrier()
#define PG8_SCHED __builtin_amdgcn_sched_barrier(0)
  Unit cur, nxt; int ui = 0;
  if (!S.next(0, cur)) return;
  f32x4 acc[2][2][4][2];
#pragma unroll
  for (int a = 0; a < 2; ++a)
#pragma unroll
    for (int b = 0; b < 2; ++b)
#pragma unroll
      for (int m = 0; m < 4; ++m)
#pragma unroll
        for (int n = 0; n < 2; ++n) acc[a][b][m][n] = (f32x4){0.f, 0.f, 0.f, 0.f};
  bf16x8 At[4][2], B0[2][2], B1[2][2];
  const char* cA = (const char*)g.A + (size_t)cur.pm * tstep; const char* cB = (const char*)g.Bt + (size_t)cur.pn * tstep;
  PG8_STAGE(PG8_SB(0, 0), cB, voffB); PG8_STAGE(PG8_SA(0, 0), cA, voffA); PG8_STAGE(PG8_SB(0, 1), cB + hstep, voffB); PG8_STAGE(PG8_SA(0, 1), cA + hstep, voffA);
  if (wr == 1) PG8_BAR;
  PG8_WAIT_V(4); PG8_BAR;
  PG8_STAGE(PG8_SB(1, 0), cB + kstep, voffB); PG8_STAGE(PG8_SA(1, 0), cA + kstep, voffA); PG8_STAGE(PG8_SB(1, 1), cB + hstep + kstep, voffB);
  PG8_WAIT_V(6); PG8_BAR;
  for (;;) {
    const bool has_next = S.next(ui + 1, nxt);
    const char* nA = has_next ? (const char*)g.A + (size_t)nxt.pm * tstep : cA; const char* nB = has_next ? (const char*)g.Bt + (size_t)nxt.pn * tstep : cB;
    for (int t = 0; t < nt; t += 2) {
      const bool last = (t == nt - 2);
      const char* a1 = cA + (size_t)(t + 1) * kstep;
      const char* a2 = last ? nA : cA + (size_t)(t + 2) * kstep; const char* b2 = last ? nB : cB + (size_t)(t + 2) * kstep;
      const char* a3 = a2 + kstep; const char* b3 = b2 + kstep;
      PG8_LDB(B0, 0, 0); PG8_SCHED; PG8_LDA(At, 0, 0); PG8_STAGE(PG8_SA(1, 1), a1 + hstep, voffA);
      PG8_WAIT_L(8); PG8_BAR; PG8_WAIT_L(0); PG8_MMA(0, 0, At, B0); PG8_BAR; PG8_SCHED;
      PG8_LDB(B1, 0, 1); PG8_STAGE(PG8_SB(0, 0), b2, voffB);
      PG8_BAR; PG8_WAIT_L(0); PG8_MMA(0, 1, At, B1); PG8_BAR;
      PG8_LDA(At, 0, 1); PG8_STAGE(PG8_SA(0, 0), a2, voffA);
      PG8_BAR; PG8_WAIT_L(0); PG8_MMA(1, 0, At, B0); PG8_BAR; PG8_SCHED;
      PG8_STAGE(PG8_SB(0, 1), b2 + hstep, voffB);
      PG8_WAIT_V(6); PG8_BAR; PG8_MMA(1, 1, At, B1); PG8_BAR;
      PG8_LDB(B0, 1, 0); PG8_SCHED; PG8_LDA(At, 1, 0); PG8_STAGE(PG8_SA(0, 1), a2 + hstep, voffA);
      PG8_WAIT_L(8); PG8_BAR; PG8_WAIT_L(0); PG8_MMA(0, 0, At, B0); PG8_BAR; PG8_SCHED;
      PG8_LDB(B1, 1, 1); PG8_STAGE(PG8_SB(1, 0), b3, voffB);
      PG8_BAR; PG8_WAIT_L(0); PG8_MMA(0, 1, At, B1); PG8_BAR;
      PG8_LDA(At, 1, 1); PG8_STAGE(PG8_SA(1, 0), a3, voffA);
      PG8_BAR; PG8_WAIT_L(0); PG8_MMA(1, 0, At, B0); PG8_BAR; PG8_SCHED;
      PG8_STAGE(PG8_SB(1, 1), b3 + hstep, voffB);
      PG8_WAIT_V(6); PG8_BAR; PG8_MMA(1, 1, At, B1); PG8_BAR;
    }
    E(acc, cur, wr, wc, fr, fq);
    if (!has_next) break;
#pragma unroll
    for (int a = 0; a < 2; ++a)
#pragma unroll
      for (int b = 0; b < 2; ++b)
#pragma unroll
        for (int m = 0; m < 4; ++m)
#pragma unroll
          for (int n = 0; n < 2; ++n) acc[a][b][m][n] = (f32x4){0.f, 0.f, 0.f, 0.f};
    cur = nxt; cA = nA; cB = nB; ++ui;
  }
  PG8_WAIT_V(0);
  if (wr == 0) PG8_BAR;
  PG8_BAR;
#undef PG8_SA
#undef PG8_SB
#undef PG8_STAGE
#undef PG8_LDA
#undef PG8_LDB
#undef PG8_MMA
#undef PG8_WAIT_V
#undef PG8_WAIT_L
#undef PG8_BAR
#undef PG8_SCHED
}
}

struct EpiProj {
  static constexpr bool PERM = true;
  char* ws; const float* b_merge;
  DI void operator()(const f32x4 (&acc)[2][2][4][2], const pg8::Unit& u, int wr, int wc, int fr, int fq) const {
    const float* rope = (const float*)(ws + OFF_ROPE);
    const int row0 = u.pm * 256 + wr * 64 + fr;
#pragma unroll
    for (int bj = 0; bj < 2; ++bj) {
      const int cg = u.pn * 256 + bj * 128 + wc * 32;
      const int c0 = cg + 8 * fq;
      if (cg >= 4384) continue;
      if (cg < 1280 && (cg < 640 || (cg >= 768 && cg < 896) || (cg >= 1024 && cg < 1152))) {
        bf16_t* dst; unsigned ld, cofs; float scale = 1.0f;
        if (cg < 512) { dst = (bf16_t*)(ws + OFF_Q); ld = 512; cofs = c0; scale = 0.18033688011112042f; }
        else if (cg < 640) { dst = (bf16_t*)(ws + OFF_KC); ld = 128; cofs = c0 - 512; }
        else if (cg < 896) { dst = (bf16_t*)(ws + OFF_KS); ld = 128; cofs = c0 - 768; }
        else { dst = (bf16_t*)(ws + OFF_KW); ld = 128; cofs = c0 - 1024; }
        const int d0 = 16 * ((cg >> 5) & 1) + 4 * fq;
#pragma unroll
        for (int ai = 0; ai < 2; ++ai)
#pragma unroll
          for (int m = 0; m < 4; ++m) {
            const int row = row0 + ai * 128 + m * 16, pos = row & (SEQ - 1);
            const f32x4 cs = *(const f32x4*)(rope + pos * 32 + d0), sn = *(const f32x4*)(rope + 262144 + pos * 32 + d0);
            const f32x4 t1 = acc[ai][bj][m][0], t2 = acc[ai][bj][m][1];
            const f32x4 o1 = (t1 * cs - t2 * sn) * scale, o2 = (t1 * sn + t2 * cs) * scale;
            u32x4 w; w.x = pack2(o1.x, o1.y); w.y = pack2(o1.z, o1.w); w.z = pack2(o2.x, o2.y); w.w = pack2(o2.z, o2.w);
            *(u32x4*)(dst + (unsigned)row * ld + cofs) = w;
          }
      } else if (cg < 1280) {
        bf16_t* dst; unsigned cofs;
        if (cg < 768) { dst = (bf16_t*)(ws + OFF_VC); cofs = c0 - 640; }
        else if (cg < 1024) { dst = (bf16_t*)(ws + OFF_VS); cofs = c0 - 896; }
        else { dst = (bf16_t*)(ws + OFF_VW); cofs = c0 - 1152; }
#pragma unroll
        for (int ai = 0; ai < 2; ++ai)
#pragma unroll
          for (int m = 0; m < 4; ++m) {
            const int row = row0 + ai * 128 + m * 16;
            const f32x4 a = acc[ai][bj][m][0], b = acc[ai][bj][m][1];
            u32x4 w; w.x = pack2(a.x, a.y); w.y = pack2(a.z, a.w); w.z = pack2(b.x, b.y); w.w = pack2(b.z, b.w);
            *(u32x4*)(dst + (unsigned)row * 128u + cofs) = w;
          }
      } else if (cg < 2304) {
        bf16_t* dst = (bf16_t*)(ws + (cg < 1792 ? OFF_U : OFF_V));
        const unsigned cofs = c0 - (cg < 1792 ? 1280 : 1792);
#pragma unroll
        for (int ai = 0; ai < 2; ++ai)
#pragma unroll
          for (int m = 0; m < 4; ++m) {
            const int row = row0 + ai * 128 + m * 16;
            const f32x4 a = acc[ai][bj][m][0], b = acc[ai][bj][m][1];
            const f32x2 g0 = gelu_pk((f32x2){a.x, a.y}), g1 = gelu_pk((f32x2){a.z, a.w}), g2 = gelu_pk((f32x2){b.x, b.y}), g3 = gelu_pk((f32x2){b.z, b.w});
            u32x4 w; w.x = pack2(g0.x, g0.y); w.y = pack2(g1.x, g1.y); w.z = pack2(g2.x, g2.y); w.w = pack2(g3.x, g3.y);
            *(u32x4*)(dst + (unsigned)row * 512u + cofs) = w;
          }
      } else if (cg < 4352) {
        bf16_t* dst = (bf16_t*)(ws + OFF_GATE);
        const unsigned cofs = c0 - 2304;
        const f32x4 b0 = *(const f32x4*)(b_merge + cofs), b1 = *(const f32x4*)(b_merge + cofs + 4);
#pragma unroll
        for (int ai = 0; ai < 2; ++ai)
#pragma unroll
          for (int m = 0; m < 4; ++m) {
            const int row = row0 + ai * 128 + m * 16;
            const f32x4 a = acc[ai][bj][m][0] + b0, b = acc[ai][bj][m][1] + b1;
            u32x4 w; w.x = pack2(sigmoid_f(a.x), sigmoid_f(a.y)); w.y = pack2(sigmoid_f(a.z), sigmoid_f(a.w));
            w.z = pack2(sigmoid_f(b.x), sigmoid_f(b.y)); w.w = pack2(sigmoid_f(b.z), sigmoid_f(b.w));
            *(u32x4*)(dst + (unsigned)row * 2048u + cofs) = w;
          }
      } else {
        float* gs = (float*)(ws + OFF_GSIG);
        if (fq < 3) {
#pragma unroll
          for (int ai = 0; ai < 2; ++ai)
#pragma unroll
            for (int m = 0; m < 4; ++m) {
              const int row = row0 + ai * 128 + m * 16;
              const f32x4 a = acc[ai][bj][m][0], b = acc[ai][bj][m][1];
              f32x4 o0, o1; o0.x = sigmoid_f(a.x); o0.y = sigmoid_f(a.y); o0.z = sigmoid_f(a.z); o0.w = sigmoid_f(a.w);
              o1.x = sigmoid_f(b.x); o1.y = sigmoid_f(b.y); o1.z = sigmoid_f(b.z); o1.w = sigmoid_f(b.w);
              *(f32x4*)(gs + (unsigned)row * 32u + 8 * fq) = o0; *(f32x4*)(gs + (unsigned)row * 32u + 8 * fq + 4) = o1;
            }
        }
      }
    }
  }
};
DI void phase_gemm1(const Params& p, char* smem) {
  pg8::Gemm g{(const bf16_t*)(p.ws + OFF_H), (const bf16_t*)(p.ws + OFF_WT1), NTOK, N1, 1024};
  pg8::StaticOrder S; S.init(NTOK, N1, gridDim.x, blockIdx.x);
  EpiProj E{p.ws, p.b_merge};
  pg8::gemm_phase((LAS unsigned char*)smem, g, S, E);
}

template <int BR> struct EpiMerge {
  static constexpr bool PERM = true;
  char* ws;
  DI void operator()(const f32x4 (&acc)[2][2][4][2], const pg8::Unit& u, int wr, int wc, int fr, int fq) const {
    const bf16_t* gate = (const bf16_t*)(ws + OFF_GATE);
    bf16_t* merged = (bf16_t*)(ws + OFF_H);
    const int row0 = u.pm * 256 + wr * 64 + fr;
#pragma unroll
    for (int bj = 0; bj < 2; ++bj) {
      const unsigned c0 = u.pn * 256 + bj * 128 + wc * 32 + 8 * fq;
#pragma unroll
      for (int ai = 0; ai < 2; ++ai)
#pragma unroll
        for (int m = 0; m < 4; ++m) {
          const unsigned row = row0 + ai * 128 + m * 16;
          float gg[8]; unpack8(*(const u32x4*)(gate + row * 2048u + BR * 1024 + c0), gg);
          const f32x4 a = acc[ai][bj][m][0], b = acc[ai][bj][m][1];
          float v[8] = {a.x * gg[0], a.y * gg[1], a.z * gg[2], a.w * gg[3], b.x * gg[4], b.y * gg[5], b.z * gg[6], b.w * gg[7]};
          bf16_t* mp = merged + row * 1024u + c0;
          if (BR == 1) {
            float old[8]; unpack8(*(const u32x4*)mp, old);
#pragma unroll
            for (int j = 0; j < 8; ++j) v[j] += old[j];
          }
          *(u32x4*)mp = pack8(v);
        }
    }
  }
};
DI void phase_merge(const Params& p, char* smem) {
  pg8::StaticOrder S; S.init(NTOK, 1024, gridDim.x, blockIdx.x);
  {
    pg8::Gemm g{(const bf16_t*)(p.ws + OFF_ONSA), (const bf16_t*)(p.ws + OFF_WB), NTOK, 1024, 512};
    EpiMerge<0> E{p.ws};
    pg8::gemm_phase((LAS unsigned char*)smem, g, S, E);
  }
  {
    pg8::Gemm g{(const bf16_t*)(p.ws + OFF_U), (const bf16_t*)(p.ws + OFF_WB) + (size_t)1024 * 512, NTOK, 1024, 512};
    EpiMerge<1> E{p.ws};
    pg8::gemm_phase((LAS unsigned char*)smem, g, S, E);
  }
}

struct EpiOut {
  static constexpr bool PERM = true;
  char* ws; const float* x;
  DI void operator()(const f32x4 (&acc)[2][2][4][2], const pg8::Unit& u, int wr, int wc, int fr, int fq) const {
    const float* mod = (const float*)(ws + OFF_MOD);
    bf16_t* y = (bf16_t*)(ws + OFF_Y);
    const int row0 = u.pm * 256 + wr * 64 + fr, b = (u.pm * 256) >> 13;
#pragma unroll
    for (int bj = 0; bj < 2; ++bj) {
      const unsigned c0 = u.pn * 256 + bj * 128 + wc * 32 + 8 * fq;
      const f32x4 g0 = *(const f32x4*)(mod + b * 6144 + 2048 + c0), g1 = *(const f32x4*)(mod + b * 6144 + 2048 + c0 + 4);
#pragma unroll
      for (int ai = 0; ai < 2; ++ai)
#pragma unroll
        for (int m = 0; m < 4; ++m) {
          const unsigned o = (unsigned)(row0 + ai * 128 + m * 16) * 1024u + c0;
          const f32x4 x0 = *(const f32x4*)(x + o), x1v = *(const f32x4*)(x + o + 4);
          const f32x4 v0 = x0 * DN_ALPHA + g0 * acc[ai][bj][m][0], v1 = x1v * DN_ALPHA + g1 * acc[ai][bj][m][1];
          u32x4 w; w.x = pack2(v0.x, v0.y); w.y = pack2(v0.z, v0.w); w.z = pack2(v1.x, v1.y); w.w = pack2(v1.z, v1.w);
          *(u32x4*)(y + o) = w;
        }
    }
  }
};
DI void phase_outproj(const Params& p, char* smem) {
  pg8::Gemm g{(const bf16_t*)(p.ws + OFF_H), (const bf16_t*)(p.ws + OFF_WOUT), NTOK, 1024, 1024};
  pg8::StaticOrder S; S.init(NTOK, 1024, gridDim.x, blockIdx.x);
  EpiOut E{p.ws, p.x};
  pg8::gemm_phase((LAS unsigned char*)smem, g, S, E);
}

struct EpiPq {
  static constexpr bool PERM = true;
  char* ws;
  DI void operator()(const f32x4 (&acc)[2][2][4][2], const pg8::Unit& u, int wr, int wc, int fr, int fq) const {
    bf16_t* pq = (bf16_t*)(ws + OFF_PQ);
    const int row0 = u.pm * 256 + wr * 64 + fr;
#pragma unroll
    for (int bj = 0; bj < 2; ++bj) {
      const unsigned c0 = u.pn * 256 + bj * 128 + wc * 32 + 8 * fq;
#pragma unroll
      for (int ai = 0; ai < 2; ++ai)
#pragma unroll
        for (int m = 0; m < 4; ++m) {
          const f32x4 a = acc[ai][bj][m][0], b = acc[ai][bj][m][1];
          u32x4 w; w.x = pack2(a.x, a.y); w.y = pack2(a.z, a.w); w.z = pack2(b.x, b.y); w.w = pack2(b.z, b.w);
          *(u32x4*)(pq + (unsigned)(row0 + ai * 128 + m * 16) * 2048u + c0) = w;
        }
    }
  }
};
DI void phase_peerq(const Params& p, char* smem) {
  pg8::Gemm g{(const bf16_t*)(p.ws + OFF_H), (const bf16_t*)(p.ws + OFF_WQ), NTOK, 2048, 1024};
  pg8::StaticOrder S; S.init(NTOK, 2048, gridDim.x, blockIdx.x);
  EpiPq E{p.ws};
  pg8::gemm_phase((LAS unsigned char*)smem, g, S, E);
}

DI void phase_sgu(const Params& p, char* smem) {
  char* ws = p.ws;
  const int tid = otid(), lane = tid & 63, wave = tid >> 6, l31 = lane & 31, hh = lane >> 5;
  bf16_t* u = (bf16_t*)(ws + OFF_U);
  const bf16_t* v = (const bf16_t*)(ws + OFF_V);
  const bf16_t* W = (const bf16_t*)(ws + OFF_SGUW);
  float* st = (float*)smem;
  bf16_t* vn = (bf16_t*)(smem + 1024);
  constexpr int LN_ = 72;
  const int dt = wave & 1, it = wave >> 1;
  const int gi = lane >> 4, i16 = lane & 15, tq = i16 >> 2, tp = i16 & 3;
  for (int item = blockIdx.x; item < NTOK / 128; item += gridDim.x) {
    const int t0 = item * 128;
    __syncthreads();
    for (int i = 0; i < 16; ++i) {
      const int t = wave * 16 + i;
      const u32x4 raw = *(const u32x4*)(v + (size_t)(t0 + t) * 512 + lane * 8);
      float f[8]; unpack8(raw, f);
      float s = 0.f;
#pragma unroll
      for (int j = 0; j < 8; ++j) s += f[j];
      const float mean = wave_sum(s) * (1.f / 512.f);
      float q = 0.f;
#pragma unroll
      for (int j = 0; j < 8; ++j) { const float d = f[j] - mean; q += d * d; }
      const float rstd = rsqrtf(wave_sum(q) * (1.f / 512.f) + LN_EPS);
      if (lane == 0) { st[t * 2] = mean; st[t * 2 + 1] = rstd; }
    }
    u32x4 vnext[2];
#pragma unroll
    for (int i = 0; i < 2; ++i) { const int idx = tid + i * NT; vnext[i] = *(const u32x4*)(v + (size_t)(t0 + (idx >> 3)) * 512 + (idx & 7) * 8); }
    for (int g = 0; g < 8; ++g) {
      u32x4 vcur[2] = {vnext[0], vnext[1]};
      if (g + 1 < 8) {
#pragma unroll
        for (int i = 0; i < 2; ++i) { const int idx = tid + i * NT; vnext[i] = *(const u32x4*)(v + (size_t)(t0 + (idx >> 3)) * 512 + (g + 1) * 64 + (idx & 7) * 8); }
      }
      u32x2 uold[4];
      {
        const bf16_t* urow0 = u + (size_t)(t0 + it * 32 + l31) * 512 + g * 64 + dt * 32 + 4 * hh;
#pragma unroll
        for (int q4 = 0; q4 < 4; ++q4) uold[q4] = *(const u32x2*)(urow0 + 8 * q4);
      }
      lds_barrier();
#pragma unroll
      for (int i = 0; i < 2; ++i) {
        const int idx = tid + i * NT, j = idx >> 3, dc = (idx & 7) * 8;
        const u32x4 raw = vcur[i];
        const float mean = st[j * 2], rstd = st[j * 2 + 1];
        float f[8], gg[8], bb[8]; unpack8(raw, f); ld8(p.sgu_ln_g + g * 64 + dc, gg); ld8(p.sgu_ln_b + g * 64 + dc, bb);
#pragma unroll
        for (int k = 0; k < 8; ++k) f[k] = (f[k] - mean) * rstd * gg[k] + bb[k];
        *(u32x4*)(vn + j * LN_ + dc) = pack8(f);
      }
      lds_barrier();
      f32x16 acc;
#pragma unroll
      for (int r = 0; r < 16; ++r) acc[r] = 0.f;
      const bf16_t* wrow = W + ((size_t)g * 128 + it * 32 + l31) * 128 + hh * 8;
      const LAS bf16_t* vbase = (const LAS bf16_t*)vn + (8 * (gi >> 1) + tq) * LN_ + dt * 32 + 16 * (gi & 1) + 4 * tp;
#pragma unroll
      for (int ks = 0; ks < 8; ++ks) {
        if (ks <= 2 * it + 1) {
          const LAS bf16_t* vp = vbase + (ks * 16) * LN_;
          const s16x4 lo = __builtin_amdgcn_ds_read_tr16_b64_v4i16((LAS s16x4*)vp);
          const s16x4 hi = __builtin_amdgcn_ds_read_tr16_b64_v4i16((LAS s16x4*)(vp + 4 * LN_));
          const bf16x8 bw = *(const bf16x8*)(wrow + ks * 16);
          acc = MFMA32(__builtin_shufflevector(lo, hi, 0, 1, 2, 3, 4, 5, 6, 7), bw, acc);
        }
      }
      const int i = it * 32 + l31;
      const float bsv = p.sgu_b[g * 128 + i];
      bf16_t* urow = u + (size_t)(t0 + i) * 512 + g * 64 + dt * 32 + 4 * hh;
#pragma unroll
      for (int q4 = 0; q4 < 4; ++q4) {
        u32x2* up = (u32x2*)(urow + 8 * q4);
        const u32x2 old = uold[q4];
        u32x2 wv; wv.x = pack2(bflo(old.x) * (acc[4 * q4] + bsv), bfhi(old.x) * (acc[4 * q4 + 1] + bsv));
        wv.y = pack2(bflo(old.y) * (acc[4 * q4 + 2] + bsv), bfhi(old.y) * (acc[4 * q4 + 3] + bsv));
        *up = wv;
      }
    }
  }
}

DI void phase_compress(const Params& p, char* smem) {
  char* ws = p.ws;
  const int tid = otid(), lane = tid & 63, wave = tid >> 6, l31 = lane & 31, hh = lane >> 5;
  bf16_t* hid = (bf16_t*)smem;
  constexpr int LH = 136;
  for (int item = blockIdx.x; item < 128; item += gridDim.x) {
    const int w = item >> 6, R0 = (item & 63) * 128;
    const bf16_t* src = (const bf16_t*)(ws + (w == 0 ? OFF_KC : OFF_VC));
    const bf16_t* W1 = (const bf16_t*)(ws + OFF_CW1) + (size_t)w * 128 * 2048;
    const bf16_t* W2 = (const bf16_t*)(ws + OFF_CW2) + (size_t)w * 64 * 128;
    const float* posb = (const float*)(ws + OFF_POSB) + w * 128;
    const int rg = wave >> 2, cgp = wave & 3;
    const bf16_t* abase[2];
#pragma unroll
    for (int mi = 0; mi < 2; ++mi) {
      const int R = R0 + rg * 64 + mi * 32 + l31, bg = R >> 9, n = R & 511, nn = n < 510 ? n : 510;
      abase[mi] = src + ((size_t)((bg >> 1) * SEQ + 16 * nn)) * 128 + (bg & 1) * 64 + hh * 8;
    }
    const bf16_t* bbase = W1 + (size_t)(cgp * 32 + l31) * 2048 + hh * 8;
    f32x16 acc[2];
#pragma unroll
    for (int r = 0; r < 16; ++r) { acc[0][r] = 0.f; acc[1][r] = 0.f; }
#pragma unroll 8
    for (int ks = 0; ks < 128; ++ks) {
      const int aofs = (ks >> 2) * 128 + (ks & 3) * 16;
      const bf16x8 a0 = *(const bf16x8*)(abase[0] + aofs), a1 = *(const bf16x8*)(abase[1] + aofs);
      const bf16x8 bb = *(const bf16x8*)(bbase + ks * 16);
      acc[0] = MFMA32(a0, bb, acc[0]); acc[1] = MFMA32(a1, bb, acc[1]);
    }
    __syncthreads();
    {
      const float pb = posb[cgp * 32 + l31];
#pragma unroll
      for (int mi = 0; mi < 2; ++mi)
#pragma unroll
        for (int r = 0; r < 16; ++r) {
          const int row = rg * 64 + mi * 32 + (r & 3) + 8 * (r >> 2) + 4 * hh;
          hid[row * LH + cgp * 32 + l31] = f2bf(gelu_f(acc[mi][r] + pb));
        }
    }
    __syncthreads();
    const int mi2 = wave >> 1, ni = wave & 1;
    f32x16 o;
#pragma unroll
    for (int r = 0; r < 16; ++r) o[r] = 0.f;
#pragma unroll
    for (int ks = 0; ks < 8; ++ks) {
      const bf16x8 a = *(const bf16x8*)(hid + (mi2 * 32 + l31) * LH + ks * 16 + hh * 8);
      const bf16x8 bb = *(const bf16x8*)(W2 + (size_t)(ni * 32 + l31) * 128 + ks * 16 + hh * 8);
      o = MFMA32(a, bb, o);
    }
    const int d = ni * 32 + l31;
    const float b2 = p.cmp_b2[w * 64 + (w == 0 ? dperm(d) : d)];
    const int bg = R0 >> 9;
    bf16_t* dst = (bf16_t*)(ws + (w == 0 ? OFF_KCMP : OFF_VCMP));
#pragma unroll
    for (int r = 0; r < 16; ++r) {
      const int n = (R0 & 511) + mi2 * 32 + (r & 3) + 8 * (r >> 2) + 4 * hh;
      dst[((size_t)bg * 512 + n) * 64 + d] = f2bf(n < 511 ? o[r] + b2 : 0.f);
    }
  }
}

constexpr int LK = 72;
constexpr int NSA_TILE = 18432;
constexpr int NSA_AIMP = 3 * NSA_TILE, NSA_CIMP = NSA_AIMP + 32768, NSA_SELM = NSA_CIMP + 32768;
constexpr float NSA_THR = 6.0f;
struct TileRegs { u32x4 k; u32x4 v; };

DI void nsa_load_tile(TileRegs& t, const bf16_t* kbase, size_t kstride, const bf16_t* vbase, size_t vstride) {
  const int tid = otid(), r = tid >> 3, ch = tid & 7;
  t.k = *(const u32x4*)(kbase + (size_t)r * kstride + ch * 8);
  t.v = *(const u32x4*)(vbase + (size_t)r * vstride + ch * 8);
}
DI void nsa_store_tile(const TileRegs& t, char* tile) {
  const int tid = otid(), r = tid >> 3, ch = tid & 7;
  *(u32x4*)((bf16_t*)tile + r * LK + ch * 8) = t.k;
  *(u32x4*)((bf16_t*)(tile + 9216) + r * LK + ch * 8) = t.v;
}
DI void nsa_scores(f32x16 (&st)[2], const char* tile, const bf16x8 (&qf)[4], int lane) {
  const bf16_t* Ks = (const bf16_t*)tile;
#pragma unroll
  for (int kt = 0; kt < 2; ++kt)
#pragma unroll
    for (int r = 0; r < 16; ++r) st[kt][r] = 0.f;
  __builtin_amdgcn_s_setprio(1);
#pragma unroll
  for (int ks = 0; ks < 4; ++ks)
#pragma unroll
    for (int kt = 0; kt < 2; ++kt) {
      const bf16x8 a = *(const bf16x8*)(Ks + (kt * 32 + (lane & 31)) * LK + ks * 16 + (lane >> 5) * 8);
      st[kt] = MFMA32(a, qf[ks], st[kt]);
    }
  __builtin_amdgcn_s_setprio(0);
}
DI void nsa_pv(f32x16 (&o)[2], const f32x16 (&pt)[2], const char* tile, int lane) {
  const int gi = lane >> 4, i16 = lane & 15, q = i16 >> 2, pp = i16 & 3;
  const LAS bf16_t* Vs = (const LAS bf16_t*)(tile + 9216) + (4 * (gi >> 1) + q) * LK + 16 * (gi & 1) + 4 * pp;
#pragma unroll
  for (int kt = 0; kt < 2; ++kt)
#pragma unroll
    for (int s = 0; s < 2; ++s) {
      u32x4 pk; pk.x = pack2(pt[kt][8 * s], pt[kt][8 * s + 1]); pk.y = pack2(pt[kt][8 * s + 2], pt[kt][8 * s + 3]);
      pk.z = pack2(pt[kt][8 * s + 4], pt[kt][8 * s + 5]); pk.w = pack2(pt[kt][8 * s + 6], pt[kt][8 * s + 7]);
      const bf16x8 pb = __builtin_bit_cast(bf16x8, pk);
      bf16x8 a[2];
#pragma unroll
      for (int dt = 0; dt < 2; ++dt) {
        const LAS bf16_t* vp = Vs + (kt * 32 + 16 * s) * LK + dt * 32;
        const s16x4 lo = __builtin_amdgcn_ds_read_tr16_b64_v4i16((LAS s16x4*)vp);
        const s16x4 hi = __builtin_amdgcn_ds_read_tr16_b64_v4i16((LAS s16x4*)(vp + 8 * LK));
        a[dt] = __builtin_shufflevector(lo, hi, 0, 1, 2, 3, 4, 5, 6, 7);
      }
      o[0] = MFMA32(a[0], pb, o[0]); o[1] = MFMA32(a[1], pb, o[1]);
    }
}

constexpr float NSA_NEG = -3.0e38f;
DI void nsa_online(f32x16 (&st)[2], bool sel, float& m, float& l, f32x16 (&o)[2], const char* tile, int lane) {
  float mx = NSA_NEG;
#pragma unroll
  for (int r = 0; r < 16; ++r) mx = fmaxf(mx, fmaxf(st[0][r], st[1][r]));
  mx = fmaxf(mx, xor32f(mx, lane));
  mx = sel ? mx : NSA_NEG;
  if (__any(mx > m + NSA_THR)) {
    const float mn = fmaxf(m, mx);
    const float alpha = __builtin_amdgcn_exp2f(m - mn);
    m = mn; l *= alpha;
#pragma unroll
    for (int r = 0; r < 16; ++r) { o[0][r] *= alpha; o[1][r] *= alpha; }
  }
  const float ms = sel ? m : 1e30f;
  float sum = 0.f;
#pragma unroll
  for (int r = 0; r < 16; ++r) {
    const float p0 = __builtin_amdgcn_exp2f(st[0][r] - ms), p1 = __builtin_amdgcn_exp2f(st[1][r] - ms);
    st[0][r] = p0; st[1][r] = p1; sum += p0 + p1;
  }
  l += sum;
  nsa_pv(o, st, tile, lane);
}

struct NsaItem { int qb, b, g, bg, t; size_t tokrow; };
DI NsaItem nsa_item(int item0, int wave, int qi) {
  const int G = gridDim.x, k = item0 / G, bb = item0 - k * G;
  const int item = (k & 1) ? (k * G + (G - 1 - bb)) : item0;
  NsaItem it; it.qb = 127 - (item >> 4); const int rest = item & 15; it.b = rest >> 1; it.g = rest & 1;
  it.bg = it.b * 2 + it.g; it.t = it.qb * 64 + wave * 8 + qi; it.tokrow = (size_t)it.b * SEQ + it.t; return it;
}
DI void nsa_accum_store(bf16_t* dst, const f32x16 (&o)[2], float sc, bool first, int hh) {
#pragma unroll
  for (int dt = 0; dt < 2; ++dt)
#pragma unroll
    for (int q4 = 0; q4 < 4; ++q4) {
      u32x2* pp = (u32x2*)(dst + dt * 32 + 8 * q4 + 4 * hh);
      float a0 = sc * o[dt][4 * q4], a1 = sc * o[dt][4 * q4 + 1], a2 = sc * o[dt][4 * q4 + 2], a3 = sc * o[dt][4 * q4 + 3];
      if (!first) { const u32x2 old = *pp; a0 += bflo(old.x); a1 += bfhi(old.x); a2 += bflo(old.y); a3 += bfhi(old.y); }
      u32x2 wv; wv.x = pack2(a0, a1); wv.y = pack2(a2, a3);
      *pp = wv;
    }
}

constexpr int NSA_STAGE = 4 * 18432;
typedef float f32x4v __attribute__((ext_vector_type(4)));
#define MFMA16(a, b, c) __builtin_amdgcn_mfma_f32_16x16x32_bf16((a), (b), (c), 0, 0, 0)
struct StageRegs { u32x4 r[8]; };
DI void nsa_load_stage(StageRegs& sr, const bf16_t* kb, const bf16_t* vb, int j0s, int qb) {
  const int tid = otid(), r = tid >> 3, ch = tid & 7;
#pragma unroll
  for (int tt = 0; tt < 4; ++tt) {
    const int j = (j0s + tt <= qb) ? j0s + tt : qb;
    sr.r[2 * tt] = *(const u32x4*)(kb + ((size_t)j * 64 + r) * 128 + ch * 8);
    sr.r[2 * tt + 1] = *(const u32x4*)(vb + ((size_t)j * 64 + r) * 128 + ch * 8);
  }
}
DI void nsa_store_stage(const StageRegs& sr, char* stage) {
  const int tid = otid(), r = tid >> 3, ch = tid & 7;
#pragma unroll
  for (int tt = 0; tt < 4; ++tt) {
    *(u32x4*)((bf16_t*)(stage + tt * 18432) + r * LK + ch * 8) = sr.r[2 * tt];
    *(u32x4*)((bf16_t*)(stage + tt * 18432 + 9216) + r * LK + ch * 8) = sr.r[2 * tt + 1];
  }
}
struct Sel16 { float m, l; bool has; f32x4v o[4]; };
DI void nsa_unit16(Sel16& g, const char* tile, const bf16x8 (&qf)[2], bool sel, int klim  , int lane) {
  const int c16 = lane & 15, kg = lane >> 4, tq = c16 >> 2, tp = c16 & 3;
  const bf16_t* Ks = (const bf16_t*)tile + c16 * LK + kg * 8;
  f32x4v st[4];
  const float ini = sel ? -g.m : -1e30f;
#pragma unroll
  for (int kt = 0; kt < 4; ++kt) {
    st[kt] = (f32x4v){ini, ini, ini, ini};
#pragma unroll
    for (int ks = 0; ks < 2; ++ks) st[kt] = MFMA16(*(const bf16x8*)(Ks + kt * 16 * LK + ks * 32), qf[ks], st[kt]);
  }
  if (klim < 64) {
#pragma unroll
    for (int kt = 0; kt < 4; ++kt)
#pragma unroll
      for (int r = 0; r < 4; ++r) st[kt][r] = (kt * 16 + 4 * kg + r <= klim) ? st[kt][r] : NSA_NEG;
  }
  float mx = fmaxf(fmaxf(fmaxf(st[0][0], st[0][1]), fmaxf(st[0][2], st[0][3])), fmaxf(fmaxf(st[1][0], st[1][1]), fmaxf(st[1][2], st[1][3])));
  mx = fmaxf(mx, fmaxf(fmaxf(fmaxf(st[2][0], st[2][1]), fmaxf(st[2][2], st[2][3])), fmaxf(fmaxf(st[3][0], st[3][1]), fmaxf(st[3][2], st[3][3]))));
  mx = fmaxf(mx, xor16f(mx, lane));
  mx = fmaxf(mx, xor32f(mx, lane));
  const bool real = mx > -1e29f;
  const bool fresh = !g.has && real, up = g.has && (mx > NSA_THR);
  if (__any(fresh || up)) {
    const float delta = (fresh || up) ? mx : 0.f;
    const float alpha = up ? __builtin_amdgcn_exp2f(-delta) : 1.0f;
    g.m += delta; g.l *= alpha;
#pragma unroll
    for (int dt = 0; dt < 4; ++dt) g.o[dt] *= alpha;
#pragma unroll
    for (int kt = 0; kt < 4; ++kt) st[kt] -= delta;
  }
  g.has = g.has || real;
  float sum = 0.f;
#pragma unroll
  for (int kt = 0; kt < 4; ++kt)
#pragma unroll
    for (int r = 0; r < 4; ++r) { const float pv = __builtin_amdgcn_exp2f(st[kt][r]); st[kt][r] = pv; sum += pv; }
  g.l += sum;
  const LAS bf16_t* Vs = (const LAS bf16_t*)(tile + 9216) + (4 * kg + tq) * LK + 4 * tp;
#pragma unroll
  for (int kp = 0; kp < 2; ++kp) {
    u32x4 pk; pk.x = pack2(st[2 * kp][0], st[2 * kp][1]); pk.y = pack2(st[2 * kp][2], st[2 * kp][3]);
    pk.z = pack2(st[2 * kp + 1][0], st[2 * kp + 1][1]); pk.w = pack2(st[2 * kp + 1][2], st[2 * kp + 1][3]);
    const bf16x8 pb = __builtin_bit_cast(bf16x8, pk);
#pragma unroll
    for (int dt = 0; dt < 4; ++dt) {
      const LAS bf16_t* vp = Vs + (2 * kp) * 16 * LK + dt * 16;
      const s16x4 lo = __builtin_amdgcn_ds_read_tr16_b64_v4i16((LAS s16x4*)vp);
      const s16x4 hi = __builtin_amdgcn_ds_read_tr16_b64_v4i16((LAS s16x4*)(vp + 16 * LK));
      g.o[dt] = MFMA16(__builtin_shufflevector(lo, hi, 0, 1, 2, 3, 4, 5, 6, 7), pb, g.o[dt]);
    }
  }
}
DI void nsa_sel16(const Params& p, char* smem, bool dry) {
  char* ws = p.ws;
  const int tid = otid(), lane = tid & 63, wave = tid >> 6, c16 = lane & 15, kg = lane >> 4, qi4 = c16 >> 2, r4 = c16 & 3;
  const bf16_t* Q = (const bf16_t*)(ws + OFF_Q);
  const float* gsig = (const float*)(ws + OFF_GSIG);
  bf16_t* ONSA = (bf16_t*)(ws + OFF_ONSA);
  const u32x4* SELG = (const u32x4*)(ws + OFF_SELG);
  const bf16_t* KS = (const bf16_t*)(ws + OFF_KS); const bf16_t* VS = (const bf16_t*)(ws + OFF_VS);
  constexpr int NITEM = NB * 2 * 128;
  for (int item = blockIdx.x; item < NITEM; item += gridDim.x) {
    const NsaItem it = nsa_item(item, wave, 0);
    const int qb = it.qb;
    bf16x8 qf[2][2]; u32x4 selw[2]; float g_s[2]; int tg[2]; Sel16 G[2];
#pragma unroll
    for (int gq = 0; gq < 2; ++gq) {
      tg[gq] = it.t + 4 * gq + qi4;
      const size_t tokrow = (size_t)it.b * SEQ + tg[gq];
#pragma unroll
      for (int ks = 0; ks < 2; ++ks) qf[gq][ks] = *(const bf16x8*)(Q + tokrow * 512 + (it.g * 4 + r4) * 64 + ks * 32 + kg * 8);
      selw[gq] = SELG[(size_t)it.bg * SEQ + tg[gq]];
      g_s[gq] = gsig[tokrow * 32 + (it.g * 4 + r4) * 3 + 1];
      G[gq].m = 0.f; G[gq].l = 0.f; G[gq].has = false;
#pragma unroll
      for (int dt = 0; dt < 4; ++dt) G[gq].o[dt] = (f32x4v){0.f, 0.f, 0.f, 0.f};
    }
    const bf16_t* kb = KS + (size_t)it.b * SEQ * 128 + it.g * 64;
    const bf16_t* vb = VS + (size_t)it.b * SEQ * 128 + it.g * 64;
    const int nst = (qb >> 2) + 1;
    StageRegs sr;
    lds_barrier();
    nsa_load_stage(sr, kb, vb, 0, qb);
    nsa_store_stage(sr, smem);
    lds_barrier();
    for (int sidx = 0; sidx < nst; ++sidx) {
      const char* stage = smem + (sidx & 1) * NSA_STAGE;
      if (sidx + 1 < nst) nsa_load_stage(sr, kb, vb, 4 * (sidx + 1), qb);
#pragma unroll 1
      for (int tt = 0; tt < 4; ++tt) {
        const int j = 4 * sidx + tt;
        if (j > qb) break;
#pragma unroll
        for (int gq = 0; gq < 2; ++gq) {
          const unsigned w = j < 32 ? selw[gq].x : (j < 64 ? selw[gq].y : (j < 96 ? selw[gq].z : selw[gq].w));
          const bool sel = (w >> (j & 31)) & 1u;
          if (__any(sel)) nsa_unit16(G[gq], stage + tt * 18432, qf[gq], sel, (j == qb) ? (tg[gq] - j * 64) : 1000, lane);
        }
      }
      if (sidx + 1 < nst) nsa_store_stage(sr, smem + ((sidx + 1) & 1) * NSA_STAGE);
      lds_barrier();
    }
#pragma unroll
    for (int gq = 0; gq < 2; ++gq) {
      float l = G[gq].l;
      l += xor16f(l, lane); l += xor32f(l, lane);
      const float sc = l > 0.f ? g_s[gq] / l : 0.f;
      bf16_t* dst = ONSA + ((size_t)it.b * SEQ + tg[gq]) * 512 + (it.g * 4 + r4) * 64 + 4 * kg;
      if (!dry) {
#pragma unroll
        for (int dt = 0; dt < 4; ++dt) {
          u32x2* pp = (u32x2*)(dst + dt * 16);
          const u32x2 old = *pp;
          u32x2 wv; wv.x = pack2(bflo(old.x) + sc * G[gq].o[dt][0], bfhi(old.x) + sc * G[gq].o[dt][1]);
          wv.y = pack2(bflo(old.y) + sc * G[gq].o[dt][2], bfhi(old.y) + sc * G[gq].o[dt][3]);
          *pp = wv;
        }
      } else asm volatile("" :: "v"(G[gq].o[0]), "v"(G[gq].o[1]), "v"(G[gq].o[2]), "v"(G[gq].o[3]), "v"(l));
    }
  }
}

DI void phase_nsa(const Params& p, char* smem, int branch_mask) {
  char* ws = p.ws;
  const int tid = otid(), lane = tid & 63, wave = tid >> 6, hh = lane >> 5, c = lane & 31, qi = c >> 2, r4 = c & 3;
  const bf16_t* Q = (const bf16_t*)(ws + OFF_Q);
  const float* gsig = (const float*)(ws + OFF_GSIG);
  bf16_t* ONSA = (bf16_t*)(ws + OFF_ONSA);
  u32x4* SELG = (u32x4*)(ws + OFF_SELG);
  constexpr int NITEM = NB * 2 * 128;

#pragma unroll 1
  for (int rep1 = 0; rep1 < ((PROBE_DUP & 4096) ? 2 : 1); ++rep1) {
    const bf16_t* KCMP = (const bf16_t*)(ws + OFF_KCMP); const bf16_t* VCMP = (const bf16_t*)(ws + OFF_VCMP);
    float* Aimp = (float*)(smem + NSA_AIMP) + wave * 1024;
    float* Cimp = (float*)(smem + NSA_CIMP) + wave * 1024;
    unsigned short* selm16 = (unsigned short*)(smem + NSA_SELM) + wave * 64;
    const u32x4* selm128 = (const u32x4*)(smem + NSA_SELM) + wave * 8;
    for (int item = blockIdx.x; item < NITEM; item += gridDim.x) {
      const NsaItem it = nsa_item(item, wave, qi);
      const int t = it.t;
      bf16x8 qf[4];
#pragma unroll
      for (int ks = 0; ks < 4; ++ks) qf[ks] = *(const bf16x8*)(Q + it.tokrow * 512 + (it.g * 4 + r4) * 64 + ks * 16 + hh * 8);
      const float g_c = gsig[it.tokrow * 32 + (it.g * 4 + r4) * 3 + 0];
      TileRegs tr;
      const int nmax = (it.qb * 64 + 63 - 31) >> 4, ntile = (nmax >> 6) + 1;
      const int nfull = (it.qb * 64 - 31) >> 4;
      const bf16_t* kb = KCMP + (size_t)it.bg * 512 * 64;
      const bf16_t* vb = VCMP + (size_t)it.bg * 512 * 64;
      float m = -1e30f, l = 0.f;
      nsa_load_tile(tr, kb, 64, vb, 64);
      nsa_store_tile(tr, smem);
      __syncthreads();
      for (int j = 0; j < ntile; ++j) {
        const char* tile = smem + (j & 1) * NSA_TILE;
        if (j + 1 < ntile) nsa_load_tile(tr, kb + (size_t)(j + 1) * 64 * 64, 64, vb + (size_t)(j + 1) * 64 * 64, 64);
        f32x16 st[2];
        nsa_scores(st, tile, qf, lane);
        const bool full = (j * 64 + 63 <= nfull);
        const int nlim = full ? 100000 : ((t - 31) >> 4) - j * 64 - 4 * hh;
        float mx = NSA_NEG;
#pragma unroll
        for (int kt = 0; kt < 2; ++kt)
#pragma unroll
          for (int r = 0; r < 16; ++r) {
            st[kt][r] = (kt * 32 + (r & 3) + 8 * (r >> 2) <= nlim) ? st[kt][r] : NSA_NEG;
            mx = fmaxf(mx, st[kt][r]);
          }
        mx = fmaxf(mx, xor32f(mx, lane));
        const float mn = fmaxf(m, mx);
        float sum = 0.f;
#pragma unroll
        for (int kt = 0; kt < 2; ++kt)
#pragma unroll
          for (int r = 0; r < 16; ++r) sum += __builtin_amdgcn_exp2f(st[kt][r] - mn);
        l = l * __builtin_amdgcn_exp2f(m - mn) + sum;
        m = mn;
        if (j + 1 < ntile) nsa_store_tile(tr, smem + ((j + 1) & 1) * NSA_TILE);
        __syncthreads();
      }
      l += xor32f(l, lane);
      const float inv_l = l > 0.f ? 1.0f / l : 0.f;
      f32x16 o[2];
#pragma unroll
      for (int r = 0; r < 16; ++r) { o[0][r] = 0.f; o[1][r] = 0.f; }
      nsa_load_tile(tr, kb, 64, vb, 64);
      nsa_store_tile(tr, smem);
      __syncthreads();
      for (int j = 0; j < ntile; ++j) {
        const char* tile = smem + (j & 1) * NSA_TILE;
        if (j + 1 < ntile) nsa_load_tile(tr, kb + (size_t)(j + 1) * 64 * 64, 64, vb + (size_t)(j + 1) * 64 * 64, 64);
        f32x16 st[2];
        nsa_scores(st, tile, qf, lane);
        const bool full = (j * 64 + 63 <= nfull);
        const int nlim = full ? 100000 : ((t - 31) >> 4) - j * 64 - 4 * hh;
#pragma unroll
        for (int kt = 0; kt < 2; ++kt)
#pragma unroll
          for (int r = 0; r < 16; ++r) {
            const float arg = (kt * 32 + (r & 3) + 8 * (r >> 2) <= nlim) ? st[kt][r] - m : NSA_NEG;
            st[kt][r] = __builtin_amdgcn_exp2f(arg) * inv_l;
          }
#pragma unroll
        for (int kt = 0; kt < 2; ++kt)
#pragma unroll
          for (int c4 = 0; c4 < 4; ++c4) {
            float carry = 0.5f * st[kt][4 * c4 + 3];
            float fullv = st[kt][4 * c4] + st[kt][4 * c4 + 1] + st[kt][4 * c4 + 2] + carry;
            fullv += xor1f(fullv); fullv += xor2f(fullv);
            carry += xor1f(carry); carry += xor2f(carry);
            const int jb = j * 16 + kt * 8 + 2 * c4 + hh;
            if (r4 == 0) { Aimp[qi * 128 + jb] = fullv; Cimp[qi * 128 + jb] = carry; }
          }
        if (branch_mask & 1) nsa_pv(o, st, tile, lane);
        if (j + 1 < ntile) nsa_store_tile(tr, smem + ((j + 1) & 1) * NSA_TILE);
        __syncthreads();
      }
      nsa_accum_store(ONSA + it.tokrow * 512 + (it.g * 4 + r4) * 64, o, (branch_mask & 1) ? g_c : 0.f, true, hh);
      const int cur = it.qb;
      if (cur <= 15) {
        if (lane < 8) { selm16[lane * 8 + 0] = (unsigned short)((2u << cur) - 1u);
#pragma unroll
          for (int k = 1; k < 8; ++k) selm16[lane * 8 + k] = 0; }
      } else {
        const int qs = lane >> 3, sub = lane & 7;
        float v[16];
#pragma unroll
        for (int i = 0; i < 16; ++i) {
          const int jj = sub * 16 + i;
          const bool ok = (jj >= 1) && (jj <= cur - 2);
          const int jm = jj >= 1 ? jj - 1 : 0;
          v[i] = ok ? (Aimp[qs * 128 + jj] + Cimp[qs * 128 + jm]) : -3e38f;
        }
        unsigned bits = 0;
        for (int itn = 0; itn < 13; ++itn) {
          float bv = v[0]; int bi = 0;
#pragma unroll
          for (int i = 1; i < 16; ++i) if (v[i] > bv) { bv = v[i]; bi = i; }
          int bj = sub * 16 + bi;
#pragma unroll
          for (int o2 = 1; o2 < 8; o2 <<= 1) {
            const float ov = __shfl_xor(bv, o2); const int oj = __shfl_xor(bj, o2);
            if (ov > bv || (ov == bv && oj < bj)) { bv = ov; bj = oj; }
          }
          if ((bj >> 4) == sub) {
            const int i2 = bj & 15;
#pragma unroll
            for (int i = 0; i < 16; ++i) if (i == i2) v[i] = -3e38f;
            bits |= 1u << i2;
          }
        }
        if (sub == 0) bits |= 1u;
        if ((cur >> 4) == sub) bits |= 1u << (cur & 15);
        if (((cur - 1) >> 4) == sub) bits |= 1u << ((cur - 1) & 15);
        selm16[qs * 8 + sub] = (unsigned short)bits;
      }
      __syncthreads();
      if (r4 == 0 && hh == 0) SELG[(size_t)it.bg * SEQ + t] = selm128[qi];
    }
  }
  __threadfence_block();
  __syncthreads();

#pragma unroll 1
  for (int sweep_i = 0; sweep_i < 2 + ((PROBE_DUP & 1024) ? 1 : 0) + ((PROBE_DUP & 2048) ? 1 : 0); ++sweep_i) {
    const int sweep = (sweep_i < 2) ? sweep_i : (((PROBE_DUP & 1024) && sweep_i == 2) ? 0 : 1);
    const bool dry = sweep_i >= 2;
    if (!(branch_mask & (sweep == 0 ? 2 : 4))) continue;
    if (sweep == 0) { nsa_sel16(p, smem, dry); continue; }
    const bf16_t* KB = (const bf16_t*)(ws + (sweep == 0 ? OFF_KS : OFF_KW)); const bf16_t* VB = (const bf16_t*)(ws + (sweep == 0 ? OFF_VS : OFF_VW));
    for (int item = blockIdx.x; item < NITEM; item += gridDim.x) {
      const NsaItem it = nsa_item(item, wave, qi);
      const int t = it.t, qb = it.qb;
      bf16x8 qf[4];
#pragma unroll
      for (int ks = 0; ks < 4; ++ks) qf[ks] = *(const bf16x8*)(Q + it.tokrow * 512 + (it.g * 4 + r4) * 64 + ks * 16 + hh * 8);
      const float g_b = gsig[it.tokrow * 32 + (it.g * 4 + r4) * 3 + 1 + sweep];
      u32x4 selw = {0xffffffffu, 0xffffffffu, 0xffffffffu, 0xffffffffu};
      if (sweep == 0) selw = SELG[(size_t)it.bg * SEQ + t];
      TileRegs tr;
      const bf16_t* kb = KB + (size_t)it.b * SEQ * 128 + it.g * 64;
      const bf16_t* vb = VB + (size_t)it.b * SEQ * 128 + it.g * 64;
      float m = -1e30f, l = 0.f;
      f32x16 o[2];
#pragma unroll
      for (int r = 0; r < 16; ++r) { o[0][r] = 0.f; o[1][r] = 0.f; }
      const int j0 = (sweep == 1 && qb >= 8) ? qb - 8 : 0;
      __syncthreads();
      nsa_load_tile(tr, kb + (size_t)j0 * 64 * 128, 128, vb + (size_t)j0 * 64 * 128, 128);
      nsa_store_tile(tr, smem);
      if (j0 + 1 <= qb) { nsa_load_tile(tr, kb + (size_t)(j0 + 1) * 64 * 128, 128, vb + (size_t)(j0 + 1) * 64 * 128, 128); nsa_store_tile(tr, smem + NSA_TILE); }
      if (j0 + 2 <= qb) nsa_load_tile(tr, kb + (size_t)(j0 + 2) * 64 * 128, 128, vb + (size_t)(j0 + 2) * 64 * 128, 128);
      __syncthreads();
      const bool late = wave >= 4;
      if (__builtin_amdgcn_readfirstlane(wave) >= 4) __builtin_amdgcn_s_setprio(1);
      bool has = false;
      m = 0.f;
      f32x16 st[2];
      {
        const unsigned w0 = j0 < 32 ? selw.x : (j0 < 64 ? selw.y : (j0 < 96 ? selw.z : selw.w));
        const float ini = ((w0 >> (j0 & 31)) & 1u) ? 0.f : -1e30f;
#pragma unroll
        for (int r = 0; r < 16; ++r) { st[0][r] = ini; st[1][r] = ini; }
        const bf16_t* Kc = (const bf16_t*)smem;
#pragma unroll
        for (int ks = 0; ks < 4; ++ks)
#pragma unroll
          for (int kt = 0; kt < 2; ++kt) st[kt] = MFMA32(*(const bf16x8*)(Kc + (kt * 32 + (lane & 31)) * LK + ks * 16 + (lane >> 5) * 8), qf[ks], st[kt]);
      }
      int bi = 0;
      for (int j = j0; j <= qb; ++j) {
        const char* tile = smem + bi * NSA_TILE;
        const int bn = bi == 2 ? 0 : bi + 1, bnn = bn == 2 ? 0 : bn + 1;
        const int jn = j + 1;
        const unsigned wn = jn < 32 ? selw.x : (jn < 64 ? selw.y : (jn < 96 ? selw.z : selw.w));
        const bool seln = (wn >> (jn & 31)) & 1u;
        const bf16_t* Kn = (const bf16_t*)(smem + bn * NSA_TILE) + (lane & 31) * LK + (lane >> 5) * 8;
        f32x16 sn[2];
        if (!late) {
          const float ini = seln ? -m : -1e30f;
#pragma unroll
          for (int r = 0; r < 16; ++r) { sn[0][r] = ini; sn[1][r] = ini; }
#pragma unroll
          for (int ks = 0; ks < 4; ++ks)
#pragma unroll
            for (int kt = 0; kt < 2; ++kt) sn[kt] = MFMA32(*(const bf16x8*)(Kn + kt * 32 * LK + ks * 16), qf[ks], sn[kt]);
        }
        if (j == qb || (sweep == 1 && j == qb - 8)) {
          const int khi = t - j * 64 - 4 * hh, klo = (sweep == 1) ? khi - 511 : -100000;
#pragma unroll
          for (int r = 0; r < 16; ++r) {
            const int o0 = (r & 3) + 8 * (r >> 2);
            st[0][r] = (o0 <= khi && o0 >= klo) ? st[0][r] : NSA_NEG;
            st[1][r] = (o0 + 32 <= khi && o0 + 32 >= klo) ? st[1][r] : NSA_NEG;
          }
        }
        float mx;
        {
          float a0, a1, a2, a3;
          asm("v_max3_f32 %0, %1, %2, %3" : "=v"(a0) : "v"(st[0][0]), "v"(st[0][1]), "v"(st[0][2]));
          asm("v_max3_f32 %0, %1, %2, %3" : "=v"(a1) : "v"(st[0][3]), "v"(st[0][4]), "v"(st[0][5]));
          asm("v_max3_f32 %0, %1, %2, %3" : "=v"(a2) : "v"(st[0][6]), "v"(st[0][7]), "v"(st[0][8]));
          asm("v_max3_f32 %0, %1, %2, %3" : "=v"(a3) : "v"(st[0][9]), "v"(st[0][10]), "v"(st[0][11]));
          asm("v_max3_f32 %0, %1, %2, %3" : "=v"(a0) : "v"(a0), "v"(st[0][12]), "v"(st[0][13]));
          asm("v_max3_f32 %0, %1, %2, %3" : "=v"(a1) : "v"(a1), "v"(st[0][14]), "v"(st[0][15]));
          asm("v_max3_f32 %0, %1, %2, %3" : "=v"(a2) : "v"(a2), "v"(st[1][0]), "v"(st[1][1]));
          asm("v_max3_f32 %0, %1, %2, %3" : "=v"(a3) : "v"(a3), "v"(st[1][2]), "v"(st[1][3]));
          asm("v_max3_f32 %0, %1, %2, %3" : "=v"(a0) : "v"(a0), "v"(st[1][4]), "v"(st[1][5]));
          asm("v_max3_f32 %0, %1, %2, %3" : "=v"(a1) : "v"(a1), "v"(st[1][6]), "v"(st[1][7]));
          asm("v_max3_f32 %0, %1, %2, %3" : "=v"(a2) : "v"(a2), "v"(st[1][8]), "v"(st[1][9]));
          asm("v_max3_f32 %0, %1, %2, %3" : "=v"(a3) : "v"(a3), "v"(st[1][10]), "v"(st[1][11]));
          asm("v_max3_f32 %0, %1, %2, %3" : "=v"(a0) : "v"(a0), "v"(st[1][12]), "v"(st[1][13]));
          asm("v_max3_f32 %0, %1, %2, %3" : "=v"(a1) : "v"(a1), "v"(st[1][14]), "v"(st[1][15]));
          asm("v_max3_f32 %0, %1, %2, %3" : "=v"(a0) : "v"(a0), "v"(a1), "v"(a2));
          const float other = a3;
          asm("v_max_f32 %0, %1, %2" : "=v"(mx) : "v"(a0), "v"(other));
          const float px = xor32f(mx, lane);
          asm("v_max_f32 %0, %1, %2" : "=v"(mx) : "v"(mx), "v"(px));
        }
        const bool real = mx > -1e29f;
        const bool fresh = !has && real, up = has && (mx > NSA_THR);
        if (__any(fresh || up)) {
          const float delta = (fresh || up) ? mx : 0.f;
          const float alpha = up ? __builtin_amdgcn_exp2f(-delta) : 1.0f;
          m += delta; l *= alpha;
#pragma unroll
          for (int r = 0; r < 16; ++r) { o[0][r] *= alpha; o[1][r] *= alpha; st[0][r] -= delta; st[1][r] -= delta; }
          if (!late) {
            const float dn = seln ? delta : 0.f;
#pragma unroll
            for (int r = 0; r < 16; ++r) { sn[0][r] -= dn; sn[1][r] -= dn; }
          }
        }
        has = has || real;
        f32x2 s2 = {0.f, 0.f};
#pragma unroll
        for (int r = 0; r < 16; ++r) {
          const float p0 = __builtin_amdgcn_exp2f(st[0][r]), p1 = __builtin_amdgcn_exp2f(st[1][r]);
          st[0][r] = p0; st[1][r] = p1; s2 += (f32x2){p0, p1};
        }
        l += s2.x + s2.y;
        nsa_pv(o, st, tile, lane);
        if (late) {
          const float ini = seln ? -m : -1e30f;
#pragma unroll
          for (int r = 0; r < 16; ++r) { sn[0][r] = ini; sn[1][r] = ini; }
#pragma unroll
          for (int ks = 0; ks < 4; ++ks)
#pragma unroll
            for (int kt = 0; kt < 2; ++kt) sn[kt] = MFMA32(*(const bf16x8*)(Kn + kt * 32 * LK + ks * 16), qf[ks], sn[kt]);
        }
        if (j + 2 <= qb) nsa_store_tile(tr, smem + bnn * NSA_TILE);
        if (j + 3 <= qb) nsa_load_tile(tr, kb + (size_t)(j + 3) * 64 * 128, 128, vb + (size_t)(j + 3) * 64 * 128, 128);
#pragma unroll
        for (int r = 0; r < 16; ++r) { st[0][r] = sn[0][r]; st[1][r] = sn[1][r]; }
        bi = bn;
        __syncthreads();
      }
      __builtin_amdgcn_s_setprio(0);
      l += xor32f(l, lane);
      if (!dry) nsa_accum_store(ONSA + it.tokrow * 512 + (it.g * 4 + r4) * 64, o, l > 0.f ? g_b / l : 0.f, false, hh);
      else asm volatile("" :: "v"(o[0]), "v"(o[1]), "v"(l));
    }
  }
}

DI unsigned ord_key(float f) { const unsigned u = __float_as_uint(f); return (u & 0x80000000u) ? ~u : (u | 0x80000000u); }
DI float ord_val(unsigned k) { return __uint_as_float((k & 0x80000000u) ? (k & 0x7fffffffu) : ~k); }
DI void cex(unsigned& hi, unsigned& lo) { const unsigned x = hi, y = lo; hi = x > y ? x : y; lo = x > y ? y : x; }
DI void sort16_desc(unsigned (&a)[16]) {
#pragma unroll
  for (int k = 2; k <= 16; k <<= 1)
#pragma unroll
    for (int j = k >> 1; j > 0; j >>= 1)
#pragma unroll
      for (int i = 0; i < 16; ++i) {
        const int l = i ^ j;
        if (l > i) { if ((i & k) == 0) cex(a[i], a[l]); else cex(a[l], a[i]); }
      }
}
DI void bitonic_finish16(unsigned (&a)[16]) {
#pragma unroll
  for (int j = 8; j > 0; j >>= 1)
#pragma unroll
    for (int i = 0; i < 16; ++i) { const int l = i ^ j; if (l > i) cex(a[i], a[l]); }
}
DI void merge_top16(unsigned (&a)[16], const unsigned (&b)[16]) {
#pragma unroll
  for (int i = 0; i < 16; ++i) a[i] = a[i] > b[15 - i] ? a[i] : b[15 - i];
  bitonic_finish16(a);
}
DI void merge_partner16(unsigned (&a)[16]) {
  unsigned b[16];
#pragma unroll
  for (int i = 0; i < 16; ++i) b[i] = xor32u(a[i], otid());
  merge_top16(a, b);
}


constexpr int KLD = 136;
DI void peer_top16(unsigned (&top)[16], const bf16x8 (&bq)[8], const bf16_t* keys  , int lane) {
  const int l31 = lane & 31, hh = lane >> 5;
  unsigned grp[16];
#pragma unroll
  for (int nt = 0; nt < 4; ++nt) {
    f32x16 sa;
#pragma unroll
    for (int r = 0; r < 16; ++r) sa[r] = 0.f;
    const bf16_t* kp = keys + (nt * 32 + l31) * KLD + hh * 8;
#pragma unroll
    for (int ks = 0; ks < 8; ++ks) { const bf16x8 a = *(const bf16x8*)(kp + ks * 16); sa = MFMA32(a, bq[ks], sa); }
#pragma unroll
    for (int r = 0; r < 16; ++r) {
      const int n = nt * 32 + (r & 3) + 8 * (r >> 2) + 4 * hh;
      grp[r] = (ord_key(sa[r]) & ~0x7Fu) | (unsigned)(127 - n);
    }
    sort16_desc(grp);
    if (nt == 0) {
#pragma unroll
      for (int i = 0; i < 16; ++i) top[i] = grp[i];
    } else merge_top16(top, grp);
  }
  merge_partner16(top);
}

DI void phase_route(const Params& p, char* smem) {
  char* ws = p.ws;
  const int tid = otid(), lane = tid & 63, wave = tid >> 6, l31 = lane & 31, hh = lane >> 5;
  const bf16_t* pq = (const bf16_t*)(ws + OFF_PQ);
  const bf16_t* pk = (const bf16_t*)(ws + OFF_PKEYS);
  int* eidx = (int*)(ws + OFF_EIDX);
  float* pgate = (float*)(ws + OFF_PGATE);
  bf16_t* KL = (bf16_t*)smem;
  unsigned* LS = (unsigned*)(smem + 2 * 128 * KLD * 2) + wave * 1024;
  {
    const int h0 = blockIdx.x & 7;
    __syncthreads();
#pragma unroll
    for (int i = 0; i < 8; ++i) {
      const int idx = tid + i * NT, row = idx >> 4, ch = idx & 15;
      *(u32x4*)(KL + row * KLD + ch * 8) = *(const u32x4*)(pk + ((size_t)h0 * 256 + row) * 128 + ch * 8);
    }
    __syncthreads();
  }
  constexpr int CA[64] = {0,0,0,0,0,0,0,0,0,0,0,0,0,0,0,0, 1,1,1,1,1,1,1,1, 2,2,2,2,2, 3,3,3,3, 4,4,4, 5,5, 6,6, 7,7, 8,9,10,11,12,13,14,15, 0,0,0,0,0,0,0,0,0,0,0,0,0,0};
  constexpr int CB[64] = {0,1,2,3,4,5,6,7,8,9,10,11,12,13,14,15, 0,1,2,3,4,5,6,7, 0,1,2,3,4, 0,1,2,3, 0,1,2, 0,1, 0,1, 0,1, 0,0,0,0,0,0,0,0, 0,0,0,0,0,0,0,0,0,0,0,0,0,0};
  for (int item = blockIdx.x; item < (NTOK / 256) * 8; item += gridDim.x) {
    const int h = item & 7, t0 = (item >> 3) * 256 + wave * 32;
    unsigned s1[16], s2[16];
    const bf16_t* pqrow = pq + (size_t)(t0 + l31) * 2048 + h * 256 + hh * 8;
    bf16x8 bq1[8], bq2[8];
#pragma unroll
    for (int ks = 0; ks < 8; ++ks) { bq1[ks] = *(const bf16x8*)(pqrow + ks * 16); bq2[ks] = *(const bf16x8*)(pqrow + 128 + ks * 16); }
    peer_top16(s1, bq1, KL, lane);
    peer_top16(s2, bq2, KL + 128 * KLD, lane);
    float f1[16], f2[16];
#pragma unroll
    for (int i = 0; i < 16; ++i) { f1[i] = ord_val(s1[i]); f2[i] = ord_val(s2[i]); }
    unsigned ca[16], cb2[16];
#pragma unroll
    for (int i = 0; i < 32; ++i) {
      const int i0 = i, i1 = 25 + i;
      unsigned k0 = 0u, k1 = 0u;
      if (i0 < 25) k0 = (ord_key(f1[CA[i0]] + f2[CB[i0]]) & ~0xFFu) | (unsigned)(255 - (CA[i0] * 16 + CB[i0]));
      if (i1 < 50) k1 = (ord_key(f1[CA[i1]] + f2[CB[i1]]) & ~0xFFu) | (unsigned)(255 - (CA[i1] * 16 + CB[i1]));
      const unsigned kk = hh ? k1 : k0;
      if (i < 16) ca[i] = kk; else cb2[i - 16] = kk;
    }
    sort16_desc(ca); sort16_desc(cb2);
    merge_top16(ca, cb2);
    merge_partner16(ca);
    if (hh == 0) {
#pragma unroll
      for (int i = 0; i < 16; ++i) { LS[l31 * 32 + i] = s1[i]; LS[l31 * 32 + 16 + i] = s2[i]; }
    }
    const float mx = ord_val(ca[0]);
    float ex[16], sum = 0.f;
#pragma unroll
    for (int i = 0; i < 16; ++i) { ex[i] = __expf(ord_val(ca[i]) - mx); sum += ex[i]; }
    const float inv = 1.0f / sum;
    int eo[16]; float go[16];
#pragma unroll
    for (int i = 0; i < 16; ++i) {
      const int flat = 255 - (int)(ca[i] & 0xFFu);
      const unsigned k1 = LS[l31 * 32 + (flat >> 4)], k2 = LS[l31 * 32 + 16 + (flat & 15)];
      eo[i] = (127 - (int)(k1 & 0x7Fu)) * 128 + (127 - (int)(k2 & 0x7Fu));
      go[i] = ex[i] * inv;
    }
    const size_t ob = ((size_t)(t0 + l31) * 8 + h) * 16;
    if (hh == 0) {
      *(u32x4*)(eidx + ob) = (u32x4){(unsigned)eo[0], (unsigned)eo[1], (unsigned)eo[2], (unsigned)eo[3]};
      *(u32x4*)(eidx + ob + 4) = (u32x4){(unsigned)eo[4], (unsigned)eo[5], (unsigned)eo[6], (unsigned)eo[7]};
      *(f32x4*)(pgate + ob) = (f32x4){go[0], go[1], go[2], go[3]};
      *(f32x4*)(pgate + ob + 4) = (f32x4){go[4], go[5], go[6], go[7]};
    } else {
      *(u32x4*)(eidx + ob + 8) = (u32x4){(unsigned)eo[8], (unsigned)eo[9], (unsigned)eo[10], (unsigned)eo[11]};
      *(u32x4*)(eidx + ob + 12) = (u32x4){(unsigned)eo[12], (unsigned)eo[13], (unsigned)eo[14], (unsigned)eo[15]};
      *(f32x4*)(pgate + ob + 8) = (f32x4){go[8], go[9], go[10], go[11]};
      *(f32x4*)(pgate + ob + 12) = (f32x4){go[12], go[13], go[14], go[15]};
    }
  }
}

#define FOR32(M) M(0) M(1) M(2) M(3) M(4) M(5) M(6) M(7) M(8) M(9) M(10) M(11) M(12) M(13) M(14) M(15) M(16) M(17) M(18) M(19) M(20) M(21) M(22) M(23) M(24) M(25) M(26) M(27) M(28) M(29) M(30) M(31)
DI float dot16_fp8(const u32x4 raw, const float (&hx)[16]) {
  const f32x2 a0 = __builtin_amdgcn_cvt_pk_f32_fp8((int)raw.x, false), a1 = __builtin_amdgcn_cvt_pk_f32_fp8((int)raw.x, true);
  const f32x2 b0 = __builtin_amdgcn_cvt_pk_f32_fp8((int)raw.y, false), b1 = __builtin_amdgcn_cvt_pk_f32_fp8((int)raw.y, true);
  const f32x2 c0 = __builtin_amdgcn_cvt_pk_f32_fp8((int)raw.z, false), c1 = __builtin_amdgcn_cvt_pk_f32_fp8((int)raw.z, true);
  const f32x2 d0 = __builtin_amdgcn_cvt_pk_f32_fp8((int)raw.w, false), d1 = __builtin_amdgcn_cvt_pk_f32_fp8((int)raw.w, true);
  f32x2 s0 = a0 * (f32x2){hx[0], hx[1]}, s1 = a1 * (f32x2){hx[2], hx[3]};
  s0 = b0 * (f32x2){hx[4], hx[5]} + s0; s1 = b1 * (f32x2){hx[6], hx[7]} + s1;
  s0 = c0 * (f32x2){hx[8], hx[9]} + s0; s1 = c1 * (f32x2){hx[10], hx[11]} + s1;
  s0 = d0 * (f32x2){hx[12], hx[13]} + s0; s1 = d1 * (f32x2){hx[14], hx[15]} + s1;
  s0 += s1;
  return s0.x + s0.y;
}
#define FOR16(M) M(0) M(1) M(2) M(3) M(4) M(5) M(6) M(7) M(8) M(9) M(10) M(11) M(12) M(13) M(14) M(15)
DI void phase_ffn_u(const Params& p) {
  char* ws = p.ws;
  const int lane = otid() & 63, wave = otid() >> 6, pg = lane >> 3, dc = lane & 7;
  const int sl = blockIdx.x & 7, wslot = (blockIdx.x >> 3) * NW + wave, nw = (gridDim.x >> 3) * NW;
  const unsigned char* PU8 = (const unsigned char*)(ws + OFF_PU8) + (size_t)sl * 16384 * 128 + dc * 16;
  const bf16_t* h2 = (const bf16_t*)(ws + OFF_H) + sl * 128 + dc * 16;
  const int* eidx = (const int*)(ws + OFF_EIDX);
  float* part = (float*)(ws + OFF_PART) + (size_t)sl * NTOK * 128;
  const int j0 = (dc >> 2) * 64 + ((2 * dc) & 7) * 8 + pg;
  int ev0 = 0, ev1 = 0, nev0 = 0, nev1 = 0; u32x4 ha = {0u, 0u, 0u, 0u}, hb = ha, nha = ha, nhb = ha;
  if (wslot < NTOK) { ev0 = eidx[(size_t)wslot * 128 + lane]; ev1 = eidx[(size_t)wslot * 128 + 64 + lane]; ha = *(const u32x4*)(h2 + (size_t)wslot * DM); hb = *(const u32x4*)(h2 + (size_t)wslot * DM + 8); }
  for (int t = wslot; t < NTOK; t += nw) {
    if (t + nw < NTOK) { const size_t o = (size_t)(t + nw) * 128; nev0 = eidx[o + lane]; nev1 = eidx[o + 64 + lane]; nha = *(const u32x4*)(h2 + (size_t)(t + nw) * DM); nhb = *(const u32x4*)(h2 + (size_t)(t + nw) * DM + 8); }
    float hx[16];
    { float t8[8]; unpack8(ha, t8);
#pragma unroll
      for (int i = 0; i < 8; ++i) hx[i] = t8[i];
      unpack8(hb, t8);
#pragma unroll
      for (int i = 0; i < 8; ++i) hx[8 + i] = t8[i]; }
#define FFU_LD(it) const u32x4 ru##it = *(const u32x4*)(PU8 + (size_t)__shfl((it) < 8 ? ev0 : ev1, ((it) & 7) * 8 + pg) * 128);
    FOR16(FFU_LD)
    float d[16];
#define FFU_CP(it) d[it] = dot16_fp8(ru##it, hx);
    FOR16(FFU_CP)
    float r8[8], r4[4], r2[2];
    { const bool hi = dc & 4;
#pragma unroll
      for (int i = 0; i < 8; ++i) { const float keep = hi ? d[8 + i] : d[i], send = hi ? d[i] : d[8 + i]; r8[i] = keep + __shfl_xor(send, 4); } }
    { const bool hi = dc & 2;
#pragma unroll
      for (int i = 0; i < 4; ++i) { const float keep = hi ? r8[4 + i] : r8[i], send = hi ? r8[i] : r8[4 + i]; r4[i] = keep + xor2f(send); } }
    { const bool hi = dc & 1;
#pragma unroll
      for (int i = 0; i < 2; ++i) { const float keep = hi ? r4[2 + i] : r4[i], send = hi ? r4[i] : r4[2 + i]; r2[i] = keep + xor1f(send); } }
    part[(size_t)t * 128 + j0] = r2[0];
    part[(size_t)t * 128 + j0 + 8] = r2[1];
    ev0 = nev0; ev1 = nev1; ha = nha; hb = nhb;
  }
}
DI void phase_ffn_w(const Params& p) {
  char* ws = p.ws;
  const int lane = otid() & 63, wave = otid() >> 6;
  const float* part = (const float*)(ws + OFF_PART);
  const float* scu = (const float*)(ws + OFF_SCU); const float* scv = (const float*)(ws + OFF_SCV);
  const int* eidx = (const int*)(ws + OFF_EIDX);
  const float* pgate = (const float*)(ws + OFF_PGATE);
  float* wbuf = (float*)(ws + OFF_WBUF);
  for (int grp = blockIdx.x; grp < NTOK / NW; grp += gridDim.x) {
    const size_t o = (size_t)(grp * NW + wave) * 128 + lane;
    float a0 = 0.f, a1 = 0.f;
#pragma unroll
    for (int s8 = 0; s8 < 8; ++s8) { a0 += part[(size_t)s8 * NTOK * 128 + o]; a1 += part[(size_t)s8 * NTOK * 128 + o + 64]; }
    const int e0 = eidx[o], e1 = eidx[o + 64];
    wbuf[o] = pgate[o] * gelu_f(a0 * scu[e0]) * scv[e0];
    wbuf[o + 64] = pgate[o + 64] * gelu_f(a1 * scu[e1]) * scv[e1];
  }
}
DI void phase_ffn_v(const Params& p) {
  char* ws = p.ws;
  const int lane = otid() & 63, wave = otid() >> 6, pg = lane >> 3, dc = lane & 7;
  const int sl = blockIdx.x & 7, wslot = (blockIdx.x >> 3) * NW + wave, nw = (gridDim.x >> 3) * NW;
  const unsigned char* PV8 = (const unsigned char*)(ws + OFF_PV8) + (size_t)sl * 16384 * 128 + dc * 16;
  const int* eidx = (const int*)(ws + OFF_EIDX) + 16 * pg;
  const float* wbuf = (const float*)(ws + OFF_WBUF) + 16 * pg;
  bf16_t* ffnb = (bf16_t*)(ws + OFF_FFNB);
  u32x4 ne0 = {0u, 0u, 0u, 0u}, ne1 = ne0, ne2 = ne0, ne3 = ne0;
  if (wslot < NTOK) { const int* ep = eidx + (size_t)wslot * 128; ne0 = *(const u32x4*)ep; ne1 = *(const u32x4*)(ep + 4); ne2 = *(const u32x4*)(ep + 8); ne3 = *(const u32x4*)(ep + 12); }
#pragma unroll 1
  for (int t = wslot; t < NTOK; t += nw) {
    const u32x4 ce0 = ne0, ce1 = ne1, ce2 = ne2, ce3 = ne3;
    if (t + nw < NTOK) { const int* ep = eidx + (size_t)(t + nw) * 128; ne0 = *(const u32x4*)ep; ne1 = *(const u32x4*)(ep + 4); ne2 = *(const u32x4*)(ep + 8); ne3 = *(const u32x4*)(ep + 12); }
    const float* wp = wbuf + (size_t)t * 128;
    const f32x4 wq0 = *(const f32x4*)wp, wq1 = *(const f32x4*)(wp + 4), wq2 = *(const f32x4*)(wp + 8), wq3 = *(const f32x4*)(wp + 12);
#define FFV_E(it) ((it) < 4 ? ce0[(it) & 3] : (it) < 8 ? ce1[(it) & 3] : (it) < 12 ? ce2[(it) & 3] : ce3[(it) & 3])
#define FFV_W(it) ((it) < 4 ? wq0[(it) & 3] : (it) < 8 ? wq1[(it) & 3] : (it) < 12 ? wq2[(it) & 3] : wq3[(it) & 3])
#define FFV_LD(it) const u32x4 rv##it = *(const u32x4*)(PV8 + (size_t)FFV_E(it) * 128);
#define FFV_CP(it) { const float wj = FFV_W(it); const f32x2 w2 = {wj, wj}; \
      acc2[0] += __builtin_amdgcn_cvt_pk_f32_fp8((int)rv##it.x, false) * w2; acc2[1] += __builtin_amdgcn_cvt_pk_f32_fp8((int)rv##it.x, true) * w2; \
      acc2[2] += __builtin_amdgcn_cvt_pk_f32_fp8((int)rv##it.y, false) * w2; acc2[3] += __builtin_amdgcn_cvt_pk_f32_fp8((int)rv##it.y, true) * w2; \
      acc2[4] += __builtin_amdgcn_cvt_pk_f32_fp8((int)rv##it.z, false) * w2; acc2[5] += __builtin_amdgcn_cvt_pk_f32_fp8((int)rv##it.z, true) * w2; \
      acc2[6] += __builtin_amdgcn_cvt_pk_f32_fp8((int)rv##it.w, false) * w2; acc2[7] += __builtin_amdgcn_cvt_pk_f32_fp8((int)rv##it.w, true) * w2; }
    FOR16(FFV_LD)
    f32x2 acc2[8];
#pragma unroll
    for (int i = 0; i < 8; ++i) acc2[i] = (f32x2){0.f, 0.f};
    FOR16(FFV_CP)
    float acc[16];
#pragma unroll
    for (int i = 0; i < 8; ++i) { acc[2 * i] = acc2[i].x; acc[2 * i + 1] = acc2[i].y; }
    float r8[8], r4[4], r2[2];
    { const bool hi = lane & 32;
#pragma unroll
      for (int i = 0; i < 8; ++i) { const float keep = hi ? acc[8 + i] : acc[i], send = hi ? acc[i] : acc[8 + i]; r8[i] = keep + xor32f(send, lane); } }
    { const bool hi = lane & 16;
#pragma unroll
      for (int i = 0; i < 4; ++i) { const float keep = hi ? r8[4 + i] : r8[i], send = hi ? r8[i] : r8[4 + i]; r4[i] = keep + xor16f(send, lane); } }
    { const bool hi = lane & 8;
#pragma unroll
      for (int i = 0; i < 2; ++i) { const float keep = hi ? r4[2 + i] : r4[i], send = hi ? r4[i] : r4[2 + i]; r2[i] = keep + xor8f(send); } }
    *(unsigned*)(ffnb + (size_t)t * DM + sl * 128 + dc * 16 + 2 * pg) = pack2(r2[0], r2[1]);
  }
}
DI void phase_final(const Params& p) {
  char* ws = p.ws;
  const int lane = otid() & 63, wave = otid() >> 6;
  const bf16_t* x1 = (const bf16_t*)(ws + OFF_X1);
  const bf16_t* ffnb = (const bf16_t*)(ws + OFF_FFNB);
  const float* mod = (const float*)(ws + OFF_MOD);
  for (int grp = blockIdx.x; grp < NTOK / NW; grp += gridDim.x) {
    const int row = grp * NW + wave, b = row >> 13;
    float v[16];
#pragma unroll
    for (int i = 0; i < 4; ++i) {
      const int col = i * 256 + lane * 4;
      const f32x4 gt2 = *(const f32x4*)(mod + b * 6144 + 5120 + col);
      const u32x2 xr = *(const u32x2*)(x1 + (size_t)row * DM + col), fr = *(const u32x2*)(ffnb + (size_t)row * DM + col);
      v[4 * i] = DN_ALPHA * bflo(xr.x) + gt2.x * bflo(fr.x); v[4 * i + 1] = DN_ALPHA * bfhi(xr.x) + gt2.y * bfhi(fr.x);
      v[4 * i + 2] = DN_ALPHA * bflo(xr.y) + gt2.z * bflo(fr.y); v[4 * i + 3] = DN_ALPHA * bfhi(xr.y) + gt2.w * bfhi(fr.y);
    }
    float mean, rstd; row_stats(v, mean, rstd);
#pragma unroll
    for (int i = 0; i < 4; ++i) {
      const int col = i * 256 + lane * 4;
      const f32x4 g = *(const f32x4*)(p.ln2_g + col), bb = *(const f32x4*)(p.ln2_b + col);
      f32x4 o;
      o.x = (v[4 * i] - mean) * rstd * g.x + bb.x; o.y = (v[4 * i + 1] - mean) * rstd * g.y + bb.y;
      o.z = (v[4 * i + 2] - mean) * rstd * g.z + bb.z; o.w = (v[4 * i + 3] - mean) * rstd * g.w + bb.w;
      *(f32x4*)(p.out + (size_t)row * DM + col) = o;
    }
  }
}

#define XB_TMO      128
#define XB_XCNT(j)  (256  + 64 * (j))
#define XB_XSUB(j)  (1280 + 64 * (j))
#define XB_XGEN(j)  (2304 + 64 * (j))
#define XB_TOP      3328
#define XB_TOPGEN   3392
#define XCD_BAR_WORDS 3456
#define XB_SPIN_CAP (1u << 22)
DI unsigned xb_ld(unsigned* p) { return __hip_atomic_load(p, __ATOMIC_RELAXED, __HIP_MEMORY_SCOPE_AGENT); }
DI unsigned xb_add(unsigned* p, unsigned v) { return __hip_atomic_fetch_add(p, v, __ATOMIC_RELAXED, __HIP_MEMORY_SCOPE_AGENT); }
DI unsigned xb_xcc_id() { return (unsigned)__builtin_amdgcn_s_getreg((3 << 11) | 20) & 0xFu; }
#define XB_SPIN(cond, bar) do { unsigned _sp = 0; while (cond) { __builtin_amdgcn_s_sleep(1); \
    if ((++_sp & 255u) == 0u) { if (xb_ld(&(bar)[XB_TMO])) break; if (_sp > XB_SPIN_CAP) { atomicAdd(&(bar)[XB_TMO], 1u); break; } } } } while (0)
struct XcdBarrier { unsigned* bar; unsigned x; volatile LAS unsigned* st; };
DI XcdBarrier xcd_barrier_post(unsigned* bar, volatile LAS unsigned* st) {
  XcdBarrier b; b.bar = bar; b.x = xb_xcc_id(); b.st = st;
  if (threadIdx.x == 0) (void)xb_add(&bar[XB_XCNT(b.x)], 1u);
  return b;
}
DI void xcd_barrier_complete(unsigned* bar, unsigned x, unsigned& nloc, unsigned& nx) {
  const unsigned G = gridDim.x * gridDim.y * gridDim.z;
  unsigned sum, cnt, mine, sp = 0u;
  for (;;) {
    sum = 0u; cnt = 0u; mine = 0u;
#pragma unroll
    for (unsigned j = 0; j < 16; ++j) { const unsigned c = xb_ld(&bar[XB_XCNT(j)]); sum += c; cnt += (c > 0u) ? 1u : 0u; mine = (j == x) ? c : mine; }
    if (sum == G) break;
    __builtin_amdgcn_s_sleep(1);
    if ((++sp & 255u) == 0u) { if (xb_ld(&bar[XB_TMO])) break; if (sp > XB_SPIN_CAP) { atomicAdd(&bar[XB_TMO], 1u); break; } }
  }
  nloc = mine > 0u ? mine : 1u; nx = cnt > 0u ? cnt : 1u;
}
DI void xcd_barrier(const XcdBarrier& b) {
  asm volatile("s_waitcnt vmcnt(0)" ::: "memory");
  __syncthreads();
  if (threadIdx.x == 0) {
    unsigned* bar = b.bar;
    __builtin_amdgcn_s_waitcnt(0);
    unsigned nloc = b.st[0], nx = b.st[1];
    if (nloc == 0u) { xcd_barrier_complete(bar, b.x, nloc, nx); b.st[0] = nloc; b.st[1] = nx; }
    const unsigned old = xb_add(&bar[XB_XSUB(b.x)], 1u);
    const unsigned gen = old / nloc;
    if (old + 1u == (gen + 1u) * nloc) {
      __builtin_amdgcn_fence(__ATOMIC_RELEASE, "agent");
      asm volatile("s_waitcnt vmcnt(0)" ::: "memory");
      const unsigned og = xb_add(&bar[XB_TOP], 1u);
      const unsigned tg = og / nx;
      if (og + 1u == (tg + 1u) * nx) xb_add(&bar[XB_TOPGEN], 1u);
      else XB_SPIN(xb_ld(&bar[XB_TOPGEN]) == tg, bar);
      __builtin_amdgcn_fence(__ATOMIC_ACQUIRE, "agent");
      xb_add(&bar[XB_XGEN(b.x)], 1u);
      asm volatile("s_waitcnt vmcnt(0)" ::: "memory");
    } else {
      XB_SPIN(xb_ld(&bar[XB_XGEN(b.x)]) == gen, bar);
      __builtin_amdgcn_fence(__ATOMIC_ACQUIRE, "agent");
      asm volatile("s_waitcnt vmcnt(0)" ::: "memory");
    }
  }
  __syncthreads();
}

constexpr int SMEM_BYTES = 147456 + 256;

__global__ void __launch_bounds__(NT, 2) k_mega(Params p) {
  __shared__ __attribute__((aligned(16))) char smem[SMEM_BYTES];
  cg::grid_group grid = cg::this_grid();
  if (threadIdx.x == 0) *(u32x4*)(smem + 147456) = (u32x4){0u, 0u, 0u, 0u};
  __syncthreads();
  const XcdBarrier xb = xcd_barrier_post((unsigned*)(p.ws + OFF_BAR), (volatile LAS unsigned*)(smem + 147456));
#define REP(mask) _Pragma("unroll 1") for (int rep_ = 0; rep_ < ((PROBE_DUP & (mask)) ? 2 : 1); ++rep_)
  REP(1) phase_prep(p, smem);
  grid.sync();
  REP(1) phase_ln_in(p);
  xcd_barrier(xb);
  REP(2) phase_gemm1(p, smem);
  xcd_barrier(xb);
  REP(4) phase_compress(p, smem);
  phase_sgu(p, smem);
  xcd_barrier(xb);
  REP(8) phase_nsa(p, smem, NSA_MASK);
  xcd_barrier(xb);
  REP(16) phase_merge(p, smem);
  xcd_barrier(xb);
  REP(16) phase_outproj(p, smem);
  xcd_barrier(xb);
  REP(1) phase_ln_mid(p);
  xcd_barrier(xb);
  REP(32) phase_peerq(p, smem);
  xcd_barrier(xb);
  REP(64) phase_route(p, smem);
  xcd_barrier(xb);
  REP(128) phase_ffn_u(p);
  xcd_barrier(xb);
  REP(128) phase_ffn_w(p);
  xcd_barrier(xb);
  REP(256) phase_ffn_v(p);
  xcd_barrier(xb);
  REP(512) phase_final(p);
}

extern "C" void kernel_launch(void* const* d_in, const int* in_sizes, int n_in, void* d_out, int out_size, void* d_ws, size_t ws_size, hipStream_t stream) {
  if (ws_size < OFF_END) { fprintf(stderr, "workspace too small: %zu < %zu\n", ws_size, (size_t)OFF_END); return; }
  static int grid_blocks = 0;
  if (!grid_blocks) {
    int dev = 0, cus = 0, per_cu = 0;
    (void)hipGetDevice(&dev);
    (void)hipDeviceGetAttribute(&cus, hipDeviceAttributeMultiprocessorCount, dev);
    (void)hipOccupancyMaxActiveBlocksPerMultiprocessor(&per_cu, k_mega, NT, 0);
    if (per_cu < 1) fprintf(stderr, "occupancy query returned %d\n", per_cu);
    grid_blocks = (cus / 8) * 8;
  }
  Params p{};
  const float** fp = (const float**)&p;
  for (int i = 0; i < 26; ++i) fp[i] = (const float*)d_in[i];
  p.out = (float*)d_out;
  p.ws = (char*)d_ws;
  for (int i = 0; i < 32; ++i) p.inv_freq[i] = (float)pow(10000.0, -(double)i / 32.0);
  (void)hipMemsetAsync((char*)d_ws + OFF_BAR, 0, XCD_BAR_WORDS * 4, stream);
  void* args[] = {&p};
  hipError_t e = hipLaunchCooperativeKernel((void*)k_mega, dim3(grid_blocks), dim3(NT), args, 0, stream);
  if (e != hipSuccess) fprintf(stderr, "cooperative launch failed: %s (grid %d)\n", hipGetErrorString(e), grid_blocks);
}
```

```cpp
#include <hip/hip_runtime.h>
#include <hip/hip_cooperative_groups.h>
#include <stdint.h>
#include <stdio.h>
#include <math.h>
namespace cg = cooperative_groups;

#ifndef PROBE_DUP
#define PROBE_DUP 0
#endif
#ifndef NSA_MASK
#define NSA_MASK 7
#endif
typedef unsigned short bf16_t;
typedef short bf16x8 __attribute__((ext_vector_type(8)));
typedef short s16x4 __attribute__((ext_vector_type(4)));
typedef float f32x16 __attribute__((ext_vector_type(16)));
typedef float f32x4 __attribute__((ext_vector_type(4)));
typedef float f32x2 __attribute__((ext_vector_type(2)));
typedef __bf16 bf16v2 __attribute__((ext_vector_type(2)));
typedef unsigned u32x4 __attribute__((ext_vector_type(4)));
typedef unsigned u32x2 __attribute__((ext_vector_type(2)));
#define DI __device__ __forceinline__
#define LAS __attribute__((address_space(3)))
#define MFMA32(a, b, c) __builtin_amdgcn_mfma_f32_32x32x16_bf16((a), (b), (c), 0, 0, 0)

constexpr int NT = 512, NW = 8;
constexpr int NB = 8, SEQ = 8192, DM = 1024, NTOK = NB * SEQ;
constexpr int N1 = 4608;
constexpr float DN_ALPHA = 1.189207115002721f;
constexpr float LN_EPS = 1e-5f;

constexpr size_t MB = 1024 * 1024;
constexpr size_t OFF_MOD = 0;
constexpr size_t OFF_ROPE = OFF_MOD + 256 * 1024;
constexpr size_t OFF_POSB = OFF_ROPE + 2 * MB;
constexpr size_t OFF_WT1 = OFF_POSB + 4096;
constexpr size_t OFF_WB = OFF_WT1 + (size_t)N1 * 1024 * 2;
constexpr size_t OFF_WOUT = OFF_WB + 2 * MB;
constexpr size_t OFF_WQ = OFF_WOUT + 2 * MB;
constexpr size_t OFF_PKEYS = OFF_WQ + 4 * MB;
constexpr size_t OFF_CW1 = OFF_PKEYS + MB / 2;
constexpr size_t OFF_CW2 = OFF_CW1 + MB;
constexpr size_t OFF_SGUW = OFF_CW2 + 32 * 1024;
constexpr size_t OFF_SCU = OFF_SGUW + 256 * 1024;
constexpr size_t OFF_SCV = OFF_SCU + 64 * 1024;
constexpr size_t OFF_PU = OFF_SCV + 64 * 1024;
constexpr size_t OFF_PV = OFF_PU + 32 * MB;
constexpr size_t OFF_ACT = ((OFF_PV + 32 * MB + 4095) / 4096) * 4096;
constexpr size_t OFF_H = OFF_ACT;
constexpr size_t OFF_Q = OFF_H + 128 * MB;
constexpr size_t OFF_KC = OFF_Q + 64 * MB;
constexpr size_t OFF_VC = OFF_KC + 16 * MB;
constexpr size_t OFF_KS = OFF_VC + 16 * MB;
constexpr size_t OFF_VS = OFF_KS + 16 * MB;
constexpr size_t OFF_KW = OFF_VS + 16 * MB;
constexpr size_t OFF_VW = OFF_KW + 16 * MB;
constexpr size_t OFF_U = OFF_VW + 16 * MB;
constexpr size_t OFF_V = OFF_U + 64 * MB;
constexpr size_t OFF_GATE = OFF_V + 64 * MB;
constexpr size_t OFF_GSIG = OFF_GATE + 256 * MB;
constexpr size_t OFF_KCMP = OFF_GSIG + 8 * MB;
constexpr size_t OFF_VCMP = OFF_KCMP + MB;
constexpr size_t OFF_ONSA = OFF_VCMP + MB;
constexpr size_t OFF_SELG = OFF_ONSA + 64 * MB;
constexpr size_t OFF_BAR = OFF_SELG + 2 * MB;
constexpr size_t OFF_END = OFF_BAR + 64 * 1024;
constexpr size_t OFF_X1 = OFF_Q;
constexpr size_t OFF_Y = OFF_GATE;
constexpr size_t OFF_PQ = OFF_GATE;
constexpr size_t OFF_EIDX = OFF_ONSA;
constexpr size_t OFF_PGATE = OFF_ONSA + 32 * MB;
constexpr size_t OFF_PU8 = OFF_PU;
constexpr size_t OFF_PART = OFF_GATE;
constexpr size_t OFF_PV8 = OFF_PU + 16 * MB;
constexpr size_t OFF_WBUF = OFF_PU + 32 * MB;
constexpr size_t OFF_H2Q = OFF_U;
constexpr size_t OFF_SH = OFF_V;
constexpr size_t OFF_FFNB = OFF_GATE;

struct Params {
  const float *x, *c, *w_ada, *b_ada, *w_in, *cmp_pos, *cmp_w1, *cmp_b1, *cmp_w2, *cmp_b2, *sgu_ln_g, *sgu_ln_b, *sgu_w, *sgu_b,
      *w_branch, *w_merge, *b_merge, *w_out, *ln1_g, *ln1_b, *peer_wq, *peer_keys, *peer_u, *peer_v, *ln2_g, *ln2_b;
  float* out;
  char* ws;
  float inv_freq[32];
};

DI unsigned pack2(float lo, float hi) { f32x2 v = {lo, hi}; bf16v2 r = __builtin_convertvector(v, bf16v2); return __builtin_bit_cast(unsigned, r); }
DI bf16_t f2bf(float f) { __bf16 r = (__bf16)f; return __builtin_bit_cast(unsigned short, r); }
DI float bf2f(bf16_t h) { return __uint_as_float(((unsigned)h) << 16); }
DI float bflo(unsigned u) { return __uint_as_float(u << 16); }
DI float bfhi(unsigned u) { return __uint_as_float(u & 0xffff0000u); }
DI float gelu_f(float v) { return 0.5f * v * (1.0f + erff(v * 0.70710678118654752f)); }
DI float sigmoid_f(float v) { return 1.0f / (1.0f + __expf(-v)); }
DI int otid() { int t = __builtin_amdgcn_workitem_id_x(); asm volatile("" : "+v"(t)); return t; }
DI void lds_barrier() { asm volatile("s_waitcnt lgkmcnt(0)" ::: "memory"); __builtin_amdgcn_s_barrier(); asm volatile("" ::: "memory"); }
DI float xor1f(float x) { const int xi = __float_as_int(x); return __int_as_float(__builtin_amdgcn_update_dpp(xi, xi, 0xB1, 0xF, 0xF, false)); }
DI float xor2f(float x) { const int xi = __float_as_int(x); return __int_as_float(__builtin_amdgcn_update_dpp(xi, xi, 0x4E, 0xF, 0xF, false)); }
DI float xor8f(float x) { const int xi = __float_as_int(x); return __int_as_float(__builtin_amdgcn_update_dpp(xi, xi, 0x128, 0xF, 0xF, false)); }
DI unsigned xor32u(unsigned x, int lane) { const u32x2 r = __builtin_amdgcn_permlane32_swap(x, x, false, false); return (lane & 32) ? r.x : r.y; }
DI unsigned xor16u(unsigned x, int lane) { const u32x2 r = __builtin_amdgcn_permlane16_swap(x, x, false, false); return (lane & 16) ? r.x : r.y; }
DI float xor32f(float x, int lane) { return __uint_as_float(xor32u(__float_as_uint(x), lane)); }
DI float xor16f(float x, int lane) { return __uint_as_float(xor16u(__float_as_uint(x), lane)); }
DI unsigned pack_i8x4(float a, float b, float c, float d) {
  const int ia = (int)rintf(a), ib = (int)rintf(b), ic = (int)rintf(c), id = (int)rintf(d);
  return (unsigned)(ia & 0xff) | ((unsigned)(ib & 0xff) << 8) | ((unsigned)(ic & 0xff) << 16) | ((unsigned)id << 24);
}
DI float wave_sum(float v) {
#pragma unroll
  for (int o = 32; o > 0; o >>= 1) v += __shfl_xor(v, o);
  return v;
}
DI void ld8(const float* pz, float (&v)[8]) { const f32x4 a = *(const f32x4*)pz, b = *(const f32x4*)(pz + 4); v[0] = a.x; v[1] = a.y; v[2] = a.z; v[3] = a.w; v[4] = b.x; v[5] = b.y; v[6] = b.z; v[7] = b.w; }
DI u32x4 pack8(const float (&v)[8]) { u32x4 w; w.x = pack2(v[0], v[1]); w.y = pack2(v[2], v[3]); w.z = pack2(v[4], v[5]); w.w = pack2(v[6], v[7]); return w; }
DI void unpack8(const u32x4 w, float (&v)[8]) { v[0] = bflo(w.x); v[1] = bfhi(w.x); v[2] = bflo(w.y); v[3] = bfhi(w.y); v[4] = bflo(w.z); v[5] = bfhi(w.z); v[6] = bflo(w.w); v[7] = bfhi(w.w); }
DI f32x2 gelu_pk(f32x2 v) {
  const f32x2 av = __builtin_elementwise_abs(v), d = av * 0.2316418882f + 1.0f;
  f32x2 t; t.x = __builtin_amdgcn_rcpf(d.x); t.y = __builtin_amdgcn_rcpf(d.y);
  f32x2 q = t * 0.5307027145f + (-0.7265760135f); q = q * t + 0.7107068705f; q = q * t + (-0.142248368f); q = q * t + 0.127414796f; q = q * t;
  const f32x2 s = (v * v) * (-0.72134752044f);
  f32x2 e; e.x = __builtin_amdgcn_exp2f(s.x); e.y = __builtin_amdgcn_exp2f(s.y);
  const f32x2 m = v * (q * e), r = v - m;
  f32x2 o; o.x = v.x < 0.f ? m.x : r.x; o.y = v.y < 0.f ? m.y : r.y; return o;
}
__host__ __device__ __forceinline__ int dperm(int q) { const int grp = q >> 5, fq = (q >> 3) & 3, j = q & 7; return (j < 4) ? (16 * grp + 4 * fq + j) : (32 + 16 * grp + 4 * fq + (j - 4)); }

template <class F>
DI void tconv_tile(float* tile, int k0, int n0, bf16_t* dst, int ldd, F f) {
  const int tid = otid();
  __syncthreads();
#pragma unroll 4
  for (int i = 0; i < 8; ++i) { const int kl = i * 8 + (tid >> 6), nl = tid & 63; tile[nl * 65 + kl] = f(k0 + kl, n0 + nl); }
  __syncthreads();
  {
    const int nl = tid >> 3, kc = tid & 7;
    const float* t = tile + nl * 65 + kc * 8;
    u32x4 w; w.x = pack2(t[0], t[1]); w.y = pack2(t[2], t[3]); w.z = pack2(t[4], t[5]); w.w = pack2(t[6], t[7]);
    *(u32x4*)(dst + (size_t)(n0 + nl) * ldd + k0 + kc * 8) = w;
  }
}

DI void conv_chunk(const float* src, bf16_t* dst, size_t base) {
  const size_t i = base + (size_t)otid() * 8;
  const f32x4 a = *(const f32x4*)(src + i), b = *(const f32x4*)(src + i + 4);
  u32x4 w; w.x = pack2(a.x, a.y); w.y = pack2(a.z, a.w); w.z = pack2(b.x, b.y); w.w = pack2(b.z, b.w);
  *(u32x4*)(dst + i) = w;
}

DI void sincos_d(double x, double& s, double& c) {
  const double y = x * 0.25, y2 = y * y;
  double sn = y * (1.0 + y2 * (-1.0 / 6 + y2 * (1.0 / 120 + y2 * (-1.0 / 5040 + y2 * (1.0 / 362880 + y2 * (-1.0 / 39916800 + y2 * (1.0 / 6227020800.0)))))));
  double cs = 1.0 + y2 * (-0.5 + y2 * (1.0 / 24 + y2 * (-1.0 / 720 + y2 * (1.0 / 40320 + y2 * (-1.0 / 3628800 + y2 * (1.0 / 479001600.0 + y2 * (-1.0 / 87178291200.0)))))));
#pragma unroll
  for (int i = 0; i < 2; ++i) { const double s2 = 2.0 * sn * cs, c2 = cs * cs - sn * sn; sn = s2; cs = c2; }
  s = sn; c = cs;
}

DI void phase_prep(const Params& p, char* smem) {
  const int tid = otid();
  float* fs = (float*)smem;
  char* ws = p.ws;
  constexpr int nA = 192, nB = 16 * 72, nC = 2 * 8 * 16, nD = 256, nE = 16 * 32, nF = 2 * 32 * 2, nG = 4, nH = 8, nI = 512, nJ = 64, nK = 32, nL = 2048, nM = 2048;
  constexpr int total = nA + nB + nC + nD + nE + nF + nG + nH + nI + nJ + nK + nL + nM;
  for (int item = blockIdx.x; item < total; item += gridDim.x) {
    int it = item;
    if (it < nA) {
      float* sc = fs;
      float* red = fs + 8192;
      __syncthreads();
      for (int i = tid; i < 8192; i += NT) { const float v = p.c[i]; sc[i] = v / (1.0f + __expf(-v)); }
      __syncthreads();
      const int ks = tid >> 5, cj = tid & 31, col = it * 32 + cj;
      float acc[8];
#pragma unroll
      for (int b = 0; b < 8; ++b) acc[b] = 0.f;
#pragma unroll 4
      for (int k = ks * 64; k < ks * 64 + 64; ++k) {
        const float w = p.w_ada[(size_t)k * 6144 + col];
#pragma unroll
        for (int b = 0; b < 8; ++b) acc[b] += sc[b * 1024 + k] * w;
      }
#pragma unroll
      for (int b = 0; b < 8; ++b) red[(ks * 8 + b) * 32 + cj] = acc[b];
      __syncthreads();
      if (tid < 256) {
        const int b = tid >> 5;
        float s = p.b_ada[col];
#pragma unroll
        for (int k2 = 0; k2 < 16; ++k2) s += red[(k2 * 8 + b) * 32 + cj];
        ((float*)(ws + OFF_MOD))[b * 6144 + col] = s;
      }
      continue;
    }
    it -= nA;
    if (it < nB) {
      const int kt = it / 72, ntile = it % 72;
      const float* w_in = p.w_in; const float* w_merge = p.w_merge;
      tconv_tile(fs, kt * 64, ntile * 64, (bf16_t*)(ws + OFF_WT1), 1024, [=](int k, int n) -> float {
        if (n < 1280) {
          const bool roped = (n < 640) || (n >= 768 && n < 896) || (n >= 1024 && n < 1152);
          const int col = roped ? ((n & ~63) + dperm(n & 63)) : n;
          return w_in[(size_t)k * 2328 + col];
        }
        if (n < 2304) return w_in[(size_t)k * 2328 + n + 24];
        if (n < 4352) return w_merge[(size_t)k * 2048 + (n - 2304)];
        if (n < 4376) return w_in[(size_t)k * 2328 + 1280 + (n - 4352)];
        return 0.f; });
      continue;
    }
    it -= nB;
    if (it < nC) {
      const int br = it >> 7, r = it & 127, kt = r >> 4, ntile = r & 15;
      const float* src = p.w_branch + (size_t)br * 512 * 1024;
      tconv_tile(fs, kt * 64, ntile * 64, (bf16_t*)(ws + OFF_WB) + (size_t)br * 1024 * 512, 512, [=](int k, int n) -> float { return src[(size_t)k * 1024 + n]; });
      continue;
    }
    it -= nC;
    if (it < nD) {
      const int kt = it >> 4, ntile = it & 15;
      const float* src = p.w_out;
      tconv_tile(fs, kt * 64, ntile * 64, (bf16_t*)(ws + OFF_WOUT), 1024, [=](int k, int n) -> float { return src[(size_t)k * 1024 + n]; });
      continue;
    }
    it -= nD;
    if (it < nE) {
      const int kt = it >> 5, ntile = it & 31;
      const float* src = p.peer_wq;
      tconv_tile(fs, kt * 64, ntile * 64, (bf16_t*)(ws + OFF_WQ), 1024, [=](int k, int n) -> float { return src[(size_t)k * 2048 + n]; });
      continue;
    }
    it -= nE;
    if (it < nF) {
      const int w = it >> 6, r = it & 63, kt = r >> 1, ntile = r & 1;
      const float* src = p.cmp_w1 + (size_t)w * 2048 * 128;
      tconv_tile(fs, kt * 64, ntile * 64, (bf16_t*)(ws + OFF_CW1) + (size_t)w * 128 * 2048, 2048, [=](int k, int n) -> float {
        const int ksrc = (w == 0) ? ((k & ~63) + dperm(k & 63)) : k;
        return src[(size_t)ksrc * 128 + n]; });
      continue;
    }
    it -= nF;
    if (it < nG) {
      const int w = it >> 1, kt = it & 1;
      const float* src = p.cmp_w2 + (size_t)w * 128 * 64;
      tconv_tile(fs, kt * 64, 0, (bf16_t*)(ws + OFF_CW2) + (size_t)w * 64 * 128, 128, [=](int k, int n) -> float { return src[(size_t)k * 64 + ((w == 0) ? dperm(n) : n)]; });
      continue;
    }
    it -= nG;
    if (it < nH) {
      const int w = it >> 2, jc = it & 3, ks = tid >> 5, cj = tid & 31, j = jc * 32 + cj;
      float* red = fs;
      const float* pos = p.cmp_pos + w * 2048; const float* w1 = p.cmp_w1 + (size_t)w * 2048 * 128;
      float acc = 0.f;
#pragma unroll 4
      for (int k = ks * 128; k < ks * 128 + 128; ++k) acc += pos[k] * w1[(size_t)k * 128 + j];
      __syncthreads();
      red[ks * 32 + cj] = acc;
      __syncthreads();
      if (tid < 32) { float s = p.cmp_b1[w * 128 + j]; for (int k2 = 0; k2 < 16; ++k2) s += red[k2 * 32 + tid]; ((float*)(ws + OFF_POSB))[w * 128 + j] = s; }
      continue;
    }
    it -= nH;
    if (it < nI) {
      const int e = it * 512 + tid, pos = e >> 5, i = e & 31;
      const float ang = (float)pos * p.inv_freq[i];
      const double a = (double)ang;
      const double kk = rint(a * 0.15915494309189535);
      const double r = a - kk * 6.283185307179586476925;
      double s, c; sincos_d(r, s, c);
      ((float*)(ws + OFF_ROPE))[e] = (float)c;
      ((float*)(ws + OFF_ROPE))[262144 + e] = (float)s;
      continue;
    }
    it -= nI;
    if (it < nJ) { conv_chunk(p.peer_keys, (bf16_t*)(ws + OFF_PKEYS), (size_t)it * 4096); continue; }
    it -= nJ;
    if (it < nK) {
      const size_t i0 = (size_t)it * 4096 + (size_t)tid * 8;
      const int rowi = (int)((i0 >> 7) & 127), j0 = (int)(i0 & 127);
      float v[8];
#pragma unroll
      for (int j = 0; j < 8; ++j) v[j] = (j0 + j <= rowi) ? p.sgu_w[i0 + j] : 0.f;
      u32x4 w; w.x = pack2(v[0], v[1]); w.y = pack2(v[2], v[3]); w.z = pack2(v[4], v[5]); w.w = pack2(v[6], v[7]);
      *(u32x4*)((bf16_t*)(ws + OFF_SGUW) + i0) = w;
      continue;
    }
    it -= nK;
    {
      const bool isv = it >= nL;
      if (isv) it -= nL;
      const int lane = tid & 63, e = it * 8 + (tid >> 6);
      const float* src = (isv ? p.peer_v : p.peer_u) + (size_t)e * 1024 + lane * 16;
      float v[16];
#pragma unroll
      for (int i = 0; i < 4; ++i) { const f32x4 t4 = *(const f32x4*)(src + i * 4); v[4 * i] = t4.x; v[4 * i + 1] = t4.y; v[4 * i + 2] = t4.z; v[4 * i + 3] = t4.w; }
      float amax = 0.f;
#pragma unroll
      for (int i = 0; i < 16; ++i) amax = fmaxf(amax, fabsf(v[i]));
#pragma unroll
      for (int o = 32; o > 0; o >>= 1) amax = fmaxf(amax, __shfl_xor(amax, o));
      const unsigned be = (__float_as_uint(amax) >> 23) & 0xffu;
      const bool okr = be >= 16u && be <= 240u;
      const float scale = okr ? __uint_as_float((261u - be) << 23) : 1.0f;
      const float inv = okr ? __uint_as_float((be - 7u) << 23) : 1.0f;
      u32x4 w;
      int t0 = 0, t1 = 0, t2 = 0, t3 = 0;
      t0 = __builtin_amdgcn_cvt_pk_fp8_f32(v[0] * scale, v[1] * scale, t0, false); t0 = __builtin_amdgcn_cvt_pk_fp8_f32(v[2] * scale, v[3] * scale, t0, true);
      t1 = __builtin_amdgcn_cvt_pk_fp8_f32(v[4] * scale, v[5] * scale, t1, false); t1 = __builtin_amdgcn_cvt_pk_fp8_f32(v[6] * scale, v[7] * scale, t1, true);
      t2 = __builtin_amdgcn_cvt_pk_fp8_f32(v[8] * scale, v[9] * scale, t2, false); t2 = __builtin_amdgcn_cvt_pk_fp8_f32(v[10] * scale, v[11] * scale, t2, true);
      t3 = __builtin_amdgcn_cvt_pk_fp8_f32(v[12] * scale, v[13] * scale, t3, false); t3 = __builtin_amdgcn_cvt_pk_fp8_f32(v[14] * scale, v[15] * scale, t3, true);
      w.x = (unsigned)t0; w.y = (unsigned)t1; w.z = (unsigned)t2; w.w = (unsigned)t3;
      if (!isv) {
        const float qs = amax > 0.f ? 127.0f / amax : 0.f;
        u32x4 wi; wi.x = pack_i8x4(v[0] * qs, v[1] * qs, v[2] * qs, v[3] * qs); wi.y = pack_i8x4(v[4] * qs, v[5] * qs, v[6] * qs, v[7] * qs);
        wi.z = pack_i8x4(v[8] * qs, v[9] * qs, v[10] * qs, v[11] * qs); wi.w = pack_i8x4(v[12] * qs, v[13] * qs, v[14] * qs, v[15] * qs);
        *(u32x4*)(ws + OFF_PU8 + ((size_t)(lane >> 3) * 16384 + e) * 128 + (lane & 7) * 16) = wi;
        if (lane == 0) ((float*)(ws + OFF_SCU))[e] = amax * (1.0f / 127.0f);
      } else {
        *(u32x4*)(ws + OFF_PV8 + ((size_t)(lane >> 3) * 16384 + e) * 128 + (lane & 7) * 16) = w;
        if (lane == 0) ((float*)(ws + OFF_SCV))[e] = inv;
      }
    }
  }
}

DI void row_stats(const float (&v)[16], float& mean, float& rstd) {
  float s = 0.f;
#pragma unroll
  for (int i = 0; i < 16; ++i) s += v[i];
  mean = wave_sum(s) * (1.0f / 1024.0f);
  float q = 0.f;
#pragma unroll
  for (int i = 0; i < 16; ++i) { const float d = v[i] - mean; q += d * d; }
  rstd = rsqrtf(wave_sum(q) * (1.0f / 1024.0f) + LN_EPS);
}

DI void phase_ln_in(const Params& p) {
  const int lane = otid() & 63, wave = otid() >> 6;
  const float* mod = (const float*)(p.ws + OFF_MOD);
  bf16_t* h = (bf16_t*)(p.ws + OFF_H);
  for (int grp = blockIdx.x; grp < NTOK / NW; grp += gridDim.x) {
    const int row = grp * NW + wave, b = row >> 13;
    const float* xr = p.x + (size_t)row * DM;
    float v[16];
#pragma unroll
    for (int i = 0; i < 4; ++i) { const f32x4 t = *(const f32x4*)(xr + i * 256 + lane * 4); v[4 * i] = t.x; v[4 * i + 1] = t.y; v[4 * i + 2] = t.z; v[4 * i + 3] = t.w; }
    float mean, rstd; row_stats(v, mean, rstd);
#pragma unroll
    for (int i = 0; i < 4; ++i) {
      const int col = i * 256 + lane * 4;
      const f32x4 sh = *(const f32x4*)(mod + b * 6144 + col), sc = *(const f32x4*)(mod + b * 6144 + 1024 + col);
      const float o0 = (v[4 * i] - mean) * rstd * (1.f + sc.x) + sh.x, o1 = (v[4 * i + 1] - mean) * rstd * (1.f + sc.y) + sh.y;
      const float o2 = (v[4 * i + 2] - mean) * rstd * (1.f + sc.z) + sh.z, o3 = (v[4 * i + 3] - mean) * rstd * (1.f + sc.w) + sh.w;
      u32x2 w; w.x = pack2(o0, o1); w.y = pack2(o2, o3);
      *(u32x2*)(h + (size_t)row * DM + col) = w;
    }
  }
}

DI void phase_ln_mid(const Params& p) {
  const int lane = otid() & 63, wave = otid() >> 6;
  const float* mod = (const float*)(p.ws + OFF_MOD);
  const bf16_t* y = (const bf16_t*)(p.ws + OFF_Y);
  bf16_t* x1 = (bf16_t*)(p.ws + OFF_X1);
  bf16_t* h2 = (bf16_t*)(p.ws + OFF_H);
  for (int grp = blockIdx.x; grp < NTOK / NW; grp += gridDim.x) {
    const int row = grp * NW + wave, b = row >> 13;
    const bf16_t* yr = y + (size_t)row * DM;
    float v[16];
#pragma unroll
    for (int i = 0; i < 4; ++i) { const u32x2 t = *(const u32x2*)(yr + i * 256 + lane * 4); v[4 * i] = bflo(t.x); v[4 * i + 1] = bfhi(t.x); v[4 * i + 2] = bflo(t.y); v[4 * i + 3] = bfhi(t.y); }
    float mean, rstd; row_stats(v, mean, rstd);
#pragma unroll
    for (int i = 0; i < 4; ++i) {
      const int col = i * 256 + lane * 4;
      const f32x4 g = *(const f32x4*)(p.ln1_g + col), bb = *(const f32x4*)(p.ln1_b + col);
      f32x4 o;
      o.x = (v[4 * i] - mean) * rstd * g.x + bb.x; o.y = (v[4 * i + 1] - mean) * rstd * g.y + bb.y;
      o.z = (v[4 * i + 2] - mean) * rstd * g.z + bb.z; o.w = (v[4 * i + 3] - mean) * rstd * g.w + bb.w;
      { u32x2 w; w.x = pack2(o.x, o.y); w.y = pack2(o.z, o.w); *(u32x2*)(x1 + (size_t)row * DM + col) = w; }
      v[4 * i] = o.x; v[4 * i + 1] = o.y; v[4 * i + 2] = o.z; v[4 * i + 3] = o.w;
    }
    row_stats(v, mean, rstd);
    float amax = 0.f;
#pragma unroll
    for (int i = 0; i < 4; ++i) {
      const int col = i * 256 + lane * 4;
      const f32x4 sh = *(const f32x4*)(mod + b * 6144 + 3072 + col), sc = *(const f32x4*)(mod + b * 6144 + 4096 + col);
      const float o0 = (v[4 * i] - mean) * rstd * (1.f + sc.x) + sh.x, o1 = (v[4 * i + 1] - mean) * rstd * (1.f + sc.y) + sh.y;
      const float o2 = (v[4 * i + 2] - mean) * rstd * (1.f + sc.z) + sh.z, o3 = (v[4 * i + 3] - mean) * rstd * (1.f + sc.w) + sh.w;
      u32x2 w; w.x = pack2(o0, o1); w.y = pack2(o2, o3);
      *(u32x2*)(h2 + (size_t)row * DM + col) = w;
      v[4 * i] = o0; v[4 * i + 1] = o1; v[4 * i + 2] = o2; v[4 * i + 3] = o3;
      amax = fmaxf(amax, fmaxf(fmaxf(fabsf(o0), fabsf(o1)), fmaxf(fabsf(o2), fabsf(o3))));
    }
#pragma unroll
    for (int o = 32; o > 0; o >>= 1) amax = fmaxf(amax, __shfl_xor(amax, o));
    const float qs = amax > 0.f ? 127.0f / amax : 0.f;
    unsigned* h2q = (unsigned*)(p.ws + OFF_H2Q);
#pragma unroll
    for (int i = 0; i < 4; ++i) h2q[(size_t)row * 256 + i * 64 + lane] = pack_i8x4(v[4 * i] * qs, v[4 * i + 1] * qs, v[4 * i + 2] * qs, v[4 * i + 3] * qs);
    if (lane == 0) ((float*)(p.ws + OFF_SH))[row] = amax * (1.0f / 127.0f);
  }
}

namespace pg8 {
constexpr int BM = 256, BK = 64, HALF = 128, HTB = HALF * BK * 2, STAGE_BYTES = 8 * HTB, NXCD = 8, WGM = 8;
DI int lds_byte(int r, int c) { const int st = (r >> 4) * 2 + (c >> 5), rr = r & 15, cc = c & 31, ob = rr * 64 + cc * 2; return st * 1024 + (ob ^ (((ob >> 9) & 1) << 5)); }
DI void stage_rc(int b, int& R, int& C) { const int st = b / 1024, sb = b % 1024, swz = sb ^ (((sb >> 9) & 1) << 5); R = (st >> 1) * 16 + swz / 64; C = (st & 1) * 32 + (swz % 64) / 2; }
DI int perm32(int rho) { const int n = rho >> 4, i = rho & 15; return 8 * (i >> 2) + 4 * n + (i & 3); }
struct Unit { int pm, pn; };
struct Gemm { const bf16_t* A; const bf16_t* Bt; int M, N, K; };
struct StaticOrder {
  int nM, nN, nwg, G, c;
  DI void init(int M, int N, int G_, int c_) { nM = M / BM; nN = N / BM; nwg = nM * nN; G = G_; c = c_; }
  DI bool next(int i, Unit& u) const {
    const long L = (long)i * G + c; if (L >= nwg) return false;
    int wgid = (int)L; { const int q = nwg / NXCD, r = nwg % NXCD, xcd = wgid % NXCD, off = wgid / NXCD; wgid = (xcd < r ? xcd * (q + 1) : r * (q + 1) + (xcd - r) * q) + off; }
    const int nig = WGM * nN, gid = wgid / nig, fm = gid * WGM, gsz = (nM - fm) < WGM ? (nM - fm) : WGM;
    u.pm = fm + ((wgid % nig) % gsz); u.pn = (wgid % nig) / gsz; return true;
  }
};

template <class Epi>
DI void gemm_phase(LAS unsigned char* lds, const Gemm g, const StaticOrder& S, const Epi& E) {
  const int tid = otid(), wid = __builtin_amdgcn_readfirstlane(tid >> 6), lane = tid & 63, wr = wid >> 2, wc = wid & 3, fr = lane & 15, fq = lane >> 4;
  const int K = g.K, nt = K / BK;
  unsigned voffA[2], voffB[2];
#pragma unroll
  for (int i = 0; i < 2; ++i) { int R, C; stage_rc(tid * 16 + i * 8192, R, C); const int Rb = Epi::PERM ? ((R & ~31) + perm32(R & 31)) : R;
    voffA[i] = (unsigned)(R * K + C) * 2u; voffB[i] = (unsigned)(Rb * K + C) * 2u; }
  const size_t kstep = (size_t)(BK * 2);
  const size_t hstep = (size_t)HALF * K * 2;
  const size_t tstep = 2 * hstep;
  const unsigned ldsw = (unsigned)wid * 1024u;
  const int aoff = lds_byte(wr * 64 + fr, fq * 8), boff = lds_byte(wc * 32 + fr, fq * 8);
#define PG8_SA(b, h) (((b) * 2 + (h)) * HTB)
#define PG8_SB(b, h) ((4 + (b) * 2 + (h)) * HTB)
#define PG8_STAGE(bufoff, gbase, voff) do { _Pragma("unroll") for (int _i = 0; _i < 2; ++_i) \
    __builtin_amdgcn_global_load_lds((const unsigned*)((const char*)(gbase) + (voff)[_i]), (LAS unsigned*)(lds + (bufoff) + ldsw + _i * 8192), 16, 0, 0); } while (0)
#define PG8_LDA(dst, b, h) do { _Pragma("unroll") for (int m = 0; m < 4; ++m) _Pragma("unroll") for (int k = 0; k < 2; ++k) dst[m][k] = *(const LAS bf16x8*)(lds + PG8_SA(b, h) + aoff + m * 2048 + k * 1024); } while (0)
#define PG8_LDB(dst, b, h) do { _Pragma("unroll") for (int n = 0; n < 2; ++n) _Pragma("unroll") for (int k = 0; k < 2; ++k) dst[n][k] = *(const LAS bf16x8*)(lds + PG8_SB(b, h) + boff + n * 2048 + k * 1024); } while (0)
#define PG8_MMA(ai, bj, At, Bt) do { __builtin_amdgcn_s_setprio(1); _Pragma("unroll") for (int m = 0; m < 4; ++m) _Pragma("unroll") for (int n = 0; n < 2; ++n) _Pragma("unroll") for (int k = 0; k < 2; ++k) \
    acc[ai][bj][m][n] = __builtin_amdgcn_mfma_f32_16x16x32_bf16(Bt[n][k], At[m][k], acc[ai][bj][m][n], 0, 0, 0); __builtin_amdgcn_s_setprio(0); } while (0)
#define PG8_WAIT_V(n) asm volatile("s_waitcnt vmcnt(" #n ")" ::: "memory")
#define PG8_WAIT_L(n) asm volatile("s_waitcnt lgkmcnt(" #n ")" ::: "memory")
#define PG8_BAR __builtin_amdgcn_s_barrier()
#define PG8_SCHED __builtin_amdgcn_sched_barrier(0)
  Unit cur, nxt; int ui = 0;
  if (!S.next(0, cur)) return;
  f32x4 acc[2][2][4][2];
#pragma unroll
  for (int a = 0; a < 2; ++a)
#pragma unroll
    for (int b = 0; b < 2; ++b)
#pragma unroll
      for (int m = 0; m < 4; ++m)
#pragma unroll
        for (int n = 0; n < 2; ++n) acc[a][b][m][n] = (f32x4){0.f, 0.f, 0.f, 0.f};
  bf16x8 At[4][2], B0[2][2], B1[2][2];
  const char* cA = (const char*)g.A + (size_t)cur.pm * tstep; const char* cB = (const char*)g.Bt + (size_t)cur.pn * tstep;
  PG8_STAGE(PG8_SB(0, 0), cB, voffB); PG8_STAGE(PG8_SA(0, 0), cA, voffA); PG8_STAGE(PG8_SB(0, 1), cB + hstep, voffB); PG8_STAGE(PG8_SA(0, 1), cA + hstep, voffA);
  if (wr == 1) PG8_BAR;
  PG8_WAIT_V(4); PG8_BAR;
  PG8_STAGE(PG8_SB(1, 0), cB + kstep, voffB); PG8_STAGE(PG8_SA(1, 0), cA + kstep, voffA); PG8_STAGE(PG8_SB(1, 1), cB + hstep + kstep, voffB);
  PG8_WAIT_V(6); PG8_BAR;
  for (;;) {
    const bool has_next = S.next(ui + 1, nxt);
    const char* nA = has_next ? (const char*)g.A + (size_t)nxt.pm * tstep : cA; const char* nB = has_next ? (const char*)g.Bt + (size_t)nxt.pn * tstep : cB;
    for (int t = 0; t < nt; t += 2) {
      const bool last = (t == nt - 2);
      const char* a1 = cA + (size_t)(t + 1) * kstep;
      const char* a2 = last ? nA : cA + (size_t)(t + 2) * kstep; const char* b2 = last ? nB : cB + (size_t)(t + 2) * kstep;
      const char* a3 = a2 + kstep; const char* b3 = b2 + kstep;
      PG8_LDB(B0, 0, 0); PG8_SCHED; PG8_LDA(At, 0, 0); PG8_STAGE(PG8_SA(1, 1), a1 + hstep, voffA);
      PG8_WAIT_L(8); PG8_BAR; PG8_WAIT_L(0); PG8_MMA(0, 0, At, B0); PG8_BAR; PG8_SCHED;
      PG8_LDB(B1, 0, 1); PG8_STAGE(PG8_SB(0, 0), b2, voffB);
      PG8_BAR; PG8_WAIT_L(0); PG8_MMA(0, 1, At, B1); PG8_BAR;
      PG8_LDA(At, 0, 1); PG8_STAGE(PG8_SA(0, 0), a2, voffA);
      PG8_BAR; PG8_WAIT_L(0); PG8_MMA(1, 0, At, B0); PG8_BAR; PG8_SCHED;
      PG8_STAGE(PG8_SB(0, 1), b2 + hstep, voffB);
      PG8_WAIT_V(6); PG8_BAR; PG8_MMA(1, 1, At, B1); PG8_BAR;
      PG8_LDB(B0, 1, 0); PG8_SCHED; PG8_LDA(At, 1, 0); PG8_STAGE(PG8_SA(0, 1), a2 + hstep, voffA);
      PG8_WAIT_L(8); PG8_BAR; PG8_WAIT_L(0); PG8_MMA(0, 0, At, B0); PG8_BAR; PG8_SCHED;
      PG8_LDB(B1, 1, 1); PG8_STAGE(PG8_SB(1, 0), b3, voffB);
      PG8_BAR; PG8_WAIT_L(0); PG8_MMA(0, 1, At, B1); PG8_BAR;
      PG8_LDA(At, 1, 1); PG8_STAGE(PG8_SA(1, 0), a3, voffA);
      PG8_BAR; PG8_WAIT_L(0); PG8_MMA(1, 0, At, B0); PG8_BAR; PG8_SCHED;
      PG8_STAGE(PG8_SB(1, 1), b3 + hstep, voffB);
      PG8_WAIT_V(6); PG8_BAR; PG8_MMA(1, 1, At, B1); PG8_BAR;
    }
    E(acc, cur, wr, wc, fr, fq);
    if (!has_next) break;
#pragma unroll
    for (int a = 0; a < 2; ++a)
#pragma unroll
      for (int b = 0; b < 2; ++b)
#pragma unroll
        for (int m = 0; m < 4; ++m)
#pragma unroll
          for (int n = 0; n < 2; ++n) acc[a][b][m][n] = (f32x4){0.f, 0.f, 0.f, 0.f};
    cur = nxt; cA = nA; cB = nB; ++ui;
  }
  PG8_WAIT_V(0);
  if (wr == 0) PG8_BAR;
  PG8_BAR;
#undef PG8_SA
#undef PG8_SB
#undef PG8_STAGE
#undef PG8_LDA
#undef PG8_LDB
#undef PG8_MMA
#undef PG8_WAIT_V
#undef PG8_WAIT_L
#undef PG8_BAR
#undef PG8_SCHED
}
}

struct EpiProj {
  static constexpr bool PERM = true;
  char* ws; const float* b_merge;
  DI void operator()(const f32x4 (&acc)[2][2][4][2], const pg8::Unit& u, int wr, int wc, int fr, int fq) const {
    const float* rope = (const float*)(ws + OFF_ROPE);
    const int row0 = u.pm * 256 + wr * 64 + fr;
#pragma unroll
    for (int bj = 0; bj < 2; ++bj) {
      const int cg = u.pn * 256 + bj * 128 + wc * 32;
      const int c0 = cg + 8 * fq;
      if (cg >= 4384) continue;
      if (cg < 1280 && (cg < 640 || (cg >= 768 && cg < 896) || (cg >= 1024 && cg < 1152))) {
        bf16_t* dst; unsigned ld, cofs; float scale = 1.0f;
        if (cg < 512) { dst = (bf16_t*)(ws + OFF_Q); ld = 512; cofs = c0; scale = 0.18033688011112042f; }
        else if (cg < 640) { dst = (bf16_t*)(ws + OFF_KC); ld = 128; cofs = c0 - 512; }
        else if (cg < 896) { dst = (bf16_t*)(ws + OFF_KS); ld = 128; cofs = c0 - 768; }
        else { dst = (bf16_t*)(ws + OFF_KW); ld = 128; cofs = c0 - 1024; }
        const int d0 = 16 * ((cg >> 5) & 1) + 4 * fq;
#pragma unroll
        for (int ai = 0; ai < 2; ++ai)
#pragma unroll
          for (int m = 0; m < 4; ++m) {
            const int row = row0 + ai * 128 + m * 16, pos = row & (SEQ - 1);
            const f32x4 cs = *(const f32x4*)(rope + pos * 32 + d0), sn = *(const f32x4*)(rope + 262144 + pos * 32 + d0);
            const f32x4 t1 = acc[ai][bj][m][0], t2 = acc[ai][bj][m][1];
            const f32x4 o1 = (t1 * cs - t2 * sn) * scale, o2 = (t1 * sn + t2 * cs) * scale;
            u32x4 w; w.x = pack2(o1.x, o1.y); w.y = pack2(o1.z, o1.w); w.z = pack2(o2.x, o2.y); w.w = pack2(o2.z, o2.w);
            *(u32x4*)(dst + (unsigned)row * ld + cofs) = w;
          }
      } else if (cg < 1280) {
        bf16_t* dst; unsigned cofs;
        if (cg < 768) { dst = (bf16_t*)(ws + OFF_VC); cofs = c0 - 640; }
        else if (cg < 1024) { dst = (bf16_t*)(ws + OFF_VS); cofs = c0 - 896; }
        else { dst = (bf16_t*)(ws + OFF_VW); cofs = c0 - 1152; }
#pragma unroll
        for (int ai = 0; ai < 2; ++ai)
#pragma unroll
          for (int m = 0; m < 4; ++m) {
            const int row = row0 + ai * 128 + m * 16;
            const f32x4 a = acc[ai][bj][m][0], b = acc[ai][bj][m][1];
            u32x4 w; w.x = pack2(a.x, a.y); w.y = pack2(a.z, a.w); w.z = pack2(b.x, b.y); w.w = pack2(b.z, b.w);
            *(u32x4*)(dst + (unsigned)row * 128u + cofs) = w;
          }
      } else if (cg < 2304) {
        bf16_t* dst = (bf16_t*)(ws + (cg < 1792 ? OFF_U : OFF_V));
        const unsigned cofs = c0 - (cg < 1792 ? 1280 : 1792);
#pragma unroll
        for (int ai = 0; ai < 2; ++ai)
#pragma unroll
          for (int m = 0; m < 4; ++m) {
            const int row = row0 + ai * 128 + m * 16;
            const f32x4 a = acc[ai][bj][m][0], b = acc[ai][bj][m][1];
            const f32x2 g0 = gelu_pk((f32x2){a.x, a.y}), g1 = gelu_pk((f32x2){a.z, a.w}), g2 = gelu_pk((f32x2){b.x, b.y}), g3 = gelu_pk((f32x2){b.z, b.w});
            u32x4 w; w.x = pack2(g0.x, g0.y); w.y = pack2(g1.x, g1.y); w.z = pack2(g2.x, g2.y); w.w = pack2(g3.x, g3.y);
            *(u32x4*)(dst + (unsigned)row * 512u + cofs) = w;
          }
      } else if (cg < 4352) {
        bf16_t* dst = (bf16_t*)(ws + OFF_GATE);
        const unsigned cofs = c0 - 2304;
        const f32x4 b0 = *(const f32x4*)(b_merge + cofs), b1 = *(const f32x4*)(b_merge + cofs + 4);
#pragma unroll
        for (int ai = 0; ai < 2; ++ai)
#pragma unroll
          for (int m = 0; m < 4; ++m) {
            const int row = row0 + ai * 128 + m * 16;
            const f32x4 a = acc[ai][bj][m][0] + b0, b = acc[ai][bj][m][1] + b1;
            u32x4 w; w.x = pack2(sigmoid_f(a.x), sigmoid_f(a.y)); w.y = pack2(sigmoid_f(a.z), sigmoid_f(a.w));
            w.z = pack2(sigmoid_f(b.x), sigmoid_f(b.y)); w.w = pack2(sigmoid_f(b.z), sigmoid_f(b.w));
            *(u32x4*)(dst + (unsigned)row * 2048u + cofs) = w;
          }
      } else {
        float* gs = (float*)(ws + OFF_GSIG);
        if (fq < 3) {
#pragma unroll
          for (int ai = 0; ai < 2; ++ai)
#pragma unroll
            for (int m = 0; m < 4; ++m) {
              const int row = row0 + ai * 128 + m * 16;
              const f32x4 a = acc[ai][bj][m][0], b = acc[ai][bj][m][1];
              f32x4 o0, o1; o0.x = sigmoid_f(a.x); o0.y = sigmoid_f(a.y); o0.z = sigmoid_f(a.z); o0.w = sigmoid_f(a.w);
              o1.x = sigmoid_f(b.x); o1.y = sigmoid_f(b.y); o1.z = sigmoid_f(b.z); o1.w = sigmoid_f(b.w);
              *(f32x4*)(gs + (unsigned)row * 32u + 8 * fq) = o0; *(f32x4*)(gs + (unsigned)row * 32u + 8 * fq + 4) = o1;
            }
        }
      }
    }
  }
};
DI void phase_gemm1(const Params& p, char* smem) {
  pg8::Gemm g{(const bf16_t*)(p.ws + OFF_H), (const bf16_t*)(p.ws + OFF_WT1), NTOK, N1, 1024};
  pg8::StaticOrder S; S.init(NTOK, N1, gridDim.x, blockIdx.x);
  EpiProj E{p.ws, p.b_merge};
  pg8::gemm_phase((LAS unsigned char*)smem, g, S, E);
}

template <int BR> struct EpiMerge {
  static constexpr bool PERM = true;
  char* ws;
  DI void operator()(const f32x4 (&acc)[2][2][4][2], const pg8::Unit& u, int wr, int wc, int fr, int fq) const {
    const bf16_t* gate = (const bf16_t*)(ws + OFF_GATE);
    bf16_t* merged = (bf16_t*)(ws + OFF_H);
    const int row0 = u.pm * 256 + wr * 64 + fr;
#pragma unroll
    for (int bj = 0; bj < 2; ++bj) {
      const unsigned c0 = u.pn * 256 + bj * 128 + wc * 32 + 8 * fq;
#pragma unroll
      for (int ai = 0; ai < 2; ++ai)
#pragma unroll
        for (int m = 0; m < 4; ++m) {
          const unsigned row = row0 + ai * 128 + m * 16;
          float gg[8]; unpack8(*(const u32x4*)(gate + row * 2048u + BR * 1024 + c0), gg);
          const f32x4 a = acc[ai][bj][m][0], b = acc[ai][bj][m][1];
          float v[8] = {a.x * gg[0], a.y * gg[1], a.z * gg[2], a.w * gg[3], b.x * gg[4], b.y * gg[5], b.z * gg[6], b.w * gg[7]};
          bf16_t* mp = merged + row * 1024u + c0;
          if (BR == 1) {
            float old[8]; unpack8(*(const u32x4*)mp, old);
#pragma unroll
            for (int j = 0; j < 8; ++j) v[j] += old[j];
          }
          *(u32x4*)mp = pack8(v);
        }
    }
  }
};
DI void phase_merge(const Params& p, char* smem) {
  pg8::StaticOrder S; S.init(NTOK, 1024, gridDim.x, blockIdx.x);
  {
    pg8::Gemm g{(const bf16_t*)(p.ws + OFF_ONSA), (const bf16_t*)(p.ws + OFF_WB), NTOK, 1024, 512};
    EpiMerge<0> E{p.ws};
    pg8::gemm_phase((LAS unsigned char*)smem, g, S, E);
  }
  {
    pg8::Gemm g{(const bf16_t*)(p.ws + OFF_U), (const bf16_t*)(p.ws + OFF_WB) + (size_t)1024 * 512, NTOK, 1024, 512};
    EpiMerge<1> E{p.ws};
    pg8::gemm_phase((LAS unsigned char*)smem, g, S, E);
  }
}

struct EpiOut {
  static constexpr bool PERM = true;
  char* ws; const float* x;
  DI void operator()(const f32x4 (&acc)[2][2][4][2], const pg8::Unit& u, int wr, int wc, int fr, int fq) const {
    const float* mod = (const float*)(ws + OFF_MOD);
    bf16_t* y = (bf16_t*)(ws + OFF_Y);
    const int row0 = u.pm * 256 + wr * 64 + fr, b = (u.pm * 256) >> 13;
#pragma unroll
    for (int bj = 0; bj < 2; ++bj) {
      const unsigned c0 = u.pn * 256 + bj * 128 + wc * 32 + 8 * fq;
      const f32x4 g0 = *(const f32x4*)(mod + b * 6144 + 2048 + c0), g1 = *(const f32x4*)(mod + b * 6144 + 2048 + c0 + 4);
#pragma unroll
      for (int ai = 0; ai < 2; ++ai)
#pragma unroll
        for (int m = 0; m < 4; ++m) {
          const unsigned o = (unsigned)(row0 + ai * 128 + m * 16) * 1024u + c0;
          const f32x4 x0 = *(const f32x4*)(x + o), x1v = *(const f32x4*)(x + o + 4);
          const f32x4 v0 = x0 * DN_ALPHA + g0 * acc[ai][bj][m][0], v1 = x1v * DN_ALPHA + g1 * acc[ai][bj][m][1];
          u32x4 w; w.x = pack2(v0.x, v0.y); w.y = pack2(v0.z, v0.w); w.z = pack2(v1.x, v1.y); w.w = pack2(v1.z, v1.w);
          *(u32x4*)(y + o) = w;
        }
    }
  }
};
DI void phase_outproj(const Params& p, char* smem) {
  pg8::Gemm g{(const bf16_t*)(p.ws + OFF_H), (const bf16_t*)(p.ws + OFF_WOUT), NTOK, 1024, 1024};
  pg8::StaticOrder S; S.init(NTOK, 1024, gridDim.x, blockIdx.x);
  EpiOut E{p.ws, p.x};
  pg8::gemm_phase((LAS unsigned char*)smem, g, S, E);
}

struct EpiPq {
  static constexpr bool PERM = true;
  char* ws;
  DI void operator()(const f32x4 (&acc)[2][2][4][2], const pg8::Unit& u, int wr, int wc, int fr, int fq) const {
    bf16_t* pq = (bf16_t*)(ws + OFF_PQ);
    const int row0 = u.pm * 256 + wr * 64 + fr;
#pragma unroll
    for (int bj = 0; bj < 2; ++bj) {
      const unsigned c0 = u.pn * 256 + bj * 128 + wc * 32 + 8 * fq;
#pragma unroll
      for (int ai = 0; ai < 2; ++ai)
#pragma unroll
        for (int m = 0; m < 4; ++m) {
          const f32x4 a = acc[ai][bj][m][0], b = acc[ai][bj][m][1];
          u32x4 w; w.x = pack2(a.x, a.y); w.y = pack2(a.z, a.w); w.z = pack2(b.x, b.y); w.w = pack2(b.z, b.w);
          *(u32x4*)(pq + (unsigned)(row0 + ai * 128 + m * 16) * 2048u + c0) = w;
        }
    }
  }
};
DI void phase_peerq(const Params& p, char* smem) {
  pg8::Gemm g{(const bf16_t*)(p.ws + OFF_H), (const bf16_t*)(p.ws + OFF_WQ), NTOK, 2048, 1024};
  pg8::StaticOrder S; S.init(NTOK, 2048, gridDim.x, blockIdx.x);
  EpiPq E{p.ws};
  pg8::gemm_phase((LAS unsigned char*)smem, g, S, E);
}

DI void phase_sgu(const Params& p, char* smem) {
  char* ws = p.ws;
  const int tid = otid(), lane = tid & 63, wave = tid >> 6, l31 = lane & 31, hh = lane >> 5;
  bf16_t* u = (bf16_t*)(ws + OFF_U);
  const bf16_t* v = (const bf16_t*)(ws + OFF_V);
  const bf16_t* W = (const bf16_t*)(ws + OFF_SGUW);
  float* st = (float*)smem;
  bf16_t* vn = (bf16_t*)(smem + 1024);
  constexpr int LN_ = 72;
  const int dt = wave & 1, it = wave >> 1;
  const int gi = lane >> 4, i16 = lane & 15, tq = i16 >> 2, tp = i16 & 3;
  for (int item = blockIdx.x; item < NTOK / 128; item += gridDim.x) {
    const int t0 = item * 128;
    __syncthreads();
    for (int i = 0; i < 16; ++i) {
      const int t = wave * 16 + i;
      const u32x4 raw = *(const u32x4*)(v + (size_t)(t0 + t) * 512 + lane * 8);
      float f[8]; unpack8(raw, f);
      float s = 0.f;
#pragma unroll
      for (int j = 0; j < 8; ++j) s += f[j];
      const float mean = wave_sum(s) * (1.f / 512.f);
      float q = 0.f;
#pragma unroll
      for (int j = 0; j < 8; ++j) { const float d = f[j] - mean; q += d * d; }
      const float rstd = rsqrtf(wave_sum(q) * (1.f / 512.f) + LN_EPS);
      if (lane == 0) { st[t * 2] = mean; st[t * 2 + 1] = rstd; }
    }
    u32x4 vnext[2];
#pragma unroll
    for (int i = 0; i < 2; ++i) { const int idx = tid + i * NT; vnext[i] = *(const u32x4*)(v + (size_t)(t0 + (idx >> 3)) * 512 + (idx & 7) * 8); }
    for (int g = 0; g < 8; ++g) {
      u32x4 vcur[2] = {vnext[0], vnext[1]};
      if (g + 1 < 8) {
#pragma unroll
        for (int i = 0; i < 2; ++i) { const int idx = tid + i * NT; vnext[i] = *(const u32x4*)(v + (size_t)(t0 + (idx >> 3)) * 512 + (g + 1) * 64 + (idx & 7) * 8); }
      }
      u32x2 uold[4];
      {
        const bf16_t* urow0 = u + (size_t)(t0 + it * 32 + l31) * 512 + g * 64 + dt * 32 + 4 * hh;
#pragma unroll
        for (int q4 = 0; q4 < 4; ++q4) uold[q4] = *(const u32x2*)(urow0 + 8 * q4);
      }
      lds_barrier();
#pragma unroll
      for (int i = 0; i < 2; ++i) {
        const int idx = tid + i * NT, j = idx >> 3, dc = (idx & 7) * 8;
        const u32x4 raw = vcur[i];
        const float mean = st[j * 2], rstd = st[j * 2 + 1];
        float f[8], gg[8], bb[8]; unpack8(raw, f); ld8(p.sgu_ln_g + g * 64 + dc, gg); ld8(p.sgu_ln_b + g * 64 + dc, bb);
#pragma unroll
        for (int k = 0; k < 8; ++k) f[k] = (f[k] - mean) * rstd * gg[k] + bb[k];
        *(u32x4*)(vn + j * LN_ + dc) = pack8(f);
      }
      lds_barrier();
      f32x16 acc;
#pragma unroll
      for (int r = 0; r < 16; ++r) acc[r] = 0.f;
      const bf16_t* wrow = W + ((size_t)g * 128 + it * 32 + l31) * 128 + hh * 8;
      const LAS bf16_t* vbase = (const LAS bf16_t*)vn + (8 * (gi >> 1) + tq) * LN_ + dt * 32 + 16 * (gi & 1) + 4 * tp;
#pragma unroll
      for (int ks = 0; ks < 8; ++ks) {
        if (ks <= 2 * it + 1) {
          const LAS bf16_t* vp = vbase + (ks * 16) * LN_;
          const s16x4 lo = __builtin_amdgcn_ds_read_tr16_b64_v4i16((LAS s16x4*)vp);
          const s16x4 hi = __builtin_amdgcn_ds_read_tr16_b64_v4i16((LAS s16x4*)(vp + 4 * LN_));
          const bf16x8 bw = *(const bf16x8*)(wrow + ks * 16);
          acc = MFMA32(__builtin_shufflevector(lo, hi, 0, 1, 2, 3, 4, 5, 6, 7), bw, acc);
        }
      }
      const int i = it * 32 + l31;
      const float bsv = p.sgu_b[g * 128 + i];
      bf16_t* urow = u + (size_t)(t0 + i) * 512 + g * 64 + dt * 32 + 4 * hh;
#pragma unroll
      for (int q4 = 0; q4 < 4; ++q4) {
        u32x2* up = (u32x2*)(urow + 8 * q4);
        const u32x2 old = uold[q4];
        u32x2 wv; wv.x = pack2(bflo(old.x) * (acc[4 * q4] + bsv), bfhi(old.x) * (acc[4 * q4 + 1] + bsv));
        wv.y = pack2(bflo(old.y) * (acc[4 * q4 + 2] + bsv), bfhi(old.y) * (acc[4 * q4 + 3] + bsv));
        *up = wv;
      }
    }
  }
}

DI void phase_compress(const Params& p, char* smem) {
  char* ws = p.ws;
  const int tid = otid(), lane = tid & 63, wave = tid >> 6, l31 = lane & 31, hh = lane >> 5;
  bf16_t* hid = (bf16_t*)smem;
  constexpr int LH = 136;
  for (int item = blockIdx.x; item < 128; item += gridDim.x) {
    const int w = item >> 6, R0 = (item & 63) * 128;
    const bf16_t* src = (const bf16_t*)(ws + (w == 0 ? OFF_KC : OFF_VC));
    const bf16_t* W1 = (const bf16_t*)(ws + OFF_CW1) + (size_t)w * 128 * 2048;
    const bf16_t* W2 = (const bf16_t*)(ws + OFF_CW2) + (size_t)w * 64 * 128;
    const float* posb = (const float*)(ws + OFF_POSB) + w * 128;
    const int rg = wave >> 2, cgp = wave & 3;
    const bf16_t* abase[2];
#pragma unroll
    for (int mi = 0; mi < 2; ++mi) {
      const int R = R0 + rg * 64 + mi * 32 + l31, bg = R >> 9, n = R & 511, nn = n < 510 ? n : 510;
      abase[mi] = src + ((size_t)((bg >> 1) * SEQ + 16 * nn)) * 128 + (bg & 1) * 64 + hh * 8;
    }
    const bf16_t* bbase = W1 + (size_t)(cgp * 32 + l31) * 2048 + hh * 8;
    f32x16 acc[2];
#pragma unroll
    for (int r = 0; r < 16; ++r) { acc[0][r] = 0.f; acc[1][r] = 0.f; }
#pragma unroll 8
    for (int ks = 0; ks < 128; ++ks) {
      const int aofs = (ks >> 2) * 128 + (ks & 3) * 16;
      const bf16x8 a0 = *(const bf16x8*)(abase[0] + aofs), a1 = *(const bf16x8*)(abase[1] + aofs);
      const bf16x8 bb = *(const bf16x8*)(bbase + ks * 16);
      acc[0] = MFMA32(a0, bb, acc[0]); acc[1] = MFMA32(a1, bb, acc[1]);
    }
    __syncthreads();
    {
      const float pb = posb[cgp * 32 + l31];
#pragma unroll
      for (int mi = 0; mi < 2; ++mi)
#pragma unroll
        for (int r = 0; r < 16; ++r) {
          const int row = rg * 64 + mi * 32 + (r & 3) + 8 * (r >> 2) + 4 * hh;
          hid[row * LH + cgp * 32 + l31] = f2bf(gelu_f(acc[mi][r] + pb));
        }
    }
    __syncthreads();
    const int mi2 = wave >> 1, ni = wave & 1;
    f32x16 o;
#pragma unroll
    for (int r = 0; r < 16; ++r) o[r] = 0.f;
#pragma unroll
    for (int ks = 0; ks < 8; ++ks) {
      const bf16x8 a = *(const bf16x8*)(hid + (mi2 * 32 + l31) * LH + ks * 16 + hh * 8);
      const bf16x8 bb = *(const bf16x8*)(W2 + (size_t)(ni * 32 + l31) * 128 + ks * 16 + hh * 8);
      o = MFMA32(a, bb, o);
    }
    const int d = ni * 32 + l31;
    const float b2 = p.cmp_b2[w * 64 + (w == 0 ? dperm(d) : d)];
    const int bg = R0 >> 9;
    bf16_t* dst = (bf16_t*)(ws + (w == 0 ? OFF_KCMP : OFF_VCMP));
#pragma unroll
    for (int r = 0; r < 16; ++r) {
      const int n = (R0 & 511) + mi2 * 32 + (r & 3) + 8 * (r >> 2) + 4 * hh;
      dst[((size_t)bg * 512 + n) * 64 + d] = f2bf(n < 511 ? o[r] + b2 : 0.f);
    }
  }
}

constexpr int LK = 72;
constexpr int NSA_TILE = 18432;
constexpr int NSA_AIMP = 3 * NSA_TILE, NSA_CIMP = NSA_AIMP + 32768, NSA_SELM = NSA_CIMP + 32768;
constexpr float NSA_THR = 6.0f;
struct TileRegs { u32x4 k; u32x4 v; };

DI void nsa_load_tile(TileRegs& t, const bf16_t* kbase, size_t kstride, const bf16_t* vbase, size_t vstride) {
  const int tid = otid(), r = tid >> 3, ch = tid & 7;
  t.k = *(const u32x4*)(kbase + (size_t)r * kstride + ch * 8);
  t.v = *(const u32x4*)(vbase + (size_t)r * vstride + ch * 8);
}
DI void nsa_store_tile(const TileRegs& t, char* tile) {
  const int tid = otid(), r = tid >> 3, ch = tid & 7;
  *(u32x4*)((bf16_t*)tile + r * LK + ch * 8) = t.k;
  *(u32x4*)((bf16_t*)(tile + 9216) + r * LK + ch * 8) = t.v;
}
DI void nsa_scores(f32x16 (&st)[2], const char* tile, const bf16x8 (&qf)[4], int lane) {
  const bf16_t* Ks = (const bf16_t*)tile;
#pragma unroll
  for (int kt = 0; kt < 2; ++kt)
#pragma unroll
    for (int r = 0; r < 16; ++r) st[kt][r] = 0.f;
  __builtin_amdgcn_s_setprio(1);
#pragma unroll
  for (int ks = 0; ks < 4; ++ks)
#pragma unroll
    for (int kt = 0; kt < 2; ++kt) {
      const bf16x8 a = *(const bf16x8*)(Ks + (kt * 32 + (lane & 31)) * LK + ks * 16 + (lane >> 5) * 8);
      st[kt] = MFMA32(a, qf[ks], st[kt]);
    }
  __builtin_amdgcn_s_setprio(0);
}
DI void nsa_pv(f32x16 (&o)[2], const f32x16 (&pt)[2], const char* tile, int lane) {
  const int gi = lane >> 4, i16 = lane & 15, q = i16 >> 2, pp = i16 & 3;
  const LAS bf16_t* Vs = (const LAS bf16_t*)(tile + 9216) + (4 * (gi >> 1) + q) * LK + 16 * (gi & 1) + 4 * pp;
#pragma unroll
  for (int kt = 0; kt < 2; ++kt)
#pragma unroll
    for (int s = 0; s < 2; ++s) {
      u32x4 pk; pk.x = pack2(pt[kt][8 * s], pt[kt][8 * s + 1]); pk.y = pack2(pt[kt][8 * s + 2], pt[kt][8 * s + 3]);
      pk.z = pack2(pt[kt][8 * s + 4], pt[kt][8 * s + 5]); pk.w = pack2(pt[kt][8 * s + 6], pt[kt][8 * s + 7]);
      const bf16x8 pb = __builtin_bit_cast(bf16x8, pk);
      bf16x8 a[2];
#pragma unroll
      for (int dt = 0; dt < 2; ++dt) {
        const LAS bf16_t* vp = Vs + (kt * 32 + 16 * s) * LK + dt * 32;
        const s16x4 lo = __builtin_amdgcn_ds_read_tr16_b64_v4i16((LAS s16x4*)vp);
        const s16x4 hi = __builtin_amdgcn_ds_read_tr16_b64_v4i16((LAS s16x4*)(vp + 8 * LK));
        a[dt] = __builtin_shufflevector(lo, hi, 0, 1, 2, 3, 4, 5, 6, 7);
      }
      o[0] = MFMA32(a[0], pb, o[0]); o[1] = MFMA32(a[1], pb, o[1]);
    }
}

constexpr float NSA_NEG = -3.0e38f;
DI void nsa_online(f32x16 (&st)[2], bool sel, float& m, float& l, f32x16 (&o)[2], const char* tile, int lane) {
  float mx = NSA_NEG;
#pragma unroll
  for (int r = 0; r < 16; ++r) mx = fmaxf(mx, fmaxf(st[0][r], st[1][r]));
  mx = fmaxf(mx, xor32f(mx, lane));
  mx = sel ? mx : NSA_NEG;
  if (__any(mx > m + NSA_THR)) {
    const float mn = fmaxf(m, mx);
    const float alpha = __builtin_amdgcn_exp2f(m - mn);
    m = mn; l *= alpha;
#pragma unroll
    for (int r = 0; r < 16; ++r) { o[0][r] *= alpha; o[1][r] *= alpha; }
  }
  const float ms = sel ? m : 1e30f;
  float sum = 0.f;
#pragma unroll
  for (int r = 0; r < 16; ++r) {
    const float p0 = __builtin_amdgcn_exp2f(st[0][r] - ms), p1 = __builtin_amdgcn_exp2f(st[1][r] - ms);
    st[0][r] = p0; st[1][r] = p1; sum += p0 + p1;
  }
  l += sum;
  nsa_pv(o, st, tile, lane);
}

struct NsaItem { int qb, b, g, bg, t; size_t tokrow; };
DI NsaItem nsa_item(int item0, int wave, int qi) {
  const int G = gridDim.x, k = item0 / G, bb = item0 - k * G;
  const int item = (k & 1) ? (k * G + (G - 1 - bb)) : item0;
  NsaItem it; it.qb = 127 - (item >> 4); const int rest = item & 15; it.b = rest >> 1; it.g = rest & 1;
  it.bg = it.b * 2 + it.g; it.t = it.qb * 64 + wave * 8 + qi; it.tokrow = (size_t)it.b * SEQ + it.t; return it;
}
DI void nsa_accum_store(bf16_t* dst, const f32x16 (&o)[2], float sc, bool first, int hh) {
#pragma unroll
  for (int dt = 0; dt < 2; ++dt)
#pragma unroll
    for (int q4 = 0; q4 < 4; ++q4) {
      u32x2* pp = (u32x2*)(dst + dt * 32 + 8 * q4 + 4 * hh);
      float a0 = sc * o[dt][4 * q4], a1 = sc * o[dt][4 * q4 + 1], a2 = sc * o[dt][4 * q4 + 2], a3 = sc * o[dt][4 * q4 + 3];
      if (!first) { const u32x2 old = *pp; a0 += bflo(old.x); a1 += bfhi(old.x); a2 += bflo(old.y); a3 += bfhi(old.y); }
      u32x2 wv; wv.x = pack2(a0, a1); wv.y = pack2(a2, a3);
      *pp = wv;
    }
}

constexpr int NSA_STAGE = 4 * 18432;
typedef float f32x4v __attribute__((ext_vector_type(4)));
#define MFMA16(a, b, c) __builtin_amdgcn_mfma_f32_16x16x32_bf16((a), (b), (c), 0, 0, 0)
struct StageRegs { u32x4 r[8]; };
DI void nsa_load_stage(StageRegs& sr, const bf16_t* kb, const bf16_t* vb, int j0s, int qb) {
  const int tid = otid(), r = tid >> 3, ch = tid & 7;
#pragma unroll
  for (int tt = 0; tt < 4; ++tt) {
    const int j = (j0s + tt <= qb) ? j0s + tt : qb;
    sr.r[2 * tt] = *(const u32x4*)(kb + ((size_t)j * 64 + r) * 128 + ch * 8);
    sr.r[2 * tt + 1] = *(const u32x4*)(vb + ((size_t)j * 64 + r) * 128 + ch * 8);
  }
}
DI void nsa_store_stage(const StageRegs& sr, char* stage) {
  const int tid = otid(), r = tid >> 3, ch = tid & 7;
#pragma unroll
  for (int tt = 0; tt < 4; ++tt) {
    *(u32x4*)((bf16_t*)(stage + tt * 18432) + r * LK + ch * 8) = sr.r[2 * tt];
    *(u32x4*)((bf16_t*)(stage + tt * 18432 + 9216) + r * LK + ch * 8) = sr.r[2 * tt + 1];
  }
}
struct Sel16 { float m, l; bool has; f32x4v o[4]; };
DI void nsa_unit16(Sel16& g, const char* tile, const bf16x8 (&qf)[2], bool sel, int klim  , int lane) {
  const int c16 = lane & 15, kg = lane >> 4, tq = c16 >> 2, tp = c16 & 3;
  const bf16_t* Ks = (const bf16_t*)tile + c16 * LK + kg * 8;
  f32x4v st[4];
  const float ini = sel ? -g.m : -1e30f;
#pragma unroll
  for (int kt = 0; kt < 4; ++kt) {
    st[kt] = (f32x4v){ini, ini, ini, ini};
#pragma unroll
    for (int ks = 0; ks < 2; ++ks) st[kt] = MFMA16(*(const bf16x8*)(Ks + kt * 16 * LK + ks * 32), qf[ks], st[kt]);
  }
  if (klim < 64) {
#pragma unroll
    for (int kt = 0; kt < 4; ++kt)
#pragma unroll
      for (int r = 0; r < 4; ++r) st[kt][r] = (kt * 16 + 4 * kg + r <= klim) ? st[kt][r] : NSA_NEG;
  }
  float mx = fmaxf(fmaxf(fmaxf(st[0][0], st[0][1]), fmaxf(st[0][2], st[0][3])), fmaxf(fmaxf(st[1][0], st[1][1]), fmaxf(st[1][2], st[1][3])));
  mx = fmaxf(mx, fmaxf(fmaxf(fmaxf(st[2][0], st[2][1]), fmaxf(st[2][2], st[2][3])), fmaxf(fmaxf(st[3][0], st[3][1]), fmaxf(st[3][2], st[3][3]))));
  mx = fmaxf(mx, xor16f(mx, lane));
  mx = fmaxf(mx, xor32f(mx, lane));
  const bool real = mx > -1e29f;
  const bool fresh = !g.has && real, up = g.has && (mx > NSA_THR);
  if (__any(fresh || up)) {
    const float delta = (fresh || up) ? mx : 0.f;
    const float alpha = up ? __builtin_amdgcn_exp2f(-delta) : 1.0f;
    g.m += delta; g.l *= alpha;
#pragma unroll
    for (int dt = 0; dt < 4; ++dt) g.o[dt] *= alpha;
#pragma unroll
    for (int kt = 0; kt < 4; ++kt) st[kt] -= delta;
  }
  g.has = g.has || real;
  float sum = 0.f;
#pragma unroll
  for (int kt = 0; kt < 4; ++kt)
#pragma unroll
    for (int r = 0; r < 4; ++r) { const float pv = __builtin_amdgcn_exp2f(st[kt][r]); st[kt][r] = pv; sum += pv; }
  g.l += sum;
  const LAS bf16_t* Vs = (const LAS bf16_t*)(tile + 9216) + (4 * kg + tq) * LK + 4 * tp;
#pragma unroll
  for (int kp = 0; kp < 2; ++kp) {
    u32x4 pk; pk.x = pack2(st[2 * kp][0], st[2 * kp][1]); pk.y = pack2(st[2 * kp][2], st[2 * kp][3]);
    pk.z = pack2(st[2 * kp + 1][0], st[2 * kp + 1][1]); pk.w = pack2(st[2 * kp + 1][2], st[2 * kp + 1][3]);
    const bf16x8 pb = __builtin_bit_cast(bf16x8, pk);
#pragma unroll
    for (int dt = 0; dt < 4; ++dt) {
      const LAS bf16_t* vp = Vs + (2 * kp) * 16 * LK + dt * 16;
      const s16x4 lo = __builtin_amdgcn_ds_read_tr16_b64_v4i16((LAS s16x4*)vp);
      const s16x4 hi = __builtin_amdgcn_ds_read_tr16_b64_v4i16((LAS s16x4*)(vp + 16 * LK));
      g.o[dt] = MFMA16(__builtin_shufflevector(lo, hi, 0, 1, 2, 3, 4, 5, 6, 7), pb, g.o[dt]);
    }
  }
}
DI void nsa_sel16(const Params& p, char* smem, bool dry) {
  char* ws = p.ws;
  const int tid = otid(), lane = tid & 63, wave = tid >> 6, c16 = lane & 15, kg = lane >> 4, qi4 = c16 >> 2, r4 = c16 & 3;
  const bf16_t* Q = (const bf16_t*)(ws + OFF_Q);
  const float* gsig = (const float*)(ws + OFF_GSIG);
  bf16_t* ONSA = (bf16_t*)(ws + OFF_ONSA);
  const u32x4* SELG = (const u32x4*)(ws + OFF_SELG);
  const bf16_t* KS = (const bf16_t*)(ws + OFF_KS); const bf16_t* VS = (const bf16_t*)(ws + OFF_VS);
  constexpr int NITEM = NB * 2 * 128;
  for (int item = blockIdx.x; item < NITEM; item += gridDim.x) {
    const NsaItem it = nsa_item(item, wave, 0);
    const int qb = it.qb;
    bf16x8 qf[2][2]; u32x4 selw[2]; float g_s[2]; int tg[2]; Sel16 G[2];
#pragma unroll
    for (int gq = 0; gq < 2; ++gq) {
      tg[gq] = it.t + 4 * gq + qi4;
      const size_t tokrow = (size_t)it.b * SEQ + tg[gq];
#pragma unroll
      for (int ks = 0; ks < 2; ++ks) qf[gq][ks] = *(const bf16x8*)(Q + tokrow * 512 + (it.g * 4 + r4) * 64 + ks * 32 + kg * 8);
      selw[gq] = SELG[(size_t)it.bg * SEQ + tg[gq]];
      g_s[gq] = gsig[tokrow * 32 + (it.g * 4 + r4) * 3 + 1];
      G[gq].m = 0.f; G[gq].l = 0.f; G[gq].has = false;
#pragma unroll
      for (int dt = 0; dt < 4; ++dt) G[gq].o[dt] = (f32x4v){0.f, 0.f, 0.f, 0.f};
    }
    const bf16_t* kb = KS + (size_t)it.b * SEQ * 128 + it.g * 64;
    const bf16_t* vb = VS + (size_t)it.b * SEQ * 128 + it.g * 64;
    const int nst = (qb >> 2) + 1;
    StageRegs sr;
    lds_barrier();
    nsa_load_stage(sr, kb, vb, 0, qb);
    nsa_store_stage(sr, smem);
    lds_barrier();
    for (int sidx = 0; sidx < nst; ++sidx) {
      const char* stage = smem + (sidx & 1) * NSA_STAGE;
      if (sidx + 1 < nst) nsa_load_stage(sr, kb, vb, 4 * (sidx + 1), qb);
#pragma unroll 1
      for (int tt = 0; tt < 4; ++tt) {
        const int j = 4 * sidx + tt;
        if (j > qb) break;
#pragma unroll
        for (int gq = 0; gq < 2; ++gq) {
          const unsigned w = j < 32 ? selw[gq].x : (j < 64 ? selw[gq].y : (j < 96 ? selw[gq].z : selw[gq].w));
          const bool sel = (w >> (j & 31)) & 1u;
          if (__any(sel)) nsa_unit16(G[gq], stage + tt * 18432, qf[gq], sel, (j == qb) ? (tg[gq] - j * 64) : 1000, lane);
        }
      }
      if (sidx + 1 < nst) nsa_store_stage(sr, smem + ((sidx + 1) & 1) * NSA_STAGE);
      lds_barrier();
    }
#pragma unroll
    for (int gq = 0; gq < 2; ++gq) {
      float l = G[gq].l;
      l += xor16f(l, lane); l += xor32f(l, lane);
      const float sc = l > 0.f ? g_s[gq] / l : 0.f;
      bf16_t* dst = ONSA + ((size_t)it.b * SEQ + tg[gq]) * 512 + (it.g * 4 + r4) * 64 + 4 * kg;
      if (!dry) {
#pragma unroll
        for (int dt = 0; dt < 4; ++dt) {
          u32x2* pp = (u32x2*)(dst + dt * 16);
          const u32x2 old = *pp;
          u32x2 wv; wv.x = pack2(bflo(old.x) + sc * G[gq].o[dt][0], bfhi(old.x) + sc * G[gq].o[dt][1]);
          wv.y = pack2(bflo(old.y) + sc * G[gq].o[dt][2], bfhi(old.y) + sc * G[gq].o[dt][3]);
          *pp = wv;
        }
      } else asm volatile("" :: "v"(G[gq].o[0]), "v"(G[gq].o[1]), "v"(G[gq].o[2]), "v"(G[gq].o[3]), "v"(l));
    }
  }
}

DI void phase_nsa(const Params& p, char* smem, int branch_mask) {
  char* ws = p.ws;
  const int tid = otid(), lane = tid & 63, wave = tid >> 6, hh = lane >> 5, c = lane & 31, qi = c >> 2, r4 = c & 3;
  const bf16_t* Q = (const bf16_t*)(ws + OFF_Q);
  const float* gsig = (const float*)(ws + OFF_GSIG);
  bf16_t* ONSA = (bf16_t*)(ws + OFF_ONSA);
  u32x4* SELG = (u32x4*)(ws + OFF_SELG);
  constexpr int NITEM = NB * 2 * 128;

#pragma unroll 1
  for (int rep1 = 0; rep1 < ((PROBE_DUP & 4096) ? 2 : 1); ++rep1) {
    const bf16_t* KCMP = (const bf16_t*)(ws + OFF_KCMP); const bf16_t* VCMP = (const bf16_t*)(ws + OFF_VCMP);
    float* Aimp = (float*)(smem + NSA_AIMP) + wave * 1024;
    float* Cimp = (float*)(smem + NSA_CIMP) + wave * 1024;
    unsigned short* selm16 = (unsigned short*)(smem + NSA_SELM) + wave * 64;
    const u32x4* selm128 = (const u32x4*)(smem + NSA_SELM) + wave * 8;
    for (int item = blockIdx.x; item < NITEM; item += gridDim.x) {
      const NsaItem it = nsa_item(item, wave, qi);
      const int t = it.t;
      bf16x8 qf[4];
#pragma unroll
      for (int ks = 0; ks < 4; ++ks) qf[ks] = *(const bf16x8*)(Q + it.tokrow * 512 + (it.g * 4 + r4) * 64 + ks * 16 + hh * 8);
      const float g_c = gsig[it.tokrow * 32 + (it.g * 4 + r4) * 3 + 0];
      TileRegs tr;
      const int nmax = (it.qb * 64 + 63 - 31) >> 4, ntile = (nmax >> 6) + 1;
      const int nfull = (it.qb * 64 - 31) >> 4;
      const bf16_t* kb = KCMP + (size_t)it.bg * 512 * 64;
      const bf16_t* vb = VCMP + (size_t)it.bg * 512 * 64;
      float m = -1e30f, l = 0.f;
      nsa_load_tile(tr, kb, 64, vb, 64);
      nsa_store_tile(tr, smem);
      __syncthreads();
      for (int j = 0; j < ntile; ++j) {
        const char* tile = smem + (j & 1) * NSA_TILE;
        if (j + 1 < ntile) nsa_load_tile(tr, kb + (size_t)(j + 1) * 64 * 64, 64, vb + (size_t)(j + 1) * 64 * 64, 64);
        f32x16 st[2];
        nsa_scores(st, tile, qf, lane);
        const bool full = (j * 64 + 63 <= nfull);
        const int nlim = full ? 100000 : ((t - 31) >> 4) - j * 64 - 4 * hh;
        float mx = NSA_NEG;
#pragma unroll
        for (int kt = 0; kt < 2; ++kt)
#pragma unroll
          for (int r = 0; r < 16; ++r) {
            st[kt][r] = (kt * 32 + (r & 3) + 8 * (r >> 2) <= nlim) ? st[kt][r] : NSA_NEG;
            mx = fmaxf(mx, st[kt][r]);
          }
        mx = fmaxf(mx, xor32f(mx, lane));
        const float mn = fmaxf(m, mx);
        float sum = 0.f;
#pragma unroll
        for (int kt = 0; kt < 2; ++kt)
#pragma unroll
          for (int r = 0; r < 16; ++r) sum += __builtin_amdgcn_exp2f(st[kt][r] - mn);
        l = l * __builtin_amdgcn_exp2f(m - mn) + sum;
        m = mn;
        if (j + 1 < ntile) nsa_store_tile(tr, smem + ((j + 1) & 1) * NSA_TILE);
        __syncthreads();
      }
      l += xor32f(l, lane);
      const float inv_l = l > 0.f ? 1.0f / l : 0.f;
      f32x16 o[2];
#pragma unroll
      for (int r = 0; r < 16; ++r) { o[0][r] = 0.f; o[1][r] = 0.f; }
      nsa_load_tile(tr, kb, 64, vb, 64);
      nsa_store_tile(tr, smem);
      __syncthreads();
      for (int j = 0; j < ntile; ++j) {
        const char* tile = smem + (j & 1) * NSA_TILE;
        if (j + 1 < ntile) nsa_load_tile(tr, kb + (size_t)(j + 1) * 64 * 64, 64, vb + (size_t)(j + 1) * 64 * 64, 64);
        f32x16 st[2];
        nsa_scores(st, tile, qf, lane);
        const bool full = (j * 64 + 63 <= nfull);
        const int nlim = full ? 100000 : ((t - 31) >> 4) - j * 64 - 4 * hh;
#pragma unroll
        for (int kt = 0; kt < 2; ++kt)
#pragma unroll
          for (int r = 0; r < 16; ++r) {
            const float arg = (kt * 32 + (r & 3) + 8 * (r >> 2) <= nlim) ? st[kt][r] - m : NSA_NEG;
            st[kt][r] = __builtin_amdgcn_exp2f(arg) * inv_l;
          }
#pragma unroll
        for (int kt = 0; kt < 2; ++kt)
#pragma unroll
          for (int c4 = 0; c4 < 4; ++c4) {
            float carry = 0.5f * st[kt][4 * c4 + 3];
            float fullv = st[kt][4 * c4] + st[kt][4 * c4 + 1] + st[kt][4 * c4 + 2] + carry;
            fullv += xor1f(fullv); fullv += xor2f(fullv);
            carry += xor1f(carry); carry += xor2f(carry);
            const int jb = j * 16 + kt * 8 + 2 * c4 + hh;
            if (r4 == 0) { Aimp[qi * 128 + jb] = fullv; Cimp[qi * 128 + jb] = carry; }
          }
        if (branch_mask & 1) nsa_pv(o, st, tile, lane);
        if (j + 1 < ntile) nsa_store_tile(tr, smem + ((j + 1) & 1) * NSA_TILE);
        __syncthreads();
      }
      nsa_accum_store(ONSA + it.tokrow * 512 + (it.g * 4 + r4) * 64, o, (branch_mask & 1) ? g_c : 0.f, true, hh);
      const int cur = it.qb;
      if (cur <= 15) {
        if (lane < 8) { selm16[lane * 8 + 0] = (unsigned short)((2u << cur) - 1u);
#pragma unroll
          for (int k = 1; k < 8; ++k) selm16[lane * 8 + k] = 0; }
      } else {
        const int qs = lane >> 3, sub = lane & 7;
        float v[16];
#pragma unroll
        for (int i = 0; i < 16; ++i) {
          const int jj = sub * 16 + i;
          const bool ok = (jj >= 1) && (jj <= cur - 2);
          const int jm = jj >= 1 ? jj - 1 : 0;
          v[i] = ok ? (Aimp[qs * 128 + jj] + Cimp[qs * 128 + jm]) : -3e38f;
        }
        unsigned bits = 0;
        for (int itn = 0; itn < 13; ++itn) {
          float bv = v[0]; int bi = 0;
#pragma unroll
          for (int i = 1; i < 16; ++i) if (v[i] > bv) { bv = v[i]; bi = i; }
          int bj = sub * 16 + bi;
#pragma unroll
          for (int o2 = 1; o2 < 8; o2 <<= 1) {
            const float ov = __shfl_xor(bv, o2); const int oj = __shfl_xor(bj, o2);
            if (ov > bv || (ov == bv && oj < bj)) { bv = ov; bj = oj; }
          }
          if ((bj >> 4) == sub) {
            const int i2 = bj & 15;
#pragma unroll
            for (int i = 0; i < 16; ++i) if (i == i2) v[i] = -3e38f;
            bits |= 1u << i2;
          }
        }
        if (sub == 0) bits |= 1u;
        if ((cur >> 4) == sub) bits |= 1u << (cur & 15);
        if (((cur - 1) >> 4) == sub) bits |= 1u << ((cur - 1) & 15);
        selm16[qs * 8 + sub] = (unsigned short)bits;
      }
      __syncthreads();
      if (r4 == 0 && hh == 0) SELG[(size_t)it.bg * SEQ + t] = selm128[qi];
    }
  }
  __threadfence_block();
  __syncthreads();

#pragma unroll 1
  for (int sweep_i = 0; sweep_i < 2 + ((PROBE_DUP & 1024) ? 1 : 0) + ((PROBE_DUP & 2048) ? 1 : 0); ++sweep_i) {
    const int sweep = (sweep_i < 2) ? sweep_i : (((PROBE_DUP & 1024) && sweep_i == 2) ? 0 : 1);
    const bool dry = sweep_i >= 2;
    if (!(branch_mask & (sweep == 0 ? 2 : 4))) continue;
    if (sweep == 0) { nsa_sel16(p, smem, dry); continue; }
    const bf16_t* KB = (const bf16_t*)(ws + (sweep == 0 ? OFF_KS : OFF_KW)); const bf16_t* VB = (const bf16_t*)(ws + (sweep == 0 ? OFF_VS : OFF_VW));
    for (int item = blockIdx.x; item < NITEM; item += gridDim.x) {
      const NsaItem it = nsa_item(item, wave, qi);
      const int t = it.t, qb = it.qb;
      bf16x8 qf[4];
#pragma unroll
      for (int ks = 0; ks < 4; ++ks) qf[ks] = *(const bf16x8*)(Q + it.tokrow * 512 + (it.g * 4 + r4) * 64 + ks * 16 + hh * 8);
      const float g_b = gsig[it.tokrow * 32 + (it.g * 4 + r4) * 3 + 1 + sweep];
      u32x4 selw = {0xffffffffu, 0xffffffffu, 0xffffffffu, 0xffffffffu};
      if (sweep == 0) selw = SELG[(size_t)it.bg * SEQ + t];
      TileRegs tr;
      const bf16_t* kb = KB + (size_t)it.b * SEQ * 128 + it.g * 64;
      const bf16_t* vb = VB + (size_t)it.b * SEQ * 128 + it.g * 64;
      float m = -1e30f, l = 0.f;
      f32x16 o[2];
#pragma unroll
      for (int r = 0; r < 16; ++r) { o[0][r] = 0.f; o[1][r] = 0.f; }
      const int j0 = (sweep == 1 && qb >= 8) ? qb - 8 : 0;
      __syncthreads();
      nsa_load_tile(tr, kb + (size_t)j0 * 64 * 128, 128, vb + (size_t)j0 * 64 * 128, 128);
      nsa_store_tile(tr, smem);
      if (j0 + 1 <= qb) { nsa_load_tile(tr, kb + (size_t)(j0 + 1) * 64 * 128, 128, vb + (size_t)(j0 + 1) * 64 * 128, 128); nsa_store_tile(tr, smem + NSA_TILE); }
      if (j0 + 2 <= qb) nsa_load_tile(tr, kb + (size_t)(j0 + 2) * 64 * 128, 128, vb + (size_t)(j0 + 2) * 64 * 128, 128);
      __syncthreads();
      const bool late = wave >= 4;
      if (__builtin_amdgcn_readfirstlane(wave) >= 4) __builtin_amdgcn_s_setprio(1);
      bool has = false;
      m = 0.f;
      f32x16 st[2];
      {
        const unsigned w0 = j0 < 32 ? selw.x : (j0 < 64 ? selw.y : (j0 < 96 ? selw.z : selw.w));
        const float ini = ((w0 >> (j0 & 31)) & 1u) ? 0.f : -1e30f;
#pragma unroll
        for (int r = 0; r < 16; ++r) { st[0][r] = ini; st[1][r] = ini; }
        const bf16_t* Kc = (const bf16_t*)smem;
#pragma unroll
        for (int ks = 0; ks < 4; ++ks)
#pragma unroll
          for (int kt = 0; kt < 2; ++kt) st[kt] = MFMA32(*(const bf16x8*)(Kc + (kt * 32 + (lane & 31)) * LK + ks * 16 + (lane >> 5) * 8), qf[ks], st[kt]);
      }
      int bi = 0;
      for (int j = j0; j <= qb; ++j) {
        const char* tile = smem + bi * NSA_TILE;
        const int bn = bi == 2 ? 0 : bi + 1, bnn = bn == 2 ? 0 : bn + 1;
        const int jn = j + 1;
        const unsigned wn = jn < 32 ? selw.x : (jn < 64 ? selw.y : (jn < 96 ? selw.z : selw.w));
        const bool seln = (wn >> (jn & 31)) & 1u;
        const bf16_t* Kn = (const bf16_t*)(smem + bn * NSA_TILE) + (lane & 31) * LK + (lane >> 5) * 8;
        f32x16 sn[2];
        if (!late) {
          const float ini = seln ? -m : -1e30f;
#pragma unroll
          for (int r = 0; r < 16; ++r) { sn[0][r] = ini; sn[1][r] = ini; }
#pragma unroll
          for (int ks = 0; ks < 4; ++ks)
#pragma unroll
            for (int kt = 0; kt < 2; ++kt) sn[kt] = MFMA32(*(const bf16x8*)(Kn + kt * 32 * LK + ks * 16), qf[ks], sn[kt]);
        }
        if (j == qb || (sweep == 1 && j == qb - 8)) {
          const int khi = t - j * 64 - 4 * hh, klo = (sweep == 1) ? khi - 511 : -100000;
#pragma unroll
          for (int r = 0; r < 16; ++r) {
            const int o0 = (r & 3) + 8 * (r >> 2);
            st[0][r] = (o0 <= khi && o0 >= klo) ? st[0][r] : NSA_NEG;
            st[1][r] = (o0 + 32 <= khi && o0 + 32 >= klo) ? st[1][r] : NSA_NEG;
          }
        }
        float mx;
        {
          float a0, a1, a2, a3;
          asm("v_max3_f32 %0, %1, %2, %3" : "=v"(a0) : "v"(st[0][0]), "v"(st[0][1]), "v"(st[0][2]));
          asm("v_max3_f32 %0, %1, %2, %3" : "=v"(a1) : "v"(st[0][3]), "v"(st[0][4]), "v"(st[0][5]));
          asm("v_max3_f32 %0, %1, %2, %3" : "=v"(a2) : "v"(st[0][6]), "v"(st[0][7]), "v"(st[0][8]));
          asm("v_max3_f32 %0, %1, %2, %3" : "=v"(a3) : "v"(st[0][9]), "v"(st[0][10]), "v"(st[0][11]));
          asm("v_max3_f32 %0, %1, %2, %3" : "=v"(a0) : "v"(a0), "v"(st[0][12]), "v"(st[0][13]));
          asm("v_max3_f32 %0, %1, %2, %3" : "=v"(a1) : "v"(a1), "v"(st[0][14]), "v"(st[0][15]));
          asm("v_max3_f32 %0, %1, %2, %3" : "=v"(a2) : "v"(a2), "v"(st[1][0]), "v"(st[1][1]));
          asm("v_max3_f32 %0, %1, %2, %3" : "=v"(a3) : "v"(a3), "v"(st[1][2]), "v"(st[1][3]));
          asm("v_max3_f32 %0, %1, %2, %3" : "=v"(a0) : "v"(a0), "v"(st[1][4]), "v"(st[1][5]));
          asm("v_max3_f32 %0, %1, %2, %3" : "=v"(a1) : "v"(a1), "v"(st[1][6]), "v"(st[1][7]));
          asm("v_max3_f32 %0, %1, %2, %3" : "=v"(a2) : "v"(a2), "v"(st[1][8]), "v"(st[1][9]));
          asm("v_max3_f32 %0, %1, %2, %3" : "=v"(a3) : "v"(a3), "v"(st[1][10]), "v"(st[1][11]));
          asm("v_max3_f32 %0, %1, %2, %3" : "=v"(a0) : "v"(a0), "v"(st[1][12]), "v"(st[1][13]));
          asm("v_max3_f32 %0, %1, %2, %3" : "=v"(a1) : "v"(a1), "v"(st[1][14]), "v"(st[1][15]));
          asm("v_max3_f32 %0, %1, %2, %3" : "=v"(a0) : "v"(a0), "v"(a1), "v"(a2));
          const float other = a3;
          asm("v_max_f32 %0, %1, %2" : "=v"(mx) : "v"(a0), "v"(other));
          const float px = xor32f(mx, lane);
          asm("v_max_f32 %0, %1, %2" : "=v"(mx) : "v"(mx), "v"(px));
        }
        const bool real = mx > -1e29f;
        const bool fresh = !has && real, up = has && (mx > NSA_THR);
        if (__any(fresh || up)) {
          const float delta = (fresh || up) ? mx : 0.f;
          const float alpha = up ? __builtin_amdgcn_exp2f(-delta) : 1.0f;
          m += delta; l *= alpha;
#pragma unroll
          for (int r = 0; r < 16; ++r) { o[0][r] *= alpha; o[1][r] *= alpha; st[0][r] -= delta; st[1][r] -= delta; }
          if (!late) {
            const float dn = seln ? delta : 0.f;
#pragma unroll
            for (int r = 0; r < 16; ++r) { sn[0][r] -= dn; sn[1][r] -= dn; }
          }
        }
        has = has || real;
        f32x2 s2 = {0.f, 0.f};
#pragma unroll
        for (int r = 0; r < 16; ++r) {
          const float p0 = __builtin_amdgcn_exp2f(st[0][r]), p1 = __builtin_amdgcn_exp2f(st[1][r]);
          st[0][r] = p0; st[1][r] = p1; s2 += (f32x2){p0, p1};
        }
        l += s2.x + s2.y;
        nsa_pv(o, st, tile, lane);
        if (late) {
          const float ini = seln ? -m : -1e30f;
#pragma unroll
          for (int r = 0; r < 16; ++r) { sn[0][r] = ini; sn[1][r] = ini; }
#pragma unroll
          for (int ks = 0; ks < 4; ++ks)
#pragma unroll
            for (int kt = 0; kt < 2; ++kt) sn[kt] = MFMA32(*(const bf16x8*)(Kn + kt * 32 * LK + ks * 16), qf[ks], sn[kt]);
        }
        if (j + 2 <= qb) nsa_store_tile(tr, smem + bnn * NSA_TILE);
        if (j + 3 <= qb) nsa_load_tile(tr, kb + (size_t)(j + 3) * 64 * 128, 128, vb + (size_t)(j + 3) * 64 * 128, 128);
#pragma unroll
        for (int r = 0; r < 16; ++r) { st[0][r] = sn[0][r]; st[1][r] = sn[1][r]; }
        bi = bn;
        __syncthreads();
      }
      __builtin_amdgcn_s_setprio(0);
      l += xor32f(l, lane);
      if (!dry) nsa_accum_store(ONSA + it.tokrow * 512 + (it.g * 4 + r4) * 64, o, l > 0.f ? g_b / l : 0.f, false, hh);
      else asm volatile("" :: "v"(o[0]), "v"(o[1]), "v"(l));
    }
  }
}

DI unsigned ord_key(float f) { const unsigned u = __float_as_uint(f); return (u & 0x80000000u) ? ~u : (u | 0x80000000u); }
DI float ord_val(unsigned k) { return __uint_as_float((k & 0x80000000u) ? (k & 0x7fffffffu) : ~k); }
DI void cex(unsigned& hi, unsigned& lo) { const unsigned x = hi, y = lo; hi = x > y ? x : y; lo = x > y ? y : x; }
DI void sort16_desc(unsigned (&a)[16]) {
#pragma unroll
  for (int k = 2; k <= 16; k <<= 1)
#pragma unroll
    for (int j = k >> 1; j > 0; j >>= 1)
#pragma unroll
      for (int i = 0; i < 16; ++i) {
        const int l = i ^ j;
        if (l > i) { if ((i & k) == 0) cex(a[i], a[l]); else cex(a[l], a[i]); }
      }
}
DI void bitonic_finish16(unsigned (&a)[16]) {
#pragma unroll
  for (int j = 8; j > 0; j >>= 1)
#pragma unroll
    for (int i = 0; i < 16; ++i) { const int l = i ^ j; if (l > i) cex(a[i], a[l]); }
}
DI void merge_top16(unsigned (&a)[16], const unsigned (&b)[16]) {
#pragma unroll
  for (int i = 0; i < 16; ++i) a[i] = a[i] > b[15 - i] ? a[i] : b[15 - i];
  bitonic_finish16(a);
}
DI void merge_partner16(unsigned (&a)[16]) {
  unsigned b[16];
#pragma unroll
  for (int i = 0; i < 16; ++i) b[i] = xor32u(a[i], otid());
  merge_top16(a, b);
}


constexpr int KLD = 136;
DI void peer_top16(unsigned (&top)[16], const bf16x8 (&bq)[8], const bf16_t* keys  , int lane) {
  const int l31 = lane & 31, hh = lane >> 5;
  unsigned grp[16];
#pragma unroll
  for (int nt = 0; nt < 4; ++nt) {
    f32x16 sa;
#pragma unroll
    for (int r = 0; r < 16; ++r) sa[r] = 0.f;
    const bf16_t* kp = keys + (nt * 32 + l31) * KLD + hh * 8;
#pragma unroll
    for (int ks = 0; ks < 8; ++ks) { const bf16x8 a = *(const bf16x8*)(kp + ks * 16); sa = MFMA32(a, bq[ks], sa); }
#pragma unroll
    for (int r = 0; r < 16; ++r) {
      const int n = nt * 32 + (r & 3) + 8 * (r >> 2) + 4 * hh;
      grp[r] = (ord_key(sa[r]) & ~0x7Fu) | (unsigned)(127 - n);
    }
    sort16_desc(grp);
    if (nt == 0) {
#pragma unroll
      for (int i = 0; i < 16; ++i) top[i] = grp[i];
    } else merge_top16(top, grp);
  }
  merge_partner16(top);
}

DI void phase_route(const Params& p, char* smem) {
  char* ws = p.ws;
  const int tid = otid(), lane = tid & 63, wave = tid >> 6, l31 = lane & 31, hh = lane >> 5;
  const bf16_t* pq = (const bf16_t*)(ws + OFF_PQ);
  const bf16_t* pk = (const bf16_t*)(ws + OFF_PKEYS);
  int* eidx = (int*)(ws + OFF_EIDX);
  float* pgate = (float*)(ws + OFF_PGATE);
  bf16_t* KL = (bf16_t*)smem;
  unsigned* LS = (unsigned*)(smem + 2 * 128 * KLD * 2) + wave * 1024;
  {
    const int h0 = blockIdx.x & 7;
    __syncthreads();
#pragma unroll
    for (int i = 0; i < 8; ++i) {
      const int idx = tid + i * NT, row = idx >> 4, ch = idx & 15;
      *(u32x4*)(KL + row * KLD + ch * 8) = *(const u32x4*)(pk + ((size_t)h0 * 256 + row) * 128 + ch * 8);
    }
    __syncthreads();
  }
  constexpr int CA[64] = {0,0,0,0,0,0,0,0,0,0,0,0,0,0,0,0, 1,1,1,1,1,1,1,1, 2,2,2,2,2, 3,3,3,3, 4,4,4, 5,5, 6,6, 7,7, 8,9,10,11,12,13,14,15, 0,0,0,0,0,0,0,0,0,0,0,0,0,0};
  constexpr int CB[64] = {0,1,2,3,4,5,6,7,8,9,10,11,12,13,14,15, 0,1,2,3,4,5,6,7, 0,1,2,3,4, 0,1,2,3, 0,1,2, 0,1, 0,1, 0,1, 0,0,0,0,0,0,0,0, 0,0,0,0,0,0,0,0,0,0,0,0,0,0};
  for (int item = blockIdx.x; item < (NTOK / 256) * 8; item += gridDim.x) {
    const int h = item & 7, t0 = (item >> 3) * 256 + wave * 32;
    unsigned s1[16], s2[16];
    const bf16_t* pqrow = pq + (size_t)(t0 + l31) * 2048 + h * 256 + hh * 8;
    bf16x8 bq1[8], bq2[8];
#pragma unroll
    for (int ks = 0; ks < 8; ++ks) { bq1[ks] = *(const bf16x8*)(pqrow + ks * 16); bq2[ks] = *(const bf16x8*)(pqrow + 128 + ks * 16); }
    peer_top16(s1, bq1, KL, lane);
    peer_top16(s2, bq2, KL + 128 * KLD, lane);
    float f1[16], f2[16];
#pragma unroll
    for (int i = 0; i < 16; ++i) { f1[i] = ord_val(s1[i]); f2[i] = ord_val(s2[i]); }
    unsigned ca[16], cb2[16];
#pragma unroll
    for (int i = 0; i < 32; ++i) {
      const int i0 = i, i1 = 25 + i;
      unsigned k0 = 0u, k1 = 0u;
      if (i0 < 25) k0 = (ord_key(f1[CA[i0]] + f2[CB[i0]]) & ~0xFFu) | (unsigned)(255 - (CA[i0] * 16 + CB[i0]));
      if (i1 < 50) k1 = (ord_key(f1[CA[i1]] + f2[CB[i1]]) & ~0xFFu) | (unsigned)(255 - (CA[i1] * 16 + CB[i1]));
      const unsigned kk = hh ? k1 : k0;
      if (i < 16) ca[i] = kk; else cb2[i - 16] = kk;
    }
    sort16_desc(ca); sort16_desc(cb2);
    merge_top16(ca, cb2);
    merge_partner16(ca);
    if (hh == 0) {
#pragma unroll
      for (int i = 0; i < 16; ++i) { LS[l31 * 32 + i] = s1[i]; LS[l31 * 32 + 16 + i] = s2[i]; }
    }
    const float mx = ord_val(ca[0]);
    float ex[16], sum = 0.f;
#pragma unroll
    for (int i = 0; i < 16; ++i) { ex[i] = __expf(ord_val(ca[i]) - mx); sum += ex[i]; }
    const float inv = 1.0f / sum;
    int eo[16]; float go[16];
#pragma unroll
    for (int i = 0; i < 16; ++i) {
      const int flat = 255 - (int)(ca[i] & 0xFFu);
      const unsigned k1 = LS[l31 * 32 + (flat >> 4)], k2 = LS[l31 * 32 + 16 + (flat & 15)];
      eo[i] = (127 - (int)(k1 & 0x7Fu)) * 128 + (127 - (int)(k2 & 0x7Fu));
      go[i] = ex[i] * inv;
    }
    const size_t ob = ((size_t)(t0 + l31) * 8 + h) * 16;
    if (hh == 0) {
      *(u32x4*)(eidx + ob) = (u32x4){(unsigned)eo[0], (unsigned)eo[1], (unsigned)eo[2], (unsigned)eo[3]};
      *(u32x4*)(eidx + ob + 4) = (u32x4){(unsigned)eo[4], (unsigned)eo[5], (unsigned)eo[6], (unsigned)eo[7]};
      *(f32x4*)(pgate + ob) = (f32x4){go[0], go[1], go[2], go[3]};
      *(f32x4*)(pgate + ob + 4) = (f32x4){go[4], go[5], go[6], go[7]};
    } else {
      *(u32x4*)(eidx + ob + 8) = (u32x4){(unsigned)eo[8], (unsigned)eo[9], (unsigned)eo[10], (unsigned)eo[11]};
      *(u32x4*)(eidx + ob + 12) = (u32x4){(unsigned)eo[12], (unsigned)eo[13], (unsigned)eo[14], (unsigned)eo[15]};
      *(f32x4*)(pgate + ob + 8) = (f32x4){go[8], go[9], go[10], go[11]};
      *(f32x4*)(pgate + ob + 12) = (f32x4){go[12], go[13], go[14], go[15]};
    }
  }
}

#define FOR32(M) M(0) M(1) M(2) M(3) M(4) M(5) M(6) M(7) M(8) M(9) M(10) M(11) M(12) M(13) M(14) M(15) M(16) M(17) M(18) M(19) M(20) M(21) M(22) M(23) M(24) M(25) M(26) M(27) M(28) M(29) M(30) M(31)
#define FOR16(M) M(0) M(1) M(2) M(3) M(4) M(5) M(6) M(7) M(8) M(9) M(10) M(11) M(12) M(13) M(14) M(15)
DI void phase_ffn_u(const Params& p) {
  char* ws = p.ws;
  const int lane = otid() & 63, wave = otid() >> 6, pg = lane >> 3, dc = lane & 7;
  const int sl = blockIdx.x & 7, wslot = (blockIdx.x >> 3) * NW + wave, nw = (gridDim.x >> 3) * NW;
  const unsigned char* PU8 = (const unsigned char*)(ws + OFF_PU8) + (size_t)sl * 16384 * 128 + dc * 16;
  const unsigned char* h2q = (const unsigned char*)(ws + OFF_H2Q) + sl * 128 + dc * 16;
  const int* eidx = (const int*)(ws + OFF_EIDX);
  float* part = (float*)(ws + OFF_PART) + (size_t)sl * NTOK * 128;
  const int j0 = (dc >> 2) * 64 + ((2 * dc) & 7) * 8 + pg;
  int ev0 = 0, ev1 = 0, nev0 = 0, nev1 = 0; u32x4 hq = {0u, 0u, 0u, 0u}, nhq = hq;
  if (wslot < NTOK) { ev0 = eidx[(size_t)wslot * 128 + lane]; ev1 = eidx[(size_t)wslot * 128 + 64 + lane]; hq = *(const u32x4*)(h2q + (size_t)wslot * DM); }
  for (int t = wslot; t < NTOK; t += nw) {
    if (t + nw < NTOK) { const size_t o = (size_t)(t + nw) * 128; nev0 = eidx[o + lane]; nev1 = eidx[o + 64 + lane]; nhq = *(const u32x4*)(h2q + (size_t)(t + nw) * DM); }
#define FFU_LD(it) const u32x4 ru##it = *(const u32x4*)(PU8 + (size_t)__shfl((it) < 8 ? ev0 : ev1, ((it) & 7) * 8 + pg) * 128);
    FOR16(FFU_LD)
    int d[16];
#define FFU_CP(it) { int a_ = __builtin_amdgcn_sdot4((int)ru##it.x, (int)hq.x, 0, false); a_ = __builtin_amdgcn_sdot4((int)ru##it.y, (int)hq.y, a_, false); \
      a_ = __builtin_amdgcn_sdot4((int)ru##it.z, (int)hq.z, a_, false); d[it] = __builtin_amdgcn_sdot4((int)ru##it.w, (int)hq.w, a_, false); }
    FOR16(FFU_CP)
    int r8[8], r4[4], r2[2];
    { const bool hi = dc & 4;
#pragma unroll
      for (int i = 0; i < 8; ++i) { const int keep = hi ? d[8 + i] : d[i], send = hi ? d[i] : d[8 + i]; r8[i] = keep + __shfl_xor(send, 4); } }
    { const bool hi = dc & 2;
#pragma unroll
      for (int i = 0; i < 4; ++i) { const int keep = hi ? r8[4 + i] : r8[i], send = hi ? r8[i] : r8[4 + i]; r4[i] = keep + __float_as_int(xor2f(__int_as_float(send))); } }
    { const bool hi = dc & 1;
#pragma unroll
      for (int i = 0; i < 2; ++i) { const int keep = hi ? r4[2 + i] : r4[i], send = hi ? r4[i] : r4[2 + i]; r2[i] = keep + __float_as_int(xor1f(__int_as_float(send))); } }
    part[(size_t)t * 128 + j0] = (float)r2[0];
    part[(size_t)t * 128 + j0 + 8] = (float)r2[1];
    ev0 = nev0; ev1 = nev1; hq = nhq;
  }
}
DI void phase_ffn_w(const Params& p) {
  char* ws = p.ws;
  const int lane = otid() & 63, wave = otid() >> 6;
  const float* part = (const float*)(ws + OFF_PART);
  const float* scu = (const float*)(ws + OFF_SCU); const float* scv = (const float*)(ws + OFF_SCV);
  const int* eidx = (const int*)(ws + OFF_EIDX);
  const float* pgate = (const float*)(ws + OFF_PGATE);
  float* wbuf = (float*)(ws + OFF_WBUF);
  for (int grp = blockIdx.x; grp < NTOK / NW; grp += gridDim.x) {
    const size_t o = (size_t)(grp * NW + wave) * 128 + lane;
    float a0 = 0.f, a1 = 0.f;
#pragma unroll
    for (int s8 = 0; s8 < 8; ++s8) { a0 += part[(size_t)s8 * NTOK * 128 + o]; a1 += part[(size_t)s8 * NTOK * 128 + o + 64]; }
    const int e0 = eidx[o], e1 = eidx[o + 64];
    const float sht = ((const float*)(ws + OFF_SH))[grp * NW + wave];
    wbuf[o] = pgate[o] * gelu_f(a0 * (scu[e0] * sht)) * scv[e0];
    wbuf[o + 64] = pgate[o + 64] * gelu_f(a1 * (scu[e1] * sht)) * scv[e1];
  }
}
DI void phase_ffn_v(const Params& p) {
  char* ws = p.ws;
  const int lane = otid() & 63, wave = otid() >> 6, pg = lane >> 3, dc = lane & 7;
  const int sl = blockIdx.x & 7, wslot = (blockIdx.x >> 3) * NW + wave, nw = (gridDim.x >> 3) * NW;
  const unsigned char* PV8 = (const unsigned char*)(ws + OFF_PV8) + (size_t)sl * 16384 * 128 + dc * 16;
  const int* eidx = (const int*)(ws + OFF_EIDX) + 16 * pg;
  const float* wbuf = (const float*)(ws + OFF_WBUF) + 16 * pg;
  bf16_t* ffnb = (bf16_t*)(ws + OFF_FFNB);
  u32x4 ne0 = {0u, 0u, 0u, 0u}, ne1 = ne0, ne2 = ne0, ne3 = ne0;
  if (wslot < NTOK) { const int* ep = eidx + (size_t)wslot * 128; ne0 = *(const u32x4*)ep; ne1 = *(const u32x4*)(ep + 4); ne2 = *(const u32x4*)(ep + 8); ne3 = *(const u32x4*)(ep + 12); }
#pragma unroll 1
  for (int t = wslot; t < NTOK; t += nw) {
    const u32x4 ce0 = ne0, ce1 = ne1, ce2 = ne2, ce3 = ne3;
    if (t + nw < NTOK) { const int* ep = eidx + (size_t)(t + nw) * 128; ne0 = *(const u32x4*)ep; ne1 = *(const u32x4*)(ep + 4); ne2 = *(const u32x4*)(ep + 8); ne3 = *(const u32x4*)(ep + 12); }
    const float* wp = wbuf + (size_t)t * 128;
    const f32x4 wq0 = *(const f32x4*)wp, wq1 = *(const f32x4*)(wp + 4), wq2 = *(const f32x4*)(wp + 8), wq3 = *(const f32x4*)(wp + 12);
#define FFV_E(it) ((it) < 4 ? ce0[(it) & 3] : (it) < 8 ? ce1[(it) & 3] : (it) < 12 ? ce2[(it) & 3] : ce3[(it) & 3])
#define FFV_W(it) ((it) < 4 ? wq0[(it) & 3] : (it) < 8 ? wq1[(it) & 3] : (it) < 12 ? wq2[(it) & 3] : wq3[(it) & 3])
#define FFV_LD(it) const u32x4 rv##it = *(const u32x4*)(PV8 + (size_t)FFV_E(it) * 128);
#define FFV_CP(it) { const float wj = FFV_W(it); const f32x2 w2 = {wj, wj}; \
      acc2[0] += __builtin_amdgcn_cvt_pk_f32_fp8((int)rv##it.x, false) * w2; acc2[1] += __builtin_amdgcn_cvt_pk_f32_fp8((int)rv##it.x, true) * w2; \
      acc2[2] += __builtin_amdgcn_cvt_pk_f32_fp8((int)rv##it.y, false) * w2; acc2[3] += __builtin_amdgcn_cvt_pk_f32_fp8((int)rv##it.y, true) * w2; \
      acc2[4] += __builtin_amdgcn_cvt_pk_f32_fp8((int)rv##it.z, false) * w2; acc2[5] += __builtin_amdgcn_cvt_pk_f32_fp8((int)rv##it.z, true) * w2; \
      acc2[6] += __builtin_amdgcn_cvt_pk_f32_fp8((int)rv##it.w, false) * w2; acc2[7] += __builtin_amdgcn_cvt_pk_f32_fp8((int)rv##it.w, true) * w2; }
    FOR16(FFV_LD)
    f32x2 acc2[8];
#pragma unroll
    for (int i = 0; i < 8; ++i) acc2[i] = (f32x2){0.f, 0.f};
    FOR16(FFV_CP)
    float acc[16];
#pragma unroll
    for (int i = 0; i < 8; ++i) { acc[2 * i] = acc2[i].x; acc[2 * i + 1] = acc2[i].y; }
    float r8[8], r4[4], r2[2];
    { const bool hi = lane & 32;
#pragma unroll
      for (int i = 0; i < 8; ++i) { const float keep = hi ? acc[8 + i] : acc[i], send = hi ? acc[i] : acc[8 + i]; r8[i] = keep + xor32f(send, lane); } }
    { const bool hi = lane & 16;
#pragma unroll
      for (int i = 0; i < 4; ++i) { const float keep = hi ? r8[4 + i] : r8[i], send = hi ? r8[i] : r8[4 + i]; r4[i] = keep + xor16f(send, lane); } }
    { const bool hi = lane & 8;
#pragma unroll
      for (int i = 0; i < 2; ++i) { const float keep = hi ? r4[2 + i] : r4[i], send = hi ? r4[i] : r4[2 + i]; r2[i] = keep + xor8f(send); } }
    *(unsigned*)(ffnb + (size_t)t * DM + sl * 128 + dc * 16 + 2 * pg) = pack2(r2[0], r2[1]);
  }
}
DI void phase_final(const Params& p) {
  char* ws = p.ws;
  const int lane = otid() & 63, wave = otid() >> 6;
  const bf16_t* x1 = (const bf16_t*)(ws + OFF_X1);
  const bf16_t* ffnb = (const bf16_t*)(ws + OFF_FFNB);
  const float* mod = (const float*)(ws + OFF_MOD);
  for (int grp = blockIdx.x; grp < NTOK / NW; grp += gridDim.x) {
    const int row = grp * NW + wave, b = row >> 13;
    float v[16];
#pragma unroll
    for (int i = 0; i < 4; ++i) {
      const int col = i * 256 + lane * 4;
      const f32x4 gt2 = *(const f32x4*)(mod + b * 6144 + 5120 + col);
      const u32x2 xr = *(const u32x2*)(x1 + (size_t)row * DM + col), fr = *(const u32x2*)(ffnb + (size_t)row * DM + col);
      v[4 * i] = DN_ALPHA * bflo(xr.x) + gt2.x * bflo(fr.x); v[4 * i + 1] = DN_ALPHA * bfhi(xr.x) + gt2.y * bfhi(fr.x);
      v[4 * i + 2] = DN_ALPHA * bflo(xr.y) + gt2.z * bflo(fr.y); v[4 * i + 3] = DN_ALPHA * bfhi(xr.y) + gt2.w * bfhi(fr.y);
    }
    float mean, rstd; row_stats(v, mean, rstd);
#pragma unroll
    for (int i = 0; i < 4; ++i) {
      const int col = i * 256 + lane * 4;
      const f32x4 g = *(const f32x4*)(p.ln2_g + col), bb = *(const f32x4*)(p.ln2_b + col);
      f32x4 o;
      o.x = (v[4 * i] - mean) * rstd * g.x + bb.x; o.y = (v[4 * i + 1] - mean) * rstd * g.y + bb.y;
      o.z = (v[4 * i + 2] - mean) * rstd * g.z + bb.z; o.w = (v[4 * i + 3] - mean) * rstd * g.w + bb.w;
      *(f32x4*)(p.out + (size_t)row * DM + col) = o;
    }
  }
}

#define XB_TMO      128
#define XB_XCNT(j)  (256  + 64 * (j))
#define XB_XSUB(j)  (1280 + 64 * (j))
#define XB_XGEN(j)  (2304 + 64 * (j))
#define XB_TOP      3328
#define XB_TOPGEN   3392
#define XCD_BAR_WORDS 3456
#define XB_SPIN_CAP (1u << 22)
DI unsigned xb_ld(unsigned* p) { return __hip_atomic_load(p, __ATOMIC_RELAXED, __HIP_MEMORY_SCOPE_AGENT); }
DI unsigned xb_add(unsigned* p, unsigned v) { return __hip_atomic_fetch_add(p, v, __ATOMIC_RELAXED, __HIP_MEMORY_SCOPE_AGENT); }
DI unsigned xb_xcc_id() { return (unsigned)__builtin_amdgcn_s_getreg((3 << 11) | 20) & 0xFu; }
#define XB_SPIN(cond, bar) do { unsigned _sp = 0; while (cond) { __builtin_amdgcn_s_sleep(1); \
    if ((++_sp & 255u) == 0u) { if (xb_ld(&(bar)[XB_TMO])) break; if (_sp > XB_SPIN_CAP) { atomicAdd(&(bar)[XB_TMO], 1u); break; } } } } while (0)
struct XcdBarrier { unsigned* bar; unsigned x; volatile LAS unsigned* st; };
DI XcdBarrier xcd_barrier_post(unsigned* bar, volatile LAS unsigned* st) {
  XcdBarrier b; b.bar = bar; b.x = xb_xcc_id(); b.st = st;
  if (threadIdx.x == 0) (void)xb_add(&bar[XB_XCNT(b.x)], 1u);
  return b;
}
DI void xcd_barrier_complete(unsigned* bar, unsigned x, unsigned& nloc, unsigned& nx) {
  const unsigned G = gridDim.x * gridDim.y * gridDim.z;
  unsigned sum, cnt, mine, sp = 0u;
  for (;;) {
    sum = 0u; cnt = 0u; mine = 0u;
#pragma unroll
    for (unsigned j = 0; j < 16; ++j) { const unsigned c = xb_ld(&bar[XB_XCNT(j)]); sum += c; cnt += (c > 0u) ? 1u : 0u; mine = (j == x) ? c : mine; }
    if (sum == G) break;
    __builtin_amdgcn_s_sleep(1);
    if ((++sp & 255u) == 0u) { if (xb_ld(&bar[XB_TMO])) break; if (sp > XB_SPIN_CAP) { atomicAdd(&bar[XB_TMO], 1u); break; } }
  }
  nloc = mine > 0u ? mine : 1u; nx = cnt > 0u ? cnt : 1u;
}
DI void xcd_barrier(const XcdBarrier& b) {
  asm volatile("s_waitcnt vmcnt(0)" ::: "memory");
  __syncthreads();
  if (threadIdx.x == 0) {
    unsigned* bar = b.bar;
    __builtin_amdgcn_s_waitcnt(0);
    unsigned nloc = b.st[0], nx = b.st[1];
    if (nloc == 0u) { xcd_barrier_complete(bar, b.x, nloc, nx); b.st[0] = nloc; b.st[1] = nx; }
    const unsigned old = xb_add(&bar[XB_XSUB(b.x)], 1u);
    const unsigned gen = old / nloc;
    if (old + 1u == (gen + 1u) * nloc) {
      __builtin_amdgcn_fence(__ATOMIC_RELEASE, "agent");
      asm volatile("s_waitcnt vmcnt(0)" ::: "memory");
      const unsigned og = xb_add(&bar[XB_TOP], 1u);
      const unsigned tg = og / nx;
      if (og + 1u == (tg + 1u) * nx) xb_add(&bar[XB_TOPGEN], 1u);
      else XB_SPIN(xb_ld(&bar[XB_TOPGEN]) == tg, bar);
      __builtin_amdgcn_fence(__ATOMIC_ACQUIRE, "agent");
      xb_add(&bar[XB_XGEN(b.x)], 1u);
      asm volatile("s_waitcnt vmcnt(0)" ::: "memory");
    } else {
      XB_SPIN(xb_ld(&bar[XB_XGEN(b.x)]) == gen, bar);
      __builtin_amdgcn_fence(__ATOMIC_ACQUIRE, "agent");
      asm volatile("s_waitcnt vmcnt(0)" ::: "memory");
    }
  }
  __syncthreads();
}

constexpr int SMEM_BYTES = 147456 + 256;

__global__ void __launch_bounds__(NT, 2) k_mega(Params p) {
  __shared__ __attribute__((aligned(16))) char smem[SMEM_BYTES];
  cg::grid_group grid = cg::this_grid();
  if (threadIdx.x == 0) *(u32x4*)(smem + 147456) = (u32x4){0u, 0u, 0u, 0u};
  __syncthreads();
  const XcdBarrier xb = xcd_barrier_post((unsigned*)(p.ws + OFF_BAR), (volatile LAS unsigned*)(smem + 147456));
#define REP(mask) _Pragma("unroll 1") for (int rep_ = 0; rep_ < ((PROBE_DUP & (mask)) ? 2 : 1); ++rep_)
  REP(1) phase_prep(p, smem);
  grid.sync();
  REP(1) phase_ln_in(p);
  xcd_barrier(xb);
  REP(2) phase_gemm1(p, smem);
  xcd_barrier(xb);
  REP(4) phase_compress(p, smem);
  phase_sgu(p, smem);
  xcd_barrier(xb);
  REP(8) phase_nsa(p, smem, NSA_MASK);
  xcd_barrier(xb);
  REP(16) phase_merge(p, smem);
  xcd_barrier(xb);
  REP(16) phase_outproj(p, smem);
  xcd_barrier(xb);
  REP(1) phase_ln_mid(p);
  xcd_barrier(xb);
  REP(32) phase_peerq(p, smem);
  xcd_barrier(xb);
  REP(64) phase_route(p, smem);
  xcd_barrier(xb);
  REP(128) phase_ffn_u(p);
  xcd_barrier(xb);
  REP(128) phase_ffn_w(p);
  xcd_barrier(xb);
  REP(256) phase_ffn_v(p);
  xcd_barrier(xb);
  REP(512) phase_final(p);
}

extern "C" void kernel_launch(void* const* d_in, const int* in_sizes, int n_in, void* d_out, int out_size, void* d_ws, size_t ws_size, hipStream_t stream) {
  if (ws_size < OFF_END) { fprintf(stderr, "workspace too small: %zu < %zu\n", ws_size, (size_t)OFF_END); return; }
  static int grid_blocks = 0;
  if (!grid_blocks) {
    int dev = 0, cus = 0, per_cu = 0;
    (void)hipGetDevice(&dev);
    (void)hipDeviceGetAttribute(&cus, hipDeviceAttributeMultiprocessorCount, dev);
    (void)hipOccupancyMaxActiveBlocksPerMultiprocessor(&per_cu, k_mega, NT, 0);
    if (per_cu < 1) fprintf(stderr, "occupancy query returned %d\n", per_cu);
    grid_blocks = (cus / 8) * 8;
  }
  Params p{};
  const float** fp = (const float**)&p;
  for (int i = 0; i < 26; ++i) fp[i] = (const float*)d_in[i];
  p.out = (float*)d_out;
  p.ws = (char*)d_ws;
  for (int i = 0; i < 32; ++i) p.inv_freq[i] = (float)pow(10000.0, -(double)i / 32.0);
  (void)hipMemsetAsync((char*)d_ws + OFF_BAR, 0, XCD_BAR_WORDS * 4, stream);
  void* args[] = {&p};
  hipError_t e = hipLaunchCooperativeKernel((void*)k_mega, dim3(grid_blocks), dim3(NT), args, 0, stream);
  if (e != hipSuccess) fprintf(stderr, "cooperative launch failed: %s (grid %d)\n", hipGetErrorString(e), grid_blocks);
}
```

```cpp
#include <hip/hip_runtime.h>
#include <hip/hip_cooperative_groups.h>
#include <stdint.h>
#include <stdio.h>
#include <math.h>
namespace cg = cooperative_groups;

#ifndef PROBE_DUP
#define PROBE_DUP 0
#endif
#ifndef NSA_MASK
#define NSA_MASK 7
#endif
typedef unsigned short bf16_t;
typedef short bf16x8 __attribute__((ext_vector_type(8)));
typedef short s16x4 __attribute__((ext_vector_type(4)));
typedef float f32x16 __attribute__((ext_vector_type(16)));
typedef float f32x4 __attribute__((ext_vector_type(4)));
typedef float f32x2 __attribute__((ext_vector_type(2)));
typedef __bf16 bf16v2 __attribute__((ext_vector_type(2)));
typedef unsigned u32x4 __attribute__((ext_vector_type(4)));
typedef int i32x4 __attribute__((ext_vector_type(4)));
typedef unsigned u32x2 __attribute__((ext_vector_type(2)));
#define DI __device__ __forceinline__
#define LAS __attribute__((address_space(3)))
#define MFMA32(a, b, c) __builtin_amdgcn_mfma_f32_32x32x16_bf16((a), (b), (c), 0, 0, 0)

constexpr int NT = 512, NW = 8;
constexpr int NB = 8, SEQ = 8192, DM = 1024, NTOK = NB * SEQ;
constexpr int N1 = 4608;
constexpr float DN_ALPHA = 1.189207115002721f;
constexpr float LN_EPS = 1e-5f;

constexpr size_t MB = 1024 * 1024;
constexpr size_t OFF_MOD = 0;
constexpr size_t OFF_ROPE = OFF_MOD + 256 * 1024;
constexpr size_t OFF_POSB = OFF_ROPE + 2 * MB;
constexpr size_t OFF_WT1 = OFF_POSB + 4096;
constexpr size_t OFF_WB = OFF_WT1 + (size_t)N1 * 1024 * 2;
constexpr size_t OFF_WOUT = OFF_WB + 2 * MB;
constexpr size_t OFF_WQ = OFF_WOUT + 2 * MB;
constexpr size_t OFF_PKEYS = OFF_WQ + 4 * MB;
constexpr size_t OFF_CW1 = OFF_PKEYS + MB / 2;
constexpr size_t OFF_CW2 = OFF_CW1 + MB;
constexpr size_t OFF_SGUW = OFF_CW2 + 32 * 1024;
constexpr size_t OFF_SCU = OFF_SGUW + 256 * 1024;
constexpr size_t OFF_SCV = OFF_SCU + 64 * 1024;
constexpr size_t OFF_PU = OFF_SCV + 64 * 1024;
constexpr size_t OFF_PV = OFF_PU + 32 * MB;
constexpr size_t OFF_ACT = ((OFF_PV + 32 * MB + 4095) / 4096) * 4096;
constexpr size_t OFF_H = OFF_ACT;
constexpr size_t OFF_Q = OFF_H + 128 * MB;
constexpr size_t OFF_KC = OFF_Q + 64 * MB;
constexpr size_t OFF_VC = OFF_KC + 16 * MB;
constexpr size_t OFF_KS = OFF_VC + 16 * MB;
constexpr size_t OFF_VS = OFF_KS + 16 * MB;
constexpr size_t OFF_KW = OFF_VS + 16 * MB;
constexpr size_t OFF_VW = OFF_KW + 16 * MB;
constexpr size_t OFF_U = OFF_VW + 16 * MB;
constexpr size_t OFF_V = OFF_U + 64 * MB;
constexpr size_t OFF_GATE = OFF_V + 64 * MB;
constexpr size_t OFF_GSIG = OFF_GATE + 256 * MB;
constexpr size_t OFF_KCMP = OFF_GSIG + 8 * MB;
constexpr size_t OFF_VCMP = OFF_KCMP + MB;
constexpr size_t OFF_ONSA = OFF_VCMP + MB;
constexpr size_t OFF_SELG = OFF_ONSA + 64 * MB;
constexpr size_t OFF_BAR = OFF_SELG + 2 * MB;
constexpr size_t OFF_END = OFF_BAR + 64 * 1024;
constexpr size_t OFF_X1 = OFF_Q;
constexpr size_t OFF_Y = OFF_GATE;
constexpr size_t OFF_PQ = OFF_GATE;
constexpr size_t OFF_EIDX = OFF_ONSA;
constexpr size_t OFF_PGATE = OFF_ONSA + 32 * MB;
constexpr size_t OFF_PU8 = OFF_PU;
constexpr size_t OFF_PART = OFF_GATE;
constexpr size_t OFF_PV8 = OFF_PU + 16 * MB;
constexpr size_t OFF_WBUF = OFF_PU + 32 * MB;
constexpr size_t OFF_H2Q = OFF_U;
constexpr size_t OFF_SH = OFF_V;
constexpr size_t OFF_FFNB = OFF_GATE;
constexpr size_t OFF_SCW1 = OFF_WT1 + 5 * MB;
constexpr size_t OFF_SCWQ = OFF_WQ + 3 * MB;
constexpr size_t OFF_SA = OFF_H + 64 * MB;

struct Params {
  const float *x, *c, *w_ada, *b_ada, *w_in, *cmp_pos, *cmp_w1, *cmp_b1, *cmp_w2, *cmp_b2, *sgu_ln_g, *sgu_ln_b, *sgu_w, *sgu_b,
      *w_branch, *w_merge, *b_merge, *w_out, *ln1_g, *ln1_b, *peer_wq, *peer_keys, *peer_u, *peer_v, *ln2_g, *ln2_b;
  float* out;
  char* ws;
  float inv_freq[32];
};

DI unsigned pack2(float lo, float hi) { f32x2 v = {lo, hi}; bf16v2 r = __builtin_convertvector(v, bf16v2); return __builtin_bit_cast(unsigned, r); }
DI bf16_t f2bf(float f) { __bf16 r = (__bf16)f; return __builtin_bit_cast(unsigned short, r); }
DI float bf2f(bf16_t h) { return __uint_as_float(((unsigned)h) << 16); }
DI float bflo(unsigned u) { return __uint_as_float(u << 16); }
DI float bfhi(unsigned u) { return __uint_as_float(u & 0xffff0000u); }
DI float gelu_f(float v) { return 0.5f * v * (1.0f + erff(v * 0.70710678118654752f)); }
DI float sigmoid_f(float v) { return 1.0f / (1.0f + __expf(-v)); }
DI int otid() { int t = __builtin_amdgcn_workitem_id_x(); asm volatile("" : "+v"(t)); return t; }
DI void lds_barrier() { asm volatile("s_waitcnt lgkmcnt(0)" ::: "memory"); __builtin_amdgcn_s_barrier(); asm volatile("" ::: "memory"); }
DI float xor1f(float x) { const int xi = __float_as_int(x); return __int_as_float(__builtin_amdgcn_update_dpp(xi, xi, 0xB1, 0xF, 0xF, false)); }
DI float xor2f(float x) { const int xi = __float_as_int(x); return __int_as_float(__builtin_amdgcn_update_dpp(xi, xi, 0x4E, 0xF, 0xF, false)); }
DI float xor8f(float x) { const int xi = __float_as_int(x); return __int_as_float(__builtin_amdgcn_update_dpp(xi, xi, 0x128, 0xF, 0xF, false)); }
DI unsigned xor32u(unsigned x, int lane) { const u32x2 r = __builtin_amdgcn_permlane32_swap(x, x, false, false); return (lane & 32) ? r.x : r.y; }
DI unsigned xor16u(unsigned x, int lane) { const u32x2 r = __builtin_amdgcn_permlane16_swap(x, x, false, false); return (lane & 16) ? r.x : r.y; }
DI float xor32f(float x, int lane) { return __uint_as_float(xor32u(__float_as_uint(x), lane)); }
DI float xor16f(float x, int lane) { return __uint_as_float(xor16u(__float_as_uint(x), lane)); }
DI unsigned pack_i8x4(float a, float b, float c, float d) {
  const int ia = (int)rintf(a), ib = (int)rintf(b), ic = (int)rintf(c), id = (int)rintf(d);
  return (unsigned)(ia & 0xff) | ((unsigned)(ib & 0xff) << 8) | ((unsigned)(ic & 0xff) << 16) | ((unsigned)id << 24);
}
DI float wave_sum(float v) {
#pragma unroll
  for (int o = 32; o > 0; o >>= 1) v += __shfl_xor(v, o);
  return v;
}
DI void ld8(const float* pz, float (&v)[8]) { const f32x4 a = *(const f32x4*)pz, b = *(const f32x4*)(pz + 4); v[0] = a.x; v[1] = a.y; v[2] = a.z; v[3] = a.w; v[4] = b.x; v[5] = b.y; v[6] = b.z; v[7] = b.w; }
DI u32x4 pack8(const float (&v)[8]) { u32x4 w; w.x = pack2(v[0], v[1]); w.y = pack2(v[2], v[3]); w.z = pack2(v[4], v[5]); w.w = pack2(v[6], v[7]); return w; }
DI void unpack8(const u32x4 w, float (&v)[8]) { v[0] = bflo(w.x); v[1] = bfhi(w.x); v[2] = bflo(w.y); v[3] = bfhi(w.y); v[4] = bflo(w.z); v[5] = bfhi(w.z); v[6] = bflo(w.w); v[7] = bfhi(w.w); }
DI f32x2 gelu_pk(f32x2 v) {
  const f32x2 av = __builtin_elementwise_abs(v), d = av * 0.2316418882f + 1.0f;
  f32x2 t; t.x = __builtin_amdgcn_rcpf(d.x); t.y = __builtin_amdgcn_rcpf(d.y);
  f32x2 q = t * 0.5307027145f + (-0.7265760135f); q = q * t + 0.7107068705f; q = q * t + (-0.142248368f); q = q * t + 0.127414796f; q = q * t;
  const f32x2 s = (v * v) * (-0.72134752044f);
  f32x2 e; e.x = __builtin_amdgcn_exp2f(s.x); e.y = __builtin_amdgcn_exp2f(s.y);
  const f32x2 m = v * (q * e), r = v - m;
  f32x2 o; o.x = v.x < 0.f ? m.x : r.x; o.y = v.y < 0.f ? m.y : r.y; return o;
}
__host__ __device__ __forceinline__ int dperm(int q) { const int grp = q >> 5, fq = (q >> 3) & 3, j = q & 7; return (j < 4) ? (16 * grp + 4 * fq + j) : (32 + 16 * grp + 4 * fq + (j - 4)); }

template <class F>
DI void tconv_tile(float* tile, int k0, int n0, bf16_t* dst, int ldd, F f) {
  const int tid = otid();
  __syncthreads();
#pragma unroll 4
  for (int i = 0; i < 8; ++i) { const int kl = i * 8 + (tid >> 6), nl = tid & 63; tile[nl * 65 + kl] = f(k0 + kl, n0 + nl); }
  __syncthreads();
  {
    const int nl = tid >> 3, kc = tid & 7;
    const float* t = tile + nl * 65 + kc * 8;
    u32x4 w; w.x = pack2(t[0], t[1]); w.y = pack2(t[2], t[3]); w.z = pack2(t[4], t[5]); w.w = pack2(t[6], t[7]);
    *(u32x4*)(dst + (size_t)(n0 + nl) * ldd + k0 + kc * 8) = w;
  }
}

template <class F>
DI void tconv_strip_i8(float* tile, int n0, int K, unsigned char* dst, float* gscale, F f) {
  const int tid = otid();
  float am = 0.f;
  { const int kl = tid >> 6, nl = tid & 63;
#pragma unroll 4
    for (int k = kl; k < K; k += 8) am = fmaxf(am, fabsf(f(k, n0 + nl))); }
#pragma unroll
  for (int o = 16; o > 0; o >>= 1) am = fmaxf(am, __shfl_xor(am, o));
  __syncthreads();
  if ((tid & 31) == 0) tile[(tid >> 6) * 2 + ((tid >> 5) & 1)] = am;
  __syncthreads();
  float g0 = 0.f, g1 = 0.f;
#pragma unroll
  for (int w = 0; w < 8; ++w) { g0 = fmaxf(g0, tile[2 * w]); g1 = fmaxf(g1, tile[2 * w + 1]); }
  const float q0 = g0 > 0.f ? 127.0f / g0 : 0.f, q1 = g1 > 0.f ? 127.0f / g1 : 0.f;
  if (tid == 0) { gscale[n0 >> 5] = g0 * (1.0f / 127.0f); gscale[(n0 >> 5) + 1] = g1 * (1.0f / 127.0f); }
  float* tl = tile + 64;
  for (int k0 = 0; k0 < K; k0 += 64) {
    __syncthreads();
#pragma unroll 4
    for (int i = 0; i < 8; ++i) { const int kl = i * 8 + (tid >> 6), nl = tid & 63; tl[nl * 65 + kl] = f(k0 + kl, n0 + nl) * (nl < 32 ? q0 : q1); }
    __syncthreads();
    {
      const int nl = tid >> 3, kc = tid & 7;
      const float* t = tl + nl * 65 + kc * 8;
      u32x2 w; w.x = pack_i8x4(t[0], t[1], t[2], t[3]); w.y = pack_i8x4(t[4], t[5], t[6], t[7]);
      *(u32x2*)(dst + (size_t)(n0 + nl) * K + k0 + kc * 8) = w;
    }
  }
}

DI void conv_chunk(const float* src, bf16_t* dst, size_t base) {
  const size_t i = base + (size_t)otid() * 8;
  const f32x4 a = *(const f32x4*)(src + i), b = *(const f32x4*)(src + i + 4);
  u32x4 w; w.x = pack2(a.x, a.y); w.y = pack2(a.z, a.w); w.z = pack2(b.x, b.y); w.w = pack2(b.z, b.w);
  *(u32x4*)(dst + i) = w;
}

DI void sincos_d(double x, double& s, double& c) {
  const double y = x * 0.25, y2 = y * y;
  double sn = y * (1.0 + y2 * (-1.0 / 6 + y2 * (1.0 / 120 + y2 * (-1.0 / 5040 + y2 * (1.0 / 362880 + y2 * (-1.0 / 39916800 + y2 * (1.0 / 6227020800.0)))))));
  double cs = 1.0 + y2 * (-0.5 + y2 * (1.0 / 24 + y2 * (-1.0 / 720 + y2 * (1.0 / 40320 + y2 * (-1.0 / 3628800 + y2 * (1.0 / 479001600.0 + y2 * (-1.0 / 87178291200.0)))))));
#pragma unroll
  for (int i = 0; i < 2; ++i) { const double s2 = 2.0 * sn * cs, c2 = cs * cs - sn * sn; sn = s2; cs = c2; }
  s = sn; c = cs;
}

DI void phase_prep(const Params& p, char* smem) {
  const int tid = otid();
  float* fs = (float*)smem;
  char* ws = p.ws;
  constexpr int nA = 192, nB = 72, nC = 2 * 8 * 16, nD = 256, nE = 32, nF = 2 * 32 * 2, nG = 4, nH = 8, nI = 512, nJ = 64, nK = 32, nL = 2048, nM = 2048;
  constexpr int total = nA + nB + nC + nD + nE + nF + nG + nH + nI + nJ + nK + nL + nM;
  for (int item = blockIdx.x; item < total; item += gridDim.x) {
    int it = item;
    if (it < nA) {
      float* sc = fs;
      float* red = fs + 8192;
      __syncthreads();
      for (int i = tid; i < 8192; i += NT) { const float v = p.c[i]; sc[i] = v / (1.0f + __expf(-v)); }
      __syncthreads();
      const int ks = tid >> 5, cj = tid & 31, col = it * 32 + cj;
      float acc[8];
#pragma unroll
      for (int b = 0; b < 8; ++b) acc[b] = 0.f;
#pragma unroll 4
      for (int k = ks * 64; k < ks * 64 + 64; ++k) {
        const float w = p.w_ada[(size_t)k * 6144 + col];
#pragma unroll
        for (int b = 0; b < 8; ++b) acc[b] += sc[b * 1024 + k] * w;
      }
#pragma unroll
      for (int b = 0; b < 8; ++b) red[(ks * 8 + b) * 32 + cj] = acc[b];
      __syncthreads();
      if (tid < 256) {
        const int b = tid >> 5;
        float s = p.b_ada[col];
#pragma unroll
        for (int k2 = 0; k2 < 16; ++k2) s += red[(k2 * 8 + b) * 32 + cj];
        ((float*)(ws + OFF_MOD))[b * 6144 + col] = s;
      }
      continue;
    }
    it -= nA;
    if (it < nB) {
      const float* w_in = p.w_in; const float* w_merge = p.w_merge;
      tconv_strip_i8(fs, it * 64, 1024, (unsigned char*)(ws + OFF_WT1), (float*)(ws + OFF_SCW1), [=](int k, int n) -> float {
        if (n < 1280) {
          const bool roped = (n < 640) || (n >= 768 && n < 896) || (n >= 1024 && n < 1152);
          const int col = roped ? ((n & ~63) + dperm(n & 63)) : n;
          return w_in[(size_t)k * 2328 + col];
        }
        if (n < 2304) return w_in[(size_t)k * 2328 + n + 24];
        if (n < 4352) return w_merge[(size_t)k * 2048 + (n - 2304)];
        if (n < 4376) return w_in[(size_t)k * 2328 + 1280 + (n - 4352)];
        return 0.f; });
      continue;
    }
    it -= nB;
    if (it < nC) {
      const int br = it >> 7, r = it & 127, kt = r >> 4, ntile = r & 15;
      const float* src = p.w_branch + (size_t)br * 512 * 1024;
      tconv_tile(fs, kt * 64, ntile * 64, (bf16_t*)(ws + OFF_WB) + (size_t)br * 1024 * 512, 512, [=](int k, int n) -> float { return src[(size_t)k * 1024 + n]; });
      continue;
    }
    it -= nC;
    if (it < nD) {
      const int kt = it >> 4, ntile = it & 15;
      const float* src = p.w_out;
      tconv_tile(fs, kt * 64, ntile * 64, (bf16_t*)(ws + OFF_WOUT), 1024, [=](int k, int n) -> float { return src[(size_t)k * 1024 + n]; });
      continue;
    }
    it -= nD;
    if (it < nE) {
      const float* src = p.peer_wq;
      tconv_strip_i8(fs, it * 64, 1024, (unsigned char*)(ws + OFF_WQ), (float*)(ws + OFF_SCWQ), [=](int k, int n) -> float { return src[(size_t)k * 2048 + n]; });
      continue;
    }
    it -= nE;
    if (it < nF) {
      const int w = it >> 6, r = it & 63, kt = r >> 1, ntile = r & 1;
      const float* src = p.cmp_w1 + (size_t)w * 2048 * 128;
      tconv_tile(fs, kt * 64, ntile * 64, (bf16_t*)(ws + OFF_CW1) + (size_t)w * 128 * 2048, 2048, [=](int k, int n) -> float {
        const int ksrc = (w == 0) ? ((k & ~63) + dperm(k & 63)) : k;
        return src[(size_t)ksrc * 128 + n]; });
      continue;
    }
    it -= nF;
    if (it < nG) {
      const int w = it >> 1, kt = it & 1;
      const float* src = p.cmp_w2 + (size_t)w * 128 * 64;
      tconv_tile(fs, kt * 64, 0, (bf16_t*)(ws + OFF_CW2) + (size_t)w * 64 * 128, 128, [=](int k, int n) -> float { return src[(size_t)k * 64 + ((w == 0) ? dperm(n) : n)]; });
      continue;
    }
    it -= nG;
    if (it < nH) {
      const int w = it >> 2, jc = it & 3, ks = tid >> 5, cj = tid & 31, j = jc * 32 + cj;
      float* red = fs;
      const float* pos = p.cmp_pos + w * 2048; const float* w1 = p.cmp_w1 + (size_t)w * 2048 * 128;
      float acc = 0.f;
#pragma unroll 4
      for (int k = ks * 128; k < ks * 128 + 128; ++k) acc += pos[k] * w1[(size_t)k * 128 + j];
      __syncthreads();
      red[ks * 32 + cj] = acc;
      __syncthreads();
      if (tid < 32) { float s = p.cmp_b1[w * 128 + j]; for (int k2 = 0; k2 < 16; ++k2) s += red[k2 * 32 + tid]; ((float*)(ws + OFF_POSB))[w * 128 + j] = s; }
      continue;
    }
    it -= nH;
    if (it < nI) {
      const int e = it * 512 + tid, pos = e >> 5, i = e & 31;
      const float ang = (float)pos * p.inv_freq[i];
      const double a = (double)ang;
      const double kk = rint(a * 0.15915494309189535);
      const double r = a - kk * 6.283185307179586476925;
      double s, c; sincos_d(r, s, c);
      ((float*)(ws + OFF_ROPE))[e] = (float)c;
      ((float*)(ws + OFF_ROPE))[262144 + e] = (float)s;
      continue;
    }
    it -= nI;
    if (it < nJ) { conv_chunk(p.peer_keys, (bf16_t*)(ws + OFF_PKEYS), (size_t)it * 4096); continue; }
    it -= nJ;
    if (it < nK) {
      const size_t i0 = (size_t)it * 4096 + (size_t)tid * 8;
      const int rowi = (int)((i0 >> 7) & 127), j0 = (int)(i0 & 127);
      float v[8];
#pragma unroll
      for (int j = 0; j < 8; ++j) v[j] = (j0 + j <= rowi) ? p.sgu_w[i0 + j] : 0.f;
      u32x4 w; w.x = pack2(v[0], v[1]); w.y = pack2(v[2], v[3]); w.z = pack2(v[4], v[5]); w.w = pack2(v[6], v[7]);
      *(u32x4*)((bf16_t*)(ws + OFF_SGUW) + i0) = w;
      continue;
    }
    it -= nK;
    {
      const bool isv = it >= nL;
      if (isv) it -= nL;
      const int lane = tid & 63, e = it * 8 + (tid >> 6);
      const float* src = (isv ? p.peer_v : p.peer_u) + (size_t)e * 1024 + lane * 16;
      float v[16];
#pragma unroll
      for (int i = 0; i < 4; ++i) { const f32x4 t4 = *(const f32x4*)(src + i * 4); v[4 * i] = t4.x; v[4 * i + 1] = t4.y; v[4 * i + 2] = t4.z; v[4 * i + 3] = t4.w; }
      float amax = 0.f;
#pragma unroll
      for (int i = 0; i < 16; ++i) amax = fmaxf(amax, fabsf(v[i]));
#pragma unroll
      for (int o = 32; o > 0; o >>= 1) amax = fmaxf(amax, __shfl_xor(amax, o));
      const unsigned be = (__float_as_uint(amax) >> 23) & 0xffu;
      const bool okr = be >= 16u && be <= 240u;
      const float scale = okr ? __uint_as_float((261u - be) << 23) : 1.0f;
      const float inv = okr ? __uint_as_float((be - 7u) << 23) : 1.0f;
      u32x4 w;
      int t0 = 0, t1 = 0, t2 = 0, t3 = 0;
      t0 = __builtin_amdgcn_cvt_pk_fp8_f32(v[0] * scale, v[1] * scale, t0, false); t0 = __builtin_amdgcn_cvt_pk_fp8_f32(v[2] * scale, v[3] * scale, t0, true);
      t1 = __builtin_amdgcn_cvt_pk_fp8_f32(v[4] * scale, v[5] * scale, t1, false); t1 = __builtin_amdgcn_cvt_pk_fp8_f32(v[6] * scale, v[7] * scale, t1, true);
      t2 = __builtin_amdgcn_cvt_pk_fp8_f32(v[8] * scale, v[9] * scale, t2, false); t2 = __builtin_amdgcn_cvt_pk_fp8_f32(v[10] * scale, v[11] * scale, t2, true);
      t3 = __builtin_amdgcn_cvt_pk_fp8_f32(v[12] * scale, v[13] * scale, t3, false); t3 = __builtin_amdgcn_cvt_pk_fp8_f32(v[14] * scale, v[15] * scale, t3, true);
      w.x = (unsigned)t0; w.y = (unsigned)t1; w.z = (unsigned)t2; w.w = (unsigned)t3;
      if (!isv) {
        const float qs = amax > 0.f ? 127.0f / amax : 0.f;
        u32x4 wi; wi.x = pack_i8x4(v[0] * qs, v[1] * qs, v[2] * qs, v[3] * qs); wi.y = pack_i8x4(v[4] * qs, v[5] * qs, v[6] * qs, v[7] * qs);
        wi.z = pack_i8x4(v[8] * qs, v[9] * qs, v[10] * qs, v[11] * qs); wi.w = pack_i8x4(v[12] * qs, v[13] * qs, v[14] * qs, v[15] * qs);
        *(u32x4*)(ws + OFF_PU8 + ((size_t)(lane >> 3) * 16384 + e) * 128 + (lane & 7) * 16) = wi;
        if (lane == 0) ((float*)(ws + OFF_SCU))[e] = amax * (1.0f / 127.0f);
      } else {
        *(u32x4*)(ws + OFF_PV8 + ((size_t)(lane >> 3) * 16384 + e) * 128 + (lane & 7) * 16) = w;
        if (lane == 0) ((float*)(ws + OFF_SCV))[e] = inv;
      }
    }
  }
}

DI void row_stats(const float (&v)[16], float& mean, float& rstd) {
  float s = 0.f;
#pragma unroll
  for (int i = 0; i < 16; ++i) s += v[i];
  mean = wave_sum(s) * (1.0f / 1024.0f);
  float q = 0.f;
#pragma unroll
  for (int i = 0; i < 16; ++i) { const float d = v[i] - mean; q += d * d; }
  rstd = rsqrtf(wave_sum(q) * (1.0f / 1024.0f) + LN_EPS);
}

DI void phase_ln_in(const Params& p) {
  const int lane = otid() & 63, wave = otid() >> 6;
  const float* mod = (const float*)(p.ws + OFF_MOD);
  unsigned* h8 = (unsigned*)(p.ws + OFF_H);
  for (int grp = blockIdx.x; grp < NTOK / NW; grp += gridDim.x) {
    const int row = grp * NW + wave, b = row >> 13;
    const float* xr = p.x + (size_t)row * DM;
    float v[16];
#pragma unroll
    for (int i = 0; i < 4; ++i) { const f32x4 t = *(const f32x4*)(xr + i * 256 + lane * 4); v[4 * i] = t.x; v[4 * i + 1] = t.y; v[4 * i + 2] = t.z; v[4 * i + 3] = t.w; }
    float mean, rstd; row_stats(v, mean, rstd);
    float amax = 0.f;
#pragma unroll
    for (int i = 0; i < 4; ++i) {
      const int col = i * 256 + lane * 4;
      const f32x4 sh = *(const f32x4*)(mod + b * 6144 + col), sc = *(const f32x4*)(mod + b * 6144 + 1024 + col);
      const float o0 = (v[4 * i] - mean) * rstd * (1.f + sc.x) + sh.x, o1 = (v[4 * i + 1] - mean) * rstd * (1.f + sc.y) + sh.y;
      const float o2 = (v[4 * i + 2] - mean) * rstd * (1.f + sc.z) + sh.z, o3 = (v[4 * i + 3] - mean) * rstd * (1.f + sc.w) + sh.w;
      v[4 * i] = o0; v[4 * i + 1] = o1; v[4 * i + 2] = o2; v[4 * i + 3] = o3;
      amax = fmaxf(amax, fmaxf(fmaxf(fabsf(o0), fabsf(o1)), fmaxf(fabsf(o2), fabsf(o3))));
    }
#pragma unroll
    for (int o = 32; o > 0; o >>= 1) amax = fmaxf(amax, __shfl_xor(amax, o));
    const float qs = amax > 0.f ? 127.0f / amax : 0.f;
#pragma unroll
    for (int i = 0; i < 4; ++i) h8[(size_t)row * 256 + i * 64 + lane] = pack_i8x4(v[4 * i] * qs, v[4 * i + 1] * qs, v[4 * i + 2] * qs, v[4 * i + 3] * qs);
    if (lane == 0) ((float*)(p.ws + OFF_SA))[row] = amax * (1.0f / 127.0f);
  }
}

DI void phase_ln_mid(const Params& p) {
  const int lane = otid() & 63, wave = otid() >> 6;
  const float* mod = (const float*)(p.ws + OFF_MOD);
  const bf16_t* y = (const bf16_t*)(p.ws + OFF_Y);
  bf16_t* x1 = (bf16_t*)(p.ws + OFF_X1);
  for (int grp = blockIdx.x; grp < NTOK / NW; grp += gridDim.x) {
    const int row = grp * NW + wave, b = row >> 13;
    const bf16_t* yr = y + (size_t)row * DM;
    float v[16];
#pragma unroll
    for (int i = 0; i < 4; ++i) { const u32x2 t = *(const u32x2*)(yr + i * 256 + lane * 4); v[4 * i] = bflo(t.x); v[4 * i + 1] = bfhi(t.x); v[4 * i + 2] = bflo(t.y); v[4 * i + 3] = bfhi(t.y); }
    float mean, rstd; row_stats(v, mean, rstd);
#pragma unroll
    for (int i = 0; i < 4; ++i) {
      const int col = i * 256 + lane * 4;
      const f32x4 g = *(const f32x4*)(p.ln1_g + col), bb = *(const f32x4*)(p.ln1_b + col);
      f32x4 o;
      o.x = (v[4 * i] - mean) * rstd * g.x + bb.x; o.y = (v[4 * i + 1] - mean) * rstd * g.y + bb.y;
      o.z = (v[4 * i + 2] - mean) * rstd * g.z + bb.z; o.w = (v[4 * i + 3] - mean) * rstd * g.w + bb.w;
      { u32x2 w; w.x = pack2(o.x, o.y); w.y = pack2(o.z, o.w); *(u32x2*)(x1 + (size_t)row * DM + col) = w; }
      v[4 * i] = o.x; v[4 * i + 1] = o.y; v[4 * i + 2] = o.z; v[4 * i + 3] = o.w;
    }
    row_stats(v, mean, rstd);
    float amax = 0.f;
#pragma unroll
    for (int i = 0; i < 4; ++i) {
      const int col = i * 256 + lane * 4;
      const f32x4 sh = *(const f32x4*)(mod + b * 6144 + 3072 + col), sc = *(const f32x4*)(mod + b * 6144 + 4096 + col);
      const float o0 = (v[4 * i] - mean) * rstd * (1.f + sc.x) + sh.x, o1 = (v[4 * i + 1] - mean) * rstd * (1.f + sc.y) + sh.y;
      const float o2 = (v[4 * i + 2] - mean) * rstd * (1.f + sc.z) + sh.z, o3 = (v[4 * i + 3] - mean) * rstd * (1.f + sc.w) + sh.w;
      v[4 * i] = o0; v[4 * i + 1] = o1; v[4 * i + 2] = o2; v[4 * i + 3] = o3;
      amax = fmaxf(amax, fmaxf(fmaxf(fabsf(o0), fabsf(o1)), fmaxf(fabsf(o2), fabsf(o3))));
    }
#pragma unroll
    for (int o = 32; o > 0; o >>= 1) amax = fmaxf(amax, __shfl_xor(amax, o));
    const float qs = amax > 0.f ? 127.0f / amax : 0.f;
    unsigned* h2q = (unsigned*)(p.ws + OFF_H2Q);
#pragma unroll
    for (int i = 0; i < 4; ++i) h2q[(size_t)row * 256 + i * 64 + lane] = pack_i8x4(v[4 * i] * qs, v[4 * i + 1] * qs, v[4 * i + 2] * qs, v[4 * i + 3] * qs);
    if (lane == 0) ((float*)(p.ws + OFF_SH))[row] = amax * (1.0f / 127.0f);
  }
}

namespace pg8 {
constexpr int BM = 256, BK = 64, HALF = 128, HTB = HALF * BK * 2, STAGE_BYTES = 8 * HTB, NXCD = 8, WGM = 8;
DI int lds_byte(int r, int c) { const int st = (r >> 4) * 2 + (c >> 5), rr = r & 15, cc = c & 31, ob = rr * 64 + cc * 2; return st * 1024 + (ob ^ (((ob >> 9) & 1) << 5)); }
DI void stage_rc(int b, int& R, int& C) { const int st = b / 1024, sb = b % 1024, swz = sb ^ (((sb >> 9) & 1) << 5); R = (st >> 1) * 16 + swz / 64; C = (st & 1) * 32 + (swz % 64) / 2; }
DI int perm32(int rho) { const int n = rho >> 4, i = rho & 15; return 8 * (i >> 2) + 4 * n + (i & 3); }
struct Unit { int pm, pn; };
struct Gemm { const bf16_t* A; const bf16_t* Bt; int M, N, K; };
struct StaticOrder {
  int nM, nN, nwg, G, c;
  DI void init(int M, int N, int G_, int c_) { nM = M / BM; nN = N / BM; nwg = nM * nN; G = G_; c = c_; }
  DI bool next(int i, Unit& u) const {
    const long L = (long)i * G + c; if (L >= nwg) return false;
    int wgid = (int)L; { const int q = nwg / NXCD, r = nwg % NXCD, xcd = wgid % NXCD, off = wgid / NXCD; wgid = (xcd < r ? xcd * (q + 1) : r * (q + 1) + (xcd - r) * q) + off; }
    const int nig = WGM * nN, gid = wgid / nig, fm = gid * WGM, gsz = (nM - fm) < WGM ? (nM - fm) : WGM;
    u.pm = fm + ((wgid % nig) % gsz); u.pn = (wgid % nig) / gsz; return true;
  }
};

DI f32x4 mma16(bf16x8 a, bf16x8 b, f32x4 c) { return __builtin_amdgcn_mfma_f32_16x16x32_bf16(a, b, c, 0, 0, 0); }
DI i32x4 mma16(bf16x8 a, bf16x8 b, i32x4 c) { return __builtin_amdgcn_mfma_i32_16x16x64_i8(__builtin_bit_cast(i32x4, a), __builtin_bit_cast(i32x4, b), c, 0, 0, 0); }
template <class Epi>
DI void gemm_phase(LAS unsigned char* lds, const Gemm g, const StaticOrder& S, const Epi& E) {
  const int tid = otid(), wid = __builtin_amdgcn_readfirstlane(tid >> 6), lane = tid & 63, wr = wid >> 2, wc = wid & 3, fr = lane & 15, fq = lane >> 4;
  const int K = g.K, nt = K / BK;
  unsigned voffA[2], voffB[2];
#pragma unroll
  for (int i = 0; i < 2; ++i) { int R, C; stage_rc(tid * 16 + i * 8192, R, C); const int Rb = Epi::PERM ? ((R & ~31) + perm32(R & 31)) : R;
    voffA[i] = (unsigned)(R * K + C) * 2u; voffB[i] = (unsigned)(Rb * K + C) * 2u; }
  const size_t kstep = (size_t)(BK * 2);
  const size_t hstep = (size_t)HALF * K * 2;
  const size_t tstep = 2 * hstep;
  const unsigned ldsw = (unsigned)wid * 1024u;
  const int aoff = lds_byte(wr * 64 + fr, fq * 8), boff = lds_byte(wc * 32 + fr, fq * 8);
#define PG8_SA(b, h) (((b) * 2 + (h)) * HTB)
#define PG8_SB(b, h) ((4 + (b) * 2 + (h)) * HTB)
#define PG8_STAGE(bufoff, gbase, voff) do { _Pragma("unroll") for (int _i = 0; _i < 2; ++_i) \
    __builtin_amdgcn_global_load_lds((const unsigned*)((const char*)(gbase) + (voff)[_i]), (LAS unsigned*)(lds + (bufoff) + ldsw + _i * 8192), 16, 0, 0); } while (0)
#define PG8_LDA(dst, b, h) do { _Pragma("unroll") for (int m = 0; m < 4; ++m) _Pragma("unroll") for (int k = 0; k < 2; ++k) dst[m][k] = *(const LAS bf16x8*)(lds + PG8_SA(b, h) + aoff + m * 2048 + k * 1024); } while (0)
#define PG8_LDB(dst, b, h) do { _Pragma("unroll") for (int n = 0; n < 2; ++n) _Pragma("unroll") for (int k = 0; k < 2; ++k) dst[n][k] = *(const LAS bf16x8*)(lds + PG8_SB(b, h) + boff + n * 2048 + k * 1024); } while (0)
#define PG8_MMA(ai, bj, At, Bt) do { __builtin_amdgcn_s_setprio(1); _Pragma("unroll") for (int m = 0; m < 4; ++m) _Pragma("unroll") for (int n = 0; n < 2; ++n) _Pragma("unroll") for (int k = 0; k < 2; ++k) \
    acc[ai][bj][m][n] = mma16(Bt[n][k], At[m][k], acc[ai][bj][m][n]); __builtin_amdgcn_s_setprio(0); } while (0)
#define PG8_WAIT_V(n) asm volatile("s_waitcnt vmcnt(" #n ")" ::: "memory")
#define PG8_WAIT_L(n) asm volatile("s_waitcnt lgkmcnt(" #n ")" ::: "memory")
#define PG8_BAR __builtin_amdgcn_s_barrier()
#define PG8_SCHED __builtin_amdgcn_sched_barrier(0)
  Unit cur, nxt; int ui = 0;
  if (!S.next(0, cur)) return;
  typedef typename Epi::AccT AccT;
  const AccT zacc = {0, 0, 0, 0};
  AccT acc[2][2][4][2];
#pragma unroll
  for (int a = 0; a < 2; ++a)
#pragma unroll
    for (int b = 0; b < 2; ++b)
#pragma unroll
      for (int m = 0; m < 4; ++m)
#pragma unroll
        for (int n = 0; n < 2; ++n) acc[a][b][m][n] = zacc;
  bf16x8 At[4][2], B0[2][2], B1[2][2];
  const char* cA = (const char*)g.A + (size_t)cur.pm * tstep; const char* cB = (const char*)g.Bt + (size_t)cur.pn * tstep;
  PG8_STAGE(PG8_SB(0, 0), cB, voffB); PG8_STAGE(PG8_SA(0, 0), cA, voffA); PG8_STAGE(PG8_SB(0, 1), cB + hstep, voffB); PG8_STAGE(PG8_SA(0, 1), cA + hstep, voffA);
  if (wr == 1) PG8_BAR;
  PG8_WAIT_V(4); PG8_BAR;
  PG8_STAGE(PG8_SB(1, 0), cB + kstep, voffB); PG8_STAGE(PG8_SA(1, 0), cA + kstep, voffA); PG8_STAGE(PG8_SB(1, 1), cB + hstep + kstep, voffB);
  PG8_WAIT_V(6); PG8_BAR;
  for (;;) {
    const bool has_next = S.next(ui + 1, nxt);
    const char* nA = has_next ? (const char*)g.A + (size_t)nxt.pm * tstep : cA; const char* nB = has_next ? (const char*)g.Bt + (size_t)nxt.pn * tstep : cB;
    for (int t = 0; t < nt; t += 2) {
      const bool last = (t == nt - 2);
      const char* a1 = cA + (size_t)(t + 1) * kstep;
      const char* a2 = last ? nA : cA + (size_t)(t + 2) * kstep; const char* b2 = last ? nB : cB + (size_t)(t + 2) * kstep;
      const char* a3 = a2 + kstep; const char* b3 = b2 + kstep;
      PG8_LDB(B0, 0, 0); PG8_SCHED; PG8_LDA(At, 0, 0); PG8_STAGE(PG8_SA(1, 1), a1 + hstep, voffA);
      PG8_WAIT_L(8); PG8_BAR; PG8_WAIT_L(0); PG8_MMA(0, 0, At, B0); PG8_BAR; PG8_SCHED;
      PG8_LDB(B1, 0, 1); PG8_STAGE(PG8_SB(0, 0), b2, voffB);
      PG8_BAR; PG8_WAIT_L(0); PG8_MMA(0, 1, At, B1); PG8_BAR;
      PG8_LDA(At, 0, 1); PG8_STAGE(PG8_SA(0, 0), a2, voffA);
      PG8_BAR; PG8_WAIT_L(0); PG8_MMA(1, 0, At, B0); PG8_BAR; PG8_SCHED;
      PG8_STAGE(PG8_SB(0, 1), b2 + hstep, voffB);
      PG8_WAIT_V(6); PG8_BAR; PG8_MMA(1, 1, At, B1); PG8_BAR;
      PG8_LDB(B0, 1, 0); PG8_SCHED; PG8_LDA(At, 1, 0); PG8_STAGE(PG8_SA(0, 1), a2 + hstep, voffA);
      PG8_WAIT_L(8); PG8_BAR; PG8_WAIT_L(0); PG8_MMA(0, 0, At, B0); PG8_BAR; PG8_SCHED;
      PG8_LDB(B1, 1, 1); PG8_STAGE(PG8_SB(1, 0), b3, voffB);
      PG8_BAR; PG8_WAIT_L(0); PG8_MMA(0, 1, At, B1); PG8_BAR;
      PG8_LDA(At, 1, 1); PG8_STAGE(PG8_SA(1, 0), a3, voffA);
      PG8_BAR; PG8_WAIT_L(0); PG8_MMA(1, 0, At, B0); PG8_BAR; PG8_SCHED;
      PG8_STAGE(PG8_SB(1, 1), b3 + hstep, voffB);
      PG8_WAIT_V(6); PG8_BAR; PG8_MMA(1, 1, At, B1); PG8_BAR;
    }
    E(acc, cur, wr, wc, fr, fq);
    if (!has_next) break;
#pragma unroll
    for (int a = 0; a < 2; ++a)
#pragma unroll
      for (int b = 0; b < 2; ++b)
#pragma unroll
        for (int m = 0; m < 4; ++m)
#pragma unroll
          for (int n = 0; n < 2; ++n) acc[a][b][m][n] = zacc;
    cur = nxt; cA = nA; cB = nB; ++ui;
  }
  PG8_WAIT_V(0);
  if (wr == 0) PG8_BAR;
  PG8_BAR;
#undef PG8_SA
#undef PG8_SB
#undef PG8_STAGE
#undef PG8_LDA
#undef PG8_LDB
#undef PG8_MMA
#undef PG8_WAIT_V
#undef PG8_WAIT_L
#undef PG8_BAR
#undef PG8_SCHED
}
}

struct EpiProj {
  static constexpr bool PERM = true;
  typedef i32x4 AccT;
  char* ws; const float* b_merge;
  DI void operator()(const i32x4 (&acc)[2][2][4][2], const pg8::Unit& u, int wr, int wc, int fr, int fq) const {
    const float* rope = (const float*)(ws + OFF_ROPE);
    const float* sa = (const float*)(ws + OFF_SA); const float* sw = (const float*)(ws + OFF_SCW1);
    const int row0 = u.pm * 256 + wr * 64 + fr;
#pragma unroll
    for (int bj = 0; bj < 2; ++bj) {
      const int cg = u.pn * 256 + bj * 128 + wc * 32;
      const int c0 = cg + 8 * fq;
      if (cg >= 4384) continue;
      const float sbg = sw[cg >> 5];
#define EPJ_CV(sc_) const float f_ = sa[row] * (sc_); const f32x4 cv0 = __builtin_convertvector(acc[ai][bj][m][0], f32x4) * f_, cv1 = __builtin_convertvector(acc[ai][bj][m][1], f32x4) * f_;
      if (cg < 1280 && (cg < 640 || (cg >= 768 && cg < 896) || (cg >= 1024 && cg < 1152))) {
        bf16_t* dst; unsigned ld, cofs; float scale = 1.0f;
        if (cg < 512) { dst = (bf16_t*)(ws + OFF_Q); ld = 512; cofs = c0; scale = 0.18033688011112042f; }
        else if (cg < 640) { dst = (bf16_t*)(ws + OFF_KC); ld = 128; cofs = c0 - 512; }
        else if (cg < 896) { dst = (bf16_t*)(ws + OFF_KS); ld = 128; cofs = c0 - 768; }
        else { dst = (bf16_t*)(ws + OFF_KW); ld = 128; cofs = c0 - 1024; }
        const int d0 = 16 * ((cg >> 5) & 1) + 4 * fq;
#pragma unroll
        for (int ai = 0; ai < 2; ++ai)
#pragma unroll
          for (int m = 0; m < 4; ++m) {
            const int row = row0 + ai * 128 + m * 16, pos = row & (SEQ - 1);
            const f32x4 cs = *(const f32x4*)(rope + pos * 32 + d0), sn = *(const f32x4*)(rope + 262144 + pos * 32 + d0);
            EPJ_CV(sbg * scale)
            const f32x4 o1 = cv0 * cs - cv1 * sn, o2 = cv0 * sn + cv1 * cs;
            u32x4 w; w.x = pack2(o1.x, o1.y); w.y = pack2(o1.z, o1.w); w.z = pack2(o2.x, o2.y); w.w = pack2(o2.z, o2.w);
            *(u32x4*)(dst + (unsigned)row * ld + cofs) = w;
          }
      } else if (cg < 1280) {
        bf16_t* dst; unsigned cofs;
        if (cg < 768) { dst = (bf16_t*)(ws + OFF_VC); cofs = c0 - 640; }
        else if (cg < 1024) { dst = (bf16_t*)(ws + OFF_VS); cofs = c0 - 896; }
        else { dst = (bf16_t*)(ws + OFF_VW); cofs = c0 - 1152; }
#pragma unroll
        for (int ai = 0; ai < 2; ++ai)
#pragma unroll
          for (int m = 0; m < 4; ++m) {
            const int row = row0 + ai * 128 + m * 16;
            EPJ_CV(sbg)
            const f32x4 a = cv0, b = cv1;
            u32x4 w; w.x = pack2(a.x, a.y); w.y = pack2(a.z, a.w); w.z = pack2(b.x, b.y); w.w = pack2(b.z, b.w);
            *(u32x4*)(dst + (unsigned)row * 128u + cofs) = w;
          }
      } else if (cg < 2304) {
        bf16_t* dst = (bf16_t*)(ws + (cg < 1792 ? OFF_U : OFF_V));
        const unsigned cofs = c0 - (cg < 1792 ? 1280 : 1792);
#pragma unroll
        for (int ai = 0; ai < 2; ++ai)
#pragma unroll
          for (int m = 0; m < 4; ++m) {
            const int row = row0 + ai * 128 + m * 16;
            EPJ_CV(sbg)
            const f32x4 a = cv0, b = cv1;
            const f32x2 g0 = gelu_pk((f32x2){a.x, a.y}), g1 = gelu_pk((f32x2){a.z, a.w}), g2 = gelu_pk((f32x2){b.x, b.y}), g3 = gelu_pk((f32x2){b.z, b.w});
            u32x4 w; w.x = pack2(g0.x, g0.y); w.y = pack2(g1.x, g1.y); w.z = pack2(g2.x, g2.y); w.w = pack2(g3.x, g3.y);
            *(u32x4*)(dst + (unsigned)row * 512u + cofs) = w;
          }
      } else if (cg < 4352) {
        bf16_t* dst = (bf16_t*)(ws + OFF_GATE);
        const unsigned cofs = c0 - 2304;
        const f32x4 b0 = *(const f32x4*)(b_merge + cofs), b1 = *(const f32x4*)(b_merge + cofs + 4);
#pragma unroll
        for (int ai = 0; ai < 2; ++ai)
#pragma unroll
          for (int m = 0; m < 4; ++m) {
            const int row = row0 + ai * 128 + m * 16;
            EPJ_CV(sbg)
            const f32x4 a = cv0 + b0, b = cv1 + b1;
            u32x4 w; w.x = pack2(sigmoid_f(a.x), sigmoid_f(a.y)); w.y = pack2(sigmoid_f(a.z), sigmoid_f(a.w));
            w.z = pack2(sigmoid_f(b.x), sigmoid_f(b.y)); w.w = pack2(sigmoid_f(b.z), sigmoid_f(b.w));
            *(u32x4*)(dst + (unsigned)row * 2048u + cofs) = w;
          }
      } else {
        float* gs = (float*)(ws + OFF_GSIG);
        if (fq < 3) {
#pragma unroll
          for (int ai = 0; ai < 2; ++ai)
#pragma unroll
            for (int m = 0; m < 4; ++m) {
              const int row = row0 + ai * 128 + m * 16;
              EPJ_CV(sbg)
              const f32x4 a = cv0, b = cv1;
              f32x4 o0, o1; o0.x = sigmoid_f(a.x); o0.y = sigmoid_f(a.y); o0.z = sigmoid_f(a.z); o0.w = sigmoid_f(a.w);
              o1.x = sigmoid_f(b.x); o1.y = sigmoid_f(b.y); o1.z = sigmoid_f(b.z); o1.w = sigmoid_f(b.w);
              *(f32x4*)(gs + (unsigned)row * 32u + 8 * fq) = o0; *(f32x4*)(gs + (unsigned)row * 32u + 8 * fq + 4) = o1;
            }
        }
      }
    }
  }
};
DI void phase_gemm1(const Params& p, char* smem) {
  pg8::Gemm g{(const bf16_t*)(p.ws + OFF_H), (const bf16_t*)(p.ws + OFF_WT1), NTOK, N1, 512};
  pg8::StaticOrder S; S.init(NTOK, N1, gridDim.x, blockIdx.x);
  EpiProj E{p.ws, p.b_merge};
  pg8::gemm_phase((LAS unsigned char*)smem, g, S, E);
}

template <int BR> struct EpiMerge {
  static constexpr bool PERM = true;
  typedef f32x4 AccT;
  char* ws;
  DI void operator()(const f32x4 (&acc)[2][2][4][2], const pg8::Unit& u, int wr, int wc, int fr, int fq) const {
    const bf16_t* gate = (const bf16_t*)(ws + OFF_GATE);
    bf16_t* merged = (bf16_t*)(ws + OFF_H);
    const int row0 = u.pm * 256 + wr * 64 + fr;
#pragma unroll
    for (int bj = 0; bj < 2; ++bj) {
      const unsigned c0 = u.pn * 256 + bj * 128 + wc * 32 + 8 * fq;
#pragma unroll
      for (int ai = 0; ai < 2; ++ai)
#pragma unroll
        for (int m = 0; m < 4; ++m) {
          const unsigned row = row0 + ai * 128 + m * 16;
          float gg[8]; unpack8(*(const u32x4*)(gate + row * 2048u + BR * 1024 + c0), gg);
          const f32x4 a = acc[ai][bj][m][0], b = acc[ai][bj][m][1];
          float v[8] = {a.x * gg[0], a.y * gg[1], a.z * gg[2], a.w * gg[3], b.x * gg[4], b.y * gg[5], b.z * gg[6], b.w * gg[7]};
          bf16_t* mp = merged + row * 1024u + c0;
          if (BR == 1) {
            float old[8]; unpack8(*(const u32x4*)mp, old);
#pragma unroll
            for (int j = 0; j < 8; ++j) v[j] += old[j];
          }
          *(u32x4*)mp = pack8(v);
        }
    }
  }
};
DI void phase_merge(const Params& p, char* smem) {
  pg8::StaticOrder S; S.init(NTOK, 1024, gridDim.x, blockIdx.x);
  {
    pg8::Gemm g{(const bf16_t*)(p.ws + OFF_ONSA), (const bf16_t*)(p.ws + OFF_WB), NTOK, 1024, 512};
    EpiMerge<0> E{p.ws};
    pg8::gemm_phase((LAS unsigned char*)smem, g, S, E);
  }
  {
    pg8::Gemm g{(const bf16_t*)(p.ws + OFF_U), (const bf16_t*)(p.ws + OFF_WB) + (size_t)1024 * 512, NTOK, 1024, 512};
    EpiMerge<1> E{p.ws};
    pg8::gemm_phase((LAS unsigned char*)smem, g, S, E);
  }
}

struct EpiOut {
  static constexpr bool PERM = true;
  typedef f32x4 AccT;
  char* ws; const float* x;
  DI void operator()(const f32x4 (&acc)[2][2][4][2], const pg8::Unit& u, int wr, int wc, int fr, int fq) const {
    const float* mod = (const float*)(ws + OFF_MOD);
    bf16_t* y = (bf16_t*)(ws + OFF_Y);
    const int row0 = u.pm * 256 + wr * 64 + fr, b = (u.pm * 256) >> 13;
#pragma unroll
    for (int bj = 0; bj < 2; ++bj) {
      const unsigned c0 = u.pn * 256 + bj * 128 + wc * 32 + 8 * fq;
      const f32x4 g0 = *(const f32x4*)(mod + b * 6144 + 2048 + c0), g1 = *(const f32x4*)(mod + b * 6144 + 2048 + c0 + 4);
#pragma unroll
      for (int ai = 0; ai < 2; ++ai)
#pragma unroll
        for (int m = 0; m < 4; ++m) {
          const unsigned o = (unsigned)(row0 + ai * 128 + m * 16) * 1024u + c0;
          const f32x4 x0 = *(const f32x4*)(x + o), x1v = *(const f32x4*)(x + o + 4);
          const f32x4 v0 = x0 * DN_ALPHA + g0 * acc[ai][bj][m][0], v1 = x1v * DN_ALPHA + g1 * acc[ai][bj][m][1];
          u32x4 w; w.x = pack2(v0.x, v0.y); w.y = pack2(v0.z, v0.w); w.z = pack2(v1.x, v1.y); w.w = pack2(v1.z, v1.w);
          *(u32x4*)(y + o) = w;
        }
    }
  }
};
DI void phase_outproj(const Params& p, char* smem) {
  pg8::Gemm g{(const bf16_t*)(p.ws + OFF_H), (const bf16_t*)(p.ws + OFF_WOUT), NTOK, 1024, 1024};
  pg8::StaticOrder S; S.init(NTOK, 1024, gridDim.x, blockIdx.x);
  EpiOut E{p.ws, p.x};
  pg8::gemm_phase((LAS unsigned char*)smem, g, S, E);
}

struct EpiPq {
  static constexpr bool PERM = true;
  typedef i32x4 AccT;
  char* ws;
  DI void operator()(const i32x4 (&acc)[2][2][4][2], const pg8::Unit& u, int wr, int wc, int fr, int fq) const {
    bf16_t* pq = (bf16_t*)(ws + OFF_PQ);
    const float* sh = (const float*)(ws + OFF_SH); const float* sq = (const float*)(ws + OFF_SCWQ);
    const int row0 = u.pm * 256 + wr * 64 + fr;
#pragma unroll
    for (int bj = 0; bj < 2; ++bj) {
      const unsigned c0 = u.pn * 256 + bj * 128 + wc * 32 + 8 * fq;
      const float sbg = sq[(u.pn * 256 + bj * 128 + wc * 32) >> 5];
#pragma unroll
      for (int ai = 0; ai < 2; ++ai)
#pragma unroll
        for (int m = 0; m < 4; ++m) {
          const float f_ = sh[row0 + ai * 128 + m * 16] * sbg;
          const f32x4 a = __builtin_convertvector(acc[ai][bj][m][0], f32x4) * f_, b = __builtin_convertvector(acc[ai][bj][m][1], f32x4) * f_;
          u32x4 w; w.x = pack2(a.x, a.y); w.y = pack2(a.z, a.w); w.z = pack2(b.x, b.y); w.w = pack2(b.z, b.w);
          *(u32x4*)(pq + (unsigned)(row0 + ai * 128 + m * 16) * 2048u + c0) = w;
        }
    }
  }
};
DI void phase_peerq(const Params& p, char* smem) {
  pg8::Gemm g{(const bf16_t*)(p.ws + OFF_H2Q), (const bf16_t*)(p.ws + OFF_WQ), NTOK, 2048, 512};
  pg8::StaticOrder S; S.init(NTOK, 2048, gridDim.x, blockIdx.x);
  EpiPq E{p.ws};
  pg8::gemm_phase((LAS unsigned char*)smem, g, S, E);
}

DI void phase_sgu(const Params& p, char* smem) {
  char* ws = p.ws;
  const int tid = otid(), lane = tid & 63, wave = tid >> 6, l31 = lane & 31, hh = lane >> 5;
  bf16_t* u = (bf16_t*)(ws + OFF_U);
  const bf16_t* v = (const bf16_t*)(ws + OFF_V);
  const bf16_t* W = (const bf16_t*)(ws + OFF_SGUW);
  float* st = (float*)smem;
  bf16_t* vn = (bf16_t*)(smem + 1024);
  constexpr int LN_ = 72;
  const int dt = wave & 1, it = wave >> 1;
  const int gi = lane >> 4, i16 = lane & 15, tq = i16 >> 2, tp = i16 & 3;
  for (int item = blockIdx.x; item < NTOK / 128; item += gridDim.x) {
    const int t0 = item * 128;
    __syncthreads();
    for (int i = 0; i < 16; ++i) {
      const int t = wave * 16 + i;
      const u32x4 raw = *(const u32x4*)(v + (size_t)(t0 + t) * 512 + lane * 8);
      float f[8]; unpack8(raw, f);
      float s = 0.f;
#pragma unroll
      for (int j = 0; j < 8; ++j) s += f[j];
      const float mean = wave_sum(s) * (1.f / 512.f);
      float q = 0.f;
#pragma unroll
      for (int j = 0; j < 8; ++j) { const float d = f[j] - mean; q += d * d; }
      const float rstd = rsqrtf(wave_sum(q) * (1.f / 512.f) + LN_EPS);
      if (lane == 0) { st[t * 2] = mean; st[t * 2 + 1] = rstd; }
    }
    u32x4 vnext[2];
#pragma unroll
    for (int i = 0; i < 2; ++i) { const int idx = tid + i * NT; vnext[i] = *(const u32x4*)(v + (size_t)(t0 + (idx >> 3)) * 512 + (idx & 7) * 8); }
    for (int g = 0; g < 8; ++g) {
      u32x4 vcur[2] = {vnext[0], vnext[1]};
      if (g + 1 < 8) {
#pragma unroll
        for (int i = 0; i < 2; ++i) { const int idx = tid + i * NT; vnext[i] = *(const u32x4*)(v + (size_t)(t0 + (idx >> 3)) * 512 + (g + 1) * 64 + (idx & 7) * 8); }
      }
      u32x2 uold[4];
      {
        const bf16_t* urow0 = u + (size_t)(t0 + it * 32 + l31) * 512 + g * 64 + dt * 32 + 4 * hh;
#pragma unroll
        for (int q4 = 0; q4 < 4; ++q4) uold[q4] = *(const u32x2*)(urow0 + 8 * q4);
      }
      lds_barrier();
#pragma unroll
      for (int i = 0; i < 2; ++i) {
        const int idx = tid + i * NT, j = idx >> 3, dc = (idx & 7) * 8;
        const u32x4 raw = vcur[i];
        const float mean = st[j * 2], rstd = st[j * 2 + 1];
        float f[8], gg[8], bb[8]; unpack8(raw, f); ld8(p.sgu_ln_g + g * 64 + dc, gg); ld8(p.sgu_ln_b + g * 64 + dc, bb);
#pragma unroll
        for (int k = 0; k < 8; ++k) f[k] = (f[k] - mean) * rstd * gg[k] + bb[k];
        *(u32x4*)(vn + j * LN_ + dc) = pack8(f);
      }
      lds_barrier();
      f32x16 acc;
#pragma unroll
      for (int r = 0; r < 16; ++r) acc[r] = 0.f;
      const bf16_t* wrow = W + ((size_t)g * 128 + it * 32 + l31) * 128 + hh * 8;
      const LAS bf16_t* vbase = (const LAS bf16_t*)vn + (8 * (gi >> 1) + tq) * LN_ + dt * 32 + 16 * (gi & 1) + 4 * tp;
#pragma unroll
      for (int ks = 0; ks < 8; ++ks) {
        if (ks <= 2 * it + 1) {
          const LAS bf16_t* vp = vbase + (ks * 16) * LN_;
          const s16x4 lo = __builtin_amdgcn_ds_read_tr16_b64_v4i16((LAS s16x4*)vp);
          const s16x4 hi = __builtin_amdgcn_ds_read_tr16_b64_v4i16((LAS s16x4*)(vp + 4 * LN_));
          const bf16x8 bw = *(const bf16x8*)(wrow + ks * 16);
          acc = MFMA32(__builtin_shufflevector(lo, hi, 0, 1, 2, 3, 4, 5, 6, 7), bw, acc);
        }
      }
      const int i = it * 32 + l31;
      const float bsv = p.sgu_b[g * 128 + i];
      bf16_t* urow = u + (size_t)(t0 + i) * 512 + g * 64 + dt * 32 + 4 * hh;
#pragma unroll
      for (int q4 = 0; q4 < 4; ++q4) {
        u32x2* up = (u32x2*)(urow + 8 * q4);
        const u32x2 old = uold[q4];
        u32x2 wv; wv.x = pack2(bflo(old.x) * (acc[4 * q4] + bsv), bfhi(old.x) * (acc[4 * q4 + 1] + bsv));
        wv.y = pack2(bflo(old.y) * (acc[4 * q4 + 2] + bsv), bfhi(old.y) * (acc[4 * q4 + 3] + bsv));
        *up = wv;
      }
    }
  }
}

DI void phase_compress(const Params& p, char* smem) {
  char* ws = p.ws;
  const int tid = otid(), lane = tid & 63, wave = tid >> 6, l31 = lane & 31, hh = lane >> 5;
  bf16_t* hid = (bf16_t*)smem;
  constexpr int LH = 136;
  for (int item = blockIdx.x; item < 128; item += gridDim.x) {
    const int w = item >> 6, R0 = (item & 63) * 128;
    const bf16_t* src = (const bf16_t*)(ws + (w == 0 ? OFF_KC : OFF_VC));
    const bf16_t* W1 = (const bf16_t*)(ws + OFF_CW1) + (size_t)w * 128 * 2048;
    const bf16_t* W2 = (const bf16_t*)(ws + OFF_CW2) + (size_t)w * 64 * 128;
    const float* posb = (const float*)(ws + OFF_POSB) + w * 128;
    const int rg = wave >> 2, cgp = wave & 3;
    const bf16_t* abase[2];
#pragma unroll
    for (int mi = 0; mi < 2; ++mi) {
      const int R = R0 + rg * 64 + mi * 32 + l31, bg = R >> 9, n = R & 511, nn = n < 510 ? n : 510;
      abase[mi] = src + ((size_t)((bg >> 1) * SEQ + 16 * nn)) * 128 + (bg & 1) * 64 + hh * 8;
    }
    const bf16_t* bbase = W1 + (size_t)(cgp * 32 + l31) * 2048 + hh * 8;
    f32x16 acc[2];
#pragma unroll
    for (int r = 0; r < 16; ++r) { acc[0][r] = 0.f; acc[1][r] = 0.f; }
#pragma unroll 8
    for (int ks = 0; ks < 128; ++ks) {
      const int aofs = (ks >> 2) * 128 + (ks & 3) * 16;
      const bf16x8 a0 = *(const bf16x8*)(abase[0] + aofs), a1 = *(const bf16x8*)(abase[1] + aofs);
      const bf16x8 bb = *(const bf16x8*)(bbase + ks * 16);
      acc[0] = MFMA32(a0, bb, acc[0]); acc[1] = MFMA32(a1, bb, acc[1]);
    }
    __syncthreads();
    {
      const float pb = posb[cgp * 32 + l31];
#pragma unroll
      for (int mi = 0; mi < 2; ++mi)
#pragma unroll
        for (int r = 0; r < 16; ++r) {
          const int row = rg * 64 + mi * 32 + (r & 3) + 8 * (r >> 2) + 4 * hh;
          hid[row * LH + cgp * 32 + l31] = f2bf(gelu_f(acc[mi][r] + pb));
        }
    }
    __syncthreads();
    const int mi2 = wave >> 1, ni = wave & 1;
    f32x16 o;
#pragma unroll
    for (int r = 0; r < 16; ++r) o[r] = 0.f;
#pragma unroll
    for (int ks = 0; ks < 8; ++ks) {
      const bf16x8 a = *(const bf16x8*)(hid + (mi2 * 32 + l31) * LH + ks * 16 + hh * 8);
      const bf16x8 bb = *(const bf16x8*)(W2 + (size_t)(ni * 32 + l31) * 128 + ks * 16 + hh * 8);
      o = MFMA32(a, bb, o);
    }
    const int d = ni * 32 + l31;
    const float b2 = p.cmp_b2[w * 64 + (w == 0 ? dperm(d) : d)];
    const int bg = R0 >> 9;
    bf16_t* dst = (bf16_t*)(ws + (w == 0 ? OFF_KCMP : OFF_VCMP));
#pragma unroll
    for (int r = 0; r < 16; ++r) {
      const int n = (R0 & 511) + mi2 * 32 + (r & 3) + 8 * (r >> 2) + 4 * hh;
      dst[((size_t)bg * 512 + n) * 64 + d] = f2bf(n < 511 ? o[r] + b2 : 0.f);
    }
  }
}

constexpr int LK = 72;
constexpr int NSA_TILE = 18432;
constexpr int NSA_AIMP = 3 * NSA_TILE, NSA_CIMP = NSA_AIMP + 32768, NSA_SELM = NSA_CIMP + 32768;
constexpr float NSA_THR = 6.0f;
struct TileRegs { u32x4 k; u32x4 v; };

DI void nsa_load_tile(TileRegs& t, const bf16_t* kbase, size_t kstride, const bf16_t* vbase, size_t vstride) {
  const int tid = otid(), r = tid >> 3, ch = tid & 7;
  t.k = *(const u32x4*)(kbase + (size_t)r * kstride + ch * 8);
  t.v = *(const u32x4*)(vbase + (size_t)r * vstride + ch * 8);
}
DI void nsa_store_tile(const TileRegs& t, char* tile) {
  const int tid = otid(), r = tid >> 3, ch = tid & 7;
  *(u32x4*)((bf16_t*)tile + r * LK + ch * 8) = t.k;
  *(u32x4*)((bf16_t*)(tile + 9216) + r * LK + ch * 8) = t.v;
}
DI void nsa_scores(f32x16 (&st)[2], const char* tile, const bf16x8 (&qf)[4], int lane) {
  const bf16_t* Ks = (const bf16_t*)tile;
#pragma unroll
  for (int kt = 0; kt < 2; ++kt)
#pragma unroll
    for (int r = 0; r < 16; ++r) st[kt][r] = 0.f;
  __builtin_amdgcn_s_setprio(1);
#pragma unroll
  for (int ks = 0; ks < 4; ++ks)
#pragma unroll
    for (int kt = 0; kt < 2; ++kt) {
      const bf16x8 a = *(const bf16x8*)(Ks + (kt * 32 + (lane & 31)) * LK + ks * 16 + (lane >> 5) * 8);
      st[kt] = MFMA32(a, qf[ks], st[kt]);
    }
  __builtin_amdgcn_s_setprio(0);
}
DI void nsa_pv(f32x16 (&o)[2], const f32x16 (&pt)[2], const char* tile, int lane) {
  const int gi = lane >> 4, i16 = lane & 15, q = i16 >> 2, pp = i16 & 3;
  const LAS bf16_t* Vs = (const LAS bf16_t*)(tile + 9216) + (4 * (gi >> 1) + q) * LK + 16 * (gi & 1) + 4 * pp;
#pragma unroll
  for (int kt = 0; kt < 2; ++kt)
#pragma unroll
    for (int s = 0; s < 2; ++s) {
      u32x4 pk; pk.x = pack2(pt[kt][8 * s], pt[kt][8 * s + 1]); pk.y = pack2(pt[kt][8 * s + 2], pt[kt][8 * s + 3]);
      pk.z = pack2(pt[kt][8 * s + 4], pt[kt][8 * s + 5]); pk.w = pack2(pt[kt][8 * s + 6], pt[kt][8 * s + 7]);
      const bf16x8 pb = __builtin_bit_cast(bf16x8, pk);
      bf16x8 a[2];
#pragma unroll
      for (int dt = 0; dt < 2; ++dt) {
        const LAS bf16_t* vp = Vs + (kt * 32 + 16 * s) * LK + dt * 32;
        const s16x4 lo = __builtin_amdgcn_ds_read_tr16_b64_v4i16((LAS s16x4*)vp);
        const s16x4 hi = __builtin_amdgcn_ds_read_tr16_b64_v4i16((LAS s16x4*)(vp + 8 * LK));
        a[dt] = __builtin_shufflevector(lo, hi, 0, 1, 2, 3, 4, 5, 6, 7);
      }
      o[0] = MFMA32(a[0], pb, o[0]); o[1] = MFMA32(a[1], pb, o[1]);
    }
}

constexpr float NSA_NEG = -3.0e38f;
DI void nsa_online(f32x16 (&st)[2], bool sel, float& m, float& l, f32x16 (&o)[2], const char* tile, int lane) {
  float mx = NSA_NEG;
#pragma unroll
  for (int r = 0; r < 16; ++r) mx = fmaxf(mx, fmaxf(st[0][r], st[1][r]));
  mx = fmaxf(mx, xor32f(mx, lane));
  mx = sel ? mx : NSA_NEG;
  if (__any(mx > m + NSA_THR)) {
    const float mn = fmaxf(m, mx);
    const float alpha = __builtin_amdgcn_exp2f(m - mn);
    m = mn; l *= alpha;
#pragma unroll
    for (int r = 0; r < 16; ++r) { o[0][r] *= alpha; o[1][r] *= alpha; }
  }
  const float ms = sel ? m : 1e30f;
  float sum = 0.f;
#pragma unroll
  for (int r = 0; r < 16; ++r) {
    const float p0 = __builtin_amdgcn_exp2f(st[0][r] - ms), p1 = __builtin_amdgcn_exp2f(st[1][r] - ms);
    st[0][r] = p0; st[1][r] = p1; sum += p0 + p1;
  }
  l += sum;
  nsa_pv(o, st, tile, lane);
}

struct NsaItem { int qb, b, g, bg, t; size_t tokrow; };
DI NsaItem nsa_item(int item0, int wave, int qi) {
  const int G = gridDim.x, k = item0 / G, bb = item0 - k * G;
  const int item = (k & 1) ? (k * G + (G - 1 - bb)) : item0;
  NsaItem it; it.qb = 127 - (item >> 4); const int rest = item & 15; it.b = rest >> 1; it.g = rest & 1;
  it.bg = it.b * 2 + it.g; it.t = it.qb * 64 + wave * 8 + qi; it.tokrow = (size_t)it.b * SEQ + it.t; return it;
}
DI void nsa_accum_store(bf16_t* dst, const f32x16 (&o)[2], float sc, bool first, int hh) {
#pragma unroll
  for (int dt = 0; dt < 2; ++dt)
#pragma unroll
    for (int q4 = 0; q4 < 4; ++q4) {
      u32x2* pp = (u32x2*)(dst + dt * 32 + 8 * q4 + 4 * hh);
      float a0 = sc * o[dt][4 * q4], a1 = sc * o[dt][4 * q4 + 1], a2 = sc * o[dt][4 * q4 + 2], a3 = sc * o[dt][4 * q4 + 3];
      if (!first) { const u32x2 old = *pp; a0 += bflo(old.x); a1 += bfhi(old.x); a2 += bflo(old.y); a3 += bfhi(old.y); }
      u32x2 wv; wv.x = pack2(a0, a1); wv.y = pack2(a2, a3);
      *pp = wv;
    }
}

constexpr int NSA_STAGE = 4 * 18432;
typedef float f32x4v __attribute__((ext_vector_type(4)));
#define MFMA16(a, b, c) __builtin_amdgcn_mfma_f32_16x16x32_bf16((a), (b), (c), 0, 0, 0)
struct StageRegs { u32x4 r[8]; };
DI void nsa_load_stage(StageRegs& sr, const bf16_t* kb, const bf16_t* vb, int j0s, int qb) {
  const int tid = otid(), r = tid >> 3, ch = tid & 7;
#pragma unroll
  for (int tt = 0; tt < 4; ++tt) {
    const int j = (j0s + tt <= qb) ? j0s + tt : qb;
    sr.r[2 * tt] = *(const u32x4*)(kb + ((size_t)j * 64 + r) * 128 + ch * 8);
    sr.r[2 * tt + 1] = *(const u32x4*)(vb + ((size_t)j * 64 + r) * 128 + ch * 8);
  }
}
DI void nsa_store_stage(const StageRegs& sr, char* stage) {
  const int tid = otid(), r = tid >> 3, ch = tid & 7;
#pragma unroll
  for (int tt = 0; tt < 4; ++tt) {
    *(u32x4*)((bf16_t*)(stage + tt * 18432) + r * LK + ch * 8) = sr.r[2 * tt];
    *(u32x4*)((bf16_t*)(stage + tt * 18432 + 9216) + r * LK + ch * 8) = sr.r[2 * tt + 1];
  }
}
struct Sel16 { float m, l; bool has; f32x4v o[4]; };
DI void nsa_unit16(Sel16& g, const char* tile, const bf16x8 (&qf)[2], bool sel, int klim  , int lane) {
  const int c16 = lane & 15, kg = lane >> 4, tq = c16 >> 2, tp = c16 & 3;
  const bf16_t* Ks = (const bf16_t*)tile + c16 * LK + kg * 8;
  f32x4v st[4];
  const float ini = sel ? -g.m : -1e30f;
#pragma unroll
  for (int kt = 0; kt < 4; ++kt) {
    st[kt] = (f32x4v){ini, ini, ini, ini};
#pragma unroll
    for (int ks = 0; ks < 2; ++ks) st[kt] = MFMA16(*(const bf16x8*)(Ks + kt * 16 * LK + ks * 32), qf[ks], st[kt]);
  }
  if (klim < 64) {
#pragma unroll
    for (int kt = 0; kt < 4; ++kt)
#pragma unroll
      for (int r = 0; r < 4; ++r) st[kt][r] = (kt * 16 + 4 * kg + r <= klim) ? st[kt][r] : NSA_NEG;
  }
  float mx = fmaxf(fmaxf(fmaxf(st[0][0], st[0][1]), fmaxf(st[0][2], st[0][3])), fmaxf(fmaxf(st[1][0], st[1][1]), fmaxf(st[1][2], st[1][3])));
  mx = fmaxf(mx, fmaxf(fmaxf(fmaxf(st[2][0], st[2][1]), fmaxf(st[2][2], st[2][3])), fmaxf(fmaxf(st[3][0], st[3][1]), fmaxf(st[3][2], st[3][3]))));
  mx = fmaxf(mx, xor16f(mx, lane));
  mx = fmaxf(mx, xor32f(mx, lane));
  const bool real = mx > -1e29f;
  const bool fresh = !g.has && real, up = g.has && (mx > NSA_THR);
  if (__any(fresh || up)) {
    const float delta = (fresh || up) ? mx : 0.f;
    const float alpha = up ? __builtin_amdgcn_exp2f(-delta) : 1.0f;
    g.m += delta; g.l *= alpha;
#pragma unroll
    for (int dt = 0; dt < 4; ++dt) g.o[dt] *= alpha;
#pragma unroll
    for (int kt = 0; kt < 4; ++kt) st[kt] -= delta;
  }
  g.has = g.has || real;
  float sum = 0.f;
#pragma unroll
  for (int kt = 0; kt < 4; ++kt)
#pragma unroll
    for (int r = 0; r < 4; ++r) { const float pv = __builtin_amdgcn_exp2f(st[kt][r]); st[kt][r] = pv; sum += pv; }
  g.l += sum;
  const LAS bf16_t* Vs = (const LAS bf16_t*)(tile + 9216) + (4 * kg + tq) * LK + 4 * tp;
#pragma unroll
  for (int kp = 0; kp < 2; ++kp) {
    u32x4 pk; pk.x = pack2(st[2 * kp][0], st[2 * kp][1]); pk.y = pack2(st[2 * kp][2], st[2 * kp][3]);
    pk.z = pack2(st[2 * kp + 1][0], st[2 * kp + 1][1]); pk.w = pack2(st[2 * kp + 1][2], st[2 * kp + 1][3]);
    const bf16x8 pb = __builtin_bit_cast(bf16x8, pk);
#pragma unroll
    for (int dt = 0; dt < 4; ++dt) {
      const LAS bf16_t* vp = Vs + (2 * kp) * 16 * LK + dt * 16;
      const s16x4 lo = __builtin_amdgcn_ds_read_tr16_b64_v4i16((LAS s16x4*)vp);
      const s16x4 hi = __builtin_amdgcn_ds_read_tr16_b64_v4i16((LAS s16x4*)(vp + 16 * LK));
      g.o[dt] = MFMA16(__builtin_shufflevector(lo, hi, 0, 1, 2, 3, 4, 5, 6, 7), pb, g.o[dt]);
    }
  }
}
DI void nsa_sel16(const Params& p, char* smem, bool dry) {
  char* ws = p.ws;
  const int tid = otid(), lane = tid & 63, wave = tid >> 6, c16 = lane & 15, kg = lane >> 4, qi4 = c16 >> 2, r4 = c16 & 3;
  const bf16_t* Q = (const bf16_t*)(ws + OFF_Q);
  const float* gsig = (const float*)(ws + OFF_GSIG);
  bf16_t* ONSA = (bf16_t*)(ws + OFF_ONSA);
  const u32x4* SELG = (const u32x4*)(ws + OFF_SELG);
  const bf16_t* KS = (const bf16_t*)(ws + OFF_KS); const bf16_t* VS = (const bf16_t*)(ws + OFF_VS);
  constexpr int NITEM = NB * 2 * 128;
  for (int item = blockIdx.x; item < NITEM; item += gridDim.x) {
    const NsaItem it = nsa_item(item, wave, 0);
    const int qb = it.qb;
    bf16x8 qf[2][2]; u32x4 selw[2]; float g_s[2]; int tg[2]; Sel16 G[2];
#pragma unroll
    for (int gq = 0; gq < 2; ++gq) {
      tg[gq] = it.t + 4 * gq + qi4;
      const size_t tokrow = (size_t)it.b * SEQ + tg[gq];
#pragma unroll
      for (int ks = 0; ks < 2; ++ks) qf[gq][ks] = *(const bf16x8*)(Q + tokrow * 512 + (it.g * 4 + r4) * 64 + ks * 32 + kg * 8);
      selw[gq] = SELG[(size_t)it.bg * SEQ + tg[gq]];
      g_s[gq] = gsig[tokrow * 32 + (it.g * 4 + r4) * 3 + 1];
      G[gq].m = 0.f; G[gq].l = 0.f; G[gq].has = false;
#pragma unroll
      for (int dt = 0; dt < 4; ++dt) G[gq].o[dt] = (f32x4v){0.f, 0.f, 0.f, 0.f};
    }
    const bf16_t* kb = KS + (size_t)it.b * SEQ * 128 + it.g * 64;
    const bf16_t* vb = VS + (size_t)it.b * SEQ * 128 + it.g * 64;
    const int nst = (qb >> 2) + 1;
    StageRegs sr;
    lds_barrier();
    nsa_load_stage(sr, kb, vb, 0, qb);
    nsa_store_stage(sr, smem);
    lds_barrier();
    for (int sidx = 0; sidx < nst; ++sidx) {
      const char* stage = smem + (sidx & 1) * NSA_STAGE;
      if (sidx + 1 < nst) nsa_load_stage(sr, kb, vb, 4 * (sidx + 1), qb);
#pragma unroll 1
      for (int tt = 0; tt < 4; ++tt) {
        const int j = 4 * sidx + tt;
        if (j > qb) break;
#pragma unroll
        for (int gq = 0; gq < 2; ++gq) {
          const unsigned w = j < 32 ? selw[gq].x : (j < 64 ? selw[gq].y : (j < 96 ? selw[gq].z : selw[gq].w));
          const bool sel = (w >> (j & 31)) & 1u;
          if (__any(sel)) nsa_unit16(G[gq], stage + tt * 18432, qf[gq], sel, (j == qb) ? (tg[gq] - j * 64) : 1000, lane);
        }
      }
      if (sidx + 1 < nst) nsa_store_stage(sr, smem + ((sidx + 1) & 1) * NSA_STAGE);
      lds_barrier();
    }
#pragma unroll
    for (int gq = 0; gq < 2; ++gq) {
      float l = G[gq].l;
      l += xor16f(l, lane); l += xor32f(l, lane);
      const float sc = l > 0.f ? g_s[gq] / l : 0.f;
      bf16_t* dst = ONSA + ((size_t)it.b * SEQ + tg[gq]) * 512 + (it.g * 4 + r4) * 64 + 4 * kg;
      if (!dry) {
#pragma unroll
        for (int dt = 0; dt < 4; ++dt) {
          u32x2* pp = (u32x2*)(dst + dt * 16);
          const u32x2 old = *pp;
          u32x2 wv; wv.x = pack2(bflo(old.x) + sc * G[gq].o[dt][0], bfhi(old.x) + sc * G[gq].o[dt][1]);
          wv.y = pack2(bflo(old.y) + sc * G[gq].o[dt][2], bfhi(old.y) + sc * G[gq].o[dt][3]);
          *pp = wv;
        }
      } else asm volatile("" :: "v"(G[gq].o[0]), "v"(G[gq].o[1]), "v"(G[gq].o[2]), "v"(G[gq].o[3]), "v"(l));
    }
  }
}

DI void phase_nsa(const Params& p, char* smem, int branch_mask) {
  char* ws = p.ws;
  const int tid = otid(), lane = tid & 63, wave = tid >> 6, hh = lane >> 5, c = lane & 31, qi = c >> 2, r4 = c & 3;
  const bf16_t* Q = (const bf16_t*)(ws + OFF_Q);
  const float* gsig = (const float*)(ws + OFF_GSIG);
  bf16_t* ONSA = (bf16_t*)(ws + OFF_ONSA);
  u32x4* SELG = (u32x4*)(ws + OFF_SELG);
  constexpr int NITEM = NB * 2 * 128;

#pragma unroll 1
  for (int rep1 = 0; rep1 < ((PROBE_DUP & 4096) ? 2 : 1); ++rep1) {
    const bf16_t* KCMP = (const bf16_t*)(ws + OFF_KCMP); const bf16_t* VCMP = (const bf16_t*)(ws + OFF_VCMP);
    float* Aimp = (float*)(smem + NSA_AIMP) + wave * 1024;
    float* Cimp = (float*)(smem + NSA_CIMP) + wave * 1024;
    unsigned short* selm16 = (unsigned short*)(smem + NSA_SELM) + wave * 64;
    const u32x4* selm128 = (const u32x4*)(smem + NSA_SELM) + wave * 8;
    for (int item = blockIdx.x; item < NITEM; item += gridDim.x) {
      const NsaItem it = nsa_item(item, wave, qi);
      const int t = it.t;
      bf16x8 qf[4];
#pragma unroll
      for (int ks = 0; ks < 4; ++ks) qf[ks] = *(const bf16x8*)(Q + it.tokrow * 512 + (it.g * 4 + r4) * 64 + ks * 16 + hh * 8);
      const float g_c = gsig[it.tokrow * 32 + (it.g * 4 + r4) * 3 + 0];
      TileRegs tr;
      const int nmax = (it.qb * 64 + 63 - 31) >> 4, ntile = (nmax >> 6) + 1;
      const int nfull = (it.qb * 64 - 31) >> 4;
      const bf16_t* kb = KCMP + (size_t)it.bg * 512 * 64;
      const bf16_t* vb = VCMP + (size_t)it.bg * 512 * 64;
      float m = -1e30f, l = 0.f;
      nsa_load_tile(tr, kb, 64, vb, 64);
      nsa_store_tile(tr, smem);
      __syncthreads();
      for (int j = 0; j < ntile; ++j) {
        const char* tile = smem + (j & 1) * NSA_TILE;
        if (j + 1 < ntile) nsa_load_tile(tr, kb + (size_t)(j + 1) * 64 * 64, 64, vb + (size_t)(j + 1) * 64 * 64, 64);
        f32x16 st[2];
        nsa_scores(st, tile, qf, lane);
        const bool full = (j * 64 + 63 <= nfull);
        const int nlim = full ? 100000 : ((t - 31) >> 4) - j * 64 - 4 * hh;
        float mx = NSA_NEG;
#pragma unroll
        for (int kt = 0; kt < 2; ++kt)
#pragma unroll
          for (int r = 0; r < 16; ++r) {
            st[kt][r] = (kt * 32 + (r & 3) + 8 * (r >> 2) <= nlim) ? st[kt][r] : NSA_NEG;
            mx = fmaxf(mx, st[kt][r]);
          }
        mx = fmaxf(mx, xor32f(mx, lane));
        const float mn = fmaxf(m, mx);
        float sum = 0.f;
#pragma unroll
        for (int kt = 0; kt < 2; ++kt)
#pragma unroll
          for (int r = 0; r < 16; ++r) sum += __builtin_amdgcn_exp2f(st[kt][r] - mn);
        l = l * __builtin_amdgcn_exp2f(m - mn) + sum;
        m = mn;
        if (j + 1 < ntile) nsa_store_tile(tr, smem + ((j + 1) & 1) * NSA_TILE);
        __syncthreads();
      }
      l += xor32f(l, lane);
      const float inv_l = l > 0.f ? 1.0f / l : 0.f;
      f32x16 o[2];
#pragma unroll
      for (int r = 0; r < 16; ++r) { o[0][r] = 0.f; o[1][r] = 0.f; }
      nsa_load_tile(tr, kb, 64, vb, 64);
      nsa_store_tile(tr, smem);
      __syncthreads();
      for (int j = 0; j < ntile; ++j) {
        const char* tile = smem + (j & 1) * NSA_TILE;
        if (j + 1 < ntile) nsa_load_tile(tr, kb + (size_t)(j + 1) * 64 * 64, 64, vb + (size_t)(j + 1) * 64 * 64, 64);
        f32x16 st[2];
        nsa_scores(st, tile, qf, lane);
        const bool full = (j * 64 + 63 <= nfull);
        const int nlim = full ? 100000 : ((t - 31) >> 4) - j * 64 - 4 * hh;
#pragma unroll
        for (int kt = 0; kt < 2; ++kt)
#pragma unroll
          for (int r = 0; r < 16; ++r) {
            const float arg = (kt * 32 + (r & 3) + 8 * (r >> 2) <= nlim) ? st[kt][r] - m : NSA_NEG;
            st[kt][r] = __builtin_amdgcn_exp2f(arg) * inv_l;
          }
#pragma unroll
        for (int kt = 0; kt < 2; ++kt)
#pragma unroll
          for (int c4 = 0; c4 < 4; ++c4) {
            float carry = 0.5f * st[kt][4 * c4 + 3];
            float fullv = st[kt][4 * c4] + st[kt][4 * c4 + 1] + st[kt][4 * c4 + 2] + carry;
            fullv += xor1f(fullv); fullv += xor2f(fullv);
            carry += xor1f(carry); carry += xor2f(carry);
            const int jb = j * 16 + kt * 8 + 2 * c4 + hh;
            if (r4 == 0) { Aimp[qi * 128 + jb] = fullv; Cimp[qi * 128 + jb] = carry; }
          }
        if (branch_mask & 1) nsa_pv(o, st, tile, lane);
        if (j + 1 < ntile) nsa_store_tile(tr, smem + ((j + 1) & 1) * NSA_TILE);
        __syncthreads();
      }
      nsa_accum_store(ONSA + it.tokrow * 512 + (it.g * 4 + r4) * 64, o, (branch_mask & 1) ? g_c : 0.f, true, hh);
      const int cur = it.qb;
      if (cur <= 15) {
        if (lane < 8) { selm16[lane * 8 + 0] = (unsigned short)((2u << cur) - 1u);
#pragma unroll
          for (int k = 1; k < 8; ++k) selm16[lane * 8 + k] = 0; }
      } else {
        const int qs = lane >> 3, sub = lane & 7;
        float v[16];
#pragma unroll
        for (int i = 0; i < 16; ++i) {
          const int jj = sub * 16 + i;
          const bool ok = (jj >= 1) && (jj <= cur - 2);
          const int jm = jj >= 1 ? jj - 1 : 0;
          v[i] = ok ? (Aimp[qs * 128 + jj] + Cimp[qs * 128 + jm]) : -3e38f;
        }
        unsigned bits = 0;
        for (int itn = 0; itn < 13; ++itn) {
          float bv = v[0]; int bi = 0;
#pragma unroll
          for (int i = 1; i < 16; ++i) if (v[i] > bv) { bv = v[i]; bi = i; }
          int bj = sub * 16 + bi;
#pragma unroll
          for (int o2 = 1; o2 < 8; o2 <<= 1) {
            const float ov = __shfl_xor(bv, o2); const int oj = __shfl_xor(bj, o2);
            if (ov > bv || (ov == bv && oj < bj)) { bv = ov; bj = oj; }
          }
          if ((bj >> 4) == sub) {
            const int i2 = bj & 15;
#pragma unroll
            for (int i = 0; i < 16; ++i) if (i == i2) v[i] = -3e38f;
            bits |= 1u << i2;
          }
        }
        if (sub == 0) bits |= 1u;
        if ((cur >> 4) == sub) bits |= 1u << (cur & 15);
        if (((cur - 1) >> 4) == sub) bits |= 1u << ((cur - 1) & 15);
        selm16[qs * 8 + sub] = (unsigned short)bits;
      }
      __syncthreads();
      if (r4 == 0 && hh == 0) SELG[(size_t)it.bg * SEQ + t] = selm128[qi];
    }
  }
  __threadfence_block();
  __syncthreads();

#pragma unroll 1
  for (int sweep_i = 0; sweep_i < 2 + ((PROBE_DUP & 1024) ? 1 : 0) + ((PROBE_DUP & 2048) ? 1 : 0); ++sweep_i) {
    const int sweep = (sweep_i < 2) ? sweep_i : (((PROBE_DUP & 1024) && sweep_i == 2) ? 0 : 1);
    const bool dry = sweep_i >= 2;
    if (!(branch_mask & (sweep == 0 ? 2 : 4))) continue;
    if (sweep == 0) { nsa_sel16(p, smem, dry); continue; }
    const bf16_t* KB = (const bf16_t*)(ws + (sweep == 0 ? OFF_KS : OFF_KW)); const bf16_t* VB = (const bf16_t*)(ws + (sweep == 0 ? OFF_VS : OFF_VW));
    for (int item = blockIdx.x; item < NITEM; item += gridDim.x) {
      const NsaItem it = nsa_item(item, wave, qi);
      const int t = it.t, qb = it.qb;
      bf16x8 qf[4];
#pragma unroll
      for (int ks = 0; ks < 4; ++ks) qf[ks] = *(const bf16x8*)(Q + it.tokrow * 512 + (it.g * 4 + r4) * 64 + ks * 16 + hh * 8);
      const float g_b = gsig[it.tokrow * 32 + (it.g * 4 + r4) * 3 + 1 + sweep];
      u32x4 selw = {0xffffffffu, 0xffffffffu, 0xffffffffu, 0xffffffffu};
      if (sweep == 0) selw = SELG[(size_t)it.bg * SEQ + t];
      TileRegs tr;
      const bf16_t* kb = KB + (size_t)it.b * SEQ * 128 + it.g * 64;
      const bf16_t* vb = VB + (size_t)it.b * SEQ * 128 + it.g * 64;
      float m = -1e30f, l = 0.f;
      f32x16 o[2];
#pragma unroll
      for (int r = 0; r < 16; ++r) { o[0][r] = 0.f; o[1][r] = 0.f; }
      const int j0 = (sweep == 1 && qb >= 8) ? qb - 8 : 0;
      __syncthreads();
      nsa_load_tile(tr, kb + (size_t)j0 * 64 * 128, 128, vb + (size_t)j0 * 64 * 128, 128);
      nsa_store_tile(tr, smem);
      if (j0 + 1 <= qb) { nsa_load_tile(tr, kb + (size_t)(j0 + 1) * 64 * 128, 128, vb + (size_t)(j0 + 1) * 64 * 128, 128); nsa_store_tile(tr, smem + NSA_TILE); }
      if (j0 + 2 <= qb) nsa_load_tile(tr, kb + (size_t)(j0 + 2) * 64 * 128, 128, vb + (size_t)(j0 + 2) * 64 * 128, 128);
      __syncthreads();
      const bool late = wave >= 4;
      if (__builtin_amdgcn_readfirstlane(wave) >= 4) __builtin_amdgcn_s_setprio(1);
      bool has = false;
      m = 0.f;
      f32x16 st[2];
      {
        const unsigned w0 = j0 < 32 ? selw.x : (j0 < 64 ? selw.y : (j0 < 96 ? selw.z : selw.w));
        const float ini = ((w0 >> (j0 & 31)) & 1u) ? 0.f : -1e30f;
#pragma unroll
        for (int r = 0; r < 16; ++r) { st[0][r] = ini; st[1][r] = ini; }
        const bf16_t* Kc = (const bf16_t*)smem;
#pragma unroll
        for (int ks = 0; ks < 4; ++ks)
#pragma unroll
          for (int kt = 0; kt < 2; ++kt) st[kt] = MFMA32(*(const bf16x8*)(Kc + (kt * 32 + (lane & 31)) * LK + ks * 16 + (lane >> 5) * 8), qf[ks], st[kt]);
      }
      int bi = 0;
      for (int j = j0; j <= qb; ++j) {
        const char* tile = smem + bi * NSA_TILE;
        const int bn = bi == 2 ? 0 : bi + 1, bnn = bn == 2 ? 0 : bn + 1;
        const int jn = j + 1;
        const unsigned wn = jn < 32 ? selw.x : (jn < 64 ? selw.y : (jn < 96 ? selw.z : selw.w));
        const bool seln = (wn >> (jn & 31)) & 1u;
        const bf16_t* Kn = (const bf16_t*)(smem + bn * NSA_TILE) + (lane & 31) * LK + (lane >> 5) * 8;
        f32x16 sn[2];
        if (!late) {
          const float ini = seln ? -m : -1e30f;
#pragma unroll
          for (int r = 0; r < 16; ++r) { sn[0][r] = ini; sn[1][r] = ini; }
#pragma unroll
          for (int ks = 0; ks < 4; ++ks)
#pragma unroll
            for (int kt = 0; kt < 2; ++kt) sn[kt] = MFMA32(*(const bf16x8*)(Kn + kt * 32 * LK + ks * 16), qf[ks], sn[kt]);
        }
        if (j == qb || (sweep == 1 && j == qb - 8)) {
          const int khi = t - j * 64 - 4 * hh, klo = (sweep == 1) ? khi - 511 : -100000;
#pragma unroll
          for (int r = 0; r < 16; ++r) {
            const int o0 = (r & 3) + 8 * (r >> 2);
            st[0][r] = (o0 <= khi && o0 >= klo) ? st[0][r] : NSA_NEG;
            st[1][r] = (o0 + 32 <= khi && o0 + 32 >= klo) ? st[1][r] : NSA_NEG;
          }
        }
        float mx;
        {
          float a0, a1, a2, a3;
          asm("v_max3_f32 %0, %1, %2, %3" : "=v"(a0) : "v"(st[0][0]), "v"(st[0][1]), "v"(st[0][2]));
          asm("v_max3_f32 %0, %1, %2, %3" : "=v"(a1) : "v"(st[0][3]), "v"(st[0][4]), "v"(st[0][5]));
          asm("v_max3_f32 %0, %1, %2, %3" : "=v"(a2) : "v"(st[0][6]), "v"(st[0][7]), "v"(st[0][8]));
          asm("v_max3_f32 %0, %1, %2, %3" : "=v"(a3) : "v"(st[0][9]), "v"(st[0][10]), "v"(st[0][11]));
          asm("v_max3_f32 %0, %1, %2, %3" : "=v"(a0) : "v"(a0), "v"(st[0][12]), "v"(st[0][13]));
          asm("v_max3_f32 %0, %1, %2, %3" : "=v"(a1) : "v"(a1), "v"(st[0][14]), "v"(st[0][15]));
          asm("v_max3_f32 %0, %1, %2, %3" : "=v"(a2) : "v"(a2), "v"(st[1][0]), "v"(st[1][1]));
          asm("v_max3_f32 %0, %1, %2, %3" : "=v"(a3) : "v"(a3), "v"(st[1][2]), "v"(st[1][3]));
          asm("v_max3_f32 %0, %1, %2, %3" : "=v"(a0) : "v"(a0), "v"(st[1][4]), "v"(st[1][5]));
          asm("v_max3_f32 %0, %1, %2, %3" : "=v"(a1) : "v"(a1), "v"(st[1][6]), "v"(st[1][7]));
          asm("v_max3_f32 %0, %1, %2, %3" : "=v"(a2) : "v"(a2), "v"(st[1][8]), "v"(st[1][9]));
          asm("v_max3_f32 %0, %1, %2, %3" : "=v"(a3) : "v"(a3), "v"(st[1][10]), "v"(st[1][11]));
          asm("v_max3_f32 %0, %1, %2, %3" : "=v"(a0) : "v"(a0), "v"(st[1][12]), "v"(st[1][13]));
          asm("v_max3_f32 %0, %1, %2, %3" : "=v"(a1) : "v"(a1), "v"(st[1][14]), "v"(st[1][15]));
          asm("v_max3_f32 %0, %1, %2, %3" : "=v"(a0) : "v"(a0), "v"(a1), "v"(a2));
          const float other = a3;
          asm("v_max_f32 %0, %1, %2" : "=v"(mx) : "v"(a0), "v"(other));
          const float px = xor32f(mx, lane);
          asm("v_max_f32 %0, %1, %2" : "=v"(mx) : "v"(mx), "v"(px));
        }
        const bool real = mx > -1e29f;
        const bool fresh = !has && real, up = has && (mx > NSA_THR);
        if (__any(fresh || up)) {
          const float delta = (fresh || up) ? mx : 0.f;
          const float alpha = up ? __builtin_amdgcn_exp2f(-delta) : 1.0f;
          m += delta; l *= alpha;
#pragma unroll
          for (int r = 0; r < 16; ++r) { o[0][r] *= alpha; o[1][r] *= alpha; st[0][r] -= delta; st[1][r] -= delta; }
          if (!late) {
            const float dn = seln ? delta : 0.f;
#pragma unroll
            for (int r = 0; r < 16; ++r) { sn[0][r] -= dn; sn[1][r] -= dn; }
          }
        }
        has = has || real;
        f32x2 s2 = {0.f, 0.f};
#pragma unroll
        for (int r = 0; r < 16; ++r) {
          const float p0 = __builtin_amdgcn_exp2f(st[0][r]), p1 = __builtin_amdgcn_exp2f(st[1][r]);
          st[0][r] = p0; st[1][r] = p1; s2 += (f32x2){p0, p1};
        }
        l += s2.x + s2.y;
        nsa_pv(o, st, tile, lane);
        if (late) {
          const float ini = seln ? -m : -1e30f;
#pragma unroll
          for (int r = 0; r < 16; ++r) { sn[0][r] = ini; sn[1][r] = ini; }
#pragma unroll
          for (int ks = 0; ks < 4; ++ks)
#pragma unroll
            for (int kt = 0; kt < 2; ++kt) sn[kt] = MFMA32(*(const bf16x8*)(Kn + kt * 32 * LK + ks * 16), qf[ks], sn[kt]);
        }
        if (j + 2 <= qb) nsa_store_tile(tr, smem + bnn * NSA_TILE);
        if (j + 3 <= qb) nsa_load_tile(tr, kb + (size_t)(j + 3) * 64 * 128, 128, vb + (size_t)(j + 3) * 64 * 128, 128);
#pragma unroll
        for (int r = 0; r < 16; ++r) { st[0][r] = sn[0][r]; st[1][r] = sn[1][r]; }
        bi = bn;
        __syncthreads();
      }
      __builtin_amdgcn_s_setprio(0);
      l += xor32f(l, lane);
      if (!dry) nsa_accum_store(ONSA + it.tokrow * 512 + (it.g * 4 + r4) * 64, o, l > 0.f ? g_b / l : 0.f, false, hh);
      else asm volatile("" :: "v"(o[0]), "v"(o[1]), "v"(l));
    }
  }
}

DI unsigned ord_key(float f) { const unsigned u = __float_as_uint(f); return (u & 0x80000000u) ? ~u : (u | 0x80000000u); }
DI float ord_val(unsigned k) { return __uint_as_float((k & 0x80000000u) ? (k & 0x7fffffffu) : ~k); }
DI void cex(unsigned& hi, unsigned& lo) { const unsigned x = hi, y = lo; hi = x > y ? x : y; lo = x > y ? y : x; }
DI void sort16_desc(unsigned (&a)[16]) {
#pragma unroll
  for (int k = 2; k <= 16; k <<= 1)
#pragma unroll
    for (int j = k >> 1; j > 0; j >>= 1)
#pragma unroll
      for (int i = 0; i < 16; ++i) {
        const int l = i ^ j;
        if (l > i) { if ((i & k) == 0) cex(a[i], a[l]); else cex(a[l], a[i]); }
      }
}
DI void bitonic_finish16(unsigned (&a)[16]) {
#pragma unroll
  for (int j = 8; j > 0; j >>= 1)
#pragma unroll
    for (int i = 0; i < 16; ++i) { const int l = i ^ j; if (l > i) cex(a[i], a[l]); }
}
DI void merge_top16(unsigned (&a)[16], const unsigned (&b)[16]) {
#pragma unroll
  for (int i = 0; i < 16; ++i) a[i] = a[i] > b[15 - i] ? a[i] : b[15 - i];
  bitonic_finish16(a);
}
DI void merge_partner16(unsigned (&a)[16]) {
  unsigned b[16];
#pragma unroll
  for (int i = 0; i < 16; ++i) b[i] = xor32u(a[i], otid());
  merge_top16(a, b);
}


constexpr int KLD = 136;
DI void peer_top16(unsigned (&top)[16], const bf16x8 (&bq)[8], const bf16_t* keys  , int lane) {
  const int l31 = lane & 31, hh = lane >> 5;
  unsigned grp[16];
#pragma unroll
  for (int nt = 0; nt < 4; ++nt) {
    f32x16 sa;
#pragma unroll
    for (int r = 0; r < 16; ++r) sa[r] = 0.f;
    const bf16_t* kp = keys + (nt * 32 + l31) * KLD + hh * 8;
#pragma unroll
    for (int ks = 0; ks < 8; ++ks) { const bf16x8 a = *(const bf16x8*)(kp + ks * 16); sa = MFMA32(a, bq[ks], sa); }
#pragma unroll
    for (int r = 0; r < 16; ++r) {
      const int n = nt * 32 + (r & 3) + 8 * (r >> 2) + 4 * hh;
      grp[r] = (ord_key(sa[r]) & ~0x7Fu) | (unsigned)(127 - n);
    }
    sort16_desc(grp);
    if (nt == 0) {
#pragma unroll
      for (int i = 0; i < 16; ++i) top[i] = grp[i];
    } else merge_top16(top, grp);
  }
  merge_partner16(top);
}

DI void phase_route(const Params& p, char* smem) {
  char* ws = p.ws;
  const int tid = otid(), lane = tid & 63, wave = tid >> 6, l31 = lane & 31, hh = lane >> 5;
  const bf16_t* pq = (const bf16_t*)(ws + OFF_PQ);
  const bf16_t* pk = (const bf16_t*)(ws + OFF_PKEYS);
  int* eidx = (int*)(ws + OFF_EIDX);
  float* pgate = (float*)(ws + OFF_PGATE);
  bf16_t* KL = (bf16_t*)smem;
  unsigned* LS = (unsigned*)(smem + 2 * 128 * KLD * 2) + wave * 1024;
  {
    const int h0 = blockIdx.x & 7;
    __syncthreads();
#pragma unroll
    for (int i = 0; i < 8; ++i) {
      const int idx = tid + i * NT, row = idx >> 4, ch = idx & 15;
      *(u32x4*)(KL + row * KLD + ch * 8) = *(const u32x4*)(pk + ((size_t)h0 * 256 + row) * 128 + ch * 8);
    }
    __syncthreads();
  }
  constexpr int CA[64] = {0,0,0,0,0,0,0,0,0,0,0,0,0,0,0,0, 1,1,1,1,1,1,1,1, 2,2,2,2,2, 3,3,3,3, 4,4,4, 5,5, 6,6, 7,7, 8,9,10,11,12,13,14,15, 0,0,0,0,0,0,0,0,0,0,0,0,0,0};
  constexpr int CB[64] = {0,1,2,3,4,5,6,7,8,9,10,11,12,13,14,15, 0,1,2,3,4,5,6,7, 0,1,2,3,4, 0,1,2,3, 0,1,2, 0,1, 0,1, 0,1, 0,0,0,0,0,0,0,0, 0,0,0,0,0,0,0,0,0,0,0,0,0,0};
  for (int item = blockIdx.x; item < (NTOK / 256) * 8; item += gridDim.x) {
    const int h = item & 7, t0 = (item >> 3) * 256 + wave * 32;
    unsigned s1[16], s2[16];
    const bf16_t* pqrow = pq + (size_t)(t0 + l31) * 2048 + h * 256 + hh * 8;
    bf16x8 bq1[8], bq2[8];
#pragma unroll
    for (int ks = 0; ks < 8; ++ks) { bq1[ks] = *(const bf16x8*)(pqrow + ks * 16); bq2[ks] = *(const bf16x8*)(pqrow + 128 + ks * 16); }
    peer_top16(s1, bq1, KL, lane);
    peer_top16(s2, bq2, KL + 128 * KLD, lane);
    float f1[16], f2[16];
#pragma unroll
    for (int i = 0; i < 16; ++i) { f1[i] = ord_val(s1[i]); f2[i] = ord_val(s2[i]); }
    unsigned ca[16], cb2[16];
#pragma unroll
    for (int i = 0; i < 32; ++i) {
      const int i0 = i, i1 = 25 + i;
      unsigned k0 = 0u, k1 = 0u;
      if (i0 < 25) k0 = (ord_key(f1[CA[i0]] + f2[CB[i0]]) & ~0xFFu) | (unsigned)(255 - (CA[i0] * 16 + CB[i0]));
      if (i1 < 50) k1 = (ord_key(f1[CA[i1]] + f2[CB[i1]]) & ~0xFFu) | (unsigned)(255 - (CA[i1] * 16 + CB[i1]));
      const unsigned kk = hh ? k1 : k0;
      if (i < 16) ca[i] = kk; else cb2[i - 16] = kk;
    }
    sort16_desc(ca); sort16_desc(cb2);
    merge_top16(ca, cb2);
    merge_partner16(ca);
    if (hh == 0) {
#pragma unroll
      for (int i = 0; i < 16; ++i) { LS[l31 * 32 + i] = s1[i]; LS[l31 * 32 + 16 + i] = s2[i]; }
    }
    const float mx = ord_val(ca[0]);
    float ex[16], sum = 0.f;
#pragma unroll
    for (int i = 0; i < 16; ++i) { ex[i] = __expf(ord_val(ca[i]) - mx); sum += ex[i]; }
    const float inv = 1.0f / sum;
    int eo[16]; float go[16];
#pragma unroll
    for (int i = 0; i < 16; ++i) {
      const int flat = 255 - (int)(ca[i] & 0xFFu);
      const unsigned k1 = LS[l31 * 32 + (flat >> 4)], k2 = LS[l31 * 32 + 16 + (flat & 15)];
      eo[i] = (127 - (int)(k1 & 0x7Fu)) * 128 + (127 - (int)(k2 & 0x7Fu));
      go[i] = ex[i] * inv;
    }
    const size_t ob = ((size_t)(t0 + l31) * 8 + h) * 16;
    if (hh == 0) {
      *(u32x4*)(eidx + ob) = (u32x4){(unsigned)eo[0], (unsigned)eo[1], (unsigned)eo[2], (unsigned)eo[3]};
      *(u32x4*)(eidx + ob + 4) = (u32x4){(unsigned)eo[4], (unsigned)eo[5], (unsigned)eo[6], (unsigned)eo[7]};
      *(f32x4*)(pgate + ob) = (f32x4){go[0], go[1], go[2], go[3]};
      *(f32x4*)(pgate + ob + 4) = (f32x4){go[4], go[5], go[6], go[7]};
    } else {
      *(u32x4*)(eidx + ob + 8) = (u32x4){(unsigned)eo[8], (unsigned)eo[9], (unsigned)eo[10], (unsigned)eo[11]};
      *(u32x4*)(eidx + ob + 12) = (u32x4){(unsigned)eo[12], (unsigned)eo[13], (unsigned)eo[14], (unsigned)eo[15]};
      *(f32x4*)(pgate + ob + 8) = (f32x4){go[8], go[9], go[10], go[11]};
      *(f32x4*)(pgate + ob + 12) = (f32x4){go[12], go[13], go[14], go[15]};
    }
  }
}

#define FOR32(M) M(0) M(1) M(2) M(3) M(4) M(5) M(6) M(7) M(8) M(9) M(10) M(11) M(12) M(13) M(14) M(15) M(16) M(17) M(18) M(19) M(20) M(21) M(22) M(23) M(24) M(25) M(26) M(27) M(28) M(29) M(30) M(31)
#define FOR16(M) M(0) M(1) M(2) M(3) M(4) M(5) M(6) M(7) M(8) M(9) M(10) M(11) M(12) M(13) M(14) M(15)
DI void phase_ffn_u(const Params& p) {
  char* ws = p.ws;
  const int lane = otid() & 63, wave = otid() >> 6, pg = lane >> 3, dc = lane & 7;
  const int sl = blockIdx.x & 7, wslot = (blockIdx.x >> 3) * NW + wave, nw = (gridDim.x >> 3) * NW;
  const unsigned char* PU8 = (const unsigned char*)(ws + OFF_PU8) + (size_t)sl * 16384 * 128 + dc * 16;
  const unsigned char* h2q = (const unsigned char*)(ws + OFF_H2Q) + sl * 128 + dc * 16;
  const int* eidx = (const int*)(ws + OFF_EIDX);
  float* part = (float*)(ws + OFF_PART) + (size_t)sl * NTOK * 128;
  const int j0 = (dc >> 2) * 64 + ((2 * dc) & 7) * 8 + pg;
  int ev0 = 0, ev1 = 0, nev0 = 0, nev1 = 0; u32x4 hq = {0u, 0u, 0u, 0u}, nhq = hq;
  if (wslot < NTOK) { ev0 = eidx[(size_t)wslot * 128 + lane]; ev1 = eidx[(size_t)wslot * 128 + 64 + lane]; hq = *(const u32x4*)(h2q + (size_t)wslot * DM); }
  for (int t = wslot; t < NTOK; t += nw) {
    if (t + nw < NTOK) { const size_t o = (size_t)(t + nw) * 128; nev0 = eidx[o + lane]; nev1 = eidx[o + 64 + lane]; nhq = *(const u32x4*)(h2q + (size_t)(t + nw) * DM); }
#define FFU_LD(it) const u32x4 ru##it = *(const u32x4*)(PU8 + (size_t)__shfl((it) < 8 ? ev0 : ev1, ((it) & 7) * 8 + pg) * 128);
    FOR16(FFU_LD)
    int d[16];
#define FFU_CP(it) { int a_ = __builtin_amdgcn_sdot4((int)ru##it.x, (int)hq.x, 0, false); a_ = __builtin_amdgcn_sdot4((int)ru##it.y, (int)hq.y, a_, false); \
      a_ = __builtin_amdgcn_sdot4((int)ru##it.z, (int)hq.z, a_, false); d[it] = __builtin_amdgcn_sdot4((int)ru##it.w, (int)hq.w, a_, false); }
    FOR16(FFU_CP)
    int r8[8], r4[4], r2[2];
    { const bool hi = dc & 4;
#pragma unroll
      for (int i = 0; i < 8; ++i) { const int keep = hi ? d[8 + i] : d[i], send = hi ? d[i] : d[8 + i]; r8[i] = keep + __shfl_xor(send, 4); } }
    { const bool hi = dc & 2;
#pragma unroll
      for (int i = 0; i < 4; ++i) { const int keep = hi ? r8[4 + i] : r8[i], send = hi ? r8[i] : r8[4 + i]; r4[i] = keep + __float_as_int(xor2f(__int_as_float(send))); } }
    { const bool hi = dc & 1;
#pragma unroll
      for (int i = 0; i < 2; ++i) { const int keep = hi ? r4[2 + i] : r4[i], send = hi ? r4[i] : r4[2 + i]; r2[i] = keep + __float_as_int(xor1f(__int_as_float(send))); } }
    part[(size_t)t * 128 + j0] = (float)r2[0];
    part[(size_t)t * 128 + j0 + 8] = (float)r2[1];
    ev0 = nev0; ev1 = nev1; hq = nhq;
  }
}
DI void phase_ffn_w(const Params& p) {
  char* ws = p.ws;
  const int lane = otid() & 63, wave = otid() >> 6;
  const float* part = (const float*)(ws + OFF_PART);
  const float* scu = (const float*)(ws + OFF_SCU); const float* scv = (const float*)(ws + OFF_SCV);
  const int* eidx = (const int*)(ws + OFF_EIDX);
  const float* pgate = (const float*)(ws + OFF_PGATE);
  float* wbuf = (float*)(ws + OFF_WBUF);
  for (int grp = blockIdx.x; grp < NTOK / NW; grp += gridDim.x) {
    const size_t o = (size_t)(grp * NW + wave) * 128 + lane;
    float a0 = 0.f, a1 = 0.f;
#pragma unroll
    for (int s8 = 0; s8 < 8; ++s8) { a0 += part[(size_t)s8 * NTOK * 128 + o]; a1 += part[(size_t)s8 * NTOK * 128 + o + 64]; }
    const int e0 = eidx[o], e1 = eidx[o + 64];
    const float sht = ((const float*)(ws + OFF_SH))[grp * NW + wave];
    wbuf[o] = pgate[o] * gelu_f(a0 * (scu[e0] * sht)) * scv[e0];
    wbuf[o + 64] = pgate[o + 64] * gelu_f(a1 * (scu[e1] * sht)) * scv[e1];
  }
}
DI void phase_ffn_v(const Params& p) {
  char* ws = p.ws;
  const int lane = otid() & 63, wave = otid() >> 6, pg = lane >> 3, dc = lane & 7;
  const int sl = blockIdx.x & 7, wslot = (blockIdx.x >> 3) * NW + wave, nw = (gridDim.x >> 3) * NW;
  const unsigned char* PV8 = (const unsigned char*)(ws + OFF_PV8) + (size_t)sl * 16384 * 128 + dc * 16;
  const int* eidx = (const int*)(ws + OFF_EIDX) + 16 * pg;
  const float* wbuf = (const float*)(ws + OFF_WBUF) + 16 * pg;
  bf16_t* ffnb = (bf16_t*)(ws + OFF_FFNB);
  u32x4 ne0 = {0u, 0u, 0u, 0u}, ne1 = ne0, ne2 = ne0, ne3 = ne0;
  if (wslot < NTOK) { const int* ep = eidx + (size_t)wslot * 128; ne0 = *(const u32x4*)ep; ne1 = *(const u32x4*)(ep + 4); ne2 = *(const u32x4*)(ep + 8); ne3 = *(const u32x4*)(ep + 12); }
#pragma unroll 1
  for (int t = wslot; t < NTOK; t += nw) {
    const u32x4 ce0 = ne0, ce1 = ne1, ce2 = ne2, ce3 = ne3;
    if (t + nw < NTOK) { const int* ep = eidx + (size_t)(t + nw) * 128; ne0 = *(const u32x4*)ep; ne1 = *(const u32x4*)(ep + 4); ne2 = *(const u32x4*)(ep + 8); ne3 = *(const u32x4*)(ep + 12); }
    const float* wp = wbuf + (size_t)t * 128;
    const f32x4 wq0 = *(const f32x4*)wp, wq1 = *(const f32x4*)(wp + 4), wq2 = *(const f32x4*)(wp + 8), wq3 = *(const f32x4*)(wp + 12);
#define FFV_E(it) ((it) < 4 ? ce0[(it) & 3] : (it) < 8 ? ce1[(it) & 3] : (it) < 12 ? ce2[(it) & 3] : ce3[(it) & 3])
#define FFV_W(it) ((it) < 4 ? wq0[(it) & 3] : (it) < 8 ? wq1[(it) & 3] : (it) < 12 ? wq2[(it) & 3] : wq3[(it) & 3])
#define FFV_LD(it) const u32x4 rv##it = *(const u32x4*)(PV8 + (size_t)FFV_E(it) * 128);
#define FFV_CP(it) { const float wj = FFV_W(it); const f32x2 w2 = {wj, wj}; \
      acc2[0] += __builtin_amdgcn_cvt_pk_f32_fp8((int)rv##it.x, false) * w2; acc2[1] += __builtin_amdgcn_cvt_pk_f32_fp8((int)rv##it.x, true) * w2; \
      acc2[2] += __builtin_amdgcn_cvt_pk_f32_fp8((int)rv##it.y, false) * w2; acc2[3] += __builtin_amdgcn_cvt_pk_f32_fp8((int)rv##it.y, true) * w2; \
      acc2[4] += __builtin_amdgcn_cvt_pk_f32_fp8((int)rv##it.z, false) * w2; acc2[5] += __builtin_amdgcn_cvt_pk_f32_fp8((int)rv##it.z, true) * w2; \
      acc2[6] += __builtin_amdgcn_cvt_pk_f32_fp8((int)rv##it.w, false) * w2; acc2[7] += __builtin_amdgcn_cvt_pk_f32_fp8((int)rv##it.w, true) * w2; }
    FOR16(FFV_LD)
    f32x2 acc2[8];
#pragma unroll
    for (int i = 0; i < 8; ++i) acc2[i] = (f32x2){0.f, 0.f};
    FOR16(FFV_CP)
    float acc[16];
#pragma unroll
    for (int i = 0; i < 8; ++i) { acc[2 * i] = acc2[i].x; acc[2 * i + 1] = acc2[i].y; }
    float r8[8], r4[4], r2[2];
    { const bool hi = lane & 32;
#pragma unroll
      for (int i = 0; i < 8; ++i) { const float keep = hi ? acc[8 + i] : acc[i], send = hi ? acc[i] : acc[8 + i]; r8[i] = keep + xor32f(send, lane); } }
    { const bool hi = lane & 16;
#pragma unroll
      for (int i = 0; i < 4; ++i) { const float keep = hi ? r8[4 + i] : r8[i], send = hi ? r8[i] : r8[4 + i]; r4[i] = keep + xor16f(send, lane); } }
    { const bool hi = lane & 8;
#pragma unroll
      for (int i = 0; i < 2; ++i) { const float keep = hi ? r4[2 + i] : r4[i], send = hi ? r4[i] : r4[2 + i]; r2[i] = keep + xor8f(send); } }
    *(unsigned*)(ffnb + (size_t)t * DM + sl * 128 + dc * 16 + 2 * pg) = pack2(r2[0], r2[1]);
  }
}
DI void phase_final(const Params& p) {
  char* ws = p.ws;
  const int lane = otid() & 63, wave = otid() >> 6;
  const bf16_t* x1 = (const bf16_t*)(ws + OFF_X1);
  const bf16_t* ffnb = (const bf16_t*)(ws + OFF_FFNB);
  const float* mod = (const float*)(ws + OFF_MOD);
  for (int grp = blockIdx.x; grp < NTOK / NW; grp += gridDim.x) {
    const int row = grp * NW + wave, b = row >> 13;
    float v[16];
#pragma unroll
    for (int i = 0; i < 4; ++i) {
      const int col = i * 256 + lane * 4;
      const f32x4 gt2 = *(const f32x4*)(mod + b * 6144 + 5120 + col);
      const u32x2 xr = *(const u32x2*)(x1 + (size_t)row * DM + col), fr = *(const u32x2*)(ffnb + (size_t)row * DM + col);
      v[4 * i] = DN_ALPHA * bflo(xr.x) + gt2.x * bflo(fr.x); v[4 * i + 1] = DN_ALPHA * bfhi(xr.x) + gt2.y * bfhi(fr.x);
      v[4 * i + 2] = DN_ALPHA * bflo(xr.y) + gt2.z * bflo(fr.y); v[4 * i + 3] = DN_ALPHA * bfhi(xr.y) + gt2.w * bfhi(fr.y);
    }
    float mean, rstd; row_stats(v, mean, rstd);
#pragma unroll
    for (int i = 0; i < 4; ++i) {
      const int col = i * 256 + lane * 4;
      const f32x4 g = *(const f32x4*)(p.ln2_g + col), bb = *(const f32x4*)(p.ln2_b + col);
      f32x4 o;
      o.x = (v[4 * i] - mean) * rstd * g.x + bb.x; o.y = (v[4 * i + 1] - mean) * rstd * g.y + bb.y;
      o.z = (v[4 * i + 2] - mean) * rstd * g.z + bb.z; o.w = (v[4 * i + 3] - mean) * rstd * g.w + bb.w;
      *(f32x4*)(p.out + (size_t)row * DM + col) = o;
    }
  }
}

#define XB_TMO      128
#define XB_XCNT(j)  (256  + 64 * (j))
#define XB_XSUB(j)  (1280 + 64 * (j))
#define XB_XGEN(j)  (2304 + 64 * (j))
#define XB_TOP      3328
#define XB_TOPGEN   3392
#define XCD_BAR_WORDS 3456
#define XB_SPIN_CAP (1u << 22)
DI unsigned xb_ld(unsigned* p) { return __hip_atomic_load(p, __ATOMIC_RELAXED, __HIP_MEMORY_SCOPE_AGENT); }
DI unsigned xb_add(unsigned* p, unsigned v) { return __hip_atomic_fetch_add(p, v, __ATOMIC_RELAXED, __HIP_MEMORY_SCOPE_AGENT); }
DI unsigned xb_xcc_id() { return (unsigned)__builtin_amdgcn_s_getreg((3 << 11) | 20) & 0xFu; }
#define XB_SPIN(cond, bar) do { unsigned _sp = 0; while (cond) { __builtin_amdgcn_s_sleep(1); \
    if ((++_sp & 255u) == 0u) { if (xb_ld(&(bar)[XB_TMO])) break; if (_sp > XB_SPIN_CAP) { atomicAdd(&(bar)[XB_TMO], 1u); break; } } } } while (0)
struct XcdBarrier { unsigned* bar; unsigned x; volatile LAS unsigned* st; };
DI XcdBarrier xcd_barrier_post(unsigned* bar, volatile LAS unsigned* st) {
  XcdBarrier b; b.bar = bar; b.x = xb_xcc_id(); b.st = st;
  if (threadIdx.x == 0) (void)xb_add(&bar[XB_XCNT(b.x)], 1u);
  return b;
}
DI void xcd_barrier_complete(unsigned* bar, unsigned x, unsigned& nloc, unsigned& nx) {
  const unsigned G = gridDim.x * gridDim.y * gridDim.z;
  unsigned sum, cnt, mine, sp = 0u;
  for (;;) {
    sum = 0u; cnt = 0u; mine = 0u;
#pragma unroll
    for (unsigned j = 0; j < 16; ++j) { const unsigned c = xb_ld(&bar[XB_XCNT(j)]); sum += c; cnt += (c > 0u) ? 1u : 0u; mine = (j == x) ? c : mine; }
    if (sum == G) break;
    __builtin_amdgcn_s_sleep(1);
    if ((++sp & 255u) == 0u) { if (xb_ld(&bar[XB_TMO])) break; if (sp > XB_SPIN_CAP) { atomicAdd(&bar[XB_TMO], 1u); break; } }
  }
  nloc = mine > 0u ? mine : 1u; nx = cnt > 0u ? cnt : 1u;
}
DI void xcd_barrier(const XcdBarrier& b) {
  asm volatile("s_waitcnt vmcnt(0)" ::: "memory");
  __syncthreads();
  if (threadIdx.x == 0) {
    unsigned* bar = b.bar;
    __builtin_amdgcn_s_waitcnt(0);
    unsigned nloc = b.st[0], nx = b.st[1];
    if (nloc == 0u) { xcd_barrier_complete(bar, b.x, nloc, nx); b.st[0] = nloc; b.st[1] = nx; }
    const unsigned old = xb_add(&bar[XB_XSUB(b.x)], 1u);
    const unsigned gen = old / nloc;
    if (old + 1u == (gen + 1u) * nloc) {
      __builtin_amdgcn_fence(__ATOMIC_RELEASE, "agent");
      asm volatile("s_waitcnt vmcnt(0)" ::: "memory");
      const unsigned og = xb_add(&bar[XB_TOP], 1u);
      const unsigned tg = og / nx;
      if (og + 1u == (tg + 1u) * nx) xb_add(&bar[XB_TOPGEN], 1u);
      else XB_SPIN(xb_ld(&bar[XB_TOPGEN]) == tg, bar);
      __builtin_amdgcn_fence(__ATOMIC_ACQUIRE, "agent");
      xb_add(&bar[XB_XGEN(b.x)], 1u);
      asm volatile("s_waitcnt vmcnt(0)" ::: "memory");
    } else {
      XB_SPIN(xb_ld(&bar[XB_XGEN(b.x)]) == gen, bar);
      __builtin_amdgcn_fence(__ATOMIC_ACQUIRE, "agent");
      asm volatile("s_waitcnt vmcnt(0)" ::: "memory");
    }
  }
  __syncthreads();
}

constexpr int SMEM_BYTES = 147456 + 256;

__global__ void __launch_bounds__(NT, 2) k_mega(Params p) {
  __shared__ __attribute__((aligned(16))) char smem[SMEM_BYTES];
  cg::grid_group grid = cg::this_grid();
  if (threadIdx.x == 0) *(u32x4*)(smem + 147456) = (u32x4){0u, 0u, 0u, 0u};
  __syncthreads();
  const XcdBarrier xb = xcd_barrier_post((unsigned*)(p.ws + OFF_BAR), (volatile LAS unsigned*)(smem + 147456));
#define REP(mask) _Pragma("unroll 1") for (int rep_ = 0; rep_ < ((PROBE_DUP & (mask)) ? 2 : 1); ++rep_)
  REP(1) phase_prep(p, smem);
  grid.sync();
  REP(1) phase_ln_in(p);
  xcd_barrier(xb);
  REP(2) phase_gemm1(p, smem);
  xcd_barrier(xb);
  REP(4) phase_compress(p, smem);
  phase_sgu(p, smem);
  xcd_barrier(xb);
  REP(8) phase_nsa(p, smem, NSA_MASK);
  xcd_barrier(xb);
  REP(16) phase_merge(p, smem);
  xcd_barrier(xb);
  REP(16) phase_outproj(p, smem);
  xcd_barrier(xb);
  REP(1) phase_ln_mid(p);
  xcd_barrier(xb);
  REP(32) phase_peerq(p, smem);
  xcd_barrier(xb);
  REP(64) phase_route(p, smem);
  xcd_barrier(xb);
  REP(128) phase_ffn_u(p);
  xcd_barrier(xb);
  REP(128) phase_ffn_w(p);
  xcd_barrier(xb);
  REP(256) phase_ffn_v(p);
  xcd_barrier(xb);
  REP(512) phase_final(p);
}

extern "C" void kernel_launch(void* const* d_in, const int* in_sizes, int n_in, void* d_out, int out_size, void* d_ws, size_t ws_size, hipStream_t stream) {
  if (ws_size < OFF_END) { fprintf(stderr, "workspace too small: %zu < %zu\n", ws_size, (size_t)OFF_END); return; }
  static int grid_blocks = 0;
  if (!grid_blocks) {
    int dev = 0, cus = 0, per_cu = 0;
    (void)hipGetDevice(&dev);
    (void)hipDeviceGetAttribute(&cus, hipDeviceAttributeMultiprocessorCount, dev);
    (void)hipOccupancyMaxActiveBlocksPerMultiprocessor(&per_cu, k_mega, NT, 0);
    if (per_cu < 1) fprintf(stderr, "occupancy query returned %d\n", per_cu);
    grid_blocks = (cus / 8) * 8;
  }
  Params p{};
  const float** fp = (const float**)&p;
  for (int i = 0; i < 26; ++i) fp[i] = (const float*)d_in[i];
  p.out = (float*)d_out;
  p.ws = (char*)d_ws;
  for (int i = 0; i < 32; ++i) p.inv_freq[i] = (float)pow(10000.0, -(double)i / 32.0);
  (void)hipMemsetAsync((char*)d_ws + OFF_BAR, 0, XCD_BAR_WORDS * 4, stream);
  void* args[] = {&p};
  hipError_t e = hipLaunchCooperativeKernel((void*)k_mega, dim3(grid_blocks), dim3(NT), args, 0, stream);
  if (e != hipSuccess) fprintf(stderr, "cooperative launch failed: %s (grid %d)\n", hipGetErrorString(e), grid_blocks);
}
```

```cpp
#include <hip/hip_runtime.h>
#include <hip/hip_cooperative_groups.h>
#include <stdint.h>
#include <stdio.h>
#include <math.h>
namespace cg = cooperative_groups;

#ifndef PROBE_DUP
#define PROBE_DUP 0
#endif
#ifndef NSA_MASK
#define NSA_MASK 7
#endif
typedef unsigned short bf16_t;
typedef short bf16x8 __attribute__((ext_vector_type(8)));
typedef short s16x4 __attribute__((ext_vector_type(4)));
typedef float f32x16 __attribute__((ext_vector_type(16)));
typedef float f32x4 __attribute__((ext_vector_type(4)));
typedef float f32x2 __attribute__((ext_vector_type(2)));
typedef __bf16 bf16v2 __attribute__((ext_vector_type(2)));
typedef unsigned u32x4 __attribute__((ext_vector_type(4)));
typedef int i32x4 __attribute__((ext_vector_type(4)));
typedef int i32x8 __attribute__((ext_vector_type(8)));
typedef unsigned u32x2 __attribute__((ext_vector_type(2)));
#define DI __device__ __forceinline__
#define LAS __attribute__((address_space(3)))
#define MFMA32(a, b, c) __builtin_amdgcn_mfma_f32_32x32x16_bf16((a), (b), (c), 0, 0, 0)

constexpr int NT = 512, NW = 8;
constexpr int NB = 8, SEQ = 8192, DM = 1024, NTOK = NB * SEQ;
constexpr int N1 = 4608;
constexpr float DN_ALPHA = 1.189207115002721f;
constexpr float LN_EPS = 1e-5f;

constexpr size_t MB = 1024 * 1024;
constexpr size_t OFF_MOD = 0;
constexpr size_t OFF_ROPE = OFF_MOD + 256 * 1024;
constexpr size_t OFF_POSB = OFF_ROPE + 2 * MB;
constexpr size_t OFF_WT1 = OFF_POSB + 4096;
constexpr size_t OFF_WB = OFF_WT1 + (size_t)N1 * 1024 * 2;
constexpr size_t OFF_WOUT = OFF_WB + 2 * MB;
constexpr size_t OFF_WQ = OFF_WOUT + 2 * MB;
constexpr size_t OFF_PKEYS = OFF_WQ + 4 * MB;
constexpr size_t OFF_CW1 = OFF_PKEYS + MB / 2;
constexpr size_t OFF_CW2 = OFF_CW1 + MB;
constexpr size_t OFF_SGUW = OFF_CW2 + 32 * 1024;
constexpr size_t OFF_SCU = OFF_SGUW + 256 * 1024;
constexpr size_t OFF_SCV = OFF_SCU + 64 * 1024;
constexpr size_t OFF_PU = OFF_SCV + 64 * 1024;
constexpr size_t OFF_PV = OFF_PU + 32 * MB;
constexpr size_t OFF_ACT = ((OFF_PV + 32 * MB + 4095) / 4096) * 4096;
constexpr size_t OFF_H = OFF_ACT;
constexpr size_t OFF_Q = OFF_H + 128 * MB;
constexpr size_t OFF_KC = OFF_Q + 64 * MB;
constexpr size_t OFF_VC = OFF_KC + 16 * MB;
constexpr size_t OFF_KS = OFF_VC + 16 * MB;
constexpr size_t OFF_VS = OFF_KS + 16 * MB;
constexpr size_t OFF_KW = OFF_VS + 16 * MB;
constexpr size_t OFF_VW = OFF_KW + 16 * MB;
constexpr size_t OFF_U = OFF_VW + 16 * MB;
constexpr size_t OFF_V = OFF_U + 64 * MB;
constexpr size_t OFF_GATE = OFF_V + 64 * MB;
constexpr size_t OFF_GSIG = OFF_GATE + 256 * MB;
constexpr size_t OFF_KCMP = OFF_GSIG + 8 * MB;
constexpr size_t OFF_VCMP = OFF_KCMP + MB;
constexpr size_t OFF_ONSA = OFF_VCMP + MB;
constexpr size_t OFF_SELG = OFF_ONSA + 64 * MB;
constexpr size_t OFF_BAR = OFF_SELG + 2 * MB;
constexpr size_t OFF_END = OFF_BAR + 64 * 1024;
constexpr size_t OFF_X1 = OFF_Q;
constexpr size_t OFF_Y = OFF_GATE;
constexpr size_t OFF_PQ = OFF_GATE;
constexpr size_t OFF_EIDX = OFF_ONSA;
constexpr size_t OFF_PGATE = OFF_ONSA + 32 * MB;
constexpr size_t OFF_PU8 = OFF_PU;
constexpr size_t OFF_PART = OFF_GATE;
constexpr size_t OFF_PV8 = OFF_PU + 16 * MB;
constexpr size_t OFF_WBUF = OFF_PU + 32 * MB;
constexpr size_t OFF_H2Q = OFF_U;
constexpr size_t OFF_SH = OFF_V;
constexpr size_t OFF_FFNB = OFF_GATE;
constexpr size_t OFF_SCW1 = OFF_WT1 + 5 * MB;
constexpr size_t OFF_SCWQ = OFF_WQ + 3 * MB;
constexpr size_t OFF_GATE8 = OFF_GATE;
constexpr size_t OFF_OSGU8 = OFF_GATE + 128 * MB;
constexpr size_t OFF_ONSA8 = OFF_GATE + 160 * MB;
constexpr size_t OFF_MRG8 = OFF_GATE + 192 * MB;
constexpr size_t OFF_M08 = OFF_H;
constexpr size_t OFF_SCWB = OFF_WB + 3 * MB / 2;
constexpr size_t OFF_SCWO = OFF_WOUT + 3 * MB / 2;
constexpr size_t OFF_SA = OFF_H + 64 * MB;

struct Params {
  const float *x, *c, *w_ada, *b_ada, *w_in, *cmp_pos, *cmp_w1, *cmp_b1, *cmp_w2, *cmp_b2, *sgu_ln_g, *sgu_ln_b, *sgu_w, *sgu_b,
      *w_branch, *w_merge, *b_merge, *w_out, *ln1_g, *ln1_b, *peer_wq, *peer_keys, *peer_u, *peer_v, *ln2_g, *ln2_b;
  float* out;
  char* ws;
  float inv_freq[32];
};

DI unsigned pack2(float lo, float hi) { f32x2 v = {lo, hi}; bf16v2 r = __builtin_convertvector(v, bf16v2); return __builtin_bit_cast(unsigned, r); }
DI bf16_t f2bf(float f) { __bf16 r = (__bf16)f; return __builtin_bit_cast(unsigned short, r); }
DI float bf2f(bf16_t h) { return __uint_as_float(((unsigned)h) << 16); }
DI float bflo(unsigned u) { return __uint_as_float(u << 16); }
DI float bfhi(unsigned u) { return __uint_as_float(u & 0xffff0000u); }
DI float gelu_f(float v) { return 0.5f * v * (1.0f + erff(v * 0.70710678118654752f)); }
DI float sigmoid_f(float v) { return 1.0f / (1.0f + __expf(-v)); }
DI int otid() { int t = __builtin_amdgcn_workitem_id_x(); asm volatile("" : "+v"(t)); return t; }
DI void lds_barrier() { asm volatile("s_waitcnt lgkmcnt(0)" ::: "memory"); __builtin_amdgcn_s_barrier(); asm volatile("" ::: "memory"); }
DI float xor1f(float x) { const int xi = __float_as_int(x); return __int_as_float(__builtin_amdgcn_update_dpp(xi, xi, 0xB1, 0xF, 0xF, false)); }
DI float xor2f(float x) { const int xi = __float_as_int(x); return __int_as_float(__builtin_amdgcn_update_dpp(xi, xi, 0x4E, 0xF, 0xF, false)); }
DI float xor8f(float x) { const int xi = __float_as_int(x); return __int_as_float(__builtin_amdgcn_update_dpp(xi, xi, 0x128, 0xF, 0xF, false)); }
DI unsigned xor32u(unsigned x, int lane) { const u32x2 r = __builtin_amdgcn_permlane32_swap(x, x, false, false); return (lane & 32) ? r.x : r.y; }
DI unsigned xor16u(unsigned x, int lane) { const u32x2 r = __builtin_amdgcn_permlane16_swap(x, x, false, false); return (lane & 16) ? r.x : r.y; }
DI float xor32f(float x, int lane) { return __uint_as_float(xor32u(__float_as_uint(x), lane)); }
DI float xor16f(float x, int lane) { return __uint_as_float(xor16u(__float_as_uint(x), lane)); }
DI unsigned pack_i8x4(float a, float b, float c, float d) {
  const int ia = (int)rintf(a), ib = (int)rintf(b), ic = (int)rintf(c), id = (int)rintf(d);
  return (unsigned)(ia & 0xff) | ((unsigned)(ib & 0xff) << 8) | ((unsigned)(ic & 0xff) << 16) | ((unsigned)id << 24);
}
DI unsigned pk4_fp8(float a, float b, float c, float d) { int t = 0; t = __builtin_amdgcn_cvt_pk_fp8_f32(a, b, t, false); t = __builtin_amdgcn_cvt_pk_fp8_f32(c, d, t, true); return (unsigned)t; }
DI float clamp_f8(float v) { return __builtin_amdgcn_fmed3f(v, -448.0f, 448.0f); }
DI void unpack8_fp8(const u32x2 w, float (&v)[8]) {
  const f32x2 a = __builtin_amdgcn_cvt_pk_f32_fp8((int)w.x, false), b = __builtin_amdgcn_cvt_pk_f32_fp8((int)w.x, true);
  const f32x2 c = __builtin_amdgcn_cvt_pk_f32_fp8((int)w.y, false), d = __builtin_amdgcn_cvt_pk_f32_fp8((int)w.y, true);
  v[0] = a.x; v[1] = a.y; v[2] = b.x; v[3] = b.y; v[4] = c.x; v[5] = c.y; v[6] = d.x; v[7] = d.y;
}
DI float wave_sum(float v) {
#pragma unroll
  for (int o = 32; o > 0; o >>= 1) v += __shfl_xor(v, o);
  return v;
}
DI void ld8(const float* pz, float (&v)[8]) { const f32x4 a = *(const f32x4*)pz, b = *(const f32x4*)(pz + 4); v[0] = a.x; v[1] = a.y; v[2] = a.z; v[3] = a.w; v[4] = b.x; v[5] = b.y; v[6] = b.z; v[7] = b.w; }
DI u32x4 pack8(const float (&v)[8]) { u32x4 w; w.x = pack2(v[0], v[1]); w.y = pack2(v[2], v[3]); w.z = pack2(v[4], v[5]); w.w = pack2(v[6], v[7]); return w; }
DI void unpack8(const u32x4 w, float (&v)[8]) { v[0] = bflo(w.x); v[1] = bfhi(w.x); v[2] = bflo(w.y); v[3] = bfhi(w.y); v[4] = bflo(w.z); v[5] = bfhi(w.z); v[6] = bflo(w.w); v[7] = bfhi(w.w); }
DI f32x2 gelu_pk(f32x2 v) {
  const f32x2 av = __builtin_elementwise_abs(v), d = av * 0.2316418882f + 1.0f;
  f32x2 t; t.x = __builtin_amdgcn_rcpf(d.x); t.y = __builtin_amdgcn_rcpf(d.y);
  f32x2 q = t * 0.5307027145f + (-0.7265760135f); q = q * t + 0.7107068705f; q = q * t + (-0.142248368f); q = q * t + 0.127414796f; q = q * t;
  const f32x2 s = (v * v) * (-0.72134752044f);
  f32x2 e; e.x = __builtin_amdgcn_exp2f(s.x); e.y = __builtin_amdgcn_exp2f(s.y);
  const f32x2 m = v * (q * e), r = v - m;
  f32x2 o; o.x = v.x < 0.f ? m.x : r.x; o.y = v.y < 0.f ? m.y : r.y; return o;
}
__host__ __device__ __forceinline__ int dperm(int q) { const int grp = q >> 5, fq = (q >> 3) & 3, j = q & 7; return (j < 4) ? (16 * grp + 4 * fq + j) : (32 + 16 * grp + 4 * fq + (j - 4)); }

template <class F>
DI void tconv_tile(float* tile, int k0, int n0, bf16_t* dst, int ldd, F f) {
  const int tid = otid();
  __syncthreads();
#pragma unroll 4
  for (int i = 0; i < 8; ++i) { const int kl = i * 8 + (tid >> 6), nl = tid & 63; tile[nl * 65 + kl] = f(k0 + kl, n0 + nl); }
  __syncthreads();
  {
    const int nl = tid >> 3, kc = tid & 7;
    const float* t = tile + nl * 65 + kc * 8;
    u32x4 w; w.x = pack2(t[0], t[1]); w.y = pack2(t[2], t[3]); w.z = pack2(t[4], t[5]); w.w = pack2(t[6], t[7]);
    *(u32x4*)(dst + (size_t)(n0 + nl) * ldd + k0 + kc * 8) = w;
  }
}

template <bool FP8, class F>
DI void tconv_strip_q(float* tile, int n0, int K, unsigned char* dst, float* gscale, F f) {
  const int tid = otid();
  float am = 0.f;
  { const int kl = tid >> 6, nl = tid & 63;
#pragma unroll 4
    for (int k = kl; k < K; k += 8) am = fmaxf(am, fabsf(f(k, n0 + nl))); }
#pragma unroll
  for (int o = 16; o > 0; o >>= 1) am = fmaxf(am, __shfl_xor(am, o));
  __syncthreads();
  if ((tid & 31) == 0) tile[(tid >> 6) * 2 + ((tid >> 5) & 1)] = am;
  __syncthreads();
  float g0 = 0.f, g1 = 0.f;
#pragma unroll
  for (int w = 0; w < 8; ++w) { g0 = fmaxf(g0, tile[2 * w]); g1 = fmaxf(g1, tile[2 * w + 1]); }
  float q0, q1, i0, i1;
  if (FP8) {
    const unsigned b0 = (__float_as_uint(g0) >> 23) & 0xffu, b1 = (__float_as_uint(g1) >> 23) & 0xffu;
    const bool k0 = b0 >= 16u && b0 <= 240u, k1 = b1 >= 16u && b1 <= 240u;
    q0 = k0 ? __uint_as_float((261u - b0) << 23) : 1.0f; i0 = k0 ? __uint_as_float((b0 - 7u) << 23) : 1.0f;
    q1 = k1 ? __uint_as_float((261u - b1) << 23) : 1.0f; i1 = k1 ? __uint_as_float((b1 - 7u) << 23) : 1.0f;
  } else { q0 = g0 > 0.f ? 127.0f / g0 : 0.f; q1 = g1 > 0.f ? 127.0f / g1 : 0.f; i0 = g0 * (1.0f / 127.0f); i1 = g1 * (1.0f / 127.0f); }
  if (tid == 0) { gscale[n0 >> 5] = i0; gscale[(n0 >> 5) + 1] = i1; }
  float* tl = tile + 64;
  for (int k0 = 0; k0 < K; k0 += 64) {
    __syncthreads();
#pragma unroll 4
    for (int i = 0; i < 8; ++i) { const int kl = i * 8 + (tid >> 6), nl = tid & 63; tl[nl * 65 + kl] = f(k0 + kl, n0 + nl) * (nl < 32 ? q0 : q1); }
    __syncthreads();
    {
      const int nl = tid >> 3, kc = tid & 7;
      const float* t = tl + nl * 65 + kc * 8;
      u32x2 w;
      if (FP8) { w.x = pk4_fp8(t[0], t[1], t[2], t[3]); w.y = pk4_fp8(t[4], t[5], t[6], t[7]); }
      else { w.x = pack_i8x4(t[0], t[1], t[2], t[3]); w.y = pack_i8x4(t[4], t[5], t[6], t[7]); }
      *(u32x2*)(dst + (size_t)(n0 + nl) * K + k0 + kc * 8) = w;
    }
  }
}

DI void conv_chunk(const float* src, bf16_t* dst, size_t base) {
  const size_t i = base + (size_t)otid() * 8;
  const f32x4 a = *(const f32x4*)(src + i), b = *(const f32x4*)(src + i + 4);
  u32x4 w; w.x = pack2(a.x, a.y); w.y = pack2(a.z, a.w); w.z = pack2(b.x, b.y); w.w = pack2(b.z, b.w);
  *(u32x4*)(dst + i) = w;
}

DI void sincos_d(double x, double& s, double& c) {
  const double y = x * 0.25, y2 = y * y;
  double sn = y * (1.0 + y2 * (-1.0 / 6 + y2 * (1.0 / 120 + y2 * (-1.0 / 5040 + y2 * (1.0 / 362880 + y2 * (-1.0 / 39916800 + y2 * (1.0 / 6227020800.0)))))));
  double cs = 1.0 + y2 * (-0.5 + y2 * (1.0 / 24 + y2 * (-1.0 / 720 + y2 * (1.0 / 40320 + y2 * (-1.0 / 3628800 + y2 * (1.0 / 479001600.0 + y2 * (-1.0 / 87178291200.0)))))));
#pragma unroll
  for (int i = 0; i < 2; ++i) { const double s2 = 2.0 * sn * cs, c2 = cs * cs - sn * sn; sn = s2; cs = c2; }
  s = sn; c = cs;
}

DI void phase_prep(const Params& p, char* smem) {
  const int tid = otid();
  float* fs = (float*)smem;
  char* ws = p.ws;
  constexpr int nA = 192, nB = 72, nC = 32, nD = 16, nE = 32, nF = 2 * 32 * 2, nG = 4, nH = 8, nI = 512, nJ = 64, nK = 32, nL = 2048, nM = 2048;
  constexpr int total = nA + nB + nC + nD + nE + nF + nG + nH + nI + nJ + nK + nL + nM;
  for (int item = blockIdx.x; item < total; item += gridDim.x) {
    int it = item;
    if (it < nA) {
      float* sc = fs;
      float* red = fs + 8192;
      __syncthreads();
      for (int i = tid; i < 8192; i += NT) { const float v = p.c[i]; sc[i] = v / (1.0f + __expf(-v)); }
      __syncthreads();
      const int ks = tid >> 5, cj = tid & 31, col = it * 32 + cj;
      float acc[8];
#pragma unroll
      for (int b = 0; b < 8; ++b) acc[b] = 0.f;
#pragma unroll 4
      for (int k = ks * 64; k < ks * 64 + 64; ++k) {
        const float w = p.w_ada[(size_t)k * 6144 + col];
#pragma unroll
        for (int b = 0; b < 8; ++b) acc[b] += sc[b * 1024 + k] * w;
      }
#pragma unroll
      for (int b = 0; b < 8; ++b) red[(ks * 8 + b) * 32 + cj] = acc[b];
      __syncthreads();
      if (tid < 256) {
        const int b = tid >> 5;
        float s = p.b_ada[col];
#pragma unroll
        for (int k2 = 0; k2 < 16; ++k2) s += red[(k2 * 8 + b) * 32 + cj];
        ((float*)(ws + OFF_MOD))[b * 6144 + col] = s;
      }
      continue;
    }
    it -= nA;
    if (it < nB) {
      const float* w_in = p.w_in; const float* w_merge = p.w_merge;
      tconv_strip_q<false>(fs, it * 64, 1024, (unsigned char*)(ws + OFF_WT1), (float*)(ws + OFF_SCW1), [=](int k, int n) -> float {
        if (n < 1280) {
          const bool roped = (n < 640) || (n >= 768 && n < 896) || (n >= 1024 && n < 1152);
          const int col = roped ? ((n & ~63) + dperm(n & 63)) : n;
          return w_in[(size_t)k * 2328 + col];
        }
        if (n < 2304) return w_in[(size_t)k * 2328 + n + 24];
        if (n < 4352) return w_merge[(size_t)k * 2048 + (n - 2304)];
        if (n < 4376) return w_in[(size_t)k * 2328 + 1280 + (n - 4352)];
        return 0.f; });
      continue;
    }
    it -= nB;
    if (it < nC) {
      const int br = it >> 4, strip = it & 15;
      const float* src = p.w_branch + (size_t)br * 512 * 1024;
      tconv_strip_q<true>(fs, strip * 64, 512, (unsigned char*)(ws + OFF_WB) + (size_t)br * 1024 * 512, (float*)(ws + OFF_SCWB) + br * 32, [=](int k, int n) -> float { return src[(size_t)k * 1024 + n]; });
      continue;
    }
    it -= nC;
    if (it < nD) {
      const float* src = p.w_out;
      tconv_strip_q<true>(fs, it * 64, 1024, (unsigned char*)(ws + OFF_WOUT), (float*)(ws + OFF_SCWO), [=](int k, int n) -> float { return src[(size_t)k * 1024 + n]; });
      continue;
    }
    it -= nD;
    if (it < nE) {
      const float* src = p.peer_wq;
      tconv_strip_q<false>(fs, it * 64, 1024, (unsigned char*)(ws + OFF_WQ), (float*)(ws + OFF_SCWQ), [=](int k, int n) -> float { return src[(size_t)k * 2048 + n]; });
      continue;
    }
    it -= nE;
    if (it < nF) {
      const int w = it >> 6, r = it & 63, kt = r >> 1, ntile = r & 1;
      const float* src = p.cmp_w1 + (size_t)w * 2048 * 128;
      tconv_tile(fs, kt * 64, ntile * 64, (bf16_t*)(ws + OFF_CW1) + (size_t)w * 128 * 2048, 2048, [=](int k, int n) -> float {
        const int ksrc = (w == 0) ? ((k & ~63) + dperm(k & 63)) : k;
        return src[(size_t)ksrc * 128 + n]; });
      continue;
    }
    it -= nF;
    if (it < nG) {
      const int w = it >> 1, kt = it & 1;
      const float* src = p.cmp_w2 + (size_t)w * 128 * 64;
      tconv_tile(fs, kt * 64, 0, (bf16_t*)(ws + OFF_CW2) + (size_t)w * 64 * 128, 128, [=](int k, int n) -> float { return src[(size_t)k * 64 + ((w == 0) ? dperm(n) : n)]; });
      continue;
    }
    it -= nG;
    if (it < nH) {
      const int w = it >> 2, jc = it & 3, ks = tid >> 5, cj = tid & 31, j = jc * 32 + cj;
      float* red = fs;
      const float* pos = p.cmp_pos + w * 2048; const float* w1 = p.cmp_w1 + (size_t)w * 2048 * 128;
      float acc = 0.f;
#pragma unroll 4
      for (int k = ks * 128; k < ks * 128 + 128; ++k) acc += pos[k] * w1[(size_t)k * 128 + j];
      __syncthreads();
      red[ks * 32 + cj] = acc;
      __syncthreads();
      if (tid < 32) { float s = p.cmp_b1[w * 128 + j]; for (int k2 = 0; k2 < 16; ++k2) s += red[k2 * 32 + tid]; ((float*)(ws + OFF_POSB))[w * 128 + j] = s; }
      continue;
    }
    it -= nH;
    if (it < nI) {
      const int e = it * 512 + tid, pos = e >> 5, i = e & 31;
      const float ang = (float)pos * p.inv_freq[i];
      const double a = (double)ang;
      const double kk = rint(a * 0.15915494309189535);
      const double r = a - kk * 6.283185307179586476925;
      double s, c; sincos_d(r, s, c);
      ((float*)(ws + OFF_ROPE))[e] = (float)c;
      ((float*)(ws + OFF_ROPE))[262144 + e] = (float)s;
      continue;
    }
    it -= nI;
    if (it < nJ) { conv_chunk(p.peer_keys, (bf16_t*)(ws + OFF_PKEYS), (size_t)it * 4096); continue; }
    it -= nJ;
    if (it < nK) {
      const size_t i0 = (size_t)it * 4096 + (size_t)tid * 8;
      const int rowi = (int)((i0 >> 7) & 127), j0 = (int)(i0 & 127);
      float v[8];
#pragma unroll
      for (int j = 0; j < 8; ++j) v[j] = (j0 + j <= rowi) ? p.sgu_w[i0 + j] : 0.f;
      u32x4 w; w.x = pack2(v[0], v[1]); w.y = pack2(v[2], v[3]); w.z = pack2(v[4], v[5]); w.w = pack2(v[6], v[7]);
      *(u32x4*)((bf16_t*)(ws + OFF_SGUW) + i0) = w;
      continue;
    }
    it -= nK;
    {
      const bool isv = it >= nL;
      if (isv) it -= nL;
      const int lane = tid & 63, e = it * 8 + (tid >> 6);
      const float* src = (isv ? p.peer_v : p.peer_u) + (size_t)e * 1024 + lane * 16;
      float v[16];
#pragma unroll
      for (int i = 0; i < 4; ++i) { const f32x4 t4 = *(const f32x4*)(src + i * 4); v[4 * i] = t4.x; v[4 * i + 1] = t4.y; v[4 * i + 2] = t4.z; v[4 * i + 3] = t4.w; }
      float amax = 0.f;
#pragma unroll
      for (int i = 0; i < 16; ++i) amax = fmaxf(amax, fabsf(v[i]));
#pragma unroll
      for (int o = 32; o > 0; o >>= 1) amax = fmaxf(amax, __shfl_xor(amax, o));
      const unsigned be = (__float_as_uint(amax) >> 23) & 0xffu;
      const bool okr = be >= 16u && be <= 240u;
      const float scale = okr ? __uint_as_float((261u - be) << 23) : 1.0f;
      const float inv = okr ? __uint_as_float((be - 7u) << 23) : 1.0f;
      u32x4 w;
      int t0 = 0, t1 = 0, t2 = 0, t3 = 0;
      t0 = __builtin_amdgcn_cvt_pk_fp8_f32(v[0] * scale, v[1] * scale, t0, false); t0 = __builtin_amdgcn_cvt_pk_fp8_f32(v[2] * scale, v[3] * scale, t0, true);
      t1 = __builtin_amdgcn_cvt_pk_fp8_f32(v[4] * scale, v[5] * scale, t1, false); t1 = __builtin_amdgcn_cvt_pk_fp8_f32(v[6] * scale, v[7] * scale, t1, true);
      t2 = __builtin_amdgcn_cvt_pk_fp8_f32(v[8] * scale, v[9] * scale, t2, false); t2 = __builtin_amdgcn_cvt_pk_fp8_f32(v[10] * scale, v[11] * scale, t2, true);
      t3 = __builtin_amdgcn_cvt_pk_fp8_f32(v[12] * scale, v[13] * scale, t3, false); t3 = __builtin_amdgcn_cvt_pk_fp8_f32(v[14] * scale, v[15] * scale, t3, true);
      w.x = (unsigned)t0; w.y = (unsigned)t1; w.z = (unsigned)t2; w.w = (unsigned)t3;
      if (!isv) {
        const float qs = amax > 0.f ? 127.0f / amax : 0.f;
        u32x4 wi; wi.x = pack_i8x4(v[0] * qs, v[1] * qs, v[2] * qs, v[3] * qs); wi.y = pack_i8x4(v[4] * qs, v[5] * qs, v[6] * qs, v[7] * qs);
        wi.z = pack_i8x4(v[8] * qs, v[9] * qs, v[10] * qs, v[11] * qs); wi.w = pack_i8x4(v[12] * qs, v[13] * qs, v[14] * qs, v[15] * qs);
        *(u32x4*)(ws + OFF_PU8 + ((size_t)(lane >> 3) * 16384 + e) * 128 + (lane & 7) * 16) = wi;
        if (lane == 0) ((float*)(ws + OFF_SCU))[e] = amax * (1.0f / 127.0f);
      } else {
        *(u32x4*)(ws + OFF_PV8 + ((size_t)(lane >> 3) * 16384 + e) * 128 + (lane & 7) * 16) = w;
        if (lane == 0) ((float*)(ws + OFF_SCV))[e] = inv;
      }
    }
  }
}

DI void row_stats(const float (&v)[16], float& mean, float& rstd) {
  float s = 0.f;
#pragma unroll
  for (int i = 0; i < 16; ++i) s += v[i];
  mean = wave_sum(s) * (1.0f / 1024.0f);
  float q = 0.f;
#pragma unroll
  for (int i = 0; i < 16; ++i) { const float d = v[i] - mean; q += d * d; }
  rstd = rsqrtf(wave_sum(q) * (1.0f / 1024.0f) + LN_EPS);
}

DI void phase_ln_in(const Params& p) {
  const int lane = otid() & 63, wave = otid() >> 6;
  const float* mod = (const float*)(p.ws + OFF_MOD);
  unsigned* h8 = (unsigned*)(p.ws + OFF_H);
  for (int grp = blockIdx.x; grp < NTOK / NW; grp += gridDim.x) {
    const int row = grp * NW + wave, b = row >> 13;
    const float* xr = p.x + (size_t)row * DM;
    float v[16];
#pragma unroll
    for (int i = 0; i < 4; ++i) { const f32x4 t = *(const f32x4*)(xr + i * 256 + lane * 4); v[4 * i] = t.x; v[4 * i + 1] = t.y; v[4 * i + 2] = t.z; v[4 * i + 3] = t.w; }
    float mean, rstd; row_stats(v, mean, rstd);
    float amax = 0.f;
#pragma unroll
    for (int i = 0; i < 4; ++i) {
      const int col = i * 256 + lane * 4;
      const f32x4 sh = *(const f32x4*)(mod + b * 6144 + col), sc = *(const f32x4*)(mod + b * 6144 + 1024 + col);
      const float o0 = (v[4 * i] - mean) * rstd * (1.f + sc.x) + sh.x, o1 = (v[4 * i + 1] - mean) * rstd * (1.f + sc.y) + sh.y;
      const float o2 = (v[4 * i + 2] - mean) * rstd * (1.f + sc.z) + sh.z, o3 = (v[4 * i + 3] - mean) * rstd * (1.f + sc.w) + sh.w;
      v[4 * i] = o0; v[4 * i + 1] = o1; v[4 * i + 2] = o2; v[4 * i + 3] = o3;
      amax = fmaxf(amax, fmaxf(fmaxf(fabsf(o0), fabsf(o1)), fmaxf(fabsf(o2), fabsf(o3))));
    }
#pragma unroll
    for (int o = 32; o > 0; o >>= 1) amax = fmaxf(amax, __shfl_xor(amax, o));
    const float qs = amax > 0.f ? 127.0f / amax : 0.f;
#pragma unroll
    for (int i = 0; i < 4; ++i) h8[(size_t)row * 256 + i * 64 + lane] = pack_i8x4(v[4 * i] * qs, v[4 * i + 1] * qs, v[4 * i + 2] * qs, v[4 * i + 3] * qs);
    if (lane == 0) ((float*)(p.ws + OFF_SA))[row] = amax * (1.0f / 127.0f);
  }
}

DI void phase_ln_mid(const Params& p) {
  const int lane = otid() & 63, wave = otid() >> 6;
  const float* mod = (const float*)(p.ws + OFF_MOD);
  const bf16_t* y = (const bf16_t*)(p.ws + OFF_Y);
  bf16_t* x1 = (bf16_t*)(p.ws + OFF_X1);
  for (int grp = blockIdx.x; grp < NTOK / NW; grp += gridDim.x) {
    const int row = grp * NW + wave, b = row >> 13;
    const bf16_t* yr = y + (size_t)row * DM;
    float v[16];
#pragma unroll
    for (int i = 0; i < 4; ++i) { const u32x2 t = *(const u32x2*)(yr + i * 256 + lane * 4); v[4 * i] = bflo(t.x); v[4 * i + 1] = bfhi(t.x); v[4 * i + 2] = bflo(t.y); v[4 * i + 3] = bfhi(t.y); }
    float mean, rstd; row_stats(v, mean, rstd);
#pragma unroll
    for (int i = 0; i < 4; ++i) {
      const int col = i * 256 + lane * 4;
      const f32x4 g = *(const f32x4*)(p.ln1_g + col), bb = *(const f32x4*)(p.ln1_b + col);
      f32x4 o;
      o.x = (v[4 * i] - mean) * rstd * g.x + bb.x; o.y = (v[4 * i + 1] - mean) * rstd * g.y + bb.y;
      o.z = (v[4 * i + 2] - mean) * rstd * g.z + bb.z; o.w = (v[4 * i + 3] - mean) * rstd * g.w + bb.w;
      { u32x2 w; w.x = pack2(o.x, o.y); w.y = pack2(o.z, o.w); *(u32x2*)(x1 + (size_t)row * DM + col) = w; }
      v[4 * i] = o.x; v[4 * i + 1] = o.y; v[4 * i + 2] = o.z; v[4 * i + 3] = o.w;
    }
    row_stats(v, mean, rstd);
    float amax = 0.f;
#pragma unroll
    for (int i = 0; i < 4; ++i) {
      const int col = i * 256 + lane * 4;
      const f32x4 sh = *(const f32x4*)(mod + b * 6144 + 3072 + col), sc = *(const f32x4*)(mod + b * 6144 + 4096 + col);
      const float o0 = (v[4 * i] - mean) * rstd * (1.f + sc.x) + sh.x, o1 = (v[4 * i + 1] - mean) * rstd * (1.f + sc.y) + sh.y;
      const float o2 = (v[4 * i + 2] - mean) * rstd * (1.f + sc.z) + sh.z, o3 = (v[4 * i + 3] - mean) * rstd * (1.f + sc.w) + sh.w;
      v[4 * i] = o0; v[4 * i + 1] = o1; v[4 * i + 2] = o2; v[4 * i + 3] = o3;
      amax = fmaxf(amax, fmaxf(fmaxf(fabsf(o0), fabsf(o1)), fmaxf(fabsf(o2), fabsf(o3))));
    }
#pragma unroll
    for (int o = 32; o > 0; o >>= 1) amax = fmaxf(amax, __shfl_xor(amax, o));
    const float qs = amax > 0.f ? 127.0f / amax : 0.f;
    unsigned* h2q = (unsigned*)(p.ws + OFF_H2Q);
#pragma unroll
    for (int i = 0; i < 4; ++i) h2q[(size_t)row * 256 + i * 64 + lane] = pack_i8x4(v[4 * i] * qs, v[4 * i + 1] * qs, v[4 * i + 2] * qs, v[4 * i + 3] * qs);
    if (lane == 0) ((float*)(p.ws + OFF_SH))[row] = amax * (1.0f / 127.0f);
  }
}

namespace pg8 {
constexpr int BM = 256, BK = 64, HALF = 128, HTB = HALF * BK * 2, STAGE_BYTES = 8 * HTB, NXCD = 8, WGM = 8;
DI int lds_byte(int r, int c) { const int st = (r >> 4) * 2 + (c >> 5), rr = r & 15, cc = c & 31, ob = rr * 64 + cc * 2; return st * 1024 + (ob ^ (((ob >> 9) & 1) << 5)); }
DI void stage_rc(int b, int& R, int& C) { const int st = b / 1024, sb = b % 1024, swz = sb ^ (((sb >> 9) & 1) << 5); R = (st >> 1) * 16 + swz / 64; C = (st & 1) * 32 + (swz % 64) / 2; }
DI int perm32(int rho) { const int n = rho >> 4, i = rho & 15; return 8 * (i >> 2) + 4 * n + (i & 3); }
struct Unit { int pm, pn; };
struct Gemm { const bf16_t* A; const bf16_t* Bt; int M, N, K; };
struct StaticOrder {
  int nM, nN, nwg, G, c;
  DI void init(int M, int N, int G_, int c_) { nM = M / BM; nN = N / BM; nwg = nM * nN; G = G_; c = c_; }
  DI bool next(int i, Unit& u) const {
    const long L = (long)i * G + c; if (L >= nwg) return false;
    int wgid = (int)L; { const int q = nwg / NXCD, r = nwg % NXCD, xcd = wgid % NXCD, off = wgid / NXCD; wgid = (xcd < r ? xcd * (q + 1) : r * (q + 1) + (xcd - r) * q) + off; }
    const int nig = WGM * nN, gid = wgid / nig, fm = gid * WGM, gsz = (nM - fm) < WGM ? (nM - fm) : WGM;
    u.pm = fm + ((wgid % nig) % gsz); u.pn = (wgid % nig) / gsz; return true;
  }
};

template <int MODE, class AccT>
DI AccT mma_pair(bf16x8 b0, bf16x8 b1, bf16x8 a0, bf16x8 a1, AccT c) {
  if constexpr (MODE == 0) { c = __builtin_amdgcn_mfma_f32_16x16x32_bf16(b0, a0, c, 0, 0, 0); return __builtin_amdgcn_mfma_f32_16x16x32_bf16(b1, a1, c, 0, 0, 0); }
  else if constexpr (MODE == 1) {
    c = __builtin_amdgcn_mfma_i32_16x16x64_i8(__builtin_bit_cast(i32x4, b0), __builtin_bit_cast(i32x4, a0), c, 0, 0, 0);
    return __builtin_amdgcn_mfma_i32_16x16x64_i8(__builtin_bit_cast(i32x4, b1), __builtin_bit_cast(i32x4, a1), c, 0, 0, 0);
  } else {
    const i32x8 B = __builtin_shufflevector(__builtin_bit_cast(i32x4, b0), __builtin_bit_cast(i32x4, b1), 0, 1, 2, 3, 4, 5, 6, 7);
    const i32x8 A = __builtin_shufflevector(__builtin_bit_cast(i32x4, a0), __builtin_bit_cast(i32x4, a1), 0, 1, 2, 3, 4, 5, 6, 7);
    asm volatile("v_mfma_f32_16x16x128_f8f6f4 %0, %1, %2, %0" : "+v"(c) : "v"(B), "v"(A));
    return c;
  }
}
DI f32x4 mma16(bf16x8 a, bf16x8 b, f32x4 c) { return __builtin_amdgcn_mfma_f32_16x16x32_bf16(a, b, c, 0, 0, 0); }
DI i32x4 mma16(bf16x8 a, bf16x8 b, i32x4 c) { return __builtin_amdgcn_mfma_i32_16x16x64_i8(__builtin_bit_cast(i32x4, a), __builtin_bit_cast(i32x4, b), c, 0, 0, 0); }
template <class Epi>
DI void gemm_phase(LAS unsigned char* lds, const Gemm g, const StaticOrder& S, const Epi& E) {
  const int tid = otid(), wid = __builtin_amdgcn_readfirstlane(tid >> 6), lane = tid & 63, wr = wid >> 2, wc = wid & 3, fr = lane & 15, fq = lane >> 4;
  const int K = g.K, nt = K / BK;
  unsigned voffA[2], voffB[2];
#pragma unroll
  for (int i = 0; i < 2; ++i) { int R, C; stage_rc(tid * 16 + i * 8192, R, C); const int Rb = Epi::PERM ? ((R & ~31) + perm32(R & 31)) : R;
    voffA[i] = (unsigned)(R * K + C) * 2u; voffB[i] = (unsigned)(Rb * K + C) * 2u; }
  const size_t kstep = (size_t)(BK * 2);
  const size_t hstep = (size_t)HALF * K * 2;
  const size_t tstep = 2 * hstep;
  const unsigned ldsw = (unsigned)wid * 1024u;
  const int aoff = lds_byte(wr * 64 + fr, fq * 8), boff = lds_byte(wc * 32 + fr, fq * 8);
  LAS unsigned char* ldsB = lds + 4 * HTB + boff;
  asm volatile("" : "+v"(ldsB));
#define PG8_SA(b, h) (((b) * 2 + (h)) * HTB)
#define PG8_SB(b, h) ((4 + (b) * 2 + (h)) * HTB)
#define PG8_STAGE(bufoff, gbase, voff) do { _Pragma("unroll") for (int _i = 0; _i < 2; ++_i) \
    __builtin_amdgcn_global_load_lds((const unsigned*)((const char*)(gbase) + (voff)[_i]), (LAS unsigned*)(lds + (bufoff) + ldsw + _i * 8192), 16, 0, 0); } while (0)
#define PG8_LDA(dst, b, h) do { _Pragma("unroll") for (int m = 0; m < 4; ++m) _Pragma("unroll") for (int k = 0; k < 2; ++k) dst[m][k] = *(const LAS bf16x8*)(lds + PG8_SA(b, h) + aoff + m * 2048 + k * 1024); } while (0)
#define PG8_LDB(dst, b, h) do { _Pragma("unroll") for (int n = 0; n < 2; ++n) _Pragma("unroll") for (int k = 0; k < 2; ++k) dst[n][k] = *(const LAS bf16x8*)(ldsB + ((b) * 2 + (h)) * HTB + n * 2048 + k * 1024); } while (0)
#define PG8_MMA(ai, bj, At, Bt) do { __builtin_amdgcn_s_setprio(1); _Pragma("unroll") for (int m = 0; m < 4; ++m) _Pragma("unroll") for (int n = 0; n < 2; ++n) \
    acc[ai][bj][m][n] = mma_pair<Epi::MODE>(Bt[n][0], Bt[n][1], At[m][0], At[m][1], acc[ai][bj][m][n]); __builtin_amdgcn_s_setprio(0); } while (0)
#define PG8_WAIT_V(n) asm volatile("s_waitcnt vmcnt(" #n ")" ::: "memory")
#define PG8_WAIT_L(n) asm volatile("s_waitcnt lgkmcnt(" #n ")" ::: "memory")
#define PG8_BAR __builtin_amdgcn_s_barrier()
#define PG8_SCHED __builtin_amdgcn_sched_barrier(0)
  Unit cur, nxt; int ui = 0;
  if (!S.next(0, cur)) return;
  typedef typename Epi::AccT AccT;
  const AccT zacc = {0, 0, 0, 0};
  AccT acc[2][2][4][2];
#pragma unroll
  for (int a = 0; a < 2; ++a)
#pragma unroll
    for (int b = 0; b < 2; ++b)
#pragma unroll
      for (int m = 0; m < 4; ++m)
#pragma unroll
        for (int n = 0; n < 2; ++n) acc[a][b][m][n] = zacc;
  bf16x8 At[4][2], B0[2][2], B1[2][2];
  const char* cA = (const char*)g.A + (size_t)cur.pm * tstep; const char* cB = (const char*)g.Bt + (size_t)cur.pn * tstep;
  PG8_STAGE(PG8_SB(0, 0), cB, voffB); PG8_STAGE(PG8_SA(0, 0), cA, voffA); PG8_STAGE(PG8_SB(0, 1), cB + hstep, voffB); PG8_STAGE(PG8_SA(0, 1), cA + hstep, voffA);
  if (wr == 1) PG8_BAR;
  PG8_WAIT_V(4); PG8_BAR;
  PG8_STAGE(PG8_SB(1, 0), cB + kstep, voffB); PG8_STAGE(PG8_SA(1, 0), cA + kstep, voffA); PG8_STAGE(PG8_SB(1, 1), cB + hstep + kstep, voffB);
  PG8_WAIT_V(6); PG8_BAR;
  for (;;) {
    const bool has_next = S.next(ui + 1, nxt);
    const char* nA = has_next ? (const char*)g.A + (size_t)nxt.pm * tstep : cA; const char* nB = has_next ? (const char*)g.Bt + (size_t)nxt.pn * tstep : cB;
#pragma unroll 1
    for (int t = 0; t < nt; t += 2) {
      const bool last = (t == nt - 2);
      const char* a1 = cA + (size_t)(t + 1) * kstep;
      const char* a2 = last ? nA : cA + (size_t)(t + 2) * kstep; const char* b2 = last ? nB : cB + (size_t)(t + 2) * kstep;
      const char* a3 = a2 + kstep; const char* b3 = b2 + kstep;
      PG8_LDB(B0, 0, 0); PG8_SCHED; PG8_LDA(At, 0, 0); PG8_STAGE(PG8_SA(1, 1), a1 + hstep, voffA);
      PG8_WAIT_L(8); PG8_BAR; PG8_WAIT_L(0); PG8_MMA(0, 0, At, B0); PG8_BAR; PG8_SCHED;
      PG8_LDB(B1, 0, 1); PG8_STAGE(PG8_SB(0, 0), b2, voffB);
      PG8_BAR; PG8_WAIT_L(0); PG8_MMA(0, 1, At, B1); PG8_BAR;
      PG8_LDA(At, 0, 1); PG8_STAGE(PG8_SA(0, 0), a2, voffA);
      PG8_BAR; PG8_WAIT_L(0); PG8_MMA(1, 0, At, B0); PG8_BAR; PG8_SCHED;
      PG8_STAGE(PG8_SB(0, 1), b2 + hstep, voffB);
      PG8_WAIT_V(6); PG8_BAR; PG8_MMA(1, 1, At, B1); PG8_BAR;
      PG8_LDB(B0, 1, 0); PG8_SCHED; PG8_LDA(At, 1, 0); PG8_STAGE(PG8_SA(0, 1), a2 + hstep, voffA);
      PG8_WAIT_L(8); PG8_BAR; PG8_WAIT_L(0); PG8_MMA(0, 0, At, B0); PG8_BAR; PG8_SCHED;
      PG8_LDB(B1, 1, 1); PG8_STAGE(PG8_SB(1, 0), b3, voffB);
      PG8_BAR; PG8_WAIT_L(0); PG8_MMA(0, 1, At, B1); PG8_BAR;
      PG8_LDA(At, 1, 1); PG8_STAGE(PG8_SA(1, 0), a3, voffA);
      PG8_BAR; PG8_WAIT_L(0); PG8_MMA(1, 0, At, B0); PG8_BAR; PG8_SCHED;
      PG8_STAGE(PG8_SB(1, 1), b3 + hstep, voffB);
      PG8_WAIT_V(6); PG8_BAR; PG8_MMA(1, 1, At, B1); PG8_BAR;
    }
    PG8_SCHED;
    if constexpr (Epi::MODE == 2) asm volatile("s_nop 15\n\ts_nop 15\n\ts_nop 15\n\ts_nop 15" ::: "memory");
    { const int l2 = otid() & 63; E(acc, cur, wr, wc, l2 & 15, l2 >> 4); }
    PG8_SCHED;
    if (!has_next) break;
#pragma unroll
    for (int a = 0; a < 2; ++a)
#pragma unroll
      for (int b = 0; b < 2; ++b)
#pragma unroll
        for (int m = 0; m < 4; ++m)
#pragma unroll
          for (int n = 0; n < 2; ++n) acc[a][b][m][n] = zacc;
    cur = nxt; cA = nA; cB = nB; ++ui;
  }
  PG8_WAIT_V(0);
  if (wr == 0) PG8_BAR;
  PG8_BAR;
#undef PG8_SA
#undef PG8_SB
#undef PG8_STAGE
#undef PG8_LDA
#undef PG8_LDB
#undef PG8_MMA
#undef PG8_WAIT_V
#undef PG8_WAIT_L
#undef PG8_BAR
#undef PG8_SCHED
}
}

struct EpiProj {
  static constexpr bool PERM = true;
  static constexpr int MODE = 1;
  typedef i32x4 AccT;
  char* ws; const float* b_merge;
  DI void operator()(const i32x4 (&acc)[2][2][4][2], const pg8::Unit& u, int wr, int wc, int fr, int fq) const {
    const float* rope = (const float*)(ws + OFF_ROPE);
    const float* sa = (const float*)(ws + OFF_SA); const float* sw = (const float*)(ws + OFF_SCW1);
    const int row0 = u.pm * 256 + wr * 64 + fr;
#pragma unroll
    for (int bj = 0; bj < 2; ++bj) {
      const int cg = u.pn * 256 + bj * 128 + wc * 32;
      const int c0 = cg + 8 * fq;
      if (cg >= 4384) continue;
      const float sbg = sw[cg >> 5];
#define EPJ_CV(sc_) const float f_ = sa[row] * (sc_); const f32x4 cv0 = __builtin_convertvector(acc[ai][bj][m][0], f32x4) * f_, cv1 = __builtin_convertvector(acc[ai][bj][m][1], f32x4) * f_;
      if (cg < 1280 && (cg < 640 || (cg >= 768 && cg < 896) || (cg >= 1024 && cg < 1152))) {
        bf16_t* dst; unsigned ld, cofs; float scale = 1.0f;
        if (cg < 512) { dst = (bf16_t*)(ws + OFF_Q); ld = 512; cofs = c0; scale = 0.18033688011112042f; }
        else if (cg < 640) { dst = (bf16_t*)(ws + OFF_KC); ld = 128; cofs = c0 - 512; }
        else if (cg < 896) { dst = (bf16_t*)(ws + OFF_KS); ld = 128; cofs = c0 - 768; }
        else { dst = (bf16_t*)(ws + OFF_KW); ld = 128; cofs = c0 - 1024; }
        const int d0 = 16 * ((cg >> 5) & 1) + 4 * fq;
#pragma unroll
        for (int ai = 0; ai < 2; ++ai)
#pragma unroll
          for (int m = 0; m < 4; ++m) {
            const int row = row0 + ai * 128 + m * 16, pos = row & (SEQ - 1);
            const f32x4 cs = *(const f32x4*)(rope + pos * 32 + d0), sn = *(const f32x4*)(rope + 262144 + pos * 32 + d0);
            EPJ_CV(sbg * scale)
            const f32x4 o1 = cv0 * cs - cv1 * sn, o2 = cv0 * sn + cv1 * cs;
            u32x4 w; w.x = pack2(o1.x, o1.y); w.y = pack2(o1.z, o1.w); w.z = pack2(o2.x, o2.y); w.w = pack2(o2.z, o2.w);
            *(u32x4*)(dst + (unsigned)row * ld + cofs) = w;
          }
      } else if (cg < 1280) {
        bf16_t* dst; unsigned cofs;
        if (cg < 768) { dst = (bf16_t*)(ws + OFF_VC); cofs = c0 - 640; }
        else if (cg < 1024) { dst = (bf16_t*)(ws + OFF_VS); cofs = c0 - 896; }
        else { dst = (bf16_t*)(ws + OFF_VW); cofs = c0 - 1152; }
#pragma unroll
        for (int ai = 0; ai < 2; ++ai)
#pragma unroll
          for (int m = 0; m < 4; ++m) {
            const int row = row0 + ai * 128 + m * 16;
            EPJ_CV(sbg)
            const f32x4 a = cv0, b = cv1;
            u32x4 w; w.x = pack2(a.x, a.y); w.y = pack2(a.z, a.w); w.z = pack2(b.x, b.y); w.w = pack2(b.z, b.w);
            *(u32x4*)(dst + (unsigned)row * 128u + cofs) = w;
          }
      } else if (cg < 2304) {
        bf16_t* dst = (bf16_t*)(ws + (cg < 1792 ? OFF_U : OFF_V));
        const unsigned cofs = c0 - (cg < 1792 ? 1280 : 1792);
#pragma unroll
        for (int ai = 0; ai < 2; ++ai)
#pragma unroll
          for (int m = 0; m < 4; ++m) {
            const int row = row0 + ai * 128 + m * 16;
            EPJ_CV(sbg)
            const f32x4 a = cv0, b = cv1;
            const f32x2 g0 = gelu_pk((f32x2){a.x, a.y}), g1 = gelu_pk((f32x2){a.z, a.w}), g2 = gelu_pk((f32x2){b.x, b.y}), g3 = gelu_pk((f32x2){b.z, b.w});
            u32x4 w; w.x = pack2(g0.x, g0.y); w.y = pack2(g1.x, g1.y); w.z = pack2(g2.x, g2.y); w.w = pack2(g3.x, g3.y);
            *(u32x4*)(dst + (unsigned)row * 512u + cofs) = w;
          }
      } else if (cg < 4352) {
        unsigned char* dst = (unsigned char*)(ws + OFF_GATE8);
        const unsigned cofs = c0 - 2304;
        const f32x4 b0 = *(const f32x4*)(b_merge + cofs), b1 = *(const f32x4*)(b_merge + cofs + 4);
#pragma unroll
        for (int ai = 0; ai < 2; ++ai)
#pragma unroll
          for (int m = 0; m < 4; ++m) {
            const int row = row0 + ai * 128 + m * 16;
            EPJ_CV(sbg)
            const f32x4 a = cv0 + b0, b = cv1 + b1;
            u32x2 w; w.x = pk4_fp8(sigmoid_f(a.x), sigmoid_f(a.y), sigmoid_f(a.z), sigmoid_f(a.w));
            w.y = pk4_fp8(sigmoid_f(b.x), sigmoid_f(b.y), sigmoid_f(b.z), sigmoid_f(b.w));
            *(u32x2*)(dst + (unsigned)row * 2048u + cofs) = w;
          }
      } else {
        float* gs = (float*)(ws + OFF_GSIG);
        if (fq < 3) {
#pragma unroll
          for (int ai = 0; ai < 2; ++ai)
#pragma unroll
            for (int m = 0; m < 4; ++m) {
              const int row = row0 + ai * 128 + m * 16;
              EPJ_CV(sbg)
              const f32x4 a = cv0, b = cv1;
              f32x4 o0, o1; o0.x = sigmoid_f(a.x); o0.y = sigmoid_f(a.y); o0.z = sigmoid_f(a.z); o0.w = sigmoid_f(a.w);
              o1.x = sigmoid_f(b.x); o1.y = sigmoid_f(b.y); o1.z = sigmoid_f(b.z); o1.w = sigmoid_f(b.w);
              *(f32x4*)(gs + (unsigned)row * 32u + 8 * fq) = o0; *(f32x4*)(gs + (unsigned)row * 32u + 8 * fq + 4) = o1;
            }
        }
      }
    }
  }
};
DI void phase_gemm1(const Params& p, char* smem) {
  pg8::Gemm g{(const bf16_t*)(p.ws + OFF_H), (const bf16_t*)(p.ws + OFF_WT1), NTOK, N1, 512};
  pg8::StaticOrder S; S.init(NTOK, N1, gridDim.x, blockIdx.x);
  EpiProj E{p.ws, p.b_merge};
  pg8::gemm_phase((LAS unsigned char*)smem, g, S, E);
}

template <int BR> struct EpiMerge {
  static constexpr bool PERM = true;
  static constexpr int MODE = 2;
  typedef f32x4 AccT;
  char* ws;
  DI void operator()(const f32x4 (&acc)[2][2][4][2], const pg8::Unit& u, int wr, int wc, int fr, int fq) const {
    const unsigned char* gate = (const unsigned char*)(ws + OFF_GATE8);
    unsigned char* m0 = (unsigned char*)(ws + OFF_M08);
    unsigned char* mrg = (unsigned char*)(ws + OFF_MRG8);
    const float* sw = (const float*)(ws + OFF_SCWB) + BR * 32;
    const int row0 = u.pm * 256 + wr * 64 + fr;
#pragma unroll
    for (int bj = 0; bj < 2; ++bj) {
      const unsigned cgp = u.pn * 256 + bj * 128 + wc * 32, c0 = cgp + 8 * fq;
      const float f = sw[cgp >> 5] * (BR == 0 ? 1.0f : 2.0f);
#pragma unroll
      for (int ai = 0; ai < 2; ++ai)
#pragma unroll
        for (int m = 0; m < 4; ++m) {
          const unsigned row = row0 + ai * 128 + m * 16;
          float gg[8]; unpack8_fp8(*(const u32x2*)(gate + row * 2048u + BR * 1024 + c0), gg);
          const f32x4 a = acc[ai][bj][m][0] * f, b = acc[ai][bj][m][1] * f;
          float v[8] = {a.x * gg[0], a.y * gg[1], a.z * gg[2], a.w * gg[3], b.x * gg[4], b.y * gg[5], b.z * gg[6], b.w * gg[7]};
          if (BR == 1) {
            float old[8]; unpack8_fp8(*(const u32x2*)(m0 + row * 1024u + c0), old);
#pragma unroll
            for (int j = 0; j < 8; ++j) v[j] += old[j];
          }
#pragma unroll
          for (int j = 0; j < 8; ++j) v[j] = clamp_f8(v[j]);
          u32x2 w; w.x = pk4_fp8(v[0], v[1], v[2], v[3]); w.y = pk4_fp8(v[4], v[5], v[6], v[7]);
          *(u32x2*)((BR == 0 ? m0 : mrg) + row * 1024u + c0) = w;
        }
    }
  }
};
DI void phase_merge(const Params& p, char* smem) {
  pg8::StaticOrder S; S.init(NTOK, 1024, gridDim.x, blockIdx.x);
  {
    pg8::Gemm g{(const bf16_t*)(p.ws + OFF_ONSA8), (const bf16_t*)(p.ws + OFF_WB), NTOK, 1024, 256};
    EpiMerge<0> E{p.ws};
    pg8::gemm_phase((LAS unsigned char*)smem, g, S, E);
  }
  {
    pg8::Gemm g{(const bf16_t*)(p.ws + OFF_OSGU8), (const bf16_t*)(p.ws + OFF_WB + (size_t)1024 * 512), NTOK, 1024, 256};
    EpiMerge<1> E{p.ws};
    pg8::gemm_phase((LAS unsigned char*)smem, g, S, E);
  }
}

struct EpiOut {
  static constexpr bool PERM = true;
  static constexpr int MODE = 2;
  typedef f32x4 AccT;
  char* ws; const float* x;
  DI void operator()(const f32x4 (&acc)[2][2][4][2], const pg8::Unit& u, int wr, int wc, int fr, int fq) const {
    const float* mod = (const float*)(ws + OFF_MOD);
    bf16_t* y = (bf16_t*)(ws + OFF_Y);
    const int row0 = u.pm * 256 + wr * 64 + fr, b = (u.pm * 256) >> 13;
#pragma unroll
    for (int bj = 0; bj < 2; ++bj) {
      const unsigned c0 = u.pn * 256 + bj * 128 + wc * 32 + 8 * fq;
      const float f = ((const float*)(ws + OFF_SCWO))[c0 >> 5] * 0.0625f;
      const f32x4 g0 = *(const f32x4*)(mod + b * 6144 + 2048 + c0) * f, g1 = *(const f32x4*)(mod + b * 6144 + 2048 + c0 + 4) * f;
#pragma unroll
      for (int ai = 0; ai < 2; ++ai)
#pragma unroll
        for (int m = 0; m < 4; ++m) {
          const unsigned o = (unsigned)(row0 + ai * 128 + m * 16) * 1024u + c0;
          const f32x4 x0 = *(const f32x4*)(x + o), x1v = *(const f32x4*)(x + o + 4);
          const f32x4 v0 = x0 * DN_ALPHA + g0 * acc[ai][bj][m][0], v1 = x1v * DN_ALPHA + g1 * acc[ai][bj][m][1];
          u32x4 w; w.x = pack2(v0.x, v0.y); w.y = pack2(v0.z, v0.w); w.z = pack2(v1.x, v1.y); w.w = pack2(v1.z, v1.w);
          *(u32x4*)(y + o) = w;
        }
    }
  }
};
DI void phase_outproj(const Params& p, char* smem) {
  pg8::Gemm g{(const bf16_t*)(p.ws + OFF_MRG8), (const bf16_t*)(p.ws + OFF_WOUT), NTOK, 1024, 512};
  pg8::StaticOrder S; S.init(NTOK, 1024, gridDim.x, blockIdx.x);
  EpiOut E{p.ws, p.x};
  pg8::gemm_phase((LAS unsigned char*)smem, g, S, E);
}

struct EpiPq {
  static constexpr bool PERM = true;
  static constexpr int MODE = 1;
  typedef i32x4 AccT;
  char* ws;
  DI void operator()(const i32x4 (&acc)[2][2][4][2], const pg8::Unit& u, int wr, int wc, int fr, int fq) const {
    bf16_t* pq = (bf16_t*)(ws + OFF_PQ);
    const float* sh = (const float*)(ws + OFF_SH); const float* sq = (const float*)(ws + OFF_SCWQ);
    const int row0 = u.pm * 256 + wr * 64 + fr;
#pragma unroll
    for (int bj = 0; bj < 2; ++bj) {
      const unsigned c0 = u.pn * 256 + bj * 128 + wc * 32 + 8 * fq;
      const float sbg = sq[(u.pn * 256 + bj * 128 + wc * 32) >> 5];
#pragma unroll
      for (int ai = 0; ai < 2; ++ai)
#pragma unroll
        for (int m = 0; m < 4; ++m) {
          const float f_ = sh[row0 + ai * 128 + m * 16] * sbg;
          const f32x4 a = __builtin_convertvector(acc[ai][bj][m][0], f32x4) * f_, b = __builtin_convertvector(acc[ai][bj][m][1], f32x4) * f_;
          u32x4 w; w.x = pack2(a.x, a.y); w.y = pack2(a.z, a.w); w.z = pack2(b.x, b.y); w.w = pack2(b.z, b.w);
          *(u32x4*)(pq + (unsigned)(row0 + ai * 128 + m * 16) * 2048u + c0) = w;
        }
    }
  }
};
DI void phase_peerq(const Params& p, char* smem) {
  pg8::Gemm g{(const bf16_t*)(p.ws + OFF_H2Q), (const bf16_t*)(p.ws + OFF_WQ), NTOK, 2048, 512};
  pg8::StaticOrder S; S.init(NTOK, 2048, gridDim.x, blockIdx.x);
  EpiPq E{p.ws};
  pg8::gemm_phase((LAS unsigned char*)smem, g, S, E);
}

DI void phase_sgu(const Params& p, char* smem) {
  char* ws = p.ws;
  const int tid = otid(), lane = tid & 63, wave = tid >> 6, l31 = lane & 31, hh = lane >> 5;
  const bf16_t* u = (const bf16_t*)(ws + OFF_U);
  const bf16_t* v = (const bf16_t*)(ws + OFF_V);
  const bf16_t* W = (const bf16_t*)(ws + OFF_SGUW);
  float* st = (float*)smem;
  bf16_t* vn = (bf16_t*)(smem + 1024);
  constexpr int LN_ = 72;
  const int dt = wave & 1, it = wave >> 1;
  const int gi = lane >> 4, i16 = lane & 15, tq = i16 >> 2, tp = i16 & 3;
  for (int item = blockIdx.x; item < NTOK / 128; item += gridDim.x) {
    const int t0 = item * 128;
    __syncthreads();
    for (int i = 0; i < 16; ++i) {
      const int t = wave * 16 + i;
      const u32x4 raw = *(const u32x4*)(v + (size_t)(t0 + t) * 512 + lane * 8);
      float f[8]; unpack8(raw, f);
      float s = 0.f;
#pragma unroll
      for (int j = 0; j < 8; ++j) s += f[j];
      const float mean = wave_sum(s) * (1.f / 512.f);
      float q = 0.f;
#pragma unroll
      for (int j = 0; j < 8; ++j) { const float d = f[j] - mean; q += d * d; }
      const float rstd = rsqrtf(wave_sum(q) * (1.f / 512.f) + LN_EPS);
      if (lane == 0) { st[t * 2] = mean; st[t * 2 + 1] = rstd; }
    }
    u32x4 vnext[2];
#pragma unroll
    for (int i = 0; i < 2; ++i) { const int idx = tid + i * NT; vnext[i] = *(const u32x4*)(v + (size_t)(t0 + (idx >> 3)) * 512 + (idx & 7) * 8); }
    for (int g = 0; g < 8; ++g) {
      u32x4 vcur[2] = {vnext[0], vnext[1]};
      if (g + 1 < 8) {
#pragma unroll
        for (int i = 0; i < 2; ++i) { const int idx = tid + i * NT; vnext[i] = *(const u32x4*)(v + (size_t)(t0 + (idx >> 3)) * 512 + (g + 1) * 64 + (idx & 7) * 8); }
      }
      u32x2 uold[4];
      {
        const bf16_t* urow0 = u + (size_t)(t0 + it * 32 + l31) * 512 + g * 64 + dt * 32 + 4 * hh;
#pragma unroll
        for (int q4 = 0; q4 < 4; ++q4) uold[q4] = *(const u32x2*)(urow0 + 8 * q4);
      }
      lds_barrier();
#pragma unroll
      for (int i = 0; i < 2; ++i) {
        const int idx = tid + i * NT, j = idx >> 3, dc = (idx & 7) * 8;
        const u32x4 raw = vcur[i];
        const float mean = st[j * 2], rstd = st[j * 2 + 1];
        float f[8], gg[8], bb[8]; unpack8(raw, f); ld8(p.sgu_ln_g + g * 64 + dc, gg); ld8(p.sgu_ln_b + g * 64 + dc, bb);
#pragma unroll
        for (int k = 0; k < 8; ++k) f[k] = (f[k] - mean) * rstd * gg[k] + bb[k];
        *(u32x4*)(vn + j * LN_ + dc) = pack8(f);
      }
      lds_barrier();
      f32x16 acc;
#pragma unroll
      for (int r = 0; r < 16; ++r) acc[r] = 0.f;
      const bf16_t* wrow = W + ((size_t)g * 128 + it * 32 + l31) * 128 + hh * 8;
      const LAS bf16_t* vbase = (const LAS bf16_t*)vn + (8 * (gi >> 1) + tq) * LN_ + dt * 32 + 16 * (gi & 1) + 4 * tp;
#pragma unroll
      for (int ks = 0; ks < 8; ++ks) {
        if (ks <= 2 * it + 1) {
          const LAS bf16_t* vp = vbase + (ks * 16) * LN_;
          const s16x4 lo = __builtin_amdgcn_ds_read_tr16_b64_v4i16((LAS s16x4*)vp);
          const s16x4 hi = __builtin_amdgcn_ds_read_tr16_b64_v4i16((LAS s16x4*)(vp + 4 * LN_));
          const bf16x8 bw = *(const bf16x8*)(wrow + ks * 16);
          acc = MFMA32(__builtin_shufflevector(lo, hi, 0, 1, 2, 3, 4, 5, 6, 7), bw, acc);
        }
      }
      const int i = it * 32 + l31;
      const float bsv = p.sgu_b[g * 128 + i];
      unsigned char* orow = (unsigned char*)(ws + OFF_OSGU8) + (size_t)(t0 + i) * 512 + g * 64 + dt * 32 + 4 * hh;
#pragma unroll
      for (int q4 = 0; q4 < 4; ++q4) {
        const u32x2 old = uold[q4];
        *(unsigned*)(orow + 8 * q4) = pk4_fp8(clamp_f8(8.0f * bflo(old.x) * (acc[4 * q4] + bsv)), clamp_f8(8.0f * bfhi(old.x) * (acc[4 * q4 + 1] + bsv)),
                                              clamp_f8(8.0f * bflo(old.y) * (acc[4 * q4 + 2] + bsv)), clamp_f8(8.0f * bfhi(old.y) * (acc[4 * q4 + 3] + bsv)));
      }
    }
  }
}

DI void phase_compress(const Params& p, char* smem) {
  char* ws = p.ws;
  const int tid = otid(), lane = tid & 63, wave = tid >> 6, l31 = lane & 31, hh = lane >> 5;
  bf16_t* hid = (bf16_t*)smem;
  constexpr int LH = 136;
  for (int item = blockIdx.x; item < 128; item += gridDim.x) {
    const int w = item >> 6, R0 = (item & 63) * 128;
    const bf16_t* src = (const bf16_t*)(ws + (w == 0 ? OFF_KC : OFF_VC));
    const bf16_t* W1 = (const bf16_t*)(ws + OFF_CW1) + (size_t)w * 128 * 2048;
    const bf16_t* W2 = (const bf16_t*)(ws + OFF_CW2) + (size_t)w * 64 * 128;
    const float* posb = (const float*)(ws + OFF_POSB) + w * 128;
    const int rg = wave >> 2, cgp = wave & 3;
    const bf16_t* abase[2];
#pragma unroll
    for (int mi = 0; mi < 2; ++mi) {
      const int R = R0 + rg * 64 + mi * 32 + l31, bg = R >> 9, n = R & 511, nn = n < 510 ? n : 510;
      abase[mi] = src + ((size_t)((bg >> 1) * SEQ + 16 * nn)) * 128 + (bg & 1) * 64 + hh * 8;
    }
    const bf16_t* bbase = W1 + (size_t)(cgp * 32 + l31) * 2048 + hh * 8;
    f32x16 acc[2];
#pragma unroll
    for (int r = 0; r < 16; ++r) { acc[0][r] = 0.f; acc[1][r] = 0.f; }
#pragma unroll 8
    for (int ks = 0; ks < 128; ++ks) {
      const int aofs = (ks >> 2) * 128 + (ks & 3) * 16;
      const bf16x8 a0 = *(const bf16x8*)(abase[0] + aofs), a1 = *(const bf16x8*)(abase[1] + aofs);
      const bf16x8 bb = *(const bf16x8*)(bbase + ks * 16);
      acc[0] = MFMA32(a0, bb, acc[0]); acc[1] = MFMA32(a1, bb, acc[1]);
    }
    __syncthreads();
    {
      const float pb = posb[cgp * 32 + l31];
#pragma unroll
      for (int mi = 0; mi < 2; ++mi)
#pragma unroll
        for (int r = 0; r < 16; ++r) {
          const int row = rg * 64 + mi * 32 + (r & 3) + 8 * (r >> 2) + 4 * hh;
          hid[row * LH + cgp * 32 + l31] = f2bf(gelu_f(acc[mi][r] + pb));
        }
    }
    __syncthreads();
    const int mi2 = wave >> 1, ni = wave & 1;
    f32x16 o;
#pragma unroll
    for (int r = 0; r < 16; ++r) o[r] = 0.f;
#pragma unroll
    for (int ks = 0; ks < 8; ++ks) {
      const bf16x8 a = *(const bf16x8*)(hid + (mi2 * 32 + l31) * LH + ks * 16 + hh * 8);
      const bf16x8 bb = *(const bf16x8*)(W2 + (size_t)(ni * 32 + l31) * 128 + ks * 16 + hh * 8);
      o = MFMA32(a, bb, o);
    }
    const int d = ni * 32 + l31;
    const float b2 = p.cmp_b2[w * 64 + (w == 0 ? dperm(d) : d)];
    const int bg = R0 >> 9;
    bf16_t* dst = (bf16_t*)(ws + (w == 0 ? OFF_KCMP : OFF_VCMP));
#pragma unroll
    for (int r = 0; r < 16; ++r) {
      const int n = (R0 & 511) + mi2 * 32 + (r & 3) + 8 * (r >> 2) + 4 * hh;
      dst[((size_t)bg * 512 + n) * 64 + d] = f2bf(n < 511 ? o[r] + b2 : 0.f);
    }
  }
}

constexpr int LK = 72;
constexpr int NSA_TILE = 18432;
constexpr int NSA_AIMP = 3 * NSA_TILE, NSA_CIMP = NSA_AIMP + 32768, NSA_SELM = NSA_CIMP + 32768;
constexpr float NSA_THR = 6.0f;
struct TileRegs { u32x4 k; u32x4 v; };

DI void nsa_load_tile(TileRegs& t, const bf16_t* kbase, size_t kstride, const bf16_t* vbase, size_t vstride) {
  const int tid = otid(), r = tid >> 3, ch = tid & 7;
  t.k = *(const u32x4*)(kbase + (size_t)r * kstride + ch * 8);
  t.v = *(const u32x4*)(vbase + (size_t)r * vstride + ch * 8);
}
DI void nsa_store_tile(const TileRegs& t, char* tile) {
  const int tid = otid(), r = tid >> 3, ch = tid & 7;
  *(u32x4*)((bf16_t*)tile + r * LK + ch * 8) = t.k;
  *(u32x4*)((bf16_t*)(tile + 9216) + r * LK + ch * 8) = t.v;
}
DI void nsa_scores(f32x16 (&st)[2], const char* tile, const bf16x8 (&qf)[4], int lane) {
  const bf16_t* Ks = (const bf16_t*)tile;
#pragma unroll
  for (int kt = 0; kt < 2; ++kt)
#pragma unroll
    for (int r = 0; r < 16; ++r) st[kt][r] = 0.f;
  __builtin_amdgcn_s_setprio(1);
#pragma unroll
  for (int ks = 0; ks < 4; ++ks)
#pragma unroll
    for (int kt = 0; kt < 2; ++kt) {
      const bf16x8 a = *(const bf16x8*)(Ks + (kt * 32 + (lane & 31)) * LK + ks * 16 + (lane >> 5) * 8);
      st[kt] = MFMA32(a, qf[ks], st[kt]);
    }
  __builtin_amdgcn_s_setprio(0);
}
DI void nsa_pv(f32x16 (&o)[2], const f32x16 (&pt)[2], const char* tile, int lane) {
  const int gi = lane >> 4, i16 = lane & 15, q = i16 >> 2, pp = i16 & 3;
  const LAS bf16_t* Vs = (const LAS bf16_t*)(tile + 9216) + (4 * (gi >> 1) + q) * LK + 16 * (gi & 1) + 4 * pp;
#pragma unroll
  for (int kt = 0; kt < 2; ++kt)
#pragma unroll
    for (int s = 0; s < 2; ++s) {
      u32x4 pk; pk.x = pack2(pt[kt][8 * s], pt[kt][8 * s + 1]); pk.y = pack2(pt[kt][8 * s + 2], pt[kt][8 * s + 3]);
      pk.z = pack2(pt[kt][8 * s + 4], pt[kt][8 * s + 5]); pk.w = pack2(pt[kt][8 * s + 6], pt[kt][8 * s + 7]);
      const bf16x8 pb = __builtin_bit_cast(bf16x8, pk);
      bf16x8 a[2];
#pragma unroll
      for (int dt = 0; dt < 2; ++dt) {
        const LAS bf16_t* vp = Vs + (kt * 32 + 16 * s) * LK + dt * 32;
        const s16x4 lo = __builtin_amdgcn_ds_read_tr16_b64_v4i16((LAS s16x4*)vp);
        const s16x4 hi = __builtin_amdgcn_ds_read_tr16_b64_v4i16((LAS s16x4*)(vp + 8 * LK));
        a[dt] = __builtin_shufflevector(lo, hi, 0, 1, 2, 3, 4, 5, 6, 7);
      }
      o[0] = MFMA32(a[0], pb, o[0]); o[1] = MFMA32(a[1], pb, o[1]);
    }
}

constexpr float NSA_NEG = -3.0e38f;
DI void nsa_online(f32x16 (&st)[2], bool sel, float& m, float& l, f32x16 (&o)[2], const char* tile, int lane) {
  float mx = NSA_NEG;
#pragma unroll
  for (int r = 0; r < 16; ++r) mx = fmaxf(mx, fmaxf(st[0][r], st[1][r]));
  mx = fmaxf(mx, xor32f(mx, lane));
  mx = sel ? mx : NSA_NEG;
  if (__any(mx > m + NSA_THR)) {
    const float mn = fmaxf(m, mx);
    const float alpha = __builtin_amdgcn_exp2f(m - mn);
    m = mn; l *= alpha;
#pragma unroll
    for (int r = 0; r < 16; ++r) { o[0][r] *= alpha; o[1][r] *= alpha; }
  }
  const float ms = sel ? m : 1e30f;
  float sum = 0.f;
#pragma unroll
  for (int r = 0; r < 16; ++r) {
    const float p0 = __builtin_amdgcn_exp2f(st[0][r] - ms), p1 = __builtin_amdgcn_exp2f(st[1][r] - ms);
    st[0][r] = p0; st[1][r] = p1; sum += p0 + p1;
  }
  l += sum;
  nsa_pv(o, st, tile, lane);
}

struct NsaItem { int qb, b, g, bg, t; size_t tokrow; };
DI NsaItem nsa_item(int item0, int wave, int qi) {
  const int G = gridDim.x, k = item0 / G, bb = item0 - k * G;
  const int item = (k & 1) ? (k * G + (G - 1 - bb)) : item0;
  NsaItem it; it.qb = 127 - (item >> 4); const int rest = item & 15; it.b = rest >> 1; it.g = rest & 1;
  it.bg = it.b * 2 + it.g; it.t = it.qb * 64 + wave * 8 + qi; it.tokrow = (size_t)it.b * SEQ + it.t; return it;
}
DI void nsa_accum_store(bf16_t* dst, const f32x16 (&o)[2], float sc, bool first, int hh, unsigned char* dst8 = nullptr) {
#pragma unroll
  for (int dt = 0; dt < 2; ++dt)
#pragma unroll
    for (int q4 = 0; q4 < 4; ++q4) {
      u32x2* pp = (u32x2*)(dst + dt * 32 + 8 * q4 + 4 * hh);
      float a0 = sc * o[dt][4 * q4], a1 = sc * o[dt][4 * q4 + 1], a2 = sc * o[dt][4 * q4 + 2], a3 = sc * o[dt][4 * q4 + 3];
      if (!first) { const u32x2 old = *pp; a0 += bflo(old.x); a1 += bfhi(old.x); a2 += bflo(old.y); a3 += bfhi(old.y); }
      if (dst8) *(unsigned*)(dst8 + dt * 32 + 8 * q4 + 4 * hh) = pk4_fp8(clamp_f8(16.0f * a0), clamp_f8(16.0f * a1), clamp_f8(16.0f * a2), clamp_f8(16.0f * a3));
      else { u32x2 wv; wv.x = pack2(a0, a1); wv.y = pack2(a2, a3); *pp = wv; }
    }
}

constexpr int NSA_STAGE = 4 * 18432;
typedef float f32x4v __attribute__((ext_vector_type(4)));
#define MFMA16(a, b, c) __builtin_amdgcn_mfma_f32_16x16x32_bf16((a), (b), (c), 0, 0, 0)
struct StageRegs { u32x4 r[8]; };
DI void nsa_load_stage(StageRegs& sr, const bf16_t* kb, const bf16_t* vb, int j0s, int qb) {
  const int tid = otid(), r = tid >> 3, ch = tid & 7;
#pragma unroll
  for (int tt = 0; tt < 4; ++tt) {
    const int j = (j0s + tt <= qb) ? j0s + tt : qb;
    sr.r[2 * tt] = *(const u32x4*)(kb + ((size_t)j * 64 + r) * 128 + ch * 8);
    sr.r[2 * tt + 1] = *(const u32x4*)(vb + ((size_t)j * 64 + r) * 128 + ch * 8);
  }
}
DI void nsa_store_stage(const StageRegs& sr, char* stage) {
  const int tid = otid(), r = tid >> 3, ch = tid & 7;
#pragma unroll
  for (int tt = 0; tt < 4; ++tt) {
    *(u32x4*)((bf16_t*)(stage + tt * 18432) + r * LK + ch * 8) = sr.r[2 * tt];
    *(u32x4*)((bf16_t*)(stage + tt * 18432 + 9216) + r * LK + ch * 8) = sr.r[2 * tt + 1];
  }
}
struct Sel16 { float m, l; bool has; f32x4v o[4]; };
DI void nsa_unit16(Sel16& g, const char* tile, const bf16x8 (&qf)[2], bool sel, int klim  , int lane) {
  const int c16 = lane & 15, kg = lane >> 4, tq = c16 >> 2, tp = c16 & 3;
  const bf16_t* Ks = (const bf16_t*)tile + c16 * LK + kg * 8;
  f32x4v st[4];
  const float ini = sel ? -g.m : -1e30f;
#pragma unroll
  for (int kt = 0; kt < 4; ++kt) {
    st[kt] = (f32x4v){ini, ini, ini, ini};
#pragma unroll
    for (int ks = 0; ks < 2; ++ks) st[kt] = MFMA16(*(const bf16x8*)(Ks + kt * 16 * LK + ks * 32), qf[ks], st[kt]);
  }
  if (klim < 64) {
#pragma unroll
    for (int kt = 0; kt < 4; ++kt)
#pragma unroll
      for (int r = 0; r < 4; ++r) st[kt][r] = (kt * 16 + 4 * kg + r <= klim) ? st[kt][r] : NSA_NEG;
  }
  float mx = fmaxf(fmaxf(fmaxf(st[0][0], st[0][1]), fmaxf(st[0][2], st[0][3])), fmaxf(fmaxf(st[1][0], st[1][1]), fmaxf(st[1][2], st[1][3])));
  mx = fmaxf(mx, fmaxf(fmaxf(fmaxf(st[2][0], st[2][1]), fmaxf(st[2][2], st[2][3])), fmaxf(fmaxf(st[3][0], st[3][1]), fmaxf(st[3][2], st[3][3]))));
  mx = fmaxf(mx, xor16f(mx, lane));
  mx = fmaxf(mx, xor32f(mx, lane));
  const bool real = mx > -1e29f;
  const bool fresh = !g.has && real, up = g.has && (mx > NSA_THR);
  if (__any(fresh || up)) {
    const float delta = (fresh || up) ? mx : 0.f;
    const float alpha = up ? __builtin_amdgcn_exp2f(-delta) : 1.0f;
    g.m += delta; g.l *= alpha;
#pragma unroll
    for (int dt = 0; dt < 4; ++dt) g.o[dt] *= alpha;
#pragma unroll
    for (int kt = 0; kt < 4; ++kt) st[kt] -= delta;
  }
  g.has = g.has || real;
  float sum = 0.f;
#pragma unroll
  for (int kt = 0; kt < 4; ++kt)
#pragma unroll
    for (int r = 0; r < 4; ++r) { const float pv = __builtin_amdgcn_exp2f(st[kt][r]); st[kt][r] = pv; sum += pv; }
  g.l += sum;
  const LAS bf16_t* Vs = (const LAS bf16_t*)(tile + 9216) + (4 * kg + tq) * LK + 4 * tp;
#pragma unroll
  for (int kp = 0; kp < 2; ++kp) {
    u32x4 pk; pk.x = pack2(st[2 * kp][0], st[2 * kp][1]); pk.y = pack2(st[2 * kp][2], st[2 * kp][3]);
    pk.z = pack2(st[2 * kp + 1][0], st[2 * kp + 1][1]); pk.w = pack2(st[2 * kp + 1][2], st[2 * kp + 1][3]);
    const bf16x8 pb = __builtin_bit_cast(bf16x8, pk);
#pragma unroll
    for (int dt = 0; dt < 4; ++dt) {
      const LAS bf16_t* vp = Vs + (2 * kp) * 16 * LK + dt * 16;
      const s16x4 lo = __builtin_amdgcn_ds_read_tr16_b64_v4i16((LAS s16x4*)vp);
      const s16x4 hi = __builtin_amdgcn_ds_read_tr16_b64_v4i16((LAS s16x4*)(vp + 16 * LK));
      g.o[dt] = MFMA16(__builtin_shufflevector(lo, hi, 0, 1, 2, 3, 4, 5, 6, 7), pb, g.o[dt]);
    }
  }
}
DI void nsa_sel16(const Params& p, char* smem, bool dry) {
  char* ws = p.ws;
  const int tid = otid(), lane = tid & 63, wave = tid >> 6, c16 = lane & 15, kg = lane >> 4, qi4 = c16 >> 2, r4 = c16 & 3;
  const bf16_t* Q = (const bf16_t*)(ws + OFF_Q);
  const float* gsig = (const float*)(ws + OFF_GSIG);
  bf16_t* ONSA = (bf16_t*)(ws + OFF_ONSA);
  const u32x4* SELG = (const u32x4*)(ws + OFF_SELG);
  const bf16_t* KS = (const bf16_t*)(ws + OFF_KS); const bf16_t* VS = (const bf16_t*)(ws + OFF_VS);
  constexpr int NITEM = NB * 2 * 128;
  for (int item = blockIdx.x; item < NITEM; item += gridDim.x) {
    const NsaItem it = nsa_item(item, wave, 0);
    const int qb = it.qb;
    bf16x8 qf[2][2]; u32x4 selw[2]; float g_s[2]; int tg[2]; Sel16 G[2];
#pragma unroll
    for (int gq = 0; gq < 2; ++gq) {
      tg[gq] = it.t + 4 * gq + qi4;
      const size_t tokrow = (size_t)it.b * SEQ + tg[gq];
#pragma unroll
      for (int ks = 0; ks < 2; ++ks) qf[gq][ks] = *(const bf16x8*)(Q + tokrow * 512 + (it.g * 4 + r4) * 64 + ks * 32 + kg * 8);
      selw[gq] = SELG[(size_t)it.bg * SEQ + tg[gq]];
      g_s[gq] = gsig[tokrow * 32 + (it.g * 4 + r4) * 3 + 1];
      G[gq].m = 0.f; G[gq].l = 0.f; G[gq].has = false;
#pragma unroll
      for (int dt = 0; dt < 4; ++dt) G[gq].o[dt] = (f32x4v){0.f, 0.f, 0.f, 0.f};
    }
    const bf16_t* kb = KS + (size_t)it.b * SEQ * 128 + it.g * 64;
    const bf16_t* vb = VS + (size_t)it.b * SEQ * 128 + it.g * 64;
    const int nst = (qb >> 2) + 1;
    StageRegs sr;
    lds_barrier();
    nsa_load_stage(sr, kb, vb, 0, qb);
    nsa_store_stage(sr, smem);
    lds_barrier();
    for (int sidx = 0; sidx < nst; ++sidx) {
      const char* stage = smem + (sidx & 1) * NSA_STAGE;
      if (sidx + 1 < nst) nsa_load_stage(sr, kb, vb, 4 * (sidx + 1), qb);
#pragma unroll 1
      for (int tt = 0; tt < 4; ++tt) {
        const int j = 4 * sidx + tt;
        if (j > qb) break;
#pragma unroll
        for (int gq = 0; gq < 2; ++gq) {
          const unsigned w = j < 32 ? selw[gq].x : (j < 64 ? selw[gq].y : (j < 96 ? selw[gq].z : selw[gq].w));
          const bool sel = (w >> (j & 31)) & 1u;
          if (__any(sel)) nsa_unit16(G[gq], stage + tt * 18432, qf[gq], sel, (j == qb) ? (tg[gq] - j * 64) : 1000, lane);
        }
      }
      if (sidx + 1 < nst) nsa_store_stage(sr, smem + ((sidx + 1) & 1) * NSA_STAGE);
      lds_barrier();
    }
#pragma unroll
    for (int gq = 0; gq < 2; ++gq) {
      float l = G[gq].l;
      l += xor16f(l, lane); l += xor32f(l, lane);
      const float sc = l > 0.f ? g_s[gq] / l : 0.f;
      bf16_t* dst = ONSA + ((size_t)it.b * SEQ + tg[gq]) * 512 + (it.g * 4 + r4) * 64 + 4 * kg;
      if (!dry) {
#pragma unroll
        for (int dt = 0; dt < 4; ++dt) {
          u32x2* pp = (u32x2*)(dst + dt * 16);
          const u32x2 old = *pp;
          u32x2 wv; wv.x = pack2(bflo(old.x) + sc * G[gq].o[dt][0], bfhi(old.x) + sc * G[gq].o[dt][1]);
          wv.y = pack2(bflo(old.y) + sc * G[gq].o[dt][2], bfhi(old.y) + sc * G[gq].o[dt][3]);
          *pp = wv;
        }
      } else asm volatile("" :: "v"(G[gq].o[0]), "v"(G[gq].o[1]), "v"(G[gq].o[2]), "v"(G[gq].o[3]), "v"(l));
    }
  }
}

DI void phase_nsa(const Params& p, char* smem, int branch_mask) {
  char* ws = p.ws;
  const int tid = otid(), lane = tid & 63, wave = tid >> 6, hh = lane >> 5, c = lane & 31, qi = c >> 2, r4 = c & 3;
  const bf16_t* Q = (const bf16_t*)(ws + OFF_Q);
  const float* gsig = (const float*)(ws + OFF_GSIG);
  bf16_t* ONSA = (bf16_t*)(ws + OFF_ONSA);
  u32x4* SELG = (u32x4*)(ws + OFF_SELG);
  constexpr int NITEM = NB * 2 * 128;

#pragma unroll 1
  for (int rep1 = 0; rep1 < ((PROBE_DUP & 4096) ? 2 : 1); ++rep1) {
    const bf16_t* KCMP = (const bf16_t*)(ws + OFF_KCMP); const bf16_t* VCMP = (const bf16_t*)(ws + OFF_VCMP);
    float* Aimp = (float*)(smem + NSA_AIMP) + wave * 1024;
    float* Cimp = (float*)(smem + NSA_CIMP) + wave * 1024;
    unsigned short* selm16 = (unsigned short*)(smem + NSA_SELM) + wave * 64;
    const u32x4* selm128 = (const u32x4*)(smem + NSA_SELM) + wave * 8;
    for (int item = blockIdx.x; item < NITEM; item += gridDim.x) {
      const NsaItem it = nsa_item(item, wave, qi);
      const int t = it.t;
      bf16x8 qf[4];
#pragma unroll
      for (int ks = 0; ks < 4; ++ks) qf[ks] = *(const bf16x8*)(Q + it.tokrow * 512 + (it.g * 4 + r4) * 64 + ks * 16 + hh * 8);
      const float g_c = gsig[it.tokrow * 32 + (it.g * 4 + r4) * 3 + 0];
      TileRegs tr;
      const int nmax = (it.qb * 64 + 63 - 31) >> 4, ntile = (nmax >> 6) + 1;
      const int nfull = (it.qb * 64 - 31) >> 4;
      const bf16_t* kb = KCMP + (size_t)it.bg * 512 * 64;
      const bf16_t* vb = VCMP + (size_t)it.bg * 512 * 64;
      float m = -1e30f, l = 0.f;
      nsa_load_tile(tr, kb, 64, vb, 64);
      nsa_store_tile(tr, smem);
      __syncthreads();
      for (int j = 0; j < ntile; ++j) {
        const char* tile = smem + (j & 1) * NSA_TILE;
        if (j + 1 < ntile) nsa_load_tile(tr, kb + (size_t)(j + 1) * 64 * 64, 64, vb + (size_t)(j + 1) * 64 * 64, 64);
        f32x16 st[2];
        nsa_scores(st, tile, qf, lane);
        const bool full = (j * 64 + 63 <= nfull);
        const int nlim = full ? 100000 : ((t - 31) >> 4) - j * 64 - 4 * hh;
        float mx = NSA_NEG;
#pragma unroll
        for (int kt = 0; kt < 2; ++kt)
#pragma unroll
          for (int r = 0; r < 16; ++r) {
            st[kt][r] = (kt * 32 + (r & 3) + 8 * (r >> 2) <= nlim) ? st[kt][r] : NSA_NEG;
            mx = fmaxf(mx, st[kt][r]);
          }
        mx = fmaxf(mx, xor32f(mx, lane));
        const float mn = fmaxf(m, mx);
        float sum = 0.f;
#pragma unroll
        for (int kt = 0; kt < 2; ++kt)
#pragma unroll
          for (int r = 0; r < 16; ++r) sum += __builtin_amdgcn_exp2f(st[kt][r] - mn);
        l = l * __builtin_amdgcn_exp2f(m - mn) + sum;
        m = mn;
        if (j + 1 < ntile) nsa_store_tile(tr, smem + ((j + 1) & 1) * NSA_TILE);
        __syncthreads();
      }
      l += xor32f(l, lane);
      const float inv_l = l > 0.f ? 1.0f / l : 0.f;
      f32x16 o[2];
#pragma unroll
      for (int r = 0; r < 16; ++r) { o[0][r] = 0.f; o[1][r] = 0.f; }
      nsa_load_tile(tr, kb, 64, vb, 64);
      nsa_store_tile(tr, smem);
      __syncthreads();
      for (int j = 0; j < ntile; ++j) {
        const char* tile = smem + (j & 1) * NSA_TILE;
        if (j + 1 < ntile) nsa_load_tile(tr, kb + (size_t)(j + 1) * 64 * 64, 64, vb + (size_t)(j + 1) * 64 * 64, 64);
        f32x16 st[2];
        nsa_scores(st, tile, qf, lane);
        const bool full = (j * 64 + 63 <= nfull);
        const int nlim = full ? 100000 : ((t - 31) >> 4) - j * 64 - 4 * hh;
#pragma unroll
        for (int kt = 0; kt < 2; ++kt)
#pragma unroll
          for (int r = 0; r < 16; ++r) {
            const float arg = (kt * 32 + (r & 3) + 8 * (r >> 2) <= nlim) ? st[kt][r] - m : NSA_NEG;
            st[kt][r] = __builtin_amdgcn_exp2f(arg) * inv_l;
          }
#pragma unroll
        for (int kt = 0; kt < 2; ++kt)
#pragma unroll
          for (int c4 = 0; c4 < 4; ++c4) {
            float carry = 0.5f * st[kt][4 * c4 + 3];
            float fullv = st[kt][4 * c4] + st[kt][4 * c4 + 1] + st[kt][4 * c4 + 2] + carry;
            fullv += xor1f(fullv); fullv += xor2f(fullv);
            carry += xor1f(carry); carry += xor2f(carry);
            const int jb = j * 16 + kt * 8 + 2 * c4 + hh;
            if (r4 == 0) { Aimp[qi * 128 + jb] = fullv; Cimp[qi * 128 + jb] = carry; }
          }
        if (branch_mask & 1) nsa_pv(o, st, tile, lane);
        if (j + 1 < ntile) nsa_store_tile(tr, smem + ((j + 1) & 1) * NSA_TILE);
        __syncthreads();
      }
      nsa_accum_store(ONSA + it.tokrow * 512 + (it.g * 4 + r4) * 64, o, (branch_mask & 1) ? g_c : 0.f, true, hh);
      const int cur = it.qb;
      if (cur <= 15) {
        if (lane < 8) { selm16[lane * 8 + 0] = (unsigned short)((2u << cur) - 1u);
#pragma unroll
          for (int k = 1; k < 8; ++k) selm16[lane * 8 + k] = 0; }
      } else {
        const int qs = lane >> 3, sub = lane & 7;
        float v[16];
#pragma unroll
        for (int i = 0; i < 16; ++i) {
          const int jj = sub * 16 + i;
          const bool ok = (jj >= 1) && (jj <= cur - 2);
          const int jm = jj >= 1 ? jj - 1 : 0;
          v[i] = ok ? (Aimp[qs * 128 + jj] + Cimp[qs * 128 + jm]) : -3e38f;
        }
        unsigned bits = 0;
        for (int itn = 0; itn < 13; ++itn) {
          float bv = v[0]; int bi = 0;
#pragma unroll
          for (int i = 1; i < 16; ++i) if (v[i] > bv) { bv = v[i]; bi = i; }
          int bj = sub * 16 + bi;
#pragma unroll
          for (int o2 = 1; o2 < 8; o2 <<= 1) {
            const float ov = __shfl_xor(bv, o2); const int oj = __shfl_xor(bj, o2);
            if (ov > bv || (ov == bv && oj < bj)) { bv = ov; bj = oj; }
          }
          if ((bj >> 4) == sub) {
            const int i2 = bj & 15;
#pragma unroll
            for (int i = 0; i < 16; ++i) if (i == i2) v[i] = -3e38f;
            bits |= 1u << i2;
          }
        }
        if (sub == 0) bits |= 1u;
        if ((cur >> 4) == sub) bits |= 1u << (cur & 15);
        if (((cur - 1) >> 4) == sub) bits |= 1u << ((cur - 1) & 15);
        selm16[qs * 8 + sub] = (unsigned short)bits;
      }
      __syncthreads();
      if (r4 == 0 && hh == 0) SELG[(size_t)it.bg * SEQ + t] = selm128[qi];
    }
  }
  __threadfence_block();
  __syncthreads();

#pragma unroll 1
  for (int sweep_i = 0; sweep_i < 2 + ((PROBE_DUP & 1024) ? 1 : 0) + ((PROBE_DUP & 2048) ? 1 : 0); ++sweep_i) {
    const int sweep = (sweep_i < 2) ? sweep_i : (((PROBE_DUP & 1024) && sweep_i == 2) ? 0 : 1);
    const bool dry = sweep_i >= 2;
    if (!(branch_mask & (sweep == 0 ? 2 : 4))) continue;
    if (sweep == 0) { nsa_sel16(p, smem, dry); continue; }
    const bf16_t* KB = (const bf16_t*)(ws + (sweep == 0 ? OFF_KS : OFF_KW)); const bf16_t* VB = (const bf16_t*)(ws + (sweep == 0 ? OFF_VS : OFF_VW));
    for (int item = blockIdx.x; item < NITEM; item += gridDim.x) {
      const NsaItem it = nsa_item(item, wave, qi);
      const int t = it.t, qb = it.qb;
      bf16x8 qf[4];
#pragma unroll
      for (int ks = 0; ks < 4; ++ks) qf[ks] = *(const bf16x8*)(Q + it.tokrow * 512 + (it.g * 4 + r4) * 64 + ks * 16 + hh * 8);
      const float g_b = gsig[it.tokrow * 32 + (it.g * 4 + r4) * 3 + 1 + sweep];
      u32x4 selw = {0xffffffffu, 0xffffffffu, 0xffffffffu, 0xffffffffu};
      if (sweep == 0) selw = SELG[(size_t)it.bg * SEQ + t];
      TileRegs tr;
      const bf16_t* kb = KB + (size_t)it.b * SEQ * 128 + it.g * 64;
      const bf16_t* vb = VB + (size_t)it.b * SEQ * 128 + it.g * 64;
      float m = -1e30f, l = 0.f;
      f32x16 o[2];
#pragma unroll
      for (int r = 0; r < 16; ++r) { o[0][r] = 0.f; o[1][r] = 0.f; }
      const int j0 = (sweep == 1 && qb >= 8) ? qb - 8 : 0;
      __syncthreads();
      nsa_load_tile(tr, kb + (size_t)j0 * 64 * 128, 128, vb + (size_t)j0 * 64 * 128, 128);
      nsa_store_tile(tr, smem);
      if (j0 + 1 <= qb) { nsa_load_tile(tr, kb + (size_t)(j0 + 1) * 64 * 128, 128, vb + (size_t)(j0 + 1) * 64 * 128, 128); nsa_store_tile(tr, smem + NSA_TILE); }
      if (j0 + 2 <= qb) nsa_load_tile(tr, kb + (size_t)(j0 + 2) * 64 * 128, 128, vb + (size_t)(j0 + 2) * 64 * 128, 128);
      __syncthreads();
      const bool late = wave >= 4;
      if (__builtin_amdgcn_readfirstlane(wave) >= 4) __builtin_amdgcn_s_setprio(1);
      bool has = false;
      m = 0.f;
      f32x16 st[2];
      {
        const unsigned w0 = j0 < 32 ? selw.x : (j0 < 64 ? selw.y : (j0 < 96 ? selw.z : selw.w));
        const float ini = ((w0 >> (j0 & 31)) & 1u) ? 0.f : -1e30f;
#pragma unroll
        for (int r = 0; r < 16; ++r) { st[0][r] = ini; st[1][r] = ini; }
        const bf16_t* Kc = (const bf16_t*)smem;
#pragma unroll
        for (int ks = 0; ks < 4; ++ks)
#pragma unroll
          for (int kt = 0; kt < 2; ++kt) st[kt] = MFMA32(*(const bf16x8*)(Kc + (kt * 32 + (lane & 31)) * LK + ks * 16 + (lane >> 5) * 8), qf[ks], st[kt]);
      }
      int bi = 0;
      for (int j = j0; j <= qb; ++j) {
        const char* tile = smem + bi * NSA_TILE;
        const int bn = bi == 2 ? 0 : bi + 1, bnn = bn == 2 ? 0 : bn + 1;
        const int jn = j + 1;
        const unsigned wn = jn < 32 ? selw.x : (jn < 64 ? selw.y : (jn < 96 ? selw.z : selw.w));
        const bool seln = (wn >> (jn & 31)) & 1u;
        const bf16_t* Kn = (const bf16_t*)(smem + bn * NSA_TILE) + (lane & 31) * LK + (lane >> 5) * 8;
        f32x16 sn[2];
        if (!late) {
          const float ini = seln ? -m : -1e30f;
#pragma unroll
          for (int r = 0; r < 16; ++r) { sn[0][r] = ini; sn[1][r] = ini; }
#pragma unroll
          for (int ks = 0; ks < 4; ++ks)
#pragma unroll
            for (int kt = 0; kt < 2; ++kt) sn[kt] = MFMA32(*(const bf16x8*)(Kn + kt * 32 * LK + ks * 16), qf[ks], sn[kt]);
        }
        if (j == qb || (sweep == 1 && j == qb - 8)) {
          const int khi = t - j * 64 - 4 * hh, klo = (sweep == 1) ? khi - 511 : -100000;
#pragma unroll
          for (int r = 0; r < 16; ++r) {
            const int o0 = (r & 3) + 8 * (r >> 2);
            st[0][r] = (o0 <= khi && o0 >= klo) ? st[0][r] : NSA_NEG;
            st[1][r] = (o0 + 32 <= khi && o0 + 32 >= klo) ? st[1][r] : NSA_NEG;
          }
        }
        float mx;
        {
          float a0, a1, a2, a3;
          asm("v_max3_f32 %0, %1, %2, %3" : "=v"(a0) : "v"(st[0][0]), "v"(st[0][1]), "v"(st[0][2]));
          asm("v_max3_f32 %0, %1, %2, %3" : "=v"(a1) : "v"(st[0][3]), "v"(st[0][4]), "v"(st[0][5]));
          asm("v_max3_f32 %0, %1, %2, %3" : "=v"(a2) : "v"(st[0][6]), "v"(st[0][7]), "v"(st[0][8]));
          asm("v_max3_f32 %0, %1, %2, %3" : "=v"(a3) : "v"(st[0][9]), "v"(st[0][10]), "v"(st[0][11]));
          asm("v_max3_f32 %0, %1, %2, %3" : "=v"(a0) : "v"(a0), "v"(st[0][12]), "v"(st[0][13]));
          asm("v_max3_f32 %0, %1, %2, %3" : "=v"(a1) : "v"(a1), "v"(st[0][14]), "v"(st[0][15]));
          asm("v_max3_f32 %0, %1, %2, %3" : "=v"(a2) : "v"(a2), "v"(st[1][0]), "v"(st[1][1]));
          asm("v_max3_f32 %0, %1, %2, %3" : "=v"(a3) : "v"(a3), "v"(st[1][2]), "v"(st[1][3]));
          asm("v_max3_f32 %0, %1, %2, %3" : "=v"(a0) : "v"(a0), "v"(st[1][4]), "v"(st[1][5]));
          asm("v_max3_f32 %0, %1, %2, %3" : "=v"(a1) : "v"(a1), "v"(st[1][6]), "v"(st[1][7]));
          asm("v_max3_f32 %0, %1, %2, %3" : "=v"(a2) : "v"(a2), "v"(st[1][8]), "v"(st[1][9]));
          asm("v_max3_f32 %0, %1, %2, %3" : "=v"(a3) : "v"(a3), "v"(st[1][10]), "v"(st[1][11]));
          asm("v_max3_f32 %0, %1, %2, %3" : "=v"(a0) : "v"(a0), "v"(st[1][12]), "v"(st[1][13]));
          asm("v_max3_f32 %0, %1, %2, %3" : "=v"(a1) : "v"(a1), "v"(st[1][14]), "v"(st[1][15]));
          asm("v_max3_f32 %0, %1, %2, %3" : "=v"(a0) : "v"(a0), "v"(a1), "v"(a2));
          const float other = a3;
          asm("v_max_f32 %0, %1, %2" : "=v"(mx) : "v"(a0), "v"(other));
          const float px = xor32f(mx, lane);
          asm("v_max_f32 %0, %1, %2" : "=v"(mx) : "v"(mx), "v"(px));
        }
        const bool real = mx > -1e29f;
        const bool fresh = !has && real, up = has && (mx > NSA_THR);
        if (__any(fresh || up)) {
          const float delta = (fresh || up) ? mx : 0.f;
          const float alpha = up ? __builtin_amdgcn_exp2f(-delta) : 1.0f;
          m += delta; l *= alpha;
#pragma unroll
          for (int r = 0; r < 16; ++r) { o[0][r] *= alpha; o[1][r] *= alpha; st[0][r] -= delta; st[1][r] -= delta; }
          if (!late) {
            const float dn = seln ? delta : 0.f;
#pragma unroll
            for (int r = 0; r < 16; ++r) { sn[0][r] -= dn; sn[1][r] -= dn; }
          }
        }
        has = has || real;
        f32x2 s2 = {0.f, 0.f};
#pragma unroll
        for (int r = 0; r < 16; ++r) {
          const float p0 = __builtin_amdgcn_exp2f(st[0][r]), p1 = __builtin_amdgcn_exp2f(st[1][r]);
          st[0][r] = p0; st[1][r] = p1; s2 += (f32x2){p0, p1};
        }
        l += s2.x + s2.y;
        nsa_pv(o, st, tile, lane);
        if (late) {
          const float ini = seln ? -m : -1e30f;
#pragma unroll
          for (int r = 0; r < 16; ++r) { sn[0][r] = ini; sn[1][r] = ini; }
#pragma unroll
          for (int ks = 0; ks < 4; ++ks)
#pragma unroll
            for (int kt = 0; kt < 2; ++kt) sn[kt] = MFMA32(*(const bf16x8*)(Kn + kt * 32 * LK + ks * 16), qf[ks], sn[kt]);
        }
        if (j + 2 <= qb) nsa_store_tile(tr, smem + bnn * NSA_TILE);
        if (j + 3 <= qb) nsa_load_tile(tr, kb + (size_t)(j + 3) * 64 * 128, 128, vb + (size_t)(j + 3) * 64 * 128, 128);
#pragma unroll
        for (int r = 0; r < 16; ++r) { st[0][r] = sn[0][r]; st[1][r] = sn[1][r]; }
        bi = bn;
        __syncthreads();
      }
      __builtin_amdgcn_s_setprio(0);
      l += xor32f(l, lane);
      if (!dry) nsa_accum_store(ONSA + it.tokrow * 512 + (it.g * 4 + r4) * 64, o, l > 0.f ? g_b / l : 0.f, false, hh, (unsigned char*)(ws + OFF_ONSA8) + it.tokrow * 512 + (it.g * 4 + r4) * 64);
      else asm volatile("" :: "v"(o[0]), "v"(o[1]), "v"(l));
    }
  }
}

DI unsigned ord_key(float f) { const unsigned u = __float_as_uint(f); return (u & 0x80000000u) ? ~u : (u | 0x80000000u); }
DI float ord_val(unsigned k) { return __uint_as_float((k & 0x80000000u) ? (k & 0x7fffffffu) : ~k); }
DI void cex(unsigned& hi, unsigned& lo) { const unsigned x = hi, y = lo; hi = x > y ? x : y; lo = x > y ? y : x; }
DI void sort16_desc(unsigned (&a)[16]) {
#pragma unroll
  for (int k = 2; k <= 16; k <<= 1)
#pragma unroll
    for (int j = k >> 1; j > 0; j >>= 1)
#pragma unroll
      for (int i = 0; i < 16; ++i) {
        const int l = i ^ j;
        if (l > i) { if ((i & k) == 0) cex(a[i], a[l]); else cex(a[l], a[i]); }
      }
}
DI void bitonic_finish16(unsigned (&a)[16]) {
#pragma unroll
  for (int j = 8; j > 0; j >>= 1)
#pragma unroll
    for (int i = 0; i < 16; ++i) { const int l = i ^ j; if (l > i) cex(a[i], a[l]); }
}
DI void merge_top16(unsigned (&a)[16], const unsigned (&b)[16]) {
#pragma unroll
  for (int i = 0; i < 16; ++i) a[i] = a[i] > b[15 - i] ? a[i] : b[15 - i];
  bitonic_finish16(a);
}
DI void merge_partner16(unsigned (&a)[16]) {
  unsigned b[16];
#pragma unroll
  for (int i = 0; i < 16; ++i) b[i] = xor32u(a[i], otid());
  merge_top16(a, b);
}


constexpr int KLD = 136;
DI void peer_top16(unsigned (&top)[16], const bf16x8 (&bq)[8], const bf16_t* keys  , int lane) {
  const int l31 = lane & 31, hh = lane >> 5;
  unsigned grp[16];
#pragma unroll
  for (int nt = 0; nt < 4; ++nt) {
    f32x16 sa;
#pragma unroll
    for (int r = 0; r < 16; ++r) sa[r] = 0.f;
    const bf16_t* kp = keys + (nt * 32 + l31) * KLD + hh * 8;
#pragma unroll
    for (int ks = 0; ks < 8; ++ks) { const bf16x8 a = *(const bf16x8*)(kp + ks * 16); sa = MFMA32(a, bq[ks], sa); }
#pragma unroll
    for (int r = 0; r < 16; ++r) {
      const int n = nt * 32 + (r & 3) + 8 * (r >> 2) + 4 * hh;
      grp[r] = (ord_key(sa[r]) & ~0x7Fu) | (unsigned)(127 - n);
    }
    sort16_desc(grp);
    if (nt == 0) {
#pragma unroll
      for (int i = 0; i < 16; ++i) top[i] = grp[i];
    } else merge_top16(top, grp);
  }
  merge_partner16(top);
}

DI void phase_route(const Params& p, char* smem) {
  char* ws = p.ws;
  const int tid = otid(), lane = tid & 63, wave = tid >> 6, l31 = lane & 31, hh = lane >> 5;
  const bf16_t* pq = (const bf16_t*)(ws + OFF_PQ);
  const bf16_t* pk = (const bf16_t*)(ws + OFF_PKEYS);
  int* eidx = (int*)(ws + OFF_EIDX);
  float* pgate = (float*)(ws + OFF_PGATE);
  bf16_t* KL = (bf16_t*)smem;
  unsigned* LS = (unsigned*)(smem + 2 * 128 * KLD * 2) + wave * 1024;
  {
    const int h0 = blockIdx.x & 7;
    __syncthreads();
#pragma unroll
    for (int i = 0; i < 8; ++i) {
      const int idx = tid + i * NT, row = idx >> 4, ch = idx & 15;
      *(u32x4*)(KL + row * KLD + ch * 8) = *(const u32x4*)(pk + ((size_t)h0 * 256 + row) * 128 + ch * 8);
    }
    __syncthreads();
  }
  constexpr int CA[64] = {0,0,0,0,0,0,0,0,0,0,0,0,0,0,0,0, 1,1,1,1,1,1,1,1, 2,2,2,2,2, 3,3,3,3, 4,4,4, 5,5, 6,6, 7,7, 8,9,10,11,12,13,14,15, 0,0,0,0,0,0,0,0,0,0,0,0,0,0};
  constexpr int CB[64] = {0,1,2,3,4,5,6,7,8,9,10,11,12,13,14,15, 0,1,2,3,4,5,6,7, 0,1,2,3,4, 0,1,2,3, 0,1,2, 0,1, 0,1, 0,1, 0,0,0,0,0,0,0,0, 0,0,0,0,0,0,0,0,0,0,0,0,0,0};
  for (int item = blockIdx.x; item < (NTOK / 256) * 8; item += gridDim.x) {
    const int h = item & 7, t0 = (item >> 3) * 256 + wave * 32;
    unsigned s1[16], s2[16];
    const bf16_t* pqrow = pq + (size_t)(t0 + l31) * 2048 + h * 256 + hh * 8;
    bf16x8 bq1[8], bq2[8];
#pragma unroll
    for (int ks = 0; ks < 8; ++ks) { bq1[ks] = *(const bf16x8*)(pqrow + ks * 16); bq2[ks] = *(const bf16x8*)(pqrow + 128 + ks * 16); }
    peer_top16(s1, bq1, KL, lane);
    peer_top16(s2, bq2, KL + 128 * KLD, lane);
    float f1[16], f2[16];
#pragma unroll
    for (int i = 0; i < 16; ++i) { f1[i] = ord_val(s1[i]); f2[i] = ord_val(s2[i]); }
    unsigned ca[16], cb2[16];
#pragma unroll
    for (int i = 0; i < 32; ++i) {
      const int i0 = i, i1 = 25 + i;
      unsigned k0 = 0u, k1 = 0u;
      if (i0 < 25) k0 = (ord_key(f1[CA[i0]] + f2[CB[i0]]) & ~0xFFu) | (unsigned)(255 - (CA[i0] * 16 + CB[i0]));
      if (i1 < 50) k1 = (ord_key(f1[CA[i1]] + f2[CB[i1]]) & ~0xFFu) | (unsigned)(255 - (CA[i1] * 16 + CB[i1]));
      const unsigned kk = hh ? k1 : k0;
      if (i < 16) ca[i] = kk; else cb2[i - 16] = kk;
    }
    sort16_desc(ca); sort16_desc(cb2);
    merge_top16(ca, cb2);
    merge_partner16(ca);
    if (hh == 0) {
#pragma unroll
      for (int i = 0; i < 16; ++i) { LS[l31 * 32 + i] = s1[i]; LS[l31 * 32 + 16 + i] = s2[i]; }
    }
    const float mx = ord_val(ca[0]);
    float ex[16], sum = 0.f;
#pragma unroll
    for (int i = 0; i < 16; ++i) { ex[i] = __expf(ord_val(ca[i]) - mx); sum += ex[i]; }
    const float inv = 1.0f / sum;
    int eo[16]; float go[16];
#pragma unroll
    for (int i = 0; i < 16; ++i) {
      const int flat = 255 - (int)(ca[i] & 0xFFu);
      const unsigned k1 = LS[l31 * 32 + (flat >> 4)], k2 = LS[l31 * 32 + 16 + (flat & 15)];
      eo[i] = (127 - (int)(k1 & 0x7Fu)) * 128 + (127 - (int)(k2 & 0x7Fu));
      go[i] = ex[i] * inv;
    }
    const size_t ob = ((size_t)(t0 + l31) * 8 + h) * 16;
    if (hh == 0) {
      *(u32x4*)(eidx + ob) = (u32x4){(unsigned)eo[0], (unsigned)eo[1], (unsigned)eo[2], (unsigned)eo[3]};
      *(u32x4*)(eidx + ob + 4) = (u32x4){(unsigned)eo[4], (unsigned)eo[5], (unsigned)eo[6], (unsigned)eo[7]};
      *(f32x4*)(pgate + ob) = (f32x4){go[0], go[1], go[2], go[3]};
      *(f32x4*)(pgate + ob + 4) = (f32x4){go[4], go[5], go[6], go[7]};
    } else {
      *(u32x4*)(eidx + ob + 8) = (u32x4){(unsigned)eo[8], (unsigned)eo[9], (unsigned)eo[10], (unsigned)eo[11]};
      *(u32x4*)(eidx + ob + 12) = (u32x4){(unsigned)eo[12], (unsigned)eo[13], (unsigned)eo[14], (unsigned)eo[15]};
      *(f32x4*)(pgate + ob + 8) = (f32x4){go[8], go[9], go[10], go[11]};
      *(f32x4*)(pgate + ob + 12) = (f32x4){go[12], go[13], go[14], go[15]};
    }
  }
}

#define FOR32(M) M(0) M(1) M(2) M(3) M(4) M(5) M(6) M(7) M(8) M(9) M(10) M(11) M(12) M(13) M(14) M(15) M(16) M(17) M(18) M(19) M(20) M(21) M(22) M(23) M(24) M(25) M(26) M(27) M(28) M(29) M(30) M(31)
#define FOR16(M) M(0) M(1) M(2) M(3) M(4) M(5) M(6) M(7) M(8) M(9) M(10) M(11) M(12) M(13) M(14) M(15)
DI void phase_ffn_u(const Params& p) {
  char* ws = p.ws;
  const int lane = otid() & 63, wave = otid() >> 6, pg = lane >> 3, dc = lane & 7;
  const int sl = blockIdx.x & 7, wslot = (blockIdx.x >> 3) * NW + wave, nw = (gridDim.x >> 3) * NW;
  const unsigned char* PU8 = (const unsigned char*)(ws + OFF_PU8) + (size_t)sl * 16384 * 128 + dc * 16;
  const unsigned char* h2q = (const unsigned char*)(ws + OFF_H2Q) + sl * 128 + dc * 16;
  const int* eidx = (const int*)(ws + OFF_EIDX);
  float* part = (float*)(ws + OFF_PART) + (size_t)sl * NTOK * 128;
  const int j0 = (dc >> 2) * 64 + ((2 * dc) & 7) * 8 + pg;
  int ev0 = 0, ev1 = 0, nev0 = 0, nev1 = 0; u32x4 hq = {0u, 0u, 0u, 0u}, nhq = hq;
  if (wslot < NTOK) { ev0 = eidx[(size_t)wslot * 128 + lane]; ev1 = eidx[(size_t)wslot * 128 + 64 + lane]; hq = *(const u32x4*)(h2q + (size_t)wslot * DM); }
  for (int t = wslot; t < NTOK; t += nw) {
    if (t + nw < NTOK) { const size_t o = (size_t)(t + nw) * 128; nev0 = eidx[o + lane]; nev1 = eidx[o + 64 + lane]; nhq = *(const u32x4*)(h2q + (size_t)(t + nw) * DM); }
#define FFU_LD(it) const u32x4 ru##it = *(const u32x4*)(PU8 + (size_t)__shfl((it) < 8 ? ev0 : ev1, ((it) & 7) * 8 + pg) * 128);
    FOR16(FFU_LD)
    int d[16];
#define FFU_CP(it) { int a_ = __builtin_amdgcn_sdot4((int)ru##it.x, (int)hq.x, 0, false); a_ = __builtin_amdgcn_sdot4((int)ru##it.y, (int)hq.y, a_, false); \
      a_ = __builtin_amdgcn_sdot4((int)ru##it.z, (int)hq.z, a_, false); d[it] = __builtin_amdgcn_sdot4((int)ru##it.w, (int)hq.w, a_, false); }
    FOR16(FFU_CP)
    int r8[8], r4[4], r2[2];
    { const bool hi = dc & 4;
#pragma unroll
      for (int i = 0; i < 8; ++i) { const int keep = hi ? d[8 + i] : d[i], send = hi ? d[i] : d[8 + i]; r8[i] = keep + __shfl_xor(send, 4); } }
    { const bool hi = dc & 2;
#pragma unroll
      for (int i = 0; i < 4; ++i) { const int keep = hi ? r8[4 + i] : r8[i], send = hi ? r8[i] : r8[4 + i]; r4[i] = keep + __float_as_int(xor2f(__int_as_float(send))); } }
    { const bool hi = dc & 1;
#pragma unroll
      for (int i = 0; i < 2; ++i) { const int keep = hi ? r4[2 + i] : r4[i], send = hi ? r4[i] : r4[2 + i]; r2[i] = keep + __float_as_int(xor1f(__int_as_float(send))); } }
    part[(size_t)t * 128 + j0] = (float)r2[0];
    part[(size_t)t * 128 + j0 + 8] = (float)r2[1];
    ev0 = nev0; ev1 = nev1; hq = nhq;
  }
}
DI void phase_ffn_w(const Params& p) {
  char* ws = p.ws;
  const int lane = otid() & 63, wave = otid() >> 6;
  const float* part = (const float*)(ws + OFF_PART);
  const float* scu = (const float*)(ws + OFF_SCU); const float* scv = (const float*)(ws + OFF_SCV);
  const int* eidx = (const int*)(ws + OFF_EIDX);
  const float* pgate = (const float*)(ws + OFF_PGATE);
  float* wbuf = (float*)(ws + OFF_WBUF);
  for (int grp = blockIdx.x; grp < NTOK / NW; grp += gridDim.x) {
    const size_t o = (size_t)(grp * NW + wave) * 128 + lane;
    float a0 = 0.f, a1 = 0.f;
#pragma unroll
    for (int s8 = 0; s8 < 8; ++s8) { a0 += part[(size_t)s8 * NTOK * 128 + o]; a1 += part[(size_t)s8 * NTOK * 128 + o + 64]; }
    const int e0 = eidx[o], e1 = eidx[o + 64];
    const float sht = ((const float*)(ws + OFF_SH))[grp * NW + wave];
    wbuf[o] = pgate[o] * gelu_f(a0 * (scu[e0] * sht)) * scv[e0];
    wbuf[o + 64] = pgate[o + 64] * gelu_f(a1 * (scu[e1] * sht)) * scv[e1];
  }
}
DI void phase_ffn_v(const Params& p) {
  char* ws = p.ws;
  const int lane = otid() & 63, wave = otid() >> 6, pg = lane >> 3, dc = lane & 7;
  const int sl = blockIdx.x & 7, wslot = (blockIdx.x >> 3) * NW + wave, nw = (gridDim.x >> 3) * NW;
  const unsigned char* PV8 = (const unsigned char*)(ws + OFF_PV8) + (size_t)sl * 16384 * 128 + dc * 16;
  const int* eidx = (const int*)(ws + OFF_EIDX) + 16 * pg;
  const float* wbuf = (const float*)(ws + OFF_WBUF) + 16 * pg;
  bf16_t* ffnb = (bf16_t*)(ws + OFF_FFNB);
  u32x4 ne0 = {0u, 0u, 0u, 0u}, ne1 = ne0, ne2 = ne0, ne3 = ne0;
  if (wslot < NTOK) { const int* ep = eidx + (size_t)wslot * 128; ne0 = *(const u32x4*)ep; ne1 = *(const u32x4*)(ep + 4); ne2 = *(const u32x4*)(ep + 8); ne3 = *(const u32x4*)(ep + 12); }
#pragma unroll 1
  for (int t = wslot; t < NTOK; t += nw) {
    const u32x4 ce0 = ne0, ce1 = ne1, ce2 = ne2, ce3 = ne3;
    if (t + nw < NTOK) { const int* ep = eidx + (size_t)(t + nw) * 128; ne0 = *(const u32x4*)ep; ne1 = *(const u32x4*)(ep + 4); ne2 = *(const u32x4*)(ep + 8); ne3 = *(const u32x4*)(ep + 12); }
    const float* wp = wbuf + (size_t)t * 128;
    const f32x4 wq0 = *(const f32x4*)wp, wq1 = *(const f32x4*)(wp + 4), wq2 = *(const f32x4*)(wp + 8), wq3 = *(const f32x4*)(wp + 12);
#define FFV_E(it) ((it) < 4 ? ce0[(it) & 3] : (it) < 8 ? ce1[(it) & 3] : (it) < 12 ? ce2[(it) & 3] : ce3[(it) & 3])
#define FFV_W(it) ((it) < 4 ? wq0[(it) & 3] : (it) < 8 ? wq1[(it) & 3] : (it) < 12 ? wq2[(it) & 3] : wq3[(it) & 3])
#define FFV_LD(it) const u32x4 rv##it = *(const u32x4*)(PV8 + (size_t)FFV_E(it) * 128);
#define FFV_CP(it) { const float wj = FFV_W(it); const f32x2 w2 = {wj, wj}; \
      acc2[0] += __builtin_amdgcn_cvt_pk_f32_fp8((int)rv##it.x, false) * w2; acc2[1] += __builtin_amdgcn_cvt_pk_f32_fp8((int)rv##it.x, true) * w2; \
      acc2[2] += __builtin_amdgcn_cvt_pk_f32_fp8((int)rv##it.y, false) * w2; acc2[3] += __builtin_amdgcn_cvt_pk_f32_fp8((int)rv##it.y, true) * w2; \
      acc2[4] += __builtin_amdgcn_cvt_pk_f32_fp8((int)rv##it.z, false) * w2; acc2[5] += __builtin_amdgcn_cvt_pk_f32_fp8((int)rv##it.z, true) * w2; \
      acc2[6] += __builtin_amdgcn_cvt_pk_f32_fp8((int)rv##it.w, false) * w2; acc2[7] += __builtin_amdgcn_cvt_pk_f32_fp8((int)rv##it.w, true) * w2; }
    FOR16(FFV_LD)
    f32x2 acc2[8];
#pragma unroll
    for (int i = 0; i < 8; ++i) acc2[i] = (f32x2){0.f, 0.f};
    FOR16(FFV_CP)
    float acc[16];
#pragma unroll
    for (int i = 0; i < 8; ++i) { acc[2 * i] = acc2[i].x; acc[2 * i + 1] = acc2[i].y; }
    float r8[8], r4[4], r2[2];
    { const bool hi = lane & 32;
#pragma unroll
      for (int i = 0; i < 8; ++i) { const float keep = hi ? acc[8 + i] : acc[i], send = hi ? acc[i] : acc[8 + i]; r8[i] = keep + xor32f(send, lane); } }
    { const bool hi = lane & 16;
#pragma unroll
      for (int i = 0; i < 4; ++i) { const float keep = hi ? r8[4 + i] : r8[i], send = hi ? r8[i] : r8[4 + i]; r4[i] = keep + xor16f(send, lane); } }
    { const bool hi = lane & 8;
#pragma unroll
      for (int i = 0; i < 2; ++i) { const float keep = hi ? r4[2 + i] : r4[i], send = hi ? r4[i] : r4[2 + i]; r2[i] = keep + xor8f(send); } }
    *(unsigned*)(ffnb + (size_t)t * DM + sl * 128 + dc * 16 + 2 * pg) = pack2(r2[0], r2[1]);
  }
}
DI void phase_final(const Params& p) {
  char* ws = p.ws;
  const int lane = otid() & 63, wave = otid() >> 6;
  const bf16_t* x1 = (const bf16_t*)(ws + OFF_X1);
  const bf16_t* ffnb = (const bf16_t*)(ws + OFF_FFNB);
  const float* mod = (const float*)(ws + OFF_MOD);
  for (int grp = blockIdx.x; grp < NTOK / NW; grp += gridDim.x) {
    const int row = grp * NW + wave, b = row >> 13;
    float v[16];
#pragma unroll
    for (int i = 0; i < 4; ++i) {
      const int col = i * 256 + lane * 4;
      const f32x4 gt2 = *(const f32x4*)(mod + b * 6144 + 5120 + col);
      const u32x2 xr = *(const u32x2*)(x1 + (size_t)row * DM + col), fr = *(const u32x2*)(ffnb + (size_t)row * DM + col);
      v[4 * i] = DN_ALPHA * bflo(xr.x) + gt2.x * bflo(fr.x); v[4 * i + 1] = DN_ALPHA * bfhi(xr.x) + gt2.y * bfhi(fr.x);
      v[4 * i + 2] = DN_ALPHA * bflo(xr.y) + gt2.z * bflo(fr.y); v[4 * i + 3] = DN_ALPHA * bfhi(xr.y) + gt2.w * bfhi(fr.y);
    }
    float mean, rstd; row_stats(v, mean, rstd);
#pragma unroll
    for (int i = 0; i < 4; ++i) {
      const int col = i * 256 + lane * 4;
      const f32x4 g = *(const f32x4*)(p.ln2_g + col), bb = *(const f32x4*)(p.ln2_b + col);
      f32x4 o;
      o.x = (v[4 * i] - mean) * rstd * g.x + bb.x; o.y = (v[4 * i + 1] - mean) * rstd * g.y + bb.y;
      o.z = (v[4 * i + 2] - mean) * rstd * g.z + bb.z; o.w = (v[4 * i + 3] - mean) * rstd * g.w + bb.w;
      *(f32x4*)(p.out + (size_t)row * DM + col) = o;
    }
  }
}

#define XB_TMO      128
#define XB_XCNT(j)  (256  + 64 * (j))
#define XB_XSUB(j)  (1280 + 64 * (j))
#define XB_XGEN(j)  (2304 + 64 * (j))
#define XB_TOP      3328
#define XB_TOPGEN   3392
#define XCD_BAR_WORDS 3456
#define XB_SPIN_CAP (1u << 22)
DI unsigned xb_ld(unsigned* p) { return __hip_atomic_load(p, __ATOMIC_RELAXED, __HIP_MEMORY_SCOPE_AGENT); }
DI unsigned xb_add(unsigned* p, unsigned v) { return __hip_atomic_fetch_add(p, v, __ATOMIC_RELAXED, __HIP_MEMORY_SCOPE_AGENT); }
DI unsigned xb_xcc_id() { return (unsigned)__builtin_amdgcn_s_getreg((3 << 11) | 20) & 0xFu; }
#define XB_SPIN(cond, bar) do { unsigned _sp = 0; while (cond) { __builtin_amdgcn_s_sleep(1); \
    if ((++_sp & 255u) == 0u) { if (xb_ld(&(bar)[XB_TMO])) break; if (_sp > XB_SPIN_CAP) { atomicAdd(&(bar)[XB_TMO], 1u); break; } } } } while (0)
struct XcdBarrier { unsigned* bar; unsigned x; volatile LAS unsigned* st; };
DI XcdBarrier xcd_barrier_post(unsigned* bar, volatile LAS unsigned* st) {
  XcdBarrier b; b.bar = bar; b.x = xb_xcc_id(); b.st = st;
  if (threadIdx.x == 0) (void)xb_add(&bar[XB_XCNT(b.x)], 1u);
  return b;
}
DI void xcd_barrier_complete(unsigned* bar, unsigned x, unsigned& nloc, unsigned& nx) {
  const unsigned G = gridDim.x * gridDim.y * gridDim.z;
  unsigned sum, cnt, mine, sp = 0u;
  for (;;) {
    sum = 0u; cnt = 0u; mine = 0u;
#pragma unroll
    for (unsigned j = 0; j < 16; ++j) { const unsigned c = xb_ld(&bar[XB_XCNT(j)]); sum += c; cnt += (c > 0u) ? 1u : 0u; mine = (j == x) ? c : mine; }
    if (sum == G) break;
    __builtin_amdgcn_s_sleep(1);
    if ((++sp & 255u) == 0u) { if (xb_ld(&bar[XB_TMO])) break; if (sp > XB_SPIN_CAP) { atomicAdd(&bar[XB_TMO], 1u); break; } }
  }
  nloc = mine > 0u ? mine : 1u; nx = cnt > 0u ? cnt : 1u;
}
DI void xcd_barrier(const XcdBarrier& b) {
  asm volatile("s_waitcnt vmcnt(0)" ::: "memory");
  __syncthreads();
  if (threadIdx.x == 0) {
    unsigned* bar = b.bar;
    __builtin_amdgcn_s_waitcnt(0);
    unsigned nloc = b.st[0], nx = b.st[1];
    if (nloc == 0u) { xcd_barrier_complete(bar, b.x, nloc, nx); b.st[0] = nloc; b.st[1] = nx; }
    const unsigned old = xb_add(&bar[XB_XSUB(b.x)], 1u);
    const unsigned gen = old / nloc;
    if (old + 1u == (gen + 1u) * nloc) {
      __builtin_amdgcn_fence(__ATOMIC_RELEASE, "agent");
      asm volatile("s_waitcnt vmcnt(0)" ::: "memory");
      const unsigned og = xb_add(&bar[XB_TOP], 1u);
      const unsigned tg = og / nx;
      if (og + 1u == (tg + 1u) * nx) xb_add(&bar[XB_TOPGEN], 1u);
      else XB_SPIN(xb_ld(&bar[XB_TOPGEN]) == tg, bar);
      __builtin_amdgcn_fence(__ATOMIC_ACQUIRE, "agent");
      xb_add(&bar[XB_XGEN(b.x)], 1u);
      asm volatile("s_waitcnt vmcnt(0)" ::: "memory");
    } else {
      XB_SPIN(xb_ld(&bar[XB_XGEN(b.x)]) == gen, bar);
      __builtin_amdgcn_fence(__ATOMIC_ACQUIRE, "agent");
      asm volatile("s_waitcnt vmcnt(0)" ::: "memory");
    }
  }
  __syncthreads();
}

constexpr int SMEM_BYTES = 147456 + 256;

__global__ void __launch_bounds__(NT, 2) k_mega(Params p) {
  __shared__ __attribute__((aligned(16))) char smem[SMEM_BYTES];
  cg::grid_group grid = cg::this_grid();
  if (threadIdx.x == 0) *(u32x4*)(smem + 147456) = (u32x4){0u, 0u, 0u, 0u};
  __syncthreads();
  const XcdBarrier xb = xcd_barrier_post((unsigned*)(p.ws + OFF_BAR), (volatile LAS unsigned*)(smem + 147456));
#define REP(mask) _Pragma("unroll 1") for (int rep_ = 0; rep_ < ((PROBE_DUP & (mask)) ? 2 : 1); ++rep_)
  REP(1) phase_prep(p, smem);
  grid.sync();
  REP(1) phase_ln_in(p);
  xcd_barrier(xb);
  REP(2) phase_gemm1(p, smem);
  xcd_barrier(xb);
  REP(4) phase_compress(p, smem);
  phase_sgu(p, smem);
  xcd_barrier(xb);
  REP(8) phase_nsa(p, smem, NSA_MASK);
  xcd_barrier(xb);
  REP(16) phase_merge(p, smem);
  xcd_barrier(xb);
  REP(16) phase_outproj(p, smem);
  xcd_barrier(xb);
  REP(1) phase_ln_mid(p);
  xcd_barrier(xb);
  REP(32) phase_peerq(p, smem);
  xcd_barrier(xb);
  REP(64) phase_route(p, smem);
  xcd_barrier(xb);
  REP(128) phase_ffn_u(p);
  xcd_barrier(xb);
  REP(128) phase_ffn_w(p);
  xcd_barrier(xb);
  REP(256) phase_ffn_v(p);
  xcd_barrier(xb);
  REP(512) phase_final(p);
}

extern "C" void kernel_launch(void* const* d_in, const int* in_sizes, int n_in, void* d_out, int out_size, void* d_ws, size_t ws_size, hipStream_t stream) {
  if (ws_size < OFF_END) { fprintf(stderr, "workspace too small: %zu < %zu\n", ws_size, (size_t)OFF_END); return; }
  static int grid_blocks = 0;
  if (!grid_blocks) {
    int dev = 0, cus = 0, per_cu = 0;
    (void)hipGetDevice(&dev);
    (void)hipDeviceGetAttribute(&cus, hipDeviceAttributeMultiprocessorCount, dev);
    (void)hipOccupancyMaxActiveBlocksPerMultiprocessor(&per_cu, k_mega, NT, 0);
    if (per_cu < 1) fprintf(stderr, "occupancy query returned %d\n", per_cu);
    grid_blocks = (cus / 8) * 8;
  }
  Params p{};
  const float** fp = (const float**)&p;
  for (int i = 0; i < 26; ++i) fp[i] = (const float*)d_in[i];
  p.out = (float*)d_out;
  p.ws = (char*)d_ws;
  for (int i = 0; i < 32; ++i) p.inv_freq[i] = (float)pow(10000.0, -(double)i / 32.0);
  (void)hipMemsetAsync((char*)d_ws + OFF_BAR, 0, XCD_BAR_WORDS * 4, stream);
  void* args[] = {&p};
  hipError_t e = hipLaunchCooperativeKernel((void*)k_mega, dim3(grid_blocks), dim3(NT), args, 0, stream);
  if (e != hipSuccess) fprintf(stderr, "cooperative launch failed: %s (grid %d)\n", hipGetErrorString(e), grid_blocks);
}
```

```cpp
#include <hip/hip_runtime.h>
#include <hip/hip_cooperative_groups.h>
#include <stdint.h>
#include <stdio.h>
#include <math.h>
namespace cg = cooperative_groups;

#ifndef PROBE_DUP
#define PROBE_DUP 0
#endif
#ifndef NSA_MASK
#define NSA_MASK 7
#endif
typedef unsigned short bf16_t;
typedef short bf16x8 __attribute__((ext_vector_type(8)));
typedef short s16x4 __attribute__((ext_vector_type(4)));
typedef float f32x16 __attribute__((ext_vector_type(16)));
typedef float f32x4 __attribute__((ext_vector_type(4)));
typedef float f32x2 __attribute__((ext_vector_type(2)));
typedef __bf16 bf16v2 __attribute__((ext_vector_type(2)));
typedef unsigned u32x4 __attribute__((ext_vector_type(4)));
typedef int i32x4 __attribute__((ext_vector_type(4)));
typedef int i32x8 __attribute__((ext_vector_type(8)));
typedef unsigned u32x2 __attribute__((ext_vector_type(2)));
#define DI __device__ __forceinline__
#define LAS __attribute__((address_space(3)))
#define MFMA32(a, b, c) __builtin_amdgcn_mfma_f32_32x32x16_bf16((a), (b), (c), 0, 0, 0)

constexpr int NT = 512, NW = 8;
constexpr int NB = 8, SEQ = 8192, DM = 1024, NTOK = NB * SEQ;
constexpr int N1 = 4608;
constexpr float DN_ALPHA = 1.189207115002721f;
constexpr float LN_EPS = 1e-5f;

constexpr size_t MB = 1024 * 1024;
constexpr size_t OFF_MOD = 0;
constexpr size_t OFF_ROPE = OFF_MOD + 256 * 1024;
constexpr size_t OFF_POSB = OFF_ROPE + 2 * MB;
constexpr size_t OFF_WT1 = OFF_POSB + 4096;
constexpr size_t OFF_WB = OFF_WT1 + (size_t)N1 * 1024 * 2;
constexpr size_t OFF_WOUT = OFF_WB + 2 * MB;
constexpr size_t OFF_WQ = OFF_WOUT + 2 * MB;
constexpr size_t OFF_PKEYS = OFF_WQ + 4 * MB;
constexpr size_t OFF_CW1 = OFF_PKEYS + MB / 2;
constexpr size_t OFF_CW2 = OFF_CW1 + MB;
constexpr size_t OFF_SGUW = OFF_CW2 + 32 * 1024;
constexpr size_t OFF_SCU = OFF_SGUW + 256 * 1024;
constexpr size_t OFF_SCV = OFF_SCU + 64 * 1024;
constexpr size_t OFF_PU = OFF_SCV + 64 * 1024;
constexpr size_t OFF_PV = OFF_PU + 32 * MB;
constexpr size_t OFF_ACT = ((OFF_PV + 32 * MB + 4095) / 4096) * 4096;
constexpr size_t OFF_H = OFF_ACT;
constexpr size_t OFF_Q = OFF_H + 128 * MB;
constexpr size_t OFF_KC = OFF_Q + 64 * MB;
constexpr size_t OFF_VC = OFF_KC + 16 * MB;
constexpr size_t OFF_KS = OFF_VC + 16 * MB;
constexpr size_t OFF_VS = OFF_KS + 16 * MB;
constexpr size_t OFF_KW = OFF_VS + 16 * MB;
constexpr size_t OFF_VW = OFF_KW + 16 * MB;
constexpr size_t OFF_U = OFF_VW + 16 * MB;
constexpr size_t OFF_V = OFF_U + 64 * MB;
constexpr size_t OFF_GATE = OFF_V + 64 * MB;
constexpr size_t OFF_GSIG = OFF_GATE + 256 * MB;
constexpr size_t OFF_KCMP = OFF_GSIG + 8 * MB;
constexpr size_t OFF_VCMP = OFF_KCMP + MB;
constexpr size_t OFF_ONSA = OFF_VCMP + MB;
constexpr size_t OFF_SELG = OFF_ONSA + 64 * MB;
constexpr size_t OFF_BAR = OFF_SELG + 2 * MB;
constexpr size_t OFF_END = OFF_BAR + 64 * 1024;
constexpr size_t OFF_X1 = OFF_Q;
constexpr size_t OFF_Y = OFF_GATE;
constexpr size_t OFF_PQ = OFF_GATE;
constexpr size_t OFF_EIDX = OFF_ONSA;
constexpr size_t OFF_PGATE = OFF_ONSA + 32 * MB;
constexpr size_t OFF_PU8 = OFF_PU;
constexpr size_t OFF_PART = OFF_GATE;
constexpr size_t OFF_PV8 = OFF_PU + 16 * MB;
constexpr size_t OFF_WBUF = OFF_PU + 32 * MB;
constexpr size_t OFF_H2Q = OFF_U;
constexpr size_t OFF_SH = OFF_V;
constexpr size_t OFF_FFNB = OFF_GATE;
constexpr size_t OFF_SCW1 = OFF_WT1 + 5 * MB;
constexpr size_t OFF_SCWQ = OFF_WQ + 3 * MB;
constexpr size_t OFF_GATE8 = OFF_GATE;
constexpr size_t OFF_OSGU8 = OFF_GATE + 128 * MB;
constexpr size_t OFF_ONSA8 = OFF_GATE + 160 * MB;
constexpr size_t OFF_MRG8 = OFF_GATE + 192 * MB;
constexpr size_t OFF_M08 = OFF_H;
constexpr size_t OFF_SCWB = OFF_WB + 3 * MB / 2;
constexpr size_t OFF_SCWO = OFF_WOUT + 3 * MB / 2;
constexpr size_t OFF_SA = OFF_H + 64 * MB;

struct Params {
  const float *x, *c, *w_ada, *b_ada, *w_in, *cmp_pos, *cmp_w1, *cmp_b1, *cmp_w2, *cmp_b2, *sgu_ln_g, *sgu_ln_b, *sgu_w, *sgu_b,
      *w_branch, *w_merge, *b_merge, *w_out, *ln1_g, *ln1_b, *peer_wq, *peer_keys, *peer_u, *peer_v, *ln2_g, *ln2_b;
  float* out;
  char* ws;
  float inv_freq[32];
};

DI unsigned pack2(float lo, float hi) { f32x2 v = {lo, hi}; bf16v2 r = __builtin_convertvector(v, bf16v2); return __builtin_bit_cast(unsigned, r); }
DI bf16_t f2bf(float f) { __bf16 r = (__bf16)f; return __builtin_bit_cast(unsigned short, r); }
DI float bf2f(bf16_t h) { return __uint_as_float(((unsigned)h) << 16); }
DI float bflo(unsigned u) { return __uint_as_float(u << 16); }
DI float bfhi(unsigned u) { return __uint_as_float(u & 0xffff0000u); }
DI float gelu_f(float v) { return 0.5f * v * (1.0f + erff(v * 0.70710678118654752f)); }
DI float sigmoid_f(float v) { return 1.0f / (1.0f + __expf(-v)); }
DI int otid() { int t = __builtin_amdgcn_workitem_id_x(); asm volatile("" : "+v"(t)); return t; }
DI void lds_barrier() { asm volatile("s_waitcnt lgkmcnt(0)" ::: "memory"); __builtin_amdgcn_s_barrier(); asm volatile("" ::: "memory"); }
DI float xor1f(float x) { const int xi = __float_as_int(x); return __int_as_float(__builtin_amdgcn_update_dpp(xi, xi, 0xB1, 0xF, 0xF, false)); }
DI float xor2f(float x) { const int xi = __float_as_int(x); return __int_as_float(__builtin_amdgcn_update_dpp(xi, xi, 0x4E, 0xF, 0xF, false)); }
DI float xor8f(float x) { const int xi = __float_as_int(x); return __int_as_float(__builtin_amdgcn_update_dpp(xi, xi, 0x128, 0xF, 0xF, false)); }
DI unsigned xor32u(unsigned x, int lane) { const u32x2 r = __builtin_amdgcn_permlane32_swap(x, x, false, false); return (lane & 32) ? r.x : r.y; }
DI unsigned xor16u(unsigned x, int lane) { const u32x2 r = __builtin_amdgcn_permlane16_swap(x, x, false, false); return (lane & 16) ? r.x : r.y; }
DI float xor32f(float x, int lane) { return __uint_as_float(xor32u(__float_as_uint(x), lane)); }
DI float xor16f(float x, int lane) { return __uint_as_float(xor16u(__float_as_uint(x), lane)); }
DI unsigned pack_i8x4(float a, float b, float c, float d) {
  const int ia = (int)rintf(a), ib = (int)rintf(b), ic = (int)rintf(c), id = (int)rintf(d);
  return (unsigned)(ia & 0xff) | ((unsigned)(ib & 0xff) << 8) | ((unsigned)(ic & 0xff) << 16) | ((unsigned)id << 24);
}
DI unsigned pk4_fp8(float a, float b, float c, float d) { int t = 0; t = __builtin_amdgcn_cvt_pk_fp8_f32(a, b, t, false); t = __builtin_amdgcn_cvt_pk_fp8_f32(c, d, t, true); return (unsigned)t; }
DI float clamp_f8(float v) { return __builtin_amdgcn_fmed3f(v, -448.0f, 448.0f); }
DI void unpack8_fp8(const u32x2 w, float (&v)[8]) {
  const f32x2 a = __builtin_amdgcn_cvt_pk_f32_fp8((int)w.x, false), b = __builtin_amdgcn_cvt_pk_f32_fp8((int)w.x, true);
  const f32x2 c = __builtin_amdgcn_cvt_pk_f32_fp8((int)w.y, false), d = __builtin_amdgcn_cvt_pk_f32_fp8((int)w.y, true);
  v[0] = a.x; v[1] = a.y; v[2] = b.x; v[3] = b.y; v[4] = c.x; v[5] = c.y; v[6] = d.x; v[7] = d.y;
}
DI float wave_sum(float v) {
#pragma unroll
  for (int o = 32; o > 0; o >>= 1) v += __shfl_xor(v, o);
  return v;
}
DI void ld8(const float* pz, float (&v)[8]) { const f32x4 a = *(const f32x4*)pz, b = *(const f32x4*)(pz + 4); v[0] = a.x; v[1] = a.y; v[2] = a.z; v[3] = a.w; v[4] = b.x; v[5] = b.y; v[6] = b.z; v[7] = b.w; }
DI u32x4 pack8(const float (&v)[8]) { u32x4 w; w.x = pack2(v[0], v[1]); w.y = pack2(v[2], v[3]); w.z = pack2(v[4], v[5]); w.w = pack2(v[6], v[7]); return w; }
DI void unpack8(const u32x4 w, float (&v)[8]) { v[0] = bflo(w.x); v[1] = bfhi(w.x); v[2] = bflo(w.y); v[3] = bfhi(w.y); v[4] = bflo(w.z); v[5] = bfhi(w.z); v[6] = bflo(w.w); v[7] = bfhi(w.w); }
DI f32x2 gelu_pk(f32x2 v) {
  const f32x2 av = __builtin_elementwise_abs(v), d = av * 0.2316418882f + 1.0f;
  f32x2 t; t.x = __builtin_amdgcn_rcpf(d.x); t.y = __builtin_amdgcn_rcpf(d.y);
  f32x2 q = t * 0.5307027145f + (-0.7265760135f); q = q * t + 0.7107068705f; q = q * t + (-0.142248368f); q = q * t + 0.127414796f; q = q * t;
  const f32x2 s = (v * v) * (-0.72134752044f);
  f32x2 e; e.x = __builtin_amdgcn_exp2f(s.x); e.y = __builtin_amdgcn_exp2f(s.y);
  const f32x2 m = v * (q * e), r = v - m;
  f32x2 o; o.x = v.x < 0.f ? m.x : r.x; o.y = v.y < 0.f ? m.y : r.y; return o;
}
__host__ __device__ __forceinline__ int dperm(int q) { const int grp = q >> 5, fq = (q >> 3) & 3, j = q & 7; return (j < 4) ? (16 * grp + 4 * fq + j) : (32 + 16 * grp + 4 * fq + (j - 4)); }

template <class F>
DI void tconv_tile(float* tile, int k0, int n0, bf16_t* dst, int ldd, F f) {
  const int tid = otid();
  __syncthreads();
#pragma unroll 4
  for (int i = 0; i < 8; ++i) { const int kl = i * 8 + (tid >> 6), nl = tid & 63; tile[nl * 65 + kl] = f(k0 + kl, n0 + nl); }
  __syncthreads();
  {
    const int nl = tid >> 3, kc = tid & 7;
    const float* t = tile + nl * 65 + kc * 8;
    u32x4 w; w.x = pack2(t[0], t[1]); w.y = pack2(t[2], t[3]); w.z = pack2(t[4], t[5]); w.w = pack2(t[6], t[7]);
    *(u32x4*)(dst + (size_t)(n0 + nl) * ldd + k0 + kc * 8) = w;
  }
}

template <bool FP8, class F>
DI void tconv_strip32(float* tile, int n0, int K, unsigned char* dst, float* gscale, F f) {
  const int tid = otid(), nl = tid & 31, kr = tid >> 5, ld = K + 1;
  float am = 0.f;
#pragma unroll 16
  for (int k = kr; k < K; k += 16) { const float v = f(k, n0 + nl); tile[nl * ld + k] = v; am = fmaxf(am, fabsf(v)); }
#pragma unroll
  for (int o = 16; o > 0; o >>= 1) am = fmaxf(am, __shfl_xor(am, o));
  float* red = tile + 32 * ld;
  if (nl == 0) red[kr] = am;
  __syncthreads();
  float g = 0.f;
#pragma unroll
  for (int w = 0; w < 16; ++w) g = fmaxf(g, red[w]);
  float q, inv;
  if (FP8) {
    const unsigned be = (__float_as_uint(g) >> 23) & 0xffu;
    const bool ok = be >= 16u && be <= 240u;
    q = ok ? __uint_as_float((261u - be) << 23) : 1.0f; inv = ok ? __uint_as_float((be - 7u) << 23) : 1.0f;
  } else { q = g > 0.f ? 127.0f / g : 0.f; inv = g * (1.0f / 127.0f); }
  if (tid == 0) gscale[n0 >> 5] = inv;
  const int cpr = K >> 3;
  for (int idx = tid; idx < 32 * cpr; idx += NT) {
    const int row = idx / cpr, kc = idx - row * cpr;
    const float* t = tile + row * ld + kc * 8;
    u32x2 w;
    if (FP8) { w.x = pk4_fp8(t[0] * q, t[1] * q, t[2] * q, t[3] * q); w.y = pk4_fp8(t[4] * q, t[5] * q, t[6] * q, t[7] * q); }
    else { w.x = pack_i8x4(t[0] * q, t[1] * q, t[2] * q, t[3] * q); w.y = pack_i8x4(t[4] * q, t[5] * q, t[6] * q, t[7] * q); }
    *(u32x2*)(dst + (size_t)(n0 + row) * K + kc * 8) = w;
  }
}

DI void conv_chunk(const float* src, bf16_t* dst, size_t base) {
  const size_t i = base + (size_t)otid() * 8;
  const f32x4 a = *(const f32x4*)(src + i), b = *(const f32x4*)(src + i + 4);
  u32x4 w; w.x = pack2(a.x, a.y); w.y = pack2(a.z, a.w); w.z = pack2(b.x, b.y); w.w = pack2(b.z, b.w);
  *(u32x4*)(dst + i) = w;
}

DI void sincos_d(double x, double& s, double& c) {
  const double y = x * 0.25, y2 = y * y;
  double sn = y * (1.0 + y2 * (-1.0 / 6 + y2 * (1.0 / 120 + y2 * (-1.0 / 5040 + y2 * (1.0 / 362880 + y2 * (-1.0 / 39916800 + y2 * (1.0 / 6227020800.0)))))));
  double cs = 1.0 + y2 * (-0.5 + y2 * (1.0 / 24 + y2 * (-1.0 / 720 + y2 * (1.0 / 40320 + y2 * (-1.0 / 3628800 + y2 * (1.0 / 479001600.0 + y2 * (-1.0 / 87178291200.0)))))));
#pragma unroll
  for (int i = 0; i < 2; ++i) { const double s2 = 2.0 * sn * cs, c2 = cs * cs - sn * sn; sn = s2; cs = c2; }
  s = sn; c = cs;
}

DI void phase_prep(const Params& p, char* smem, unsigned* wcnt) {
  const int tid = otid();
  float* fs = (float*)smem;
  char* ws = p.ws;
  volatile LAS unsigned* slot = (volatile LAS unsigned*)(smem + 147456 + 64);
  constexpr int nB = 144, nE = 64, nC = 64, nD = 32, nA = 192, nI = 512, nF = 2 * 32 * 2, nG = 4, nH = 8, nJ = 64, nK = 32, nL = 512, nM = 512;
  constexpr int total = nB + nE + nC + nD + nA + nI + nF + nG + nH + nJ + nK + nL + nM;
  for (;;) {
    __syncthreads();
    if (tid == 0) *slot = __hip_atomic_fetch_add(wcnt, 1u, __ATOMIC_RELAXED, __HIP_MEMORY_SCOPE_AGENT);
    __syncthreads();
    int it = (int)*slot;
    if (it >= total) break;
    if (it < nB) {
      const float* w_in = p.w_in; const float* w_merge = p.w_merge;
      tconv_strip32<false>(fs, it * 32, 1024, (unsigned char*)(ws + OFF_WT1), (float*)(ws + OFF_SCW1), [=](int k, int n) -> float {
        if (n < 1280) {
          const bool roped = (n < 640) || (n >= 768 && n < 896) || (n >= 1024 && n < 1152);
          const int col = roped ? ((n & ~63) + dperm(n & 63)) : n;
          return w_in[(size_t)k * 2328 + col];
        }
        if (n < 2304) return w_in[(size_t)k * 2328 + n + 24];
        if (n < 4352) return w_merge[(size_t)k * 2048 + (n - 2304)];
        if (n < 4376) return w_in[(size_t)k * 2328 + 1280 + (n - 4352)];
        return 0.f; });
      continue;
    }
    it -= nB;
    if (it < nE) {
      const float* src = p.peer_wq;
      tconv_strip32<false>(fs, it * 32, 1024, (unsigned char*)(ws + OFF_WQ), (float*)(ws + OFF_SCWQ), [=](int k, int n) -> float { return src[(size_t)k * 2048 + n]; });
      continue;
    }
    it -= nE;
    if (it < nC) {
      const int br = it >> 5, strip = it & 31;
      const float* src = p.w_branch + (size_t)br * 512 * 1024;
      tconv_strip32<true>(fs, strip * 32, 512, (unsigned char*)(ws + OFF_WB) + (size_t)br * 1024 * 512, (float*)(ws + OFF_SCWB) + br * 32, [=](int k, int n) -> float { return src[(size_t)k * 1024 + n]; });
      continue;
    }
    it -= nC;
    if (it < nD) {
      const float* src = p.w_out;
      tconv_strip32<true>(fs, it * 32, 1024, (unsigned char*)(ws + OFF_WOUT), (float*)(ws + OFF_SCWO), [=](int k, int n) -> float { return src[(size_t)k * 1024 + n]; });
      continue;
    }
    it -= nD;
    if (it < nA) {
      float* sc = fs;
      float* red = fs + 8192;
      for (int i = tid; i < 8192; i += NT) { const float v = p.c[i]; sc[i] = v / (1.0f + __expf(-v)); }
      __syncthreads();
      const int ks = tid >> 5, cj = tid & 31, col = it * 32 + cj;
      float acc[8];
#pragma unroll
      for (int b = 0; b < 8; ++b) acc[b] = 0.f;
#pragma unroll 16
      for (int k = ks * 64; k < ks * 64 + 64; ++k) {
        const float w = p.w_ada[(size_t)k * 6144 + col];
#pragma unroll
        for (int b = 0; b < 8; ++b) acc[b] += sc[b * 1024 + k] * w;
      }
#pragma unroll
      for (int b = 0; b < 8; ++b) red[(ks * 8 + b) * 32 + cj] = acc[b];
      __syncthreads();
      if (tid < 256) {
        const int b = tid >> 5;
        float s = p.b_ada[col];
#pragma unroll
        for (int k2 = 0; k2 < 16; ++k2) s += red[(k2 * 8 + b) * 32 + cj];
        ((float*)(ws + OFF_MOD))[b * 6144 + col] = s;
      }
      continue;
    }
    it -= nA;
    if (it < nI) {
      const int e = it * 512 + tid, pos = e >> 5, i = e & 31;
      const float ang = (float)pos * p.inv_freq[i];
      const double a = (double)ang;
      const double kk = rint(a * 0.15915494309189535);
      const double r = a - kk * 6.283185307179586476925;
      double sn, cs; sincos_d(r, sn, cs);
      ((float*)(ws + OFF_ROPE))[e] = (float)cs;
      ((float*)(ws + OFF_ROPE))[262144 + e] = (float)sn;
      continue;
    }
    it -= nI;
    if (it < nF) {
      const int w = it >> 6, r = it & 63, kt = r >> 1, ntile = r & 1;
      const float* src = p.cmp_w1 + (size_t)w * 2048 * 128;
      tconv_tile(fs, kt * 64, ntile * 64, (bf16_t*)(ws + OFF_CW1) + (size_t)w * 128 * 2048, 2048, [=](int k, int n) -> float {
        const int ksrc = (w == 0) ? ((k & ~63) + dperm(k & 63)) : k;
        return src[(size_t)ksrc * 128 + n]; });
      continue;
    }
    it -= nF;
    if (it < nG) {
      const int w = it >> 1, kt = it & 1;
      const float* src = p.cmp_w2 + (size_t)w * 128 * 64;
      tconv_tile(fs, kt * 64, 0, (bf16_t*)(ws + OFF_CW2) + (size_t)w * 64 * 128, 128, [=](int k, int n) -> float { return src[(size_t)k * 64 + ((w == 0) ? dperm(n) : n)]; });
      continue;
    }
    it -= nG;
    if (it < nH) {
      const int w = it >> 2, jc = it & 3, ks = tid >> 5, cj = tid & 31, j = jc * 32 + cj;
      float* red = fs;
      const float* pos = p.cmp_pos + w * 2048; const float* w1 = p.cmp_w1 + (size_t)w * 2048 * 128;
      float acc = 0.f;
#pragma unroll 16
      for (int k = ks * 128; k < ks * 128 + 128; ++k) acc += pos[k] * w1[(size_t)k * 128 + j];
      red[ks * 32 + cj] = acc;
      __syncthreads();
      if (tid < 32) { float s = p.cmp_b1[w * 128 + j]; for (int k2 = 0; k2 < 16; ++k2) s += red[k2 * 32 + tid]; ((float*)(ws + OFF_POSB))[w * 128 + j] = s; }
      continue;
    }
    it -= nH;
    if (it < nJ) { conv_chunk(p.peer_keys, (bf16_t*)(ws + OFF_PKEYS), (size_t)it * 4096); continue; }
    it -= nJ;
    if (it < nK) {
      const size_t i0 = (size_t)it * 4096 + (size_t)tid * 8;
      const int rowi = (int)((i0 >> 7) & 127), j0 = (int)(i0 & 127);
      float v[8];
#pragma unroll
      for (int j = 0; j < 8; ++j) v[j] = (j0 + j <= rowi) ? p.sgu_w[i0 + j] : 0.f;
      u32x4 w; w.x = pack2(v[0], v[1]); w.y = pack2(v[2], v[3]); w.z = pack2(v[4], v[5]); w.w = pack2(v[6], v[7]);
      *(u32x4*)((bf16_t*)(ws + OFF_SGUW) + i0) = w;
      continue;
    }
    it -= nK;
    {
      const bool isv = it >= nL;
      if (isv) it -= nL;
      const int lane = tid & 63, e0 = it * 32 + (tid >> 6) * 4;
      const float* src = (isv ? p.peer_v : p.peer_u) + (size_t)e0 * 1024 + lane * 16;
      f32x4 raw[4][4];
#pragma unroll
      for (int r = 0; r < 4; ++r)
#pragma unroll
        for (int i = 0; i < 4; ++i) raw[r][i] = *(const f32x4*)(src + (size_t)r * 1024 + i * 4);
#pragma unroll
      for (int r = 0; r < 4; ++r) {
        const int e = e0 + r;
        float v[16];
#pragma unroll
        for (int i = 0; i < 4; ++i) { v[4 * i] = raw[r][i].x; v[4 * i + 1] = raw[r][i].y; v[4 * i + 2] = raw[r][i].z; v[4 * i + 3] = raw[r][i].w; }
        float amax = 0.f;
#pragma unroll
        for (int i = 0; i < 16; ++i) amax = fmaxf(amax, fabsf(v[i]));
#pragma unroll
        for (int o = 32; o > 0; o >>= 1) amax = fmaxf(amax, __shfl_xor(amax, o));
        if (!isv) {
          const float qs = amax > 0.f ? 127.0f / amax : 0.f;
          u32x4 wi; wi.x = pack_i8x4(v[0] * qs, v[1] * qs, v[2] * qs, v[3] * qs); wi.y = pack_i8x4(v[4] * qs, v[5] * qs, v[6] * qs, v[7] * qs);
          wi.z = pack_i8x4(v[8] * qs, v[9] * qs, v[10] * qs, v[11] * qs); wi.w = pack_i8x4(v[12] * qs, v[13] * qs, v[14] * qs, v[15] * qs);
          *(u32x4*)(ws + OFF_PU8 + ((size_t)(lane >> 3) * 16384 + e) * 128 + (lane & 7) * 16) = wi;
          if (lane == 0) ((float*)(ws + OFF_SCU))[e] = amax * (1.0f / 127.0f);
        } else {
          const unsigned be = (__float_as_uint(amax) >> 23) & 0xffu;
          const bool okr = be >= 16u && be <= 240u;
          const float scale = okr ? __uint_as_float((261u - be) << 23) : 1.0f;
          const float inv = okr ? __uint_as_float((be - 7u) << 23) : 1.0f;
          u32x4 w; w.x = pk4_fp8(v[0] * scale, v[1] * scale, v[2] * scale, v[3] * scale); w.y = pk4_fp8(v[4] * scale, v[5] * scale, v[6] * scale, v[7] * scale);
          w.z = pk4_fp8(v[8] * scale, v[9] * scale, v[10] * scale, v[11] * scale); w.w = pk4_fp8(v[12] * scale, v[13] * scale, v[14] * scale, v[15] * scale);
          *(u32x4*)(ws + OFF_PV8 + ((size_t)(lane >> 3) * 16384 + e) * 128 + (lane & 7) * 16) = w;
          if (lane == 0) ((float*)(ws + OFF_SCV))[e] = inv;
        }
      }
    }
  }
}

DI void row_stats(const float (&v)[16], float& mean, float& rstd) {
  float s = 0.f;
#pragma unroll
  for (int i = 0; i < 16; ++i) s += v[i];
  mean = wave_sum(s) * (1.0f / 1024.0f);
  float q = 0.f;
#pragma unroll
  for (int i = 0; i < 16; ++i) { const float d = v[i] - mean; q += d * d; }
  rstd = rsqrtf(wave_sum(q) * (1.0f / 1024.0f) + LN_EPS);
}

DI void phase_ln_in(const Params& p) {
  const int lane = otid() & 63, wave = otid() >> 6;
  const float* mod = (const float*)(p.ws + OFF_MOD);
  unsigned* h8 = (unsigned*)(p.ws + OFF_H);
  for (int grp = blockIdx.x; grp < NTOK / NW; grp += gridDim.x) {
    const int row = grp * NW + wave, b = row >> 13;
    const float* xr = p.x + (size_t)row * DM;
    float v[16];
#pragma unroll
    for (int i = 0; i < 4; ++i) { const f32x4 t = *(const f32x4*)(xr + i * 256 + lane * 4); v[4 * i] = t.x; v[4 * i + 1] = t.y; v[4 * i + 2] = t.z; v[4 * i + 3] = t.w; }
    float mean, rstd; row_stats(v, mean, rstd);
    float amax = 0.f;
#pragma unroll
    for (int i = 0; i < 4; ++i) {
      const int col = i * 256 + lane * 4;
      const f32x4 sh = *(const f32x4*)(mod + b * 6144 + col), sc = *(const f32x4*)(mod + b * 6144 + 1024 + col);
      const float o0 = (v[4 * i] - mean) * rstd * (1.f + sc.x) + sh.x, o1 = (v[4 * i + 1] - mean) * rstd * (1.f + sc.y) + sh.y;
      const float o2 = (v[4 * i + 2] - mean) * rstd * (1.f + sc.z) + sh.z, o3 = (v[4 * i + 3] - mean) * rstd * (1.f + sc.w) + sh.w;
      v[4 * i] = o0; v[4 * i + 1] = o1; v[4 * i + 2] = o2; v[4 * i + 3] = o3;
      amax = fmaxf(amax, fmaxf(fmaxf(fabsf(o0), fabsf(o1)), fmaxf(fabsf(o2), fabsf(o3))));
    }
#pragma unroll
    for (int o = 32; o > 0; o >>= 1) amax = fmaxf(amax, __shfl_xor(amax, o));
    const float qs = amax > 0.f ? 127.0f / amax : 0.f;
#pragma unroll
    for (int i = 0; i < 4; ++i) h8[(size_t)row * 256 + i * 64 + lane] = pack_i8x4(v[4 * i] * qs, v[4 * i + 1] * qs, v[4 * i + 2] * qs, v[4 * i + 3] * qs);
    if (lane == 0) ((float*)(p.ws + OFF_SA))[row] = amax * (1.0f / 127.0f);
  }
}

DI void phase_ln_mid(const Params& p) {
  const int lane = otid() & 63, wave = otid() >> 6;
  const float* mod = (const float*)(p.ws + OFF_MOD);
  const bf16_t* y = (const bf16_t*)(p.ws + OFF_Y);
  bf16_t* x1 = (bf16_t*)(p.ws + OFF_X1);
  for (int grp = blockIdx.x; grp < NTOK / NW; grp += gridDim.x) {
    const int row = grp * NW + wave, b = row >> 13;
    const bf16_t* yr = y + (size_t)row * DM;
    float v[16];
#pragma unroll
    for (int i = 0; i < 4; ++i) { const u32x2 t = *(const u32x2*)(yr + i * 256 + lane * 4); v[4 * i] = bflo(t.x); v[4 * i + 1] = bfhi(t.x); v[4 * i + 2] = bflo(t.y); v[4 * i + 3] = bfhi(t.y); }
    float mean, rstd; row_stats(v, mean, rstd);
#pragma unroll
    for (int i = 0; i < 4; ++i) {
      const int col = i * 256 + lane * 4;
      const f32x4 g = *(const f32x4*)(p.ln1_g + col), bb = *(const f32x4*)(p.ln1_b + col);
      f32x4 o;
      o.x = (v[4 * i] - mean) * rstd * g.x + bb.x; o.y = (v[4 * i + 1] - mean) * rstd * g.y + bb.y;
      o.z = (v[4 * i + 2] - mean) * rstd * g.z + bb.z; o.w = (v[4 * i + 3] - mean) * rstd * g.w + bb.w;
      { u32x2 w; w.x = pack2(o.x, o.y); w.y = pack2(o.z, o.w); *(u32x2*)(x1 + (size_t)row * DM + col) = w; }
      v[4 * i] = o.x; v[4 * i + 1] = o.y; v[4 * i + 2] = o.z; v[4 * i + 3] = o.w;
    }
    row_stats(v, mean, rstd);
    float amax = 0.f;
#pragma unroll
    for (int i = 0; i < 4; ++i) {
      const int col = i * 256 + lane * 4;
      const f32x4 sh = *(const f32x4*)(mod + b * 6144 + 3072 + col), sc = *(const f32x4*)(mod + b * 6144 + 4096 + col);
      const float o0 = (v[4 * i] - mean) * rstd * (1.f + sc.x) + sh.x, o1 = (v[4 * i + 1] - mean) * rstd * (1.f + sc.y) + sh.y;
      const float o2 = (v[4 * i + 2] - mean) * rstd * (1.f + sc.z) + sh.z, o3 = (v[4 * i + 3] - mean) * rstd * (1.f + sc.w) + sh.w;
      v[4 * i] = o0; v[4 * i + 1] = o1; v[4 * i + 2] = o2; v[4 * i + 3] = o3;
      amax = fmaxf(amax, fmaxf(fmaxf(fabsf(o0), fabsf(o1)), fmaxf(fabsf(o2), fabsf(o3))));
    }
#pragma unroll
    for (int o = 32; o > 0; o >>= 1) amax = fmaxf(amax, __shfl_xor(amax, o));
    const float qs = amax > 0.f ? 127.0f / amax : 0.f;
    unsigned* h2q = (unsigned*)(p.ws + OFF_H2Q);
#pragma unroll
    for (int i = 0; i < 4; ++i) h2q[(size_t)row * 256 + i * 64 + lane] = pack_i8x4(v[4 * i] * qs, v[4 * i + 1] * qs, v[4 * i + 2] * qs, v[4 * i + 3] * qs);
    if (lane == 0) ((float*)(p.ws + OFF_SH))[row] = amax * (1.0f / 127.0f);
  }
}

namespace pg8 {
constexpr int BM = 256, BK = 64, HALF = 128, HTB = HALF * BK * 2, STAGE_BYTES = 8 * HTB, NXCD = 8, WGM = 8;
DI int lds_byte(int r, int c) { const int st = (r >> 4) * 2 + (c >> 5), rr = r & 15, cc = c & 31, ob = rr * 64 + cc * 2; return st * 1024 + (ob ^ (((ob >> 9) & 1) << 5)); }
DI void stage_rc(int b, int& R, int& C) { const int st = b / 1024, sb = b % 1024, swz = sb ^ (((sb >> 9) & 1) << 5); R = (st >> 1) * 16 + swz / 64; C = (st & 1) * 32 + (swz % 64) / 2; }
DI int perm32(int rho) { const int n = rho >> 4, i = rho & 15; return 8 * (i >> 2) + 4 * n + (i & 3); }
struct Unit { int pm, pn; };
struct Gemm { const bf16_t* A; const bf16_t* Bt; int M, N, K; };
struct StaticOrder {
  int nM, nN, nwg, G, c;
  DI void init(int M, int N, int G_, int c_) { nM = M / BM; nN = N / BM; nwg = nM * nN; G = G_; c = c_; }
  DI bool next(int i, Unit& u) const {
    const long L = (long)i * G + c; if (L >= nwg) return false;
    int wgid = (int)L; { const int q = nwg / NXCD, r = nwg % NXCD, xcd = wgid % NXCD, off = wgid / NXCD; wgid = (xcd < r ? xcd * (q + 1) : r * (q + 1) + (xcd - r) * q) + off; }
    const int nig = WGM * nN, gid = wgid / nig, fm = gid * WGM, gsz = (nM - fm) < WGM ? (nM - fm) : WGM;
    u.pm = fm + ((wgid % nig) % gsz); u.pn = (wgid % nig) / gsz; return true;
  }
};

template <int MODE, class AccT>
DI AccT mma_pair(bf16x8 b0, bf16x8 b1, bf16x8 a0, bf16x8 a1, AccT c) {
  if constexpr (MODE == 0) { c = __builtin_amdgcn_mfma_f32_16x16x32_bf16(b0, a0, c, 0, 0, 0); return __builtin_amdgcn_mfma_f32_16x16x32_bf16(b1, a1, c, 0, 0, 0); }
  else if constexpr (MODE == 1) {
    c = __builtin_amdgcn_mfma_i32_16x16x64_i8(__builtin_bit_cast(i32x4, b0), __builtin_bit_cast(i32x4, a0), c, 0, 0, 0);
    return __builtin_amdgcn_mfma_i32_16x16x64_i8(__builtin_bit_cast(i32x4, b1), __builtin_bit_cast(i32x4, a1), c, 0, 0, 0);
  } else {
    const i32x8 B = __builtin_shufflevector(__builtin_bit_cast(i32x4, b0), __builtin_bit_cast(i32x4, b1), 0, 1, 2, 3, 4, 5, 6, 7);
    const i32x8 A = __builtin_shufflevector(__builtin_bit_cast(i32x4, a0), __builtin_bit_cast(i32x4, a1), 0, 1, 2, 3, 4, 5, 6, 7);
    asm volatile("v_mfma_f32_16x16x128_f8f6f4 %0, %1, %2, %0" : "+v"(c) : "v"(B), "v"(A));
    return c;
  }
}
DI f32x4 mma16(bf16x8 a, bf16x8 b, f32x4 c) { return __builtin_amdgcn_mfma_f32_16x16x32_bf16(a, b, c, 0, 0, 0); }
DI i32x4 mma16(bf16x8 a, bf16x8 b, i32x4 c) { return __builtin_amdgcn_mfma_i32_16x16x64_i8(__builtin_bit_cast(i32x4, a), __builtin_bit_cast(i32x4, b), c, 0, 0, 0); }
template <class Epi>
DI void gemm_phase(LAS unsigned char* lds, const Gemm g, const StaticOrder& S, const Epi& E) {
  const int tid = otid(), wid = __builtin_amdgcn_readfirstlane(tid >> 6), lane = tid & 63, wr = wid >> 2, wc = wid & 3, fr = lane & 15, fq = lane >> 4;
  const int K = g.K, nt = K / BK;
  unsigned voffA[2], voffB[2];
#pragma unroll
  for (int i = 0; i < 2; ++i) { int R, C; stage_rc(tid * 16 + i * 8192, R, C); const int Rb = Epi::PERM ? ((R & ~31) + perm32(R & 31)) : R;
    voffA[i] = (unsigned)(R * K + C) * 2u; voffB[i] = (unsigned)(Rb * K + C) * 2u; }
  const size_t kstep = (size_t)(BK * 2);
  const size_t hstep = (size_t)HALF * K * 2;
  const size_t tstep = 2 * hstep;
  const unsigned ldsw = (unsigned)wid * 1024u;
  const int aoff = lds_byte(wr * 64 + fr, fq * 8), boff = lds_byte(wc * 32 + fr, fq * 8);
  LAS unsigned char* ldsB = lds + 4 * HTB + boff;
  asm volatile("" : "+v"(ldsB));
#define PG8_SA(b, h) (((b) * 2 + (h)) * HTB)
#define PG8_SB(b, h) ((4 + (b) * 2 + (h)) * HTB)
#define PG8_STAGE(bufoff, gbase, voff) do { _Pragma("unroll") for (int _i = 0; _i < 2; ++_i) \
    __builtin_amdgcn_global_load_lds((const unsigned*)((const char*)(gbase) + (voff)[_i]), (LAS unsigned*)(lds + (bufoff) + ldsw + _i * 8192), 16, 0, 0); } while (0)
#define PG8_LDA(dst, b, h) do { _Pragma("unroll") for (int m = 0; m < 4; ++m) _Pragma("unroll") for (int k = 0; k < 2; ++k) dst[m][k] = *(const LAS bf16x8*)(lds + PG8_SA(b, h) + aoff + m * 2048 + k * 1024); } while (0)
#define PG8_LDB(dst, b, h) do { _Pragma("unroll") for (int n = 0; n < 2; ++n) _Pragma("unroll") for (int k = 0; k < 2; ++k) dst[n][k] = *(const LAS bf16x8*)(ldsB + ((b) * 2 + (h)) * HTB + n * 2048 + k * 1024); } while (0)
#define PG8_MMA(ai, bj, At, Bt) do { __builtin_amdgcn_s_setprio(1); _Pragma("unroll") for (int m = 0; m < 4; ++m) _Pragma("unroll") for (int n = 0; n < 2; ++n) \
    acc[ai][bj][m][n] = mma_pair<Epi::MODE>(Bt[n][0], Bt[n][1], At[m][0], At[m][1], acc[ai][bj][m][n]); __builtin_amdgcn_s_setprio(0); } while (0)
#define PG8_WAIT_V(n) asm volatile("s_waitcnt vmcnt(" #n ")" ::: "memory")
#define PG8_WAIT_L(n) asm volatile("s_waitcnt lgkmcnt(" #n ")" ::: "memory")
#define PG8_BAR __builtin_amdgcn_s_barrier()
#define PG8_SCHED __builtin_amdgcn_sched_barrier(0)
  Unit cur, nxt; int ui = 0;
  if (!S.next(0, cur)) return;
  typedef typename Epi::AccT AccT;
  const AccT zacc = {0, 0, 0, 0};
  AccT acc[2][2][4][2];
#pragma unroll
  for (int a = 0; a < 2; ++a)
#pragma unroll
    for (int b = 0; b < 2; ++b)
#pragma unroll
      for (int m = 0; m < 4; ++m)
#pragma unroll
        for (int n = 0; n < 2; ++n) acc[a][b][m][n] = zacc;
  bf16x8 At[4][2], B0[2][2], B1[2][2];
  const char* cA = (const char*)g.A + (size_t)cur.pm * tstep; const char* cB = (const char*)g.Bt + (size_t)cur.pn * tstep;
  PG8_STAGE(PG8_SB(0, 0), cB, voffB); PG8_STAGE(PG8_SA(0, 0), cA, voffA); PG8_STAGE(PG8_SB(0, 1), cB + hstep, voffB); PG8_STAGE(PG8_SA(0, 1), cA + hstep, voffA);
  if (wr == 1) PG8_BAR;
  PG8_WAIT_V(4); PG8_BAR;
  PG8_STAGE(PG8_SB(1, 0), cB + kstep, voffB); PG8_STAGE(PG8_SA(1, 0), cA + kstep, voffA); PG8_STAGE(PG8_SB(1, 1), cB + hstep + kstep, voffB);
  PG8_WAIT_V(6); PG8_BAR;
  for (;;) {
    const bool has_next = S.next(ui + 1, nxt);
    const char* nA = has_next ? (const char*)g.A + (size_t)nxt.pm * tstep : cA; const char* nB = has_next ? (const char*)g.Bt + (size_t)nxt.pn * tstep : cB;
#pragma unroll 1
    for (int t = 0; t < nt; t += 2) {
      const bool last = (t == nt - 2);
      const char* a1 = cA + (size_t)(t + 1) * kstep;
      const char* a2 = last ? nA : cA + (size_t)(t + 2) * kstep; const char* b2 = last ? nB : cB + (size_t)(t + 2) * kstep;
      const char* a3 = a2 + kstep; const char* b3 = b2 + kstep;
      PG8_LDB(B0, 0, 0); PG8_SCHED; PG8_LDA(At, 0, 0); PG8_STAGE(PG8_SA(1, 1), a1 + hstep, voffA);
      PG8_WAIT_L(8); PG8_BAR; PG8_WAIT_L(0); PG8_MMA(0, 0, At, B0); PG8_BAR; PG8_SCHED;
      PG8_LDB(B1, 0, 1); PG8_STAGE(PG8_SB(0, 0), b2, voffB);
      PG8_BAR; PG8_WAIT_L(0); PG8_MMA(0, 1, At, B1); PG8_BAR;
      PG8_LDA(At, 0, 1); PG8_STAGE(PG8_SA(0, 0), a2, voffA);
      PG8_BAR; PG8_WAIT_L(0); PG8_MMA(1, 0, At, B0); PG8_BAR; PG8_SCHED;
      PG8_STAGE(PG8_SB(0, 1), b2 + hstep, voffB);
      PG8_WAIT_V(6); PG8_BAR; PG8_MMA(1, 1, At, B1); PG8_BAR;
      PG8_LDB(B0, 1, 0); PG8_SCHED; PG8_LDA(At, 1, 0); PG8_STAGE(PG8_SA(0, 1), a2 + hstep, voffA);
      PG8_WAIT_L(8); PG8_BAR; PG8_WAIT_L(0); PG8_MMA(0, 0, At, B0); PG8_BAR; PG8_SCHED;
      PG8_LDB(B1, 1, 1); PG8_STAGE(PG8_SB(1, 0), b3, voffB);
      PG8_BAR; PG8_WAIT_L(0); PG8_MMA(0, 1, At, B1); PG8_BAR;
      PG8_LDA(At, 1, 1); PG8_STAGE(PG8_SA(1, 0), a3, voffA);
      PG8_BAR; PG8_WAIT_L(0); PG8_MMA(1, 0, At, B0); PG8_BAR; PG8_SCHED;
      PG8_STAGE(PG8_SB(1, 1), b3 + hstep, voffB);
      PG8_WAIT_V(6); PG8_BAR; PG8_MMA(1, 1, At, B1); PG8_BAR;
    }
    PG8_SCHED;
    if constexpr (Epi::MODE == 2) asm volatile("s_nop 15\n\ts_nop 15\n\ts_nop 15\n\ts_nop 15" ::: "memory");
    { const int l2 = otid() & 63; E(acc, cur, wr, wc, l2 & 15, l2 >> 4); }
    PG8_SCHED;
    if (!has_next) break;
#pragma unroll
    for (int a = 0; a < 2; ++a)
#pragma unroll
      for (int b = 0; b < 2; ++b)
#pragma unroll
        for (int m = 0; m < 4; ++m)
#pragma unroll
          for (int n = 0; n < 2; ++n) acc[a][b][m][n] = zacc;
    cur = nxt; cA = nA; cB = nB; ++ui;
  }
  PG8_WAIT_V(0);
  if (wr == 0) PG8_BAR;
  PG8_BAR;
#undef PG8_SA
#undef PG8_SB
#undef PG8_STAGE
#undef PG8_LDA
#undef PG8_LDB
#undef PG8_MMA
#undef PG8_WAIT_V
#undef PG8_WAIT_L
#undef PG8_BAR
#undef PG8_SCHED
}
}

struct EpiProj {
  static constexpr bool PERM = true;
  static constexpr int MODE = 1;
  typedef i32x4 AccT;
  char* ws; const float* b_merge;
  DI void operator()(const i32x4 (&acc)[2][2][4][2], const pg8::Unit& u, int wr, int wc, int fr, int fq) const {
    const float* rope = (const float*)(ws + OFF_ROPE);
    const float* sa = (const float*)(ws + OFF_SA); const float* sw = (const float*)(ws + OFF_SCW1);
    const int row0 = u.pm * 256 + wr * 64 + fr;
#pragma unroll
    for (int bj = 0; bj < 2; ++bj) {
      const int cg = u.pn * 256 + bj * 128 + wc * 32;
      const int c0 = cg + 8 * fq;
      if (cg >= 4384) continue;
      const float sbg = sw[cg >> 5];
#define EPJ_CV(sc_) const float f_ = sa[row] * (sc_); const f32x4 cv0 = __builtin_convertvector(acc[ai][bj][m][0], f32x4) * f_, cv1 = __builtin_convertvector(acc[ai][bj][m][1], f32x4) * f_;
      if (cg < 1280 && (cg < 640 || (cg >= 768 && cg < 896) || (cg >= 1024 && cg < 1152))) {
        bf16_t* dst; unsigned ld, cofs; float scale = 1.0f;
        if (cg < 512) { dst = (bf16_t*)(ws + OFF_Q); ld = 512; cofs = c0; scale = 0.18033688011112042f; }
        else if (cg < 640) { dst = (bf16_t*)(ws + OFF_KC); ld = 128; cofs = c0 - 512; }
        else if (cg < 896) { dst = (bf16_t*)(ws + OFF_KS); ld = 128; cofs = c0 - 768; }
        else { dst = (bf16_t*)(ws + OFF_KW); ld = 128; cofs = c0 - 1024; }
        const int d0 = 16 * ((cg >> 5) & 1) + 4 * fq;
#pragma unroll
        for (int ai = 0; ai < 2; ++ai)
#pragma unroll
          for (int m = 0; m < 4; ++m) {
            const int row = row0 + ai * 128 + m * 16, pos = row & (SEQ - 1);
            const f32x4 cs = *(const f32x4*)(rope + pos * 32 + d0), sn = *(const f32x4*)(rope + 262144 + pos * 32 + d0);
            EPJ_CV(sbg * scale)
            const f32x4 o1 = cv0 * cs - cv1 * sn, o2 = cv0 * sn + cv1 * cs;
            u32x4 w; w.x = pack2(o1.x, o1.y); w.y = pack2(o1.z, o1.w); w.z = pack2(o2.x, o2.y); w.w = pack2(o2.z, o2.w);
            *(u32x4*)(dst + (unsigned)row * ld + cofs) = w;
          }
      } else if (cg < 1280) {
        bf16_t* dst; unsigned cofs;
        if (cg < 768) { dst = (bf16_t*)(ws + OFF_VC); cofs = c0 - 640; }
        else if (cg < 1024) { dst = (bf16_t*)(ws + OFF_VS); cofs = c0 - 896; }
        else { dst = (bf16_t*)(ws + OFF_VW); cofs = c0 - 1152; }
#pragma unroll
        for (int ai = 0; ai < 2; ++ai)
#pragma unroll
          for (int m = 0; m < 4; ++m) {
            const int row = row0 + ai * 128 + m * 16;
            EPJ_CV(sbg)
            const f32x4 a = cv0, b = cv1;
            u32x4 w; w.x = pack2(a.x, a.y); w.y = pack2(a.z, a.w); w.z = pack2(b.x, b.y); w.w = pack2(b.z, b.w);
            *(u32x4*)(dst + (unsigned)row * 128u + cofs) = w;
          }
      } else if (cg < 2304) {
        bf16_t* dst = (bf16_t*)(ws + (cg < 1792 ? OFF_U : OFF_V));
        const unsigned cofs = c0 - (cg < 1792 ? 1280 : 1792);
#pragma unroll
        for (int ai = 0; ai < 2; ++ai)
#pragma unroll
          for (int m = 0; m < 4; ++m) {
            const int row = row0 + ai * 128 + m * 16;
            EPJ_CV(sbg)
            const f32x4 a = cv0, b = cv1;
            const f32x2 g0 = gelu_pk((f32x2){a.x, a.y}), g1 = gelu_pk((f32x2){a.z, a.w}), g2 = gelu_pk((f32x2){b.x, b.y}), g3 = gelu_pk((f32x2){b.z, b.w});
            u32x4 w; w.x = pack2(g0.x, g0.y); w.y = pack2(g1.x, g1.y); w.z = pack2(g2.x, g2.y); w.w = pack2(g3.x, g3.y);
            *(u32x4*)(dst + (unsigned)row * 512u + cofs) = w;
          }
      } else if (cg < 4352) {
        unsigned char* dst = (unsigned char*)(ws + OFF_GATE8);
        const unsigned cofs = c0 - 2304;
        const f32x4 b0 = *(const f32x4*)(b_merge + cofs), b1 = *(const f32x4*)(b_merge + cofs + 4);
#pragma unroll
        for (int ai = 0; ai < 2; ++ai)
#pragma unroll
          for (int m = 0; m < 4; ++m) {
            const int row = row0 + ai * 128 + m * 16;
            EPJ_CV(sbg)
            const f32x4 a = cv0 + b0, b = cv1 + b1;
            u32x2 w; w.x = pk4_fp8(sigmoid_f(a.x), sigmoid_f(a.y), sigmoid_f(a.z), sigmoid_f(a.w));
            w.y = pk4_fp8(sigmoid_f(b.x), sigmoid_f(b.y), sigmoid_f(b.z), sigmoid_f(b.w));
            *(u32x2*)(dst + (unsigned)row * 2048u + cofs) = w;
          }
      } else {
        float* gs = (float*)(ws + OFF_GSIG);
        if (fq < 3) {
#pragma unroll
          for (int ai = 0; ai < 2; ++ai)
#pragma unroll
            for (int m = 0; m < 4; ++m) {
              const int row = row0 + ai * 128 + m * 16;
              EPJ_CV(sbg)
              const f32x4 a = cv0, b = cv1;
              f32x4 o0, o1; o0.x = sigmoid_f(a.x); o0.y = sigmoid_f(a.y); o0.z = sigmoid_f(a.z); o0.w = sigmoid_f(a.w);
              o1.x = sigmoid_f(b.x); o1.y = sigmoid_f(b.y); o1.z = sigmoid_f(b.z); o1.w = sigmoid_f(b.w);
              *(f32x4*)(gs + (unsigned)row * 32u + 8 * fq) = o0; *(f32x4*)(gs + (unsigned)row * 32u + 8 * fq + 4) = o1;
            }
        }
      }
    }
  }
};
DI void phase_gemm1(const Params& p, char* smem) {
  pg8::Gemm g{(const bf16_t*)(p.ws + OFF_H), (const bf16_t*)(p.ws + OFF_WT1), NTOK, N1, 512};
  pg8::StaticOrder S; S.init(NTOK, N1, gridDim.x, blockIdx.x);
  EpiProj E{p.ws, p.b_merge};
  pg8::gemm_phase((LAS unsigned char*)smem, g, S, E);
}

template <int BR> struct EpiMerge {
  static constexpr bool PERM = true;
  static constexpr int MODE = 2;
  typedef f32x4 AccT;
  char* ws;
  DI void operator()(const f32x4 (&acc)[2][2][4][2], const pg8::Unit& u, int wr, int wc, int fr, int fq) const {
    const unsigned char* gate = (const unsigned char*)(ws + OFF_GATE8);
    unsigned char* m0 = (unsigned char*)(ws + OFF_M08);
    unsigned char* mrg = (unsigned char*)(ws + OFF_MRG8);
    const float* sw = (const float*)(ws + OFF_SCWB) + BR * 32;
    const int row0 = u.pm * 256 + wr * 64 + fr;
#pragma unroll
    for (int bj = 0; bj < 2; ++bj) {
      const unsigned cgp = u.pn * 256 + bj * 128 + wc * 32, c0 = cgp + 8 * fq;
      const float f = sw[cgp >> 5] * (BR == 0 ? 1.0f : 2.0f);
#pragma unroll
      for (int ai = 0; ai < 2; ++ai)
#pragma unroll
        for (int m = 0; m < 4; ++m) {
          const unsigned row = row0 + ai * 128 + m * 16;
          float gg[8]; unpack8_fp8(*(const u32x2*)(gate + row * 2048u + BR * 1024 + c0), gg);
          const f32x4 a = acc[ai][bj][m][0] * f, b = acc[ai][bj][m][1] * f;
          float v[8] = {a.x * gg[0], a.y * gg[1], a.z * gg[2], a.w * gg[3], b.x * gg[4], b.y * gg[5], b.z * gg[6], b.w * gg[7]};
          if (BR == 1) {
            float old[8]; unpack8_fp8(*(const u32x2*)(m0 + row * 1024u + c0), old);
#pragma unroll
            for (int j = 0; j < 8; ++j) v[j] += old[j];
          }
#pragma unroll
          for (int j = 0; j < 8; ++j) v[j] = clamp_f8(v[j]);
          u32x2 w; w.x = pk4_fp8(v[0], v[1], v[2], v[3]); w.y = pk4_fp8(v[4], v[5], v[6], v[7]);
          *(u32x2*)((BR == 0 ? m0 : mrg) + row * 1024u + c0) = w;
        }
    }
  }
};
DI void phase_merge(const Params& p, char* smem) {
  pg8::StaticOrder S; S.init(NTOK, 1024, gridDim.x, blockIdx.x);
  {
    pg8::Gemm g{(const bf16_t*)(p.ws + OFF_ONSA8), (const bf16_t*)(p.ws + OFF_WB), NTOK, 1024, 256};
    EpiMerge<0> E{p.ws};
    pg8::gemm_phase((LAS unsigned char*)smem, g, S, E);
  }
  {
    pg8::Gemm g{(const bf16_t*)(p.ws + OFF_OSGU8), (const bf16_t*)(p.ws + OFF_WB + (size_t)1024 * 512), NTOK, 1024, 256};
    EpiMerge<1> E{p.ws};
    pg8::gemm_phase((LAS unsigned char*)smem, g, S, E);
  }
}

struct EpiOut {
  static constexpr bool PERM = true;
  static constexpr int MODE = 2;
  typedef f32x4 AccT;
  char* ws; const float* x;
  DI void operator()(const f32x4 (&acc)[2][2][4][2], const pg8::Unit& u, int wr, int wc, int fr, int fq) const {
    const float* mod = (const float*)(ws + OFF_MOD);
    bf16_t* y = (bf16_t*)(ws + OFF_Y);
    const int row0 = u.pm * 256 + wr * 64 + fr, b = (u.pm * 256) >> 13;
#pragma unroll
    for (int bj = 0; bj < 2; ++bj) {
      const unsigned c0 = u.pn * 256 + bj * 128 + wc * 32 + 8 * fq;
      const float f = ((const float*)(ws + OFF_SCWO))[c0 >> 5] * 0.0625f;
      const f32x4 g0 = *(const f32x4*)(mod + b * 6144 + 2048 + c0) * f, g1 = *(const f32x4*)(mod + b * 6144 + 2048 + c0 + 4) * f;
#pragma unroll
      for (int ai = 0; ai < 2; ++ai)
#pragma unroll
        for (int m = 0; m < 4; ++m) {
          const unsigned o = (unsigned)(row0 + ai * 128 + m * 16) * 1024u + c0;
          const f32x4 x0 = *(const f32x4*)(x + o), x1v = *(const f32x4*)(x + o + 4);
          const f32x4 v0 = x0 * DN_ALPHA + g0 * acc[ai][bj][m][0], v1 = x1v * DN_ALPHA + g1 * acc[ai][bj][m][1];
          u32x4 w; w.x = pack2(v0.x, v0.y); w.y = pack2(v0.z, v0.w); w.z = pack2(v1.x, v1.y); w.w = pack2(v1.z, v1.w);
          *(u32x4*)(y + o) = w;
        }
    }
  }
};
DI void phase_outproj(const Params& p, char* smem) {
  pg8::Gemm g{(const bf16_t*)(p.ws + OFF_MRG8), (const bf16_t*)(p.ws + OFF_WOUT), NTOK, 1024, 512};
  pg8::StaticOrder S; S.init(NTOK, 1024, gridDim.x, blockIdx.x);
  EpiOut E{p.ws, p.x};
  pg8::gemm_phase((LAS unsigned char*)smem, g, S, E);
}

struct EpiPq {
  static constexpr bool PERM = true;
  static constexpr int MODE = 1;
  typedef i32x4 AccT;
  char* ws;
  DI void operator()(const i32x4 (&acc)[2][2][4][2], const pg8::Unit& u, int wr, int wc, int fr, int fq) const {
    bf16_t* pq = (bf16_t*)(ws + OFF_PQ);
    const float* sh = (const float*)(ws + OFF_SH); const float* sq = (const float*)(ws + OFF_SCWQ);
    const int row0 = u.pm * 256 + wr * 64 + fr;
#pragma unroll
    for (int bj = 0; bj < 2; ++bj) {
      const unsigned c0 = u.pn * 256 + bj * 128 + wc * 32 + 8 * fq;
      const float sbg = sq[(u.pn * 256 + bj * 128 + wc * 32) >> 5];
#pragma unroll
      for (int ai = 0; ai < 2; ++ai)
#pragma unroll
        for (int m = 0; m < 4; ++m) {
          const float f_ = sh[row0 + ai * 128 + m * 16] * sbg;
          const f32x4 a = __builtin_convertvector(acc[ai][bj][m][0], f32x4) * f_, b = __builtin_convertvector(acc[ai][bj][m][1], f32x4) * f_;
          u32x4 w; w.x = pack2(a.x, a.y); w.y = pack2(a.z, a.w); w.z = pack2(b.x, b.y); w.w = pack2(b.z, b.w);
          *(u32x4*)(pq + (unsigned)(row0 + ai * 128 + m * 16) * 2048u + c0) = w;
        }
    }
  }
};
DI void phase_peerq(const Params& p, char* smem) {
  pg8::Gemm g{(const bf16_t*)(p.ws + OFF_H2Q), (const bf16_t*)(p.ws + OFF_WQ), NTOK, 2048, 512};
  pg8::StaticOrder S; S.init(NTOK, 2048, gridDim.x, blockIdx.x);
  EpiPq E{p.ws};
  pg8::gemm_phase((LAS unsigned char*)smem, g, S, E);
}

DI void phase_sgu(const Params& p, char* smem) {
  char* ws = p.ws;
  const int tid = otid(), lane = tid & 63, wave = tid >> 6, l31 = lane & 31, hh = lane >> 5;
  const bf16_t* u = (const bf16_t*)(ws + OFF_U);
  const bf16_t* v = (const bf16_t*)(ws + OFF_V);
  const bf16_t* W = (const bf16_t*)(ws + OFF_SGUW);
  float* st = (float*)smem;
  bf16_t* vn = (bf16_t*)(smem + 1024);
  constexpr int LN_ = 72;
  const int dt = wave & 1, it = wave >> 1;
  const int gi = lane >> 4, i16 = lane & 15, tq = i16 >> 2, tp = i16 & 3;
  for (int item = blockIdx.x; item < NTOK / 128; item += gridDim.x) {
    const int t0 = item * 128;
    __syncthreads();
    for (int i = 0; i < 16; ++i) {
      const int t = wave * 16 + i;
      const u32x4 raw = *(const u32x4*)(v + (size_t)(t0 + t) * 512 + lane * 8);
      float f[8]; unpack8(raw, f);
      float s = 0.f;
#pragma unroll
      for (int j = 0; j < 8; ++j) s += f[j];
      const float mean = wave_sum(s) * (1.f / 512.f);
      float q = 0.f;
#pragma unroll
      for (int j = 0; j < 8; ++j) { const float d = f[j] - mean; q += d * d; }
      const float rstd = rsqrtf(wave_sum(q) * (1.f / 512.f) + LN_EPS);
      if (lane == 0) { st[t * 2] = mean; st[t * 2 + 1] = rstd; }
    }
    u32x4 vnext[2];
#pragma unroll
    for (int i = 0; i < 2; ++i) { const int idx = tid + i * NT; vnext[i] = *(const u32x4*)(v + (size_t)(t0 + (idx >> 3)) * 512 + (idx & 7) * 8); }
    for (int g = 0; g < 8; ++g) {
      u32x4 vcur[2] = {vnext[0], vnext[1]};
      if (g + 1 < 8) {
#pragma unroll
        for (int i = 0; i < 2; ++i) { const int idx = tid + i * NT; vnext[i] = *(const u32x4*)(v + (size_t)(t0 + (idx >> 3)) * 512 + (g + 1) * 64 + (idx & 7) * 8); }
      }
      u32x2 uold[4];
      {
        const bf16_t* urow0 = u + (size_t)(t0 + it * 32 + l31) * 512 + g * 64 + dt * 32 + 4 * hh;
#pragma unroll
        for (int q4 = 0; q4 < 4; ++q4) uold[q4] = *(const u32x2*)(urow0 + 8 * q4);
      }
      lds_barrier();
#pragma unroll
      for (int i = 0; i < 2; ++i) {
        const int idx = tid + i * NT, j = idx >> 3, dc = (idx & 7) * 8;
        const u32x4 raw = vcur[i];
        const float mean = st[j * 2], rstd = st[j * 2 + 1];
        float f[8], gg[8], bb[8]; unpack8(raw, f); ld8(p.sgu_ln_g + g * 64 + dc, gg); ld8(p.sgu_ln_b + g * 64 + dc, bb);
#pragma unroll
        for (int k = 0; k < 8; ++k) f[k] = (f[k] - mean) * rstd * gg[k] + bb[k];
        *(u32x4*)(vn + j * LN_ + dc) = pack8(f);
      }
      lds_barrier();
      f32x16 acc;
#pragma unroll
      for (int r = 0; r < 16; ++r) acc[r] = 0.f;
      const bf16_t* wrow = W + ((size_t)g * 128 + it * 32 + l31) * 128 + hh * 8;
      const LAS bf16_t* vbase = (const LAS bf16_t*)vn + (8 * (gi >> 1) + tq) * LN_ + dt * 32 + 16 * (gi & 1) + 4 * tp;
#pragma unroll
      for (int ks = 0; ks < 8; ++ks) {
        if (ks <= 2 * it + 1) {
          const LAS bf16_t* vp = vbase + (ks * 16) * LN_;
          const s16x4 lo = __builtin_amdgcn_ds_read_tr16_b64_v4i16((LAS s16x4*)vp);
          const s16x4 hi = __builtin_amdgcn_ds_read_tr16_b64_v4i16((LAS s16x4*)(vp + 4 * LN_));
          const bf16x8 bw = *(const bf16x8*)(wrow + ks * 16);
          acc = MFMA32(__builtin_shufflevector(lo, hi, 0, 1, 2, 3, 4, 5, 6, 7), bw, acc);
        }
      }
      const int i = it * 32 + l31;
      const float bsv = p.sgu_b[g * 128 + i];
      unsigned char* orow = (unsigned char*)(ws + OFF_OSGU8) + (size_t)(t0 + i) * 512 + g * 64 + dt * 32 + 4 * hh;
#pragma unroll
      for (int q4 = 0; q4 < 4; ++q4) {
        const u32x2 old = uold[q4];
        *(unsigned*)(orow + 8 * q4) = pk4_fp8(clamp_f8(8.0f * bflo(old.x) * (acc[4 * q4] + bsv)), clamp_f8(8.0f * bfhi(old.x) * (acc[4 * q4 + 1] + bsv)),
                                              clamp_f8(8.0f * bflo(old.y) * (acc[4 * q4 + 2] + bsv)), clamp_f8(8.0f * bfhi(old.y) * (acc[4 * q4 + 3] + bsv)));
      }
    }
  }
}

DI void phase_compress(const Params& p, char* smem) {
  char* ws = p.ws;
  const int tid = otid(), lane = tid & 63, wave = tid >> 6, l31 = lane & 31, hh = lane >> 5;
  bf16_t* hid = (bf16_t*)smem;
  constexpr int LH = 136;
  for (int item = blockIdx.x; item < 128; item += gridDim.x) {
    const int w = item >> 6, R0 = (item & 63) * 128;
    const bf16_t* src = (const bf16_t*)(ws + (w == 0 ? OFF_KC : OFF_VC));
    const bf16_t* W1 = (const bf16_t*)(ws + OFF_CW1) + (size_t)w * 128 * 2048;
    const bf16_t* W2 = (const bf16_t*)(ws + OFF_CW2) + (size_t)w * 64 * 128;
    const float* posb = (const float*)(ws + OFF_POSB) + w * 128;
    const int rg = wave >> 2, cgp = wave & 3;
    const bf16_t* abase[2];
#pragma unroll
    for (int mi = 0; mi < 2; ++mi) {
      const int R = R0 + rg * 64 + mi * 32 + l31, bg = R >> 9, n = R & 511, nn = n < 510 ? n : 510;
      abase[mi] = src + ((size_t)((bg >> 1) * SEQ + 16 * nn)) * 128 + (bg & 1) * 64 + hh * 8;
    }
    const bf16_t* bbase = W1 + (size_t)(cgp * 32 + l31) * 2048 + hh * 8;
    f32x16 acc[2];
#pragma unroll
    for (int r = 0; r < 16; ++r) { acc[0][r] = 0.f; acc[1][r] = 0.f; }
#pragma unroll 8
    for (int ks = 0; ks < 128; ++ks) {
      const int aofs = (ks >> 2) * 128 + (ks & 3) * 16;
      const bf16x8 a0 = *(const bf16x8*)(abase[0] + aofs), a1 = *(const bf16x8*)(abase[1] + aofs);
      const bf16x8 bb = *(const bf16x8*)(bbase + ks * 16);
      acc[0] = MFMA32(a0, bb, acc[0]); acc[1] = MFMA32(a1, bb, acc[1]);
    }
    __syncthreads();
    {
      const float pb = posb[cgp * 32 + l31];
#pragma unroll
      for (int mi = 0; mi < 2; ++mi)
#pragma unroll
        for (int r = 0; r < 16; ++r) {
          const int row = rg * 64 + mi * 32 + (r & 3) + 8 * (r >> 2) + 4 * hh;
          hid[row * LH + cgp * 32 + l31] = f2bf(gelu_f(acc[mi][r] + pb));
        }
    }
    __syncthreads();
    const int mi2 = wave >> 1, ni = wave & 1;
    f32x16 o;
#pragma unroll
    for (int r = 0; r < 16; ++r) o[r] = 0.f;
#pragma unroll
    for (int ks = 0; ks < 8; ++ks) {
      const bf16x8 a = *(const bf16x8*)(hid + (mi2 * 32 + l31) * LH + ks * 16 + hh * 8);
      const bf16x8 bb = *(const bf16x8*)(W2 + (size_t)(ni * 32 + l31) * 128 + ks * 16 + hh * 8);
      o = MFMA32(a, bb, o);
    }
    const int d = ni * 32 + l31;
    const float b2 = p.cmp_b2[w * 64 + (w == 0 ? dperm(d) : d)];
    const int bg = R0 >> 9;
    bf16_t* dst = (bf16_t*)(ws + (w == 0 ? OFF_KCMP : OFF_VCMP));
#pragma unroll
    for (int r = 0; r < 16; ++r) {
      const int n = (R0 & 511) + mi2 * 32 + (r & 3) + 8 * (r >> 2) + 4 * hh;
      dst[((size_t)bg * 512 + n) * 64 + d] = f2bf(n < 511 ? o[r] + b2 : 0.f);
    }
  }
}

constexpr int LK = 72;
constexpr int NSA_TILE = 18432;
constexpr int NSA_AIMP = 3 * NSA_TILE, NSA_CIMP = NSA_AIMP + 32768, NSA_SELM = NSA_CIMP + 32768;
constexpr float NSA_THR = 6.0f;
struct TileRegs { u32x4 k; u32x4 v; };

DI void nsa_load_tile(TileRegs& t, const bf16_t* kbase, size_t kstride, const bf16_t* vbase, size_t vstride) {
  const int tid = otid(), r = tid >> 3, ch = tid & 7;
  t.k = *(const u32x4*)(kbase + (size_t)r * kstride + ch * 8);
  t.v = *(const u32x4*)(vbase + (size_t)r * vstride + ch * 8);
}
DI void nsa_store_tile(const TileRegs& t, char* tile) {
  const int tid = otid(), r = tid >> 3, ch = tid & 7;
  *(u32x4*)((bf16_t*)tile + r * LK + ch * 8) = t.k;
  *(u32x4*)((bf16_t*)(tile + 9216) + r * LK + ch * 8) = t.v;
}
DI void nsa_scores(f32x16 (&st)[2], const char* tile, const bf16x8 (&qf)[4], int lane) {
  const bf16_t* Ks = (const bf16_t*)tile;
#pragma unroll
  for (int kt = 0; kt < 2; ++kt)
#pragma unroll
    for (int r = 0; r < 16; ++r) st[kt][r] = 0.f;
  __builtin_amdgcn_s_setprio(1);
#pragma unroll
  for (int ks = 0; ks < 4; ++ks)
#pragma unroll
    for (int kt = 0; kt < 2; ++kt) {
      const bf16x8 a = *(const bf16x8*)(Ks + (kt * 32 + (lane & 31)) * LK + ks * 16 + (lane >> 5) * 8);
      st[kt] = MFMA32(a, qf[ks], st[kt]);
    }
  __builtin_amdgcn_s_setprio(0);
}
DI void nsa_pv(f32x16 (&o)[2], const f32x16 (&pt)[2], const char* tile, int lane) {
  const int gi = lane >> 4, i16 = lane & 15, q = i16 >> 2, pp = i16 & 3;
  const LAS bf16_t* Vs = (const LAS bf16_t*)(tile + 9216) + (4 * (gi >> 1) + q) * LK + 16 * (gi & 1) + 4 * pp;
#pragma unroll
  for (int kt = 0; kt < 2; ++kt)
#pragma unroll
    for (int s = 0; s < 2; ++s) {
      u32x4 pk; pk.x = pack2(pt[kt][8 * s], pt[kt][8 * s + 1]); pk.y = pack2(pt[kt][8 * s + 2], pt[kt][8 * s + 3]);
      pk.z = pack2(pt[kt][8 * s + 4], pt[kt][8 * s + 5]); pk.w = pack2(pt[kt][8 * s + 6], pt[kt][8 * s + 7]);
      const bf16x8 pb = __builtin_bit_cast(bf16x8, pk);
      bf16x8 a[2];
#pragma unroll
      for (int dt = 0; dt < 2; ++dt) {
        const LAS bf16_t* vp = Vs + (kt * 32 + 16 * s) * LK + dt * 32;
        const s16x4 lo = __builtin_amdgcn_ds_read_tr16_b64_v4i16((LAS s16x4*)vp);
        const s16x4 hi = __builtin_amdgcn_ds_read_tr16_b64_v4i16((LAS s16x4*)(vp + 8 * LK));
        a[dt] = __builtin_shufflevector(lo, hi, 0, 1, 2, 3, 4, 5, 6, 7);
      }
      o[0] = MFMA32(a[0], pb, o[0]); o[1] = MFMA32(a[1], pb, o[1]);
    }
}

constexpr float NSA_NEG = -3.0e38f;
DI void nsa_online(f32x16 (&st)[2], bool sel, float& m, float& l, f32x16 (&o)[2], const char* tile, int lane) {
  float mx = NSA_NEG;
#pragma unroll
  for (int r = 0; r < 16; ++r) mx = fmaxf(mx, fmaxf(st[0][r], st[1][r]));
  mx = fmaxf(mx, xor32f(mx, lane));
  mx = sel ? mx : NSA_NEG;
  if (__any(mx > m + NSA_THR)) {
    const float mn = fmaxf(m, mx);
    const float alpha = __builtin_amdgcn_exp2f(m - mn);
    m = mn; l *= alpha;
#pragma unroll
    for (int r = 0; r < 16; ++r) { o[0][r] *= alpha; o[1][r] *= alpha; }
  }
  const float ms = sel ? m : 1e30f;
  float sum = 0.f;
#pragma unroll
  for (int r = 0; r < 16; ++r) {
    const float p0 = __builtin_amdgcn_exp2f(st[0][r] - ms), p1 = __builtin_amdgcn_exp2f(st[1][r] - ms);
    st[0][r] = p0; st[1][r] = p1; sum += p0 + p1;
  }
  l += sum;
  nsa_pv(o, st, tile, lane);
}

struct NsaItem { int qb, b, g, bg, t; size_t tokrow; };
DI NsaItem nsa_item(int item0, int wave, int qi) {
  const int G = gridDim.x, k = item0 / G, bb = item0 - k * G;
  const int item = (k & 1) ? (k * G + (G - 1 - bb)) : item0;
  NsaItem it; it.qb = 127 - (item >> 4); const int rest = item & 15; it.b = rest >> 1; it.g = rest & 1;
  it.bg = it.b * 2 + it.g; it.t = it.qb * 64 + wave * 8 + qi; it.tokrow = (size_t)it.b * SEQ + it.t; return it;
}
DI void nsa_accum_store(bf16_t* dst, const f32x16 (&o)[2], float sc, bool first, int hh, unsigned char* dst8 = nullptr) {
#pragma unroll
  for (int dt = 0; dt < 2; ++dt)
#pragma unroll
    for (int q4 = 0; q4 < 4; ++q4) {
      u32x2* pp = (u32x2*)(dst + dt * 32 + 8 * q4 + 4 * hh);
      float a0 = sc * o[dt][4 * q4], a1 = sc * o[dt][4 * q4 + 1], a2 = sc * o[dt][4 * q4 + 2], a3 = sc * o[dt][4 * q4 + 3];
      if (!first) { const u32x2 old = *pp; a0 += bflo(old.x); a1 += bfhi(old.x); a2 += bflo(old.y); a3 += bfhi(old.y); }
      if (dst8) *(unsigned*)(dst8 + dt * 32 + 8 * q4 + 4 * hh) = pk4_fp8(clamp_f8(16.0f * a0), clamp_f8(16.0f * a1), clamp_f8(16.0f * a2), clamp_f8(16.0f * a3));
      else { u32x2 wv; wv.x = pack2(a0, a1); wv.y = pack2(a2, a3); *pp = wv; }
    }
}

constexpr int NSA_STAGE = 4 * 18432;
typedef float f32x4v __attribute__((ext_vector_type(4)));
#define MFMA16(a, b, c) __builtin_amdgcn_mfma_f32_16x16x32_bf16((a), (b), (c), 0, 0, 0)
struct StageRegs { u32x4 r[8]; };
DI void nsa_load_stage(StageRegs& sr, const bf16_t* kb, const bf16_t* vb, int j0s, int qb) {
  const int tid = otid(), r = tid >> 3, ch = tid & 7;
#pragma unroll
  for (int tt = 0; tt < 4; ++tt) {
    const int j = (j0s + tt <= qb) ? j0s + tt : qb;
    sr.r[2 * tt] = *(const u32x4*)(kb + ((size_t)j * 64 + r) * 128 + ch * 8);
    sr.r[2 * tt + 1] = *(const u32x4*)(vb + ((size_t)j * 64 + r) * 128 + ch * 8);
  }
}
DI void nsa_store_stage(const StageRegs& sr, char* stage) {
  const int tid = otid(), r = tid >> 3, ch = tid & 7;
#pragma unroll
  for (int tt = 0; tt < 4; ++tt) {
    *(u32x4*)((bf16_t*)(stage + tt * 18432) + r * LK + ch * 8) = sr.r[2 * tt];
    *(u32x4*)((bf16_t*)(stage + tt * 18432 + 9216) + r * LK + ch * 8) = sr.r[2 * tt + 1];
  }
}
struct Sel16 { float m, l; bool has; f32x4v o[4]; };
DI void nsa_unit16(Sel16& g, const char* tile, const bf16x8 (&qf)[2], bool sel, int klim  , int lane) {
  const int c16 = lane & 15, kg = lane >> 4, tq = c16 >> 2, tp = c16 & 3;
  const bf16_t* Ks = (const bf16_t*)tile + c16 * LK + kg * 8;
  f32x4v st[4];
  const float ini = sel ? -g.m : -1e30f;
#pragma unroll
  for (int kt = 0; kt < 4; ++kt) {
    st[kt] = (f32x4v){ini, ini, ini, ini};
#pragma unroll
    for (int ks = 0; ks < 2; ++ks) st[kt] = MFMA16(*(const bf16x8*)(Ks + kt * 16 * LK + ks * 32), qf[ks], st[kt]);
  }
  if (klim < 64) {
#pragma unroll
    for (int kt = 0; kt < 4; ++kt)
#pragma unroll
      for (int r = 0; r < 4; ++r) st[kt][r] = (kt * 16 + 4 * kg + r <= klim) ? st[kt][r] : NSA_NEG;
  }
  float mx = fmaxf(fmaxf(fmaxf(st[0][0], st[0][1]), fmaxf(st[0][2], st[0][3])), fmaxf(fmaxf(st[1][0], st[1][1]), fmaxf(st[1][2], st[1][3])));
  mx = fmaxf(mx, fmaxf(fmaxf(fmaxf(st[2][0], st[2][1]), fmaxf(st[2][2], st[2][3])), fmaxf(fmaxf(st[3][0], st[3][1]), fmaxf(st[3][2], st[3][3]))));
  mx = fmaxf(mx, xor16f(mx, lane));
  mx = fmaxf(mx, xor32f(mx, lane));
  const bool real = mx > -1e29f;
  const bool fresh = !g.has && real, up = g.has && (mx > NSA_THR);
  if (__any(fresh || up)) {
    const float delta = (fresh || up) ? mx : 0.f;
    const float alpha = up ? __builtin_amdgcn_exp2f(-delta) : 1.0f;
    g.m += delta; g.l *= alpha;
#pragma unroll
    for (int dt = 0; dt < 4; ++dt) g.o[dt] *= alpha;
#pragma unroll
    for (int kt = 0; kt < 4; ++kt) st[kt] -= delta;
  }
  g.has = g.has || real;
  float sum = 0.f;
#pragma unroll
  for (int kt = 0; kt < 4; ++kt)
#pragma unroll
    for (int r = 0; r < 4; ++r) { const float pv = __builtin_amdgcn_exp2f(st[kt][r]); st[kt][r] = pv; sum += pv; }
  g.l += sum;
  const LAS bf16_t* Vs = (const LAS bf16_t*)(tile + 9216) + (4 * kg + tq) * LK + 4 * tp;
#pragma unroll
  for (int kp = 0; kp < 2; ++kp) {
    u32x4 pk; pk.x = pack2(st[2 * kp][0], st[2 * kp][1]); pk.y = pack2(st[2 * kp][2], st[2 * kp][3]);
    pk.z = pack2(st[2 * kp + 1][0], st[2 * kp + 1][1]); pk.w = pack2(st[2 * kp + 1][2], st[2 * kp + 1][3]);
    const bf16x8 pb = __builtin_bit_cast(bf16x8, pk);
#pragma unroll
    for (int dt = 0; dt < 4; ++dt) {
      const LAS bf16_t* vp = Vs + (2 * kp) * 16 * LK + dt * 16;
      const s16x4 lo = __builtin_amdgcn_ds_read_tr16_b64_v4i16((LAS s16x4*)vp);
      const s16x4 hi = __builtin_amdgcn_ds_read_tr16_b64_v4i16((LAS s16x4*)(vp + 16 * LK));
      g.o[dt] = MFMA16(__builtin_shufflevector(lo, hi, 0, 1, 2, 3, 4, 5, 6, 7), pb, g.o[dt]);
    }
  }
}
DI void nsa_sel16(const Params& p, char* smem, bool dry) {
  char* ws = p.ws;
  const int tid = otid(), lane = tid & 63, wave = tid >> 6, c16 = lane & 15, kg = lane >> 4, qi4 = c16 >> 2, r4 = c16 & 3;
  const bf16_t* Q = (const bf16_t*)(ws + OFF_Q);
  const float* gsig = (const float*)(ws + OFF_GSIG);
  bf16_t* ONSA = (bf16_t*)(ws + OFF_ONSA);
  const u32x4* SELG = (const u32x4*)(ws + OFF_SELG);
  const bf16_t* KS = (const bf16_t*)(ws + OFF_KS); const bf16_t* VS = (const bf16_t*)(ws + OFF_VS);
  constexpr int NITEM = NB * 2 * 128;
  for (int item = blockIdx.x; item < NITEM; item += gridDim.x) {
    const NsaItem it = nsa_item(item, wave, 0);
    const int qb = it.qb;
    bf16x8 qf[2][2]; u32x4 selw[2]; float g_s[2]; int tg[2]; Sel16 G[2];
#pragma unroll
    for (int gq = 0; gq < 2; ++gq) {
      tg[gq] = it.t + 4 * gq + qi4;
      const size_t tokrow = (size_t)it.b * SEQ + tg[gq];
#pragma unroll
      for (int ks = 0; ks < 2; ++ks) qf[gq][ks] = *(const bf16x8*)(Q + tokrow * 512 + (it.g * 4 + r4) * 64 + ks * 32 + kg * 8);
      selw[gq] = SELG[(size_t)it.bg * SEQ + tg[gq]];
      g_s[gq] = gsig[tokrow * 32 + (it.g * 4 + r4) * 3 + 1];
      G[gq].m = 0.f; G[gq].l = 0.f; G[gq].has = false;
#pragma unroll
      for (int dt = 0; dt < 4; ++dt) G[gq].o[dt] = (f32x4v){0.f, 0.f, 0.f, 0.f};
    }
    const bf16_t* kb = KS + (size_t)it.b * SEQ * 128 + it.g * 64;
    const bf16_t* vb = VS + (size_t)it.b * SEQ * 128 + it.g * 64;
    const int nst = (qb >> 2) + 1;
    StageRegs sr;
    lds_barrier();
    nsa_load_stage(sr, kb, vb, 0, qb);
    nsa_store_stage(sr, smem);
    lds_barrier();
    for (int sidx = 0; sidx < nst; ++sidx) {
      const char* stage = smem + (sidx & 1) * NSA_STAGE;
      if (sidx + 1 < nst) nsa_load_stage(sr, kb, vb, 4 * (sidx + 1), qb);
#pragma unroll 1
      for (int tt = 0; tt < 4; ++tt) {
        const int j = 4 * sidx + tt;
        if (j > qb) break;
#pragma unroll
        for (int gq = 0; gq < 2; ++gq) {
          const unsigned w = j < 32 ? selw[gq].x : (j < 64 ? selw[gq].y : (j < 96 ? selw[gq].z : selw[gq].w));
          const bool sel = (w >> (j & 31)) & 1u;
          if (__any(sel)) nsa_unit16(G[gq], stage + tt * 18432, qf[gq], sel, (j == qb) ? (tg[gq] - j * 64) : 1000, lane);
        }
      }
      if (sidx + 1 < nst) nsa_store_stage(sr, smem + ((sidx + 1) & 1) * NSA_STAGE);
      lds_barrier();
    }
#pragma unroll
    for (int gq = 0; gq < 2; ++gq) {
      float l = G[gq].l;
      l += xor16f(l, lane); l += xor32f(l, lane);
      const float sc = l > 0.f ? g_s[gq] / l : 0.f;
      bf16_t* dst = ONSA + ((size_t)it.b * SEQ + tg[gq]) * 512 + (it.g * 4 + r4) * 64 + 4 * kg;
      if (!dry) {
#pragma unroll
        for (int dt = 0; dt < 4; ++dt) {
          u32x2* pp = (u32x2*)(dst + dt * 16);
          const u32x2 old = *pp;
          u32x2 wv; wv.x = pack2(bflo(old.x) + sc * G[gq].o[dt][0], bfhi(old.x) + sc * G[gq].o[dt][1]);
          wv.y = pack2(bflo(old.y) + sc * G[gq].o[dt][2], bfhi(old.y) + sc * G[gq].o[dt][3]);
          *pp = wv;
        }
      } else asm volatile("" :: "v"(G[gq].o[0]), "v"(G[gq].o[1]), "v"(G[gq].o[2]), "v"(G[gq].o[3]), "v"(l));
    }
  }
}

DI void phase_nsa(const Params& p, char* smem, int branch_mask) {
  char* ws = p.ws;
  const int tid = otid(), lane = tid & 63, wave = tid >> 6, hh = lane >> 5, c = lane & 31, qi = c >> 2, r4 = c & 3;
  const bf16_t* Q = (const bf16_t*)(ws + OFF_Q);
  const float* gsig = (const float*)(ws + OFF_GSIG);
  bf16_t* ONSA = (bf16_t*)(ws + OFF_ONSA);
  u32x4* SELG = (u32x4*)(ws + OFF_SELG);
  constexpr int NITEM = NB * 2 * 128;

#pragma unroll 1
  for (int rep1 = 0; rep1 < ((PROBE_DUP & 4096) ? 2 : 1); ++rep1) {
    const bf16_t* KCMP = (const bf16_t*)(ws + OFF_KCMP); const bf16_t* VCMP = (const bf16_t*)(ws + OFF_VCMP);
    float* Aimp = (float*)(smem + NSA_AIMP) + wave * 1024;
    float* Cimp = (float*)(smem + NSA_CIMP) + wave * 1024;
    unsigned short* selm16 = (unsigned short*)(smem + NSA_SELM) + wave * 64;
    const u32x4* selm128 = (const u32x4*)(smem + NSA_SELM) + wave * 8;
    for (int item = blockIdx.x; item < NITEM; item += gridDim.x) {
      const NsaItem it = nsa_item(item, wave, qi);
      const int t = it.t;
      bf16x8 qf[4];
#pragma unroll
      for (int ks = 0; ks < 4; ++ks) qf[ks] = *(const bf16x8*)(Q + it.tokrow * 512 + (it.g * 4 + r4) * 64 + ks * 16 + hh * 8);
      const float g_c = gsig[it.tokrow * 32 + (it.g * 4 + r4) * 3 + 0];
      TileRegs tr;
      const int nmax = (it.qb * 64 + 63 - 31) >> 4, ntile = (nmax >> 6) + 1;
      const int nfull = (it.qb * 64 - 31) >> 4;
      const bf16_t* kb = KCMP + (size_t)it.bg * 512 * 64;
      const bf16_t* vb = VCMP + (size_t)it.bg * 512 * 64;
      float m = -1e30f, l = 0.f;
      nsa_load_tile(tr, kb, 64, vb, 64);
      nsa_store_tile(tr, smem);
      __syncthreads();
      for (int j = 0; j < ntile; ++j) {
        const char* tile = smem + (j & 1) * NSA_TILE;
        if (j + 1 < ntile) nsa_load_tile(tr, kb + (size_t)(j + 1) * 64 * 64, 64, vb + (size_t)(j + 1) * 64 * 64, 64);
        f32x16 st[2];
        nsa_scores(st, tile, qf, lane);
        const bool full = (j * 64 + 63 <= nfull);
        const int nlim = full ? 100000 : ((t - 31) >> 4) - j * 64 - 4 * hh;
        float mx = NSA_NEG;
#pragma unroll
        for (int kt = 0; kt < 2; ++kt)
#pragma unroll
          for (int r = 0; r < 16; ++r) {
            st[kt][r] = (kt * 32 + (r & 3) + 8 * (r >> 2) <= nlim) ? st[kt][r] : NSA_NEG;
            mx = fmaxf(mx, st[kt][r]);
          }
        mx = fmaxf(mx, xor32f(mx, lane));
        const float mn = fmaxf(m, mx);
        float sum = 0.f;
#pragma unroll
        for (int kt = 0; kt < 2; ++kt)
#pragma unroll
          for (int r = 0; r < 16; ++r) sum += __builtin_amdgcn_exp2f(st[kt][r] - mn);
        l = l * __builtin_amdgcn_exp2f(m - mn) + sum;
        m = mn;
        if (j + 1 < ntile) nsa_store_tile(tr, smem + ((j + 1) & 1) * NSA_TILE);
        __syncthreads();
      }
      l += xor32f(l, lane);
      const float inv_l = l > 0.f ? 1.0f / l : 0.f;
      f32x16 o[2];
#pragma unroll
      for (int r = 0; r < 16; ++r) { o[0][r] = 0.f; o[1][r] = 0.f; }
      nsa_load_tile(tr, kb, 64, vb, 64);
      nsa_store_tile(tr, smem);
      __syncthreads();
      for (int j = 0; j < ntile; ++j) {
        const char* tile = smem + (j & 1) * NSA_TILE;
        if (j + 1 < ntile) nsa_load_tile(tr, kb + (size_t)(j + 1) * 64 * 64, 64, vb + (size_t)(j + 1) * 64 * 64, 64);
        f32x16 st[2];
        nsa_scores(st, tile, qf, lane);
        const bool full = (j * 64 + 63 <= nfull);
        const int nlim = full ? 100000 : ((t - 31) >> 4) - j * 64 - 4 * hh;
#pragma unroll
        for (int kt = 0; kt < 2; ++kt)
#pragma unroll
          for (int r = 0; r < 16; ++r) {
            const float arg = (kt * 32 + (r & 3) + 8 * (r >> 2) <= nlim) ? st[kt][r] - m : NSA_NEG;
            st[kt][r] = __builtin_amdgcn_exp2f(arg) * inv_l;
          }
#pragma unroll
        for (int kt = 0; kt < 2; ++kt)
#pragma unroll
          for (int c4 = 0; c4 < 4; ++c4) {
            float carry = 0.5f * st[kt][4 * c4 + 3];
            float fullv = st[kt][4 * c4] + st[kt][4 * c4 + 1] + st[kt][4 * c4 + 2] + carry;
            fullv += xor1f(fullv); fullv += xor2f(fullv);
            carry += xor1f(carry); carry += xor2f(carry);
            const int jb = j * 16 + kt * 8 + 2 * c4 + hh;
            if (r4 == 0) { Aimp[qi * 128 + jb] = fullv; Cimp[qi * 128 + jb] = carry; }
          }
        if (branch_mask & 1) nsa_pv(o, st, tile, lane);
        if (j + 1 < ntile) nsa_store_tile(tr, smem + ((j + 1) & 1) * NSA_TILE);
        __syncthreads();
      }
      nsa_accum_store(ONSA + it.tokrow * 512 + (it.g * 4 + r4) * 64, o, (branch_mask & 1) ? g_c : 0.f, true, hh);
      const int cur = it.qb;
      if (cur <= 15) {
        if (lane < 8) { selm16[lane * 8 + 0] = (unsigned short)((2u << cur) - 1u);
#pragma unroll
          for (int k = 1; k < 8; ++k) selm16[lane * 8 + k] = 0; }
      } else {
        const int qs = lane >> 3, sub = lane & 7;
        float v[16];
#pragma unroll
        for (int i = 0; i < 16; ++i) {
          const int jj = sub * 16 + i;
          const bool ok = (jj >= 1) && (jj <= cur - 2);
          const int jm = jj >= 1 ? jj - 1 : 0;
          v[i] = ok ? (Aimp[qs * 128 + jj] + Cimp[qs * 128 + jm]) : -3e38f;
        }
        unsigned bits = 0;
        for (int itn = 0; itn < 13; ++itn) {
          float bv = v[0]; int bi = 0;
#pragma unroll
          for (int i = 1; i < 16; ++i) if (v[i] > bv) { bv = v[i]; bi = i; }
          int bj = sub * 16 + bi;
#pragma unroll
          for (int o2 = 1; o2 < 8; o2 <<= 1) {
            const float ov = __shfl_xor(bv, o2); const int oj = __shfl_xor(bj, o2);
            if (ov > bv || (ov == bv && oj < bj)) { bv = ov; bj = oj; }
          }
          if ((bj >> 4) == sub) {
            const int i2 = bj & 15;
#pragma unroll
            for (int i = 0; i < 16; ++i) if (i == i2) v[i] = -3e38f;
            bits |= 1u << i2;
          }
        }
        if (sub == 0) bits |= 1u;
        if ((cur >> 4) == sub) bits |= 1u << (cur & 15);
        if (((cur - 1) >> 4) == sub) bits |= 1u << ((cur - 1) & 15);
        selm16[qs * 8 + sub] = (unsigned short)bits;
      }
      __syncthreads();
      if (r4 == 0 && hh == 0) SELG[(size_t)it.bg * SEQ + t] = selm128[qi];
    }
  }
  __threadfence_block();
  __syncthreads();

#pragma unroll 1
  for (int sweep_i = 0; sweep_i < 2 + ((PROBE_DUP & 1024) ? 1 : 0) + ((PROBE_DUP & 2048) ? 1 : 0); ++sweep_i) {
    const int sweep = (sweep_i < 2) ? sweep_i : (((PROBE_DUP & 1024) && sweep_i == 2) ? 0 : 1);
    const bool dry = sweep_i >= 2;
    if (!(branch_mask & (sweep == 0 ? 2 : 4))) continue;
    if (sweep == 0) { nsa_sel16(p, smem, dry); continue; }
    const bf16_t* KB = (const bf16_t*)(ws + (sweep == 0 ? OFF_KS : OFF_KW)); const bf16_t* VB = (const bf16_t*)(ws + (sweep == 0 ? OFF_VS : OFF_VW));
    for (int item = blockIdx.x; item < NITEM; item += gridDim.x) {
      const NsaItem it = nsa_item(item, wave, qi);
      const int t = it.t, qb = it.qb;
      bf16x8 qf[4];
#pragma unroll
      for (int ks = 0; ks < 4; ++ks) qf[ks] = *(const bf16x8*)(Q + it.tokrow * 512 + (it.g * 4 + r4) * 64 + ks * 16 + hh * 8);
      const float g_b = gsig[it.tokrow * 32 + (it.g * 4 + r4) * 3 + 1 + sweep];
      u32x4 selw = {0xffffffffu, 0xffffffffu, 0xffffffffu, 0xffffffffu};
      if (sweep == 0) selw = SELG[(size_t)it.bg * SEQ + t];
      TileRegs tr;
      const bf16_t* kb = KB + (size_t)it.b * SEQ * 128 + it.g * 64;
      const bf16_t* vb = VB + (size_t)it.b * SEQ * 128 + it.g * 64;
      float m = -1e30f, l = 0.f;
      f32x16 o[2];
#pragma unroll
      for (int r = 0; r < 16; ++r) { o[0][r] = 0.f; o[1][r] = 0.f; }
      const int j0 = (sweep == 1 && qb >= 8) ? qb - 8 : 0;
      __syncthreads();
      nsa_load_tile(tr, kb + (size_t)j0 * 64 * 128, 128, vb + (size_t)j0 * 64 * 128, 128);
      nsa_store_tile(tr, smem);
      if (j0 + 1 <= qb) { nsa_load_tile(tr, kb + (size_t)(j0 + 1) * 64 * 128, 128, vb + (size_t)(j0 + 1) * 64 * 128, 128); nsa_store_tile(tr, smem + NSA_TILE); }
      if (j0 + 2 <= qb) nsa_load_tile(tr, kb + (size_t)(j0 + 2) * 64 * 128, 128, vb + (size_t)(j0 + 2) * 64 * 128, 128);
      __syncthreads();
      const bool late = wave >= 4;
      if (__builtin_amdgcn_readfirstlane(wave) >= 4) __builtin_amdgcn_s_setprio(1);
      bool has = false;
      m = 0.f;
      f32x16 st[2];
      {
        const unsigned w0 = j0 < 32 ? selw.x : (j0 < 64 ? selw.y : (j0 < 96 ? selw.z : selw.w));
        const float ini = ((w0 >> (j0 & 31)) & 1u) ? 0.f : -1e30f;
#pragma unroll
        for (int r = 0; r < 16; ++r) { st[0][r] = ini; st[1][r] = ini; }
        const bf16_t* Kc = (const bf16_t*)smem;
#pragma unroll
        for (int ks = 0; ks < 4; ++ks)
#pragma unroll
          for (int kt = 0; kt < 2; ++kt) st[kt] = MFMA32(*(const bf16x8*)(Kc + (kt * 32 + (lane & 31)) * LK + ks * 16 + (lane >> 5) * 8), qf[ks], st[kt]);
      }
      int bi = 0;
      for (int j = j0; j <= qb; ++j) {
        const char* tile = smem + bi * NSA_TILE;
        const int bn = bi == 2 ? 0 : bi + 1, bnn = bn == 2 ? 0 : bn + 1;
        const int jn = j + 1;
        const unsigned wn = jn < 32 ? selw.x : (jn < 64 ? selw.y : (jn < 96 ? selw.z : selw.w));
        const bool seln = (wn >> (jn & 31)) & 1u;
        const bf16_t* Kn = (const bf16_t*)(smem + bn * NSA_TILE) + (lane & 31) * LK + (lane >> 5) * 8;
        f32x16 sn[2];
        if (!late) {
          const float ini = seln ? -m : -1e30f;
#pragma unroll
          for (int r = 0; r < 16; ++r) { sn[0][r] = ini; sn[1][r] = ini; }
#pragma unroll
          for (int ks = 0; ks < 4; ++ks)
#pragma unroll
            for (int kt = 0; kt < 2; ++kt) sn[kt] = MFMA32(*(const bf16x8*)(Kn + kt * 32 * LK + ks * 16), qf[ks], sn[kt]);
        }
        if (j == qb || (sweep == 1 && j == qb - 8)) {
          const int khi = t - j * 64 - 4 * hh, klo = (sweep == 1) ? khi - 511 : -100000;
#pragma unroll
          for (int r = 0; r < 16; ++r) {
            const int o0 = (r & 3) + 8 * (r >> 2);
            st[0][r] = (o0 <= khi && o0 >= klo) ? st[0][r] : NSA_NEG;
            st[1][r] = (o0 + 32 <= khi && o0 + 32 >= klo) ? st[1][r] : NSA_NEG;
          }
        }
        float mx;
        {
          float a0, a1, a2, a3;
          asm("v_max3_f32 %0, %1, %2, %3" : "=v"(a0) : "v"(st[0][0]), "v"(st[0][1]), "v"(st[0][2]));
          asm("v_max3_f32 %0, %1, %2, %3" : "=v"(a1) : "v"(st[0][3]), "v"(st[0][4]), "v"(st[0][5]));
          asm("v_max3_f32 %0, %1, %2, %3" : "=v"(a2) : "v"(st[0][6]), "v"(st[0][7]), "v"(st[0][8]));
          asm("v_max3_f32 %0, %1, %2, %3" : "=v"(a3) : "v"(st[0][9]), "v"(st[0][10]), "v"(st[0][11]));
          asm("v_max3_f32 %0, %1, %2, %3" : "=v"(a0) : "v"(a0), "v"(st[0][12]), "v"(st[0][13]));
          asm("v_max3_f32 %0, %1, %2, %3" : "=v"(a1) : "v"(a1), "v"(st[0][14]), "v"(st[0][15]));
          asm("v_max3_f32 %0, %1, %2, %3" : "=v"(a2) : "v"(a2), "v"(st[1][0]), "v"(st[1][1]));
          asm("v_max3_f32 %0, %1, %2, %3" : "=v"(a3) : "v"(a3), "v"(st[1][2]), "v"(st[1][3]));
          asm("v_max3_f32 %0, %1, %2, %3" : "=v"(a0) : "v"(a0), "v"(st[1][4]), "v"(st[1][5]));
          asm("v_max3_f32 %0, %1, %2, %3" : "=v"(a1) : "v"(a1), "v"(st[1][6]), "v"(st[1][7]));
          asm("v_max3_f32 %0, %1, %2, %3" : "=v"(a2) : "v"(a2), "v"(st[1][8]), "v"(st[1][9]));
          asm("v_max3_f32 %0, %1, %2, %3" : "=v"(a3) : "v"(a3), "v"(st[1][10]), "v"(st[1][11]));
          asm("v_max3_f32 %0, %1, %2, %3" : "=v"(a0) : "v"(a0), "v"(st[1][12]), "v"(st[1][13]));
          asm("v_max3_f32 %0, %1, %2, %3" : "=v"(a1) : "v"(a1), "v"(st[1][14]), "v"(st[1][15]));
          asm("v_max3_f32 %0, %1, %2, %3" : "=v"(a0) : "v"(a0), "v"(a1), "v"(a2));
          const float other = a3;
          asm("v_max_f32 %0, %1, %2" : "=v"(mx) : "v"(a0), "v"(other));
          const float px = xor32f(mx, lane);
          asm("v_max_f32 %0, %1, %2" : "=v"(mx) : "v"(mx), "v"(px));
        }
        const bool real = mx > -1e29f;
        const bool fresh = !has && real, up = has && (mx > NSA_THR);
        if (__any(fresh || up)) {
          const float delta = (fresh || up) ? mx : 0.f;
          const float alpha = up ? __builtin_amdgcn_exp2f(-delta) : 1.0f;
          m += delta; l *= alpha;
#pragma unroll
          for (int r = 0; r < 16; ++r) { o[0][r] *= alpha; o[1][r] *= alpha; st[0][r] -= delta; st[1][r] -= delta; }
          if (!late) {
            const float dn = seln ? delta : 0.f;
#pragma unroll
            for (int r = 0; r < 16; ++r) { sn[0][r] -= dn; sn[1][r] -= dn; }
          }
        }
        has = has || real;
        f32x2 s2 = {0.f, 0.f};
#pragma unroll
        for (int r = 0; r < 16; ++r) {
          const float p0 = __builtin_amdgcn_exp2f(st[0][r]), p1 = __builtin_amdgcn_exp2f(st[1][r]);
          st[0][r] = p0; st[1][r] = p1; s2 += (f32x2){p0, p1};
        }
        l += s2.x + s2.y;
        nsa_pv(o, st, tile, lane);
        if (late) {
          const float ini = seln ? -m : -1e30f;
#pragma unroll
          for (int r = 0; r < 16; ++r) { sn[0][r] = ini; sn[1][r] = ini; }
#pragma unroll
          for (int ks = 0; ks < 4; ++ks)
#pragma unroll
            for (int kt = 0; kt < 2; ++kt) sn[kt] = MFMA32(*(const bf16x8*)(Kn + kt * 32 * LK + ks * 16), qf[ks], sn[kt]);
        }
        if (j + 2 <= qb) nsa_store_tile(tr, smem + bnn * NSA_TILE);
        if (j + 3 <= qb) nsa_load_tile(tr, kb + (size_t)(j + 3) * 64 * 128, 128, vb + (size_t)(j + 3) * 64 * 128, 128);
#pragma unroll
        for (int r = 0; r < 16; ++r) { st[0][r] = sn[0][r]; st[1][r] = sn[1][r]; }
        bi = bn;
        __syncthreads();
      }
      __builtin_amdgcn_s_setprio(0);
      l += xor32f(l, lane);
      if (!dry) nsa_accum_store(ONSA + it.tokrow * 512 + (it.g * 4 + r4) * 64, o, l > 0.f ? g_b / l : 0.f, false, hh, (unsigned char*)(ws + OFF_ONSA8) + it.tokrow * 512 + (it.g * 4 + r4) * 64);
      else asm volatile("" :: "v"(o[0]), "v"(o[1]), "v"(l));
    }
  }
}

DI unsigned ord_key(float f) { const unsigned u = __float_as_uint(f); return (u & 0x80000000u) ? ~u : (u | 0x80000000u); }
DI float ord_val(unsigned k) { return __uint_as_float((k & 0x80000000u) ? (k & 0x7fffffffu) : ~k); }
DI void cex(unsigned& hi, unsigned& lo) { const unsigned x = hi, y = lo; hi = x > y ? x : y; lo = x > y ? y : x; }
DI void sort16_desc(unsigned (&a)[16]) {
#pragma unroll
  for (int k = 2; k <= 16; k <<= 1)
#pragma unroll
    for (int j = k >> 1; j > 0; j >>= 1)
#pragma unroll
      for (int i = 0; i < 16; ++i) {
        const int l = i ^ j;
        if (l > i) { if ((i & k) == 0) cex(a[i], a[l]); else cex(a[l], a[i]); }
      }
}
DI void bitonic_finish16(unsigned (&a)[16]) {
#pragma unroll
  for (int j = 8; j > 0; j >>= 1)
#pragma unroll
    for (int i = 0; i < 16; ++i) { const int l = i ^ j; if (l > i) cex(a[i], a[l]); }
}
DI void merge_top16(unsigned (&a)[16], const unsigned (&b)[16]) {
#pragma unroll
  for (int i = 0; i < 16; ++i) a[i] = a[i] > b[15 - i] ? a[i] : b[15 - i];
  bitonic_finish16(a);
}
DI void merge_partner16(unsigned (&a)[16]) {
  unsigned b[16];
#pragma unroll
  for (int i = 0; i < 16; ++i) b[i] = xor32u(a[i], otid());
  merge_top16(a, b);
}


constexpr int KLD = 136;
DI void peer_top16(unsigned (&top)[16], const bf16x8 (&bq)[8], const bf16_t* keys  , int lane) {
  const int l31 = lane & 31, hh = lane >> 5;
  unsigned grp[16];
#pragma unroll
  for (int nt = 0; nt < 4; ++nt) {
    f32x16 sa;
#pragma unroll
    for (int r = 0; r < 16; ++r) sa[r] = 0.f;
    const bf16_t* kp = keys + (nt * 32 + l31) * KLD + hh * 8;
#pragma unroll
    for (int ks = 0; ks < 8; ++ks) { const bf16x8 a = *(const bf16x8*)(kp + ks * 16); sa = MFMA32(a, bq[ks], sa); }
#pragma unroll
    for (int r = 0; r < 16; ++r) {
      const int n = nt * 32 + (r & 3) + 8 * (r >> 2) + 4 * hh;
      grp[r] = (ord_key(sa[r]) & ~0x7Fu) | (unsigned)(127 - n);
    }
    sort16_desc(grp);
    if (nt == 0) {
#pragma unroll
      for (int i = 0; i < 16; ++i) top[i] = grp[i];
    } else merge_top16(top, grp);
  }
  merge_partner16(top);
}

DI void phase_route(const Params& p, char* smem) {
  char* ws = p.ws;
  const int tid = otid(), lane = tid & 63, wave = tid >> 6, l31 = lane & 31, hh = lane >> 5;
  const bf16_t* pq = (const bf16_t*)(ws + OFF_PQ);
  const bf16_t* pk = (const bf16_t*)(ws + OFF_PKEYS);
  int* eidx = (int*)(ws + OFF_EIDX);
  float* pgate = (float*)(ws + OFF_PGATE);
  bf16_t* KL = (bf16_t*)smem;
  unsigned* LS = (unsigned*)(smem + 2 * 128 * KLD * 2) + wave * 1024;
  {
    const int h0 = blockIdx.x & 7;
    __syncthreads();
#pragma unroll
    for (int i = 0; i < 8; ++i) {
      const int idx = tid + i * NT, row = idx >> 4, ch = idx & 15;
      *(u32x4*)(KL + row * KLD + ch * 8) = *(const u32x4*)(pk + ((size_t)h0 * 256 + row) * 128 + ch * 8);
    }
    __syncthreads();
  }
  constexpr int CA[64] = {0,0,0,0,0,0,0,0,0,0,0,0,0,0,0,0, 1,1,1,1,1,1,1,1, 2,2,2,2,2, 3,3,3,3, 4,4,4, 5,5, 6,6, 7,7, 8,9,10,11,12,13,14,15, 0,0,0,0,0,0,0,0,0,0,0,0,0,0};
  constexpr int CB[64] = {0,1,2,3,4,5,6,7,8,9,10,11,12,13,14,15, 0,1,2,3,4,5,6,7, 0,1,2,3,4, 0,1,2,3, 0,1,2, 0,1, 0,1, 0,1, 0,0,0,0,0,0,0,0, 0,0,0,0,0,0,0,0,0,0,0,0,0,0};
  for (int item = blockIdx.x; item < (NTOK / 256) * 8; item += gridDim.x) {
    const int h = item & 7, t0 = (item >> 3) * 256 + wave * 32;
    unsigned s1[16], s2[16];
    const bf16_t* pqrow = pq + (size_t)(t0 + l31) * 2048 + h * 256 + hh * 8;
    bf16x8 bq1[8], bq2[8];
#pragma unroll
    for (int ks = 0; ks < 8; ++ks) { bq1[ks] = *(const bf16x8*)(pqrow + ks * 16); bq2[ks] = *(const bf16x8*)(pqrow + 128 + ks * 16); }
    peer_top16(s1, bq1, KL, lane);
    peer_top16(s2, bq2, KL + 128 * KLD, lane);
    float f1[16], f2[16];
#pragma unroll
    for (int i = 0; i < 16; ++i) { f1[i] = ord_val(s1[i]); f2[i] = ord_val(s2[i]); }
    unsigned ca[16], cb2[16];
#pragma unroll
    for (int i = 0; i < 32; ++i) {
      const int i0 = i, i1 = 25 + i;
      unsigned k0 = 0u, k1 = 0u;
      if (i0 < 25) k0 = (ord_key(f1[CA[i0]] + f2[CB[i0]]) & ~0xFFu) | (unsigned)(255 - (CA[i0] * 16 + CB[i0]));
      if (i1 < 50) k1 = (ord_key(f1[CA[i1]] + f2[CB[i1]]) & ~0xFFu) | (unsigned)(255 - (CA[i1] * 16 + CB[i1]));
      const unsigned kk = hh ? k1 : k0;
      if (i < 16) ca[i] = kk; else cb2[i - 16] = kk;
    }
    sort16_desc(ca); sort16_desc(cb2);
    merge_top16(ca, cb2);
    merge_partner16(ca);
    if (hh == 0) {
#pragma unroll
      for (int i = 0; i < 16; ++i) { LS[l31 * 32 + i] = s1[i]; LS[l31 * 32 + 16 + i] = s2[i]; }
    }
    const float mx = ord_val(ca[0]);
    float ex[16], sum = 0.f;
#pragma unroll
    for (int i = 0; i < 16; ++i) { ex[i] = __expf(ord_val(ca[i]) - mx); sum += ex[i]; }
    const float inv = 1.0f / sum;
    int eo[16]; float go[16];
#pragma unroll
    for (int i = 0; i < 16; ++i) {
      const int flat = 255 - (int)(ca[i] & 0xFFu);
      const unsigned k1 = LS[l31 * 32 + (flat >> 4)], k2 = LS[l31 * 32 + 16 + (flat & 15)];
      eo[i] = (127 - (int)(k1 & 0x7Fu)) * 128 + (127 - (int)(k2 & 0x7Fu));
      go[i] = ex[i] * inv;
    }
    const size_t ob = ((size_t)(t0 + l31) * 8 + h) * 16;
    if (hh == 0) {
      *(u32x4*)(eidx + ob) = (u32x4){(unsigned)eo[0], (unsigned)eo[1], (unsigned)eo[2], (unsigned)eo[3]};
      *(u32x4*)(eidx + ob + 4) = (u32x4){(unsigned)eo[4], (unsigned)eo[5], (unsigned)eo[6], (unsigned)eo[7]};
      *(f32x4*)(pgate + ob) = (f32x4){go[0], go[1], go[2], go[3]};
      *(f32x4*)(pgate + ob + 4) = (f32x4){go[4], go[5], go[6], go[7]};
    } else {
      *(u32x4*)(eidx + ob + 8) = (u32x4){(unsigned)eo[8], (unsigned)eo[9], (unsigned)eo[10], (unsigned)eo[11]};
      *(u32x4*)(eidx + ob + 12) = (u32x4){(unsigned)eo[12], (unsigned)eo[13], (unsigned)eo[14], (unsigned)eo[15]};
      *(f32x4*)(pgate + ob + 8) = (f32x4){go[8], go[9], go[10], go[11]};
      *(f32x4*)(pgate + ob + 12) = (f32x4){go[12], go[13], go[14], go[15]};
    }
  }
}

#define FOR32(M) M(0) M(1) M(2) M(3) M(4) M(5) M(6) M(7) M(8) M(9) M(10) M(11) M(12) M(13) M(14) M(15) M(16) M(17) M(18) M(19) M(20) M(21) M(22) M(23) M(24) M(25) M(26) M(27) M(28) M(29) M(30) M(31)
#define FOR16(M) M(0) M(1) M(2) M(3) M(4) M(5) M(6) M(7) M(8) M(9) M(10) M(11) M(12) M(13) M(14) M(15)
DI void phase_ffn_u(const Params& p) {
  char* ws = p.ws;
  const int lane = otid() & 63, wave = otid() >> 6, pg = lane >> 3, dc = lane & 7;
  const int sl = blockIdx.x & 7, wslot = (blockIdx.x >> 3) * NW + wave, nw = (gridDim.x >> 3) * NW;
  const unsigned char* PU8 = (const unsigned char*)(ws + OFF_PU8) + (size_t)sl * 16384 * 128 + dc * 16;
  const unsigned char* h2q = (const unsigned char*)(ws + OFF_H2Q) + sl * 128 + dc * 16;
  const int* eidx = (const int*)(ws + OFF_EIDX);
  float* part = (float*)(ws + OFF_PART) + (size_t)sl * NTOK * 128;
  const int j0 = (dc >> 2) * 64 + ((2 * dc) & 7) * 8 + pg;
  int ev0 = 0, ev1 = 0, nev0 = 0, nev1 = 0; u32x4 hq = {0u, 0u, 0u, 0u}, nhq = hq;
  if (wslot < NTOK) { ev0 = eidx[(size_t)wslot * 128 + lane]; ev1 = eidx[(size_t)wslot * 128 + 64 + lane]; hq = *(const u32x4*)(h2q + (size_t)wslot * DM); }
  for (int t = wslot; t < NTOK; t += nw) {
    if (t + nw < NTOK) { const size_t o = (size_t)(t + nw) * 128; nev0 = eidx[o + lane]; nev1 = eidx[o + 64 + lane]; nhq = *(const u32x4*)(h2q + (size_t)(t + nw) * DM); }
#define FFU_LD(it) const u32x4 ru##it = *(const u32x4*)(PU8 + (size_t)__shfl((it) < 8 ? ev0 : ev1, ((it) & 7) * 8 + pg) * 128);
    FOR16(FFU_LD)
    int d[16];
#define FFU_CP(it) { int a_ = __builtin_amdgcn_sdot4((int)ru##it.x, (int)hq.x, 0, false); a_ = __builtin_amdgcn_sdot4((int)ru##it.y, (int)hq.y, a_, false); \
      a_ = __builtin_amdgcn_sdot4((int)ru##it.z, (int)hq.z, a_, false); d[it] = __builtin_amdgcn_sdot4((int)ru##it.w, (int)hq.w, a_, false); }
    FOR16(FFU_CP)
    int r8[8], r4[4], r2[2];
    { const bool hi = dc & 4;
#pragma unroll
      for (int i = 0; i < 8; ++i) { const int keep = hi ? d[8 + i] : d[i], send = hi ? d[i] : d[8 + i]; r8[i] = keep + __shfl_xor(send, 4); } }
    { const bool hi = dc & 2;
#pragma unroll
      for (int i = 0; i < 4; ++i) { const int keep = hi ? r8[4 + i] : r8[i], send = hi ? r8[i] : r8[4 + i]; r4[i] = keep + __float_as_int(xor2f(__int_as_float(send))); } }
    { const bool hi = dc & 1;
#pragma unroll
      for (int i = 0; i < 2; ++i) { const int keep = hi ? r4[2 + i] : r4[i], send = hi ? r4[i] : r4[2 + i]; r2[i] = keep + __float_as_int(xor1f(__int_as_float(send))); } }
    part[(size_t)t * 128 + j0] = (float)r2[0];
    part[(size_t)t * 128 + j0 + 8] = (float)r2[1];
    ev0 = nev0; ev1 = nev1; hq = nhq;
  }
}
DI void phase_ffn_w(const Params& p) {
  char* ws = p.ws;
  const int lane = otid() & 63, wave = otid() >> 6;
  const float* part = (const float*)(ws + OFF_PART);
  const float* scu = (const float*)(ws + OFF_SCU); const float* scv = (const float*)(ws + OFF_SCV);
  const int* eidx = (const int*)(ws + OFF_EIDX);
  const float* pgate = (const float*)(ws + OFF_PGATE);
  float* wbuf = (float*)(ws + OFF_WBUF);
  for (int grp = blockIdx.x; grp < NTOK / NW; grp += gridDim.x) {
    const size_t o = (size_t)(grp * NW + wave) * 128 + lane;
    float a0 = 0.f, a1 = 0.f;
#pragma unroll
    for (int s8 = 0; s8 < 8; ++s8) { a0 += part[(size_t)s8 * NTOK * 128 + o]; a1 += part[(size_t)s8 * NTOK * 128 + o + 64]; }
    const int e0 = eidx[o], e1 = eidx[o + 64];
    const float sht = ((const float*)(ws + OFF_SH))[grp * NW + wave];
    wbuf[o] = pgate[o] * gelu_f(a0 * (scu[e0] * sht)) * scv[e0];
    wbuf[o + 64] = pgate[o + 64] * gelu_f(a1 * (scu[e1] * sht)) * scv[e1];
  }
}
DI void phase_ffn_v(const Params& p) {
  char* ws = p.ws;
  const int lane = otid() & 63, wave = otid() >> 6, pg = lane >> 3, dc = lane & 7;
  const int sl = blockIdx.x & 7, wslot = (blockIdx.x >> 3) * NW + wave, nw = (gridDim.x >> 3) * NW;
  const unsigned char* PV8 = (const unsigned char*)(ws + OFF_PV8) + (size_t)sl * 16384 * 128 + dc * 16;
  const int* eidx = (const int*)(ws + OFF_EIDX) + 16 * pg;
  const float* wbuf = (const float*)(ws + OFF_WBUF) + 16 * pg;
  bf16_t* ffnb = (bf16_t*)(ws + OFF_FFNB);
  u32x4 ne0 = {0u, 0u, 0u, 0u}, ne1 = ne0, ne2 = ne0, ne3 = ne0;
  if (wslot < NTOK) { const int* ep = eidx + (size_t)wslot * 128; ne0 = *(const u32x4*)ep; ne1 = *(const u32x4*)(ep + 4); ne2 = *(const u32x4*)(ep + 8); ne3 = *(const u32x4*)(ep + 12); }
#pragma unroll 1
  for (int t = wslot; t < NTOK; t += nw) {
    const u32x4 ce0 = ne0, ce1 = ne1, ce2 = ne2, ce3 = ne3;
    if (t + nw < NTOK) { const int* ep = eidx + (size_t)(t + nw) * 128; ne0 = *(const u32x4*)ep; ne1 = *(const u32x4*)(ep + 4); ne2 = *(const u32x4*)(ep + 8); ne3 = *(const u32x4*)(ep + 12); }
    const float* wp = wbuf + (size_t)t * 128;
    const f32x4 wq0 = *(const f32x4*)wp, wq1 = *(const f32x4*)(wp + 4), wq2 = *(const f32x4*)(wp + 8), wq3 = *(const f32x4*)(wp + 12);
#define FFV_E(it) ((it) < 4 ? ce0[(it) & 3] : (it) < 8 ? ce1[(it) & 3] : (it) < 12 ? ce2[(it) & 3] : ce3[(it) & 3])
#define FFV_W(it) ((it) < 4 ? wq0[(it) & 3] : (it) < 8 ? wq1[(it) & 3] : (it) < 12 ? wq2[(it) & 3] : wq3[(it) & 3])
#define FFV_LD(it) const u32x4 rv##it = *(const u32x4*)(PV8 + (size_t)FFV_E(it) * 128);
#define FFV_CP(it) { const float wj = FFV_W(it); const f32x2 w2 = {wj, wj}; \
      acc2[0] += __builtin_amdgcn_cvt_pk_f32_fp8((int)rv##it.x, false) * w2; acc2[1] += __builtin_amdgcn_cvt_pk_f32_fp8((int)rv##it.x, true) * w2; \
      acc2[2] += __builtin_amdgcn_cvt_pk_f32_fp8((int)rv##it.y, false) * w2; acc2[3] += __builtin_amdgcn_cvt_pk_f32_fp8((int)rv##it.y, true) * w2; \
      acc2[4] += __builtin_amdgcn_cvt_pk_f32_fp8((int)rv##it.z, false) * w2; acc2[5] += __builtin_amdgcn_cvt_pk_f32_fp8((int)rv##it.z, true) * w2; \
      acc2[6] += __builtin_amdgcn_cvt_pk_f32_fp8((int)rv##it.w, false) * w2; acc2[7] += __builtin_amdgcn_cvt_pk_f32_fp8((int)rv##it.w, true) * w2; }
    FOR16(FFV_LD)
    f32x2 acc2[8];
#pragma unroll
    for (int i = 0; i < 8; ++i) acc2[i] = (f32x2){0.f, 0.f};
    FOR16(FFV_CP)
    float acc[16];
#pragma unroll
    for (int i = 0; i < 8; ++i) { acc[2 * i] = acc2[i].x; acc[2 * i + 1] = acc2[i].y; }
    float r8[8], r4[4], r2[2];
    { const bool hi = lane & 32;
#pragma unroll
      for (int i = 0; i < 8; ++i) { const float keep = hi ? acc[8 + i] : acc[i], send = hi ? acc[i] : acc[8 + i]; r8[i] = keep + xor32f(send, lane); } }
    { const bool hi = lane & 16;
#pragma unroll
      for (int i = 0; i < 4; ++i) { const float keep = hi ? r8[4 + i] : r8[i], send = hi ? r8[i] : r8[4 + i]; r4[i] = keep + xor16f(send, lane); } }
    { const bool hi = lane & 8;
#pragma unroll
      for (int i = 0; i < 2; ++i) { const float keep = hi ? r4[2 + i] : r4[i], send = hi ? r4[i] : r4[2 + i]; r2[i] = keep + xor8f(send); } }
    *(unsigned*)(ffnb + (size_t)t * DM + sl * 128 + dc * 16 + 2 * pg) = pack2(r2[0], r2[1]);
  }
}
DI void phase_final(const Params& p) {
  char* ws = p.ws;
  const int lane = otid() & 63, wave = otid() >> 6;
  const bf16_t* x1 = (const bf16_t*)(ws + OFF_X1);
  const bf16_t* ffnb = (const bf16_t*)(ws + OFF_FFNB);
  const float* mod = (const float*)(ws + OFF_MOD);
  for (int grp = blockIdx.x; grp < NTOK / NW; grp += gridDim.x) {
    const int row = grp * NW + wave, b = row >> 13;
    float v[16];
#pragma unroll
    for (int i = 0; i < 4; ++i) {
      const int col = i * 256 + lane * 4;
      const f32x4 gt2 = *(const f32x4*)(mod + b * 6144 + 5120 + col);
      const u32x2 xr = *(const u32x2*)(x1 + (size_t)row * DM + col), fr = *(const u32x2*)(ffnb + (size_t)row * DM + col);
      v[4 * i] = DN_ALPHA * bflo(xr.x) + gt2.x * bflo(fr.x); v[4 * i + 1] = DN_ALPHA * bfhi(xr.x) + gt2.y * bfhi(fr.x);
      v[4 * i + 2] = DN_ALPHA * bflo(xr.y) + gt2.z * bflo(fr.y); v[4 * i + 3] = DN_ALPHA * bfhi(xr.y) + gt2.w * bfhi(fr.y);
    }
    float mean, rstd; row_stats(v, mean, rstd);
#pragma unroll
    for (int i = 0; i < 4; ++i) {
      const int col = i * 256 + lane * 4;
      const f32x4 g = *(const f32x4*)(p.ln2_g + col), bb = *(const f32x4*)(p.ln2_b + col);
      f32x4 o;
      o.x = (v[4 * i] - mean) * rstd * g.x + bb.x; o.y = (v[4 * i + 1] - mean) * rstd * g.y + bb.y;
      o.z = (v[4 * i + 2] - mean) * rstd * g.z + bb.z; o.w = (v[4 * i + 3] - mean) * rstd * g.w + bb.w;
      *(f32x4*)(p.out + (size_t)row * DM + col) = o;
    }
  }
}

#define XB_TMO      128
#define XB_XCNT(j)  (256  + 64 * (j))
#define XB_XSUB(j)  (1280 + 64 * (j))
#define XB_XGEN(j)  (2304 + 64 * (j))
#define XB_TOP      3328
#define XB_TOPGEN   3392
#define XCD_BAR_WORDS 3456
#define XB_SPIN_CAP (1u << 22)
DI unsigned xb_ld(unsigned* p) { return __hip_atomic_load(p, __ATOMIC_RELAXED, __HIP_MEMORY_SCOPE_AGENT); }
DI unsigned xb_add(unsigned* p, unsigned v) { return __hip_atomic_fetch_add(p, v, __ATOMIC_RELAXED, __HIP_MEMORY_SCOPE_AGENT); }
DI unsigned xb_xcc_id() { return (unsigned)__builtin_amdgcn_s_getreg((3 << 11) | 20) & 0xFu; }
#define XB_SPIN(cond, bar) do { unsigned _sp = 0; while (cond) { __builtin_amdgcn_s_sleep(1); \
    if ((++_sp & 255u) == 0u) { if (xb_ld(&(bar)[XB_TMO])) break; if (_sp > XB_SPIN_CAP) { atomicAdd(&(bar)[XB_TMO], 1u); break; } } } } while (0)
struct XcdBarrier { unsigned* bar; unsigned x; volatile LAS unsigned* st; };
DI XcdBarrier xcd_barrier_post(unsigned* bar, volatile LAS unsigned* st) {
  XcdBarrier b; b.bar = bar; b.x = xb_xcc_id(); b.st = st;
  if (threadIdx.x == 0) (void)xb_add(&bar[XB_XCNT(b.x)], 1u);
  return b;
}
DI void xcd_barrier_complete(unsigned* bar, unsigned x, unsigned& nloc, unsigned& nx) {
  const unsigned G = gridDim.x * gridDim.y * gridDim.z;
  unsigned sum, cnt, mine, sp = 0u;
  for (;;) {
    sum = 0u; cnt = 0u; mine = 0u;
#pragma unroll
    for (unsigned j = 0; j < 16; ++j) { const unsigned c = xb_ld(&bar[XB_XCNT(j)]); sum += c; cnt += (c > 0u) ? 1u : 0u; mine = (j == x) ? c : mine; }
    if (sum == G) break;
    __builtin_amdgcn_s_sleep(1);
    if ((++sp & 255u) == 0u) { if (xb_ld(&bar[XB_TMO])) break; if (sp > XB_SPIN_CAP) { atomicAdd(&bar[XB_TMO], 1u); break; } }
  }
  nloc = mine > 0u ? mine : 1u; nx = cnt > 0u ? cnt : 1u;
}
DI void xcd_barrier(const XcdBarrier& b) {
  asm volatile("s_waitcnt vmcnt(0)" ::: "memory");
  __syncthreads();
  if (threadIdx.x == 0) {
    unsigned* bar = b.bar;
    __builtin_amdgcn_s_waitcnt(0);
    unsigned nloc = b.st[0], nx = b.st[1];
    if (nloc == 0u) { xcd_barrier_complete(bar, b.x, nloc, nx); b.st[0] = nloc; b.st[1] = nx; }
    const unsigned old = xb_add(&bar[XB_XSUB(b.x)], 1u);
    const unsigned gen = old / nloc;
    if (old + 1u == (gen + 1u) * nloc) {
      __builtin_amdgcn_fence(__ATOMIC_RELEASE, "agent");
      asm volatile("s_waitcnt vmcnt(0)" ::: "memory");
      const unsigned og = xb_add(&bar[XB_TOP], 1u);
      const unsigned tg = og / nx;
      if (og + 1u == (tg + 1u) * nx) xb_add(&bar[XB_TOPGEN], 1u);
      else XB_SPIN(xb_ld(&bar[XB_TOPGEN]) == tg, bar);
      __builtin_amdgcn_fence(__ATOMIC_ACQUIRE, "agent");
      xb_add(&bar[XB_XGEN(b.x)], 1u);
      asm volatile("s_waitcnt vmcnt(0)" ::: "memory");
    } else {
      XB_SPIN(xb_ld(&bar[XB_XGEN(b.x)]) == gen, bar);
      __builtin_amdgcn_fence(__ATOMIC_ACQUIRE, "agent");
      asm volatile("s_waitcnt vmcnt(0)" ::: "memory");
    }
  }
  __syncthreads();
}

constexpr int SMEM_BYTES = 147456 + 256;

__global__ void __launch_bounds__(NT, 2) k_mega(Params p) {
  __shared__ __attribute__((aligned(16))) char smem[SMEM_BYTES];
  cg::grid_group grid = cg::this_grid();
  if (threadIdx.x == 0) *(u32x4*)(smem + 147456) = (u32x4){0u, 0u, 0u, 0u};
  __syncthreads();
  const XcdBarrier xb = xcd_barrier_post((unsigned*)(p.ws + OFF_BAR), (volatile LAS unsigned*)(smem + 147456));
#define REP(mask) _Pragma("unroll 1") for (int rep_ = 0; rep_ < ((PROBE_DUP & (mask)) ? 2 : 1); ++rep_)
  REP(1) phase_prep(p, smem, (unsigned*)(p.ws + OFF_BAR) + XCD_BAR_WORDS + rep_);
  grid.sync();
  REP(1) phase_ln_in(p);
  xcd_barrier(xb);
  REP(2) phase_gemm1(p, smem);
  xcd_barrier(xb);
  REP(4) phase_compress(p, smem);
  phase_sgu(p, smem);
  xcd_barrier(xb);
  REP(8) phase_nsa(p, smem, NSA_MASK);
  xcd_barrier(xb);
  REP(16) phase_merge(p, smem);
  xcd_barrier(xb);
  REP(16) phase_outproj(p, smem);
  xcd_barrier(xb);
  REP(1) phase_ln_mid(p);
  xcd_barrier(xb);
  REP(32) phase_peerq(p, smem);
  xcd_barrier(xb);
  REP(64) phase_route(p, smem);
  xcd_barrier(xb);
  REP(128) phase_ffn_u(p);
  xcd_barrier(xb);
  REP(128) phase_ffn_w(p);
  xcd_barrier(xb);
  REP(256) phase_ffn_v(p);
  xcd_barrier(xb);
  REP(512) phase_final(p);
}

extern "C" void kernel_launch(void* const* d_in, const int* in_sizes, int n_in, void* d_out, int out_size, void* d_ws, size_t ws_size, hipStream_t stream) {
  if (ws_size < OFF_END) { fprintf(stderr, "workspace too small: %zu < %zu\n", ws_size, (size_t)OFF_END); return; }
  static int grid_blocks = 0;
  if (!grid_blocks) {
    int dev = 0, cus = 0, per_cu = 0;
    (void)hipGetDevice(&dev);
    (void)hipDeviceGetAttribute(&cus, hipDeviceAttributeMultiprocessorCount, dev);
    (void)hipOccupancyMaxActiveBlocksPerMultiprocessor(&per_cu, k_mega, NT, 0);
    if (per_cu < 1) fprintf(stderr, "occupancy query returned %d\n", per_cu);
    grid_blocks = (cus / 8) * 8;
  }
  Params p{};
  const float** fp = (const float**)&p;
  for (int i = 0; i < 26; ++i) fp[i] = (const float*)d_in[i];
  p.out = (float*)d_out;
  p.ws = (char*)d_ws;
  for (int i = 0; i < 32; ++i) p.inv_freq[i] = (float)pow(10000.0, -(double)i / 32.0);
  (void)hipMemsetAsync((char*)d_ws + OFF_BAR, 0, (XCD_BAR_WORDS + 64) * 4, stream);
  void* args[] = {&p};
  hipError_t e = hipLaunchCooperativeKernel((void*)k_mega, dim3(grid_blocks), dim3(NT), args, 0, stream);
  if (e != hipSuccess) fprintf(stderr, "cooperative launch failed: %s (grid %d)\n", hipGetErrorString(e), grid_blocks);
}
```

```cpp
#include <hip/hip_runtime.h>
#include <hip/hip_cooperative_groups.h>
#include <stdint.h>
#include <stdio.h>
#include <math.h>
namespace cg = cooperative_groups;

#ifndef PROBE_DUP
#define PROBE_DUP 0
#endif
#ifndef NSA_MASK
#define NSA_MASK 7
#endif
typedef unsigned short bf16_t;
typedef short bf16x8 __attribute__((ext_vector_type(8)));
typedef short s16x4 __attribute__((ext_vector_type(4)));
typedef float f32x16 __attribute__((ext_vector_type(16)));
typedef float f32x4 __attribute__((ext_vector_type(4)));
typedef float f32x2 __attribute__((ext_vector_type(2)));
typedef __bf16 bf16v2 __attribute__((ext_vector_type(2)));
typedef unsigned u32x4 __attribute__((ext_vector_type(4)));
typedef int i32x4 __attribute__((ext_vector_type(4)));
typedef int i32x8 __attribute__((ext_vector_type(8)));
typedef unsigned u32x2 __attribute__((ext_vector_type(2)));
#define DI __device__ __forceinline__
#define LAS __attribute__((address_space(3)))
#define MFMA32(a, b, c) __builtin_amdgcn_mfma_f32_32x32x16_bf16((a), (b), (c), 0, 0, 0)

constexpr int NT = 512, NW = 8;
constexpr int NB = 8, SEQ = 8192, DM = 1024, NTOK = NB * SEQ;
constexpr int N1 = 4608;
constexpr float DN_ALPHA = 1.189207115002721f;
constexpr float LN_EPS = 1e-5f;

constexpr size_t MB = 1024 * 1024;
constexpr size_t OFF_MOD = 0;
constexpr size_t OFF_ROPE = OFF_MOD + 256 * 1024;
constexpr size_t OFF_POSB = OFF_ROPE + 2 * MB;
constexpr size_t OFF_WT1 = OFF_POSB + 4096;
constexpr size_t OFF_WB = OFF_WT1 + (size_t)N1 * 1024 * 2;
constexpr size_t OFF_WOUT = OFF_WB + 2 * MB;
constexpr size_t OFF_WQ = OFF_WOUT + 2 * MB;
constexpr size_t OFF_PKEYS = OFF_WQ + 4 * MB;
constexpr size_t OFF_CW1 = OFF_PKEYS + MB / 2;
constexpr size_t OFF_CW2 = OFF_CW1 + MB;
constexpr size_t OFF_SGUW = OFF_CW2 + 32 * 1024;
constexpr size_t OFF_SCU = OFF_SGUW + 256 * 1024;
constexpr size_t OFF_SCV = OFF_SCU + 64 * 1024;
constexpr size_t OFF_PU = OFF_SCV + 64 * 1024;
constexpr size_t OFF_PV = OFF_PU + 32 * MB;
constexpr size_t OFF_ACT = ((OFF_PV + 32 * MB + 4095) / 4096) * 4096;
constexpr size_t OFF_H = OFF_ACT;
constexpr size_t OFF_Q = OFF_H + 128 * MB;
constexpr size_t OFF_KC = OFF_Q + 64 * MB;
constexpr size_t OFF_VC = OFF_KC + 16 * MB;
constexpr size_t OFF_KS = OFF_VC + 16 * MB;
constexpr size_t OFF_VS = OFF_KS + 16 * MB;
constexpr size_t OFF_KW = OFF_VS + 16 * MB;
constexpr size_t OFF_VW = OFF_KW + 16 * MB;
constexpr size_t OFF_U = OFF_VW + 16 * MB;
constexpr size_t OFF_V = OFF_U + 64 * MB;
constexpr size_t OFF_GATE = OFF_V + 64 * MB;
constexpr size_t OFF_GSIG = OFF_GATE + 256 * MB;
constexpr size_t OFF_KCMP = OFF_GSIG + 8 * MB;
constexpr size_t OFF_VCMP = OFF_KCMP + MB;
constexpr size_t OFF_ONSA = OFF_VCMP + MB;
constexpr size_t OFF_SELG = OFF_ONSA + 64 * MB;
constexpr size_t OFF_BAR = OFF_SELG + 2 * MB;
constexpr size_t OFF_END = OFF_BAR + 64 * 1024;
constexpr size_t OFF_X1 = OFF_Q;
constexpr size_t OFF_Y = OFF_GATE;
constexpr size_t OFF_PQ = OFF_GATE;
constexpr size_t OFF_EIDX = OFF_ONSA;
constexpr size_t OFF_PGATE = OFF_ONSA + 32 * MB;
constexpr size_t OFF_PU8 = OFF_PU;
constexpr size_t OFF_PART = OFF_GATE;
constexpr size_t OFF_PV8 = OFF_PU + 16 * MB;
constexpr size_t OFF_WBUF = OFF_PU + 32 * MB;
constexpr size_t OFF_H2Q = OFF_U;
constexpr size_t OFF_SH = OFF_V;
constexpr size_t OFF_FFNB = OFF_GATE;
constexpr size_t OFF_SCW1 = OFF_WT1 + 5 * MB;
constexpr size_t OFF_SCWQ = OFF_WQ + 3 * MB;
constexpr size_t OFF_GATE8 = OFF_GATE;
constexpr size_t OFF_OSGU8 = OFF_GATE + 128 * MB;
constexpr size_t OFF_ONSA8 = OFF_GATE + 160 * MB;
constexpr size_t OFF_MRG8 = OFF_GATE + 192 * MB;
constexpr size_t OFF_M08 = OFF_H;
constexpr size_t OFF_SCWB = OFF_WB + 3 * MB / 2;
constexpr size_t OFF_SCWO = OFF_WOUT + 3 * MB / 2;
constexpr size_t OFF_SA = OFF_H + 64 * MB;

struct Params {
  const float *x, *c, *w_ada, *b_ada, *w_in, *cmp_pos, *cmp_w1, *cmp_b1, *cmp_w2, *cmp_b2, *sgu_ln_g, *sgu_ln_b, *sgu_w, *sgu_b,
      *w_branch, *w_merge, *b_merge, *w_out, *ln1_g, *ln1_b, *peer_wq, *peer_keys, *peer_u, *peer_v, *ln2_g, *ln2_b;
  float* out;
  char* ws;
  float inv_freq[32];
};

DI unsigned pack2(float lo, float hi) { f32x2 v = {lo, hi}; bf16v2 r = __builtin_convertvector(v, bf16v2); return __builtin_bit_cast(unsigned, r); }
DI bf16_t f2bf(float f) { __bf16 r = (__bf16)f; return __builtin_bit_cast(unsigned short, r); }
DI float bf2f(bf16_t h) { return __uint_as_float(((unsigned)h) << 16); }
DI float bflo(unsigned u) { return __uint_as_float(u << 16); }
DI float bfhi(unsigned u) { return __uint_as_float(u & 0xffff0000u); }
DI float gelu_f(float v) { return 0.5f * v * (1.0f + erff(v * 0.70710678118654752f)); }
DI float sigmoid_f(float v) { return __builtin_amdgcn_rcpf(1.0f + __builtin_amdgcn_exp2f(v * -1.4426950408889634f)); }
DI int otid() { int t = __builtin_amdgcn_workitem_id_x(); asm volatile("" : "+v"(t)); return t; }
DI void lds_barrier() { asm volatile("s_waitcnt lgkmcnt(0)" ::: "memory"); __builtin_amdgcn_s_barrier(); asm volatile("" ::: "memory"); }
DI float xor1f(float x) { const int xi = __float_as_int(x); return __int_as_float(__builtin_amdgcn_update_dpp(xi, xi, 0xB1, 0xF, 0xF, false)); }
DI float xor2f(float x) { const int xi = __float_as_int(x); return __int_as_float(__builtin_amdgcn_update_dpp(xi, xi, 0x4E, 0xF, 0xF, false)); }
DI float xor8f(float x) { const int xi = __float_as_int(x); return __int_as_float(__builtin_amdgcn_update_dpp(xi, xi, 0x128, 0xF, 0xF, false)); }
DI unsigned xor32u(unsigned x, int lane) { const u32x2 r = __builtin_amdgcn_permlane32_swap(x, x, false, false); return (lane & 32) ? r.x : r.y; }
DI unsigned xor16u(unsigned x, int lane) { const u32x2 r = __builtin_amdgcn_permlane16_swap(x, x, false, false); return (lane & 16) ? r.x : r.y; }
DI float xor32f(float x, int lane) { return __uint_as_float(xor32u(__float_as_uint(x), lane)); }
DI float xor16f(float x, int lane) { return __uint_as_float(xor16u(__float_as_uint(x), lane)); }
DI unsigned pack_i8x4(float a, float b, float c, float d) {
  const int ia = (int)rintf(a), ib = (int)rintf(b), ic = (int)rintf(c), id = (int)rintf(d);
  return (unsigned)(ia & 0xff) | ((unsigned)(ib & 0xff) << 8) | ((unsigned)(ic & 0xff) << 16) | ((unsigned)id << 24);
}
DI unsigned pk4_fp8(float a, float b, float c, float d) { int t = 0; t = __builtin_amdgcn_cvt_pk_fp8_f32(a, b, t, false); t = __builtin_amdgcn_cvt_pk_fp8_f32(c, d, t, true); return (unsigned)t; }
DI float clamp_f8(float v) { return __builtin_amdgcn_fmed3f(v, -448.0f, 448.0f); }
DI void unpack8_fp8(const u32x2 w, float (&v)[8]) {
  const f32x2 a = __builtin_amdgcn_cvt_pk_f32_fp8((int)w.x, false), b = __builtin_amdgcn_cvt_pk_f32_fp8((int)w.x, true);
  const f32x2 c = __builtin_amdgcn_cvt_pk_f32_fp8((int)w.y, false), d = __builtin_amdgcn_cvt_pk_f32_fp8((int)w.y, true);
  v[0] = a.x; v[1] = a.y; v[2] = b.x; v[3] = b.y; v[4] = c.x; v[5] = c.y; v[6] = d.x; v[7] = d.y;
}
DI float wave_sum(float v) {
#pragma unroll
  for (int o = 32; o > 0; o >>= 1) v += __shfl_xor(v, o);
  return v;
}
DI void ld8(const float* pz, float (&v)[8]) { const f32x4 a = *(const f32x4*)pz, b = *(const f32x4*)(pz + 4); v[0] = a.x; v[1] = a.y; v[2] = a.z; v[3] = a.w; v[4] = b.x; v[5] = b.y; v[6] = b.z; v[7] = b.w; }
DI u32x4 pack8(const float (&v)[8]) { u32x4 w; w.x = pack2(v[0], v[1]); w.y = pack2(v[2], v[3]); w.z = pack2(v[4], v[5]); w.w = pack2(v[6], v[7]); return w; }
DI void unpack8(const u32x4 w, float (&v)[8]) { v[0] = bflo(w.x); v[1] = bfhi(w.x); v[2] = bflo(w.y); v[3] = bfhi(w.y); v[4] = bflo(w.z); v[5] = bfhi(w.z); v[6] = bflo(w.w); v[7] = bfhi(w.w); }
DI f32x2 gelu_pk(f32x2 v) {
  const f32x2 av = __builtin_elementwise_abs(v), d = av * 0.2316418882f + 1.0f;
  f32x2 t; t.x = __builtin_amdgcn_rcpf(d.x); t.y = __builtin_amdgcn_rcpf(d.y);
  f32x2 q = t * 0.5307027145f + (-0.7265760135f); q = q * t + 0.7107068705f; q = q * t + (-0.142248368f); q = q * t + 0.127414796f; q = q * t;
  const f32x2 s = (v * v) * (-0.72134752044f);
  f32x2 e; e.x = __builtin_amdgcn_exp2f(s.x); e.y = __builtin_amdgcn_exp2f(s.y);
  const f32x2 m = v * (q * e), r = v - m;
  f32x2 o; o.x = v.x < 0.f ? m.x : r.x; o.y = v.y < 0.f ? m.y : r.y; return o;
}
__host__ __device__ __forceinline__ int dperm(int q) { const int grp = q >> 5, fq = (q >> 3) & 3, j = q & 7; return (j < 4) ? (16 * grp + 4 * fq + j) : (32 + 16 * grp + 4 * fq + (j - 4)); }

template <class F>
DI void tconv_tile(float* tile, int k0, int n0, bf16_t* dst, int ldd, F f) {
  const int tid = otid();
  __syncthreads();
#pragma unroll 4
  for (int i = 0; i < 8; ++i) { const int kl = i * 8 + (tid >> 6), nl = tid & 63; tile[nl * 65 + kl] = f(k0 + kl, n0 + nl); }
  __syncthreads();
  {
    const int nl = tid >> 3, kc = tid & 7;
    const float* t = tile + nl * 65 + kc * 8;
    u32x4 w; w.x = pack2(t[0], t[1]); w.y = pack2(t[2], t[3]); w.z = pack2(t[4], t[5]); w.w = pack2(t[6], t[7]);
    *(u32x4*)(dst + (size_t)(n0 + nl) * ldd + k0 + kc * 8) = w;
  }
}

template <bool FP8, class F>
DI void tconv_strip32(float* tile, int n0, int K, unsigned char* dst, float* gscale, F f) {
  const int tid = otid(), nl = tid & 31, kr = tid >> 5, ld = K + 1;
  float am = 0.f;
#pragma unroll 16
  for (int k = kr; k < K; k += 16) { const float v = f(k, n0 + nl); tile[nl * ld + k] = v; am = fmaxf(am, fabsf(v)); }
#pragma unroll
  for (int o = 16; o > 0; o >>= 1) am = fmaxf(am, __shfl_xor(am, o));
  float* red = tile + 32 * ld;
  if (nl == 0) red[kr] = am;
  __syncthreads();
  float g = 0.f;
#pragma unroll
  for (int w = 0; w < 16; ++w) g = fmaxf(g, red[w]);
  float q, inv;
  if (FP8) {
    const unsigned be = (__float_as_uint(g) >> 23) & 0xffu;
    const bool ok = be >= 16u && be <= 240u;
    q = ok ? __uint_as_float((261u - be) << 23) : 1.0f; inv = ok ? __uint_as_float((be - 7u) << 23) : 1.0f;
  } else { q = g > 0.f ? 127.0f / g : 0.f; inv = g * (1.0f / 127.0f); }
  if (tid == 0) gscale[n0 >> 5] = inv;
  const int cpr = K >> 3;
  for (int idx = tid; idx < 32 * cpr; idx += NT) {
    const int row = idx / cpr, kc = idx - row * cpr;
    const float* t = tile + row * ld + kc * 8;
    u32x2 w;
    if (FP8) { w.x = pk4_fp8(t[0] * q, t[1] * q, t[2] * q, t[3] * q); w.y = pk4_fp8(t[4] * q, t[5] * q, t[6] * q, t[7] * q); }
    else { w.x = pack_i8x4(t[0] * q, t[1] * q, t[2] * q, t[3] * q); w.y = pack_i8x4(t[4] * q, t[5] * q, t[6] * q, t[7] * q); }
    *(u32x2*)(dst + (size_t)(n0 + row) * K + kc * 8) = w;
  }
}

DI void conv_chunk(const float* src, bf16_t* dst, size_t base) {
  const size_t i = base + (size_t)otid() * 8;
  const f32x4 a = *(const f32x4*)(src + i), b = *(const f32x4*)(src + i + 4);
  u32x4 w; w.x = pack2(a.x, a.y); w.y = pack2(a.z, a.w); w.z = pack2(b.x, b.y); w.w = pack2(b.z, b.w);
  *(u32x4*)(dst + i) = w;
}

DI void sincos_d(double x, double& s, double& c) {
  const double y = x * 0.25, y2 = y * y;
  double sn = y * (1.0 + y2 * (-1.0 / 6 + y2 * (1.0 / 120 + y2 * (-1.0 / 5040 + y2 * (1.0 / 362880 + y2 * (-1.0 / 39916800 + y2 * (1.0 / 6227020800.0)))))));
  double cs = 1.0 + y2 * (-0.5 + y2 * (1.0 / 24 + y2 * (-1.0 / 720 + y2 * (1.0 / 40320 + y2 * (-1.0 / 3628800 + y2 * (1.0 / 479001600.0 + y2 * (-1.0 / 87178291200.0)))))));
#pragma unroll
  for (int i = 0; i < 2; ++i) { const double s2 = 2.0 * sn * cs, c2 = cs * cs - sn * sn; sn = s2; cs = c2; }
  s = sn; c = cs;
}

DI void phase_prep(const Params& p, char* smem, unsigned* wcnt) {
  const int tid = otid();
  float* fs = (float*)smem;
  char* ws = p.ws;
  volatile LAS unsigned* slot = (volatile LAS unsigned*)(smem + 147456 + 64);
  constexpr int nB = 144, nE = 64, nC = 64, nD = 32, nA = 192, nI = 512, nF = 2 * 32 * 2, nG = 4, nH = 8, nJ = 64, nK = 32, nL = 512, nM = 512;
  constexpr int total = nB + nE + nC + nD + nA + nI + nF + nG + nH + nJ + nK + nL + nM;
  for (;;) {
    __syncthreads();
    if (tid == 0) *slot = __hip_atomic_fetch_add(wcnt, 1u, __ATOMIC_RELAXED, __HIP_MEMORY_SCOPE_AGENT);
    __syncthreads();
    int it = (int)*slot;
    if (it >= total) break;
    if (it < nB) {
      const float* w_in = p.w_in; const float* w_merge = p.w_merge;
      tconv_strip32<false>(fs, it * 32, 1024, (unsigned char*)(ws + OFF_WT1), (float*)(ws + OFF_SCW1), [=](int k, int n) -> float {
        if (n < 1280) {
          const bool roped = (n < 640) || (n >= 768 && n < 896) || (n >= 1024 && n < 1152);
          const int col = roped ? ((n & ~63) + dperm(n & 63)) : n;
          return w_in[(size_t)k * 2328 + col];
        }
        if (n < 2304) return w_in[(size_t)k * 2328 + n + 24];
        if (n < 4352) return w_merge[(size_t)k * 2048 + (n - 2304)];
        if (n < 4376) return w_in[(size_t)k * 2328 + 1280 + (n - 4352)];
        return 0.f; });
      continue;
    }
    it -= nB;
    if (it < nE) {
      const float* src = p.peer_wq;
      tconv_strip32<false>(fs, it * 32, 1024, (unsigned char*)(ws + OFF_WQ), (float*)(ws + OFF_SCWQ), [=](int k, int n) -> float { return src[(size_t)k * 2048 + n]; });
      continue;
    }
    it -= nE;
    if (it < nC) {
      const int br = it >> 5, strip = it & 31;
      const float* src = p.w_branch + (size_t)br * 512 * 1024;
      tconv_strip32<true>(fs, strip * 32, 512, (unsigned char*)(ws + OFF_WB) + (size_t)br * 1024 * 512, (float*)(ws + OFF_SCWB) + br * 32, [=](int k, int n) -> float { return src[(size_t)k * 1024 + n]; });
      continue;
    }
    it -= nC;
    if (it < nD) {
      const float* src = p.w_out;
      tconv_strip32<true>(fs, it * 32, 1024, (unsigned char*)(ws + OFF_WOUT), (float*)(ws + OFF_SCWO), [=](int k, int n) -> float { return src[(size_t)k * 1024 + n]; });
      continue;
    }
    it -= nD;
    if (it < nA) {
      float* sc = fs;
      float* red = fs + 8192;
      for (int i = tid; i < 8192; i += NT) { const float v = p.c[i]; sc[i] = v / (1.0f + __expf(-v)); }
      __syncthreads();
      const int ks = tid >> 5, cj = tid & 31, col = it * 32 + cj;
      float acc[8];
#pragma unroll
      for (int b = 0; b < 8; ++b) acc[b] = 0.f;
#pragma unroll 16
      for (int k = ks * 64; k < ks * 64 + 64; ++k) {
        const float w = p.w_ada[(size_t)k * 6144 + col];
#pragma unroll
        for (int b = 0; b < 8; ++b) acc[b] += sc[b * 1024 + k] * w;
      }
#pragma unroll
      for (int b = 0; b < 8; ++b) red[(ks * 8 + b) * 32 + cj] = acc[b];
      __syncthreads();
      if (tid < 256) {
        const int b = tid >> 5;
        float s = p.b_ada[col];
#pragma unroll
        for (int k2 = 0; k2 < 16; ++k2) s += red[(k2 * 8 + b) * 32 + cj];
        ((float*)(ws + OFF_MOD))[b * 6144 + col] = s;
      }
      continue;
    }
    it -= nA;
    if (it < nI) {
      const int e = it * 512 + tid, pos = e >> 5, i = e & 31;
      const float ang = (float)pos * p.inv_freq[i];
      const double a = (double)ang;
      const double kk = rint(a * 0.15915494309189535);
      const double r = a - kk * 6.283185307179586476925;
      double sn, cs; sincos_d(r, sn, cs);
      ((float*)(ws + OFF_ROPE))[e] = (float)cs;
      ((float*)(ws + OFF_ROPE))[262144 + e] = (float)sn;
      continue;
    }
    it -= nI;
    if (it < nF) {
      const int w = it >> 6, r = it & 63, kt = r >> 1, ntile = r & 1;
      const float* src = p.cmp_w1 + (size_t)w * 2048 * 128;
      tconv_tile(fs, kt * 64, ntile * 64, (bf16_t*)(ws + OFF_CW1) + (size_t)w * 128 * 2048, 2048, [=](int k, int n) -> float {
        const int ksrc = (w == 0) ? ((k & ~63) + dperm(k & 63)) : k;
        return src[(size_t)ksrc * 128 + n]; });
      continue;
    }
    it -= nF;
    if (it < nG) {
      const int w = it >> 1, kt = it & 1;
      const float* src = p.cmp_w2 + (size_t)w * 128 * 64;
      tconv_tile(fs, kt * 64, 0, (bf16_t*)(ws + OFF_CW2) + (size_t)w * 64 * 128, 128, [=](int k, int n) -> float { return src[(size_t)k * 64 + ((w == 0) ? dperm(n) : n)]; });
      continue;
    }
    it -= nG;
    if (it < nH) {
      const int w = it >> 2, jc = it & 3, ks = tid >> 5, cj = tid & 31, j = jc * 32 + cj;
      float* red = fs;
      const float* pos = p.cmp_pos + w * 2048; const float* w1 = p.cmp_w1 + (size_t)w * 2048 * 128;
      float acc = 0.f;
#pragma unroll 16
      for (int k = ks * 128; k < ks * 128 + 128; ++k) acc += pos[k] * w1[(size_t)k * 128 + j];
      red[ks * 32 + cj] = acc;
      __syncthreads();
      if (tid < 32) { float s = p.cmp_b1[w * 128 + j]; for (int k2 = 0; k2 < 16; ++k2) s += red[k2 * 32 + tid]; ((float*)(ws + OFF_POSB))[w * 128 + j] = s; }
      continue;
    }
    it -= nH;
    if (it < nJ) { conv_chunk(p.peer_keys, (bf16_t*)(ws + OFF_PKEYS), (size_t)it * 4096); continue; }
    it -= nJ;
    if (it < nK) {
      const size_t i0 = (size_t)it * 4096 + (size_t)tid * 8;
      const int rowi = (int)((i0 >> 7) & 127), j0 = (int)(i0 & 127);
      float v[8];
#pragma unroll
      for (int j = 0; j < 8; ++j) v[j] = (j0 + j <= rowi) ? p.sgu_w[i0 + j] : 0.f;
      u32x4 w; w.x = pack2(v[0], v[1]); w.y = pack2(v[2], v[3]); w.z = pack2(v[4], v[5]); w.w = pack2(v[6], v[7]);
      *(u32x4*)((bf16_t*)(ws + OFF_SGUW) + i0) = w;
      continue;
    }
    it -= nK;
    {
      const bool isv = it >= nL;
      if (isv) it -= nL;
      const int lane = tid & 63, e0 = it * 32 + (tid >> 6) * 4;
      const float* src = (isv ? p.peer_v : p.peer_u) + (size_t)e0 * 1024 + lane * 16;
      f32x4 raw[4][4];
#pragma unroll
      for (int r = 0; r < 4; ++r)
#pragma unroll
        for (int i = 0; i < 4; ++i) raw[r][i] = *(const f32x4*)(src + (size_t)r * 1024 + i * 4);
#pragma unroll
      for (int r = 0; r < 4; ++r) {
        const int e = e0 + r;
        float v[16];
#pragma unroll
        for (int i = 0; i < 4; ++i) { v[4 * i] = raw[r][i].x; v[4 * i + 1] = raw[r][i].y; v[4 * i + 2] = raw[r][i].z; v[4 * i + 3] = raw[r][i].w; }
        float amax = 0.f;
#pragma unroll
        for (int i = 0; i < 16; ++i) amax = fmaxf(amax, fabsf(v[i]));
#pragma unroll
        for (int o = 32; o > 0; o >>= 1) amax = fmaxf(amax, __shfl_xor(amax, o));
        if (!isv) {
          const float qs = amax > 0.f ? 127.0f / amax : 0.f;
          u32x4 wi; wi.x = pack_i8x4(v[0] * qs, v[1] * qs, v[2] * qs, v[3] * qs); wi.y = pack_i8x4(v[4] * qs, v[5] * qs, v[6] * qs, v[7] * qs);
          wi.z = pack_i8x4(v[8] * qs, v[9] * qs, v[10] * qs, v[11] * qs); wi.w = pack_i8x4(v[12] * qs, v[13] * qs, v[14] * qs, v[15] * qs);
          *(u32x4*)(ws + OFF_PU8 + ((size_t)(lane >> 3) * 16384 + e) * 128 + (lane & 7) * 16) = wi;
          if (lane == 0) ((float*)(ws + OFF_SCU))[e] = amax * (1.0f / 127.0f);
        } else {
          const unsigned be = (__float_as_uint(amax) >> 23) & 0xffu;
          const bool okr = be >= 16u && be <= 240u;
          const float scale = okr ? __uint_as_float((261u - be) << 23) : 1.0f;
          const float inv = okr ? __uint_as_float((be - 7u) << 23) : 1.0f;
          u32x4 w; w.x = pk4_fp8(v[0] * scale, v[1] * scale, v[2] * scale, v[3] * scale); w.y = pk4_fp8(v[4] * scale, v[5] * scale, v[6] * scale, v[7] * scale);
          w.z = pk4_fp8(v[8] * scale, v[9] * scale, v[10] * scale, v[11] * scale); w.w = pk4_fp8(v[12] * scale, v[13] * scale, v[14] * scale, v[15] * scale);
          *(u32x4*)(ws + OFF_PV8 + ((size_t)(lane >> 3) * 16384 + e) * 128 + (lane & 7) * 16) = w;
          if (lane == 0) ((float*)(ws + OFF_SCV))[e] = inv;
        }
      }
    }
  }
}

DI void row_stats(const float (&v)[16], float& mean, float& rstd) {
  float s = 0.f;
#pragma unroll
  for (int i = 0; i < 16; ++i) s += v[i];
  mean = wave_sum(s) * (1.0f / 1024.0f);
  float q = 0.f;
#pragma unroll
  for (int i = 0; i < 16; ++i) { const float d = v[i] - mean; q += d * d; }
  rstd = rsqrtf(wave_sum(q) * (1.0f / 1024.0f) + LN_EPS);
}

DI void phase_ln_in(const Params& p) {
  const int lane = otid() & 63, wave = otid() >> 6;
  const float* mod = (const float*)(p.ws + OFF_MOD);
  unsigned* h8 = (unsigned*)(p.ws + OFF_H);
  for (int grp = blockIdx.x; grp < NTOK / NW; grp += gridDim.x) {
    const int row = grp * NW + wave, b = row >> 13;
    const float* xr = p.x + (size_t)row * DM;
    float v[16];
#pragma unroll
    for (int i = 0; i < 4; ++i) { const f32x4 t = *(const f32x4*)(xr + i * 256 + lane * 4); v[4 * i] = t.x; v[4 * i + 1] = t.y; v[4 * i + 2] = t.z; v[4 * i + 3] = t.w; }
    float mean, rstd; row_stats(v, mean, rstd);
    float amax = 0.f;
#pragma unroll
    for (int i = 0; i < 4; ++i) {
      const int col = i * 256 + lane * 4;
      const f32x4 sh = *(const f32x4*)(mod + b * 6144 + col), sc = *(const f32x4*)(mod + b * 6144 + 1024 + col);
      const float o0 = (v[4 * i] - mean) * rstd * (1.f + sc.x) + sh.x, o1 = (v[4 * i + 1] - mean) * rstd * (1.f + sc.y) + sh.y;
      const float o2 = (v[4 * i + 2] - mean) * rstd * (1.f + sc.z) + sh.z, o3 = (v[4 * i + 3] - mean) * rstd * (1.f + sc.w) + sh.w;
      v[4 * i] = o0; v[4 * i + 1] = o1; v[4 * i + 2] = o2; v[4 * i + 3] = o3;
      amax = fmaxf(amax, fmaxf(fmaxf(fabsf(o0), fabsf(o1)), fmaxf(fabsf(o2), fabsf(o3))));
    }
#pragma unroll
    for (int o = 32; o > 0; o >>= 1) amax = fmaxf(amax, __shfl_xor(amax, o));
    const float qs = amax > 0.f ? 127.0f / amax : 0.f;
#pragma unroll
    for (int i = 0; i < 4; ++i) h8[(size_t)row * 256 + i * 64 + lane] = pack_i8x4(v[4 * i] * qs, v[4 * i + 1] * qs, v[4 * i + 2] * qs, v[4 * i + 3] * qs);
    if (lane == 0) ((float*)(p.ws + OFF_SA))[row] = amax * (1.0f / 127.0f);
  }
}

DI void phase_ln_mid(const Params& p) {
  const int lane = otid() & 63, wave = otid() >> 6;
  const float* mod = (const float*)(p.ws + OFF_MOD);
  const bf16_t* y = (const bf16_t*)(p.ws + OFF_Y);
  bf16_t* x1 = (bf16_t*)(p.ws + OFF_X1);
  for (int grp = blockIdx.x; grp < NTOK / NW; grp += gridDim.x) {
    const int row = grp * NW + wave, b = row >> 13;
    const bf16_t* yr = y + (size_t)row * DM;
    float v[16];
#pragma unroll
    for (int i = 0; i < 4; ++i) { const u32x2 t = *(const u32x2*)(yr + i * 256 + lane * 4); v[4 * i] = bflo(t.x); v[4 * i + 1] = bfhi(t.x); v[4 * i + 2] = bflo(t.y); v[4 * i + 3] = bfhi(t.y); }
    float mean, rstd; row_stats(v, mean, rstd);
#pragma unroll
    for (int i = 0; i < 4; ++i) {
      const int col = i * 256 + lane * 4;
      const f32x4 g = *(const f32x4*)(p.ln1_g + col), bb = *(const f32x4*)(p.ln1_b + col);
      f32x4 o;
      o.x = (v[4 * i] - mean) * rstd * g.x + bb.x; o.y = (v[4 * i + 1] - mean) * rstd * g.y + bb.y;
      o.z = (v[4 * i + 2] - mean) * rstd * g.z + bb.z; o.w = (v[4 * i + 3] - mean) * rstd * g.w + bb.w;
      { u32x2 w; w.x = pack2(o.x, o.y); w.y = pack2(o.z, o.w); *(u32x2*)(x1 + (size_t)row * DM + col) = w; }
      v[4 * i] = o.x; v[4 * i + 1] = o.y; v[4 * i + 2] = o.z; v[4 * i + 3] = o.w;
    }
    row_stats(v, mean, rstd);
    float amax = 0.f;
#pragma unroll
    for (int i = 0; i < 4; ++i) {
      const int col = i * 256 + lane * 4;
      const f32x4 sh = *(const f32x4*)(mod + b * 6144 + 3072 + col), sc = *(const f32x4*)(mod + b * 6144 + 4096 + col);
      const float o0 = (v[4 * i] - mean) * rstd * (1.f + sc.x) + sh.x, o1 = (v[4 * i + 1] - mean) * rstd * (1.f + sc.y) + sh.y;
      const float o2 = (v[4 * i + 2] - mean) * rstd * (1.f + sc.z) + sh.z, o3 = (v[4 * i + 3] - mean) * rstd * (1.f + sc.w) + sh.w;
      v[4 * i] = o0; v[4 * i + 1] = o1; v[4 * i + 2] = o2; v[4 * i + 3] = o3;
      amax = fmaxf(amax, fmaxf(fmaxf(fabsf(o0), fabsf(o1)), fmaxf(fabsf(o2), fabsf(o3))));
    }
#pragma unroll
    for (int o = 32; o > 0; o >>= 1) amax = fmaxf(amax, __shfl_xor(amax, o));
    const float qs = amax > 0.f ? 127.0f / amax : 0.f;
    unsigned* h2q = (unsigned*)(p.ws + OFF_H2Q);
#pragma unroll
    for (int i = 0; i < 4; ++i) h2q[(size_t)row * 256 + i * 64 + lane] = pack_i8x4(v[4 * i] * qs, v[4 * i + 1] * qs, v[4 * i + 2] * qs, v[4 * i + 3] * qs);
    if (lane == 0) ((float*)(p.ws + OFF_SH))[row] = amax * (1.0f / 127.0f);
  }
}

namespace pg8 {
constexpr int BM = 256, BK = 64, HALF = 128, HTB = HALF * BK * 2, STAGE_BYTES = 8 * HTB, NXCD = 8, WGM = 8;
DI int lds_byte(int r, int c) { const int st = (r >> 4) * 2 + (c >> 5), rr = r & 15, cc = c & 31, ob = rr * 64 + cc * 2; return st * 1024 + (ob ^ (((ob >> 9) & 1) << 5)); }
DI void stage_rc(int b, int& R, int& C) { const int st = b / 1024, sb = b % 1024, swz = sb ^ (((sb >> 9) & 1) << 5); R = (st >> 1) * 16 + swz / 64; C = (st & 1) * 32 + (swz % 64) / 2; }
DI int perm32(int rho) { const int n = rho >> 4, i = rho & 15; return 8 * (i >> 2) + 4 * n + (i & 3); }
struct Unit { int pm, pn; };
struct Gemm { const bf16_t* A; const bf16_t* Bt; int M, N, K; };
struct StaticOrder {
  int nM, nN, nwg, G, c;
  DI void init(int M, int N, int G_, int c_) { nM = M / BM; nN = N / BM; nwg = nM * nN; G = G_; c = c_; }
  DI bool next(int i, Unit& u) const {
    const long L = (long)i * G + c; if (L >= nwg) return false;
    int wgid = (int)L; { const int q = nwg / NXCD, r = nwg % NXCD, xcd = wgid % NXCD, off = wgid / NXCD; wgid = (xcd < r ? xcd * (q + 1) : r * (q + 1) + (xcd - r) * q) + off; }
    const int nig = WGM * nN, gid = wgid / nig, fm = gid * WGM, gsz = (nM - fm) < WGM ? (nM - fm) : WGM;
    u.pm = fm + ((wgid % nig) % gsz); u.pn = (wgid % nig) / gsz; return true;
  }
};

template <int MODE, class AccT>
DI AccT mma_pair(bf16x8 b0, bf16x8 b1, bf16x8 a0, bf16x8 a1, AccT c) {
  if constexpr (MODE == 0) { c = __builtin_amdgcn_mfma_f32_16x16x32_bf16(b0, a0, c, 0, 0, 0); return __builtin_amdgcn_mfma_f32_16x16x32_bf16(b1, a1, c, 0, 0, 0); }
  else if constexpr (MODE == 1) {
    c = __builtin_amdgcn_mfma_i32_16x16x64_i8(__builtin_bit_cast(i32x4, b0), __builtin_bit_cast(i32x4, a0), c, 0, 0, 0);
    return __builtin_amdgcn_mfma_i32_16x16x64_i8(__builtin_bit_cast(i32x4, b1), __builtin_bit_cast(i32x4, a1), c, 0, 0, 0);
  } else {
    const i32x8 B = __builtin_shufflevector(__builtin_bit_cast(i32x4, b0), __builtin_bit_cast(i32x4, b1), 0, 1, 2, 3, 4, 5, 6, 7);
    const i32x8 A = __builtin_shufflevector(__builtin_bit_cast(i32x4, a0), __builtin_bit_cast(i32x4, a1), 0, 1, 2, 3, 4, 5, 6, 7);
    asm volatile("v_mfma_f32_16x16x128_f8f6f4 %0, %1, %2, %0" : "+v"(c) : "v"(B), "v"(A));
    return c;
  }
}
DI f32x4 mma16(bf16x8 a, bf16x8 b, f32x4 c) { return __builtin_amdgcn_mfma_f32_16x16x32_bf16(a, b, c, 0, 0, 0); }
DI i32x4 mma16(bf16x8 a, bf16x8 b, i32x4 c) { return __builtin_amdgcn_mfma_i32_16x16x64_i8(__builtin_bit_cast(i32x4, a), __builtin_bit_cast(i32x4, b), c, 0, 0, 0); }
template <class Epi>
DI void gemm_phase(LAS unsigned char* lds, const Gemm g, const StaticOrder& S, const Epi& E) {
  const int tid = otid(), wid = __builtin_amdgcn_readfirstlane(tid >> 6), lane = tid & 63, wr = wid >> 2, wc = wid & 3, fr = lane & 15, fq = lane >> 4;
  const int K = g.K, nt = K / BK;
  unsigned voffA[2], voffB[2];
#pragma unroll
  for (int i = 0; i < 2; ++i) { int R, C; stage_rc(tid * 16 + i * 8192, R, C); const int Rb = Epi::PERM ? ((R & ~31) + perm32(R & 31)) : R;
    voffA[i] = (unsigned)(R * K + C) * 2u; voffB[i] = (unsigned)(Rb * K + C) * 2u; }
  const size_t kstep = (size_t)(BK * 2);
  const size_t hstep = (size_t)HALF * K * 2;
  const size_t tstep = 2 * hstep;
  const unsigned ldsw = (unsigned)wid * 1024u;
  const int aoff = lds_byte(wr * 64 + fr, fq * 8), boff = lds_byte(wc * 32 + fr, fq * 8);
  LAS unsigned char* ldsB = lds + 4 * HTB + boff;
  asm volatile("" : "+v"(ldsB));
#define PG8_SA(b, h) (((b) * 2 + (h)) * HTB)
#define PG8_SB(b, h) ((4 + (b) * 2 + (h)) * HTB)
#define PG8_STAGE(bufoff, gbase, voff) do { _Pragma("unroll") for (int _i = 0; _i < 2; ++_i) \
    __builtin_amdgcn_global_load_lds((const unsigned*)((const char*)(gbase) + (voff)[_i]), (LAS unsigned*)(lds + (bufoff) + ldsw + _i * 8192), 16, 0, 0); } while (0)
#define PG8_LDA(dst, b, h) do { _Pragma("unroll") for (int m = 0; m < 4; ++m) _Pragma("unroll") for (int k = 0; k < 2; ++k) dst[m][k] = *(const LAS bf16x8*)(lds + PG8_SA(b, h) + aoff + m * 2048 + k * 1024); } while (0)
#define PG8_LDB(dst, b, h) do { _Pragma("unroll") for (int n = 0; n < 2; ++n) _Pragma("unroll") for (int k = 0; k < 2; ++k) dst[n][k] = *(const LAS bf16x8*)(ldsB + ((b) * 2 + (h)) * HTB + n * 2048 + k * 1024); } while (0)
#define PG8_MMA(ai, bj, At, Bt) do { __builtin_amdgcn_s_setprio(1); _Pragma("unroll") for (int m = 0; m < 4; ++m) _Pragma("unroll") for (int n = 0; n < 2; ++n) \
    acc[ai][bj][m][n] = mma_pair<Epi::MODE>(Bt[n][0], Bt[n][1], At[m][0], At[m][1], acc[ai][bj][m][n]); __builtin_amdgcn_s_setprio(0); } while (0)
#define PG8_WAIT_V(n) asm volatile("s_waitcnt vmcnt(" #n ")" ::: "memory")
#define PG8_WAIT_L(n) asm volatile("s_waitcnt lgkmcnt(" #n ")" ::: "memory")
#define PG8_BAR __builtin_amdgcn_s_barrier()
#define PG8_SCHED __builtin_amdgcn_sched_barrier(0)
  Unit cur, nxt; int ui = 0;
  if (!S.next(0, cur)) return;
  typedef typename Epi::AccT AccT;
  const AccT zacc = {0, 0, 0, 0};
  AccT acc[2][2][4][2];
#pragma unroll
  for (int a = 0; a < 2; ++a)
#pragma unroll
    for (int b = 0; b < 2; ++b)
#pragma unroll
      for (int m = 0; m < 4; ++m)
#pragma unroll
        for (int n = 0; n < 2; ++n) acc[a][b][m][n] = zacc;
  bf16x8 At[4][2], B0[2][2], B1[2][2];
  const char* cA = (const char*)g.A + (size_t)cur.pm * tstep; const char* cB = (const char*)g.Bt + (size_t)cur.pn * tstep;
  PG8_STAGE(PG8_SB(0, 0), cB, voffB); PG8_STAGE(PG8_SA(0, 0), cA, voffA); PG8_STAGE(PG8_SB(0, 1), cB + hstep, voffB); PG8_STAGE(PG8_SA(0, 1), cA + hstep, voffA);
  if (wr == 1) PG8_BAR;
  PG8_WAIT_V(4); PG8_BAR;
  PG8_STAGE(PG8_SB(1, 0), cB + kstep, voffB); PG8_STAGE(PG8_SA(1, 0), cA + kstep, voffA); PG8_STAGE(PG8_SB(1, 1), cB + hstep + kstep, voffB);
  PG8_WAIT_V(6); PG8_BAR;
  for (;;) {
    const bool has_next = S.next(ui + 1, nxt);
    const char* nA = has_next ? (const char*)g.A + (size_t)nxt.pm * tstep : cA; const char* nB = has_next ? (const char*)g.Bt + (size_t)nxt.pn * tstep : cB;
#pragma unroll 1
    for (int t = 0; t < nt; t += 2) {
      const bool last = (t == nt - 2);
      const char* a1 = cA + (size_t)(t + 1) * kstep;
      const char* a2 = last ? nA : cA + (size_t)(t + 2) * kstep; const char* b2 = last ? nB : cB + (size_t)(t + 2) * kstep;
      const char* a3 = a2 + kstep; const char* b3 = b2 + kstep;
      PG8_LDB(B0, 0, 0); PG8_SCHED; PG8_LDA(At, 0, 0); PG8_STAGE(PG8_SA(1, 1), a1 + hstep, voffA);
      PG8_WAIT_L(8); PG8_BAR; PG8_WAIT_L(0); PG8_MMA(0, 0, At, B0); PG8_BAR; PG8_SCHED;
      PG8_LDB(B1, 0, 1); PG8_STAGE(PG8_SB(0, 0), b2, voffB);
      PG8_BAR; PG8_WAIT_L(0); PG8_MMA(0, 1, At, B1); PG8_BAR;
      PG8_LDA(At, 0, 1); PG8_STAGE(PG8_SA(0, 0), a2, voffA);
      PG8_BAR; PG8_WAIT_L(0); PG8_MMA(1, 0, At, B0); PG8_BAR; PG8_SCHED;
      PG8_STAGE(PG8_SB(0, 1), b2 + hstep, voffB);
      PG8_WAIT_V(6); PG8_BAR; PG8_MMA(1, 1, At, B1); PG8_BAR;
      PG8_LDB(B0, 1, 0); PG8_SCHED; PG8_LDA(At, 1, 0); PG8_STAGE(PG8_SA(0, 1), a2 + hstep, voffA);
      PG8_WAIT_L(8); PG8_BAR; PG8_WAIT_L(0); PG8_MMA(0, 0, At, B0); PG8_BAR; PG8_SCHED;
      PG8_LDB(B1, 1, 1); PG8_STAGE(PG8_SB(1, 0), b3, voffB);
      PG8_BAR; PG8_WAIT_L(0); PG8_MMA(0, 1, At, B1); PG8_BAR;
      PG8_LDA(At, 1, 1); PG8_STAGE(PG8_SA(1, 0), a3, voffA);
      PG8_BAR; PG8_WAIT_L(0); PG8_MMA(1, 0, At, B0); PG8_BAR; PG8_SCHED;
      PG8_STAGE(PG8_SB(1, 1), b3 + hstep, voffB);
      PG8_WAIT_V(6); PG8_BAR; PG8_MMA(1, 1, At, B1); PG8_BAR;
    }
    PG8_SCHED;
    if constexpr (Epi::MODE == 2) asm volatile("s_nop 15\n\ts_nop 15\n\ts_nop 15\n\ts_nop 15" ::: "memory");
    { const int l2 = otid() & 63; E(acc, cur, wr, wc, l2 & 15, l2 >> 4); }
    PG8_SCHED;
    if (!has_next) break;
#pragma unroll
    for (int a = 0; a < 2; ++a)
#pragma unroll
      for (int b = 0; b < 2; ++b)
#pragma unroll
        for (int m = 0; m < 4; ++m)
#pragma unroll
          for (int n = 0; n < 2; ++n) acc[a][b][m][n] = zacc;
    cur = nxt; cA = nA; cB = nB; ++ui;
  }
  PG8_WAIT_V(0);
  if (wr == 0) PG8_BAR;
  PG8_BAR;
#undef PG8_SA
#undef PG8_SB
#undef PG8_STAGE
#undef PG8_LDA
#undef PG8_LDB
#undef PG8_MMA
#undef PG8_WAIT_V
#undef PG8_WAIT_L
#undef PG8_BAR
#undef PG8_SCHED
}
}

struct EpiProj {
  static constexpr bool PERM = true;
  static constexpr int MODE = 1;
  typedef i32x4 AccT;
  char* ws; const float* b_merge;
  DI void operator()(const i32x4 (&acc)[2][2][4][2], const pg8::Unit& u, int wr, int wc, int fr, int fq) const {
    const float* rope = (const float*)(ws + OFF_ROPE);
    const float* sa = (const float*)(ws + OFF_SA); const float* sw = (const float*)(ws + OFF_SCW1);
    const int row0 = u.pm * 256 + wr * 64 + fr;
#pragma unroll
    for (int bj = 0; bj < 2; ++bj) {
      const int cg = u.pn * 256 + bj * 128 + wc * 32;
      const int c0 = cg + 8 * fq;
      if (cg >= 4384) continue;
      const float sbg = sw[cg >> 5];
#define EPJ_CV(sc_) const float f_ = sa[row] * (sc_); const f32x4 cv0 = __builtin_convertvector(acc[ai][bj][m][0], f32x4) * f_, cv1 = __builtin_convertvector(acc[ai][bj][m][1], f32x4) * f_;
      if (cg < 1280 && (cg < 640 || (cg >= 768 && cg < 896) || (cg >= 1024 && cg < 1152))) {
        bf16_t* dst; unsigned ld, cofs; float scale = 1.0f;
        if (cg < 512) { dst = (bf16_t*)(ws + OFF_Q); ld = 512; cofs = c0; scale = 0.18033688011112042f; }
        else if (cg < 640) { dst = (bf16_t*)(ws + OFF_KC); ld = 128; cofs = c0 - 512; }
        else if (cg < 896) { dst = (bf16_t*)(ws + OFF_KS); ld = 128; cofs = c0 - 768; }
        else { dst = (bf16_t*)(ws + OFF_KW); ld = 128; cofs = c0 - 1024; }
        const int d0 = 16 * ((cg >> 5) & 1) + 4 * fq;
#pragma unroll
        for (int ai = 0; ai < 2; ++ai)
#pragma unroll
          for (int m = 0; m < 4; ++m) {
            const int row = row0 + ai * 128 + m * 16, pos = row & (SEQ - 1);
            const f32x4 cs = *(const f32x4*)(rope + pos * 32 + d0), sn = *(const f32x4*)(rope + 262144 + pos * 32 + d0);
            EPJ_CV(sbg * scale)
            const f32x4 o1 = cv0 * cs - cv1 * sn, o2 = cv0 * sn + cv1 * cs;
            u32x4 w; w.x = pack2(o1.x, o1.y); w.y = pack2(o1.z, o1.w); w.z = pack2(o2.x, o2.y); w.w = pack2(o2.z, o2.w);
            *(u32x4*)(dst + (unsigned)row * ld + cofs) = w;
          }
      } else if (cg < 1280) {
        bf16_t* dst; unsigned cofs;
        if (cg < 768) { dst = (bf16_t*)(ws + OFF_VC); cofs = c0 - 640; }
        else if (cg < 1024) { dst = (bf16_t*)(ws + OFF_VS); cofs = c0 - 896; }
        else { dst = (bf16_t*)(ws + OFF_VW); cofs = c0 - 1152; }
#pragma unroll
        for (int ai = 0; ai < 2; ++ai)
#pragma unroll
          for (int m = 0; m < 4; ++m) {
            const int row = row0 + ai * 128 + m * 16;
            EPJ_CV(sbg)
            const f32x4 a = cv0, b = cv1;
            u32x4 w; w.x = pack2(a.x, a.y); w.y = pack2(a.z, a.w); w.z = pack2(b.x, b.y); w.w = pack2(b.z, b.w);
            *(u32x4*)(dst + (unsigned)row * 128u + cofs) = w;
          }
      } else if (cg < 2304) {
        bf16_t* dst = (bf16_t*)(ws + (cg < 1792 ? OFF_U : OFF_V));
        const unsigned cofs = c0 - (cg < 1792 ? 1280 : 1792);
#pragma unroll
        for (int ai = 0; ai < 2; ++ai)
#pragma unroll
          for (int m = 0; m < 4; ++m) {
            const int row = row0 + ai * 128 + m * 16;
            EPJ_CV(sbg)
            const f32x4 a = cv0, b = cv1;
            const f32x2 g0 = gelu_pk((f32x2){a.x, a.y}), g1 = gelu_pk((f32x2){a.z, a.w}), g2 = gelu_pk((f32x2){b.x, b.y}), g3 = gelu_pk((f32x2){b.z, b.w});
            u32x4 w; w.x = pack2(g0.x, g0.y); w.y = pack2(g1.x, g1.y); w.z = pack2(g2.x, g2.y); w.w = pack2(g3.x, g3.y);
            *(u32x4*)(dst + (unsigned)row * 512u + cofs) = w;
          }
      } else if (cg < 4352) {
        unsigned char* dst = (unsigned char*)(ws + OFF_GATE8);
        const unsigned cofs = c0 - 2304;
        const f32x4 b0 = *(const f32x4*)(b_merge + cofs), b1 = *(const f32x4*)(b_merge + cofs + 4);
#pragma unroll
        for (int ai = 0; ai < 2; ++ai)
#pragma unroll
          for (int m = 0; m < 4; ++m) {
            const int row = row0 + ai * 128 + m * 16;
            EPJ_CV(sbg)
            const f32x4 a = cv0 + b0, b = cv1 + b1;
            u32x2 w; w.x = pk4_fp8(sigmoid_f(a.x), sigmoid_f(a.y), sigmoid_f(a.z), sigmoid_f(a.w));
            w.y = pk4_fp8(sigmoid_f(b.x), sigmoid_f(b.y), sigmoid_f(b.z), sigmoid_f(b.w));
            *(u32x2*)(dst + (unsigned)row * 2048u + cofs) = w;
          }
      } else {
        float* gs = (float*)(ws + OFF_GSIG);
        if (fq < 3) {
#pragma unroll
          for (int ai = 0; ai < 2; ++ai)
#pragma unroll
            for (int m = 0; m < 4; ++m) {
              const int row = row0 + ai * 128 + m * 16;
              EPJ_CV(sbg)
              const f32x4 a = cv0, b = cv1;
              f32x4 o0, o1; o0.x = sigmoid_f(a.x); o0.y = sigmoid_f(a.y); o0.z = sigmoid_f(a.z); o0.w = sigmoid_f(a.w);
              o1.x = sigmoid_f(b.x); o1.y = sigmoid_f(b.y); o1.z = sigmoid_f(b.z); o1.w = sigmoid_f(b.w);
              *(f32x4*)(gs + (unsigned)row * 32u + 8 * fq) = o0; *(f32x4*)(gs + (unsigned)row * 32u + 8 * fq + 4) = o1;
            }
        }
      }
    }
  }
};
DI void phase_gemm1(const Params& p, char* smem) {
  pg8::Gemm g{(const bf16_t*)(p.ws + OFF_H), (const bf16_t*)(p.ws + OFF_WT1), NTOK, N1, 512};
  pg8::StaticOrder S; S.init(NTOK, N1, gridDim.x, blockIdx.x);
  EpiProj E{p.ws, p.b_merge};
  pg8::gemm_phase((LAS unsigned char*)smem, g, S, E);
}

template <int BR> struct EpiMerge {
  static constexpr bool PERM = true;
  static constexpr int MODE = 2;
  typedef f32x4 AccT;
  char* ws;
  DI void operator()(const f32x4 (&acc)[2][2][4][2], const pg8::Unit& u, int wr, int wc, int fr, int fq) const {
    const unsigned char* gate = (const unsigned char*)(ws + OFF_GATE8);
    unsigned char* m0 = (unsigned char*)(ws + OFF_M08);
    unsigned char* mrg = (unsigned char*)(ws + OFF_MRG8);
    const float* sw = (const float*)(ws + OFF_SCWB) + BR * 32;
    const int row0 = u.pm * 256 + wr * 64 + fr;
#pragma unroll
    for (int bj = 0; bj < 2; ++bj) {
      const unsigned cgp = u.pn * 256 + bj * 128 + wc * 32, c0 = cgp + 8 * fq;
      const float f = sw[cgp >> 5] * (BR == 0 ? 1.0f : 2.0f);
#pragma unroll
      for (int ai = 0; ai < 2; ++ai)
#pragma unroll
        for (int m = 0; m < 4; ++m) {
          const unsigned row = row0 + ai * 128 + m * 16;
          float gg[8]; unpack8_fp8(*(const u32x2*)(gate + row * 2048u + BR * 1024 + c0), gg);
          const f32x4 a = acc[ai][bj][m][0] * f, b = acc[ai][bj][m][1] * f;
          float v[8] = {a.x * gg[0], a.y * gg[1], a.z * gg[2], a.w * gg[3], b.x * gg[4], b.y * gg[5], b.z * gg[6], b.w * gg[7]};
          if (BR == 1) {
            float old[8]; unpack8_fp8(*(const u32x2*)(m0 + row * 1024u + c0), old);
#pragma unroll
            for (int j = 0; j < 8; ++j) v[j] += old[j];
          }
#pragma unroll
          for (int j = 0; j < 8; ++j) v[j] = clamp_f8(v[j]);
          u32x2 w; w.x = pk4_fp8(v[0], v[1], v[2], v[3]); w.y = pk4_fp8(v[4], v[5], v[6], v[7]);
          *(u32x2*)((BR == 0 ? m0 : mrg) + row * 1024u + c0) = w;
        }
    }
  }
};
DI void phase_merge(const Params& p, char* smem) {
  pg8::StaticOrder S; S.init(NTOK, 1024, gridDim.x, blockIdx.x);
  {
    pg8::Gemm g{(const bf16_t*)(p.ws + OFF_ONSA8), (const bf16_t*)(p.ws + OFF_WB), NTOK, 1024, 256};
    EpiMerge<0> E{p.ws};
    pg8::gemm_phase((LAS unsigned char*)smem, g, S, E);
  }
  {
    pg8::Gemm g{(const bf16_t*)(p.ws + OFF_OSGU8), (const bf16_t*)(p.ws + OFF_WB + (size_t)1024 * 512), NTOK, 1024, 256};
    EpiMerge<1> E{p.ws};
    pg8::gemm_phase((LAS unsigned char*)smem, g, S, E);
  }
}

struct EpiOut {
  static constexpr bool PERM = true;
  static constexpr int MODE = 2;
  typedef f32x4 AccT;
  char* ws; const float* x;
  DI void operator()(const f32x4 (&acc)[2][2][4][2], const pg8::Unit& u, int wr, int wc, int fr, int fq) const {
    const float* mod = (const float*)(ws + OFF_MOD);
    bf16_t* y = (bf16_t*)(ws + OFF_Y);
    const int row0 = u.pm * 256 + wr * 64 + fr, b = (u.pm * 256) >> 13;
#pragma unroll
    for (int bj = 0; bj < 2; ++bj) {
      const unsigned c0 = u.pn * 256 + bj * 128 + wc * 32 + 8 * fq;
      const float f = ((const float*)(ws + OFF_SCWO))[c0 >> 5] * 0.0625f;
      const f32x4 g0 = *(const f32x4*)(mod + b * 6144 + 2048 + c0) * f, g1 = *(const f32x4*)(mod + b * 6144 + 2048 + c0 + 4) * f;
#pragma unroll
      for (int ai = 0; ai < 2; ++ai)
#pragma unroll
        for (int m = 0; m < 4; ++m) {
          const unsigned o = (unsigned)(row0 + ai * 128 + m * 16) * 1024u + c0;
          const f32x4 x0 = *(const f32x4*)(x + o), x1v = *(const f32x4*)(x + o + 4);
          const f32x4 v0 = x0 * DN_ALPHA + g0 * acc[ai][bj][m][0], v1 = x1v * DN_ALPHA + g1 * acc[ai][bj][m][1];
          u32x4 w; w.x = pack2(v0.x, v0.y); w.y = pack2(v0.z, v0.w); w.z = pack2(v1.x, v1.y); w.w = pack2(v1.z, v1.w);
          *(u32x4*)(y + o) = w;
        }
    }
  }
};
DI void phase_outproj(const Params& p, char* smem) {
  pg8::Gemm g{(const bf16_t*)(p.ws + OFF_MRG8), (const bf16_t*)(p.ws + OFF_WOUT), NTOK, 1024, 512};
  pg8::StaticOrder S; S.init(NTOK, 1024, gridDim.x, blockIdx.x);
  EpiOut E{p.ws, p.x};
  pg8::gemm_phase((LAS unsigned char*)smem, g, S, E);
}

struct EpiPq {
  static constexpr bool PERM = true;
  static constexpr int MODE = 1;
  typedef i32x4 AccT;
  char* ws;
  DI void operator()(const i32x4 (&acc)[2][2][4][2], const pg8::Unit& u, int wr, int wc, int fr, int fq) const {
    bf16_t* pq = (bf16_t*)(ws + OFF_PQ);
    const float* sh = (const float*)(ws + OFF_SH); const float* sq = (const float*)(ws + OFF_SCWQ);
    const int row0 = u.pm * 256 + wr * 64 + fr;
#pragma unroll
    for (int bj = 0; bj < 2; ++bj) {
      const unsigned c0 = u.pn * 256 + bj * 128 + wc * 32 + 8 * fq;
      const float sbg = sq[(u.pn * 256 + bj * 128 + wc * 32) >> 5];
#pragma unroll
      for (int ai = 0; ai < 2; ++ai)
#pragma unroll
        for (int m = 0; m < 4; ++m) {
          const float f_ = sh[row0 + ai * 128 + m * 16] * sbg;
          const f32x4 a = __builtin_convertvector(acc[ai][bj][m][0], f32x4) * f_, b = __builtin_convertvector(acc[ai][bj][m][1], f32x4) * f_;
          u32x4 w; w.x = pack2(a.x, a.y); w.y = pack2(a.z, a.w); w.z = pack2(b.x, b.y); w.w = pack2(b.z, b.w);
          *(u32x4*)(pq + (unsigned)(row0 + ai * 128 + m * 16) * 2048u + c0) = w;
        }
    }
  }
};
DI void phase_peerq(const Params& p, char* smem) {
  pg8::Gemm g{(const bf16_t*)(p.ws + OFF_H2Q), (const bf16_t*)(p.ws + OFF_WQ), NTOK, 2048, 512};
  pg8::StaticOrder S; S.init(NTOK, 2048, gridDim.x, blockIdx.x);
  EpiPq E{p.ws};
  pg8::gemm_phase((LAS unsigned char*)smem, g, S, E);
}

DI void phase_sgu(const Params& p, char* smem) {
  char* ws = p.ws;
  const int tid = otid(), lane = tid & 63, wave = tid >> 6, l31 = lane & 31, hh = lane >> 5;
  const bf16_t* u = (const bf16_t*)(ws + OFF_U);
  const bf16_t* v = (const bf16_t*)(ws + OFF_V);
  const bf16_t* W = (const bf16_t*)(ws + OFF_SGUW);
  float* st = (float*)smem;
  bf16_t* vn = (bf16_t*)(smem + 1024);
  constexpr int LN_ = 72;
  const int dt = wave & 1, it = wave >> 1;
  const int gi = lane >> 4, i16 = lane & 15, tq = i16 >> 2, tp = i16 & 3;
  for (int item = blockIdx.x; item < NTOK / 128; item += gridDim.x) {
    const int t0 = item * 128;
    __syncthreads();
    for (int i = 0; i < 16; ++i) {
      const int t = wave * 16 + i;
      const u32x4 raw = *(const u32x4*)(v + (size_t)(t0 + t) * 512 + lane * 8);
      float f[8]; unpack8(raw, f);
      float s = 0.f;
#pragma unroll
      for (int j = 0; j < 8; ++j) s += f[j];
      const float mean = wave_sum(s) * (1.f / 512.f);
      float q = 0.f;
#pragma unroll
      for (int j = 0; j < 8; ++j) { const float d = f[j] - mean; q += d * d; }
      const float rstd = rsqrtf(wave_sum(q) * (1.f / 512.f) + LN_EPS);
      if (lane == 0) { st[t * 2] = mean; st[t * 2 + 1] = rstd; }
    }
    u32x4 vnext[2];
#pragma unroll
    for (int i = 0; i < 2; ++i) { const int idx = tid + i * NT; vnext[i] = *(const u32x4*)(v + (size_t)(t0 + (idx >> 3)) * 512 + (idx & 7) * 8); }
    for (int g = 0; g < 8; ++g) {
      u32x4 vcur[2] = {vnext[0], vnext[1]};
      if (g + 1 < 8) {
#pragma unroll
        for (int i = 0; i < 2; ++i) { const int idx = tid + i * NT; vnext[i] = *(const u32x4*)(v + (size_t)(t0 + (idx >> 3)) * 512 + (g + 1) * 64 + (idx & 7) * 8); }
      }
      u32x2 uold[4];
      {
        const bf16_t* urow0 = u + (size_t)(t0 + it * 32 + l31) * 512 + g * 64 + dt * 32 + 4 * hh;
#pragma unroll
        for (int q4 = 0; q4 < 4; ++q4) uold[q4] = *(const u32x2*)(urow0 + 8 * q4);
      }
      lds_barrier();
#pragma unroll
      for (int i = 0; i < 2; ++i) {
        const int idx = tid + i * NT, j = idx >> 3, dc = (idx & 7) * 8;
        const u32x4 raw = vcur[i];
        const float mean = st[j * 2], rstd = st[j * 2 + 1];
        float f[8], gg[8], bb[8]; unpack8(raw, f); ld8(p.sgu_ln_g + g * 64 + dc, gg); ld8(p.sgu_ln_b + g * 64 + dc, bb);
#pragma unroll
        for (int k = 0; k < 8; ++k) f[k] = (f[k] - mean) * rstd * gg[k] + bb[k];
        *(u32x4*)(vn + j * LN_ + dc) = pack8(f);
      }
      lds_barrier();
      f32x16 acc;
#pragma unroll
      for (int r = 0; r < 16; ++r) acc[r] = 0.f;
      const bf16_t* wrow = W + ((size_t)g * 128 + it * 32 + l31) * 128 + hh * 8;
      const LAS bf16_t* vbase = (const LAS bf16_t*)vn + (8 * (gi >> 1) + tq) * LN_ + dt * 32 + 16 * (gi & 1) + 4 * tp;
#pragma unroll
      for (int ks = 0; ks < 8; ++ks) {
        if (ks <= 2 * it + 1) {
          const LAS bf16_t* vp = vbase + (ks * 16) * LN_;
          const s16x4 lo = __builtin_amdgcn_ds_read_tr16_b64_v4i16((LAS s16x4*)vp);
          const s16x4 hi = __builtin_amdgcn_ds_read_tr16_b64_v4i16((LAS s16x4*)(vp + 4 * LN_));
          const bf16x8 bw = *(const bf16x8*)(wrow + ks * 16);
          acc = MFMA32(__builtin_shufflevector(lo, hi, 0, 1, 2, 3, 4, 5, 6, 7), bw, acc);
        }
      }
      const int i = it * 32 + l31;
      const float bsv = p.sgu_b[g * 128 + i];
      unsigned char* orow = (unsigned char*)(ws + OFF_OSGU8) + (size_t)(t0 + i) * 512 + g * 64 + dt * 32 + 4 * hh;
#pragma unroll
      for (int q4 = 0; q4 < 4; ++q4) {
        const u32x2 old = uold[q4];
        *(unsigned*)(orow + 8 * q4) = pk4_fp8(clamp_f8(8.0f * bflo(old.x) * (acc[4 * q4] + bsv)), clamp_f8(8.0f * bfhi(old.x) * (acc[4 * q4 + 1] + bsv)),
                                              clamp_f8(8.0f * bflo(old.y) * (acc[4 * q4 + 2] + bsv)), clamp_f8(8.0f * bfhi(old.y) * (acc[4 * q4 + 3] + bsv)));
      }
    }
  }
}

DI void phase_compress(const Params& p, char* smem) {
  char* ws = p.ws;
  const int tid = otid(), lane = tid & 63, wave = tid >> 6, l31 = lane & 31, hh = lane >> 5;
  bf16_t* hid = (bf16_t*)smem;
  constexpr int LH = 136;
  for (int item = blockIdx.x; item < 128; item += gridDim.x) {
    const int w = item >> 6, R0 = (item & 63) * 128;
    const bf16_t* src = (const bf16_t*)(ws + (w == 0 ? OFF_KC : OFF_VC));
    const bf16_t* W1 = (const bf16_t*)(ws + OFF_CW1) + (size_t)w * 128 * 2048;
    const bf16_t* W2 = (const bf16_t*)(ws + OFF_CW2) + (size_t)w * 64 * 128;
    const float* posb = (const float*)(ws + OFF_POSB) + w * 128;
    const int rg = wave >> 2, cgp = wave & 3;
    const bf16_t* abase[2];
#pragma unroll
    for (int mi = 0; mi < 2; ++mi) {
      const int R = R0 + rg * 64 + mi * 32 + l31, bg = R >> 9, n = R & 511, nn = n < 510 ? n : 510;
      abase[mi] = src + ((size_t)((bg >> 1) * SEQ + 16 * nn)) * 128 + (bg & 1) * 64 + hh * 8;
    }
    const bf16_t* bbase = W1 + (size_t)(cgp * 32 + l31) * 2048 + hh * 8;
    f32x16 acc[2];
#pragma unroll
    for (int r = 0; r < 16; ++r) { acc[0][r] = 0.f; acc[1][r] = 0.f; }
#pragma unroll 8
    for (int ks = 0; ks < 128; ++ks) {
      const int aofs = (ks >> 2) * 128 + (ks & 3) * 16;
      const bf16x8 a0 = *(const bf16x8*)(abase[0] + aofs), a1 = *(const bf16x8*)(abase[1] + aofs);
      const bf16x8 bb = *(const bf16x8*)(bbase + ks * 16);
      acc[0] = MFMA32(a0, bb, acc[0]); acc[1] = MFMA32(a1, bb, acc[1]);
    }
    __syncthreads();
    {
      const float pb = posb[cgp * 32 + l31];
#pragma unroll
      for (int mi = 0; mi < 2; ++mi)
#pragma unroll
        for (int r = 0; r < 16; ++r) {
          const int row = rg * 64 + mi * 32 + (r & 3) + 8 * (r >> 2) + 4 * hh;
          hid[row * LH + cgp * 32 + l31] = f2bf(gelu_f(acc[mi][r] + pb));
        }
    }
    __syncthreads();
    const int mi2 = wave >> 1, ni = wave & 1;
    f32x16 o;
#pragma unroll
    for (int r = 0; r < 16; ++r) o[r] = 0.f;
#pragma unroll
    for (int ks = 0; ks < 8; ++ks) {
      const bf16x8 a = *(const bf16x8*)(hid + (mi2 * 32 + l31) * LH + ks * 16 + hh * 8);
      const bf16x8 bb = *(const bf16x8*)(W2 + (size_t)(ni * 32 + l31) * 128 + ks * 16 + hh * 8);
      o = MFMA32(a, bb, o);
    }
    const int d = ni * 32 + l31;
    const float b2 = p.cmp_b2[w * 64 + (w == 0 ? dperm(d) : d)];
    const int bg = R0 >> 9;
    bf16_t* dst = (bf16_t*)(ws + (w == 0 ? OFF_KCMP : OFF_VCMP));
#pragma unroll
    for (int r = 0; r < 16; ++r) {
      const int n = (R0 & 511) + mi2 * 32 + (r & 3) + 8 * (r >> 2) + 4 * hh;
      dst[((size_t)bg * 512 + n) * 64 + d] = f2bf(n < 511 ? o[r] + b2 : 0.f);
    }
  }
}

constexpr int LK = 72;
constexpr int NSA_TILE = 18432;
constexpr int NSA_AIMP = 3 * NSA_TILE, NSA_CIMP = NSA_AIMP + 32768, NSA_SELM = NSA_CIMP + 32768;
constexpr float NSA_THR = 6.0f;
struct TileRegs { u32x4 k; u32x4 v; };

DI void nsa_load_tile(TileRegs& t, const bf16_t* kbase, size_t kstride, const bf16_t* vbase, size_t vstride) {
  const int tid = otid(), r = tid >> 3, ch = tid & 7;
  t.k = *(const u32x4*)(kbase + (size_t)r * kstride + ch * 8);
  t.v = *(const u32x4*)(vbase + (size_t)r * vstride + ch * 8);
}
DI void nsa_store_tile(const TileRegs& t, char* tile) {
  const int tid = otid(), r = tid >> 3, ch = tid & 7;
  *(u32x4*)((bf16_t*)tile + r * LK + ch * 8) = t.k;
  *(u32x4*)((bf16_t*)(tile + 9216) + r * LK + ch * 8) = t.v;
}
DI void nsa_scores(f32x16 (&st)[2], const char* tile, const bf16x8 (&qf)[4], int lane) {
  const bf16_t* Ks = (const bf16_t*)tile;
#pragma unroll
  for (int kt = 0; kt < 2; ++kt)
#pragma unroll
    for (int r = 0; r < 16; ++r) st[kt][r] = 0.f;
  __builtin_amdgcn_s_setprio(1);
#pragma unroll
  for (int ks = 0; ks < 4; ++ks)
#pragma unroll
    for (int kt = 0; kt < 2; ++kt) {
      const bf16x8 a = *(const bf16x8*)(Ks + (kt * 32 + (lane & 31)) * LK + ks * 16 + (lane >> 5) * 8);
      st[kt] = MFMA32(a, qf[ks], st[kt]);
    }
  __builtin_amdgcn_s_setprio(0);
}
DI void nsa_pv(f32x16 (&o)[2], const f32x16 (&pt)[2], const char* tile, int lane) {
  const int gi = lane >> 4, i16 = lane & 15, q = i16 >> 2, pp = i16 & 3;
  const LAS bf16_t* Vs = (const LAS bf16_t*)(tile + 9216) + (4 * (gi >> 1) + q) * LK + 16 * (gi & 1) + 4 * pp;
#pragma unroll
  for (int kt = 0; kt < 2; ++kt)
#pragma unroll
    for (int s = 0; s < 2; ++s) {
      u32x4 pk; pk.x = pack2(pt[kt][8 * s], pt[kt][8 * s + 1]); pk.y = pack2(pt[kt][8 * s + 2], pt[kt][8 * s + 3]);
      pk.z = pack2(pt[kt][8 * s + 4], pt[kt][8 * s + 5]); pk.w = pack2(pt[kt][8 * s + 6], pt[kt][8 * s + 7]);
      const bf16x8 pb = __builtin_bit_cast(bf16x8, pk);
      bf16x8 a[2];
#pragma unroll
      for (int dt = 0; dt < 2; ++dt) {
        const LAS bf16_t* vp = Vs + (kt * 32 + 16 * s) * LK + dt * 32;
        const s16x4 lo = __builtin_amdgcn_ds_read_tr16_b64_v4i16((LAS s16x4*)vp);
        const s16x4 hi = __builtin_amdgcn_ds_read_tr16_b64_v4i16((LAS s16x4*)(vp + 8 * LK));
        a[dt] = __builtin_shufflevector(lo, hi, 0, 1, 2, 3, 4, 5, 6, 7);
      }
      o[0] = MFMA32(a[0], pb, o[0]); o[1] = MFMA32(a[1], pb, o[1]);
    }
}

constexpr float NSA_NEG = -3.0e38f;
DI void nsa_online(f32x16 (&st)[2], bool sel, float& m, float& l, f32x16 (&o)[2], const char* tile, int lane) {
  float mx = NSA_NEG;
#pragma unroll
  for (int r = 0; r < 16; ++r) mx = fmaxf(mx, fmaxf(st[0][r], st[1][r]));
  mx = fmaxf(mx, xor32f(mx, lane));
  mx = sel ? mx : NSA_NEG;
  if (__any(mx > m + NSA_THR)) {
    const float mn = fmaxf(m, mx);
    const float alpha = __builtin_amdgcn_exp2f(m - mn);
    m = mn; l *= alpha;
#pragma unroll
    for (int r = 0; r < 16; ++r) { o[0][r] *= alpha; o[1][r] *= alpha; }
  }
  const float ms = sel ? m : 1e30f;
  float sum = 0.f;
#pragma unroll
  for (int r = 0; r < 16; ++r) {
    const float p0 = __builtin_amdgcn_exp2f(st[0][r] - ms), p1 = __builtin_amdgcn_exp2f(st[1][r] - ms);
    st[0][r] = p0; st[1][r] = p1; sum += p0 + p1;
  }
  l += sum;
  nsa_pv(o, st, tile, lane);
}

struct NsaItem { int qb, b, g, bg, t; size_t tokrow; };
DI NsaItem nsa_item(int item0, int wave, int qi) {
  const int G = gridDim.x, k = item0 / G, bb = item0 - k * G;
  const int item = (k & 1) ? (k * G + (G - 1 - bb)) : item0;
  NsaItem it; it.qb = 127 - (item >> 4); const int rest = item & 15; it.b = rest >> 1; it.g = rest & 1;
  it.bg = it.b * 2 + it.g; it.t = it.qb * 64 + wave * 8 + qi; it.tokrow = (size_t)it.b * SEQ + it.t; return it;
}
DI void nsa_accum_store(bf16_t* dst, const f32x16 (&o)[2], float sc, bool first, int hh, unsigned char* dst8 = nullptr) {
#pragma unroll
  for (int dt = 0; dt < 2; ++dt)
#pragma unroll
    for (int q4 = 0; q4 < 4; ++q4) {
      u32x2* pp = (u32x2*)(dst + dt * 32 + 8 * q4 + 4 * hh);
      float a0 = sc * o[dt][4 * q4], a1 = sc * o[dt][4 * q4 + 1], a2 = sc * o[dt][4 * q4 + 2], a3 = sc * o[dt][4 * q4 + 3];
      if (!first) { const u32x2 old = *pp; a0 += bflo(old.x); a1 += bfhi(old.x); a2 += bflo(old.y); a3 += bfhi(old.y); }
      if (dst8) *(unsigned*)(dst8 + dt * 32 + 8 * q4 + 4 * hh) = pk4_fp8(clamp_f8(16.0f * a0), clamp_f8(16.0f * a1), clamp_f8(16.0f * a2), clamp_f8(16.0f * a3));
      else { u32x2 wv; wv.x = pack2(a0, a1); wv.y = pack2(a2, a3); *pp = wv; }
    }
}

constexpr int NSA_STAGE = 4 * 18432;
typedef float f32x4v __attribute__((ext_vector_type(4)));
#define MFMA16(a, b, c) __builtin_amdgcn_mfma_f32_16x16x32_bf16((a), (b), (c), 0, 0, 0)
struct StageRegs { u32x4 r[8]; };
DI void nsa_load_stage(StageRegs& sr, const bf16_t* kb, const bf16_t* vb, int j0s, int qb) {
  const int tid = otid(), r = tid >> 3, ch = tid & 7;
#pragma unroll
  for (int tt = 0; tt < 4; ++tt) {
    const int j = (j0s + tt <= qb) ? j0s + tt : qb;
    sr.r[2 * tt] = *(const u32x4*)(kb + ((size_t)j * 64 + r) * 128 + ch * 8);
    sr.r[2 * tt + 1] = *(const u32x4*)(vb + ((size_t)j * 64 + r) * 128 + ch * 8);
  }
}
DI void nsa_store_stage(const StageRegs& sr, char* stage) {
  const int tid = otid(), r = tid >> 3, ch = tid & 7;
#pragma unroll
  for (int tt = 0; tt < 4; ++tt) {
    *(u32x4*)((bf16_t*)(stage + tt * 18432) + r * LK + ch * 8) = sr.r[2 * tt];
    *(u32x4*)((bf16_t*)(stage + tt * 18432 + 9216) + r * LK + ch * 8) = sr.r[2 * tt + 1];
  }
}
struct Sel16 { float m, l; bool has; f32x4v o[4]; };
DI void nsa_unit16(Sel16& g, const char* tile, const bf16x8 (&qf)[2], bool sel, int klim  , int lane) {
  const int c16 = lane & 15, kg = lane >> 4, tq = c16 >> 2, tp = c16 & 3;
  const bf16_t* Ks = (const bf16_t*)tile + c16 * LK + kg * 8;
  f32x4v st[4];
  const float ini = sel ? -g.m : -1e30f;
#pragma unroll
  for (int kt = 0; kt < 4; ++kt) {
    st[kt] = (f32x4v){ini, ini, ini, ini};
#pragma unroll
    for (int ks = 0; ks < 2; ++ks) st[kt] = MFMA16(*(const bf16x8*)(Ks + kt * 16 * LK + ks * 32), qf[ks], st[kt]);
  }
  if (klim < 64) {
#pragma unroll
    for (int kt = 0; kt < 4; ++kt)
#pragma unroll
      for (int r = 0; r < 4; ++r) st[kt][r] = (kt * 16 + 4 * kg + r <= klim) ? st[kt][r] : NSA_NEG;
  }
  float mx = fmaxf(fmaxf(fmaxf(st[0][0], st[0][1]), fmaxf(st[0][2], st[0][3])), fmaxf(fmaxf(st[1][0], st[1][1]), fmaxf(st[1][2], st[1][3])));
  mx = fmaxf(mx, fmaxf(fmaxf(fmaxf(st[2][0], st[2][1]), fmaxf(st[2][2], st[2][3])), fmaxf(fmaxf(st[3][0], st[3][1]), fmaxf(st[3][2], st[3][3]))));
  mx = fmaxf(mx, xor16f(mx, lane));
  mx = fmaxf(mx, xor32f(mx, lane));
  const bool real = mx > -1e29f;
  const bool fresh = !g.has && real, up = g.has && (mx > NSA_THR);
  if (__any(fresh || up)) {
    const float delta = (fresh || up) ? mx : 0.f;
    const float alpha = up ? __builtin_amdgcn_exp2f(-delta) : 1.0f;
    g.m += delta; g.l *= alpha;
#pragma unroll
    for (int dt = 0; dt < 4; ++dt) g.o[dt] *= alpha;
#pragma unroll
    for (int kt = 0; kt < 4; ++kt) st[kt] -= delta;
  }
  g.has = g.has || real;
  float sum = 0.f;
#pragma unroll
  for (int kt = 0; kt < 4; ++kt)
#pragma unroll
    for (int r = 0; r < 4; ++r) { const float pv = __builtin_amdgcn_exp2f(st[kt][r]); st[kt][r] = pv; sum += pv; }
  g.l += sum;
  const LAS bf16_t* Vs = (const LAS bf16_t*)(tile + 9216) + (4 * kg + tq) * LK + 4 * tp;
#pragma unroll
  for (int kp = 0; kp < 2; ++kp) {
    u32x4 pk; pk.x = pack2(st[2 * kp][0], st[2 * kp][1]); pk.y = pack2(st[2 * kp][2], st[2 * kp][3]);
    pk.z = pack2(st[2 * kp + 1][0], st[2 * kp + 1][1]); pk.w = pack2(st[2 * kp + 1][2], st[2 * kp + 1][3]);
    const bf16x8 pb = __builtin_bit_cast(bf16x8, pk);
#pragma unroll
    for (int dt = 0; dt < 4; ++dt) {
      const LAS bf16_t* vp = Vs + (2 * kp) * 16 * LK + dt * 16;
      const s16x4 lo = __builtin_amdgcn_ds_read_tr16_b64_v4i16((LAS s16x4*)vp);
      const s16x4 hi = __builtin_amdgcn_ds_read_tr16_b64_v4i16((LAS s16x4*)(vp + 16 * LK));
      g.o[dt] = MFMA16(__builtin_shufflevector(lo, hi, 0, 1, 2, 3, 4, 5, 6, 7), pb, g.o[dt]);
    }
  }
}
DI void nsa_sel16(const Params& p, char* smem, bool dry) {
  char* ws = p.ws;
  const int tid = otid(), lane = tid & 63, wave = tid >> 6, c16 = lane & 15, kg = lane >> 4, qi4 = c16 >> 2, r4 = c16 & 3;
  const bf16_t* Q = (const bf16_t*)(ws + OFF_Q);
  const float* gsig = (const float*)(ws + OFF_GSIG);
  bf16_t* ONSA = (bf16_t*)(ws + OFF_ONSA);
  const u32x4* SELG = (const u32x4*)(ws + OFF_SELG);
  const bf16_t* KS = (const bf16_t*)(ws + OFF_KS); const bf16_t* VS = (const bf16_t*)(ws + OFF_VS);
  constexpr int NITEM = NB * 2 * 128;
  for (int item = blockIdx.x; item < NITEM; item += gridDim.x) {
    const NsaItem it = nsa_item(item, wave, 0);
    const int qb = it.qb;
    bf16x8 qf[2][2]; u32x4 selw[2]; float g_s[2]; int tg[2]; Sel16 G[2];
#pragma unroll
    for (int gq = 0; gq < 2; ++gq) {
      tg[gq] = it.t + 4 * gq + qi4;
      const size_t tokrow = (size_t)it.b * SEQ + tg[gq];
#pragma unroll
      for (int ks = 0; ks < 2; ++ks) qf[gq][ks] = *(const bf16x8*)(Q + tokrow * 512 + (it.g * 4 + r4) * 64 + ks * 32 + kg * 8);
      selw[gq] = SELG[(size_t)it.bg * SEQ + tg[gq]];
      g_s[gq] = gsig[tokrow * 32 + (it.g * 4 + r4) * 3 + 1];
      G[gq].m = 0.f; G[gq].l = 0.f; G[gq].has = false;
#pragma unroll
      for (int dt = 0; dt < 4; ++dt) G[gq].o[dt] = (f32x4v){0.f, 0.f, 0.f, 0.f};
    }
    const bf16_t* kb = KS + (size_t)it.b * SEQ * 128 + it.g * 64;
    const bf16_t* vb = VS + (size_t)it.b * SEQ * 128 + it.g * 64;
    const int nst = (qb >> 2) + 1;
    StageRegs sr;
    lds_barrier();
    nsa_load_stage(sr, kb, vb, 0, qb);
    nsa_store_stage(sr, smem);
    lds_barrier();
    for (int sidx = 0; sidx < nst; ++sidx) {
      const char* stage = smem + (sidx & 1) * NSA_STAGE;
      if (sidx + 1 < nst) nsa_load_stage(sr, kb, vb, 4 * (sidx + 1), qb);
#pragma unroll 1
      for (int tt = 0; tt < 4; ++tt) {
        const int j = 4 * sidx + tt;
        if (j > qb) break;
#pragma unroll
        for (int gq = 0; gq < 2; ++gq) {
          const unsigned w = j < 32 ? selw[gq].x : (j < 64 ? selw[gq].y : (j < 96 ? selw[gq].z : selw[gq].w));
          const bool sel = (w >> (j & 31)) & 1u;
          if (__any(sel)) nsa_unit16(G[gq], stage + tt * 18432, qf[gq], sel, (j == qb) ? (tg[gq] - j * 64) : 1000, lane);
        }
      }
      if (sidx + 1 < nst) nsa_store_stage(sr, smem + ((sidx + 1) & 1) * NSA_STAGE);
      lds_barrier();
    }
#pragma unroll
    for (int gq = 0; gq < 2; ++gq) {
      float l = G[gq].l;
      l += xor16f(l, lane); l += xor32f(l, lane);
      const float sc = l > 0.f ? g_s[gq] / l : 0.f;
      bf16_t* dst = ONSA + ((size_t)it.b * SEQ + tg[gq]) * 512 + (it.g * 4 + r4) * 64 + 4 * kg;
      if (!dry) {
#pragma unroll
        for (int dt = 0; dt < 4; ++dt) {
          u32x2* pp = (u32x2*)(dst + dt * 16);
          const u32x2 old = *pp;
          u32x2 wv; wv.x = pack2(bflo(old.x) + sc * G[gq].o[dt][0], bfhi(old.x) + sc * G[gq].o[dt][1]);
          wv.y = pack2(bflo(old.y) + sc * G[gq].o[dt][2], bfhi(old.y) + sc * G[gq].o[dt][3]);
          *pp = wv;
        }
      } else asm volatile("" :: "v"(G[gq].o[0]), "v"(G[gq].o[1]), "v"(G[gq].o[2]), "v"(G[gq].o[3]), "v"(l));
    }
  }
}

DI void phase_nsa(const Params& p, char* smem, int branch_mask) {
  char* ws = p.ws;
  const int tid = otid(), lane = tid & 63, wave = tid >> 6, hh = lane >> 5, c = lane & 31, qi = c >> 2, r4 = c & 3;
  const bf16_t* Q = (const bf16_t*)(ws + OFF_Q);
  const float* gsig = (const float*)(ws + OFF_GSIG);
  bf16_t* ONSA = (bf16_t*)(ws + OFF_ONSA);
  u32x4* SELG = (u32x4*)(ws + OFF_SELG);
  constexpr int NITEM = NB * 2 * 128;

#pragma unroll 1
  for (int rep1 = 0; rep1 < ((PROBE_DUP & 4096) ? 2 : 1); ++rep1) {
    const bf16_t* KCMP = (const bf16_t*)(ws + OFF_KCMP); const bf16_t* VCMP = (const bf16_t*)(ws + OFF_VCMP);
    float* Aimp = (float*)(smem + NSA_AIMP) + wave * 1024;
    float* Cimp = (float*)(smem + NSA_CIMP) + wave * 1024;
    unsigned short* selm16 = (unsigned short*)(smem + NSA_SELM) + wave * 64;
    const u32x4* selm128 = (const u32x4*)(smem + NSA_SELM) + wave * 8;
    for (int item = blockIdx.x; item < NITEM; item += gridDim.x) {
      const NsaItem it = nsa_item(item, wave, qi);
      const int t = it.t;
      bf16x8 qf[4];
#pragma unroll
      for (int ks = 0; ks < 4; ++ks) qf[ks] = *(const bf16x8*)(Q + it.tokrow * 512 + (it.g * 4 + r4) * 64 + ks * 16 + hh * 8);
      const float g_c = gsig[it.tokrow * 32 + (it.g * 4 + r4) * 3 + 0];
      TileRegs tr;
      const int nmax = (it.qb * 64 + 63 - 31) >> 4, ntile = (nmax >> 6) + 1;
      const int nfull = (it.qb * 64 - 31) >> 4;
      const bf16_t* kb = KCMP + (size_t)it.bg * 512 * 64;
      const bf16_t* vb = VCMP + (size_t)it.bg * 512 * 64;
      float m = -1e30f, l = 0.f;
      nsa_load_tile(tr, kb, 64, vb, 64);
      nsa_store_tile(tr, smem);
      __syncthreads();
      for (int j = 0; j < ntile; ++j) {
        const char* tile = smem + (j & 1) * NSA_TILE;
        if (j + 1 < ntile) nsa_load_tile(tr, kb + (size_t)(j + 1) * 64 * 64, 64, vb + (size_t)(j + 1) * 64 * 64, 64);
        f32x16 st[2];
        nsa_scores(st, tile, qf, lane);
        const bool full = (j * 64 + 63 <= nfull);
        const int nlim = full ? 100000 : ((t - 31) >> 4) - j * 64 - 4 * hh;
        float mx = NSA_NEG;
#pragma unroll
        for (int kt = 0; kt < 2; ++kt)
#pragma unroll
          for (int r = 0; r < 16; ++r) {
            st[kt][r] = (kt * 32 + (r & 3) + 8 * (r >> 2) <= nlim) ? st[kt][r] : NSA_NEG;
            mx = fmaxf(mx, st[kt][r]);
          }
        mx = fmaxf(mx, xor32f(mx, lane));
        const float mn = fmaxf(m, mx);
        float sum = 0.f;
#pragma unroll
        for (int kt = 0; kt < 2; ++kt)
#pragma unroll
          for (int r = 0; r < 16; ++r) sum += __builtin_amdgcn_exp2f(st[kt][r] - mn);
        l = l * __builtin_amdgcn_exp2f(m - mn) + sum;
        m = mn;
        if (j + 1 < ntile) nsa_store_tile(tr, smem + ((j + 1) & 1) * NSA_TILE);
        __syncthreads();
      }
      l += xor32f(l, lane);
      const float inv_l = l > 0.f ? 1.0f / l : 0.f;
      f32x16 o[2];
#pragma unroll
      for (int r = 0; r < 16; ++r) { o[0][r] = 0.f; o[1][r] = 0.f; }
      nsa_load_tile(tr, kb, 64, vb, 64);
      nsa_store_tile(tr, smem);
      __syncthreads();
      for (int j = 0; j < ntile; ++j) {
        const char* tile = smem + (j & 1) * NSA_TILE;
        if (j + 1 < ntile) nsa_load_tile(tr, kb + (size_t)(j + 1) * 64 * 64, 64, vb + (size_t)(j + 1) * 64 * 64, 64);
        f32x16 st[2];
        nsa_scores(st, tile, qf, lane);
        const bool full = (j * 64 + 63 <= nfull);
        const int nlim = full ? 100000 : ((t - 31) >> 4) - j * 64 - 4 * hh;
#pragma unroll
        for (int kt = 0; kt < 2; ++kt)
#pragma unroll
          for (int r = 0; r < 16; ++r) {
            const float arg = (kt * 32 + (r & 3) + 8 * (r >> 2) <= nlim) ? st[kt][r] - m : NSA_NEG;
            st[kt][r] = __builtin_amdgcn_exp2f(arg) * inv_l;
          }
#pragma unroll
        for (int kt = 0; kt < 2; ++kt)
#pragma unroll
          for (int c4 = 0; c4 < 4; ++c4) {
            float carry = 0.5f * st[kt][4 * c4 + 3];
            float fullv = st[kt][4 * c4] + st[kt][4 * c4 + 1] + st[kt][4 * c4 + 2] + carry;
            fullv += xor1f(fullv); fullv += xor2f(fullv);
            carry += xor1f(carry); carry += xor2f(carry);
            const int jb = j * 16 + kt * 8 + 2 * c4 + hh;
            if (r4 == 0) { Aimp[qi * 128 + jb] = fullv; Cimp[qi * 128 + jb] = carry; }
          }
        if (branch_mask & 1) nsa_pv(o, st, tile, lane);
        if (j + 1 < ntile) nsa_store_tile(tr, smem + ((j + 1) & 1) * NSA_TILE);
        __syncthreads();
      }
      nsa_accum_store(ONSA + it.tokrow * 512 + (it.g * 4 + r4) * 64, o, (branch_mask & 1) ? g_c : 0.f, true, hh);
      const int cur = it.qb;
      if (cur <= 15) {
        if (lane < 8) { selm16[lane * 8 + 0] = (unsigned short)((2u << cur) - 1u);
#pragma unroll
          for (int k = 1; k < 8; ++k) selm16[lane * 8 + k] = 0; }
      } else {
        const int qs = lane >> 3, sub = lane & 7;
        float v[16];
#pragma unroll
        for (int i = 0; i < 16; ++i) {
          const int jj = sub * 16 + i;
          const bool ok = (jj >= 1) && (jj <= cur - 2);
          const int jm = jj >= 1 ? jj - 1 : 0;
          v[i] = ok ? (Aimp[qs * 128 + jj] + Cimp[qs * 128 + jm]) : -3e38f;
        }
        unsigned bits = 0;
        for (int itn = 0; itn < 13; ++itn) {
          float bv = v[0]; int bi = 0;
#pragma unroll
          for (int i = 1; i < 16; ++i) if (v[i] > bv) { bv = v[i]; bi = i; }
          int bj = sub * 16 + bi;
#pragma unroll
          for (int o2 = 1; o2 < 8; o2 <<= 1) {
            const float ov = __shfl_xor(bv, o2); const int oj = __shfl_xor(bj, o2);
            if (ov > bv || (ov == bv && oj < bj)) { bv = ov; bj = oj; }
          }
          if ((bj >> 4) == sub) {
            const int i2 = bj & 15;
#pragma unroll
            for (int i = 0; i < 16; ++i) if (i == i2) v[i] = -3e38f;
            bits |= 1u << i2;
          }
        }
        if (sub == 0) bits |= 1u;
        if ((cur >> 4) == sub) bits |= 1u << (cur & 15);
        if (((cur - 1) >> 4) == sub) bits |= 1u << ((cur - 1) & 15);
        selm16[qs * 8 + sub] = (unsigned short)bits;
      }
      __syncthreads();
      if (r4 == 0 && hh == 0) SELG[(size_t)it.bg * SEQ + t] = selm128[qi];
    }
  }
  __threadfence_block();
  __syncthreads();

#pragma unroll 1
  for (int sweep_i = 0; sweep_i < 2 + ((PROBE_DUP & 1024) ? 1 : 0) + ((PROBE_DUP & 2048) ? 1 : 0); ++sweep_i) {
    const int sweep = (sweep_i < 2) ? sweep_i : (((PROBE_DUP & 1024) && sweep_i == 2) ? 0 : 1);
    const bool dry = sweep_i >= 2;
    if (!(branch_mask & (sweep == 0 ? 2 : 4))) continue;
    if (sweep == 0) { nsa_sel16(p, smem, dry); continue; }
    const bf16_t* KB = (const bf16_t*)(ws + (sweep == 0 ? OFF_KS : OFF_KW)); const bf16_t* VB = (const bf16_t*)(ws + (sweep == 0 ? OFF_VS : OFF_VW));
    for (int item = blockIdx.x; item < NITEM; item += gridDim.x) {
      const NsaItem it = nsa_item(item, wave, qi);
      const int t = it.t, qb = it.qb;
      bf16x8 qf[4];
#pragma unroll
      for (int ks = 0; ks < 4; ++ks) qf[ks] = *(const bf16x8*)(Q + it.tokrow * 512 + (it.g * 4 + r4) * 64 + ks * 16 + hh * 8);
      const float g_b = gsig[it.tokrow * 32 + (it.g * 4 + r4) * 3 + 1 + sweep];
      u32x4 selw = {0xffffffffu, 0xffffffffu, 0xffffffffu, 0xffffffffu};
      if (sweep == 0) selw = SELG[(size_t)it.bg * SEQ + t];
      TileRegs tr;
      const bf16_t* kb = KB + (size_t)it.b * SEQ * 128 + it.g * 64;
      const bf16_t* vb = VB + (size_t)it.b * SEQ * 128 + it.g * 64;
      float m = -1e30f, l = 0.f;
      f32x16 o[2];
#pragma unroll
      for (int r = 0; r < 16; ++r) { o[0][r] = 0.f; o[1][r] = 0.f; }
      const int j0 = (sweep == 1 && qb >= 8) ? qb - 8 : 0;
      __syncthreads();
      nsa_load_tile(tr, kb + (size_t)j0 * 64 * 128, 128, vb + (size_t)j0 * 64 * 128, 128);
      nsa_store_tile(tr, smem);
      if (j0 + 1 <= qb) { nsa_load_tile(tr, kb + (size_t)(j0 + 1) * 64 * 128, 128, vb + (size_t)(j0 + 1) * 64 * 128, 128); nsa_store_tile(tr, smem + NSA_TILE); }
      if (j0 + 2 <= qb) nsa_load_tile(tr, kb + (size_t)(j0 + 2) * 64 * 128, 128, vb + (size_t)(j0 + 2) * 64 * 128, 128);
      __syncthreads();
      const bool late = wave >= 4;
      if (__builtin_amdgcn_readfirstlane(wave) >= 4) __builtin_amdgcn_s_setprio(1);
      bool has = false;
      m = 0.f;
      f32x16 st[2];
      {
        const unsigned w0 = j0 < 32 ? selw.x : (j0 < 64 ? selw.y : (j0 < 96 ? selw.z : selw.w));
        const float ini = ((w0 >> (j0 & 31)) & 1u) ? 0.f : -1e30f;
#pragma unroll
        for (int r = 0; r < 16; ++r) { st[0][r] = ini; st[1][r] = ini; }
        const bf16_t* Kc = (const bf16_t*)smem;
#pragma unroll
        for (int ks = 0; ks < 4; ++ks)
#pragma unroll
          for (int kt = 0; kt < 2; ++kt) st[kt] = MFMA32(*(const bf16x8*)(Kc + (kt * 32 + (lane & 31)) * LK + ks * 16 + (lane >> 5) * 8), qf[ks], st[kt]);
      }
      int bi = 0;
      for (int j = j0; j <= qb; ++j) {
        const char* tile = smem + bi * NSA_TILE;
        const int bn = bi == 2 ? 0 : bi + 1, bnn = bn == 2 ? 0 : bn + 1;
        const int jn = j + 1;
        const unsigned wn = jn < 32 ? selw.x : (jn < 64 ? selw.y : (jn < 96 ? selw.z : selw.w));
        const bool seln = (wn >> (jn & 31)) & 1u;
        const bf16_t* Kn = (const bf16_t*)(smem + bn * NSA_TILE) + (lane & 31) * LK + (lane >> 5) * 8;
        f32x16 sn[2];
        if (!late) {
          const float ini = seln ? -m : -1e30f;
#pragma unroll
          for (int r = 0; r < 16; ++r) { sn[0][r] = ini; sn[1][r] = ini; }
#pragma unroll
          for (int ks = 0; ks < 4; ++ks)
#pragma unroll
            for (int kt = 0; kt < 2; ++kt) sn[kt] = MFMA32(*(const bf16x8*)(Kn + kt * 32 * LK + ks * 16), qf[ks], sn[kt]);
        }
        if (j == qb || (sweep == 1 && j == qb - 8)) {
          const int khi = t - j * 64 - 4 * hh, klo = (sweep == 1) ? khi - 511 : -100000;
#pragma unroll
          for (int r = 0; r < 16; ++r) {
            const int o0 = (r & 3) + 8 * (r >> 2);
            st[0][r] = (o0 <= khi && o0 >= klo) ? st[0][r] : NSA_NEG;
            st[1][r] = (o0 + 32 <= khi && o0 + 32 >= klo) ? st[1][r] : NSA_NEG;
          }
        }
        float mx;
        {
          float a0, a1, a2, a3;
          asm("v_max3_f32 %0, %1, %2, %3" : "=v"(a0) : "v"(st[0][0]), "v"(st[0][1]), "v"(st[0][2]));
          asm("v_max3_f32 %0, %1, %2, %3" : "=v"(a1) : "v"(st[0][3]), "v"(st[0][4]), "v"(st[0][5]));
          asm("v_max3_f32 %0, %1, %2, %3" : "=v"(a2) : "v"(st[0][6]), "v"(st[0][7]), "v"(st[0][8]));
          asm("v_max3_f32 %0, %1, %2, %3" : "=v"(a3) : "v"(st[0][9]), "v"(st[0][10]), "v"(st[0][11]));
          asm("v_max3_f32 %0, %1, %2, %3" : "=v"(a0) : "v"(a0), "v"(st[0][12]), "v"(st[0][13]));
          asm("v_max3_f32 %0, %1, %2, %3" : "=v"(a1) : "v"(a1), "v"(st[0][14]), "v"(st[0][15]));
          asm("v_max3_f32 %0, %1, %2, %3" : "=v"(a2) : "v"(a2), "v"(st[1][0]), "v"(st[1][1]));
          asm("v_max3_f32 %0, %1, %2, %3" : "=v"(a3) : "v"(a3), "v"(st[1][2]), "v"(st[1][3]));
          asm("v_max3_f32 %0, %1, %2, %3" : "=v"(a0) : "v"(a0), "v"(st[1][4]), "v"(st[1][5]));
          asm("v_max3_f32 %0, %1, %2, %3" : "=v"(a1) : "v"(a1), "v"(st[1][6]), "v"(st[1][7]));
          asm("v_max3_f32 %0, %1, %2, %3" : "=v"(a2) : "v"(a2), "v"(st[1][8]), "v"(st[1][9]));
          asm("v_max3_f32 %0, %1, %2, %3" : "=v"(a3) : "v"(a3), "v"(st[1][10]), "v"(st[1][11]));
          asm("v_max3_f32 %0, %1, %2, %3" : "=v"(a0) : "v"(a0), "v"(st[1][12]), "v"(st[1][13]));
          asm("v_max3_f32 %0, %1, %2, %3" : "=v"(a1) : "v"(a1), "v"(st[1][14]), "v"(st[1][15]));
          asm("v_max3_f32 %0, %1, %2, %3" : "=v"(a0) : "v"(a0), "v"(a1), "v"(a2));
          const float other = a3;
          asm("v_max_f32 %0, %1, %2" : "=v"(mx) : "v"(a0), "v"(other));
          const float px = xor32f(mx, lane);
          asm("v_max_f32 %0, %1, %2" : "=v"(mx) : "v"(mx), "v"(px));
        }
        const bool real = mx > -1e29f;
        const bool fresh = !has && real, up = has && (mx > NSA_THR);
        if (__any(fresh || up)) {
          const float delta = (fresh || up) ? mx : 0.f;
          const float alpha = up ? __builtin_amdgcn_exp2f(-delta) : 1.0f;
          m += delta; l *= alpha;
#pragma unroll
          for (int r = 0; r < 16; ++r) { o[0][r] *= alpha; o[1][r] *= alpha; st[0][r] -= delta; st[1][r] -= delta; }
          if (!late) {
            const float dn = seln ? delta : 0.f;
#pragma unroll
            for (int r = 0; r < 16; ++r) { sn[0][r] -= dn; sn[1][r] -= dn; }
          }
        }
        has = has || real;
        f32x2 s2 = {0.f, 0.f};
#pragma unroll
        for (int r = 0; r < 16; ++r) {
          const float p0 = __builtin_amdgcn_exp2f(st[0][r]), p1 = __builtin_amdgcn_exp2f(st[1][r]);
          st[0][r] = p0; st[1][r] = p1; s2 += (f32x2){p0, p1};
        }
        l += s2.x + s2.y;
        nsa_pv(o, st, tile, lane);
        if (late) {
          const float ini = seln ? -m : -1e30f;
#pragma unroll
          for (int r = 0; r < 16; ++r) { sn[0][r] = ini; sn[1][r] = ini; }
#pragma unroll
          for (int ks = 0; ks < 4; ++ks)
#pragma unroll
            for (int kt = 0; kt < 2; ++kt) sn[kt] = MFMA32(*(const bf16x8*)(Kn + kt * 32 * LK + ks * 16), qf[ks], sn[kt]);
        }
        if (j + 2 <= qb) nsa_store_tile(tr, smem + bnn * NSA_TILE);
        if (j + 3 <= qb) nsa_load_tile(tr, kb + (size_t)(j + 3) * 64 * 128, 128, vb + (size_t)(j + 3) * 64 * 128, 128);
#pragma unroll
        for (int r = 0; r < 16; ++r) { st[0][r] = sn[0][r]; st[1][r] = sn[1][r]; }
        bi = bn;
        __syncthreads();
      }
      __builtin_amdgcn_s_setprio(0);
      l += xor32f(l, lane);
      if (!dry) nsa_accum_store(ONSA + it.tokrow * 512 + (it.g * 4 + r4) * 64, o, l > 0.f ? g_b / l : 0.f, false, hh, (unsigned char*)(ws + OFF_ONSA8) + it.tokrow * 512 + (it.g * 4 + r4) * 64);
      else asm volatile("" :: "v"(o[0]), "v"(o[1]), "v"(l));
    }
  }
}

DI unsigned ord_key(float f) { const unsigned u = __float_as_uint(f); return (u & 0x80000000u) ? ~u : (u | 0x80000000u); }
DI float ord_val(unsigned k) { return __uint_as_float((k & 0x80000000u) ? (k & 0x7fffffffu) : ~k); }
DI void cex(unsigned& hi, unsigned& lo) { const unsigned x = hi, y = lo; hi = x > y ? x : y; lo = x > y ? y : x; }
DI void sort16_desc(unsigned (&a)[16]) {
#pragma unroll
  for (int k = 2; k <= 16; k <<= 1)
#pragma unroll
    for (int j = k >> 1; j > 0; j >>= 1)
#pragma unroll
      for (int i = 0; i < 16; ++i) {
        const int l = i ^ j;
        if (l > i) { if ((i & k) == 0) cex(a[i], a[l]); else cex(a[l], a[i]); }
      }
}
DI void bitonic_finish16(unsigned (&a)[16]) {
#pragma unroll
  for (int j = 8; j > 0; j >>= 1)
#pragma unroll
    for (int i = 0; i < 16; ++i) { const int l = i ^ j; if (l > i) cex(a[i], a[l]); }
}
DI void merge_top16(unsigned (&a)[16], const unsigned (&b)[16]) {
#pragma unroll
  for (int i = 0; i < 16; ++i) a[i] = a[i] > b[15 - i] ? a[i] : b[15 - i];
  bitonic_finish16(a);
}
DI void merge_partner16(unsigned (&a)[16]) {
  unsigned b[16];
#pragma unroll
  for (int i = 0; i < 16; ++i) b[i] = xor32u(a[i], otid());
  merge_top16(a, b);
}


constexpr int KLD = 136;
DI void peer_top16(unsigned (&top)[16], const bf16x8 (&bq)[8], const bf16_t* keys  , int lane) {
  const int l31 = lane & 31, hh = lane >> 5;
  unsigned grp[16];
#pragma unroll
  for (int nt = 0; nt < 4; ++nt) {
    f32x16 sa;
#pragma unroll
    for (int r = 0; r < 16; ++r) sa[r] = 0.f;
    const bf16_t* kp = keys + (nt * 32 + l31) * KLD + hh * 8;
#pragma unroll
    for (int ks = 0; ks < 8; ++ks) { const bf16x8 a = *(const bf16x8*)(kp + ks * 16); sa = MFMA32(a, bq[ks], sa); }
#pragma unroll
    for (int r = 0; r < 16; ++r) {
      const int n = nt * 32 + (r & 3) + 8 * (r >> 2) + 4 * hh;
      grp[r] = (ord_key(sa[r]) & ~0x7Fu) | (unsigned)(127 - n);
    }
    sort16_desc(grp);
    if (nt == 0) {
#pragma unroll
      for (int i = 0; i < 16; ++i) top[i] = grp[i];
    } else merge_top16(top, grp);
  }
  merge_partner16(top);
}

DI void phase_route(const Params& p, char* smem) {
  char* ws = p.ws;
  const int tid = otid(), lane = tid & 63, wave = tid >> 6, l31 = lane & 31, hh = lane >> 5;
  const bf16_t* pq = (const bf16_t*)(ws + OFF_PQ);
  const bf16_t* pk = (const bf16_t*)(ws + OFF_PKEYS);
  int* eidx = (int*)(ws + OFF_EIDX);
  float* pgate = (float*)(ws + OFF_PGATE);
  bf16_t* KL = (bf16_t*)smem;
  unsigned* LS = (unsigned*)(smem + 2 * 128 * KLD * 2) + wave * 1024;
  {
    const int h0 = blockIdx.x & 7;
    __syncthreads();
#pragma unroll
    for (int i = 0; i < 8; ++i) {
      const int idx = tid + i * NT, row = idx >> 4, ch = idx & 15;
      *(u32x4*)(KL + row * KLD + ch * 8) = *(const u32x4*)(pk + ((size_t)h0 * 256 + row) * 128 + ch * 8);
    }
    __syncthreads();
  }
  constexpr int CA[64] = {0,0,0,0,0,0,0,0,0,0,0,0,0,0,0,0, 1,1,1,1,1,1,1,1, 2,2,2,2,2, 3,3,3,3, 4,4,4, 5,5, 6,6, 7,7, 8,9,10,11,12,13,14,15, 0,0,0,0,0,0,0,0,0,0,0,0,0,0};
  constexpr int CB[64] = {0,1,2,3,4,5,6,7,8,9,10,11,12,13,14,15, 0,1,2,3,4,5,6,7, 0,1,2,3,4, 0,1,2,3, 0,1,2, 0,1, 0,1, 0,1, 0,0,0,0,0,0,0,0, 0,0,0,0,0,0,0,0,0,0,0,0,0,0};
  for (int item = blockIdx.x; item < (NTOK / 256) * 8; item += gridDim.x) {
    const int h = item & 7, t0 = (item >> 3) * 256 + wave * 32;
    unsigned s1[16], s2[16];
    const bf16_t* pqrow = pq + (size_t)(t0 + l31) * 2048 + h * 256 + hh * 8;
    bf16x8 bq1[8], bq2[8];
#pragma unroll
    for (int ks = 0; ks < 8; ++ks) { bq1[ks] = *(const bf16x8*)(pqrow + ks * 16); bq2[ks] = *(const bf16x8*)(pqrow + 128 + ks * 16); }
    peer_top16(s1, bq1, KL, lane);
    peer_top16(s2, bq2, KL + 128 * KLD, lane);
    float f1[16], f2[16];
#pragma unroll
    for (int i = 0; i < 16; ++i) { f1[i] = ord_val(s1[i]); f2[i] = ord_val(s2[i]); }
    unsigned ca[16], cb2[16];
#pragma unroll
    for (int i = 0; i < 32; ++i) {
      const int i0 = i, i1 = 25 + i;
      unsigned k0 = 0u, k1 = 0u;
      if (i0 < 25) k0 = (ord_key(f1[CA[i0]] + f2[CB[i0]]) & ~0xFFu) | (unsigned)(255 - (CA[i0] * 16 + CB[i0]));
      if (i1 < 50) k1 = (ord_key(f1[CA[i1]] + f2[CB[i1]]) & ~0xFFu) | (unsigned)(255 - (CA[i1] * 16 + CB[i1]));
      const unsigned kk = hh ? k1 : k0;
      if (i < 16) ca[i] = kk; else cb2[i - 16] = kk;
    }
    sort16_desc(ca); sort16_desc(cb2);
    merge_top16(ca, cb2);
    merge_partner16(ca);
    if (hh == 0) {
#pragma unroll
      for (int i = 0; i < 16; ++i) { LS[l31 * 32 + i] = s1[i]; LS[l31 * 32 + 16 + i] = s2[i]; }
    }
    const float mx = ord_val(ca[0]);
    float ex[16], sum = 0.f;
#pragma unroll
    for (int i = 0; i < 16; ++i) { ex[i] = __expf(ord_val(ca[i]) - mx); sum += ex[i]; }
    const float inv = 1.0f / sum;
    int eo[16]; float go[16];
#pragma unroll
    for (int i = 0; i < 16; ++i) {
      const int flat = 255 - (int)(ca[i] & 0xFFu);
      const unsigned k1 = LS[l31 * 32 + (flat >> 4)], k2 = LS[l31 * 32 + 16 + (flat & 15)];
      eo[i] = (127 - (int)(k1 & 0x7Fu)) * 128 + (127 - (int)(k2 & 0x7Fu));
      go[i] = ex[i] * inv;
    }
    const size_t ob = ((size_t)(t0 + l31) * 8 + h) * 16;
    if (hh == 0) {
      *(u32x4*)(eidx + ob) = (u32x4){(unsigned)eo[0], (unsigned)eo[1], (unsigned)eo[2], (unsigned)eo[3]};
      *(u32x4*)(eidx + ob + 4) = (u32x4){(unsigned)eo[4], (unsigned)eo[5], (unsigned)eo[6], (unsigned)eo[7]};
      *(f32x4*)(pgate + ob) = (f32x4){go[0], go[1], go[2], go[3]};
      *(f32x4*)(pgate + ob + 4) = (f32x4){go[4], go[5], go[6], go[7]};
    } else {
      *(u32x4*)(eidx + ob + 8) = (u32x4){(unsigned)eo[8], (unsigned)eo[9], (unsigned)eo[10], (unsigned)eo[11]};
      *(u32x4*)(eidx + ob + 12) = (u32x4){(unsigned)eo[12], (unsigned)eo[13], (unsigned)eo[14], (unsigned)eo[15]};
      *(f32x4*)(pgate + ob + 8) = (f32x4){go[8], go[9], go[10], go[11]};
      *(f32x4*)(pgate + ob + 12) = (f32x4){go[12], go[13], go[14], go[15]};
    }
  }
}

#define FOR32(M) M(0) M(1) M(2) M(3) M(4) M(5) M(6) M(7) M(8) M(9) M(10) M(11) M(12) M(13) M(14) M(15) M(16) M(17) M(18) M(19) M(20) M(21) M(22) M(23) M(24) M(25) M(26) M(27) M(28) M(29) M(30) M(31)
#define FOR16(M) M(0) M(1) M(2) M(3) M(4) M(5) M(6) M(7) M(8) M(9) M(10) M(11) M(12) M(13) M(14) M(15)
DI void phase_ffn_u(const Params& p) {
  char* ws = p.ws;
  const int lane = otid() & 63, wave = otid() >> 6, pg = lane >> 3, dc = lane & 7;
  const int sl = blockIdx.x & 7, wslot = (blockIdx.x >> 3) * NW + wave, nw = (gridDim.x >> 3) * NW;
  const unsigned char* PU8 = (const unsigned char*)(ws + OFF_PU8) + (size_t)sl * 16384 * 128 + dc * 16;
  const unsigned char* h2q = (const unsigned char*)(ws + OFF_H2Q) + sl * 128 + dc * 16;
  const int* eidx = (const int*)(ws + OFF_EIDX);
  float* part = (float*)(ws + OFF_PART) + (size_t)sl * NTOK * 128;
  const int j0 = (dc >> 2) * 64 + ((2 * dc) & 7) * 8 + pg;
  int ev0 = 0, ev1 = 0, nev0 = 0, nev1 = 0; u32x4 hq = {0u, 0u, 0u, 0u}, nhq = hq;
  if (wslot < NTOK) { ev0 = eidx[(size_t)wslot * 128 + lane]; ev1 = eidx[(size_t)wslot * 128 + 64 + lane]; hq = *(const u32x4*)(h2q + (size_t)wslot * DM); }
  for (int t = wslot; t < NTOK; t += nw) {
    if (t + nw < NTOK) { const size_t o = (size_t)(t + nw) * 128; nev0 = eidx[o + lane]; nev1 = eidx[o + 64 + lane]; nhq = *(const u32x4*)(h2q + (size_t)(t + nw) * DM); }
#define FFU_LD(it) const u32x4 ru##it = *(const u32x4*)(PU8 + (size_t)__shfl((it) < 8 ? ev0 : ev1, ((it) & 7) * 8 + pg) * 128);
    FOR16(FFU_LD)
    int d[16];
#define FFU_CP(it) { int a_ = __builtin_amdgcn_sdot4((int)ru##it.x, (int)hq.x, 0, false); a_ = __builtin_amdgcn_sdot4((int)ru##it.y, (int)hq.y, a_, false); \
      a_ = __builtin_amdgcn_sdot4((int)ru##it.z, (int)hq.z, a_, false); d[it] = __builtin_amdgcn_sdot4((int)ru##it.w, (int)hq.w, a_, false); }
    FOR16(FFU_CP)
    int r8[8], r4[4], r2[2];
    { const bool hi = dc & 4;
#pragma unroll
      for (int i = 0; i < 8; ++i) { const int keep = hi ? d[8 + i] : d[i], send = hi ? d[i] : d[8 + i]; r8[i] = keep + __shfl_xor(send, 4); } }
    { const bool hi = dc & 2;
#pragma unroll
      for (int i = 0; i < 4; ++i) { const int keep = hi ? r8[4 + i] : r8[i], send = hi ? r8[i] : r8[4 + i]; r4[i] = keep + __float_as_int(xor2f(__int_as_float(send))); } }
    { const bool hi = dc & 1;
#pragma unroll
      for (int i = 0; i < 2; ++i) { const int keep = hi ? r4[2 + i] : r4[i], send = hi ? r4[i] : r4[2 + i]; r2[i] = keep + __float_as_int(xor1f(__int_as_float(send))); } }
    part[(size_t)t * 128 + j0] = (float)r2[0];
    part[(size_t)t * 128 + j0 + 8] = (float)r2[1];
    ev0 = nev0; ev1 = nev1; hq = nhq;
  }
}
DI void phase_ffn_w(const Params& p) {
  char* ws = p.ws;
  const int lane = otid() & 63, wave = otid() >> 6;
  const float* part = (const float*)(ws + OFF_PART);
  const float* scu = (const float*)(ws + OFF_SCU); const float* scv = (const float*)(ws + OFF_SCV);
  const int* eidx = (const int*)(ws + OFF_EIDX);
  const float* pgate = (const float*)(ws + OFF_PGATE);
  float* wbuf = (float*)(ws + OFF_WBUF);
  for (int grp = blockIdx.x; grp < NTOK / NW; grp += gridDim.x) {
    const size_t o = (size_t)(grp * NW + wave) * 128 + lane;
    float a0 = 0.f, a1 = 0.f;
#pragma unroll
    for (int s8 = 0; s8 < 8; ++s8) { a0 += part[(size_t)s8 * NTOK * 128 + o]; a1 += part[(size_t)s8 * NTOK * 128 + o + 64]; }
    const int e0 = eidx[o], e1 = eidx[o + 64];
    const float sht = ((const float*)(ws + OFF_SH))[grp * NW + wave];
    wbuf[o] = pgate[o] * gelu_f(a0 * (scu[e0] * sht)) * scv[e0];
    wbuf[o + 64] = pgate[o + 64] * gelu_f(a1 * (scu[e1] * sht)) * scv[e1];
  }
}
DI void phase_ffn_v(const Params& p) {
  char* ws = p.ws;
  const int lane = otid() & 63, wave = otid() >> 6, pg = lane >> 3, dc = lane & 7;
  const int sl = blockIdx.x & 7, wslot = (blockIdx.x >> 3) * NW + wave, nw = (gridDim.x >> 3) * NW;
  const unsigned char* PV8 = (const unsigned char*)(ws + OFF_PV8) + (size_t)sl * 16384 * 128 + dc * 16;
  const int* eidx = (const int*)(ws + OFF_EIDX) + 16 * pg;
  const float* wbuf = (const float*)(ws + OFF_WBUF) + 16 * pg;
  bf16_t* ffnb = (bf16_t*)(ws + OFF_FFNB);
  u32x4 ne0 = {0u, 0u, 0u, 0u}, ne1 = ne0, ne2 = ne0, ne3 = ne0;
  if (wslot < NTOK) { const int* ep = eidx + (size_t)wslot * 128; ne0 = *(const u32x4*)ep; ne1 = *(const u32x4*)(ep + 4); ne2 = *(const u32x4*)(ep + 8); ne3 = *(const u32x4*)(ep + 12); }
#pragma unroll 1
  for (int t = wslot; t < NTOK; t += nw) {
    const u32x4 ce0 = ne0, ce1 = ne1, ce2 = ne2, ce3 = ne3;
    if (t + nw < NTOK) { const int* ep = eidx + (size_t)(t + nw) * 128; ne0 = *(const u32x4*)ep; ne1 = *(const u32x4*)(ep + 4); ne2 = *(const u32x4*)(ep + 8); ne3 = *(const u32x4*)(ep + 12); }
    const float* wp = wbuf + (size_t)t * 128;
    const f32x4 wq0 = *(const f32x4*)wp, wq1 = *(const f32x4*)(wp + 4), wq2 = *(const f32x4*)(wp + 8), wq3 = *(const f32x4*)(wp + 12);
#define FFV_E(it) ((it) < 4 ? ce0[(it) & 3] : (it) < 8 ? ce1[(it) & 3] : (it) < 12 ? ce2[(it) & 3] : ce3[(it) & 3])
#define FFV_W(it) ((it) < 4 ? wq0[(it) & 3] : (it) < 8 ? wq1[(it) & 3] : (it) < 12 ? wq2[(it) & 3] : wq3[(it) & 3])
#define FFV_LD(it) const u32x4 rv##it = *(const u32x4*)(PV8 + (size_t)FFV_E(it) * 128);
#define FFV_CP(it) { const float wj = FFV_W(it); const f32x2 w2 = {wj, wj}; \
      acc2[0] += __builtin_amdgcn_cvt_pk_f32_fp8((int)rv##it.x, false) * w2; acc2[1] += __builtin_amdgcn_cvt_pk_f32_fp8((int)rv##it.x, true) * w2; \
      acc2[2] += __builtin_amdgcn_cvt_pk_f32_fp8((int)rv##it.y, false) * w2; acc2[3] += __builtin_amdgcn_cvt_pk_f32_fp8((int)rv##it.y, true) * w2; \
      acc2[4] += __builtin_amdgcn_cvt_pk_f32_fp8((int)rv##it.z, false) * w2; acc2[5] += __builtin_amdgcn_cvt_pk_f32_fp8((int)rv##it.z, true) * w2; \
      acc2[6] += __builtin_amdgcn_cvt_pk_f32_fp8((int)rv##it.w, false) * w2; acc2[7] += __builtin_amdgcn_cvt_pk_f32_fp8((int)rv##it.w, true) * w2; }
    FOR16(FFV_LD)
    f32x2 acc2[8];
#pragma unroll
    for (int i = 0; i < 8; ++i) acc2[i] = (f32x2){0.f, 0.f};
    FOR16(FFV_CP)
    float acc[16];
#pragma unroll
    for (int i = 0; i < 8; ++i) { acc[2 * i] = acc2[i].x; acc[2 * i + 1] = acc2[i].y; }
    float r8[8], r4[4], r2[2];
    { const bool hi = lane & 32;
#pragma unroll
      for (int i = 0; i < 8; ++i) { const float keep = hi ? acc[8 + i] : acc[i], send = hi ? acc[i] : acc[8 + i]; r8[i] = keep + xor32f(send, lane); } }
    { const bool hi = lane & 16;
#pragma unroll
      for (int i = 0; i < 4; ++i) { const float keep = hi ? r8[4 + i] : r8[i], send = hi ? r8[i] : r8[4 + i]; r4[i] = keep + xor16f(send, lane); } }
    { const bool hi = lane & 8;
#pragma unroll
      for (int i = 0; i < 2; ++i) { const float keep = hi ? r4[2 + i] : r4[i], send = hi ? r4[i] : r4[2 + i]; r2[i] = keep + xor8f(send); } }
    *(unsigned*)(ffnb + (size_t)t * DM + sl * 128 + dc * 16 + 2 * pg) = pack2(r2[0], r2[1]);
  }
}
DI void phase_final(const Params& p) {
  char* ws = p.ws;
  const int lane = otid() & 63, wave = otid() >> 6;
  const bf16_t* x1 = (const bf16_t*)(ws + OFF_X1);
  const bf16_t* ffnb = (const bf16_t*)(ws + OFF_FFNB);
  const float* mod = (const float*)(ws + OFF_MOD);
  for (int grp = blockIdx.x; grp < NTOK / NW; grp += gridDim.x) {
    const int row = grp * NW + wave, b = row >> 13;
    float v[16];
#pragma unroll
    for (int i = 0; i < 4; ++i) {
      const int col = i * 256 + lane * 4;
      const f32x4 gt2 = *(const f32x4*)(mod + b * 6144 + 5120 + col);
      const u32x2 xr = *(const u32x2*)(x1 + (size_t)row * DM + col), fr = *(const u32x2*)(ffnb + (size_t)row * DM + col);
      v[4 * i] = DN_ALPHA * bflo(xr.x) + gt2.x * bflo(fr.x); v[4 * i + 1] = DN_ALPHA * bfhi(xr.x) + gt2.y * bfhi(fr.x);
      v[4 * i + 2] = DN_ALPHA * bflo(xr.y) + gt2.z * bflo(fr.y); v[4 * i + 3] = DN_ALPHA * bfhi(xr.y) + gt2.w * bfhi(fr.y);
    }
    float mean, rstd; row_stats(v, mean, rstd);
#pragma unroll
    for (int i = 0; i < 4; ++i) {
      const int col = i * 256 + lane * 4;
      const f32x4 g = *(const f32x4*)(p.ln2_g + col), bb = *(const f32x4*)(p.ln2_b + col);
      f32x4 o;
      o.x = (v[4 * i] - mean) * rstd * g.x + bb.x; o.y = (v[4 * i + 1] - mean) * rstd * g.y + bb.y;
      o.z = (v[4 * i + 2] - mean) * rstd * g.z + bb.z; o.w = (v[4 * i + 3] - mean) * rstd * g.w + bb.w;
      *(f32x4*)(p.out + (size_t)row * DM + col) = o;
    }
  }
}

#define XB_TMO      128
#define XB_XCNT(j)  (256  + 64 * (j))
#define XB_XSUB(j)  (1280 + 64 * (j))
#define XB_XGEN(j)  (2304 + 64 * (j))
#define XB_TOP      3328
#define XB_TOPGEN   3392
#define XCD_BAR_WORDS 3456
#define XB_SPIN_CAP (1u << 22)
DI unsigned xb_ld(unsigned* p) { return __hip_atomic_load(p, __ATOMIC_RELAXED, __HIP_MEMORY_SCOPE_AGENT); }
DI unsigned xb_add(unsigned* p, unsigned v) { return __hip_atomic_fetch_add(p, v, __ATOMIC_RELAXED, __HIP_MEMORY_SCOPE_AGENT); }
DI unsigned xb_xcc_id() { return (unsigned)__builtin_amdgcn_s_getreg((3 << 11) | 20) & 0xFu; }
#define XB_SPIN(cond, bar) do { unsigned _sp = 0; while (cond) { __builtin_amdgcn_s_sleep(1); \
    if ((++_sp & 255u) == 0u) { if (xb_ld(&(bar)[XB_TMO])) break; if (_sp > XB_SPIN_CAP) { atomicAdd(&(bar)[XB_TMO], 1u); break; } } } } while (0)
struct XcdBarrier { unsigned* bar; unsigned x; volatile LAS unsigned* st; };
DI XcdBarrier xcd_barrier_post(unsigned* bar, volatile LAS unsigned* st) {
  XcdBarrier b; b.bar = bar; b.x = xb_xcc_id(); b.st = st;
  if (threadIdx.x == 0) (void)xb_add(&bar[XB_XCNT(b.x)], 1u);
  return b;
}
DI void xcd_barrier_complete(unsigned* bar, unsigned x, unsigned& nloc, unsigned& nx) {
  const unsigned G = gridDim.x * gridDim.y * gridDim.z;
  unsigned sum, cnt, mine, sp = 0u;
  for (;;) {
    sum = 0u; cnt = 0u; mine = 0u;
#pragma unroll
    for (unsigned j = 0; j < 16; ++j) { const unsigned c = xb_ld(&bar[XB_XCNT(j)]); sum += c; cnt += (c > 0u) ? 1u : 0u; mine = (j == x) ? c : mine; }
    if (sum == G) break;
    __builtin_amdgcn_s_sleep(1);
    if ((++sp & 255u) == 0u) { if (xb_ld(&bar[XB_TMO])) break; if (sp > XB_SPIN_CAP) { atomicAdd(&bar[XB_TMO], 1u); break; } }
  }
  nloc = mine > 0u ? mine : 1u; nx = cnt > 0u ? cnt : 1u;
}
DI void xcd_barrier(const XcdBarrier& b) {
  asm volatile("s_waitcnt vmcnt(0)" ::: "memory");
  __syncthreads();
  if (threadIdx.x == 0) {
    unsigned* bar = b.bar;
    __builtin_amdgcn_s_waitcnt(0);
    unsigned nloc = b.st[0], nx = b.st[1];
    if (nloc == 0u) { xcd_barrier_complete(bar, b.x, nloc, nx); b.st[0] = nloc; b.st[1] = nx; }
    const unsigned old = xb_add(&bar[XB_XSUB(b.x)], 1u);
    const unsigned gen = old / nloc;
    if (old + 1u == (gen + 1u) * nloc) {
      __builtin_amdgcn_fence(__ATOMIC_RELEASE, "agent");
      asm volatile("s_waitcnt vmcnt(0)" ::: "memory");
      const unsigned og = xb_add(&bar[XB_TOP], 1u);
      const unsigned tg = og / nx;
      if (og + 1u == (tg + 1u) * nx) xb_add(&bar[XB_TOPGEN], 1u);
      else XB_SPIN(xb_ld(&bar[XB_TOPGEN]) == tg, bar);
      __builtin_amdgcn_fence(__ATOMIC_ACQUIRE, "agent");
      xb_add(&bar[XB_XGEN(b.x)], 1u);
      asm volatile("s_waitcnt vmcnt(0)" ::: "memory");
    } else {
      XB_SPIN(xb_ld(&bar[XB_XGEN(b.x)]) == gen, bar);
      __builtin_amdgcn_fence(__ATOMIC_ACQUIRE, "agent");
      asm volatile("s_waitcnt vmcnt(0)" ::: "memory");
    }
  }
  __syncthreads();
}

constexpr int SMEM_BYTES = 147456 + 256;

__global__ void __launch_bounds__(NT, 2) k_mega(Params p) {
  __shared__ __attribute__((aligned(16))) char smem[SMEM_BYTES];
  cg::grid_group grid = cg::this_grid();
  if (threadIdx.x == 0) *(u32x4*)(smem + 147456) = (u32x4){0u, 0u, 0u, 0u};
  __syncthreads();
  const XcdBarrier xb = xcd_barrier_post((unsigned*)(p.ws + OFF_BAR), (volatile LAS unsigned*)(smem + 147456));
#define REP(mask) _Pragma("unroll 1") for (int rep_ = 0; rep_ < ((PROBE_DUP & (mask)) ? 2 : 1); ++rep_)
  REP(1) phase_prep(p, smem, (unsigned*)(p.ws + OFF_BAR) + XCD_BAR_WORDS + rep_);
  grid.sync();
  REP(1) phase_ln_in(p);
  xcd_barrier(xb);
  REP(2) phase_gemm1(p, smem);
  xcd_barrier(xb);
  REP(4) phase_compress(p, smem);
  phase_sgu(p, smem);
  xcd_barrier(xb);
  REP(8) phase_nsa(p, smem, NSA_MASK);
  xcd_barrier(xb);
  REP(16) phase_merge(p, smem);
  xcd_barrier(xb);
  REP(16) phase_outproj(p, smem);
  xcd_barrier(xb);
  REP(1) phase_ln_mid(p);
  xcd_barrier(xb);
  REP(32) phase_peerq(p, smem);
  xcd_barrier(xb);
  REP(64) phase_route(p, smem);
  xcd_barrier(xb);
  REP(128) phase_ffn_u(p);
  xcd_barrier(xb);
  REP(128) phase_ffn_w(p);
  xcd_barrier(xb);
  REP(256) phase_ffn_v(p);
  xcd_barrier(xb);
  REP(512) phase_final(p);
}

extern "C" void kernel_launch(void* const* d_in, const int* in_sizes, int n_in, void* d_out, int out_size, void* d_ws, size_t ws_size, hipStream_t stream) {
  if (ws_size < OFF_END) { fprintf(stderr, "workspace too small: %zu < %zu\n", ws_size, (size_t)OFF_END); return; }
  static int grid_blocks = 0;
  if (!grid_blocks) {
    int dev = 0, cus = 0, per_cu = 0;
    (void)hipGetDevice(&dev);
    (void)hipDeviceGetAttribute(&cus, hipDeviceAttributeMultiprocessorCount, dev);
    (void)hipOccupancyMaxActiveBlocksPerMultiprocessor(&per_cu, k_mega, NT, 0);
    if (per_cu < 1) fprintf(stderr, "occupancy query returned %d\n", per_cu);
    grid_blocks = (cus / 8) * 8;
  }
  Params p{};
  const float** fp = (const float**)&p;
  for (int i = 0; i < 26; ++i) fp[i] = (const float*)d_in[i];
  p.out = (float*)d_out;
  p.ws = (char*)d_ws;
  for (int i = 0; i < 32; ++i) p.inv_freq[i] = (float)pow(10000.0, -(double)i / 32.0);
  (void)hipMemsetAsync((char*)d_ws + OFF_BAR, 0, (XCD_BAR_WORDS + 64) * 4, stream);
  void* args[] = {&p};
  hipError_t e = hipLaunchCooperativeKernel((void*)k_mega, dim3(grid_blocks), dim3(NT), args, 0, stream);
  if (e != hipSuccess) fprintf(stderr, "cooperative launch failed: %s (grid %d)\n", hipGetErrorString(e), grid_blocks);
}
```

```cpp
#include <hip/hip_runtime.h>
#include <hip/hip_cooperative_groups.h>
#include <stdint.h>
#include <stdio.h>
#include <math.h>
namespace cg = cooperative_groups;

#ifndef PROBE_DUP
#define PROBE_DUP 0
#endif
#ifndef NSA_MASK
#define NSA_MASK 7
#endif
typedef unsigned short bf16_t;
typedef short bf16x8 __attribute__((ext_vector_type(8)));
typedef short s16x4 __attribute__((ext_vector_type(4)));
typedef float f32x16 __attribute__((ext_vector_type(16)));
typedef float f32x4 __attribute__((ext_vector_type(4)));
typedef float f32x2 __attribute__((ext_vector_type(2)));
typedef __bf16 bf16v2 __attribute__((ext_vector_type(2)));
typedef unsigned u32x4 __attribute__((ext_vector_type(4)));
typedef int i32x4 __attribute__((ext_vector_type(4)));
typedef int i32x8 __attribute__((ext_vector_type(8)));
typedef unsigned u32x2 __attribute__((ext_vector_type(2)));
#define DI __device__ __forceinline__
#define LAS __attribute__((address_space(3)))
#define MFMA32(a, b, c) __builtin_amdgcn_mfma_f32_32x32x16_bf16((a), (b), (c), 0, 0, 0)

constexpr int NT = 512, NW = 8;
constexpr int NB = 8, SEQ = 8192, DM = 1024, NTOK = NB * SEQ;
constexpr int N1 = 4608;
constexpr float DN_ALPHA = 1.189207115002721f;
constexpr float LN_EPS = 1e-5f;

constexpr size_t MB = 1024 * 1024;
constexpr size_t OFF_MOD = 0;
constexpr size_t OFF_ROPE = OFF_MOD + 256 * 1024;
constexpr size_t OFF_POSB = OFF_ROPE + 2 * MB;
constexpr size_t OFF_WT1 = OFF_POSB + 4096;
constexpr size_t OFF_WB = OFF_WT1 + (size_t)N1 * 1024 * 2;
constexpr size_t OFF_WOUT = OFF_WB + 2 * MB;
constexpr size_t OFF_WQ = OFF_WOUT + 2 * MB;
constexpr size_t OFF_PKEYS = OFF_WQ + 4 * MB;
constexpr size_t OFF_CW1 = OFF_PKEYS + MB / 2;
constexpr size_t OFF_CW2 = OFF_CW1 + MB;
constexpr size_t OFF_SGUW = OFF_CW2 + 32 * 1024;
constexpr size_t OFF_SCU = OFF_SGUW + 256 * 1024;
constexpr size_t OFF_SCV = OFF_SCU + 64 * 1024;
constexpr size_t OFF_PU = OFF_SCV + 64 * 1024;
constexpr size_t OFF_PV = OFF_PU + 32 * MB;
constexpr size_t OFF_ACT = ((OFF_PV + 32 * MB + 4095) / 4096) * 4096;
constexpr size_t OFF_H = OFF_ACT;
constexpr size_t OFF_Q = OFF_H + 128 * MB;
constexpr size_t OFF_KC = OFF_Q + 64 * MB;
constexpr size_t OFF_VC = OFF_KC + 16 * MB;
constexpr size_t OFF_KS = OFF_VC + 16 * MB;
constexpr size_t OFF_VS = OFF_KS + 16 * MB;
constexpr size_t OFF_KW = OFF_VS + 16 * MB;
constexpr size_t OFF_VW = OFF_KW + 16 * MB;
constexpr size_t OFF_U = OFF_VW + 16 * MB;
constexpr size_t OFF_V = OFF_U + 64 * MB;
constexpr size_t OFF_GATE = OFF_V + 64 * MB;
constexpr size_t OFF_GSIG = OFF_GATE + 256 * MB;
constexpr size_t OFF_KCMP = OFF_GSIG + 8 * MB;
constexpr size_t OFF_VCMP = OFF_KCMP + MB;
constexpr size_t OFF_ONSA = OFF_VCMP + MB;
constexpr size_t OFF_SELG = OFF_ONSA + 64 * MB;
constexpr size_t OFF_BAR = OFF_SELG + 2 * MB;
constexpr size_t OFF_END = OFF_BAR + 64 * 1024;
constexpr size_t OFF_X1 = OFF_Q;
constexpr size_t OFF_Y = OFF_GATE;
constexpr size_t OFF_PQ = OFF_GATE;
constexpr size_t OFF_EIDX = OFF_ONSA;
constexpr size_t OFF_PGATE = OFF_ONSA + 32 * MB;
constexpr size_t OFF_PU8 = OFF_PU;
constexpr size_t OFF_PART = OFF_GATE;
constexpr size_t OFF_PV8 = OFF_PU + 16 * MB;
constexpr size_t OFF_WBUF = OFF_PU + 32 * MB;
constexpr size_t OFF_H2Q = OFF_U;
constexpr size_t OFF_SH = OFF_V;
constexpr size_t OFF_FFNB = OFF_GATE;
constexpr size_t OFF_SCW1 = OFF_WT1 + 5 * MB;
constexpr size_t OFF_SCWQ = OFF_WQ + 3 * MB;
constexpr size_t OFF_GATE8 = OFF_GATE;
constexpr size_t OFF_OSGU8 = OFF_GATE + 128 * MB;
constexpr size_t OFF_ONSA8 = OFF_GATE + 160 * MB;
constexpr size_t OFF_MRG8 = OFF_GATE + 192 * MB;
constexpr size_t OFF_M08 = OFF_H;
constexpr size_t OFF_SCWB = OFF_WB + 3 * MB / 2;
constexpr size_t OFF_SCWO = OFF_WOUT + 3 * MB / 2;
constexpr size_t OFF_SA = OFF_H + 64 * MB;

struct Params {
  const float *x, *c, *w_ada, *b_ada, *w_in, *cmp_pos, *cmp_w1, *cmp_b1, *cmp_w2, *cmp_b2, *sgu_ln_g, *sgu_ln_b, *sgu_w, *sgu_b,
      *w_branch, *w_merge, *b_merge, *w_out, *ln1_g, *ln1_b, *peer_wq, *peer_keys, *peer_u, *peer_v, *ln2_g, *ln2_b;
  float* out;
  char* ws;
  float inv_freq[32];
};

DI unsigned pack2(float lo, float hi) { f32x2 v = {lo, hi}; bf16v2 r = __builtin_convertvector(v, bf16v2); return __builtin_bit_cast(unsigned, r); }
DI bf16_t f2bf(float f) { __bf16 r = (__bf16)f; return __builtin_bit_cast(unsigned short, r); }
DI float bf2f(bf16_t h) { return __uint_as_float(((unsigned)h) << 16); }
DI float bflo(unsigned u) { return __uint_as_float(u << 16); }
DI float bfhi(unsigned u) { return __uint_as_float(u & 0xffff0000u); }
DI float gelu_f(float v) { return 0.5f * v * (1.0f + erff(v * 0.70710678118654752f)); }
DI float sigmoid_f(float v) { return __builtin_amdgcn_rcpf(1.0f + __builtin_amdgcn_exp2f(v * -1.4426950408889634f)); }
DI int otid() { int t = __builtin_amdgcn_workitem_id_x(); asm volatile("" : "+v"(t)); return t; }
DI void lds_barrier() { asm volatile("s_waitcnt lgkmcnt(0)" ::: "memory"); __builtin_amdgcn_s_barrier(); asm volatile("" ::: "memory"); }
DI float xor1f(float x) { const int xi = __float_as_int(x); return __int_as_float(__builtin_amdgcn_update_dpp(xi, xi, 0xB1, 0xF, 0xF, false)); }
DI float xor2f(float x) { const int xi = __float_as_int(x); return __int_as_float(__builtin_amdgcn_update_dpp(xi, xi, 0x4E, 0xF, 0xF, false)); }
DI float xor8f(float x) { const int xi = __float_as_int(x); return __int_as_float(__builtin_amdgcn_update_dpp(xi, xi, 0x128, 0xF, 0xF, false)); }
DI unsigned xor32u(unsigned x, int lane) { const u32x2 r = __builtin_amdgcn_permlane32_swap(x, x, false, false); return (lane & 32) ? r.x : r.y; }
DI unsigned xor16u(unsigned x, int lane) { const u32x2 r = __builtin_amdgcn_permlane16_swap(x, x, false, false); return (lane & 16) ? r.x : r.y; }
DI float xor32f(float x, int lane) { return __uint_as_float(xor32u(__float_as_uint(x), lane)); }
DI float xor16f(float x, int lane) { return __uint_as_float(xor16u(__float_as_uint(x), lane)); }
DI unsigned pack_i8x4(float a, float b, float c, float d) {
  const int ia = (int)rintf(a), ib = (int)rintf(b), ic = (int)rintf(c), id = (int)rintf(d);
  return (unsigned)(ia & 0xff) | ((unsigned)(ib & 0xff) << 8) | ((unsigned)(ic & 0xff) << 16) | ((unsigned)id << 24);
}
DI unsigned pk4_fp8(float a, float b, float c, float d) { int t = 0; t = __builtin_amdgcn_cvt_pk_fp8_f32(a, b, t, false); t = __builtin_amdgcn_cvt_pk_fp8_f32(c, d, t, true); return (unsigned)t; }
DI float clamp_f8(float v) { return __builtin_amdgcn_fmed3f(v, -448.0f, 448.0f); }
DI void unpack8_fp8(const u32x2 w, float (&v)[8]) {
  const f32x2 a = __builtin_amdgcn_cvt_pk_f32_fp8((int)w.x, false), b = __builtin_amdgcn_cvt_pk_f32_fp8((int)w.x, true);
  const f32x2 c = __builtin_amdgcn_cvt_pk_f32_fp8((int)w.y, false), d = __builtin_amdgcn_cvt_pk_f32_fp8((int)w.y, true);
  v[0] = a.x; v[1] = a.y; v[2] = b.x; v[3] = b.y; v[4] = c.x; v[5] = c.y; v[6] = d.x; v[7] = d.y;
}
DI float wave_sum(float v) {
#pragma unroll
  for (int o = 32; o > 0; o >>= 1) v += __shfl_xor(v, o);
  return v;
}
DI void ld8(const float* pz, float (&v)[8]) { const f32x4 a = *(const f32x4*)pz, b = *(const f32x4*)(pz + 4); v[0] = a.x; v[1] = a.y; v[2] = a.z; v[3] = a.w; v[4] = b.x; v[5] = b.y; v[6] = b.z; v[7] = b.w; }
DI u32x4 pack8(const float (&v)[8]) { u32x4 w; w.x = pack2(v[0], v[1]); w.y = pack2(v[2], v[3]); w.z = pack2(v[4], v[5]); w.w = pack2(v[6], v[7]); return w; }
DI void unpack8(const u32x4 w, float (&v)[8]) { v[0] = bflo(w.x); v[1] = bfhi(w.x); v[2] = bflo(w.y); v[3] = bfhi(w.y); v[4] = bflo(w.z); v[5] = bfhi(w.z); v[6] = bflo(w.w); v[7] = bfhi(w.w); }
DI f32x2 gelu_pk(f32x2 v) {
  const f32x2 av = __builtin_elementwise_abs(v), d = av * 0.2316418882f + 1.0f;
  f32x2 t; t.x = __builtin_amdgcn_rcpf(d.x); t.y = __builtin_amdgcn_rcpf(d.y);
  f32x2 q = t * 0.5307027145f + (-0.7265760135f); q = q * t + 0.7107068705f; q = q * t + (-0.142248368f); q = q * t + 0.127414796f; q = q * t;
  const f32x2 s = (v * v) * (-0.72134752044f);
  f32x2 e; e.x = __builtin_amdgcn_exp2f(s.x); e.y = __builtin_amdgcn_exp2f(s.y);
  const f32x2 m = v * (q * e), r = v - m;
  f32x2 o; o.x = v.x < 0.f ? m.x : r.x; o.y = v.y < 0.f ? m.y : r.y; return o;
}
__host__ __device__ __forceinline__ int dperm(int q) { const int grp = q >> 5, fq = (q >> 3) & 3, j = q & 7; return (j < 4) ? (16 * grp + 4 * fq + j) : (32 + 16 * grp + 4 * fq + (j - 4)); }

template <class F>
DI void tconv_tile(float* tile, int k0, int n0, bf16_t* dst, int ldd, F f) {
  const int tid = otid();
  __syncthreads();
#pragma unroll 4
  for (int i = 0; i < 8; ++i) { const int kl = i * 8 + (tid >> 6), nl = tid & 63; tile[nl * 65 + kl] = f(k0 + kl, n0 + nl); }
  __syncthreads();
  {
    const int nl = tid >> 3, kc = tid & 7;
    const float* t = tile + nl * 65 + kc * 8;
    u32x4 w; w.x = pack2(t[0], t[1]); w.y = pack2(t[2], t[3]); w.z = pack2(t[4], t[5]); w.w = pack2(t[6], t[7]);
    *(u32x4*)(dst + (size_t)(n0 + nl) * ldd + k0 + kc * 8) = w;
  }
}

template <bool FP8, class F>
DI void tconv_strip32(float* tile, int n0, int K, unsigned char* dst, float* gscale, F f) {
  const int tid = otid(), nl = tid & 31, kr = tid >> 5, ld = K + 1;
  float am = 0.f;
#pragma unroll 16
  for (int k = kr; k < K; k += 16) { const float v = f(k, n0 + nl); tile[nl * ld + k] = v; am = fmaxf(am, fabsf(v)); }
#pragma unroll
  for (int o = 16; o > 0; o >>= 1) am = fmaxf(am, __shfl_xor(am, o));
  float* red = tile + 32 * ld;
  if (nl == 0) red[kr] = am;
  __syncthreads();
  float g = 0.f;
#pragma unroll
  for (int w = 0; w < 16; ++w) g = fmaxf(g, red[w]);
  float q, inv;
  if (FP8) {
    const unsigned be = (__float_as_uint(g) >> 23) & 0xffu;
    const bool ok = be >= 16u && be <= 240u;
    q = ok ? __uint_as_float((261u - be) << 23) : 1.0f; inv = ok ? __uint_as_float((be - 7u) << 23) : 1.0f;
  } else { q = g > 0.f ? 127.0f / g : 0.f; inv = g * (1.0f / 127.0f); }
  if (tid == 0) gscale[n0 >> 5] = inv;
  const int cpr = K >> 3;
  for (int idx = tid; idx < 32 * cpr; idx += NT) {
    const int row = idx / cpr, kc = idx - row * cpr;
    const float* t = tile + row * ld + kc * 8;
    u32x2 w;
    if (FP8) { w.x = pk4_fp8(t[0] * q, t[1] * q, t[2] * q, t[3] * q); w.y = pk4_fp8(t[4] * q, t[5] * q, t[6] * q, t[7] * q); }
    else { w.x = pack_i8x4(t[0] * q, t[1] * q, t[2] * q, t[3] * q); w.y = pack_i8x4(t[4] * q, t[5] * q, t[6] * q, t[7] * q); }
    *(u32x2*)(dst + (size_t)(n0 + row) * K + kc * 8) = w;
  }
}

DI void conv_chunk(const float* src, bf16_t* dst, size_t base) {
  const size_t i = base + (size_t)otid() * 8;
  const f32x4 a = *(const f32x4*)(src + i), b = *(const f32x4*)(src + i + 4);
  u32x4 w; w.x = pack2(a.x, a.y); w.y = pack2(a.z, a.w); w.z = pack2(b.x, b.y); w.w = pack2(b.z, b.w);
  *(u32x4*)(dst + i) = w;
}

DI void sincos_d(double x, double& s, double& c) {
  const double y = x * 0.25, y2 = y * y;
  double sn = y * (1.0 + y2 * (-1.0 / 6 + y2 * (1.0 / 120 + y2 * (-1.0 / 5040 + y2 * (1.0 / 362880 + y2 * (-1.0 / 39916800 + y2 * (1.0 / 6227020800.0)))))));
  double cs = 1.0 + y2 * (-0.5 + y2 * (1.0 / 24 + y2 * (-1.0 / 720 + y2 * (1.0 / 40320 + y2 * (-1.0 / 3628800 + y2 * (1.0 / 479001600.0 + y2 * (-1.0 / 87178291200.0)))))));
#pragma unroll
  for (int i = 0; i < 2; ++i) { const double s2 = 2.0 * sn * cs, c2 = cs * cs - sn * sn; sn = s2; cs = c2; }
  s = sn; c = cs;
}

DI void phase_prep(const Params& p, char* smem, unsigned* wcnt) {
  const int tid = otid();
  float* fs = (float*)smem;
  char* ws = p.ws;
  volatile LAS unsigned* slot = (volatile LAS unsigned*)(smem + 147456 + 64);
  constexpr int nB = 144, nE = 64, nC = 64, nD = 32, nA = 192, nI = 512, nF = 2 * 32 * 2, nG = 4, nH = 8, nJ = 64, nK = 32, nL = 512, nM = 512;
  constexpr int total = nB + nE + nC + nD + nA + nI + nF + nG + nH + nJ + nK + nL + nM;
  for (;;) {
    __syncthreads();
    if (tid == 0) *slot = __hip_atomic_fetch_add(wcnt, 1u, __ATOMIC_RELAXED, __HIP_MEMORY_SCOPE_AGENT);
    __syncthreads();
    int it = (int)*slot;
    if (it >= total) break;
    if (it < nB) {
      const float* w_in = p.w_in; const float* w_merge = p.w_merge;
      tconv_strip32<false>(fs, it * 32, 1024, (unsigned char*)(ws + OFF_WT1), (float*)(ws + OFF_SCW1), [=](int k, int n) -> float {
        if (n < 1280) {
          const bool roped = (n < 640) || (n >= 768 && n < 896) || (n >= 1024 && n < 1152);
          const int col = roped ? ((n & ~63) + dperm(n & 63)) : n;
          return w_in[(size_t)k * 2328 + col];
        }
        if (n < 2304) return w_in[(size_t)k * 2328 + n + 24];
        if (n < 4352) return w_merge[(size_t)k * 2048 + (n - 2304)];
        if (n < 4376) return w_in[(size_t)k * 2328 + 1280 + (n - 4352)];
        return 0.f; });
      continue;
    }
    it -= nB;
    if (it < nE) {
      const float* src = p.peer_wq;
      tconv_strip32<false>(fs, it * 32, 1024, (unsigned char*)(ws + OFF_WQ), (float*)(ws + OFF_SCWQ), [=](int k, int n) -> float { return src[(size_t)k * 2048 + n]; });
      continue;
    }
    it -= nE;
    if (it < nC) {
      const int br = it >> 5, strip = it & 31;
      const float* src = p.w_branch + (size_t)br * 512 * 1024;
      tconv_strip32<true>(fs, strip * 32, 512, (unsigned char*)(ws + OFF_WB) + (size_t)br * 1024 * 512, (float*)(ws + OFF_SCWB) + br * 32, [=](int k, int n) -> float { return src[(size_t)k * 1024 + n]; });
      continue;
    }
    it -= nC;
    if (it < nD) {
      const float* src = p.w_out;
      tconv_strip32<true>(fs, it * 32, 1024, (unsigned char*)(ws + OFF_WOUT), (float*)(ws + OFF_SCWO), [=](int k, int n) -> float { return src[(size_t)k * 1024 + n]; });
      continue;
    }
    it -= nD;
    if (it < nA) {
      float* sc = fs;
      float* red = fs + 8192;
      for (int i = tid; i < 8192; i += NT) { const float v = p.c[i]; sc[i] = v / (1.0f + __expf(-v)); }
      __syncthreads();
      const int ks = tid >> 5, cj = tid & 31, col = it * 32 + cj;
      float acc[8];
#pragma unroll
      for (int b = 0; b < 8; ++b) acc[b] = 0.f;
#pragma unroll 16
      for (int k = ks * 64; k < ks * 64 + 64; ++k) {
        const float w = p.w_ada[(size_t)k * 6144 + col];
#pragma unroll
        for (int b = 0; b < 8; ++b) acc[b] += sc[b * 1024 + k] * w;
      }
#pragma unroll
      for (int b = 0; b < 8; ++b) red[(ks * 8 + b) * 32 + cj] = acc[b];
      __syncthreads();
      if (tid < 256) {
        const int b = tid >> 5;
        float s = p.b_ada[col];
#pragma unroll
        for (int k2 = 0; k2 < 16; ++k2) s += red[(k2 * 8 + b) * 32 + cj];
        ((float*)(ws + OFF_MOD))[b * 6144 + col] = s;
      }
      continue;
    }
    it -= nA;
    if (it < nI) {
      const int e = it * 512 + tid, pos = e >> 5, i = e & 31;
      const float ang = (float)pos * p.inv_freq[i];
      const double a = (double)ang;
      const double kk = rint(a * 0.15915494309189535);
      const double r = a - kk * 6.283185307179586476925;
      double sn, cs; sincos_d(r, sn, cs);
      ((float*)(ws + OFF_ROPE))[e] = (float)cs;
      ((float*)(ws + OFF_ROPE))[262144 + e] = (float)sn;
      continue;
    }
    it -= nI;
    if (it < nF) {
      const int w = it >> 6, r = it & 63, kt = r >> 1, ntile = r & 1;
      const float* src = p.cmp_w1 + (size_t)w * 2048 * 128;
      tconv_tile(fs, kt * 64, ntile * 64, (bf16_t*)(ws + OFF_CW1) + (size_t)w * 128 * 2048, 2048, [=](int k, int n) -> float {
        const int ksrc = (w == 0) ? ((k & ~63) + dperm(k & 63)) : k;
        return src[(size_t)ksrc * 128 + n]; });
      continue;
    }
    it -= nF;
    if (it < nG) {
      const int w = it >> 1, kt = it & 1;
      const float* src = p.cmp_w2 + (size_t)w * 128 * 64;
      tconv_tile(fs, kt * 64, 0, (bf16_t*)(ws + OFF_CW2) + (size_t)w * 64 * 128, 128, [=](int k, int n) -> float { return src[(size_t)k * 64 + ((w == 0) ? dperm(n) : n)]; });
      continue;
    }
    it -= nG;
    if (it < nH) {
      const int w = it >> 2, jc = it & 3, ks = tid >> 5, cj = tid & 31, j = jc * 32 + cj;
      float* red = fs;
      const float* pos = p.cmp_pos + w * 2048; const float* w1 = p.cmp_w1 + (size_t)w * 2048 * 128;
      float acc = 0.f;
#pragma unroll 16
      for (int k = ks * 128; k < ks * 128 + 128; ++k) acc += pos[k] * w1[(size_t)k * 128 + j];
      red[ks * 32 + cj] = acc;
      __syncthreads();
      if (tid < 32) { float s = p.cmp_b1[w * 128 + j]; for (int k2 = 0; k2 < 16; ++k2) s += red[k2 * 32 + tid]; ((float*)(ws + OFF_POSB))[w * 128 + j] = s; }
      continue;
    }
    it -= nH;
    if (it < nJ) { conv_chunk(p.peer_keys, (bf16_t*)(ws + OFF_PKEYS), (size_t)it * 4096); continue; }
    it -= nJ;
    if (it < nK) {
      const size_t i0 = (size_t)it * 4096 + (size_t)tid * 8;
      const int rowi = (int)((i0 >> 7) & 127), j0 = (int)(i0 & 127);
      float v[8];
#pragma unroll
      for (int j = 0; j < 8; ++j) v[j] = (j0 + j <= rowi) ? p.sgu_w[i0 + j] : 0.f;
      u32x4 w; w.x = pack2(v[0], v[1]); w.y = pack2(v[2], v[3]); w.z = pack2(v[4], v[5]); w.w = pack2(v[6], v[7]);
      *(u32x4*)((bf16_t*)(ws + OFF_SGUW) + i0) = w;
      continue;
    }
    it -= nK;
    {
      const bool isv = it >= nL;
      if (isv) it -= nL;
      const int lane = tid & 63, e0 = it * 32 + (tid >> 6) * 4;
      const float* src = (isv ? p.peer_v : p.peer_u) + (size_t)e0 * 1024 + lane * 16;
      f32x4 raw[4][4];
#pragma unroll
      for (int r = 0; r < 4; ++r)
#pragma unroll
        for (int i = 0; i < 4; ++i) raw[r][i] = *(const f32x4*)(src + (size_t)r * 1024 + i * 4);
#pragma unroll
      for (int r = 0; r < 4; ++r) {
        const int e = e0 + r;
        float v[16];
#pragma unroll
        for (int i = 0; i < 4; ++i) { v[4 * i] = raw[r][i].x; v[4 * i + 1] = raw[r][i].y; v[4 * i + 2] = raw[r][i].z; v[4 * i + 3] = raw[r][i].w; }
        float amax = 0.f;
#pragma unroll
        for (int i = 0; i < 16; ++i) amax = fmaxf(amax, fabsf(v[i]));
#pragma unroll
        for (int o = 32; o > 0; o >>= 1) amax = fmaxf(amax, __shfl_xor(amax, o));
        if (!isv) {
          const float qs = amax > 0.f ? 127.0f / amax : 0.f;
          u32x4 wi; wi.x = pack_i8x4(v[0] * qs, v[1] * qs, v[2] * qs, v[3] * qs); wi.y = pack_i8x4(v[4] * qs, v[5] * qs, v[6] * qs, v[7] * qs);
          wi.z = pack_i8x4(v[8] * qs, v[9] * qs, v[10] * qs, v[11] * qs); wi.w = pack_i8x4(v[12] * qs, v[13] * qs, v[14] * qs, v[15] * qs);
          *(u32x4*)(ws + OFF_PU8 + ((size_t)(lane >> 3) * 16384 + e) * 128 + (lane & 7) * 16) = wi;
          if (lane == 0) ((float*)(ws + OFF_SCU))[e] = amax * (1.0f / 127.0f);
        } else {
          const unsigned be = (__float_as_uint(amax) >> 23) & 0xffu;
          const bool okr = be >= 16u && be <= 240u;
          const float scale = okr ? __uint_as_float((261u - be) << 23) : 1.0f;
          const float inv = okr ? __uint_as_float((be - 7u) << 23) : 1.0f;
          u32x4 w; w.x = pk4_fp8(v[0] * scale, v[1] * scale, v[2] * scale, v[3] * scale); w.y = pk4_fp8(v[4] * scale, v[5] * scale, v[6] * scale, v[7] * scale);
          w.z = pk4_fp8(v[8] * scale, v[9] * scale, v[10] * scale, v[11] * scale); w.w = pk4_fp8(v[12] * scale, v[13] * scale, v[14] * scale, v[15] * scale);
          *(u32x4*)(ws + OFF_PV8 + ((size_t)(lane >> 3) * 16384 + e) * 128 + (lane & 7) * 16) = w;
          if (lane == 0) ((float*)(ws + OFF_SCV))[e] = inv;
        }
      }
    }
  }
}

DI void row_stats(const float (&v)[16], float& mean, float& rstd) {
  float s = 0.f;
#pragma unroll
  for (int i = 0; i < 16; ++i) s += v[i];
  mean = wave_sum(s) * (1.0f / 1024.0f);
  float q = 0.f;
#pragma unroll
  for (int i = 0; i < 16; ++i) { const float d = v[i] - mean; q += d * d; }
  rstd = rsqrtf(wave_sum(q) * (1.0f / 1024.0f) + LN_EPS);
}

DI void phase_ln_in(const Params& p) {
  const int lane = otid() & 63, wave = otid() >> 6;
  const float* mod = (const float*)(p.ws + OFF_MOD);
  unsigned* h8 = (unsigned*)(p.ws + OFF_H);
  for (int grp = blockIdx.x; grp < NTOK / NW; grp += gridDim.x) {
    const int row = grp * NW + wave, b = row >> 13;
    const float* xr = p.x + (size_t)row * DM;
    float v[16];
#pragma unroll
    for (int i = 0; i < 4; ++i) { const f32x4 t = *(const f32x4*)(xr + i * 256 + lane * 4); v[4 * i] = t.x; v[4 * i + 1] = t.y; v[4 * i + 2] = t.z; v[4 * i + 3] = t.w; }
    float mean, rstd; row_stats(v, mean, rstd);
    float amax = 0.f;
#pragma unroll
    for (int i = 0; i < 4; ++i) {
      const int col = i * 256 + lane * 4;
      const f32x4 sh = *(const f32x4*)(mod + b * 6144 + col), sc = *(const f32x4*)(mod + b * 6144 + 1024 + col);
      const float o0 = (v[4 * i] - mean) * rstd * (1.f + sc.x) + sh.x, o1 = (v[4 * i + 1] - mean) * rstd * (1.f + sc.y) + sh.y;
      const float o2 = (v[4 * i + 2] - mean) * rstd * (1.f + sc.z) + sh.z, o3 = (v[4 * i + 3] - mean) * rstd * (1.f + sc.w) + sh.w;
      v[4 * i] = o0; v[4 * i + 1] = o1; v[4 * i + 2] = o2; v[4 * i + 3] = o3;
      amax = fmaxf(amax, fmaxf(fmaxf(fabsf(o0), fabsf(o1)), fmaxf(fabsf(o2), fabsf(o3))));
    }
#pragma unroll
    for (int o = 32; o > 0; o >>= 1) amax = fmaxf(amax, __shfl_xor(amax, o));
    const float qs = amax > 0.f ? 127.0f / amax : 0.f;
#pragma unroll
    for (int i = 0; i < 4; ++i) h8[(size_t)row * 256 + i * 64 + lane] = pack_i8x4(v[4 * i] * qs, v[4 * i + 1] * qs, v[4 * i + 2] * qs, v[4 * i + 3] * qs);
    if (lane == 0) ((float*)(p.ws + OFF_SA))[row] = amax * (1.0f / 127.0f);
  }
}

DI void phase_ln_mid(const Params& p) {
  const int lane = otid() & 63, wave = otid() >> 6;
  const float* mod = (const float*)(p.ws + OFF_MOD);
  const bf16_t* y = (const bf16_t*)(p.ws + OFF_Y);
  bf16_t* x1 = (bf16_t*)(p.ws + OFF_X1);
  for (int grp = blockIdx.x; grp < NTOK / NW; grp += gridDim.x) {
    const int row = grp * NW + wave, b = row >> 13;
    const bf16_t* yr = y + (size_t)row * DM;
    float v[16];
#pragma unroll
    for (int i = 0; i < 4; ++i) { const u32x2 t = *(const u32x2*)(yr + i * 256 + lane * 4); v[4 * i] = bflo(t.x); v[4 * i + 1] = bfhi(t.x); v[4 * i + 2] = bflo(t.y); v[4 * i + 3] = bfhi(t.y); }
    float mean, rstd; row_stats(v, mean, rstd);
#pragma unroll
    for (int i = 0; i < 4; ++i) {
      const int col = i * 256 + lane * 4;
      const f32x4 g = *(const f32x4*)(p.ln1_g + col), bb = *(const f32x4*)(p.ln1_b + col);
      f32x4 o;
      o.x = (v[4 * i] - mean) * rstd * g.x + bb.x; o.y = (v[4 * i + 1] - mean) * rstd * g.y + bb.y;
      o.z = (v[4 * i + 2] - mean) * rstd * g.z + bb.z; o.w = (v[4 * i + 3] - mean) * rstd * g.w + bb.w;
      { u32x2 w; w.x = pack2(o.x, o.y); w.y = pack2(o.z, o.w); *(u32x2*)(x1 + (size_t)row * DM + col) = w; }
      v[4 * i] = o.x; v[4 * i + 1] = o.y; v[4 * i + 2] = o.z; v[4 * i + 3] = o.w;
    }
    row_stats(v, mean, rstd);
    float amax = 0.f;
#pragma unroll
    for (int i = 0; i < 4; ++i) {
      const int col = i * 256 + lane * 4;
      const f32x4 sh = *(const f32x4*)(mod + b * 6144 + 3072 + col), sc = *(const f32x4*)(mod + b * 6144 + 4096 + col);
      const float o0 = (v[4 * i] - mean) * rstd * (1.f + sc.x) + sh.x, o1 = (v[4 * i + 1] - mean) * rstd * (1.f + sc.y) + sh.y;
      const float o2 = (v[4 * i + 2] - mean) * rstd * (1.f + sc.z) + sh.z, o3 = (v[4 * i + 3] - mean) * rstd * (1.f + sc.w) + sh.w;
      v[4 * i] = o0; v[4 * i + 1] = o1; v[4 * i + 2] = o2; v[4 * i + 3] = o3;
      amax = fmaxf(amax, fmaxf(fmaxf(fabsf(o0), fabsf(o1)), fmaxf(fabsf(o2), fabsf(o3))));
    }
#pragma unroll
    for (int o = 32; o > 0; o >>= 1) amax = fmaxf(amax, __shfl_xor(amax, o));
    const float qs = amax > 0.f ? 127.0f / amax : 0.f;
    unsigned* h2q = (unsigned*)(p.ws + OFF_H2Q);
#pragma unroll
    for (int i = 0; i < 4; ++i) h2q[(size_t)row * 256 + i * 64 + lane] = pack_i8x4(v[4 * i] * qs, v[4 * i + 1] * qs, v[4 * i + 2] * qs, v[4 * i + 3] * qs);
    if (lane == 0) ((float*)(p.ws + OFF_SH))[row] = amax * (1.0f / 127.0f);
  }
}

namespace pg8 {
constexpr int BM = 256, BK = 64, HALF = 128, HTB = HALF * BK * 2, STAGE_BYTES = 8 * HTB, NXCD = 8, WGM = 8;
DI int lds_byte(int r, int c) { const int st = (r >> 4) * 2 + (c >> 5), rr = r & 15, cc = c & 31, ob = rr * 64 + cc * 2; return st * 1024 + (ob ^ (((ob >> 9) & 1) << 5)); }
DI void stage_rc(int b, int& R, int& C) { const int st = b / 1024, sb = b % 1024, swz = sb ^ (((sb >> 9) & 1) << 5); R = (st >> 1) * 16 + swz / 64; C = (st & 1) * 32 + (swz % 64) / 2; }
DI int perm32(int rho) { const int n = rho >> 4, i = rho & 15; return 8 * (i >> 2) + 4 * n + (i & 3); }
struct Unit { int pm, pn; };
struct Gemm { const bf16_t* A; const bf16_t* Bt; int M, N, K; };
struct StaticOrder {
  int nM, nN, nwg, G, c, nr, rot;
  DI void init(int M, int N, int G_, int c_, bool rotate = false) {
    nM = M / BM; nN = N / BM; nwg = nM * nN; G = G_; c = c_;
    nr = (rotate && nwg % G == 0) ? nwg / G : 0; rot = nr ? ((c % NXCD) * nr) / NXCD : 0;
  }
  DI bool next(int i, Unit& u) const {
    if (nr) { if (i >= nr) return false; i += rot; if (i >= nr) i -= nr; }
    const long L = (long)i * G + c; if (L >= nwg) return false;
    int wgid = (int)L; { const int q = nwg / NXCD, r = nwg % NXCD, xcd = wgid % NXCD, off = wgid / NXCD; wgid = (xcd < r ? xcd * (q + 1) : r * (q + 1) + (xcd - r) * q) + off; }
    const int nig = WGM * nN, gid = wgid / nig, fm = gid * WGM, gsz = (nM - fm) < WGM ? (nM - fm) : WGM;
    u.pm = fm + ((wgid % nig) % gsz); u.pn = (wgid % nig) / gsz; return true;
  }
};

template <int MODE, class AccT>
DI AccT mma_pair(bf16x8 b0, bf16x8 b1, bf16x8 a0, bf16x8 a1, AccT c) {
  if constexpr (MODE == 0) { c = __builtin_amdgcn_mfma_f32_16x16x32_bf16(b0, a0, c, 0, 0, 0); return __builtin_amdgcn_mfma_f32_16x16x32_bf16(b1, a1, c, 0, 0, 0); }
  else if constexpr (MODE == 1) {
    c = __builtin_amdgcn_mfma_i32_16x16x64_i8(__builtin_bit_cast(i32x4, b0), __builtin_bit_cast(i32x4, a0), c, 0, 0, 0);
    return __builtin_amdgcn_mfma_i32_16x16x64_i8(__builtin_bit_cast(i32x4, b1), __builtin_bit_cast(i32x4, a1), c, 0, 0, 0);
  } else {
    const i32x8 B = __builtin_shufflevector(__builtin_bit_cast(i32x4, b0), __builtin_bit_cast(i32x4, b1), 0, 1, 2, 3, 4, 5, 6, 7);
    const i32x8 A = __builtin_shufflevector(__builtin_bit_cast(i32x4, a0), __builtin_bit_cast(i32x4, a1), 0, 1, 2, 3, 4, 5, 6, 7);
    asm volatile("v_mfma_f32_16x16x128_f8f6f4 %0, %1, %2, %0" : "+v"(c) : "v"(B), "v"(A));
    return c;
  }
}
DI f32x4 mma16(bf16x8 a, bf16x8 b, f32x4 c) { return __builtin_amdgcn_mfma_f32_16x16x32_bf16(a, b, c, 0, 0, 0); }
DI i32x4 mma16(bf16x8 a, bf16x8 b, i32x4 c) { return __builtin_amdgcn_mfma_i32_16x16x64_i8(__builtin_bit_cast(i32x4, a), __builtin_bit_cast(i32x4, b), c, 0, 0, 0); }
template <class Epi>
DI void gemm_phase(LAS unsigned char* lds, const Gemm g, const StaticOrder& S, const Epi& E) {
  const int tid = otid(), wid = __builtin_amdgcn_readfirstlane(tid >> 6), lane = tid & 63, wr = wid >> 2, wc = wid & 3, fr = lane & 15, fq = lane >> 4;
  const int K = g.K, nt = K / BK;
  unsigned voffA[2], voffB[2];
#pragma unroll
  for (int i = 0; i < 2; ++i) { int R, C; stage_rc(tid * 16 + i * 8192, R, C); const int Rb = Epi::PERM ? ((R & ~31) + perm32(R & 31)) : R;
    voffA[i] = (unsigned)(R * K + C) * 2u; voffB[i] = (unsigned)(Rb * K + C) * 2u; }
  const size_t kstep = (size_t)(BK * 2);
  const size_t hstep = (size_t)HALF * K * 2;
  const size_t tstep = 2 * hstep;
  const unsigned ldsw = (unsigned)wid * 1024u;
  const int aoff = lds_byte(wr * 64 + fr, fq * 8), boff = lds_byte(wc * 32 + fr, fq * 8);
  LAS unsigned char* ldsB = lds + 4 * HTB + boff;
  asm volatile("" : "+v"(ldsB));
#define PG8_SA(b, h) (((b) * 2 + (h)) * HTB)
#define PG8_SB(b, h) ((4 + (b) * 2 + (h)) * HTB)
#define PG8_STAGE(bufoff, gbase, voff) do { _Pragma("unroll") for (int _i = 0; _i < 2; ++_i) \
    __builtin_amdgcn_global_load_lds((const unsigned*)((const char*)(gbase) + (voff)[_i]), (LAS unsigned*)(lds + (bufoff) + ldsw + _i * 8192), 16, 0, 0); } while (0)
#define PG8_LDA(dst, b, h) do { _Pragma("unroll") for (int m = 0; m < 4; ++m) _Pragma("unroll") for (int k = 0; k < 2; ++k) dst[m][k] = *(const LAS bf16x8*)(lds + PG8_SA(b, h) + aoff + m * 2048 + k * 1024); } while (0)
#define PG8_LDB(dst, b, h) do { _Pragma("unroll") for (int n = 0; n < 2; ++n) _Pragma("unroll") for (int k = 0; k < 2; ++k) dst[n][k] = *(const LAS bf16x8*)(ldsB + ((b) * 2 + (h)) * HTB + n * 2048 + k * 1024); } while (0)
#define PG8_MMA(ai, bj, At, Bt) do { __builtin_amdgcn_s_setprio(1); _Pragma("unroll") for (int m = 0; m < 4; ++m) _Pragma("unroll") for (int n = 0; n < 2; ++n) \
    acc[ai][bj][m][n] = mma_pair<Epi::MODE>(Bt[n][0], Bt[n][1], At[m][0], At[m][1], acc[ai][bj][m][n]); __builtin_amdgcn_s_setprio(0); } while (0)
#define PG8_WAIT_V(n) asm volatile("s_waitcnt vmcnt(" #n ")" ::: "memory")
#define PG8_WAIT_L(n) asm volatile("s_waitcnt lgkmcnt(" #n ")" ::: "memory")
#define PG8_BAR __builtin_amdgcn_s_barrier()
#define PG8_SCHED __builtin_amdgcn_sched_barrier(0)
  Unit cur, nxt; int ui = 0;
  if (!S.next(0, cur)) return;
  typedef typename Epi::AccT AccT;
  const AccT zacc = {0, 0, 0, 0};
  AccT acc[2][2][4][2];
#pragma unroll
  for (int a = 0; a < 2; ++a)
#pragma unroll
    for (int b = 0; b < 2; ++b)
#pragma unroll
      for (int m = 0; m < 4; ++m)
#pragma unroll
        for (int n = 0; n < 2; ++n) acc[a][b][m][n] = zacc;
  bf16x8 At[4][2], B0[2][2], B1[2][2];
  const char* cA = (const char*)g.A + (size_t)cur.pm * tstep; const char* cB = (const char*)g.Bt + (size_t)cur.pn * tstep;
  PG8_STAGE(PG8_SB(0, 0), cB, voffB); PG8_STAGE(PG8_SA(0, 0), cA, voffA); PG8_STAGE(PG8_SB(0, 1), cB + hstep, voffB); PG8_STAGE(PG8_SA(0, 1), cA + hstep, voffA);
  if (wr == 1) PG8_BAR;
  PG8_WAIT_V(4); PG8_BAR;
  PG8_STAGE(PG8_SB(1, 0), cB + kstep, voffB); PG8_STAGE(PG8_SA(1, 0), cA + kstep, voffA); PG8_STAGE(PG8_SB(1, 1), cB + hstep + kstep, voffB);
  PG8_WAIT_V(6); PG8_BAR;
  for (;;) {
    const bool has_next = S.next(ui + 1, nxt);
    const char* nA = has_next ? (const char*)g.A + (size_t)nxt.pm * tstep : cA; const char* nB = has_next ? (const char*)g.Bt + (size_t)nxt.pn * tstep : cB;
#pragma unroll 1
    for (int t = 0; t < nt; t += 2) {
      const bool last = (t == nt - 2);
      const char* a1 = cA + (size_t)(t + 1) * kstep;
      const char* a2 = last ? nA : cA + (size_t)(t + 2) * kstep; const char* b2 = last ? nB : cB + (size_t)(t + 2) * kstep;
      const char* a3 = a2 + kstep; const char* b3 = b2 + kstep;
      PG8_LDB(B0, 0, 0); PG8_SCHED; PG8_LDA(At, 0, 0); PG8_STAGE(PG8_SA(1, 1), a1 + hstep, voffA);
      PG8_WAIT_L(8); PG8_BAR; PG8_WAIT_L(0); PG8_MMA(0, 0, At, B0); PG8_BAR; PG8_SCHED;
      PG8_LDB(B1, 0, 1); PG8_STAGE(PG8_SB(0, 0), b2, voffB);
      PG8_BAR; PG8_WAIT_L(0); PG8_MMA(0, 1, At, B1); PG8_BAR;
      PG8_LDA(At, 0, 1); PG8_STAGE(PG8_SA(0, 0), a2, voffA);
      PG8_BAR; PG8_WAIT_L(0); PG8_MMA(1, 0, At, B0); PG8_BAR; PG8_SCHED;
      PG8_STAGE(PG8_SB(0, 1), b2 + hstep, voffB);
      PG8_WAIT_V(6); PG8_BAR; PG8_MMA(1, 1, At, B1); PG8_BAR;
      PG8_LDB(B0, 1, 0); PG8_SCHED; PG8_LDA(At, 1, 0); PG8_STAGE(PG8_SA(0, 1), a2 + hstep, voffA);
      PG8_WAIT_L(8); PG8_BAR; PG8_WAIT_L(0); PG8_MMA(0, 0, At, B0); PG8_BAR; PG8_SCHED;
      PG8_LDB(B1, 1, 1); PG8_STAGE(PG8_SB(1, 0), b3, voffB);
      PG8_BAR; PG8_WAIT_L(0); PG8_MMA(0, 1, At, B1); PG8_BAR;
      PG8_LDA(At, 1, 1); PG8_STAGE(PG8_SA(1, 0), a3, voffA);
      PG8_BAR; PG8_WAIT_L(0); PG8_MMA(1, 0, At, B0); PG8_BAR; PG8_SCHED;
      PG8_STAGE(PG8_SB(1, 1), b3 + hstep, voffB);
      PG8_WAIT_V(6); PG8_BAR; PG8_MMA(1, 1, At, B1); PG8_BAR;
    }
    PG8_SCHED;
    if constexpr (Epi::MODE == 2) asm volatile("s_nop 15\n\ts_nop 15\n\ts_nop 15\n\ts_nop 15" ::: "memory");
    { const int l2 = otid() & 63; E(acc, cur, wr, wc, l2 & 15, l2 >> 4); }
    PG8_SCHED;
    if (!has_next) break;
#pragma unroll
    for (int a = 0; a < 2; ++a)
#pragma unroll
      for (int b = 0; b < 2; ++b)
#pragma unroll
        for (int m = 0; m < 4; ++m)
#pragma unroll
          for (int n = 0; n < 2; ++n) acc[a][b][m][n] = zacc;
    cur = nxt; cA = nA; cB = nB; ++ui;
  }
  PG8_WAIT_V(0);
  if (wr == 0) PG8_BAR;
  PG8_BAR;
#undef PG8_SA
#undef PG8_SB
#undef PG8_STAGE
#undef PG8_LDA
#undef PG8_LDB
#undef PG8_MMA
#undef PG8_WAIT_V
#undef PG8_WAIT_L
#undef PG8_BAR
#undef PG8_SCHED
}
}

struct EpiProj {
  static constexpr bool PERM = true;
  static constexpr int MODE = 1;
  typedef i32x4 AccT;
  char* ws; const float* b_merge;
  DI void operator()(const i32x4 (&acc)[2][2][4][2], const pg8::Unit& u, int wr, int wc, int fr, int fq) const {
    const float* rope = (const float*)(ws + OFF_ROPE);
    const float* sa = (const float*)(ws + OFF_SA); const float* sw = (const float*)(ws + OFF_SCW1);
    const int row0 = u.pm * 256 + wr * 64 + fr;
#pragma unroll
    for (int bj = 0; bj < 2; ++bj) {
      const int cg = u.pn * 256 + bj * 128 + wc * 32;
      const int c0 = cg + 8 * fq;
      if (cg >= 4384) continue;
      const float sbg = sw[cg >> 5];
#define EPJ_CV(sc_) const float f_ = sa[row] * (sc_); const f32x4 cv0 = __builtin_convertvector(acc[ai][bj][m][0], f32x4) * f_, cv1 = __builtin_convertvector(acc[ai][bj][m][1], f32x4) * f_;
      if (cg < 1280 && (cg < 640 || (cg >= 768 && cg < 896) || (cg >= 1024 && cg < 1152))) {
        bf16_t* dst; unsigned ld, cofs; float scale = 1.0f;
        if (cg < 512) { dst = (bf16_t*)(ws + OFF_Q); ld = 512; cofs = c0; scale = 0.18033688011112042f; }
        else if (cg < 640) { dst = (bf16_t*)(ws + OFF_KC); ld = 128; cofs = c0 - 512; }
        else if (cg < 896) { dst = (bf16_t*)(ws + OFF_KS); ld = 128; cofs = c0 - 768; }
        else { dst = (bf16_t*)(ws + OFF_KW); ld = 128; cofs = c0 - 1024; }
        const int d0 = 16 * ((cg >> 5) & 1) + 4 * fq;
#pragma unroll
        for (int ai = 0; ai < 2; ++ai)
#pragma unroll
          for (int m = 0; m < 4; ++m) {
            const int row = row0 + ai * 128 + m * 16, pos = row & (SEQ - 1);
            const f32x4 cs = *(const f32x4*)(rope + pos * 32 + d0), sn = *(const f32x4*)(rope + 262144 + pos * 32 + d0);
            EPJ_CV(sbg * scale)
            const f32x4 o1 = cv0 * cs - cv1 * sn, o2 = cv0 * sn + cv1 * cs;
            u32x4 w; w.x = pack2(o1.x, o1.y); w.y = pack2(o1.z, o1.w); w.z = pack2(o2.x, o2.y); w.w = pack2(o2.z, o2.w);
            *(u32x4*)(dst + (unsigned)row * ld + cofs) = w;
          }
      } else if (cg < 1280) {
        bf16_t* dst; unsigned cofs;
        if (cg < 768) { dst = (bf16_t*)(ws + OFF_VC); cofs = c0 - 640; }
        else if (cg < 1024) { dst = (bf16_t*)(ws + OFF_VS); cofs = c0 - 896; }
        else { dst = (bf16_t*)(ws + OFF_VW); cofs = c0 - 1152; }
#pragma unroll
        for (int ai = 0; ai < 2; ++ai)
#pragma unroll
          for (int m = 0; m < 4; ++m) {
            const int row = row0 + ai * 128 + m * 16;
            EPJ_CV(sbg)
            const f32x4 a = cv0, b = cv1;
            u32x4 w; w.x = pack2(a.x, a.y); w.y = pack2(a.z, a.w); w.z = pack2(b.x, b.y); w.w = pack2(b.z, b.w);
            *(u32x4*)(dst + (unsigned)row * 128u + cofs) = w;
          }
      } else if (cg < 2304) {
        bf16_t* dst = (bf16_t*)(ws + (cg < 1792 ? OFF_U : OFF_V));
        const unsigned cofs = c0 - (cg < 1792 ? 1280 : 1792);
#pragma unroll
        for (int ai = 0; ai < 2; ++ai)
#pragma unroll
          for (int m = 0; m < 4; ++m) {
            const int row = row0 + ai * 128 + m * 16;
            EPJ_CV(sbg)
            const f32x4 a = cv0, b = cv1;
            const f32x2 g0 = gelu_pk((f32x2){a.x, a.y}), g1 = gelu_pk((f32x2){a.z, a.w}), g2 = gelu_pk((f32x2){b.x, b.y}), g3 = gelu_pk((f32x2){b.z, b.w});
            u32x4 w; w.x = pack2(g0.x, g0.y); w.y = pack2(g1.x, g1.y); w.z = pack2(g2.x, g2.y); w.w = pack2(g3.x, g3.y);
            *(u32x4*)(dst + (unsigned)row * 512u + cofs) = w;
          }
      } else if (cg < 4352) {
        unsigned char* dst = (unsigned char*)(ws + OFF_GATE8);
        const unsigned cofs = c0 - 2304;
        const f32x4 b0 = *(const f32x4*)(b_merge + cofs), b1 = *(const f32x4*)(b_merge + cofs + 4);
#pragma unroll
        for (int ai = 0; ai < 2; ++ai)
#pragma unroll
          for (int m = 0; m < 4; ++m) {
            const int row = row0 + ai * 128 + m * 16;
            EPJ_CV(sbg)
            const f32x4 a = cv0 + b0, b = cv1 + b1;
            u32x2 w; w.x = pk4_fp8(sigmoid_f(a.x), sigmoid_f(a.y), sigmoid_f(a.z), sigmoid_f(a.w));
            w.y = pk4_fp8(sigmoid_f(b.x), sigmoid_f(b.y), sigmoid_f(b.z), sigmoid_f(b.w));
            *(u32x2*)(dst + (unsigned)row * 2048u + cofs) = w;
          }
      } else {
        float* gs = (float*)(ws + OFF_GSIG);
        if (fq < 3) {
#pragma unroll
          for (int ai = 0; ai < 2; ++ai)
#pragma unroll
            for (int m = 0; m < 4; ++m) {
              const int row = row0 + ai * 128 + m * 16;
              EPJ_CV(sbg)
              const f32x4 a = cv0, b = cv1;
              f32x4 o0, o1; o0.x = sigmoid_f(a.x); o0.y = sigmoid_f(a.y); o0.z = sigmoid_f(a.z); o0.w = sigmoid_f(a.w);
              o1.x = sigmoid_f(b.x); o1.y = sigmoid_f(b.y); o1.z = sigmoid_f(b.z); o1.w = sigmoid_f(b.w);
              *(f32x4*)(gs + (unsigned)row * 32u + 8 * fq) = o0; *(f32x4*)(gs + (unsigned)row * 32u + 8 * fq + 4) = o1;
            }
        }
      }
    }
  }
};
DI void phase_gemm1(const Params& p, char* smem) {
  pg8::Gemm g{(const bf16_t*)(p.ws + OFF_H), (const bf16_t*)(p.ws + OFF_WT1), NTOK, N1, 512};
  pg8::StaticOrder S; S.init(NTOK, N1, gridDim.x, blockIdx.x, true);
  EpiProj E{p.ws, p.b_merge};
  pg8::gemm_phase((LAS unsigned char*)smem, g, S, E);
}

template <int BR> struct EpiMerge {
  static constexpr bool PERM = true;
  static constexpr int MODE = 2;
  typedef f32x4 AccT;
  char* ws;
  DI void operator()(const f32x4 (&acc)[2][2][4][2], const pg8::Unit& u, int wr, int wc, int fr, int fq) const {
    const unsigned char* gate = (const unsigned char*)(ws + OFF_GATE8);
    unsigned char* m0 = (unsigned char*)(ws + OFF_M08);
    unsigned char* mrg = (unsigned char*)(ws + OFF_MRG8);
    const float* sw = (const float*)(ws + OFF_SCWB) + BR * 32;
    const int row0 = u.pm * 256 + wr * 64 + fr;
#pragma unroll
    for (int bj = 0; bj < 2; ++bj) {
      const unsigned cgp = u.pn * 256 + bj * 128 + wc * 32, c0 = cgp + 8 * fq;
      const float f = sw[cgp >> 5] * (BR == 0 ? 1.0f : 2.0f);
#pragma unroll
      for (int ai = 0; ai < 2; ++ai)
#pragma unroll
        for (int m = 0; m < 4; ++m) {
          const unsigned row = row0 + ai * 128 + m * 16;
          float gg[8]; unpack8_fp8(*(const u32x2*)(gate + row * 2048u + BR * 1024 + c0), gg);
          const f32x4 a = acc[ai][bj][m][0] * f, b = acc[ai][bj][m][1] * f;
          float v[8] = {a.x * gg[0], a.y * gg[1], a.z * gg[2], a.w * gg[3], b.x * gg[4], b.y * gg[5], b.z * gg[6], b.w * gg[7]};
          if (BR == 1) {
            float old[8]; unpack8_fp8(*(const u32x2*)(m0 + row * 1024u + c0), old);
#pragma unroll
            for (int j = 0; j < 8; ++j) v[j] += old[j];
          }
#pragma unroll
          for (int j = 0; j < 8; ++j) v[j] = clamp_f8(v[j]);
          u32x2 w; w.x = pk4_fp8(v[0], v[1], v[2], v[3]); w.y = pk4_fp8(v[4], v[5], v[6], v[7]);
          *(u32x2*)((BR == 0 ? m0 : mrg) + row * 1024u + c0) = w;
        }
    }
  }
};
DI void phase_merge(const Params& p, char* smem) {
  pg8::StaticOrder S; S.init(NTOK, 1024, gridDim.x, blockIdx.x);
  {
    pg8::Gemm g{(const bf16_t*)(p.ws + OFF_ONSA8), (const bf16_t*)(p.ws + OFF_WB), NTOK, 1024, 256};
    EpiMerge<0> E{p.ws};
    pg8::gemm_phase((LAS unsigned char*)smem, g, S, E);
  }
  {
    pg8::Gemm g{(const bf16_t*)(p.ws + OFF_OSGU8), (const bf16_t*)(p.ws + OFF_WB + (size_t)1024 * 512), NTOK, 1024, 256};
    EpiMerge<1> E{p.ws};
    pg8::gemm_phase((LAS unsigned char*)smem, g, S, E);
  }
}

struct EpiOut {
  static constexpr bool PERM = true;
  static constexpr int MODE = 2;
  typedef f32x4 AccT;
  char* ws; const float* x;
  DI void operator()(const f32x4 (&acc)[2][2][4][2], const pg8::Unit& u, int wr, int wc, int fr, int fq) const {
    const float* mod = (const float*)(ws + OFF_MOD);
    bf16_t* y = (bf16_t*)(ws + OFF_Y);
    const int row0 = u.pm * 256 + wr * 64 + fr, b = (u.pm * 256) >> 13;
#pragma unroll
    for (int bj = 0; bj < 2; ++bj) {
      const unsigned c0 = u.pn * 256 + bj * 128 + wc * 32 + 8 * fq;
      const float f = ((const float*)(ws + OFF_SCWO))[c0 >> 5] * 0.0625f;
      const f32x4 g0 = *(const f32x4*)(mod + b * 6144 + 2048 + c0) * f, g1 = *(const f32x4*)(mod + b * 6144 + 2048 + c0 + 4) * f;
#pragma unroll
      for (int ai = 0; ai < 2; ++ai)
#pragma unroll
        for (int m = 0; m < 4; ++m) {
          const unsigned o = (unsigned)(row0 + ai * 128 + m * 16) * 1024u + c0;
          const f32x4 x0 = *(const f32x4*)(x + o), x1v = *(const f32x4*)(x + o + 4);
          const f32x4 v0 = x0 * DN_ALPHA + g0 * acc[ai][bj][m][0], v1 = x1v * DN_ALPHA + g1 * acc[ai][bj][m][1];
          u32x4 w; w.x = pack2(v0.x, v0.y); w.y = pack2(v0.z, v0.w); w.z = pack2(v1.x, v1.y); w.w = pack2(v1.z, v1.w);
          *(u32x4*)(y + o) = w;
        }
    }
  }
};
DI void phase_outproj(const Params& p, char* smem) {
  pg8::Gemm g{(const bf16_t*)(p.ws + OFF_MRG8), (const bf16_t*)(p.ws + OFF_WOUT), NTOK, 1024, 512};
  pg8::StaticOrder S; S.init(NTOK, 1024, gridDim.x, blockIdx.x);
  EpiOut E{p.ws, p.x};
  pg8::gemm_phase((LAS unsigned char*)smem, g, S, E);
}

struct EpiPq {
  static constexpr bool PERM = true;
  static constexpr int MODE = 1;
  typedef i32x4 AccT;
  char* ws;
  DI void operator()(const i32x4 (&acc)[2][2][4][2], const pg8::Unit& u, int wr, int wc, int fr, int fq) const {
    bf16_t* pq = (bf16_t*)(ws + OFF_PQ);
    const float* sh = (const float*)(ws + OFF_SH); const float* sq = (const float*)(ws + OFF_SCWQ);
    const int row0 = u.pm * 256 + wr * 64 + fr;
#pragma unroll
    for (int bj = 0; bj < 2; ++bj) {
      const unsigned c0 = u.pn * 256 + bj * 128 + wc * 32 + 8 * fq;
      const float sbg = sq[(u.pn * 256 + bj * 128 + wc * 32) >> 5];
#pragma unroll
      for (int ai = 0; ai < 2; ++ai)
#pragma unroll
        for (int m = 0; m < 4; ++m) {
          const float f_ = sh[row0 + ai * 128 + m * 16] * sbg;
          const f32x4 a = __builtin_convertvector(acc[ai][bj][m][0], f32x4) * f_, b = __builtin_convertvector(acc[ai][bj][m][1], f32x4) * f_;
          u32x4 w; w.x = pack2(a.x, a.y); w.y = pack2(a.z, a.w); w.z = pack2(b.x, b.y); w.w = pack2(b.z, b.w);
          *(u32x4*)(pq + (unsigned)(row0 + ai * 128 + m * 16) * 2048u + c0) = w;
        }
    }
  }
};
DI void phase_peerq(const Params& p, char* smem) {
  pg8::Gemm g{(const bf16_t*)(p.ws + OFF_H2Q), (const bf16_t*)(p.ws + OFF_WQ), NTOK, 2048, 512};
  pg8::StaticOrder S; S.init(NTOK, 2048, gridDim.x, blockIdx.x);
  EpiPq E{p.ws};
  pg8::gemm_phase((LAS unsigned char*)smem, g, S, E);
}

DI void phase_sgu(const Params& p, char* smem) {
  char* ws = p.ws;
  const int tid = otid(), lane = tid & 63, wave = tid >> 6, l31 = lane & 31, hh = lane >> 5;
  const bf16_t* u = (const bf16_t*)(ws + OFF_U);
  const bf16_t* v = (const bf16_t*)(ws + OFF_V);
  const bf16_t* W = (const bf16_t*)(ws + OFF_SGUW);
  float* st = (float*)smem;
  bf16_t* vn = (bf16_t*)(smem + 1024);
  constexpr int LN_ = 72;
  const int dt = wave & 1, it = wave >> 1;
  const int gi = lane >> 4, i16 = lane & 15, tq = i16 >> 2, tp = i16 & 3;
  for (int item = blockIdx.x; item < NTOK / 128; item += gridDim.x) {
    const int t0 = item * 128;
    __syncthreads();
    for (int i = 0; i < 16; ++i) {
      const int t = wave * 16 + i;
      const u32x4 raw = *(const u32x4*)(v + (size_t)(t0 + t) * 512 + lane * 8);
      float f[8]; unpack8(raw, f);
      float s = 0.f;
#pragma unroll
      for (int j = 0; j < 8; ++j) s += f[j];
      const float mean = wave_sum(s) * (1.f / 512.f);
      float q = 0.f;
#pragma unroll
      for (int j = 0; j < 8; ++j) { const float d = f[j] - mean; q += d * d; }
      const float rstd = rsqrtf(wave_sum(q) * (1.f / 512.f) + LN_EPS);
      if (lane == 0) { st[t * 2] = mean; st[t * 2 + 1] = rstd; }
    }
    u32x4 vnext[2];
#pragma unroll
    for (int i = 0; i < 2; ++i) { const int idx = tid + i * NT; vnext[i] = *(const u32x4*)(v + (size_t)(t0 + (idx >> 3)) * 512 + (idx & 7) * 8); }
    for (int g = 0; g < 8; ++g) {
      u32x4 vcur[2] = {vnext[0], vnext[1]};
      if (g + 1 < 8) {
#pragma unroll
        for (int i = 0; i < 2; ++i) { const int idx = tid + i * NT; vnext[i] = *(const u32x4*)(v + (size_t)(t0 + (idx >> 3)) * 512 + (g + 1) * 64 + (idx & 7) * 8); }
      }
      u32x2 uold[4];
      {
        const bf16_t* urow0 = u + (size_t)(t0 + it * 32 + l31) * 512 + g * 64 + dt * 32 + 4 * hh;
#pragma unroll
        for (int q4 = 0; q4 < 4; ++q4) uold[q4] = *(const u32x2*)(urow0 + 8 * q4);
      }
      lds_barrier();
#pragma unroll
      for (int i = 0; i < 2; ++i) {
        const int idx = tid + i * NT, j = idx >> 3, dc = (idx & 7) * 8;
        const u32x4 raw = vcur[i];
        const float mean = st[j * 2], rstd = st[j * 2 + 1];
        float f[8], gg[8], bb[8]; unpack8(raw, f); ld8(p.sgu_ln_g + g * 64 + dc, gg); ld8(p.sgu_ln_b + g * 64 + dc, bb);
#pragma unroll
        for (int k = 0; k < 8; ++k) f[k] = (f[k] - mean) * rstd * gg[k] + bb[k];
        *(u32x4*)(vn + j * LN_ + dc) = pack8(f);
      }
      lds_barrier();
      f32x16 acc;
#pragma unroll
      for (int r = 0; r < 16; ++r) acc[r] = 0.f;
      const bf16_t* wrow = W + ((size_t)g * 128 + it * 32 + l31) * 128 + hh * 8;
      const LAS bf16_t* vbase = (const LAS bf16_t*)vn + (8 * (gi >> 1) + tq) * LN_ + dt * 32 + 16 * (gi & 1) + 4 * tp;
#pragma unroll
      for (int ks = 0; ks < 8; ++ks) {
        if (ks <= 2 * it + 1) {
          const LAS bf16_t* vp = vbase + (ks * 16) * LN_;
          const s16x4 lo = __builtin_amdgcn_ds_read_tr16_b64_v4i16((LAS s16x4*)vp);
          const s16x4 hi = __builtin_amdgcn_ds_read_tr16_b64_v4i16((LAS s16x4*)(vp + 4 * LN_));
          const bf16x8 bw = *(const bf16x8*)(wrow + ks * 16);
          acc = MFMA32(__builtin_shufflevector(lo, hi, 0, 1, 2, 3, 4, 5, 6, 7), bw, acc);
        }
      }
      const int i = it * 32 + l31;
      const float bsv = p.sgu_b[g * 128 + i];
      unsigned char* orow = (unsigned char*)(ws + OFF_OSGU8) + (size_t)(t0 + i) * 512 + g * 64 + dt * 32 + 4 * hh;
#pragma unroll
      for (int q4 = 0; q4 < 4; ++q4) {
        const u32x2 old = uold[q4];
        *(unsigned*)(orow + 8 * q4) = pk4_fp8(clamp_f8(8.0f * bflo(old.x) * (acc[4 * q4] + bsv)), clamp_f8(8.0f * bfhi(old.x) * (acc[4 * q4 + 1] + bsv)),
                                              clamp_f8(8.0f * bflo(old.y) * (acc[4 * q4 + 2] + bsv)), clamp_f8(8.0f * bfhi(old.y) * (acc[4 * q4 + 3] + bsv)));
      }
    }
  }
}

DI void phase_compress(const Params& p, char* smem) {
  char* ws = p.ws;
  const int tid = otid(), lane = tid & 63, wave = tid >> 6, l31 = lane & 31, hh = lane >> 5;
  bf16_t* hid = (bf16_t*)smem;
  constexpr int LH = 136;
  for (int item = blockIdx.x; item < 128; item += gridDim.x) {
    const int w = item >> 6, R0 = (item & 63) * 128;
    const bf16_t* src = (const bf16_t*)(ws + (w == 0 ? OFF_KC : OFF_VC));
    const bf16_t* W1 = (const bf16_t*)(ws + OFF_CW1) + (size_t)w * 128 * 2048;
    const bf16_t* W2 = (const bf16_t*)(ws + OFF_CW2) + (size_t)w * 64 * 128;
    const float* posb = (const float*)(ws + OFF_POSB) + w * 128;
    const int rg = wave >> 2, cgp = wave & 3;
    const bf16_t* abase[2];
#pragma unroll
    for (int mi = 0; mi < 2; ++mi) {
      const int R = R0 + rg * 64 + mi * 32 + l31, bg = R >> 9, n = R & 511, nn = n < 510 ? n : 510;
      abase[mi] = src + ((size_t)((bg >> 1) * SEQ + 16 * nn)) * 128 + (bg & 1) * 64 + hh * 8;
    }
    const bf16_t* bbase = W1 + (size_t)(cgp * 32 + l31) * 2048 + hh * 8;
    f32x16 acc[2];
#pragma unroll
    for (int r = 0; r < 16; ++r) { acc[0][r] = 0.f; acc[1][r] = 0.f; }
#pragma unroll 8
    for (int ks = 0; ks < 128; ++ks) {
      const int aofs = (ks >> 2) * 128 + (ks & 3) * 16;
      const bf16x8 a0 = *(const bf16x8*)(abase[0] + aofs), a1 = *(const bf16x8*)(abase[1] + aofs);
      const bf16x8 bb = *(const bf16x8*)(bbase + ks * 16);
      acc[0] = MFMA32(a0, bb, acc[0]); acc[1] = MFMA32(a1, bb, acc[1]);
    }
    __syncthreads();
    {
      const float pb = posb[cgp * 32 + l31];
#pragma unroll
      for (int mi = 0; mi < 2; ++mi)
#pragma unroll
        for (int r = 0; r < 16; ++r) {
          const int row = rg * 64 + mi * 32 + (r & 3) + 8 * (r >> 2) + 4 * hh;
          hid[row * LH + cgp * 32 + l31] = f2bf(gelu_f(acc[mi][r] + pb));
        }
    }
    __syncthreads();
    const int mi2 = wave >> 1, ni = wave & 1;
    f32x16 o;
#pragma unroll
    for (int r = 0; r < 16; ++r) o[r] = 0.f;
#pragma unroll
    for (int ks = 0; ks < 8; ++ks) {
      const bf16x8 a = *(const bf16x8*)(hid + (mi2 * 32 + l31) * LH + ks * 16 + hh * 8);
      const bf16x8 bb = *(const bf16x8*)(W2 + (size_t)(ni * 32 + l31) * 128 + ks * 16 + hh * 8);
      o = MFMA32(a, bb, o);
    }
    const int d = ni * 32 + l31;
    const float b2 = p.cmp_b2[w * 64 + (w == 0 ? dperm(d) : d)];
    const int bg = R0 >> 9;
    bf16_t* dst = (bf16_t*)(ws + (w == 0 ? OFF_KCMP : OFF_VCMP));
#pragma unroll
    for (int r = 0; r < 16; ++r) {
      const int n = (R0 & 511) + mi2 * 32 + (r & 3) + 8 * (r >> 2) + 4 * hh;
      dst[((size_t)bg * 512 + n) * 64 + d] = f2bf(n < 511 ? o[r] + b2 : 0.f);
    }
  }
}

constexpr int LK = 72;
constexpr int NSA_TILE = 18432;
constexpr int NSA_AIMP = 3 * NSA_TILE, NSA_CIMP = NSA_AIMP + 32768, NSA_SELM = NSA_CIMP + 32768;
constexpr float NSA_THR = 6.0f;
struct TileRegs { u32x4 k; u32x4 v; };

DI void nsa_load_tile(TileRegs& t, const bf16_t* kbase, size_t kstride, const bf16_t* vbase, size_t vstride) {
  const int tid = otid(), r = tid >> 3, ch = tid & 7;
  t.k = *(const u32x4*)(kbase + (size_t)r * kstride + ch * 8);
  t.v = *(const u32x4*)(vbase + (size_t)r * vstride + ch * 8);
}
DI void nsa_store_tile(const TileRegs& t, char* tile) {
  const int tid = otid(), r = tid >> 3, ch = tid & 7;
  *(u32x4*)((bf16_t*)tile + r * LK + ch * 8) = t.k;
  *(u32x4*)((bf16_t*)(tile + 9216) + r * LK + ch * 8) = t.v;
}
DI void nsa_scores(f32x16 (&st)[2], const char* tile, const bf16x8 (&qf)[4], int lane) {
  const bf16_t* Ks = (const bf16_t*)tile;
#pragma unroll
  for (int kt = 0; kt < 2; ++kt)
#pragma unroll
    for (int r = 0; r < 16; ++r) st[kt][r] = 0.f;
  __builtin_amdgcn_s_setprio(1);
#pragma unroll
  for (int ks = 0; ks < 4; ++ks)
#pragma unroll
    for (int kt = 0; kt < 2; ++kt) {
      const bf16x8 a = *(const bf16x8*)(Ks + (kt * 32 + (lane & 31)) * LK + ks * 16 + (lane >> 5) * 8);
      st[kt] = MFMA32(a, qf[ks], st[kt]);
    }
  __builtin_amdgcn_s_setprio(0);
}
DI void nsa_pv(f32x16 (&o)[2], const f32x16 (&pt)[2], const char* tile, int lane) {
  const int gi = lane >> 4, i16 = lane & 15, q = i16 >> 2, pp = i16 & 3;
  const LAS bf16_t* Vs = (const LAS bf16_t*)(tile + 9216) + (4 * (gi >> 1) + q) * LK + 16 * (gi & 1) + 4 * pp;
#pragma unroll
  for (int kt = 0; kt < 2; ++kt)
#pragma unroll
    for (int s = 0; s < 2; ++s) {
      u32x4 pk; pk.x = pack2(pt[kt][8 * s], pt[kt][8 * s + 1]); pk.y = pack2(pt[kt][8 * s + 2], pt[kt][8 * s + 3]);
      pk.z = pack2(pt[kt][8 * s + 4], pt[kt][8 * s + 5]); pk.w = pack2(pt[kt][8 * s + 6], pt[kt][8 * s + 7]);
      const bf16x8 pb = __builtin_bit_cast(bf16x8, pk);
      bf16x8 a[2];
#pragma unroll
      for (int dt = 0; dt < 2; ++dt) {
        const LAS bf16_t* vp = Vs + (kt * 32 + 16 * s) * LK + dt * 32;
        const s16x4 lo = __builtin_amdgcn_ds_read_tr16_b64_v4i16((LAS s16x4*)vp);
        const s16x4 hi = __builtin_amdgcn_ds_read_tr16_b64_v4i16((LAS s16x4*)(vp + 8 * LK));
        a[dt] = __builtin_shufflevector(lo, hi, 0, 1, 2, 3, 4, 5, 6, 7);
      }
      o[0] = MFMA32(a[0], pb, o[0]); o[1] = MFMA32(a[1], pb, o[1]);
    }
}

constexpr float NSA_NEG = -3.0e38f;
DI void nsa_online(f32x16 (&st)[2], bool sel, float& m, float& l, f32x16 (&o)[2], const char* tile, int lane) {
  float mx = NSA_NEG;
#pragma unroll
  for (int r = 0; r < 16; ++r) mx = fmaxf(mx, fmaxf(st[0][r], st[1][r]));
  mx = fmaxf(mx, xor32f(mx, lane));
  mx = sel ? mx : NSA_NEG;
  if (__any(mx > m + NSA_THR)) {
    const float mn = fmaxf(m, mx);
    const float alpha = __builtin_amdgcn_exp2f(m - mn);
    m = mn; l *= alpha;
#pragma unroll
    for (int r = 0; r < 16; ++r) { o[0][r] *= alpha; o[1][r] *= alpha; }
  }
  const float ms = sel ? m : 1e30f;
  float sum = 0.f;
#pragma unroll
  for (int r = 0; r < 16; ++r) {
    const float p0 = __builtin_amdgcn_exp2f(st[0][r] - ms), p1 = __builtin_amdgcn_exp2f(st[1][r] - ms);
    st[0][r] = p0; st[1][r] = p1; sum += p0 + p1;
  }
  l += sum;
  nsa_pv(o, st, tile, lane);
}

struct NsaItem { int qb, b, g, bg, t; size_t tokrow; };
DI NsaItem nsa_item(int item0, int wave, int qi) {
  const int G = gridDim.x, k = item0 / G, bb = item0 - k * G;
  const int item = (k & 1) ? (k * G + (G - 1 - bb)) : item0;
  NsaItem it; it.qb = 127 - (item >> 4); const int rest = item & 15; it.b = rest >> 1; it.g = rest & 1;
  it.bg = it.b * 2 + it.g; it.t = it.qb * 64 + wave * 8 + qi; it.tokrow = (size_t)it.b * SEQ + it.t; return it;
}
DI void nsa_accum_store(bf16_t* dst, const f32x16 (&o)[2], float sc, bool first, int hh, unsigned char* dst8 = nullptr) {
#pragma unroll
  for (int dt = 0; dt < 2; ++dt)
#pragma unroll
    for (int q4 = 0; q4 < 4; ++q4) {
      u32x2* pp = (u32x2*)(dst + dt * 32 + 8 * q4 + 4 * hh);
      float a0 = sc * o[dt][4 * q4], a1 = sc * o[dt][4 * q4 + 1], a2 = sc * o[dt][4 * q4 + 2], a3 = sc * o[dt][4 * q4 + 3];
      if (!first) { const u32x2 old = *pp; a0 += bflo(old.x); a1 += bfhi(old.x); a2 += bflo(old.y); a3 += bfhi(old.y); }
      if (dst8) *(unsigned*)(dst8 + dt * 32 + 8 * q4 + 4 * hh) = pk4_fp8(clamp_f8(16.0f * a0), clamp_f8(16.0f * a1), clamp_f8(16.0f * a2), clamp_f8(16.0f * a3));
      else { u32x2 wv; wv.x = pack2(a0, a1); wv.y = pack2(a2, a3); *pp = wv; }
    }
}

constexpr int NSA_STAGE = 4 * 18432;
typedef float f32x4v __attribute__((ext_vector_type(4)));
#define MFMA16(a, b, c) __builtin_amdgcn_mfma_f32_16x16x32_bf16((a), (b), (c), 0, 0, 0)
struct StageRegs { u32x4 r[8]; };
DI void nsa_load_stage(StageRegs& sr, const bf16_t* kb, const bf16_t* vb, int j0s, int qb) {
  const int tid = otid(), r = tid >> 3, ch = tid & 7;
#pragma unroll
  for (int tt = 0; tt < 4; ++tt) {
    const int j = (j0s + tt <= qb) ? j0s + tt : qb;
    sr.r[2 * tt] = *(const u32x4*)(kb + ((size_t)j * 64 + r) * 128 + ch * 8);
    sr.r[2 * tt + 1] = *(const u32x4*)(vb + ((size_t)j * 64 + r) * 128 + ch * 8);
  }
}
DI void nsa_store_stage(const StageRegs& sr, char* stage) {
  const int tid = otid(), r = tid >> 3, ch = tid & 7;
#pragma unroll
  for (int tt = 0; tt < 4; ++tt) {
    *(u32x4*)((bf16_t*)(stage + tt * 18432) + r * LK + ch * 8) = sr.r[2 * tt];
    *(u32x4*)((bf16_t*)(stage + tt * 18432 + 9216) + r * LK + ch * 8) = sr.r[2 * tt + 1];
  }
}
struct Sel16 { float m; bool has; f32x4v o[4], ol; };
DI void nsa_unit16(Sel16& g, const char* tile, const bf16x8 (&qf)[2], bool sel, int klim  , int lane) {
  const int c16 = lane & 15, kg = lane >> 4, tq = c16 >> 2, tp = c16 & 3;
  const bf16_t* Ks = (const bf16_t*)tile + c16 * LK + kg * 8;
  f32x4v st[4];
  const float ini = sel ? -g.m : -1e30f;
#pragma unroll
  for (int kt = 0; kt < 4; ++kt) {
    st[kt] = (f32x4v){ini, ini, ini, ini};
#pragma unroll
    for (int ks = 0; ks < 2; ++ks) st[kt] = MFMA16(*(const bf16x8*)(Ks + kt * 16 * LK + ks * 32), qf[ks], st[kt]);
  }
  if (klim < 64) {
#pragma unroll
    for (int kt = 0; kt < 4; ++kt)
#pragma unroll
      for (int r = 0; r < 4; ++r) st[kt][r] = (kt * 16 + 4 * kg + r <= klim) ? st[kt][r] : NSA_NEG;
  }
  float mx = fmaxf(fmaxf(st[0][0], st[0][1]), st[0][2]);
  mx = fmaxf(fmaxf(mx, st[0][3]), st[1][0]); mx = fmaxf(fmaxf(mx, st[1][1]), st[1][2]); mx = fmaxf(fmaxf(mx, st[1][3]), st[2][0]);
  mx = fmaxf(fmaxf(mx, st[2][1]), st[2][2]); mx = fmaxf(fmaxf(mx, st[2][3]), st[3][0]); mx = fmaxf(fmaxf(mx, st[3][1]), st[3][2]); mx = fmaxf(mx, st[3][3]);
  mx = fmaxf(mx, xor16f(mx, lane));
  mx = fmaxf(mx, xor32f(mx, lane));
  const bool real = mx > -1e29f;
  const bool fresh = !g.has && real, up = g.has && (mx > NSA_THR);
  if (__any(fresh || up)) {
    const float delta = (fresh || up) ? mx : 0.f;
    const float alpha = up ? __builtin_amdgcn_exp2f(-delta) : 1.0f;
    g.m += delta; g.ol *= alpha;
#pragma unroll
    for (int dt = 0; dt < 4; ++dt) g.o[dt] *= alpha;
#pragma unroll
    for (int kt = 0; kt < 4; ++kt) st[kt] -= delta;
  }
  g.has = g.has || real;
#pragma unroll
  for (int kt = 0; kt < 4; ++kt)
#pragma unroll
    for (int r = 0; r < 4; ++r) st[kt][r] = __builtin_amdgcn_exp2f(st[kt][r]);
  const bf16x8 ones = {16256, 16256, 16256, 16256, 16256, 16256, 16256, 16256};
  const LAS bf16_t* Vs = (const LAS bf16_t*)(tile + 9216) + (4 * kg + tq) * LK + 4 * tp;
#pragma unroll
  for (int kp = 0; kp < 2; ++kp) {
    u32x4 pk; pk.x = pack2(st[2 * kp][0], st[2 * kp][1]); pk.y = pack2(st[2 * kp][2], st[2 * kp][3]);
    pk.z = pack2(st[2 * kp + 1][0], st[2 * kp + 1][1]); pk.w = pack2(st[2 * kp + 1][2], st[2 * kp + 1][3]);
    const bf16x8 pb = __builtin_bit_cast(bf16x8, pk);
    g.ol = MFMA16(ones, pb, g.ol);
#pragma unroll
    for (int dt = 0; dt < 4; ++dt) {
      const LAS bf16_t* vp = Vs + (2 * kp) * 16 * LK + dt * 16;
      const s16x4 lo = __builtin_amdgcn_ds_read_tr16_b64_v4i16((LAS s16x4*)vp);
      const s16x4 hi = __builtin_amdgcn_ds_read_tr16_b64_v4i16((LAS s16x4*)(vp + 16 * LK));
      g.o[dt] = MFMA16(__builtin_shufflevector(lo, hi, 0, 1, 2, 3, 4, 5, 6, 7), pb, g.o[dt]);
    }
  }
}
DI void nsa_sel16(const Params& p, char* smem, bool dry) {
  char* ws = p.ws;
  const int tid = otid(), lane = tid & 63, wave = tid >> 6, c16 = lane & 15, kg = lane >> 4, qi4 = c16 >> 2, r4 = c16 & 3;
  const bf16_t* Q = (const bf16_t*)(ws + OFF_Q);
  const float* gsig = (const float*)(ws + OFF_GSIG);
  bf16_t* ONSA = (bf16_t*)(ws + OFF_ONSA);
  const u32x4* SELG = (const u32x4*)(ws + OFF_SELG);
  const bf16_t* KS = (const bf16_t*)(ws + OFF_KS); const bf16_t* VS = (const bf16_t*)(ws + OFF_VS);
  constexpr int NITEM = NB * 2 * 128;
  for (int item = blockIdx.x; item < NITEM; item += gridDim.x) {
    const NsaItem it = nsa_item(item, wave, 0);
    const int qb = it.qb;
    bf16x8 qf[2][2]; u32x4 selw[2]; float g_s[2]; int tg[2]; Sel16 G[2];
#pragma unroll
    for (int gq = 0; gq < 2; ++gq) {
      tg[gq] = it.t + 4 * gq + qi4;
      const size_t tokrow = (size_t)it.b * SEQ + tg[gq];
#pragma unroll
      for (int ks = 0; ks < 2; ++ks) qf[gq][ks] = *(const bf16x8*)(Q + tokrow * 512 + (it.g * 4 + r4) * 64 + ks * 32 + kg * 8);
      selw[gq] = SELG[(size_t)it.bg * SEQ + tg[gq]];
      g_s[gq] = gsig[tokrow * 32 + (it.g * 4 + r4) * 3 + 1];
      G[gq].m = 0.f; G[gq].ol = (f32x4v){0.f, 0.f, 0.f, 0.f}; G[gq].has = false;
#pragma unroll
      for (int dt = 0; dt < 4; ++dt) G[gq].o[dt] = (f32x4v){0.f, 0.f, 0.f, 0.f};
    }
    const bf16_t* kb = KS + (size_t)it.b * SEQ * 128 + it.g * 64;
    const bf16_t* vb = VS + (size_t)it.b * SEQ * 128 + it.g * 64;
    const int nst = (qb >> 2) + 1;
    StageRegs sr;
    lds_barrier();
    nsa_load_stage(sr, kb, vb, 0, qb);
    nsa_store_stage(sr, smem);
    lds_barrier();
    for (int sidx = 0; sidx < nst; ++sidx) {
      const char* stage = smem + (sidx & 1) * NSA_STAGE;
      if (sidx + 1 < nst) nsa_load_stage(sr, kb, vb, 4 * (sidx + 1), qb);
#pragma unroll 1
      for (int tt = 0; tt < 4; ++tt) {
        const int j = 4 * sidx + tt;
        if (j > qb) break;
#pragma unroll
        for (int gq = 0; gq < 2; ++gq) {
          const unsigned w = j < 32 ? selw[gq].x : (j < 64 ? selw[gq].y : (j < 96 ? selw[gq].z : selw[gq].w));
          const bool sel = (w >> (j & 31)) & 1u;
          if (__any(sel)) nsa_unit16(G[gq], stage + tt * 18432, qf[gq], sel, (j == qb) ? (tg[gq] - j * 64) : 1000, lane);
        }
      }
      if (sidx + 1 < nst) nsa_store_stage(sr, smem + ((sidx + 1) & 1) * NSA_STAGE);
      lds_barrier();
    }
#pragma unroll
    for (int gq = 0; gq < 2; ++gq) {
      const float l = G[gq].ol[0];
      const float sc = l > 0.f ? g_s[gq] / l : 0.f;
      bf16_t* dst = ONSA + ((size_t)it.b * SEQ + tg[gq]) * 512 + (it.g * 4 + r4) * 64 + 4 * kg;
      if (!dry) {
#pragma unroll
        for (int dt = 0; dt < 4; ++dt) {
          u32x2* pp = (u32x2*)(dst + dt * 16);
          const u32x2 old = *pp;
          u32x2 wv; wv.x = pack2(bflo(old.x) + sc * G[gq].o[dt][0], bfhi(old.x) + sc * G[gq].o[dt][1]);
          wv.y = pack2(bflo(old.y) + sc * G[gq].o[dt][2], bfhi(old.y) + sc * G[gq].o[dt][3]);
          *pp = wv;
        }
      } else asm volatile("" :: "v"(G[gq].o[0]), "v"(G[gq].o[1]), "v"(G[gq].o[2]), "v"(G[gq].o[3]), "v"(l));
    }
  }
}

DI void phase_nsa(const Params& p, char* smem, int branch_mask) {
  char* ws = p.ws;
  const int tid = otid(), lane = tid & 63, wave = tid >> 6, hh = lane >> 5, c = lane & 31, qi = c >> 2, r4 = c & 3;
  const bf16_t* Q = (const bf16_t*)(ws + OFF_Q);
  const float* gsig = (const float*)(ws + OFF_GSIG);
  bf16_t* ONSA = (bf16_t*)(ws + OFF_ONSA);
  u32x4* SELG = (u32x4*)(ws + OFF_SELG);
  constexpr int NITEM = NB * 2 * 128;

#pragma unroll 1
  for (int rep1 = 0; rep1 < ((PROBE_DUP & 4096) ? 2 : 1); ++rep1) {
    const bf16_t* KCMP = (const bf16_t*)(ws + OFF_KCMP); const bf16_t* VCMP = (const bf16_t*)(ws + OFF_VCMP);
    float* Aimp = (float*)(smem + NSA_AIMP) + wave * 1024;
    float* Cimp = (float*)(smem + NSA_CIMP) + wave * 1024;
    unsigned short* selm16 = (unsigned short*)(smem + NSA_SELM) + wave * 64;
    const u32x4* selm128 = (const u32x4*)(smem + NSA_SELM) + wave * 8;
    for (int item = blockIdx.x; item < NITEM; item += gridDim.x) {
      const NsaItem it = nsa_item(item, wave, qi);
      const int t = it.t;
      bf16x8 qf[4];
#pragma unroll
      for (int ks = 0; ks < 4; ++ks) qf[ks] = *(const bf16x8*)(Q + it.tokrow * 512 + (it.g * 4 + r4) * 64 + ks * 16 + hh * 8);
      const float g_c = gsig[it.tokrow * 32 + (it.g * 4 + r4) * 3 + 0];
      TileRegs tr;
      const int nmax = (it.qb * 64 + 63 - 31) >> 4, ntile = (nmax >> 6) + 1;
      const int nfull = (it.qb * 64 - 31) >> 4;
      const bf16_t* kb = KCMP + (size_t)it.bg * 512 * 64;
      const bf16_t* vb = VCMP + (size_t)it.bg * 512 * 64;
      float m = -1e30f, l = 0.f;
      nsa_load_tile(tr, kb, 64, vb, 64);
      nsa_store_tile(tr, smem);
      __syncthreads();
      for (int j = 0; j < ntile; ++j) {
        const char* tile = smem + (j & 1) * NSA_TILE;
        if (j + 1 < ntile) nsa_load_tile(tr, kb + (size_t)(j + 1) * 64 * 64, 64, vb + (size_t)(j + 1) * 64 * 64, 64);
        f32x16 st[2];
        nsa_scores(st, tile, qf, lane);
        const bool full = (j * 64 + 63 <= nfull);
        const int nlim = full ? 100000 : ((t - 31) >> 4) - j * 64 - 4 * hh;
        float mx = NSA_NEG;
#pragma unroll
        for (int kt = 0; kt < 2; ++kt)
#pragma unroll
          for (int r = 0; r < 16; ++r) {
            st[kt][r] = (kt * 32 + (r & 3) + 8 * (r >> 2) <= nlim) ? st[kt][r] : NSA_NEG;
            mx = fmaxf(mx, st[kt][r]);
          }
        mx = fmaxf(mx, xor32f(mx, lane));
        const float mn = fmaxf(m, mx);
        float sum = 0.f;
#pragma unroll
        for (int kt = 0; kt < 2; ++kt)
#pragma unroll
          for (int r = 0; r < 16; ++r) sum += __builtin_amdgcn_exp2f(st[kt][r] - mn);
        l = l * __builtin_amdgcn_exp2f(m - mn) + sum;
        m = mn;
        if (j + 1 < ntile) nsa_store_tile(tr, smem + ((j + 1) & 1) * NSA_TILE);
        __syncthreads();
      }
      l += xor32f(l, lane);
      const float inv_l = l > 0.f ? 1.0f / l : 0.f;
      f32x16 o[2];
#pragma unroll
      for (int r = 0; r < 16; ++r) { o[0][r] = 0.f; o[1][r] = 0.f; }
      nsa_load_tile(tr, kb, 64, vb, 64);
      nsa_store_tile(tr, smem);
      __syncthreads();
      for (int j = 0; j < ntile; ++j) {
        const char* tile = smem + (j & 1) * NSA_TILE;
        if (j + 1 < ntile) nsa_load_tile(tr, kb + (size_t)(j + 1) * 64 * 64, 64, vb + (size_t)(j + 1) * 64 * 64, 64);
        f32x16 st[2];
        nsa_scores(st, tile, qf, lane);
        const bool full = (j * 64 + 63 <= nfull);
        const int nlim = full ? 100000 : ((t - 31) >> 4) - j * 64 - 4 * hh;
#pragma unroll
        for (int kt = 0; kt < 2; ++kt)
#pragma unroll
          for (int r = 0; r < 16; ++r) {
            const float arg = (kt * 32 + (r & 3) + 8 * (r >> 2) <= nlim) ? st[kt][r] - m : NSA_NEG;
            st[kt][r] = __builtin_amdgcn_exp2f(arg) * inv_l;
          }
#pragma unroll
        for (int kt = 0; kt < 2; ++kt)
#pragma unroll
          for (int c4 = 0; c4 < 4; ++c4) {
            float carry = 0.5f * st[kt][4 * c4 + 3];
            float fullv = st[kt][4 * c4] + st[kt][4 * c4 + 1] + st[kt][4 * c4 + 2] + carry;
            fullv += xor1f(fullv); fullv += xor2f(fullv);
            carry += xor1f(carry); carry += xor2f(carry);
            const int jb = j * 16 + kt * 8 + 2 * c4 + hh;
            if (r4 == 0) { Aimp[qi * 128 + jb] = fullv; Cimp[qi * 128 + jb] = carry; }
          }
        if (branch_mask & 1) nsa_pv(o, st, tile, lane);
        if (j + 1 < ntile) nsa_store_tile(tr, smem + ((j + 1) & 1) * NSA_TILE);
        __syncthreads();
      }
      nsa_accum_store(ONSA + it.tokrow * 512 + (it.g * 4 + r4) * 64, o, (branch_mask & 1) ? g_c : 0.f, true, hh);
      const int cur = it.qb;
      if (cur <= 15) {
        if (lane < 8) { selm16[lane * 8 + 0] = (unsigned short)((2u << cur) - 1u);
#pragma unroll
          for (int k = 1; k < 8; ++k) selm16[lane * 8 + k] = 0; }
      } else {
        const int qs = lane >> 3, sub = lane & 7;
        float v[16];
#pragma unroll
        for (int i = 0; i < 16; ++i) {
          const int jj = sub * 16 + i;
          const bool ok = (jj >= 1) && (jj <= cur - 2);
          const int jm = jj >= 1 ? jj - 1 : 0;
          v[i] = ok ? (Aimp[qs * 128 + jj] + Cimp[qs * 128 + jm]) : -3e38f;
        }
        unsigned bits = 0;
        for (int itn = 0; itn < 13; ++itn) {
          float bv = v[0]; int bi = 0;
#pragma unroll
          for (int i = 1; i < 16; ++i) if (v[i] > bv) { bv = v[i]; bi = i; }
          int bj = sub * 16 + bi;
#pragma unroll
          for (int o2 = 1; o2 < 8; o2 <<= 1) {
            const float ov = __shfl_xor(bv, o2); const int oj = __shfl_xor(bj, o2);
            if (ov > bv || (ov == bv && oj < bj)) { bv = ov; bj = oj; }
          }
          if ((bj >> 4) == sub) {
            const int i2 = bj & 15;
#pragma unroll
            for (int i = 0; i < 16; ++i) if (i == i2) v[i] = -3e38f;
            bits |= 1u << i2;
          }
        }
        if (sub == 0) bits |= 1u;
        if ((cur >> 4) == sub) bits |= 1u << (cur & 15);
        if (((cur - 1) >> 4) == sub) bits |= 1u << ((cur - 1) & 15);
        selm16[qs * 8 + sub] = (unsigned short)bits;
      }
      __syncthreads();
      if (r4 == 0 && hh == 0) SELG[(size_t)it.bg * SEQ + t] = selm128[qi];
    }
  }
  __threadfence_block();
  __syncthreads();

#pragma unroll 1
  for (int sweep_i = 0; sweep_i < 2 + ((PROBE_DUP & 1024) ? 1 : 0) + ((PROBE_DUP & 2048) ? 1 : 0); ++sweep_i) {
    const int sweep = (sweep_i < 2) ? sweep_i : (((PROBE_DUP & 1024) && sweep_i == 2) ? 0 : 1);
    const bool dry = sweep_i >= 2;
    if (!(branch_mask & (sweep == 0 ? 2 : 4))) continue;
    if (sweep == 0) { nsa_sel16(p, smem, dry); continue; }
    const bf16_t* KB = (const bf16_t*)(ws + (sweep == 0 ? OFF_KS : OFF_KW)); const bf16_t* VB = (const bf16_t*)(ws + (sweep == 0 ? OFF_VS : OFF_VW));
    for (int item = blockIdx.x; item < NITEM; item += gridDim.x) {
      const NsaItem it = nsa_item(item, wave, qi);
      const int t = it.t, qb = it.qb;
      bf16x8 qf[4];
#pragma unroll
      for (int ks = 0; ks < 4; ++ks) qf[ks] = *(const bf16x8*)(Q + it.tokrow * 512 + (it.g * 4 + r4) * 64 + ks * 16 + hh * 8);
      const float g_b = gsig[it.tokrow * 32 + (it.g * 4 + r4) * 3 + 1 + sweep];
      u32x4 selw = {0xffffffffu, 0xffffffffu, 0xffffffffu, 0xffffffffu};
      if (sweep == 0) selw = SELG[(size_t)it.bg * SEQ + t];
      TileRegs tr;
      const bf16_t* kb = KB + (size_t)it.b * SEQ * 128 + it.g * 64;
      const bf16_t* vb = VB + (size_t)it.b * SEQ * 128 + it.g * 64;
      float m = -1e30f, l = 0.f;
      f32x16 o[2];
#pragma unroll
      for (int r = 0; r < 16; ++r) { o[0][r] = 0.f; o[1][r] = 0.f; }
      const int j0 = (sweep == 1 && qb >= 8) ? qb - 8 : 0;
      __syncthreads();
      nsa_load_tile(tr, kb + (size_t)j0 * 64 * 128, 128, vb + (size_t)j0 * 64 * 128, 128);
      nsa_store_tile(tr, smem);
      if (j0 + 1 <= qb) { nsa_load_tile(tr, kb + (size_t)(j0 + 1) * 64 * 128, 128, vb + (size_t)(j0 + 1) * 64 * 128, 128); nsa_store_tile(tr, smem + NSA_TILE); }
      if (j0 + 2 <= qb) nsa_load_tile(tr, kb + (size_t)(j0 + 2) * 64 * 128, 128, vb + (size_t)(j0 + 2) * 64 * 128, 128);
      __syncthreads();
      const bool late = wave >= 4;
      if (__builtin_amdgcn_readfirstlane(wave) >= 4) __builtin_amdgcn_s_setprio(1);
      bool has = false;
      m = 0.f;
      f32x16 st[2];
      {
        const unsigned w0 = j0 < 32 ? selw.x : (j0 < 64 ? selw.y : (j0 < 96 ? selw.z : selw.w));
        const float ini = ((w0 >> (j0 & 31)) & 1u) ? 0.f : -1e30f;
#pragma unroll
        for (int r = 0; r < 16; ++r) { st[0][r] = ini; st[1][r] = ini; }
        const bf16_t* Kc = (const bf16_t*)smem;
#pragma unroll
        for (int ks = 0; ks < 4; ++ks)
#pragma unroll
          for (int kt = 0; kt < 2; ++kt) st[kt] = MFMA32(*(const bf16x8*)(Kc + (kt * 32 + (lane & 31)) * LK + ks * 16 + (lane >> 5) * 8), qf[ks], st[kt]);
      }
      int bi = 0;
      for (int j = j0; j <= qb; ++j) {
        const char* tile = smem + bi * NSA_TILE;
        const int bn = bi == 2 ? 0 : bi + 1, bnn = bn == 2 ? 0 : bn + 1;
        const int jn = j + 1;
        const unsigned wn = jn < 32 ? selw.x : (jn < 64 ? selw.y : (jn < 96 ? selw.z : selw.w));
        const bool seln = (wn >> (jn & 31)) & 1u;
        const bf16_t* Kn = (const bf16_t*)(smem + bn * NSA_TILE) + (lane & 31) * LK + (lane >> 5) * 8;
        f32x16 sn[2];
        if (!late) {
          const float ini = seln ? -m : -1e30f;
#pragma unroll
          for (int r = 0; r < 16; ++r) { sn[0][r] = ini; sn[1][r] = ini; }
#pragma unroll
          for (int ks = 0; ks < 4; ++ks)
#pragma unroll
            for (int kt = 0; kt < 2; ++kt) sn[kt] = MFMA32(*(const bf16x8*)(Kn + kt * 32 * LK + ks * 16), qf[ks], sn[kt]);
        }
        if (j == qb || (sweep == 1 && j == qb - 8)) {
          const int khi = t - j * 64 - 4 * hh, klo = (sweep == 1) ? khi - 511 : -100000;
#pragma unroll
          for (int r = 0; r < 16; ++r) {
            const int o0 = (r & 3) + 8 * (r >> 2);
            st[0][r] = (o0 <= khi && o0 >= klo) ? st[0][r] : NSA_NEG;
            st[1][r] = (o0 + 32 <= khi && o0 + 32 >= klo) ? st[1][r] : NSA_NEG;
          }
        }
        float mx;
        {
          float a0, a1, a2, a3;
          asm("v_max3_f32 %0, %1, %2, %3" : "=v"(a0) : "v"(st[0][0]), "v"(st[0][1]), "v"(st[0][2]));
          asm("v_max3_f32 %0, %1, %2, %3" : "=v"(a1) : "v"(st[0][3]), "v"(st[0][4]), "v"(st[0][5]));
          asm("v_max3_f32 %0, %1, %2, %3" : "=v"(a2) : "v"(st[0][6]), "v"(st[0][7]), "v"(st[0][8]));
          asm("v_max3_f32 %0, %1, %2, %3" : "=v"(a3) : "v"(st[0][9]), "v"(st[0][10]), "v"(st[0][11]));
          asm("v_max3_f32 %0, %1, %2, %3" : "=v"(a0) : "v"(a0), "v"(st[0][12]), "v"(st[0][13]));
          asm("v_max3_f32 %0, %1, %2, %3" : "=v"(a1) : "v"(a1), "v"(st[0][14]), "v"(st[0][15]));
          asm("v_max3_f32 %0, %1, %2, %3" : "=v"(a2) : "v"(a2), "v"(st[1][0]), "v"(st[1][1]));
          asm("v_max3_f32 %0, %1, %2, %3" : "=v"(a3) : "v"(a3), "v"(st[1][2]), "v"(st[1][3]));
          asm("v_max3_f32 %0, %1, %2, %3" : "=v"(a0) : "v"(a0), "v"(st[1][4]), "v"(st[1][5]));
          asm("v_max3_f32 %0, %1, %2, %3" : "=v"(a1) : "v"(a1), "v"(st[1][6]), "v"(st[1][7]));
          asm("v_max3_f32 %0, %1, %2, %3" : "=v"(a2) : "v"(a2), "v"(st[1][8]), "v"(st[1][9]));
          asm("v_max3_f32 %0, %1, %2, %3" : "=v"(a3) : "v"(a3), "v"(st[1][10]), "v"(st[1][11]));
          asm("v_max3_f32 %0, %1, %2, %3" : "=v"(a0) : "v"(a0), "v"(st[1][12]), "v"(st[1][13]));
          asm("v_max3_f32 %0, %1, %2, %3" : "=v"(a1) : "v"(a1), "v"(st[1][14]), "v"(st[1][15]));
          asm("v_max3_f32 %0, %1, %2, %3" : "=v"(a0) : "v"(a0), "v"(a1), "v"(a2));
          const float other = a3;
          asm("v_max_f32 %0, %1, %2" : "=v"(mx) : "v"(a0), "v"(other));
          const float px = xor32f(mx, lane);
          asm("v_max_f32 %0, %1, %2" : "=v"(mx) : "v"(mx), "v"(px));
        }
        const bool real = mx > -1e29f;
        const bool fresh = !has && real, up = has && (mx > NSA_THR);
        if (__any(fresh || up)) {
          const float delta = (fresh || up) ? mx : 0.f;
          const float alpha = up ? __builtin_amdgcn_exp2f(-delta) : 1.0f;
          m += delta; l *= alpha;
#pragma unroll
          for (int r = 0; r < 16; ++r) { o[0][r] *= alpha; o[1][r] *= alpha; st[0][r] -= delta; st[1][r] -= delta; }
          if (!late) {
            const float dn = seln ? delta : 0.f;
#pragma unroll
            for (int r = 0; r < 16; ++r) { sn[0][r] -= dn; sn[1][r] -= dn; }
          }
        }
        has = has || real;
        f32x2 s2 = {0.f, 0.f};
#pragma unroll
        for (int r = 0; r < 16; ++r) {
          const float p0 = __builtin_amdgcn_exp2f(st[0][r]), p1 = __builtin_amdgcn_exp2f(st[1][r]);
          st[0][r] = p0; st[1][r] = p1; s2 += (f32x2){p0, p1};
        }
        l += s2.x + s2.y;
        nsa_pv(o, st, tile, lane);
        if (late) {
          const float ini = seln ? -m : -1e30f;
#pragma unroll
          for (int r = 0; r < 16; ++r) { sn[0][r] = ini; sn[1][r] = ini; }
#pragma unroll
          for (int ks = 0; ks < 4; ++ks)
#pragma unroll
            for (int kt = 0; kt < 2; ++kt) sn[kt] = MFMA32(*(const bf16x8*)(Kn + kt * 32 * LK + ks * 16), qf[ks], sn[kt]);
        }
        if (j + 2 <= qb) nsa_store_tile(tr, smem + bnn * NSA_TILE);
        if (j + 3 <= qb) nsa_load_tile(tr, kb + (size_t)(j + 3) * 64 * 128, 128, vb + (size_t)(j + 3) * 64 * 128, 128);
#pragma unroll
        for (int r = 0; r < 16; ++r) { st[0][r] = sn[0][r]; st[1][r] = sn[1][r]; }
        bi = bn;
        __syncthreads();
      }
      __builtin_amdgcn_s_setprio(0);
      l += xor32f(l, lane);
      if (!dry) nsa_accum_store(ONSA + it.tokrow * 512 + (it.g * 4 + r4) * 64, o, l > 0.f ? g_b / l : 0.f, false, hh, (unsigned char*)(ws + OFF_ONSA8) + it.tokrow * 512 + (it.g * 4 + r4) * 64);
      else asm volatile("" :: "v"(o[0]), "v"(o[1]), "v"(l));
    }
  }
}

DI unsigned ord_key(float f) { const unsigned u = __float_as_uint(f); return (u & 0x80000000u) ? ~u : (u | 0x80000000u); }
DI float ord_val(unsigned k) { return __uint_as_float((k & 0x80000000u) ? (k & 0x7fffffffu) : ~k); }
DI void cex(unsigned& hi, unsigned& lo) { const unsigned x = hi, y = lo; hi = x > y ? x : y; lo = x > y ? y : x; }
DI void sort16_desc(unsigned (&a)[16]) {
#pragma unroll
  for (int k = 2; k <= 16; k <<= 1)
#pragma unroll
    for (int j = k >> 1; j > 0; j >>= 1)
#pragma unroll
      for (int i = 0; i < 16; ++i) {
        const int l = i ^ j;
        if (l > i) { if ((i & k) == 0) cex(a[i], a[l]); else cex(a[l], a[i]); }
      }
}
DI void bitonic_finish16(unsigned (&a)[16]) {
#pragma unroll
  for (int j = 8; j > 0; j >>= 1)
#pragma unroll
    for (int i = 0; i < 16; ++i) { const int l = i ^ j; if (l > i) cex(a[i], a[l]); }
}
DI void merge_top16(unsigned (&a)[16], const unsigned (&b)[16]) {
#pragma unroll
  for (int i = 0; i < 16; ++i) a[i] = a[i] > b[15 - i] ? a[i] : b[15 - i];
  bitonic_finish16(a);
}
DI void merge_partner16(unsigned (&a)[16]) {
  unsigned b[16];
#pragma unroll
  for (int i = 0; i < 16; ++i) b[i] = xor32u(a[i], otid());
  merge_top16(a, b);
}


constexpr int KLD = 136;
DI void peer_top16(unsigned (&top)[16], const bf16x8 (&bq)[8], const bf16_t* keys  , int lane) {
  const int l31 = lane & 31, hh = lane >> 5;
  unsigned grp[16];
#pragma unroll
  for (int nt = 0; nt < 4; ++nt) {
    f32x16 sa;
#pragma unroll
    for (int r = 0; r < 16; ++r) sa[r] = 0.f;
    const bf16_t* kp = keys + (nt * 32 + l31) * KLD + hh * 8;
#pragma unroll
    for (int ks = 0; ks < 8; ++ks) { const bf16x8 a = *(const bf16x8*)(kp + ks * 16); sa = MFMA32(a, bq[ks], sa); }
#pragma unroll
    for (int r = 0; r < 16; ++r) {
      const int n = nt * 32 + (r & 3) + 8 * (r >> 2) + 4 * hh;
      grp[r] = (ord_key(sa[r]) & ~0x7Fu) | (unsigned)(127 - n);
    }
    sort16_desc(grp);
    if (nt == 0) {
#pragma unroll
      for (int i = 0; i < 16; ++i) top[i] = grp[i];
    } else merge_top16(top, grp);
  }
  merge_partner16(top);
}

DI void phase_route(const Params& p, char* smem) {
  char* ws = p.ws;
  const int tid = otid(), lane = tid & 63, wave = tid >> 6, l31 = lane & 31, hh = lane >> 5;
  const bf16_t* pq = (const bf16_t*)(ws + OFF_PQ);
  const bf16_t* pk = (const bf16_t*)(ws + OFF_PKEYS);
  int* eidx = (int*)(ws + OFF_EIDX);
  float* pgate = (float*)(ws + OFF_PGATE);
  bf16_t* KL = (bf16_t*)smem;
  unsigned* LS = (unsigned*)(smem + 2 * 128 * KLD * 2) + wave * 1024;
  {
    const int h0 = blockIdx.x & 7;
    __syncthreads();
#pragma unroll
    for (int i = 0; i < 8; ++i) {
      const int idx = tid + i * NT, row = idx >> 4, ch = idx & 15;
      *(u32x4*)(KL + row * KLD + ch * 8) = *(const u32x4*)(pk + ((size_t)h0 * 256 + row) * 128 + ch * 8);
    }
    __syncthreads();
  }
  constexpr int CA[64] = {0,0,0,0,0,0,0,0,0,0,0,0,0,0,0,0, 1,1,1,1,1,1,1,1, 2,2,2,2,2, 3,3,3,3, 4,4,4, 5,5, 6,6, 7,7, 8,9,10,11,12,13,14,15, 0,0,0,0,0,0,0,0,0,0,0,0,0,0};
  constexpr int CB[64] = {0,1,2,3,4,5,6,7,8,9,10,11,12,13,14,15, 0,1,2,3,4,5,6,7, 0,1,2,3,4, 0,1,2,3, 0,1,2, 0,1, 0,1, 0,1, 0,0,0,0,0,0,0,0, 0,0,0,0,0,0,0,0,0,0,0,0,0,0};
  for (int item = blockIdx.x; item < (NTOK / 256) * 8; item += gridDim.x) {
    const int h = item & 7, t0 = (item >> 3) * 256 + wave * 32;
    unsigned s1[16], s2[16];
    const bf16_t* pqrow = pq + (size_t)(t0 + l31) * 2048 + h * 256 + hh * 8;
    bf16x8 bq1[8], bq2[8];
#pragma unroll
    for (int ks = 0; ks < 8; ++ks) { bq1[ks] = *(const bf16x8*)(pqrow + ks * 16); bq2[ks] = *(const bf16x8*)(pqrow + 128 + ks * 16); }
    peer_top16(s1, bq1, KL, lane);
    peer_top16(s2, bq2, KL + 128 * KLD, lane);
    float f1[16], f2[16];
#pragma unroll
    for (int i = 0; i < 16; ++i) { f1[i] = ord_val(s1[i]); f2[i] = ord_val(s2[i]); }
    unsigned ca[16], cb2[16];
#pragma unroll
    for (int i = 0; i < 32; ++i) {
      const int i0 = i, i1 = 25 + i;
      unsigned k0 = 0u, k1 = 0u;
      if (i0 < 25) k0 = (ord_key(f1[CA[i0]] + f2[CB[i0]]) & ~0xFFu) | (unsigned)(255 - (CA[i0] * 16 + CB[i0]));
      if (i1 < 50) k1 = (ord_key(f1[CA[i1]] + f2[CB[i1]]) & ~0xFFu) | (unsigned)(255 - (CA[i1] * 16 + CB[i1]));
      const unsigned kk = hh ? k1 : k0;
      if (i < 16) ca[i] = kk; else cb2[i - 16] = kk;
    }
    sort16_desc(ca); sort16_desc(cb2);
    merge_top16(ca, cb2);
    merge_partner16(ca);
    if (hh == 0) {
#pragma unroll
      for (int i = 0; i < 16; ++i) { LS[l31 * 32 + i] = s1[i]; LS[l31 * 32 + 16 + i] = s2[i]; }
    }
    const float mx = ord_val(ca[0]);
    float ex[16], sum = 0.f;
#pragma unroll
    for (int i = 0; i < 16; ++i) { ex[i] = __expf(ord_val(ca[i]) - mx); sum += ex[i]; }
    const float inv = 1.0f / sum;
    int eo[16]; float go[16];
#pragma unroll
    for (int i = 0; i < 16; ++i) {
      const int flat = 255 - (int)(ca[i] & 0xFFu);
      const unsigned k1 = LS[l31 * 32 + (flat >> 4)], k2 = LS[l31 * 32 + 16 + (flat & 15)];
      eo[i] = (127 - (int)(k1 & 0x7Fu)) * 128 + (127 - (int)(k2 & 0x7Fu));
      go[i] = ex[i] * inv;
    }
    const size_t ob = ((size_t)(t0 + l31) * 8 + h) * 16;
    if (hh == 0) {
      *(u32x4*)(eidx + ob) = (u32x4){(unsigned)eo[0], (unsigned)eo[1], (unsigned)eo[2], (unsigned)eo[3]};
      *(u32x4*)(eidx + ob + 4) = (u32x4){(unsigned)eo[4], (unsigned)eo[5], (unsigned)eo[6], (unsigned)eo[7]};
      *(f32x4*)(pgate + ob) = (f32x4){go[0], go[1], go[2], go[3]};
      *(f32x4*)(pgate + ob + 4) = (f32x4){go[4], go[5], go[6], go[7]};
    } else {
      *(u32x4*)(eidx + ob + 8) = (u32x4){(unsigned)eo[8], (unsigned)eo[9], (unsigned)eo[10], (unsigned)eo[11]};
      *(u32x4*)(eidx + ob + 12) = (u32x4){(unsigned)eo[12], (unsigned)eo[13], (unsigned)eo[14], (unsigned)eo[15]};
      *(f32x4*)(pgate + ob + 8) = (f32x4){go[8], go[9], go[10], go[11]};
      *(f32x4*)(pgate + ob + 12) = (f32x4){go[12], go[13], go[14], go[15]};
    }
  }
}

#define FOR32(M) M(0) M(1) M(2) M(3) M(4) M(5) M(6) M(7) M(8) M(9) M(10) M(11) M(12) M(13) M(14) M(15) M(16) M(17) M(18) M(19) M(20) M(21) M(22) M(23) M(24) M(25) M(26) M(27) M(28) M(29) M(30) M(31)
#define FOR16(M) M(0) M(1) M(2) M(3) M(4) M(5) M(6) M(7) M(8) M(9) M(10) M(11) M(12) M(13) M(14) M(15)
DI void phase_ffn_u(const Params& p) {
  char* ws = p.ws;
  const int lane = otid() & 63, wave = otid() >> 6, pg = lane >> 3, dc = lane & 7;
  const int sl = blockIdx.x & 7, wslot = (blockIdx.x >> 3) * NW + wave, nw = (gridDim.x >> 3) * NW;
  const unsigned char* PU8 = (const unsigned char*)(ws + OFF_PU8) + (size_t)sl * 16384 * 128 + dc * 16;
  const unsigned char* h2q = (const unsigned char*)(ws + OFF_H2Q) + sl * 128 + dc * 16;
  const int* eidx = (const int*)(ws + OFF_EIDX);
  float* part = (float*)(ws + OFF_PART) + (size_t)sl * NTOK * 128;
  const int j0 = (dc >> 2) * 64 + ((2 * dc) & 7) * 8 + pg;
  int ev0 = 0, ev1 = 0, nev0 = 0, nev1 = 0; u32x4 hq = {0u, 0u, 0u, 0u}, nhq = hq;
  if (wslot < NTOK) { ev0 = eidx[(size_t)wslot * 128 + lane]; ev1 = eidx[(size_t)wslot * 128 + 64 + lane]; hq = *(const u32x4*)(h2q + (size_t)wslot * DM); }
  for (int t = wslot; t < NTOK; t += nw) {
    if (t + nw < NTOK) { const size_t o = (size_t)(t + nw) * 128; nev0 = eidx[o + lane]; nev1 = eidx[o + 64 + lane]; nhq = *(const u32x4*)(h2q + (size_t)(t + nw) * DM); }
#define FFU_LD(it) const u32x4 ru##it = *(const u32x4*)(PU8 + (size_t)__shfl((it) < 8 ? ev0 : ev1, ((it) & 7) * 8 + pg) * 128);
    FOR16(FFU_LD)
    int d[16];
#define FFU_CP(it) { int a_ = __builtin_amdgcn_sdot4((int)ru##it.x, (int)hq.x, 0, false); a_ = __builtin_amdgcn_sdot4((int)ru##it.y, (int)hq.y, a_, false); \
      a_ = __builtin_amdgcn_sdot4((int)ru##it.z, (int)hq.z, a_, false); d[it] = __builtin_amdgcn_sdot4((int)ru##it.w, (int)hq.w, a_, false); }
    FOR16(FFU_CP)
    int r8[8], r4[4], r2[2];
    { const bool hi = dc & 4;
#pragma unroll
      for (int i = 0; i < 8; ++i) { const int keep = hi ? d[8 + i] : d[i], send = hi ? d[i] : d[8 + i]; r8[i] = keep + __shfl_xor(send, 4); } }
    { const bool hi = dc & 2;
#pragma unroll
      for (int i = 0; i < 4; ++i) { const int keep = hi ? r8[4 + i] : r8[i], send = hi ? r8[i] : r8[4 + i]; r4[i] = keep + __float_as_int(xor2f(__int_as_float(send))); } }
    { const bool hi = dc & 1;
#pragma unroll
      for (int i = 0; i < 2; ++i) { const int keep = hi ? r4[2 + i] : r4[i], send = hi ? r4[i] : r4[2 + i]; r2[i] = keep + __float_as_int(xor1f(__int_as_float(send))); } }
    part[(size_t)t * 128 + j0] = (float)r2[0];
    part[(size_t)t * 128 + j0 + 8] = (float)r2[1];
    ev0 = nev0; ev1 = nev1; hq = nhq;
  }
}
DI void phase_ffn_w(const Params& p) {
  char* ws = p.ws;
  const int lane = otid() & 63, wave = otid() >> 6;
  const float* part = (const float*)(ws + OFF_PART);
  const float* scu = (const float*)(ws + OFF_SCU); const float* scv = (const float*)(ws + OFF_SCV);
  const int* eidx = (const int*)(ws + OFF_EIDX);
  const float* pgate = (const float*)(ws + OFF_PGATE);
  float* wbuf = (float*)(ws + OFF_WBUF);
  for (int grp = blockIdx.x; grp < NTOK / NW; grp += gridDim.x) {
    const size_t o = (size_t)(grp * NW + wave) * 128 + lane;
    float a0 = 0.f, a1 = 0.f;
#pragma unroll
    for (int s8 = 0; s8 < 8; ++s8) { a0 += part[(size_t)s8 * NTOK * 128 + o]; a1 += part[(size_t)s8 * NTOK * 128 + o + 64]; }
    const int e0 = eidx[o], e1 = eidx[o + 64];
    const float sht = ((const float*)(ws + OFF_SH))[grp * NW + wave];
    wbuf[o] = pgate[o] * gelu_f(a0 * (scu[e0] * sht)) * scv[e0];
    wbuf[o + 64] = pgate[o + 64] * gelu_f(a1 * (scu[e1] * sht)) * scv[e1];
  }
}
DI void phase_ffn_v(const Params& p) {
  char* ws = p.ws;
  const int lane = otid() & 63, wave = otid() >> 6, pg = lane >> 3, dc = lane & 7;
  const int sl = blockIdx.x & 7, wslot = (blockIdx.x >> 3) * NW + wave, nw = (gridDim.x >> 3) * NW;
  const unsigned char* PV8 = (const unsigned char*)(ws + OFF_PV8) + (size_t)sl * 16384 * 128 + dc * 16;
  const int* eidx = (const int*)(ws + OFF_EIDX) + 16 * pg;
  const float* wbuf = (const float*)(ws + OFF_WBUF) + 16 * pg;
  bf16_t* ffnb = (bf16_t*)(ws + OFF_FFNB);
  u32x4 ne0 = {0u, 0u, 0u, 0u}, ne1 = ne0, ne2 = ne0, ne3 = ne0;
  if (wslot < NTOK) { const int* ep = eidx + (size_t)wslot * 128; ne0 = *(const u32x4*)ep; ne1 = *(const u32x4*)(ep + 4); ne2 = *(const u32x4*)(ep + 8); ne3 = *(const u32x4*)(ep + 12); }
#pragma unroll 1
  for (int t = wslot; t < NTOK; t += nw) {
    const u32x4 ce0 = ne0, ce1 = ne1, ce2 = ne2, ce3 = ne3;
    if (t + nw < NTOK) { const int* ep = eidx + (size_t)(t + nw) * 128; ne0 = *(const u32x4*)ep; ne1 = *(const u32x4*)(ep + 4); ne2 = *(const u32x4*)(ep + 8); ne3 = *(const u32x4*)(ep + 12); }
    const float* wp = wbuf + (size_t)t * 128;
    const f32x4 wq0 = *(const f32x4*)wp, wq1 = *(const f32x4*)(wp + 4), wq2 = *(const f32x4*)(wp + 8), wq3 = *(const f32x4*)(wp + 12);
#define FFV_E(it) ((it) < 4 ? ce0[(it) & 3] : (it) < 8 ? ce1[(it) & 3] : (it) < 12 ? ce2[(it) & 3] : ce3[(it) & 3])
#define FFV_W(it) ((it) < 4 ? wq0[(it) & 3] : (it) < 8 ? wq1[(it) & 3] : (it) < 12 ? wq2[(it) & 3] : wq3[(it) & 3])
#define FFV_LD(it) const u32x4 rv##it = *(const u32x4*)(PV8 + (size_t)FFV_E(it) * 128);
#define FFV_CP(it) { const float wj = FFV_W(it); const f32x2 w2 = {wj, wj}; \
      acc2[0] += __builtin_amdgcn_cvt_pk_f32_fp8((int)rv##it.x, false) * w2; acc2[1] += __builtin_amdgcn_cvt_pk_f32_fp8((int)rv##it.x, true) * w2; \
      acc2[2] += __builtin_amdgcn_cvt_pk_f32_fp8((int)rv##it.y, false) * w2; acc2[3] += __builtin_amdgcn_cvt_pk_f32_fp8((int)rv##it.y, true) * w2; \
      acc2[4] += __builtin_amdgcn_cvt_pk_f32_fp8((int)rv##it.z, false) * w2; acc2[5] += __builtin_amdgcn_cvt_pk_f32_fp8((int)rv##it.z, true) * w2; \
      acc2[6] += __builtin_amdgcn_cvt_pk_f32_fp8((int)rv##it.w, false) * w2; acc2[7] += __builtin_amdgcn_cvt_pk_f32_fp8((int)rv##it.w, true) * w2; }
    FOR16(FFV_LD)
    f32x2 acc2[8];
#pragma unroll
    for (int i = 0; i < 8; ++i) acc2[i] = (f32x2){0.f, 0.f};
    FOR16(FFV_CP)
    float acc[16];
#pragma unroll
    for (int i = 0; i < 8; ++i) { acc[2 * i] = acc2[i].x; acc[2 * i + 1] = acc2[i].y; }
    float r8[8], r4[4], r2[2];
    { const bool hi = lane & 32;
#pragma unroll
      for (int i = 0; i < 8; ++i) { const float keep = hi ? acc[8 + i] : acc[i], send = hi ? acc[i] : acc[8 + i]; r8[i] = keep + xor32f(send, lane); } }
    { const bool hi = lane & 16;
#pragma unroll
      for (int i = 0; i < 4; ++i) { const float keep = hi ? r8[4 + i] : r8[i], send = hi ? r8[i] : r8[4 + i]; r4[i] = keep + xor16f(send, lane); } }
    { const bool hi = lane & 8;
#pragma unroll
      for (int i = 0; i < 2; ++i) { const float keep = hi ? r4[2 + i] : r4[i], send = hi ? r4[i] : r4[2 + i]; r2[i] = keep + xor8f(send); } }
    *(unsigned*)(ffnb + (size_t)t * DM + sl * 128 + dc * 16 + 2 * pg) = pack2(r2[0], r2[1]);
  }
}
DI void phase_final(const Params& p) {
  char* ws = p.ws;
  const int lane = otid() & 63, wave = otid() >> 6;
  const bf16_t* x1 = (const bf16_t*)(ws + OFF_X1);
  const bf16_t* ffnb = (const bf16_t*)(ws + OFF_FFNB);
  const float* mod = (const float*)(ws + OFF_MOD);
  for (int grp = blockIdx.x; grp < NTOK / NW; grp += gridDim.x) {
    const int row = grp * NW + wave, b = row >> 13;
    float v[16];
#pragma unroll
    for (int i = 0; i < 4; ++i) {
      const int col = i * 256 + lane * 4;
      const f32x4 gt2 = *(const f32x4*)(mod + b * 6144 + 5120 + col);
      const u32x2 xr = *(const u32x2*)(x1 + (size_t)row * DM + col), fr = *(const u32x2*)(ffnb + (size_t)row * DM + col);
      v[4 * i] = DN_ALPHA * bflo(xr.x) + gt2.x * bflo(fr.x); v[4 * i + 1] = DN_ALPHA * bfhi(xr.x) + gt2.y * bfhi(fr.x);
      v[4 * i + 2] = DN_ALPHA * bflo(xr.y) + gt2.z * bflo(fr.y); v[4 * i + 3] = DN_ALPHA * bfhi(xr.y) + gt2.w * bfhi(fr.y);
    }
    float mean, rstd; row_stats(v, mean, rstd);
#pragma unroll
    for (int i = 0; i < 4; ++i) {
      const int col = i * 256 + lane * 4;
      const f32x4 g = *(const f32x4*)(p.ln2_g + col), bb = *(const f32x4*)(p.ln2_b + col);
      f32x4 o;
      o.x = (v[4 * i] - mean) * rstd * g.x + bb.x; o.y = (v[4 * i + 1] - mean) * rstd * g.y + bb.y;
      o.z = (v[4 * i + 2] - mean) * rstd * g.z + bb.z; o.w = (v[4 * i + 3] - mean) * rstd * g.w + bb.w;
      *(f32x4*)(p.out + (size_t)row * DM + col) = o;
    }
  }
}

#define XB_TMO      128
#define XB_XCNT(j)  (256  + 64 * (j))
#define XB_XSUB(j)  (1280 + 64 * (j))
#define XB_XGEN(j)  (2304 + 64 * (j))
#define XB_TOP      3328
#define XB_TOPGEN   3392
#define XCD_BAR_WORDS 3456
#define XB_SPIN_CAP (1u << 22)
DI unsigned xb_ld(unsigned* p) { return __hip_atomic_load(p, __ATOMIC_RELAXED, __HIP_MEMORY_SCOPE_AGENT); }
DI unsigned xb_add(unsigned* p, unsigned v) { return __hip_atomic_fetch_add(p, v, __ATOMIC_RELAXED, __HIP_MEMORY_SCOPE_AGENT); }
DI unsigned xb_xcc_id() { return (unsigned)__builtin_amdgcn_s_getreg((3 << 11) | 20) & 0xFu; }
#define XB_SPIN(cond, bar) do { unsigned _sp = 0; while (cond) { __builtin_amdgcn_s_sleep(1); \
    if ((++_sp & 255u) == 0u) { if (xb_ld(&(bar)[XB_TMO])) break; if (_sp > XB_SPIN_CAP) { atomicAdd(&(bar)[XB_TMO], 1u); break; } } } } while (0)
struct XcdBarrier { unsigned* bar; unsigned x; volatile LAS unsigned* st; };
DI XcdBarrier xcd_barrier_post(unsigned* bar, volatile LAS unsigned* st) {
  XcdBarrier b; b.bar = bar; b.x = xb_xcc_id(); b.st = st;
  if (threadIdx.x == 0) (void)xb_add(&bar[XB_XCNT(b.x)], 1u);
  return b;
}
DI void xcd_barrier_complete(unsigned* bar, unsigned x, unsigned& nloc, unsigned& nx) {
  const unsigned G = gridDim.x * gridDim.y * gridDim.z;
  unsigned sum, cnt, mine, sp = 0u;
  for (;;) {
    sum = 0u; cnt = 0u; mine = 0u;
#pragma unroll
    for (unsigned j = 0; j < 16; ++j) { const unsigned c = xb_ld(&bar[XB_XCNT(j)]); sum += c; cnt += (c > 0u) ? 1u : 0u; mine = (j == x) ? c : mine; }
    if (sum == G) break;
    __builtin_amdgcn_s_sleep(1);
    if ((++sp & 255u) == 0u) { if (xb_ld(&bar[XB_TMO])) break; if (sp > XB_SPIN_CAP) { atomicAdd(&bar[XB_TMO], 1u); break; } }
  }
  nloc = mine > 0u ? mine : 1u; nx = cnt > 0u ? cnt : 1u;
}
DI void xcd_barrier(const XcdBarrier& b) {
  asm volatile("s_waitcnt vmcnt(0)" ::: "memory");
  __syncthreads();
  if (threadIdx.x == 0) {
    unsigned* bar = b.bar;
    __builtin_amdgcn_s_waitcnt(0);
    unsigned nloc = b.st[0], nx = b.st[1];
    if (nloc == 0u) { xcd_barrier_complete(bar, b.x, nloc, nx); b.st[0] = nloc; b.st[1] = nx; }
    const unsigned old = xb_add(&bar[XB_XSUB(b.x)], 1u);
    const unsigned gen = old / nloc;
    if (old + 1u == (gen + 1u) * nloc) {
      __builtin_amdgcn_fence(__ATOMIC_RELEASE, "agent");
      asm volatile("s_waitcnt vmcnt(0)" ::: "memory");
      const unsigned og = xb_add(&bar[XB_TOP], 1u);
      const unsigned tg = og / nx;
      if (og + 1u == (tg + 1u) * nx) xb_add(&bar[XB_TOPGEN], 1u);
      else XB_SPIN(xb_ld(&bar[XB_TOPGEN]) == tg, bar);
      __builtin_amdgcn_fence(__ATOMIC_ACQUIRE, "agent");
      xb_add(&bar[XB_XGEN(b.x)], 1u);
      asm volatile("s_waitcnt vmcnt(0)" ::: "memory");
    } else {
      XB_SPIN(xb_ld(&bar[XB_XGEN(b.x)]) == gen, bar);
      __builtin_amdgcn_fence(__ATOMIC_ACQUIRE, "agent");
      asm volatile("s_waitcnt vmcnt(0)" ::: "memory");
    }
  }
  __syncthreads();
}

constexpr int SMEM_BYTES = 147456 + 256;

__global__ void __launch_bounds__(NT, 2) k_mega(Params p) {
  __shared__ __attribute__((aligned(16))) char smem[SMEM_BYTES];
  cg::grid_group grid = cg::this_grid();
  if (threadIdx.x == 0) *(u32x4*)(smem + 147456) = (u32x4){0u, 0u, 0u, 0u};
  __syncthreads();
  const XcdBarrier xb = xcd_barrier_post((unsigned*)(p.ws + OFF_BAR), (volatile LAS unsigned*)(smem + 147456));
#define REP(mask) _Pragma("unroll 1") for (int rep_ = 0; rep_ < ((PROBE_DUP & (mask)) ? 2 : 1); ++rep_)
  REP(1) phase_prep(p, smem, (unsigned*)(p.ws + OFF_BAR) + XCD_BAR_WORDS + rep_);
  grid.sync();
  REP(1) phase_ln_in(p);
  xcd_barrier(xb);
  REP(2) phase_gemm1(p, smem);
  xcd_barrier(xb);
  REP(4) phase_compress(p, smem);
  phase_sgu(p, smem);
  xcd_barrier(xb);
  REP(8) phase_nsa(p, smem, NSA_MASK);
  xcd_barrier(xb);
  REP(16) phase_merge(p, smem);
  xcd_barrier(xb);
  REP(16) phase_outproj(p, smem);
  xcd_barrier(xb);
  REP(1) phase_ln_mid(p);
  xcd_barrier(xb);
  REP(32) phase_peerq(p, smem);
  xcd_barrier(xb);
  REP(64) phase_route(p, smem);
  xcd_barrier(xb);
  REP(128) phase_ffn_u(p);
  xcd_barrier(xb);
  REP(128) phase_ffn_w(p);
  xcd_barrier(xb);
  REP(256) phase_ffn_v(p);
  xcd_barrier(xb);
  REP(512) phase_final(p);
}

extern "C" void kernel_launch(void* const* d_in, const int* in_sizes, int n_in, void* d_out, int out_size, void* d_ws, size_t ws_size, hipStream_t stream) {
  if (ws_size < OFF_END) { fprintf(stderr, "workspace too small: %zu < %zu\n", ws_size, (size_t)OFF_END); return; }
  static int grid_blocks = 0;
  if (!grid_blocks) {
    int dev = 0, cus = 0, per_cu = 0;
    (void)hipGetDevice(&dev);
    (void)hipDeviceGetAttribute(&cus, hipDeviceAttributeMultiprocessorCount, dev);
    (void)hipOccupancyMaxActiveBlocksPerMultiprocessor(&per_cu, k_mega, NT, 0);
    if (per_cu < 1) fprintf(stderr, "occupancy query returned %d\n", per_cu);
    grid_blocks = (cus / 8) * 8;
  }
  Params p{};
  const float** fp = (const float**)&p;
  for (int i = 0; i < 26; ++i) fp[i] = (const float*)d_in[i];
  p.out = (float*)d_out;
  p.ws = (char*)d_ws;
  for (int i = 0; i < 32; ++i) p.inv_freq[i] = (float)pow(10000.0, -(double)i / 32.0);
  (void)hipMemsetAsync((char*)d_ws + OFF_BAR, 0, (XCD_BAR_WORDS + 64) * 4, stream);
  void* args[] = {&p};
  hipError_t e = hipLaunchCooperativeKernel((void*)k_mega, dim3(grid_blocks), dim3(NT), args, 0, stream);
  if (e != hipSuccess) fprintf(stderr, "cooperative launch failed: %s (grid %d)\n", hipGetErrorString(e), grid_blocks);
}
```

```cpp
#include <hip/hip_runtime.h>
#include <hip/hip_cooperative_groups.h>
#include <stdint.h>
#include <stdio.h>
#include <math.h>
namespace cg = cooperative_groups;

#ifndef PROBE_DUP
#define PROBE_DUP 0
#endif
#ifndef NSA_MASK
#define NSA_MASK 7
#endif
typedef unsigned short bf16_t;
typedef short bf16x8 __attribute__((ext_vector_type(8)));
typedef short s16x4 __attribute__((ext_vector_type(4)));
typedef float f32x16 __attribute__((ext_vector_type(16)));
typedef float f32x4 __attribute__((ext_vector_type(4)));
typedef float f32x2 __attribute__((ext_vector_type(2)));
typedef __bf16 bf16v2 __attribute__((ext_vector_type(2)));
typedef unsigned u32x4 __attribute__((ext_vector_type(4)));
typedef int i32x4 __attribute__((ext_vector_type(4)));
typedef int i32x8 __attribute__((ext_vector_type(8)));
typedef unsigned u32x2 __attribute__((ext_vector_type(2)));
#define DI __device__ __forceinline__
#define LAS __attribute__((address_space(3)))
#define MFMA32(a, b, c) __builtin_amdgcn_mfma_f32_32x32x16_bf16((a), (b), (c), 0, 0, 0)

constexpr int NT = 512, NW = 8;
constexpr int NB = 8, SEQ = 8192, DM = 1024, NTOK = NB * SEQ;
constexpr int N1 = 4608;
constexpr float DN_ALPHA = 1.189207115002721f;
constexpr float LN_EPS = 1e-5f;

constexpr size_t MB = 1024 * 1024;
constexpr size_t OFF_MOD = 0;
constexpr size_t OFF_ROPE = OFF_MOD + 256 * 1024;
constexpr size_t OFF_POSB = OFF_ROPE + 2 * MB;
constexpr size_t OFF_WT1 = OFF_POSB + 4096;
constexpr size_t OFF_WB = OFF_WT1 + (size_t)N1 * 1024 * 2;
constexpr size_t OFF_WOUT = OFF_WB + 2 * MB;
constexpr size_t OFF_WQ = OFF_WOUT + 2 * MB;
constexpr size_t OFF_PKEYS = OFF_WQ + 4 * MB;
constexpr size_t OFF_CW1 = OFF_PKEYS + MB / 2;
constexpr size_t OFF_CW2 = OFF_CW1 + MB;
constexpr size_t OFF_SGUW = OFF_CW2 + 32 * 1024;
constexpr size_t OFF_SCU = OFF_SGUW + 256 * 1024;
constexpr size_t OFF_SCV = OFF_SCU + 64 * 1024;
constexpr size_t OFF_PU = OFF_SCV + 64 * 1024;
constexpr size_t OFF_PV = OFF_PU + 32 * MB;
constexpr size_t OFF_ACT = ((OFF_PV + 32 * MB + 4095) / 4096) * 4096;
constexpr size_t OFF_H = OFF_ACT;
constexpr size_t OFF_Q = OFF_H + 128 * MB;
constexpr size_t OFF_KC = OFF_Q + 64 * MB;
constexpr size_t OFF_VC = OFF_KC + 16 * MB;
constexpr size_t OFF_KS = OFF_VC + 16 * MB;
constexpr size_t OFF_VS = OFF_KS + 16 * MB;
constexpr size_t OFF_KW = OFF_VS + 16 * MB;
constexpr size_t OFF_VW = OFF_KW + 16 * MB;
constexpr size_t OFF_U = OFF_VW + 16 * MB;
constexpr size_t OFF_V = OFF_U + 64 * MB;
constexpr size_t OFF_GATE = OFF_V + 64 * MB;
constexpr size_t OFF_GSIG = OFF_GATE + 256 * MB;
constexpr size_t OFF_KCMP = OFF_GSIG + 8 * MB;
constexpr size_t OFF_VCMP = OFF_KCMP + MB;
constexpr size_t OFF_ONSA = OFF_VCMP + MB;
constexpr size_t OFF_SELG = OFF_ONSA + 64 * MB;
constexpr size_t OFF_BAR = OFF_SELG + 2 * MB;
constexpr size_t OFF_END = OFF_BAR + 64 * 1024;
constexpr size_t OFF_X1 = OFF_Q;
constexpr size_t OFF_Y = OFF_GATE;
constexpr size_t OFF_PQ = OFF_GATE;
constexpr size_t OFF_EIDX = OFF_ONSA;
constexpr size_t OFF_PGATE = OFF_ONSA + 32 * MB;
constexpr size_t OFF_PU8 = OFF_PU;
constexpr size_t OFF_PART = OFF_GATE;
constexpr size_t OFF_PV8 = OFF_PU + 16 * MB;
constexpr size_t OFF_WBUF = OFF_PU + 32 * MB;
constexpr size_t OFF_H2Q = OFF_U;
constexpr size_t OFF_SH = OFF_V;
constexpr size_t OFF_FFNB = OFF_GATE;
constexpr size_t OFF_SCW1 = OFF_WT1 + 5 * MB;
constexpr size_t OFF_SCWQ = OFF_WQ + 3 * MB;
constexpr size_t OFF_GATE8 = OFF_GATE;
constexpr size_t OFF_OSGU8 = OFF_GATE + 128 * MB;
constexpr size_t OFF_ONSA8 = OFF_GATE + 160 * MB;
constexpr size_t OFF_MRG8 = OFF_GATE + 192 * MB;
constexpr size_t OFF_M08 = OFF_H;
constexpr size_t OFF_SCWB = OFF_WB + 3 * MB / 2;
constexpr size_t OFF_SCWO = OFF_WOUT + 3 * MB / 2;
constexpr size_t OFF_SA = OFF_H + 64 * MB;

struct Params {
  const float *x, *c, *w_ada, *b_ada, *w_in, *cmp_pos, *cmp_w1, *cmp_b1, *cmp_w2, *cmp_b2, *sgu_ln_g, *sgu_ln_b, *sgu_w, *sgu_b,
      *w_branch, *w_merge, *b_merge, *w_out, *ln1_g, *ln1_b, *peer_wq, *peer_keys, *peer_u, *peer_v, *ln2_g, *ln2_b;
  float* out;
  char* ws;
  float inv_freq[32];
};

DI unsigned pack2(float lo, float hi) { f32x2 v = {lo, hi}; bf16v2 r = __builtin_convertvector(v, bf16v2); return __builtin_bit_cast(unsigned, r); }
DI bf16_t f2bf(float f) { __bf16 r = (__bf16)f; return __builtin_bit_cast(unsigned short, r); }
DI float bf2f(bf16_t h) { return __uint_as_float(((unsigned)h) << 16); }
DI float bflo(unsigned u) { return __uint_as_float(u << 16); }
DI float bfhi(unsigned u) { return __uint_as_float(u & 0xffff0000u); }
DI float gelu_f(float v) { return 0.5f * v * (1.0f + erff(v * 0.70710678118654752f)); }
DI float sigmoid_f(float v) { return __builtin_amdgcn_rcpf(1.0f + __builtin_amdgcn_exp2f(v * -1.4426950408889634f)); }
DI int otid() { int t = __builtin_amdgcn_workitem_id_x(); asm volatile("" : "+v"(t)); return t; }
DI void lds_barrier() { asm volatile("s_waitcnt lgkmcnt(0)" ::: "memory"); __builtin_amdgcn_s_barrier(); asm volatile("" ::: "memory"); }
DI float xor1f(float x) { const int xi = __float_as_int(x); return __int_as_float(__builtin_amdgcn_update_dpp(xi, xi, 0xB1, 0xF, 0xF, false)); }
DI float xor2f(float x) { const int xi = __float_as_int(x); return __int_as_float(__builtin_amdgcn_update_dpp(xi, xi, 0x4E, 0xF, 0xF, false)); }
DI float xor8f(float x) { const int xi = __float_as_int(x); return __int_as_float(__builtin_amdgcn_update_dpp(xi, xi, 0x128, 0xF, 0xF, false)); }
DI unsigned xor32u(unsigned x, int lane) { const u32x2 r = __builtin_amdgcn_permlane32_swap(x, x, false, false); return (lane & 32) ? r.x : r.y; }
DI unsigned xor16u(unsigned x, int lane) { const u32x2 r = __builtin_amdgcn_permlane16_swap(x, x, false, false); return (lane & 16) ? r.x : r.y; }
DI float xor32f(float x, int lane) { return __uint_as_float(xor32u(__float_as_uint(x), lane)); }
DI float xor16f(float x, int lane) { return __uint_as_float(xor16u(__float_as_uint(x), lane)); }
DI unsigned pack_i8x4(float a, float b, float c, float d) {
  const int ia = (int)rintf(a), ib = (int)rintf(b), ic = (int)rintf(c), id = (int)rintf(d);
  return (unsigned)(ia & 0xff) | ((unsigned)(ib & 0xff) << 8) | ((unsigned)(ic & 0xff) << 16) | ((unsigned)id << 24);
}
DI unsigned pk4_fp8(float a, float b, float c, float d) { int t = 0; t = __builtin_amdgcn_cvt_pk_fp8_f32(a, b, t, false); t = __builtin_amdgcn_cvt_pk_fp8_f32(c, d, t, true); return (unsigned)t; }
DI float clamp_f8(float v) { return __builtin_amdgcn_fmed3f(v, -448.0f, 448.0f); }
DI void unpack8_fp8(const u32x2 w, float (&v)[8]) {
  const f32x2 a = __builtin_amdgcn_cvt_pk_f32_fp8((int)w.x, false), b = __builtin_amdgcn_cvt_pk_f32_fp8((int)w.x, true);
  const f32x2 c = __builtin_amdgcn_cvt_pk_f32_fp8((int)w.y, false), d = __builtin_amdgcn_cvt_pk_f32_fp8((int)w.y, true);
  v[0] = a.x; v[1] = a.y; v[2] = b.x; v[3] = b.y; v[4] = c.x; v[5] = c.y; v[6] = d.x; v[7] = d.y;
}
DI float wave_sum(float v) {
#pragma unroll
  for (int o = 32; o > 0; o >>= 1) v += __shfl_xor(v, o);
  return v;
}
DI void ld8(const float* pz, float (&v)[8]) { const f32x4 a = *(const f32x4*)pz, b = *(const f32x4*)(pz + 4); v[0] = a.x; v[1] = a.y; v[2] = a.z; v[3] = a.w; v[4] = b.x; v[5] = b.y; v[6] = b.z; v[7] = b.w; }
DI u32x4 pack8(const float (&v)[8]) { u32x4 w; w.x = pack2(v[0], v[1]); w.y = pack2(v[2], v[3]); w.z = pack2(v[4], v[5]); w.w = pack2(v[6], v[7]); return w; }
DI void unpack8(const u32x4 w, float (&v)[8]) { v[0] = bflo(w.x); v[1] = bfhi(w.x); v[2] = bflo(w.y); v[3] = bfhi(w.y); v[4] = bflo(w.z); v[5] = bfhi(w.z); v[6] = bflo(w.w); v[7] = bfhi(w.w); }
DI f32x2 gelu_pk(f32x2 v) {
  const f32x2 av = __builtin_elementwise_abs(v), d = av * 0.2316418882f + 1.0f;
  f32x2 t; t.x = __builtin_amdgcn_rcpf(d.x); t.y = __builtin_amdgcn_rcpf(d.y);
  f32x2 q = t * 0.5307027145f + (-0.7265760135f); q = q * t + 0.7107068705f; q = q * t + (-0.142248368f); q = q * t + 0.127414796f; q = q * t;
  const f32x2 s = (v * v) * (-0.72134752044f);
  f32x2 e; e.x = __builtin_amdgcn_exp2f(s.x); e.y = __builtin_amdgcn_exp2f(s.y);
  const f32x2 m = v * (q * e), r = v - m;
  f32x2 o; o.x = v.x < 0.f ? m.x : r.x; o.y = v.y < 0.f ? m.y : r.y; return o;
}
__host__ __device__ __forceinline__ int dperm(int q) { const int grp = q >> 5, fq = (q >> 3) & 3, j = q & 7; return (j < 4) ? (16 * grp + 4 * fq + j) : (32 + 16 * grp + 4 * fq + (j - 4)); }

template <class F>
DI void tconv_tile(float* tile, int k0, int n0, bf16_t* dst, int ldd, F f) {
  const int tid = otid();
  __syncthreads();
#pragma unroll 4
  for (int i = 0; i < 8; ++i) { const int kl = i * 8 + (tid >> 6), nl = tid & 63; tile[nl * 65 + kl] = f(k0 + kl, n0 + nl); }
  __syncthreads();
  {
    const int nl = tid >> 3, kc = tid & 7;
    const float* t = tile + nl * 65 + kc * 8;
    u32x4 w; w.x = pack2(t[0], t[1]); w.y = pack2(t[2], t[3]); w.z = pack2(t[4], t[5]); w.w = pack2(t[6], t[7]);
    *(u32x4*)(dst + (size_t)(n0 + nl) * ldd + k0 + kc * 8) = w;
  }
}

template <bool FP8, class F>
DI void tconv_strip32(float* tile, int n0, int K, unsigned char* dst, float* gscale, F f) {
  const int tid = otid(), nl = tid & 31, kr = tid >> 5, ld = K + 1;
  float am = 0.f;
#pragma unroll 16
  for (int k = kr; k < K; k += 16) { const float v = f(k, n0 + nl); tile[nl * ld + k] = v; am = fmaxf(am, fabsf(v)); }
#pragma unroll
  for (int o = 16; o > 0; o >>= 1) am = fmaxf(am, __shfl_xor(am, o));
  float* red = tile + 32 * ld;
  if (nl == 0) red[kr] = am;
  __syncthreads();
  float g = 0.f;
#pragma unroll
  for (int w = 0; w < 16; ++w) g = fmaxf(g, red[w]);
  float q, inv;
  if (FP8) {
    const unsigned be = (__float_as_uint(g) >> 23) & 0xffu;
    const bool ok = be >= 16u && be <= 240u;
    q = ok ? __uint_as_float((261u - be) << 23) : 1.0f; inv = ok ? __uint_as_float((be - 7u) << 23) : 1.0f;
  } else { q = g > 0.f ? 127.0f / g : 0.f; inv = g * (1.0f / 127.0f); }
  if (tid == 0) gscale[n0 >> 5] = inv;
  const int cpr = K >> 3;
  for (int idx = tid; idx < 32 * cpr; idx += NT) {
    const int row = idx / cpr, kc = idx - row * cpr;
    const float* t = tile + row * ld + kc * 8;
    u32x2 w;
    if (FP8) { w.x = pk4_fp8(t[0] * q, t[1] * q, t[2] * q, t[3] * q); w.y = pk4_fp8(t[4] * q, t[5] * q, t[6] * q, t[7] * q); }
    else { w.x = pack_i8x4(t[0] * q, t[1] * q, t[2] * q, t[3] * q); w.y = pack_i8x4(t[4] * q, t[5] * q, t[6] * q, t[7] * q); }
    *(u32x2*)(dst + (size_t)(n0 + row) * K + kc * 8) = w;
  }
}

DI void conv_chunk(const float* src, bf16_t* dst, size_t base) {
  const size_t i = base + (size_t)otid() * 8;
  const f32x4 a = *(const f32x4*)(src + i), b = *(const f32x4*)(src + i + 4);
  u32x4 w; w.x = pack2(a.x, a.y); w.y = pack2(a.z, a.w); w.z = pack2(b.x, b.y); w.w = pack2(b.z, b.w);
  *(u32x4*)(dst + i) = w;
}

DI void sincos_d(double x, double& s, double& c) {
  const double y = x * 0.25, y2 = y * y;
  double sn = y * (1.0 + y2 * (-1.0 / 6 + y2 * (1.0 / 120 + y2 * (-1.0 / 5040 + y2 * (1.0 / 362880 + y2 * (-1.0 / 39916800 + y2 * (1.0 / 6227020800.0)))))));
  double cs = 1.0 + y2 * (-0.5 + y2 * (1.0 / 24 + y2 * (-1.0 / 720 + y2 * (1.0 / 40320 + y2 * (-1.0 / 3628800 + y2 * (1.0 / 479001600.0 + y2 * (-1.0 / 87178291200.0)))))));
#pragma unroll
  for (int i = 0; i < 2; ++i) { const double s2 = 2.0 * sn * cs, c2 = cs * cs - sn * sn; sn = s2; cs = c2; }
  s = sn; c = cs;
}

DI void phase_prep(const Params& p, char* smem, unsigned* wcnt) {
  const int tid = otid();
  float* fs = (float*)smem;
  char* ws = p.ws;
  volatile LAS unsigned* slot = (volatile LAS unsigned*)(smem + 147456 + 64);
  constexpr int nB = 144, nE = 64, nC = 64, nD = 32, nA = 192, nI = 512, nF = 2 * 32 * 2, nG = 4, nH = 8, nJ = 64, nK = 32, nL = 512, nM = 512;
  constexpr int total = nB + nE + nC + nD + nA + nI + nF + nG + nH + nJ + nK + nL + nM;
  for (;;) {
    __syncthreads();
    if (tid == 0) *slot = __hip_atomic_fetch_add(wcnt, 1u, __ATOMIC_RELAXED, __HIP_MEMORY_SCOPE_AGENT);
    __syncthreads();
    int it = (int)*slot;
    if (it >= total) break;
    if (it < nB) {
      const float* w_in = p.w_in; const float* w_merge = p.w_merge;
      tconv_strip32<false>(fs, it * 32, 1024, (unsigned char*)(ws + OFF_WT1), (float*)(ws + OFF_SCW1), [=](int k, int n) -> float {
        if (n < 1280) {
          const bool roped = (n < 640) || (n >= 768 && n < 896) || (n >= 1024 && n < 1152);
          const int col = roped ? ((n & ~63) + dperm(n & 63)) : n;
          return w_in[(size_t)k * 2328 + col];
        }
        if (n < 2304) return w_in[(size_t)k * 2328 + n + 24];
        if (n < 4352) return w_merge[(size_t)k * 2048 + (n - 2304)];
        if (n < 4376) return w_in[(size_t)k * 2328 + 1280 + (n - 4352)];
        return 0.f; });
      continue;
    }
    it -= nB;
    if (it < nE) {
      const float* src = p.peer_wq;
      tconv_strip32<false>(fs, it * 32, 1024, (unsigned char*)(ws + OFF_WQ), (float*)(ws + OFF_SCWQ), [=](int k, int n) -> float { return src[(size_t)k * 2048 + n]; });
      continue;
    }
    it -= nE;
    if (it < nC) {
      const int br = it >> 5, strip = it & 31;
      const float* src = p.w_branch + (size_t)br * 512 * 1024;
      tconv_strip32<true>(fs, strip * 32, 512, (unsigned char*)(ws + OFF_WB) + (size_t)br * 1024 * 512, (float*)(ws + OFF_SCWB) + br * 32, [=](int k, int n) -> float { return src[(size_t)k * 1024 + n]; });
      continue;
    }
    it -= nC;
    if (it < nD) {
      const float* src = p.w_out;
      tconv_strip32<true>(fs, it * 32, 1024, (unsigned char*)(ws + OFF_WOUT), (float*)(ws + OFF_SCWO), [=](int k, int n) -> float { return src[(size_t)k * 1024 + n]; });
      continue;
    }
    it -= nD;
    if (it < nA) {
      float* sc = fs;
      float* red = fs + 8192;
      for (int i = tid; i < 8192; i += NT) { const float v = p.c[i]; sc[i] = v / (1.0f + __expf(-v)); }
      __syncthreads();
      const int ks = tid >> 5, cj = tid & 31, col = it * 32 + cj;
      float acc[8];
#pragma unroll
      for (int b = 0; b < 8; ++b) acc[b] = 0.f;
#pragma unroll 16
      for (int k = ks * 64; k < ks * 64 + 64; ++k) {
        const float w = p.w_ada[(size_t)k * 6144 + col];
#pragma unroll
        for (int b = 0; b < 8; ++b) acc[b] += sc[b * 1024 + k] * w;
      }
#pragma unroll
      for (int b = 0; b < 8; ++b) red[(ks * 8 + b) * 32 + cj] = acc[b];
      __syncthreads();
      if (tid < 256) {
        const int b = tid >> 5;
        float s = p.b_ada[col];
#pragma unroll
        for (int k2 = 0; k2 < 16; ++k2) s += red[(k2 * 8 + b) * 32 + cj];
        ((float*)(ws + OFF_MOD))[b * 6144 + col] = s;
      }
      continue;
    }
    it -= nA;
    if (it < nI) {
      const int e = it * 512 + tid, pos = e >> 5, i = e & 31;
      const float ang = (float)pos * p.inv_freq[i];
      const double a = (double)ang;
      const double kk = rint(a * 0.15915494309189535);
      const double r = a - kk * 6.283185307179586476925;
      double sn, cs; sincos_d(r, sn, cs);
      ((float*)(ws + OFF_ROPE))[e] = (float)cs;
      ((float*)(ws + OFF_ROPE))[262144 + e] = (float)sn;
      continue;
    }
    it -= nI;
    if (it < nF) {
      const int w = it >> 6, r = it & 63, kt = r >> 1, ntile = r & 1;
      const float* src = p.cmp_w1 + (size_t)w * 2048 * 128;
      tconv_tile(fs, kt * 64, ntile * 64, (bf16_t*)(ws + OFF_CW1) + (size_t)w * 128 * 2048, 2048, [=](int k, int n) -> float {
        const int ksrc = (w == 0) ? ((k & ~63) + dperm(k & 63)) : k;
        return src[(size_t)ksrc * 128 + n]; });
      continue;
    }
    it -= nF;
    if (it < nG) {
      const int w = it >> 1, kt = it & 1;
      const float* src = p.cmp_w2 + (size_t)w * 128 * 64;
      tconv_tile(fs, kt * 64, 0, (bf16_t*)(ws + OFF_CW2) + (size_t)w * 64 * 128, 128, [=](int k, int n) -> float { return src[(size_t)k * 64 + ((w == 0) ? dperm(n) : n)]; });
      continue;
    }
    it -= nG;
    if (it < nH) {
      const int w = it >> 2, jc = it & 3, ks = tid >> 5, cj = tid & 31, j = jc * 32 + cj;
      float* red = fs;
      const float* pos = p.cmp_pos + w * 2048; const float* w1 = p.cmp_w1 + (size_t)w * 2048 * 128;
      float acc = 0.f;
#pragma unroll 16
      for (int k = ks * 128; k < ks * 128 + 128; ++k) acc += pos[k] * w1[(size_t)k * 128 + j];
      red[ks * 32 + cj] = acc;
      __syncthreads();
      if (tid < 32) { float s = p.cmp_b1[w * 128 + j]; for (int k2 = 0; k2 < 16; ++k2) s += red[k2 * 32 + tid]; ((float*)(ws + OFF_POSB))[w * 128 + j] = s; }
      continue;
    }
    it -= nH;
    if (it < nJ) { conv_chunk(p.peer_keys, (bf16_t*)(ws + OFF_PKEYS), (size_t)it * 4096); continue; }
    it -= nJ;
    if (it < nK) {
      const size_t i0 = (size_t)it * 4096 + (size_t)tid * 8;
      const int rowi = (int)((i0 >> 7) & 127), j0 = (int)(i0 & 127);
      float v[8];
#pragma unroll
      for (int j = 0; j < 8; ++j) v[j] = (j0 + j <= rowi) ? p.sgu_w[i0 + j] : 0.f;
      u32x4 w; w.x = pack2(v[0], v[1]); w.y = pack2(v[2], v[3]); w.z = pack2(v[4], v[5]); w.w = pack2(v[6], v[7]);
      *(u32x4*)((bf16_t*)(ws + OFF_SGUW) + i0) = w;
      continue;
    }
    it -= nK;
    {
      const bool isv = it >= nL;
      if (isv) it -= nL;
      const int lane = tid & 63, e0 = it * 32 + (tid >> 6) * 4;
      const float* src = (isv ? p.peer_v : p.peer_u) + (size_t)e0 * 1024 + lane * 16;
      f32x4 raw[4][4];
#pragma unroll
      for (int r = 0; r < 4; ++r)
#pragma unroll
        for (int i = 0; i < 4; ++i) raw[r][i] = *(const f32x4*)(src + (size_t)r * 1024 + i * 4);
#pragma unroll
      for (int r = 0; r < 4; ++r) {
        const int e = e0 + r;
        float v[16];
#pragma unroll
        for (int i = 0; i < 4; ++i) { v[4 * i] = raw[r][i].x; v[4 * i + 1] = raw[r][i].y; v[4 * i + 2] = raw[r][i].z; v[4 * i + 3] = raw[r][i].w; }
        float amax = 0.f;
#pragma unroll
        for (int i = 0; i < 16; ++i) amax = fmaxf(amax, fabsf(v[i]));
#pragma unroll
        for (int o = 32; o > 0; o >>= 1) amax = fmaxf(amax, __shfl_xor(amax, o));
        if (!isv) {
          const float qs = amax > 0.f ? 127.0f / amax : 0.f;
          u32x4 wi; wi.x = pack_i8x4(v[0] * qs, v[1] * qs, v[2] * qs, v[3] * qs); wi.y = pack_i8x4(v[4] * qs, v[5] * qs, v[6] * qs, v[7] * qs);
          wi.z = pack_i8x4(v[8] * qs, v[9] * qs, v[10] * qs, v[11] * qs); wi.w = pack_i8x4(v[12] * qs, v[13] * qs, v[14] * qs, v[15] * qs);
          *(u32x4*)(ws + OFF_PU8 + ((size_t)(lane >> 3) * 16384 + e) * 128 + (lane & 7) * 16) = wi;
          if (lane == 0) ((float*)(ws + OFF_SCU))[e] = amax * (1.0f / 127.0f);
        } else {
          const unsigned be = (__float_as_uint(amax) >> 23) & 0xffu;
          const bool okr = be >= 16u && be <= 240u;
          const float scale = okr ? __uint_as_float((261u - be) << 23) : 1.0f;
          const float inv = okr ? __uint_as_float((be - 7u) << 23) : 1.0f;
          u32x4 w; w.x = pk4_fp8(v[0] * scale, v[1] * scale, v[2] * scale, v[3] * scale); w.y = pk4_fp8(v[4] * scale, v[5] * scale, v[6] * scale, v[7] * scale);
          w.z = pk4_fp8(v[8] * scale, v[9] * scale, v[10] * scale, v[11] * scale); w.w = pk4_fp8(v[12] * scale, v[13] * scale, v[14] * scale, v[15] * scale);
          *(u32x4*)(ws + OFF_PV8 + ((size_t)(lane >> 3) * 16384 + e) * 128 + (lane & 7) * 16) = w;
          if (lane == 0) ((float*)(ws + OFF_SCV))[e] = inv;
        }
      }
    }
  }
}

DI void row_stats(const float (&v)[16], float& mean, float& rstd) {
  float s = 0.f;
#pragma unroll
  for (int i = 0; i < 16; ++i) s += v[i];
  mean = wave_sum(s) * (1.0f / 1024.0f);
  float q = 0.f;
#pragma unroll
  for (int i = 0; i < 16; ++i) { const float d = v[i] - mean; q += d * d; }
  rstd = rsqrtf(wave_sum(q) * (1.0f / 1024.0f) + LN_EPS);
}

DI void phase_ln_in(const Params& p) {
  const int lane = otid() & 63, wave = otid() >> 6;
  const float* mod = (const float*)(p.ws + OFF_MOD);
  unsigned* h8 = (unsigned*)(p.ws + OFF_H);
  for (int grp = blockIdx.x; grp < NTOK / NW; grp += gridDim.x) {
    const int row = grp * NW + wave, b = row >> 13;
    const float* xr = p.x + (size_t)row * DM;
    float v[16];
#pragma unroll
    for (int i = 0; i < 4; ++i) { const f32x4 t = *(const f32x4*)(xr + i * 256 + lane * 4); v[4 * i] = t.x; v[4 * i + 1] = t.y; v[4 * i + 2] = t.z; v[4 * i + 3] = t.w; }
    float mean, rstd; row_stats(v, mean, rstd);
    float amax = 0.f;
#pragma unroll
    for (int i = 0; i < 4; ++i) {
      const int col = i * 256 + lane * 4;
      const f32x4 sh = *(const f32x4*)(mod + b * 6144 + col), sc = *(const f32x4*)(mod + b * 6144 + 1024 + col);
      const float o0 = (v[4 * i] - mean) * rstd * (1.f + sc.x) + sh.x, o1 = (v[4 * i + 1] - mean) * rstd * (1.f + sc.y) + sh.y;
      const float o2 = (v[4 * i + 2] - mean) * rstd * (1.f + sc.z) + sh.z, o3 = (v[4 * i + 3] - mean) * rstd * (1.f + sc.w) + sh.w;
      v[4 * i] = o0; v[4 * i + 1] = o1; v[4 * i + 2] = o2; v[4 * i + 3] = o3;
      amax = fmaxf(amax, fmaxf(fmaxf(fabsf(o0), fabsf(o1)), fmaxf(fabsf(o2), fabsf(o3))));
    }
#pragma unroll
    for (int o = 32; o > 0; o >>= 1) amax = fmaxf(amax, __shfl_xor(amax, o));
    const float qs = amax > 0.f ? 127.0f / amax : 0.f;
#pragma unroll
    for (int i = 0; i < 4; ++i) h8[(size_t)row * 256 + i * 64 + lane] = pack_i8x4(v[4 * i] * qs, v[4 * i + 1] * qs, v[4 * i + 2] * qs, v[4 * i + 3] * qs);
    if (lane == 0) ((float*)(p.ws + OFF_SA))[row] = amax * (1.0f / 127.0f);
  }
}

DI void phase_ln_mid(const Params& p) {
  const int lane = otid() & 63, wave = otid() >> 6;
  const float* mod = (const float*)(p.ws + OFF_MOD);
  const bf16_t* y = (const bf16_t*)(p.ws + OFF_Y);
  bf16_t* x1 = (bf16_t*)(p.ws + OFF_X1);
  for (int grp = blockIdx.x; grp < NTOK / NW; grp += gridDim.x) {
    const int row = grp * NW + wave, b = row >> 13;
    const bf16_t* yr = y + (size_t)row * DM;
    float v[16];
#pragma unroll
    for (int i = 0; i < 4; ++i) { const u32x2 t = *(const u32x2*)(yr + i * 256 + lane * 4); v[4 * i] = bflo(t.x); v[4 * i + 1] = bfhi(t.x); v[4 * i + 2] = bflo(t.y); v[4 * i + 3] = bfhi(t.y); }
    float mean, rstd; row_stats(v, mean, rstd);
#pragma unroll
    for (int i = 0; i < 4; ++i) {
      const int col = i * 256 + lane * 4;
      const f32x4 g = *(const f32x4*)(p.ln1_g + col), bb = *(const f32x4*)(p.ln1_b + col);
      f32x4 o;
      o.x = (v[4 * i] - mean) * rstd * g.x + bb.x; o.y = (v[4 * i + 1] - mean) * rstd * g.y + bb.y;
      o.z = (v[4 * i + 2] - mean) * rstd * g.z + bb.z; o.w = (v[4 * i + 3] - mean) * rstd * g.w + bb.w;
      { u32x2 w; w.x = pack2(o.x, o.y); w.y = pack2(o.z, o.w); *(u32x2*)(x1 + (size_t)row * DM + col) = w; }
      v[4 * i] = o.x; v[4 * i + 1] = o.y; v[4 * i + 2] = o.z; v[4 * i + 3] = o.w;
    }
    row_stats(v, mean, rstd);
    float amax = 0.f;
#pragma unroll
    for (int i = 0; i < 4; ++i) {
      const int col = i * 256 + lane * 4;
      const f32x4 sh = *(const f32x4*)(mod + b * 6144 + 3072 + col), sc = *(const f32x4*)(mod + b * 6144 + 4096 + col);
      const float o0 = (v[4 * i] - mean) * rstd * (1.f + sc.x) + sh.x, o1 = (v[4 * i + 1] - mean) * rstd * (1.f + sc.y) + sh.y;
      const float o2 = (v[4 * i + 2] - mean) * rstd * (1.f + sc.z) + sh.z, o3 = (v[4 * i + 3] - mean) * rstd * (1.f + sc.w) + sh.w;
      v[4 * i] = o0; v[4 * i + 1] = o1; v[4 * i + 2] = o2; v[4 * i + 3] = o3;
      amax = fmaxf(amax, fmaxf(fmaxf(fabsf(o0), fabsf(o1)), fmaxf(fabsf(o2), fabsf(o3))));
    }
#pragma unroll
    for (int o = 32; o > 0; o >>= 1) amax = fmaxf(amax, __shfl_xor(amax, o));
    const float qs = amax > 0.f ? 127.0f / amax : 0.f;
    unsigned* h2q = (unsigned*)(p.ws + OFF_H2Q);
#pragma unroll
    for (int i = 0; i < 4; ++i) h2q[(size_t)row * 256 + i * 64 + lane] = pack_i8x4(v[4 * i] * qs, v[4 * i + 1] * qs, v[4 * i + 2] * qs, v[4 * i + 3] * qs);
    if (lane == 0) ((float*)(p.ws + OFF_SH))[row] = amax * (1.0f / 127.0f);
  }
}

namespace pg8 {
constexpr int BM = 256, BK = 64, HALF = 128, HTB = HALF * BK * 2, STAGE_BYTES = 8 * HTB, NXCD = 8, WGM = 8;
DI int lds_byte(int r, int c) { const int st = (r >> 4) * 2 + (c >> 5), rr = r & 15, cc = c & 31, ob = rr * 64 + cc * 2; return st * 1024 + (ob ^ (((ob >> 9) & 1) << 5)); }
DI void stage_rc(int b, int& R, int& C) { const int st = b / 1024, sb = b % 1024, swz = sb ^ (((sb >> 9) & 1) << 5); R = (st >> 1) * 16 + swz / 64; C = (st & 1) * 32 + (swz % 64) / 2; }
DI int perm32(int rho) { const int n = rho >> 4, i = rho & 15; return 8 * (i >> 2) + 4 * n + (i & 3); }
struct Unit { int pm, pn; };
struct Gemm { const bf16_t* A; const bf16_t* Bt; int M, N, K; };
struct StaticOrder {
  int nM, nN, nwg, G, c, nr, rot;
  DI void init(int M, int N, int G_, int c_, bool rotate = false) {
    nM = M / BM; nN = N / BM; nwg = nM * nN; G = G_; c = c_;
    nr = (rotate && nwg % G == 0) ? nwg / G : 0; rot = nr ? ((c % NXCD) * nr) / NXCD : 0;
  }
  DI bool next(int i, Unit& u) const {
    if (nr) { if (i >= nr) return false; i += rot; if (i >= nr) i -= nr; }
    const long L = (long)i * G + c; if (L >= nwg) return false;
    int wgid = (int)L; { const int q = nwg / NXCD, r = nwg % NXCD, xcd = wgid % NXCD, off = wgid / NXCD; wgid = (xcd < r ? xcd * (q + 1) : r * (q + 1) + (xcd - r) * q) + off; }
    const int nig = WGM * nN, gid = wgid / nig, fm = gid * WGM, gsz = (nM - fm) < WGM ? (nM - fm) : WGM;
    u.pm = fm + ((wgid % nig) % gsz); u.pn = (wgid % nig) / gsz; return true;
  }
};

template <int MODE, class AccT>
DI AccT mma_pair(bf16x8 b0, bf16x8 b1, bf16x8 a0, bf16x8 a1, AccT c) {
  if constexpr (MODE == 0) { c = __builtin_amdgcn_mfma_f32_16x16x32_bf16(b0, a0, c, 0, 0, 0); return __builtin_amdgcn_mfma_f32_16x16x32_bf16(b1, a1, c, 0, 0, 0); }
  else if constexpr (MODE == 1) {
    c = __builtin_amdgcn_mfma_i32_16x16x64_i8(__builtin_bit_cast(i32x4, b0), __builtin_bit_cast(i32x4, a0), c, 0, 0, 0);
    return __builtin_amdgcn_mfma_i32_16x16x64_i8(__builtin_bit_cast(i32x4, b1), __builtin_bit_cast(i32x4, a1), c, 0, 0, 0);
  } else {
    const i32x8 B = __builtin_shufflevector(__builtin_bit_cast(i32x4, b0), __builtin_bit_cast(i32x4, b1), 0, 1, 2, 3, 4, 5, 6, 7);
    const i32x8 A = __builtin_shufflevector(__builtin_bit_cast(i32x4, a0), __builtin_bit_cast(i32x4, a1), 0, 1, 2, 3, 4, 5, 6, 7);
    asm volatile("v_mfma_f32_16x16x128_f8f6f4 %0, %1, %2, %0" : "+v"(c) : "v"(B), "v"(A));
    return c;
  }
}
DI f32x4 mma16(bf16x8 a, bf16x8 b, f32x4 c) { return __builtin_amdgcn_mfma_f32_16x16x32_bf16(a, b, c, 0, 0, 0); }
DI i32x4 mma16(bf16x8 a, bf16x8 b, i32x4 c) { return __builtin_amdgcn_mfma_i32_16x16x64_i8(__builtin_bit_cast(i32x4, a), __builtin_bit_cast(i32x4, b), c, 0, 0, 0); }
template <class Epi>
DI void gemm_phase(LAS unsigned char* lds, const Gemm g, const StaticOrder& S, const Epi& E) {
  const int tid = otid(), wid = __builtin_amdgcn_readfirstlane(tid >> 6), lane = tid & 63, wr = wid >> 2, wc = wid & 3, fr = lane & 15, fq = lane >> 4;
  const int K = g.K, nt = K / BK;
  unsigned voffA[2], voffB[2];
#pragma unroll
  for (int i = 0; i < 2; ++i) { int R, C; stage_rc(tid * 16 + i * 8192, R, C); const int Rb = Epi::PERM ? ((R & ~31) + perm32(R & 31)) : R;
    voffA[i] = (unsigned)(R * K + C) * 2u; voffB[i] = (unsigned)(Rb * K + C) * 2u; }
  const size_t kstep = (size_t)(BK * 2);
  const size_t hstep = (size_t)HALF * K * 2;
  const size_t tstep = 2 * hstep;
  const unsigned ldsw = (unsigned)wid * 1024u;
  const int aoff = lds_byte(wr * 64 + fr, fq * 8), boff = lds_byte(wc * 32 + fr, fq * 8);
  LAS unsigned char* ldsB = lds + 4 * HTB + boff;
  asm volatile("" : "+v"(ldsB));
#define PG8_SA(b, h) (((b) * 2 + (h)) * HTB)
#define PG8_SB(b, h) ((4 + (b) * 2 + (h)) * HTB)
#define PG8_STAGE(bufoff, gbase, voff) do { _Pragma("unroll") for (int _i = 0; _i < 2; ++_i) \
    __builtin_amdgcn_global_load_lds((const unsigned*)((const char*)(gbase) + (voff)[_i]), (LAS unsigned*)(lds + (bufoff) + ldsw + _i * 8192), 16, 0, 0); } while (0)
#define PG8_LDA(dst, b, h) do { _Pragma("unroll") for (int m = 0; m < 4; ++m) _Pragma("unroll") for (int k = 0; k < 2; ++k) dst[m][k] = *(const LAS bf16x8*)(lds + PG8_SA(b, h) + aoff + m * 2048 + k * 1024); } while (0)
#define PG8_LDB(dst, b, h) do { _Pragma("unroll") for (int n = 0; n < 2; ++n) _Pragma("unroll") for (int k = 0; k < 2; ++k) dst[n][k] = *(const LAS bf16x8*)(ldsB + ((b) * 2 + (h)) * HTB + n * 2048 + k * 1024); } while (0)
#define PG8_MMA(ai, bj, At, Bt) do { __builtin_amdgcn_s_setprio(1); _Pragma("unroll") for (int m = 0; m < 4; ++m) _Pragma("unroll") for (int n = 0; n < 2; ++n) \
    acc[ai][bj][m][n] = mma_pair<Epi::MODE>(Bt[n][0], Bt[n][1], At[m][0], At[m][1], acc[ai][bj][m][n]); __builtin_amdgcn_s_setprio(0); } while (0)
#define PG8_WAIT_V(n) asm volatile("s_waitcnt vmcnt(" #n ")" ::: "memory")
#define PG8_WAIT_L(n) asm volatile("s_waitcnt lgkmcnt(" #n ")" ::: "memory")
#define PG8_BAR __builtin_amdgcn_s_barrier()
#define PG8_SCHED __builtin_amdgcn_sched_barrier(0)
  Unit cur, nxt; int ui = 0;
  if (!S.next(0, cur)) return;
  typedef typename Epi::AccT AccT;
  const AccT zacc = {0, 0, 0, 0};
  AccT acc[2][2][4][2];
#pragma unroll
  for (int a = 0; a < 2; ++a)
#pragma unroll
    for (int b = 0; b < 2; ++b)
#pragma unroll
      for (int m = 0; m < 4; ++m)
#pragma unroll
        for (int n = 0; n < 2; ++n) acc[a][b][m][n] = zacc;
  bf16x8 At[4][2], B0[2][2], B1[2][2];
  const char* cA = (const char*)g.A + (size_t)cur.pm * tstep; const char* cB = (const char*)g.Bt + (size_t)cur.pn * tstep;
  PG8_STAGE(PG8_SB(0, 0), cB, voffB); PG8_STAGE(PG8_SA(0, 0), cA, voffA); PG8_STAGE(PG8_SB(0, 1), cB + hstep, voffB); PG8_STAGE(PG8_SA(0, 1), cA + hstep, voffA);
  if (wr == 1) PG8_BAR;
  PG8_WAIT_V(4); PG8_BAR;
  PG8_STAGE(PG8_SB(1, 0), cB + kstep, voffB); PG8_STAGE(PG8_SA(1, 0), cA + kstep, voffA); PG8_STAGE(PG8_SB(1, 1), cB + hstep + kstep, voffB);
  PG8_WAIT_V(6); PG8_BAR;
  for (;;) {
    const bool has_next = S.next(ui + 1, nxt);
    const char* nA = has_next ? (const char*)g.A + (size_t)nxt.pm * tstep : cA; const char* nB = has_next ? (const char*)g.Bt + (size_t)nxt.pn * tstep : cB;
#pragma unroll 1
    for (int t = 0; t < nt; t += 2) {
      const bool last = (t == nt - 2);
      const char* a1 = cA + (size_t)(t + 1) * kstep;
      const char* a2 = last ? nA : cA + (size_t)(t + 2) * kstep; const char* b2 = last ? nB : cB + (size_t)(t + 2) * kstep;
      const char* a3 = a2 + kstep; const char* b3 = b2 + kstep;
      PG8_LDB(B0, 0, 0); PG8_SCHED; PG8_LDA(At, 0, 0); PG8_STAGE(PG8_SA(1, 1), a1 + hstep, voffA);
      PG8_WAIT_L(8); PG8_BAR; PG8_WAIT_L(0); PG8_MMA(0, 0, At, B0); PG8_BAR; PG8_SCHED;
      PG8_LDB(B1, 0, 1); PG8_STAGE(PG8_SB(0, 0), b2, voffB);
      PG8_BAR; PG8_WAIT_L(0); PG8_MMA(0, 1, At, B1); PG8_BAR;
      PG8_LDA(At, 0, 1); PG8_STAGE(PG8_SA(0, 0), a2, voffA);
      PG8_BAR; PG8_WAIT_L(0); PG8_MMA(1, 0, At, B0); PG8_BAR; PG8_SCHED;
      PG8_STAGE(PG8_SB(0, 1), b2 + hstep, voffB);
      PG8_WAIT_V(6); PG8_BAR; PG8_MMA(1, 1, At, B1); PG8_BAR;
      PG8_LDB(B0, 1, 0); PG8_SCHED; PG8_LDA(At, 1, 0); PG8_STAGE(PG8_SA(0, 1), a2 + hstep, voffA);
      PG8_WAIT_L(8); PG8_BAR; PG8_WAIT_L(0); PG8_MMA(0, 0, At, B0); PG8_BAR; PG8_SCHED;
      PG8_LDB(B1, 1, 1); PG8_STAGE(PG8_SB(1, 0), b3, voffB);
      PG8_BAR; PG8_WAIT_L(0); PG8_MMA(0, 1, At, B1); PG8_BAR;
      PG8_LDA(At, 1, 1); PG8_STAGE(PG8_SA(1, 0), a3, voffA);
      PG8_BAR; PG8_WAIT_L(0); PG8_MMA(1, 0, At, B0); PG8_BAR; PG8_SCHED;
      PG8_STAGE(PG8_SB(1, 1), b3 + hstep, voffB);
      PG8_WAIT_V(6); PG8_BAR; PG8_MMA(1, 1, At, B1); PG8_BAR;
    }
    PG8_SCHED;
    if constexpr (Epi::MODE == 2) asm volatile("s_nop 15\n\ts_nop 15\n\ts_nop 15\n\ts_nop 15" ::: "memory");
    { const int l2 = otid() & 63; E(acc, cur, wr, wc, l2 & 15, l2 >> 4); }
    PG8_SCHED;
    if (!has_next) break;
#pragma unroll
    for (int a = 0; a < 2; ++a)
#pragma unroll
      for (int b = 0; b < 2; ++b)
#pragma unroll
        for (int m = 0; m < 4; ++m)
#pragma unroll
          for (int n = 0; n < 2; ++n) acc[a][b][m][n] = zacc;
    cur = nxt; cA = nA; cB = nB; ++ui;
  }
  PG8_WAIT_V(0);
  if (wr == 0) PG8_BAR;
  PG8_BAR;
#undef PG8_SA
#undef PG8_SB
#undef PG8_STAGE
#undef PG8_LDA
#undef PG8_LDB
#undef PG8_MMA
#undef PG8_WAIT_V
#undef PG8_WAIT_L
#undef PG8_BAR
#undef PG8_SCHED
}
}

struct EpiProj {
  static constexpr bool PERM = true;
  static constexpr int MODE = 1;
  typedef i32x4 AccT;
  char* ws; const float* b_merge;
  DI void operator()(const i32x4 (&acc)[2][2][4][2], const pg8::Unit& u, int wr, int wc, int fr, int fq) const {
    const float* rope = (const float*)(ws + OFF_ROPE);
    const float* sa = (const float*)(ws + OFF_SA); const float* sw = (const float*)(ws + OFF_SCW1);
    const int row0 = u.pm * 256 + wr * 64 + fr;
#pragma unroll
    for (int bj = 0; bj < 2; ++bj) {
      const int cg = u.pn * 256 + bj * 128 + wc * 32;
      const int c0 = cg + 8 * fq;
      if (cg >= 4384) continue;
      const float sbg = sw[cg >> 5];
#define EPJ_CV(sc_) const float f_ = sa[row] * (sc_); const f32x4 cv0 = __builtin_convertvector(acc[ai][bj][m][0], f32x4) * f_, cv1 = __builtin_convertvector(acc[ai][bj][m][1], f32x4) * f_;
      if (cg < 1280 && (cg < 640 || (cg >= 768 && cg < 896) || (cg >= 1024 && cg < 1152))) {
        bf16_t* dst; unsigned ld, cofs; float scale = 1.0f;
        if (cg < 512) { dst = (bf16_t*)(ws + OFF_Q); ld = 512; cofs = c0; scale = 0.18033688011112042f; }
        else if (cg < 640) { dst = (bf16_t*)(ws + OFF_KC); ld = 128; cofs = c0 - 512; }
        else if (cg < 896) { dst = (bf16_t*)(ws + OFF_KS); ld = 128; cofs = c0 - 768; }
        else { dst = (bf16_t*)(ws + OFF_KW); ld = 128; cofs = c0 - 1024; }
        const int d0 = 16 * ((cg >> 5) & 1) + 4 * fq;
#pragma unroll
        for (int ai = 0; ai < 2; ++ai)
#pragma unroll
          for (int m = 0; m < 4; ++m) {
            const int row = row0 + ai * 128 + m * 16, pos = row & (SEQ - 1);
            const f32x4 cs = *(const f32x4*)(rope + pos * 32 + d0), sn = *(const f32x4*)(rope + 262144 + pos * 32 + d0);
            EPJ_CV(sbg * scale)
            const f32x4 o1 = cv0 * cs - cv1 * sn, o2 = cv0 * sn + cv1 * cs;
            u32x4 w; w.x = pack2(o1.x, o1.y); w.y = pack2(o1.z, o1.w); w.z = pack2(o2.x, o2.y); w.w = pack2(o2.z, o2.w);
            *(u32x4*)(dst + (unsigned)row * ld + cofs) = w;
          }
      } else if (cg < 1280) {
        bf16_t* dst; unsigned cofs;
        if (cg < 768) { dst = (bf16_t*)(ws + OFF_VC); cofs = c0 - 640; }
        else if (cg < 1024) { dst = (bf16_t*)(ws + OFF_VS); cofs = c0 - 896; }
        else { dst = (bf16_t*)(ws + OFF_VW); cofs = c0 - 1152; }
#pragma unroll
        for (int ai = 0; ai < 2; ++ai)
#pragma unroll
          for (int m = 0; m < 4; ++m) {
            const int row = row0 + ai * 128 + m * 16;
            EPJ_CV(sbg)
            const f32x4 a = cv0, b = cv1;
            u32x4 w; w.x = pack2(a.x, a.y); w.y = pack2(a.z, a.w); w.z = pack2(b.x, b.y); w.w = pack2(b.z, b.w);
            *(u32x4*)(dst + (unsigned)row * 128u + cofs) = w;
          }
      } else if (cg < 2304) {
        bf16_t* dst = (bf16_t*)(ws + (cg < 1792 ? OFF_U : OFF_V));
        const unsigned cofs = c0 - (cg < 1792 ? 1280 : 1792);
#pragma unroll
        for (int ai = 0; ai < 2; ++ai)
#pragma unroll
          for (int m = 0; m < 4; ++m) {
            const int row = row0 + ai * 128 + m * 16;
            EPJ_CV(sbg)
            const f32x4 a = cv0, b = cv1;
            const f32x2 g0 = gelu_pk((f32x2){a.x, a.y}), g1 = gelu_pk((f32x2){a.z, a.w}), g2 = gelu_pk((f32x2){b.x, b.y}), g3 = gelu_pk((f32x2){b.z, b.w});
            u32x4 w; w.x = pack2(g0.x, g0.y); w.y = pack2(g1.x, g1.y); w.z = pack2(g2.x, g2.y); w.w = pack2(g3.x, g3.y);
            *(u32x4*)(dst + (unsigned)row * 512u + cofs) = w;
          }
      } else if (cg < 4352) {
        unsigned char* dst = (unsigned char*)(ws + OFF_GATE8);
        const unsigned cofs = c0 - 2304;
        const f32x4 b0 = *(const f32x4*)(b_merge + cofs), b1 = *(const f32x4*)(b_merge + cofs + 4);
#pragma unroll
        for (int ai = 0; ai < 2; ++ai)
#pragma unroll
          for (int m = 0; m < 4; ++m) {
            const int row = row0 + ai * 128 + m * 16;
            EPJ_CV(sbg)
            const f32x4 a = cv0 + b0, b = cv1 + b1;
            u32x2 w; w.x = pk4_fp8(sigmoid_f(a.x), sigmoid_f(a.y), sigmoid_f(a.z), sigmoid_f(a.w));
            w.y = pk4_fp8(sigmoid_f(b.x), sigmoid_f(b.y), sigmoid_f(b.z), sigmoid_f(b.w));
            *(u32x2*)(dst + (unsigned)row * 2048u + cofs) = w;
          }
      } else {
        float* gs = (float*)(ws + OFF_GSIG);
        if (fq < 3) {
#pragma unroll
          for (int ai = 0; ai < 2; ++ai)
#pragma unroll
            for (int m = 0; m < 4; ++m) {
              const int row = row0 + ai * 128 + m * 16;
              EPJ_CV(sbg)
              const f32x4 a = cv0, b = cv1;
              f32x4 o0, o1; o0.x = sigmoid_f(a.x); o0.y = sigmoid_f(a.y); o0.z = sigmoid_f(a.z); o0.w = sigmoid_f(a.w);
              o1.x = sigmoid_f(b.x); o1.y = sigmoid_f(b.y); o1.z = sigmoid_f(b.z); o1.w = sigmoid_f(b.w);
              *(f32x4*)(gs + (unsigned)row * 32u + 8 * fq) = o0; *(f32x4*)(gs + (unsigned)row * 32u + 8 * fq + 4) = o1;
            }
        }
      }
    }
  }
};
DI void phase_gemm1(const Params& p, char* smem) {
  pg8::Gemm g{(const bf16_t*)(p.ws + OFF_H), (const bf16_t*)(p.ws + OFF_WT1), NTOK, N1, 512};
  pg8::StaticOrder S; S.init(NTOK, N1, gridDim.x, blockIdx.x, true);
  EpiProj E{p.ws, p.b_merge};
  pg8::gemm_phase((LAS unsigned char*)smem, g, S, E);
}

template <int BR> struct EpiMerge {
  static constexpr bool PERM = true;
  static constexpr int MODE = 2;
  typedef f32x4 AccT;
  char* ws;
  DI void operator()(const f32x4 (&acc)[2][2][4][2], const pg8::Unit& u, int wr, int wc, int fr, int fq) const {
    const unsigned char* gate = (const unsigned char*)(ws + OFF_GATE8);
    unsigned char* m0 = (unsigned char*)(ws + OFF_M08);
    unsigned char* mrg = (unsigned char*)(ws + OFF_MRG8);
    const float* sw = (const float*)(ws + OFF_SCWB) + BR * 32;
    const int row0 = u.pm * 256 + wr * 64 + fr;
#pragma unroll
    for (int bj = 0; bj < 2; ++bj) {
      const unsigned cgp = u.pn * 256 + bj * 128 + wc * 32, c0 = cgp + 8 * fq;
      const float f = sw[cgp >> 5] * (BR == 0 ? 1.0f : 2.0f);
#pragma unroll
      for (int ai = 0; ai < 2; ++ai)
#pragma unroll
        for (int m = 0; m < 4; ++m) {
          const unsigned row = row0 + ai * 128 + m * 16;
          float gg[8]; unpack8_fp8(*(const u32x2*)(gate + row * 2048u + BR * 1024 + c0), gg);
          const f32x4 a = acc[ai][bj][m][0] * f, b = acc[ai][bj][m][1] * f;
          float v[8] = {a.x * gg[0], a.y * gg[1], a.z * gg[2], a.w * gg[3], b.x * gg[4], b.y * gg[5], b.z * gg[6], b.w * gg[7]};
          if (BR == 1) {
            float old[8]; unpack8_fp8(*(const u32x2*)(m0 + row * 1024u + c0), old);
#pragma unroll
            for (int j = 0; j < 8; ++j) v[j] += old[j];
          }
#pragma unroll
          for (int j = 0; j < 8; ++j) v[j] = clamp_f8(v[j]);
          u32x2 w; w.x = pk4_fp8(v[0], v[1], v[2], v[3]); w.y = pk4_fp8(v[4], v[5], v[6], v[7]);
          *(u32x2*)((BR == 0 ? m0 : mrg) + row * 1024u + c0) = w;
        }
    }
  }
};
DI void phase_merge(const Params& p, char* smem) {
  pg8::StaticOrder S; S.init(NTOK, 1024, gridDim.x, blockIdx.x);
  {
    pg8::Gemm g{(const bf16_t*)(p.ws + OFF_ONSA8), (const bf16_t*)(p.ws + OFF_WB), NTOK, 1024, 256};
    EpiMerge<0> E{p.ws};
    pg8::gemm_phase((LAS unsigned char*)smem, g, S, E);
  }
  {
    pg8::Gemm g{(const bf16_t*)(p.ws + OFF_OSGU8), (const bf16_t*)(p.ws + OFF_WB + (size_t)1024 * 512), NTOK, 1024, 256};
    EpiMerge<1> E{p.ws};
    pg8::gemm_phase((LAS unsigned char*)smem, g, S, E);
  }
}

struct EpiOut {
  static constexpr bool PERM = true;
  static constexpr int MODE = 2;
  typedef f32x4 AccT;
  char* ws; const float* x;
  DI void operator()(const f32x4 (&acc)[2][2][4][2], const pg8::Unit& u, int wr, int wc, int fr, int fq) const {
    const float* mod = (const float*)(ws + OFF_MOD);
    bf16_t* y = (bf16_t*)(ws + OFF_Y);
    const int row0 = u.pm * 256 + wr * 64 + fr, b = (u.pm * 256) >> 13;
#pragma unroll
    for (int bj = 0; bj < 2; ++bj) {
      const unsigned c0 = u.pn * 256 + bj * 128 + wc * 32 + 8 * fq;
      const float f = ((const float*)(ws + OFF_SCWO))[c0 >> 5] * 0.0625f;
      const f32x4 g0 = *(const f32x4*)(mod + b * 6144 + 2048 + c0) * f, g1 = *(const f32x4*)(mod + b * 6144 + 2048 + c0 + 4) * f;
#pragma unroll
      for (int ai = 0; ai < 2; ++ai)
#pragma unroll
        for (int m = 0; m < 4; ++m) {
          const unsigned o = (unsigned)(row0 + ai * 128 + m * 16) * 1024u + c0;
          const f32x4 x0 = *(const f32x4*)(x + o), x1v = *(const f32x4*)(x + o + 4);
          const f32x4 v0 = x0 * DN_ALPHA + g0 * acc[ai][bj][m][0], v1 = x1v * DN_ALPHA + g1 * acc[ai][bj][m][1];
          u32x4 w; w.x = pack2(v0.x, v0.y); w.y = pack2(v0.z, v0.w); w.z = pack2(v1.x, v1.y); w.w = pack2(v1.z, v1.w);
          *(u32x4*)(y + o) = w;
        }
    }
  }
};
DI void phase_outproj(const Params& p, char* smem) {
  pg8::Gemm g{(const bf16_t*)(p.ws + OFF_MRG8), (const bf16_t*)(p.ws + OFF_WOUT), NTOK, 1024, 512};
  pg8::StaticOrder S; S.init(NTOK, 1024, gridDim.x, blockIdx.x);
  EpiOut E{p.ws, p.x};
  pg8::gemm_phase((LAS unsigned char*)smem, g, S, E);
}

struct EpiPq {
  static constexpr bool PERM = true;
  static constexpr int MODE = 1;
  typedef i32x4 AccT;
  char* ws;
  DI void operator()(const i32x4 (&acc)[2][2][4][2], const pg8::Unit& u, int wr, int wc, int fr, int fq) const {
    bf16_t* pq = (bf16_t*)(ws + OFF_PQ);
    const float* sh = (const float*)(ws + OFF_SH); const float* sq = (const float*)(ws + OFF_SCWQ);
    const int row0 = u.pm * 256 + wr * 64 + fr;
#pragma unroll
    for (int bj = 0; bj < 2; ++bj) {
      const unsigned c0 = u.pn * 256 + bj * 128 + wc * 32 + 8 * fq;
      const float sbg = sq[(u.pn * 256 + bj * 128 + wc * 32) >> 5];
#pragma unroll
      for (int ai = 0; ai < 2; ++ai)
#pragma unroll
        for (int m = 0; m < 4; ++m) {
          const float f_ = sh[row0 + ai * 128 + m * 16] * sbg;
          const f32x4 a = __builtin_convertvector(acc[ai][bj][m][0], f32x4) * f_, b = __builtin_convertvector(acc[ai][bj][m][1], f32x4) * f_;
          u32x4 w; w.x = pack2(a.x, a.y); w.y = pack2(a.z, a.w); w.z = pack2(b.x, b.y); w.w = pack2(b.z, b.w);
          *(u32x4*)(pq + (unsigned)(row0 + ai * 128 + m * 16) * 2048u + c0) = w;
        }
    }
  }
};
DI void phase_peerq(const Params& p, char* smem) {
  pg8::Gemm g{(const bf16_t*)(p.ws + OFF_H2Q), (const bf16_t*)(p.ws + OFF_WQ), NTOK, 2048, 512};
  pg8::StaticOrder S; S.init(NTOK, 2048, gridDim.x, blockIdx.x);
  EpiPq E{p.ws};
  pg8::gemm_phase((LAS unsigned char*)smem, g, S, E);
}

DI void phase_sgu(const Params& p, char* smem) {
  char* ws = p.ws;
  const int tid = otid(), lane = tid & 63, wave = tid >> 6, l31 = lane & 31, hh = lane >> 5;
  const bf16_t* u = (const bf16_t*)(ws + OFF_U);
  const bf16_t* v = (const bf16_t*)(ws + OFF_V);
  const bf16_t* W = (const bf16_t*)(ws + OFF_SGUW);
  float* st = (float*)smem;
  bf16_t* vn = (bf16_t*)(smem + 1024);
  constexpr int LN_ = 72;
  const int dt = wave & 1, it = wave >> 1;
  const int gi = lane >> 4, i16 = lane & 15, tq = i16 >> 2, tp = i16 & 3;
  for (int item = blockIdx.x; item < NTOK / 128; item += gridDim.x) {
    const int t0 = item * 128;
    __syncthreads();
    for (int i = 0; i < 16; ++i) {
      const int t = wave * 16 + i;
      const u32x4 raw = *(const u32x4*)(v + (size_t)(t0 + t) * 512 + lane * 8);
      float f[8]; unpack8(raw, f);
      float s = 0.f;
#pragma unroll
      for (int j = 0; j < 8; ++j) s += f[j];
      const float mean = wave_sum(s) * (1.f / 512.f);
      float q = 0.f;
#pragma unroll
      for (int j = 0; j < 8; ++j) { const float d = f[j] - mean; q += d * d; }
      const float rstd = rsqrtf(wave_sum(q) * (1.f / 512.f) + LN_EPS);
      if (lane == 0) { st[t * 2] = mean; st[t * 2 + 1] = rstd; }
    }
    u32x4 vnext[2];
#pragma unroll
    for (int i = 0; i < 2; ++i) { const int idx = tid + i * NT; vnext[i] = *(const u32x4*)(v + (size_t)(t0 + (idx >> 3)) * 512 + (idx & 7) * 8); }
    for (int g = 0; g < 8; ++g) {
      u32x4 vcur[2] = {vnext[0], vnext[1]};
      if (g + 1 < 8) {
#pragma unroll
        for (int i = 0; i < 2; ++i) { const int idx = tid + i * NT; vnext[i] = *(const u32x4*)(v + (size_t)(t0 + (idx >> 3)) * 512 + (g + 1) * 64 + (idx & 7) * 8); }
      }
      u32x2 uold[4];
      {
        const bf16_t* urow0 = u + (size_t)(t0 + it * 32 + l31) * 512 + g * 64 + dt * 32 + 4 * hh;
#pragma unroll
        for (int q4 = 0; q4 < 4; ++q4) uold[q4] = *(const u32x2*)(urow0 + 8 * q4);
      }
      lds_barrier();
#pragma unroll
      for (int i = 0; i < 2; ++i) {
        const int idx = tid + i * NT, j = idx >> 3, dc = (idx & 7) * 8;
        const u32x4 raw = vcur[i];
        const float mean = st[j * 2], rstd = st[j * 2 + 1];
        float f[8], gg[8], bb[8]; unpack8(raw, f); ld8(p.sgu_ln_g + g * 64 + dc, gg); ld8(p.sgu_ln_b + g * 64 + dc, bb);
#pragma unroll
        for (int k = 0; k < 8; ++k) f[k] = (f[k] - mean) * rstd * gg[k] + bb[k];
        *(u32x4*)(vn + j * LN_ + dc) = pack8(f);
      }
      lds_barrier();
      f32x16 acc;
#pragma unroll
      for (int r = 0; r < 16; ++r) acc[r] = 0.f;
      const bf16_t* wrow = W + ((size_t)g * 128 + it * 32 + l31) * 128 + hh * 8;
      const LAS bf16_t* vbase = (const LAS bf16_t*)vn + (8 * (gi >> 1) + tq) * LN_ + dt * 32 + 16 * (gi & 1) + 4 * tp;
#pragma unroll
      for (int ks = 0; ks < 8; ++ks) {
        if (ks <= 2 * it + 1) {
          const LAS bf16_t* vp = vbase + (ks * 16) * LN_;
          const s16x4 lo = __builtin_amdgcn_ds_read_tr16_b64_v4i16((LAS s16x4*)vp);
          const s16x4 hi = __builtin_amdgcn_ds_read_tr16_b64_v4i16((LAS s16x4*)(vp + 4 * LN_));
          const bf16x8 bw = *(const bf16x8*)(wrow + ks * 16);
          acc = MFMA32(__builtin_shufflevector(lo, hi, 0, 1, 2, 3, 4, 5, 6, 7), bw, acc);
        }
      }
      const int i = it * 32 + l31;
      const float bsv = p.sgu_b[g * 128 + i];
      unsigned char* orow = (unsigned char*)(ws + OFF_OSGU8) + (size_t)(t0 + i) * 512 + g * 64 + dt * 32 + 4 * hh;
#pragma unroll
      for (int q4 = 0; q4 < 4; ++q4) {
        const u32x2 old = uold[q4];
        *(unsigned*)(orow + 8 * q4) = pk4_fp8(clamp_f8(8.0f * bflo(old.x) * (acc[4 * q4] + bsv)), clamp_f8(8.0f * bfhi(old.x) * (acc[4 * q4 + 1] + bsv)),
                                              clamp_f8(8.0f * bflo(old.y) * (acc[4 * q4 + 2] + bsv)), clamp_f8(8.0f * bfhi(old.y) * (acc[4 * q4 + 3] + bsv)));
      }
    }
  }
}

DI void phase_compress(const Params& p, char* smem) {
  char* ws = p.ws;
  const int tid = otid(), lane = tid & 63, wave = tid >> 6, l31 = lane & 31, hh = lane >> 5;
  bf16_t* hid = (bf16_t*)smem;
  constexpr int LH = 136;
  for (int item = blockIdx.x; item < 128; item += gridDim.x) {
    const int w = item >> 6, R0 = (item & 63) * 128;
    const bf16_t* src = (const bf16_t*)(ws + (w == 0 ? OFF_KC : OFF_VC));
    const bf16_t* W1 = (const bf16_t*)(ws + OFF_CW1) + (size_t)w * 128 * 2048;
    const bf16_t* W2 = (const bf16_t*)(ws + OFF_CW2) + (size_t)w * 64 * 128;
    const float* posb = (const float*)(ws + OFF_POSB) + w * 128;
    const int rg = wave >> 2, cgp = wave & 3;
    const bf16_t* abase[2];
#pragma unroll
    for (int mi = 0; mi < 2; ++mi) {
      const int R = R0 + rg * 64 + mi * 32 + l31, bg = R >> 9, n = R & 511, nn = n < 510 ? n : 510;
      abase[mi] = src + ((size_t)((bg >> 1) * SEQ + 16 * nn)) * 128 + (bg & 1) * 64 + hh * 8;
    }
    const bf16_t* bbase = W1 + (size_t)(cgp * 32 + l31) * 2048 + hh * 8;
    f32x16 acc[2];
#pragma unroll
    for (int r = 0; r < 16; ++r) { acc[0][r] = 0.f; acc[1][r] = 0.f; }
#pragma unroll 8
    for (int ks = 0; ks < 128; ++ks) {
      const int aofs = (ks >> 2) * 128 + (ks & 3) * 16;
      const bf16x8 a0 = *(const bf16x8*)(abase[0] + aofs), a1 = *(const bf16x8*)(abase[1] + aofs);
      const bf16x8 bb = *(const bf16x8*)(bbase + ks * 16);
      acc[0] = MFMA32(a0, bb, acc[0]); acc[1] = MFMA32(a1, bb, acc[1]);
    }
    __syncthreads();
    {
      const float pb = posb[cgp * 32 + l31];
#pragma unroll
      for (int mi = 0; mi < 2; ++mi)
#pragma unroll
        for (int r = 0; r < 16; ++r) {
          const int row = rg * 64 + mi * 32 + (r & 3) + 8 * (r >> 2) + 4 * hh;
          hid[row * LH + cgp * 32 + l31] = f2bf(gelu_f(acc[mi][r] + pb));
        }
    }
    __syncthreads();
    const int mi2 = wave >> 1, ni = wave & 1;
    f32x16 o;
#pragma unroll
    for (int r = 0; r < 16; ++r) o[r] = 0.f;
#pragma unroll
    for (int ks = 0; ks < 8; ++ks) {
      const bf16x8 a = *(const bf16x8*)(hid + (mi2 * 32 + l31) * LH + ks * 16 + hh * 8);
      const bf16x8 bb = *(const bf16x8*)(W2 + (size_t)(ni * 32 + l31) * 128 + ks * 16 + hh * 8);
      o = MFMA32(a, bb, o);
    }
    const int d = ni * 32 + l31;
    const float b2 = p.cmp_b2[w * 64 + (w == 0 ? dperm(d) : d)];
    const int bg = R0 >> 9;
    bf16_t* dst = (bf16_t*)(ws + (w == 0 ? OFF_KCMP : OFF_VCMP));
#pragma unroll
    for (int r = 0; r < 16; ++r) {
      const int n = (R0 & 511) + mi2 * 32 + (r & 3) + 8 * (r >> 2) + 4 * hh;
      dst[((size_t)bg * 512 + n) * 64 + d] = f2bf(n < 511 ? o[r] + b2 : 0.f);
    }
  }
}

constexpr int LK = 72;
constexpr int NSA_TILE = 18432;
constexpr int NSA_AIMP = 3 * NSA_TILE, NSA_CIMP = NSA_AIMP + 32768, NSA_SELM = NSA_CIMP + 32768;
constexpr float NSA_THR = 6.0f;
struct TileRegs { u32x4 k; u32x4 v; };

DI void nsa_load_tile(TileRegs& t, const bf16_t* kbase, size_t kstride, const bf16_t* vbase, size_t vstride) {
  const int tid = otid(), r = tid >> 3, ch = tid & 7;
  t.k = *(const u32x4*)(kbase + (size_t)r * kstride + ch * 8);
  t.v = *(const u32x4*)(vbase + (size_t)r * vstride + ch * 8);
}
DI void nsa_store_tile(const TileRegs& t, char* tile) {
  const int tid = otid(), r = tid >> 3, ch = tid & 7;
  *(u32x4*)((bf16_t*)tile + r * LK + ch * 8) = t.k;
  *(u32x4*)((bf16_t*)(tile + 9216) + r * LK + ch * 8) = t.v;
}
DI void nsa_scores(f32x16 (&st)[2], const char* tile, const bf16x8 (&qf)[4], int lane) {
  const bf16_t* Ks = (const bf16_t*)tile;
#pragma unroll
  for (int kt = 0; kt < 2; ++kt)
#pragma unroll
    for (int r = 0; r < 16; ++r) st[kt][r] = 0.f;
  __builtin_amdgcn_s_setprio(1);
#pragma unroll
  for (int ks = 0; ks < 4; ++ks)
#pragma unroll
    for (int kt = 0; kt < 2; ++kt) {
      const bf16x8 a = *(const bf16x8*)(Ks + (kt * 32 + (lane & 31)) * LK + ks * 16 + (lane >> 5) * 8);
      st[kt] = MFMA32(a, qf[ks], st[kt]);
    }
  __builtin_amdgcn_s_setprio(0);
}
DI void nsa_pv(f32x16 (&o)[2], const f32x16 (&pt)[2], const char* tile, int lane) {
  const int gi = lane >> 4, i16 = lane & 15, q = i16 >> 2, pp = i16 & 3;
  const LAS bf16_t* Vs = (const LAS bf16_t*)(tile + 9216) + (4 * (gi >> 1) + q) * LK + 16 * (gi & 1) + 4 * pp;
#pragma unroll
  for (int kt = 0; kt < 2; ++kt)
#pragma unroll
    for (int s = 0; s < 2; ++s) {
      u32x4 pk; pk.x = pack2(pt[kt][8 * s], pt[kt][8 * s + 1]); pk.y = pack2(pt[kt][8 * s + 2], pt[kt][8 * s + 3]);
      pk.z = pack2(pt[kt][8 * s + 4], pt[kt][8 * s + 5]); pk.w = pack2(pt[kt][8 * s + 6], pt[kt][8 * s + 7]);
      const bf16x8 pb = __builtin_bit_cast(bf16x8, pk);
      bf16x8 a[2];
#pragma unroll
      for (int dt = 0; dt < 2; ++dt) {
        const LAS bf16_t* vp = Vs + (kt * 32 + 16 * s) * LK + dt * 32;
        const s16x4 lo = __builtin_amdgcn_ds_read_tr16_b64_v4i16((LAS s16x4*)vp);
        const s16x4 hi = __builtin_amdgcn_ds_read_tr16_b64_v4i16((LAS s16x4*)(vp + 8 * LK));
        a[dt] = __builtin_shufflevector(lo, hi, 0, 1, 2, 3, 4, 5, 6, 7);
      }
      o[0] = MFMA32(a[0], pb, o[0]); o[1] = MFMA32(a[1], pb, o[1]);
    }
}

constexpr float NSA_NEG = -3.0e38f;
DI void nsa_online(f32x16 (&st)[2], bool sel, float& m, float& l, f32x16 (&o)[2], const char* tile, int lane) {
  float mx = NSA_NEG;
#pragma unroll
  for (int r = 0; r < 16; ++r) mx = fmaxf(mx, fmaxf(st[0][r], st[1][r]));
  mx = fmaxf(mx, xor32f(mx, lane));
  mx = sel ? mx : NSA_NEG;
  if (__any(mx > m + NSA_THR)) {
    const float mn = fmaxf(m, mx);
    const float alpha = __builtin_amdgcn_exp2f(m - mn);
    m = mn; l *= alpha;
#pragma unroll
    for (int r = 0; r < 16; ++r) { o[0][r] *= alpha; o[1][r] *= alpha; }
  }
  const float ms = sel ? m : 1e30f;
  float sum = 0.f;
#pragma unroll
  for (int r = 0; r < 16; ++r) {
    const float p0 = __builtin_amdgcn_exp2f(st[0][r] - ms), p1 = __builtin_amdgcn_exp2f(st[1][r] - ms);
    st[0][r] = p0; st[1][r] = p1; sum += p0 + p1;
  }
  l += sum;
  nsa_pv(o, st, tile, lane);
}

struct NsaItem { int qb, b, g, bg, t; size_t tokrow; };
DI NsaItem nsa_item(int item0, int wave, int qi) {
  const int G = gridDim.x, k = item0 / G, bb = item0 - k * G;
  const int item = (k & 1) ? (k * G + (G - 1 - bb)) : item0;
  NsaItem it; it.qb = 127 - (item >> 4); const int rest = item & 15; it.b = rest >> 1; it.g = rest & 1;
  it.bg = it.b * 2 + it.g; it.t = it.qb * 64 + wave * 8 + qi; it.tokrow = (size_t)it.b * SEQ + it.t; return it;
}
DI void nsa_accum_store(bf16_t* dst, const f32x16 (&o)[2], float sc, bool first, int hh, unsigned char* dst8 = nullptr) {
#pragma unroll
  for (int dt = 0; dt < 2; ++dt)
#pragma unroll
    for (int q4 = 0; q4 < 4; ++q4) {
      u32x2* pp = (u32x2*)(dst + dt * 32 + 8 * q4 + 4 * hh);
      float a0 = sc * o[dt][4 * q4], a1 = sc * o[dt][4 * q4 + 1], a2 = sc * o[dt][4 * q4 + 2], a3 = sc * o[dt][4 * q4 + 3];
      if (!first) { const u32x2 old = *pp; a0 += bflo(old.x); a1 += bfhi(old.x); a2 += bflo(old.y); a3 += bfhi(old.y); }
      if (dst8) *(unsigned*)(dst8 + dt * 32 + 8 * q4 + 4 * hh) = pk4_fp8(clamp_f8(16.0f * a0), clamp_f8(16.0f * a1), clamp_f8(16.0f * a2), clamp_f8(16.0f * a3));
      else { u32x2 wv; wv.x = pack2(a0, a1); wv.y = pack2(a2, a3); *pp = wv; }
    }
}

constexpr int NSA_STAGE = 4 * 18432;
typedef float f32x4v __attribute__((ext_vector_type(4)));
#define MFMA16(a, b, c) __builtin_amdgcn_mfma_f32_16x16x32_bf16((a), (b), (c), 0, 0, 0)
struct StageRegs { u32x4 r[8]; };
DI void nsa_load_stage(StageRegs& sr, const bf16_t* kb, const bf16_t* vb, int j0s, int qb) {
  const int tid = otid(), r = tid >> 3, ch = tid & 7;
#pragma unroll
  for (int tt = 0; tt < 4; ++tt) {
    const int j = (j0s + tt <= qb) ? j0s + tt : qb;
    sr.r[2 * tt] = *(const u32x4*)(kb + ((size_t)j * 64 + r) * 128 + ch * 8);
    sr.r[2 * tt + 1] = *(const u32x4*)(vb + ((size_t)j * 64 + r) * 128 + ch * 8);
  }
}
DI void nsa_store_stage(const StageRegs& sr, char* stage) {
  const int tid = otid(), r = tid >> 3, ch = tid & 7;
#pragma unroll
  for (int tt = 0; tt < 4; ++tt) {
    *(u32x4*)((bf16_t*)(stage + tt * 18432) + r * LK + ch * 8) = sr.r[2 * tt];
    *(u32x4*)((bf16_t*)(stage + tt * 18432 + 9216) + r * LK + ch * 8) = sr.r[2 * tt + 1];
  }
}
struct Sel16 { float m; bool has; f32x4v o[4], ol; };
DI void nsa_unit16(Sel16& g, const char* tile, const bf16x8 (&qf)[2], bool sel, int klim  , int lane) {
  const int c16 = lane & 15, kg = lane >> 4, tq = c16 >> 2, tp = c16 & 3;
  const bf16_t* Ks = (const bf16_t*)tile + c16 * LK + kg * 8;
  f32x4v st[4];
  const float ini = sel ? -g.m : -1e30f;
#pragma unroll
  for (int kt = 0; kt < 4; ++kt) {
    st[kt] = (f32x4v){ini, ini, ini, ini};
#pragma unroll
    for (int ks = 0; ks < 2; ++ks) st[kt] = MFMA16(*(const bf16x8*)(Ks + kt * 16 * LK + ks * 32), qf[ks], st[kt]);
  }
  if (klim < 64) {
#pragma unroll
    for (int kt = 0; kt < 4; ++kt)
#pragma unroll
      for (int r = 0; r < 4; ++r) st[kt][r] = (kt * 16 + 4 * kg + r <= klim) ? st[kt][r] : NSA_NEG;
  }
  float mx = fmaxf(fmaxf(st[0][0], st[0][1]), st[0][2]);
  mx = fmaxf(fmaxf(mx, st[0][3]), st[1][0]); mx = fmaxf(fmaxf(mx, st[1][1]), st[1][2]); mx = fmaxf(fmaxf(mx, st[1][3]), st[2][0]);
  mx = fmaxf(fmaxf(mx, st[2][1]), st[2][2]); mx = fmaxf(fmaxf(mx, st[2][3]), st[3][0]); mx = fmaxf(fmaxf(mx, st[3][1]), st[3][2]); mx = fmaxf(mx, st[3][3]);
  mx = fmaxf(mx, xor16f(mx, lane));
  mx = fmaxf(mx, xor32f(mx, lane));
  const bool real = mx > -1e29f;
  const bool fresh = !g.has && real, up = g.has && (mx > NSA_THR);
  if (__any(fresh || up)) {
    const float delta = (fresh || up) ? mx : 0.f;
    const float alpha = up ? __builtin_amdgcn_exp2f(-delta) : 1.0f;
    g.m += delta; g.ol *= alpha;
#pragma unroll
    for (int dt = 0; dt < 4; ++dt) g.o[dt] *= alpha;
#pragma unroll
    for (int kt = 0; kt < 4; ++kt) st[kt] -= delta;
  }
  g.has = g.has || real;
#pragma unroll
  for (int kt = 0; kt < 4; ++kt)
#pragma unroll
    for (int r = 0; r < 4; ++r) st[kt][r] = __builtin_amdgcn_exp2f(st[kt][r]);
  const bf16x8 ones = {16256, 16256, 16256, 16256, 16256, 16256, 16256, 16256};
  const LAS bf16_t* Vs = (const LAS bf16_t*)(tile + 9216) + (4 * kg + tq) * LK + 4 * tp;
#pragma unroll
  for (int kp = 0; kp < 2; ++kp) {
    u32x4 pk; pk.x = pack2(st[2 * kp][0], st[2 * kp][1]); pk.y = pack2(st[2 * kp][2], st[2 * kp][3]);
    pk.z = pack2(st[2 * kp + 1][0], st[2 * kp + 1][1]); pk.w = pack2(st[2 * kp + 1][2], st[2 * kp + 1][3]);
    const bf16x8 pb = __builtin_bit_cast(bf16x8, pk);
    g.ol = MFMA16(ones, pb, g.ol);
#pragma unroll
    for (int dt = 0; dt < 4; ++dt) {
      const LAS bf16_t* vp = Vs + (2 * kp) * 16 * LK + dt * 16;
      const s16x4 lo = __builtin_amdgcn_ds_read_tr16_b64_v4i16((LAS s16x4*)vp);
      const s16x4 hi = __builtin_amdgcn_ds_read_tr16_b64_v4i16((LAS s16x4*)(vp + 16 * LK));
      g.o[dt] = MFMA16(__builtin_shufflevector(lo, hi, 0, 1, 2, 3, 4, 5, 6, 7), pb, g.o[dt]);
    }
  }
}
DI void nsa_sel16(const Params& p, char* smem, bool dry) {
  char* ws = p.ws;
  const int tid = otid(), lane = tid & 63, wave = tid >> 6, c16 = lane & 15, kg = lane >> 4, qi4 = c16 >> 2, r4 = c16 & 3;
  const bf16_t* Q = (const bf16_t*)(ws + OFF_Q);
  const float* gsig = (const float*)(ws + OFF_GSIG);
  bf16_t* ONSA = (bf16_t*)(ws + OFF_ONSA);
  const u32x4* SELG = (const u32x4*)(ws + OFF_SELG);
  const bf16_t* KS = (const bf16_t*)(ws + OFF_KS); const bf16_t* VS = (const bf16_t*)(ws + OFF_VS);
  constexpr int NITEM = NB * 2 * 128;
  for (int item = blockIdx.x; item < NITEM; item += gridDim.x) {
    const NsaItem it = nsa_item(item, wave, 0);
    const int qb = it.qb;
    bf16x8 qf[2][2]; u32x4 selw[2]; float g_s[2]; int tg[2]; Sel16 G[2];
#pragma unroll
    for (int gq = 0; gq < 2; ++gq) {
      tg[gq] = it.t + 4 * gq + qi4;
      const size_t tokrow = (size_t)it.b * SEQ + tg[gq];
#pragma unroll
      for (int ks = 0; ks < 2; ++ks) qf[gq][ks] = *(const bf16x8*)(Q + tokrow * 512 + (it.g * 4 + r4) * 64 + ks * 32 + kg * 8);
      selw[gq] = SELG[(size_t)it.bg * SEQ + tg[gq]];
      g_s[gq] = gsig[tokrow * 32 + (it.g * 4 + r4) * 3 + 1];
      G[gq].m = 0.f; G[gq].ol = (f32x4v){0.f, 0.f, 0.f, 0.f}; G[gq].has = false;
#pragma unroll
      for (int dt = 0; dt < 4; ++dt) G[gq].o[dt] = (f32x4v){0.f, 0.f, 0.f, 0.f};
    }
    const bf16_t* kb = KS + (size_t)it.b * SEQ * 128 + it.g * 64;
    const bf16_t* vb = VS + (size_t)it.b * SEQ * 128 + it.g * 64;
    const int nst = (qb >> 2) + 1;
    StageRegs sr;
    lds_barrier();
    nsa_load_stage(sr, kb, vb, 0, qb);
    nsa_store_stage(sr, smem);
    lds_barrier();
    for (int sidx = 0; sidx < nst; ++sidx) {
      const char* stage = smem + (sidx & 1) * NSA_STAGE;
      if (sidx + 1 < nst) nsa_load_stage(sr, kb, vb, 4 * (sidx + 1), qb);
#pragma unroll 1
      for (int tt = 0; tt < 4; ++tt) {
        const int j = 4 * sidx + tt;
        if (j > qb) break;
#pragma unroll
        for (int gq = 0; gq < 2; ++gq) {
          const unsigned w = j < 32 ? selw[gq].x : (j < 64 ? selw[gq].y : (j < 96 ? selw[gq].z : selw[gq].w));
          const bool sel = (w >> (j & 31)) & 1u;
          if (__any(sel)) nsa_unit16(G[gq], stage + tt * 18432, qf[gq], sel, (j == qb) ? (tg[gq] - j * 64) : 1000, lane);
        }
      }
      if (sidx + 1 < nst) nsa_store_stage(sr, smem + ((sidx + 1) & 1) * NSA_STAGE);
      lds_barrier();
    }
#pragma unroll
    for (int gq = 0; gq < 2; ++gq) {
      const float l = G[gq].ol[0];
      const float sc = l > 0.f ? g_s[gq] / l : 0.f;
      bf16_t* dst = ONSA + ((size_t)it.b * SEQ + tg[gq]) * 512 + (it.g * 4 + r4) * 64 + 4 * kg;
      if (!dry) {
#pragma unroll
        for (int dt = 0; dt < 4; ++dt) {
          u32x2* pp = (u32x2*)(dst + dt * 16);
          const u32x2 old = *pp;
          u32x2 wv; wv.x = pack2(bflo(old.x) + sc * G[gq].o[dt][0], bfhi(old.x) + sc * G[gq].o[dt][1]);
          wv.y = pack2(bflo(old.y) + sc * G[gq].o[dt][2], bfhi(old.y) + sc * G[gq].o[dt][3]);
          *pp = wv;
        }
      } else asm volatile("" :: "v"(G[gq].o[0]), "v"(G[gq].o[1]), "v"(G[gq].o[2]), "v"(G[gq].o[3]), "v"(l));
    }
  }
}

DI void phase_nsa(const Params& p, char* smem, int branch_mask) {
  char* ws = p.ws;
  const int tid = otid(), lane = tid & 63, wave = tid >> 6, hh = lane >> 5, c = lane & 31, qi = c >> 2, r4 = c & 3;
  const bf16_t* Q = (const bf16_t*)(ws + OFF_Q);
  const float* gsig = (const float*)(ws + OFF_GSIG);
  bf16_t* ONSA = (bf16_t*)(ws + OFF_ONSA);
  u32x4* SELG = (u32x4*)(ws + OFF_SELG);
  constexpr int NITEM = NB * 2 * 128;

#pragma unroll 1
  for (int rep1 = 0; rep1 < ((PROBE_DUP & 4096) ? 2 : 1); ++rep1) {
    const bf16_t* KCMP = (const bf16_t*)(ws + OFF_KCMP); const bf16_t* VCMP = (const bf16_t*)(ws + OFF_VCMP);
    float* Aimp = (float*)(smem + NSA_AIMP) + wave * 1024;
    float* Cimp = (float*)(smem + NSA_CIMP) + wave * 1024;
    unsigned short* selm16 = (unsigned short*)(smem + NSA_SELM) + wave * 64;
    const u32x4* selm128 = (const u32x4*)(smem + NSA_SELM) + wave * 8;
    for (int item = blockIdx.x; item < NITEM; item += gridDim.x) {
      const NsaItem it = nsa_item(item, wave, qi);
      const int t = it.t;
      bf16x8 qf[4];
#pragma unroll
      for (int ks = 0; ks < 4; ++ks) qf[ks] = *(const bf16x8*)(Q + it.tokrow * 512 + (it.g * 4 + r4) * 64 + ks * 16 + hh * 8);
      const float g_c = gsig[it.tokrow * 32 + (it.g * 4 + r4) * 3 + 0];
      TileRegs tr;
      const int nmax = (it.qb * 64 + 63 - 31) >> 4, ntile = (nmax >> 6) + 1;
      const int nfull = (it.qb * 64 - 31) >> 4;
      const bf16_t* kb = KCMP + (size_t)it.bg * 512 * 64;
      const bf16_t* vb = VCMP + (size_t)it.bg * 512 * 64;
      float m = -1e30f, l = 0.f;
      nsa_load_tile(tr, kb, 64, vb, 64);
      nsa_store_tile(tr, smem);
      __syncthreads();
      for (int j = 0; j < ntile; ++j) {
        const char* tile = smem + (j & 1) * NSA_TILE;
        if (j + 1 < ntile) nsa_load_tile(tr, kb + (size_t)(j + 1) * 64 * 64, 64, vb + (size_t)(j + 1) * 64 * 64, 64);
        f32x16 st[2];
        nsa_scores(st, tile, qf, lane);
        const bool full = (j * 64 + 63 <= nfull);
        const int nlim = full ? 100000 : ((t - 31) >> 4) - j * 64 - 4 * hh;
        float mx = NSA_NEG;
#pragma unroll
        for (int kt = 0; kt < 2; ++kt)
#pragma unroll
          for (int r = 0; r < 16; ++r) {
            st[kt][r] = (kt * 32 + (r & 3) + 8 * (r >> 2) <= nlim) ? st[kt][r] : NSA_NEG;
            mx = fmaxf(mx, st[kt][r]);
          }
        mx = fmaxf(mx, xor32f(mx, lane));
        const float mn = fmaxf(m, mx);
        float sum = 0.f;
#pragma unroll
        for (int kt = 0; kt < 2; ++kt)
#pragma unroll
          for (int r = 0; r < 16; ++r) sum += __builtin_amdgcn_exp2f(st[kt][r] - mn);
        l = l * __builtin_amdgcn_exp2f(m - mn) + sum;
        m = mn;
        if (j + 1 < ntile) nsa_store_tile(tr, smem + ((j + 1) & 1) * NSA_TILE);
        __syncthreads();
      }
      l += xor32f(l, lane);
      const float inv_l = l > 0.f ? 1.0f / l : 0.f;
      f32x16 o[2];
#pragma unroll
      for (int r = 0; r < 16; ++r) { o[0][r] = 0.f; o[1][r] = 0.f; }
      nsa_load_tile(tr, kb, 64, vb, 64);
      nsa_store_tile(tr, smem);
      __syncthreads();
      for (int j = 0; j < ntile; ++j) {
        const char* tile = smem + (j & 1) * NSA_TILE;
        if (j + 1 < ntile) nsa_load_tile(tr, kb + (size_t)(j + 1) * 64 * 64, 64, vb + (size_t)(j + 1) * 64 * 64, 64);
        f32x16 st[2];
        nsa_scores(st, tile, qf, lane);
        const bool full = (j * 64 + 63 <= nfull);
        const int nlim = full ? 100000 : ((t - 31) >> 4) - j * 64 - 4 * hh;
#pragma unroll
        for (int kt = 0; kt < 2; ++kt)
#pragma unroll
          for (int r = 0; r < 16; ++r) {
            const float arg = (kt * 32 + (r & 3) + 8 * (r >> 2) <= nlim) ? st[kt][r] - m : NSA_NEG;
            st[kt][r] = __builtin_amdgcn_exp2f(arg) * inv_l;
          }
#pragma unroll
        for (int kt = 0; kt < 2; ++kt)
#pragma unroll
          for (int c4 = 0; c4 < 4; ++c4) {
            float carry = 0.5f * st[kt][4 * c4 + 3];
            float fullv = st[kt][4 * c4] + st[kt][4 * c4 + 1] + st[kt][4 * c4 + 2] + carry;
            fullv += xor1f(fullv); fullv += xor2f(fullv);
            carry += xor1f(carry); carry += xor2f(carry);
            const int jb = j * 16 + kt * 8 + 2 * c4 + hh;
            if (r4 == 0) { Aimp[qi * 128 + jb] = fullv; Cimp[qi * 128 + jb] = carry; }
          }
        if (branch_mask & 1) nsa_pv(o, st, tile, lane);
        if (j + 1 < ntile) nsa_store_tile(tr, smem + ((j + 1) & 1) * NSA_TILE);
        __syncthreads();
      }
      nsa_accum_store(ONSA + it.tokrow * 512 + (it.g * 4 + r4) * 64, o, (branch_mask & 1) ? g_c : 0.f, true, hh);
      const int cur = it.qb;
      if (cur <= 15) {
        if (lane < 8) { selm16[lane * 8 + 0] = (unsigned short)((2u << cur) - 1u);
#pragma unroll
          for (int k = 1; k < 8; ++k) selm16[lane * 8 + k] = 0; }
      } else {
        const int qs = lane >> 3, sub = lane & 7;
        float v[16];
#pragma unroll
        for (int i = 0; i < 16; ++i) {
          const int jj = sub * 16 + i;
          const bool ok = (jj >= 1) && (jj <= cur - 2);
          const int jm = jj >= 1 ? jj - 1 : 0;
          v[i] = ok ? (Aimp[qs * 128 + jj] + Cimp[qs * 128 + jm]) : -3e38f;
        }
        unsigned bits = 0;
        for (int itn = 0; itn < 13; ++itn) {
          float bv = v[0]; int bi = 0;
#pragma unroll
          for (int i = 1; i < 16; ++i) if (v[i] > bv) { bv = v[i]; bi = i; }
          int bj = sub * 16 + bi;
#pragma unroll
          for (int o2 = 1; o2 < 8; o2 <<= 1) {
            const float ov = __shfl_xor(bv, o2); const int oj = __shfl_xor(bj, o2);
            if (ov > bv || (ov == bv && oj < bj)) { bv = ov; bj = oj; }
          }
          if ((bj >> 4) == sub) {
            const int i2 = bj & 15;
#pragma unroll
            for (int i = 0; i < 16; ++i) if (i == i2) v[i] = -3e38f;
            bits |= 1u << i2;
          }
        }
        if (sub == 0) bits |= 1u;
        if ((cur >> 4) == sub) bits |= 1u << (cur & 15);
        if (((cur - 1) >> 4) == sub) bits |= 1u << ((cur - 1) & 15);
        selm16[qs * 8 + sub] = (unsigned short)bits;
      }
      __syncthreads();
      if (r4 == 0 && hh == 0) SELG[(size_t)it.bg * SEQ + t] = selm128[qi];
    }
  }
  __threadfence_block();
  __syncthreads();

#pragma unroll 1
  for (int sweep_i = 0; sweep_i < 2 + ((PROBE_DUP & 1024) ? 1 : 0) + ((PROBE_DUP & 2048) ? 1 : 0); ++sweep_i) {
    const int sweep = (sweep_i < 2) ? sweep_i : (((PROBE_DUP & 1024) && sweep_i == 2) ? 0 : 1);
    const bool dry = sweep_i >= 2;
    if (!(branch_mask & (sweep == 0 ? 2 : 4))) continue;
    if (sweep == 0) { nsa_sel16(p, smem, dry); continue; }
    const bf16_t* KB = (const bf16_t*)(ws + (sweep == 0 ? OFF_KS : OFF_KW)); const bf16_t* VB = (const bf16_t*)(ws + (sweep == 0 ? OFF_VS : OFF_VW));
    for (int item = blockIdx.x; item < NITEM; item += gridDim.x) {
      const NsaItem it = nsa_item(item, wave, qi);
      const int t = it.t, qb = it.qb;
      bf16x8 qf[4];
#pragma unroll
      for (int ks = 0; ks < 4; ++ks) qf[ks] = *(const bf16x8*)(Q + it.tokrow * 512 + (it.g * 4 + r4) * 64 + ks * 16 + hh * 8);
      const float g_b = gsig[it.tokrow * 32 + (it.g * 4 + r4) * 3 + 1 + sweep];
      u32x4 selw = {0xffffffffu, 0xffffffffu, 0xffffffffu, 0xffffffffu};
      if (sweep == 0) selw = SELG[(size_t)it.bg * SEQ + t];
      TileRegs tr;
      const bf16_t* kb = KB + (size_t)it.b * SEQ * 128 + it.g * 64;
      const bf16_t* vb = VB + (size_t)it.b * SEQ * 128 + it.g * 64;
      float m = -1e30f, l = 0.f;
      f32x16 o[2];
#pragma unroll
      for (int r = 0; r < 16; ++r) { o[0][r] = 0.f; o[1][r] = 0.f; }
      const int j0 = (sweep == 1 && qb >= 8) ? qb - 8 : 0;
      __syncthreads();
      nsa_load_tile(tr, kb + (size_t)j0 * 64 * 128, 128, vb + (size_t)j0 * 64 * 128, 128);
      nsa_store_tile(tr, smem);
      if (j0 + 1 <= qb) { nsa_load_tile(tr, kb + (size_t)(j0 + 1) * 64 * 128, 128, vb + (size_t)(j0 + 1) * 64 * 128, 128); nsa_store_tile(tr, smem + NSA_TILE); }
      if (j0 + 2 <= qb) nsa_load_tile(tr, kb + (size_t)(j0 + 2) * 64 * 128, 128, vb + (size_t)(j0 + 2) * 64 * 128, 128);
      __syncthreads();
      const bool late = wave >= 4;
      if (__builtin_amdgcn_readfirstlane(wave) >= 4) __builtin_amdgcn_s_setprio(1);
      bool has = false;
      m = 0.f;
      f32x16 st[2];
      {
        const unsigned w0 = j0 < 32 ? selw.x : (j0 < 64 ? selw.y : (j0 < 96 ? selw.z : selw.w));
        const float ini = ((w0 >> (j0 & 31)) & 1u) ? 0.f : -1e30f;
#pragma unroll
        for (int r = 0; r < 16; ++r) { st[0][r] = ini; st[1][r] = ini; }
        const bf16_t* Kc = (const bf16_t*)smem;
#pragma unroll
        for (int ks = 0; ks < 4; ++ks)
#pragma unroll
          for (int kt = 0; kt < 2; ++kt) st[kt] = MFMA32(*(const bf16x8*)(Kc + (kt * 32 + (lane & 31)) * LK + ks * 16 + (lane >> 5) * 8), qf[ks], st[kt]);
      }
      int bi = 0;
      for (int j = j0; j <= qb; ++j) {
        const char* tile = smem + bi * NSA_TILE;
        const int bn = bi == 2 ? 0 : bi + 1, bnn = bn == 2 ? 0 : bn + 1;
        const int jn = j + 1;
        const unsigned wn = jn < 32 ? selw.x : (jn < 64 ? selw.y : (jn < 96 ? selw.z : selw.w));
        const bool seln = (wn >> (jn & 31)) & 1u;
        const bf16_t* Kn = (const bf16_t*)(smem + bn * NSA_TILE) + (lane & 31) * LK + (lane >> 5) * 8;
        f32x16 sn[2];
        if (!late) {
          const float ini = seln ? -m : -1e30f;
#pragma unroll
          for (int r = 0; r < 16; ++r) { sn[0][r] = ini; sn[1][r] = ini; }
#pragma unroll
          for (int ks = 0; ks < 4; ++ks)
#pragma unroll
            for (int kt = 0; kt < 2; ++kt) sn[kt] = MFMA32(*(const bf16x8*)(Kn + kt * 32 * LK + ks * 16), qf[ks], sn[kt]);
        }
        if (j == qb || (sweep == 1 && j == qb - 8)) {
          const int khi = t - j * 64 - 4 * hh, klo = (sweep == 1) ? khi - 511 : -100000;
#pragma unroll
          for (int r = 0; r < 16; ++r) {
            const int o0 = (r & 3) + 8 * (r >> 2);
            st[0][r] = (o0 <= khi && o0 >= klo) ? st[0][r] : NSA_NEG;
            st[1][r] = (o0 + 32 <= khi && o0 + 32 >= klo) ? st[1][r] : NSA_NEG;
          }
        }
        float mx;
        {
          float a0, a1, a2, a3;
          asm("v_max3_f32 %0, %1, %2, %3" : "=v"(a0) : "v"(st[0][0]), "v"(st[0][1]), "v"(st[0][2]));
          asm("v_max3_f32 %0, %1, %2, %3" : "=v"(a1) : "v"(st[0][3]), "v"(st[0][4]), "v"(st[0][5]));
          asm("v_max3_f32 %0, %1, %2, %3" : "=v"(a2) : "v"(st[0][6]), "v"(st[0][7]), "v"(st[0][8]));
          asm("v_max3_f32 %0, %1, %2, %3" : "=v"(a3) : "v"(st[0][9]), "v"(st[0][10]), "v"(st[0][11]));
          asm("v_max3_f32 %0, %1, %2, %3" : "=v"(a0) : "v"(a0), "v"(st[0][12]), "v"(st[0][13]));
          asm("v_max3_f32 %0, %1, %2, %3" : "=v"(a1) : "v"(a1), "v"(st[0][14]), "v"(st[0][15]));
          asm("v_max3_f32 %0, %1, %2, %3" : "=v"(a2) : "v"(a2), "v"(st[1][0]), "v"(st[1][1]));
          asm("v_max3_f32 %0, %1, %2, %3" : "=v"(a3) : "v"(a3), "v"(st[1][2]), "v"(st[1][3]));
          asm("v_max3_f32 %0, %1, %2, %3" : "=v"(a0) : "v"(a0), "v"(st[1][4]), "v"(st[1][5]));
          asm("v_max3_f32 %0, %1, %2, %3" : "=v"(a1) : "v"(a1), "v"(st[1][6]), "v"(st[1][7]));
          asm("v_max3_f32 %0, %1, %2, %3" : "=v"(a2) : "v"(a2), "v"(st[1][8]), "v"(st[1][9]));
          asm("v_max3_f32 %0, %1, %2, %3" : "=v"(a3) : "v"(a3), "v"(st[1][10]), "v"(st[1][11]));
          asm("v_max3_f32 %0, %1, %2, %3" : "=v"(a0) : "v"(a0), "v"(st[1][12]), "v"(st[1][13]));
          asm("v_max3_f32 %0, %1, %2, %3" : "=v"(a1) : "v"(a1), "v"(st[1][14]), "v"(st[1][15]));
          asm("v_max3_f32 %0, %1, %2, %3" : "=v"(a0) : "v"(a0), "v"(a1), "v"(a2));
          const float other = a3;
          asm("v_max_f32 %0, %1, %2" : "=v"(mx) : "v"(a0), "v"(other));
          const float px = xor32f(mx, lane);
          asm("v_max_f32 %0, %1, %2" : "=v"(mx) : "v"(mx), "v"(px));
        }
        const bool real = mx > -1e29f;
        const bool fresh = !has && real, up = has && (mx > NSA_THR);
        if (__any(fresh || up)) {
          const float delta = (fresh || up) ? mx : 0.f;
          const float alpha = up ? __builtin_amdgcn_exp2f(-delta) : 1.0f;
          m += delta; l *= alpha;
#pragma unroll
          for (int r = 0; r < 16; ++r) { o[0][r] *= alpha; o[1][r] *= alpha; st[0][r] -= delta; st[1][r] -= delta; }
          if (!late) {
            const float dn = seln ? delta : 0.f;
#pragma unroll
            for (int r = 0; r < 16; ++r) { sn[0][r] -= dn; sn[1][r] -= dn; }
          }
        }
        has = has || real;
        f32x2 s2 = {0.f, 0.f};
#pragma unroll
        for (int r = 0; r < 16; ++r) {
          const float p0 = __builtin_amdgcn_exp2f(st[0][r]), p1 = __builtin_amdgcn_exp2f(st[1][r]);
          st[0][r] = p0; st[1][r] = p1; s2 += (f32x2){p0, p1};
        }
        l += s2.x + s2.y;
        nsa_pv(o, st, tile, lane);
        if (late) {
          const float ini = seln ? -m : -1e30f;
#pragma unroll
          for (int r = 0; r < 16; ++r) { sn[0][r] = ini; sn[1][r] = ini; }
#pragma unroll
          for (int ks = 0; ks < 4; ++ks)
#pragma unroll
            for (int kt = 0; kt < 2; ++kt) sn[kt] = MFMA32(*(const bf16x8*)(Kn + kt * 32 * LK + ks * 16), qf[ks], sn[kt]);
        }
        if (j + 2 <= qb) nsa_store_tile(tr, smem + bnn * NSA_TILE);
        if (j + 3 <= qb) nsa_load_tile(tr, kb + (size_t)(j + 3) * 64 * 128, 128, vb + (size_t)(j + 3) * 64 * 128, 128);
#pragma unroll
        for (int r = 0; r < 16; ++r) { st[0][r] = sn[0][r]; st[1][r] = sn[1][r]; }
        bi = bn;
        __syncthreads();
      }
      __builtin_amdgcn_s_setprio(0);
      l += xor32f(l, lane);
      if (!dry) nsa_accum_store(ONSA + it.tokrow * 512 + (it.g * 4 + r4) * 64, o, l > 0.f ? g_b / l : 0.f, false, hh, (unsigned char*)(ws + OFF_ONSA8) + it.tokrow * 512 + (it.g * 4 + r4) * 64);
      else asm volatile("" :: "v"(o[0]), "v"(o[1]), "v"(l));
    }
  }
}

DI unsigned ord_key(float f) { const unsigned u = __float_as_uint(f); return (u & 0x80000000u) ? ~u : (u | 0x80000000u); }
DI float ord_val(unsigned k) { return __uint_as_float((k & 0x80000000u) ? (k & 0x7fffffffu) : ~k); }
DI void cex(unsigned& hi, unsigned& lo) { const unsigned x = hi, y = lo; hi = x > y ? x : y; lo = x > y ? y : x; }
DI void sort16_desc(unsigned (&a)[16]) {
#pragma unroll
  for (int k = 2; k <= 16; k <<= 1)
#pragma unroll
    for (int j = k >> 1; j > 0; j >>= 1)
#pragma unroll
      for (int i = 0; i < 16; ++i) {
        const int l = i ^ j;
        if (l > i) { if ((i & k) == 0) cex(a[i], a[l]); else cex(a[l], a[i]); }
      }
}
DI void bitonic_finish16(unsigned (&a)[16]) {
#pragma unroll
  for (int j = 8; j > 0; j >>= 1)
#pragma unroll
    for (int i = 0; i < 16; ++i) { const int l = i ^ j; if (l > i) cex(a[i], a[l]); }
}
DI void merge_top16(unsigned (&a)[16], const unsigned (&b)[16]) {
#pragma unroll
  for (int i = 0; i < 16; ++i) a[i] = a[i] > b[15 - i] ? a[i] : b[15 - i];
  bitonic_finish16(a);
}
DI void merge_partner16(unsigned (&a)[16]) {
  unsigned b[16];
#pragma unroll
  for (int i = 0; i < 16; ++i) b[i] = xor32u(a[i], otid());
  merge_top16(a, b);
}


constexpr int KLD = 136;
DI void peer_top16(unsigned (&top)[16], const bf16x8 (&bq)[8], const bf16_t* keys  , int lane) {
  const int l31 = lane & 31, hh = lane >> 5;
  unsigned grp[16];
#pragma unroll
  for (int nt = 0; nt < 4; ++nt) {
    f32x16 sa;
#pragma unroll
    for (int r = 0; r < 16; ++r) sa[r] = 0.f;
    const bf16_t* kp = keys + (nt * 32 + l31) * KLD + hh * 8;
#pragma unroll
    for (int ks = 0; ks < 8; ++ks) { const bf16x8 a = *(const bf16x8*)(kp + ks * 16); sa = MFMA32(a, bq[ks], sa); }
#pragma unroll
    for (int r = 0; r < 16; ++r) {
      const int n = nt * 32 + (r & 3) + 8 * (r >> 2) + 4 * hh;
      grp[r] = (ord_key(sa[r]) & ~0x7Fu) | (unsigned)(127 - n);
    }
    sort16_desc(grp);
    if (nt == 0) {
#pragma unroll
      for (int i = 0; i < 16; ++i) top[i] = grp[i];
    } else merge_top16(top, grp);
  }
  merge_partner16(top);
}

DI void phase_route(const Params& p, char* smem) {
  char* ws = p.ws;
  const int tid = otid(), lane = tid & 63, wave = tid >> 6, l31 = lane & 31, hh = lane >> 5;
  const bf16_t* pq = (const bf16_t*)(ws + OFF_PQ);
  const bf16_t* pk = (const bf16_t*)(ws + OFF_PKEYS);
  int* eidx = (int*)(ws + OFF_EIDX);
  float* pgate = (float*)(ws + OFF_PGATE);
  bf16_t* KL = (bf16_t*)smem;
  unsigned* LS = (unsigned*)(smem + 2 * 128 * KLD * 2) + wave * 1024;
  {
    const int h0 = blockIdx.x & 7;
    __syncthreads();
#pragma unroll
    for (int i = 0; i < 8; ++i) {
      const int idx = tid + i * NT, row = idx >> 4, ch = idx & 15;
      *(u32x4*)(KL + row * KLD + ch * 8) = *(const u32x4*)(pk + ((size_t)h0 * 256 + row) * 128 + ch * 8);
    }
    __syncthreads();
  }
  constexpr int CA[64] = {0,0,0,0,0,0,0,0,0,0,0,0,0,0,0,0, 1,1,1,1,1,1,1,1, 2,2,2,2,2, 3,3,3,3, 4,4,4, 5,5, 6,6, 7,7, 8,9,10,11,12,13,14,15, 0,0,0,0,0,0,0,0,0,0,0,0,0,0};
  constexpr int CB[64] = {0,1,2,3,4,5,6,7,8,9,10,11,12,13,14,15, 0,1,2,3,4,5,6,7, 0,1,2,3,4, 0,1,2,3, 0,1,2, 0,1, 0,1, 0,1, 0,0,0,0,0,0,0,0, 0,0,0,0,0,0,0,0,0,0,0,0,0,0};
  for (int item = blockIdx.x; item < (NTOK / 256) * 8; item += gridDim.x) {
    const int h = item & 7, t0 = (item >> 3) * 256 + wave * 32;
    unsigned s1[16], s2[16];
    const bf16_t* pqrow = pq + (size_t)(t0 + l31) * 2048 + h * 256 + hh * 8;
    bf16x8 bq1[8], bq2[8];
#pragma unroll
    for (int ks = 0; ks < 8; ++ks) { bq1[ks] = *(const bf16x8*)(pqrow + ks * 16); bq2[ks] = *(const bf16x8*)(pqrow + 128 + ks * 16); }
    peer_top16(s1, bq1, KL, lane);
    peer_top16(s2, bq2, KL + 128 * KLD, lane);
    float f1[16], f2[16];
#pragma unroll
    for (int i = 0; i < 16; ++i) { f1[i] = ord_val(s1[i]); f2[i] = ord_val(s2[i]); }
    unsigned ca[16], cb2[16];
#pragma unroll
    for (int i = 0; i < 32; ++i) {
      const int i0 = i, i1 = 25 + i;
      unsigned k0 = 0u, k1 = 0u;
      if (i0 < 25) k0 = (ord_key(f1[CA[i0]] + f2[CB[i0]]) & ~0xFFu) | (unsigned)(255 - (CA[i0] * 16 + CB[i0]));
      if (i1 < 50) k1 = (ord_key(f1[CA[i1]] + f2[CB[i1]]) & ~0xFFu) | (unsigned)(255 - (CA[i1] * 16 + CB[i1]));
      const unsigned kk = hh ? k1 : k0;
      if (i < 16) ca[i] = kk; else cb2[i - 16] = kk;
    }
    sort16_desc(ca); sort16_desc(cb2);
    merge_top16(ca, cb2);
    merge_partner16(ca);
    if (hh == 0) {
#pragma unroll
      for (int i = 0; i < 16; ++i) { LS[l31 * 32 + i] = s1[i]; LS[l31 * 32 + 16 + i] = s2[i]; }
    }
    const float mx = ord_val(ca[0]);
    float ex[16], sum = 0.f;
#pragma unroll
    for (int i = 0; i < 16; ++i) { ex[i] = __expf(ord_val(ca[i]) - mx); sum += ex[i]; }
    const float inv = 1.0f / sum;
    int eo[16]; float go[16];
#pragma unroll
    for (int i = 0; i < 16; ++i) {
      const int flat = 255 - (int)(ca[i] & 0xFFu);
      const unsigned k1 = LS[l31 * 32 + (flat >> 4)], k2 = LS[l31 * 32 + 16 + (flat & 15)];
      eo[i] = (127 - (int)(k1 & 0x7Fu)) * 128 + (127 - (int)(k2 & 0x7Fu));
      go[i] = ex[i] * inv;
    }
    const size_t ob = ((size_t)(t0 + l31) * 8 + h) * 16;
    if (hh == 0) {
      *(u32x4*)(eidx + ob) = (u32x4){(unsigned)eo[0], (unsigned)eo[1], (unsigned)eo[2], (unsigned)eo[3]};
      *(u32x4*)(eidx + ob + 4) = (u32x4){(unsigned)eo[4], (unsigned)eo[5], (unsigned)eo[6], (unsigned)eo[7]};
      *(f32x4*)(pgate + ob) = (f32x4){go[0], go[1], go[2], go[3]};
      *(f32x4*)(pgate + ob + 4) = (f32x4){go[4], go[5], go[6], go[7]};
    } else {
      *(u32x4*)(eidx + ob + 8) = (u32x4){(unsigned)eo[8], (unsigned)eo[9], (unsigned)eo[10], (unsigned)eo[11]};
      *(u32x4*)(eidx + ob + 12) = (u32x4){(unsigned)eo[12], (unsigned)eo[13], (unsigned)eo[14], (unsigned)eo[15]};
      *(f32x4*)(pgate + ob + 8) = (f32x4){go[8], go[9], go[10], go[11]};
      *(f32x4*)(pgate + ob + 12) = (f32x4){go[12], go[13], go[14], go[15]};
    }
  }
}

#define FOR32(M) M(0) M(1) M(2) M(3) M(4) M(5) M(6) M(7) M(8) M(9) M(10) M(11) M(12) M(13) M(14) M(15) M(16) M(17) M(18) M(19) M(20) M(21) M(22) M(23) M(24) M(25) M(26) M(27) M(28) M(29) M(30) M(31)
#define FOR16(M) M(0) M(1) M(2) M(3) M(4) M(5) M(6) M(7) M(8) M(9) M(10) M(11) M(12) M(13) M(14) M(15)
DI void phase_ffn_u(const Params& p) {
  char* ws = p.ws;
  const int lane = otid() & 63, wave = otid() >> 6, pg = lane >> 3, dc = lane & 7;
  const int sl = blockIdx.x & 7, wslot = (blockIdx.x >> 3) * NW + wave, nw = (gridDim.x >> 3) * NW;
  const unsigned char* PU8 = (const unsigned char*)(ws + OFF_PU8) + (size_t)sl * 16384 * 128 + dc * 16;
  const unsigned char* h2q = (const unsigned char*)(ws + OFF_H2Q) + sl * 128 + dc * 16;
  const int* eidx = (const int*)(ws + OFF_EIDX);
  float* part = (float*)(ws + OFF_PART) + (size_t)sl * NTOK * 128;
  const int j0 = (dc >> 2) * 64 + ((2 * dc) & 7) * 8 + pg;
  int ev0 = 0, ev1 = 0, nev0 = 0, nev1 = 0; u32x4 hq = {0u, 0u, 0u, 0u}, nhq = hq;
  if (wslot < NTOK) { ev0 = eidx[(size_t)wslot * 128 + lane]; ev1 = eidx[(size_t)wslot * 128 + 64 + lane]; hq = *(const u32x4*)(h2q + (size_t)wslot * DM); }
  for (int t = wslot; t < NTOK; t += nw) {
    if (t + nw < NTOK) { const size_t o = (size_t)(t + nw) * 128; nev0 = eidx[o + lane]; nev1 = eidx[o + 64 + lane]; nhq = *(const u32x4*)(h2q + (size_t)(t + nw) * DM); }
#define FFU_LD(it) const u32x4 ru##it = *(const u32x4*)(PU8 + (size_t)__shfl((it) < 8 ? ev0 : ev1, ((it) & 7) * 8 + pg) * 128);
    FOR16(FFU_LD)
    int d[16];
#define FFU_CP(it) { int a_ = __builtin_amdgcn_sdot4((int)ru##it.x, (int)hq.x, 0, false); a_ = __builtin_amdgcn_sdot4((int)ru##it.y, (int)hq.y, a_, false); \
      a_ = __builtin_amdgcn_sdot4((int)ru##it.z, (int)hq.z, a_, false); d[it] = __builtin_amdgcn_sdot4((int)ru##it.w, (int)hq.w, a_, false); }
    FOR16(FFU_CP)
    int r8[8], r4[4], r2[2];
    { const bool hi = dc & 4;
#pragma unroll
      for (int i = 0; i < 8; ++i) { const int keep = hi ? d[8 + i] : d[i], send = hi ? d[i] : d[8 + i]; r8[i] = keep + __shfl_xor(send, 4); } }
    { const bool hi = dc & 2;
#pragma unroll
      for (int i = 0; i < 4; ++i) { const int keep = hi ? r8[4 + i] : r8[i], send = hi ? r8[i] : r8[4 + i]; r4[i] = keep + __float_as_int(xor2f(__int_as_float(send))); } }
    { const bool hi = dc & 1;
#pragma unroll
      for (int i = 0; i < 2; ++i) { const int keep = hi ? r4[2 + i] : r4[i], send = hi ? r4[i] : r4[2 + i]; r2[i] = keep + __float_as_int(xor1f(__int_as_float(send))); } }
    part[(size_t)t * 128 + j0] = (float)r2[0];
    part[(size_t)t * 128 + j0 + 8] = (float)r2[1];
    ev0 = nev0; ev1 = nev1; hq = nhq;
  }
}
DI void phase_ffn_w(const Params& p) {
  char* ws = p.ws;
  const int lane = otid() & 63, wave = otid() >> 6;
  const float* part = (const float*)(ws + OFF_PART);
  const float* scu = (const float*)(ws + OFF_SCU); const float* scv = (const float*)(ws + OFF_SCV);
  const int* eidx = (const int*)(ws + OFF_EIDX);
  const float* pgate = (const float*)(ws + OFF_PGATE);
  float* wbuf = (float*)(ws + OFF_WBUF);
  for (int grp = blockIdx.x; grp < NTOK / NW; grp += gridDim.x) {
    const size_t o = (size_t)(grp * NW + wave) * 128 + lane;
    float a0 = 0.f, a1 = 0.f;
#pragma unroll
    for (int s8 = 0; s8 < 8; ++s8) { a0 += part[(size_t)s8 * NTOK * 128 + o]; a1 += part[(size_t)s8 * NTOK * 128 + o + 64]; }
    const int e0 = eidx[o], e1 = eidx[o + 64];
    const float sht = ((const float*)(ws + OFF_SH))[grp * NW + wave];
    wbuf[o] = pgate[o] * gelu_f(a0 * (scu[e0] * sht)) * scv[e0];
    wbuf[o + 64] = pgate[o + 64] * gelu_f(a1 * (scu[e1] * sht)) * scv[e1];
  }
}
DI void ffv_store(const f32x2 (&acc2)[8], bf16_t* dst, int lane) {
  float acc[16];
#pragma unroll
  for (int i = 0; i < 8; ++i) { acc[2 * i] = acc2[i].x; acc[2 * i + 1] = acc2[i].y; }
  float r8[8], r4[4], r2[2];
  { const bool hi = lane & 32;
#pragma unroll
    for (int i = 0; i < 8; ++i) { const float keep = hi ? acc[8 + i] : acc[i], send = hi ? acc[i] : acc[8 + i]; r8[i] = keep + xor32f(send, lane); } }
  { const bool hi = lane & 16;
#pragma unroll
    for (int i = 0; i < 4; ++i) { const float keep = hi ? r8[4 + i] : r8[i], send = hi ? r8[i] : r8[4 + i]; r4[i] = keep + xor16f(send, lane); } }
  { const bool hi = lane & 8;
#pragma unroll
    for (int i = 0; i < 2; ++i) { const float keep = hi ? r4[2 + i] : r4[i], send = hi ? r4[i] : r4[2 + i]; r2[i] = keep + xor8f(send); } }
  *(unsigned*)dst = pack2(r2[0], r2[1]);
}
DI void phase_ffn_v(const Params& p) {
  char* ws = p.ws;
  const int lane = otid() & 63, wave = otid() >> 6, pg = lane >> 3, dc = lane & 7;
  const int sl = blockIdx.x & 7, wslot = (blockIdx.x >> 3) * NW + wave, nw = (gridDim.x >> 3) * NW;
  const unsigned char* PV8 = (const unsigned char*)(ws + OFF_PV8) + (size_t)sl * 16384 * 128 + dc * 16;
  const int* eidx = (const int*)(ws + OFF_EIDX) + 16 * pg;
  const float* wbuf = (const float*)(ws + OFF_WBUF) + 16 * pg;
  bf16_t* ffnb = (bf16_t*)(ws + OFF_FFNB) + sl * 128 + dc * 16 + 2 * pg;
#define FFV_TOK(t_) min((t_), NTOK - 1)
#define FFV_LDE(S, t_) { const int* ep_ = eidx + (size_t)FFV_TOK(t_) * 128; S##e0 = *(const u32x4*)ep_; S##e1 = *(const u32x4*)(ep_ + 4); S##e2 = *(const u32x4*)(ep_ + 8); S##e3 = *(const u32x4*)(ep_ + 12); }
#define FFV_LDW(S, t_) { const float* wp_ = wbuf + (size_t)FFV_TOK(t_) * 128; S##w0 = *(const f32x4*)wp_; S##w1 = *(const f32x4*)(wp_ + 4); S##w2 = *(const f32x4*)(wp_ + 8); S##w3 = *(const f32x4*)(wp_ + 12); }
#define FFV_E(S, it) ((it) < 4 ? S##e0[(it) & 3] : (it) < 8 ? S##e1[(it) & 3] : (it) < 12 ? S##e2[(it) & 3] : S##e3[(it) & 3])
#define FFV_W(S, it) ((it) < 4 ? S##w0[(it) & 3] : (it) < 8 ? S##w1[(it) & 3] : (it) < 12 ? S##w2[(it) & 3] : S##w3[(it) & 3])
#define FFV_LDR1(S, it) S##r##it = *(const u32x4*)(PV8 + (size_t)FFV_E(S, it) * 128);
#define FFV_LDR(S) FFV_LDR1(S, 0) FFV_LDR1(S, 1) FFV_LDR1(S, 2) FFV_LDR1(S, 3) FFV_LDR1(S, 4) FFV_LDR1(S, 5) FFV_LDR1(S, 6) FFV_LDR1(S, 7) \
                   FFV_LDR1(S, 8) FFV_LDR1(S, 9) FFV_LDR1(S, 10) FFV_LDR1(S, 11) FFV_LDR1(S, 12) FFV_LDR1(S, 13) FFV_LDR1(S, 14) FFV_LDR1(S, 15)
#define FFV_CP(S, it) { const float wj = FFV_W(S, it); const f32x2 w2 = {wj, wj}; \
      acc2[0] += __builtin_amdgcn_cvt_pk_f32_fp8((int)S##r##it.x, false) * w2; acc2[1] += __builtin_amdgcn_cvt_pk_f32_fp8((int)S##r##it.x, true) * w2; \
      acc2[2] += __builtin_amdgcn_cvt_pk_f32_fp8((int)S##r##it.y, false) * w2; acc2[3] += __builtin_amdgcn_cvt_pk_f32_fp8((int)S##r##it.y, true) * w2; \
      acc2[4] += __builtin_amdgcn_cvt_pk_f32_fp8((int)S##r##it.z, false) * w2; acc2[5] += __builtin_amdgcn_cvt_pk_f32_fp8((int)S##r##it.z, true) * w2; \
      acc2[6] += __builtin_amdgcn_cvt_pk_f32_fp8((int)S##r##it.w, false) * w2; acc2[7] += __builtin_amdgcn_cvt_pk_f32_fp8((int)S##r##it.w, true) * w2; }
#define FFV_ACC(S, t_) { f32x2 acc2[8]; _Pragma("unroll") for (int i_ = 0; i_ < 8; ++i_) acc2[i_] = (f32x2){0.f, 0.f}; \
    FFV_CP(S, 0) FFV_CP(S, 1) FFV_CP(S, 2) FFV_CP(S, 3) FFV_CP(S, 4) FFV_CP(S, 5) FFV_CP(S, 6) FFV_CP(S, 7) \
    FFV_CP(S, 8) FFV_CP(S, 9) FFV_CP(S, 10) FFV_CP(S, 11) FFV_CP(S, 12) FFV_CP(S, 13) FFV_CP(S, 14) FFV_CP(S, 15) \
    ffv_store(acc2, ffnb + (size_t)FFV_TOK(t_) * DM, lane); }
  u32x4 Ae0, Ae1, Ae2, Ae3, Be0, Be1, Be2, Be3; f32x4 Aw0, Aw1, Aw2, Aw3, Bw0, Bw1, Bw2, Bw3;
  u32x4 Ar0, Ar1, Ar2, Ar3, Ar4, Ar5, Ar6, Ar7, Ar8, Ar9, Ar10, Ar11, Ar12, Ar13, Ar14, Ar15;
  u32x4 Br0, Br1, Br2, Br3, Br4, Br5, Br6, Br7, Br8, Br9, Br10, Br11, Br12, Br13, Br14, Br15;
  if (wslot >= NTOK) return;
  FFV_LDE(A, wslot) FFV_LDE(B, wslot + nw) FFV_LDW(A, wslot)
  FFV_LDR(A)
  FFV_LDE(A, wslot + 2 * nw)
#pragma unroll 1
  for (int t = wslot; t < NTOK; t += 2 * nw) {
    FFV_LDR(B) FFV_LDW(B, t + nw)
    __builtin_amdgcn_sched_barrier(0);
    FFV_ACC(A, t)
    __builtin_amdgcn_sched_barrier(0);
    FFV_LDR(A) FFV_LDW(A, t + 2 * nw) FFV_LDE(B, t + 3 * nw)
    __builtin_amdgcn_sched_barrier(0);
    FFV_ACC(B, t + nw)
    __builtin_amdgcn_sched_barrier(0);
    FFV_LDE(A, t + 4 * nw)
  }
}
DI void phase_final(const Params& p) {
  char* ws = p.ws;
  const int lane = otid() & 63, wave = otid() >> 6;
  const bf16_t* x1 = (const bf16_t*)(ws + OFF_X1);
  const bf16_t* ffnb = (const bf16_t*)(ws + OFF_FFNB);
  const float* mod = (const float*)(ws + OFF_MOD);
  for (int grp = blockIdx.x; grp < NTOK / NW; grp += gridDim.x) {
    const int row = grp * NW + wave, b = row >> 13;
    float v[16];
#pragma unroll
    for (int i = 0; i < 4; ++i) {
      const int col = i * 256 + lane * 4;
      const f32x4 gt2 = *(const f32x4*)(mod + b * 6144 + 5120 + col);
      const u32x2 xr = *(const u32x2*)(x1 + (size_t)row * DM + col), fr = *(const u32x2*)(ffnb + (size_t)row * DM + col);
      v[4 * i] = DN_ALPHA * bflo(xr.x) + gt2.x * bflo(fr.x); v[4 * i + 1] = DN_ALPHA * bfhi(xr.x) + gt2.y * bfhi(fr.x);
      v[4 * i + 2] = DN_ALPHA * bflo(xr.y) + gt2.z * bflo(fr.y); v[4 * i + 3] = DN_ALPHA * bfhi(xr.y) + gt2.w * bfhi(fr.y);
    }
    float mean, rstd; row_stats(v, mean, rstd);
#pragma unroll
    for (int i = 0; i < 4; ++i) {
      const int col = i * 256 + lane * 4;
      const f32x4 g = *(const f32x4*)(p.ln2_g + col), bb = *(const f32x4*)(p.ln2_b + col);
      f32x4 o;
      o.x = (v[4 * i] - mean) * rstd * g.x + bb.x; o.y = (v[4 * i + 1] - mean) * rstd * g.y + bb.y;
      o.z = (v[4 * i + 2] - mean) * rstd * g.z + bb.z; o.w = (v[4 * i + 3] - mean) * rstd * g.w + bb.w;
      *(f32x4*)(p.out + (size_t)row * DM + col) = o;
    }
  }
}

#define XB_TMO      128
#define XB_XCNT(j)  (256  + 64 * (j))
#define XB_XSUB(j)  (1280 + 64 * (j))
#define XB_XGEN(j)  (2304 + 64 * (j))
#define XB_TOP      3328
#define XB_TOPGEN   3392
#define XCD_BAR_WORDS 3456
#define XB_SPIN_CAP (1u << 22)
DI unsigned xb_ld(unsigned* p) { return __hip_atomic_load(p, __ATOMIC_RELAXED, __HIP_MEMORY_SCOPE_AGENT); }
DI unsigned xb_add(unsigned* p, unsigned v) { return __hip_atomic_fetch_add(p, v, __ATOMIC_RELAXED, __HIP_MEMORY_SCOPE_AGENT); }
DI unsigned xb_xcc_id() { return (unsigned)__builtin_amdgcn_s_getreg((3 << 11) | 20) & 0xFu; }
#define XB_SPIN(cond, bar) do { unsigned _sp = 0; while (cond) { __builtin_amdgcn_s_sleep(1); \
    if ((++_sp & 255u) == 0u) { if (xb_ld(&(bar)[XB_TMO])) break; if (_sp > XB_SPIN_CAP) { atomicAdd(&(bar)[XB_TMO], 1u); break; } } } } while (0)
struct XcdBarrier { unsigned* bar; unsigned x; volatile LAS unsigned* st; };
DI XcdBarrier xcd_barrier_post(unsigned* bar, volatile LAS unsigned* st) {
  XcdBarrier b; b.bar = bar; b.x = xb_xcc_id(); b.st = st;
  if (threadIdx.x == 0) (void)xb_add(&bar[XB_XCNT(b.x)], 1u);
  return b;
}
DI void xcd_barrier_complete(unsigned* bar, unsigned x, unsigned& nloc, unsigned& nx) {
  const unsigned G = gridDim.x * gridDim.y * gridDim.z;
  unsigned sum, cnt, mine, sp = 0u;
  for (;;) {
    sum = 0u; cnt = 0u; mine = 0u;
#pragma unroll
    for (unsigned j = 0; j < 16; ++j) { const unsigned c = xb_ld(&bar[XB_XCNT(j)]); sum += c; cnt += (c > 0u) ? 1u : 0u; mine = (j == x) ? c : mine; }
    if (sum == G) break;
    __builtin_amdgcn_s_sleep(1);
    if ((++sp & 255u) == 0u) { if (xb_ld(&bar[XB_TMO])) break; if (sp > XB_SPIN_CAP) { atomicAdd(&bar[XB_TMO], 1u); break; } }
  }
  nloc = mine > 0u ? mine : 1u; nx = cnt > 0u ? cnt : 1u;
}
DI void xcd_barrier(const XcdBarrier& b) {
  asm volatile("s_waitcnt vmcnt(0)" ::: "memory");
  __syncthreads();
  if (threadIdx.x == 0) {
    unsigned* bar = b.bar;
    __builtin_amdgcn_s_waitcnt(0);
    unsigned nloc = b.st[0], nx = b.st[1];
    if (nloc == 0u) { xcd_barrier_complete(bar, b.x, nloc, nx); b.st[0] = nloc; b.st[1] = nx; }
    const unsigned old = xb_add(&bar[XB_XSUB(b.x)], 1u);
    const unsigned gen = old / nloc;
    if (old + 1u == (gen + 1u) * nloc) {
      __builtin_amdgcn_fence(__ATOMIC_RELEASE, "agent");
      asm volatile("s_waitcnt vmcnt(0)" ::: "memory");
      const unsigned og = xb_add(&bar[XB_TOP], 1u);
      const unsigned tg = og / nx;
      if (og + 1u == (tg + 1u) * nx) xb_add(&bar[XB_TOPGEN], 1u);
      else XB_SPIN(xb_ld(&bar[XB_TOPGEN]) == tg, bar);
      __builtin_amdgcn_fence(__ATOMIC_ACQUIRE, "agent");
      xb_add(&bar[XB_XGEN(b.x)], 1u);
      asm volatile("s_waitcnt vmcnt(0)" ::: "memory");
    } else {
      XB_SPIN(xb_ld(&bar[XB_XGEN(b.x)]) == gen, bar);
      __builtin_amdgcn_fence(__ATOMIC_ACQUIRE, "agent");
      asm volatile("s_waitcnt vmcnt(0)" ::: "memory");
    }
  }
  __syncthreads();
}

constexpr int SMEM_BYTES = 147456 + 256;

__global__ void __launch_bounds__(NT, 2) k_mega(Params p) {
  __shared__ __attribute__((aligned(16))) char smem[SMEM_BYTES];
  cg::grid_group grid = cg::this_grid();
  if (threadIdx.x == 0) *(u32x4*)(smem + 147456) = (u32x4){0u, 0u, 0u, 0u};
  __syncthreads();
  const XcdBarrier xb = xcd_barrier_post((unsigned*)(p.ws + OFF_BAR), (volatile LAS unsigned*)(smem + 147456));
#define REP(mask) _Pragma("unroll 1") for (int rep_ = 0; rep_ < ((PROBE_DUP & (mask)) ? 2 : 1); ++rep_)
  REP(1) phase_prep(p, smem, (unsigned*)(p.ws + OFF_BAR) + XCD_BAR_WORDS + rep_);
  grid.sync();
  REP(1) phase_ln_in(p);
  xcd_barrier(xb);
  REP(2) phase_gemm1(p, smem);
  xcd_barrier(xb);
  REP(4) phase_compress(p, smem);
  phase_sgu(p, smem);
  xcd_barrier(xb);
  REP(8) phase_nsa(p, smem, NSA_MASK);
  xcd_barrier(xb);
  REP(16) phase_merge(p, smem);
  xcd_barrier(xb);
  REP(16) phase_outproj(p, smem);
  xcd_barrier(xb);
  REP(1) phase_ln_mid(p);
  xcd_barrier(xb);
  REP(32) phase_peerq(p, smem);
  xcd_barrier(xb);
  REP(64) phase_route(p, smem);
  xcd_barrier(xb);
  REP(128) phase_ffn_u(p);
  xcd_barrier(xb);
  REP(128) phase_ffn_w(p);
  xcd_barrier(xb);
  REP(256) phase_ffn_v(p);
  xcd_barrier(xb);
  REP(512) phase_final(p);
}

extern "C" void kernel_launch(void* const* d_in, const int* in_sizes, int n_in, void* d_out, int out_size, void* d_ws, size_t ws_size, hipStream_t stream) {
  if (ws_size < OFF_END) { fprintf(stderr, "workspace too small: %zu < %zu\n", ws_size, (size_t)OFF_END); return; }
  static int grid_blocks = 0;
  if (!grid_blocks) {
    int dev = 0, cus = 0, per_cu = 0;
    (void)hipGetDevice(&dev);
    (void)hipDeviceGetAttribute(&cus, hipDeviceAttributeMultiprocessorCount, dev);
    (void)hipOccupancyMaxActiveBlocksPerMultiprocessor(&per_cu, k_mega, NT, 0);
    if (per_cu < 1) fprintf(stderr, "occupancy query returned %d\n", per_cu);
    grid_blocks = (cus / 8) * 8;
  }
  Params p{};
  const float** fp = (const float**)&p;
  for (int i = 0; i < 26; ++i) fp[i] = (const float*)d_in[i];
  p.out = (float*)d_out;
  p.ws = (char*)d_ws;
  for (int i = 0; i < 32; ++i) p.inv_freq[i] = (float)pow(10000.0, -(double)i / 32.0);
  (void)hipMemsetAsync((char*)d_ws + OFF_BAR, 0, (XCD_BAR_WORDS + 64) * 4, stream);
  void* args[] = {&p};
  hipError_t e = hipLaunchCooperativeKernel((void*)k_mega, dim3(grid_blocks), dim3(NT), args, 0, stream);
  if (e != hipSuccess) fprintf(stderr, "cooperative launch failed: %s (grid %d)\n", hipGetErrorString(e), grid_blocks);
}
```

```cpp
#include <hip/hip_runtime.h>
#include <hip/hip_cooperative_groups.h>
#include <stdint.h>
#include <stdio.h>
#include <math.h>
namespace cg = cooperative_groups;

#ifndef PROBE_DUP
#define PROBE_DUP 0
#endif
#ifndef NSA_MASK
#define NSA_MASK 7
#endif
typedef unsigned short bf16_t;
typedef short bf16x8 __attribute__((ext_vector_type(8)));
typedef short s16x4 __attribute__((ext_vector_type(4)));
typedef float f32x16 __attribute__((ext_vector_type(16)));
typedef float f32x4 __attribute__((ext_vector_type(4)));
typedef float f32x2 __attribute__((ext_vector_type(2)));
typedef __bf16 bf16v2 __attribute__((ext_vector_type(2)));
typedef unsigned u32x4 __attribute__((ext_vector_type(4)));
typedef int i32x4 __attribute__((ext_vector_type(4)));
typedef int i32x8 __attribute__((ext_vector_type(8)));
typedef unsigned u32x2 __attribute__((ext_vector_type(2)));
#define DI __device__ __forceinline__
#define LAS __attribute__((address_space(3)))
#define MFMA32(a, b, c) __builtin_amdgcn_mfma_f32_32x32x16_bf16((a), (b), (c), 0, 0, 0)

constexpr int NT = 512, NW = 8;
constexpr int NB = 8, SEQ = 8192, DM = 1024, NTOK = NB * SEQ;
constexpr int N1 = 4608;
constexpr float DN_ALPHA = 1.189207115002721f;
constexpr float LN_EPS = 1e-5f;

constexpr size_t MB = 1024 * 1024;
constexpr size_t OFF_MOD = 0;
constexpr size_t OFF_ROPE = OFF_MOD + 256 * 1024;
constexpr size_t OFF_POSB = OFF_ROPE + 2 * MB;
constexpr size_t OFF_WT1 = OFF_POSB + 4096;
constexpr size_t OFF_WB = OFF_WT1 + (size_t)N1 * 1024 * 2;
constexpr size_t OFF_WOUT = OFF_WB + 2 * MB;
constexpr size_t OFF_WQ = OFF_WOUT + 2 * MB;
constexpr size_t OFF_PKEYS = OFF_WQ + 4 * MB;
constexpr size_t OFF_CW1 = OFF_PKEYS + MB / 2;
constexpr size_t OFF_CW2 = OFF_CW1 + MB;
constexpr size_t OFF_SGUW = OFF_CW2 + 32 * 1024;
constexpr size_t OFF_SCU = OFF_SGUW + 256 * 1024;
constexpr size_t OFF_SCV = OFF_SCU + 64 * 1024;
constexpr size_t OFF_PU = OFF_SCV + 64 * 1024;
constexpr size_t OFF_PV = OFF_PU + 32 * MB;
constexpr size_t OFF_ACT = ((OFF_PV + 32 * MB + 4095) / 4096) * 4096;
constexpr size_t OFF_H = OFF_ACT;
constexpr size_t OFF_Q = OFF_H + 128 * MB;
constexpr size_t OFF_KC = OFF_Q + 64 * MB;
constexpr size_t OFF_VC = OFF_KC + 16 * MB;
constexpr size_t OFF_KS = OFF_VC + 16 * MB;
constexpr size_t OFF_VS = OFF_KS + 16 * MB;
constexpr size_t OFF_KW = OFF_VS + 16 * MB;
constexpr size_t OFF_VW = OFF_KW + 16 * MB;
constexpr size_t OFF_U = OFF_VW + 16 * MB;
constexpr size_t OFF_V = OFF_U + 64 * MB;
constexpr size_t OFF_GATE = OFF_V + 64 * MB;
constexpr size_t OFF_GSIG = OFF_GATE + 256 * MB;
constexpr size_t OFF_KCMP = OFF_GSIG + 8 * MB;
constexpr size_t OFF_VCMP = OFF_KCMP + MB;
constexpr size_t OFF_ONSA = OFF_VCMP + MB;
constexpr size_t OFF_SELG = OFF_ONSA + 64 * MB;
constexpr size_t OFF_BAR = OFF_SELG + 2 * MB;
constexpr size_t OFF_END = OFF_BAR + 64 * 1024;
constexpr size_t OFF_X1 = OFF_Q;
constexpr size_t OFF_Y = OFF_GATE;
constexpr size_t OFF_PQ = OFF_GATE;
constexpr size_t OFF_EIDX = OFF_ONSA;
constexpr size_t OFF_PGATE = OFF_ONSA + 32 * MB;
constexpr size_t OFF_PU8 = OFF_PU;
constexpr size_t OFF_PART = OFF_GATE;
constexpr size_t OFF_PV8 = OFF_PU + 16 * MB;
constexpr size_t OFF_WBUF = OFF_PU + 32 * MB;
constexpr size_t OFF_H2Q = OFF_U;
constexpr size_t OFF_SH = OFF_V;
constexpr size_t OFF_FFNB = OFF_GATE;
constexpr size_t OFF_SCW1 = OFF_WT1 + 5 * MB;
constexpr size_t OFF_SCWQ = OFF_WQ + 3 * MB;
constexpr size_t OFF_GATE8 = OFF_GATE;
constexpr size_t OFF_OSGU8 = OFF_GATE + 128 * MB;
constexpr size_t OFF_ONSA8 = OFF_GATE + 160 * MB;
constexpr size_t OFF_MRG8 = OFF_GATE + 192 * MB;
constexpr size_t OFF_M08 = OFF_H;
constexpr size_t OFF_SCWB = OFF_WB + 3 * MB / 2;
constexpr size_t OFF_SCWO = OFF_WOUT + 3 * MB / 2;
constexpr size_t OFF_SA = OFF_H + 64 * MB;

struct Params {
  const float *x, *c, *w_ada, *b_ada, *w_in, *cmp_pos, *cmp_w1, *cmp_b1, *cmp_w2, *cmp_b2, *sgu_ln_g, *sgu_ln_b, *sgu_w, *sgu_b,
      *w_branch, *w_merge, *b_merge, *w_out, *ln1_g, *ln1_b, *peer_wq, *peer_keys, *peer_u, *peer_v, *ln2_g, *ln2_b;
  float* out;
  char* ws;
  float inv_freq[32];
};

DI unsigned pack2(float lo, float hi) { f32x2 v = {lo, hi}; bf16v2 r = __builtin_convertvector(v, bf16v2); return __builtin_bit_cast(unsigned, r); }
DI bf16_t f2bf(float f) { __bf16 r = (__bf16)f; return __builtin_bit_cast(unsigned short, r); }
DI float bf2f(bf16_t h) { return __uint_as_float(((unsigned)h) << 16); }
DI float bflo(unsigned u) { return __uint_as_float(u << 16); }
DI float bfhi(unsigned u) { return __uint_as_float(u & 0xffff0000u); }
DI float gelu_f(float v) { return 0.5f * v * (1.0f + erff(v * 0.70710678118654752f)); }
DI float sigmoid_f(float v) { return __builtin_amdgcn_rcpf(1.0f + __builtin_amdgcn_exp2f(v * -1.4426950408889634f)); }
DI int otid() { int t = __builtin_amdgcn_workitem_id_x(); asm volatile("" : "+v"(t)); return t; }
DI void lds_barrier() { asm volatile("s_waitcnt lgkmcnt(0)" ::: "memory"); __builtin_amdgcn_s_barrier(); asm volatile("" ::: "memory"); }
DI float xor1f(float x) { const int xi = __float_as_int(x); return __int_as_float(__builtin_amdgcn_update_dpp(xi, xi, 0xB1, 0xF, 0xF, false)); }
DI float xor2f(float x) { const int xi = __float_as_int(x); return __int_as_float(__builtin_amdgcn_update_dpp(xi, xi, 0x4E, 0xF, 0xF, false)); }
DI float xor8f(float x) { const int xi = __float_as_int(x); return __int_as_float(__builtin_amdgcn_update_dpp(xi, xi, 0x128, 0xF, 0xF, false)); }
DI unsigned xor32u(unsigned x, int lane) { const u32x2 r = __builtin_amdgcn_permlane32_swap(x, x, false, false); return (lane & 32) ? r.x : r.y; }
DI unsigned xor16u(unsigned x, int lane) { const u32x2 r = __builtin_amdgcn_permlane16_swap(x, x, false, false); return (lane & 16) ? r.x : r.y; }
DI float xor32f(float x, int lane) { return __uint_as_float(xor32u(__float_as_uint(x), lane)); }
DI float xor16f(float x, int lane) { return __uint_as_float(xor16u(__float_as_uint(x), lane)); }
DI unsigned pack_i8x4(float a, float b, float c, float d) {
  const int ia = (int)rintf(a), ib = (int)rintf(b), ic = (int)rintf(c), id = (int)rintf(d);
  return (unsigned)(ia & 0xff) | ((unsigned)(ib & 0xff) << 8) | ((unsigned)(ic & 0xff) << 16) | ((unsigned)id << 24);
}
DI unsigned pk4_fp8(float a, float b, float c, float d) { int t = 0; t = __builtin_amdgcn_cvt_pk_fp8_f32(a, b, t, false); t = __builtin_amdgcn_cvt_pk_fp8_f32(c, d, t, true); return (unsigned)t; }
DI float clamp_f8(float v) { return __builtin_amdgcn_fmed3f(v, -448.0f, 448.0f); }
DI void unpack8_fp8(const u32x2 w, float (&v)[8]) {
  const f32x2 a = __builtin_amdgcn_cvt_pk_f32_fp8((int)w.x, false), b = __builtin_amdgcn_cvt_pk_f32_fp8((int)w.x, true);
  const f32x2 c = __builtin_amdgcn_cvt_pk_f32_fp8((int)w.y, false), d = __builtin_amdgcn_cvt_pk_f32_fp8((int)w.y, true);
  v[0] = a.x; v[1] = a.y; v[2] = b.x; v[3] = b.y; v[4] = c.x; v[5] = c.y; v[6] = d.x; v[7] = d.y;
}
DI float wave_sum(float v) {
#pragma unroll
  for (int o = 32; o > 0; o >>= 1) v += __shfl_xor(v, o);
  return v;
}
DI void ld8(const float* pz, float (&v)[8]) { const f32x4 a = *(const f32x4*)pz, b = *(const f32x4*)(pz + 4); v[0] = a.x; v[1] = a.y; v[2] = a.z; v[3] = a.w; v[4] = b.x; v[5] = b.y; v[6] = b.z; v[7] = b.w; }
DI u32x4 pack8(const float (&v)[8]) { u32x4 w; w.x = pack2(v[0], v[1]); w.y = pack2(v[2], v[3]); w.z = pack2(v[4], v[5]); w.w = pack2(v[6], v[7]); return w; }
DI void unpack8(const u32x4 w, float (&v)[8]) { v[0] = bflo(w.x); v[1] = bfhi(w.x); v[2] = bflo(w.y); v[3] = bfhi(w.y); v[4] = bflo(w.z); v[5] = bfhi(w.z); v[6] = bflo(w.w); v[7] = bfhi(w.w); }
DI f32x2 gelu_pk(f32x2 v) {
  const f32x2 av = __builtin_elementwise_abs(v), d = av * 0.2316418882f + 1.0f;
  f32x2 t; t.x = __builtin_amdgcn_rcpf(d.x); t.y = __builtin_amdgcn_rcpf(d.y);
  f32x2 q = t * 0.5307027145f + (-0.7265760135f); q = q * t + 0.7107068705f; q = q * t + (-0.142248368f); q = q * t + 0.127414796f; q = q * t;
  const f32x2 s = (v * v) * (-0.72134752044f);
  f32x2 e; e.x = __builtin_amdgcn_exp2f(s.x); e.y = __builtin_amdgcn_exp2f(s.y);
  const f32x2 m = v * (q * e), r = v - m;
  f32x2 o; o.x = v.x < 0.f ? m.x : r.x; o.y = v.y < 0.f ? m.y : r.y; return o;
}
__host__ __device__ __forceinline__ int dperm(int q) { const int grp = q >> 5, fq = (q >> 3) & 3, j = q & 7; return (j < 4) ? (16 * grp + 4 * fq + j) : (32 + 16 * grp + 4 * fq + (j - 4)); }

template <class F>
DI void tconv_tile(float* tile, int k0, int n0, bf16_t* dst, int ldd, F f) {
  const int tid = otid();
  __syncthreads();
#pragma unroll 4
  for (int i = 0; i < 8; ++i) { const int kl = i * 8 + (tid >> 6), nl = tid & 63; tile[nl * 65 + kl] = f(k0 + kl, n0 + nl); }
  __syncthreads();
  {
    const int nl = tid >> 3, kc = tid & 7;
    const float* t = tile + nl * 65 + kc * 8;
    u32x4 w; w.x = pack2(t[0], t[1]); w.y = pack2(t[2], t[3]); w.z = pack2(t[4], t[5]); w.w = pack2(t[6], t[7]);
    *(u32x4*)(dst + (size_t)(n0 + nl) * ldd + k0 + kc * 8) = w;
  }
}

template <bool FP8, class F>
DI void tconv_strip32(float* tile, int n0, int K, unsigned char* dst, float* gscale, F f) {
  const int tid = otid(), nl = tid & 31, kr = tid >> 5, ld = K + 1;
  float am = 0.f;
#pragma unroll 16
  for (int k = kr; k < K; k += 16) { const float v = f(k, n0 + nl); tile[nl * ld + k] = v; am = fmaxf(am, fabsf(v)); }
#pragma unroll
  for (int o = 16; o > 0; o >>= 1) am = fmaxf(am, __shfl_xor(am, o));
  float* red = tile + 32 * ld;
  if (nl == 0) red[kr] = am;
  __syncthreads();
  float g = 0.f;
#pragma unroll
  for (int w = 0; w < 16; ++w) g = fmaxf(g, red[w]);
  float q, inv;
  if (FP8) {
    const unsigned be = (__float_as_uint(g) >> 23) & 0xffu;
    const bool ok = be >= 16u && be <= 240u;
    q = ok ? __uint_as_float((261u - be) << 23) : 1.0f; inv = ok ? __uint_as_float((be - 7u) << 23) : 1.0f;
  } else { q = g > 0.f ? 127.0f / g : 0.f; inv = g * (1.0f / 127.0f); }
  if (tid == 0) gscale[n0 >> 5] = inv;
  const int cpr = K >> 3;
  for (int idx = tid; idx < 32 * cpr; idx += NT) {
    const int row = idx / cpr, kc = idx - row * cpr;
    const float* t = tile + row * ld + kc * 8;
    u32x2 w;
    if (FP8) { w.x = pk4_fp8(t[0] * q, t[1] * q, t[2] * q, t[3] * q); w.y = pk4_fp8(t[4] * q, t[5] * q, t[6] * q, t[7] * q); }
    else { w.x = pack_i8x4(t[0] * q, t[1] * q, t[2] * q, t[3] * q); w.y = pack_i8x4(t[4] * q, t[5] * q, t[6] * q, t[7] * q); }
    *(u32x2*)(dst + (size_t)(n0 + row) * K + kc * 8) = w;
  }
}

DI void conv_chunk(const float* src, bf16_t* dst, size_t base) {
  const size_t i = base + (size_t)otid() * 8;
  const f32x4 a = *(const f32x4*)(src + i), b = *(const f32x4*)(src + i + 4);
  u32x4 w; w.x = pack2(a.x, a.y); w.y = pack2(a.z, a.w); w.z = pack2(b.x, b.y); w.w = pack2(b.z, b.w);
  *(u32x4*)(dst + i) = w;
}

DI void sincos_d(double x, double& s, double& c) {
  const double y = x * 0.25, y2 = y * y;
  double sn = y * (1.0 + y2 * (-1.0 / 6 + y2 * (1.0 / 120 + y2 * (-1.0 / 5040 + y2 * (1.0 / 362880 + y2 * (-1.0 / 39916800 + y2 * (1.0 / 6227020800.0)))))));
  double cs = 1.0 + y2 * (-0.5 + y2 * (1.0 / 24 + y2 * (-1.0 / 720 + y2 * (1.0 / 40320 + y2 * (-1.0 / 3628800 + y2 * (1.0 / 479001600.0 + y2 * (-1.0 / 87178291200.0)))))));
#pragma unroll
  for (int i = 0; i < 2; ++i) { const double s2 = 2.0 * sn * cs, c2 = cs * cs - sn * sn; sn = s2; cs = c2; }
  s = sn; c = cs;
}

DI void phase_prep(const Params& p, char* smem, unsigned* wcnt) {
  const int tid = otid();
  float* fs = (float*)smem;
  char* ws = p.ws;
  volatile LAS unsigned* slot = (volatile LAS unsigned*)(smem + 147456 + 64);
  constexpr int nB = 144, nE = 64, nC = 64, nD = 32, nA = 192, nI = 512, nF = 2 * 32 * 2, nG = 4, nH = 8, nJ = 64, nK = 32, nL = 512, nM = 512;
  constexpr int total = nB + nE + nC + nD + nA + nI + nF + nG + nH + nJ + nK + nL + nM;
  for (;;) {
    __syncthreads();
    if (tid == 0) *slot = __hip_atomic_fetch_add(wcnt, 1u, __ATOMIC_RELAXED, __HIP_MEMORY_SCOPE_AGENT);
    __syncthreads();
    int it = (int)*slot;
    if (it >= total) break;
    if (it < nB) {
      const float* w_in = p.w_in; const float* w_merge = p.w_merge;
      tconv_strip32<false>(fs, it * 32, 1024, (unsigned char*)(ws + OFF_WT1), (float*)(ws + OFF_SCW1), [=](int k, int n) -> float {
        if (n < 1280) {
          const bool roped = (n < 640) || (n >= 768 && n < 896) || (n >= 1024 && n < 1152);
          const int col = roped ? ((n & ~63) + dperm(n & 63)) : n;
          return w_in[(size_t)k * 2328 + col];
        }
        if (n < 2304) return w_in[(size_t)k * 2328 + n + 24];
        if (n < 4352) return w_merge[(size_t)k * 2048 + (n - 2304)];
        if (n < 4376) return w_in[(size_t)k * 2328 + 1280 + (n - 4352)];
        return 0.f; });
      continue;
    }
    it -= nB;
    if (it < nE) {
      const float* src = p.peer_wq;
      tconv_strip32<false>(fs, it * 32, 1024, (unsigned char*)(ws + OFF_WQ), (float*)(ws + OFF_SCWQ), [=](int k, int n) -> float { return src[(size_t)k * 2048 + n]; });
      continue;
    }
    it -= nE;
    if (it < nC) {
      const int br = it >> 5, strip = it & 31;
      const float* src = p.w_branch + (size_t)br * 512 * 1024;
      tconv_strip32<true>(fs, strip * 32, 512, (unsigned char*)(ws + OFF_WB) + (size_t)br * 1024 * 512, (float*)(ws + OFF_SCWB) + br * 32, [=](int k, int n) -> float { return src[(size_t)k * 1024 + n]; });
      continue;
    }
    it -= nC;
    if (it < nD) {
      const float* src = p.w_out;
      tconv_strip32<true>(fs, it * 32, 1024, (unsigned char*)(ws + OFF_WOUT), (float*)(ws + OFF_SCWO), [=](int k, int n) -> float { return src[(size_t)k * 1024 + n]; });
      continue;
    }
    it -= nD;
    if (it < nA) {
      float* sc = fs;
      float* red = fs + 8192;
      for (int i = tid; i < 8192; i += NT) { const float v = p.c[i]; sc[i] = v / (1.0f + __expf(-v)); }
      __syncthreads();
      const int ks = tid >> 5, cj = tid & 31, col = it * 32 + cj;
      float acc[8];
#pragma unroll
      for (int b = 0; b < 8; ++b) acc[b] = 0.f;
#pragma unroll 16
      for (int k = ks * 64; k < ks * 64 + 64; ++k) {
        const float w = p.w_ada[(size_t)k * 6144 + col];
#pragma unroll
        for (int b = 0; b < 8; ++b) acc[b] += sc[b * 1024 + k] * w;
      }
#pragma unroll
      for (int b = 0; b < 8; ++b) red[(ks * 8 + b) * 32 + cj] = acc[b];
      __syncthreads();
      if (tid < 256) {
        const int b = tid >> 5;
        float s = p.b_ada[col];
#pragma unroll
        for (int k2 = 0; k2 < 16; ++k2) s += red[(k2 * 8 + b) * 32 + cj];
        ((float*)(ws + OFF_MOD))[b * 6144 + col] = s;
      }
      continue;
    }
    it -= nA;
    if (it < nI) {
      const int e = it * 512 + tid, pos = e >> 5, i = e & 31;
      const float ang = (float)pos * p.inv_freq[i];
      const double a = (double)ang;
      const double kk = rint(a * 0.15915494309189535);
      const double r = a - kk * 6.283185307179586476925;
      double sn, cs; sincos_d(r, sn, cs);
      ((float*)(ws + OFF_ROPE))[e] = (float)cs;
      ((float*)(ws + OFF_ROPE))[262144 + e] = (float)sn;
      continue;
    }
    it -= nI;
    if (it < nF) {
      const int w = it >> 6, r = it & 63, kt = r >> 1, ntile = r & 1;
      const float* src = p.cmp_w1 + (size_t)w * 2048 * 128;
      tconv_tile(fs, kt * 64, ntile * 64, (bf16_t*)(ws + OFF_CW1) + (size_t)w * 128 * 2048, 2048, [=](int k, int n) -> float {
        const int ksrc = (w == 0) ? ((k & ~63) + dperm(k & 63)) : k;
        return src[(size_t)ksrc * 128 + n]; });
      continue;
    }
    it -= nF;
    if (it < nG) {
      const int w = it >> 1, kt = it & 1;
      const float* src = p.cmp_w2 + (size_t)w * 128 * 64;
      tconv_tile(fs, kt * 64, 0, (bf16_t*)(ws + OFF_CW2) + (size_t)w * 64 * 128, 128, [=](int k, int n) -> float { return src[(size_t)k * 64 + ((w == 0) ? dperm(n) : n)]; });
      continue;
    }
    it -= nG;
    if (it < nH) {
      const int w = it >> 2, jc = it & 3, ks = tid >> 5, cj = tid & 31, j = jc * 32 + cj;
      float* red = fs;
      const float* pos = p.cmp_pos + w * 2048; const float* w1 = p.cmp_w1 + (size_t)w * 2048 * 128;
      float acc = 0.f;
#pragma unroll 16
      for (int k = ks * 128; k < ks * 128 + 128; ++k) acc += pos[k] * w1[(size_t)k * 128 + j];
      red[ks * 32 + cj] = acc;
      __syncthreads();
      if (tid < 32) { float s = p.cmp_b1[w * 128 + j]; for (int k2 = 0; k2 < 16; ++k2) s += red[k2 * 32 + tid]; ((float*)(ws + OFF_POSB))[w * 128 + j] = s; }
      continue;
    }
    it -= nH;
    if (it < nJ) { conv_chunk(p.peer_keys, (bf16_t*)(ws + OFF_PKEYS), (size_t)it * 4096); continue; }
    it -= nJ;
    if (it < nK) {
      const size_t i0 = (size_t)it * 4096 + (size_t)tid * 8;
      const int rowi = (int)((i0 >> 7) & 127), j0 = (int)(i0 & 127);
      float v[8];
#pragma unroll
      for (int j = 0; j < 8; ++j) v[j] = (j0 + j <= rowi) ? p.sgu_w[i0 + j] : 0.f;
      u32x4 w; w.x = pack2(v[0], v[1]); w.y = pack2(v[2], v[3]); w.z = pack2(v[4], v[5]); w.w = pack2(v[6], v[7]);
      *(u32x4*)((bf16_t*)(ws + OFF_SGUW) + i0) = w;
      continue;
    }
    it -= nK;
    {
      const bool isv = it >= nL;
      if (isv) it -= nL;
      const int lane = tid & 63, e0 = it * 32 + (tid >> 6) * 4;
      const float* src = (isv ? p.peer_v : p.peer_u) + (size_t)e0 * 1024 + lane * 16;
      f32x4 raw[4][4];
#pragma unroll
      for (int r = 0; r < 4; ++r)
#pragma unroll
        for (int i = 0; i < 4; ++i) raw[r][i] = *(const f32x4*)(src + (size_t)r * 1024 + i * 4);
#pragma unroll
      for (int r = 0; r < 4; ++r) {
        const int e = e0 + r;
        float v[16];
#pragma unroll
        for (int i = 0; i < 4; ++i) { v[4 * i] = raw[r][i].x; v[4 * i + 1] = raw[r][i].y; v[4 * i + 2] = raw[r][i].z; v[4 * i + 3] = raw[r][i].w; }
        float amax = 0.f;
#pragma unroll
        for (int i = 0; i < 16; ++i) amax = fmaxf(amax, fabsf(v[i]));
#pragma unroll
        for (int o = 32; o > 0; o >>= 1) amax = fmaxf(amax, __shfl_xor(amax, o));
        if (!isv) {
          const float qs = amax > 0.f ? 127.0f / amax : 0.f;
          u32x4 wi; wi.x = pack_i8x4(v[0] * qs, v[1] * qs, v[2] * qs, v[3] * qs); wi.y = pack_i8x4(v[4] * qs, v[5] * qs, v[6] * qs, v[7] * qs);
          wi.z = pack_i8x4(v[8] * qs, v[9] * qs, v[10] * qs, v[11] * qs); wi.w = pack_i8x4(v[12] * qs, v[13] * qs, v[14] * qs, v[15] * qs);
          *(u32x4*)(ws + OFF_PU8 + ((size_t)(lane >> 3) * 16384 + e) * 128 + (lane & 7) * 16) = wi;
          if (lane == 0) ((float*)(ws + OFF_SCU))[e] = amax * (1.0f / 127.0f);
        } else {
          const unsigned be = (__float_as_uint(amax) >> 23) & 0xffu;
          const bool okr = be >= 16u && be <= 240u;
          const float scale = okr ? __uint_as_float((261u - be) << 23) : 1.0f;
          const float inv = okr ? __uint_as_float((be - 7u) << 23) : 1.0f;
          u32x4 w; w.x = pk4_fp8(v[0] * scale, v[1] * scale, v[2] * scale, v[3] * scale); w.y = pk4_fp8(v[4] * scale, v[5] * scale, v[6] * scale, v[7] * scale);
          w.z = pk4_fp8(v[8] * scale, v[9] * scale, v[10] * scale, v[11] * scale); w.w = pk4_fp8(v[12] * scale, v[13] * scale, v[14] * scale, v[15] * scale);
          *(u32x4*)(ws + OFF_PV8 + ((size_t)(lane >> 3) * 16384 + e) * 128 + (lane & 7) * 16) = w;
          if (lane == 0) ((float*)(ws + OFF_SCV))[e] = inv;
        }
      }
    }
  }
}

DI void row_stats(const float (&v)[16], float& mean, float& rstd) {
  float s = 0.f;
#pragma unroll
  for (int i = 0; i < 16; ++i) s += v[i];
  mean = wave_sum(s) * (1.0f / 1024.0f);
  float q = 0.f;
#pragma unroll
  for (int i = 0; i < 16; ++i) { const float d = v[i] - mean; q += d * d; }
  rstd = rsqrtf(wave_sum(q) * (1.0f / 1024.0f) + LN_EPS);
}

DI void phase_ln_in(const Params& p) {
  const int lane = otid() & 63, wave = otid() >> 6;
  const float* mod = (const float*)(p.ws + OFF_MOD);
  unsigned* h8 = (unsigned*)(p.ws + OFF_H);
  for (int grp = blockIdx.x; grp < NTOK / NW; grp += gridDim.x) {
    const int row = grp * NW + wave, b = row >> 13;
    const float* xr = p.x + (size_t)row * DM;
    float v[16];
#pragma unroll
    for (int i = 0; i < 4; ++i) { const f32x4 t = *(const f32x4*)(xr + i * 256 + lane * 4); v[4 * i] = t.x; v[4 * i + 1] = t.y; v[4 * i + 2] = t.z; v[4 * i + 3] = t.w; }
    float mean, rstd; row_stats(v, mean, rstd);
    float amax = 0.f;
#pragma unroll
    for (int i = 0; i < 4; ++i) {
      const int col = i * 256 + lane * 4;
      const f32x4 sh = *(const f32x4*)(mod + b * 6144 + col), sc = *(const f32x4*)(mod + b * 6144 + 1024 + col);
      const float o0 = (v[4 * i] - mean) * rstd * (1.f + sc.x) + sh.x, o1 = (v[4 * i + 1] - mean) * rstd * (1.f + sc.y) + sh.y;
      const float o2 = (v[4 * i + 2] - mean) * rstd * (1.f + sc.z) + sh.z, o3 = (v[4 * i + 3] - mean) * rstd * (1.f + sc.w) + sh.w;
      v[4 * i] = o0; v[4 * i + 1] = o1; v[4 * i + 2] = o2; v[4 * i + 3] = o3;
      amax = fmaxf(amax, fmaxf(fmaxf(fabsf(o0), fabsf(o1)), fmaxf(fabsf(o2), fabsf(o3))));
    }
#pragma unroll
    for (int o = 32; o > 0; o >>= 1) amax = fmaxf(amax, __shfl_xor(amax, o));
    const float qs = amax > 0.f ? 127.0f / amax : 0.f;
#pragma unroll
    for (int i = 0; i < 4; ++i) h8[(size_t)row * 256 + i * 64 + lane] = pack_i8x4(v[4 * i] * qs, v[4 * i + 1] * qs, v[4 * i + 2] * qs, v[4 * i + 3] * qs);
    if (lane == 0) ((float*)(p.ws + OFF_SA))[row] = amax * (1.0f / 127.0f);
  }
}

DI void phase_ln_mid(const Params& p) {
  const int lane = otid() & 63, wave = otid() >> 6;
  const float* mod = (const float*)(p.ws + OFF_MOD);
  const bf16_t* y = (const bf16_t*)(p.ws + OFF_Y);
  bf16_t* x1 = (bf16_t*)(p.ws + OFF_X1);
  for (int grp = blockIdx.x; grp < NTOK / NW; grp += gridDim.x) {
    const int row = grp * NW + wave, b = row >> 13;
    const bf16_t* yr = y + (size_t)row * DM;
    float v[16];
#pragma unroll
    for (int i = 0; i < 4; ++i) { const u32x2 t = *(const u32x2*)(yr + i * 256 + lane * 4); v[4 * i] = bflo(t.x); v[4 * i + 1] = bfhi(t.x); v[4 * i + 2] = bflo(t.y); v[4 * i + 3] = bfhi(t.y); }
    float mean, rstd; row_stats(v, mean, rstd);
#pragma unroll
    for (int i = 0; i < 4; ++i) {
      const int col = i * 256 + lane * 4;
      const f32x4 g = *(const f32x4*)(p.ln1_g + col), bb = *(const f32x4*)(p.ln1_b + col);
      f32x4 o;
      o.x = (v[4 * i] - mean) * rstd * g.x + bb.x; o.y = (v[4 * i + 1] - mean) * rstd * g.y + bb.y;
      o.z = (v[4 * i + 2] - mean) * rstd * g.z + bb.z; o.w = (v[4 * i + 3] - mean) * rstd * g.w + bb.w;
      { u32x2 w; w.x = pack2(o.x, o.y); w.y = pack2(o.z, o.w); *(u32x2*)(x1 + (size_t)row * DM + col) = w; }
      v[4 * i] = o.x; v[4 * i + 1] = o.y; v[4 * i + 2] = o.z; v[4 * i + 3] = o.w;
    }
    row_stats(v, mean, rstd);
    float amax = 0.f;
#pragma unroll
    for (int i = 0; i < 4; ++i) {
      const int col = i * 256 + lane * 4;
      const f32x4 sh = *(const f32x4*)(mod + b * 6144 + 3072 + col), sc = *(const f32x4*)(mod + b * 6144 + 4096 + col);
      const float o0 = (v[4 * i] - mean) * rstd * (1.f + sc.x) + sh.x, o1 = (v[4 * i + 1] - mean) * rstd * (1.f + sc.y) + sh.y;
      const float o2 = (v[4 * i + 2] - mean) * rstd * (1.f + sc.z) + sh.z, o3 = (v[4 * i + 3] - mean) * rstd * (1.f + sc.w) + sh.w;
      v[4 * i] = o0; v[4 * i + 1] = o1; v[4 * i + 2] = o2; v[4 * i + 3] = o3;
      amax = fmaxf(amax, fmaxf(fmaxf(fabsf(o0), fabsf(o1)), fmaxf(fabsf(o2), fabsf(o3))));
    }
#pragma unroll
    for (int o = 32; o > 0; o >>= 1) amax = fmaxf(amax, __shfl_xor(amax, o));
    const float qs = amax > 0.f ? 127.0f / amax : 0.f;
    unsigned* h2q = (unsigned*)(p.ws + OFF_H2Q);
#pragma unroll
    for (int i = 0; i < 4; ++i) h2q[(size_t)row * 256 + i * 64 + lane] = pack_i8x4(v[4 * i] * qs, v[4 * i + 1] * qs, v[4 * i + 2] * qs, v[4 * i + 3] * qs);
    if (lane == 0) ((float*)(p.ws + OFF_SH))[row] = amax * (1.0f / 127.0f);
  }
}

namespace pg8 {
constexpr int BM = 256, BK = 64, HALF = 128, HTB = HALF * BK * 2, STAGE_BYTES = 8 * HTB, NXCD = 8, WGM = 8;
DI int lds_byte(int r, int c) { const int st = (r >> 4) * 2 + (c >> 5), rr = r & 15, cc = c & 31, ob = rr * 64 + cc * 2; return st * 1024 + (ob ^ (((ob >> 9) & 1) << 5)); }
DI void stage_rc(int b, int& R, int& C) { const int st = b / 1024, sb = b % 1024, swz = sb ^ (((sb >> 9) & 1) << 5); R = (st >> 1) * 16 + swz / 64; C = (st & 1) * 32 + (swz % 64) / 2; }
DI int perm32(int rho) { const int n = rho >> 4, i = rho & 15; return 8 * (i >> 2) + 4 * n + (i & 3); }
struct Unit { int pm, pn; };
struct Gemm { const bf16_t* A; const bf16_t* Bt; int M, N, K; };
struct StaticOrder {
  int nM, nN, nwg, G, c, nr, rot;
  DI void init(int M, int N, int G_, int c_, bool rotate = false) {
    nM = M / BM; nN = N / BM; nwg = nM * nN; G = G_; c = c_;
    nr = (rotate && nwg % G == 0) ? nwg / G : 0; rot = nr ? ((c % NXCD) * nr) / NXCD : 0;
  }
  DI bool next(int i, Unit& u) const {
    if (nr) { if (i >= nr) return false; i += rot; if (i >= nr) i -= nr; }
    const long L = (long)i * G + c; if (L >= nwg) return false;
    int wgid = (int)L; { const int q = nwg / NXCD, r = nwg % NXCD, xcd = wgid % NXCD, off = wgid / NXCD; wgid = (xcd < r ? xcd * (q + 1) : r * (q + 1) + (xcd - r) * q) + off; }
    const int nig = WGM * nN, gid = wgid / nig, fm = gid * WGM, gsz = (nM - fm) < WGM ? (nM - fm) : WGM;
    u.pm = fm + ((wgid % nig) % gsz); u.pn = (wgid % nig) / gsz; return true;
  }
};

template <int MODE, class AccT>
DI AccT mma_pair(bf16x8 b0, bf16x8 b1, bf16x8 a0, bf16x8 a1, AccT c) {
  if constexpr (MODE == 0) { c = __builtin_amdgcn_mfma_f32_16x16x32_bf16(b0, a0, c, 0, 0, 0); return __builtin_amdgcn_mfma_f32_16x16x32_bf16(b1, a1, c, 0, 0, 0); }
  else if constexpr (MODE == 1) {
    c = __builtin_amdgcn_mfma_i32_16x16x64_i8(__builtin_bit_cast(i32x4, b0), __builtin_bit_cast(i32x4, a0), c, 0, 0, 0);
    return __builtin_amdgcn_mfma_i32_16x16x64_i8(__builtin_bit_cast(i32x4, b1), __builtin_bit_cast(i32x4, a1), c, 0, 0, 0);
  } else {
    const i32x8 B = __builtin_shufflevector(__builtin_bit_cast(i32x4, b0), __builtin_bit_cast(i32x4, b1), 0, 1, 2, 3, 4, 5, 6, 7);
    const i32x8 A = __builtin_shufflevector(__builtin_bit_cast(i32x4, a0), __builtin_bit_cast(i32x4, a1), 0, 1, 2, 3, 4, 5, 6, 7);
    asm volatile("v_mfma_f32_16x16x128_f8f6f4 %0, %1, %2, %0" : "+v"(c) : "v"(B), "v"(A));
    return c;
  }
}
DI f32x4 mma16(bf16x8 a, bf16x8 b, f32x4 c) { return __builtin_amdgcn_mfma_f32_16x16x32_bf16(a, b, c, 0, 0, 0); }
DI i32x4 mma16(bf16x8 a, bf16x8 b, i32x4 c) { return __builtin_amdgcn_mfma_i32_16x16x64_i8(__builtin_bit_cast(i32x4, a), __builtin_bit_cast(i32x4, b), c, 0, 0, 0); }
template <class Epi>
DI void gemm_phase(LAS unsigned char* lds, const Gemm g, const StaticOrder& S, const Epi& E) {
  const int tid = otid(), wid = __builtin_amdgcn_readfirstlane(tid >> 6), lane = tid & 63, wr = wid >> 2, wc = wid & 3, fr = lane & 15, fq = lane >> 4;
  const int K = g.K, nt = K / BK;
  unsigned voffA[2], voffB[2];
#pragma unroll
  for (int i = 0; i < 2; ++i) { int R, C; stage_rc(tid * 16 + i * 8192, R, C); const int Rb = Epi::PERM ? ((R & ~31) + perm32(R & 31)) : R;
    voffA[i] = (unsigned)(R * K + C) * 2u; voffB[i] = (unsigned)(Rb * K + C) * 2u; }
  const size_t kstep = (size_t)(BK * 2);
  const size_t hstep = (size_t)HALF * K * 2;
  const size_t tstep = 2 * hstep;
  const unsigned ldsw = (unsigned)wid * 1024u;
  const int aoff = lds_byte(wr * 64 + fr, fq * 8), boff = lds_byte(wc * 32 + fr, fq * 8);
  LAS unsigned char* ldsB = lds + 4 * HTB + boff;
  asm volatile("" : "+v"(ldsB));
#define PG8_SA(b, h) (((b) * 2 + (h)) * HTB)
#define PG8_SB(b, h) ((4 + (b) * 2 + (h)) * HTB)
#define PG8_STAGE(bufoff, gbase, voff) do { _Pragma("unroll") for (int _i = 0; _i < 2; ++_i) \
    __builtin_amdgcn_global_load_lds((const unsigned*)((const char*)(gbase) + (voff)[_i]), (LAS unsigned*)(lds + (bufoff) + ldsw + _i * 8192), 16, 0, 0); } while (0)
#define PG8_LDA(dst, b, h) do { _Pragma("unroll") for (int m = 0; m < 4; ++m) _Pragma("unroll") for (int k = 0; k < 2; ++k) dst[m][k] = *(const LAS bf16x8*)(lds + PG8_SA(b, h) + aoff + m * 2048 + k * 1024); } while (0)
#define PG8_LDB(dst, b, h) do { _Pragma("unroll") for (int n = 0; n < 2; ++n) _Pragma("unroll") for (int k = 0; k < 2; ++k) dst[n][k] = *(const LAS bf16x8*)(ldsB + ((b) * 2 + (h)) * HTB + n * 2048 + k * 1024); } while (0)
#define PG8_MMA(ai, bj, At, Bt) do { __builtin_amdgcn_s_setprio(1); _Pragma("unroll") for (int m = 0; m < 4; ++m) _Pragma("unroll") for (int n = 0; n < 2; ++n) \
    acc[ai][bj][m][n] = mma_pair<Epi::MODE>(Bt[n][0], Bt[n][1], At[m][0], At[m][1], acc[ai][bj][m][n]); __builtin_amdgcn_s_setprio(0); } while (0)
#define PG8_WAIT_V(n) asm volatile("s_waitcnt vmcnt(" #n ")" ::: "memory")
#define PG8_WAIT_L(n) asm volatile("s_waitcnt lgkmcnt(" #n ")" ::: "memory")
#define PG8_BAR __builtin_amdgcn_s_barrier()
#define PG8_SCHED __builtin_amdgcn_sched_barrier(0)
  Unit cur, nxt; int ui = 0;
  if (!S.next(0, cur)) return;
  typedef typename Epi::AccT AccT;
  const AccT zacc = {0, 0, 0, 0};
  AccT acc[2][2][4][2];
#pragma unroll
  for (int a = 0; a < 2; ++a)
#pragma unroll
    for (int b = 0; b < 2; ++b)
#pragma unroll
      for (int m = 0; m < 4; ++m)
#pragma unroll
        for (int n = 0; n < 2; ++n) acc[a][b][m][n] = zacc;
  bf16x8 At[4][2], B0[2][2], B1[2][2];
  const char* cA = (const char*)g.A + (size_t)cur.pm * tstep; const char* cB = (const char*)g.Bt + (size_t)cur.pn * tstep;
  PG8_STAGE(PG8_SB(0, 0), cB, voffB); PG8_STAGE(PG8_SA(0, 0), cA, voffA); PG8_STAGE(PG8_SB(0, 1), cB + hstep, voffB); PG8_STAGE(PG8_SA(0, 1), cA + hstep, voffA);
  if (wr == 1) PG8_BAR;
  PG8_WAIT_V(4); PG8_BAR;
  PG8_STAGE(PG8_SB(1, 0), cB + kstep, voffB); PG8_STAGE(PG8_SA(1, 0), cA + kstep, voffA); PG8_STAGE(PG8_SB(1, 1), cB + hstep + kstep, voffB);
  PG8_WAIT_V(6); PG8_BAR;
  for (;;) {
    const bool has_next = S.next(ui + 1, nxt);
    const char* nA = has_next ? (const char*)g.A + (size_t)nxt.pm * tstep : cA; const char* nB = has_next ? (const char*)g.Bt + (size_t)nxt.pn * tstep : cB;
#pragma unroll 1
    for (int t = 0; t < nt; t += 2) {
      const bool last = (t == nt - 2);
      const char* a1 = cA + (size_t)(t + 1) * kstep;
      const char* a2 = last ? nA : cA + (size_t)(t + 2) * kstep; const char* b2 = last ? nB : cB + (size_t)(t + 2) * kstep;
      const char* a3 = a2 + kstep; const char* b3 = b2 + kstep;
      PG8_LDB(B0, 0, 0); PG8_SCHED; PG8_LDA(At, 0, 0); PG8_STAGE(PG8_SA(1, 1), a1 + hstep, voffA);
      PG8_WAIT_L(8); PG8_BAR; PG8_WAIT_L(0); PG8_MMA(0, 0, At, B0); PG8_BAR; PG8_SCHED;
      PG8_LDB(B1, 0, 1); PG8_STAGE(PG8_SB(0, 0), b2, voffB);
      PG8_BAR; PG8_WAIT_L(0); PG8_MMA(0, 1, At, B1); PG8_BAR;
      PG8_LDA(At, 0, 1); PG8_STAGE(PG8_SA(0, 0), a2, voffA);
      PG8_BAR; PG8_WAIT_L(0); PG8_MMA(1, 0, At, B0); PG8_BAR; PG8_SCHED;
      PG8_STAGE(PG8_SB(0, 1), b2 + hstep, voffB);
      PG8_WAIT_V(6); PG8_BAR; PG8_MMA(1, 1, At, B1); PG8_BAR;
      PG8_LDB(B0, 1, 0); PG8_SCHED; PG8_LDA(At, 1, 0); PG8_STAGE(PG8_SA(0, 1), a2 + hstep, voffA);
      PG8_WAIT_L(8); PG8_BAR; PG8_WAIT_L(0); PG8_MMA(0, 0, At, B0); PG8_BAR; PG8_SCHED;
      PG8_LDB(B1, 1, 1); PG8_STAGE(PG8_SB(1, 0), b3, voffB);
      PG8_BAR; PG8_WAIT_L(0); PG8_MMA(0, 1, At, B1); PG8_BAR;
      PG8_LDA(At, 1, 1); PG8_STAGE(PG8_SA(1, 0), a3, voffA);
      PG8_BAR; PG8_WAIT_L(0); PG8_MMA(1, 0, At, B0); PG8_BAR; PG8_SCHED;
      PG8_STAGE(PG8_SB(1, 1), b3 + hstep, voffB);
      PG8_WAIT_V(6); PG8_BAR; PG8_MMA(1, 1, At, B1); PG8_BAR;
    }
    PG8_SCHED;
    if constexpr (Epi::MODE == 2) asm volatile("s_nop 15\n\ts_nop 15\n\ts_nop 15\n\ts_nop 15" ::: "memory");
    { const int l2 = otid() & 63; E(acc, cur, wr, wc, l2 & 15, l2 >> 4); }
    PG8_SCHED;
    if (!has_next) break;
#pragma unroll
    for (int a = 0; a < 2; ++a)
#pragma unroll
      for (int b = 0; b < 2; ++b)
#pragma unroll
        for (int m = 0; m < 4; ++m)
#pragma unroll
          for (int n = 0; n < 2; ++n) acc[a][b][m][n] = zacc;
    cur = nxt; cA = nA; cB = nB; ++ui;
  }
  PG8_WAIT_V(0);
  if (wr == 0) PG8_BAR;
  PG8_BAR;
#undef PG8_SA
#undef PG8_SB
#undef PG8_STAGE
#undef PG8_LDA
#undef PG8_LDB
#undef PG8_MMA
#undef PG8_WAIT_V
#undef PG8_WAIT_L
#undef PG8_BAR
#undef PG8_SCHED
}
}

struct EpiProj {
  static constexpr bool PERM = true;
  static constexpr int MODE = 1;
  typedef i32x4 AccT;
  char* ws; const float* b_merge;
  DI void operator()(const i32x4 (&acc)[2][2][4][2], const pg8::Unit& u, int wr, int wc, int fr, int fq) const {
    const float* rope = (const float*)(ws + OFF_ROPE);
    const float* sa = (const float*)(ws + OFF_SA); const float* sw = (const float*)(ws + OFF_SCW1);
    const int row0 = u.pm * 256 + wr * 64 + fr;
#pragma unroll
    for (int bj = 0; bj < 2; ++bj) {
      const int cg = u.pn * 256 + bj * 128 + wc * 32;
      const int c0 = cg + 8 * fq;
      if (cg >= 4384) continue;
      const float sbg = sw[cg >> 5];
#define EPJ_CV(sc_) const float f_ = sa[row] * (sc_); const f32x4 cv0 = __builtin_convertvector(acc[ai][bj][m][0], f32x4) * f_, cv1 = __builtin_convertvector(acc[ai][bj][m][1], f32x4) * f_;
      if (cg < 1280 && (cg < 640 || (cg >= 768 && cg < 896) || (cg >= 1024 && cg < 1152))) {
        bf16_t* dst; unsigned ld, cofs; float scale = 1.0f;
        if (cg < 512) { dst = (bf16_t*)(ws + OFF_Q); ld = 512; cofs = c0; scale = 0.18033688011112042f; }
        else if (cg < 640) { dst = (bf16_t*)(ws + OFF_KC); ld = 128; cofs = c0 - 512; }
        else if (cg < 896) { dst = (bf16_t*)(ws + OFF_KS); ld = 128; cofs = c0 - 768; }
        else { dst = (bf16_t*)(ws + OFF_KW); ld = 128; cofs = c0 - 1024; }
        const int d0 = 16 * ((cg >> 5) & 1) + 4 * fq;
#pragma unroll
        for (int ai = 0; ai < 2; ++ai)
#pragma unroll
          for (int m = 0; m < 4; ++m) {
            const int row = row0 + ai * 128 + m * 16, pos = row & (SEQ - 1);
            const f32x4 cs = *(const f32x4*)(rope + pos * 32 + d0), sn = *(const f32x4*)(rope + 262144 + pos * 32 + d0);
            EPJ_CV(sbg * scale)
            const f32x4 o1 = cv0 * cs - cv1 * sn, o2 = cv0 * sn + cv1 * cs;
            u32x4 w; w.x = pack2(o1.x, o1.y); w.y = pack2(o1.z, o1.w); w.z = pack2(o2.x, o2.y); w.w = pack2(o2.z, o2.w);
            *(u32x4*)(dst + (unsigned)row * ld + cofs) = w;
          }
      } else if (cg < 1280) {
        bf16_t* dst; unsigned cofs;
        if (cg < 768) { dst = (bf16_t*)(ws + OFF_VC); cofs = c0 - 640; }
        else if (cg < 1024) { dst = (bf16_t*)(ws + OFF_VS); cofs = c0 - 896; }
        else { dst = (bf16_t*)(ws + OFF_VW); cofs = c0 - 1152; }
#pragma unroll
        for (int ai = 0; ai < 2; ++ai)
#pragma unroll
          for (int m = 0; m < 4; ++m) {
            const int row = row0 + ai * 128 + m * 16;
            EPJ_CV(sbg)
            const f32x4 a = cv0, b = cv1;
            u32x4 w; w.x = pack2(a.x, a.y); w.y = pack2(a.z, a.w); w.z = pack2(b.x, b.y); w.w = pack2(b.z, b.w);
            *(u32x4*)(dst + (unsigned)row * 128u + cofs) = w;
          }
      } else if (cg < 2304) {
        bf16_t* dst = (bf16_t*)(ws + (cg < 1792 ? OFF_U : OFF_V));
        const unsigned cofs = c0 - (cg < 1792 ? 1280 : 1792);
#pragma unroll
        for (int ai = 0; ai < 2; ++ai)
#pragma unroll
          for (int m = 0; m < 4; ++m) {
            const int row = row0 + ai * 128 + m * 16;
            EPJ_CV(sbg)
            const f32x4 a = cv0, b = cv1;
            const f32x2 g0 = gelu_pk((f32x2){a.x, a.y}), g1 = gelu_pk((f32x2){a.z, a.w}), g2 = gelu_pk((f32x2){b.x, b.y}), g3 = gelu_pk((f32x2){b.z, b.w});
            u32x4 w; w.x = pack2(g0.x, g0.y); w.y = pack2(g1.x, g1.y); w.z = pack2(g2.x, g2.y); w.w = pack2(g3.x, g3.y);
            *(u32x4*)(dst + (unsigned)row * 512u + cofs) = w;
          }
      } else if (cg < 4352) {
        unsigned char* dst = (unsigned char*)(ws + OFF_GATE8);
        const unsigned cofs = c0 - 2304;
        const f32x4 b0 = *(const f32x4*)(b_merge + cofs) * -1.4426950408889634f, b1 = *(const f32x4*)(b_merge + cofs + 4) * -1.4426950408889634f;
        const float sbn = sbg * -1.4426950408889634f;
#define EPJ_SG(x_) __builtin_amdgcn_rcpf(1.0f + __builtin_amdgcn_exp2f(x_))
#pragma unroll
        for (int ai = 0; ai < 2; ++ai)
#pragma unroll
          for (int m = 0; m < 4; ++m) {
            const int row = row0 + ai * 128 + m * 16;
            const float f_ = sa[row] * sbn;
            const f32x4 a = __builtin_convertvector(acc[ai][bj][m][0], f32x4) * f_ + b0, b = __builtin_convertvector(acc[ai][bj][m][1], f32x4) * f_ + b1;
            u32x2 w; w.x = pk4_fp8(EPJ_SG(a.x), EPJ_SG(a.y), EPJ_SG(a.z), EPJ_SG(a.w));
            w.y = pk4_fp8(EPJ_SG(b.x), EPJ_SG(b.y), EPJ_SG(b.z), EPJ_SG(b.w));
            *(u32x2*)(dst + (unsigned)row * 2048u + cofs) = w;
          }
      } else {
        float* gs = (float*)(ws + OFF_GSIG);
        if (fq < 3) {
#pragma unroll
          for (int ai = 0; ai < 2; ++ai)
#pragma unroll
            for (int m = 0; m < 4; ++m) {
              const int row = row0 + ai * 128 + m * 16;
              EPJ_CV(sbg)
              const f32x4 a = cv0, b = cv1;
              f32x4 o0, o1; o0.x = sigmoid_f(a.x); o0.y = sigmoid_f(a.y); o0.z = sigmoid_f(a.z); o0.w = sigmoid_f(a.w);
              o1.x = sigmoid_f(b.x); o1.y = sigmoid_f(b.y); o1.z = sigmoid_f(b.z); o1.w = sigmoid_f(b.w);
              *(f32x4*)(gs + (unsigned)row * 32u + 8 * fq) = o0; *(f32x4*)(gs + (unsigned)row * 32u + 8 * fq + 4) = o1;
            }
        }
      }
    }
  }
};
DI void phase_gemm1(const Params& p, char* smem) {
  pg8::Gemm g{(const bf16_t*)(p.ws + OFF_H), (const bf16_t*)(p.ws + OFF_WT1), NTOK, N1, 512};
  pg8::StaticOrder S; S.init(NTOK, N1, gridDim.x, blockIdx.x, true);
  EpiProj E{p.ws, p.b_merge};
  pg8::gemm_phase((LAS unsigned char*)smem, g, S, E);
}

template <int BR> struct EpiMerge {
  static constexpr bool PERM = true;
  static constexpr int MODE = 2;
  typedef f32x4 AccT;
  char* ws;
  DI void operator()(const f32x4 (&acc)[2][2][4][2], const pg8::Unit& u, int wr, int wc, int fr, int fq) const {
    const unsigned char* gate = (const unsigned char*)(ws + OFF_GATE8);
    unsigned char* m0 = (unsigned char*)(ws + OFF_M08);
    unsigned char* mrg = (unsigned char*)(ws + OFF_MRG8);
    const float* sw = (const float*)(ws + OFF_SCWB) + BR * 32;
    const int row0 = u.pm * 256 + wr * 64 + fr;
#pragma unroll
    for (int bj = 0; bj < 2; ++bj) {
      const unsigned cgp = u.pn * 256 + bj * 128 + wc * 32, c0 = cgp + 8 * fq;
      const float f = sw[cgp >> 5] * (BR == 0 ? 1.0f : 2.0f);
#pragma unroll
      for (int ai = 0; ai < 2; ++ai)
#pragma unroll
        for (int m = 0; m < 4; ++m) {
          const unsigned row = row0 + ai * 128 + m * 16;
          float gg[8]; unpack8_fp8(*(const u32x2*)(gate + row * 2048u + BR * 1024 + c0), gg);
          const f32x4 a = acc[ai][bj][m][0] * f, b = acc[ai][bj][m][1] * f;
          float v[8] = {a.x * gg[0], a.y * gg[1], a.z * gg[2], a.w * gg[3], b.x * gg[4], b.y * gg[5], b.z * gg[6], b.w * gg[7]};
          if (BR == 1) {
            float old[8]; unpack8_fp8(*(const u32x2*)(m0 + row * 1024u + c0), old);
#pragma unroll
            for (int j = 0; j < 8; ++j) v[j] += old[j];
          }
#pragma unroll
          for (int j = 0; j < 8; ++j) v[j] = clamp_f8(v[j]);
          u32x2 w; w.x = pk4_fp8(v[0], v[1], v[2], v[3]); w.y = pk4_fp8(v[4], v[5], v[6], v[7]);
          *(u32x2*)((BR == 0 ? m0 : mrg) + row * 1024u + c0) = w;
        }
    }
  }
};
DI void phase_merge(const Params& p, char* smem) {
  pg8::StaticOrder S; S.init(NTOK, 1024, gridDim.x, blockIdx.x);
  {
    pg8::Gemm g{(const bf16_t*)(p.ws + OFF_ONSA8), (const bf16_t*)(p.ws + OFF_WB), NTOK, 1024, 256};
    EpiMerge<0> E{p.ws};
    pg8::gemm_phase((LAS unsigned char*)smem, g, S, E);
  }
  {
    pg8::Gemm g{(const bf16_t*)(p.ws + OFF_OSGU8), (const bf16_t*)(p.ws + OFF_WB + (size_t)1024 * 512), NTOK, 1024, 256};
    EpiMerge<1> E{p.ws};
    pg8::gemm_phase((LAS unsigned char*)smem, g, S, E);
  }
}

struct EpiOut {
  static constexpr bool PERM = true;
  static constexpr int MODE = 2;
  typedef f32x4 AccT;
  char* ws; const float* x;
  DI void operator()(const f32x4 (&acc)[2][2][4][2], const pg8::Unit& u, int wr, int wc, int fr, int fq) const {
    const float* mod = (const float*)(ws + OFF_MOD);
    bf16_t* y = (bf16_t*)(ws + OFF_Y);
    const int row0 = u.pm * 256 + wr * 64 + fr, b = (u.pm * 256) >> 13;
#pragma unroll
    for (int bj = 0; bj < 2; ++bj) {
      const unsigned c0 = u.pn * 256 + bj * 128 + wc * 32 + 8 * fq;
      const float f = ((const float*)(ws + OFF_SCWO))[c0 >> 5] * 0.0625f;
      const f32x4 g0 = *(const f32x4*)(mod + b * 6144 + 2048 + c0) * f, g1 = *(const f32x4*)(mod + b * 6144 + 2048 + c0 + 4) * f;
#pragma unroll
      for (int ai = 0; ai < 2; ++ai)
#pragma unroll
        for (int m = 0; m < 4; ++m) {
          const unsigned o = (unsigned)(row0 + ai * 128 + m * 16) * 1024u + c0;
          const f32x4 x0 = *(const f32x4*)(x + o), x1v = *(const f32x4*)(x + o + 4);
          const f32x4 v0 = x0 * DN_ALPHA + g0 * acc[ai][bj][m][0], v1 = x1v * DN_ALPHA + g1 * acc[ai][bj][m][1];
          u32x4 w; w.x = pack2(v0.x, v0.y); w.y = pack2(v0.z, v0.w); w.z = pack2(v1.x, v1.y); w.w = pack2(v1.z, v1.w);
          *(u32x4*)(y + o) = w;
        }
    }
  }
};
DI void phase_outproj(const Params& p, char* smem) {
  pg8::Gemm g{(const bf16_t*)(p.ws + OFF_MRG8), (const bf16_t*)(p.ws + OFF_WOUT), NTOK, 1024, 512};
  pg8::StaticOrder S; S.init(NTOK, 1024, gridDim.x, blockIdx.x);
  EpiOut E{p.ws, p.x};
  pg8::gemm_phase((LAS unsigned char*)smem, g, S, E);
}

struct EpiPq {
  static constexpr bool PERM = true;
  static constexpr int MODE = 1;
  typedef i32x4 AccT;
  char* ws;
  DI void operator()(const i32x4 (&acc)[2][2][4][2], const pg8::Unit& u, int wr, int wc, int fr, int fq) const {
    bf16_t* pq = (bf16_t*)(ws + OFF_PQ);
    const float* sh = (const float*)(ws + OFF_SH); const float* sq = (const float*)(ws + OFF_SCWQ);
    const int row0 = u.pm * 256 + wr * 64 + fr;
#pragma unroll
    for (int bj = 0; bj < 2; ++bj) {
      const unsigned c0 = u.pn * 256 + bj * 128 + wc * 32 + 8 * fq;
      const float sbg = sq[(u.pn * 256 + bj * 128 + wc * 32) >> 5];
#pragma unroll
      for (int ai = 0; ai < 2; ++ai)
#pragma unroll
        for (int m = 0; m < 4; ++m) {
          const float f_ = sh[row0 + ai * 128 + m * 16] * sbg;
          const f32x4 a = __builtin_convertvector(acc[ai][bj][m][0], f32x4) * f_, b = __builtin_convertvector(acc[ai][bj][m][1], f32x4) * f_;
          u32x4 w; w.x = pack2(a.x, a.y); w.y = pack2(a.z, a.w); w.z = pack2(b.x, b.y); w.w = pack2(b.z, b.w);
          *(u32x4*)(pq + (unsigned)(row0 + ai * 128 + m * 16) * 2048u + c0) = w;
        }
    }
  }
};
DI void phase_peerq(const Params& p, char* smem) {
  pg8::Gemm g{(const bf16_t*)(p.ws + OFF_H2Q), (const bf16_t*)(p.ws + OFF_WQ), NTOK, 2048, 512};
  pg8::StaticOrder S; S.init(NTOK, 2048, gridDim.x, blockIdx.x);
  EpiPq E{p.ws};
  pg8::gemm_phase((LAS unsigned char*)smem, g, S, E);
}

DI void phase_sgu(const Params& p, char* smem) {
  char* ws = p.ws;
  const int tid = otid(), lane = tid & 63, wave = tid >> 6, l31 = lane & 31, hh = lane >> 5;
  const bf16_t* u = (const bf16_t*)(ws + OFF_U);
  const bf16_t* v = (const bf16_t*)(ws + OFF_V);
  const bf16_t* W = (const bf16_t*)(ws + OFF_SGUW);
  float* st = (float*)smem;
  bf16_t* vn = (bf16_t*)(smem + 1024);
  constexpr int LN_ = 72;
  const int dt = wave & 1, it = wave >> 1;
  const int gi = lane >> 4, i16 = lane & 15, tq = i16 >> 2, tp = i16 & 3;
  for (int item = blockIdx.x; item < NTOK / 128; item += gridDim.x) {
    const int t0 = item * 128;
    __syncthreads();
    for (int i = 0; i < 16; ++i) {
      const int t = wave * 16 + i;
      const u32x4 raw = *(const u32x4*)(v + (size_t)(t0 + t) * 512 + lane * 8);
      float f[8]; unpack8(raw, f);
      float s = 0.f;
#pragma unroll
      for (int j = 0; j < 8; ++j) s += f[j];
      const float mean = wave_sum(s) * (1.f / 512.f);
      float q = 0.f;
#pragma unroll
      for (int j = 0; j < 8; ++j) { const float d = f[j] - mean; q += d * d; }
      const float rstd = rsqrtf(wave_sum(q) * (1.f / 512.f) + LN_EPS);
      if (lane == 0) { st[t * 2] = mean; st[t * 2 + 1] = rstd; }
    }
    u32x4 vnext[2];
#pragma unroll
    for (int i = 0; i < 2; ++i) { const int idx = tid + i * NT; vnext[i] = *(const u32x4*)(v + (size_t)(t0 + (idx >> 3)) * 512 + (idx & 7) * 8); }
    for (int g = 0; g < 8; ++g) {
      u32x4 vcur[2] = {vnext[0], vnext[1]};
      if (g + 1 < 8) {
#pragma unroll
        for (int i = 0; i < 2; ++i) { const int idx = tid + i * NT; vnext[i] = *(const u32x4*)(v + (size_t)(t0 + (idx >> 3)) * 512 + (g + 1) * 64 + (idx & 7) * 8); }
      }
      u32x2 uold[4];
      {
        const bf16_t* urow0 = u + (size_t)(t0 + it * 32 + l31) * 512 + g * 64 + dt * 32 + 4 * hh;
#pragma unroll
        for (int q4 = 0; q4 < 4; ++q4) uold[q4] = *(const u32x2*)(urow0 + 8 * q4);
      }
      lds_barrier();
#pragma unroll
      for (int i = 0; i < 2; ++i) {
        const int idx = tid + i * NT, j = idx >> 3, dc = (idx & 7) * 8;
        const u32x4 raw = vcur[i];
        const float mean = st[j * 2], rstd = st[j * 2 + 1];
        float f[8], gg[8], bb[8]; unpack8(raw, f); ld8(p.sgu_ln_g + g * 64 + dc, gg); ld8(p.sgu_ln_b + g * 64 + dc, bb);
#pragma unroll
        for (int k = 0; k < 8; ++k) f[k] = (f[k] - mean) * rstd * gg[k] + bb[k];
        *(u32x4*)(vn + j * LN_ + dc) = pack8(f);
      }
      lds_barrier();
      f32x16 acc;
#pragma unroll
      for (int r = 0; r < 16; ++r) acc[r] = 0.f;
      const bf16_t* wrow = W + ((size_t)g * 128 + it * 32 + l31) * 128 + hh * 8;
      const LAS bf16_t* vbase = (const LAS bf16_t*)vn + (8 * (gi >> 1) + tq) * LN_ + dt * 32 + 16 * (gi & 1) + 4 * tp;
#pragma unroll
      for (int ks = 0; ks < 8; ++ks) {
        if (ks <= 2 * it + 1) {
          const LAS bf16_t* vp = vbase + (ks * 16) * LN_;
          const s16x4 lo = __builtin_amdgcn_ds_read_tr16_b64_v4i16((LAS s16x4*)vp);
          const s16x4 hi = __builtin_amdgcn_ds_read_tr16_b64_v4i16((LAS s16x4*)(vp + 4 * LN_));
          const bf16x8 bw = *(const bf16x8*)(wrow + ks * 16);
          acc = MFMA32(__builtin_shufflevector(lo, hi, 0, 1, 2, 3, 4, 5, 6, 7), bw, acc);
        }
      }
      const int i = it * 32 + l31;
      const float bsv = p.sgu_b[g * 128 + i];
      unsigned char* orow = (unsigned char*)(ws + OFF_OSGU8) + (size_t)(t0 + i) * 512 + g * 64 + dt * 32 + 4 * hh;
#pragma unroll
      for (int q4 = 0; q4 < 4; ++q4) {
        const u32x2 old = uold[q4];
        *(unsigned*)(orow + 8 * q4) = pk4_fp8(clamp_f8(8.0f * bflo(old.x) * (acc[4 * q4] + bsv)), clamp_f8(8.0f * bfhi(old.x) * (acc[4 * q4 + 1] + bsv)),
                                              clamp_f8(8.0f * bflo(old.y) * (acc[4 * q4 + 2] + bsv)), clamp_f8(8.0f * bfhi(old.y) * (acc[4 * q4 + 3] + bsv)));
      }
    }
  }
}

DI void phase_compress(const Params& p, char* smem) {
  char* ws = p.ws;
  const int tid = otid(), lane = tid & 63, wave = tid >> 6, l31 = lane & 31, hh = lane >> 5;
  bf16_t* hid = (bf16_t*)smem;
  constexpr int LH = 136;
  for (int item = blockIdx.x; item < 128; item += gridDim.x) {
    const int w = item >> 6, R0 = (item & 63) * 128;
    const bf16_t* src = (const bf16_t*)(ws + (w == 0 ? OFF_KC : OFF_VC));
    const bf16_t* W1 = (const bf16_t*)(ws + OFF_CW1) + (size_t)w * 128 * 2048;
    const bf16_t* W2 = (const bf16_t*)(ws + OFF_CW2) + (size_t)w * 64 * 128;
    const float* posb = (const float*)(ws + OFF_POSB) + w * 128;
    const int rg = wave >> 2, cgp = wave & 3;
    const bf16_t* abase[2];
#pragma unroll
    for (int mi = 0; mi < 2; ++mi) {
      const int R = R0 + rg * 64 + mi * 32 + l31, bg = R >> 9, n = R & 511, nn = n < 510 ? n : 510;
      abase[mi] = src + ((size_t)((bg >> 1) * SEQ + 16 * nn)) * 128 + (bg & 1) * 64 + hh * 8;
    }
    const bf16_t* bbase = W1 + (size_t)(cgp * 32 + l31) * 2048 + hh * 8;
    f32x16 acc[2];
#pragma unroll
    for (int r = 0; r < 16; ++r) { acc[0][r] = 0.f; acc[1][r] = 0.f; }
#pragma unroll 8
    for (int ks = 0; ks < 128; ++ks) {
      const int aofs = (ks >> 2) * 128 + (ks & 3) * 16;
      const bf16x8 a0 = *(const bf16x8*)(abase[0] + aofs), a1 = *(const bf16x8*)(abase[1] + aofs);
      const bf16x8 bb = *(const bf16x8*)(bbase + ks * 16);
      acc[0] = MFMA32(a0, bb, acc[0]); acc[1] = MFMA32(a1, bb, acc[1]);
    }
    __syncthreads();
    {
      const float pb = posb[cgp * 32 + l31];
#pragma unroll
      for (int mi = 0; mi < 2; ++mi)
#pragma unroll
        for (int r = 0; r < 16; ++r) {
          const int row = rg * 64 + mi * 32 + (r & 3) + 8 * (r >> 2) + 4 * hh;
          hid[row * LH + cgp * 32 + l31] = f2bf(gelu_f(acc[mi][r] + pb));
        }
    }
    __syncthreads();
    const int mi2 = wave >> 1, ni = wave & 1;
    f32x16 o;
#pragma unroll
    for (int r = 0; r < 16; ++r) o[r] = 0.f;
#pragma unroll
    for (int ks = 0; ks < 8; ++ks) {
      const bf16x8 a = *(const bf16x8*)(hid + (mi2 * 32 + l31) * LH + ks * 16 + hh * 8);
      const bf16x8 bb = *(const bf16x8*)(W2 + (size_t)(ni * 32 + l31) * 128 + ks * 16 + hh * 8);
      o = MFMA32(a, bb, o);
    }
    const int d = ni * 32 + l31;
    const float b2 = p.cmp_b2[w * 64 + (w == 0 ? dperm(d) : d)];
    const int bg = R0 >> 9;
    bf16_t* dst = (bf16_t*)(ws + (w == 0 ? OFF_KCMP : OFF_VCMP));
#pragma unroll
    for (int r = 0; r < 16; ++r) {
      const int n = (R0 & 511) + mi2 * 32 + (r & 3) + 8 * (r >> 2) + 4 * hh;
      dst[((size_t)bg * 512 + n) * 64 + d] = f2bf(n < 511 ? o[r] + b2 : 0.f);
    }
  }
}

constexpr int LK = 72;
constexpr int NSA_TILE = 18432;
constexpr int NSA_AIMP = 3 * NSA_TILE, NSA_CIMP = NSA_AIMP + 32768, NSA_SELM = NSA_CIMP + 32768;
constexpr float NSA_THR = 6.0f;
struct TileRegs { u32x4 k; u32x4 v; };

DI void nsa_load_tile(TileRegs& t, const bf16_t* kbase, size_t kstride, const bf16_t* vbase, size_t vstride) {
  const int tid = otid(), r = tid >> 3, ch = tid & 7;
  t.k = *(const u32x4*)(kbase + (size_t)r * kstride + ch * 8);
  t.v = *(const u32x4*)(vbase + (size_t)r * vstride + ch * 8);
}
DI void nsa_store_tile(const TileRegs& t, char* tile) {
  const int tid = otid(), r = tid >> 3, ch = tid & 7;
  *(u32x4*)((bf16_t*)tile + r * LK + ch * 8) = t.k;
  *(u32x4*)((bf16_t*)(tile + 9216) + r * LK + ch * 8) = t.v;
}
DI void nsa_scores(f32x16 (&st)[2], const char* tile, const bf16x8 (&qf)[4], int lane) {
  const bf16_t* Ks = (const bf16_t*)tile;
#pragma unroll
  for (int kt = 0; kt < 2; ++kt)
#pragma unroll
    for (int r = 0; r < 16; ++r) st[kt][r] = 0.f;
  __builtin_amdgcn_s_setprio(1);
#pragma unroll
  for (int ks = 0; ks < 4; ++ks)
#pragma unroll
    for (int kt = 0; kt < 2; ++kt) {
      const bf16x8 a = *(const bf16x8*)(Ks + (kt * 32 + (lane & 31)) * LK + ks * 16 + (lane >> 5) * 8);
      st[kt] = MFMA32(a, qf[ks], st[kt]);
    }
  __builtin_amdgcn_s_setprio(0);
}
DI void nsa_pv(f32x16 (&o)[2], const f32x16 (&pt)[2], const char* tile, int lane) {
  const int gi = lane >> 4, i16 = lane & 15, q = i16 >> 2, pp = i16 & 3;
  const LAS bf16_t* Vs = (const LAS bf16_t*)(tile + 9216) + (4 * (gi >> 1) + q) * LK + 16 * (gi & 1) + 4 * pp;
#pragma unroll
  for (int kt = 0; kt < 2; ++kt)
#pragma unroll
    for (int s = 0; s < 2; ++s) {
      u32x4 pk; pk.x = pack2(pt[kt][8 * s], pt[kt][8 * s + 1]); pk.y = pack2(pt[kt][8 * s + 2], pt[kt][8 * s + 3]);
      pk.z = pack2(pt[kt][8 * s + 4], pt[kt][8 * s + 5]); pk.w = pack2(pt[kt][8 * s + 6], pt[kt][8 * s + 7]);
      const bf16x8 pb = __builtin_bit_cast(bf16x8, pk);
      bf16x8 a[2];
#pragma unroll
      for (int dt = 0; dt < 2; ++dt) {
        const LAS bf16_t* vp = Vs + (kt * 32 + 16 * s) * LK + dt * 32;
        const s16x4 lo = __builtin_amdgcn_ds_read_tr16_b64_v4i16((LAS s16x4*)vp);
        const s16x4 hi = __builtin_amdgcn_ds_read_tr16_b64_v4i16((LAS s16x4*)(vp + 8 * LK));
        a[dt] = __builtin_shufflevector(lo, hi, 0, 1, 2, 3, 4, 5, 6, 7);
      }
      o[0] = MFMA32(a[0], pb, o[0]); o[1] = MFMA32(a[1], pb, o[1]);
    }
}

constexpr float NSA_NEG = -3.0e38f;
DI void nsa_online(f32x16 (&st)[2], bool sel, float& m, float& l, f32x16 (&o)[2], const char* tile, int lane) {
  float mx = NSA_NEG;
#pragma unroll
  for (int r = 0; r < 16; ++r) mx = fmaxf(mx, fmaxf(st[0][r], st[1][r]));
  mx = fmaxf(mx, xor32f(mx, lane));
  mx = sel ? mx : NSA_NEG;
  if (__any(mx > m + NSA_THR)) {
    const float mn = fmaxf(m, mx);
    const float alpha = __builtin_amdgcn_exp2f(m - mn);
    m = mn; l *= alpha;
#pragma unroll
    for (int r = 0; r < 16; ++r) { o[0][r] *= alpha; o[1][r] *= alpha; }
  }
  const float ms = sel ? m : 1e30f;
  float sum = 0.f;
#pragma unroll
  for (int r = 0; r < 16; ++r) {
    const float p0 = __builtin_amdgcn_exp2f(st[0][r] - ms), p1 = __builtin_amdgcn_exp2f(st[1][r] - ms);
    st[0][r] = p0; st[1][r] = p1; sum += p0 + p1;
  }
  l += sum;
  nsa_pv(o, st, tile, lane);
}

struct NsaItem { int qb, b, g, bg, t; size_t tokrow; };
DI NsaItem nsa_item(int item0, int wave, int qi) {
  const int G = gridDim.x, k = item0 / G, bb = item0 - k * G;
  const int item = (k & 1) ? (k * G + (G - 1 - bb)) : item0;
  NsaItem it; it.qb = 127 - (item >> 4); const int rest = item & 15; it.b = rest >> 1; it.g = rest & 1;
  it.bg = it.b * 2 + it.g; it.t = it.qb * 64 + wave * 8 + qi; it.tokrow = (size_t)it.b * SEQ + it.t; return it;
}
DI void nsa_accum_store(bf16_t* dst, const f32x16 (&o)[2], float sc, bool first, int hh, unsigned char* dst8 = nullptr) {
#pragma unroll
  for (int dt = 0; dt < 2; ++dt)
#pragma unroll
    for (int q4 = 0; q4 < 4; ++q4) {
      u32x2* pp = (u32x2*)(dst + dt * 32 + 8 * q4 + 4 * hh);
      float a0 = sc * o[dt][4 * q4], a1 = sc * o[dt][4 * q4 + 1], a2 = sc * o[dt][4 * q4 + 2], a3 = sc * o[dt][4 * q4 + 3];
      if (!first) { const u32x2 old = *pp; a0 += bflo(old.x); a1 += bfhi(old.x); a2 += bflo(old.y); a3 += bfhi(old.y); }
      if (dst8) *(unsigned*)(dst8 + dt * 32 + 8 * q4 + 4 * hh) = pk4_fp8(clamp_f8(16.0f * a0), clamp_f8(16.0f * a1), clamp_f8(16.0f * a2), clamp_f8(16.0f * a3));
      else { u32x2 wv; wv.x = pack2(a0, a1); wv.y = pack2(a2, a3); *pp = wv; }
    }
}

constexpr int NSA_STAGE = 4 * 18432;
typedef float f32x4v __attribute__((ext_vector_type(4)));
#define MFMA16(a, b, c) __builtin_amdgcn_mfma_f32_16x16x32_bf16((a), (b), (c), 0, 0, 0)
struct StageRegs { u32x4 r[8]; };
DI void nsa_load_stage(StageRegs& sr, const bf16_t* kb, const bf16_t* vb, int j0s, int qb) {
  const int tid = otid(), r = tid >> 3, ch = tid & 7;
#pragma unroll
  for (int tt = 0; tt < 4; ++tt) {
    const int j = (j0s + tt <= qb) ? j0s + tt : qb;
    sr.r[2 * tt] = *(const u32x4*)(kb + ((size_t)j * 64 + r) * 128 + ch * 8);
    sr.r[2 * tt + 1] = *(const u32x4*)(vb + ((size_t)j * 64 + r) * 128 + ch * 8);
  }
}
DI void nsa_store_stage(const StageRegs& sr, char* stage) {
  const int tid = otid(), r = tid >> 3, ch = tid & 7;
#pragma unroll
  for (int tt = 0; tt < 4; ++tt) {
    *(u32x4*)((bf16_t*)(stage + tt * 18432) + r * LK + ch * 8) = sr.r[2 * tt];
    *(u32x4*)((bf16_t*)(stage + tt * 18432 + 9216) + r * LK + ch * 8) = sr.r[2 * tt + 1];
  }
}
struct Sel16 { float m; bool has; f32x4v o[4], ol; };
DI void nsa_unit16(Sel16& g, const char* tile, const bf16x8 (&qf)[2], bool sel, int klim  , int lane) {
  const int c16 = lane & 15, kg = lane >> 4, tq = c16 >> 2, tp = c16 & 3;
  const bf16_t* Ks = (const bf16_t*)tile + c16 * LK + kg * 8;
  f32x4v st[4];
  const float ini = sel ? -g.m : -1e30f;
#pragma unroll
  for (int kt = 0; kt < 4; ++kt) {
    st[kt] = (f32x4v){ini, ini, ini, ini};
#pragma unroll
    for (int ks = 0; ks < 2; ++ks) st[kt] = MFMA16(*(const bf16x8*)(Ks + kt * 16 * LK + ks * 32), qf[ks], st[kt]);
  }
  if (klim < 64) {
#pragma unroll
    for (int kt = 0; kt < 4; ++kt)
#pragma unroll
      for (int r = 0; r < 4; ++r) st[kt][r] = (kt * 16 + 4 * kg + r <= klim) ? st[kt][r] : NSA_NEG;
  }
  float mx = fmaxf(fmaxf(st[0][0], st[0][1]), st[0][2]);
  mx = fmaxf(fmaxf(mx, st[0][3]), st[1][0]); mx = fmaxf(fmaxf(mx, st[1][1]), st[1][2]); mx = fmaxf(fmaxf(mx, st[1][3]), st[2][0]);
  mx = fmaxf(fmaxf(mx, st[2][1]), st[2][2]); mx = fmaxf(fmaxf(mx, st[2][3]), st[3][0]); mx = fmaxf(fmaxf(mx, st[3][1]), st[3][2]); mx = fmaxf(mx, st[3][3]);
  mx = fmaxf(mx, xor16f(mx, lane));
  mx = fmaxf(mx, xor32f(mx, lane));
  const bool real = mx > -1e29f;
  const bool fresh = !g.has && real, up = g.has && (mx > NSA_THR);
  if (__any(fresh || up)) {
    const float delta = (fresh || up) ? mx : 0.f;
    const float alpha = up ? __builtin_amdgcn_exp2f(-delta) : 1.0f;
    g.m += delta; g.ol *= alpha;
#pragma unroll
    for (int dt = 0; dt < 4; ++dt) g.o[dt] *= alpha;
#pragma unroll
    for (int kt = 0; kt < 4; ++kt) st[kt] -= delta;
  }
  g.has = g.has || real;
#pragma unroll
  for (int kt = 0; kt < 4; ++kt)
#pragma unroll
    for (int r = 0; r < 4; ++r) st[kt][r] = __builtin_amdgcn_exp2f(st[kt][r]);
  const bf16x8 ones = {16256, 16256, 16256, 16256, 16256, 16256, 16256, 16256};
  const LAS bf16_t* Vs = (const LAS bf16_t*)(tile + 9216) + (4 * kg + tq) * LK + 4 * tp;
#pragma unroll
  for (int kp = 0; kp < 2; ++kp) {
    u32x4 pk; pk.x = pack2(st[2 * kp][0], st[2 * kp][1]); pk.y = pack2(st[2 * kp][2], st[2 * kp][3]);
    pk.z = pack2(st[2 * kp + 1][0], st[2 * kp + 1][1]); pk.w = pack2(st[2 * kp + 1][2], st[2 * kp + 1][3]);
    const bf16x8 pb = __builtin_bit_cast(bf16x8, pk);
    g.ol = MFMA16(ones, pb, g.ol);
#pragma unroll
    for (int dt = 0; dt < 4; ++dt) {
      const LAS bf16_t* vp = Vs + (2 * kp) * 16 * LK + dt * 16;
      const s16x4 lo = __builtin_amdgcn_ds_read_tr16_b64_v4i16((LAS s16x4*)vp);
      const s16x4 hi = __builtin_amdgcn_ds_read_tr16_b64_v4i16((LAS s16x4*)(vp + 16 * LK));
      g.o[dt] = MFMA16(__builtin_shufflevector(lo, hi, 0, 1, 2, 3, 4, 5, 6, 7), pb, g.o[dt]);
    }
  }
}
DI void nsa_sel16(const Params& p, char* smem, bool dry) {
  char* ws = p.ws;
  const int tid = otid(), lane = tid & 63, wave = tid >> 6, c16 = lane & 15, kg = lane >> 4, qi4 = c16 >> 2, r4 = c16 & 3;
  const bf16_t* Q = (const bf16_t*)(ws + OFF_Q);
  const float* gsig = (const float*)(ws + OFF_GSIG);
  bf16_t* ONSA = (bf16_t*)(ws + OFF_ONSA);
  const u32x4* SELG = (const u32x4*)(ws + OFF_SELG);
  const bf16_t* KS = (const bf16_t*)(ws + OFF_KS); const bf16_t* VS = (const bf16_t*)(ws + OFF_VS);
  constexpr int NITEM = NB * 2 * 128;
  for (int item = blockIdx.x; item < NITEM; item += gridDim.x) {
    const NsaItem it = nsa_item(item, wave, 0);
    const int qb = it.qb;
    bf16x8 qf[2][2]; u32x4 selw[2]; float g_s[2]; int tg[2]; Sel16 G[2];
#pragma unroll
    for (int gq = 0; gq < 2; ++gq) {
      tg[gq] = it.t + 4 * gq + qi4;
      const size_t tokrow = (size_t)it.b * SEQ + tg[gq];
#pragma unroll
      for (int ks = 0; ks < 2; ++ks) qf[gq][ks] = *(const bf16x8*)(Q + tokrow * 512 + (it.g * 4 + r4) * 64 + ks * 32 + kg * 8);
      selw[gq] = SELG[(size_t)it.bg * SEQ + tg[gq]];
      g_s[gq] = gsig[tokrow * 32 + (it.g * 4 + r4) * 3 + 1];
      G[gq].m = 0.f; G[gq].ol = (f32x4v){0.f, 0.f, 0.f, 0.f}; G[gq].has = false;
#pragma unroll
      for (int dt = 0; dt < 4; ++dt) G[gq].o[dt] = (f32x4v){0.f, 0.f, 0.f, 0.f};
    }
    const bf16_t* kb = KS + (size_t)it.b * SEQ * 128 + it.g * 64;
    const bf16_t* vb = VS + (size_t)it.b * SEQ * 128 + it.g * 64;
    const int nst = (qb >> 2) + 1;
    StageRegs sr;
    lds_barrier();
    nsa_load_stage(sr, kb, vb, 0, qb);
    nsa_store_stage(sr, smem);
    lds_barrier();
    for (int sidx = 0; sidx < nst; ++sidx) {
      const char* stage = smem + (sidx & 1) * NSA_STAGE;
      if (sidx + 1 < nst) nsa_load_stage(sr, kb, vb, 4 * (sidx + 1), qb);
#pragma unroll 1
      for (int tt = 0; tt < 4; ++tt) {
        const int j = 4 * sidx + tt;
        if (j > qb) break;
#pragma unroll
        for (int gq = 0; gq < 2; ++gq) {
          const unsigned w = j < 32 ? selw[gq].x : (j < 64 ? selw[gq].y : (j < 96 ? selw[gq].z : selw[gq].w));
          const bool sel = (w >> (j & 31)) & 1u;
          if (__any(sel)) nsa_unit16(G[gq], stage + tt * 18432, qf[gq], sel, (j == qb) ? (tg[gq] - j * 64) : 1000, lane);
        }
      }
      if (sidx + 1 < nst) nsa_store_stage(sr, smem + ((sidx + 1) & 1) * NSA_STAGE);
      lds_barrier();
    }
#pragma unroll
    for (int gq = 0; gq < 2; ++gq) {
      const float l = G[gq].ol[0];
      const float sc = l > 0.f ? g_s[gq] / l : 0.f;
      bf16_t* dst = ONSA + ((size_t)it.b * SEQ + tg[gq]) * 512 + (it.g * 4 + r4) * 64 + 4 * kg;
      if (!dry) {
#pragma unroll
        for (int dt = 0; dt < 4; ++dt) {
          u32x2* pp = (u32x2*)(dst + dt * 16);
          const u32x2 old = *pp;
          u32x2 wv; wv.x = pack2(bflo(old.x) + sc * G[gq].o[dt][0], bfhi(old.x) + sc * G[gq].o[dt][1]);
          wv.y = pack2(bflo(old.y) + sc * G[gq].o[dt][2], bfhi(old.y) + sc * G[gq].o[dt][3]);
          *pp = wv;
        }
      } else asm volatile("" :: "v"(G[gq].o[0]), "v"(G[gq].o[1]), "v"(G[gq].o[2]), "v"(G[gq].o[3]), "v"(l));
    }
  }
}

DI void phase_nsa(const Params& p, char* smem, int branch_mask) {
  char* ws = p.ws;
  const int tid = otid(), lane = tid & 63, wave = tid >> 6, hh = lane >> 5, c = lane & 31, qi = c >> 2, r4 = c & 3;
  const bf16_t* Q = (const bf16_t*)(ws + OFF_Q);
  const float* gsig = (const float*)(ws + OFF_GSIG);
  bf16_t* ONSA = (bf16_t*)(ws + OFF_ONSA);
  u32x4* SELG = (u32x4*)(ws + OFF_SELG);
  constexpr int NITEM = NB * 2 * 128;

#pragma unroll 1
  for (int rep1 = 0; rep1 < ((PROBE_DUP & 4096) ? 2 : 1); ++rep1) {
    const bf16_t* KCMP = (const bf16_t*)(ws + OFF_KCMP); const bf16_t* VCMP = (const bf16_t*)(ws + OFF_VCMP);
    float* Aimp = (float*)(smem + NSA_AIMP) + wave * 1024;
    float* Cimp = (float*)(smem + NSA_CIMP) + wave * 1024;
    unsigned short* selm16 = (unsigned short*)(smem + NSA_SELM) + wave * 64;
    const u32x4* selm128 = (const u32x4*)(smem + NSA_SELM) + wave * 8;
    for (int item = blockIdx.x; item < NITEM; item += gridDim.x) {
      const NsaItem it = nsa_item(item, wave, qi);
      const int t = it.t;
      bf16x8 qf[4];
#pragma unroll
      for (int ks = 0; ks < 4; ++ks) qf[ks] = *(const bf16x8*)(Q + it.tokrow * 512 + (it.g * 4 + r4) * 64 + ks * 16 + hh * 8);
      const float g_c = gsig[it.tokrow * 32 + (it.g * 4 + r4) * 3 + 0];
      TileRegs tr;
      const int nmax = (it.qb * 64 + 63 - 31) >> 4, ntile = (nmax >> 6) + 1;
      const int nfull = (it.qb * 64 - 31) >> 4;
      const bf16_t* kb = KCMP + (size_t)it.bg * 512 * 64;
      const bf16_t* vb = VCMP + (size_t)it.bg * 512 * 64;
      float m = -1e30f, l = 0.f;
      nsa_load_tile(tr, kb, 64, vb, 64);
      nsa_store_tile(tr, smem);
      __syncthreads();
      for (int j = 0; j < ntile; ++j) {
        const char* tile = smem + (j & 1) * NSA_TILE;
        if (j + 1 < ntile) nsa_load_tile(tr, kb + (size_t)(j + 1) * 64 * 64, 64, vb + (size_t)(j + 1) * 64 * 64, 64);
        f32x16 st[2];
        nsa_scores(st, tile, qf, lane);
        const bool full = (j * 64 + 63 <= nfull);
        const int nlim = full ? 100000 : ((t - 31) >> 4) - j * 64 - 4 * hh;
        float mx = NSA_NEG;
#pragma unroll
        for (int kt = 0; kt < 2; ++kt)
#pragma unroll
          for (int r = 0; r < 16; ++r) {
            st[kt][r] = (kt * 32 + (r & 3) + 8 * (r >> 2) <= nlim) ? st[kt][r] : NSA_NEG;
            mx = fmaxf(mx, st[kt][r]);
          }
        mx = fmaxf(mx, xor32f(mx, lane));
        const float mn = fmaxf(m, mx);
        float sum = 0.f;
#pragma unroll
        for (int kt = 0; kt < 2; ++kt)
#pragma unroll
          for (int r = 0; r < 16; ++r) sum += __builtin_amdgcn_exp2f(st[kt][r] - mn);
        l = l * __builtin_amdgcn_exp2f(m - mn) + sum;
        m = mn;
        if (j + 1 < ntile) nsa_store_tile(tr, smem + ((j + 1) & 1) * NSA_TILE);
        __syncthreads();
      }
      l += xor32f(l, lane);
      const float inv_l = l > 0.f ? 1.0f / l : 0.f;
      f32x16 o[2];
#pragma unroll
      for (int r = 0; r < 16; ++r) { o[0][r] = 0.f; o[1][r] = 0.f; }
      nsa_load_tile(tr, kb, 64, vb, 64);
      nsa_store_tile(tr, smem);
      __syncthreads();
      for (int j = 0; j < ntile; ++j) {
        const char* tile = smem + (j & 1) * NSA_TILE;
        if (j + 1 < ntile) nsa_load_tile(tr, kb + (size_t)(j + 1) * 64 * 64, 64, vb + (size_t)(j + 1) * 64 * 64, 64);
        f32x16 st[2];
        nsa_scores(st, tile, qf, lane);
        const bool full = (j * 64 + 63 <= nfull);
        const int nlim = full ? 100000 : ((t - 31) >> 4) - j * 64 - 4 * hh;
#pragma unroll
        for (int kt = 0; kt < 2; ++kt)
#pragma unroll
          for (int r = 0; r < 16; ++r) {
            const float arg = (kt * 32 + (r & 3) + 8 * (r >> 2) <= nlim) ? st[kt][r] - m : NSA_NEG;
            st[kt][r] = __builtin_amdgcn_exp2f(arg) * inv_l;
          }
#pragma unroll
        for (int kt = 0; kt < 2; ++kt)
#pragma unroll
          for (int c4 = 0; c4 < 4; ++c4) {
            float carry = 0.5f * st[kt][4 * c4 + 3];
            float fullv = st[kt][4 * c4] + st[kt][4 * c4 + 1] + st[kt][4 * c4 + 2] + carry;
            fullv += xor1f(fullv); fullv += xor2f(fullv);
            carry += xor1f(carry); carry += xor2f(carry);
            const int jb = j * 16 + kt * 8 + 2 * c4 + hh;
            if (r4 == 0) { Aimp[qi * 128 + jb] = fullv; Cimp[qi * 128 + jb] = carry; }
          }
        if (branch_mask & 1) nsa_pv(o, st, tile, lane);
        if (j + 1 < ntile) nsa_store_tile(tr, smem + ((j + 1) & 1) * NSA_TILE);
        __syncthreads();
      }
      nsa_accum_store(ONSA + it.tokrow * 512 + (it.g * 4 + r4) * 64, o, (branch_mask & 1) ? g_c : 0.f, true, hh);
      const int cur = it.qb;
      if (cur <= 15) {
        if (lane < 8) { selm16[lane * 8 + 0] = (unsigned short)((2u << cur) - 1u);
#pragma unroll
          for (int k = 1; k < 8; ++k) selm16[lane * 8 + k] = 0; }
      } else {
        const int qs = lane >> 3, sub = lane & 7;
        float v[16];
#pragma unroll
        for (int i = 0; i < 16; ++i) {
          const int jj = sub * 16 + i;
          const bool ok = (jj >= 1) && (jj <= cur - 2);
          const int jm = jj >= 1 ? jj - 1 : 0;
          v[i] = ok ? (Aimp[qs * 128 + jj] + Cimp[qs * 128 + jm]) : -3e38f;
        }
        unsigned bits = 0;
        for (int itn = 0; itn < 13; ++itn) {
          float bv = v[0]; int bi = 0;
#pragma unroll
          for (int i = 1; i < 16; ++i) if (v[i] > bv) { bv = v[i]; bi = i; }
          int bj = sub * 16 + bi;
#pragma unroll
          for (int o2 = 1; o2 < 8; o2 <<= 1) {
            const float ov = __shfl_xor(bv, o2); const int oj = __shfl_xor(bj, o2);
            if (ov > bv || (ov == bv && oj < bj)) { bv = ov; bj = oj; }
          }
          if ((bj >> 4) == sub) {
            const int i2 = bj & 15;
#pragma unroll
            for (int i = 0; i < 16; ++i) if (i == i2) v[i] = -3e38f;
            bits |= 1u << i2;
          }
        }
        if (sub == 0) bits |= 1u;
        if ((cur >> 4) == sub) bits |= 1u << (cur & 15);
        if (((cur - 1) >> 4) == sub) bits |= 1u << ((cur - 1) & 15);
        selm16[qs * 8 + sub] = (unsigned short)bits;
      }
      __syncthreads();
      if (r4 == 0 && hh == 0) SELG[(size_t)it.bg * SEQ + t] = selm128[qi];
    }
  }
  __threadfence_block();
  __syncthreads();

#pragma unroll 1
  for (int sweep_i = 0; sweep_i < 2 + ((PROBE_DUP & 1024) ? 1 : 0) + ((PROBE_DUP & 2048) ? 1 : 0); ++sweep_i) {
    const int sweep = (sweep_i < 2) ? sweep_i : (((PROBE_DUP & 1024) && sweep_i == 2) ? 0 : 1);
    const bool dry = sweep_i >= 2;
    if (!(branch_mask & (sweep == 0 ? 2 : 4))) continue;
    if (sweep == 0) { nsa_sel16(p, smem, dry); continue; }
    const bf16_t* KB = (const bf16_t*)(ws + (sweep == 0 ? OFF_KS : OFF_KW)); const bf16_t* VB = (const bf16_t*)(ws + (sweep == 0 ? OFF_VS : OFF_VW));
    for (int item = blockIdx.x; item < NITEM; item += gridDim.x) {
      const NsaItem it = nsa_item(item, wave, qi);
      const int t = it.t, qb = it.qb;
      bf16x8 qf[4];
#pragma unroll
      for (int ks = 0; ks < 4; ++ks) qf[ks] = *(const bf16x8*)(Q + it.tokrow * 512 + (it.g * 4 + r4) * 64 + ks * 16 + hh * 8);
      const float g_b = gsig[it.tokrow * 32 + (it.g * 4 + r4) * 3 + 1 + sweep];
      u32x4 selw = {0xffffffffu, 0xffffffffu, 0xffffffffu, 0xffffffffu};
      if (sweep == 0) selw = SELG[(size_t)it.bg * SEQ + t];
      TileRegs tr;
      const bf16_t* kb = KB + (size_t)it.b * SEQ * 128 + it.g * 64;
      const bf16_t* vb = VB + (size_t)it.b * SEQ * 128 + it.g * 64;
      float m = -1e30f, l = 0.f;
      f32x16 o[2];
#pragma unroll
      for (int r = 0; r < 16; ++r) { o[0][r] = 0.f; o[1][r] = 0.f; }
      const int j0 = (sweep == 1 && qb >= 8) ? qb - 8 : 0;
      __syncthreads();
      nsa_load_tile(tr, kb + (size_t)j0 * 64 * 128, 128, vb + (size_t)j0 * 64 * 128, 128);
      nsa_store_tile(tr, smem);
      if (j0 + 1 <= qb) { nsa_load_tile(tr, kb + (size_t)(j0 + 1) * 64 * 128, 128, vb + (size_t)(j0 + 1) * 64 * 128, 128); nsa_store_tile(tr, smem + NSA_TILE); }
      if (j0 + 2 <= qb) nsa_load_tile(tr, kb + (size_t)(j0 + 2) * 64 * 128, 128, vb + (size_t)(j0 + 2) * 64 * 128, 128);
      __syncthreads();
      const bool late = wave >= 4;
      if (__builtin_amdgcn_readfirstlane(wave) >= 4) __builtin_amdgcn_s_setprio(1);
      bool has = false;
      m = 0.f;
      f32x16 st[2];
      {
        const unsigned w0 = j0 < 32 ? selw.x : (j0 < 64 ? selw.y : (j0 < 96 ? selw.z : selw.w));
        const float ini = ((w0 >> (j0 & 31)) & 1u) ? 0.f : -1e30f;
#pragma unroll
        for (int r = 0; r < 16; ++r) { st[0][r] = ini; st[1][r] = ini; }
        const bf16_t* Kc = (const bf16_t*)smem;
#pragma unroll
        for (int ks = 0; ks < 4; ++ks)
#pragma unroll
          for (int kt = 0; kt < 2; ++kt) st[kt] = MFMA32(*(const bf16x8*)(Kc + (kt * 32 + (lane & 31)) * LK + ks * 16 + (lane >> 5) * 8), qf[ks], st[kt]);
      }
      int bi = 0;
      for (int j = j0; j <= qb; ++j) {
        const char* tile = smem + bi * NSA_TILE;
        const int bn = bi == 2 ? 0 : bi + 1, bnn = bn == 2 ? 0 : bn + 1;
        const int jn = j + 1;
        const unsigned wn = jn < 32 ? selw.x : (jn < 64 ? selw.y : (jn < 96 ? selw.z : selw.w));
        const bool seln = (wn >> (jn & 31)) & 1u;
        const bf16_t* Kn = (const bf16_t*)(smem + bn * NSA_TILE) + (lane & 31) * LK + (lane >> 5) * 8;
        f32x16 sn[2];
        if (!late) {
          const float ini = seln ? -m : -1e30f;
#pragma unroll
          for (int r = 0; r < 16; ++r) { sn[0][r] = ini; sn[1][r] = ini; }
#pragma unroll
          for (int ks = 0; ks < 4; ++ks)
#pragma unroll
            for (int kt = 0; kt < 2; ++kt) sn[kt] = MFMA32(*(const bf16x8*)(Kn + kt * 32 * LK + ks * 16), qf[ks], sn[kt]);
        }
        if (j == qb || (sweep == 1 && j == qb - 8)) {
          const int khi = t - j * 64 - 4 * hh, klo = (sweep == 1) ? khi - 511 : -100000;
#pragma unroll
          for (int r = 0; r < 16; ++r) {
            const int o0 = (r & 3) + 8 * (r >> 2);
            st[0][r] = (o0 <= khi && o0 >= klo) ? st[0][r] : NSA_NEG;
            st[1][r] = (o0 + 32 <= khi && o0 + 32 >= klo) ? st[1][r] : NSA_NEG;
          }
        }
        float mx;
        {
          float a0, a1, a2, a3;
          asm("v_max3_f32 %0, %1, %2, %3" : "=v"(a0) : "v"(st[0][0]), "v"(st[0][1]), "v"(st[0][2]));
          asm("v_max3_f32 %0, %1, %2, %3" : "=v"(a1) : "v"(st[0][3]), "v"(st[0][4]), "v"(st[0][5]));
          asm("v_max3_f32 %0, %1, %2, %3" : "=v"(a2) : "v"(st[0][6]), "v"(st[0][7]), "v"(st[0][8]));
          asm("v_max3_f32 %0, %1, %2, %3" : "=v"(a3) : "v"(st[0][9]), "v"(st[0][10]), "v"(st[0][11]));
          asm("v_max3_f32 %0, %1, %2, %3" : "=v"(a0) : "v"(a0), "v"(st[0][12]), "v"(st[0][13]));
          asm("v_max3_f32 %0, %1, %2, %3" : "=v"(a1) : "v"(a1), "v"(st[0][14]), "v"(st[0][15]));
          asm("v_max3_f32 %0, %1, %2, %3" : "=v"(a2) : "v"(a2), "v"(st[1][0]), "v"(st[1][1]));
          asm("v_max3_f32 %0, %1, %2, %3" : "=v"(a3) : "v"(a3), "v"(st[1][2]), "v"(st[1][3]));
          asm("v_max3_f32 %0, %1, %2, %3" : "=v"(a0) : "v"(a0), "v"(st[1][4]), "v"(st[1][5]));
          asm("v_max3_f32 %0, %1, %2, %3" : "=v"(a1) : "v"(a1), "v"(st[1][6]), "v"(st[1][7]));
          asm("v_max3_f32 %0, %1, %2, %3" : "=v"(a2) : "v"(a2), "v"(st[1][8]), "v"(st[1][9]));
          asm("v_max3_f32 %0, %1, %2, %3" : "=v"(a3) : "v"(a3), "v"(st[1][10]), "v"(st[1][11]));
          asm("v_max3_f32 %0, %1, %2, %3" : "=v"(a0) : "v"(a0), "v"(st[1][12]), "v"(st[1][13]));
          asm("v_max3_f32 %0, %1, %2, %3" : "=v"(a1) : "v"(a1), "v"(st[1][14]), "v"(st[1][15]));
          asm("v_max3_f32 %0, %1, %2, %3" : "=v"(a0) : "v"(a0), "v"(a1), "v"(a2));
          const float other = a3;
          asm("v_max_f32 %0, %1, %2" : "=v"(mx) : "v"(a0), "v"(other));
          const float px = xor32f(mx, lane);
          asm("v_max_f32 %0, %1, %2" : "=v"(mx) : "v"(mx), "v"(px));
        }
        const bool real = mx > -1e29f;
        const bool fresh = !has && real, up = has && (mx > NSA_THR);
        if (__any(fresh || up)) {
          const float delta = (fresh || up) ? mx : 0.f;
          const float alpha = up ? __builtin_amdgcn_exp2f(-delta) : 1.0f;
          m += delta; l *= alpha;
#pragma unroll
          for (int r = 0; r < 16; ++r) { o[0][r] *= alpha; o[1][r] *= alpha; st[0][r] -= delta; st[1][r] -= delta; }
          if (!late) {
            const float dn = seln ? delta : 0.f;
#pragma unroll
            for (int r = 0; r < 16; ++r) { sn[0][r] -= dn; sn[1][r] -= dn; }
          }
        }
        has = has || real;
        f32x2 s2 = {0.f, 0.f};
#pragma unroll
        for (int r = 0; r < 16; ++r) {
          const float p0 = __builtin_amdgcn_exp2f(st[0][r]), p1 = __builtin_amdgcn_exp2f(st[1][r]);
          st[0][r] = p0; st[1][r] = p1; s2 += (f32x2){p0, p1};
        }
        l += s2.x + s2.y;
        nsa_pv(o, st, tile, lane);
        if (late) {
          const float ini = seln ? -m : -1e30f;
#pragma unroll
          for (int r = 0; r < 16; ++r) { sn[0][r] = ini; sn[1][r] = ini; }
#pragma unroll
          for (int ks = 0; ks < 4; ++ks)
#pragma unroll
            for (int kt = 0; kt < 2; ++kt) sn[kt] = MFMA32(*(const bf16x8*)(Kn + kt * 32 * LK + ks * 16), qf[ks], sn[kt]);
        }
        if (j + 2 <= qb) nsa_store_tile(tr, smem + bnn * NSA_TILE);
        if (j + 3 <= qb) nsa_load_tile(tr, kb + (size_t)(j + 3) * 64 * 128, 128, vb + (size_t)(j + 3) * 64 * 128, 128);
#pragma unroll
        for (int r = 0; r < 16; ++r) { st[0][r] = sn[0][r]; st[1][r] = sn[1][r]; }
        bi = bn;
        __syncthreads();
      }
      __builtin_amdgcn_s_setprio(0);
      l += xor32f(l, lane);
      if (!dry) nsa_accum_store(ONSA + it.tokrow * 512 + (it.g * 4 + r4) * 64, o, l > 0.f ? g_b / l : 0.f, false, hh, (unsigned char*)(ws + OFF_ONSA8) + it.tokrow * 512 + (it.g * 4 + r4) * 64);
      else asm volatile("" :: "v"(o[0]), "v"(o[1]), "v"(l));
    }
  }
}

DI unsigned ord_key(float f) { const unsigned u = __float_as_uint(f); return (u & 0x80000000u) ? ~u : (u | 0x80000000u); }
DI float ord_val(unsigned k) { return __uint_as_float((k & 0x80000000u) ? (k & 0x7fffffffu) : ~k); }
DI void cex(unsigned& hi, unsigned& lo) { const unsigned x = hi, y = lo; hi = x > y ? x : y; lo = x > y ? y : x; }
DI void sort16_desc(unsigned (&a)[16]) {
#pragma unroll
  for (int k = 2; k <= 16; k <<= 1)
#pragma unroll
    for (int j = k >> 1; j > 0; j >>= 1)
#pragma unroll
      for (int i = 0; i < 16; ++i) {
        const int l = i ^ j;
        if (l > i) { if ((i & k) == 0) cex(a[i], a[l]); else cex(a[l], a[i]); }
      }
}
DI void bitonic_finish16(unsigned (&a)[16]) {
#pragma unroll
  for (int j = 8; j > 0; j >>= 1)
#pragma unroll
    for (int i = 0; i < 16; ++i) { const int l = i ^ j; if (l > i) cex(a[i], a[l]); }
}
DI void merge_top16(unsigned (&a)[16], const unsigned (&b)[16]) {
#pragma unroll
  for (int i = 0; i < 16; ++i) a[i] = a[i] > b[15 - i] ? a[i] : b[15 - i];
  bitonic_finish16(a);
}
DI void merge_partner16(unsigned (&a)[16]) {
  unsigned b[16];
#pragma unroll
  for (int i = 0; i < 16; ++i) b[i] = xor32u(a[i], otid());
  merge_top16(a, b);
}


constexpr int KLD = 136;
DI void peer_top16(unsigned (&top)[16], const bf16x8 (&bq)[8], const bf16_t* keys  , int lane) {
  const int l31 = lane & 31, hh = lane >> 5;
  unsigned grp[16];
#pragma unroll
  for (int nt = 0; nt < 4; ++nt) {
    f32x16 sa;
#pragma unroll
    for (int r = 0; r < 16; ++r) sa[r] = 0.f;
    const bf16_t* kp = keys + (nt * 32 + l31) * KLD + hh * 8;
#pragma unroll
    for (int ks = 0; ks < 8; ++ks) { const bf16x8 a = *(const bf16x8*)(kp + ks * 16); sa = MFMA32(a, bq[ks], sa); }
#pragma unroll
    for (int r = 0; r < 16; ++r) {
      const int n = nt * 32 + (r & 3) + 8 * (r >> 2) + 4 * hh;
      grp[r] = (ord_key(sa[r]) & ~0x7Fu) | (unsigned)(127 - n);
    }
    sort16_desc(grp);
    if (nt == 0) {
#pragma unroll
      for (int i = 0; i < 16; ++i) top[i] = grp[i];
    } else merge_top16(top, grp);
  }
  merge_partner16(top);
}

DI void phase_route(const Params& p, char* smem) {
  char* ws = p.ws;
  const int tid = otid(), lane = tid & 63, wave = tid >> 6, l31 = lane & 31, hh = lane >> 5;
  const bf16_t* pq = (const bf16_t*)(ws + OFF_PQ);
  const bf16_t* pk = (const bf16_t*)(ws + OFF_PKEYS);
  int* eidx = (int*)(ws + OFF_EIDX);
  float* pgate = (float*)(ws + OFF_PGATE);
  bf16_t* KL = (bf16_t*)smem;
  unsigned* LS = (unsigned*)(smem + 2 * 128 * KLD * 2) + wave * 1024;
  {
    const int h0 = blockIdx.x & 7;
    __syncthreads();
#pragma unroll
    for (int i = 0; i < 8; ++i) {
      const int idx = tid + i * NT, row = idx >> 4, ch = idx & 15;
      *(u32x4*)(KL + row * KLD + ch * 8) = *(const u32x4*)(pk + ((size_t)h0 * 256 + row) * 128 + ch * 8);
    }
    __syncthreads();
  }
  constexpr int CA[64] = {0,0,0,0,0,0,0,0,0,0,0,0,0,0,0,0, 1,1,1,1,1,1,1,1, 2,2,2,2,2, 3,3,3,3, 4,4,4, 5,5, 6,6, 7,7, 8,9,10,11,12,13,14,15, 0,0,0,0,0,0,0,0,0,0,0,0,0,0};
  constexpr int CB[64] = {0,1,2,3,4,5,6,7,8,9,10,11,12,13,14,15, 0,1,2,3,4,5,6,7, 0,1,2,3,4, 0,1,2,3, 0,1,2, 0,1, 0,1, 0,1, 0,0,0,0,0,0,0,0, 0,0,0,0,0,0,0,0,0,0,0,0,0,0};
  for (int item = blockIdx.x; item < (NTOK / 256) * 8; item += gridDim.x) {
    const int h = item & 7, t0 = (item >> 3) * 256 + wave * 32;
    unsigned s1[16], s2[16];
    const bf16_t* pqrow = pq + (size_t)(t0 + l31) * 2048 + h * 256 + hh * 8;
    bf16x8 bq1[8], bq2[8];
#pragma unroll
    for (int ks = 0; ks < 8; ++ks) { bq1[ks] = *(const bf16x8*)(pqrow + ks * 16); bq2[ks] = *(const bf16x8*)(pqrow + 128 + ks * 16); }
    peer_top16(s1, bq1, KL, lane);
    peer_top16(s2, bq2, KL + 128 * KLD, lane);
    float f1[16], f2[16];
#pragma unroll
    for (int i = 0; i < 16; ++i) { f1[i] = ord_val(s1[i]); f2[i] = ord_val(s2[i]); }
    unsigned ca[16], cb2[16];
#pragma unroll
    for (int i = 0; i < 32; ++i) {
      const int i0 = i, i1 = 25 + i;
      unsigned k0 = 0u, k1 = 0u;
      if (i0 < 25) k0 = (ord_key(f1[CA[i0]] + f2[CB[i0]]) & ~0xFFu) | (unsigned)(255 - (CA[i0] * 16 + CB[i0]));
      if (i1 < 50) k1 = (ord_key(f1[CA[i1]] + f2[CB[i1]]) & ~0xFFu) | (unsigned)(255 - (CA[i1] * 16 + CB[i1]));
      const unsigned kk = hh ? k1 : k0;
      if (i < 16) ca[i] = kk; else cb2[i - 16] = kk;
    }
    sort16_desc(ca); sort16_desc(cb2);
    merge_top16(ca, cb2);
    merge_partner16(ca);
    if (hh == 0) {
#pragma unroll
      for (int i = 0; i < 16; ++i) { LS[l31 * 32 + i] = s1[i]; LS[l31 * 32 + 16 + i] = s2[i]; }
    }
    const float mx = ord_val(ca[0]);
    float ex[16], sum = 0.f;
#pragma unroll
    for (int i = 0; i < 16; ++i) { ex[i] = __expf(ord_val(ca[i]) - mx); sum += ex[i]; }
    const float inv = 1.0f / sum;
    int eo[16]; float go[16];
#pragma unroll
    for (int i = 0; i < 16; ++i) {
      const int flat = 255 - (int)(ca[i] & 0xFFu);
      const unsigned k1 = LS[l31 * 32 + (flat >> 4)], k2 = LS[l31 * 32 + 16 + (flat & 15)];
      eo[i] = (127 - (int)(k1 & 0x7Fu)) * 128 + (127 - (int)(k2 & 0x7Fu));
      go[i] = ex[i] * inv;
    }
    const size_t ob = ((size_t)(t0 + l31) * 8 + h) * 16;
    if (hh == 0) {
      *(u32x4*)(eidx + ob) = (u32x4){(unsigned)eo[0], (unsigned)eo[1], (unsigned)eo[2], (unsigned)eo[3]};
      *(u32x4*)(eidx + ob + 4) = (u32x4){(unsigned)eo[4], (unsigned)eo[5], (unsigned)eo[6], (unsigned)eo[7]};
      *(f32x4*)(pgate + ob) = (f32x4){go[0], go[1], go[2], go[3]};
      *(f32x4*)(pgate + ob + 4) = (f32x4){go[4], go[5], go[6], go[7]};
    } else {
      *(u32x4*)(eidx + ob + 8) = (u32x4){(unsigned)eo[8], (unsigned)eo[9], (unsigned)eo[10], (unsigned)eo[11]};
      *(u32x4*)(eidx + ob + 12) = (u32x4){(unsigned)eo[12], (unsigned)eo[13], (unsigned)eo[14], (unsigned)eo[15]};
      *(f32x4*)(pgate + ob + 8) = (f32x4){go[8], go[9], go[10], go[11]};
      *(f32x4*)(pgate + ob + 12) = (f32x4){go[12], go[13], go[14], go[15]};
    }
  }
}

#define FOR32(M) M(0) M(1) M(2) M(3) M(4) M(5) M(6) M(7) M(8) M(9) M(10) M(11) M(12) M(13) M(14) M(15) M(16) M(17) M(18) M(19) M(20) M(21) M(22) M(23) M(24) M(25) M(26) M(27) M(28) M(29) M(30) M(31)
#define FOR16(M) M(0) M(1) M(2) M(3) M(4) M(5) M(6) M(7) M(8) M(9) M(10) M(11) M(12) M(13) M(14) M(15)
DI void phase_ffn_u(const Params& p) {
  char* ws = p.ws;
  const int lane = otid() & 63, wave = otid() >> 6, pg = lane >> 3, dc = lane & 7;
  const int sl = blockIdx.x & 7, wslot = (blockIdx.x >> 3) * NW + wave, nw = (gridDim.x >> 3) * NW;
  const unsigned char* PU8 = (const unsigned char*)(ws + OFF_PU8) + (size_t)sl * 16384 * 128 + dc * 16;
  const unsigned char* h2q = (const unsigned char*)(ws + OFF_H2Q) + sl * 128 + dc * 16;
  const int* eidx = (const int*)(ws + OFF_EIDX);
  float* part = (float*)(ws + OFF_PART) + (size_t)sl * NTOK * 128;
  const int j0 = (dc >> 2) * 64 + ((2 * dc) & 7) * 8 + pg;
  int ev0 = 0, ev1 = 0, nev0 = 0, nev1 = 0; u32x4 hq = {0u, 0u, 0u, 0u}, nhq = hq;
  if (wslot < NTOK) { ev0 = eidx[(size_t)wslot * 128 + lane]; ev1 = eidx[(size_t)wslot * 128 + 64 + lane]; hq = *(const u32x4*)(h2q + (size_t)wslot * DM); }
  for (int t = wslot; t < NTOK; t += nw) {
    if (t + nw < NTOK) { const size_t o = (size_t)(t + nw) * 128; nev0 = eidx[o + lane]; nev1 = eidx[o + 64 + lane]; nhq = *(const u32x4*)(h2q + (size_t)(t + nw) * DM); }
#define FFU_LD(it) const u32x4 ru##it = *(const u32x4*)(PU8 + (size_t)__shfl((it) < 8 ? ev0 : ev1, ((it) & 7) * 8 + pg) * 128);
    FOR16(FFU_LD)
    int d[16];
#define FFU_CP(it) { int a_ = __builtin_amdgcn_sdot4((int)ru##it.x, (int)hq.x, 0, false); a_ = __builtin_amdgcn_sdot4((int)ru##it.y, (int)hq.y, a_, false); \
      a_ = __builtin_amdgcn_sdot4((int)ru##it.z, (int)hq.z, a_, false); d[it] = __builtin_amdgcn_sdot4((int)ru##it.w, (int)hq.w, a_, false); }
    FOR16(FFU_CP)
    int r8[8], r4[4], r2[2];
    { const bool hi = dc & 4;
#pragma unroll
      for (int i = 0; i < 8; ++i) { const int keep = hi ? d[8 + i] : d[i], send = hi ? d[i] : d[8 + i]; r8[i] = keep + __shfl_xor(send, 4); } }
    { const bool hi = dc & 2;
#pragma unroll
      for (int i = 0; i < 4; ++i) { const int keep = hi ? r8[4 + i] : r8[i], send = hi ? r8[i] : r8[4 + i]; r4[i] = keep + __float_as_int(xor2f(__int_as_float(send))); } }
    { const bool hi = dc & 1;
#pragma unroll
      for (int i = 0; i < 2; ++i) { const int keep = hi ? r4[2 + i] : r4[i], send = hi ? r4[i] : r4[2 + i]; r2[i] = keep + __float_as_int(xor1f(__int_as_float(send))); } }
    part[(size_t)t * 128 + j0] = (float)r2[0];
    part[(size_t)t * 128 + j0 + 8] = (float)r2[1];
    ev0 = nev0; ev1 = nev1; hq = nhq;
  }
}
DI void phase_ffn_w(const Params& p) {
  char* ws = p.ws;
  const int lane = otid() & 63, wave = otid() >> 6;
  const float* part = (const float*)(ws + OFF_PART);
  const float* scu = (const float*)(ws + OFF_SCU); const float* scv = (const float*)(ws + OFF_SCV);
  const int* eidx = (const int*)(ws + OFF_EIDX);
  const float* pgate = (const float*)(ws + OFF_PGATE);
  float* wbuf = (float*)(ws + OFF_WBUF);
  for (int grp = blockIdx.x; grp < NTOK / NW; grp += gridDim.x) {
    const size_t o = (size_t)(grp * NW + wave) * 128 + lane;
    float a0 = 0.f, a1 = 0.f;
#pragma unroll
    for (int s8 = 0; s8 < 8; ++s8) { a0 += part[(size_t)s8 * NTOK * 128 + o]; a1 += part[(size_t)s8 * NTOK * 128 + o + 64]; }
    const int e0 = eidx[o], e1 = eidx[o + 64];
    const float sht = ((const float*)(ws + OFF_SH))[grp * NW + wave];
    wbuf[o] = pgate[o] * gelu_f(a0 * (scu[e0] * sht)) * scv[e0];
    wbuf[o + 64] = pgate[o + 64] * gelu_f(a1 * (scu[e1] * sht)) * scv[e1];
  }
}
DI void ffv_store(const f32x2 (&acc2)[8], bf16_t* dst, int lane) {
  float acc[16];
#pragma unroll
  for (int i = 0; i < 8; ++i) { acc[2 * i] = acc2[i].x; acc[2 * i + 1] = acc2[i].y; }
  float r8[8], r4[4], r2[2];
  { const bool hi = lane & 32;
#pragma unroll
    for (int i = 0; i < 8; ++i) { const float keep = hi ? acc[8 + i] : acc[i], send = hi ? acc[i] : acc[8 + i]; r8[i] = keep + xor32f(send, lane); } }
  { const bool hi = lane & 16;
#pragma unroll
    for (int i = 0; i < 4; ++i) { const float keep = hi ? r8[4 + i] : r8[i], send = hi ? r8[i] : r8[4 + i]; r4[i] = keep + xor16f(send, lane); } }
  { const bool hi = lane & 8;
#pragma unroll
    for (int i = 0; i < 2; ++i) { const float keep = hi ? r4[2 + i] : r4[i], send = hi ? r4[i] : r4[2 + i]; r2[i] = keep + xor8f(send); } }
  *(unsigned*)dst = pack2(r2[0], r2[1]);
}
DI void phase_ffn_v(const Params& p) {
  char* ws = p.ws;
  const int lane = otid() & 63, wave = otid() >> 6, pg = lane >> 3, dc = lane & 7;
  const int sl = blockIdx.x & 7, wslot = (blockIdx.x >> 3) * NW + wave, nw = (gridDim.x >> 3) * NW;
  const unsigned char* PV8 = (const unsigned char*)(ws + OFF_PV8) + (size_t)sl * 16384 * 128 + dc * 16;
  const int* eidx = (const int*)(ws + OFF_EIDX) + 16 * pg;
  const float* wbuf = (const float*)(ws + OFF_WBUF) + 16 * pg;
  bf16_t* ffnb = (bf16_t*)(ws + OFF_FFNB) + sl * 128 + dc * 16 + 2 * pg;
#define FFV_TOK(t_) min((t_), NTOK - 1)
#define FFV_LDE(S, t_) { const int* ep_ = eidx + (size_t)FFV_TOK(t_) * 128; S##e0 = *(const u32x4*)ep_; S##e1 = *(const u32x4*)(ep_ + 4); S##e2 = *(const u32x4*)(ep_ + 8); S##e3 = *(const u32x4*)(ep_ + 12); }
#define FFV_LDW(S, t_) { const float* wp_ = wbuf + (size_t)FFV_TOK(t_) * 128; S##w0 = *(const f32x4*)wp_; S##w1 = *(const f32x4*)(wp_ + 4); S##w2 = *(const f32x4*)(wp_ + 8); S##w3 = *(const f32x4*)(wp_ + 12); }
#define FFV_E(S, it) ((it) < 4 ? S##e0[(it) & 3] : (it) < 8 ? S##e1[(it) & 3] : (it) < 12 ? S##e2[(it) & 3] : S##e3[(it) & 3])
#define FFV_W(S, it) ((it) < 4 ? S##w0[(it) & 3] : (it) < 8 ? S##w1[(it) & 3] : (it) < 12 ? S##w2[(it) & 3] : S##w3[(it) & 3])
#define FFV_LDR1(S, it) S##r##it = *(const u32x4*)(PV8 + (size_t)FFV_E(S, it) * 128);
#define FFV_LDR(S) FFV_LDR1(S, 0) FFV_LDR1(S, 1) FFV_LDR1(S, 2) FFV_LDR1(S, 3) FFV_LDR1(S, 4) FFV_LDR1(S, 5) FFV_LDR1(S, 6) FFV_LDR1(S, 7) \
                   FFV_LDR1(S, 8) FFV_LDR1(S, 9) FFV_LDR1(S, 10) FFV_LDR1(S, 11) FFV_LDR1(S, 12) FFV_LDR1(S, 13) FFV_LDR1(S, 14) FFV_LDR1(S, 15)
#define FFV_CP(S, it) { const float wj = FFV_W(S, it); const f32x2 w2 = {wj, wj}; \
      acc2[0] += __builtin_amdgcn_cvt_pk_f32_fp8((int)S##r##it.x, false) * w2; acc2[1] += __builtin_amdgcn_cvt_pk_f32_fp8((int)S##r##it.x, true) * w2; \
      acc2[2] += __builtin_amdgcn_cvt_pk_f32_fp8((int)S##r##it.y, false) * w2; acc2[3] += __builtin_amdgcn_cvt_pk_f32_fp8((int)S##r##it.y, true) * w2; \
      acc2[4] += __builtin_amdgcn_cvt_pk_f32_fp8((int)S##r##it.z, false) * w2; acc2[5] += __builtin_amdgcn_cvt_pk_f32_fp8((int)S##r##it.z, true) * w2; \
      acc2[6] += __builtin_amdgcn_cvt_pk_f32_fp8((int)S##r##it.w, false) * w2; acc2[7] += __builtin_amdgcn_cvt_pk_f32_fp8((int)S##r##it.w, true) * w2; }
#define FFV_ACC(S, t_) { f32x2 acc2[8]; _Pragma("unroll") for (int i_ = 0; i_ < 8; ++i_) acc2[i_] = (f32x2){0.f, 0.f}; \
    FFV_CP(S, 0) FFV_CP(S, 1) FFV_CP(S, 2) FFV_CP(S, 3) FFV_CP(S, 4) FFV_CP(S, 5) FFV_CP(S, 6) FFV_CP(S, 7) \
    FFV_CP(S, 8) FFV_CP(S, 9) FFV_CP(S, 10) FFV_CP(S, 11) FFV_CP(S, 12) FFV_CP(S, 13) FFV_CP(S, 14) FFV_CP(S, 15) \
    ffv_store(acc2, ffnb + (size_t)FFV_TOK(t_) * DM, lane); }
  u32x4 Ae0, Ae1, Ae2, Ae3, Be0, Be1, Be2, Be3; f32x4 Aw0, Aw1, Aw2, Aw3, Bw0, Bw1, Bw2, Bw3;
  u32x4 Ar0, Ar1, Ar2, Ar3, Ar4, Ar5, Ar6, Ar7, Ar8, Ar9, Ar10, Ar11, Ar12, Ar13, Ar14, Ar15;
  u32x4 Br0, Br1, Br2, Br3, Br4, Br5, Br6, Br7, Br8, Br9, Br10, Br11, Br12, Br13, Br14, Br15;
  if (wslot >= NTOK) return;
  FFV_LDE(A, wslot) FFV_LDE(B, wslot + nw) FFV_LDW(A, wslot)
  FFV_LDR(A)
  FFV_LDE(A, wslot + 2 * nw)
#pragma unroll 1
  for (int t = wslot; t < NTOK; t += 2 * nw) {
    FFV_LDR(B) FFV_LDW(B, t + nw)
    __builtin_amdgcn_sched_barrier(0);
    FFV_ACC(A, t)
    __builtin_amdgcn_sched_barrier(0);
    FFV_LDR(A) FFV_LDW(A, t + 2 * nw) FFV_LDE(B, t + 3 * nw)
    __builtin_amdgcn_sched_barrier(0);
    FFV_ACC(B, t + nw)
    __builtin_amdgcn_sched_barrier(0);
    FFV_LDE(A, t + 4 * nw)
  }
}
DI void phase_final(const Params& p) {
  char* ws = p.ws;
  const int lane = otid() & 63, wave = otid() >> 6;
  const bf16_t* x1 = (const bf16_t*)(ws + OFF_X1);
  const bf16_t* ffnb = (const bf16_t*)(ws + OFF_FFNB);
  const float* mod = (const float*)(ws + OFF_MOD);
  for (int grp = blockIdx.x; grp < NTOK / NW; grp += gridDim.x) {
    const int row = grp * NW + wave, b = row >> 13;
    float v[16];
#pragma unroll
    for (int i = 0; i < 4; ++i) {
      const int col = i * 256 + lane * 4;
      const f32x4 gt2 = *(const f32x4*)(mod + b * 6144 + 5120 + col);
      const u32x2 xr = *(const u32x2*)(x1 + (size_t)row * DM + col), fr = *(const u32x2*)(ffnb + (size_t)row * DM + col);
      v[4 * i] = DN_ALPHA * bflo(xr.x) + gt2.x * bflo(fr.x); v[4 * i + 1] = DN_ALPHA * bfhi(xr.x) + gt2.y * bfhi(fr.x);
      v[4 * i + 2] = DN_ALPHA * bflo(xr.y) + gt2.z * bflo(fr.y); v[4 * i + 3] = DN_ALPHA * bfhi(xr.y) + gt2.w * bfhi(fr.y);
    }
    float mean, rstd; row_stats(v, mean, rstd);
#pragma unroll
    for (int i = 0; i < 4; ++i) {
      const int col = i * 256 + lane * 4;
      const f32x4 g = *(const f32x4*)(p.ln2_g + col), bb = *(const f32x4*)(p.ln2_b + col);
      f32x4 o;
      o.x = (v[4 * i] - mean) * rstd * g.x + bb.x; o.y = (v[4 * i + 1] - mean) * rstd * g.y + bb.y;
      o.z = (v[4 * i + 2] - mean) * rstd * g.z + bb.z; o.w = (v[4 * i + 3] - mean) * rstd * g.w + bb.w;
      *(f32x4*)(p.out + (size_t)row * DM + col) = o;
    }
  }
}

#define XB_TMO      128
#define XB_XCNT(j)  (256  + 64 * (j))
#define XB_XSUB(j)  (1280 + 64 * (j))
#define XB_XGEN(j)  (2304 + 64 * (j))
#define XB_TOP      3328
#define XB_TOPGEN   3392
#define XCD_BAR_WORDS 3456
#define XB_SPIN_CAP (1u << 22)
DI unsigned xb_ld(unsigned* p) { return __hip_atomic_load(p, __ATOMIC_RELAXED, __HIP_MEMORY_SCOPE_AGENT); }
DI unsigned xb_add(unsigned* p, unsigned v) { return __hip_atomic_fetch_add(p, v, __ATOMIC_RELAXED, __HIP_MEMORY_SCOPE_AGENT); }
DI unsigned xb_xcc_id() { return (unsigned)__builtin_amdgcn_s_getreg((3 << 11) | 20) & 0xFu; }
#define XB_SPIN(cond, bar) do { unsigned _sp = 0; while (cond) { __builtin_amdgcn_s_sleep(1); \
    if ((++_sp & 255u) == 0u) { if (xb_ld(&(bar)[XB_TMO])) break; if (_sp > XB_SPIN_CAP) { atomicAdd(&(bar)[XB_TMO], 1u); break; } } } } while (0)
struct XcdBarrier { unsigned* bar; unsigned x; volatile LAS unsigned* st; };
DI XcdBarrier xcd_barrier_post(unsigned* bar, volatile LAS unsigned* st) {
  XcdBarrier b; b.bar = bar; b.x = xb_xcc_id(); b.st = st;
  if (threadIdx.x == 0) (void)xb_add(&bar[XB_XCNT(b.x)], 1u);
  return b;
}
DI void xcd_barrier_complete(unsigned* bar, unsigned x, unsigned& nloc, unsigned& nx) {
  const unsigned G = gridDim.x * gridDim.y * gridDim.z;
  unsigned sum, cnt, mine, sp = 0u;
  for (;;) {
    sum = 0u; cnt = 0u; mine = 0u;
#pragma unroll
    for (unsigned j = 0; j < 16; ++j) { const unsigned c = xb_ld(&bar[XB_XCNT(j)]); sum += c; cnt += (c > 0u) ? 1u : 0u; mine = (j == x) ? c : mine; }
    if (sum == G) break;
    __builtin_amdgcn_s_sleep(1);
    if ((++sp & 255u) == 0u) { if (xb_ld(&bar[XB_TMO])) break; if (sp > XB_SPIN_CAP) { atomicAdd(&bar[XB_TMO], 1u); break; } }
  }
  nloc = mine > 0u ? mine : 1u; nx = cnt > 0u ? cnt : 1u;
}
DI void xcd_barrier(const XcdBarrier& b) {
  asm volatile("s_waitcnt vmcnt(0)" ::: "memory");
  __syncthreads();
  if (threadIdx.x == 0) {
    unsigned* bar = b.bar;
    __builtin_amdgcn_s_waitcnt(0);
    unsigned nloc = b.st[0], nx = b.st[1];
    if (nloc == 0u) { xcd_barrier_complete(bar, b.x, nloc, nx); b.st[0] = nloc; b.st[1] = nx; }
    const unsigned old = xb_add(&bar[XB_XSUB(b.x)], 1u);
    const unsigned gen = old / nloc;
    if (old + 1u == (gen + 1u) * nloc) {
      __builtin_amdgcn_fence(__ATOMIC_RELEASE, "agent");
      asm volatile("s_waitcnt vmcnt(0)" ::: "memory");
      const unsigned og = xb_add(&bar[XB_TOP], 1u);
      const unsigned tg = og / nx;
      if (og + 1u == (tg + 1u) * nx) xb_add(&bar[XB_TOPGEN], 1u);
      else XB_SPIN(xb_ld(&bar[XB_TOPGEN]) == tg, bar);
      __builtin_amdgcn_fence(__ATOMIC_ACQUIRE, "agent");
      xb_add(&bar[XB_XGEN(b.x)], 1u);
      asm volatile("s_waitcnt vmcnt(0)" ::: "memory");
    } else {
      XB_SPIN(xb_ld(&bar[XB_XGEN(b.x)]) == gen, bar);
      __builtin_amdgcn_fence(__ATOMIC_ACQUIRE, "agent");
      asm volatile("s_waitcnt vmcnt(0)" ::: "memory");
    }
  }
  __syncthreads();
}

constexpr int SMEM_BYTES = 147456 + 256;

__global__ void __launch_bounds__(NT, 2) k_mega(Params p) {
  __shared__ __attribute__((aligned(16))) char smem[SMEM_BYTES];
  cg::grid_group grid = cg::this_grid();
  if (threadIdx.x == 0) *(u32x4*)(smem + 147456) = (u32x4){0u, 0u, 0u, 0u};
  __syncthreads();
  const XcdBarrier xb = xcd_barrier_post((unsigned*)(p.ws + OFF_BAR), (volatile LAS unsigned*)(smem + 147456));
#define REP(mask) _Pragma("unroll 1") for (int rep_ = 0; rep_ < ((PROBE_DUP & (mask)) ? 2 : 1); ++rep_)
  REP(1) phase_prep(p, smem, (unsigned*)(p.ws + OFF_BAR) + XCD_BAR_WORDS + rep_);
  grid.sync();
  REP(1) phase_ln_in(p);
  xcd_barrier(xb);
  REP(2) phase_gemm1(p, smem);
  xcd_barrier(xb);
  REP(4) phase_compress(p, smem);
  phase_sgu(p, smem);
  xcd_barrier(xb);
  REP(8) phase_nsa(p, smem, NSA_MASK);
  xcd_barrier(xb);
  REP(16) phase_merge(p, smem);
  xcd_barrier(xb);
  REP(16) phase_outproj(p, smem);
  xcd_barrier(xb);
  REP(1) phase_ln_mid(p);
  xcd_barrier(xb);
  REP(32) phase_peerq(p, smem);
  xcd_barrier(xb);
  REP(64) phase_route(p, smem);
  xcd_barrier(xb);
  REP(128) phase_ffn_u(p);
  xcd_barrier(xb);
  REP(128) phase_ffn_w(p);
  xcd_barrier(xb);
  REP(256) phase_ffn_v(p);
  xcd_barrier(xb);
  REP(512) phase_final(p);
}

extern "C" void kernel_launch(void* const* d_in, const int* in_sizes, int n_in, void* d_out, int out_size, void* d_ws, size_t ws_size, hipStream_t stream) {
  if (ws_size < OFF_END) { fprintf(stderr, "workspace too small: %zu < %zu\n", ws_size, (size_t)OFF_END); return; }
  static int grid_blocks = 0;
  if (!grid_blocks) {
    int dev = 0, cus = 0, per_cu = 0;
    (void)hipGetDevice(&dev);
    (void)hipDeviceGetAttribute(&cus, hipDeviceAttributeMultiprocessorCount, dev);
    (void)hipOccupancyMaxActiveBlocksPerMultiprocessor(&per_cu, k_mega, NT, 0);
    if (per_cu < 1) fprintf(stderr, "occupancy query returned %d\n", per_cu);
    grid_blocks = (cus / 8) * 8;
  }
  Params p{};
  const float** fp = (const float**)&p;
  for (int i = 0; i < 26; ++i) fp[i] = (const float*)d_in[i];
  p.out = (float*)d_out;
  p.ws = (char*)d_ws;
  for (int i = 0; i < 32; ++i) p.inv_freq[i] = (float)pow(10000.0, -(double)i / 32.0);
  (void)hipMemsetAsync((char*)d_ws + OFF_BAR, 0, (XCD_BAR_WORDS + 64) * 4, stream);
  void* args[] = {&p};
  hipError_t e = hipLaunchCooperativeKernel((void*)k_mega, dim3(grid_blocks), dim3(NT), args, 0, stream);
  if (e != hipSuccess) fprintf(stderr, "cooperative launch failed: %s (grid %d)\n", hipGetErrorString(e), grid_blocks);
}
```

```cpp
#include <hip/hip_runtime.h>
#include <hip/hip_cooperative_groups.h>
#include <stdint.h>
#include <stdio.h>
#include <math.h>
namespace cg = cooperative_groups;

#ifndef PROBE_DUP
#define PROBE_DUP 0
#endif
#ifndef NSA_MASK
#define NSA_MASK 7
#endif
typedef unsigned short bf16_t;
typedef short bf16x8 __attribute__((ext_vector_type(8)));
typedef short s16x4 __attribute__((ext_vector_type(4)));
typedef float f32x16 __attribute__((ext_vector_type(16)));
typedef float f32x4 __attribute__((ext_vector_type(4)));
typedef float f32x2 __attribute__((ext_vector_type(2)));
typedef __bf16 bf16v2 __attribute__((ext_vector_type(2)));
typedef unsigned u32x4 __attribute__((ext_vector_type(4)));
typedef int i32x4 __attribute__((ext_vector_type(4)));
typedef int i32x8 __attribute__((ext_vector_type(8)));
typedef unsigned u32x2 __attribute__((ext_vector_type(2)));
#define DI __device__ __forceinline__
#define LAS __attribute__((address_space(3)))
#define MFMA32(a, b, c) __builtin_amdgcn_mfma_f32_32x32x16_bf16((a), (b), (c), 0, 0, 0)

constexpr int NT = 512, NW = 8;
constexpr int NB = 8, SEQ = 8192, DM = 1024, NTOK = NB * SEQ;
constexpr int N1 = 4608;
constexpr float DN_ALPHA = 1.189207115002721f;
constexpr float LN_EPS = 1e-5f;

constexpr size_t MB = 1024 * 1024;
constexpr size_t OFF_MOD = 0;
constexpr size_t OFF_ROPE = OFF_MOD + 256 * 1024;
constexpr size_t OFF_POSB = OFF_ROPE + 2 * MB;
constexpr size_t OFF_WT1 = OFF_POSB + 4096;
constexpr size_t OFF_WB = OFF_WT1 + (size_t)N1 * 1024 * 2;
constexpr size_t OFF_WOUT = OFF_WB + 2 * MB;
constexpr size_t OFF_WQ = OFF_WOUT + 2 * MB;
constexpr size_t OFF_PKEYS = OFF_WQ + 4 * MB;
constexpr size_t OFF_CW1 = OFF_PKEYS + MB / 2;
constexpr size_t OFF_CW2 = OFF_CW1 + MB;
constexpr size_t OFF_SGUW = OFF_CW2 + 32 * 1024;
constexpr size_t OFF_SCU = OFF_SGUW + 256 * 1024;
constexpr size_t OFF_SCV = OFF_SCU + 64 * 1024;
constexpr size_t OFF_PU = OFF_SCV + 64 * 1024;
constexpr size_t OFF_PV = OFF_PU + 32 * MB;
constexpr size_t OFF_ACT = ((OFF_PV + 32 * MB + 4095) / 4096) * 4096;
constexpr size_t OFF_H = OFF_ACT;
constexpr size_t OFF_Q = OFF_H + 128 * MB;
constexpr size_t OFF_KC = OFF_Q + 64 * MB;
constexpr size_t OFF_VC = OFF_KC + 16 * MB;
constexpr size_t OFF_KS = OFF_VC + 16 * MB;
constexpr size_t OFF_VS = OFF_KS + 16 * MB;
constexpr size_t OFF_KW = OFF_VS + 16 * MB;
constexpr size_t OFF_VW = OFF_KW + 16 * MB;
constexpr size_t OFF_U = OFF_VW + 16 * MB;
constexpr size_t OFF_V = OFF_U + 64 * MB;
constexpr size_t OFF_GATE = OFF_V + 64 * MB;
constexpr size_t OFF_GSIG = OFF_GATE + 256 * MB;
constexpr size_t OFF_KCMP = OFF_GSIG + 8 * MB;
constexpr size_t OFF_VCMP = OFF_KCMP + MB;
constexpr size_t OFF_ONSA = OFF_VCMP + MB;
constexpr size_t OFF_SELG = OFF_ONSA + 64 * MB;
constexpr size_t OFF_BAR = OFF_SELG + 2 * MB;
constexpr size_t OFF_END = OFF_BAR + 64 * 1024;
constexpr size_t OFF_Y = OFF_Q;
constexpr size_t OFF_PQ = OFF_GATE;
constexpr size_t OFF_EIDX = OFF_ONSA;
constexpr size_t OFF_PGATE = OFF_ONSA + 32 * MB;
constexpr size_t OFF_PU8 = OFF_PU;
constexpr size_t OFF_PART = OFF_GATE;
constexpr size_t OFF_PV8 = OFF_PU + 16 * MB;
constexpr size_t OFF_WBUF = OFF_PU + 32 * MB;
constexpr size_t OFF_H2Q = OFF_U;
constexpr size_t OFF_SH = OFF_V;
constexpr size_t OFF_FFNB = OFF_GATE;
constexpr size_t OFF_SCW1 = OFF_WT1 + 5 * MB;
constexpr size_t OFF_SCWQ = OFF_WQ + 3 * MB;
constexpr size_t OFF_GATE8 = OFF_GATE;
constexpr size_t OFF_OSGU8 = OFF_GATE + 128 * MB;
constexpr size_t OFF_ONSA8 = OFF_GATE + 160 * MB;
constexpr size_t OFF_MRG8 = OFF_GATE + 192 * MB;
constexpr size_t OFF_M08 = OFF_H;
constexpr size_t OFF_SCWB = OFF_WB + 3 * MB / 2;
constexpr size_t OFF_SCWO = OFF_WOUT + 3 * MB / 2;
constexpr size_t OFF_SA = OFF_H + 64 * MB;

struct Params {
  const float *x, *c, *w_ada, *b_ada, *w_in, *cmp_pos, *cmp_w1, *cmp_b1, *cmp_w2, *cmp_b2, *sgu_ln_g, *sgu_ln_b, *sgu_w, *sgu_b,
      *w_branch, *w_merge, *b_merge, *w_out, *ln1_g, *ln1_b, *peer_wq, *peer_keys, *peer_u, *peer_v, *ln2_g, *ln2_b;
  float* out;
  char* ws;
  float inv_freq[32];
};

DI unsigned pack2(float lo, float hi) { f32x2 v = {lo, hi}; bf16v2 r = __builtin_convertvector(v, bf16v2); return __builtin_bit_cast(unsigned, r); }
DI bf16_t f2bf(float f) { __bf16 r = (__bf16)f; return __builtin_bit_cast(unsigned short, r); }
DI float bf2f(bf16_t h) { return __uint_as_float(((unsigned)h) << 16); }
DI float bflo(unsigned u) { return __uint_as_float(u << 16); }
DI float bfhi(unsigned u) { return __uint_as_float(u & 0xffff0000u); }
DI float gelu_f(float v) { return 0.5f * v * (1.0f + erff(v * 0.70710678118654752f)); }
DI float sigmoid_f(float v) { return __builtin_amdgcn_rcpf(1.0f + __builtin_amdgcn_exp2f(v * -1.4426950408889634f)); }
DI int otid() { int t = __builtin_amdgcn_workitem_id_x(); asm volatile("" : "+v"(t)); return t; }
DI void lds_barrier() { asm volatile("s_waitcnt lgkmcnt(0)" ::: "memory"); __builtin_amdgcn_s_barrier(); asm volatile("" ::: "memory"); }
DI float xor1f(float x) { const int xi = __float_as_int(x); return __int_as_float(__builtin_amdgcn_update_dpp(xi, xi, 0xB1, 0xF, 0xF, false)); }
DI float xor2f(float x) { const int xi = __float_as_int(x); return __int_as_float(__builtin_amdgcn_update_dpp(xi, xi, 0x4E, 0xF, 0xF, false)); }
DI float xor8f(float x) { const int xi = __float_as_int(x); return __int_as_float(__builtin_amdgcn_update_dpp(xi, xi, 0x128, 0xF, 0xF, false)); }
DI unsigned xor32u(unsigned x, int lane) { const u32x2 r = __builtin_amdgcn_permlane32_swap(x, x, false, false); return (lane & 32) ? r.x : r.y; }
DI unsigned xor16u(unsigned x, int lane) { const u32x2 r = __builtin_amdgcn_permlane16_swap(x, x, false, false); return (lane & 16) ? r.x : r.y; }
DI float xor32f(float x, int lane) { return __uint_as_float(xor32u(__float_as_uint(x), lane)); }
DI float xor16f(float x, int lane) { return __uint_as_float(xor16u(__float_as_uint(x), lane)); }
DI unsigned pack_i8x4(float a, float b, float c, float d) {
  const int ia = (int)rintf(a), ib = (int)rintf(b), ic = (int)rintf(c), id = (int)rintf(d);
  return (unsigned)(ia & 0xff) | ((unsigned)(ib & 0xff) << 8) | ((unsigned)(ic & 0xff) << 16) | ((unsigned)id << 24);
}
DI unsigned pk4_fp8(float a, float b, float c, float d) { int t = 0; t = __builtin_amdgcn_cvt_pk_fp8_f32(a, b, t, false); t = __builtin_amdgcn_cvt_pk_fp8_f32(c, d, t, true); return (unsigned)t; }
DI float clamp_f8(float v) { return __builtin_amdgcn_fmed3f(v, -448.0f, 448.0f); }
DI void unpack8_fp8(const u32x2 w, float (&v)[8]) {
  const f32x2 a = __builtin_amdgcn_cvt_pk_f32_fp8((int)w.x, false), b = __builtin_amdgcn_cvt_pk_f32_fp8((int)w.x, true);
  const f32x2 c = __builtin_amdgcn_cvt_pk_f32_fp8((int)w.y, false), d = __builtin_amdgcn_cvt_pk_f32_fp8((int)w.y, true);
  v[0] = a.x; v[1] = a.y; v[2] = b.x; v[3] = b.y; v[4] = c.x; v[5] = c.y; v[6] = d.x; v[7] = d.y;
}
DI float dpp_hm(float x) { const int xi = __float_as_int(x); return __int_as_float(__builtin_amdgcn_update_dpp(xi, xi, 0x141, 0xF, 0xF, false)); }
DI float dpp_rm(float x) { const int xi = __float_as_int(x); return __int_as_float(__builtin_amdgcn_update_dpp(xi, xi, 0x140, 0xF, 0xF, false)); }
DI int wave_lane() { return (int)__builtin_amdgcn_mbcnt_hi(~0u, __builtin_amdgcn_mbcnt_lo(~0u, 0u)); }
DI float wave_sum(float v) {
  const int lane = wave_lane();
  v += xor1f(v); v += xor2f(v); v += dpp_hm(v); v += dpp_rm(v); v += xor16f(v, lane); v += xor32f(v, lane);
  return v;
}
DI float wave_max(float v) {
  const int lane = wave_lane();
  v = fmaxf(v, xor1f(v)); v = fmaxf(v, xor2f(v)); v = fmaxf(v, dpp_hm(v)); v = fmaxf(v, dpp_rm(v)); v = fmaxf(v, xor16f(v, lane)); v = fmaxf(v, xor32f(v, lane));
  return v;
}
DI void ld8(const float* pz, float (&v)[8]) { const f32x4 a = *(const f32x4*)pz, b = *(const f32x4*)(pz + 4); v[0] = a.x; v[1] = a.y; v[2] = a.z; v[3] = a.w; v[4] = b.x; v[5] = b.y; v[6] = b.z; v[7] = b.w; }
DI u32x4 pack8(const float (&v)[8]) { u32x4 w; w.x = pack2(v[0], v[1]); w.y = pack2(v[2], v[3]); w.z = pack2(v[4], v[5]); w.w = pack2(v[6], v[7]); return w; }
DI void unpack8(const u32x4 w, float (&v)[8]) { v[0] = bflo(w.x); v[1] = bfhi(w.x); v[2] = bflo(w.y); v[3] = bfhi(w.y); v[4] = bflo(w.z); v[5] = bfhi(w.z); v[6] = bflo(w.w); v[7] = bfhi(w.w); }
DI f32x2 gelu_pk(f32x2 v) {
  const f32x2 av = __builtin_elementwise_abs(v), d = av * 0.2316418882f + 1.0f;
  f32x2 t; t.x = __builtin_amdgcn_rcpf(d.x); t.y = __builtin_amdgcn_rcpf(d.y);
  f32x2 q = t * 0.5307027145f + (-0.7265760135f); q = q * t + 0.7107068705f; q = q * t + (-0.142248368f); q = q * t + 0.127414796f; q = q * t;
  const f32x2 s = (v * v) * (-0.72134752044f);
  f32x2 e; e.x = __builtin_amdgcn_exp2f(s.x); e.y = __builtin_amdgcn_exp2f(s.y);
  const f32x2 m = v * (q * e), r = v - m;
  f32x2 o; o.x = v.x < 0.f ? m.x : r.x; o.y = v.y < 0.f ? m.y : r.y; return o;
}
__host__ __device__ __forceinline__ int dperm(int q) { const int grp = q >> 5, fq = (q >> 3) & 3, j = q & 7; return (j < 4) ? (16 * grp + 4 * fq + j) : (32 + 16 * grp + 4 * fq + (j - 4)); }

template <class F>
DI void tconv_tile(float* tile, int k0, int n0, bf16_t* dst, int ldd, F f) {
  const int tid = otid();
  __syncthreads();
#pragma unroll 4
  for (int i = 0; i < 8; ++i) { const int kl = i * 8 + (tid >> 6), nl = tid & 63; tile[nl * 65 + kl] = f(k0 + kl, n0 + nl); }
  __syncthreads();
  {
    const int nl = tid >> 3, kc = tid & 7;
    const float* t = tile + nl * 65 + kc * 8;
    u32x4 w; w.x = pack2(t[0], t[1]); w.y = pack2(t[2], t[3]); w.z = pack2(t[4], t[5]); w.w = pack2(t[6], t[7]);
    *(u32x4*)(dst + (size_t)(n0 + nl) * ldd + k0 + kc * 8) = w;
  }
}

template <bool FP8, class F>
DI void tconv_strip32(float* tile, int n0, int K, unsigned char* dst, float* gscale, F f) {
  const int tid = otid(), nl = tid & 31, kr = tid >> 5, ld = K + 1;
  float am = 0.f;
#pragma unroll 16
  for (int k = kr; k < K; k += 16) { const float v = f(k, n0 + nl); tile[nl * ld + k] = v; am = fmaxf(am, fabsf(v)); }
#pragma unroll
  for (int o = 16; o > 0; o >>= 1) am = fmaxf(am, __shfl_xor(am, o));
  float* red = tile + 32 * ld;
  if (nl == 0) red[kr] = am;
  __syncthreads();
  float g = 0.f;
#pragma unroll
  for (int w = 0; w < 16; ++w) g = fmaxf(g, red[w]);
  float q, inv;
  if (FP8) {
    const unsigned be = (__float_as_uint(g) >> 23) & 0xffu;
    const bool ok = be >= 16u && be <= 240u;
    q = ok ? __uint_as_float((261u - be) << 23) : 1.0f; inv = ok ? __uint_as_float((be - 7u) << 23) : 1.0f;
  } else { q = g > 0.f ? 127.0f / g : 0.f; inv = g * (1.0f / 127.0f); }
  if (tid == 0) gscale[n0 >> 5] = inv;
  const int cpr = K >> 3;
  for (int idx = tid; idx < 32 * cpr; idx += NT) {
    const int row = idx / cpr, kc = idx - row * cpr;
    const float* t = tile + row * ld + kc * 8;
    u32x2 w;
    if (FP8) { w.x = pk4_fp8(t[0] * q, t[1] * q, t[2] * q, t[3] * q); w.y = pk4_fp8(t[4] * q, t[5] * q, t[6] * q, t[7] * q); }
    else { w.x = pack_i8x4(t[0] * q, t[1] * q, t[2] * q, t[3] * q); w.y = pack_i8x4(t[4] * q, t[5] * q, t[6] * q, t[7] * q); }
    *(u32x2*)(dst + (size_t)(n0 + row) * K + kc * 8) = w;
  }
}

DI void conv_chunk(const float* src, bf16_t* dst, size_t base) {
  const size_t i = base + (size_t)otid() * 8;
  const f32x4 a = *(const f32x4*)(src + i), b = *(const f32x4*)(src + i + 4);
  u32x4 w; w.x = pack2(a.x, a.y); w.y = pack2(a.z, a.w); w.z = pack2(b.x, b.y); w.w = pack2(b.z, b.w);
  *(u32x4*)(dst + i) = w;
}

DI void sincos_d(double x, double& s, double& c) {
  const double y = x * 0.25, y2 = y * y;
  double sn = y * (1.0 + y2 * (-1.0 / 6 + y2 * (1.0 / 120 + y2 * (-1.0 / 5040 + y2 * (1.0 / 362880 + y2 * (-1.0 / 39916800 + y2 * (1.0 / 6227020800.0)))))));
  double cs = 1.0 + y2 * (-0.5 + y2 * (1.0 / 24 + y2 * (-1.0 / 720 + y2 * (1.0 / 40320 + y2 * (-1.0 / 3628800 + y2 * (1.0 / 479001600.0 + y2 * (-1.0 / 87178291200.0)))))));
#pragma unroll
  for (int i = 0; i < 2; ++i) { const double s2 = 2.0 * sn * cs, c2 = cs * cs - sn * sn; sn = s2; cs = c2; }
  s = sn; c = cs;
}

DI void phase_prep(const Params& p, char* smem, unsigned* wcnt) {
  const int tid = otid();
  float* fs = (float*)smem;
  char* ws = p.ws;
  volatile LAS unsigned* slot = (volatile LAS unsigned*)(smem + 147456 + 64);
  constexpr int nB = 144, nE = 64, nC = 64, nD = 32, nA = 192, nI = 512, nF = 2 * 32 * 2, nG = 4, nH = 8, nJ = 64, nK = 32, nL = 512, nM = 512;
  constexpr int total = nB + nE + nC + nD + nA + nI + nF + nG + nH + nJ + nK + nL + nM;
  for (;;) {
    __syncthreads();
    if (tid == 0) *slot = __hip_atomic_fetch_add(wcnt, 1u, __ATOMIC_RELAXED, __HIP_MEMORY_SCOPE_AGENT);
    __syncthreads();
    int it = (int)*slot;
    if (it >= total) break;
    if (it < nB) {
      const float* w_in = p.w_in; const float* w_merge = p.w_merge;
      tconv_strip32<false>(fs, it * 32, 1024, (unsigned char*)(ws + OFF_WT1), (float*)(ws + OFF_SCW1), [=](int k, int n) -> float {
        if (n < 1280) {
          const bool roped = (n < 640) || (n >= 768 && n < 896) || (n >= 1024 && n < 1152);
          const int col = roped ? ((n & ~63) + dperm(n & 63)) : n;
          return w_in[(size_t)k * 2328 + col];
        }
        if (n < 2304) return w_in[(size_t)k * 2328 + n + 24];
        if (n < 4352) return w_merge[(size_t)k * 2048 + (n - 2304)];
        if (n < 4376) return w_in[(size_t)k * 2328 + 1280 + (n - 4352)];
        return 0.f; });
      continue;
    }
    it -= nB;
    if (it < nE) {
      const float* src = p.peer_wq;
      tconv_strip32<false>(fs, it * 32, 1024, (unsigned char*)(ws + OFF_WQ), (float*)(ws + OFF_SCWQ), [=](int k, int n) -> float { return src[(size_t)k * 2048 + n]; });
      continue;
    }
    it -= nE;
    if (it < nC) {
      const int br = it >> 5, strip = it & 31;
      const float* src = p.w_branch + (size_t)br * 512 * 1024;
      tconv_strip32<true>(fs, strip * 32, 512, (unsigned char*)(ws + OFF_WB) + (size_t)br * 1024 * 512, (float*)(ws + OFF_SCWB) + br * 32, [=](int k, int n) -> float { return src[(size_t)k * 1024 + n]; });
      continue;
    }
    it -= nC;
    if (it < nD) {
      const float* src = p.w_out;
      tconv_strip32<true>(fs, it * 32, 1024, (unsigned char*)(ws + OFF_WOUT), (float*)(ws + OFF_SCWO), [=](int k, int n) -> float { return src[(size_t)k * 1024 + n]; });
      continue;
    }
    it -= nD;
    if (it < nA) {
      float* sc = fs;
      float* red = fs + 8192;
      for (int i = tid; i < 8192; i += NT) { const float v = p.c[i]; sc[i] = v / (1.0f + __expf(-v)); }
      __syncthreads();
      const int ks = tid >> 5, cj = tid & 31, col = it * 32 + cj;
      float acc[8];
#pragma unroll
      for (int b = 0; b < 8; ++b) acc[b] = 0.f;
#pragma unroll 16
      for (int k = ks * 64; k < ks * 64 + 64; ++k) {
        const float w = p.w_ada[(size_t)k * 6144 + col];
#pragma unroll
        for (int b = 0; b < 8; ++b) acc[b] += sc[b * 1024 + k] * w;
      }
#pragma unroll
      for (int b = 0; b < 8; ++b) red[(ks * 8 + b) * 32 + cj] = acc[b];
      __syncthreads();
      if (tid < 256) {
        const int b = tid >> 5;
        float s = p.b_ada[col];
#pragma unroll
        for (int k2 = 0; k2 < 16; ++k2) s += red[(k2 * 8 + b) * 32 + cj];
        ((float*)(ws + OFF_MOD))[b * 6144 + col] = s;
      }
      continue;
    }
    it -= nA;
    if (it < nI) {
      const int e = it * 512 + tid, pos = e >> 5, i = e & 31;
      const float ang = (float)pos * p.inv_freq[i];
      const double a = (double)ang;
      const double kk = rint(a * 0.15915494309189535);
      const double r = a - kk * 6.283185307179586476925;
      double sn, cs; sincos_d(r, sn, cs);
      ((float*)(ws + OFF_ROPE))[e] = (float)cs;
      ((float*)(ws + OFF_ROPE))[262144 + e] = (float)sn;
      continue;
    }
    it -= nI;
    if (it < nF) {
      const int w = it >> 6, r = it & 63, kt = r >> 1, ntile = r & 1;
      const float* src = p.cmp_w1 + (size_t)w * 2048 * 128;
      tconv_tile(fs, kt * 64, ntile * 64, (bf16_t*)(ws + OFF_CW1) + (size_t)w * 128 * 2048, 2048, [=](int k, int n) -> float {
        const int ksrc = (w == 0) ? ((k & ~63) + dperm(k & 63)) : k;
        return src[(size_t)ksrc * 128 + n]; });
      continue;
    }
    it -= nF;
    if (it < nG) {
      const int w = it >> 1, kt = it & 1;
      const float* src = p.cmp_w2 + (size_t)w * 128 * 64;
      tconv_tile(fs, kt * 64, 0, (bf16_t*)(ws + OFF_CW2) + (size_t)w * 64 * 128, 128, [=](int k, int n) -> float { return src[(size_t)k * 64 + ((w == 0) ? dperm(n) : n)]; });
      continue;
    }
    it -= nG;
    if (it < nH) {
      const int w = it >> 2, jc = it & 3, ks = tid >> 5, cj = tid & 31, j = jc * 32 + cj;
      float* red = fs;
      const float* pos = p.cmp_pos + w * 2048; const float* w1 = p.cmp_w1 + (size_t)w * 2048 * 128;
      float acc = 0.f;
#pragma unroll 16
      for (int k = ks * 128; k < ks * 128 + 128; ++k) acc += pos[k] * w1[(size_t)k * 128 + j];
      red[ks * 32 + cj] = acc;
      __syncthreads();
      if (tid < 32) { float s = p.cmp_b1[w * 128 + j]; for (int k2 = 0; k2 < 16; ++k2) s += red[k2 * 32 + tid]; ((float*)(ws + OFF_POSB))[w * 128 + j] = s; }
      continue;
    }
    it -= nH;
    if (it < nJ) { conv_chunk(p.peer_keys, (bf16_t*)(ws + OFF_PKEYS), (size_t)it * 4096); continue; }
    it -= nJ;
    if (it < nK) {
      const size_t i0 = (size_t)it * 4096 + (size_t)tid * 8;
      const int rowi = (int)((i0 >> 7) & 127), j0 = (int)(i0 & 127);
      float v[8];
#pragma unroll
      for (int j = 0; j < 8; ++j) v[j] = (j0 + j <= rowi) ? p.sgu_w[i0 + j] : 0.f;
      u32x4 w; w.x = pack2(v[0], v[1]); w.y = pack2(v[2], v[3]); w.z = pack2(v[4], v[5]); w.w = pack2(v[6], v[7]);
      *(u32x4*)((bf16_t*)(ws + OFF_SGUW) + i0) = w;
      continue;
    }
    it -= nK;
    {
      const bool isv = it >= nL;
      if (isv) it -= nL;
      const int lane = tid & 63, e0 = it * 32 + (tid >> 6) * 4;
      const float* src = (isv ? p.peer_v : p.peer_u) + (size_t)e0 * 1024 + lane * 16;
      f32x4 raw[4][4];
#pragma unroll
      for (int r = 0; r < 4; ++r)
#pragma unroll
        for (int i = 0; i < 4; ++i) raw[r][i] = *(const f32x4*)(src + (size_t)r * 1024 + i * 4);
#pragma unroll
      for (int r = 0; r < 4; ++r) {
        const int e = e0 + r;
        float v[16];
#pragma unroll
        for (int i = 0; i < 4; ++i) { v[4 * i] = raw[r][i].x; v[4 * i + 1] = raw[r][i].y; v[4 * i + 2] = raw[r][i].z; v[4 * i + 3] = raw[r][i].w; }
        float amax = 0.f;
#pragma unroll
        for (int i = 0; i < 16; ++i) amax = fmaxf(amax, fabsf(v[i]));
        amax = wave_max(amax);
        if (!isv) {
          const float qs = amax > 0.f ? 127.0f / amax : 0.f;
          u32x4 wi; wi.x = pack_i8x4(v[0] * qs, v[1] * qs, v[2] * qs, v[3] * qs); wi.y = pack_i8x4(v[4] * qs, v[5] * qs, v[6] * qs, v[7] * qs);
          wi.z = pack_i8x4(v[8] * qs, v[9] * qs, v[10] * qs, v[11] * qs); wi.w = pack_i8x4(v[12] * qs, v[13] * qs, v[14] * qs, v[15] * qs);
          *(u32x4*)(ws + OFF_PU8 + ((size_t)(lane >> 3) * 16384 + e) * 128 + (lane & 7) * 16) = wi;
          if (lane == 0) ((float*)(ws + OFF_SCU))[2 * e] = amax * (1.0f / 127.0f);
        } else {
          const unsigned be = (__float_as_uint(amax) >> 23) & 0xffu;
          const bool okr = be >= 16u && be <= 240u;
          const float scale = okr ? __uint_as_float((261u - be) << 23) : 1.0f;
          const float inv = okr ? __uint_as_float((be - 7u) << 23) : 1.0f;
          u32x4 w; w.x = pk4_fp8(v[0] * scale, v[1] * scale, v[2] * scale, v[3] * scale); w.y = pk4_fp8(v[4] * scale, v[5] * scale, v[6] * scale, v[7] * scale);
          w.z = pk4_fp8(v[8] * scale, v[9] * scale, v[10] * scale, v[11] * scale); w.w = pk4_fp8(v[12] * scale, v[13] * scale, v[14] * scale, v[15] * scale);
          *(u32x4*)(ws + OFF_PV8 + ((size_t)(lane >> 3) * 16384 + e) * 128 + (lane & 7) * 16) = w;
          if (lane == 0) ((float*)(ws + OFF_SCU))[2 * e + 1] = inv;
        }
      }
    }
  }
}

DI void row_stats(const float (&v)[16], float& mean, float& rstd) {
  float s = 0.f;
#pragma unroll
  for (int i = 0; i < 16; ++i) s += v[i];
  mean = wave_sum(s) * (1.0f / 1024.0f);
  float q = 0.f;
#pragma unroll
  for (int i = 0; i < 16; ++i) { const float d = v[i] - mean; q += d * d; }
  rstd = rsqrtf(wave_sum(q) * (1.0f / 1024.0f) + LN_EPS);
}

DI void phase_ln_in(const Params& p) {
  const int lane = otid() & 63, wave = otid() >> 6;
  const float* mod = (const float*)(p.ws + OFF_MOD);
  unsigned* h8 = (unsigned*)(p.ws + OFF_H);
  for (int grp = blockIdx.x; grp < NTOK / NW; grp += gridDim.x) {
    const int row = grp * NW + wave, b = row >> 13;
    const float* xr = p.x + (size_t)row * DM;
    float v[16];
#pragma unroll
    for (int i = 0; i < 4; ++i) { const f32x4 t = *(const f32x4*)(xr + i * 256 + lane * 4); v[4 * i] = t.x; v[4 * i + 1] = t.y; v[4 * i + 2] = t.z; v[4 * i + 3] = t.w; }
    f32x4 shv[4], scv[4];
#pragma unroll
    for (int i = 0; i < 4; ++i) { shv[i] = *(const f32x4*)(mod + b * 6144 + i * 256 + lane * 4); scv[i] = *(const f32x4*)(mod + b * 6144 + 1024 + i * 256 + lane * 4); }
    float mean, rstd; row_stats(v, mean, rstd);
    float amax = 0.f;
#pragma unroll
    for (int i = 0; i < 4; ++i) {
      const f32x4 sh = shv[i], sc = scv[i];
      const float o0 = (v[4 * i] - mean) * rstd * (1.f + sc.x) + sh.x, o1 = (v[4 * i + 1] - mean) * rstd * (1.f + sc.y) + sh.y;
      const float o2 = (v[4 * i + 2] - mean) * rstd * (1.f + sc.z) + sh.z, o3 = (v[4 * i + 3] - mean) * rstd * (1.f + sc.w) + sh.w;
      v[4 * i] = o0; v[4 * i + 1] = o1; v[4 * i + 2] = o2; v[4 * i + 3] = o3;
      amax = fmaxf(amax, fmaxf(fmaxf(fabsf(o0), fabsf(o1)), fmaxf(fabsf(o2), fabsf(o3))));
    }
    amax = wave_max(amax);
    const float qs = amax > 0.f ? 127.0f / amax : 0.f;
#pragma unroll
    for (int i = 0; i < 4; ++i) h8[(size_t)row * 256 + i * 64 + lane] = pack_i8x4(v[4 * i] * qs, v[4 * i + 1] * qs, v[4 * i + 2] * qs, v[4 * i + 3] * qs);
    if (lane == 0) ((float*)(p.ws + OFF_SA))[row] = amax * (1.0f / 127.0f);
  }
}

DI void phase_ln_mid(const Params& p) {
  const int lane = otid() & 63, wave = otid() >> 6;
  const float* mod = (const float*)(p.ws + OFF_MOD);
  const bf16_t* y = (const bf16_t*)(p.ws + OFF_Y);
  f32x4 gv[4], bv[4];
#pragma unroll
  for (int i = 0; i < 4; ++i) { gv[i] = *(const f32x4*)(p.ln1_g + i * 256 + lane * 4); bv[i] = *(const f32x4*)(p.ln1_b + i * 256 + lane * 4); }
  for (int grp = blockIdx.x; grp < NTOK / NW; grp += gridDim.x) {
    const int row = grp * NW + wave, b = row >> 13;
    const bf16_t* yr = y + (size_t)row * DM;
    float v[16];
#pragma unroll
    for (int i = 0; i < 4; ++i) { const u32x2 t = *(const u32x2*)(yr + i * 256 + lane * 4); v[4 * i] = bflo(t.x); v[4 * i + 1] = bfhi(t.x); v[4 * i + 2] = bflo(t.y); v[4 * i + 3] = bfhi(t.y); }
    f32x4 shv[4], scv[4];
#pragma unroll
    for (int i = 0; i < 4; ++i) { shv[i] = *(const f32x4*)(mod + b * 6144 + 3072 + i * 256 + lane * 4); scv[i] = *(const f32x4*)(mod + b * 6144 + 4096 + i * 256 + lane * 4); }
    float mean, rstd; row_stats(v, mean, rstd);
#pragma unroll
    for (int i = 0; i < 4; ++i) {
      const int col = i * 256 + lane * 4;
      const f32x4 g = gv[i], bb = bv[i];
      f32x4 o;
      o.x = (v[4 * i] - mean) * rstd * g.x + bb.x; o.y = (v[4 * i + 1] - mean) * rstd * g.y + bb.y;
      o.z = (v[4 * i + 2] - mean) * rstd * g.z + bb.z; o.w = (v[4 * i + 3] - mean) * rstd * g.w + bb.w;
      v[4 * i] = o.x; v[4 * i + 1] = o.y; v[4 * i + 2] = o.z; v[4 * i + 3] = o.w;
    }
    row_stats(v, mean, rstd);
    float amax = 0.f;
#pragma unroll
    for (int i = 0; i < 4; ++i) {
      const f32x4 sh = shv[i], sc = scv[i];
      const float o0 = (v[4 * i] - mean) * rstd * (1.f + sc.x) + sh.x, o1 = (v[4 * i + 1] - mean) * rstd * (1.f + sc.y) + sh.y;
      const float o2 = (v[4 * i + 2] - mean) * rstd * (1.f + sc.z) + sh.z, o3 = (v[4 * i + 3] - mean) * rstd * (1.f + sc.w) + sh.w;
      v[4 * i] = o0; v[4 * i + 1] = o1; v[4 * i + 2] = o2; v[4 * i + 3] = o3;
      amax = fmaxf(amax, fmaxf(fmaxf(fabsf(o0), fabsf(o1)), fmaxf(fabsf(o2), fabsf(o3))));
    }
    amax = wave_max(amax);
    const float qs = amax > 0.f ? 127.0f / amax : 0.f;
    unsigned* h2q = (unsigned*)(p.ws + OFF_H2Q);
#pragma unroll
    for (int i = 0; i < 4; ++i) h2q[(size_t)row * 256 + i * 64 + lane] = pack_i8x4(v[4 * i] * qs, v[4 * i + 1] * qs, v[4 * i + 2] * qs, v[4 * i + 3] * qs);
    if (lane == 0) ((float*)(p.ws + OFF_SH))[row] = amax * (1.0f / 127.0f);
  }
}

namespace pg8 {
constexpr int BM = 256, BK = 64, HALF = 128, HTB = HALF * BK * 2, STAGE_BYTES = 8 * HTB, NXCD = 8, WGM = 8;
DI int lds_byte(int r, int c) { const int st = (r >> 4) * 2 + (c >> 5), rr = r & 15, cc = c & 31, ob = rr * 64 + cc * 2; return st * 1024 + (ob ^ (((ob >> 9) & 1) << 5)); }
DI void stage_rc(int b, int& R, int& C) { const int st = b / 1024, sb = b % 1024, swz = sb ^ (((sb >> 9) & 1) << 5); R = (st >> 1) * 16 + swz / 64; C = (st & 1) * 32 + (swz % 64) / 2; }
DI int perm32(int rho) { const int n = rho >> 4, i = rho & 15; return 8 * (i >> 2) + 4 * n + (i & 3); }
struct Unit { int pm, pn; };
struct Gemm { const bf16_t* A; const bf16_t* Bt; int M, N, K; };
struct StaticOrder {
  int nM, nN, nwg, G, c, nr, rot;
  DI void init(int M, int N, int G_, int c_, bool rotate = false) {
    nM = M / BM; nN = N / BM; nwg = nM * nN; G = G_; c = c_;
    nr = (rotate && nwg % G == 0) ? nwg / G : 0; rot = nr ? ((c % NXCD) * nr) / NXCD : 0;
  }
  DI bool next(int i, Unit& u) const {
    if (nr) { if (i >= nr) return false; i += rot; if (i >= nr) i -= nr; }
    const long L = (long)i * G + c; if (L >= nwg) return false;
    int wgid = (int)L; { const int q = nwg / NXCD, r = nwg % NXCD, xcd = wgid % NXCD, off = wgid / NXCD; wgid = (xcd < r ? xcd * (q + 1) : r * (q + 1) + (xcd - r) * q) + off; }
    const int nig = WGM * nN, gid = wgid / nig, fm = gid * WGM, gsz = (nM - fm) < WGM ? (nM - fm) : WGM;
    u.pm = fm + ((wgid % nig) % gsz); u.pn = (wgid % nig) / gsz; return true;
  }
};

template <int MODE, class AccT>
DI AccT mma_pair(bf16x8 b0, bf16x8 b1, bf16x8 a0, bf16x8 a1, AccT c) {
  if constexpr (MODE == 0) { c = __builtin_amdgcn_mfma_f32_16x16x32_bf16(b0, a0, c, 0, 0, 0); return __builtin_amdgcn_mfma_f32_16x16x32_bf16(b1, a1, c, 0, 0, 0); }
  else if constexpr (MODE == 1) {
    c = __builtin_amdgcn_mfma_i32_16x16x64_i8(__builtin_bit_cast(i32x4, b0), __builtin_bit_cast(i32x4, a0), c, 0, 0, 0);
    return __builtin_amdgcn_mfma_i32_16x16x64_i8(__builtin_bit_cast(i32x4, b1), __builtin_bit_cast(i32x4, a1), c, 0, 0, 0);
  } else {
    const i32x8 B = __builtin_shufflevector(__builtin_bit_cast(i32x4, b0), __builtin_bit_cast(i32x4, b1), 0, 1, 2, 3, 4, 5, 6, 7);
    const i32x8 A = __builtin_shufflevector(__builtin_bit_cast(i32x4, a0), __builtin_bit_cast(i32x4, a1), 0, 1, 2, 3, 4, 5, 6, 7);
    asm volatile("v_mfma_f32_16x16x128_f8f6f4 %0, %1, %2, %0" : "+v"(c) : "v"(B), "v"(A));
    return c;
  }
}
DI f32x4 mma16(bf16x8 a, bf16x8 b, f32x4 c) { return __builtin_amdgcn_mfma_f32_16x16x32_bf16(a, b, c, 0, 0, 0); }
DI i32x4 mma16(bf16x8 a, bf16x8 b, i32x4 c) { return __builtin_amdgcn_mfma_i32_16x16x64_i8(__builtin_bit_cast(i32x4, a), __builtin_bit_cast(i32x4, b), c, 0, 0, 0); }
template <class Epi>
DI void gemm_phase(LAS unsigned char* lds, const Gemm g, const StaticOrder& S, const Epi& E) {
  const int tid = otid(), wid = __builtin_amdgcn_readfirstlane(tid >> 6), lane = tid & 63, wr = wid >> 2, wc = wid & 3, fr = lane & 15, fq = lane >> 4;
  const int K = g.K, nt = K / BK;
  unsigned voffA[2], voffB[2];
#pragma unroll
  for (int i = 0; i < 2; ++i) { int R, C; stage_rc(tid * 16 + i * 8192, R, C); const int Rb = Epi::PERM ? ((R & ~31) + perm32(R & 31)) : R;
    voffA[i] = (unsigned)(R * K + C) * 2u; voffB[i] = (unsigned)(Rb * K + C) * 2u; }
  const size_t kstep = (size_t)(BK * 2);
  const size_t hstep = (size_t)HALF * K * 2;
  const size_t tstep = 2 * hstep;
  const unsigned ldsw = (unsigned)wid * 1024u;
  const int aoff = lds_byte(wr * 64 + fr, fq * 8), boff = lds_byte(wc * 32 + fr, fq * 8);
  LAS unsigned char* ldsB = lds + 4 * HTB + boff;
  asm volatile("" : "+v"(ldsB));
#define PG8_SA(b, h) (((b) * 2 + (h)) * HTB)
#define PG8_SB(b, h) ((4 + (b) * 2 + (h)) * HTB)
#define PG8_STAGE(bufoff, gbase, voff) do { _Pragma("unroll") for (int _i = 0; _i < 2; ++_i) \
    __builtin_amdgcn_global_load_lds((const unsigned*)((const char*)(gbase) + (voff)[_i]), (LAS unsigned*)(lds + (bufoff) + ldsw + _i * 8192), 16, 0, 0); } while (0)
#define PG8_LDA(dst, b, h) do { _Pragma("unroll") for (int m = 0; m < 4; ++m) _Pragma("unroll") for (int k = 0; k < 2; ++k) dst[m][k] = *(const LAS bf16x8*)(lds + PG8_SA(b, h) + aoff + m * 2048 + k * 1024); } while (0)
#define PG8_LDB(dst, b, h) do { _Pragma("unroll") for (int n = 0; n < 2; ++n) _Pragma("unroll") for (int k = 0; k < 2; ++k) dst[n][k] = *(const LAS bf16x8*)(ldsB + ((b) * 2 + (h)) * HTB + n * 2048 + k * 1024); } while (0)
#define PG8_MMA(ai, bj, At, Bt) do { __builtin_amdgcn_s_setprio(1); _Pragma("unroll") for (int m = 0; m < 4; ++m) _Pragma("unroll") for (int n = 0; n < 2; ++n) \
    acc[ai][bj][m][n] = mma_pair<Epi::MODE>(Bt[n][0], Bt[n][1], At[m][0], At[m][1], acc[ai][bj][m][n]); __builtin_amdgcn_s_setprio(0); } while (0)
#define PG8_WAIT_V(n) asm volatile("s_waitcnt vmcnt(" #n ")" ::: "memory")
#define PG8_WAIT_L(n) asm volatile("s_waitcnt lgkmcnt(" #n ")" ::: "memory")
#define PG8_BAR __builtin_amdgcn_s_barrier()
#define PG8_SCHED __builtin_amdgcn_sched_barrier(0)
  Unit cur, nxt; int ui = 0;
  if (!S.next(0, cur)) return;
  typedef typename Epi::AccT AccT;
  const AccT zacc = {0, 0, 0, 0};
  AccT acc[2][2][4][2];
#pragma unroll
  for (int a = 0; a < 2; ++a)
#pragma unroll
    for (int b = 0; b < 2; ++b)
#pragma unroll
      for (int m = 0; m < 4; ++m)
#pragma unroll
        for (int n = 0; n < 2; ++n) acc[a][b][m][n] = zacc;
  bf16x8 At[4][2], B0[2][2], B1[2][2];
  const char* cA = (const char*)g.A + (size_t)cur.pm * tstep; const char* cB = (const char*)g.Bt + (size_t)cur.pn * tstep;
  PG8_STAGE(PG8_SB(0, 0), cB, voffB); PG8_STAGE(PG8_SA(0, 0), cA, voffA); PG8_STAGE(PG8_SB(0, 1), cB + hstep, voffB); PG8_STAGE(PG8_SA(0, 1), cA + hstep, voffA);
  if (wr == 1) PG8_BAR;
  PG8_WAIT_V(4); PG8_BAR;
  PG8_STAGE(PG8_SB(1, 0), cB + kstep, voffB); PG8_STAGE(PG8_SA(1, 0), cA + kstep, voffA); PG8_STAGE(PG8_SB(1, 1), cB + hstep + kstep, voffB);
  PG8_WAIT_V(6); PG8_BAR;
  for (;;) {
    const bool has_next = S.next(ui + 1, nxt);
    const char* nA = has_next ? (const char*)g.A + (size_t)nxt.pm * tstep : cA; const char* nB = has_next ? (const char*)g.Bt + (size_t)nxt.pn * tstep : cB;
#pragma unroll 1
    for (int t = 0; t < nt; t += 2) {
      const bool last = (t == nt - 2);
      const char* a1 = cA + (size_t)(t + 1) * kstep;
      const char* a2 = last ? nA : cA + (size_t)(t + 2) * kstep; const char* b2 = last ? nB : cB + (size_t)(t + 2) * kstep;
      const char* a3 = a2 + kstep; const char* b3 = b2 + kstep;
      PG8_LDB(B0, 0, 0); PG8_SCHED; PG8_LDA(At, 0, 0); PG8_STAGE(PG8_SA(1, 1), a1 + hstep, voffA);
      PG8_WAIT_L(8); PG8_BAR; PG8_WAIT_L(0); PG8_MMA(0, 0, At, B0); PG8_BAR; PG8_SCHED;
      PG8_LDB(B1, 0, 1); PG8_STAGE(PG8_SB(0, 0), b2, voffB);
      PG8_BAR; PG8_WAIT_L(0); PG8_MMA(0, 1, At, B1); PG8_BAR;
      PG8_LDA(At, 0, 1); PG8_STAGE(PG8_SA(0, 0), a2, voffA);
      PG8_BAR; PG8_WAIT_L(0); PG8_MMA(1, 0, At, B0); PG8_BAR; PG8_SCHED;
      PG8_STAGE(PG8_SB(0, 1), b2 + hstep, voffB);
      PG8_WAIT_V(6); PG8_BAR; PG8_MMA(1, 1, At, B1); PG8_BAR;
      PG8_LDB(B0, 1, 0); PG8_SCHED; PG8_LDA(At, 1, 0); PG8_STAGE(PG8_SA(0, 1), a2 + hstep, voffA);
      PG8_WAIT_L(8); PG8_BAR; PG8_WAIT_L(0); PG8_MMA(0, 0, At, B0); PG8_BAR; PG8_SCHED;
      PG8_LDB(B1, 1, 1); PG8_STAGE(PG8_SB(1, 0), b3, voffB);
      PG8_BAR; PG8_WAIT_L(0); PG8_MMA(0, 1, At, B1); PG8_BAR;
      PG8_LDA(At, 1, 1); PG8_STAGE(PG8_SA(1, 0), a3, voffA);
      PG8_BAR; PG8_WAIT_L(0); PG8_MMA(1, 0, At, B0); PG8_BAR; PG8_SCHED;
      PG8_STAGE(PG8_SB(1, 1), b3 + hstep, voffB);
      PG8_WAIT_V(6); PG8_BAR; PG8_MMA(1, 1, At, B1); PG8_BAR;
    }
    PG8_SCHED;
    if constexpr (Epi::MODE == 2) asm volatile("s_nop 15\n\ts_nop 15\n\ts_nop 15\n\ts_nop 15" ::: "memory");
    { const int l2 = otid() & 63; E(acc, cur, wr, wc, l2 & 15, l2 >> 4); }
    PG8_SCHED;
    if (!has_next) break;
#pragma unroll
    for (int a = 0; a < 2; ++a)
#pragma unroll
      for (int b = 0; b < 2; ++b)
#pragma unroll
        for (int m = 0; m < 4; ++m)
#pragma unroll
          for (int n = 0; n < 2; ++n) acc[a][b][m][n] = zacc;
    cur = nxt; cA = nA; cB = nB; ++ui;
  }
  PG8_WAIT_V(0);
  if (wr == 0) PG8_BAR;
  PG8_BAR;
#undef PG8_SA
#undef PG8_SB
#undef PG8_STAGE
#undef PG8_LDA
#undef PG8_LDB
#undef PG8_MMA
#undef PG8_WAIT_V
#undef PG8_WAIT_L
#undef PG8_BAR
#undef PG8_SCHED
}
}

struct EpiProj {
  static constexpr bool PERM = true;
  static constexpr int MODE = 1;
  typedef i32x4 AccT;
  char* ws; const float* b_merge;
  DI void operator()(const i32x4 (&acc)[2][2][4][2], const pg8::Unit& u, int wr, int wc, int fr, int fq) const {
    const float* rope = (const float*)(ws + OFF_ROPE);
    const float* sa = (const float*)(ws + OFF_SA); const float* sw = (const float*)(ws + OFF_SCW1);
    const int row0 = u.pm * 256 + wr * 64 + fr;
    float ras[2][4];
#pragma unroll
    for (int ai = 0; ai < 2; ++ai)
#pragma unroll
      for (int m = 0; m < 4; ++m) ras[ai][m] = sa[row0 + ai * 128 + m * 16];
#pragma unroll
    for (int bj = 0; bj < 2; ++bj) {
      const int cg = u.pn * 256 + bj * 128 + wc * 32;
      const int c0 = cg + 8 * fq;
      if (cg >= 4384) continue;
      const float sbg = sw[cg >> 5];
#define EPJ_CV(sc_) const float f_ = ras[ai][m] * (sc_); const f32x4 cv0 = __builtin_convertvector(acc[ai][bj][m][0], f32x4) * f_, cv1 = __builtin_convertvector(acc[ai][bj][m][1], f32x4) * f_;
      if (cg < 1280 && (cg < 640 || (cg >= 768 && cg < 896) || (cg >= 1024 && cg < 1152))) {
        bf16_t* dst; unsigned ld, cofs; float scale = 1.0f;
        if (cg < 512) { dst = (bf16_t*)(ws + OFF_Q); ld = 512; cofs = c0; scale = 0.18033688011112042f; }
        else if (cg < 640) { dst = (bf16_t*)(ws + OFF_KC); ld = 128; cofs = c0 - 512; }
        else if (cg < 896) { dst = (bf16_t*)(ws + OFF_KS); ld = 128; cofs = c0 - 768; scale = 0.0625f; }
        else { dst = (bf16_t*)(ws + OFF_KW); ld = 128; cofs = c0 - 1024; }
        const int d0 = 16 * ((cg >> 5) & 1) + 4 * fq;
        f32x4 csv[2][4], snv[2][4];
#pragma unroll
        for (int ai = 0; ai < 2; ++ai)
#pragma unroll
          for (int m = 0; m < 4; ++m) { const int pos = (row0 + ai * 128 + m * 16) & (SEQ - 1); csv[ai][m] = *(const f32x4*)(rope + pos * 32 + d0); snv[ai][m] = *(const f32x4*)(rope + 262144 + pos * 32 + d0); }
#pragma unroll
        for (int ai = 0; ai < 2; ++ai)
#pragma unroll
          for (int m = 0; m < 4; ++m) {
            const int row = row0 + ai * 128 + m * 16;
            const f32x4 cs = csv[ai][m], sn = snv[ai][m];
            EPJ_CV(sbg * scale)
            const f32x4 o1 = cv0 * cs - cv1 * sn, o2 = cv0 * sn + cv1 * cs;
            if (cg >= 768 && cg < 896) {
              u32x2 w8; w8.x = pk4_fp8(clamp_f8(o1.x), clamp_f8(o1.y), clamp_f8(o1.z), clamp_f8(o1.w)); w8.y = pk4_fp8(clamp_f8(o2.x), clamp_f8(o2.y), clamp_f8(o2.z), clamp_f8(o2.w));
              *(u32x2*)((unsigned char*)dst + (unsigned)row * 128u + cofs) = w8;
            } else {
              u32x4 w; w.x = pack2(o1.x, o1.y); w.y = pack2(o1.z, o1.w); w.z = pack2(o2.x, o2.y); w.w = pack2(o2.z, o2.w);
              *(u32x4*)(dst + (unsigned)row * ld + cofs) = w;
            }
          }
      } else if (cg < 1280) {
        bf16_t* dst; unsigned cofs;
        if (cg < 768) { dst = (bf16_t*)(ws + OFF_VC); cofs = c0 - 640; }
        else if (cg < 1024) { dst = (bf16_t*)(ws + OFF_VS); cofs = c0 - 896; }
        else { dst = (bf16_t*)(ws + OFF_VW); cofs = c0 - 1152; }
#pragma unroll
        for (int ai = 0; ai < 2; ++ai)
#pragma unroll
          for (int m = 0; m < 4; ++m) {
            const int row = row0 + ai * 128 + m * 16;
            EPJ_CV(sbg)
            const f32x4 a = cv0, b = cv1;
            if (cg >= 896 && cg < 1024) {
              u32x2 w8; w8.x = pk4_fp8(clamp_f8(a.x), clamp_f8(a.y), clamp_f8(a.z), clamp_f8(a.w)); w8.y = pk4_fp8(clamp_f8(b.x), clamp_f8(b.y), clamp_f8(b.z), clamp_f8(b.w));
              *(u32x2*)((unsigned char*)dst + (unsigned)row * 128u + cofs) = w8;
            } else {
              u32x4 w; w.x = pack2(a.x, a.y); w.y = pack2(a.z, a.w); w.z = pack2(b.x, b.y); w.w = pack2(b.z, b.w);
              *(u32x4*)(dst + (unsigned)row * 128u + cofs) = w;
            }
          }
      } else if (cg < 2304) {
        bf16_t* dst = (bf16_t*)(ws + (cg < 1792 ? OFF_U : OFF_V));
        const unsigned cofs = c0 - (cg < 1792 ? 1280 : 1792);
#pragma unroll
        for (int ai = 0; ai < 2; ++ai)
#pragma unroll
          for (int m = 0; m < 4; ++m) {
            const int row = row0 + ai * 128 + m * 16;
            EPJ_CV(sbg)
            const f32x4 a = cv0, b = cv1;
            const f32x2 g0 = gelu_pk((f32x2){a.x, a.y}), g1 = gelu_pk((f32x2){a.z, a.w}), g2 = gelu_pk((f32x2){b.x, b.y}), g3 = gelu_pk((f32x2){b.z, b.w});
            u32x4 w; w.x = pack2(g0.x, g0.y); w.y = pack2(g1.x, g1.y); w.z = pack2(g2.x, g2.y); w.w = pack2(g3.x, g3.y);
            *(u32x4*)(dst + (unsigned)row * 512u + cofs) = w;
          }
      } else if (cg < 4352) {
        unsigned char* dst = (unsigned char*)(ws + OFF_GATE8);
        const unsigned cofs = c0 - 2304;
        const f32x4 b0 = *(const f32x4*)(b_merge + cofs) * -1.4426950408889634f, b1 = *(const f32x4*)(b_merge + cofs + 4) * -1.4426950408889634f;
        const float sbn = sbg * -1.4426950408889634f;
#define EPJ_SG(x_) __builtin_amdgcn_rcpf(1.0f + __builtin_amdgcn_exp2f(x_))
#pragma unroll
        for (int ai = 0; ai < 2; ++ai)
#pragma unroll
          for (int m = 0; m < 4; ++m) {
            const int row = row0 + ai * 128 + m * 16;
            const float f_ = ras[ai][m] * sbn;
            const f32x4 a = __builtin_convertvector(acc[ai][bj][m][0], f32x4) * f_ + b0, b = __builtin_convertvector(acc[ai][bj][m][1], f32x4) * f_ + b1;
            u32x2 w; w.x = pk4_fp8(EPJ_SG(a.x), EPJ_SG(a.y), EPJ_SG(a.z), EPJ_SG(a.w));
            w.y = pk4_fp8(EPJ_SG(b.x), EPJ_SG(b.y), EPJ_SG(b.z), EPJ_SG(b.w));
            *(u32x2*)(dst + (unsigned)row * 2048u + cofs) = w;
          }
      } else {
        float* gs = (float*)(ws + OFF_GSIG);
        if (fq < 3) {
#pragma unroll
          for (int ai = 0; ai < 2; ++ai)
#pragma unroll
            for (int m = 0; m < 4; ++m) {
              const int row = row0 + ai * 128 + m * 16;
              EPJ_CV(sbg)
              const f32x4 a = cv0, b = cv1;
              f32x4 o0, o1; o0.x = sigmoid_f(a.x); o0.y = sigmoid_f(a.y); o0.z = sigmoid_f(a.z); o0.w = sigmoid_f(a.w);
              o1.x = sigmoid_f(b.x); o1.y = sigmoid_f(b.y); o1.z = sigmoid_f(b.z); o1.w = sigmoid_f(b.w);
              *(f32x4*)(gs + (unsigned)row * 32u + 8 * fq) = o0; *(f32x4*)(gs + (unsigned)row * 32u + 8 * fq + 4) = o1;
            }
        }
      }
    }
  }
};
DI void phase_gemm1(const Params& p, char* smem) {
  pg8::Gemm g{(const bf16_t*)(p.ws + OFF_H), (const bf16_t*)(p.ws + OFF_WT1), NTOK, N1, 512};
  pg8::StaticOrder S; S.init(NTOK, N1, gridDim.x, blockIdx.x, true);
  EpiProj E{p.ws, p.b_merge};
  pg8::gemm_phase((LAS unsigned char*)smem, g, S, E);
}

template <int BR> struct EpiMerge {
  static constexpr bool PERM = true;
  static constexpr int MODE = 2;
  typedef f32x4 AccT;
  char* ws;
  DI void operator()(const f32x4 (&acc)[2][2][4][2], const pg8::Unit& u, int wr, int wc, int fr, int fq) const {
    const unsigned char* gate = (const unsigned char*)(ws + OFF_GATE8);
    unsigned char* m0 = (unsigned char*)(ws + OFF_M08);
    unsigned char* mrg = (unsigned char*)(ws + OFF_MRG8);
    const float* sw = (const float*)(ws + OFF_SCWB) + BR * 32;
    const int row0 = u.pm * 256 + wr * 64 + fr;
    u32x2 gq[2][2][4], oq[2][2][4];
#pragma unroll
    for (int bj = 0; bj < 2; ++bj) {
      const unsigned c0 = u.pn * 256 + bj * 128 + wc * 32 + 8 * fq;
#pragma unroll
      for (int ai = 0; ai < 2; ++ai)
#pragma unroll
        for (int m = 0; m < 4; ++m) {
          const unsigned row = row0 + ai * 128 + m * 16;
          gq[bj][ai][m] = *(const u32x2*)(gate + row * 2048u + BR * 1024 + c0);
          if (BR == 1) oq[bj][ai][m] = *(const u32x2*)(m0 + row * 1024u + c0);
        }
    }
#pragma unroll
    for (int bj = 0; bj < 2; ++bj) {
      const unsigned cgp = u.pn * 256 + bj * 128 + wc * 32, c0 = cgp + 8 * fq;
      const float f = sw[cgp >> 5] * (BR == 0 ? 1.0f : 2.0f);
#pragma unroll
      for (int ai = 0; ai < 2; ++ai)
#pragma unroll
        for (int m = 0; m < 4; ++m) {
          const unsigned row = row0 + ai * 128 + m * 16;
          float gg[8]; unpack8_fp8(gq[bj][ai][m], gg);
          const f32x4 a = acc[ai][bj][m][0] * f, b = acc[ai][bj][m][1] * f;
          float v[8] = {a.x * gg[0], a.y * gg[1], a.z * gg[2], a.w * gg[3], b.x * gg[4], b.y * gg[5], b.z * gg[6], b.w * gg[7]};
          if (BR == 1) {
            float old[8]; unpack8_fp8(oq[bj][ai][m], old);
#pragma unroll
            for (int j = 0; j < 8; ++j) v[j] += old[j];
          }
#pragma unroll
          for (int j = 0; j < 8; ++j) v[j] = clamp_f8(v[j]);
          u32x2 w; w.x = pk4_fp8(v[0], v[1], v[2], v[3]); w.y = pk4_fp8(v[4], v[5], v[6], v[7]);
          *(u32x2*)((BR == 0 ? m0 : mrg) + row * 1024u + c0) = w;
        }
    }
  }
};
DI void phase_merge(const Params& p, char* smem) {
  pg8::StaticOrder S; S.init(NTOK, 1024, gridDim.x, blockIdx.x);
  {
    pg8::Gemm g{(const bf16_t*)(p.ws + OFF_ONSA8), (const bf16_t*)(p.ws + OFF_WB), NTOK, 1024, 256};
    EpiMerge<0> E{p.ws};
    pg8::gemm_phase((LAS unsigned char*)smem, g, S, E);
  }
  {
    pg8::Gemm g{(const bf16_t*)(p.ws + OFF_OSGU8), (const bf16_t*)(p.ws + OFF_WB + (size_t)1024 * 512), NTOK, 1024, 256};
    EpiMerge<1> E{p.ws};
    pg8::gemm_phase((LAS unsigned char*)smem, g, S, E);
  }
}

struct EpiOut {
  static constexpr bool PERM = true;
  static constexpr int MODE = 2;
  typedef f32x4 AccT;
  char* ws; const float* x;
  DI void operator()(const f32x4 (&acc)[2][2][4][2], const pg8::Unit& u, int wr, int wc, int fr, int fq) const {
    const float* mod = (const float*)(ws + OFF_MOD);
    bf16_t* y = (bf16_t*)(ws + OFF_Y);
    const int row0 = u.pm * 256 + wr * 64 + fr, b = (u.pm * 256) >> 13;
#pragma unroll
    for (int bj = 0; bj < 2; ++bj) {
      const unsigned c0 = u.pn * 256 + bj * 128 + wc * 32 + 8 * fq;
      const float f = ((const float*)(ws + OFF_SCWO))[c0 >> 5] * 0.0625f;
      const f32x4 g0 = *(const f32x4*)(mod + b * 6144 + 2048 + c0) * f, g1 = *(const f32x4*)(mod + b * 6144 + 2048 + c0 + 4) * f;
      f32x4 xa[2][4], xb[2][4];
#pragma unroll
      for (int ai = 0; ai < 2; ++ai)
#pragma unroll
        for (int m = 0; m < 4; ++m) { const unsigned o = (unsigned)(row0 + ai * 128 + m * 16) * 1024u + c0; xa[ai][m] = *(const f32x4*)(x + o); xb[ai][m] = *(const f32x4*)(x + o + 4); }
#pragma unroll
      for (int ai = 0; ai < 2; ++ai)
#pragma unroll
        for (int m = 0; m < 4; ++m) {
          const unsigned o = (unsigned)(row0 + ai * 128 + m * 16) * 1024u + c0;
          const f32x4 x0 = xa[ai][m], x1v = xb[ai][m];
          const f32x4 v0 = x0 * DN_ALPHA + g0 * acc[ai][bj][m][0], v1 = x1v * DN_ALPHA + g1 * acc[ai][bj][m][1];
          u32x4 w; w.x = pack2(v0.x, v0.y); w.y = pack2(v0.z, v0.w); w.z = pack2(v1.x, v1.y); w.w = pack2(v1.z, v1.w);
          *(u32x4*)(y + o) = w;
        }
    }
  }
};
DI void phase_outproj(const Params& p, char* smem) {
  pg8::Gemm g{(const bf16_t*)(p.ws + OFF_MRG8), (const bf16_t*)(p.ws + OFF_WOUT), NTOK, 1024, 512};
  pg8::StaticOrder S; S.init(NTOK, 1024, gridDim.x, blockIdx.x);
  EpiOut E{p.ws, p.x};
  pg8::gemm_phase((LAS unsigned char*)smem, g, S, E);
}

struct EpiPq {
  static constexpr bool PERM = true;
  static constexpr int MODE = 1;
  typedef i32x4 AccT;
  char* ws;
  DI void operator()(const i32x4 (&acc)[2][2][4][2], const pg8::Unit& u, int wr, int wc, int fr, int fq) const {
    bf16_t* pq = (bf16_t*)(ws + OFF_PQ);
    const float* sh = (const float*)(ws + OFF_SH); const float* sq = (const float*)(ws + OFF_SCWQ);
    const int row0 = u.pm * 256 + wr * 64 + fr;
#pragma unroll
    for (int bj = 0; bj < 2; ++bj) {
      const unsigned c0 = u.pn * 256 + bj * 128 + wc * 32 + 8 * fq;
      const float sbg = sq[(u.pn * 256 + bj * 128 + wc * 32) >> 5];
      float rsh[2][4];
#pragma unroll
      for (int ai = 0; ai < 2; ++ai)
#pragma unroll
        for (int m = 0; m < 4; ++m) rsh[ai][m] = sh[row0 + ai * 128 + m * 16];
#pragma unroll
      for (int ai = 0; ai < 2; ++ai)
#pragma unroll
        for (int m = 0; m < 4; ++m) {
          const float f_ = rsh[ai][m] * sbg;
          const f32x4 a = __builtin_convertvector(acc[ai][bj][m][0], f32x4) * f_, b = __builtin_convertvector(acc[ai][bj][m][1], f32x4) * f_;
          u32x4 w; w.x = pack2(a.x, a.y); w.y = pack2(a.z, a.w); w.z = pack2(b.x, b.y); w.w = pack2(b.z, b.w);
          *(u32x4*)(pq + (unsigned)(row0 + ai * 128 + m * 16) * 2048u + c0) = w;
        }
    }
  }
};
DI void phase_peerq(const Params& p, char* smem) {
  pg8::Gemm g{(const bf16_t*)(p.ws + OFF_H2Q), (const bf16_t*)(p.ws + OFF_WQ), NTOK, 2048, 512};
  pg8::StaticOrder S; S.init(NTOK, 2048, gridDim.x, blockIdx.x);
  EpiPq E{p.ws};
  pg8::gemm_phase((LAS unsigned char*)smem, g, S, E);
}

DI void phase_sgu(const Params& p, char* smem) {
  char* ws = p.ws;
  const int tid = otid(), lane = tid & 63, wave = tid >> 6, l31 = lane & 31, hh = lane >> 5;
  const bf16_t* u = (const bf16_t*)(ws + OFF_U);
  const bf16_t* v = (const bf16_t*)(ws + OFF_V);
  const bf16_t* W = (const bf16_t*)(ws + OFF_SGUW);
  float* st = (float*)smem;
  bf16_t* vn = (bf16_t*)(smem + 1024);
  constexpr int LN_ = 72;
  const int dt = wave & 1, it = wave >> 1;
  const int gi = lane >> 4, i16 = lane & 15, tq = i16 >> 2, tp = i16 & 3;
  for (int item = blockIdx.x; item < NTOK / 128; item += gridDim.x) {
    const int t0 = item * 128;
    __syncthreads();
    u32x4 rawst[16];
#pragma unroll
    for (int i = 0; i < 16; ++i) rawst[i] = *(const u32x4*)(v + (size_t)(t0 + wave * 16 + i) * 512 + lane * 8);
#pragma unroll
    for (int i = 0; i < 16; ++i) {
      const int t = wave * 16 + i;
      float f[8]; unpack8(rawst[i], f);
      float s = 0.f;
#pragma unroll
      for (int j = 0; j < 8; ++j) s += f[j];
      const float mean = wave_sum(s) * (1.f / 512.f);
      float q = 0.f;
#pragma unroll
      for (int j = 0; j < 8; ++j) { const float d = f[j] - mean; q += d * d; }
      const float rstd = rsqrtf(wave_sum(q) * (1.f / 512.f) + LN_EPS);
      if (lane == 0) { st[t * 2] = mean; st[t * 2 + 1] = rstd; }
    }
    u32x4 vnext[2];
#pragma unroll
    for (int i = 0; i < 2; ++i) { const int idx = tid + i * NT; vnext[i] = *(const u32x4*)(v + (size_t)(t0 + (idx >> 3)) * 512 + (idx & 7) * 8); }
    for (int g = 0; g < 8; ++g) {
      u32x4 vcur[2] = {vnext[0], vnext[1]};
      if (g + 1 < 8) {
#pragma unroll
        for (int i = 0; i < 2; ++i) { const int idx = tid + i * NT; vnext[i] = *(const u32x4*)(v + (size_t)(t0 + (idx >> 3)) * 512 + (g + 1) * 64 + (idx & 7) * 8); }
      }
      u32x2 uold[4];
      {
        const bf16_t* urow0 = u + (size_t)(t0 + it * 32 + l31) * 512 + g * 64 + dt * 32 + 4 * hh;
#pragma unroll
        for (int q4 = 0; q4 < 4; ++q4) uold[q4] = *(const u32x2*)(urow0 + 8 * q4);
      }
      bf16x8 bwv[8];
      {
        const bf16_t* wrow0 = W + ((size_t)g * 128 + it * 32 + l31) * 128 + hh * 8;
#pragma unroll
        for (int ks = 0; ks < 8; ++ks) bwv[ks] = *(const bf16x8*)(wrow0 + ks * 16);
      }
      lds_barrier();
#pragma unroll
      for (int i = 0; i < 2; ++i) {
        const int idx = tid + i * NT, j = idx >> 3, dc = (idx & 7) * 8;
        const u32x4 raw = vcur[i];
        const float mean = st[j * 2], rstd = st[j * 2 + 1];
        float f[8], gg[8], bb[8]; unpack8(raw, f); ld8(p.sgu_ln_g + g * 64 + dc, gg); ld8(p.sgu_ln_b + g * 64 + dc, bb);
#pragma unroll
        for (int k = 0; k < 8; ++k) f[k] = (f[k] - mean) * rstd * gg[k] + bb[k];
        *(u32x4*)(vn + j * LN_ + dc) = pack8(f);
      }
      lds_barrier();
      f32x16 acc;
#pragma unroll
      for (int r = 0; r < 16; ++r) acc[r] = 0.f;
      const int itu = __builtin_amdgcn_readfirstlane(it);
      const LAS bf16_t* vbase = (const LAS bf16_t*)vn + (8 * (gi >> 1) + tq) * LN_ + dt * 32 + 16 * (gi & 1) + 4 * tp;
#pragma unroll
      for (int ks = 0; ks < 8; ++ks) {
        if (ks <= 2 * itu + 1) {
          const LAS bf16_t* vp = vbase + (ks * 16) * LN_;
          const s16x4 lo = __builtin_amdgcn_ds_read_tr16_b64_v4i16((LAS s16x4*)vp);
          const s16x4 hi = __builtin_amdgcn_ds_read_tr16_b64_v4i16((LAS s16x4*)(vp + 4 * LN_));
          acc = MFMA32(__builtin_shufflevector(lo, hi, 0, 1, 2, 3, 4, 5, 6, 7), bwv[ks], acc);
        }
      }
      const int i = it * 32 + l31;
      const float bsv = p.sgu_b[g * 128 + i];
      unsigned char* orow = (unsigned char*)(ws + OFF_OSGU8) + (size_t)(t0 + i) * 512 + g * 64 + dt * 32 + 4 * hh;
#pragma unroll
      for (int q4 = 0; q4 < 4; ++q4) {
        const u32x2 old = uold[q4];
        *(unsigned*)(orow + 8 * q4) = pk4_fp8(clamp_f8(8.0f * bflo(old.x) * (acc[4 * q4] + bsv)), clamp_f8(8.0f * bfhi(old.x) * (acc[4 * q4 + 1] + bsv)),
                                              clamp_f8(8.0f * bflo(old.y) * (acc[4 * q4 + 2] + bsv)), clamp_f8(8.0f * bfhi(old.y) * (acc[4 * q4 + 3] + bsv)));
      }
    }
  }
}

DI void phase_compress(const Params& p, char* smem) {
  char* ws = p.ws;
  const int tid = otid(), lane = tid & 63, wave = tid >> 6, l31 = lane & 31, hh = lane >> 5;
  bf16_t* hid = (bf16_t*)smem;
  constexpr int LH = 136;
  for (int item = blockIdx.x; item < 256; item += gridDim.x) {
    const int w = item >> 7, R0 = (item & 127) * 64;
    const bf16_t* src = (const bf16_t*)(ws + (w == 0 ? OFF_KC : OFF_VC));
    const bf16_t* W1 = (const bf16_t*)(ws + OFF_CW1) + (size_t)w * 128 * 2048;
    const bf16_t* W2 = (const bf16_t*)(ws + OFF_CW2) + (size_t)w * 64 * 128;
    const float* posb = (const float*)(ws + OFF_POSB) + w * 128;
    const int mi = wave >> 2, cgp = wave & 3;
    const bf16_t* abase;
    {
      const int R = R0 + mi * 32 + l31, bg = R >> 9, n = R & 511, nn = n < 510 ? n : 510;
      abase = src + ((size_t)((bg >> 1) * SEQ + 16 * nn)) * 128 + (bg & 1) * 64 + hh * 8;
    }
    const bf16_t* bbase = W1 + (size_t)(cgp * 32 + l31) * 2048 + hh * 8;
    f32x16 acc;
#pragma unroll
    for (int r = 0; r < 16; ++r) acc[r] = 0.f;
#pragma unroll 1
    for (int kb = 0; kb < 128; kb += 16) {
      bf16x8 av[16], bv[16];
#pragma unroll
      for (int j = 0; j < 16; ++j) { const int ks = kb + j; av[j] = *(const bf16x8*)(abase + (ks >> 2) * 128 + (ks & 3) * 16); bv[j] = *(const bf16x8*)(bbase + ks * 16); }
      __builtin_amdgcn_sched_barrier(0);
#pragma unroll
      for (int j = 0; j < 16; ++j) acc = MFMA32(av[j], bv[j], acc);
      __builtin_amdgcn_sched_barrier(0);
    }
    __syncthreads();
    {
      const float pb = posb[cgp * 32 + l31];
#pragma unroll
      for (int r = 0; r < 16; ++r) {
        const int row = mi * 32 + (r & 3) + 8 * (r >> 2) + 4 * hh;
        hid[row * LH + cgp * 32 + l31] = f2bf(gelu_f(acc[r] + pb));
      }
    }
    __syncthreads();
    if (wave < 4) {
      const int mi2 = wave >> 1, ni = wave & 1;
      bf16x8 b2v[8];
#pragma unroll
      for (int ks = 0; ks < 8; ++ks) b2v[ks] = *(const bf16x8*)(W2 + (size_t)(ni * 32 + l31) * 128 + ks * 16 + hh * 8);
      f32x16 o;
#pragma unroll
      for (int r = 0; r < 16; ++r) o[r] = 0.f;
#pragma unroll
      for (int ks = 0; ks < 8; ++ks) {
        const bf16x8 a = *(const bf16x8*)(hid + (mi2 * 32 + l31) * LH + ks * 16 + hh * 8);
        o = MFMA32(a, b2v[ks], o);
      }
      const int d = ni * 32 + l31;
      const float b2 = p.cmp_b2[w * 64 + (w == 0 ? dperm(d) : d)];
      const int bg = R0 >> 9;
      bf16_t* dst = (bf16_t*)(ws + (w == 0 ? OFF_KCMP : OFF_VCMP));
#pragma unroll
      for (int r = 0; r < 16; ++r) {
        const int n = (R0 & 511) + mi2 * 32 + (r & 3) + 8 * (r >> 2) + 4 * hh;
        dst[((size_t)bg * 512 + n) * 64 + d] = f2bf(n < 511 ? o[r] + b2 : 0.f);
      }
    }
  }
}

constexpr int LK = 72;
constexpr int NSA_TILE = 18432;
constexpr int NSA_AIMP = 3 * NSA_TILE, NSA_CIMP = NSA_AIMP + 32768, NSA_SELM = NSA_CIMP + 32768;
constexpr float NSA_THR = 6.0f;
struct TileRegs { u32x4 k; u32x4 v; };

DI void nsa_load_tile(TileRegs& t, const bf16_t* kbase, size_t kstride, const bf16_t* vbase, size_t vstride) {
  const int tid = otid(), r = tid >> 3, ch = tid & 7;
  t.k = *(const u32x4*)(kbase + (size_t)r * kstride + ch * 8);
  t.v = *(const u32x4*)(vbase + (size_t)r * vstride + ch * 8);
}
DI void nsa_store_tile(const TileRegs& t, char* tile) {
  const int tid = otid(), r = tid >> 3, ch = tid & 7;
  *(u32x4*)((bf16_t*)tile + r * LK + ch * 8) = t.k;
  *(u32x4*)((bf16_t*)(tile + 9216) + r * LK + ch * 8) = t.v;
}
DI void nsa_scores(f32x16 (&st)[2], const char* tile, const bf16x8 (&qf)[4], int lane) {
  const bf16_t* Ks = (const bf16_t*)tile;
#pragma unroll
  for (int kt = 0; kt < 2; ++kt)
#pragma unroll
    for (int r = 0; r < 16; ++r) st[kt][r] = 0.f;
  __builtin_amdgcn_s_setprio(1);
#pragma unroll
  for (int ks = 0; ks < 4; ++ks)
#pragma unroll
    for (int kt = 0; kt < 2; ++kt) {
      const bf16x8 a = *(const bf16x8*)(Ks + (kt * 32 + (lane & 31)) * LK + ks * 16 + (lane >> 5) * 8);
      st[kt] = MFMA32(a, qf[ks], st[kt]);
    }
  __builtin_amdgcn_s_setprio(0);
}
DI void nsa_pv(f32x16 (&o)[2], const f32x16 (&pt)[2], const char* tile, int lane) {
  const int gi = lane >> 4, i16 = lane & 15, q = i16 >> 2, pp = i16 & 3;
  const LAS bf16_t* Vs = (const LAS bf16_t*)(tile + 9216) + (4 * (gi >> 1) + q) * LK + 16 * (gi & 1) + 4 * pp;
#pragma unroll
  for (int kt = 0; kt < 2; ++kt)
#pragma unroll
    for (int s = 0; s < 2; ++s) {
      u32x4 pk; pk.x = pack2(pt[kt][8 * s], pt[kt][8 * s + 1]); pk.y = pack2(pt[kt][8 * s + 2], pt[kt][8 * s + 3]);
      pk.z = pack2(pt[kt][8 * s + 4], pt[kt][8 * s + 5]); pk.w = pack2(pt[kt][8 * s + 6], pt[kt][8 * s + 7]);
      const bf16x8 pb = __builtin_bit_cast(bf16x8, pk);
      bf16x8 a[2];
#pragma unroll
      for (int dt = 0; dt < 2; ++dt) {
        const LAS bf16_t* vp = Vs + (kt * 32 + 16 * s) * LK + dt * 32;
        const s16x4 lo = __builtin_amdgcn_ds_read_tr16_b64_v4i16((LAS s16x4*)vp);
        const s16x4 hi = __builtin_amdgcn_ds_read_tr16_b64_v4i16((LAS s16x4*)(vp + 8 * LK));
        a[dt] = __builtin_shufflevector(lo, hi, 0, 1, 2, 3, 4, 5, 6, 7);
      }
      o[0] = MFMA32(a[0], pb, o[0]); o[1] = MFMA32(a[1], pb, o[1]);
    }
}

constexpr float NSA_NEG = -3.0e38f;
DI void nsa_online(f32x16 (&st)[2], bool sel, float& m, float& l, f32x16 (&o)[2], const char* tile, int lane) {
  float mx = NSA_NEG;
#pragma unroll
  for (int r = 0; r < 16; ++r) mx = fmaxf(mx, fmaxf(st[0][r], st[1][r]));
  mx = fmaxf(mx, xor32f(mx, lane));
  mx = sel ? mx : NSA_NEG;
  if (__any(mx > m + NSA_THR)) {
    const float mn = fmaxf(m, mx);
    const float alpha = __builtin_amdgcn_exp2f(m - mn);
    m = mn; l *= alpha;
#pragma unroll
    for (int r = 0; r < 16; ++r) { o[0][r] *= alpha; o[1][r] *= alpha; }
  }
  const float ms = sel ? m : 1e30f;
  float sum = 0.f;
#pragma unroll
  for (int r = 0; r < 16; ++r) {
    const float p0 = __builtin_amdgcn_exp2f(st[0][r] - ms), p1 = __builtin_amdgcn_exp2f(st[1][r] - ms);
    st[0][r] = p0; st[1][r] = p1; sum += p0 + p1;
  }
  l += sum;
  nsa_pv(o, st, tile, lane);
}

struct NsaItem { int qb, b, g, bg, t; size_t tokrow; };
DI NsaItem nsa_item(int item0, int wave, int qi) {
  const int G = gridDim.x, k = item0 / G, bb = item0 - k * G;
  const int item = (k & 1) ? (k * G + (G - 1 - bb)) : item0;
  NsaItem it; it.qb = 127 - (item >> 4); const int rest = item & 15; it.b = rest >> 1; it.g = rest & 1;
  it.bg = it.b * 2 + it.g; it.t = it.qb * 64 + wave * 8 + qi; it.tokrow = (size_t)it.b * SEQ + it.t; return it;
}
DI void nsa_accum_store(bf16_t* dst, const f32x16 (&o)[2], float sc, bool first, int hh, unsigned char* dst8 = nullptr) {
  u32x2 oldv[2][4];
  if (!first) {
#pragma unroll
    for (int dt = 0; dt < 2; ++dt)
#pragma unroll
      for (int q4 = 0; q4 < 4; ++q4) oldv[dt][q4] = *(const u32x2*)(dst + dt * 32 + 8 * q4 + 4 * hh);
  }
#pragma unroll
  for (int dt = 0; dt < 2; ++dt)
#pragma unroll
    for (int q4 = 0; q4 < 4; ++q4) {
      u32x2* pp = (u32x2*)(dst + dt * 32 + 8 * q4 + 4 * hh);
      float a0 = sc * o[dt][4 * q4], a1 = sc * o[dt][4 * q4 + 1], a2 = sc * o[dt][4 * q4 + 2], a3 = sc * o[dt][4 * q4 + 3];
      if (!first) { const u32x2 old = oldv[dt][q4]; a0 += bflo(old.x); a1 += bfhi(old.x); a2 += bflo(old.y); a3 += bfhi(old.y); }
      if (dst8) *(unsigned*)(dst8 + dt * 32 + 8 * q4 + 4 * hh) = pk4_fp8(clamp_f8(16.0f * a0), clamp_f8(16.0f * a1), clamp_f8(16.0f * a2), clamp_f8(16.0f * a3));
      else { u32x2 wv; wv.x = pack2(a0, a1); wv.y = pack2(a2, a3); *pp = wv; }
    }
}

constexpr int NSA_STAGE = 4 * 18432;
typedef float f32x4v __attribute__((ext_vector_type(4)));
#define MFMA16(a, b, c) __builtin_amdgcn_mfma_f32_16x16x32_bf16((a), (b), (c), 0, 0, 0)
struct StageRegs { u32x4 r[8]; };
DI void nsa_load_stage(StageRegs& sr, const bf16_t* kb, const bf16_t* vb, int j0s, int qb) {
  const int tid = otid(), r = tid >> 3, ch = tid & 7;
#pragma unroll
  for (int tt = 0; tt < 4; ++tt) {
    const int j = (j0s + tt <= qb) ? j0s + tt : qb;
    sr.r[2 * tt] = *(const u32x4*)(kb + ((size_t)j * 64 + r) * 128 + ch * 8);
    sr.r[2 * tt + 1] = *(const u32x4*)(vb + ((size_t)j * 64 + r) * 128 + ch * 8);
  }
}
DI void nsa_store_stage(const StageRegs& sr, char* stage) {
  const int tid = otid(), r = tid >> 3, ch = tid & 7;
#pragma unroll
  for (int tt = 0; tt < 4; ++tt) {
    *(u32x4*)((bf16_t*)(stage + tt * 18432) + r * LK + ch * 8) = sr.r[2 * tt];
    *(u32x4*)((bf16_t*)(stage + tt * 18432 + 9216) + r * LK + ch * 8) = sr.r[2 * tt + 1];
  }
}
constexpr int LK8 = 72;
constexpr int NSA_T8 = 9216, NSA_V8 = 4608;
constexpr float NSA_PB = 6.0f, NSA_THR8 = 2.0f;
struct HalfRegs { u32x2 k[2]; u32x2 v[2]; };
DI void nsa_load_half(HalfRegs& hr, const unsigned char* kb8, const unsigned char* vb8, int j0s, int qb) {
  const int tid = otid(), r = tid >> 3, ch = tid & 7;
#pragma unroll
  for (int tt = 0; tt < 2; ++tt) {
    const int j = (j0s + tt <= qb) ? j0s + tt : qb;
    hr.k[tt] = *(const u32x2*)(kb8 + ((size_t)j * 64 + r) * 128 + ch * 8);
    hr.v[tt] = *(const u32x2*)(vb8 + ((size_t)j * 64 + r) * 128 + ch * 8);
  }
}
DI void nsa_store_half(const HalfRegs& hr, char* stage2) {
  const int tid = otid(), r = tid >> 3, ch = tid & 7;
#pragma unroll
  for (int tt = 0; tt < 2; ++tt) {
    *(u32x2*)(stage2 + tt * NSA_T8 + r * LK8 + ch * 8) = hr.k[tt];
    *(u32x2*)(stage2 + tt * NSA_T8 + NSA_V8 + r * LK8 + ch * 8) = hr.v[tt];
  }
}
struct Sel16 { float m; bool has; f32x4v o[4], ol; };
typedef int i32x2 __attribute__((ext_vector_type(2)));
struct Frag16 { long kf[4][2]; long vf[2][4]; };
DI void nsa16_load_k(Frag16& f, const char* tile, int lane) {
  const int c16 = lane & 15, kg = lane >> 4;
  const char* Ks = tile + c16 * LK8 + kg * 8;
#pragma unroll
  for (int kt = 0; kt < 4; ++kt)
#pragma unroll
    for (int ks = 0; ks < 2; ++ks) f.kf[kt][ks] = *(const long*)(Ks + kt * 16 * LK8 + ks * 32);
  __builtin_amdgcn_sched_barrier(0);
}
DI void nsa16_load_v(Frag16& f, const char* tile, int lane) {
  const int l16 = lane & 15, kg = lane >> 4, q = l16 >> 1, pcol = l16 & 1;
  const int krow = (q < 4) ? (4 * kg + q) : (16 + 4 * kg + (q - 4));
  const LAS char* Vs = (const LAS char*)(tile + NSA_V8) + krow * LK8 + 8 * pcol;
#pragma unroll
  for (int kp = 0; kp < 2; ++kp)
#pragma unroll
    for (int dt = 0; dt < 4; ++dt) {
      const i32x2 t = __builtin_amdgcn_ds_read_tr8_b64_v2i32((LAS i32x2*)(Vs + (32 * kp) * LK8 + dt * 16));
      f.vf[kp][dt] = __builtin_bit_cast(long, t);
    }
  __builtin_amdgcn_sched_barrier(0);
}
DI void nsa16_qk(f32x4v (&st)[4], const Sel16& g, const Frag16& f, const long (&qf)[2], bool sel) {
  const float ini = sel ? NSA_PB - g.m : -1e30f;
#pragma unroll
  for (int kt = 0; kt < 4; ++kt) {
    st[kt] = (f32x4v){ini, ini, ini, ini};
#pragma unroll
    for (int ks = 0; ks < 2; ++ks) st[kt] = __builtin_amdgcn_mfma_f32_16x16x32_fp8_fp8(f.kf[kt][ks], qf[ks], st[kt], 0, 0, 0);
  }
}
DI void nsa16_softmax_pv(Sel16& g, f32x4v (&st)[4], const Frag16& f, int klim  , int lane) {
  const int kg = lane >> 4;
  __builtin_amdgcn_sched_barrier(0);
  if (klim < 64) {
#pragma unroll
    for (int kt = 0; kt < 4; ++kt)
#pragma unroll
      for (int r = 0; r < 4; ++r) st[kt][r] = (kt * 16 + 4 * kg + r <= klim) ? st[kt][r] : NSA_NEG;
  }
  float mx = fmaxf(fmaxf(st[0][0], st[0][1]), st[0][2]);
  mx = fmaxf(fmaxf(mx, st[0][3]), st[1][0]); mx = fmaxf(fmaxf(mx, st[1][1]), st[1][2]); mx = fmaxf(fmaxf(mx, st[1][3]), st[2][0]);
  mx = fmaxf(fmaxf(mx, st[2][1]), st[2][2]); mx = fmaxf(fmaxf(mx, st[2][3]), st[3][0]); mx = fmaxf(fmaxf(mx, st[3][1]), st[3][2]); mx = fmaxf(mx, st[3][3]);
  mx = fmaxf(mx, xor16f(mx, lane));
  mx = fmaxf(mx, xor32f(mx, lane));
  const bool real = mx > -1e29f;
  const bool fresh = !g.has && real, up = g.has && (mx > NSA_PB + NSA_THR8);
  if (__any(fresh || up)) {
    const float delta = (fresh || up) ? mx - NSA_PB : 0.f;
    const float alpha = up ? __builtin_amdgcn_exp2f(-delta) : 1.0f;
    g.m += delta; g.ol *= alpha;
#pragma unroll
    for (int dt = 0; dt < 4; ++dt) g.o[dt] *= alpha;
#pragma unroll
    for (int kt = 0; kt < 4; ++kt) st[kt] -= delta;
  }
  g.has = g.has || real;
#pragma unroll
  for (int kt = 0; kt < 4; ++kt)
#pragma unroll
    for (int r = 0; r < 4; ++r) st[kt][r] = __builtin_amdgcn_exp2f(st[kt][r]);
  const long ones = 0x3838383838383838L;
  __builtin_amdgcn_sched_barrier(0);
#pragma unroll
  for (int kp = 0; kp < 2; ++kp) {
    const unsigned lo = pk4_fp8(st[2 * kp][0], st[2 * kp][1], st[2 * kp][2], st[2 * kp][3]), hi = pk4_fp8(st[2 * kp + 1][0], st[2 * kp + 1][1], st[2 * kp + 1][2], st[2 * kp + 1][3]);
    const long pb = (long)(((unsigned long)hi << 32) | (unsigned long)lo);
    g.ol = __builtin_amdgcn_mfma_f32_16x16x32_fp8_fp8(ones, pb, g.ol, 0, 0, 0);
#pragma unroll
    for (int dt = 0; dt < 4; ++dt) g.o[dt] = __builtin_amdgcn_mfma_f32_16x16x32_fp8_fp8(f.vf[kp][dt], pb, g.o[dt], 0, 0, 0);
  }
}
DI void nsa_sel16(const Params& p, char* smem, bool dry) {
  char* ws = p.ws;
  const int tid = otid(), lane = tid & 63, wave = tid >> 6, c16 = lane & 15, kg = lane >> 4, qi4 = c16 >> 2, r4 = c16 & 3;
  const bf16_t* Q = (const bf16_t*)(ws + OFF_Q);
  const float* gsig = (const float*)(ws + OFF_GSIG);
  bf16_t* ONSA = (bf16_t*)(ws + OFF_ONSA);
  const u32x4* SELG = (const u32x4*)(ws + OFF_SELG);
  const bf16_t* KS = (const bf16_t*)(ws + OFF_KS); const bf16_t* VS = (const bf16_t*)(ws + OFF_VS);
  constexpr int NITEM = NB * 2 * 128;
  for (int item = blockIdx.x; item < NITEM; item += gridDim.x) {
    const NsaItem it = nsa_item(item, wave, 0);
    const int qb = it.qb;
    long qf[2][2]; u32x4 selw[2]; float g_s[2]; int tg[2]; Sel16 G[2];
    const unsigned char* kb = (const unsigned char*)KS + (size_t)it.b * SEQ * 128 + it.g * 64;
    const unsigned char* vb = (const unsigned char*)VS + (size_t)it.b * SEQ * 128 + it.g * 64;
    HalfRegs f0, f1, f2, f3;
    nsa_load_half(f0, kb, vb, 0, qb); nsa_load_half(f1, kb, vb, 2, qb); nsa_load_half(f2, kb, vb, 4, qb); nsa_load_half(f3, kb, vb, 6, qb);
    u32x4 qraw[2][2];
#pragma unroll
    for (int gq = 0; gq < 2; ++gq) {
      tg[gq] = it.t + 4 * gq + qi4;
      const size_t tokrow = (size_t)it.b * SEQ + tg[gq];
#pragma unroll
      for (int ks = 0; ks < 2; ++ks) qraw[gq][ks] = *(const u32x4*)(Q + tokrow * 512 + (it.g * 4 + r4) * 64 + ks * 32 + kg * 8);
      selw[gq] = SELG[(size_t)it.bg * SEQ + tg[gq]];
      g_s[gq] = gsig[tokrow * 32 + (it.g * 4 + r4) * 3 + 1];
    }
    lds_barrier();
    nsa_store_half(f0, smem); nsa_store_half(f1, smem + 2 * NSA_T8); nsa_store_half(f2, smem + 4 * NSA_T8); nsa_store_half(f3, smem + 6 * NSA_T8);
#pragma unroll
    for (int gq = 0; gq < 2; ++gq) {
#pragma unroll
      for (int ks = 0; ks < 2; ++ks) {
        float qv[8]; unpack8(qraw[gq][ks], qv);
        const unsigned lo = pk4_fp8(clamp_f8(16.f * qv[0]), clamp_f8(16.f * qv[1]), clamp_f8(16.f * qv[2]), clamp_f8(16.f * qv[3])), hi = pk4_fp8(clamp_f8(16.f * qv[4]), clamp_f8(16.f * qv[5]), clamp_f8(16.f * qv[6]), clamp_f8(16.f * qv[7]));
        qf[gq][ks] = (long)(((unsigned long)hi << 32) | (unsigned long)lo);
      }
      G[gq].m = 0.f; G[gq].ol = (f32x4v){0.f, 0.f, 0.f, 0.f}; G[gq].has = false;
#pragma unroll
      for (int dt = 0; dt < 4; ++dt) G[gq].o[dt] = (f32x4v){0.f, 0.f, 0.f, 0.f};
    }
    const int nst = (qb >> 3) + 1;
    lds_barrier();
    for (int sidx = 0; sidx < nst; ++sidx) {
      const char* stage = smem + (sidx & 1) * NSA_STAGE;
      char* nstage = smem + ((sidx + 1) & 1) * NSA_STAGE;
      const bool more = sidx + 1 < nst;
      HalfRegs hr;
      if (more) nsa_load_half(hr, kb, vb, 8 * (sidx + 1), qb);
      if (__builtin_amdgcn_readfirstlane(wave) >= 4) __builtin_amdgcn_s_sleep(6);
#pragma unroll 1
      for (int tt = 0; tt < 8; ++tt) {
        const int j = 8 * sidx + tt;
        if (more && tt > 0 && (tt & 1) == 0) { nsa_store_half(hr, nstage + (tt - 2) * NSA_T8); nsa_load_half(hr, kb, vb, 8 * (sidx + 1) + tt, qb); }
        if (j <= qb) {
          bool selb[2], act[2];
#pragma unroll
          for (int gq = 0; gq < 2; ++gq) {
            const unsigned w = j < 32 ? selw[gq].x : (j < 64 ? selw[gq].y : (j < 96 ? selw[gq].z : selw[gq].w));
            selb[gq] = (w >> (j & 31)) & 1u; act[gq] = __any(selb[gq]);
          }
          if (act[0] || act[1]) {
            Frag16 fr; nsa16_load_k(fr, stage + tt * NSA_T8, lane);
            f32x4v st0[4], st1[4];
            if (act[0]) nsa16_qk(st0, G[0], fr, qf[0], selb[0]);
            if (act[1]) nsa16_qk(st1, G[1], fr, qf[1], selb[1]);
            nsa16_load_v(fr, stage + tt * NSA_T8, lane);
            if (act[0]) nsa16_softmax_pv(G[0], st0, fr, (j == qb) ? (tg[0] - j * 64) : 1000, lane);
            if (act[1]) nsa16_softmax_pv(G[1], st1, fr, (j == qb) ? (tg[1] - j * 64) : 1000, lane);
          }
        }
      }
      if (more) nsa_store_half(hr, nstage + 6 * NSA_T8);
      lds_barrier();
    }
    u32x2 oldv[2][4];
#pragma unroll
    for (int gq = 0; gq < 2; ++gq)
#pragma unroll
      for (int dt = 0; dt < 4; ++dt) oldv[gq][dt] = *(const u32x2*)(ONSA + ((size_t)it.b * SEQ + tg[gq]) * 512 + (it.g * 4 + r4) * 64 + 4 * kg + dt * 16);
#pragma unroll
    for (int gq = 0; gq < 2; ++gq) {
      const float l = G[gq].ol[0];
      const float sc = l > 0.f ? g_s[gq] / l : 0.f;
      bf16_t* dst = ONSA + ((size_t)it.b * SEQ + tg[gq]) * 512 + (it.g * 4 + r4) * 64 + 4 * kg;
      if (!dry) {
#pragma unroll
        for (int dt = 0; dt < 4; ++dt) {
          u32x2* pp = (u32x2*)(dst + dt * 16);
          const u32x2 old = oldv[gq][dt];
          u32x2 wv; wv.x = pack2(bflo(old.x) + sc * G[gq].o[dt][0], bfhi(old.x) + sc * G[gq].o[dt][1]);
          wv.y = pack2(bflo(old.y) + sc * G[gq].o[dt][2], bfhi(old.y) + sc * G[gq].o[dt][3]);
          *pp = wv;
        }
      } else asm volatile("" :: "v"(G[gq].o[0]), "v"(G[gq].o[1]), "v"(G[gq].o[2]), "v"(G[gq].o[3]), "v"(l));
    }
  }
}

DI void phase_nsa(const Params& p, char* smem, int branch_mask) {
  char* ws = p.ws;
  const int tid = otid(), lane = tid & 63, wave = tid >> 6, hh = lane >> 5, c = lane & 31, qi = c >> 2, r4 = c & 3;
  const bf16_t* Q = (const bf16_t*)(ws + OFF_Q);
  const float* gsig = (const float*)(ws + OFF_GSIG);
  bf16_t* ONSA = (bf16_t*)(ws + OFF_ONSA);
  u32x4* SELG = (u32x4*)(ws + OFF_SELG);
  constexpr int NITEM = NB * 2 * 128;

#pragma unroll 1
  for (int rep1 = 0; rep1 < ((PROBE_DUP & 4096) ? 2 : 1); ++rep1) {
    const bf16_t* KCMP = (const bf16_t*)(ws + OFF_KCMP); const bf16_t* VCMP = (const bf16_t*)(ws + OFF_VCMP);
    float* Aimp = (float*)(smem + NSA_AIMP) + wave * 1024;
    float* Cimp = (float*)(smem + NSA_CIMP) + wave * 1024;
    unsigned short* selm16 = (unsigned short*)(smem + NSA_SELM) + wave * 64;
    const u32x4* selm128 = (const u32x4*)(smem + NSA_SELM) + wave * 8;
    for (int item = blockIdx.x; item < NITEM; item += gridDim.x) {
      const NsaItem it = nsa_item(item, wave, qi);
      const int t = it.t;
      bf16x8 qf[4];
#pragma unroll
      for (int ks = 0; ks < 4; ++ks) qf[ks] = *(const bf16x8*)(Q + it.tokrow * 512 + (it.g * 4 + r4) * 64 + ks * 16 + hh * 8);
      const float g_c = gsig[it.tokrow * 32 + (it.g * 4 + r4) * 3 + 0];
      TileRegs tr;
      const int nmax = (it.qb * 64 + 63 - 31) >> 4, ntile = (nmax >> 6) + 1;
      const int nfull = (it.qb * 64 - 31) >> 4;
      const bf16_t* kb = KCMP + (size_t)it.bg * 512 * 64;
      const bf16_t* vb = VCMP + (size_t)it.bg * 512 * 64;
      float m = -1e30f, l = 0.f;
      nsa_load_tile(tr, kb, 64, vb, 64);
      nsa_store_tile(tr, smem);
      __syncthreads();
      for (int j = 0; j < ntile; ++j) {
        const char* tile = smem + (j & 1) * NSA_TILE;
        { const int jn = (j + 1 < ntile) ? j + 1 : 0;
          nsa_load_tile(tr, kb + (size_t)jn * 64 * 64, 64, vb + (size_t)jn * 64 * 64, 64); }
        f32x16 st[2];
        nsa_scores(st, tile, qf, lane);
        const bool full = (j * 64 + 63 <= nfull);
        const int nlim = full ? 100000 : ((t - 31) >> 4) - j * 64 - 4 * hh;
        if (!full) {
#pragma unroll
          for (int kt = 0; kt < 2; ++kt)
#pragma unroll
            for (int r = 0; r < 16; ++r) st[kt][r] = (kt * 32 + (r & 3) + 8 * (r >> 2) <= nlim) ? st[kt][r] : NSA_NEG;
        }
        float mx = fmaxf(st[0][0], st[1][0]);
#pragma unroll
        for (int r = 1; r < 16; ++r) mx = fmaxf(fmaxf(mx, st[0][r]), st[1][r]);
        mx = fmaxf(mx, xor32f(mx, lane));
        const float mn = fmaxf(m, mx);
        float sum = 0.f;
#pragma unroll
        for (int kt = 0; kt < 2; ++kt)
#pragma unroll
          for (int r = 0; r < 16; ++r) sum += __builtin_amdgcn_exp2f(st[kt][r] - mn);
        l = l * __builtin_amdgcn_exp2f(m - mn) + sum;
        m = mn;
        if (j + 1 < ntile) nsa_store_tile(tr, smem + ((j + 1) & 1) * NSA_TILE);
        __syncthreads();
      }
      l += xor32f(l, lane);
      const float mref = l > 0.f ? m + __builtin_amdgcn_logf(l) : 1e30f;
      f32x16 o[2];
#pragma unroll
      for (int r = 0; r < 16; ++r) { o[0][r] = 0.f; o[1][r] = 0.f; }
      nsa_store_tile(tr, smem);
      __syncthreads();
      for (int j = 0; j < ntile; ++j) {
        const char* tile = smem + (j & 1) * NSA_TILE;
        if (j + 1 < ntile) nsa_load_tile(tr, kb + (size_t)(j + 1) * 64 * 64, 64, vb + (size_t)(j + 1) * 64 * 64, 64);
        f32x16 st[2];
        nsa_scores(st, tile, qf, lane);
        const bool full = (j * 64 + 63 <= nfull);
        const int nlim = full ? 100000 : ((t - 31) >> 4) - j * 64 - 4 * hh;
        if (!full) {
#pragma unroll
          for (int kt = 0; kt < 2; ++kt)
#pragma unroll
            for (int r = 0; r < 16; ++r) st[kt][r] = (kt * 32 + (r & 3) + 8 * (r >> 2) <= nlim) ? st[kt][r] : NSA_NEG;
        }
#pragma unroll
        for (int kt = 0; kt < 2; ++kt)
#pragma unroll
          for (int r = 0; r < 16; ++r) st[kt][r] = __builtin_amdgcn_exp2f(st[kt][r] - mref);
#pragma unroll
        for (int kt = 0; kt < 2; ++kt)
#pragma unroll
          for (int c4 = 0; c4 < 4; ++c4) {
            float carry = 0.5f * st[kt][4 * c4 + 3];
            float fullv = st[kt][4 * c4] + st[kt][4 * c4 + 1] + st[kt][4 * c4 + 2] + carry;
            fullv += xor1f(fullv); fullv += xor2f(fullv);
            carry += xor1f(carry); carry += xor2f(carry);
            const int jb = j * 16 + kt * 8 + 2 * c4 + hh;
            if (r4 == 0) { Aimp[qi * 128 + jb] = fullv; Cimp[qi * 128 + jb] = carry; }
          }
        if (branch_mask & 1) nsa_pv(o, st, tile, lane);
        if (j + 1 < ntile) nsa_store_tile(tr, smem + ((j + 1) & 1) * NSA_TILE);
        __syncthreads();
      }
      nsa_accum_store(ONSA + it.tokrow * 512 + (it.g * 4 + r4) * 64, o, (branch_mask & 1) ? g_c : 0.f, true, hh);
      const int cur = it.qb;
      if (cur <= 15) {
        if (lane < 8) { selm16[lane * 8 + 0] = (unsigned short)((2u << cur) - 1u);
#pragma unroll
          for (int k = 1; k < 8; ++k) selm16[lane * 8 + k] = 0; }
      } else {
        const int qs = lane >> 3, sub = lane & 7;
        float v[16];
#pragma unroll
        for (int i = 0; i < 16; ++i) {
          const int jj = sub * 16 + i;
          const bool ok = (jj >= 1) && (jj <= cur - 2);
          const int jm = jj >= 1 ? jj - 1 : 0;
          v[i] = ok ? (Aimp[qs * 128 + jj] + Cimp[qs * 128 + jm]) : -3e38f;
        }
        unsigned bits = 0;
        for (int itn = 0; itn < 13; ++itn) {
          float bv = v[0]; int bi = 0;
#pragma unroll
          for (int i = 1; i < 16; ++i) if (v[i] > bv) { bv = v[i]; bi = i; }
          int bj = sub * 16 + bi;
#define NSA_ARGMAX_STEP(CTRL) { const float ov = __int_as_float(__builtin_amdgcn_update_dpp(__float_as_int(bv), __float_as_int(bv), CTRL, 0xF, 0xF, false)); \
            const int oj = __builtin_amdgcn_update_dpp(bj, bj, CTRL, 0xF, 0xF, false); if (ov > bv || (ov == bv && oj < bj)) { bv = ov; bj = oj; } }
          NSA_ARGMAX_STEP(0xB1) NSA_ARGMAX_STEP(0x4E) NSA_ARGMAX_STEP(0x141)
          if ((bj >> 4) == sub) {
            const int i2 = bj & 15;
#pragma unroll
            for (int i = 0; i < 16; ++i) if (i == i2) v[i] = -3e38f;
            bits |= 1u << i2;
          }
        }
        if (sub == 0) bits |= 1u;
        if ((cur >> 4) == sub) bits |= 1u << (cur & 15);
        if (((cur - 1) >> 4) == sub) bits |= 1u << ((cur - 1) & 15);
        selm16[qs * 8 + sub] = (unsigned short)bits;
      }
      __syncthreads();
      if (r4 == 0 && hh == 0) SELG[(size_t)it.bg * SEQ + t] = selm128[qi];
    }
  }
  __threadfence_block();
  __syncthreads();

#pragma unroll 1
  for (int sweep_i = 0; sweep_i < 2 + ((PROBE_DUP & 1024) ? 1 : 0) + ((PROBE_DUP & 2048) ? 1 : 0); ++sweep_i) {
    const int sweep = (sweep_i < 2) ? sweep_i : (((PROBE_DUP & 1024) && sweep_i == 2) ? 0 : 1);
    const bool dry = sweep_i >= 2;
    if (!(branch_mask & (sweep == 0 ? 2 : 4))) continue;
    if (sweep == 0) { nsa_sel16(p, smem, dry); continue; }
    const bf16_t* KB = (const bf16_t*)(ws + (sweep == 0 ? OFF_KS : OFF_KW)); const bf16_t* VB = (const bf16_t*)(ws + (sweep == 0 ? OFF_VS : OFF_VW));
    for (int item = blockIdx.x; item < NITEM; item += gridDim.x) {
      const NsaItem it = nsa_item(item, wave, qi);
      const int t = it.t, qb = it.qb;
      bf16x8 qf[4];
#pragma unroll
      for (int ks = 0; ks < 4; ++ks) qf[ks] = *(const bf16x8*)(Q + it.tokrow * 512 + (it.g * 4 + r4) * 64 + ks * 16 + hh * 8);
      const float g_b = gsig[it.tokrow * 32 + (it.g * 4 + r4) * 3 + 1 + sweep];
      u32x4 selw = {0xffffffffu, 0xffffffffu, 0xffffffffu, 0xffffffffu};
      if (sweep == 0) selw = SELG[(size_t)it.bg * SEQ + t];
      TileRegs tr;
      const bf16_t* kb = KB + (size_t)it.b * SEQ * 128 + it.g * 64;
      const bf16_t* vb = VB + (size_t)it.b * SEQ * 128 + it.g * 64;
      float m = -1e30f, l = 0.f;
      f32x16 o[2];
#pragma unroll
      for (int r = 0; r < 16; ++r) { o[0][r] = 0.f; o[1][r] = 0.f; }
      const int j0 = (sweep == 1 && qb >= 8) ? qb - 8 : 0;
      {
        TileRegs t0, t1;
        const int j1 = (j0 + 1 <= qb) ? j0 + 1 : j0, j2 = (j0 + 2 <= qb) ? j0 + 2 : j0;
        nsa_load_tile(t0, kb + (size_t)j0 * 64 * 128, 128, vb + (size_t)j0 * 64 * 128, 128);
        nsa_load_tile(t1, kb + (size_t)j1 * 64 * 128, 128, vb + (size_t)j1 * 64 * 128, 128);
        nsa_load_tile(tr, kb + (size_t)j2 * 64 * 128, 128, vb + (size_t)j2 * 64 * 128, 128);
        __syncthreads();
        nsa_store_tile(t0, smem);
        if (j0 + 1 <= qb) nsa_store_tile(t1, smem + NSA_TILE);
      }
      __syncthreads();
      const bool late = wave >= 4;
      if (__builtin_amdgcn_readfirstlane(wave) >= 4) __builtin_amdgcn_s_setprio(1);
      bool has = false;
      m = 0.f;
      f32x16 st[2];
      {
        const unsigned w0 = j0 < 32 ? selw.x : (j0 < 64 ? selw.y : (j0 < 96 ? selw.z : selw.w));
        const float ini = ((w0 >> (j0 & 31)) & 1u) ? 0.f : -1e30f;
#pragma unroll
        for (int r = 0; r < 16; ++r) { st[0][r] = ini; st[1][r] = ini; }
        const bf16_t* Kc = (const bf16_t*)smem;
#pragma unroll
        for (int ks = 0; ks < 4; ++ks)
#pragma unroll
          for (int kt = 0; kt < 2; ++kt) st[kt] = MFMA32(*(const bf16x8*)(Kc + (kt * 32 + (lane & 31)) * LK + ks * 16 + (lane >> 5) * 8), qf[ks], st[kt]);
      }
      int bi = 0;
      for (int j = j0; j <= qb; ++j) {
        const char* tile = smem + bi * NSA_TILE;
        const int bn = bi == 2 ? 0 : bi + 1, bnn = bn == 2 ? 0 : bn + 1;
        const int jn = j + 1;
        const unsigned wn = jn < 32 ? selw.x : (jn < 64 ? selw.y : (jn < 96 ? selw.z : selw.w));
        const bool seln = (wn >> (jn & 31)) & 1u;
        const bf16_t* Kn = (const bf16_t*)(smem + bn * NSA_TILE) + (lane & 31) * LK + (lane >> 5) * 8;
        f32x16 sn[2];
        if (!late) {
          const float ini = seln ? -m : -1e30f;
#pragma unroll
          for (int r = 0; r < 16; ++r) { sn[0][r] = ini; sn[1][r] = ini; }
#pragma unroll
          for (int ks = 0; ks < 4; ++ks)
#pragma unroll
            for (int kt = 0; kt < 2; ++kt) sn[kt] = MFMA32(*(const bf16x8*)(Kn + kt * 32 * LK + ks * 16), qf[ks], sn[kt]);
        }
        if (j == qb || (sweep == 1 && j == qb - 8)) {
          const int khi = t - j * 64 - 4 * hh, klo = (sweep == 1) ? khi - 511 : -100000;
#pragma unroll
          for (int r = 0; r < 16; ++r) {
            const int o0 = (r & 3) + 8 * (r >> 2);
            st[0][r] = (o0 <= khi && o0 >= klo) ? st[0][r] : NSA_NEG;
            st[1][r] = (o0 + 32 <= khi && o0 + 32 >= klo) ? st[1][r] : NSA_NEG;
          }
        }
        float mx;
        {
          float a0, a1, a2, a3;
          asm("v_max3_f32 %0, %1, %2, %3" : "=v"(a0) : "v"(st[0][0]), "v"(st[0][1]), "v"(st[0][2]));
          asm("v_max3_f32 %0, %1, %2, %3" : "=v"(a1) : "v"(st[0][3]), "v"(st[0][4]), "v"(st[0][5]));
          asm("v_max3_f32 %0, %1, %2, %3" : "=v"(a2) : "v"(st[0][6]), "v"(st[0][7]), "v"(st[0][8]));
          asm("v_max3_f32 %0, %1, %2, %3" : "=v"(a3) : "v"(st[0][9]), "v"(st[0][10]), "v"(st[0][11]));
          asm("v_max3_f32 %0, %1, %2, %3" : "=v"(a0) : "v"(a0), "v"(st[0][12]), "v"(st[0][13]));
          asm("v_max3_f32 %0, %1, %2, %3" : "=v"(a1) : "v"(a1), "v"(st[0][14]), "v"(st[0][15]));
          asm("v_max3_f32 %0, %1, %2, %3" : "=v"(a2) : "v"(a2), "v"(st[1][0]), "v"(st[1][1]));
          asm("v_max3_f32 %0, %1, %2, %3" : "=v"(a3) : "v"(a3), "v"(st[1][2]), "v"(st[1][3]));
          asm("v_max3_f32 %0, %1, %2, %3" : "=v"(a0) : "v"(a0), "v"(st[1][4]), "v"(st[1][5]));
          asm("v_max3_f32 %0, %1, %2, %3" : "=v"(a1) : "v"(a1), "v"(st[1][6]), "v"(st[1][7]));
          asm("v_max3_f32 %0, %1, %2, %3" : "=v"(a2) : "v"(a2), "v"(st[1][8]), "v"(st[1][9]));
          asm("v_max3_f32 %0, %1, %2, %3" : "=v"(a3) : "v"(a3), "v"(st[1][10]), "v"(st[1][11]));
          asm("v_max3_f32 %0, %1, %2, %3" : "=v"(a0) : "v"(a0), "v"(st[1][12]), "v"(st[1][13]));
          asm("v_max3_f32 %0, %1, %2, %3" : "=v"(a1) : "v"(a1), "v"(st[1][14]), "v"(st[1][15]));
          asm("v_max3_f32 %0, %1, %2, %3" : "=v"(a0) : "v"(a0), "v"(a1), "v"(a2));
          const float other = a3;
          asm("v_max_f32 %0, %1, %2" : "=v"(mx) : "v"(a0), "v"(other));
          const float px = xor32f(mx, lane);
          asm("v_max_f32 %0, %1, %2" : "=v"(mx) : "v"(mx), "v"(px));
        }
        const bool real = mx > -1e29f;
        const bool fresh = !has && real, up = has && (mx > NSA_THR);
        if (__any(fresh || up)) {
          const float delta = (fresh || up) ? mx : 0.f;
          const float alpha = up ? __builtin_amdgcn_exp2f(-delta) : 1.0f;
          m += delta; l *= alpha;
#pragma unroll
          for (int r = 0; r < 16; ++r) { o[0][r] *= alpha; o[1][r] *= alpha; st[0][r] -= delta; st[1][r] -= delta; }
          if (!late) {
            const float dn = seln ? delta : 0.f;
#pragma unroll
            for (int r = 0; r < 16; ++r) { sn[0][r] -= dn; sn[1][r] -= dn; }
          }
        }
        has = has || real;
        float s2a = 0.f, s2b = 0.f;
#pragma unroll
        for (int r = 0; r < 16; ++r) {
          const float p0 = __builtin_amdgcn_exp2f(st[0][r]), p1 = __builtin_amdgcn_exp2f(st[1][r]);
          st[0][r] = p0; st[1][r] = p1; s2a += p0; s2b += p1;
        }
        l += s2a + s2b;
        nsa_pv(o, st, tile, lane);
        if (late) {
          const float ini = seln ? -m : -1e30f;
#pragma unroll
          for (int r = 0; r < 16; ++r) { sn[0][r] = ini; sn[1][r] = ini; }
#pragma unroll
          for (int ks = 0; ks < 4; ++ks)
#pragma unroll
            for (int kt = 0; kt < 2; ++kt) sn[kt] = MFMA32(*(const bf16x8*)(Kn + kt * 32 * LK + ks * 16), qf[ks], sn[kt]);
        }
        if (j + 2 <= qb) nsa_store_tile(tr, smem + bnn * NSA_TILE);
        if (j + 3 <= qb) nsa_load_tile(tr, kb + (size_t)(j + 3) * 64 * 128, 128, vb + (size_t)(j + 3) * 64 * 128, 128);
#pragma unroll
        for (int r = 0; r < 16; ++r) { st[0][r] = sn[0][r]; st[1][r] = sn[1][r]; }
        bi = bn;
        __syncthreads();
      }
      __builtin_amdgcn_s_setprio(0);
      l += xor32f(l, lane);
      if (!dry) nsa_accum_store(ONSA + it.tokrow * 512 + (it.g * 4 + r4) * 64, o, l > 0.f ? g_b / l : 0.f, false, hh, (unsigned char*)(ws + OFF_ONSA8) + it.tokrow * 512 + (it.g * 4 + r4) * 64);
      else asm volatile("" :: "v"(o[0]), "v"(o[1]), "v"(l));
    }
  }
}

DI unsigned ord_key(float f) { const unsigned u = __float_as_uint(f); return (u & 0x80000000u) ? ~u : (u | 0x80000000u); }
DI float ord_val(unsigned k) { return __uint_as_float((k & 0x80000000u) ? (k & 0x7fffffffu) : ~k); }
DI void cex(unsigned& hi, unsigned& lo) { const unsigned x = hi, y = lo; hi = x > y ? x : y; lo = x > y ? y : x; }
DI void sort16_desc(unsigned (&a)[16]) {
#pragma unroll
  for (int k = 2; k <= 16; k <<= 1)
#pragma unroll
    for (int j = k >> 1; j > 0; j >>= 1)
#pragma unroll
      for (int i = 0; i < 16; ++i) {
        const int l = i ^ j;
        if (l > i) { if ((i & k) == 0) cex(a[i], a[l]); else cex(a[l], a[i]); }
      }
}
DI void bitonic_finish16(unsigned (&a)[16]) {
#pragma unroll
  for (int j = 8; j > 0; j >>= 1)
#pragma unroll
    for (int i = 0; i < 16; ++i) { const int l = i ^ j; if (l > i) cex(a[i], a[l]); }
}
DI void merge_top16(unsigned (&a)[16], const unsigned (&b)[16]) {
#pragma unroll
  for (int i = 0; i < 16; ++i) a[i] = a[i] > b[15 - i] ? a[i] : b[15 - i];
  bitonic_finish16(a);
}
DI void merge_partner16(unsigned (&a)[16]) {
  unsigned b[16];
#pragma unroll
  for (int i = 0; i < 16; ++i) b[i] = xor32u(a[i], otid());
  merge_top16(a, b);
}


constexpr int KLD = 136;
DI void peer_top16(unsigned (&top)[16], const bf16x8 (&bq)[8], const bf16_t* keys  , int lane) {
  const int l31 = lane & 31, hh = lane >> 5;
  unsigned grp[16];
#pragma unroll
  for (int nt = 0; nt < 4; ++nt) {
    f32x16 sa;
#pragma unroll
    for (int r = 0; r < 16; ++r) sa[r] = 0.f;
    const bf16_t* kp = keys + (nt * 32 + l31) * KLD + hh * 8;
#pragma unroll
    for (int ks = 0; ks < 8; ++ks) { const bf16x8 a = *(const bf16x8*)(kp + ks * 16); sa = MFMA32(a, bq[ks], sa); }
#pragma unroll
    for (int r = 0; r < 16; ++r) {
      const int n = nt * 32 + (r & 3) + 8 * (r >> 2) + 4 * hh;
      grp[r] = (ord_key(sa[r]) & ~0x7Fu) | (unsigned)(127 - n);
    }
    sort16_desc(grp);
    if (nt == 0) {
#pragma unroll
      for (int i = 0; i < 16; ++i) top[i] = grp[i];
    } else merge_top16(top, grp);
  }
  merge_partner16(top);
}

DI void phase_route(const Params& p, char* smem) {
  char* ws = p.ws;
  const int tid = otid(), lane = tid & 63, wave = tid >> 6, l31 = lane & 31, hh = lane >> 5;
  const bf16_t* pq = (const bf16_t*)(ws + OFF_PQ);
  const bf16_t* pk = (const bf16_t*)(ws + OFF_PKEYS);
  unsigned short* eidx = (unsigned short*)(ws + OFF_EIDX);
  bf16_t* pgate = (bf16_t*)(ws + OFF_PGATE);
  bf16_t* KL = (bf16_t*)smem;
  unsigned* LS = (unsigned*)(smem + 2 * 128 * KLD * 2) + wave * 1024;
  {
    const int h0 = blockIdx.x & 7;
    __syncthreads();
#pragma unroll
    for (int i = 0; i < 8; ++i) {
      const int idx = tid + i * NT, row = idx >> 4, ch = idx & 15;
      *(u32x4*)(KL + row * KLD + ch * 8) = *(const u32x4*)(pk + ((size_t)h0 * 256 + row) * 128 + ch * 8);
    }
    __syncthreads();
  }
  constexpr int CA[64] = {0,0,0,0,0,0,0,0,0,0,0,0,0,0,0,0, 1,1,1,1,1,1,1,1, 2,2,2,2,2, 3,3,3,3, 4,4,4, 5,5, 6,6, 7,7, 8,9,10,11,12,13,14,15, 0,0,0,0,0,0,0,0,0,0,0,0,0,0};
  constexpr int CB[64] = {0,1,2,3,4,5,6,7,8,9,10,11,12,13,14,15, 0,1,2,3,4,5,6,7, 0,1,2,3,4, 0,1,2,3, 0,1,2, 0,1, 0,1, 0,1, 0,0,0,0,0,0,0,0, 0,0,0,0,0,0,0,0,0,0,0,0,0,0};
  for (int item = blockIdx.x; item < (NTOK / 256) * 8; item += gridDim.x) {
    const int h = item & 7, t0 = (item >> 3) * 256 + wave * 32;
    unsigned s1[16], s2[16];
    const bf16_t* pqrow = pq + (size_t)(t0 + l31) * 2048 + h * 256 + hh * 8;
    bf16x8 bq1[8], bq2[8];
#pragma unroll
    for (int ks = 0; ks < 8; ++ks) { bq1[ks] = *(const bf16x8*)(pqrow + ks * 16); bq2[ks] = *(const bf16x8*)(pqrow + 128 + ks * 16); }
    peer_top16(s1, bq1, KL, lane);
    peer_top16(s2, bq2, KL + 128 * KLD, lane);
    float f1[16], f2[16];
#pragma unroll
    for (int i = 0; i < 16; ++i) { f1[i] = ord_val(s1[i]); f2[i] = ord_val(s2[i]); }
    unsigned ca[16], cb2[16];
#pragma unroll
    for (int i = 0; i < 32; ++i) {
      const int i0 = i, i1 = 25 + i;
      unsigned k0 = 0u, k1 = 0u;
      if (i0 < 25) k0 = (ord_key(f1[CA[i0]] + f2[CB[i0]]) & ~0xFFu) | (unsigned)(255 - (CA[i0] * 16 + CB[i0]));
      if (i1 < 50) k1 = (ord_key(f1[CA[i1]] + f2[CB[i1]]) & ~0xFFu) | (unsigned)(255 - (CA[i1] * 16 + CB[i1]));
      const unsigned kk = hh ? k1 : k0;
      if (i < 16) ca[i] = kk; else cb2[i - 16] = kk;
    }
    sort16_desc(ca); sort16_desc(cb2);
    merge_top16(ca, cb2);
    merge_partner16(ca);
    if (hh == 0) {
#pragma unroll
      for (int i = 0; i < 16; ++i) { LS[l31 * 32 + i] = s1[i]; LS[l31 * 32 + 16 + i] = s2[i]; }
    }
    const float mx = ord_val(ca[0]);
    float ex[16], sum = 0.f;
#pragma unroll
    for (int i = 0; i < 16; ++i) { ex[i] = __expf(ord_val(ca[i]) - mx); sum += ex[i]; }
    const float inv = 1.0f / sum;
    int eo[16]; float go[16];
#pragma unroll
    for (int i = 0; i < 16; ++i) {
      const int flat = 255 - (int)(ca[i] & 0xFFu);
      const unsigned k1 = LS[l31 * 32 + (flat >> 4)], k2 = LS[l31 * 32 + 16 + (flat & 15)];
      eo[i] = (127 - (int)(k1 & 0x7Fu)) * 128 + (127 - (int)(k2 & 0x7Fu));
      go[i] = ex[i] * inv;
    }
    const size_t ob = ((size_t)(t0 + l31) * 8 + h) * 16;
    if (hh == 0) {
      *(u32x4*)(eidx + ob) = (u32x4){(unsigned)eo[0] | ((unsigned)eo[1] << 16), (unsigned)eo[2] | ((unsigned)eo[3] << 16), (unsigned)eo[4] | ((unsigned)eo[5] << 16), (unsigned)eo[6] | ((unsigned)eo[7] << 16)};
      *(u32x4*)(pgate + ob) = (u32x4){pack2(go[0], go[1]), pack2(go[2], go[3]), pack2(go[4], go[5]), pack2(go[6], go[7])};
    } else {
      *(u32x4*)(eidx + ob + 8) = (u32x4){(unsigned)eo[8] | ((unsigned)eo[9] << 16), (unsigned)eo[10] | ((unsigned)eo[11] << 16), (unsigned)eo[12] | ((unsigned)eo[13] << 16), (unsigned)eo[14] | ((unsigned)eo[15] << 16)};
      *(u32x4*)(pgate + ob + 8) = (u32x4){pack2(go[8], go[9]), pack2(go[10], go[11]), pack2(go[12], go[13]), pack2(go[14], go[15])};
    }
  }
}

#define FOR32(M) M(0) M(1) M(2) M(3) M(4) M(5) M(6) M(7) M(8) M(9) M(10) M(11) M(12) M(13) M(14) M(15) M(16) M(17) M(18) M(19) M(20) M(21) M(22) M(23) M(24) M(25) M(26) M(27) M(28) M(29) M(30) M(31)
#define FOR16(M) M(0) M(1) M(2) M(3) M(4) M(5) M(6) M(7) M(8) M(9) M(10) M(11) M(12) M(13) M(14) M(15)
DI void phase_ffn_u(const Params& p) {
  char* ws = p.ws;
  const int lane = otid() & 63, wave = otid() >> 6, pg = lane >> 3, dc = lane & 7;
  const int sl = blockIdx.x & 7, wslot = (blockIdx.x >> 3) * NW + wave, nw = (gridDim.x >> 3) * NW;
  const unsigned char* PU8 = (const unsigned char*)(ws + OFF_PU8) + (size_t)sl * 16384 * 128 + dc * 16;
  const unsigned char* h2q = (const unsigned char*)(ws + OFF_H2Q) + sl * 128 + dc * 16;
  const unsigned short* eidx = (const unsigned short*)(ws + OFF_EIDX) + 16 * pg;
  bf16_t* part = (bf16_t*)(ws + OFF_PART) + (size_t)sl * NTOK * 128 + 16 * pg + 2 * dc;
  u32x4 ne0 = {0u, 0u, 0u, 0u}, ne1 = ne0, hq = ne0, nhq = ne0;
  if (wslot < NTOK) { const unsigned short* ep = eidx + (size_t)wslot * 128; ne0 = *(const u32x4*)ep; ne1 = *(const u32x4*)(ep + 8);
                      nhq = *(const u32x4*)(h2q + (size_t)wslot * DM); }
#pragma unroll 1
  for (int t = wslot; t < NTOK; t += nw) {
    const u32x4 ce0 = ne0, ce1 = ne1; hq = nhq;
    if (t + nw < NTOK) { const unsigned short* ep = eidx + (size_t)(t + nw) * 128; ne0 = *(const u32x4*)ep; ne1 = *(const u32x4*)(ep + 8);
                         nhq = *(const u32x4*)(h2q + (size_t)(t + nw) * DM); }
#define FFU_E(it) (((it) & 1) ? (((it) < 8 ? ce0 : ce1)[((it) >> 1) & 3] >> 16) : (((it) < 8 ? ce0 : ce1)[((it) >> 1) & 3] & 0xffffu))
#define FFU_LD(it) const u32x4 ru##it = *(const u32x4*)(PU8 + (size_t)FFU_E(it) * 128);
    FOR16(FFU_LD)
    int d[16];
#define FFU_CP(it) { int a_ = __builtin_amdgcn_sdot4((int)ru##it.x, (int)hq.x, 0, false); a_ = __builtin_amdgcn_sdot4((int)ru##it.y, (int)hq.y, a_, false); \
      a_ = __builtin_amdgcn_sdot4((int)ru##it.z, (int)hq.z, a_, false); d[it] = __builtin_amdgcn_sdot4((int)ru##it.w, (int)hq.w, a_, false); }
    FOR16(FFU_CP)
    int r8[8], r4[4], r2[2];
    { const bool hi = dc & 4;
#pragma unroll
      for (int i = 0; i < 8; ++i) { const int keep = hi ? d[8 + i] : d[i], send = hi ? d[i] : d[8 + i]; r8[i] = keep + __builtin_amdgcn_update_dpp(send, send, 0x141, 0xF, 0xF, false); } }
    { const bool hi = dc & 2;
#pragma unroll
      for (int i = 0; i < 4; ++i) { const int keep = hi ? r8[4 + i] : r8[i], send = hi ? r8[i] : r8[4 + i]; r4[i] = keep + __float_as_int(xor2f(__int_as_float(send))); } }
    { const bool hi = dc & 1;
#pragma unroll
      for (int i = 0; i < 2; ++i) { const int keep = hi ? r4[2 + i] : r4[i], send = hi ? r4[i] : r4[2 + i]; r2[i] = keep + __float_as_int(xor1f(__int_as_float(send))); } }
    *(unsigned*)(part + (size_t)t * 128) = pack2((float)r2[0], (float)r2[1]);
  }
}
DI void phase_ffn_w(const Params& p) {
  char* ws = p.ws;
  const int lane = otid() & 63, wave = otid() >> 6;
  const bf16_t* part = (const bf16_t*)(ws + OFF_PART);
  const f32x2* sc2 = (const f32x2*)(ws + OFF_SCU);
  const unsigned short* eidx = (const unsigned short*)(ws + OFF_EIDX);
  const bf16_t* pgate = (const bf16_t*)(ws + OFF_PGATE);
  bf16_t* wbuf = (bf16_t*)(ws + OFF_WBUF);
  const int G = gridDim.x, NG = NTOK / NW;
  for (int g0 = blockIdx.x; g0 < NG; g0 += 4 * G) {
    unsigned pp[4][8]; unsigned gv2[4]; float shv[4]; unsigned ev[4];
#pragma unroll
    for (int r = 0; r < 4; ++r) {
      const int tok = min(g0 + r * G, NG - 1) * NW + wave;
      const size_t o = (size_t)tok * 128 + 2 * lane;
#pragma unroll
      for (int s8 = 0; s8 < 8; ++s8) pp[r][s8] = *(const unsigned*)(part + (size_t)s8 * NTOK * 128 + o);
      ev[r] = *(const unsigned*)(eidx + o); gv2[r] = *(const unsigned*)(pgate + o);
      shv[r] = ((const float*)(ws + OFF_SH))[tok];
    }
    float su0[4], su1[4], sv0[4], sv1[4];
#pragma unroll
    for (int r = 0; r < 4; ++r) { const unsigned ea = ev[r] & 0xffffu, eb = ev[r] >> 16; const f32x2 sa_ = sc2[ea], sb_ = sc2[eb]; su0[r] = sa_.x; sv0[r] = sa_.y; su1[r] = sb_.x; sv1[r] = sb_.y; }
#pragma unroll
    for (int r = 0; r < 4; ++r) {
      if (g0 + r * G >= NG) break;
      const size_t o = (size_t)((g0 + r * G) * NW + wave) * 128 + 2 * lane;
      float a0 = 0.f, a1 = 0.f;
#pragma unroll
      for (int s8 = 0; s8 < 8; ++s8) { a0 += bflo(pp[r][s8]); a1 += bfhi(pp[r][s8]); }
      *(unsigned*)(wbuf + o) = pack2(bflo(gv2[r]) * gelu_f(a0 * (su0[r] * shv[r])) * sv0[r], bfhi(gv2[r]) * gelu_f(a1 * (su1[r] * shv[r])) * sv1[r]);
    }
  }
}
DI void ffv_store(const f32x2 (&acc2)[8], bf16_t* dst, int lane) {
  float acc[16];
#pragma unroll
  for (int i = 0; i < 8; ++i) { acc[2 * i] = acc2[i].x; acc[2 * i + 1] = acc2[i].y; }
  float r8[8], r4[4], r2[2];
  { const bool hi = lane & 32;
#pragma unroll
    for (int i = 0; i < 8; ++i) { const float keep = hi ? acc[8 + i] : acc[i], send = hi ? acc[i] : acc[8 + i]; r8[i] = keep + xor32f(send, lane); } }
  { const bool hi = lane & 16;
#pragma unroll
    for (int i = 0; i < 4; ++i) { const float keep = hi ? r8[4 + i] : r8[i], send = hi ? r8[i] : r8[4 + i]; r4[i] = keep + xor16f(send, lane); } }
  { const bool hi = lane & 8;
#pragma unroll
    for (int i = 0; i < 2; ++i) { const float keep = hi ? r4[2 + i] : r4[i], send = hi ? r4[i] : r4[2 + i]; r2[i] = keep + xor8f(send); } }
  *(unsigned*)dst = pack2(r2[0], r2[1]);
}
DI void phase_ffn_v(const Params& p) {
  char* ws = p.ws;
  const int lane = otid() & 63, wave = otid() >> 6, pg = lane >> 3, dc = lane & 7;
  const int sl = blockIdx.x & 7, wslot = (blockIdx.x >> 3) * NW + wave, nw = (gridDim.x >> 3) * NW;
  const unsigned char* PV8 = (const unsigned char*)(ws + OFF_PV8) + (size_t)sl * 16384 * 128 + dc * 16;
  const unsigned short* eidx = (const unsigned short*)(ws + OFF_EIDX) + 16 * pg;
  const bf16_t* wbuf = (const bf16_t*)(ws + OFF_WBUF) + 16 * pg;
  bf16_t* ffnb = (bf16_t*)(ws + OFF_FFNB) + sl * 128 + dc * 16 + 2 * pg;
#define FFV_TOK(t_) min((t_), NTOK - 1)
#define FFV_LDE(S, t_) { const unsigned short* ep_ = eidx + (size_t)FFV_TOK(t_) * 128; S##e0 = *(const u32x4*)ep_; S##e1 = *(const u32x4*)(ep_ + 8); }
#define FFV_LDW(S, t_) { const bf16_t* wp_ = wbuf + (size_t)FFV_TOK(t_) * 128; S##w0 = *(const u32x4*)wp_; S##w1 = *(const u32x4*)(wp_ + 8); }
#define FFV_E(S, it) (((it) & 1) ? (((it) < 8 ? S##e0 : S##e1)[((it) >> 1) & 3] >> 16) : (((it) < 8 ? S##e0 : S##e1)[((it) >> 1) & 3] & 0xffffu))
#define FFV_W(S, it) (((it) & 1) ? bfhi(((it) < 8 ? S##w0 : S##w1)[((it) >> 1) & 3]) : bflo(((it) < 8 ? S##w0 : S##w1)[((it) >> 1) & 3]))
#define FFV_LDR1(S, it) S##r##it = *(const u32x4*)(PV8 + (size_t)FFV_E(S, it) * 128);
#define FFV_LDR(S) FFV_LDR1(S, 0) FFV_LDR1(S, 1) FFV_LDR1(S, 2) FFV_LDR1(S, 3) FFV_LDR1(S, 4) FFV_LDR1(S, 5) FFV_LDR1(S, 6) FFV_LDR1(S, 7) \
                   FFV_LDR1(S, 8) FFV_LDR1(S, 9) FFV_LDR1(S, 10) FFV_LDR1(S, 11) FFV_LDR1(S, 12) FFV_LDR1(S, 13) FFV_LDR1(S, 14) FFV_LDR1(S, 15)
#define FFV_CP(S, it) { const float wj = FFV_W(S, it); const f32x2 w2 = {wj, wj}; \
      acc2[0] += __builtin_amdgcn_cvt_pk_f32_fp8((int)S##r##it.x, false) * w2; acc2[1] += __builtin_amdgcn_cvt_pk_f32_fp8((int)S##r##it.x, true) * w2; \
      acc2[2] += __builtin_amdgcn_cvt_pk_f32_fp8((int)S##r##it.y, false) * w2; acc2[3] += __builtin_amdgcn_cvt_pk_f32_fp8((int)S##r##it.y, true) * w2; \
      acc2[4] += __builtin_amdgcn_cvt_pk_f32_fp8((int)S##r##it.z, false) * w2; acc2[5] += __builtin_amdgcn_cvt_pk_f32_fp8((int)S##r##it.z, true) * w2; \
      acc2[6] += __builtin_amdgcn_cvt_pk_f32_fp8((int)S##r##it.w, false) * w2; acc2[7] += __builtin_amdgcn_cvt_pk_f32_fp8((int)S##r##it.w, true) * w2; }
#define FFV_ACC(S, t_) { f32x2 acc2[8]; _Pragma("unroll") for (int i_ = 0; i_ < 8; ++i_) acc2[i_] = (f32x2){0.f, 0.f}; \
    FFV_CP(S, 0) FFV_CP(S, 1) FFV_CP(S, 2) FFV_CP(S, 3) FFV_CP(S, 4) FFV_CP(S, 5) FFV_CP(S, 6) FFV_CP(S, 7) \
    FFV_CP(S, 8) FFV_CP(S, 9) FFV_CP(S, 10) FFV_CP(S, 11) FFV_CP(S, 12) FFV_CP(S, 13) FFV_CP(S, 14) FFV_CP(S, 15) \
    ffv_store(acc2, ffnb + (size_t)FFV_TOK(t_) * DM, lane); }
  u32x4 Ae0, Ae1, Be0, Be1, Aw0, Aw1, Bw0, Bw1;
  u32x4 Ar0, Ar1, Ar2, Ar3, Ar4, Ar5, Ar6, Ar7, Ar8, Ar9, Ar10, Ar11, Ar12, Ar13, Ar14, Ar15;
  u32x4 Br0, Br1, Br2, Br3, Br4, Br5, Br6, Br7, Br8, Br9, Br10, Br11, Br12, Br13, Br14, Br15;
  if (wslot >= NTOK) return;
  FFV_LDE(A, wslot) FFV_LDE(B, wslot + nw) FFV_LDW(A, wslot)
  FFV_LDR(A)
  FFV_LDE(A, wslot + 2 * nw)
#pragma unroll 1
  for (int t = wslot; t < NTOK; t += 2 * nw) {
    FFV_LDR(B) FFV_LDW(B, t + nw)
    __builtin_amdgcn_sched_barrier(0);
    FFV_ACC(A, t)
    __builtin_amdgcn_sched_barrier(0);
    FFV_LDR(A) FFV_LDW(A, t + 2 * nw) FFV_LDE(B, t + 3 * nw)
    __builtin_amdgcn_sched_barrier(0);
    FFV_ACC(B, t + nw)
    __builtin_amdgcn_sched_barrier(0);
    FFV_LDE(A, t + 4 * nw)
  }
}
DI void phase_final(const Params& p) {
  char* ws = p.ws;
  const int lane = otid() & 63, wave = otid() >> 6;
  const bf16_t* y = (const bf16_t*)(ws + OFF_Y);
  const bf16_t* ffnb = (const bf16_t*)(ws + OFF_FFNB);
  const float* mod = (const float*)(ws + OFF_MOD);
  f32x4 gv[4], bv[4], g1v[4], b1v[4];
#pragma unroll
  for (int i = 0; i < 4; ++i) {
    gv[i] = *(const f32x4*)(p.ln2_g + i * 256 + lane * 4); bv[i] = *(const f32x4*)(p.ln2_b + i * 256 + lane * 4);
    g1v[i] = *(const f32x4*)(p.ln1_g + i * 256 + lane * 4) * DN_ALPHA; b1v[i] = *(const f32x4*)(p.ln1_b + i * 256 + lane * 4) * DN_ALPHA;
  }
  for (int grp = blockIdx.x; grp < NTOK / NW; grp += gridDim.x) {
    const int row = grp * NW + wave, b = row >> 13;
    float v[16]; u32x2 fr[4]; f32x4 gt2[4];
#pragma unroll
    for (int i = 0; i < 4; ++i) {
      const int col = i * 256 + lane * 4;
      const u32x2 yr = *(const u32x2*)(y + (size_t)row * DM + col);
      fr[i] = *(const u32x2*)(ffnb + (size_t)row * DM + col);
      gt2[i] = *(const f32x4*)(mod + b * 6144 + 5120 + col);
      v[4 * i] = bflo(yr.x); v[4 * i + 1] = bfhi(yr.x); v[4 * i + 2] = bflo(yr.y); v[4 * i + 3] = bfhi(yr.y);
    }
    float mean, rstd; row_stats(v, mean, rstd);
#pragma unroll
    for (int i = 0; i < 4; ++i) {
      const f32x4 g = g1v[i], bb = b1v[i], t2 = gt2[i];
      v[4 * i] = (v[4 * i] - mean) * rstd * g.x + bb.x + t2.x * bflo(fr[i].x); v[4 * i + 1] = (v[4 * i + 1] - mean) * rstd * g.y + bb.y + t2.y * bfhi(fr[i].x);
      v[4 * i + 2] = (v[4 * i + 2] - mean) * rstd * g.z + bb.z + t2.z * bflo(fr[i].y); v[4 * i + 3] = (v[4 * i + 3] - mean) * rstd * g.w + bb.w + t2.w * bfhi(fr[i].y);
    }
    row_stats(v, mean, rstd);
#pragma unroll
    for (int i = 0; i < 4; ++i) {
      const int col = i * 256 + lane * 4;
      const f32x4 g = gv[i], bb = bv[i];
      f32x4 o;
      o.x = (v[4 * i] - mean) * rstd * g.x + bb.x; o.y = (v[4 * i + 1] - mean) * rstd * g.y + bb.y;
      o.z = (v[4 * i + 2] - mean) * rstd * g.z + bb.z; o.w = (v[4 * i + 3] - mean) * rstd * g.w + bb.w;
      *(f32x4*)(p.out + (size_t)row * DM + col) = o;
    }
  }
}

#define XB_TMO      128
#define XB_XCNT(j)  (256  + 64 * (j))
#define XB_XSUB(j)  (1280 + 64 * (j))
#define XB_XGEN(j)  (2304 + 64 * (j))
#define XB_TOP      3328
#define XB_TOPGEN   3392
#define XCD_BAR_WORDS 3456
#define XB_SPIN_CAP (1u << 22)
DI unsigned xb_ld(unsigned* p) { return __hip_atomic_load(p, __ATOMIC_RELAXED, __HIP_MEMORY_SCOPE_AGENT); }
DI unsigned xb_add(unsigned* p, unsigned v) { return __hip_atomic_fetch_add(p, v, __ATOMIC_RELAXED, __HIP_MEMORY_SCOPE_AGENT); }
DI unsigned xb_xcc_id() { return (unsigned)__builtin_amdgcn_s_getreg((3 << 11) | 20) & 0xFu; }
#define XB_SPIN(cond, bar) do { unsigned _sp = 0; while (cond) { __builtin_amdgcn_s_sleep(1); \
    if ((++_sp & 255u) == 0u) { if (xb_ld(&(bar)[XB_TMO])) break; if (_sp > XB_SPIN_CAP) { atomicAdd(&(bar)[XB_TMO], 1u); break; } } } } while (0)
struct XcdBarrier { unsigned* bar; unsigned x; volatile LAS unsigned* st; };
DI XcdBarrier xcd_barrier_post(unsigned* bar, volatile LAS unsigned* st) {
  XcdBarrier b; b.bar = bar; b.x = xb_xcc_id(); b.st = st;
  if (threadIdx.x == 0) (void)xb_add(&bar[XB_XCNT(b.x)], 1u);
  return b;
}
DI void xcd_barrier_complete(unsigned* bar, unsigned x, unsigned& nloc, unsigned& nx) {
  const unsigned G = gridDim.x * gridDim.y * gridDim.z;
  unsigned sum, cnt, mine, sp = 0u;
  for (;;) {
    sum = 0u; cnt = 0u; mine = 0u;
#pragma unroll
    for (unsigned j = 0; j < 16; ++j) { const unsigned c = xb_ld(&bar[XB_XCNT(j)]); sum += c; cnt += (c > 0u) ? 1u : 0u; mine = (j == x) ? c : mine; }
    if (sum == G) break;
    __builtin_amdgcn_s_sleep(1);
    if ((++sp & 255u) == 0u) { if (xb_ld(&bar[XB_TMO])) break; if (sp > XB_SPIN_CAP) { atomicAdd(&bar[XB_TMO], 1u); break; } }
  }
  nloc = mine > 0u ? mine : 1u; nx = cnt > 0u ? cnt : 1u;
}
DI void xcd_barrier(const XcdBarrier& b) {
  asm volatile("s_waitcnt vmcnt(0)" ::: "memory");
  __syncthreads();
  if (threadIdx.x == 0) {
    unsigned* bar = b.bar;
    __builtin_amdgcn_s_waitcnt(0);
    unsigned nloc = b.st[0], nx = b.st[1];
    if (nloc == 0u) { xcd_barrier_complete(bar, b.x, nloc, nx); b.st[0] = nloc; b.st[1] = nx; }
    const unsigned old = xb_add(&bar[XB_XSUB(b.x)], 1u);
    const unsigned gen = old / nloc;
    if (old + 1u == (gen + 1u) * nloc) {
      __builtin_amdgcn_fence(__ATOMIC_RELEASE, "agent");
      asm volatile("s_waitcnt vmcnt(0)" ::: "memory");
      const unsigned og = xb_add(&bar[XB_TOP], 1u);
      const unsigned tg = og / nx;
      if (og + 1u == (tg + 1u) * nx) xb_add(&bar[XB_TOPGEN], 1u);
      else XB_SPIN(xb_ld(&bar[XB_TOPGEN]) == tg, bar);
      __builtin_amdgcn_fence(__ATOMIC_ACQUIRE, "agent");
      xb_add(&bar[XB_XGEN(b.x)], 1u);
      asm volatile("s_waitcnt vmcnt(0)" ::: "memory");
    } else {
      XB_SPIN(xb_ld(&bar[XB_XGEN(b.x)]) == gen, bar);
      __builtin_amdgcn_fence(__ATOMIC_ACQUIRE, "agent");
      asm volatile("s_waitcnt vmcnt(0)" ::: "memory");
    }
  }
  __syncthreads();
}

constexpr int SMEM_BYTES = 147456 + 256;

__global__ void __launch_bounds__(NT, 2) k_mega(Params p) {
  __shared__ __attribute__((aligned(16))) char smem[SMEM_BYTES];
  cg::grid_group grid = cg::this_grid();
  if (threadIdx.x == 0) *(u32x4*)(smem + 147456) = (u32x4){0u, 0u, 0u, 0u};
  __syncthreads();
  const XcdBarrier xb = xcd_barrier_post((unsigned*)(p.ws + OFF_BAR), (volatile LAS unsigned*)(smem + 147456));
#define REP(mask) _Pragma("unroll 1") for (int rep_ = 0; rep_ < ((PROBE_DUP & (mask)) ? 2 : 1); ++rep_)
  REP(1) phase_prep(p, smem, (unsigned*)(p.ws + OFF_BAR) + XCD_BAR_WORDS + rep_);
  grid.sync();
  REP(1) phase_ln_in(p);
  xcd_barrier(xb);
  REP(2) phase_gemm1(p, smem);
  xcd_barrier(xb);
  REP(4) phase_compress(p, smem);
  phase_sgu(p, smem);
  xcd_barrier(xb);
  REP(8) phase_nsa(p, smem, NSA_MASK);
  xcd_barrier(xb);
  REP(16) phase_merge(p, smem);
  xcd_barrier(xb);
  REP(16) phase_outproj(p, smem);
  xcd_barrier(xb);
  REP(1) phase_ln_mid(p);
  xcd_barrier(xb);
  REP(32) phase_peerq(p, smem);
  xcd_barrier(xb);
  REP(64) phase_route(p, smem);
  xcd_barrier(xb);
  REP(128) phase_ffn_u(p);
  xcd_barrier(xb);
  REP(128) phase_ffn_w(p);
  xcd_barrier(xb);
  REP(256) phase_ffn_v(p);
  xcd_barrier(xb);
  REP(512) phase_final(p);
}

extern "C" void kernel_launch(void* const* d_in, const int* in_sizes, int n_in, void* d_out, int out_size, void* d_ws, size_t ws_size, hipStream_t stream) {
  if (ws_size < OFF_END) { fprintf(stderr, "workspace too small: %zu < %zu\n", ws_size, (size_t)OFF_END); return; }
  static int grid_blocks = 0;
  if (!grid_blocks) {
    int dev = 0, cus = 0, per_cu = 0;
    (void)hipGetDevice(&dev);
    (void)hipDeviceGetAttribute(&cus, hipDeviceAttributeMultiprocessorCount, dev);
    (void)hipOccupancyMaxActiveBlocksPerMultiprocessor(&per_cu, k_mega, NT, 0);
    if (per_cu < 1) fprintf(stderr, "occupancy query returned %d\n", per_cu);
    grid_blocks = (cus / 8) * 8;
  }
  Params p{};
  const float** fp = (const float**)&p;
  for (int i = 0; i < 26; ++i) fp[i] = (const float*)d_in[i];
  p.out = (float*)d_out;
  p.ws = (char*)d_ws;
  for (int i = 0; i < 32; ++i) p.inv_freq[i] = (float)pow(10000.0, -(double)i / 32.0);
  (void)hipMemsetAsync((char*)d_ws + OFF_BAR, 0, (XCD_BAR_WORDS + 64) * 4, stream);
  void* args[] = {&p};
  hipError_t e = hipLaunchCooperativeKernel((void*)k_mega, dim3(grid_blocks), dim3(NT), args, 0, stream);
  if (e != hipSuccess) fprintf(stderr, "cooperative launch failed: %s (grid %d)\n", hipGetErrorString(e), grid_blocks);
}
```
